# Optimizing an MI355X kernel written in HIP

```python
import jax, jax.numpy as jnp
from jax import lax
import numpy as np

D_MODEL = 2048
BATCH = 4
SEQ = 2048
DEPTH = 2

CHUNK = 64
Q_BLOCK = 128
HEAD_DIM = 128
MIX_WIDTH = D_MODEL // 4
N_BRANCH = 4
N_HEADS_FOX = MIX_WIDTH // HEAD_DIM
N_HEADS_CHUNK = MIX_WIDTH // HEAD_DIM
FOX_WIDTH = N_HEADS_FOX * HEAD_DIM
CHUNK_WIDTH = N_HEADS_CHUNK * HEAD_DIM
POOL_WIDTH = MIX_WIDTH
POOL_WINDOWS = (2, 4, 8, 16)
POOL_GROUPS = len(POOL_WINDOWS)
POOL_GROUP = POOL_WIDTH // POOL_GROUPS
CONV_WIDTH = MIX_WIDTH
CONV_K = 3
LEFT_CHUNKS = 8
BAND = LEFT_CHUNKS + 1
REL_CLIP = 256
REL_SIZE = REL_CLIP + CHUNK
PEER_HEADS = 8
PEER_KEYS = 128
PEER_EXPERTS = PEER_KEYS * PEER_KEYS
PEER_QDIM = 256
PEER_HALF = PEER_QDIM // 2
PEER_TOPK = 16
PEER_TOKEN_BLOCK = 128
EPS = 1e-6

SPLIT_SIZES = (FOX_WIDTH, FOX_WIDTH, FOX_WIDTH, N_HEADS_FOX,
               POOL_WIDTH,
               CONV_WIDTH, CONV_WIDTH, CONV_WIDTH,
               CHUNK_WIDTH, CHUNK_WIDTH, CHUNK_WIDTH,
               N_BRANCH * D_MODEL)
SPLIT_POINTS = tuple(sum(SPLIT_SIZES[:i + 1]) for i in range(len(SPLIT_SIZES) - 1))
IN_WIDTH = sum(SPLIT_SIZES)
FORGET_OFFSET = 3 * FOX_WIDTH

kernel_name = "hybrid_chunk_causal_peer_block"


def rmsnorm(x, g):
    x32 = x.astype(jnp.float32)
    y = x32 * lax.rsqrt(jnp.mean(x32 * x32, axis=-1, keepdims=True) + EPS)
    return y.astype(x.dtype) * g


def forgetting_attention(q, k, v, log_f):
    b, s, h, dh = q.shape
    scale = dh ** -0.5
    cum = jnp.cumsum(log_f, axis=1).transpose(0, 2, 1)
    outs = []
    for i in range(s // Q_BLOCK):
        q0, q1 = i * Q_BLOCK, (i + 1) * Q_BLOCK
        logits = jnp.einsum('bqhd,bkhd->bhqk', q[:, q0:q1], k[:, :q1]).astype(jnp.float32) * scale
        decay = cum[:, :, q0:q1, None] - cum[:, :, None, :q1]
        causal = jnp.arange(q1)[None, :] <= jnp.arange(q0, q1)[:, None]
        logits = jnp.where(causal, logits + decay, -jnp.inf)
        p = jax.nn.softmax(logits, axis=-1)
        outs.append(jnp.einsum('bhqk,bkhd->bqhd', p.astype(v.dtype), v[:, :q1]))
    return jnp.concatenate(outs, axis=1)


def multiscale_pool(p, group_w, scale):
    b, s, c = p.shape
    pg = p.reshape(b, s, POOL_GROUPS, POOL_GROUP).astype(jnp.float32)
    csum = jnp.concatenate([jnp.zeros((b, 1, POOL_GROUPS, POOL_GROUP), jnp.float32),
                            jnp.cumsum(pg, axis=1)], axis=1)
    t = jnp.arange(s)
    outs = []
    for gi, w in enumerate(POOL_WINDOWS):
        start = jnp.maximum(t + 1 - w, 0)
        count = (t + 1 - start).astype(jnp.float32)
        cg = csum[:, :, gi]
        mean = (cg[:, 1:] - cg[:, start]) / count[None, :, None]
        outs.append(mean - pg[:, :, gi])
    pooled = jnp.stack(outs, axis=2).astype(p.dtype)
    mixed = jnp.einsum('bsgc,gcd->bsgd', pooled, group_w)
    return mixed.reshape(b, s, c) * scale


def short_gated_conv(hx, gate_b, gate_c, conv_w):
    s = hx.shape[1]
    z = gate_c * hx
    zp = jnp.pad(z, ((0, 0), (CONV_K - 1, 0), (0, 0)))
    acc = conv_w[0] * zp[:, 0:s]
    for j in range(1, CONV_K):
        acc = acc + conv_w[j] * zp[:, j:j + s]
    return gate_b * acc


def chunked_rel_attention(q, k, v, rel_bias):
    b, s, h, dh = q.shape
    nc = s // CHUNK
    qc = q.reshape(b, nc, CHUNK, h, dh)

    def band_of(x):
        xc = x.reshape(b, nc, CHUNK, h, dh)
        xp = jnp.pad(xc, ((0, 0), (LEFT_CHUNKS, 0), (0, 0), (0, 0), (0, 0)))
        return jnp.stack([xp[:, j:j + nc] for j in range(BAND)], axis=2).reshape(b, nc, BAND * CHUNK, h, dh)

    kb, vb = band_of(k), band_of(v)
    logits = jnp.einsum('bcqhd,bckhd->bchqk', qc, kb).astype(jnp.float32) * dh ** -0.5
    qpos = LEFT_CHUNKS * CHUNK + jnp.arange(CHUNK)
    kpos = jnp.arange(BAND * CHUNK)
    dist = qpos[:, None] - kpos[None, :]
    idx = jnp.clip(dist, -(CHUNK - 1), REL_CLIP) + (CHUNK - 1)
    bias = rel_bias[:, idx].astype(jnp.float32)
    chunk_id = jnp.arange(nc)[:, None] + (kpos // CHUNK)[None, :] - LEFT_CHUNKS
    valid = (chunk_id >= 0)[None, :, None, None, :]
    logits = jnp.where(valid, logits + bias, -jnp.inf)
    p = jax.nn.softmax(logits, axis=-1)
    out = jnp.einsum('bchqk,bckhd->bcqhd', p.astype(v.dtype), vb)
    return out.reshape(b, s, h, dh)


def peer_ffn(x, w_q, sub_keys, expert_u, expert_v):
    b, s, d = x.shape
    q = (x @ w_q).reshape(b, s, PEER_HEADS, 2, PEER_HALF)
    scores = jnp.einsum('bshpc,hpkc->bshpk', q, sub_keys).astype(jnp.float32)
    top_s, top_i = lax.top_k(scores, PEER_TOPK)
    cand_s = (top_s[..., 0, :, None] + top_s[..., 1, None, :]).reshape(b, s, PEER_HEADS, PEER_TOPK * PEER_TOPK)
    cand_i = (top_i[..., 0, :, None] * PEER_KEYS + top_i[..., 1, None, :]).reshape(b, s, PEER_HEADS, PEER_TOPK * PEER_TOPK)
    best_s, pos = lax.top_k(cand_s, PEER_TOPK)
    expert_idx = jnp.take_along_axis(cand_i, pos, axis=-1)
    gates = jax.nn.softmax(best_s, axis=-1).astype(x.dtype)
    n_blk = (b * s) // PEER_TOKEN_BLOCK
    xt = x.reshape(n_blk, PEER_TOKEN_BLOCK, d)
    it = expert_idx.reshape(n_blk, PEER_TOKEN_BLOCK, PEER_HEADS * PEER_TOPK)
    gt = gates.reshape(n_blk, PEER_TOKEN_BLOCK, PEER_HEADS * PEER_TOPK)

    def token_block(args):
        xb, ib, gb = args
        act = jax.nn.gelu(jnp.einsum('tkd,td->tk', expert_u[ib], xb))
        return jnp.einsum('tk,tkd->td', gb * act, expert_v[ib])

    y = lax.map(token_block, (xt, it, gt))
    return y.reshape(b, s, d)


def setup_inputs(seed: int = 0) -> dict:
    key = jax.random.key(seed)
    ks = jax.random.split(key, 17)
    f32 = jnp.float32

    def nrm(k, shape, scale):
        return jax.random.normal(k, shape, f32) * scale

    x = nrm(ks[0], (BATCH, SEQ, D_MODEL), 1.0)
    norm_mix = 1.0 + nrm(ks[1], (DEPTH, D_MODEL), 0.05)
    w_in = nrm(ks[2], (DEPTH, D_MODEL, IN_WIDTH), D_MODEL ** -0.5)
    b_in = nrm(ks[3], (DEPTH, IN_WIDTH), 0.01)
    forget_bias = jax.random.uniform(ks[4], (DEPTH, N_HEADS_FOX), f32, 1.0, 4.0)
    b_in = b_in.at[:, FORGET_OFFSET:FORGET_OFFSET + N_HEADS_FOX].set(forget_bias)
    pool_w = nrm(ks[5], (DEPTH, POOL_GROUPS, POOL_GROUP, POOL_GROUP), POOL_GROUP ** -0.5)
    pool_scale = 1.0 + nrm(ks[6], (DEPTH, POOL_WIDTH), 0.1)
    conv_w = nrm(ks[7], (DEPTH, CONV_K, CONV_WIDTH), CONV_K ** -0.5)
    rel_bias = nrm(ks[8], (DEPTH, N_HEADS_CHUNK, REL_SIZE), 0.5)
    w_branch = nrm(ks[9], (DEPTH, N_BRANCH, MIX_WIDTH, D_MODEL), MIX_WIDTH ** -0.5)
    w_out = nrm(ks[10], (DEPTH, D_MODEL, D_MODEL), D_MODEL ** -0.5)
    norm_ffn = 1.0 + nrm(ks[11], (DEPTH, D_MODEL), 0.05)
    peer_wq = nrm(ks[12], (DEPTH, D_MODEL, PEER_HEADS * PEER_QDIM), D_MODEL ** -0.5)
    peer_keys = nrm(ks[13], (DEPTH, PEER_HEADS, 2, PEER_KEYS, PEER_HALF), PEER_HALF ** -0.5)
    peer_u = nrm(ks[14], (DEPTH, PEER_EXPERTS, D_MODEL), D_MODEL ** -0.5)
    peer_v = nrm(ks[15], (DEPTH, PEER_EXPERTS, D_MODEL), PEER_HEADS ** -0.5)
    norm_final = 1.0 + nrm(ks[16], (D_MODEL,), 0.05)
    return {"x": x, "norm_mix": norm_mix, "w_in": w_in, "b_in": b_in, "pool_w": pool_w,
            "pool_scale": pool_scale, "conv_w": conv_w, "rel_bias": rel_bias, "w_branch": w_branch,
            "w_out": w_out, "norm_ffn": norm_ffn, "peer_wq": peer_wq, "peer_keys": peer_keys,
            "peer_u": peer_u, "peer_v": peer_v, "norm_final": norm_final}


def reference(x, norm_mix, w_in, b_in, pool_w, pool_scale, conv_w, rel_bias, w_branch,
              w_out, norm_ffn, peer_wq, peer_keys, peer_u, peer_v, norm_final):
    b, s, d = x.shape
    h = x
    for l in range(DEPTH):
        xn = rmsnorm(h, norm_mix[l])
        proj = xn @ w_in[l] + b_in[l]
        (fq, fk, fv, f_logit, pool_in, conv_h, conv_b, conv_c,
         cq, ck, cv, gate_logit) = jnp.split(proj, SPLIT_POINTS, axis=-1)

        heads = lambda t: t.reshape(b, s, -1, HEAD_DIM)
        log_f = jax.nn.log_sigmoid(f_logit.astype(jnp.float32))
        y_fox = forgetting_attention(heads(fq), heads(fk), heads(fv), log_f).reshape(b, s, FOX_WIDTH)
        y_pool = multiscale_pool(pool_in, pool_w[l], pool_scale[l])
        y_conv = short_gated_conv(conv_h, conv_b, conv_c, conv_w[l])
        y_chunk = chunked_rel_attention(heads(cq), heads(ck), heads(cv), rel_bias[l]).reshape(b, s, CHUNK_WIDTH)

        branches = jnp.stack([y_fox, y_pool, y_conv, y_chunk], axis=2)
        branch_d = jnp.einsum('bsnc,ncd->bsnd', branches, w_branch[l])
        gates = jax.nn.sigmoid(gate_logit.reshape(b, s, N_BRANCH, d))
        merged = jnp.sum(gates * branch_d, axis=2)
        h = h + merged @ w_out[l]

        hn = rmsnorm(h, norm_ffn[l])
        h = h + peer_ffn(hn, peer_wq[l], peer_keys[l], peer_u[l], peer_v[l])
    return rmsnorm(h, norm_final)
```

```cpp
#include <hip/hip_runtime.h>
#include <hip/hip_cooperative_groups.h>
#include <cstdio>
#include <cstdint>
namespace cg = cooperative_groups;
namespace pg8 {
#define PG8_LAS __attribute__((address_space(3)))
typedef unsigned short bf16_t;
typedef short bf16x8 __attribute__((ext_vector_type(8)));
typedef float f32x4 __attribute__((ext_vector_type(4)));
typedef unsigned u32x4 __attribute__((ext_vector_type(4)));
typedef unsigned u32x2 __attribute__((ext_vector_type(2)));
constexpr int BM = 256, BK = 64, HALF = 128, HTB = HALF * BK * 2  , STAGE_BYTES = 8 * HTB, NXCD = 8, WGM = 8;

__host__ __device__ __forceinline__ int lds_byte(int r, int c) { const int st = (r >> 4) * 2 + (c >> 5), rr = r & 15, cc = c & 31, ob = rr * 64 + cc * 2; return st * 1024 + (ob ^ (((ob >> 9) & 1) << 5)); }
__host__ __device__ __forceinline__ void stage_rc(int b, int& R, int& C) { const int st = b / 1024, sb = b % 1024, swz = sb ^ (((sb >> 9) & 1) << 5); R = (st >> 1) * 16 + swz / 64; C = (st & 1) * 32 + (swz % 64) / 2; }
__host__ __device__ __forceinline__ int perm32(int rho) { const int n = rho >> 4, i = rho & 15; return 8 * (i >> 2) + 4 * n + (i & 3); }

struct Unit { int pm, pn; };
struct Gemm { const bf16_t* A; const bf16_t* Bt; int M, N, K; };

struct StaticOrder {
    int nM, nN, nwg, G, c;
    __host__ __device__ void init(int M, int N, int G_, int c_) { nM = M / BM; nN = N / BM; nwg = nM * nN; G = G_; c = c_; }
    __host__ __device__ bool next(int i, Unit& u) const {
        const long L = (long)i * G + c; if (L >= nwg) return false;
        int wgid = (int)L; { const int q = nwg / NXCD, r = nwg % NXCD, xcd = wgid % NXCD, off = wgid / NXCD; wgid = (xcd < r ? xcd * (q + 1) : r * (q + 1) + (xcd - r) * q) + off; }
        const int nig = WGM * nN, gid = wgid / nig, fm = gid * WGM, gsz = (nM - fm) < WGM ? (nM - fm) : WGM;
        u.pm = fm + ((wgid % nig) % gsz); u.pn = (wgid % nig) / gsz; return true;
    }
};

__device__ __forceinline__ unsigned cvt_pk_bf16(float lo, float hi) { unsigned r; asm volatile("v_cvt_pk_bf16_f32 %0, %1, %2" : "=v"(r) : "v"(lo), "v"(hi)); return r; }

template <class Epi, class Sched, bool ALIGN_EPI = false>
__device__ __forceinline__ void gemm_phase(PG8_LAS unsigned char* lds, const Gemm g, const Sched& S, const Epi& E, int wid) {
    int lane_; asm volatile("v_mbcnt_lo_u32_b32 %0, -1, 0\n\tv_mbcnt_hi_u32_b32 %0, -1, %0" : "=v"(lane_));
    const int lane = lane_, tid = wid * 64 + lane, wr = wid >> 2, wc = wid & 3, fr = lane & 15, fq = lane >> 4;
    const int K = g.K, nt = K / BK;
    unsigned voffA[2], voffB[2];
#pragma unroll
    for (int i = 0; i < 2; ++i) { int R, C; stage_rc(tid * 16 + i * 8192, R, C); const int Rb = Epi::PERM ? ((R & ~31) + perm32(R & 31)) : R;
        voffA[i] = (unsigned)(R * K + C) * 2u; voffB[i] = (unsigned)(Rb * K + C) * 2u; }
    const size_t kstep = (size_t)(BK * 2);
    const size_t hstep = (size_t)HALF * K * 2;
    const size_t tstep = 2 * hstep;
    const unsigned ldsw = (unsigned)wid * 1024u;
    const int aoff = lds_byte(wr * 64 + fr, fq * 8), boff = lds_byte(wc * 32 + fr, fq * 8);
#define PG8_SA(b, h) (((b) * 2 + (h)) * HTB)
#define PG8_SB(b, h) ((4 + (b) * 2 + (h)) * HTB)
#define PG8_STAGE(bufoff, gbase, voff) do { _Pragma("unroll") for (int _i = 0; _i < 2; ++_i) \
        __builtin_amdgcn_global_load_lds((const unsigned*)((const char*)(gbase) + (voff)[_i]), (PG8_LAS unsigned*)(lds + (bufoff) + ldsw + _i * 8192), 16, 0, 0); } while (0)
#define PG8_LDA(dst, b, h) do { _Pragma("unroll") for (int m = 0; m < 4; ++m) _Pragma("unroll") for (int k = 0; k < 2; ++k) dst[m][k] = *(const PG8_LAS bf16x8*)(lds + PG8_SA(b, h) + aoff + m * 2048 + k * 1024); } while (0)
#define PG8_LDB(dst, b, h) do { _Pragma("unroll") for (int n = 0; n < 2; ++n) _Pragma("unroll") for (int k = 0; k < 2; ++k) dst[n][k] = *(const PG8_LAS bf16x8*)(lds + PG8_SB(b, h) + boff + n * 2048 + k * 1024); } while (0)
#define PG8_MMA(ai, bj, At, Bt) do { __builtin_amdgcn_s_setprio(1); _Pragma("unroll") for (int m = 0; m < 4; ++m) _Pragma("unroll") for (int n = 0; n < 2; ++n) _Pragma("unroll") for (int k = 0; k < 2; ++k) \
        acc[ai][bj][m][n] = __builtin_amdgcn_mfma_f32_16x16x32_bf16(Bt[n][k], At[m][k], acc[ai][bj][m][n], 0, 0, 0); __builtin_amdgcn_s_setprio(0); } while (0)
#define PG8_WAIT_V(n) asm volatile("s_waitcnt vmcnt(" #n ")" ::: "memory")
#define PG8_WAIT_L(n) asm volatile("s_waitcnt lgkmcnt(" #n ")" ::: "memory")
#define PG8_BAR __builtin_amdgcn_s_barrier()
#define PG8_SCHED __builtin_amdgcn_sched_barrier(0)
    Unit cur, nxt; int ui = 0;
    if (!S.next(0, cur)) return;
    f32x4 acc[2][2][4][2];
#pragma unroll
    for (int a = 0; a < 2; ++a)
#pragma unroll
        for (int b = 0; b < 2; ++b)
#pragma unroll
            for (int m = 0; m < 4; ++m)
#pragma unroll
                for (int n = 0; n < 2; ++n) acc[a][b][m][n] = (f32x4){0.f, 0.f, 0.f, 0.f};
    bf16x8 At[4][2], B0[2][2], B1[2][2];
    const char* cA = (const char*)g.A + (size_t)cur.pm * tstep; const char* cB = (const char*)g.Bt + (size_t)cur.pn * tstep;
    PG8_STAGE(PG8_SB(0, 0), cB, voffB); PG8_STAGE(PG8_SB(0, 1), cB + hstep, voffB); PG8_STAGE(PG8_SA(0, 0), cA, voffA); PG8_STAGE(PG8_SA(0, 1), cA + hstep, voffA);
    if (wr == 1) PG8_BAR;
    PG8_WAIT_V(2); PG8_BAR;
    PG8_STAGE(PG8_SB(1, 0), cB + kstep, voffB); PG8_STAGE(PG8_SA(1, 0), cA + kstep, voffA); PG8_STAGE(PG8_SB(1, 1), cB + hstep + kstep, voffB);
    PG8_WAIT_V(6); PG8_BAR;
    for (;;) {
        const bool has_next = S.next(ui + 1, nxt);
        const char* nA = has_next ? (const char*)g.A + (size_t)nxt.pm * tstep : cA; const char* nB = has_next ? (const char*)g.Bt + (size_t)nxt.pn * tstep : cB;
        const int seglen = Epi::HOOK ? 8 : nt;
        for (int t0 = 0; t0 < nt; t0 += seglen) {
        if constexpr (Epi::HOOK) { if (t0 > 0) E.hook(acc, cur, t0 >> 3, wr, wc, fr, fq); }
        for (int t = t0; t < t0 + seglen; t += 2) {
            const bool last = (t == nt - 2);
            const char* a1 = cA + (size_t)(t + 1) * kstep;
            const char* a2 = last ? nA : cA + (size_t)(t + 2) * kstep; const char* b2 = last ? nB : cB + (size_t)(t + 2) * kstep;
            const char* a3 = a2 + kstep; const char* b3 = b2 + kstep;
            PG8_LDB(B0, 0, 0); PG8_LDB(B1, 0, 1); PG8_SCHED; PG8_LDA(At, 0, 0); PG8_STAGE(PG8_SA(1, 1), a1 + hstep, voffA);
            PG8_WAIT_V(8); PG8_WAIT_L(0); PG8_BAR; PG8_MMA(0, 0, At, B0); PG8_MMA(0, 1, At, B1); PG8_BAR; PG8_SCHED;
            PG8_LDA(At, 0, 1); PG8_STAGE(PG8_SB(0, 0), b2, voffB); PG8_STAGE(PG8_SB(0, 1), b2 + hstep, voffB); PG8_STAGE(PG8_SA(0, 0), a2, voffA);
            PG8_WAIT_V(8); PG8_WAIT_L(0); PG8_BAR; PG8_MMA(1, 0, At, B0); PG8_MMA(1, 1, At, B1); PG8_BAR; PG8_SCHED;
            PG8_LDB(B0, 1, 0); PG8_LDB(B1, 1, 1); PG8_SCHED; PG8_LDA(At, 1, 0); PG8_STAGE(PG8_SA(0, 1), a2 + hstep, voffA);
            PG8_WAIT_V(8); PG8_WAIT_L(0); PG8_BAR; PG8_MMA(0, 0, At, B0); PG8_MMA(0, 1, At, B1); PG8_BAR; PG8_SCHED;
            PG8_LDA(At, 1, 1); PG8_STAGE(PG8_SB(1, 0), b3, voffB); PG8_STAGE(PG8_SB(1, 1), b3 + hstep, voffB); PG8_STAGE(PG8_SA(1, 0), a3, voffA);
            PG8_WAIT_V(8); PG8_WAIT_L(0); PG8_BAR; PG8_MMA(1, 0, At, B0); PG8_MMA(1, 1, At, B1); PG8_BAR; PG8_SCHED;
        }
        }
        if constexpr (ALIGN_EPI) { if (wr == 0) PG8_BAR; }
        E(acc, cur, wr, wc, fr, fq);
        if (!has_next) break;
#pragma unroll
        for (int a = 0; a < 2; ++a)
#pragma unroll
            for (int b = 0; b < 2; ++b)
#pragma unroll
                for (int m = 0; m < 4; ++m)
#pragma unroll
                    for (int n = 0; n < 2; ++n) acc[a][b][m][n] = (f32x4){0.f, 0.f, 0.f, 0.f};
        cur = nxt; cA = nA; cB = nB; ++ui;
        if constexpr (ALIGN_EPI) { if (wr == 1) PG8_BAR; }
    }
    PG8_WAIT_V(0);
    if constexpr (!ALIGN_EPI) { if (wr == 0) PG8_BAR; }
    PG8_BAR;
#undef PG8_SA
#undef PG8_SB
#undef PG8_STAGE
#undef PG8_LDA
#undef PG8_LDB
#undef PG8_MMA
#undef PG8_WAIT_V
#undef PG8_WAIT_L
#undef PG8_BAR
#undef PG8_SCHED
}
}
constexpr int NWAVES = 8, NT = NWAVES * 64;
constexpr int M = 8192, D = 2048, SEQ = 2048, NBATCH = 4, DEPTH = 2;
constexpr int INW = 13316, NPROJ = 13312, MIXW = 512, HD = 128;
constexpr int PEER_E = 16384;
constexpr float EPS = 1e-6f;
constexpr float ATT_SCALE = 0.08838834764831845f;

constexpr size_t MiB = 1u << 20;
constexpr size_t WS_CTL = 0, CTL_ZERO_BYTES = 1 * MiB;
constexpr size_t WS_SSQ = 0;
constexpr size_t WS_SSA = 256 * 1024;
constexpr size_t WS_WF = 1 * MiB;
constexpr size_t WS_BINR = WS_WF + 64 * 1024;
constexpr size_t WS_LOGF = 2 * MiB;
constexpr size_t WS_CUM = 3 * MiB;
constexpr size_t WS_WIN = 8 * MiB;
constexpr size_t WIN_BYTES = (size_t)NPROJ * D * 2;
constexpr size_t WS_WBR = 112 * MiB, WS_WOUT = 128 * MiB, WS_WQ = 144 * MiB;
constexpr size_t SQ_BYTES = (size_t)D * D * 2;
constexpr size_t WS_PU = 160 * MiB, WS_PV = 288 * MiB;
constexpr size_t PE_BYTES = (size_t)PEER_E * D * 2;
constexpr size_t WS_H = 416 * MiB;
constexpr size_t WS_HB = 480 * MiB;
constexpr size_t WS_PROJ = 512 * MiB;
constexpr size_t PROJ_T = (size_t)M * MIXW;
constexpr size_t WS_R = 592 * MiB;
constexpr size_t R_PLANE = (size_t)M * D;
constexpr size_t WS_Y = 720 * MiB;
constexpr size_t WS_MRG = 752 * MiB;
constexpr size_t WS_Q = 784 * MiB;
constexpr size_t WS_END = 816 * MiB;

constexpr int RING_BYTES = 131072;
constexpr int LDS_BYTES = 147456;

typedef unsigned short bf16;
typedef unsigned v4u __attribute__((ext_vector_type(4)));
typedef unsigned v2u __attribute__((ext_vector_type(2)));
typedef float f32x4 __attribute__((ext_vector_type(4)));
typedef float f32x2 __attribute__((ext_vector_type(2)));
using bf16x2 = __attribute__((ext_vector_type(2))) __bf16;
#define LAS __attribute__((address_space(3)))

__device__ __forceinline__ unsigned f2bf(float f) { unsigned u = __builtin_bit_cast(unsigned, f); return (u + 0x7fffu + ((u >> 16) & 1u)) >> 16; }
__device__ __forceinline__ unsigned pk2(float lo, float hi) { return f2bf(lo) | (f2bf(hi) << 16); }
__device__ __forceinline__ float bflo(unsigned w) { return __builtin_bit_cast(float, w << 16); }
__device__ __forceinline__ float bfhi(unsigned w) { return __builtin_bit_cast(float, w & 0xffff0000u); }
__device__ __forceinline__ float bf2f(bf16 b) { return __builtin_bit_cast(float, ((unsigned)b) << 16); }
__device__ __forceinline__ float shf(float v, int src) { return __builtin_bit_cast(float, __builtin_amdgcn_ds_bpermute(src << 2, __builtin_bit_cast(int, v))); }
__device__ __forceinline__ int shi(int v, int src) { return __builtin_amdgcn_ds_bpermute(src << 2, v); }
__device__ __forceinline__ float wave_sum(float v, int lane) {
#pragma unroll
    for (int o = 1; o < 64; o <<= 1) v += shf(v, lane ^ o);
    return v;
}
__device__ __forceinline__ float wave_max(float v, int lane) {
#pragma unroll
    for (int o = 1; o < 64; o <<= 1) v = fmaxf(v, shf(v, lane ^ o));
    return v;
}
__device__ __forceinline__ float ssa_to_f(unsigned long long v) { return (float)((double)v * (1.0 / 4294967296.0)); }
__device__ __forceinline__ float dot2_bf16(unsigned w, unsigned x, float acc) { return __builtin_amdgcn_fdot2_f32_bf16(__builtin_bit_cast(bf16x2, w), __builtin_bit_cast(bf16x2, x), acc, false); }

struct Args {
    const float *x, *norm_mix, *w_in, *b_in, *pool_w, *pool_scale, *conv_w, *rel_bias, *w_branch, *w_out, *norm_ffn, *peer_wq, *peer_keys, *peer_u, *peer_v, *norm_final;
    float* out; unsigned char* ws;
};

using pg8::f32x4; using pg8::Unit;
struct EpiProj {
    static constexpr bool PERM = true, HOOK = false;
    bf16* P; bf16* R; const float* bias; const float* ssq;
    __device__ __forceinline__ void operator()(f32x4 (&acc)[2][2][4][2], const Unit& u, int wr, int wc, int fr, int fq) const {
        const int row0 = u.pm * 256 + wr * 64 + fr, cl0 = wc * 32 + 8 * fq, bcol0 = u.pn * 256 + cl0;
        f32x4 bv[2][2];
#pragma unroll
        for (int bj = 0; bj < 2; ++bj)
#pragma unroll
            for (int n = 0; n < 2; ++n) bv[bj][n] = *(const f32x4*)(bias + bcol0 + bj * 128 + 4 * n);
        if (u.pn < 20) {
            bf16* base = P + (size_t)(u.pn >> 1) * PROJ_T + (u.pn & 1) * 256 + cl0;
#pragma unroll
            for (int ai = 0; ai < 2; ++ai)
#pragma unroll
                for (int m = 0; m < 4; ++m) { const int row = row0 + ai * 128 + m * 16; const float rs = rsqrtf(ssq[row] * (1.0f / D) + EPS);
                    bf16* rowp = base + (size_t)row * MIXW;
#pragma unroll
                    for (int bj = 0; bj < 2; ++bj) { const f32x4 v0 = acc[ai][bj][m][0] * rs + bv[bj][0], v1 = acc[ai][bj][m][1] * rs + bv[bj][1];
                        pg8::u32x4 w; w.x = pg8::cvt_pk_bf16(v0[0], v0[1]); w.y = pg8::cvt_pk_bf16(v0[2], v0[3]); w.z = pg8::cvt_pk_bf16(v1[0], v1[1]); w.w = pg8::cvt_pk_bf16(v1[2], v1[3]);
                        *(pg8::u32x4*)(rowp + bj * 128) = w; } }
        } else {
            const int d0 = 64 * (u.pn - 20) + 16 * wc + 4 * fq;
#pragma unroll
            for (int ai = 0; ai < 2; ++ai)
#pragma unroll
                for (int m = 0; m < 4; ++m) { const int row = row0 + ai * 128 + m * 16; const float rs = rsqrtf(ssq[row] * (1.0f / D) + EPS);
                    float r[4][4];
#pragma unroll
                    for (int j = 0; j < 4; ++j) { float e[4], ie[4];
#pragma unroll
                        for (int g = 0; g < 4; ++g) { const float z = acc[ai][g >> 1][m][g & 1][j] * rs + bv[g >> 1][g & 1][j];
                            e[g] = fminf(1.0f + __builtin_amdgcn_exp2f(-1.4426950408889634f * z), 1e18f); ie[g] = __builtin_amdgcn_rcpf(e[g]); }
                        r[0][j] = e[1] * ie[0]; r[1][j] = e[2] * ie[1]; r[2][j] = e[3] * ie[2]; r[3][j] = ie[3]; }
#pragma unroll
                    for (int g = 0; g < 4; ++g) { pg8::u32x2 w; w.x = pg8::cvt_pk_bf16(r[g][0], r[g][1]); w.y = pg8::cvt_pk_bf16(r[g][2], r[g][3]);
                        *(pg8::u32x2*)(R + (size_t)g * R_PLANE + (size_t)row * D + d0) = w; } }
        }
    }
};
struct EpiMerge {
    static constexpr bool PERM = true, HOOK = true;
    const bf16* R; bf16* O;
    template <int NB  >
    __device__ __forceinline__ void scale(f32x4 (&acc)[2][2][4][2], const Unit& u, int plane, int wr, int wc, int fr, int fq) const {
        const __amdgpu_buffer_rsrc_t rs = __builtin_amdgcn_make_buffer_rsrc((void*)(R + (size_t)plane * R_PLANE), 0, 0x7fffffff, 0x00020000);
        int voff = (fr * D + 8 * fq) * 2; asm volatile("" : "+v"(voff));
        const int sbase = ((u.pm * 256 + wr * 64) * D + u.pn * 256 + wc * 32) * 2;
#pragma unroll
        for (int b0 = 0; b0 < 8; b0 += NB) {
            pg8::u32x4 w[NB][2];
#pragma unroll
            for (int i = 0; i < NB; ++i)
#pragma unroll
                for (int bj = 0; bj < 2; ++bj) { const int ai = (b0 + i) >> 2, m = (b0 + i) & 3;
                    w[i][bj] = __builtin_amdgcn_raw_buffer_load_b128(rs, voff + bj * 256, sbase + (ai * 128 + m * 16) * D * 2, 0); }
#pragma unroll
            for (int i = 0; i < NB; ++i)
#pragma unroll
                for (int bj = 0; bj < 2; ++bj) { const int ai = (b0 + i) >> 2, m = (b0 + i) & 3; const pg8::u32x4 v = w[i][bj];
                    acc[ai][bj][m][0] *= (f32x4){bflo(v.x), bfhi(v.x), bflo(v.y), bfhi(v.y)};
                    acc[ai][bj][m][1] *= (f32x4){bflo(v.z), bfhi(v.z), bflo(v.w), bfhi(v.w)};
                    asm volatile("" : "+v"(acc[ai][bj][m][0]), "+v"(acc[ai][bj][m][1])); }
            asm volatile("" ::: "memory"); }
    }
    __device__ __forceinline__ void hook(f32x4 (&acc)[2][2][4][2], const Unit& u, int g, int wr, int wc, int fr, int fq) const { scale<4>(acc, u, g - 1, wr, wc, fr, fq); }
    __device__ __forceinline__ void operator()(f32x4 (&acc)[2][2][4][2], const Unit& u, int wr, int wc, int fr, int fq) const {
        scale<4>(acc, u, 3, wr, wc, fr, fq);
        const int row0 = u.pm * 256 + wr * 64 + fr, col0 = u.pn * 256 + wc * 32 + 8 * fq;
#pragma unroll
        for (int ai = 0; ai < 2; ++ai)
#pragma unroll
            for (int m = 0; m < 4; ++m) { bf16* rowp = O + (size_t)(row0 + ai * 128 + m * 16) * D + col0;
#pragma unroll
                for (int bj = 0; bj < 2; ++bj) { const f32x4 v0 = acc[ai][bj][m][0], v1 = acc[ai][bj][m][1];
                    pg8::u32x4 w; w.x = pg8::cvt_pk_bf16(v0[0], v0[1]); w.y = pg8::cvt_pk_bf16(v0[2], v0[3]); w.z = pg8::cvt_pk_bf16(v1[0], v1[1]); w.w = pg8::cvt_pk_bf16(v1[2], v1[3]);
                    *(pg8::u32x4*)(rowp + bj * 128) = w; } }
    }
};
struct EpiRes {
    static constexpr bool PERM = false, HOOK = false;
    float* H; bf16* HB; unsigned long long* ssa;
    __device__ __forceinline__ void operator()(f32x4 (&acc)[2][2][4][2], const Unit& u, int wr, int wc, int fr, int fq) const {
        const int row0 = u.pm * 256 + wr * 64 + fr, col0 = u.pn * 256 + wc * 32 + 4 * fq;
#pragma unroll
        for (int ai = 0; ai < 2; ++ai)
#pragma unroll
            for (int m = 0; m < 4; ++m) { const int row = row0 + ai * 128 + m * 16; const size_t off = (size_t)row * D + col0; float s = 0.f;
#pragma unroll
                for (int bj = 0; bj < 2; ++bj)
#pragma unroll
                    for (int n = 0; n < 2; ++n) { const size_t o = off + bj * 128 + n * 16; const f32x4 h = *(const f32x4*)(H + o) + acc[ai][bj][m][n];
                        *(f32x4*)(H + o) = h; pg8::u32x2 w; w.x = pg8::cvt_pk_bf16(h[0], h[1]); w.y = pg8::cvt_pk_bf16(h[2], h[3]); *(pg8::u32x2*)(HB + o) = w;
                        s += (h[0] * h[0] + h[1] * h[1]) + (h[2] * h[2] + h[3] * h[3]); }
                { const int ln = fq * 16 + fr; s += shf(s, ln ^ 16); s += shf(s, ln ^ 32); }
                if (fq == 0) atomicAdd(ssa + row, (unsigned long long)((double)s * 4294967296.0)); }
    }
};
struct EpiQ {
    static constexpr bool PERM = true, HOOK = false;
    bf16* O; const unsigned long long* ssa;
    __device__ __forceinline__ void operator()(f32x4 (&acc)[2][2][4][2], const Unit& u, int wr, int wc, int fr, int fq) const {
        const int row0 = u.pm * 256 + wr * 64 + fr, col0 = u.pn * 256 + wc * 32 + 8 * fq;
#pragma unroll
        for (int ai = 0; ai < 2; ++ai)
#pragma unroll
            for (int m = 0; m < 4; ++m) { const int row = row0 + ai * 128 + m * 16; const float rs = rsqrtf(ssa_to_f(ssa[row]) * (1.0f / D) + EPS);
                bf16* rowp = O + (size_t)row * D + col0;
#pragma unroll
                for (int bj = 0; bj < 2; ++bj) { const f32x4 v0 = acc[ai][bj][m][0] * rs, v1 = acc[ai][bj][m][1] * rs;
                    pg8::u32x4 w; w.x = pg8::cvt_pk_bf16(v0[0], v0[1]); w.y = pg8::cvt_pk_bf16(v0[2], v0[3]); w.z = pg8::cvt_pk_bf16(v1[0], v1[1]); w.w = pg8::cvt_pk_bf16(v1[2], v1[3]);
                    *(pg8::u32x4*)(rowp + bj * 128) = w; } }
    }
};

__device__ __forceinline__ int colmap_in(int j) {
    if (j < 1536) return j;
    if (j < 5120) return j + 4;
    const int c = (j - 5120) & 255, T = (j - 5120) >> 8;
    const int g = 2 * (c >> 7) + ((c >> 2) & 1), d = 64 * T + 16 * ((c >> 5) & 3) + 4 * ((c >> 3) & 3) + (c & 3);
    return 5124 + g * 2048 + d;
}
template <bool MAP>
__device__ __forceinline__ void tr_item(const float* W, int ldw, const float* scale, bf16* WT, int ldt, int dcol0, LAS float* scr, int k0, int n0, int lane) {
    const int nn = lane & 31, sc = MAP ? colmap_in(n0 + nn) : (n0 + nn);
#pragma unroll 8
    for (int i = 0; i < 32; ++i) { const int kk = 2 * i + (lane >> 5); float v = W[(size_t)(k0 + kk) * ldw + sc]; if (scale) v *= scale[k0 + kk]; scr[kk * 33 + nn] = v; }
    asm volatile("s_waitcnt lgkmcnt(0)" ::: "memory");
    const int c = lane & 7;
#pragma unroll
    for (int j = 0; j < 4; ++j) { const int n = (lane >> 3) + 8 * j; const LAS float* s = scr + (8 * c) * 33 + n;
        v4u o; o.x = pk2(s[0 * 33], s[1 * 33]); o.y = pk2(s[2 * 33], s[3 * 33]); o.z = pk2(s[4 * 33], s[5 * 33]); o.w = pk2(s[6 * 33], s[7 * 33]);
        *(v4u*)(WT + (size_t)(n0 + n) * ldt + dcol0 + k0 + 8 * c) = o; }
    asm volatile("s_waitcnt lgkmcnt(0)" ::: "memory");
}
__device__ __forceinline__ void p0_prologue(const Args& a, LAS unsigned char* lds, int gw, int NGW, int wave, int lane) {
    unsigned char* ws = a.ws;
    LAS float* scr = (LAS float*)(lds + wave * 16384);
    constexpr int I_WIN = (D / 64) * (NPROJ / 32), I_SQ = (D / 64) * (D / 32), I_BR = (MIXW / 64) * (D / 32);
    constexpr int I_LAYER = I_WIN + 4 * I_BR + 2 * I_SQ;
    for (int it = gw; it < DEPTH * I_LAYER; it += NGW) {
        const int l = it / I_LAYER; int r = it - l * I_LAYER;
        if (r < I_WIN) { const int kb = r / (NPROJ / 32), nb = r % (NPROJ / 32);
            tr_item<true>(a.w_in + (size_t)l * D * INW, INW, a.norm_mix + l * D, (bf16*)(ws + WS_WIN + l * WIN_BYTES), D, 0, scr, 64 * kb, 32 * nb, lane); continue; }
        r -= I_WIN;
        if (r < 4 * I_BR) { const int g = r / I_BR, rr = r % I_BR, kb = rr / (D / 32), nb = rr % (D / 32);
            tr_item<false>(a.w_branch + ((size_t)l * 4 + g) * MIXW * D, D, nullptr, (bf16*)(ws + WS_WBR + l * SQ_BYTES), D, g * MIXW, scr, 64 * kb, 32 * nb, lane); continue; }
        r -= 4 * I_BR;
        if (r < I_SQ) { const int kb = r / (D / 32), nb = r % (D / 32);
            tr_item<false>(a.w_out + (size_t)l * D * D, D, nullptr, (bf16*)(ws + WS_WOUT + l * SQ_BYTES), D, 0, scr, 64 * kb, 32 * nb, lane); continue; }
        r -= I_SQ;
        { const int kb = r / (D / 32), nb = r % (D / 32);
            tr_item<false>(a.peer_wq + (size_t)l * D * D, D, a.norm_ffn + l * D, (bf16*)(ws + WS_WQ + l * SQ_BYTES), D, 0, scr, 64 * kb, 32 * nb, lane); }
    }
    {
        const size_t n8 = (size_t)DEPTH * PEER_E * D / 8;
        for (int t = 0; t < 2; ++t) { const float* src = t ? a.peer_v : a.peer_u; bf16* dst = (bf16*)(ws + (t ? WS_PV : WS_PU));
            for (size_t i = (size_t)gw * 64 + lane; i < n8; i += (size_t)NGW * 64) { const f32x4 v0 = *(const f32x4*)(src + i * 8), v1 = *(const f32x4*)(src + i * 8 + 4);
                v4u o; o.x = pk2(v0[0], v0[1]); o.y = pk2(v0[2], v0[3]); o.z = pk2(v1[0], v1[1]); o.w = pk2(v1[2], v1[3]); *(v4u*)(dst + i * 8) = o; } }
    }
    {
        float* wf = (float*)(ws + WS_WF); float* binr = (float*)(ws + WS_BINR);
        const int gt = gw * 64 + lane, NGT = NGW * 64;
        for (int i = gt; i < DEPTH * 4 * D; i += NGT) { const int l = i / (4 * D), h = (i / D) & 3, k = i % D; wf[i] = a.w_in[(size_t)l * D * INW + (size_t)k * INW + 1536 + h] * a.norm_mix[l * D + k]; }
        for (int i = gt; i < DEPTH * NPROJ; i += NGT) { const int l = i / NPROJ, j = i % NPROJ; binr[i] = a.b_in[l * INW + colmap_in(j)]; }
    }
    {
        float* H = (float*)(ws + WS_H); bf16* HB = (bf16*)(ws + WS_HB); float* ssq = (float*)(ws + WS_SSQ);
        for (int m = gw; m < M; m += NGW) { float s = 0.f;
#pragma unroll
            for (int j = 0; j < 8; ++j) { const size_t o = (size_t)m * D + j * 256 + lane * 4; const f32x4 v = *(const f32x4*)(a.x + o); *(f32x4*)(H + o) = v;
                v2u w; w.x = pk2(v[0], v[1]); w.y = pk2(v[2], v[3]); *(v2u*)(HB + o) = w; s += (v[0] * v[0] + v[1] * v[1]) + (v[2] * v[2] + v[3] * v[3]); }
            s = wave_sum(s, lane); if (lane == 0) ssq[m] = s; }
    }
}

__device__ __forceinline__ void forget_logits(const Args& a, int l, int gw, int NGW, int lane) {
    unsigned char* ws = a.ws; const bf16* HB = (const bf16*)(ws + WS_HB); const float* wf = (const float*)(ws + WS_WF) + l * 4 * D; const float* ssq = (const float*)(ws + WS_SSQ) + l * M;
    float* logf = (float*)(ws + WS_LOGF);
    for (int m = gw; m < M; m += NGW) {
        float d[4] = {0.f, 0.f, 0.f, 0.f};
#pragma unroll
        for (int j = 0; j < 4; ++j) { const int k0 = j * 512 + lane * 8; const v4u xv = *(const v4u*)(HB + (size_t)m * D + k0);
            const float x[8] = {bflo(xv.x), bfhi(xv.x), bflo(xv.y), bfhi(xv.y), bflo(xv.z), bfhi(xv.z), bflo(xv.w), bfhi(xv.w)};
#pragma unroll
            for (int h = 0; h < 4; ++h) { const f32x4 w0 = *(const f32x4*)(wf + h * D + k0), w1 = *(const f32x4*)(wf + h * D + k0 + 4);
                d[h] += x[0] * w0[0] + x[1] * w0[1] + x[2] * w0[2] + x[3] * w0[3] + x[4] * w1[0] + x[5] * w1[1] + x[6] * w1[2] + x[7] * w1[3]; } }
        const float rs = rsqrtf(ssq[m] * (1.0f / D) + EPS);
#pragma unroll
        for (int h = 0; h < 4; ++h) { const float z = wave_sum(d[h], lane) * rs + a.b_in[l * INW + 1536 + h];
            const float ls = fminf(z, 0.f) - log1pf(__expf(-fabsf(z)));
            if (lane == h) logf[m * 4 + h] = ls; }
    }
}
__device__ __forceinline__ void cum_scan(const Args& a, int gw, int lane) {
    if (gw >= 16) return;
    const float* logf = (const float*)(a.ws + WS_LOGF); float* cum = (float*)(a.ws + WS_CUM);
    const int b = gw >> 2, h = gw & 3; float run = 0.f;
    for (int c = 0; c < SEQ / 64; ++c) { float v = logf[(size_t)(b * SEQ + c * 64 + lane) * 4 + h];
#pragma unroll
        for (int o = 1; o < 64; o <<= 1) { const float t = shf(v, lane >= o ? lane - o : lane); if (lane >= o) v += t; }
        v += run; cum[(size_t)gw * SEQ + c * 64 + lane] = v; run = shf(v, 63); }
}

template <int MODE>
__device__ __forceinline__ void naive_attn(const Args& a, int l, int b, int h, int s, LAS float* sc, int lane) {
    const unsigned char* ws = a.ws; const bf16* P = (const bf16*)(ws + WS_PROJ);
    const bf16* Qp = P + (MODE ? 7 : 0) * PROJ_T; const bf16* Kp = P + (MODE ? 8 : 1) * PROJ_T; const bf16* Vp = P + (MODE ? 9 : 2) * PROJ_T;
    const float* cum = (const float*)(ws + WS_CUM) + (size_t)(b * 4 + h) * SEQ;
    const float* rb = a.rel_bias + ((size_t)l * 4 + h) * 320;
    const size_t tb = (size_t)b * SEQ;
    int klo = 0, khi = s;
    if (MODE) { const int c = s >> 6; klo = (c - 8) * 64; if (klo < 0) klo = 0; khi = c * 64 + 63; }
    const bf16* qrow = Qp + (tb + s) * MIXW + h * HD;
    float mx = -3.0e38f;
    for (int kb = klo; kb <= khi; kb += 64) { const int k = kb + lane;
        if (k <= khi) { const bf16* krow = Kp + (tb + k) * MIXW + h * HD; float d = 0.f;
#pragma unroll 4
            for (int c8 = 0; c8 < 16; ++c8) { const v4u qv = *(const v4u*)(qrow + c8 * 8), kv = *(const v4u*)(krow + c8 * 8);
                d = dot2_bf16(qv.x, kv.x, d); d = dot2_bf16(qv.y, kv.y, d); d = dot2_bf16(qv.z, kv.z, d); d = dot2_bf16(qv.w, kv.w, d); }
            float bias;
            if (MODE == 0) bias = cum[s] - cum[k];
            else { int rel = s - k; rel = rel < -63 ? -63 : (rel > 256 ? 256 : rel); bias = rb[rel + 63]; }
            const float lg = d * ATT_SCALE + bias; sc[k - klo] = lg; mx = fmaxf(mx, lg); } }
    mx = wave_max(mx, lane);
    asm volatile("s_waitcnt lgkmcnt(0)" ::: "memory");
    float sum = 0.f;
    for (int kb = klo; kb <= khi; kb += 64) { const int k = kb + lane; if (k <= khi) { const float p = __expf(sc[k - klo] - mx); sc[k - klo] = p; sum += p; } }
    sum = wave_sum(sum, lane);
    asm volatile("s_waitcnt lgkmcnt(0)" ::: "memory");
    float o0 = 0.f, o1 = 0.f;
    for (int k = klo; k <= khi; ++k) { const float p = sc[k - klo]; const unsigned v = *(const unsigned*)(Vp + (tb + k) * MIXW + h * HD + 2 * lane); o0 += p * bflo(v); o1 += p * bfhi(v); }
    const float inv = 1.0f / sum;
    bf16* Y = (bf16*)(a.ws + WS_Y);
    *(unsigned*)(Y + (tb + s) * D + (MODE ? 1536 : 0) + h * HD + 2 * lane) = pk2(o0 * inv, o1 * inv);
    asm volatile("s_waitcnt lgkmcnt(0)" ::: "memory");
}
__device__ __forceinline__ void naive_pool(const Args& a, int l, int t, int g, LAS float* sc, int lane) {
    const bf16* Pin = (const bf16*)(a.ws + WS_PROJ) + 3 * PROJ_T;
    const int s = t & (SEQ - 1), w = 2 << g; const int cnt = (s + 1 < w) ? s + 1 : w;
    float s0 = 0.f, s1 = 0.f;
    for (int j = 0; j < cnt; ++j) { const unsigned v = *(const unsigned*)(Pin + (size_t)(t - j) * MIXW + g * 128 + 2 * lane); s0 += bflo(v); s1 += bfhi(v); }
    const unsigned v0 = *(const unsigned*)(Pin + (size_t)t * MIXW + g * 128 + 2 * lane);
    const float inv = 1.0f / (float)cnt;
    sc[2 * lane] = s0 * inv - bflo(v0); sc[2 * lane + 1] = s1 * inv - bfhi(v0);
    asm volatile("s_waitcnt lgkmcnt(0)" ::: "memory");
    const float* W = a.pool_w + ((size_t)l * 4 + g) * 128 * 128;
    float o0 = 0.f, o1 = 0.f;
    for (int c = 0; c < 128; ++c) { const float p = sc[c]; const f32x2 wv = *(const f32x2*)(W + c * 128 + 2 * lane); o0 += p * wv[0]; o1 += p * wv[1]; }
    const f32x2 ps = *(const f32x2*)(a.pool_scale + l * MIXW + g * 128 + 2 * lane);
    bf16* Y = (bf16*)(a.ws + WS_Y);
    *(unsigned*)(Y + (size_t)t * D + 512 + g * 128 + 2 * lane) = pk2(o0 * ps[0], o1 * ps[1]);
    asm volatile("s_waitcnt lgkmcnt(0)" ::: "memory");
}
__device__ __forceinline__ void naive_conv(const Args& a, int l, int t, int lane) {
    const bf16* P = (const bf16*)(a.ws + WS_PROJ); const bf16* Ch = P + 4 * PROJ_T; const bf16* Cb = P + 5 * PROJ_T; const bf16* Cc = P + 6 * PROJ_T;
    const int s = t & (SEQ - 1), c0 = lane * 8;
    float acc[8] = {0.f, 0.f, 0.f, 0.f, 0.f, 0.f, 0.f, 0.f};
#pragma unroll
    for (int j = 0; j < 3; ++j) { const int dt = 2 - j;
        if (s - dt >= 0) { const v4u hv = *(const v4u*)(Ch + (size_t)(t - dt) * MIXW + c0), cv = *(const v4u*)(Cc + (size_t)(t - dt) * MIXW + c0);
            const float* w = a.conv_w + ((size_t)l * 3 + j) * MIXW + c0; const f32x4 w0 = *(const f32x4*)w, w1 = *(const f32x4*)(w + 4);
            acc[0] += w0[0] * bflo(hv.x) * bflo(cv.x); acc[1] += w0[1] * bfhi(hv.x) * bfhi(cv.x); acc[2] += w0[2] * bflo(hv.y) * bflo(cv.y); acc[3] += w0[3] * bfhi(hv.y) * bfhi(cv.y);
            acc[4] += w1[0] * bflo(hv.z) * bflo(cv.z); acc[5] += w1[1] * bfhi(hv.z) * bfhi(cv.z); acc[6] += w1[2] * bflo(hv.w) * bflo(cv.w); acc[7] += w1[3] * bfhi(hv.w) * bfhi(cv.w); } }
    const v4u bv = *(const v4u*)(Cb + (size_t)t * MIXW + c0);
    v4u o; o.x = pk2(acc[0] * bflo(bv.x), acc[1] * bfhi(bv.x)); o.y = pk2(acc[2] * bflo(bv.y), acc[3] * bfhi(bv.y)); o.z = pk2(acc[4] * bflo(bv.z), acc[5] * bfhi(bv.z)); o.w = pk2(acc[6] * bflo(bv.w), acc[7] * bfhi(bv.w));
    *(v4u*)((bf16*)(a.ws + WS_Y) + (size_t)t * D + 1024 + c0) = o;
}
__device__ __forceinline__ void mixers_naive(const Args& a, int l, LAS unsigned char* lds, int gw, int NGW, int wave, int lane) {
    LAS float* sc = (LAS float*)(lds + wave * 8192);
    for (int i = gw; i < M * 4; i += NGW) { const int t = M * 4 - 1 - i; const int h = t & 3, tok = t >> 2; naive_attn<0>(a, l, tok >> 11, h, tok & (SEQ - 1), sc, lane); }
    for (int i = gw; i < M * 4; i += NGW) { const int h = i & 3, tok = i >> 2; naive_attn<1>(a, l, tok >> 11, h, tok & (SEQ - 1), sc, lane); }
    for (int i = gw; i < M * 4; i += NGW) naive_pool(a, l, i >> 2, i & 3, sc, lane);
    for (int i = gw; i < M; i += NGW) naive_conv(a, l, i, lane);
}

__device__ __forceinline__ float gelu_tanh(float x) { const float u = 1.5957691216057308f * (x + 0.044715f * x * x * x); return x / (1.0f + __expf(-u)); }
__device__ __forceinline__ void peer_token(const Args& a, int l, int t, bool last_layer, int lane) {
    unsigned char* ws = a.ws;
    const bf16* Q = (const bf16*)(ws + WS_Q) + (size_t)t * D;
    const float* keys = a.peer_keys + (size_t)l * 8 * 2 * 128 * 128;
    int idxv[2] = {0, 0}; float gatv[2] = {0.f, 0.f};
    const float NEG = -3.0e38f;
    for (int h = 0; h < 8; ++h) {
        float tops[2] = {0.f, 0.f}; int topi[2] = {0, 0};
#pragma unroll
        for (int p = 0; p < 2; ++p) {
            const bf16* qp = Q + h * 256 + p * 128; const float* kp = keys + ((size_t)(h * 2 + p) * 128) * 128;
            float s0 = 0.f, s1 = 0.f;
#pragma unroll 4
            for (int c8 = 0; c8 < 16; ++c8) { const v4u qv = *(const v4u*)(qp + c8 * 8);
                const float q[8] = {bflo(qv.x), bfhi(qv.x), bflo(qv.y), bfhi(qv.y), bflo(qv.z), bfhi(qv.z), bflo(qv.w), bfhi(qv.w)};
                const float* k0 = kp + (size_t)lane * 128 + c8 * 8; const float* k1 = k0 + 64 * 128;
                const f32x4 a0 = *(const f32x4*)k0, a1 = *(const f32x4*)(k0 + 4), b0 = *(const f32x4*)k1, b1 = *(const f32x4*)(k1 + 4);
                s0 += q[0] * a0[0] + q[1] * a0[1] + q[2] * a0[2] + q[3] * a0[3] + q[4] * a1[0] + q[5] * a1[1] + q[6] * a1[2] + q[7] * a1[3];
                s1 += q[0] * b0[0] + q[1] * b0[1] + q[2] * b0[2] + q[3] * b0[3] + q[4] * b1[0] + q[5] * b1[1] + q[6] * b1[2] + q[7] * b1[3]; }
            for (int it = 0; it < 16; ++it) { const float m = wave_max(fmaxf(s0, s1), lane); int k;
                const unsigned long long b0 = __ballot(s0 == m);
                if (b0) { const int o = __ffsll((long long)b0) - 1; k = o; if (lane == o) s0 = NEG; }
                else { const unsigned long long b1 = __ballot(s1 == m); const int o = __ffsll((long long)b1) - 1; k = o + 64; if (lane == o) s1 = NEG; }
                if (lane == it) { tops[p] = m; topi[p] = k; } }
        }
        float cs[4]; int ci[4];
        { const float sa = shf(tops[0], lane >> 2); const int ia = shi(topi[0], lane >> 2);
#pragma unroll
            for (int e = 0; e < 4; ++e) { const int j = 4 * (lane & 3) + e; cs[e] = sa + shf(tops[1], j); ci[e] = ia * 128 + shi(topi[1], j); } }
        float bs = NEG; int bi = 0;
        for (int it = 0; it < 16; ++it) { const float m = wave_max(fmaxf(fmaxf(cs[0], cs[1]), fmaxf(cs[2], cs[3])), lane);
            int sel = -1, o = 0;
#pragma unroll
            for (int e = 0; e < 4; ++e) { if (sel < 0) { const unsigned long long bb = __ballot(cs[e] == m); if (bb) { sel = e; o = __ffsll((long long)bb) - 1; } } }
            int idx = 0;
#pragma unroll
            for (int e = 0; e < 4; ++e) { if (sel == e) { idx = shi(ci[e], o); if (lane == o) cs[e] = NEG; } }
            if (lane == it) { bs = m; bi = idx; } }
        const float mx = shf(bs, 0); const float ex = lane < 16 ? __expf(bs - mx) : 0.f; const float sum = wave_sum(ex, lane); const float gt = ex / sum;
        const int vi = shi(bi, lane & 15); const float vg = shf(gt, lane & 15);
        if ((lane >> 4) == (h & 3)) { if (h < 4) { idxv[0] = vi; gatv[0] = vg; } else { idxv[1] = vi; gatv[1] = vg; } }
    }
    const unsigned long long* ssa1 = (const unsigned long long*)(ws + WS_SSA) + l * M;
    const float rs = rsqrtf(ssa_to_f(ssa1[t]) * (1.0f / D) + EPS);
    const bf16* HB = (const bf16*)(ws + WS_HB) + (size_t)t * D; const float* gn = a.norm_ffn + l * D;
    v4u xp[4];
#pragma unroll
    for (int i = 0; i < 4; ++i) { const int k0 = 8 * lane + 512 * i; const v4u hv = *(const v4u*)(HB + k0); const f32x4 g0 = *(const f32x4*)(gn + k0), g1 = *(const f32x4*)(gn + k0 + 4);
        xp[i].x = pk2(bflo(hv.x) * rs * g0[0], bfhi(hv.x) * rs * g0[1]); xp[i].y = pk2(bflo(hv.y) * rs * g0[2], bfhi(hv.y) * rs * g0[3]);
        xp[i].z = pk2(bflo(hv.z) * rs * g1[0], bfhi(hv.z) * rs * g1[1]); xp[i].w = pk2(bflo(hv.w) * rs * g1[2], bfhi(hv.w) * rs * g1[3]); }
    const bf16* PU = (const bf16*)(ws + WS_PU + l * PE_BYTES); const bf16* PV = (const bf16*)(ws + WS_PV + l * PE_BYTES);
    float actv[2] = {0.f, 0.f};
#pragma unroll
    for (int rr = 0; rr < 2; ++rr) {
        for (int ll = 0; ll < 64; ll += 4) {
            v4u r[4][4];
#pragma unroll
            for (int j = 0; j < 4; ++j) { const int e = __builtin_amdgcn_readlane(idxv[rr], ll + j); const bf16* row = PU + (size_t)e * D + 8 * lane;
#pragma unroll
                for (int i = 0; i < 4; ++i) r[j][i] = *(const v4u*)(row + 512 * i); }
#pragma unroll
            for (int j = 0; j < 4; ++j) { float d0 = 0.f, d1 = 0.f;
#pragma unroll
                for (int i = 0; i < 4; ++i) { d0 = dot2_bf16(r[j][i].x, xp[i].x, d0); d1 = dot2_bf16(r[j][i].y, xp[i].y, d1); d0 = dot2_bf16(r[j][i].z, xp[i].z, d0); d1 = dot2_bf16(r[j][i].w, xp[i].w, d1); }
                const float d = wave_sum(d0 + d1, lane); if (lane == ll + j) actv[rr] = d; }
        }
    }
    float coef[2] = {gelu_tanh(actv[0]) * gatv[0], gelu_tanh(actv[1]) * gatv[1]};
    float y[4][8];
#pragma unroll
    for (int i = 0; i < 4; ++i)
#pragma unroll
        for (int k = 0; k < 8; ++k) y[i][k] = 0.f;
#pragma unroll
    for (int rr = 0; rr < 2; ++rr) {
        for (int ll = 0; ll < 64; ll += 4) {
            v4u r[4][4]; float c[4];
#pragma unroll
            for (int j = 0; j < 4; ++j) { const int e = __builtin_amdgcn_readlane(idxv[rr], ll + j); c[j] = __builtin_bit_cast(float, __builtin_amdgcn_readlane(__builtin_bit_cast(int, coef[rr]), ll + j));
                const bf16* row = PV + (size_t)e * D + 8 * lane;
#pragma unroll
                for (int i = 0; i < 4; ++i) r[j][i] = *(const v4u*)(row + 512 * i); }
#pragma unroll
            for (int j = 0; j < 4; ++j)
#pragma unroll
                for (int i = 0; i < 4; ++i) { y[i][0] += c[j] * bflo(r[j][i].x); y[i][1] += c[j] * bfhi(r[j][i].x); y[i][2] += c[j] * bflo(r[j][i].y); y[i][3] += c[j] * bfhi(r[j][i].y);
                    y[i][4] += c[j] * bflo(r[j][i].z); y[i][5] += c[j] * bfhi(r[j][i].z); y[i][6] += c[j] * bflo(r[j][i].w); y[i][7] += c[j] * bfhi(r[j][i].w); }
        }
    }
    float* H = (float*)(ws + WS_H) + (size_t)t * D; bf16* HBw = (bf16*)(ws + WS_HB) + (size_t)t * D;
    float s = 0.f;
#pragma unroll
    for (int i = 0; i < 4; ++i) { const int k0 = 8 * lane + 512 * i; const f32x4 h0 = *(const f32x4*)(H + k0), h1 = *(const f32x4*)(H + k0 + 4);
#pragma unroll
        for (int k = 0; k < 4; ++k) { y[i][k] += h0[k]; y[i][4 + k] += h1[k]; }
#pragma unroll
        for (int k = 0; k < 8; ++k) s += y[i][k] * y[i][k]; }
    s = wave_sum(s, lane);
    if (!last_layer) {
        float* ssqn = (float*)(ws + WS_SSQ) + (l + 1) * M; if (lane == 0) ssqn[t] = s;
#pragma unroll
        for (int i = 0; i < 4; ++i) { const int k0 = 8 * lane + 512 * i; *(f32x4*)(H + k0) = (f32x4){y[i][0], y[i][1], y[i][2], y[i][3]}; *(f32x4*)(H + k0 + 4) = (f32x4){y[i][4], y[i][5], y[i][6], y[i][7]};
            v4u o; o.x = pk2(y[i][0], y[i][1]); o.y = pk2(y[i][2], y[i][3]); o.z = pk2(y[i][4], y[i][5]); o.w = pk2(y[i][6], y[i][7]); *(v4u*)(HBw + k0) = o; }
    } else {
        const float rf = rsqrtf(s * (1.0f / D) + EPS); float* O = a.out + (size_t)t * D;
#pragma unroll
        for (int i = 0; i < 4; ++i) { const int k0 = 8 * lane + 512 * i; const f32x4 g0 = *(const f32x4*)(a.norm_final + k0), g1 = *(const f32x4*)(a.norm_final + k0 + 4);
            *(f32x4*)(O + k0) = (f32x4){y[i][0] * rf * g0[0], y[i][1] * rf * g0[1], y[i][2] * rf * g0[2], y[i][3] * rf * g0[3]};
            *(f32x4*)(O + k0 + 4) = (f32x4){y[i][4] * rf * g1[0], y[i][5] * rf * g1[1], y[i][6] * rf * g1[2], y[i][7] * rf * g1[3]}; }
    }
}

__global__ void __launch_bounds__(NT, 2) mk_fwd(Args a_in) {
    Args a = a_in;
    extern __shared__ __attribute__((aligned(16))) unsigned char lds_raw[];
    LAS unsigned char* lds = (LAS unsigned char*)lds_raw;
    cg::grid_group grid = cg::this_grid();
    const int wave = __builtin_amdgcn_readfirstlane(threadIdx.x >> 6);
    int lane;
    const int G = gridDim.x, gw = blockIdx.x * NWAVES + wave, NGW = G * NWAVES;
#define LAUNDER() do { asm volatile("v_mbcnt_lo_u32_b32 %0, -1, 0\n\tv_mbcnt_hi_u32_b32 %0, -1, %0" : "=v"(lane)); asm volatile("" : "+s"(a.ws)); } while (0)
    LAUNDER();
    p0_prologue(a, lds, gw, NGW, wave, lane);
    grid.sync();
    unsigned char* ws;
    for (int l = 0; l < DEPTH; ++l) {
        LAUNDER(); ws = a.ws;
        float* ssq_mix = (float*)(ws + WS_SSQ) + l * M; unsigned long long* ssq_ffn = (unsigned long long*)(ws + WS_SSA) + l * M;
        {
            pg8::Gemm g{(const bf16*)(ws + WS_HB), (const bf16*)(ws + WS_WIN + l * WIN_BYTES), M, NPROJ, D}; pg8::StaticOrder S; S.init(M, NPROJ, G, (int)blockIdx.x);
            EpiProj E{(bf16*)(ws + WS_PROJ), (bf16*)(ws + WS_R), (const float*)(ws + WS_BINR) + l * NPROJ, ssq_mix};
            pg8::gemm_phase<EpiProj, pg8::StaticOrder, true>(lds, g, S, E, wave);
            forget_logits(a, l, gw, NGW, lane);
        }
        grid.sync(); LAUNDER();
        cum_scan(a, gw, lane);
        grid.sync(); LAUNDER();
        mixers_naive(a, l, lds, gw, NGW, wave, lane);
        grid.sync(); LAUNDER(); ws = a.ws;
        {
            pg8::Gemm g{(const bf16*)(ws + WS_Y), (const bf16*)(ws + WS_WBR + l * SQ_BYTES), M, D, D}; pg8::StaticOrder S; S.init(M, D, G, (int)blockIdx.x);
            EpiMerge E{(const bf16*)(ws + WS_R), (bf16*)(ws + WS_MRG)};
            pg8::gemm_phase<EpiMerge, pg8::StaticOrder, false>(lds, g, S, E, wave);
        }
        grid.sync(); LAUNDER(); ws = a.ws;
        {
            pg8::Gemm g{(const bf16*)(ws + WS_MRG), (const bf16*)(ws + WS_WOUT + l * SQ_BYTES), M, D, D}; pg8::StaticOrder S; S.init(M, D, G, (int)blockIdx.x);
            EpiRes E{(float*)(ws + WS_H), (bf16*)(ws + WS_HB), ssq_ffn};
            pg8::gemm_phase<EpiRes, pg8::StaticOrder, false>(lds, g, S, E, wave);
        }
        grid.sync(); LAUNDER(); ws = a.ws;
        {
            pg8::Gemm g{(const bf16*)(ws + WS_HB), (const bf16*)(ws + WS_WQ + l * SQ_BYTES), M, D, D}; pg8::StaticOrder S; S.init(M, D, G, (int)blockIdx.x);
            EpiQ E{(bf16*)(ws + WS_Q), ssq_ffn};
            pg8::gemm_phase<EpiQ, pg8::StaticOrder, false>(lds, g, S, E, wave);
        }
        grid.sync(); LAUNDER();
        for (int t = gw; t < M; t += NGW) peer_token(a, l, t, l == DEPTH - 1, lane);
        if (l + 1 < DEPTH) grid.sync();
    }
}

extern "C" void kernel_launch(void* const* d_in, const int* in_sizes, int n_in, void* d_out, int out_size, void* d_ws, size_t ws_size, hipStream_t stream) {
    static int grid = 0;
    if (grid == 0) {
        int dev = 0, cus = 0, per_cu = 0;
        if (n_in != 16 || out_size != M * D || ws_size < WS_END) { fprintf(stderr, "kernel_launch: unexpected shapes (n_in %d out %d ws %zu)\n", n_in, out_size, ws_size); grid = -1; return; }
        (void)hipGetDevice(&dev);
        (void)hipDeviceGetAttribute(&cus, hipDeviceAttributeMultiprocessorCount, dev);
        (void)hipFuncSetAttribute((const void*)mk_fwd, hipFuncAttributeMaxDynamicSharedMemorySize, LDS_BYTES);
        (void)hipOccupancyMaxActiveBlocksPerMultiprocessor(&per_cu, (const void*)mk_fwd, NT, LDS_BYTES);
        if (per_cu < 1) { fprintf(stderr, "kernel_launch: occupancy query says %d blocks per CU\n", per_cu); }
        grid = cus;
        if (grid > 256) grid = 256;
    }
    if (grid < 0) return;
    (void)hipMemsetAsync((char*)d_ws + WS_CTL, 0, CTL_ZERO_BYTES, stream);
    Args a{};
    const float** p = (const float**)&a;
    for (int i = 0; i < 16; ++i) p[i] = (const float*)d_in[i];
    a.out = (float*)d_out; a.ws = (unsigned char*)d_ws;
    void* args[] = {&a};
    hipError_t e = hipLaunchCooperativeKernel((const void*)mk_fwd, dim3(grid), dim3(NT), args, LDS_BYTES, stream);
    if (e != hipSuccess) fprintf(stderr, "cooperative launch failed: %s (grid %d)\n", hipGetErrorString(e), grid);
}
```

```cpp
#include <hip/hip_runtime.h>
#include <hip/hip_cooperative_groups.h>
#include <cstdio>
#include <cstdint>
namespace cg = cooperative_groups;
namespace pg8 {
#define PG8_LAS __attribute__((address_space(3)))
typedef unsigned short bf16_t;
typedef short bf16x8 __attribute__((ext_vector_type(8)));
typedef float f32x4 __attribute__((ext_vector_type(4)));
typedef unsigned u32x4 __attribute__((ext_vector_type(4)));
typedef unsigned u32x2 __attribute__((ext_vector_type(2)));
constexpr int BM = 256, BK = 64, HALF = 128, HTB = HALF * BK * 2  , STAGE_BYTES = 8 * HTB, NXCD = 8, WGM = 8;

__host__ __device__ __forceinline__ int lds_byte(int r, int c) { const int st = (r >> 4) * 2 + (c >> 5), rr = r & 15, cc = c & 31, ob = rr * 64 + cc * 2; return st * 1024 + (ob ^ (((ob >> 9) & 1) << 5)); }
__host__ __device__ __forceinline__ void stage_rc(int b, int& R, int& C) { const int st = b / 1024, sb = b % 1024, swz = sb ^ (((sb >> 9) & 1) << 5); R = (st >> 1) * 16 + swz / 64; C = (st & 1) * 32 + (swz % 64) / 2; }
__host__ __device__ __forceinline__ int perm32(int rho) { const int n = rho >> 4, i = rho & 15; return 8 * (i >> 2) + 4 * n + (i & 3); }

struct Unit { int pm, pn; };
struct Gemm { const bf16_t* A; const bf16_t* Bt; int M, N, K; };

struct StaticOrder {
    int nM, nN, nwg, G, c;
    __host__ __device__ void init(int M, int N, int G_, int c_) { nM = M / BM; nN = N / BM; nwg = nM * nN; G = G_; c = c_; }
    __host__ __device__ bool next(int i, Unit& u) const {
        const long L = (long)i * G + c; if (L >= nwg) return false;
        int wgid = (int)L; { const int q = nwg / NXCD, r = nwg % NXCD, xcd = wgid % NXCD, off = wgid / NXCD; wgid = (xcd < r ? xcd * (q + 1) : r * (q + 1) + (xcd - r) * q) + off; }
        const int nig = WGM * nN, gid = wgid / nig, fm = gid * WGM, gsz = (nM - fm) < WGM ? (nM - fm) : WGM;
        u.pm = fm + ((wgid % nig) % gsz); u.pn = (wgid % nig) / gsz; return true;
    }
};

__device__ __forceinline__ unsigned cvt_pk_bf16(float lo, float hi) { unsigned r; asm volatile("v_cvt_pk_bf16_f32 %0, %1, %2" : "=v"(r) : "v"(lo), "v"(hi)); return r; }

template <class Epi, class Sched, bool ALIGN_EPI = false>
__device__ __forceinline__ void gemm_phase(PG8_LAS unsigned char* lds, const Gemm g, const Sched& S, const Epi& E, int wid) {
    int lane_; asm volatile("v_mbcnt_lo_u32_b32 %0, -1, 0\n\tv_mbcnt_hi_u32_b32 %0, -1, %0" : "=v"(lane_));
    const int lane = lane_, tid = wid * 64 + lane, wr = wid >> 2, wc = wid & 3, fr = lane & 15, fq = lane >> 4;
    const int K = g.K, nt = K / BK;
    unsigned voffA[2], voffB[2];
#pragma unroll
    for (int i = 0; i < 2; ++i) { int R, C; stage_rc(tid * 16 + i * 8192, R, C); const int Rb = Epi::PERM ? ((R & ~31) + perm32(R & 31)) : R;
        voffA[i] = (unsigned)(R * K + C) * 2u; voffB[i] = (unsigned)(Rb * K + C) * 2u; }
    const size_t kstep = (size_t)(BK * 2);
    const size_t hstep = (size_t)HALF * K * 2;
    const size_t tstep = 2 * hstep;
    const unsigned ldsw = (unsigned)wid * 1024u;
    const int aoff = lds_byte(wr * 64 + fr, fq * 8), boff = lds_byte(wc * 32 + fr, fq * 8);
#define PG8_SA(b, h) (((b) * 2 + (h)) * HTB)
#define PG8_SB(b, h) ((4 + (b) * 2 + (h)) * HTB)
#define PG8_STAGE(bufoff, gbase, voff) do { _Pragma("unroll") for (int _i = 0; _i < 2; ++_i) \
        __builtin_amdgcn_global_load_lds((const unsigned*)((const char*)(gbase) + (voff)[_i]), (PG8_LAS unsigned*)(lds + (bufoff) + ldsw + _i * 8192), 16, 0, 0); } while (0)
#define PG8_LDA(dst, b, h) do { _Pragma("unroll") for (int m = 0; m < 4; ++m) _Pragma("unroll") for (int k = 0; k < 2; ++k) dst[m][k] = *(const PG8_LAS bf16x8*)(lds + PG8_SA(b, h) + aoff + m * 2048 + k * 1024); } while (0)
#define PG8_LDB(dst, b, h) do { _Pragma("unroll") for (int n = 0; n < 2; ++n) _Pragma("unroll") for (int k = 0; k < 2; ++k) dst[n][k] = *(const PG8_LAS bf16x8*)(lds + PG8_SB(b, h) + boff + n * 2048 + k * 1024); } while (0)
#define PG8_MMA(ai, bj, At, Bt) do { __builtin_amdgcn_s_setprio(1); _Pragma("unroll") for (int m = 0; m < 4; ++m) _Pragma("unroll") for (int n = 0; n < 2; ++n) _Pragma("unroll") for (int k = 0; k < 2; ++k) \
        acc[ai][bj][m][n] = __builtin_amdgcn_mfma_f32_16x16x32_bf16(Bt[n][k], At[m][k], acc[ai][bj][m][n], 0, 0, 0); __builtin_amdgcn_s_setprio(0); } while (0)
#define PG8_WAIT_V(n) asm volatile("s_waitcnt vmcnt(" #n ")" ::: "memory")
#define PG8_WAIT_L(n) asm volatile("s_waitcnt lgkmcnt(" #n ")" ::: "memory")
#define PG8_BAR __builtin_amdgcn_s_barrier()
#define PG8_SCHED __builtin_amdgcn_sched_barrier(0)
    Unit cur, nxt; int ui = 0;
    if (!S.next(0, cur)) return;
    f32x4 acc[2][2][4][2];
#pragma unroll
    for (int a = 0; a < 2; ++a)
#pragma unroll
        for (int b = 0; b < 2; ++b)
#pragma unroll
            for (int m = 0; m < 4; ++m)
#pragma unroll
                for (int n = 0; n < 2; ++n) acc[a][b][m][n] = (f32x4){0.f, 0.f, 0.f, 0.f};
    bf16x8 At[4][2], B0[2][2], B1[2][2];
    const char* cA = (const char*)g.A + (size_t)cur.pm * tstep; const char* cB = (const char*)g.Bt + (size_t)cur.pn * tstep;
    PG8_STAGE(PG8_SB(0, 0), cB, voffB); PG8_STAGE(PG8_SB(0, 1), cB + hstep, voffB); PG8_STAGE(PG8_SA(0, 0), cA, voffA); PG8_STAGE(PG8_SA(0, 1), cA + hstep, voffA);
    if (wr == 1) PG8_BAR;
    PG8_WAIT_V(2); PG8_BAR;
    PG8_STAGE(PG8_SB(1, 0), cB + kstep, voffB); PG8_STAGE(PG8_SA(1, 0), cA + kstep, voffA); PG8_STAGE(PG8_SB(1, 1), cB + hstep + kstep, voffB);
    PG8_WAIT_V(6); PG8_BAR;
    for (;;) {
        const bool has_next = S.next(ui + 1, nxt);
        const char* nA = has_next ? (const char*)g.A + (size_t)nxt.pm * tstep : cA; const char* nB = has_next ? (const char*)g.Bt + (size_t)nxt.pn * tstep : cB;
        const int seglen = Epi::HOOK ? 8 : nt;
        for (int t0 = 0; t0 < nt; t0 += seglen) {
        if constexpr (Epi::HOOK) { if (t0 > 0) E.hook(acc, cur, t0 >> 3, wr, wc, fr, fq); }
        for (int t = t0; t < t0 + seglen; t += 2) {
            const bool last = (t == nt - 2);
            const char* a1 = cA + (size_t)(t + 1) * kstep;
            const char* a2 = last ? nA : cA + (size_t)(t + 2) * kstep; const char* b2 = last ? nB : cB + (size_t)(t + 2) * kstep;
            const char* a3 = a2 + kstep; const char* b3 = b2 + kstep;
            PG8_LDB(B0, 0, 0); PG8_LDB(B1, 0, 1); PG8_SCHED; PG8_LDA(At, 0, 0); PG8_STAGE(PG8_SA(1, 1), a1 + hstep, voffA);
            PG8_WAIT_V(8); PG8_WAIT_L(0); PG8_BAR; PG8_MMA(0, 0, At, B0); PG8_MMA(0, 1, At, B1); PG8_BAR; PG8_SCHED;
            PG8_LDA(At, 0, 1); PG8_STAGE(PG8_SB(0, 0), b2, voffB); PG8_STAGE(PG8_SB(0, 1), b2 + hstep, voffB); PG8_STAGE(PG8_SA(0, 0), a2, voffA);
            PG8_WAIT_V(8); PG8_WAIT_L(0); PG8_BAR; PG8_MMA(1, 0, At, B0); PG8_MMA(1, 1, At, B1); PG8_BAR; PG8_SCHED;
            PG8_LDB(B0, 1, 0); PG8_LDB(B1, 1, 1); PG8_SCHED; PG8_LDA(At, 1, 0); PG8_STAGE(PG8_SA(0, 1), a2 + hstep, voffA);
            PG8_WAIT_V(8); PG8_WAIT_L(0); PG8_BAR; PG8_MMA(0, 0, At, B0); PG8_MMA(0, 1, At, B1); PG8_BAR; PG8_SCHED;
            PG8_LDA(At, 1, 1); PG8_STAGE(PG8_SB(1, 0), b3, voffB); PG8_STAGE(PG8_SB(1, 1), b3 + hstep, voffB); PG8_STAGE(PG8_SA(1, 0), a3, voffA);
            PG8_WAIT_V(8); PG8_WAIT_L(0); PG8_BAR; PG8_MMA(1, 0, At, B0); PG8_MMA(1, 1, At, B1); PG8_BAR; PG8_SCHED;
        }
        }
        if constexpr (ALIGN_EPI) { if (wr == 0) PG8_BAR; }
        E(acc, cur, wr, wc, fr, fq);
        if (!has_next) break;
#pragma unroll
        for (int a = 0; a < 2; ++a)
#pragma unroll
            for (int b = 0; b < 2; ++b)
#pragma unroll
                for (int m = 0; m < 4; ++m)
#pragma unroll
                    for (int n = 0; n < 2; ++n) acc[a][b][m][n] = (f32x4){0.f, 0.f, 0.f, 0.f};
        cur = nxt; cA = nA; cB = nB; ++ui;
        if constexpr (ALIGN_EPI) { if (wr == 1) PG8_BAR; }
    }
    PG8_WAIT_V(0);
    if constexpr (!ALIGN_EPI) { if (wr == 0) PG8_BAR; }
    PG8_BAR;
#undef PG8_SA
#undef PG8_SB
#undef PG8_STAGE
#undef PG8_LDA
#undef PG8_LDB
#undef PG8_MMA
#undef PG8_WAIT_V
#undef PG8_WAIT_L
#undef PG8_BAR
#undef PG8_SCHED
}
}
constexpr int NWAVES = 8, NT = NWAVES * 64;
constexpr int M = 8192, D = 2048, SEQ = 2048, NBATCH = 4, DEPTH = 2;
constexpr int INW = 13316, NPROJ = 13312, MIXW = 512, HD = 128;
constexpr int PEER_E = 16384;
constexpr float EPS = 1e-6f;
constexpr float ATT_SCALE = 0.08838834764831845f;

constexpr size_t MiB = 1u << 20;
constexpr size_t WS_CTL = 0, CTL_ZERO_BYTES = 1 * MiB;
constexpr size_t WS_SSQ = 0;
constexpr size_t WS_SSA = 256 * 1024;
constexpr size_t WS_WF = 1 * MiB;
constexpr size_t WS_BINR = WS_WF + 64 * 1024;
constexpr size_t WS_LOGF = 2 * MiB;
constexpr size_t WS_CUM = 3 * MiB;
constexpr size_t WS_WIN = 8 * MiB;
constexpr size_t WIN_BYTES = (size_t)NPROJ * D * 2;
constexpr size_t WS_WBR = 112 * MiB, WS_WOUT = 128 * MiB, WS_WQ = 144 * MiB;
constexpr size_t SQ_BYTES = (size_t)D * D * 2;
constexpr size_t WS_PU = 160 * MiB, WS_PV = 288 * MiB;
constexpr size_t PE_BYTES = (size_t)PEER_E * D * 2;
constexpr size_t WS_H = 416 * MiB;
constexpr size_t WS_HB = 480 * MiB;
constexpr size_t WS_PROJ = 512 * MiB;
constexpr size_t PROJ_T = (size_t)M * MIXW;
constexpr size_t WS_R = 592 * MiB;
constexpr size_t R_PLANE = (size_t)M * D;
constexpr size_t WS_Y = 720 * MiB;
constexpr size_t WS_MRG = 752 * MiB;
constexpr size_t WS_Q = 784 * MiB;
constexpr size_t WS_END = 816 * MiB;

constexpr int RING_BYTES = 131072;
constexpr int LDS_BYTES = 147456;

typedef unsigned short bf16;
typedef unsigned v4u __attribute__((ext_vector_type(4)));
typedef unsigned v2u __attribute__((ext_vector_type(2)));
typedef float f32x4 __attribute__((ext_vector_type(4)));
typedef float f32x2 __attribute__((ext_vector_type(2)));
using bf16x2 = __attribute__((ext_vector_type(2))) __bf16;
#define LAS __attribute__((address_space(3)))

__device__ __forceinline__ unsigned f2bf(float f) { unsigned u = __builtin_bit_cast(unsigned, f); return (u + 0x7fffu + ((u >> 16) & 1u)) >> 16; }
__device__ __forceinline__ unsigned pk2(float lo, float hi) { return f2bf(lo) | (f2bf(hi) << 16); }
__device__ __forceinline__ float bflo(unsigned w) { return __builtin_bit_cast(float, w << 16); }
__device__ __forceinline__ float bfhi(unsigned w) { return __builtin_bit_cast(float, w & 0xffff0000u); }
__device__ __forceinline__ float bf2f(bf16 b) { return __builtin_bit_cast(float, ((unsigned)b) << 16); }
__device__ __forceinline__ float shf(float v, int src) { return __builtin_bit_cast(float, __builtin_amdgcn_ds_bpermute(src << 2, __builtin_bit_cast(int, v))); }
__device__ __forceinline__ int shi(int v, int src) { return __builtin_amdgcn_ds_bpermute(src << 2, v); }
__device__ __forceinline__ float wave_sum(float v, int lane) {
#pragma unroll
    for (int o = 1; o < 64; o <<= 1) v += shf(v, lane ^ o);
    return v;
}
__device__ __forceinline__ float wave_max(float v, int lane) {
#pragma unroll
    for (int o = 1; o < 64; o <<= 1) v = fmaxf(v, shf(v, lane ^ o));
    return v;
}
__device__ __forceinline__ float ssa_to_f(unsigned long long v) { return (float)((double)v * (1.0 / 4294967296.0)); }
__device__ __forceinline__ float dot2_bf16(unsigned w, unsigned x, float acc) { return __builtin_amdgcn_fdot2_f32_bf16(__builtin_bit_cast(bf16x2, w), __builtin_bit_cast(bf16x2, x), acc, false); }

struct Args {
    const float *x, *norm_mix, *w_in, *b_in, *pool_w, *pool_scale, *conv_w, *rel_bias, *w_branch, *w_out, *norm_ffn, *peer_wq, *peer_keys, *peer_u, *peer_v, *norm_final;
    float* out; unsigned char* ws;
};
#define GAS __attribute__((address_space(1)))
#define CAS __attribute__((address_space(4)))
struct ArgsK {
    const GAS float *x, *norm_mix, *w_in, *b_in, *pool_w, *pool_scale, *conv_w, *rel_bias, *w_branch, *w_out, *norm_ffn, *peer_wq, *peer_keys, *peer_u, *peer_v, *norm_final;
    GAS float* out; GAS unsigned char* ws;
};
__device__ __forceinline__ Args load_args(const CAS ArgsK* k, size_t zoff) {
    Args a;
    a.x = (const float*)k->x; a.norm_mix = (const float*)k->norm_mix; a.w_in = (const float*)k->w_in; a.b_in = (const float*)k->b_in; a.pool_w = (const float*)k->pool_w;
    a.pool_scale = (const float*)k->pool_scale; a.conv_w = (const float*)k->conv_w; a.rel_bias = (const float*)k->rel_bias; a.w_branch = (const float*)k->w_branch;
    a.w_out = (const float*)k->w_out; a.norm_ffn = (const float*)k->norm_ffn; a.peer_wq = (const float*)k->peer_wq; a.peer_keys = (const float*)k->peer_keys;
    a.peer_u = (const float*)k->peer_u; a.peer_v = (const float*)k->peer_v; a.norm_final = (const float*)k->norm_final; a.out = (float*)k->out; a.ws = (unsigned char*)(k->ws + zoff);
    return a;
}

using pg8::f32x4; using pg8::Unit;
struct EpiProj {
    static constexpr bool PERM = true, HOOK = false;
    bf16* P; bf16* R; const float* bias; const float* ssq;
    __device__ __forceinline__ void operator()(f32x4 (&acc)[2][2][4][2], const Unit& u, int wr, int wc, int fr, int fq) const {
        const int row0 = u.pm * 256 + wr * 64 + fr, cl0 = wc * 32 + 8 * fq, bcol0 = u.pn * 256 + cl0;
        f32x4 bv[2][2];
#pragma unroll
        for (int bj = 0; bj < 2; ++bj)
#pragma unroll
            for (int n = 0; n < 2; ++n) bv[bj][n] = *(const f32x4*)(bias + bcol0 + bj * 128 + 4 * n);
        if (u.pn < 20) {
            bf16* base = P + (size_t)(u.pn >> 1) * PROJ_T + (u.pn & 1) * 256 + cl0;
#pragma unroll
            for (int ai = 0; ai < 2; ++ai)
#pragma unroll
                for (int m = 0; m < 4; ++m) { const int row = row0 + ai * 128 + m * 16; const float rs = rsqrtf(ssq[row] * (1.0f / D) + EPS);
                    bf16* rowp = base + (size_t)row * MIXW;
#pragma unroll
                    for (int bj = 0; bj < 2; ++bj) { const f32x4 v0 = acc[ai][bj][m][0] * rs + bv[bj][0], v1 = acc[ai][bj][m][1] * rs + bv[bj][1];
                        pg8::u32x4 w; w.x = pg8::cvt_pk_bf16(v0[0], v0[1]); w.y = pg8::cvt_pk_bf16(v0[2], v0[3]); w.z = pg8::cvt_pk_bf16(v1[0], v1[1]); w.w = pg8::cvt_pk_bf16(v1[2], v1[3]);
                        *(pg8::u32x4*)(rowp + bj * 128) = w; } }
        } else {
            const int d0 = 64 * (u.pn - 20) + 16 * wc + 4 * fq;
#pragma unroll
            for (int ai = 0; ai < 2; ++ai)
#pragma unroll
                for (int m = 0; m < 4; ++m) { const int row = row0 + ai * 128 + m * 16; const float rs = rsqrtf(ssq[row] * (1.0f / D) + EPS);
                    float r[4][4];
#pragma unroll
                    for (int j = 0; j < 4; ++j) { float e[4], ie[4];
#pragma unroll
                        for (int g = 0; g < 4; ++g) { const float z = acc[ai][g >> 1][m][g & 1][j] * rs + bv[g >> 1][g & 1][j];
                            e[g] = fminf(1.0f + __builtin_amdgcn_exp2f(-1.4426950408889634f * z), 1e18f); ie[g] = __builtin_amdgcn_rcpf(e[g]); }
                        r[0][j] = e[1] * ie[0]; r[1][j] = e[2] * ie[1]; r[2][j] = e[3] * ie[2]; r[3][j] = ie[3]; }
#pragma unroll
                    for (int g = 0; g < 4; ++g) { pg8::u32x2 w; w.x = pg8::cvt_pk_bf16(r[g][0], r[g][1]); w.y = pg8::cvt_pk_bf16(r[g][2], r[g][3]);
                        *(pg8::u32x2*)(R + (size_t)g * R_PLANE + (size_t)row * D + d0) = w; } }
        }
    }
};
struct EpiMerge {
    static constexpr bool PERM = true, HOOK = true;
    const bf16* R; bf16* O;
    template <int NB  >
    __device__ __forceinline__ void scale(f32x4 (&acc)[2][2][4][2], const Unit& u, int plane, int wr, int wc, int fr, int fq) const {
        const __amdgpu_buffer_rsrc_t rs = __builtin_amdgcn_make_buffer_rsrc((void*)(R + (size_t)plane * R_PLANE), 0, 0x7fffffff, 0x00020000);
        int voff = (fr * D + 8 * fq) * 2; asm volatile("" : "+v"(voff));
        const int sbase = ((u.pm * 256 + wr * 64) * D + u.pn * 256 + wc * 32) * 2;
#pragma unroll
        for (int b0 = 0; b0 < 8; b0 += NB) {
            pg8::u32x4 w[NB][2];
#pragma unroll
            for (int i = 0; i < NB; ++i)
#pragma unroll
                for (int bj = 0; bj < 2; ++bj) { const int ai = (b0 + i) >> 2, m = (b0 + i) & 3;
                    w[i][bj] = __builtin_amdgcn_raw_buffer_load_b128(rs, voff + bj * 256, sbase + (ai * 128 + m * 16) * D * 2, 0); }
#pragma unroll
            for (int i = 0; i < NB; ++i)
#pragma unroll
                for (int bj = 0; bj < 2; ++bj) { const int ai = (b0 + i) >> 2, m = (b0 + i) & 3; const pg8::u32x4 v = w[i][bj];
                    acc[ai][bj][m][0] *= (f32x4){bflo(v.x), bfhi(v.x), bflo(v.y), bfhi(v.y)};
                    acc[ai][bj][m][1] *= (f32x4){bflo(v.z), bfhi(v.z), bflo(v.w), bfhi(v.w)};
                    asm volatile("" : "+v"(acc[ai][bj][m][0]), "+v"(acc[ai][bj][m][1])); }
            asm volatile("" ::: "memory"); }
    }
    __device__ __forceinline__ void hook(f32x4 (&acc)[2][2][4][2], const Unit& u, int g, int wr, int wc, int fr, int fq) const { scale<4>(acc, u, g - 1, wr, wc, fr, fq); }
    __device__ __forceinline__ void operator()(f32x4 (&acc)[2][2][4][2], const Unit& u, int wr, int wc, int fr, int fq) const {
        scale<4>(acc, u, 3, wr, wc, fr, fq);
        const int row0 = u.pm * 256 + wr * 64 + fr, col0 = u.pn * 256 + wc * 32 + 8 * fq;
#pragma unroll
        for (int ai = 0; ai < 2; ++ai)
#pragma unroll
            for (int m = 0; m < 4; ++m) { bf16* rowp = O + (size_t)(row0 + ai * 128 + m * 16) * D + col0;
#pragma unroll
                for (int bj = 0; bj < 2; ++bj) { const f32x4 v0 = acc[ai][bj][m][0], v1 = acc[ai][bj][m][1];
                    pg8::u32x4 w; w.x = pg8::cvt_pk_bf16(v0[0], v0[1]); w.y = pg8::cvt_pk_bf16(v0[2], v0[3]); w.z = pg8::cvt_pk_bf16(v1[0], v1[1]); w.w = pg8::cvt_pk_bf16(v1[2], v1[3]);
                    *(pg8::u32x4*)(rowp + bj * 128) = w; } }
    }
};
struct EpiRes {
    static constexpr bool PERM = false, HOOK = false;
    float* H; bf16* HB; unsigned long long* ssa;
    __device__ __forceinline__ void operator()(f32x4 (&acc)[2][2][4][2], const Unit& u, int wr, int wc, int fr, int fq) const {
        const int row0 = u.pm * 256 + wr * 64 + fr, col0 = u.pn * 256 + wc * 32 + 4 * fq;
#pragma unroll
        for (int ai = 0; ai < 2; ++ai)
#pragma unroll
            for (int m = 0; m < 4; ++m) { const int row = row0 + ai * 128 + m * 16; const size_t off = (size_t)row * D + col0; float s = 0.f;
#pragma unroll
                for (int bj = 0; bj < 2; ++bj)
#pragma unroll
                    for (int n = 0; n < 2; ++n) { const size_t o = off + bj * 128 + n * 16; const f32x4 h = *(const f32x4*)(H + o) + acc[ai][bj][m][n];
                        *(f32x4*)(H + o) = h; pg8::u32x2 w; w.x = pg8::cvt_pk_bf16(h[0], h[1]); w.y = pg8::cvt_pk_bf16(h[2], h[3]); *(pg8::u32x2*)(HB + o) = w;
                        s += (h[0] * h[0] + h[1] * h[1]) + (h[2] * h[2] + h[3] * h[3]); }
                { const int ln = fq * 16 + fr; s += shf(s, ln ^ 16); s += shf(s, ln ^ 32); }
                if (fq == 0) atomicAdd(ssa + row, (unsigned long long)((double)s * 4294967296.0)); }
    }
};
struct EpiQ {
    static constexpr bool PERM = true, HOOK = false;
    bf16* O; const unsigned long long* ssa;
    __device__ __forceinline__ void operator()(f32x4 (&acc)[2][2][4][2], const Unit& u, int wr, int wc, int fr, int fq) const {
        const int row0 = u.pm * 256 + wr * 64 + fr, col0 = u.pn * 256 + wc * 32 + 8 * fq;
#pragma unroll
        for (int ai = 0; ai < 2; ++ai)
#pragma unroll
            for (int m = 0; m < 4; ++m) { const int row = row0 + ai * 128 + m * 16; const float rs = rsqrtf(ssa_to_f(ssa[row]) * (1.0f / D) + EPS);
                bf16* rowp = O + (size_t)row * D + col0;
#pragma unroll
                for (int bj = 0; bj < 2; ++bj) { const f32x4 v0 = acc[ai][bj][m][0] * rs, v1 = acc[ai][bj][m][1] * rs;
                    pg8::u32x4 w; w.x = pg8::cvt_pk_bf16(v0[0], v0[1]); w.y = pg8::cvt_pk_bf16(v0[2], v0[3]); w.z = pg8::cvt_pk_bf16(v1[0], v1[1]); w.w = pg8::cvt_pk_bf16(v1[2], v1[3]);
                    *(pg8::u32x4*)(rowp + bj * 128) = w; } }
    }
};

__device__ __forceinline__ int colmap_in(int j) {
    if (j < 1536) return j;
    if (j < 5120) return j + 4;
    const int c = (j - 5120) & 255, T = (j - 5120) >> 8;
    const int g = 2 * (c >> 7) + ((c >> 2) & 1), d = 64 * T + 16 * ((c >> 5) & 3) + 4 * ((c >> 3) & 3) + (c & 3);
    return 5124 + g * 2048 + d;
}
template <bool MAP>
__device__ __forceinline__ void tr_item(const float* W, int ldw, const float* scale, bf16* WT, int ldt, int dcol0, LAS float* scr, int k0, int n0, int lane) {
    const int nn = lane & 31, sc = MAP ? colmap_in(n0 + nn) : (n0 + nn);
#pragma unroll 8
    for (int i = 0; i < 32; ++i) { const int kk = 2 * i + (lane >> 5); float v = W[(size_t)(k0 + kk) * ldw + sc]; if (scale) v *= scale[k0 + kk]; scr[kk * 33 + nn] = v; }
    asm volatile("s_waitcnt lgkmcnt(0)" ::: "memory");
    const int c = lane & 7;
#pragma unroll
    for (int j = 0; j < 4; ++j) { const int n = (lane >> 3) + 8 * j; const LAS float* s = scr + (8 * c) * 33 + n;
        v4u o; o.x = pk2(s[0 * 33], s[1 * 33]); o.y = pk2(s[2 * 33], s[3 * 33]); o.z = pk2(s[4 * 33], s[5 * 33]); o.w = pk2(s[6 * 33], s[7 * 33]);
        *(v4u*)(WT + (size_t)(n0 + n) * ldt + dcol0 + k0 + 8 * c) = o; }
    asm volatile("s_waitcnt lgkmcnt(0)" ::: "memory");
}
namespace att {
constexpr int D = 128, NW = 8, QBLK = 32, KVBLK = 64, QB = NW * QBLK;
constexpr int PITCH = 512, OPITCH = 2048;
constexpr float SCALE = 0.08838834764831845f, THR = 8.f;
constexpr int SHM_V = KVBLK * D * 2, SHM_K = KVBLK * D * 2;
constexpr int OFF_WS = 2 * SHM_V + 2 * SHM_K, OFF_CUM = OFF_WS + NW * 64 * 4, OFF_REL = OFF_CUM + 2048 * 4, LDS_END = OFF_REL + 320 * 4;
typedef unsigned short bf16;
typedef short bf16x8 __attribute__((ext_vector_type(8)));
typedef short s16x4 __attribute__((ext_vector_type(4)));
typedef float f32x16 __attribute__((ext_vector_type(16)));
typedef float f32x4 __attribute__((ext_vector_type(4)));
typedef unsigned u32x4 __attribute__((ext_vector_type(4)));
#define ALDS __attribute__((address_space(3)))

#define KSWZ(row, colB) ((row) * 256 + ((colB) ^ (((row) & 7) << 4)))
#define SBAR() __builtin_amdgcn_sched_barrier(0)
__device__ __forceinline__ int v_st(int k, int c) { const int kk = (k & ~0xC) | ((k & 4) << 1) | ((k & 8) >> 1); return ((kk >> 3) * 4 + (c >> 5)) * 512 + ((kk & 7) * 32 + (c & 31)) * 2; }
__device__ __forceinline__ int v_rd_base(int lane) { return ((lane & 3) << 3) | (((lane >> 2) & 3) << 6) | (((lane >> 4) & 1) << 5) | (((lane >> 5) & 1) << 8); }
constexpr int v_rd_off(int d0, int ks, int half) { return d0 * 512 + ks * 4096 + half * 2048; }
__device__ __forceinline__ int crow(int r, int hi) { return (r & 3) + 8 * (r >> 2) + 4 * hi; }
__device__ __forceinline__ unsigned cvtpk(float lo, float hi) { unsigned r; asm volatile("v_cvt_pk_bf16_f32 %0, %1, %2" : "=v"(r) : "v"(lo), "v"(hi)); return r; }
__device__ __forceinline__ bf16x8 load8(const bf16* p) { return *reinterpret_cast<const bf16x8*>(p); }

__device__ __forceinline__ void mask_tile(f32x16& p0, f32x16& p1, int dq) {
    const float NEG = -__builtin_inff();
#pragma unroll
    for (int r = 0; r < 16; ++r) { const int c = (r & 3) + 8 * (r >> 2);
        if (dq - c < 0) p0[r] = NEG;
        if (dq - c - 32 < 0) p1[r] = NEG; }
}
__device__ __forceinline__ void partialSM(f32x16& p0, f32x16& p1, float& m_reg, float& mn, float& alpha) {
    float pmax = p0[0];
#pragma unroll
    for (int r = 1; r < 16; ++r) pmax = fmaxf(pmax, p0[r]);
#pragma unroll
    for (int r = 0; r < 16; ++r) pmax = fmaxf(pmax, p1[r]);
    { auto rr = __builtin_amdgcn_permlane32_swap(__float_as_uint(pmax), __float_as_uint(pmax), false, false);
      pmax = fmaxf(__uint_as_float(rr[0]), __uint_as_float(rr[1])); }
    constexpr float C2 = 1.4426950408889634f * SCALE;
    if (__builtin_expect(__all((pmax - m_reg) * SCALE <= THR), 1)) { mn = m_reg; alpha = 1.f; }
    else { mn = fmaxf(m_reg, pmax); alpha = __builtin_amdgcn_exp2f((m_reg - mn) * C2); m_reg = mn; }
    const float mnL = -mn * C2;
#pragma unroll
    for (int r = 0; r < 16; ++r) p0[r] = fmaf(p0[r], C2, mnL);
#pragma unroll
    for (int r = 0; r < 16; ++r) p1[r] = fmaf(p1[r], C2, mnL);
#pragma unroll
    for (int r = 0; r < 16; ++r) p0[r] = __builtin_amdgcn_exp2f(p0[r]);
}
__device__ __forceinline__ void finishSM(f32x16& p0, f32x16& p1, float alpha, float& l_reg, bf16x8& pa0, bf16x8& pa1, bf16x8& pa2, bf16x8& pa3) {
#pragma unroll
    for (int r = 0; r < 16; ++r) p1[r] = __builtin_amdgcn_exp2f(p1[r]);
    float ps = 0;
#pragma unroll
    for (int r = 0; r < 16; ++r) ps += p0[r];
#pragma unroll
    for (int r = 0; r < 16; ++r) ps += p1[r];
    { auto rr = __builtin_amdgcn_permlane32_swap(__float_as_uint(ps), __float_as_uint(ps), false, false);
      ps = __uint_as_float(rr[0]) + __uint_as_float(rr[1]); }
    l_reg = l_reg * alpha + ps;
#define PK4(P, B_, OUT) do { unsigned a0 = cvtpk(P[B_+0], P[B_+1]), a1 = cvtpk(P[B_+2], P[B_+3]);                          \
        unsigned b0 = cvtpk(P[B_+4], P[B_+5]), b1 = cvtpk(P[B_+6], P[B_+7]);                                             \
        auto r0 = __builtin_amdgcn_permlane32_swap(a0, b0, false, false); auto r1 = __builtin_amdgcn_permlane32_swap(a1, b1, false, false); \
        u32x4 w = {r0[0], r1[0], r0[1], r1[1]}; OUT = *reinterpret_cast<bf16x8*>(&w); } while (0)
    PK4(p0, 0, pa0); PK4(p0, 8, pa1); PK4(p1, 0, pa2); PK4(p1, 8, pa3);
#undef PK4
}
template <int KB>
__device__ __forceinline__ void qkt(f32x16& p0, f32x16& p1, const ALDS char* K_lds, int r32, int hi, const bf16x8* qr, bool act) {
    if (!act) { const float NEG = -__builtin_inff();
#pragma unroll
        for (int r = 0; r < 16; ++r) { p0[r] = NEG; p1[r] = NEG; } return; }
    p0 = f32x16{}; p1 = f32x16{};
    const ALDS char* kb[4];
#pragma unroll
    for (int dd = 0; dd < 4; ++dd) kb[dd] = K_lds + KB * SHM_K + KSWZ(r32, (dd * 16 + hi * 8) * 2);
#pragma unroll
    for (int d0 = 0; d0 < 8; ++d0) { const ALDS char* a = kb[d0 & 3] + (d0 >> 2) * 128;
        bf16x8 b0 = *(const ALDS bf16x8*)(a);
        bf16x8 b1 = *(const ALDS bf16x8*)(a + 32 * 256);
        p0 = __builtin_amdgcn_mfma_f32_32x32x16_bf16(b0, qr[d0], p0, 0, 0, 0);
        p1 = __builtin_amdgcn_mfma_f32_32x32x16_bf16(b1, qr[d0], p1, 0, 0, 0); }
}
template <int VB>
__device__ __forceinline__ void pv_tile(f32x16* o, int vb0, bf16x8 pa0, bf16x8 pa1, bf16x8 pa2, bf16x8 pa3, bool act) {
    if (!act) return;
#define TRRD(dst, off) asm volatile("ds_read_b64_tr_b16 %0, %1 offset:%2" : "=&v"(dst) : "v"(vb0), "i"(off) : "memory")
#define PV_D0(d0) do { s16x4 l0, l1, l2, l3, h0, h1, h2, h3; constexpr int b_ = VB * SHM_V + v_rd_off(d0, 0, 0); \
        TRRD(l0, b_); TRRD(h0, b_ + 2048); TRRD(l1, b_ + 4096); TRRD(h1, b_ + 6144); TRRD(l2, b_ + 8192); TRRD(h2, b_ + 10240); TRRD(l3, b_ + 12288); TRRD(h3, b_ + 14336); \
        asm volatile("s_waitcnt lgkmcnt(0)" ::: "memory"); SBAR(); \
        o[d0] = __builtin_amdgcn_mfma_f32_32x32x16_bf16(pa0, (bf16x8){l0[0], l0[1], l0[2], l0[3], h0[0], h0[1], h0[2], h0[3]}, o[d0], 0, 0, 0);   \
        o[d0] = __builtin_amdgcn_mfma_f32_32x32x16_bf16(pa1, (bf16x8){l1[0], l1[1], l1[2], l1[3], h1[0], h1[1], h1[2], h1[3]}, o[d0], 0, 0, 0);   \
        o[d0] = __builtin_amdgcn_mfma_f32_32x32x16_bf16(pa2, (bf16x8){l2[0], l2[1], l2[2], l2[3], h2[0], h2[1], h2[2], h2[3]}, o[d0], 0, 0, 0);   \
        o[d0] = __builtin_amdgcn_mfma_f32_32x32x16_bf16(pa3, (bf16x8){l3[0], l3[1], l3[2], l3[3], h3[0], h3[1], h3[2], h3[3]}, o[d0], 0, 0, 0); } while (0)
    PV_D0(0); PV_D0(1); PV_D0(2); PV_D0(3);
#undef PV_D0
#undef TRRD
}
template <int MODE>
__device__ __forceinline__ void bias_mask(f32x16& p0, f32x16& p1, const ALDS char* lds, int kb, int qlo, int qpos, int hi, float cqs, bool act) {
    if (!act) return;
    if (MODE == 0) {
        const ALDS float* cs = (const ALDS float*)(lds + OFF_CUM) + kb + 4 * hi;
#pragma unroll
        for (int g = 0; g < 4; ++g) { const f32x4 c0 = *(const ALDS f32x4*)(cs + 8 * g), c1 = *(const ALDS f32x4*)(cs + 32 + 8 * g);
#pragma unroll
            for (int e = 0; e < 4; ++e) { p0[4 * g + e] += cqs - c0[e]; p1[4 * g + e] += cqs - c1[e]; } }
        if (kb + KVBLK - 1 > qlo) mask_tile(p0, p1, qpos - 4 * hi - kb);
    } else {
        const ALDS float* tb = (const ALDS float*)(lds + OFF_REL);
        if (qlo - (kb + KVBLK - 1) >= 256) { const float c = tb[319];
#pragma unroll
            for (int r = 0; r < 16; ++r) { p0[r] += c; p1[r] += c; } }
        else { const int d0 = qpos - kb - 4 * hi + 63;
#pragma unroll
            for (int r = 0; r < 16; ++r) { const int c = (r & 3) + 8 * (r >> 2);
                int i0 = d0 - c, i1 = d0 - c - 32; i0 = i0 > 319 ? 319 : i0; i1 = i1 > 319 ? 319 : i1; i1 = i1 < 0 ? 0 : i1; i0 = i0 < 0 ? 0 : i0;
                p0[r] += tb[i0]; p1[r] += tb[i1]; } }
    }
}

struct Seam { bf16x8 qr[8]; bf16x8 st_v0, st_v1, st_k0, st_k1; };
#define VMW() asm volatile("s_waitcnt vmcnt(0)" ::: "memory")
#define BL8(rs, vo, so) __builtin_bit_cast(bf16x8, __builtin_amdgcn_raw_buffer_load_b128(rs, vo, so, 0))
#define SLOAD_H(Kp, Vp, k0) do { S.st_v0 = BL8(rP, kvoff, (Vp) + (k0) * (PITCH * 2)); S.st_v1 = BL8(rP, kvoff, (Vp) + ((k0) + 32) * (PITCH * 2));              \
                         S.st_k0 = BL8(rP, kvoff, (Kp) + (k0) * (PITCH * 2)); S.st_k1 = BL8(rP, kvoff, (Kp) + ((k0) + 32) * (PITCH * 2)); } while (0)
#define SWRITE_HK(bf) do { *(ALDS bf16x8*)(K_lds + (bf) * SHM_K + kws) = S.st_k0; *(ALDS bf16x8*)(K_lds + (bf) * SHM_K + kws + 32 * 256) = S.st_k1; } while (0)
#define SWRITE_HV(bf) do { *(ALDS bf16x8*)(V_lds + (bf) * SHM_V + vst0) = S.st_v0; *(ALDS bf16x8*)(V_lds + (bf) * SHM_V + vst1) = S.st_v1; } while (0)
#define SWRITE_H(bf) do { SWRITE_HV(bf); SWRITE_HK(bf); } while (0)

template <int MODE>
__device__ __forceinline__ void attn_unit(const bf16* Pb, int Qo, int Kh, int Vh, bf16* Yb, int Oo, int P0, int j_lo, int j_hi, ALDS char* lds, int wid, int lane) {
    const int tid = wid * 64 + lane, r32 = lane & 31, hi = lane >> 5;
    const int NT = j_hi - j_lo;
    const int qlo = P0 + wid * QBLK, qpos = qlo + r32;
    ALDS char* V_lds = lds; ALDS char* K_lds = lds + 2 * SHM_V;
    ALDS float* ws = (ALDS float*)(lds + OFF_WS) + wid * 64; ALDS float* li_l = ws; ALDS float* al_l = ws + 32;
    float m_reg = -1e30f, l_reg = 0; f32x16 o[4] = {};
    const int sr = tid >> 4, sc = (tid & 15) * 8, vst0 = v_st(sr, sc), vst1 = v_st(32 + sr, sc), kws = KSWZ(sr, sc * 2);
    const int vb0 = (int)(unsigned)(size_t)V_lds + v_rd_base(lane);
    Seam S;
    const __amdgpu_buffer_rsrc_t rP = __builtin_amdgcn_make_buffer_rsrc((void*)Pb, 0, 0x7fffffff, 0x00020000);
    const __amdgpu_buffer_rsrc_t rO = __builtin_amdgcn_make_buffer_rsrc((void*)Yb, 0, 0x7fffffff, 0x00020000);
    const int kvoff = (sr * PITCH + sc) * 2;
#define KBASE(t) ((j_lo + (t)) * KVBLK)
#define ACT(t) (MODE == 0 ? (KBASE(t) <= qlo + QBLK - 1) : ((j_lo + (t)) <= (qlo >> 6) && (j_lo + (t)) + 8 >= (qlo >> 6)))
#define RESC(a) do { if (__any((a) < 1.f)) { if (hi == 0) al_l[r32] = (a); asm volatile("s_waitcnt lgkmcnt(0)" ::: "memory");              \
                     for (int d_ = 0; d_ < 4; ++d_) for (int r = 0; r < 16; ++r) o[d_][r] *= al_l[crow(r, hi)]; } } while (0)
#define MASKT(P0_, P1_, t) bias_mask<MODE>(P0_, P1_, lds, KBASE(t), qlo, qpos, hi, cq_, ACT(t))
    {
        const int kb0 = j_lo * KVBLK;
#pragma unroll
        for (int d0 = 0; d0 < 8; ++d0) S.qr[d0] = BL8(rP, (r32 * PITCH + hi * 8) * 2 + d0 * 32, Qo + wid * (QBLK * PITCH * 2));
        SLOAD_H(Kh, Vh, kb0); VMW(); SWRITE_HK(0);
        __syncthreads();
    }
    const float cq_ = MODE == 0 ? ((const ALDS float*)(lds + OFF_CUM))[qpos] : 0.f;
    f32x16 pA0, pA1, pB0, pB1; float mnA, mnB, alA, alB; bf16x8 pa0, pa1, pa2, pa3;
    SWRITE_HV(0); SBAR();
    if (NT > 1) { SLOAD_H(Kh, Vh, KBASE(1)); }
    SBAR(); qkt<0>(pA0, pA1, K_lds, r32, hi, S.qr, ACT(0));
    MASKT(pA0, pA1, 0); partialSM(pA0, pA1, m_reg, mnA, alA);
    if (NT > 1) { VMW(); SWRITE_H(1); }
    __syncthreads();
#define HALF_STEP(PX0, PX1, mnX, alX, PY0, PY1, alY, t, KB, VB, SB) do {                                                      \
        SBAR(); qkt<KB>(PX0, PX1, K_lds, r32, hi, S.qr, ACT(t));                                                              \
        finishSM(PY0, PY1, alY, l_reg, pa0, pa1, pa2, pa3); SBAR();                                                           \
        if ((t) + 1 < NT) { SLOAD_H(Kh, Vh, KBASE((t) + 1)); SBAR(); }                                                        \
        pv_tile<VB>(o, vb0, pa0, pa1, pa2, pa3, ACT((t) - 1)); MASKT(PX0, PX1, (t)); partialSM(PX0, PX1, m_reg, mnX, alX);    \
        __syncthreads();                                                                                                      \
        if ((t) + 1 < NT) { VMW(); SWRITE_H(SB); }                                                                            \
        RESC(alX); __syncthreads(); } while (0)
    for (int t = 1; t + 1 < NT; t += 2) {
        HALF_STEP(pB0, pB1, mnB, alB, pA0, pA1, alA, t, 1, 0, 0);
        HALF_STEP(pA0, pA1, mnA, alA, pB0, pB1, alB, t + 1, 0, 1, 1);
    }
    const bool even = (NT & 1) == 0;
    if (even) { SBAR(); qkt<1>(pB0, pB1, K_lds, r32, hi, S.qr, ACT(NT - 1)); SBAR(); }
    finishSM(pA0, pA1, alA, l_reg, pa0, pa1, pa2, pa3); SBAR();
    pv_tile<0>(o, vb0, pa0, pa1, pa2, pa3, ACT(even ? NT - 2 : NT - 1));
    if (even) { MASKT(pB0, pB1, NT - 1); partialSM(pB0, pB1, m_reg, mnB, alB); __syncthreads(); RESC(alB);
        finishSM(pB0, pB1, alB, l_reg, pa0, pa1, pa2, pa3); SBAR(); pv_tile<1>(o, vb0, pa0, pa1, pa2, pa3, ACT(NT - 1)); }
    SBAR();
    if (hi == 0) li_l[r32] = l_reg; asm volatile("s_waitcnt lgkmcnt(0)" ::: "memory");
    float rli[16];
#pragma unroll
    for (int r = 0; r < 16; ++r) rli[r] = __builtin_amdgcn_rcpf(li_l[crow(r, hi)]);
    const int ovoff = (4 * hi * OPITCH + r32) * 2, osoff = Oo + wid * (QBLK * OPITCH * 2);
#pragma unroll
    for (int r = 0; r < 16; ++r) { const int orow = (r & 3) + 8 * (r >> 2);
#pragma unroll
        for (int d0 = 0; d0 < 4; ++d0) { const float v = o[d0][r] * rli[r];
            const float vn = __builtin_bit_cast(float, __builtin_amdgcn_ds_bpermute((lane ^ 1) << 2, __builtin_bit_cast(int, v)));
            if ((r32 & 1) == 0) __builtin_amdgcn_raw_buffer_store_b32(cvtpk(v, vn), rO, ovoff + d0 * 64, osoff + orow * (OPITCH * 2), 0); } }
    __syncthreads();
#undef RESC
#undef KBASE
#undef ACT
#undef MASKT
#undef HALF_STEP
}
#undef BL8
#undef VMW
#undef SLOAD_H
#undef SWRITE_HK
#undef SWRITE_HV
#undef SWRITE_H
#undef KSWZ
#undef SBAR
}
constexpr size_t WS_QCTR = 768 * 1024;
constexpr size_t WS_POOLW = 4 * MiB;
constexpr int N_ATT_UNITS = 256, N_POOL_UNITS = 512, N_CONV_UNITS = 128;

__device__ __forceinline__ void stage_cum(const Args& a, int b, int h, LAS char* lds, int wave, int lane) {
    const float* logf = (const float*)(a.ws + WS_LOGF) + ((size_t)b * SEQ) * 4 + h;
    const int tid = wave * 64 + lane;
    float v[4];
#pragma unroll
    for (int e = 0; e < 4; ++e) v[e] = logf[(size_t)(4 * tid + e) * 4];
    v[1] += v[0]; v[2] += v[1]; v[3] += v[2];
    float incl = v[3];
#pragma unroll
    for (int o = 1; o < 64; o <<= 1) { const float t = shf(incl, lane >= o ? lane - o : lane); if (lane >= o) incl += t; }
    LAS float* wt = (LAS float*)(lds + att::OFF_WS);
    if (lane == 63) wt[wave] = incl;
    __syncthreads();
    float base = incl - v[3];
    for (int w = 0; w < wave; ++w) base += wt[w];
    LAS float* cs = (LAS float*)(lds + att::OFF_CUM);
    const float inv = 1.0f / ATT_SCALE;
    *(LAS f32x4*)(cs + 4 * tid) = (f32x4){(base + v[0]) * inv, (base + v[1]) * inv, (base + v[2]) * inv, (base + v[3]) * inv};
    __syncthreads();
}
__device__ __forceinline__ void attention_item(const Args& a, int l, int u, LAS char* lds, int wave) {
    int lane; asm volatile("v_mbcnt_lo_u32_b32 %0, -1, 0\n\tv_mbcnt_hi_u32_b32 %0, -1, %0" : "=v"(lane));
    const bf16* P = (const bf16*)(a.ws + WS_PROJ); bf16* Y = (bf16*)(a.ws + WS_Y);
    const int mode = u >> 7, v = u & 127, qb = 7 - (v >> 4), bh = v & 15, b = bh >> 2, h = bh & 3;
    const size_t row0 = (size_t)b * SEQ; const int P0 = qb * 256;
    if (mode == 0) {
        stage_cum(a, b, h, lds, wave, lane);
        att::attn_unit<0>(P, (int)((0 * PROJ_T + (row0 + P0) * MIXW + h * HD) * 2), (int)((1 * PROJ_T + row0 * MIXW + h * HD) * 2), (int)((2 * PROJ_T + row0 * MIXW + h * HD) * 2),
                          Y, (int)(((row0 + P0) * D + h * HD) * 2), P0, 0, 4 * qb + 4, lds, wave, lane);
    } else {
        const int tid = wave * 64 + lane;
        if (tid < 320) ((LAS float*)(lds + att::OFF_REL))[tid] = a.rel_bias[((size_t)l * 4 + h) * 320 + tid] * (1.0f / ATT_SCALE);
        const int jlo = 4 * qb - 8 < 0 ? 0 : 4 * qb - 8;
        att::attn_unit<1>(P, (int)((7 * PROJ_T + (row0 + P0) * MIXW + h * HD) * 2), (int)((8 * PROJ_T + row0 * MIXW + h * HD) * 2), (int)((9 * PROJ_T + row0 * MIXW + h * HD) * 2),
                          Y, (int)(((row0 + P0) * D + 1536 + h * HD) * 2), P0, jlo, 4 * qb + 4, lds, wave, lane);
    }
}
__device__ __forceinline__ void pool_item(const Args& a, int l, int u, LAS char* lds, int wave) {
    int lane; asm volatile("v_mbcnt_lo_u32_b32 %0, -1, 0\n\tv_mbcnt_hi_u32_b32 %0, -1, %0" : "=v"(lane));
    const int g = u & 3, T0 = (u >> 2) * 64, tid = wave * 64 + lane;
    const bf16* Pin = (const bf16*)(a.ws + WS_PROJ) + 3 * PROJ_T + g * 128;
    {
        const int cp = tid & 63, run = tid >> 6, w = 2 << g, t0 = T0 + run * 8, s0 = t0 & (SEQ - 1);
        const bf16* col = Pin + 2 * cp;
        float s_lo = 0.f, s_hi = 0.f;
        for (int j = 1; j < w; ++j) if (s0 - j >= 0) { const unsigned x = *(const unsigned*)(col + (size_t)(t0 - j) * MIXW); s_lo += bflo(x); s_hi += bfhi(x); }
#pragma unroll
        for (int i = 0; i < 8; ++i) { const unsigned x = *(const unsigned*)(col + (size_t)(t0 + i) * MIXW); s_lo += bflo(x); s_hi += bfhi(x);
            const int s = s0 + i; const int cnt = s + 1 < w ? s + 1 : w; const float inv = 1.0f / (float)cnt;
            *(LAS unsigned*)(lds + (run * 8 + i) * 272 + 4 * cp) = pk2(s_lo * inv - bflo(x), s_hi * inv - bfhi(x));
            if (s - w + 1 >= 0) { const unsigned y = *(const unsigned*)(col + (size_t)(t0 + i - w + 1) * MIXW); s_lo -= bflo(y); s_hi -= bfhi(y); } }
    }
    __syncthreads();
    {
        typedef short bf16x8 __attribute__((ext_vector_type(8)));
        const bf16* Wt = (const bf16*)(a.ws + WS_POOLW) + ((size_t)l * 4 + g) * 128 * 128;
        const int rt = (wave & 3) * 16, db = (wave >> 2) * 64, fr = lane & 15, kg = lane >> 4;
        f32x4 acc[4] = {};
#pragma unroll
        for (int ks = 0; ks < 4; ++ks) { const bf16x8 af = *(const LAS bf16x8*)(lds + (rt + fr) * 272 + (ks * 32 + kg * 8) * 2);
#pragma unroll
            for (int nt = 0; nt < 4; ++nt) { const bf16x8 bfr = *(const bf16x8*)(Wt + (size_t)(db + nt * 16 + fr) * 128 + ks * 32 + kg * 8);
                acc[nt] = __builtin_amdgcn_mfma_f32_16x16x32_bf16(bfr, af, acc[nt], 0, 0, 0); } }
        bf16* Y = (bf16*)(a.ws + WS_Y) + (size_t)(T0 + rt + fr) * D + 512 + g * 128;
#pragma unroll
        for (int nt = 0; nt < 4; ++nt) { const int d = db + nt * 16 + kg * 4; const f32x4 sc = *(const f32x4*)(a.pool_scale + l * MIXW + g * 128 + d);
            v2u w; w.x = pk2(acc[nt][0] * sc[0], acc[nt][1] * sc[1]); w.y = pk2(acc[nt][2] * sc[2], acc[nt][3] * sc[3]); *(v2u*)(Y + d) = w; }
    }
    __syncthreads();
}
__device__ __forceinline__ void conv_item(const Args& a, int l, int u, int wave) {
    int lane; asm volatile("v_mbcnt_lo_u32_b32 %0, -1, 0\n\tv_mbcnt_hi_u32_b32 %0, -1, %0" : "=v"(lane));
    const bf16* P = (const bf16*)(a.ws + WS_PROJ); const bf16* Ch = P + 4 * PROJ_T; const bf16* Cb = P + 5 * PROJ_T; const bf16* Cc = P + 6 * PROJ_T;
    const int tid = wave * 64 + lane, c0 = (tid & 63) * 8, t0 = u * 64 + (tid >> 6) * 8, s0 = t0 & (SEQ - 1);
    float wgt[3][8];
#pragma unroll
    for (int j = 0; j < 3; ++j) { const float* w = a.conv_w + ((size_t)l * 3 + j) * MIXW + c0; const f32x4 w0 = *(const f32x4*)w, w1 = *(const f32x4*)(w + 4);
#pragma unroll
        for (int k = 0; k < 4; ++k) { wgt[j][k] = w0[k]; wgt[j][4 + k] = w1[k]; } }
    float z2[8], z1[8];
#pragma unroll
    for (int k = 0; k < 8; ++k) { z2[k] = 0.f; z1[k] = 0.f; }
#pragma unroll
    for (int i = -2; i < 8; ++i) {
        float z[8];
        if (s0 + i >= 0) { const v4u hv = *(const v4u*)(Ch + (size_t)(t0 + i) * MIXW + c0), cv = *(const v4u*)(Cc + (size_t)(t0 + i) * MIXW + c0);
            z[0] = bflo(hv.x) * bflo(cv.x); z[1] = bfhi(hv.x) * bfhi(cv.x); z[2] = bflo(hv.y) * bflo(cv.y); z[3] = bfhi(hv.y) * bfhi(cv.y);
            z[4] = bflo(hv.z) * bflo(cv.z); z[5] = bfhi(hv.z) * bfhi(cv.z); z[6] = bflo(hv.w) * bflo(cv.w); z[7] = bfhi(hv.w) * bfhi(cv.w); }
        else {
#pragma unroll
            for (int k = 0; k < 8; ++k) z[k] = 0.f; }
        if (i >= 0) { const v4u bv = *(const v4u*)(Cb + (size_t)(t0 + i) * MIXW + c0); float o[8];
            const float bb[8] = {bflo(bv.x), bfhi(bv.x), bflo(bv.y), bfhi(bv.y), bflo(bv.z), bfhi(bv.z), bflo(bv.w), bfhi(bv.w)};
#pragma unroll
            for (int k = 0; k < 8; ++k) o[k] = bb[k] * (wgt[0][k] * z2[k] + wgt[1][k] * z1[k] + wgt[2][k] * z[k]);
            v4u ov; ov.x = pk2(o[0], o[1]); ov.y = pk2(o[2], o[3]); ov.z = pk2(o[4], o[5]); ov.w = pk2(o[6], o[7]);
            *(v4u*)((bf16*)(a.ws + WS_Y) + (size_t)(t0 + i) * D + 1024 + c0) = ov; }
#pragma unroll
        for (int k = 0; k < 8; ++k) { z2[k] = z1[k]; z1[k] = z[k]; }
    }
}
__device__ __forceinline__ void mixers_fast(const Args& a, int l, LAS char* lds, int wave, int lane, int G, int blk) {
    for (int u = blk; u < N_ATT_UNITS; u += G) attention_item(a, l, u, lds, wave);
    unsigned* head = (unsigned*)(a.ws + WS_QCTR) + 64 * l;
    volatile LAS unsigned* slot = (volatile LAS unsigned*)(lds + att::LDS_END);
    for (;;) {
        if (wave == 0 && lane == 0) *slot = __hip_atomic_fetch_add(head, 1u, __ATOMIC_RELAXED, __HIP_MEMORY_SCOPE_AGENT);
        __syncthreads();
        const unsigned it = *slot;
        __syncthreads();
        if (it >= (unsigned)(N_POOL_UNITS + N_CONV_UNITS)) break;
        if (it < (unsigned)N_POOL_UNITS) pool_item(a, l, (int)it, lds, wave); else conv_item(a, l, (int)it - N_POOL_UNITS, wave);
    }
}
__device__ __forceinline__ void p0_prologue(const Args& a, LAS unsigned char* lds, int gw, int NGW, int wave, int lane) {
    unsigned char* ws = a.ws;
    LAS float* scr = (LAS float*)(lds + wave * 16384);
    constexpr int I_WIN = (D / 64) * (NPROJ / 32), I_SQ = (D / 64) * (D / 32), I_BR = (MIXW / 64) * (D / 32);
    constexpr int I_LAYER = I_WIN + 4 * I_BR + 2 * I_SQ;
    for (int it = gw; it < DEPTH * I_LAYER; it += NGW) {
        const int l = it / I_LAYER; int r = it - l * I_LAYER;
        if (r < I_WIN) { const int kb = r / (NPROJ / 32), nb = r % (NPROJ / 32);
            tr_item<true>(a.w_in + (size_t)l * D * INW, INW, a.norm_mix + l * D, (bf16*)(ws + WS_WIN + l * WIN_BYTES), D, 0, scr, 64 * kb, 32 * nb, lane); continue; }
        r -= I_WIN;
        if (r < 4 * I_BR) { const int g = r / I_BR, rr = r % I_BR, kb = rr / (D / 32), nb = rr % (D / 32);
            tr_item<false>(a.w_branch + ((size_t)l * 4 + g) * MIXW * D, D, nullptr, (bf16*)(ws + WS_WBR + l * SQ_BYTES), D, g * MIXW, scr, 64 * kb, 32 * nb, lane); continue; }
        r -= 4 * I_BR;
        if (r < I_SQ) { const int kb = r / (D / 32), nb = r % (D / 32);
            tr_item<false>(a.w_out + (size_t)l * D * D, D, nullptr, (bf16*)(ws + WS_WOUT + l * SQ_BYTES), D, 0, scr, 64 * kb, 32 * nb, lane); continue; }
        r -= I_SQ;
        { const int kb = r / (D / 32), nb = r % (D / 32);
            tr_item<false>(a.peer_wq + (size_t)l * D * D, D, a.norm_ffn + l * D, (bf16*)(ws + WS_WQ + l * SQ_BYTES), D, 0, scr, 64 * kb, 32 * nb, lane); }
    }
    for (int it = gw; it < DEPTH * 4 * 8; it += NGW) { const int lg = it >> 3, r = it & 7;
        tr_item<false>(a.pool_w + (size_t)lg * 128 * 128, 128, nullptr, (bf16*)(ws + WS_POOLW) + (size_t)lg * 128 * 128, 128, 0, scr, 64 * (r >> 2), 32 * (r & 3), lane); }
    {
        const size_t n8 = (size_t)DEPTH * PEER_E * D / 8;
        for (int t = 0; t < 2; ++t) { const float* src = t ? a.peer_v : a.peer_u; bf16* dst = (bf16*)(ws + (t ? WS_PV : WS_PU));
            for (size_t i = (size_t)gw * 64 + lane; i < n8; i += (size_t)NGW * 64) { const f32x4 v0 = *(const f32x4*)(src + i * 8), v1 = *(const f32x4*)(src + i * 8 + 4);
                v4u o; o.x = pk2(v0[0], v0[1]); o.y = pk2(v0[2], v0[3]); o.z = pk2(v1[0], v1[1]); o.w = pk2(v1[2], v1[3]); *(v4u*)(dst + i * 8) = o; } }
    }
    {
        float* wf = (float*)(ws + WS_WF); float* binr = (float*)(ws + WS_BINR);
        const int gt = gw * 64 + lane, NGT = NGW * 64;
        for (int i = gt; i < DEPTH * 4 * D; i += NGT) { const int l = i / (4 * D), h = (i / D) & 3, k = i % D; wf[i] = a.w_in[(size_t)l * D * INW + (size_t)k * INW + 1536 + h] * a.norm_mix[l * D + k]; }
        for (int i = gt; i < DEPTH * NPROJ; i += NGT) { const int l = i / NPROJ, j = i % NPROJ; binr[i] = a.b_in[l * INW + colmap_in(j)]; }
    }
    {
        float* H = (float*)(ws + WS_H); bf16* HB = (bf16*)(ws + WS_HB); float* ssq = (float*)(ws + WS_SSQ);
        for (int m = gw; m < M; m += NGW) { float s = 0.f;
#pragma unroll
            for (int j = 0; j < 8; ++j) { const size_t o = (size_t)m * D + j * 256 + lane * 4; const f32x4 v = *(const f32x4*)(a.x + o); *(f32x4*)(H + o) = v;
                v2u w; w.x = pk2(v[0], v[1]); w.y = pk2(v[2], v[3]); *(v2u*)(HB + o) = w; s += (v[0] * v[0] + v[1] * v[1]) + (v[2] * v[2] + v[3] * v[3]); }
            s = wave_sum(s, lane); if (lane == 0) ssq[m] = s; }
    }
}

__device__ __forceinline__ void forget_logits(const Args& a, int l, int gw, int NGW, int lane) {
    unsigned char* ws = a.ws; const bf16* HB = (const bf16*)(ws + WS_HB); const float* wf = (const float*)(ws + WS_WF) + l * 4 * D; const float* ssq = (const float*)(ws + WS_SSQ) + l * M;
    float* logf = (float*)(ws + WS_LOGF);
    for (int m = gw; m < M; m += NGW) {
        float d[4] = {0.f, 0.f, 0.f, 0.f};
#pragma unroll
        for (int j = 0; j < 4; ++j) { const int k0 = j * 512 + lane * 8; const v4u xv = *(const v4u*)(HB + (size_t)m * D + k0);
            const float x[8] = {bflo(xv.x), bfhi(xv.x), bflo(xv.y), bfhi(xv.y), bflo(xv.z), bfhi(xv.z), bflo(xv.w), bfhi(xv.w)};
#pragma unroll
            for (int h = 0; h < 4; ++h) { const f32x4 w0 = *(const f32x4*)(wf + h * D + k0), w1 = *(const f32x4*)(wf + h * D + k0 + 4);
                d[h] += x[0] * w0[0] + x[1] * w0[1] + x[2] * w0[2] + x[3] * w0[3] + x[4] * w1[0] + x[5] * w1[1] + x[6] * w1[2] + x[7] * w1[3]; } }
        const float rs = rsqrtf(ssq[m] * (1.0f / D) + EPS);
#pragma unroll
        for (int h = 0; h < 4; ++h) { const float z = wave_sum(d[h], lane) * rs + a.b_in[l * INW + 1536 + h];
            const float ls = fminf(z, 0.f) - log1pf(__expf(-fabsf(z)));
            if (lane == h) logf[m * 4 + h] = ls; }
    }
}
__device__ __forceinline__ void cum_scan(const Args& a, int gw, int lane) {
    if (gw >= 16) return;
    const float* logf = (const float*)(a.ws + WS_LOGF); float* cum = (float*)(a.ws + WS_CUM);
    const int b = gw >> 2, h = gw & 3; float run = 0.f;
    for (int c = 0; c < SEQ / 64; ++c) { float v = logf[(size_t)(b * SEQ + c * 64 + lane) * 4 + h];
#pragma unroll
        for (int o = 1; o < 64; o <<= 1) { const float t = shf(v, lane >= o ? lane - o : lane); if (lane >= o) v += t; }
        v += run; cum[(size_t)gw * SEQ + c * 64 + lane] = v; run = shf(v, 63); }
}

template <int MODE>
__device__ __forceinline__ void naive_attn(const Args& a, int l, int b, int h, int s, LAS float* sc, int lane) {
    const unsigned char* ws = a.ws; const bf16* P = (const bf16*)(ws + WS_PROJ);
    const bf16* Qp = P + (MODE ? 7 : 0) * PROJ_T; const bf16* Kp = P + (MODE ? 8 : 1) * PROJ_T; const bf16* Vp = P + (MODE ? 9 : 2) * PROJ_T;
    const float* cum = (const float*)(ws + WS_CUM) + (size_t)(b * 4 + h) * SEQ;
    const float* rb = a.rel_bias + ((size_t)l * 4 + h) * 320;
    const size_t tb = (size_t)b * SEQ;
    int klo = 0, khi = s;
    if (MODE) { const int c = s >> 6; klo = (c - 8) * 64; if (klo < 0) klo = 0; khi = c * 64 + 63; }
    const bf16* qrow = Qp + (tb + s) * MIXW + h * HD;
    float mx = -3.0e38f;
    for (int kb = klo; kb <= khi; kb += 64) { const int k = kb + lane;
        if (k <= khi) { const bf16* krow = Kp + (tb + k) * MIXW + h * HD; float d = 0.f;
#pragma unroll 4
            for (int c8 = 0; c8 < 16; ++c8) { const v4u qv = *(const v4u*)(qrow + c8 * 8), kv = *(const v4u*)(krow + c8 * 8);
                d = dot2_bf16(qv.x, kv.x, d); d = dot2_bf16(qv.y, kv.y, d); d = dot2_bf16(qv.z, kv.z, d); d = dot2_bf16(qv.w, kv.w, d); }
            float bias;
            if (MODE == 0) bias = cum[s] - cum[k];
            else { int rel = s - k; rel = rel < -63 ? -63 : (rel > 256 ? 256 : rel); bias = rb[rel + 63]; }
            const float lg = d * ATT_SCALE + bias; sc[k - klo] = lg; mx = fmaxf(mx, lg); } }
    mx = wave_max(mx, lane);
    asm volatile("s_waitcnt lgkmcnt(0)" ::: "memory");
    float sum = 0.f;
    for (int kb = klo; kb <= khi; kb += 64) { const int k = kb + lane; if (k <= khi) { const float p = __expf(sc[k - klo] - mx); sc[k - klo] = p; sum += p; } }
    sum = wave_sum(sum, lane);
    asm volatile("s_waitcnt lgkmcnt(0)" ::: "memory");
    float o0 = 0.f, o1 = 0.f;
    for (int k = klo; k <= khi; ++k) { const float p = sc[k - klo]; const unsigned v = *(const unsigned*)(Vp + (tb + k) * MIXW + h * HD + 2 * lane); o0 += p * bflo(v); o1 += p * bfhi(v); }
    const float inv = 1.0f / sum;
    bf16* Y = (bf16*)(a.ws + WS_Y);
    *(unsigned*)(Y + (tb + s) * D + (MODE ? 1536 : 0) + h * HD + 2 * lane) = pk2(o0 * inv, o1 * inv);
    asm volatile("s_waitcnt lgkmcnt(0)" ::: "memory");
}
__device__ __forceinline__ void naive_pool(const Args& a, int l, int t, int g, LAS float* sc, int lane) {
    const bf16* Pin = (const bf16*)(a.ws + WS_PROJ) + 3 * PROJ_T;
    const int s = t & (SEQ - 1), w = 2 << g; const int cnt = (s + 1 < w) ? s + 1 : w;
    float s0 = 0.f, s1 = 0.f;
    for (int j = 0; j < cnt; ++j) { const unsigned v = *(const unsigned*)(Pin + (size_t)(t - j) * MIXW + g * 128 + 2 * lane); s0 += bflo(v); s1 += bfhi(v); }
    const unsigned v0 = *(const unsigned*)(Pin + (size_t)t * MIXW + g * 128 + 2 * lane);
    const float inv = 1.0f / (float)cnt;
    sc[2 * lane] = s0 * inv - bflo(v0); sc[2 * lane + 1] = s1 * inv - bfhi(v0);
    asm volatile("s_waitcnt lgkmcnt(0)" ::: "memory");
    const float* W = a.pool_w + ((size_t)l * 4 + g) * 128 * 128;
    float o0 = 0.f, o1 = 0.f;
    for (int c = 0; c < 128; ++c) { const float p = sc[c]; const f32x2 wv = *(const f32x2*)(W + c * 128 + 2 * lane); o0 += p * wv[0]; o1 += p * wv[1]; }
    const f32x2 ps = *(const f32x2*)(a.pool_scale + l * MIXW + g * 128 + 2 * lane);
    bf16* Y = (bf16*)(a.ws + WS_Y);
    *(unsigned*)(Y + (size_t)t * D + 512 + g * 128 + 2 * lane) = pk2(o0 * ps[0], o1 * ps[1]);
    asm volatile("s_waitcnt lgkmcnt(0)" ::: "memory");
}
__device__ __forceinline__ void naive_conv(const Args& a, int l, int t, int lane) {
    const bf16* P = (const bf16*)(a.ws + WS_PROJ); const bf16* Ch = P + 4 * PROJ_T; const bf16* Cb = P + 5 * PROJ_T; const bf16* Cc = P + 6 * PROJ_T;
    const int s = t & (SEQ - 1), c0 = lane * 8;
    float acc[8] = {0.f, 0.f, 0.f, 0.f, 0.f, 0.f, 0.f, 0.f};
#pragma unroll
    for (int j = 0; j < 3; ++j) { const int dt = 2 - j;
        if (s - dt >= 0) { const v4u hv = *(const v4u*)(Ch + (size_t)(t - dt) * MIXW + c0), cv = *(const v4u*)(Cc + (size_t)(t - dt) * MIXW + c0);
            const float* w = a.conv_w + ((size_t)l * 3 + j) * MIXW + c0; const f32x4 w0 = *(const f32x4*)w, w1 = *(const f32x4*)(w + 4);
            acc[0] += w0[0] * bflo(hv.x) * bflo(cv.x); acc[1] += w0[1] * bfhi(hv.x) * bfhi(cv.x); acc[2] += w0[2] * bflo(hv.y) * bflo(cv.y); acc[3] += w0[3] * bfhi(hv.y) * bfhi(cv.y);
            acc[4] += w1[0] * bflo(hv.z) * bflo(cv.z); acc[5] += w1[1] * bfhi(hv.z) * bfhi(cv.z); acc[6] += w1[2] * bflo(hv.w) * bflo(cv.w); acc[7] += w1[3] * bfhi(hv.w) * bfhi(cv.w); } }
    const v4u bv = *(const v4u*)(Cb + (size_t)t * MIXW + c0);
    v4u o; o.x = pk2(acc[0] * bflo(bv.x), acc[1] * bfhi(bv.x)); o.y = pk2(acc[2] * bflo(bv.y), acc[3] * bfhi(bv.y)); o.z = pk2(acc[4] * bflo(bv.z), acc[5] * bfhi(bv.z)); o.w = pk2(acc[6] * bflo(bv.w), acc[7] * bfhi(bv.w));
    *(v4u*)((bf16*)(a.ws + WS_Y) + (size_t)t * D + 1024 + c0) = o;
}
__device__ __forceinline__ void mixers_naive(const Args& a, int l, LAS unsigned char* lds, int gw, int NGW, int wave, int lane) {
    LAS float* sc = (LAS float*)(lds + wave * 8192);
    for (int i = gw; i < M * 4; i += NGW) { const int t = M * 4 - 1 - i; const int h = t & 3, tok = t >> 2; naive_attn<0>(a, l, tok >> 11, h, tok & (SEQ - 1), sc, lane); }
    for (int i = gw; i < M * 4; i += NGW) { const int h = i & 3, tok = i >> 2; naive_attn<1>(a, l, tok >> 11, h, tok & (SEQ - 1), sc, lane); }
    for (int i = gw; i < M * 4; i += NGW) naive_pool(a, l, i >> 2, i & 3, sc, lane);
    for (int i = gw; i < M; i += NGW) naive_conv(a, l, i, lane);
}

__device__ __forceinline__ float gelu_tanh(float x) { const float u = 1.5957691216057308f * (x + 0.044715f * x * x * x); return x / (1.0f + __expf(-u)); }
__device__ __forceinline__ void peer_token(const Args& a, int l, int t, bool last_layer, int lane) {
    unsigned char* ws = a.ws;
    const bf16* Q = (const bf16*)(ws + WS_Q) + (size_t)t * D;
    const float* keys = a.peer_keys + (size_t)l * 8 * 2 * 128 * 128;
    int idxv[2] = {0, 0}; float gatv[2] = {0.f, 0.f};
    const float NEG = -3.0e38f;
    for (int h = 0; h < 8; ++h) {
        float tops[2] = {0.f, 0.f}; int topi[2] = {0, 0};
#pragma unroll
        for (int p = 0; p < 2; ++p) {
            const bf16* qp = Q + h * 256 + p * 128; const float* kp = keys + ((size_t)(h * 2 + p) * 128) * 128;
            float s0 = 0.f, s1 = 0.f;
#pragma unroll 4
            for (int c8 = 0; c8 < 16; ++c8) { const v4u qv = *(const v4u*)(qp + c8 * 8);
                const float q[8] = {bflo(qv.x), bfhi(qv.x), bflo(qv.y), bfhi(qv.y), bflo(qv.z), bfhi(qv.z), bflo(qv.w), bfhi(qv.w)};
                const float* k0 = kp + (size_t)lane * 128 + c8 * 8; const float* k1 = k0 + 64 * 128;
                const f32x4 a0 = *(const f32x4*)k0, a1 = *(const f32x4*)(k0 + 4), b0 = *(const f32x4*)k1, b1 = *(const f32x4*)(k1 + 4);
                s0 += q[0] * a0[0] + q[1] * a0[1] + q[2] * a0[2] + q[3] * a0[3] + q[4] * a1[0] + q[5] * a1[1] + q[6] * a1[2] + q[7] * a1[3];
                s1 += q[0] * b0[0] + q[1] * b0[1] + q[2] * b0[2] + q[3] * b0[3] + q[4] * b1[0] + q[5] * b1[1] + q[6] * b1[2] + q[7] * b1[3]; }
            for (int it = 0; it < 16; ++it) { const float m = wave_max(fmaxf(s0, s1), lane); int k;
                const unsigned long long b0 = __ballot(s0 == m);
                if (b0) { const int o = __ffsll((long long)b0) - 1; k = o; if (lane == o) s0 = NEG; }
                else { const unsigned long long b1 = __ballot(s1 == m); const int o = __ffsll((long long)b1) - 1; k = o + 64; if (lane == o) s1 = NEG; }
                if (lane == it) { tops[p] = m; topi[p] = k; } }
        }
        float cs[4]; int ci[4];
        { const float sa = shf(tops[0], lane >> 2); const int ia = shi(topi[0], lane >> 2);
#pragma unroll
            for (int e = 0; e < 4; ++e) { const int j = 4 * (lane & 3) + e; cs[e] = sa + shf(tops[1], j); ci[e] = ia * 128 + shi(topi[1], j); } }
        float bs = NEG; int bi = 0;
        for (int it = 0; it < 16; ++it) { const float m = wave_max(fmaxf(fmaxf(cs[0], cs[1]), fmaxf(cs[2], cs[3])), lane);
            int sel = -1, o = 0;
#pragma unroll
            for (int e = 0; e < 4; ++e) { if (sel < 0) { const unsigned long long bb = __ballot(cs[e] == m); if (bb) { sel = e; o = __ffsll((long long)bb) - 1; } } }
            int idx = 0;
#pragma unroll
            for (int e = 0; e < 4; ++e) { if (sel == e) { idx = shi(ci[e], o); if (lane == o) cs[e] = NEG; } }
            if (lane == it) { bs = m; bi = idx; } }
        const float mx = shf(bs, 0); const float ex = lane < 16 ? __expf(bs - mx) : 0.f; const float sum = wave_sum(ex, lane); const float gt = ex / sum;
        const int vi = shi(bi, lane & 15); const float vg = shf(gt, lane & 15);
        if ((lane >> 4) == (h & 3)) { if (h < 4) { idxv[0] = vi; gatv[0] = vg; } else { idxv[1] = vi; gatv[1] = vg; } }
    }
    const unsigned long long* ssa1 = (const unsigned long long*)(ws + WS_SSA) + l * M;
    const float rs = rsqrtf(ssa_to_f(ssa1[t]) * (1.0f / D) + EPS);
    const bf16* HB = (const bf16*)(ws + WS_HB) + (size_t)t * D; const float* gn = a.norm_ffn + l * D;
    v4u xp[4];
#pragma unroll
    for (int i = 0; i < 4; ++i) { const int k0 = 8 * lane + 512 * i; const v4u hv = *(const v4u*)(HB + k0); const f32x4 g0 = *(const f32x4*)(gn + k0), g1 = *(const f32x4*)(gn + k0 + 4);
        xp[i].x = pk2(bflo(hv.x) * rs * g0[0], bfhi(hv.x) * rs * g0[1]); xp[i].y = pk2(bflo(hv.y) * rs * g0[2], bfhi(hv.y) * rs * g0[3]);
        xp[i].z = pk2(bflo(hv.z) * rs * g1[0], bfhi(hv.z) * rs * g1[1]); xp[i].w = pk2(bflo(hv.w) * rs * g1[2], bfhi(hv.w) * rs * g1[3]); }
    const bf16* PU = (const bf16*)(ws + WS_PU + l * PE_BYTES); const bf16* PV = (const bf16*)(ws + WS_PV + l * PE_BYTES);
    float actv[2] = {0.f, 0.f};
#pragma unroll
    for (int rr = 0; rr < 2; ++rr) {
        for (int ll = 0; ll < 64; ll += 4) {
            v4u r[4][4];
#pragma unroll
            for (int j = 0; j < 4; ++j) { const int e = __builtin_amdgcn_readlane(idxv[rr], ll + j); const bf16* row = PU + (size_t)e * D + 8 * lane;
#pragma unroll
                for (int i = 0; i < 4; ++i) r[j][i] = *(const v4u*)(row + 512 * i); }
#pragma unroll
            for (int j = 0; j < 4; ++j) { float d0 = 0.f, d1 = 0.f;
#pragma unroll
                for (int i = 0; i < 4; ++i) { d0 = dot2_bf16(r[j][i].x, xp[i].x, d0); d1 = dot2_bf16(r[j][i].y, xp[i].y, d1); d0 = dot2_bf16(r[j][i].z, xp[i].z, d0); d1 = dot2_bf16(r[j][i].w, xp[i].w, d1); }
                const float d = wave_sum(d0 + d1, lane); if (lane == ll + j) actv[rr] = d; }
        }
    }
    float coef[2] = {gelu_tanh(actv[0]) * gatv[0], gelu_tanh(actv[1]) * gatv[1]};
    float y[4][8];
#pragma unroll
    for (int i = 0; i < 4; ++i)
#pragma unroll
        for (int k = 0; k < 8; ++k) y[i][k] = 0.f;
#pragma unroll
    for (int rr = 0; rr < 2; ++rr) {
        for (int ll = 0; ll < 64; ll += 4) {
            v4u r[4][4]; float c[4];
#pragma unroll
            for (int j = 0; j < 4; ++j) { const int e = __builtin_amdgcn_readlane(idxv[rr], ll + j); c[j] = __builtin_bit_cast(float, __builtin_amdgcn_readlane(__builtin_bit_cast(int, coef[rr]), ll + j));
                const bf16* row = PV + (size_t)e * D + 8 * lane;
#pragma unroll
                for (int i = 0; i < 4; ++i) r[j][i] = *(const v4u*)(row + 512 * i); }
#pragma unroll
            for (int j = 0; j < 4; ++j)
#pragma unroll
                for (int i = 0; i < 4; ++i) { y[i][0] += c[j] * bflo(r[j][i].x); y[i][1] += c[j] * bfhi(r[j][i].x); y[i][2] += c[j] * bflo(r[j][i].y); y[i][3] += c[j] * bfhi(r[j][i].y);
                    y[i][4] += c[j] * bflo(r[j][i].z); y[i][5] += c[j] * bfhi(r[j][i].z); y[i][6] += c[j] * bflo(r[j][i].w); y[i][7] += c[j] * bfhi(r[j][i].w); }
        }
    }
    float* H = (float*)(ws + WS_H) + (size_t)t * D; bf16* HBw = (bf16*)(ws + WS_HB) + (size_t)t * D;
    float s = 0.f;
#pragma unroll
    for (int i = 0; i < 4; ++i) { const int k0 = 8 * lane + 512 * i; const f32x4 h0 = *(const f32x4*)(H + k0), h1 = *(const f32x4*)(H + k0 + 4);
#pragma unroll
        for (int k = 0; k < 4; ++k) { y[i][k] += h0[k]; y[i][4 + k] += h1[k]; }
#pragma unroll
        for (int k = 0; k < 8; ++k) s += y[i][k] * y[i][k]; }
    s = wave_sum(s, lane);
    if (!last_layer) {
        float* ssqn = (float*)(ws + WS_SSQ) + (l + 1) * M; if (lane == 0) ssqn[t] = s;
#pragma unroll
        for (int i = 0; i < 4; ++i) { const int k0 = 8 * lane + 512 * i; *(f32x4*)(H + k0) = (f32x4){y[i][0], y[i][1], y[i][2], y[i][3]}; *(f32x4*)(H + k0 + 4) = (f32x4){y[i][4], y[i][5], y[i][6], y[i][7]};
            v4u o; o.x = pk2(y[i][0], y[i][1]); o.y = pk2(y[i][2], y[i][3]); o.z = pk2(y[i][4], y[i][5]); o.w = pk2(y[i][6], y[i][7]); *(v4u*)(HBw + k0) = o; }
    } else {
        const float rf = rsqrtf(s * (1.0f / D) + EPS); float* O = a.out + (size_t)t * D;
#pragma unroll
        for (int i = 0; i < 4; ++i) { const int k0 = 8 * lane + 512 * i; const f32x4 g0 = *(const f32x4*)(a.norm_final + k0), g1 = *(const f32x4*)(a.norm_final + k0 + 4);
            *(f32x4*)(O + k0) = (f32x4){y[i][0] * rf * g0[0], y[i][1] * rf * g0[1], y[i][2] * rf * g0[2], y[i][3] * rf * g0[3]};
            *(f32x4*)(O + k0 + 4) = (f32x4){y[i][4] * rf * g1[0], y[i][5] * rf * g1[1], y[i][6] * rf * g1[2], y[i][7] * rf * g1[3]}; }
    }
}

#define LANE_ID(x) asm volatile("v_mbcnt_lo_u32_b32 %0, -1, 0\n\tv_mbcnt_hi_u32_b32 %0, -1, %0" : "=v"(x))
__global__ void __launch_bounds__(NT, 2) mk_fwd(ArgsK a_in) {
    extern __shared__ __attribute__((aligned(16))) unsigned char lds_raw[];
    LAS unsigned char* lds = (LAS unsigned char*)lds_raw;
    cg::grid_group grid = cg::this_grid();
    const int wave = __builtin_amdgcn_readfirstlane(threadIdx.x >> 6);
    const int G = gridDim.x, gw = blockIdx.x * NWAVES + wave, NGW = G * NWAVES;
    const CAS ArgsK* ka = (const CAS ArgsK*)__builtin_amdgcn_kernarg_segment_ptr();
    size_t zoff = 0; int lane;
#define PHASE_BEGIN() LANE_ID(lane); asm volatile("" : "+s"(zoff), "+s"(ka)); const Args a = load_args(ka, zoff); unsigned char* const ws = a.ws; (void)ws
    { PHASE_BEGIN(); p0_prologue(a, lds, gw, NGW, wave, lane); }
    grid.sync();
    for (int l = 0; l < DEPTH; ++l) {
        {
            PHASE_BEGIN();
            float* ssq_mix = (float*)(ws + WS_SSQ) + l * M;
            pg8::Gemm g{(const bf16*)(ws + WS_HB), (const bf16*)(ws + WS_WIN + l * WIN_BYTES), M, NPROJ, D}; pg8::StaticOrder S; S.init(M, NPROJ, G, (int)blockIdx.x);
            EpiProj E{(bf16*)(ws + WS_PROJ), (bf16*)(ws + WS_R), (const float*)(ws + WS_BINR) + l * NPROJ, ssq_mix};
            pg8::gemm_phase<EpiProj, pg8::StaticOrder, true>(lds, g, S, E, wave);
            forget_logits(a, l, gw, NGW, lane);
        }
        grid.sync();
        { PHASE_BEGIN(); mixers_fast(a, l, (LAS char*)lds, wave, lane, G, (int)blockIdx.x); }
        grid.sync();
        {
            PHASE_BEGIN();
            pg8::Gemm g{(const bf16*)(ws + WS_Y), (const bf16*)(ws + WS_WBR + l * SQ_BYTES), M, D, D}; pg8::StaticOrder S; S.init(M, D, G, (int)blockIdx.x);
            EpiMerge E{(const bf16*)(ws + WS_R), (bf16*)(ws + WS_MRG)};
            pg8::gemm_phase<EpiMerge, pg8::StaticOrder, false>(lds, g, S, E, wave);
        }
        grid.sync();
        {
            PHASE_BEGIN();
            pg8::Gemm g{(const bf16*)(ws + WS_MRG), (const bf16*)(ws + WS_WOUT + l * SQ_BYTES), M, D, D}; pg8::StaticOrder S; S.init(M, D, G, (int)blockIdx.x);
            EpiRes E{(float*)(ws + WS_H), (bf16*)(ws + WS_HB), (unsigned long long*)(ws + WS_SSA) + l * M};
            pg8::gemm_phase<EpiRes, pg8::StaticOrder, false>(lds, g, S, E, wave);
        }
        grid.sync();
        {
            PHASE_BEGIN();
            pg8::Gemm g{(const bf16*)(ws + WS_HB), (const bf16*)(ws + WS_WQ + l * SQ_BYTES), M, D, D}; pg8::StaticOrder S; S.init(M, D, G, (int)blockIdx.x);
            EpiQ E{(bf16*)(ws + WS_Q), (const unsigned long long*)(ws + WS_SSA) + l * M};
            pg8::gemm_phase<EpiQ, pg8::StaticOrder, false>(lds, g, S, E, wave);
        }
        grid.sync();
        { PHASE_BEGIN(); for (int t = gw; t < M; t += NGW) peer_token(a, l, t, l == DEPTH - 1, lane); }
        if (l + 1 < DEPTH) grid.sync();
    }
}

extern "C" void kernel_launch(void* const* d_in, const int* in_sizes, int n_in, void* d_out, int out_size, void* d_ws, size_t ws_size, hipStream_t stream) {
    static int grid = 0;
    if (grid == 0) {
        int dev = 0, cus = 0, per_cu = 0;
        if (n_in != 16 || out_size != M * D || ws_size < WS_END) { fprintf(stderr, "kernel_launch: unexpected shapes (n_in %d out %d ws %zu)\n", n_in, out_size, ws_size); grid = -1; return; }
        (void)hipGetDevice(&dev);
        (void)hipDeviceGetAttribute(&cus, hipDeviceAttributeMultiprocessorCount, dev);
        (void)hipFuncSetAttribute((const void*)mk_fwd, hipFuncAttributeMaxDynamicSharedMemorySize, LDS_BYTES);
        (void)hipOccupancyMaxActiveBlocksPerMultiprocessor(&per_cu, (const void*)mk_fwd, NT, LDS_BYTES);
        if (per_cu < 1) { fprintf(stderr, "kernel_launch: occupancy query says %d blocks per CU\n", per_cu); }
        grid = cus;
        if (grid > 256) grid = 256;
    }
    if (grid < 0) return;
    (void)hipMemsetAsync((char*)d_ws + WS_CTL, 0, CTL_ZERO_BYTES, stream);
    ArgsK a{};
    const GAS float** p = (const GAS float**)&a;
    for (int i = 0; i < 16; ++i) p[i] = (const GAS float*)d_in[i];
    a.out = (GAS float*)d_out; a.ws = (GAS unsigned char*)d_ws;
    void* args[] = {&a};
    hipError_t e = hipLaunchCooperativeKernel((const void*)mk_fwd, dim3(grid), dim3(NT), args, LDS_BYTES, stream);
    if (e != hipSuccess) fprintf(stderr, "cooperative launch failed: %s (grid %d)\n", hipGetErrorString(e), grid);
}
```

```cpp
#include <hip/hip_runtime.h>
#include <hip/hip_cooperative_groups.h>
#include <cstdio>
#include <cstdint>
namespace cg = cooperative_groups;
namespace pg8 {
#define PG8_LAS __attribute__((address_space(3)))
typedef unsigned short bf16_t;
typedef short bf16x8 __attribute__((ext_vector_type(8)));
typedef float f32x4 __attribute__((ext_vector_type(4)));
typedef unsigned u32x4 __attribute__((ext_vector_type(4)));
typedef unsigned u32x2 __attribute__((ext_vector_type(2)));
constexpr int BM = 256, BK = 64, HALF = 128, HTB = HALF * BK * 2  , STAGE_BYTES = 8 * HTB, NXCD = 8, WGM = 8;

__host__ __device__ __forceinline__ int lds_byte(int r, int c) { const int st = (r >> 4) * 2 + (c >> 5), rr = r & 15, cc = c & 31, ob = rr * 64 + cc * 2; return st * 1024 + (ob ^ (((ob >> 9) & 1) << 5)); }
__host__ __device__ __forceinline__ void stage_rc(int b, int& R, int& C) { const int st = b / 1024, sb = b % 1024, swz = sb ^ (((sb >> 9) & 1) << 5); R = (st >> 1) * 16 + swz / 64; C = (st & 1) * 32 + (swz % 64) / 2; }
__host__ __device__ __forceinline__ int perm32(int rho) { const int n = rho >> 4, i = rho & 15; return 8 * (i >> 2) + 4 * n + (i & 3); }

struct Unit { int pm, pn; };
struct Gemm { const bf16_t* A; const bf16_t* Bt; int M, N, K; };

struct StaticOrder {
    int nM, nN, nwg, G, c;
    __host__ __device__ void init(int M, int N, int G_, int c_) { nM = M / BM; nN = N / BM; nwg = nM * nN; G = G_; c = c_; }
    __host__ __device__ bool next(int i, Unit& u) const {
        const long L = (long)i * G + c; if (L >= nwg) return false;
        int wgid = (int)L; { const int q = nwg / NXCD, r = nwg % NXCD, xcd = wgid % NXCD, off = wgid / NXCD; wgid = (xcd < r ? xcd * (q + 1) : r * (q + 1) + (xcd - r) * q) + off; }
        const int nig = WGM * nN, gid = wgid / nig, fm = gid * WGM, gsz = (nM - fm) < WGM ? (nM - fm) : WGM;
        u.pm = fm + ((wgid % nig) % gsz); u.pn = (wgid % nig) / gsz; return true;
    }
};

__device__ __forceinline__ unsigned cvt_pk_bf16(float lo, float hi) { unsigned r; asm volatile("v_cvt_pk_bf16_f32 %0, %1, %2" : "=v"(r) : "v"(lo), "v"(hi)); return r; }

template <class Epi, class Sched, bool ALIGN_EPI = false>
__device__ __forceinline__ void gemm_phase(PG8_LAS unsigned char* lds, const Gemm g, const Sched& S, const Epi& E, int wid) {
    int lane_; asm volatile("v_mbcnt_lo_u32_b32 %0, -1, 0\n\tv_mbcnt_hi_u32_b32 %0, -1, %0" : "=v"(lane_));
    const int lane = lane_, tid = wid * 64 + lane, wr = wid >> 2, wc = wid & 3, fr = lane & 15, fq = lane >> 4;
    const int K = g.K, nt = K / BK;
    unsigned voffA[2], voffB[2];
#pragma unroll
    for (int i = 0; i < 2; ++i) { int R, C; stage_rc(tid * 16 + i * 8192, R, C); const int Rb = Epi::PERM ? ((R & ~31) + perm32(R & 31)) : R;
        voffA[i] = (unsigned)(R * K + C) * 2u; voffB[i] = (unsigned)(Rb * K + C) * 2u; }
    const size_t kstep = (size_t)(BK * 2);
    const size_t hstep = (size_t)HALF * K * 2;
    const size_t tstep = 2 * hstep;
    const unsigned ldsw = (unsigned)wid * 1024u;
    const int aoff = lds_byte(wr * 64 + fr, fq * 8), boff = lds_byte(wc * 32 + fr, fq * 8);
#define PG8_SA(b, h) (((b) * 2 + (h)) * HTB)
#define PG8_SB(b, h) ((4 + (b) * 2 + (h)) * HTB)
#define PG8_STAGE(bufoff, gbase, voff) do { _Pragma("unroll") for (int _i = 0; _i < 2; ++_i) \
        __builtin_amdgcn_global_load_lds((const unsigned*)((const char*)(gbase) + (voff)[_i]), (PG8_LAS unsigned*)(lds + (bufoff) + ldsw + _i * 8192), 16, 0, 0); } while (0)
#define PG8_LDA(dst, b, h) do { _Pragma("unroll") for (int m = 0; m < 4; ++m) _Pragma("unroll") for (int k = 0; k < 2; ++k) dst[m][k] = *(const PG8_LAS bf16x8*)(lds + PG8_SA(b, h) + aoff + m * 2048 + k * 1024); } while (0)
#define PG8_LDB(dst, b, h) do { _Pragma("unroll") for (int n = 0; n < 2; ++n) _Pragma("unroll") for (int k = 0; k < 2; ++k) dst[n][k] = *(const PG8_LAS bf16x8*)(lds + PG8_SB(b, h) + boff + n * 2048 + k * 1024); } while (0)
#define PG8_MMA(ai, bj, At, Bt) do { __builtin_amdgcn_s_setprio(1); _Pragma("unroll") for (int m = 0; m < 4; ++m) _Pragma("unroll") for (int n = 0; n < 2; ++n) _Pragma("unroll") for (int k = 0; k < 2; ++k) \
        acc[ai][bj][m][n] = __builtin_amdgcn_mfma_f32_16x16x32_bf16(Bt[n][k], At[m][k], acc[ai][bj][m][n], 0, 0, 0); __builtin_amdgcn_s_setprio(0); } while (0)
#define PG8_WAIT_V(n) asm volatile("s_waitcnt vmcnt(" #n ")" ::: "memory")
#define PG8_WAIT_L(n) asm volatile("s_waitcnt lgkmcnt(" #n ")" ::: "memory")
#define PG8_BAR __builtin_amdgcn_s_barrier()
#define PG8_SCHED __builtin_amdgcn_sched_barrier(0)
    Unit cur, nxt; int ui = 0;
    if (!S.next(0, cur)) return;
    f32x4 acc[2][2][4][2];
#pragma unroll
    for (int a = 0; a < 2; ++a)
#pragma unroll
        for (int b = 0; b < 2; ++b)
#pragma unroll
            for (int m = 0; m < 4; ++m)
#pragma unroll
                for (int n = 0; n < 2; ++n) acc[a][b][m][n] = (f32x4){0.f, 0.f, 0.f, 0.f};
    bf16x8 At[4][2], B0[2][2], B1[2][2];
    const char* cA = (const char*)g.A + (size_t)cur.pm * tstep; const char* cB = (const char*)g.Bt + (size_t)cur.pn * tstep;
    PG8_STAGE(PG8_SB(0, 0), cB, voffB); PG8_STAGE(PG8_SB(0, 1), cB + hstep, voffB); PG8_STAGE(PG8_SA(0, 0), cA, voffA); PG8_STAGE(PG8_SA(0, 1), cA + hstep, voffA);
    if (wr == 1) PG8_BAR;
    PG8_WAIT_V(2); PG8_BAR;
    PG8_STAGE(PG8_SB(1, 0), cB + kstep, voffB); PG8_STAGE(PG8_SA(1, 0), cA + kstep, voffA); PG8_STAGE(PG8_SB(1, 1), cB + hstep + kstep, voffB);
    PG8_WAIT_V(6); PG8_BAR;
    for (;;) {
        const bool has_next = S.next(ui + 1, nxt);
        const char* nA = has_next ? (const char*)g.A + (size_t)nxt.pm * tstep : cA; const char* nB = has_next ? (const char*)g.Bt + (size_t)nxt.pn * tstep : cB;
        const int seglen = Epi::HOOK ? 8 : nt;
        for (int t0 = 0; t0 < nt; t0 += seglen) {
        if constexpr (Epi::HOOK) { if (t0 > 0) E.hook(acc, cur, t0 >> 3, wr, wc, fr, fq); }
        for (int t = t0; t < t0 + seglen; t += 2) {
            const bool last = (t == nt - 2);
            const char* a1 = cA + (size_t)(t + 1) * kstep;
            const char* a2 = last ? nA : cA + (size_t)(t + 2) * kstep; const char* b2 = last ? nB : cB + (size_t)(t + 2) * kstep;
            const char* a3 = a2 + kstep; const char* b3 = b2 + kstep;
            PG8_LDB(B0, 0, 0); PG8_LDB(B1, 0, 1); PG8_SCHED; PG8_LDA(At, 0, 0); PG8_STAGE(PG8_SA(1, 1), a1 + hstep, voffA);
            PG8_WAIT_V(8); PG8_WAIT_L(0); PG8_BAR; PG8_MMA(0, 0, At, B0); PG8_MMA(0, 1, At, B1); PG8_BAR; PG8_SCHED;
            PG8_LDA(At, 0, 1); PG8_STAGE(PG8_SB(0, 0), b2, voffB); PG8_STAGE(PG8_SB(0, 1), b2 + hstep, voffB); PG8_STAGE(PG8_SA(0, 0), a2, voffA);
            PG8_WAIT_V(8); PG8_WAIT_L(0); PG8_BAR; PG8_MMA(1, 0, At, B0); PG8_MMA(1, 1, At, B1); PG8_BAR; PG8_SCHED;
            PG8_LDB(B0, 1, 0); PG8_LDB(B1, 1, 1); PG8_SCHED; PG8_LDA(At, 1, 0); PG8_STAGE(PG8_SA(0, 1), a2 + hstep, voffA);
            PG8_WAIT_V(8); PG8_WAIT_L(0); PG8_BAR; PG8_MMA(0, 0, At, B0); PG8_MMA(0, 1, At, B1); PG8_BAR; PG8_SCHED;
            PG8_LDA(At, 1, 1); PG8_STAGE(PG8_SB(1, 0), b3, voffB); PG8_STAGE(PG8_SB(1, 1), b3 + hstep, voffB); PG8_STAGE(PG8_SA(1, 0), a3, voffA);
            PG8_WAIT_V(8); PG8_WAIT_L(0); PG8_BAR; PG8_MMA(1, 0, At, B0); PG8_MMA(1, 1, At, B1); PG8_BAR; PG8_SCHED;
        }
        }
        if constexpr (ALIGN_EPI) { if (wr == 0) PG8_BAR; }
        E(acc, cur, wr, wc, fr, fq);
        if (!has_next) break;
#pragma unroll
        for (int a = 0; a < 2; ++a)
#pragma unroll
            for (int b = 0; b < 2; ++b)
#pragma unroll
                for (int m = 0; m < 4; ++m)
#pragma unroll
                    for (int n = 0; n < 2; ++n) acc[a][b][m][n] = (f32x4){0.f, 0.f, 0.f, 0.f};
        cur = nxt; cA = nA; cB = nB; ++ui;
        if constexpr (ALIGN_EPI) { if (wr == 1) PG8_BAR; }
    }
    PG8_WAIT_V(0);
    if constexpr (!ALIGN_EPI) { if (wr == 0) PG8_BAR; }
    PG8_BAR;
#undef PG8_SA
#undef PG8_SB
#undef PG8_STAGE
#undef PG8_LDA
#undef PG8_LDB
#undef PG8_MMA
#undef PG8_WAIT_V
#undef PG8_WAIT_L
#undef PG8_BAR
#undef PG8_SCHED
}
}
constexpr int NWAVES = 8, NT = NWAVES * 64;
constexpr int M = 8192, D = 2048, SEQ = 2048, NBATCH = 4, DEPTH = 2;
constexpr int INW = 13316, NPROJ = 13312, MIXW = 512, HD = 128;
constexpr int PEER_E = 16384;
constexpr float EPS = 1e-6f;
constexpr float ATT_SCALE = 0.08838834764831845f;

constexpr size_t MiB = 1u << 20;
constexpr size_t WS_CTL = 0, CTL_ZERO_BYTES = 1 * MiB;
constexpr size_t WS_SSQ = 0;
constexpr size_t WS_SSA = 256 * 1024;
constexpr size_t WS_WF = 1 * MiB;
constexpr size_t WS_BINR = WS_WF + 64 * 1024;
constexpr size_t WS_LOGF = 2 * MiB;
constexpr size_t WS_CUM = 3 * MiB;
constexpr size_t WS_WIN = 8 * MiB;
constexpr size_t WIN_BYTES = (size_t)NPROJ * D * 2;
constexpr size_t WS_WBR = 112 * MiB, WS_WOUT = 128 * MiB, WS_WQ = 144 * MiB;
constexpr size_t SQ_BYTES = (size_t)D * D * 2;
constexpr size_t WS_PU = 160 * MiB, WS_PV = 288 * MiB;
constexpr size_t PE_BYTES = (size_t)PEER_E * D;
constexpr size_t WS_SU = 5 * MiB, WS_SV = 5 * MiB + 256 * 1024;
constexpr size_t WS_H = 416 * MiB;
constexpr size_t WS_HB = 480 * MiB;
constexpr size_t WS_PROJ = 512 * MiB;
constexpr size_t PROJ_T = (size_t)M * MIXW;
constexpr size_t WS_R = 592 * MiB;
constexpr size_t R_PLANE = (size_t)M * D;
constexpr size_t WS_Y = 720 * MiB;
constexpr size_t WS_MRG = 752 * MiB;
constexpr size_t WS_Q = 784 * MiB;
constexpr size_t WS_END = 816 * MiB;

constexpr int RING_BYTES = 131072;
constexpr int LDS_BYTES = 147456;

typedef unsigned short bf16;
typedef unsigned v4u __attribute__((ext_vector_type(4)));
typedef unsigned v2u __attribute__((ext_vector_type(2)));
typedef float f32x4 __attribute__((ext_vector_type(4)));
typedef float f32x2 __attribute__((ext_vector_type(2)));
using bf16x2 = __attribute__((ext_vector_type(2))) __bf16;
#define LAS __attribute__((address_space(3)))

__device__ __forceinline__ unsigned f2bf(float f) { unsigned u = __builtin_bit_cast(unsigned, f); return (u + 0x7fffu + ((u >> 16) & 1u)) >> 16; }
__device__ __forceinline__ unsigned pk2(float lo, float hi) { return f2bf(lo) | (f2bf(hi) << 16); }
__device__ __forceinline__ float bflo(unsigned w) { return __builtin_bit_cast(float, w << 16); }
__device__ __forceinline__ float bfhi(unsigned w) { return __builtin_bit_cast(float, w & 0xffff0000u); }
__device__ __forceinline__ float bf2f(bf16 b) { return __builtin_bit_cast(float, ((unsigned)b) << 16); }
__device__ __forceinline__ float shf(float v, int src) { return __builtin_bit_cast(float, __builtin_amdgcn_ds_bpermute(src << 2, __builtin_bit_cast(int, v))); }
__device__ __forceinline__ int shi(int v, int src) { return __builtin_amdgcn_ds_bpermute(src << 2, v); }
__device__ __forceinline__ float wave_sum(float v, int lane) {
#pragma unroll
    for (int o = 1; o < 64; o <<= 1) v += shf(v, lane ^ o);
    return v;
}
__device__ __forceinline__ float wave_max(float v, int lane) {
#pragma unroll
    for (int o = 1; o < 64; o <<= 1) v = fmaxf(v, shf(v, lane ^ o));
    return v;
}
__device__ __forceinline__ float ssa_to_f(unsigned long long v) { return (float)((double)v * (1.0 / 4294967296.0)); }
__device__ __forceinline__ float dot2_bf16(unsigned w, unsigned x, float acc) { return __builtin_amdgcn_fdot2_f32_bf16(__builtin_bit_cast(bf16x2, w), __builtin_bit_cast(bf16x2, x), acc, false); }

struct Args {
    const float *x, *norm_mix, *w_in, *b_in, *pool_w, *pool_scale, *conv_w, *rel_bias, *w_branch, *w_out, *norm_ffn, *peer_wq, *peer_keys, *peer_u, *peer_v, *norm_final;
    float* out; unsigned char* ws;
};
#define GAS __attribute__((address_space(1)))
#define CAS __attribute__((address_space(4)))
struct ArgsK {
    const GAS float *x, *norm_mix, *w_in, *b_in, *pool_w, *pool_scale, *conv_w, *rel_bias, *w_branch, *w_out, *norm_ffn, *peer_wq, *peer_keys, *peer_u, *peer_v, *norm_final;
    GAS float* out; GAS unsigned char* ws;
};
__device__ __forceinline__ Args load_args(const CAS ArgsK* k, size_t zoff) {
    Args a;
    a.x = (const float*)k->x; a.norm_mix = (const float*)k->norm_mix; a.w_in = (const float*)k->w_in; a.b_in = (const float*)k->b_in; a.pool_w = (const float*)k->pool_w;
    a.pool_scale = (const float*)k->pool_scale; a.conv_w = (const float*)k->conv_w; a.rel_bias = (const float*)k->rel_bias; a.w_branch = (const float*)k->w_branch;
    a.w_out = (const float*)k->w_out; a.norm_ffn = (const float*)k->norm_ffn; a.peer_wq = (const float*)k->peer_wq; a.peer_keys = (const float*)k->peer_keys;
    a.peer_u = (const float*)k->peer_u; a.peer_v = (const float*)k->peer_v; a.norm_final = (const float*)k->norm_final; a.out = (float*)k->out; a.ws = (unsigned char*)(k->ws + zoff);
    return a;
}

using pg8::f32x4; using pg8::Unit;
struct EpiProj {
    static constexpr bool PERM = true, HOOK = false;
    bf16* P; bf16* R; const float* bias; const float* ssq;
    __device__ __forceinline__ void operator()(f32x4 (&acc)[2][2][4][2], const Unit& u, int wr, int wc, int fr, int fq) const {
        const int row0 = u.pm * 256 + wr * 64 + fr, cl0 = wc * 32 + 8 * fq, bcol0 = u.pn * 256 + cl0;
        f32x4 bv[2][2];
#pragma unroll
        for (int bj = 0; bj < 2; ++bj)
#pragma unroll
            for (int n = 0; n < 2; ++n) bv[bj][n] = *(const f32x4*)(bias + bcol0 + bj * 128 + 4 * n);
        if (u.pn < 20) {
            bf16* base = P + (size_t)(u.pn >> 1) * PROJ_T + (u.pn & 1) * 256 + cl0;
#pragma unroll
            for (int ai = 0; ai < 2; ++ai)
#pragma unroll
                for (int m = 0; m < 4; ++m) { const int row = row0 + ai * 128 + m * 16; const float rs = rsqrtf(ssq[row] * (1.0f / D) + EPS);
                    bf16* rowp = base + (size_t)row * MIXW;
#pragma unroll
                    for (int bj = 0; bj < 2; ++bj) { const f32x4 v0 = acc[ai][bj][m][0] * rs + bv[bj][0], v1 = acc[ai][bj][m][1] * rs + bv[bj][1];
                        pg8::u32x4 w; w.x = pg8::cvt_pk_bf16(v0[0], v0[1]); w.y = pg8::cvt_pk_bf16(v0[2], v0[3]); w.z = pg8::cvt_pk_bf16(v1[0], v1[1]); w.w = pg8::cvt_pk_bf16(v1[2], v1[3]);
                        *(pg8::u32x4*)(rowp + bj * 128) = w; } }
        } else {
            const int d0 = 64 * (u.pn - 20) + 16 * wc + 4 * fq;
#pragma unroll
            for (int ai = 0; ai < 2; ++ai)
#pragma unroll
                for (int m = 0; m < 4; ++m) { const int row = row0 + ai * 128 + m * 16; const float rs = rsqrtf(ssq[row] * (1.0f / D) + EPS);
                    float r[4][4];
#pragma unroll
                    for (int j = 0; j < 4; ++j) { float e[4], ie[4];
#pragma unroll
                        for (int g = 0; g < 4; ++g) { const float z = acc[ai][g >> 1][m][g & 1][j] * rs + bv[g >> 1][g & 1][j];
                            e[g] = fminf(1.0f + __builtin_amdgcn_exp2f(-1.4426950408889634f * z), 1e18f); ie[g] = __builtin_amdgcn_rcpf(e[g]); }
                        r[0][j] = e[1] * ie[0]; r[1][j] = e[2] * ie[1]; r[2][j] = e[3] * ie[2]; r[3][j] = ie[3]; }
#pragma unroll
                    for (int g = 0; g < 4; ++g) { pg8::u32x2 w; w.x = pg8::cvt_pk_bf16(r[g][0], r[g][1]); w.y = pg8::cvt_pk_bf16(r[g][2], r[g][3]);
                        *(pg8::u32x2*)(R + (size_t)g * R_PLANE + (size_t)row * D + d0) = w; } }
        }
    }
};
struct EpiMerge {
    static constexpr bool PERM = true, HOOK = true;
    const bf16* R; bf16* O;
    template <int NB  >
    __device__ __forceinline__ void scale(f32x4 (&acc)[2][2][4][2], const Unit& u, int plane, int wr, int wc, int fr, int fq) const {
        const __amdgpu_buffer_rsrc_t rs = __builtin_amdgcn_make_buffer_rsrc((void*)(R + (size_t)plane * R_PLANE), 0, 0x7fffffff, 0x00020000);
        int voff = (fr * D + 8 * fq) * 2; asm volatile("" : "+v"(voff));
        const int sbase = ((u.pm * 256 + wr * 64) * D + u.pn * 256 + wc * 32) * 2;
#pragma unroll
        for (int b0 = 0; b0 < 8; b0 += NB) {
            pg8::u32x4 w[NB][2];
#pragma unroll
            for (int i = 0; i < NB; ++i)
#pragma unroll
                for (int bj = 0; bj < 2; ++bj) { const int ai = (b0 + i) >> 2, m = (b0 + i) & 3;
                    w[i][bj] = __builtin_amdgcn_raw_buffer_load_b128(rs, voff + bj * 256, sbase + (ai * 128 + m * 16) * D * 2, 0); }
#pragma unroll
            for (int i = 0; i < NB; ++i)
#pragma unroll
                for (int bj = 0; bj < 2; ++bj) { const int ai = (b0 + i) >> 2, m = (b0 + i) & 3; const pg8::u32x4 v = w[i][bj];
                    acc[ai][bj][m][0] *= (f32x4){bflo(v.x), bfhi(v.x), bflo(v.y), bfhi(v.y)};
                    acc[ai][bj][m][1] *= (f32x4){bflo(v.z), bfhi(v.z), bflo(v.w), bfhi(v.w)};
                    asm volatile("" : "+v"(acc[ai][bj][m][0]), "+v"(acc[ai][bj][m][1])); }
            asm volatile("" ::: "memory"); }
    }
    __device__ __forceinline__ void hook(f32x4 (&acc)[2][2][4][2], const Unit& u, int g, int wr, int wc, int fr, int fq) const { scale<4>(acc, u, g - 1, wr, wc, fr, fq); }
    __device__ __forceinline__ void operator()(f32x4 (&acc)[2][2][4][2], const Unit& u, int wr, int wc, int fr, int fq) const {
        scale<4>(acc, u, 3, wr, wc, fr, fq);
        const int row0 = u.pm * 256 + wr * 64 + fr, col0 = u.pn * 256 + wc * 32 + 8 * fq;
#pragma unroll
        for (int ai = 0; ai < 2; ++ai)
#pragma unroll
            for (int m = 0; m < 4; ++m) { bf16* rowp = O + (size_t)(row0 + ai * 128 + m * 16) * D + col0;
#pragma unroll
                for (int bj = 0; bj < 2; ++bj) { const f32x4 v0 = acc[ai][bj][m][0], v1 = acc[ai][bj][m][1];
                    pg8::u32x4 w; w.x = pg8::cvt_pk_bf16(v0[0], v0[1]); w.y = pg8::cvt_pk_bf16(v0[2], v0[3]); w.z = pg8::cvt_pk_bf16(v1[0], v1[1]); w.w = pg8::cvt_pk_bf16(v1[2], v1[3]);
                    *(pg8::u32x4*)(rowp + bj * 128) = w; } }
    }
};
struct EpiRes {
    static constexpr bool PERM = false, HOOK = false;
    float* H; bf16* HB; unsigned long long* ssa;
    __device__ __forceinline__ void operator()(f32x4 (&acc)[2][2][4][2], const Unit& u, int wr, int wc, int fr, int fq) const {
        const int row0 = u.pm * 256 + wr * 64 + fr, col0 = u.pn * 256 + wc * 32 + 4 * fq;
#pragma unroll
        for (int ai = 0; ai < 2; ++ai)
#pragma unroll
            for (int m = 0; m < 4; ++m) { const int row = row0 + ai * 128 + m * 16; const size_t off = (size_t)row * D + col0; float s = 0.f;
#pragma unroll
                for (int bj = 0; bj < 2; ++bj)
#pragma unroll
                    for (int n = 0; n < 2; ++n) { const size_t o = off + bj * 128 + n * 16; const f32x4 h = *(const f32x4*)(H + o) + acc[ai][bj][m][n];
                        *(f32x4*)(H + o) = h; pg8::u32x2 w; w.x = pg8::cvt_pk_bf16(h[0], h[1]); w.y = pg8::cvt_pk_bf16(h[2], h[3]); *(pg8::u32x2*)(HB + o) = w;
                        s += (h[0] * h[0] + h[1] * h[1]) + (h[2] * h[2] + h[3] * h[3]); }
                { const int ln = fq * 16 + fr; s += shf(s, ln ^ 16); s += shf(s, ln ^ 32); }
                if (fq == 0) atomicAdd(ssa + row, (unsigned long long)((double)s * 4294967296.0)); }
    }
};
struct EpiQ {
    static constexpr bool PERM = true, HOOK = false;
    bf16* O; const unsigned long long* ssa;
    __device__ __forceinline__ void operator()(f32x4 (&acc)[2][2][4][2], const Unit& u, int wr, int wc, int fr, int fq) const {
        const int row0 = u.pm * 256 + wr * 64 + fr, col0 = u.pn * 256 + wc * 32 + 8 * fq;
#pragma unroll
        for (int ai = 0; ai < 2; ++ai)
#pragma unroll
            for (int m = 0; m < 4; ++m) { const int row = row0 + ai * 128 + m * 16; const float rs = rsqrtf(ssa_to_f(ssa[row]) * (1.0f / D) + EPS);
                bf16* rowp = O + (size_t)row * D + col0;
#pragma unroll
                for (int bj = 0; bj < 2; ++bj) { const f32x4 v0 = acc[ai][bj][m][0] * rs, v1 = acc[ai][bj][m][1] * rs;
                    pg8::u32x4 w; w.x = pg8::cvt_pk_bf16(v0[0], v0[1]); w.y = pg8::cvt_pk_bf16(v0[2], v0[3]); w.z = pg8::cvt_pk_bf16(v1[0], v1[1]); w.w = pg8::cvt_pk_bf16(v1[2], v1[3]);
                    *(pg8::u32x4*)(rowp + bj * 128) = w; } }
    }
};

__device__ __forceinline__ int colmap_in(int j) {
    if (j < 1536) return j;
    if (j < 5120) return j + 4;
    const int c = (j - 5120) & 255, T = (j - 5120) >> 8;
    const int g = 2 * (c >> 7) + ((c >> 2) & 1), d = 64 * T + 16 * ((c >> 5) & 3) + 4 * ((c >> 3) & 3) + (c & 3);
    return 5124 + g * 2048 + d;
}
template <bool MAP>
__device__ __forceinline__ void tr_item(const float* W, int ldw, const float* scale, bf16* WT, int ldt, int dcol0, LAS float* scr, int k0, int n0, int lane) {
    const int nn = lane & 31, sc = MAP ? colmap_in(n0 + nn) : (n0 + nn);
#pragma unroll 8
    for (int i = 0; i < 32; ++i) { const int kk = 2 * i + (lane >> 5); float v = W[(size_t)(k0 + kk) * ldw + sc]; if (scale) v *= scale[k0 + kk]; scr[kk * 33 + nn] = v; }
    asm volatile("s_waitcnt lgkmcnt(0)" ::: "memory");
    const int c = lane & 7;
#pragma unroll
    for (int j = 0; j < 4; ++j) { const int n = (lane >> 3) + 8 * j; const LAS float* s = scr + (8 * c) * 33 + n;
        v4u o; o.x = pk2(s[0 * 33], s[1 * 33]); o.y = pk2(s[2 * 33], s[3 * 33]); o.z = pk2(s[4 * 33], s[5 * 33]); o.w = pk2(s[6 * 33], s[7 * 33]);
        *(v4u*)(WT + (size_t)(n0 + n) * ldt + dcol0 + k0 + 8 * c) = o; }
    asm volatile("s_waitcnt lgkmcnt(0)" ::: "memory");
}
constexpr size_t WS_BAR = 512 * 1024;
#define XB_TMO      128
#define XB_XCNT(j)  (256  + 64 * (j))
#define XB_XSUB(j)  (1280 + 64 * (j))
#define XB_XGEN(j)  (2304 + 64 * (j))
#define XB_TOP      3328
#define XB_TOPGEN   3392
#define XCD_BAR_WORDS 3456
#define XB_SPIN_CAP (1u << 23)
__device__ __forceinline__ unsigned xb_ld(unsigned* p)              { return __hip_atomic_load(p, __ATOMIC_RELAXED, __HIP_MEMORY_SCOPE_AGENT); }
__device__ __forceinline__ unsigned xb_add(unsigned* p, unsigned v) { return __hip_atomic_fetch_add(p, v, __ATOMIC_RELAXED, __HIP_MEMORY_SCOPE_AGENT); }
__device__ __forceinline__ unsigned xb_xcc_id() { return (unsigned)__builtin_amdgcn_s_getreg((3 << 11) | 20) & 0xFu; }
#define XB_SPIN(cond, bar) do { unsigned _sp = 0; while (cond) { __builtin_amdgcn_s_sleep(1); \
    if ((++_sp & 255u) == 0u) { if (xb_ld(&(bar)[XB_TMO])) break; if (_sp > XB_SPIN_CAP) { atomicAdd(&(bar)[XB_TMO], 1u); break; } } } } while (0)
__device__ __forceinline__ void xcd_barrier_complete(unsigned* bar, unsigned x, unsigned G, unsigned& nloc, unsigned& nx) {
    unsigned sum, cnt, mine, sp = 0u;
    for (;;) {
        sum = 0u; cnt = 0u; mine = 0u;
#pragma unroll
        for (unsigned j = 0; j < 16; ++j) { const unsigned c = xb_ld(&bar[XB_XCNT(j)]); sum += c; cnt += (c > 0u) ? 1u : 0u; mine = (j == x) ? c : mine; }
        if (sum == G) break;
        __builtin_amdgcn_s_sleep(1);
        if ((++sp & 255u) == 0u) { if (xb_ld(&bar[XB_TMO])) break; if (sp > XB_SPIN_CAP) { atomicAdd(&bar[XB_TMO], 1u); break; } }
    }
    nloc = mine > 0u ? mine : 1u; nx = cnt > 0u ? cnt : 1u;
}
__device__ __forceinline__ void xcd_barrier(unsigned* bar, unsigned x, unsigned G, volatile LAS unsigned* st, int wave) {
    asm volatile("s_waitcnt vmcnt(0)" ::: "memory");
    __syncthreads();
    int lane; asm volatile("v_mbcnt_lo_u32_b32 %0, -1, 0\n\tv_mbcnt_hi_u32_b32 %0, -1, %0" : "=v"(lane));
    if (wave == 0 && lane == 0) {
        __builtin_amdgcn_s_waitcnt(0);
        unsigned nloc = st[0], nx = st[1];
        if (nloc == 0u) { xcd_barrier_complete(bar, x, G, nloc, nx); st[0] = nloc; st[1] = nx; }
        const unsigned old = xb_add(&bar[XB_XSUB(x)], 1u);
        const unsigned gen = old / nloc;
        if (old + 1u == (gen + 1u) * nloc) {
            __builtin_amdgcn_fence(__ATOMIC_RELEASE, "agent");
            asm volatile("s_waitcnt vmcnt(0)" ::: "memory");
            const unsigned og = xb_add(&bar[XB_TOP], 1u);
            const unsigned tg = og / nx;
            if (og + 1u == (tg + 1u) * nx) xb_add(&bar[XB_TOPGEN], 1u);
            else XB_SPIN(xb_ld(&bar[XB_TOPGEN]) == tg, bar);
            __builtin_amdgcn_fence(__ATOMIC_ACQUIRE, "agent");
            xb_add(&bar[XB_XGEN(x)], 1u);
            asm volatile("s_waitcnt vmcnt(0)" ::: "memory");
        } else {
            XB_SPIN(xb_ld(&bar[XB_XGEN(x)]) == gen, bar);
            __builtin_amdgcn_fence(__ATOMIC_ACQUIRE, "agent");
            asm volatile("s_waitcnt vmcnt(0)" ::: "memory");
        }
    }
    __syncthreads();
}
namespace att {
constexpr int D = 128, NW = 8, QBLK = 32, KVBLK = 64, QB = NW * QBLK;
constexpr int PITCH = 512, OPITCH = 2048;
constexpr float SCALE = 0.08838834764831845f, THR = 8.f;
constexpr int SHM_V = KVBLK * D * 2, SHM_K = KVBLK * D * 2;
constexpr int OFF_WS = 2 * SHM_V + 2 * SHM_K, OFF_CUM = OFF_WS + NW * 64 * 4, OFF_REL = OFF_CUM + 2048 * 4, LDS_END = OFF_REL + 320 * 4;
typedef unsigned short bf16;
typedef short bf16x8 __attribute__((ext_vector_type(8)));
typedef short s16x4 __attribute__((ext_vector_type(4)));
typedef float f32x16 __attribute__((ext_vector_type(16)));
typedef float f32x4 __attribute__((ext_vector_type(4)));
typedef unsigned u32x4 __attribute__((ext_vector_type(4)));
#define ALDS __attribute__((address_space(3)))

#define KSWZ(row, colB) ((row) * 256 + ((colB) ^ (((row) & 7) << 4)))
#define SBAR() __builtin_amdgcn_sched_barrier(0)
__device__ __forceinline__ int v_st(int k, int c) { const int kk = (k & ~0xC) | ((k & 4) << 1) | ((k & 8) >> 1); return ((kk >> 3) * 4 + (c >> 5)) * 512 + ((kk & 7) * 32 + (c & 31)) * 2; }
__device__ __forceinline__ int v_rd_base(int lane) { return ((lane & 3) << 3) | (((lane >> 2) & 3) << 6) | (((lane >> 4) & 1) << 5) | (((lane >> 5) & 1) << 8); }
constexpr int v_rd_off(int d0, int ks, int half) { return d0 * 512 + ks * 4096 + half * 2048; }
__device__ __forceinline__ int crow(int r, int hi) { return (r & 3) + 8 * (r >> 2) + 4 * hi; }
__device__ __forceinline__ unsigned cvtpk(float lo, float hi) { unsigned r; asm volatile("v_cvt_pk_bf16_f32 %0, %1, %2" : "=v"(r) : "v"(lo), "v"(hi)); return r; }
__device__ __forceinline__ bf16x8 load8(const bf16* p) { return *reinterpret_cast<const bf16x8*>(p); }

__device__ __forceinline__ void mask_tile(f32x16& p0, f32x16& p1, int dq) {
    const float NEG = -__builtin_inff();
#pragma unroll
    for (int r = 0; r < 16; ++r) { const int c = (r & 3) + 8 * (r >> 2);
        if (dq - c < 0) p0[r] = NEG;
        if (dq - c - 32 < 0) p1[r] = NEG; }
}
__device__ __forceinline__ void partialSM(f32x16& p0, f32x16& p1, float& m_reg, float& mn, float& alpha) {
    float pmax = p0[0];
#pragma unroll
    for (int r = 1; r < 16; ++r) pmax = fmaxf(pmax, p0[r]);
#pragma unroll
    for (int r = 0; r < 16; ++r) pmax = fmaxf(pmax, p1[r]);
    { auto rr = __builtin_amdgcn_permlane32_swap(__float_as_uint(pmax), __float_as_uint(pmax), false, false);
      pmax = fmaxf(__uint_as_float(rr[0]), __uint_as_float(rr[1])); }
    constexpr float C2 = 1.4426950408889634f * SCALE;
    if (__builtin_expect(__all((pmax - m_reg) * SCALE <= THR), 1)) { mn = m_reg; alpha = 1.f; }
    else { mn = fmaxf(m_reg, pmax); alpha = __builtin_amdgcn_exp2f((m_reg - mn) * C2); m_reg = mn; }
    const float mnL = -mn * C2;
#pragma unroll
    for (int r = 0; r < 16; ++r) p0[r] = fmaf(p0[r], C2, mnL);
#pragma unroll
    for (int r = 0; r < 16; ++r) p1[r] = fmaf(p1[r], C2, mnL);
#pragma unroll
    for (int r = 0; r < 16; ++r) p0[r] = __builtin_amdgcn_exp2f(p0[r]);
}
__device__ __forceinline__ void finishSM(f32x16& p0, f32x16& p1, float alpha, float& l_reg, bf16x8& pa0, bf16x8& pa1, bf16x8& pa2, bf16x8& pa3) {
#pragma unroll
    for (int r = 0; r < 16; ++r) p1[r] = __builtin_amdgcn_exp2f(p1[r]);
    float ps = 0;
#pragma unroll
    for (int r = 0; r < 16; ++r) ps += p0[r];
#pragma unroll
    for (int r = 0; r < 16; ++r) ps += p1[r];
    { auto rr = __builtin_amdgcn_permlane32_swap(__float_as_uint(ps), __float_as_uint(ps), false, false);
      ps = __uint_as_float(rr[0]) + __uint_as_float(rr[1]); }
    l_reg = l_reg * alpha + ps;
#define PK4(P, B_, OUT) do { unsigned a0 = cvtpk(P[B_+0], P[B_+1]), a1 = cvtpk(P[B_+2], P[B_+3]);                          \
        unsigned b0 = cvtpk(P[B_+4], P[B_+5]), b1 = cvtpk(P[B_+6], P[B_+7]);                                             \
        auto r0 = __builtin_amdgcn_permlane32_swap(a0, b0, false, false); auto r1 = __builtin_amdgcn_permlane32_swap(a1, b1, false, false); \
        u32x4 w = {r0[0], r1[0], r0[1], r1[1]}; OUT = *reinterpret_cast<bf16x8*>(&w); } while (0)
    PK4(p0, 0, pa0); PK4(p0, 8, pa1); PK4(p1, 0, pa2); PK4(p1, 8, pa3);
#undef PK4
}
template <int KB>
__device__ __forceinline__ void qkt(f32x16& p0, f32x16& p1, const ALDS char* K_lds, int r32, int hi, const bf16x8* qr, bool act) {
    if (!act) { const float NEG = -__builtin_inff();
#pragma unroll
        for (int r = 0; r < 16; ++r) { p0[r] = NEG; p1[r] = NEG; } return; }
    p0 = f32x16{}; p1 = f32x16{};
    const ALDS char* kb[4];
#pragma unroll
    for (int dd = 0; dd < 4; ++dd) kb[dd] = K_lds + KB * SHM_K + KSWZ(r32, (dd * 16 + hi * 8) * 2);
#pragma unroll
    for (int d0 = 0; d0 < 8; ++d0) { const ALDS char* a = kb[d0 & 3] + (d0 >> 2) * 128;
        bf16x8 b0 = *(const ALDS bf16x8*)(a);
        bf16x8 b1 = *(const ALDS bf16x8*)(a + 32 * 256);
        p0 = __builtin_amdgcn_mfma_f32_32x32x16_bf16(b0, qr[d0], p0, 0, 0, 0);
        p1 = __builtin_amdgcn_mfma_f32_32x32x16_bf16(b1, qr[d0], p1, 0, 0, 0); }
}
template <int VB>
__device__ __forceinline__ void pv_tile(f32x16* o, int vb0, bf16x8 pa0, bf16x8 pa1, bf16x8 pa2, bf16x8 pa3, bool act) {
    if (!act) return;
#define TRRD(dst, off) asm volatile("ds_read_b64_tr_b16 %0, %1 offset:%2" : "=&v"(dst) : "v"(vb0), "i"(off) : "memory")
#define PV_D0(d0) do { s16x4 l0, l1, l2, l3, h0, h1, h2, h3; constexpr int b_ = VB * SHM_V + v_rd_off(d0, 0, 0); \
        TRRD(l0, b_); TRRD(h0, b_ + 2048); TRRD(l1, b_ + 4096); TRRD(h1, b_ + 6144); TRRD(l2, b_ + 8192); TRRD(h2, b_ + 10240); TRRD(l3, b_ + 12288); TRRD(h3, b_ + 14336); \
        asm volatile("s_waitcnt lgkmcnt(0)" ::: "memory"); SBAR(); \
        o[d0] = __builtin_amdgcn_mfma_f32_32x32x16_bf16(pa0, (bf16x8){l0[0], l0[1], l0[2], l0[3], h0[0], h0[1], h0[2], h0[3]}, o[d0], 0, 0, 0);   \
        o[d0] = __builtin_amdgcn_mfma_f32_32x32x16_bf16(pa1, (bf16x8){l1[0], l1[1], l1[2], l1[3], h1[0], h1[1], h1[2], h1[3]}, o[d0], 0, 0, 0);   \
        o[d0] = __builtin_amdgcn_mfma_f32_32x32x16_bf16(pa2, (bf16x8){l2[0], l2[1], l2[2], l2[3], h2[0], h2[1], h2[2], h2[3]}, o[d0], 0, 0, 0);   \
        o[d0] = __builtin_amdgcn_mfma_f32_32x32x16_bf16(pa3, (bf16x8){l3[0], l3[1], l3[2], l3[3], h3[0], h3[1], h3[2], h3[3]}, o[d0], 0, 0, 0); } while (0)
    PV_D0(0); PV_D0(1); PV_D0(2); PV_D0(3);
#undef PV_D0
#undef TRRD
}
template <int MODE>
__device__ __forceinline__ void bias_mask(f32x16& p0, f32x16& p1, const ALDS char* lds, int kb, int qlo, int qpos, int hi, float cqs, bool act) {
    if (!act) return;
    if (MODE == 0) {
        const ALDS float* cs = (const ALDS float*)(lds + OFF_CUM) + kb + 4 * hi;
#pragma unroll
        for (int g = 0; g < 4; ++g) { const f32x4 c0 = *(const ALDS f32x4*)(cs + 8 * g), c1 = *(const ALDS f32x4*)(cs + 32 + 8 * g);
#pragma unroll
            for (int e = 0; e < 4; ++e) { p0[4 * g + e] += cqs - c0[e]; p1[4 * g + e] += cqs - c1[e]; } }
        if (kb + KVBLK - 1 > qlo) mask_tile(p0, p1, qpos - 4 * hi - kb);
    } else {
        const ALDS float* tb = (const ALDS float*)(lds + OFF_REL);
        if (qlo - (kb + KVBLK - 1) >= 256) { const float c = tb[319];
#pragma unroll
            for (int r = 0; r < 16; ++r) { p0[r] += c; p1[r] += c; } }
        else { const int d0 = qpos - kb - 4 * hi + 63;
#pragma unroll
            for (int r = 0; r < 16; ++r) { const int c = (r & 3) + 8 * (r >> 2);
                int i0 = d0 - c, i1 = d0 - c - 32; i0 = i0 > 319 ? 319 : i0; i1 = i1 > 319 ? 319 : i1; i1 = i1 < 0 ? 0 : i1; i0 = i0 < 0 ? 0 : i0;
                p0[r] += tb[i0]; p1[r] += tb[i1]; } }
    }
}

struct Seam { bf16x8 qr[8]; bf16x8 st_v0, st_v1, st_k0, st_k1; };
#define VMW() asm volatile("s_waitcnt vmcnt(0)" ::: "memory")
#define BL8(rs, vo, so) __builtin_bit_cast(bf16x8, __builtin_amdgcn_raw_buffer_load_b128(rs, vo, so, 0))
#define SLOAD_H(Kp, Vp, k0) do { S.st_v0 = BL8(rP, kvoff, (Vp) + (k0) * (PITCH * 2)); S.st_v1 = BL8(rP, kvoff, (Vp) + ((k0) + 32) * (PITCH * 2));              \
                         S.st_k0 = BL8(rP, kvoff, (Kp) + (k0) * (PITCH * 2)); S.st_k1 = BL8(rP, kvoff, (Kp) + ((k0) + 32) * (PITCH * 2)); } while (0)
#define SWRITE_HK(bf) do { *(ALDS bf16x8*)(K_lds + (bf) * SHM_K + kws) = S.st_k0; *(ALDS bf16x8*)(K_lds + (bf) * SHM_K + kws + 32 * 256) = S.st_k1; } while (0)
#define SWRITE_HV(bf) do { *(ALDS bf16x8*)(V_lds + (bf) * SHM_V + vst0) = S.st_v0; *(ALDS bf16x8*)(V_lds + (bf) * SHM_V + vst1) = S.st_v1; } while (0)
#define SWRITE_H(bf) do { SWRITE_HV(bf); SWRITE_HK(bf); } while (0)

template <int MODE>
__device__ __forceinline__ void attn_unit(const bf16* Pb, int Qo, int Kh, int Vh, bf16* Yb, int Oo, int P0, int j_lo, int j_hi, ALDS char* lds, int wid, int lane) {
    const int tid = wid * 64 + lane, r32 = lane & 31, hi = lane >> 5;
    const int NT = j_hi - j_lo;
    const int qlo = P0 + wid * QBLK, qpos = qlo + r32;
    ALDS char* V_lds = lds; ALDS char* K_lds = lds + 2 * SHM_V;
    ALDS float* ws = (ALDS float*)(lds + OFF_WS) + wid * 64; ALDS float* li_l = ws; ALDS float* al_l = ws + 32;
    float m_reg = -1e30f, l_reg = 0; f32x16 o[4] = {};
    const int sr = tid >> 4, sc = (tid & 15) * 8, vst0 = v_st(sr, sc), vst1 = v_st(32 + sr, sc), kws = KSWZ(sr, sc * 2);
    const int vb0 = (int)(unsigned)(size_t)V_lds + v_rd_base(lane);
    Seam S;
    const __amdgpu_buffer_rsrc_t rP = __builtin_amdgcn_make_buffer_rsrc((void*)Pb, 0, 0x7fffffff, 0x00020000);
    const __amdgpu_buffer_rsrc_t rO = __builtin_amdgcn_make_buffer_rsrc((void*)Yb, 0, 0x7fffffff, 0x00020000);
    const int kvoff = (sr * PITCH + sc) * 2;
#define KBASE(t) ((j_lo + (t)) * KVBLK)
#define ACT(t) (MODE == 0 ? (KBASE(t) <= qlo + QBLK - 1) : ((j_lo + (t)) <= (qlo >> 6) && (j_lo + (t)) + 8 >= (qlo >> 6)))
#define RESC(a) do { if (__any((a) < 1.f)) { if (hi == 0) al_l[r32] = (a); asm volatile("s_waitcnt lgkmcnt(0)" ::: "memory");              \
                     for (int d_ = 0; d_ < 4; ++d_) for (int r = 0; r < 16; ++r) o[d_][r] *= al_l[crow(r, hi)]; } } while (0)
#define MASKT(P0_, P1_, t) bias_mask<MODE>(P0_, P1_, lds, KBASE(t), qlo, qpos, hi, cq_, ACT(t))
    {
        const int kb0 = j_lo * KVBLK;
#pragma unroll
        for (int d0 = 0; d0 < 8; ++d0) S.qr[d0] = BL8(rP, (r32 * PITCH + hi * 8) * 2 + d0 * 32, Qo + wid * (QBLK * PITCH * 2));
        SLOAD_H(Kh, Vh, kb0); VMW(); SWRITE_HK(0);
        __syncthreads();
    }
    const float cq_ = MODE == 0 ? ((const ALDS float*)(lds + OFF_CUM))[qpos] : 0.f;
    f32x16 pA0, pA1, pB0, pB1; float mnA, mnB, alA, alB; bf16x8 pa0, pa1, pa2, pa3;
    SWRITE_HV(0); SBAR();
    if (NT > 1) { SLOAD_H(Kh, Vh, KBASE(1)); }
    SBAR(); qkt<0>(pA0, pA1, K_lds, r32, hi, S.qr, ACT(0));
    MASKT(pA0, pA1, 0); partialSM(pA0, pA1, m_reg, mnA, alA);
    if (NT > 1) { VMW(); SWRITE_H(1); }
    __syncthreads();
#define HALF_STEP(PX0, PX1, mnX, alX, PY0, PY1, alY, t, KB, VB, SB) do {                                                      \
        SBAR(); qkt<KB>(PX0, PX1, K_lds, r32, hi, S.qr, ACT(t));                                                              \
        finishSM(PY0, PY1, alY, l_reg, pa0, pa1, pa2, pa3); SBAR();                                                           \
        if ((t) + 1 < NT) { SLOAD_H(Kh, Vh, KBASE((t) + 1)); SBAR(); }                                                        \
        pv_tile<VB>(o, vb0, pa0, pa1, pa2, pa3, ACT((t) - 1)); MASKT(PX0, PX1, (t)); partialSM(PX0, PX1, m_reg, mnX, alX);    \
        __syncthreads();                                                                                                      \
        if ((t) + 1 < NT) { VMW(); SWRITE_H(SB); }                                                                            \
        RESC(alX); __syncthreads(); } while (0)
    for (int t = 1; t + 1 < NT; t += 2) {
        HALF_STEP(pB0, pB1, mnB, alB, pA0, pA1, alA, t, 1, 0, 0);
        HALF_STEP(pA0, pA1, mnA, alA, pB0, pB1, alB, t + 1, 0, 1, 1);
    }
    const bool even = (NT & 1) == 0;
    if (even) { SBAR(); qkt<1>(pB0, pB1, K_lds, r32, hi, S.qr, ACT(NT - 1)); SBAR(); }
    finishSM(pA0, pA1, alA, l_reg, pa0, pa1, pa2, pa3); SBAR();
    pv_tile<0>(o, vb0, pa0, pa1, pa2, pa3, ACT(even ? NT - 2 : NT - 1));
    if (even) { MASKT(pB0, pB1, NT - 1); partialSM(pB0, pB1, m_reg, mnB, alB); __syncthreads(); RESC(alB);
        finishSM(pB0, pB1, alB, l_reg, pa0, pa1, pa2, pa3); SBAR(); pv_tile<1>(o, vb0, pa0, pa1, pa2, pa3, ACT(NT - 1)); }
    SBAR();
    if (hi == 0) li_l[r32] = l_reg; asm volatile("s_waitcnt lgkmcnt(0)" ::: "memory");
    float rli[16];
#pragma unroll
    for (int r = 0; r < 16; ++r) rli[r] = __builtin_amdgcn_rcpf(li_l[crow(r, hi)]);
    const int ovoff = (4 * hi * OPITCH + r32) * 2, osoff = Oo + wid * (QBLK * OPITCH * 2);
#pragma unroll
    for (int r = 0; r < 16; ++r) { const int orow = (r & 3) + 8 * (r >> 2);
#pragma unroll
        for (int d0 = 0; d0 < 4; ++d0) { const float v = o[d0][r] * rli[r];
            const float vn = __builtin_bit_cast(float, __builtin_amdgcn_ds_bpermute((lane ^ 1) << 2, __builtin_bit_cast(int, v)));
            if ((r32 & 1) == 0) __builtin_amdgcn_raw_buffer_store_b32(cvtpk(v, vn), rO, ovoff + d0 * 64, osoff + orow * (OPITCH * 2), 0); } }
    __syncthreads();
#undef RESC
#undef KBASE
#undef ACT
#undef MASKT
#undef HALF_STEP
}
#undef BL8
#undef VMW
#undef SLOAD_H
#undef SWRITE_HK
#undef SWRITE_HV
#undef SWRITE_H
#undef KSWZ
#undef SBAR
}
constexpr size_t WS_QCTR = 768 * 1024;
constexpr size_t WS_POOLW = 4 * MiB;
constexpr int N_ATT_UNITS = 256, N_POOL_UNITS = 512, N_CONV_UNITS = 128;

__device__ __forceinline__ void stage_cum(const Args& a, int b, int h, LAS char* lds, int wave, int lane) {
    const float* logf = (const float*)(a.ws + WS_LOGF) + ((size_t)b * SEQ) * 4 + h;
    const int tid = wave * 64 + lane;
    float v[4];
#pragma unroll
    for (int e = 0; e < 4; ++e) v[e] = logf[(size_t)(4 * tid + e) * 4];
    v[1] += v[0]; v[2] += v[1]; v[3] += v[2];
    float incl = v[3];
#pragma unroll
    for (int o = 1; o < 64; o <<= 1) { const float t = shf(incl, lane >= o ? lane - o : lane); if (lane >= o) incl += t; }
    LAS float* wt = (LAS float*)(lds + att::OFF_WS);
    if (lane == 63) wt[wave] = incl;
    __syncthreads();
    float base = incl - v[3];
    for (int w = 0; w < wave; ++w) base += wt[w];
    LAS float* cs = (LAS float*)(lds + att::OFF_CUM);
    const float inv = 1.0f / ATT_SCALE;
    *(LAS f32x4*)(cs + 4 * tid) = (f32x4){(base + v[0]) * inv, (base + v[1]) * inv, (base + v[2]) * inv, (base + v[3]) * inv};
    __syncthreads();
}
__device__ __forceinline__ void attention_item(const Args& a, int l, int u, LAS char* lds, int wave) {
    int lane; asm volatile("v_mbcnt_lo_u32_b32 %0, -1, 0\n\tv_mbcnt_hi_u32_b32 %0, -1, %0" : "=v"(lane));
    const bf16* P = (const bf16*)(a.ws + WS_PROJ); bf16* Y = (bf16*)(a.ws + WS_Y);
    const int mode = u >> 7, v = u & 127, qb = 7 - (v >> 4), bh = v & 15, b = bh >> 2, h = bh & 3;
    const size_t row0 = (size_t)b * SEQ; const int P0 = qb * 256;
    if (mode == 0) {
        stage_cum(a, b, h, lds, wave, lane);
        att::attn_unit<0>(P, (int)((0 * PROJ_T + (row0 + P0) * MIXW + h * HD) * 2), (int)((1 * PROJ_T + row0 * MIXW + h * HD) * 2), (int)((2 * PROJ_T + row0 * MIXW + h * HD) * 2),
                          Y, (int)(((row0 + P0) * D + h * HD) * 2), P0, 0, 4 * qb + 4, lds, wave, lane);
    } else {
        const int tid = wave * 64 + lane;
        if (tid < 320) ((LAS float*)(lds + att::OFF_REL))[tid] = a.rel_bias[((size_t)l * 4 + h) * 320 + tid] * (1.0f / ATT_SCALE);
        const int jlo = 4 * qb - 8 < 0 ? 0 : 4 * qb - 8;
        att::attn_unit<1>(P, (int)((7 * PROJ_T + (row0 + P0) * MIXW + h * HD) * 2), (int)((8 * PROJ_T + row0 * MIXW + h * HD) * 2), (int)((9 * PROJ_T + row0 * MIXW + h * HD) * 2),
                          Y, (int)(((row0 + P0) * D + 1536 + h * HD) * 2), P0, jlo, 4 * qb + 4, lds, wave, lane);
    }
}
__device__ __forceinline__ void pool_item(const Args& a, int l, int u, LAS char* lds, int wave) {
    int lane; asm volatile("v_mbcnt_lo_u32_b32 %0, -1, 0\n\tv_mbcnt_hi_u32_b32 %0, -1, %0" : "=v"(lane));
    const int g = u & 3, T0 = (u >> 2) * 64, tid = wave * 64 + lane;
    const bf16* Pin = (const bf16*)(a.ws + WS_PROJ) + 3 * PROJ_T + g * 128;
    {
        const int cp = tid & 63, run = tid >> 6, w = 2 << g, t0 = T0 + run * 8, s0 = t0 & (SEQ - 1);
        const bf16* col = Pin + 2 * cp;
        float s_lo = 0.f, s_hi = 0.f;
        for (int j = 1; j < w; ++j) if (s0 - j >= 0) { const unsigned x = *(const unsigned*)(col + (size_t)(t0 - j) * MIXW); s_lo += bflo(x); s_hi += bfhi(x); }
#pragma unroll
        for (int i = 0; i < 8; ++i) { const unsigned x = *(const unsigned*)(col + (size_t)(t0 + i) * MIXW); s_lo += bflo(x); s_hi += bfhi(x);
            const int s = s0 + i; const int cnt = s + 1 < w ? s + 1 : w; const float inv = 1.0f / (float)cnt;
            *(LAS unsigned*)(lds + (run * 8 + i) * 272 + 4 * cp) = pk2(s_lo * inv - bflo(x), s_hi * inv - bfhi(x));
            if (s - w + 1 >= 0) { const unsigned y = *(const unsigned*)(col + (size_t)(t0 + i - w + 1) * MIXW); s_lo -= bflo(y); s_hi -= bfhi(y); } }
    }
    __syncthreads();
    {
        typedef short bf16x8 __attribute__((ext_vector_type(8)));
        const bf16* Wt = (const bf16*)(a.ws + WS_POOLW) + ((size_t)l * 4 + g) * 128 * 128;
        const int rt = (wave & 3) * 16, db = (wave >> 2) * 64, fr = lane & 15, kg = lane >> 4;
        f32x4 acc[4] = {};
#pragma unroll
        for (int ks = 0; ks < 4; ++ks) { const bf16x8 af = *(const LAS bf16x8*)(lds + (rt + fr) * 272 + (ks * 32 + kg * 8) * 2);
#pragma unroll
            for (int nt = 0; nt < 4; ++nt) { const bf16x8 bfr = *(const bf16x8*)(Wt + (size_t)(db + nt * 16 + fr) * 128 + ks * 32 + kg * 8);
                acc[nt] = __builtin_amdgcn_mfma_f32_16x16x32_bf16(bfr, af, acc[nt], 0, 0, 0); } }
        bf16* Y = (bf16*)(a.ws + WS_Y) + (size_t)(T0 + rt + fr) * D + 512 + g * 128;
#pragma unroll
        for (int nt = 0; nt < 4; ++nt) { const int d = db + nt * 16 + kg * 4; const f32x4 sc = *(const f32x4*)(a.pool_scale + l * MIXW + g * 128 + d);
            v2u w; w.x = pk2(acc[nt][0] * sc[0], acc[nt][1] * sc[1]); w.y = pk2(acc[nt][2] * sc[2], acc[nt][3] * sc[3]); *(v2u*)(Y + d) = w; }
    }
    __syncthreads();
}
__device__ __forceinline__ void conv_item(const Args& a, int l, int u, int wave) {
    int lane; asm volatile("v_mbcnt_lo_u32_b32 %0, -1, 0\n\tv_mbcnt_hi_u32_b32 %0, -1, %0" : "=v"(lane));
    const bf16* P = (const bf16*)(a.ws + WS_PROJ); const bf16* Ch = P + 4 * PROJ_T; const bf16* Cb = P + 5 * PROJ_T; const bf16* Cc = P + 6 * PROJ_T;
    const int tid = wave * 64 + lane, c0 = (tid & 63) * 8, t0 = u * 64 + (tid >> 6) * 8, s0 = t0 & (SEQ - 1);
    float wgt[3][8];
#pragma unroll
    for (int j = 0; j < 3; ++j) { const float* w = a.conv_w + ((size_t)l * 3 + j) * MIXW + c0; const f32x4 w0 = *(const f32x4*)w, w1 = *(const f32x4*)(w + 4);
#pragma unroll
        for (int k = 0; k < 4; ++k) { wgt[j][k] = w0[k]; wgt[j][4 + k] = w1[k]; } }
    float z2[8], z1[8];
#pragma unroll
    for (int k = 0; k < 8; ++k) { z2[k] = 0.f; z1[k] = 0.f; }
#pragma unroll
    for (int i = -2; i < 8; ++i) {
        float z[8];
        if (s0 + i >= 0) { const v4u hv = *(const v4u*)(Ch + (size_t)(t0 + i) * MIXW + c0), cv = *(const v4u*)(Cc + (size_t)(t0 + i) * MIXW + c0);
            z[0] = bflo(hv.x) * bflo(cv.x); z[1] = bfhi(hv.x) * bfhi(cv.x); z[2] = bflo(hv.y) * bflo(cv.y); z[3] = bfhi(hv.y) * bfhi(cv.y);
            z[4] = bflo(hv.z) * bflo(cv.z); z[5] = bfhi(hv.z) * bfhi(cv.z); z[6] = bflo(hv.w) * bflo(cv.w); z[7] = bfhi(hv.w) * bfhi(cv.w); }
        else {
#pragma unroll
            for (int k = 0; k < 8; ++k) z[k] = 0.f; }
        if (i >= 0) { const v4u bv = *(const v4u*)(Cb + (size_t)(t0 + i) * MIXW + c0); float o[8];
            const float bb[8] = {bflo(bv.x), bfhi(bv.x), bflo(bv.y), bfhi(bv.y), bflo(bv.z), bfhi(bv.z), bflo(bv.w), bfhi(bv.w)};
#pragma unroll
            for (int k = 0; k < 8; ++k) o[k] = bb[k] * (wgt[0][k] * z2[k] + wgt[1][k] * z1[k] + wgt[2][k] * z[k]);
            v4u ov; ov.x = pk2(o[0], o[1]); ov.y = pk2(o[2], o[3]); ov.z = pk2(o[4], o[5]); ov.w = pk2(o[6], o[7]);
            *(v4u*)((bf16*)(a.ws + WS_Y) + (size_t)(t0 + i) * D + 1024 + c0) = ov; }
#pragma unroll
        for (int k = 0; k < 8; ++k) { z2[k] = z1[k]; z1[k] = z[k]; }
    }
}
__device__ __forceinline__ void mixers_fast(const Args& a, int l, LAS char* lds, int wave, int lane, int G, int blk) {
    for (int u = blk; u < N_ATT_UNITS; u += G) attention_item(a, l, u, lds, wave);
    unsigned* head = (unsigned*)(a.ws + WS_QCTR) + 64 * l;
    volatile LAS unsigned* slot = (volatile LAS unsigned*)(lds + att::LDS_END);
    for (;;) {
        if (wave == 0 && lane == 0) *slot = __hip_atomic_fetch_add(head, 1u, __ATOMIC_RELAXED, __HIP_MEMORY_SCOPE_AGENT);
        __syncthreads();
        const unsigned it = *slot;
        __syncthreads();
        if (it >= (unsigned)(N_POOL_UNITS + N_CONV_UNITS)) break;
        if (it < (unsigned)N_POOL_UNITS) pool_item(a, l, (int)it, lds, wave); else conv_item(a, l, (int)it - N_POOL_UNITS, wave);
    }
}
__device__ __forceinline__ void p0_prologue(const Args& a, LAS unsigned char* lds, int gw, int NGW, int wave, int lane) {
    unsigned char* ws = a.ws;
    LAS float* scr = (LAS float*)(lds + wave * 16384);
    constexpr int I_WIN = (D / 64) * (NPROJ / 32), I_SQ = (D / 64) * (D / 32), I_BR = (MIXW / 64) * (D / 32);
    constexpr int I_LAYER = I_WIN + 4 * I_BR + 2 * I_SQ;
    for (int it = gw; it < DEPTH * I_LAYER; it += NGW) {
        const int l = it / I_LAYER; int r = it - l * I_LAYER;
        if (r < I_WIN) { const int kb = r / (NPROJ / 32), nb = r % (NPROJ / 32);
            tr_item<true>(a.w_in + (size_t)l * D * INW, INW, a.norm_mix + l * D, (bf16*)(ws + WS_WIN + l * WIN_BYTES), D, 0, scr, 64 * kb, 32 * nb, lane); continue; }
        r -= I_WIN;
        if (r < 4 * I_BR) { const int g = r / I_BR, rr = r % I_BR, kb = rr / (D / 32), nb = rr % (D / 32);
            tr_item<false>(a.w_branch + ((size_t)l * 4 + g) * MIXW * D, D, nullptr, (bf16*)(ws + WS_WBR + l * SQ_BYTES), D, g * MIXW, scr, 64 * kb, 32 * nb, lane); continue; }
        r -= 4 * I_BR;
        if (r < I_SQ) { const int kb = r / (D / 32), nb = r % (D / 32);
            tr_item<false>(a.w_out + (size_t)l * D * D, D, nullptr, (bf16*)(ws + WS_WOUT + l * SQ_BYTES), D, 0, scr, 64 * kb, 32 * nb, lane); continue; }
        r -= I_SQ;
        { const int kb = r / (D / 32), nb = r % (D / 32);
            tr_item<false>(a.peer_wq + (size_t)l * D * D, D, a.norm_ffn + l * D, (bf16*)(ws + WS_WQ + l * SQ_BYTES), D, 0, scr, 64 * kb, 32 * nb, lane); }
    }
    for (int it = gw; it < DEPTH * 4 * 8; it += NGW) { const int lg = it >> 3, r = it & 7;
        tr_item<false>(a.pool_w + (size_t)lg * 128 * 128, 128, nullptr, (bf16*)(ws + WS_POOLW) + (size_t)lg * 128 * 128, 128, 0, scr, 64 * (r >> 2), 32 * (r & 3), lane); }
    for (int r = gw; r < 2 * DEPTH * PEER_E; r += NGW) { const int t = r / (DEPTH * PEER_E), row = r - t * (DEPTH * PEER_E);
        const float* src = (t ? a.peer_v : a.peer_u) + (size_t)row * D + 4 * lane;
        f32x4 v[8]; float am = 0.f;
#pragma unroll
        for (int j = 0; j < 8; ++j) { v[j] = *(const f32x4*)(src + 256 * j); am = fmaxf(am, fmaxf(fmaxf(fabsf(v[j][0]), fabsf(v[j][1])), fmaxf(fabsf(v[j][2]), fabsf(v[j][3])))); }
        am = wave_max(am, lane);
        const float inv = am > 0.f ? 127.0f / am : 0.f, off = t ? 128.f : 0.f;
        unsigned char* dst = ws + (t ? WS_PV : WS_PU) + (size_t)row * D + 4 * lane;
#pragma unroll
        for (int j = 0; j < 8; ++j) { const int q0 = (int)(rintf(v[j][0] * inv) + off), q1 = (int)(rintf(v[j][1] * inv) + off), q2 = (int)(rintf(v[j][2] * inv) + off), q3 = (int)(rintf(v[j][3] * inv) + off);
            *(unsigned*)(dst + 256 * j) = (unsigned)(q0 & 255) | ((unsigned)(q1 & 255) << 8) | ((unsigned)(q2 & 255) << 16) | ((unsigned)(q3 & 255) << 24); }
        if (lane == 0) ((float*)(ws + (t ? WS_SV : WS_SU)))[row] = am * (1.0f / 127.0f); }
    {
        float* wf = (float*)(ws + WS_WF); float* binr = (float*)(ws + WS_BINR);
        const int gt = gw * 64 + lane, NGT = NGW * 64;
        for (int i = gt; i < DEPTH * 4 * D; i += NGT) { const int l = i / (4 * D), h = (i / D) & 3, k = i % D; wf[i] = a.w_in[(size_t)l * D * INW + (size_t)k * INW + 1536 + h] * a.norm_mix[l * D + k]; }
        for (int i = gt; i < DEPTH * NPROJ; i += NGT) { const int l = i / NPROJ, j = i % NPROJ; binr[i] = a.b_in[l * INW + colmap_in(j)]; }
    }
    {
        float* H = (float*)(ws + WS_H); bf16* HB = (bf16*)(ws + WS_HB); float* ssq = (float*)(ws + WS_SSQ);
        for (int m = gw; m < M; m += NGW) { float s = 0.f;
#pragma unroll
            for (int j = 0; j < 8; ++j) { const size_t o = (size_t)m * D + j * 256 + lane * 4; const f32x4 v = *(const f32x4*)(a.x + o); *(f32x4*)(H + o) = v;
                v2u w; w.x = pk2(v[0], v[1]); w.y = pk2(v[2], v[3]); *(v2u*)(HB + o) = w; s += (v[0] * v[0] + v[1] * v[1]) + (v[2] * v[2] + v[3] * v[3]); }
            s = wave_sum(s, lane); if (lane == 0) ssq[m] = s; }
    }
}

__device__ __forceinline__ void forget_logits(const Args& a, int l, int gw, int NGW, int lane) {
    unsigned char* ws = a.ws; const bf16* HB = (const bf16*)(ws + WS_HB); const float* wf = (const float*)(ws + WS_WF) + l * 4 * D; const float* ssq = (const float*)(ws + WS_SSQ) + l * M;
    float* logf = (float*)(ws + WS_LOGF);
    for (int m = gw; m < M; m += NGW) {
        float d[4] = {0.f, 0.f, 0.f, 0.f};
#pragma unroll
        for (int j = 0; j < 4; ++j) { const int k0 = j * 512 + lane * 8; const v4u xv = *(const v4u*)(HB + (size_t)m * D + k0);
            const float x[8] = {bflo(xv.x), bfhi(xv.x), bflo(xv.y), bfhi(xv.y), bflo(xv.z), bfhi(xv.z), bflo(xv.w), bfhi(xv.w)};
#pragma unroll
            for (int h = 0; h < 4; ++h) { const f32x4 w0 = *(const f32x4*)(wf + h * D + k0), w1 = *(const f32x4*)(wf + h * D + k0 + 4);
                d[h] += x[0] * w0[0] + x[1] * w0[1] + x[2] * w0[2] + x[3] * w0[3] + x[4] * w1[0] + x[5] * w1[1] + x[6] * w1[2] + x[7] * w1[3]; } }
        const float rs = rsqrtf(ssq[m] * (1.0f / D) + EPS);
#pragma unroll
        for (int h = 0; h < 4; ++h) { const float z = wave_sum(d[h], lane) * rs + a.b_in[l * INW + 1536 + h];
            const float ls = fminf(z, 0.f) - log1pf(__expf(-fabsf(z)));
            if (lane == h) logf[m * 4 + h] = ls; }
    }
}
__device__ __forceinline__ void cum_scan(const Args& a, int gw, int lane) {
    if (gw >= 16) return;
    const float* logf = (const float*)(a.ws + WS_LOGF); float* cum = (float*)(a.ws + WS_CUM);
    const int b = gw >> 2, h = gw & 3; float run = 0.f;
    for (int c = 0; c < SEQ / 64; ++c) { float v = logf[(size_t)(b * SEQ + c * 64 + lane) * 4 + h];
#pragma unroll
        for (int o = 1; o < 64; o <<= 1) { const float t = shf(v, lane >= o ? lane - o : lane); if (lane >= o) v += t; }
        v += run; cum[(size_t)gw * SEQ + c * 64 + lane] = v; run = shf(v, 63); }
}

template <int MODE>
__device__ __forceinline__ void naive_attn(const Args& a, int l, int b, int h, int s, LAS float* sc, int lane) {
    const unsigned char* ws = a.ws; const bf16* P = (const bf16*)(ws + WS_PROJ);
    const bf16* Qp = P + (MODE ? 7 : 0) * PROJ_T; const bf16* Kp = P + (MODE ? 8 : 1) * PROJ_T; const bf16* Vp = P + (MODE ? 9 : 2) * PROJ_T;
    const float* cum = (const float*)(ws + WS_CUM) + (size_t)(b * 4 + h) * SEQ;
    const float* rb = a.rel_bias + ((size_t)l * 4 + h) * 320;
    const size_t tb = (size_t)b * SEQ;
    int klo = 0, khi = s;
    if (MODE) { const int c = s >> 6; klo = (c - 8) * 64; if (klo < 0) klo = 0; khi = c * 64 + 63; }
    const bf16* qrow = Qp + (tb + s) * MIXW + h * HD;
    float mx = -3.0e38f;
    for (int kb = klo; kb <= khi; kb += 64) { const int k = kb + lane;
        if (k <= khi) { const bf16* krow = Kp + (tb + k) * MIXW + h * HD; float d = 0.f;
#pragma unroll 4
            for (int c8 = 0; c8 < 16; ++c8) { const v4u qv = *(const v4u*)(qrow + c8 * 8), kv = *(const v4u*)(krow + c8 * 8);
                d = dot2_bf16(qv.x, kv.x, d); d = dot2_bf16(qv.y, kv.y, d); d = dot2_bf16(qv.z, kv.z, d); d = dot2_bf16(qv.w, kv.w, d); }
            float bias;
            if (MODE == 0) bias = cum[s] - cum[k];
            else { int rel = s - k; rel = rel < -63 ? -63 : (rel > 256 ? 256 : rel); bias = rb[rel + 63]; }
            const float lg = d * ATT_SCALE + bias; sc[k - klo] = lg; mx = fmaxf(mx, lg); } }
    mx = wave_max(mx, lane);
    asm volatile("s_waitcnt lgkmcnt(0)" ::: "memory");
    float sum = 0.f;
    for (int kb = klo; kb <= khi; kb += 64) { const int k = kb + lane; if (k <= khi) { const float p = __expf(sc[k - klo] - mx); sc[k - klo] = p; sum += p; } }
    sum = wave_sum(sum, lane);
    asm volatile("s_waitcnt lgkmcnt(0)" ::: "memory");
    float o0 = 0.f, o1 = 0.f;
    for (int k = klo; k <= khi; ++k) { const float p = sc[k - klo]; const unsigned v = *(const unsigned*)(Vp + (tb + k) * MIXW + h * HD + 2 * lane); o0 += p * bflo(v); o1 += p * bfhi(v); }
    const float inv = 1.0f / sum;
    bf16* Y = (bf16*)(a.ws + WS_Y);
    *(unsigned*)(Y + (tb + s) * D + (MODE ? 1536 : 0) + h * HD + 2 * lane) = pk2(o0 * inv, o1 * inv);
    asm volatile("s_waitcnt lgkmcnt(0)" ::: "memory");
}
__device__ __forceinline__ void naive_pool(const Args& a, int l, int t, int g, LAS float* sc, int lane) {
    const bf16* Pin = (const bf16*)(a.ws + WS_PROJ) + 3 * PROJ_T;
    const int s = t & (SEQ - 1), w = 2 << g; const int cnt = (s + 1 < w) ? s + 1 : w;
    float s0 = 0.f, s1 = 0.f;
    for (int j = 0; j < cnt; ++j) { const unsigned v = *(const unsigned*)(Pin + (size_t)(t - j) * MIXW + g * 128 + 2 * lane); s0 += bflo(v); s1 += bfhi(v); }
    const unsigned v0 = *(const unsigned*)(Pin + (size_t)t * MIXW + g * 128 + 2 * lane);
    const float inv = 1.0f / (float)cnt;
    sc[2 * lane] = s0 * inv - bflo(v0); sc[2 * lane + 1] = s1 * inv - bfhi(v0);
    asm volatile("s_waitcnt lgkmcnt(0)" ::: "memory");
    const float* W = a.pool_w + ((size_t)l * 4 + g) * 128 * 128;
    float o0 = 0.f, o1 = 0.f;
    for (int c = 0; c < 128; ++c) { const float p = sc[c]; const f32x2 wv = *(const f32x2*)(W + c * 128 + 2 * lane); o0 += p * wv[0]; o1 += p * wv[1]; }
    const f32x2 ps = *(const f32x2*)(a.pool_scale + l * MIXW + g * 128 + 2 * lane);
    bf16* Y = (bf16*)(a.ws + WS_Y);
    *(unsigned*)(Y + (size_t)t * D + 512 + g * 128 + 2 * lane) = pk2(o0 * ps[0], o1 * ps[1]);
    asm volatile("s_waitcnt lgkmcnt(0)" ::: "memory");
}
__device__ __forceinline__ void naive_conv(const Args& a, int l, int t, int lane) {
    const bf16* P = (const bf16*)(a.ws + WS_PROJ); const bf16* Ch = P + 4 * PROJ_T; const bf16* Cb = P + 5 * PROJ_T; const bf16* Cc = P + 6 * PROJ_T;
    const int s = t & (SEQ - 1), c0 = lane * 8;
    float acc[8] = {0.f, 0.f, 0.f, 0.f, 0.f, 0.f, 0.f, 0.f};
#pragma unroll
    for (int j = 0; j < 3; ++j) { const int dt = 2 - j;
        if (s - dt >= 0) { const v4u hv = *(const v4u*)(Ch + (size_t)(t - dt) * MIXW + c0), cv = *(const v4u*)(Cc + (size_t)(t - dt) * MIXW + c0);
            const float* w = a.conv_w + ((size_t)l * 3 + j) * MIXW + c0; const f32x4 w0 = *(const f32x4*)w, w1 = *(const f32x4*)(w + 4);
            acc[0] += w0[0] * bflo(hv.x) * bflo(cv.x); acc[1] += w0[1] * bfhi(hv.x) * bfhi(cv.x); acc[2] += w0[2] * bflo(hv.y) * bflo(cv.y); acc[3] += w0[3] * bfhi(hv.y) * bfhi(cv.y);
            acc[4] += w1[0] * bflo(hv.z) * bflo(cv.z); acc[5] += w1[1] * bfhi(hv.z) * bfhi(cv.z); acc[6] += w1[2] * bflo(hv.w) * bflo(cv.w); acc[7] += w1[3] * bfhi(hv.w) * bfhi(cv.w); } }
    const v4u bv = *(const v4u*)(Cb + (size_t)t * MIXW + c0);
    v4u o; o.x = pk2(acc[0] * bflo(bv.x), acc[1] * bfhi(bv.x)); o.y = pk2(acc[2] * bflo(bv.y), acc[3] * bfhi(bv.y)); o.z = pk2(acc[4] * bflo(bv.z), acc[5] * bfhi(bv.z)); o.w = pk2(acc[6] * bflo(bv.w), acc[7] * bfhi(bv.w));
    *(v4u*)((bf16*)(a.ws + WS_Y) + (size_t)t * D + 1024 + c0) = o;
}
__device__ __forceinline__ void mixers_naive(const Args& a, int l, LAS unsigned char* lds, int gw, int NGW, int wave, int lane) {
    LAS float* sc = (LAS float*)(lds + wave * 8192);
    for (int i = gw; i < M * 4; i += NGW) { const int t = M * 4 - 1 - i; const int h = t & 3, tok = t >> 2; naive_attn<0>(a, l, tok >> 11, h, tok & (SEQ - 1), sc, lane); }
    for (int i = gw; i < M * 4; i += NGW) { const int h = i & 3, tok = i >> 2; naive_attn<1>(a, l, tok >> 11, h, tok & (SEQ - 1), sc, lane); }
    for (int i = gw; i < M * 4; i += NGW) naive_pool(a, l, i >> 2, i & 3, sc, lane);
    for (int i = gw; i < M; i += NGW) naive_conv(a, l, i, lane);
}

__device__ __forceinline__ float gelu_tanh(float x) { const float u = 1.5957691216057308f * (x + 0.044715f * x * x * x); return x / (1.0f + __expf(-u)); }
__device__ __forceinline__ void peer_token(const Args& a, int l, int t, bool last_layer) {
    int lane; asm volatile("v_mbcnt_lo_u32_b32 %0, -1, 0\n\tv_mbcnt_hi_u32_b32 %0, -1, %0" : "=v"(lane));
    unsigned char* ws = a.ws;
    const bf16* Q = (const bf16*)(ws + WS_Q) + (size_t)t * D;
    const float* keys = a.peer_keys + (size_t)l * 8 * 2 * 128 * 128;
    int idxv[2] = {0, 0}; float gatv[2] = {0.f, 0.f};
    const float NEG = -3.0e38f;
    for (int h = 0; h < 8; ++h) {
        float tops[2] = {0.f, 0.f}; int topi[2] = {0, 0};
#pragma unroll
        for (int p = 0; p < 2; ++p) {
            const bf16* qp = Q + h * 256 + p * 128; const float* kp = keys + ((size_t)(h * 2 + p) * 128) * 128;
            float s0 = 0.f, s1 = 0.f;
#pragma unroll 4
            for (int c8 = 0; c8 < 16; ++c8) { const v4u qv = *(const v4u*)(qp + c8 * 8);
                const float q[8] = {bflo(qv.x), bfhi(qv.x), bflo(qv.y), bfhi(qv.y), bflo(qv.z), bfhi(qv.z), bflo(qv.w), bfhi(qv.w)};
                const float* k0 = kp + (size_t)lane * 128 + c8 * 8; const float* k1 = k0 + 64 * 128;
                const f32x4 a0 = *(const f32x4*)k0, a1 = *(const f32x4*)(k0 + 4), b0 = *(const f32x4*)k1, b1 = *(const f32x4*)(k1 + 4);
                s0 += q[0] * a0[0] + q[1] * a0[1] + q[2] * a0[2] + q[3] * a0[3] + q[4] * a1[0] + q[5] * a1[1] + q[6] * a1[2] + q[7] * a1[3];
                s1 += q[0] * b0[0] + q[1] * b0[1] + q[2] * b0[2] + q[3] * b0[3] + q[4] * b1[0] + q[5] * b1[1] + q[6] * b1[2] + q[7] * b1[3]; }
            for (int it = 0; it < 16; ++it) { const float m = wave_max(fmaxf(s0, s1), lane); int k;
                const unsigned long long b0 = __ballot(s0 == m);
                if (b0) { const int o = __ffsll((long long)b0) - 1; k = o; if (lane == o) s0 = NEG; }
                else { const unsigned long long b1 = __ballot(s1 == m); const int o = __ffsll((long long)b1) - 1; k = o + 64; if (lane == o) s1 = NEG; }
                if (lane == it) { tops[p] = m; topi[p] = k; } }
        }
        float cs[4]; int ci[4];
        { const float sa = shf(tops[0], lane >> 2); const int ia = shi(topi[0], lane >> 2);
#pragma unroll
            for (int e = 0; e < 4; ++e) { const int j = 4 * (lane & 3) + e; cs[e] = sa + shf(tops[1], j); ci[e] = ia * 128 + shi(topi[1], j); } }
        float bs = NEG; int bi = 0;
        for (int it = 0; it < 16; ++it) { const float m = wave_max(fmaxf(fmaxf(cs[0], cs[1]), fmaxf(cs[2], cs[3])), lane);
            int sel = -1, o = 0;
#pragma unroll
            for (int e = 0; e < 4; ++e) { if (sel < 0) { const unsigned long long bb = __ballot(cs[e] == m); if (bb) { sel = e; o = __ffsll((long long)bb) - 1; } } }
            int idx = 0;
#pragma unroll
            for (int e = 0; e < 4; ++e) { if (sel == e) { idx = shi(ci[e], o); if (lane == o) cs[e] = NEG; } }
            if (lane == it) { bs = m; bi = idx; } }
        const float mx = shf(bs, 0); const float ex = lane < 16 ? __expf(bs - mx) : 0.f; const float sum = wave_sum(ex, lane); const float gt = ex / sum;
        const int vi = shi(bi, lane & 15); const float vg = shf(gt, lane & 15);
        if ((lane >> 4) == (h & 3)) { if (h < 4) { idxv[0] = vi; gatv[0] = vg; } else { idxv[1] = vi; gatv[1] = vg; } }
    }
    asm volatile("v_mbcnt_lo_u32_b32 %0, -1, 0\n\tv_mbcnt_hi_u32_b32 %0, -1, %0" : "=v"(lane));
    const unsigned long long* ssa1 = (const unsigned long long*)(ws + WS_SSA) + l * M;
    const float rs = rsqrtf(ssa_to_f(ssa1[t]) * (1.0f / D) + EPS);
    const bf16* HB = (const bf16*)(ws + WS_HB) + (size_t)t * D; const float* gn = a.norm_ffn + l * D;
    int xh[8], xl[8]; float sx;
    {
        float xf[32]; float am = 0.f;
#pragma unroll
        for (int i = 0; i < 2; ++i) { const int k0 = 16 * lane + 1024 * i; const v4u h0 = *(const v4u*)(HB + k0), h1 = *(const v4u*)(HB + k0 + 8);
            const unsigned hw[8] = {h0.x, h0.y, h0.z, h0.w, h1.x, h1.y, h1.z, h1.w};
#pragma unroll
            for (int q = 0; q < 4; ++q) { const f32x4 g = *(const f32x4*)(gn + k0 + 4 * q);
                xf[16 * i + 4 * q + 0] = bflo(hw[2 * q]) * rs * g[0]; xf[16 * i + 4 * q + 1] = bfhi(hw[2 * q]) * rs * g[1];
                xf[16 * i + 4 * q + 2] = bflo(hw[2 * q + 1]) * rs * g[2]; xf[16 * i + 4 * q + 3] = bfhi(hw[2 * q + 1]) * rs * g[3]; } }
#pragma unroll
        for (int k = 0; k < 32; ++k) am = fmaxf(am, fabsf(xf[k]));
        am = wave_max(am, lane);
        sx = am * (1.0f / 127.0f); const float inv = am > 0.f ? 127.0f / am : 0.f;
#pragma unroll
        for (int d = 0; d < 8; ++d) { unsigned ph = 0, pl = 0;
#pragma unroll
            for (int b = 0; b < 4; ++b) { const float s = xf[4 * d + b] * inv, hq = rintf(s), lq = rintf((s - hq) * 128.0f);
                ph |= ((unsigned)((int)hq & 255)) << (8 * b); pl |= ((unsigned)((int)lq & 255)) << (8 * b); }
            xh[d] = (int)ph; xl[d] = (int)pl; }
    }
    const unsigned char* PU = ws + WS_PU + (size_t)l * PE_BYTES; const unsigned char* PV = ws + WS_PV + (size_t)l * PE_BYTES;
    const float* SU = (const float*)(ws + WS_SU) + l * PEER_E; const float* SV = (const float*)(ws + WS_SV) + l * PEER_E;
    const float suv[2] = {SU[idxv[0]], SU[idxv[1]]}, svv[2] = {SV[idxv[0]], SV[idxv[1]]};
    const __amdgpu_buffer_rsrc_t rU = __builtin_amdgcn_make_buffer_rsrc((void*)PU, 0, 0x7fffffff, 0x00020000), rV = __builtin_amdgcn_make_buffer_rsrc((void*)PV, 0, 0x7fffffff, 0x00020000);
    const int lo16 = 16 * lane;
#define PEER_LOADG(buf, T, g) do { const int sel_ = ((g) & 8) ? idxv[1] : idxv[0]; _Pragma("unroll") for (int j = 0; j < 8; ++j) { \
        const int e_ = __builtin_amdgcn_readlane(sel_, ((g) & 7) * 8 + j); \
        buf[j][0] = __builtin_amdgcn_raw_buffer_load_b128(T, lo16, e_ * D, 0); buf[j][1] = __builtin_amdgcn_raw_buffer_load_b128(T, lo16 + 1024, e_ * D, 0); } } while (0)
    float actv[2] = {0.f, 0.f};
    {
        v4u bA[8][2], bB[8][2];
#define PEER_UCOMP(buf, g) do { float p_[8]; _Pragma("unroll") for (int j = 0; j < 8; ++j) { int dh = 0, dl = 0; \
            _Pragma("unroll") for (int i = 0; i < 2; ++i) { \
                dh = __builtin_amdgcn_sdot4((int)buf[j][i].x, xh[4 * i + 0], dh, false); dl = __builtin_amdgcn_sdot4((int)buf[j][i].x, xl[4 * i + 0], dl, false); \
                dh = __builtin_amdgcn_sdot4((int)buf[j][i].y, xh[4 * i + 1], dh, false); dl = __builtin_amdgcn_sdot4((int)buf[j][i].y, xl[4 * i + 1], dl, false); \
                dh = __builtin_amdgcn_sdot4((int)buf[j][i].z, xh[4 * i + 2], dh, false); dl = __builtin_amdgcn_sdot4((int)buf[j][i].z, xl[4 * i + 2], dl, false); \
                dh = __builtin_amdgcn_sdot4((int)buf[j][i].w, xh[4 * i + 3], dh, false); dl = __builtin_amdgcn_sdot4((int)buf[j][i].w, xl[4 * i + 3], dl, false); } \
            p_[j] = (float)dh + (float)dl * (1.0f / 128.0f); } \
        float q_[4]; _Pragma("unroll") for (int k = 0; k < 4; ++k) { auto r_ = __builtin_amdgcn_permlane32_swap(__float_as_uint(p_[2 * k]), __float_as_uint(p_[2 * k + 1]), false, false); q_[k] = __uint_as_float(r_[0]) + __uint_as_float(r_[1]); } \
        float s_[2]; _Pragma("unroll") for (int k = 0; k < 2; ++k) { auto r_ = __builtin_amdgcn_permlane16_swap(__float_as_uint(q_[2 * k]), __float_as_uint(q_[2 * k + 1]), false, false); s_[k] = __uint_as_float(r_[0]) + __uint_as_float(r_[1]); } \
        _Pragma("unroll") for (int k = 0; k < 2; ++k) { s_[k] += shf(s_[k], lane ^ 8); s_[k] += shf(s_[k], lane ^ 4); s_[k] += shf(s_[k], lane ^ 2); s_[k] += shf(s_[k], lane ^ 1); } \
          \
        const int src_ = 16 * (((lane & 1) << 1) | ((lane >> 1) & 1)); const float v0_ = shf(s_[0], src_), v1_ = shf(s_[1], src_); \
        if ((lane >> 3) == ((g) & 7)) { const float v_ = (lane & 4) ? v1_ : v0_; if ((g) & 8) actv[1] = v_; else actv[0] = v_; } } while (0)
        PEER_LOADG(bA, rU, 0);
        for (int g = 0; g < 16; g += 2) {
            PEER_LOADG(bB, rU, g + 1);
            PEER_UCOMP(bA, g);
            if (g + 2 < 16) PEER_LOADG(bA, rU, g + 2);
            PEER_UCOMP(bB, g + 1);
        }
#undef PEER_UCOMP
    }
    float coef[2]; float csum;
    { const float a0 = actv[0] * suv[0] * sx, a1 = actv[1] * suv[1] * sx;
      coef[0] = gelu_tanh(a0) * gatv[0] * svv[0]; coef[1] = gelu_tanh(a1) * gatv[1] * svv[1]; csum = wave_sum(coef[0] + coef[1], lane); }
    float y[4][8];
#pragma unroll
    for (int i = 0; i < 4; ++i)
#pragma unroll
        for (int k = 0; k < 8; ++k) y[i][k] = 0.f;
    {
        v4u bA[8][2], bB[8][2];
#define PEER_VCOMP(buf, g) do { const float csel_ = ((g) & 8) ? coef[1] : coef[0]; _Pragma("unroll") for (int j = 0; j < 8; ++j) { \
            const float c_ = __builtin_bit_cast(float, __builtin_amdgcn_readlane(__builtin_bit_cast(int, csel_), ((g) & 7) * 8 + j)); \
            _Pragma("unroll") for (int i = 0; i < 2; ++i) { const unsigned w_[4] = {buf[j][i].x, buf[j][i].y, buf[j][i].z, buf[j][i].w}; \
                _Pragma("unroll") for (int d = 0; d < 4; ++d) { \
                    y[2 * i + (d >> 1)][4 * (d & 1) + 0] += c_ * (float)(w_[d] & 255u); y[2 * i + (d >> 1)][4 * (d & 1) + 1] += c_ * (float)((w_[d] >> 8) & 255u); \
                    y[2 * i + (d >> 1)][4 * (d & 1) + 2] += c_ * (float)((w_[d] >> 16) & 255u); y[2 * i + (d >> 1)][4 * (d & 1) + 3] += c_ * (float)(w_[d] >> 24); } } } } while (0)
        PEER_LOADG(bA, rV, 0);
        for (int g = 0; g < 16; g += 2) {
            PEER_LOADG(bB, rV, g + 1);
            PEER_VCOMP(bA, g);
            if (g + 2 < 16) PEER_LOADG(bA, rV, g + 2);
            PEER_VCOMP(bB, g + 1);
        }
#undef PEER_VCOMP
    }
#undef PEER_LOADG
    { const float corr = 128.0f * csum;
#pragma unroll
      for (int i = 0; i < 4; ++i)
#pragma unroll
          for (int k = 0; k < 8; ++k) y[i][k] -= corr; }
    float* H = (float*)(ws + WS_H) + (size_t)t * D; bf16* HBw = (bf16*)(ws + WS_HB) + (size_t)t * D;
    float s = 0.f;
#pragma unroll
    for (int q = 0; q < 4; ++q) { const int k0 = 16 * lane + 1024 * (q >> 1) + 8 * (q & 1); const f32x4 h0 = *(const f32x4*)(H + k0), h1 = *(const f32x4*)(H + k0 + 4);
#pragma unroll
        for (int k = 0; k < 4; ++k) { y[q][k] += h0[k]; y[q][4 + k] += h1[k]; }
#pragma unroll
        for (int k = 0; k < 8; ++k) s += y[q][k] * y[q][k]; }
    s = wave_sum(s, lane);
    if (!last_layer) {
        float* ssqn = (float*)(ws + WS_SSQ) + (l + 1) * M; if (lane == 0) ssqn[t] = s;
#pragma unroll
        for (int q = 0; q < 4; ++q) { const int k0 = 16 * lane + 1024 * (q >> 1) + 8 * (q & 1); *(f32x4*)(H + k0) = (f32x4){y[q][0], y[q][1], y[q][2], y[q][3]}; *(f32x4*)(H + k0 + 4) = (f32x4){y[q][4], y[q][5], y[q][6], y[q][7]};
            v4u o; o.x = pk2(y[q][0], y[q][1]); o.y = pk2(y[q][2], y[q][3]); o.z = pk2(y[q][4], y[q][5]); o.w = pk2(y[q][6], y[q][7]); *(v4u*)(HBw + k0) = o; }
    } else {
        const float rf = rsqrtf(s * (1.0f / D) + EPS); float* O = a.out + (size_t)t * D;
#pragma unroll
        for (int q = 0; q < 4; ++q) { const int k0 = 16 * lane + 1024 * (q >> 1) + 8 * (q & 1); const f32x4 g0 = *(const f32x4*)(a.norm_final + k0), g1 = *(const f32x4*)(a.norm_final + k0 + 4);
            *(f32x4*)(O + k0) = (f32x4){y[q][0] * rf * g0[0], y[q][1] * rf * g0[1], y[q][2] * rf * g0[2], y[q][3] * rf * g0[3]};
            *(f32x4*)(O + k0 + 4) = (f32x4){y[q][4] * rf * g1[0], y[q][5] * rf * g1[1], y[q][6] * rf * g1[2], y[q][7] * rf * g1[3]}; }
    }
}

#define LANE_ID(x) asm volatile("v_mbcnt_lo_u32_b32 %0, -1, 0\n\tv_mbcnt_hi_u32_b32 %0, -1, %0" : "=v"(x))
__global__ void __launch_bounds__(NT, 2) mk_fwd(ArgsK a_in) {
    extern __shared__ __attribute__((aligned(16))) unsigned char lds_raw[];
    LAS unsigned char* lds = (LAS unsigned char*)lds_raw;
    cg::grid_group grid = cg::this_grid();
    grid.sync();
    const int wave0 = __builtin_amdgcn_readfirstlane(threadIdx.x >> 6);
    const int G = gridDim.x;
    const CAS ArgsK* ka = (const CAS ArgsK*)__builtin_amdgcn_kernarg_segment_ptr();
    size_t zoff = 0;
#define PHASE_BEGIN() int lane; LANE_ID(lane); int blk = blockIdx.x, Gp = G, wv = wave0; asm volatile("" : "+s"(zoff), "+s"(ka), "+s"(blk), "+s"(Gp), "+s"(wv)); const int wave = wv, gw = blk * NWAVES + wv, NGW = Gp * NWAVES; (void)gw; (void)NGW; const Args a = load_args(ka, zoff); unsigned char* const ws = a.ws; (void)ws
    volatile LAS unsigned* bst = (volatile LAS unsigned*)(lds + RING_BYTES + 1024);
    { PHASE_BEGIN(); if (wave == 0 && lane == 0) { bst[0] = 0u; bst[1] = 0u; (void)xb_add((unsigned*)(ws + WS_BAR) + XB_XCNT(xb_xcc_id()), 1u); }
      p0_prologue(a, lds, gw, NGW, wave, lane); }
#define GRID_BAR() do { asm volatile("" : "+s"(zoff)); unsigned char* wsb_ = (unsigned char*)ka->ws + zoff; int wvb_ = wave0; asm volatile("" : "+s"(wvb_)); xcd_barrier((unsigned*)(wsb_ + WS_BAR), xb_xcc_id(), (unsigned)G, bst, wvb_); } while (0)
    GRID_BAR();
    int depth_rt = DEPTH; asm volatile("" : "+s"(depth_rt));
    for (int lc = 0; lc < depth_rt; ++lc) {
        int l = lc; asm volatile("" : "+s"(l));
        {
            PHASE_BEGIN();
            float* ssq_mix = (float*)(ws + WS_SSQ) + l * M;
            pg8::Gemm g{(const bf16*)(ws + WS_HB), (const bf16*)(ws + WS_WIN + l * WIN_BYTES), M, NPROJ, D}; pg8::StaticOrder S; S.init(M, NPROJ, Gp, blk);
            EpiProj E{(bf16*)(ws + WS_PROJ), (bf16*)(ws + WS_R), (const float*)(ws + WS_BINR) + l * NPROJ, ssq_mix};
            pg8::gemm_phase<EpiProj, pg8::StaticOrder, true>(lds, g, S, E, wave);
            forget_logits(a, l, gw, NGW, lane);
        }
        GRID_BAR();
        { PHASE_BEGIN(); mixers_fast(a, l, (LAS char*)lds, wave, lane, Gp, blk); }
        GRID_BAR();
        {
            PHASE_BEGIN();
            pg8::Gemm g{(const bf16*)(ws + WS_Y), (const bf16*)(ws + WS_WBR + l * SQ_BYTES), M, D, D}; pg8::StaticOrder S; S.init(M, D, Gp, blk);
            EpiMerge E{(const bf16*)(ws + WS_R), (bf16*)(ws + WS_MRG)};
            pg8::gemm_phase<EpiMerge, pg8::StaticOrder, false>(lds, g, S, E, wave);
        }
        GRID_BAR();
        {
            PHASE_BEGIN();
            pg8::Gemm g{(const bf16*)(ws + WS_MRG), (const bf16*)(ws + WS_WOUT + l * SQ_BYTES), M, D, D}; pg8::StaticOrder S; S.init(M, D, Gp, blk);
            EpiRes E{(float*)(ws + WS_H), (bf16*)(ws + WS_HB), (unsigned long long*)(ws + WS_SSA) + l * M};
            pg8::gemm_phase<EpiRes, pg8::StaticOrder, false>(lds, g, S, E, wave);
        }
        GRID_BAR();
        {
            PHASE_BEGIN();
            pg8::Gemm g{(const bf16*)(ws + WS_HB), (const bf16*)(ws + WS_WQ + l * SQ_BYTES), M, D, D}; pg8::StaticOrder S; S.init(M, D, Gp, blk);
            EpiQ E{(bf16*)(ws + WS_Q), (const unsigned long long*)(ws + WS_SSA) + l * M};
            pg8::gemm_phase<EpiQ, pg8::StaticOrder, false>(lds, g, S, E, wave);
        }
        GRID_BAR();
        { PHASE_BEGIN(); (void)lane; for (int t = gw; t < M; t += NGW) peer_token(a, l, t, l == depth_rt - 1); }
        if (l + 1 < depth_rt) GRID_BAR();
    }
}

extern "C" void kernel_launch(void* const* d_in, const int* in_sizes, int n_in, void* d_out, int out_size, void* d_ws, size_t ws_size, hipStream_t stream) {
    static int grid = 0;
    if (grid == 0) {
        int dev = 0, cus = 0, per_cu = 0;
        if (n_in != 16 || out_size != M * D || ws_size < WS_END) { fprintf(stderr, "kernel_launch: unexpected shapes (n_in %d out %d ws %zu)\n", n_in, out_size, ws_size); grid = -1; return; }
        (void)hipGetDevice(&dev);
        (void)hipDeviceGetAttribute(&cus, hipDeviceAttributeMultiprocessorCount, dev);
        (void)hipFuncSetAttribute((const void*)mk_fwd, hipFuncAttributeMaxDynamicSharedMemorySize, LDS_BYTES);
        (void)hipOccupancyMaxActiveBlocksPerMultiprocessor(&per_cu, (const void*)mk_fwd, NT, LDS_BYTES);
        if (per_cu < 1) { fprintf(stderr, "kernel_launch: occupancy query says %d blocks per CU\n", per_cu); }
        grid = cus;
        if (grid > 256) grid = 256;
    }
    if (grid < 0) return;
    (void)hipMemsetAsync((char*)d_ws + WS_CTL, 0, CTL_ZERO_BYTES, stream);
    ArgsK a{};
    const GAS float** p = (const GAS float**)&a;
    for (int i = 0; i < 16; ++i) p[i] = (const GAS float*)d_in[i];
    a.out = (GAS float*)d_out; a.ws = (GAS unsigned char*)d_ws;
    void* args[] = {&a};
    hipError_t e = hipLaunchCooperativeKernel((const void*)mk_fwd, dim3(grid), dim3(NT), args, LDS_BYTES, stream);
    if (e != hipSuccess) fprintf(stderr, "cooperative launch failed: %s (grid %d)\n", hipGetErrorString(e), grid);
}
```

```cpp
#include <hip/hip_runtime.h>
#include <hip/hip_cooperative_groups.h>
#include <cstdio>
#include <cstdint>
namespace cg = cooperative_groups;
namespace pg8 {
#define PG8_LAS __attribute__((address_space(3)))
typedef unsigned short bf16_t;
typedef short bf16x8 __attribute__((ext_vector_type(8)));
typedef float f32x4 __attribute__((ext_vector_type(4)));
typedef unsigned u32x4 __attribute__((ext_vector_type(4)));
typedef unsigned u32x2 __attribute__((ext_vector_type(2)));
constexpr int BM = 256, BK = 64, HALF = 128, HTB = HALF * BK * 2  , STAGE_BYTES = 8 * HTB, NXCD = 8, WGM = 8;

__host__ __device__ __forceinline__ int lds_byte(int r, int c) { const int st = (r >> 4) * 2 + (c >> 5), rr = r & 15, cc = c & 31, ob = rr * 64 + cc * 2; return st * 1024 + (ob ^ (((ob >> 9) & 1) << 5)); }
__host__ __device__ __forceinline__ void stage_rc(int b, int& R, int& C) { const int st = b / 1024, sb = b % 1024, swz = sb ^ (((sb >> 9) & 1) << 5); R = (st >> 1) * 16 + swz / 64; C = (st & 1) * 32 + (swz % 64) / 2; }
__host__ __device__ __forceinline__ int perm32(int rho) { const int n = rho >> 4, i = rho & 15; return 8 * (i >> 2) + 4 * n + (i & 3); }

struct Unit { int pm, pn; };
struct Gemm { const bf16_t* A; const bf16_t* Bt; int M, N, K; };

struct StaticOrder {
    int nM, nN, nwg, G, c;
    __host__ __device__ void init(int M, int N, int G_, int c_) { nM = M / BM; nN = N / BM; nwg = nM * nN; G = G_; c = c_; }
    __host__ __device__ bool next(int i, Unit& u) const {
        const long L = (long)i * G + c; if (L >= nwg) return false;
        int wgid = (int)L; { const int q = nwg / NXCD, r = nwg % NXCD, xcd = wgid % NXCD, off = wgid / NXCD; wgid = (xcd < r ? xcd * (q + 1) : r * (q + 1) + (xcd - r) * q) + off; }
        const int nig = WGM * nN, gid = wgid / nig, fm = gid * WGM, gsz = (nM - fm) < WGM ? (nM - fm) : WGM;
        u.pm = fm + ((wgid % nig) % gsz); u.pn = (wgid % nig) / gsz; return true;
    }
};

__device__ __forceinline__ unsigned cvt_pk_bf16(float lo, float hi) { unsigned r; asm volatile("v_cvt_pk_bf16_f32 %0, %1, %2" : "=v"(r) : "v"(lo), "v"(hi)); return r; }

template <class Epi, class Sched, bool ALIGN_EPI = false>
__device__ __forceinline__ void gemm_phase(PG8_LAS unsigned char* lds, const Gemm g, const Sched& S, const Epi& E, int wid) {
    int lane_; asm volatile("v_mbcnt_lo_u32_b32 %0, -1, 0\n\tv_mbcnt_hi_u32_b32 %0, -1, %0" : "=v"(lane_));
    const int lane = lane_, tid = wid * 64 + lane, wr = wid >> 2, wc = wid & 3, fr = lane & 15, fq = lane >> 4;
    const int K = g.K, nt = K / BK;
    unsigned voffA[2], voffB[2];
#pragma unroll
    for (int i = 0; i < 2; ++i) { int R, C; stage_rc(tid * 16 + i * 8192, R, C); const int Rb = Epi::PERM ? ((R & ~31) + perm32(R & 31)) : R;
        voffA[i] = (unsigned)(R * K + C) * 2u; voffB[i] = (unsigned)(Rb * K + C) * 2u; }
    const size_t kstep = (size_t)(BK * 2);
    const size_t hstep = (size_t)HALF * K * 2;
    const size_t tstep = 2 * hstep;
    const unsigned ldsw = (unsigned)wid * 1024u;
    const int aoff = lds_byte(wr * 64 + fr, fq * 8), boff = lds_byte(wc * 32 + fr, fq * 8);
#define PG8_SA(b, h) (((b) * 2 + (h)) * HTB)
#define PG8_SB(b, h) ((4 + (b) * 2 + (h)) * HTB)
#define PG8_STAGE(bufoff, gbase, voff) do { _Pragma("unroll") for (int _i = 0; _i < 2; ++_i) \
        __builtin_amdgcn_global_load_lds((const unsigned*)((const char*)(gbase) + (voff)[_i]), (PG8_LAS unsigned*)(lds + (bufoff) + ldsw + _i * 8192), 16, 0, 0); } while (0)
#define PG8_LDA(dst, b, h) do { _Pragma("unroll") for (int m = 0; m < 4; ++m) _Pragma("unroll") for (int k = 0; k < 2; ++k) dst[m][k] = *(const PG8_LAS bf16x8*)(lds + PG8_SA(b, h) + aoff + m * 2048 + k * 1024); } while (0)
#define PG8_LDB(dst, b, h) do { _Pragma("unroll") for (int n = 0; n < 2; ++n) _Pragma("unroll") for (int k = 0; k < 2; ++k) dst[n][k] = *(const PG8_LAS bf16x8*)(lds + PG8_SB(b, h) + boff + n * 2048 + k * 1024); } while (0)
#define PG8_MMA(ai, bj, At, Bt) do { __builtin_amdgcn_s_setprio(1); _Pragma("unroll") for (int m = 0; m < 4; ++m) _Pragma("unroll") for (int n = 0; n < 2; ++n) _Pragma("unroll") for (int k = 0; k < 2; ++k) \
        acc[ai][bj][m][n] = __builtin_amdgcn_mfma_f32_16x16x32_bf16(Bt[n][k], At[m][k], acc[ai][bj][m][n], 0, 0, 0); __builtin_amdgcn_s_setprio(0); } while (0)
#define PG8_WAIT_V(n) asm volatile("s_waitcnt vmcnt(" #n ")" ::: "memory")
#define PG8_WAIT_L(n) asm volatile("s_waitcnt lgkmcnt(" #n ")" ::: "memory")
#define PG8_BAR __builtin_amdgcn_s_barrier()
#define PG8_SCHED __builtin_amdgcn_sched_barrier(0)
    Unit cur, nxt; int ui = 0;
    if (!S.next(0, cur)) return;
    f32x4 acc[2][2][4][2];
#pragma unroll
    for (int a = 0; a < 2; ++a)
#pragma unroll
        for (int b = 0; b < 2; ++b)
#pragma unroll
            for (int m = 0; m < 4; ++m)
#pragma unroll
                for (int n = 0; n < 2; ++n) acc[a][b][m][n] = (f32x4){0.f, 0.f, 0.f, 0.f};
    bf16x8 At[4][2], B0[2][2], B1[2][2];
    const char* cA = (const char*)g.A + (size_t)cur.pm * tstep; const char* cB = (const char*)g.Bt + (size_t)cur.pn * tstep;
    PG8_STAGE(PG8_SB(0, 0), cB, voffB); PG8_STAGE(PG8_SB(0, 1), cB + hstep, voffB); PG8_STAGE(PG8_SA(0, 0), cA, voffA); PG8_STAGE(PG8_SA(0, 1), cA + hstep, voffA);
    if (wr == 1) PG8_BAR;
    PG8_WAIT_V(2); PG8_BAR;
    PG8_STAGE(PG8_SB(1, 0), cB + kstep, voffB); PG8_STAGE(PG8_SA(1, 0), cA + kstep, voffA); PG8_STAGE(PG8_SB(1, 1), cB + hstep + kstep, voffB);
    PG8_WAIT_V(6); PG8_BAR;
    for (;;) {
        const bool has_next = S.next(ui + 1, nxt);
        const char* nA = has_next ? (const char*)g.A + (size_t)nxt.pm * tstep : cA; const char* nB = has_next ? (const char*)g.Bt + (size_t)nxt.pn * tstep : cB;
        const int seglen = Epi::HOOK ? 8 : nt;
        for (int t0 = 0; t0 < nt; t0 += seglen) {
        if constexpr (Epi::HOOK) { if (t0 > 0) E.hook(acc, cur, t0 >> 3, wr, wc, fr, fq); }
        for (int t = t0; t < t0 + seglen; t += 2) {
            const bool last = (t == nt - 2);
            const char* a1 = cA + (size_t)(t + 1) * kstep;
            const char* a2 = last ? nA : cA + (size_t)(t + 2) * kstep; const char* b2 = last ? nB : cB + (size_t)(t + 2) * kstep;
            const char* a3 = a2 + kstep; const char* b3 = b2 + kstep;
            PG8_LDB(B0, 0, 0); PG8_LDB(B1, 0, 1); PG8_SCHED; PG8_LDA(At, 0, 0); PG8_STAGE(PG8_SA(1, 1), a1 + hstep, voffA);
            PG8_WAIT_V(8); PG8_WAIT_L(0); PG8_BAR; PG8_MMA(0, 0, At, B0); PG8_MMA(0, 1, At, B1); PG8_BAR; PG8_SCHED;
            PG8_LDA(At, 0, 1); PG8_STAGE(PG8_SB(0, 0), b2, voffB); PG8_STAGE(PG8_SB(0, 1), b2 + hstep, voffB); PG8_STAGE(PG8_SA(0, 0), a2, voffA);
            PG8_WAIT_V(8); PG8_WAIT_L(0); PG8_BAR; PG8_MMA(1, 0, At, B0); PG8_MMA(1, 1, At, B1); PG8_BAR; PG8_SCHED;
            PG8_LDB(B0, 1, 0); PG8_LDB(B1, 1, 1); PG8_SCHED; PG8_LDA(At, 1, 0); PG8_STAGE(PG8_SA(0, 1), a2 + hstep, voffA);
            PG8_WAIT_V(8); PG8_WAIT_L(0); PG8_BAR; PG8_MMA(0, 0, At, B0); PG8_MMA(0, 1, At, B1); PG8_BAR; PG8_SCHED;
            PG8_LDA(At, 1, 1); PG8_STAGE(PG8_SB(1, 0), b3, voffB); PG8_STAGE(PG8_SB(1, 1), b3 + hstep, voffB); PG8_STAGE(PG8_SA(1, 0), a3, voffA);
            PG8_WAIT_V(8); PG8_WAIT_L(0); PG8_BAR; PG8_MMA(1, 0, At, B0); PG8_MMA(1, 1, At, B1); PG8_BAR; PG8_SCHED;
        }
        }
        if constexpr (ALIGN_EPI) { if (wr == 0) PG8_BAR; }
        E(acc, cur, wr, wc, fr, fq);
        if (!has_next) break;
#pragma unroll
        for (int a = 0; a < 2; ++a)
#pragma unroll
            for (int b = 0; b < 2; ++b)
#pragma unroll
                for (int m = 0; m < 4; ++m)
#pragma unroll
                    for (int n = 0; n < 2; ++n) acc[a][b][m][n] = (f32x4){0.f, 0.f, 0.f, 0.f};
        cur = nxt; cA = nA; cB = nB; ++ui;
        if constexpr (ALIGN_EPI) { if (wr == 1) PG8_BAR; }
    }
    PG8_WAIT_V(0);
    if constexpr (!ALIGN_EPI) { if (wr == 0) PG8_BAR; }
    PG8_BAR;
#undef PG8_SA
#undef PG8_SB
#undef PG8_STAGE
#undef PG8_LDA
#undef PG8_LDB
#undef PG8_MMA
#undef PG8_WAIT_V
#undef PG8_WAIT_L
#undef PG8_BAR
#undef PG8_SCHED
}
}
constexpr int NWAVES = 8, NT = NWAVES * 64;
constexpr int M = 8192, D = 2048, SEQ = 2048, NBATCH = 4, DEPTH = 2;
constexpr int INW = 13316, NPROJ = 13312, MIXW = 512, HD = 128;
constexpr int PEER_E = 16384;
constexpr float EPS = 1e-6f;
constexpr float ATT_SCALE = 0.08838834764831845f;

constexpr size_t MiB = 1u << 20;
constexpr size_t WS_CTL = 0, CTL_ZERO_BYTES = 1 * MiB;
constexpr size_t WS_SSQ = 0;
constexpr size_t WS_SSA = 256 * 1024;
constexpr size_t WS_WF = 1 * MiB;
constexpr size_t WS_BINR = WS_WF + 64 * 1024;
constexpr size_t WS_LOGF = 2 * MiB;
constexpr size_t WS_CUM = 3 * MiB;
constexpr size_t WS_WIN = 8 * MiB;
constexpr size_t WIN_BYTES = (size_t)NPROJ * D * 2;
constexpr size_t WS_WBR = 112 * MiB, WS_WOUT = 128 * MiB, WS_WQ = 144 * MiB;
constexpr size_t SQ_BYTES = (size_t)D * D * 2;
constexpr size_t WS_PU = 160 * MiB, WS_PV = 288 * MiB;
constexpr size_t PE_BYTES = (size_t)PEER_E * D;
constexpr size_t WS_PK = 6 * MiB;
constexpr size_t WS_SU = 5 * MiB, WS_SV = 5 * MiB + 256 * 1024;
constexpr size_t WS_H = 416 * MiB;
constexpr size_t WS_HB = 480 * MiB;
constexpr size_t WS_PROJ = 512 * MiB;
constexpr size_t PROJ_T = (size_t)M * MIXW;
constexpr size_t WS_R = 592 * MiB;
constexpr size_t R_PLANE = (size_t)M * D;
constexpr size_t WS_Y = 720 * MiB;
constexpr size_t WS_MRG = 752 * MiB;
constexpr size_t WS_Q = 784 * MiB;
constexpr size_t WS_END = 816 * MiB;

constexpr int RING_BYTES = 131072;
constexpr int LDS_BYTES = 147456;

typedef unsigned short bf16;
typedef unsigned v4u __attribute__((ext_vector_type(4)));
typedef unsigned v2u __attribute__((ext_vector_type(2)));
typedef float f32x4 __attribute__((ext_vector_type(4)));
typedef float f32x2 __attribute__((ext_vector_type(2)));
using bf16x2 = __attribute__((ext_vector_type(2))) __bf16;
#define LAS __attribute__((address_space(3)))

__device__ __forceinline__ unsigned f2bf(float f) { unsigned u = __builtin_bit_cast(unsigned, f); return (u + 0x7fffu + ((u >> 16) & 1u)) >> 16; }
__device__ __forceinline__ unsigned pk2(float lo, float hi) { return f2bf(lo) | (f2bf(hi) << 16); }
__device__ __forceinline__ float bflo(unsigned w) { return __builtin_bit_cast(float, w << 16); }
__device__ __forceinline__ float bfhi(unsigned w) { return __builtin_bit_cast(float, w & 0xffff0000u); }
__device__ __forceinline__ float bf2f(bf16 b) { return __builtin_bit_cast(float, ((unsigned)b) << 16); }
__device__ __forceinline__ float shf(float v, int src) { return __builtin_bit_cast(float, __builtin_amdgcn_ds_bpermute(src << 2, __builtin_bit_cast(int, v))); }
__device__ __forceinline__ int shi(int v, int src) { return __builtin_amdgcn_ds_bpermute(src << 2, v); }
__device__ __forceinline__ float wave_sum(float v, int lane) {
#pragma unroll
    for (int o = 1; o < 64; o <<= 1) v += shf(v, lane ^ o);
    return v;
}
__device__ __forceinline__ float wave_max(float v, int lane) {
#pragma unroll
    for (int o = 1; o < 64; o <<= 1) v = fmaxf(v, shf(v, lane ^ o));
    return v;
}
__device__ __forceinline__ float ssa_to_f(unsigned long long v) { return (float)((double)v * (1.0 / 4294967296.0)); }
__device__ __forceinline__ float dot2_bf16(unsigned w, unsigned x, float acc) { return __builtin_amdgcn_fdot2_f32_bf16(__builtin_bit_cast(bf16x2, w), __builtin_bit_cast(bf16x2, x), acc, false); }

struct Args {
    const float *x, *norm_mix, *w_in, *b_in, *pool_w, *pool_scale, *conv_w, *rel_bias, *w_branch, *w_out, *norm_ffn, *peer_wq, *peer_keys, *peer_u, *peer_v, *norm_final;
    float* out; unsigned char* ws;
};
#define GAS __attribute__((address_space(1)))
#define CAS __attribute__((address_space(4)))
struct ArgsK {
    const GAS float *x, *norm_mix, *w_in, *b_in, *pool_w, *pool_scale, *conv_w, *rel_bias, *w_branch, *w_out, *norm_ffn, *peer_wq, *peer_keys, *peer_u, *peer_v, *norm_final;
    GAS float* out; GAS unsigned char* ws;
};
__device__ __forceinline__ Args load_args(const CAS ArgsK* k, size_t zoff) {
    Args a;
    a.x = (const float*)k->x; a.norm_mix = (const float*)k->norm_mix; a.w_in = (const float*)k->w_in; a.b_in = (const float*)k->b_in; a.pool_w = (const float*)k->pool_w;
    a.pool_scale = (const float*)k->pool_scale; a.conv_w = (const float*)k->conv_w; a.rel_bias = (const float*)k->rel_bias; a.w_branch = (const float*)k->w_branch;
    a.w_out = (const float*)k->w_out; a.norm_ffn = (const float*)k->norm_ffn; a.peer_wq = (const float*)k->peer_wq; a.peer_keys = (const float*)k->peer_keys;
    a.peer_u = (const float*)k->peer_u; a.peer_v = (const float*)k->peer_v; a.norm_final = (const float*)k->norm_final; a.out = (float*)k->out; a.ws = (unsigned char*)(k->ws + zoff);
    return a;
}

using pg8::f32x4; using pg8::Unit;
struct EpiProj {
    static constexpr bool PERM = true, HOOK = false;
    bf16* P; bf16* R; const float* bias; const float* ssq;
    __device__ __forceinline__ void operator()(f32x4 (&acc)[2][2][4][2], const Unit& u, int wr, int wc, int fr, int fq) const {
        const int row0 = u.pm * 256 + wr * 64 + fr, cl0 = wc * 32 + 8 * fq, bcol0 = u.pn * 256 + cl0;
        f32x4 bv[2][2];
#pragma unroll
        for (int bj = 0; bj < 2; ++bj)
#pragma unroll
            for (int n = 0; n < 2; ++n) bv[bj][n] = *(const f32x4*)(bias + bcol0 + bj * 128 + 4 * n);
        if (u.pn < 20) {
            bf16* base = P + (size_t)(u.pn >> 1) * PROJ_T + (u.pn & 1) * 256 + cl0;
#pragma unroll
            for (int ai = 0; ai < 2; ++ai)
#pragma unroll
                for (int m = 0; m < 4; ++m) { const int row = row0 + ai * 128 + m * 16; const float rs = rsqrtf(ssq[row] * (1.0f / D) + EPS);
                    bf16* rowp = base + (size_t)row * MIXW;
#pragma unroll
                    for (int bj = 0; bj < 2; ++bj) { const f32x4 v0 = acc[ai][bj][m][0] * rs + bv[bj][0], v1 = acc[ai][bj][m][1] * rs + bv[bj][1];
                        pg8::u32x4 w; w.x = pg8::cvt_pk_bf16(v0[0], v0[1]); w.y = pg8::cvt_pk_bf16(v0[2], v0[3]); w.z = pg8::cvt_pk_bf16(v1[0], v1[1]); w.w = pg8::cvt_pk_bf16(v1[2], v1[3]);
                        *(pg8::u32x4*)(rowp + bj * 128) = w; } }
        } else {
            const int d0 = 64 * (u.pn - 20) + 16 * wc + 4 * fq;
#pragma unroll
            for (int ai = 0; ai < 2; ++ai)
#pragma unroll
                for (int m = 0; m < 4; ++m) { const int row = row0 + ai * 128 + m * 16; const float rs = rsqrtf(ssq[row] * (1.0f / D) + EPS);
                    float r[4][4];
#pragma unroll
                    for (int j = 0; j < 4; ++j) { float e[4], ie[4];
#pragma unroll
                        for (int g = 0; g < 4; ++g) { const float z = acc[ai][g >> 1][m][g & 1][j] * rs + bv[g >> 1][g & 1][j];
                            e[g] = fminf(1.0f + __builtin_amdgcn_exp2f(-1.4426950408889634f * z), 1e18f); ie[g] = __builtin_amdgcn_rcpf(e[g]); }
                        r[0][j] = e[1] * ie[0]; r[1][j] = e[2] * ie[1]; r[2][j] = e[3] * ie[2]; r[3][j] = ie[3]; }
#pragma unroll
                    for (int g = 0; g < 4; ++g) { pg8::u32x2 w; w.x = pg8::cvt_pk_bf16(r[g][0], r[g][1]); w.y = pg8::cvt_pk_bf16(r[g][2], r[g][3]);
                        *(pg8::u32x2*)(R + (size_t)g * R_PLANE + (size_t)row * D + d0) = w; } }
        }
    }
};
struct EpiMerge {
    static constexpr bool PERM = true, HOOK = true;
    const bf16* R; bf16* O;
    template <int NB  >
    __device__ __forceinline__ void scale(f32x4 (&acc)[2][2][4][2], const Unit& u, int plane, int wr, int wc, int fr, int fq) const {
        const __amdgpu_buffer_rsrc_t rs = __builtin_amdgcn_make_buffer_rsrc((void*)(R + (size_t)plane * R_PLANE), 0, 0x7fffffff, 0x00020000);
        int voff = (fr * D + 8 * fq) * 2; asm volatile("" : "+v"(voff));
        const int sbase = ((u.pm * 256 + wr * 64) * D + u.pn * 256 + wc * 32) * 2;
#pragma unroll
        for (int b0 = 0; b0 < 8; b0 += NB) {
            pg8::u32x4 w[NB][2];
#pragma unroll
            for (int i = 0; i < NB; ++i)
#pragma unroll
                for (int bj = 0; bj < 2; ++bj) { const int ai = (b0 + i) >> 2, m = (b0 + i) & 3;
                    w[i][bj] = __builtin_amdgcn_raw_buffer_load_b128(rs, voff + bj * 256, sbase + (ai * 128 + m * 16) * D * 2, 0); }
#pragma unroll
            for (int i = 0; i < NB; ++i)
#pragma unroll
                for (int bj = 0; bj < 2; ++bj) { const int ai = (b0 + i) >> 2, m = (b0 + i) & 3; const pg8::u32x4 v = w[i][bj];
                    acc[ai][bj][m][0] *= (f32x4){bflo(v.x), bfhi(v.x), bflo(v.y), bfhi(v.y)};
                    acc[ai][bj][m][1] *= (f32x4){bflo(v.z), bfhi(v.z), bflo(v.w), bfhi(v.w)};
                    asm volatile("" : "+v"(acc[ai][bj][m][0]), "+v"(acc[ai][bj][m][1])); }
            asm volatile("" ::: "memory"); }
    }
    __device__ __forceinline__ void hook(f32x4 (&acc)[2][2][4][2], const Unit& u, int g, int wr, int wc, int fr, int fq) const { scale<4>(acc, u, g - 1, wr, wc, fr, fq); }
    __device__ __forceinline__ void operator()(f32x4 (&acc)[2][2][4][2], const Unit& u, int wr, int wc, int fr, int fq) const {
        scale<4>(acc, u, 3, wr, wc, fr, fq);
        const int row0 = u.pm * 256 + wr * 64 + fr, col0 = u.pn * 256 + wc * 32 + 8 * fq;
#pragma unroll
        for (int ai = 0; ai < 2; ++ai)
#pragma unroll
            for (int m = 0; m < 4; ++m) { bf16* rowp = O + (size_t)(row0 + ai * 128 + m * 16) * D + col0;
#pragma unroll
                for (int bj = 0; bj < 2; ++bj) { const f32x4 v0 = acc[ai][bj][m][0], v1 = acc[ai][bj][m][1];
                    pg8::u32x4 w; w.x = pg8::cvt_pk_bf16(v0[0], v0[1]); w.y = pg8::cvt_pk_bf16(v0[2], v0[3]); w.z = pg8::cvt_pk_bf16(v1[0], v1[1]); w.w = pg8::cvt_pk_bf16(v1[2], v1[3]);
                    *(pg8::u32x4*)(rowp + bj * 128) = w; } }
    }
};
struct EpiRes {
    static constexpr bool PERM = false, HOOK = false;
    float* H; bf16* HB; unsigned long long* ssa;
    __device__ __forceinline__ void operator()(f32x4 (&acc)[2][2][4][2], const Unit& u, int wr, int wc, int fr, int fq) const {
        const int row0 = u.pm * 256 + wr * 64 + fr, col0 = u.pn * 256 + wc * 32 + 4 * fq;
#pragma unroll
        for (int ai = 0; ai < 2; ++ai)
#pragma unroll
            for (int m = 0; m < 4; ++m) { const int row = row0 + ai * 128 + m * 16; const size_t off = (size_t)row * D + col0; float s = 0.f;
#pragma unroll
                for (int bj = 0; bj < 2; ++bj)
#pragma unroll
                    for (int n = 0; n < 2; ++n) { const size_t o = off + bj * 128 + n * 16; const f32x4 h = *(const f32x4*)(H + o) + acc[ai][bj][m][n];
                        *(f32x4*)(H + o) = h; pg8::u32x2 w; w.x = pg8::cvt_pk_bf16(h[0], h[1]); w.y = pg8::cvt_pk_bf16(h[2], h[3]); *(pg8::u32x2*)(HB + o) = w;
                        s += (h[0] * h[0] + h[1] * h[1]) + (h[2] * h[2] + h[3] * h[3]); }
                { const int ln = fq * 16 + fr; s += shf(s, ln ^ 16); s += shf(s, ln ^ 32); }
                if (fq == 0) atomicAdd(ssa + row, (unsigned long long)((double)s * 4294967296.0)); }
    }
};
struct EpiQ {
    static constexpr bool PERM = true, HOOK = false;
    bf16* O; const unsigned long long* ssa;
    __device__ __forceinline__ void operator()(f32x4 (&acc)[2][2][4][2], const Unit& u, int wr, int wc, int fr, int fq) const {
        const int row0 = u.pm * 256 + wr * 64 + fr, col0 = u.pn * 256 + wc * 32 + 8 * fq;
#pragma unroll
        for (int ai = 0; ai < 2; ++ai)
#pragma unroll
            for (int m = 0; m < 4; ++m) { const int row = row0 + ai * 128 + m * 16; const float rs = rsqrtf(ssa_to_f(ssa[row]) * (1.0f / D) + EPS);
                bf16* rowp = O + (size_t)row * D + col0;
#pragma unroll
                for (int bj = 0; bj < 2; ++bj) { const f32x4 v0 = acc[ai][bj][m][0] * rs, v1 = acc[ai][bj][m][1] * rs;
                    pg8::u32x4 w; w.x = pg8::cvt_pk_bf16(v0[0], v0[1]); w.y = pg8::cvt_pk_bf16(v0[2], v0[3]); w.z = pg8::cvt_pk_bf16(v1[0], v1[1]); w.w = pg8::cvt_pk_bf16(v1[2], v1[3]);
                    *(pg8::u32x4*)(rowp + bj * 128) = w; } }
    }
};

__device__ __forceinline__ int colmap_in(int j) {
    if (j < 1536) return j;
    if (j < 5120) return j + 4;
    const int c = (j - 5120) & 255, T = (j - 5120) >> 8;
    const int g = 2 * (c >> 7) + ((c >> 2) & 1), d = 64 * T + 16 * ((c >> 5) & 3) + 4 * ((c >> 3) & 3) + (c & 3);
    return 5124 + g * 2048 + d;
}
template <bool MAP>
__device__ __forceinline__ void tr_item(const float* W, int ldw, const float* scale, bf16* WT, int ldt, int dcol0, LAS float* scr, int k0, int n0, int lane) {
    const int nn = lane & 31, sc = MAP ? colmap_in(n0 + nn) : (n0 + nn);
#pragma unroll 8
    for (int i = 0; i < 32; ++i) { const int kk = 2 * i + (lane >> 5); float v = W[(size_t)(k0 + kk) * ldw + sc]; if (scale) v *= scale[k0 + kk]; scr[kk * 33 + nn] = v; }
    asm volatile("s_waitcnt lgkmcnt(0)" ::: "memory");
    const int c = lane & 7;
#pragma unroll
    for (int j = 0; j < 4; ++j) { const int n = (lane >> 3) + 8 * j; const LAS float* s = scr + (8 * c) * 33 + n;
        v4u o; o.x = pk2(s[0 * 33], s[1 * 33]); o.y = pk2(s[2 * 33], s[3 * 33]); o.z = pk2(s[4 * 33], s[5 * 33]); o.w = pk2(s[6 * 33], s[7 * 33]);
        *(v4u*)(WT + (size_t)(n0 + n) * ldt + dcol0 + k0 + 8 * c) = o; }
    asm volatile("s_waitcnt lgkmcnt(0)" ::: "memory");
}
constexpr size_t WS_BAR = 512 * 1024;
#define XB_TMO      128
#define XB_XCNT(j)  (256  + 64 * (j))
#define XB_XSUB(j)  (1280 + 64 * (j))
#define XB_XGEN(j)  (2304 + 64 * (j))
#define XB_TOP      3328
#define XB_TOPGEN   3392
#define XCD_BAR_WORDS 3456
#define XB_SPIN_CAP (1u << 23)
__device__ __forceinline__ unsigned xb_ld(unsigned* p)              { return __hip_atomic_load(p, __ATOMIC_RELAXED, __HIP_MEMORY_SCOPE_AGENT); }
__device__ __forceinline__ unsigned xb_add(unsigned* p, unsigned v) { return __hip_atomic_fetch_add(p, v, __ATOMIC_RELAXED, __HIP_MEMORY_SCOPE_AGENT); }
__device__ __forceinline__ unsigned xb_xcc_id() { return (unsigned)__builtin_amdgcn_s_getreg((3 << 11) | 20) & 0xFu; }
#define XB_SPIN(cond, bar) do { unsigned _sp = 0; while (cond) { __builtin_amdgcn_s_sleep(1); \
    if ((++_sp & 255u) == 0u) { if (xb_ld(&(bar)[XB_TMO])) break; if (_sp > XB_SPIN_CAP) { atomicAdd(&(bar)[XB_TMO], 1u); break; } } } } while (0)
__device__ __forceinline__ void xcd_barrier_complete(unsigned* bar, unsigned x, unsigned G, unsigned& nloc, unsigned& nx) {
    unsigned sum, cnt, mine, sp = 0u;
    for (;;) {
        sum = 0u; cnt = 0u; mine = 0u;
#pragma unroll
        for (unsigned j = 0; j < 16; ++j) { const unsigned c = xb_ld(&bar[XB_XCNT(j)]); sum += c; cnt += (c > 0u) ? 1u : 0u; mine = (j == x) ? c : mine; }
        if (sum == G) break;
        __builtin_amdgcn_s_sleep(1);
        if ((++sp & 255u) == 0u) { if (xb_ld(&bar[XB_TMO])) break; if (sp > XB_SPIN_CAP) { atomicAdd(&bar[XB_TMO], 1u); break; } }
    }
    nloc = mine > 0u ? mine : 1u; nx = cnt > 0u ? cnt : 1u;
}
__device__ __forceinline__ void xcd_barrier(unsigned* bar, unsigned x, unsigned G, volatile LAS unsigned* st, int wave) {
    asm volatile("s_waitcnt vmcnt(0)" ::: "memory");
    __syncthreads();
    int lane; asm volatile("v_mbcnt_lo_u32_b32 %0, -1, 0\n\tv_mbcnt_hi_u32_b32 %0, -1, %0" : "=v"(lane));
    if (wave == 0 && lane == 0) {
        __builtin_amdgcn_s_waitcnt(0);
        unsigned nloc = st[0], nx = st[1];
        if (nloc == 0u) { xcd_barrier_complete(bar, x, G, nloc, nx); st[0] = nloc; st[1] = nx; }
        const unsigned old = xb_add(&bar[XB_XSUB(x)], 1u);
        const unsigned gen = old / nloc;
        if (old + 1u == (gen + 1u) * nloc) {
            __builtin_amdgcn_fence(__ATOMIC_RELEASE, "agent");
            asm volatile("s_waitcnt vmcnt(0)" ::: "memory");
            const unsigned og = xb_add(&bar[XB_TOP], 1u);
            const unsigned tg = og / nx;
            if (og + 1u == (tg + 1u) * nx) xb_add(&bar[XB_TOPGEN], 1u);
            else XB_SPIN(xb_ld(&bar[XB_TOPGEN]) == tg, bar);
            __builtin_amdgcn_fence(__ATOMIC_ACQUIRE, "agent");
            xb_add(&bar[XB_XGEN(x)], 1u);
            asm volatile("s_waitcnt vmcnt(0)" ::: "memory");
        } else {
            XB_SPIN(xb_ld(&bar[XB_XGEN(x)]) == gen, bar);
            __builtin_amdgcn_fence(__ATOMIC_ACQUIRE, "agent");
            asm volatile("s_waitcnt vmcnt(0)" ::: "memory");
        }
    }
    __syncthreads();
}
namespace att {
constexpr int D = 128, NW = 8, QBLK = 32, KVBLK = 64, QB = NW * QBLK;
constexpr int PITCH = 512, OPITCH = 2048;
constexpr float SCALE = 0.08838834764831845f, THR = 8.f;
constexpr int SHM_V = KVBLK * D * 2, SHM_K = KVBLK * D * 2;
constexpr int OFF_WS = 2 * SHM_V + 2 * SHM_K, OFF_CUM = OFF_WS + NW * 64 * 4, OFF_REL = OFF_CUM + 2048 * 4, LDS_END = OFF_REL + 320 * 4;
typedef unsigned short bf16;
typedef short bf16x8 __attribute__((ext_vector_type(8)));
typedef short s16x4 __attribute__((ext_vector_type(4)));
typedef float f32x16 __attribute__((ext_vector_type(16)));
typedef float f32x4 __attribute__((ext_vector_type(4)));
typedef unsigned u32x4 __attribute__((ext_vector_type(4)));
#define ALDS __attribute__((address_space(3)))

#define KSWZ(row, colB) ((row) * 256 + ((colB) ^ (((row) & 7) << 4)))
#define SBAR() __builtin_amdgcn_sched_barrier(0)
__device__ __forceinline__ int v_st(int k, int c) { const int kk = (k & ~0xC) | ((k & 4) << 1) | ((k & 8) >> 1); return ((kk >> 3) * 4 + (c >> 5)) * 512 + ((kk & 7) * 32 + (c & 31)) * 2; }
__device__ __forceinline__ int v_rd_base(int lane) { return ((lane & 3) << 3) | (((lane >> 2) & 3) << 6) | (((lane >> 4) & 1) << 5) | (((lane >> 5) & 1) << 8); }
constexpr int v_rd_off(int d0, int ks, int half) { return d0 * 512 + ks * 4096 + half * 2048; }
__device__ __forceinline__ int crow(int r, int hi) { return (r & 3) + 8 * (r >> 2) + 4 * hi; }
__device__ __forceinline__ unsigned cvtpk(float lo, float hi) { unsigned r; asm volatile("v_cvt_pk_bf16_f32 %0, %1, %2" : "=v"(r) : "v"(lo), "v"(hi)); return r; }
__device__ __forceinline__ bf16x8 load8(const bf16* p) { return *reinterpret_cast<const bf16x8*>(p); }

__device__ __forceinline__ void mask_tile(f32x16& p0, f32x16& p1, int dq) {
    const float NEG = -__builtin_inff();
#pragma unroll
    for (int r = 0; r < 16; ++r) { const int c = (r & 3) + 8 * (r >> 2);
        if (dq - c < 0) p0[r] = NEG;
        if (dq - c - 32 < 0) p1[r] = NEG; }
}
__device__ __forceinline__ void partialSM(f32x16& p0, f32x16& p1, float& m_reg, float& mn, float& alpha) {
    float pmax = p0[0];
#pragma unroll
    for (int r = 1; r < 16; ++r) pmax = fmaxf(pmax, p0[r]);
#pragma unroll
    for (int r = 0; r < 16; ++r) pmax = fmaxf(pmax, p1[r]);
    { auto rr = __builtin_amdgcn_permlane32_swap(__float_as_uint(pmax), __float_as_uint(pmax), false, false);
      pmax = fmaxf(__uint_as_float(rr[0]), __uint_as_float(rr[1])); }
    constexpr float C2 = 1.4426950408889634f * SCALE;
    if (__builtin_expect(__all((pmax - m_reg) * SCALE <= THR), 1)) { mn = m_reg; alpha = 1.f; }
    else { mn = fmaxf(m_reg, pmax); alpha = __builtin_amdgcn_exp2f((m_reg - mn) * C2); m_reg = mn; }
    const float mnL = -mn * C2;
#pragma unroll
    for (int r = 0; r < 16; ++r) p0[r] = fmaf(p0[r], C2, mnL);
#pragma unroll
    for (int r = 0; r < 16; ++r) p1[r] = fmaf(p1[r], C2, mnL);
#pragma unroll
    for (int r = 0; r < 16; ++r) p0[r] = __builtin_amdgcn_exp2f(p0[r]);
}
__device__ __forceinline__ void finishSM(f32x16& p0, f32x16& p1, float alpha, float& l_reg, bf16x8& pa0, bf16x8& pa1, bf16x8& pa2, bf16x8& pa3) {
#pragma unroll
    for (int r = 0; r < 16; ++r) p1[r] = __builtin_amdgcn_exp2f(p1[r]);
    float ps = 0;
#pragma unroll
    for (int r = 0; r < 16; ++r) ps += p0[r];
#pragma unroll
    for (int r = 0; r < 16; ++r) ps += p1[r];
    { auto rr = __builtin_amdgcn_permlane32_swap(__float_as_uint(ps), __float_as_uint(ps), false, false);
      ps = __uint_as_float(rr[0]) + __uint_as_float(rr[1]); }
    l_reg = l_reg * alpha + ps;
#define PK4(P, B_, OUT) do { unsigned a0 = cvtpk(P[B_+0], P[B_+1]), a1 = cvtpk(P[B_+2], P[B_+3]);                          \
        unsigned b0 = cvtpk(P[B_+4], P[B_+5]), b1 = cvtpk(P[B_+6], P[B_+7]);                                             \
        auto r0 = __builtin_amdgcn_permlane32_swap(a0, b0, false, false); auto r1 = __builtin_amdgcn_permlane32_swap(a1, b1, false, false); \
        u32x4 w = {r0[0], r1[0], r0[1], r1[1]}; OUT = *reinterpret_cast<bf16x8*>(&w); } while (0)
    PK4(p0, 0, pa0); PK4(p0, 8, pa1); PK4(p1, 0, pa2); PK4(p1, 8, pa3);
#undef PK4
}
template <int KB>
__device__ __forceinline__ void qkt(f32x16& p0, f32x16& p1, const ALDS char* K_lds, int r32, int hi, const bf16x8* qr, bool act) {
    if (!act) { const float NEG = -__builtin_inff();
#pragma unroll
        for (int r = 0; r < 16; ++r) { p0[r] = NEG; p1[r] = NEG; } return; }
    p0 = f32x16{}; p1 = f32x16{};
    const ALDS char* kb[4];
#pragma unroll
    for (int dd = 0; dd < 4; ++dd) kb[dd] = K_lds + KB * SHM_K + KSWZ(r32, (dd * 16 + hi * 8) * 2);
#pragma unroll
    for (int d0 = 0; d0 < 8; ++d0) { const ALDS char* a = kb[d0 & 3] + (d0 >> 2) * 128;
        bf16x8 b0 = *(const ALDS bf16x8*)(a);
        bf16x8 b1 = *(const ALDS bf16x8*)(a + 32 * 256);
        p0 = __builtin_amdgcn_mfma_f32_32x32x16_bf16(b0, qr[d0], p0, 0, 0, 0);
        p1 = __builtin_amdgcn_mfma_f32_32x32x16_bf16(b1, qr[d0], p1, 0, 0, 0); }
}
template <int VB>
__device__ __forceinline__ void pv_tile(f32x16* o, int vb0, bf16x8 pa0, bf16x8 pa1, bf16x8 pa2, bf16x8 pa3, bool act) {
    if (!act) return;
#define TRRD(dst, off) asm volatile("ds_read_b64_tr_b16 %0, %1 offset:%2" : "=&v"(dst) : "v"(vb0), "i"(off) : "memory")
#define PV_D0(d0) do { s16x4 l0, l1, l2, l3, h0, h1, h2, h3; constexpr int b_ = VB * SHM_V + v_rd_off(d0, 0, 0); \
        TRRD(l0, b_); TRRD(h0, b_ + 2048); TRRD(l1, b_ + 4096); TRRD(h1, b_ + 6144); TRRD(l2, b_ + 8192); TRRD(h2, b_ + 10240); TRRD(l3, b_ + 12288); TRRD(h3, b_ + 14336); \
        asm volatile("s_waitcnt lgkmcnt(0)" ::: "memory"); SBAR(); \
        o[d0] = __builtin_amdgcn_mfma_f32_32x32x16_bf16(pa0, (bf16x8){l0[0], l0[1], l0[2], l0[3], h0[0], h0[1], h0[2], h0[3]}, o[d0], 0, 0, 0);   \
        o[d0] = __builtin_amdgcn_mfma_f32_32x32x16_bf16(pa1, (bf16x8){l1[0], l1[1], l1[2], l1[3], h1[0], h1[1], h1[2], h1[3]}, o[d0], 0, 0, 0);   \
        o[d0] = __builtin_amdgcn_mfma_f32_32x32x16_bf16(pa2, (bf16x8){l2[0], l2[1], l2[2], l2[3], h2[0], h2[1], h2[2], h2[3]}, o[d0], 0, 0, 0);   \
        o[d0] = __builtin_amdgcn_mfma_f32_32x32x16_bf16(pa3, (bf16x8){l3[0], l3[1], l3[2], l3[3], h3[0], h3[1], h3[2], h3[3]}, o[d0], 0, 0, 0); } while (0)
    PV_D0(0); PV_D0(1); PV_D0(2); PV_D0(3);
#undef PV_D0
#undef TRRD
}
template <int MODE>
__device__ __forceinline__ void bias_mask(f32x16& p0, f32x16& p1, const ALDS char* lds, int kb, int qlo, int qpos, int hi, float cqs, bool act) {
    if (!act) return;
    if (MODE == 0) {
        const ALDS float* cs = (const ALDS float*)(lds + OFF_CUM) + kb + 4 * hi;
#pragma unroll
        for (int g = 0; g < 4; ++g) { const f32x4 c0 = *(const ALDS f32x4*)(cs + 8 * g), c1 = *(const ALDS f32x4*)(cs + 32 + 8 * g);
#pragma unroll
            for (int e = 0; e < 4; ++e) { p0[4 * g + e] += cqs - c0[e]; p1[4 * g + e] += cqs - c1[e]; } }
        if (kb + KVBLK - 1 > qlo) mask_tile(p0, p1, qpos - 4 * hi - kb);
    } else {
        const ALDS float* tb = (const ALDS float*)(lds + OFF_REL);
        if (qlo - (kb + KVBLK - 1) >= 256) { const float c = tb[319];
#pragma unroll
            for (int r = 0; r < 16; ++r) { p0[r] += c; p1[r] += c; } }
        else { const int d0 = qpos - kb - 4 * hi + 63;
#pragma unroll
            for (int r = 0; r < 16; ++r) { const int c = (r & 3) + 8 * (r >> 2);
                int i0 = d0 - c, i1 = d0 - c - 32; i0 = i0 > 319 ? 319 : i0; i1 = i1 > 319 ? 319 : i1; i1 = i1 < 0 ? 0 : i1; i0 = i0 < 0 ? 0 : i0;
                p0[r] += tb[i0]; p1[r] += tb[i1]; } }
    }
}

struct Seam { bf16x8 qr[8]; bf16x8 st_v0, st_v1, st_k0, st_k1; };
#define VMW() asm volatile("s_waitcnt vmcnt(0)" ::: "memory")
#define BL8(rs, vo, so) __builtin_bit_cast(bf16x8, __builtin_amdgcn_raw_buffer_load_b128(rs, vo, so, 0))
#define SLOAD_H(Kp, Vp, k0) do { S.st_v0 = BL8(rP, kvoff, (Vp) + (k0) * (PITCH * 2)); S.st_v1 = BL8(rP, kvoff, (Vp) + ((k0) + 32) * (PITCH * 2));              \
                         S.st_k0 = BL8(rP, kvoff, (Kp) + (k0) * (PITCH * 2)); S.st_k1 = BL8(rP, kvoff, (Kp) + ((k0) + 32) * (PITCH * 2)); } while (0)
#define SWRITE_HK(bf) do { *(ALDS bf16x8*)(K_lds + (bf) * SHM_K + kws) = S.st_k0; *(ALDS bf16x8*)(K_lds + (bf) * SHM_K + kws + 32 * 256) = S.st_k1; } while (0)
#define SWRITE_HV(bf) do { *(ALDS bf16x8*)(V_lds + (bf) * SHM_V + vst0) = S.st_v0; *(ALDS bf16x8*)(V_lds + (bf) * SHM_V + vst1) = S.st_v1; } while (0)
#define SWRITE_H(bf) do { SWRITE_HV(bf); SWRITE_HK(bf); } while (0)

template <int MODE>
__device__ __forceinline__ void attn_unit(const bf16* Pb, int Qo, int Kh, int Vh, bf16* Yb, int Oo, int P0, int j_lo, int j_hi, ALDS char* lds, int wid, int lane) {
    const int tid = wid * 64 + lane, r32 = lane & 31, hi = lane >> 5;
    const int NT = j_hi - j_lo;
    const int qlo = P0 + wid * QBLK, qpos = qlo + r32;
    ALDS char* V_lds = lds; ALDS char* K_lds = lds + 2 * SHM_V;
    ALDS float* ws = (ALDS float*)(lds + OFF_WS) + wid * 64; ALDS float* li_l = ws; ALDS float* al_l = ws + 32;
    float m_reg = -1e30f, l_reg = 0; f32x16 o[4] = {};
    const int sr = tid >> 4, sc = (tid & 15) * 8, vst0 = v_st(sr, sc), vst1 = v_st(32 + sr, sc), kws = KSWZ(sr, sc * 2);
    const int vb0 = (int)(unsigned)(size_t)V_lds + v_rd_base(lane);
    Seam S;
    const __amdgpu_buffer_rsrc_t rP = __builtin_amdgcn_make_buffer_rsrc((void*)Pb, 0, 0x7fffffff, 0x00020000);
    const __amdgpu_buffer_rsrc_t rO = __builtin_amdgcn_make_buffer_rsrc((void*)Yb, 0, 0x7fffffff, 0x00020000);
    const int kvoff = (sr * PITCH + sc) * 2;
#define KBASE(t) ((j_lo + (t)) * KVBLK)
#define ACT(t) (MODE == 0 ? (KBASE(t) <= qlo + QBLK - 1) : ((j_lo + (t)) <= (qlo >> 6) && (j_lo + (t)) + 8 >= (qlo >> 6)))
#define RESC(a) do { if (__any((a) < 1.f)) { if (hi == 0) al_l[r32] = (a); asm volatile("s_waitcnt lgkmcnt(0)" ::: "memory");              \
                     for (int d_ = 0; d_ < 4; ++d_) for (int r = 0; r < 16; ++r) o[d_][r] *= al_l[crow(r, hi)]; } } while (0)
#define MASKT(P0_, P1_, t) bias_mask<MODE>(P0_, P1_, lds, KBASE(t), qlo, qpos, hi, cq_, ACT(t))
    {
        const int kb0 = j_lo * KVBLK;
#pragma unroll
        for (int d0 = 0; d0 < 8; ++d0) S.qr[d0] = BL8(rP, (r32 * PITCH + hi * 8) * 2 + d0 * 32, Qo + wid * (QBLK * PITCH * 2));
        SLOAD_H(Kh, Vh, kb0); VMW(); SWRITE_HK(0);
        __syncthreads();
    }
    const float cq_ = MODE == 0 ? ((const ALDS float*)(lds + OFF_CUM))[qpos] : 0.f;
    f32x16 pA0, pA1, pB0, pB1; float mnA, mnB, alA, alB; bf16x8 pa0, pa1, pa2, pa3;
    SWRITE_HV(0); SBAR();
    if (NT > 1) { SLOAD_H(Kh, Vh, KBASE(1)); }
    SBAR(); qkt<0>(pA0, pA1, K_lds, r32, hi, S.qr, ACT(0));
    MASKT(pA0, pA1, 0); partialSM(pA0, pA1, m_reg, mnA, alA);
    if (NT > 1) { VMW(); SWRITE_H(1); }
    __syncthreads();
#define HALF_STEP(PX0, PX1, mnX, alX, PY0, PY1, alY, t, KB, VB, SB) do {                                                      \
        SBAR(); qkt<KB>(PX0, PX1, K_lds, r32, hi, S.qr, ACT(t));                                                              \
        finishSM(PY0, PY1, alY, l_reg, pa0, pa1, pa2, pa3); SBAR();                                                           \
        if ((t) + 1 < NT) { SLOAD_H(Kh, Vh, KBASE((t) + 1)); SBAR(); }                                                        \
        pv_tile<VB>(o, vb0, pa0, pa1, pa2, pa3, ACT((t) - 1)); MASKT(PX0, PX1, (t)); partialSM(PX0, PX1, m_reg, mnX, alX);    \
        __syncthreads();                                                                                                      \
        if ((t) + 1 < NT) { VMW(); SWRITE_H(SB); }                                                                            \
        RESC(alX); __syncthreads(); } while (0)
    for (int t = 1; t + 1 < NT; t += 2) {
        HALF_STEP(pB0, pB1, mnB, alB, pA0, pA1, alA, t, 1, 0, 0);
        HALF_STEP(pA0, pA1, mnA, alA, pB0, pB1, alB, t + 1, 0, 1, 1);
    }
    const bool even = (NT & 1) == 0;
    if (even) { SBAR(); qkt<1>(pB0, pB1, K_lds, r32, hi, S.qr, ACT(NT - 1)); SBAR(); }
    finishSM(pA0, pA1, alA, l_reg, pa0, pa1, pa2, pa3); SBAR();
    pv_tile<0>(o, vb0, pa0, pa1, pa2, pa3, ACT(even ? NT - 2 : NT - 1));
    if (even) { MASKT(pB0, pB1, NT - 1); partialSM(pB0, pB1, m_reg, mnB, alB); __syncthreads(); RESC(alB);
        finishSM(pB0, pB1, alB, l_reg, pa0, pa1, pa2, pa3); SBAR(); pv_tile<1>(o, vb0, pa0, pa1, pa2, pa3, ACT(NT - 1)); }
    SBAR();
    if (hi == 0) li_l[r32] = l_reg; asm volatile("s_waitcnt lgkmcnt(0)" ::: "memory");
    float rli[16];
#pragma unroll
    for (int r = 0; r < 16; ++r) rli[r] = __builtin_amdgcn_rcpf(li_l[crow(r, hi)]);
    const int ovoff = (4 * hi * OPITCH + r32) * 2, osoff = Oo + wid * (QBLK * OPITCH * 2);
#pragma unroll
    for (int r = 0; r < 16; ++r) { const int orow = (r & 3) + 8 * (r >> 2);
#pragma unroll
        for (int d0 = 0; d0 < 4; ++d0) { const float v = o[d0][r] * rli[r];
            const float vn = __builtin_bit_cast(float, __builtin_amdgcn_ds_bpermute((lane ^ 1) << 2, __builtin_bit_cast(int, v)));
            if ((r32 & 1) == 0) __builtin_amdgcn_raw_buffer_store_b32(cvtpk(v, vn), rO, ovoff + d0 * 64, osoff + orow * (OPITCH * 2), 0); } }
    __syncthreads();
#undef RESC
#undef KBASE
#undef ACT
#undef MASKT
#undef HALF_STEP
}
#undef BL8
#undef VMW
#undef SLOAD_H
#undef SWRITE_HK
#undef SWRITE_HV
#undef SWRITE_H
#undef KSWZ
#undef SBAR
}
constexpr size_t WS_QCTR = 768 * 1024;
constexpr size_t WS_POOLW = 4 * MiB;
constexpr int N_ATT_UNITS = 256, N_POOL_UNITS = 512, N_CONV_UNITS = 128;

__device__ __forceinline__ void stage_cum(const Args& a, int b, int h, LAS char* lds, int wave, int lane) {
    const float* logf = (const float*)(a.ws + WS_LOGF) + ((size_t)b * SEQ) * 4 + h;
    const int tid = wave * 64 + lane;
    float v[4];
#pragma unroll
    for (int e = 0; e < 4; ++e) v[e] = logf[(size_t)(4 * tid + e) * 4];
    v[1] += v[0]; v[2] += v[1]; v[3] += v[2];
    float incl = v[3];
#pragma unroll
    for (int o = 1; o < 64; o <<= 1) { const float t = shf(incl, lane >= o ? lane - o : lane); if (lane >= o) incl += t; }
    LAS float* wt = (LAS float*)(lds + att::OFF_WS);
    if (lane == 63) wt[wave] = incl;
    __syncthreads();
    float base = incl - v[3];
    for (int w = 0; w < wave; ++w) base += wt[w];
    LAS float* cs = (LAS float*)(lds + att::OFF_CUM);
    const float inv = 1.0f / ATT_SCALE;
    *(LAS f32x4*)(cs + 4 * tid) = (f32x4){(base + v[0]) * inv, (base + v[1]) * inv, (base + v[2]) * inv, (base + v[3]) * inv};
    __syncthreads();
}
__device__ __forceinline__ void attention_item(const Args& a, int l, int u, LAS char* lds, int wave) {
    int lane; asm volatile("v_mbcnt_lo_u32_b32 %0, -1, 0\n\tv_mbcnt_hi_u32_b32 %0, -1, %0" : "=v"(lane));
    const bf16* P = (const bf16*)(a.ws + WS_PROJ); bf16* Y = (bf16*)(a.ws + WS_Y);
    const int mode = u >> 7, v = u & 127, qb = 7 - (v >> 4), bh = v & 15, b = bh >> 2, h = bh & 3;
    const size_t row0 = (size_t)b * SEQ; const int P0 = qb * 256;
    if (mode == 0) {
        stage_cum(a, b, h, lds, wave, lane);
        att::attn_unit<0>(P, (int)((0 * PROJ_T + (row0 + P0) * MIXW + h * HD) * 2), (int)((1 * PROJ_T + row0 * MIXW + h * HD) * 2), (int)((2 * PROJ_T + row0 * MIXW + h * HD) * 2),
                          Y, (int)(((row0 + P0) * D + h * HD) * 2), P0, 0, 4 * qb + 4, lds, wave, lane);
    } else {
        const int tid = wave * 64 + lane;
        if (tid < 320) ((LAS float*)(lds + att::OFF_REL))[tid] = a.rel_bias[((size_t)l * 4 + h) * 320 + tid] * (1.0f / ATT_SCALE);
        const int jlo = 4 * qb - 8 < 0 ? 0 : 4 * qb - 8;
        att::attn_unit<1>(P, (int)((7 * PROJ_T + (row0 + P0) * MIXW + h * HD) * 2), (int)((8 * PROJ_T + row0 * MIXW + h * HD) * 2), (int)((9 * PROJ_T + row0 * MIXW + h * HD) * 2),
                          Y, (int)(((row0 + P0) * D + 1536 + h * HD) * 2), P0, jlo, 4 * qb + 4, lds, wave, lane);
    }
}
__device__ __forceinline__ void pool_item(const Args& a, int l, int u, LAS char* lds, int wave) {
    int lane; asm volatile("v_mbcnt_lo_u32_b32 %0, -1, 0\n\tv_mbcnt_hi_u32_b32 %0, -1, %0" : "=v"(lane));
    const int g = u & 3, T0 = (u >> 2) * 64, tid = wave * 64 + lane;
    const bf16* Pin = (const bf16*)(a.ws + WS_PROJ) + 3 * PROJ_T + g * 128;
    {
        const int cp = tid & 63, run = tid >> 6, w = 2 << g, t0 = T0 + run * 8, s0 = t0 & (SEQ - 1);
        const bf16* col = Pin + 2 * cp;
        float s_lo = 0.f, s_hi = 0.f;
        for (int j = 1; j < w; ++j) if (s0 - j >= 0) { const unsigned x = *(const unsigned*)(col + (size_t)(t0 - j) * MIXW); s_lo += bflo(x); s_hi += bfhi(x); }
#pragma unroll
        for (int i = 0; i < 8; ++i) { const unsigned x = *(const unsigned*)(col + (size_t)(t0 + i) * MIXW); s_lo += bflo(x); s_hi += bfhi(x);
            const int s = s0 + i; const int cnt = s + 1 < w ? s + 1 : w; const float inv = 1.0f / (float)cnt;
            *(LAS unsigned*)(lds + (run * 8 + i) * 272 + 4 * cp) = pk2(s_lo * inv - bflo(x), s_hi * inv - bfhi(x));
            if (s - w + 1 >= 0) { const unsigned y = *(const unsigned*)(col + (size_t)(t0 + i - w + 1) * MIXW); s_lo -= bflo(y); s_hi -= bfhi(y); } }
    }
    __syncthreads();
    {
        typedef short bf16x8 __attribute__((ext_vector_type(8)));
        const bf16* Wt = (const bf16*)(a.ws + WS_POOLW) + ((size_t)l * 4 + g) * 128 * 128;
        const int rt = (wave & 3) * 16, db = (wave >> 2) * 64, fr = lane & 15, kg = lane >> 4;
        f32x4 acc[4] = {};
#pragma unroll
        for (int ks = 0; ks < 4; ++ks) { const bf16x8 af = *(const LAS bf16x8*)(lds + (rt + fr) * 272 + (ks * 32 + kg * 8) * 2);
#pragma unroll
            for (int nt = 0; nt < 4; ++nt) { const bf16x8 bfr = *(const bf16x8*)(Wt + (size_t)(db + nt * 16 + fr) * 128 + ks * 32 + kg * 8);
                acc[nt] = __builtin_amdgcn_mfma_f32_16x16x32_bf16(bfr, af, acc[nt], 0, 0, 0); } }
        bf16* Y = (bf16*)(a.ws + WS_Y) + (size_t)(T0 + rt + fr) * D + 512 + g * 128;
#pragma unroll
        for (int nt = 0; nt < 4; ++nt) { const int d = db + nt * 16 + kg * 4; const f32x4 sc = *(const f32x4*)(a.pool_scale + l * MIXW + g * 128 + d);
            v2u w; w.x = pk2(acc[nt][0] * sc[0], acc[nt][1] * sc[1]); w.y = pk2(acc[nt][2] * sc[2], acc[nt][3] * sc[3]); *(v2u*)(Y + d) = w; }
    }
    __syncthreads();
}
__device__ __forceinline__ void conv_item(const Args& a, int l, int u, int wave) {
    int lane; asm volatile("v_mbcnt_lo_u32_b32 %0, -1, 0\n\tv_mbcnt_hi_u32_b32 %0, -1, %0" : "=v"(lane));
    const bf16* P = (const bf16*)(a.ws + WS_PROJ); const bf16* Ch = P + 4 * PROJ_T; const bf16* Cb = P + 5 * PROJ_T; const bf16* Cc = P + 6 * PROJ_T;
    const int tid = wave * 64 + lane, c0 = (tid & 63) * 8, t0 = u * 64 + (tid >> 6) * 8, s0 = t0 & (SEQ - 1);
    float wgt[3][8];
#pragma unroll
    for (int j = 0; j < 3; ++j) { const float* w = a.conv_w + ((size_t)l * 3 + j) * MIXW + c0; const f32x4 w0 = *(const f32x4*)w, w1 = *(const f32x4*)(w + 4);
#pragma unroll
        for (int k = 0; k < 4; ++k) { wgt[j][k] = w0[k]; wgt[j][4 + k] = w1[k]; } }
    float z2[8], z1[8];
#pragma unroll
    for (int k = 0; k < 8; ++k) { z2[k] = 0.f; z1[k] = 0.f; }
#pragma unroll
    for (int i = -2; i < 8; ++i) {
        float z[8];
        if (s0 + i >= 0) { const v4u hv = *(const v4u*)(Ch + (size_t)(t0 + i) * MIXW + c0), cv = *(const v4u*)(Cc + (size_t)(t0 + i) * MIXW + c0);
            z[0] = bflo(hv.x) * bflo(cv.x); z[1] = bfhi(hv.x) * bfhi(cv.x); z[2] = bflo(hv.y) * bflo(cv.y); z[3] = bfhi(hv.y) * bfhi(cv.y);
            z[4] = bflo(hv.z) * bflo(cv.z); z[5] = bfhi(hv.z) * bfhi(cv.z); z[6] = bflo(hv.w) * bflo(cv.w); z[7] = bfhi(hv.w) * bfhi(cv.w); }
        else {
#pragma unroll
            for (int k = 0; k < 8; ++k) z[k] = 0.f; }
        if (i >= 0) { const v4u bv = *(const v4u*)(Cb + (size_t)(t0 + i) * MIXW + c0); float o[8];
            const float bb[8] = {bflo(bv.x), bfhi(bv.x), bflo(bv.y), bfhi(bv.y), bflo(bv.z), bfhi(bv.z), bflo(bv.w), bfhi(bv.w)};
#pragma unroll
            for (int k = 0; k < 8; ++k) o[k] = bb[k] * (wgt[0][k] * z2[k] + wgt[1][k] * z1[k] + wgt[2][k] * z[k]);
            v4u ov; ov.x = pk2(o[0], o[1]); ov.y = pk2(o[2], o[3]); ov.z = pk2(o[4], o[5]); ov.w = pk2(o[6], o[7]);
            *(v4u*)((bf16*)(a.ws + WS_Y) + (size_t)(t0 + i) * D + 1024 + c0) = ov; }
#pragma unroll
        for (int k = 0; k < 8; ++k) { z2[k] = z1[k]; z1[k] = z[k]; }
    }
}
__device__ __forceinline__ void mixers_fast(const Args& a, int lq, LAS char* lds, int wave, int lane, int G, int blk) {
    const int l = lq & 1;
    for (int u = blk; u < N_ATT_UNITS; u += G) attention_item(a, l, u, lds, wave);
    unsigned* head = (unsigned*)(a.ws + WS_QCTR) + 64 * lq;
    volatile LAS unsigned* slot = (volatile LAS unsigned*)(lds + att::LDS_END);
    for (;;) {
        if (wave == 0 && lane == 0) *slot = __hip_atomic_fetch_add(head, 1u, __ATOMIC_RELAXED, __HIP_MEMORY_SCOPE_AGENT);
        __syncthreads();
        const unsigned it = *slot;
        __syncthreads();
        if (it >= (unsigned)(N_POOL_UNITS + N_CONV_UNITS)) break;
        if (it < (unsigned)N_POOL_UNITS) pool_item(a, l, (int)it, lds, wave); else conv_item(a, l, (int)it - N_POOL_UNITS, wave);
    }
}
__device__ __forceinline__ void p0_prologue(const Args& a, LAS unsigned char* lds, int gw, int NGW, int wave, int lane) {
    unsigned char* ws = a.ws;
    LAS float* scr = (LAS float*)(lds + wave * 16384);
    constexpr int I_WIN = (D / 64) * (NPROJ / 32), I_SQ = (D / 64) * (D / 32), I_BR = (MIXW / 64) * (D / 32);
    constexpr int I_LAYER = I_WIN + 4 * I_BR + 2 * I_SQ;
    for (int it = gw; it < DEPTH * I_LAYER; it += NGW) {
        const int l = it / I_LAYER; int r = it - l * I_LAYER;
        if (r < I_WIN) { const int kb = r / (NPROJ / 32), nb = r % (NPROJ / 32);
            tr_item<true>(a.w_in + (size_t)l * D * INW, INW, a.norm_mix + l * D, (bf16*)(ws + WS_WIN + l * WIN_BYTES), D, 0, scr, 64 * kb, 32 * nb, lane); continue; }
        r -= I_WIN;
        if (r < 4 * I_BR) { const int g = r / I_BR, rr = r % I_BR, kb = rr / (D / 32), nb = rr % (D / 32);
            tr_item<false>(a.w_branch + ((size_t)l * 4 + g) * MIXW * D, D, nullptr, (bf16*)(ws + WS_WBR + l * SQ_BYTES), D, g * MIXW, scr, 64 * kb, 32 * nb, lane); continue; }
        r -= 4 * I_BR;
        if (r < I_SQ) { const int kb = r / (D / 32), nb = r % (D / 32);
            tr_item<false>(a.w_out + (size_t)l * D * D, D, nullptr, (bf16*)(ws + WS_WOUT + l * SQ_BYTES), D, 0, scr, 64 * kb, 32 * nb, lane); continue; }
        r -= I_SQ;
        { const int kb = r / (D / 32), nb = r % (D / 32);
            tr_item<false>(a.peer_wq + (size_t)l * D * D, D, a.norm_ffn + l * D, (bf16*)(ws + WS_WQ + l * SQ_BYTES), D, 0, scr, 64 * kb, 32 * nb, lane); }
    }
    for (int it = gw; it < DEPTH * 4 * 8; it += NGW) { const int lg = it >> 3, r = it & 7;
        tr_item<false>(a.pool_w + (size_t)lg * 128 * 128, 128, nullptr, (bf16*)(ws + WS_POOLW) + (size_t)lg * 128 * 128, 128, 0, scr, 64 * (r >> 2), 32 * (r & 3), lane); }
    for (int r = gw; r < 2 * DEPTH * PEER_E; r += NGW) { const int t = r / (DEPTH * PEER_E), row = r - t * (DEPTH * PEER_E);
        const float* src = (t ? a.peer_v : a.peer_u) + (size_t)row * D + 4 * lane;
        f32x4 v[8]; float am = 0.f;
#pragma unroll
        for (int j = 0; j < 8; ++j) { v[j] = *(const f32x4*)(src + 256 * j); am = fmaxf(am, fmaxf(fmaxf(fabsf(v[j][0]), fabsf(v[j][1])), fmaxf(fabsf(v[j][2]), fabsf(v[j][3])))); }
        am = wave_max(am, lane);
        const float inv = am > 0.f ? 127.0f / am : 0.f, off = t ? 128.f : 0.f;
        unsigned char* dst = ws + (t ? WS_PV : WS_PU) + (size_t)row * D + 4 * lane;
#pragma unroll
        for (int j = 0; j < 8; ++j) { const int q0 = (int)(rintf(v[j][0] * inv) + off), q1 = (int)(rintf(v[j][1] * inv) + off), q2 = (int)(rintf(v[j][2] * inv) + off), q3 = (int)(rintf(v[j][3] * inv) + off);
            *(unsigned*)(dst + 256 * j) = (unsigned)(q0 & 255) | ((unsigned)(q1 & 255) << 8) | ((unsigned)(q2 & 255) << 16) | ((unsigned)(q3 & 255) << 24); }
        if (lane == 0) ((float*)(ws + (t ? WS_SV : WS_SU)))[row] = am * (1.0f / 127.0f); }
    { bf16* pk = (bf16*)(ws + WS_PK); const size_t n8 = (size_t)DEPTH * 8 * 2 * 128 * 128 / 8;
      for (size_t i = (size_t)gw * 64 + lane; i < n8; i += (size_t)NGW * 64) { const f32x4 v0 = *(const f32x4*)(a.peer_keys + i * 8), v1 = *(const f32x4*)(a.peer_keys + i * 8 + 4);
          v4u o; o.x = pk2(v0[0], v0[1]); o.y = pk2(v0[2], v0[3]); o.z = pk2(v1[0], v1[1]); o.w = pk2(v1[2], v1[3]); *(v4u*)(pk + i * 8) = o; } }
    {
        float* wf = (float*)(ws + WS_WF); float* binr = (float*)(ws + WS_BINR);
        const int gt = gw * 64 + lane, NGT = NGW * 64;
        for (int i = gt; i < DEPTH * 4 * D; i += NGT) { const int l = i / (4 * D), h = (i / D) & 3, k = i % D; wf[i] = a.w_in[(size_t)l * D * INW + (size_t)k * INW + 1536 + h] * a.norm_mix[l * D + k]; }
        for (int i = gt; i < DEPTH * NPROJ; i += NGT) { const int l = i / NPROJ, j = i % NPROJ; binr[i] = a.b_in[l * INW + colmap_in(j)]; }
    }
    {
        float* H = (float*)(ws + WS_H); bf16* HB = (bf16*)(ws + WS_HB); float* ssq = (float*)(ws + WS_SSQ);
        for (int m = gw; m < M; m += NGW) { float s = 0.f;
#pragma unroll
            for (int j = 0; j < 8; ++j) { const size_t o = (size_t)m * D + j * 256 + lane * 4; const f32x4 v = *(const f32x4*)(a.x + o); *(f32x4*)(H + o) = v;
                v2u w; w.x = pk2(v[0], v[1]); w.y = pk2(v[2], v[3]); *(v2u*)(HB + o) = w; s += (v[0] * v[0] + v[1] * v[1]) + (v[2] * v[2] + v[3] * v[3]); }
            s = wave_sum(s, lane); if (lane == 0) ssq[m] = s; }
    }
}

__device__ __forceinline__ void forget_logits(const Args& a, int l, int gw, int NGW, int lane) {
    unsigned char* ws = a.ws; const bf16* HB = (const bf16*)(ws + WS_HB); const float* wf = (const float*)(ws + WS_WF) + l * 4 * D; const float* ssq = (const float*)(ws + WS_SSQ) + l * M;
    float* logf = (float*)(ws + WS_LOGF);
    for (int m = gw; m < M; m += NGW) {
        float d[4] = {0.f, 0.f, 0.f, 0.f};
#pragma unroll
        for (int j = 0; j < 4; ++j) { const int k0 = j * 512 + lane * 8; const v4u xv = *(const v4u*)(HB + (size_t)m * D + k0);
            const float x[8] = {bflo(xv.x), bfhi(xv.x), bflo(xv.y), bfhi(xv.y), bflo(xv.z), bfhi(xv.z), bflo(xv.w), bfhi(xv.w)};
#pragma unroll
            for (int h = 0; h < 4; ++h) { const f32x4 w0 = *(const f32x4*)(wf + h * D + k0), w1 = *(const f32x4*)(wf + h * D + k0 + 4);
                d[h] += x[0] * w0[0] + x[1] * w0[1] + x[2] * w0[2] + x[3] * w0[3] + x[4] * w1[0] + x[5] * w1[1] + x[6] * w1[2] + x[7] * w1[3]; } }
        const float rs = rsqrtf(ssq[m] * (1.0f / D) + EPS);
#pragma unroll
        for (int h = 0; h < 4; ++h) { const float z = wave_sum(d[h], lane) * rs + a.b_in[l * INW + 1536 + h];
            const float ls = fminf(z, 0.f) - log1pf(__expf(-fabsf(z)));
            if (lane == h) logf[m * 4 + h] = ls; }
    }
}
__device__ __forceinline__ void cum_scan(const Args& a, int gw, int lane) {
    if (gw >= 16) return;
    const float* logf = (const float*)(a.ws + WS_LOGF); float* cum = (float*)(a.ws + WS_CUM);
    const int b = gw >> 2, h = gw & 3; float run = 0.f;
    for (int c = 0; c < SEQ / 64; ++c) { float v = logf[(size_t)(b * SEQ + c * 64 + lane) * 4 + h];
#pragma unroll
        for (int o = 1; o < 64; o <<= 1) { const float t = shf(v, lane >= o ? lane - o : lane); if (lane >= o) v += t; }
        v += run; cum[(size_t)gw * SEQ + c * 64 + lane] = v; run = shf(v, 63); }
}

template <int MODE>
__device__ __forceinline__ void naive_attn(const Args& a, int l, int b, int h, int s, LAS float* sc, int lane) {
    const unsigned char* ws = a.ws; const bf16* P = (const bf16*)(ws + WS_PROJ);
    const bf16* Qp = P + (MODE ? 7 : 0) * PROJ_T; const bf16* Kp = P + (MODE ? 8 : 1) * PROJ_T; const bf16* Vp = P + (MODE ? 9 : 2) * PROJ_T;
    const float* cum = (const float*)(ws + WS_CUM) + (size_t)(b * 4 + h) * SEQ;
    const float* rb = a.rel_bias + ((size_t)l * 4 + h) * 320;
    const size_t tb = (size_t)b * SEQ;
    int klo = 0, khi = s;
    if (MODE) { const int c = s >> 6; klo = (c - 8) * 64; if (klo < 0) klo = 0; khi = c * 64 + 63; }
    const bf16* qrow = Qp + (tb + s) * MIXW + h * HD;
    float mx = -3.0e38f;
    for (int kb = klo; kb <= khi; kb += 64) { const int k = kb + lane;
        if (k <= khi) { const bf16* krow = Kp + (tb + k) * MIXW + h * HD; float d = 0.f;
#pragma unroll 4
            for (int c8 = 0; c8 < 16; ++c8) { const v4u qv = *(const v4u*)(qrow + c8 * 8), kv = *(const v4u*)(krow + c8 * 8);
                d = dot2_bf16(qv.x, kv.x, d); d = dot2_bf16(qv.y, kv.y, d); d = dot2_bf16(qv.z, kv.z, d); d = dot2_bf16(qv.w, kv.w, d); }
            float bias;
            if (MODE == 0) bias = cum[s] - cum[k];
            else { int rel = s - k; rel = rel < -63 ? -63 : (rel > 256 ? 256 : rel); bias = rb[rel + 63]; }
            const float lg = d * ATT_SCALE + bias; sc[k - klo] = lg; mx = fmaxf(mx, lg); } }
    mx = wave_max(mx, lane);
    asm volatile("s_waitcnt lgkmcnt(0)" ::: "memory");
    float sum = 0.f;
    for (int kb = klo; kb <= khi; kb += 64) { const int k = kb + lane; if (k <= khi) { const float p = __expf(sc[k - klo] - mx); sc[k - klo] = p; sum += p; } }
    sum = wave_sum(sum, lane);
    asm volatile("s_waitcnt lgkmcnt(0)" ::: "memory");
    float o0 = 0.f, o1 = 0.f;
    for (int k = klo; k <= khi; ++k) { const float p = sc[k - klo]; const unsigned v = *(const unsigned*)(Vp + (tb + k) * MIXW + h * HD + 2 * lane); o0 += p * bflo(v); o1 += p * bfhi(v); }
    const float inv = 1.0f / sum;
    bf16* Y = (bf16*)(a.ws + WS_Y);
    *(unsigned*)(Y + (tb + s) * D + (MODE ? 1536 : 0) + h * HD + 2 * lane) = pk2(o0 * inv, o1 * inv);
    asm volatile("s_waitcnt lgkmcnt(0)" ::: "memory");
}
__device__ __forceinline__ void naive_pool(const Args& a, int l, int t, int g, LAS float* sc, int lane) {
    const bf16* Pin = (const bf16*)(a.ws + WS_PROJ) + 3 * PROJ_T;
    const int s = t & (SEQ - 1), w = 2 << g; const int cnt = (s + 1 < w) ? s + 1 : w;
    float s0 = 0.f, s1 = 0.f;
    for (int j = 0; j < cnt; ++j) { const unsigned v = *(const unsigned*)(Pin + (size_t)(t - j) * MIXW + g * 128 + 2 * lane); s0 += bflo(v); s1 += bfhi(v); }
    const unsigned v0 = *(const unsigned*)(Pin + (size_t)t * MIXW + g * 128 + 2 * lane);
    const float inv = 1.0f / (float)cnt;
    sc[2 * lane] = s0 * inv - bflo(v0); sc[2 * lane + 1] = s1 * inv - bfhi(v0);
    asm volatile("s_waitcnt lgkmcnt(0)" ::: "memory");
    const float* W = a.pool_w + ((size_t)l * 4 + g) * 128 * 128;
    float o0 = 0.f, o1 = 0.f;
    for (int c = 0; c < 128; ++c) { const float p = sc[c]; const f32x2 wv = *(const f32x2*)(W + c * 128 + 2 * lane); o0 += p * wv[0]; o1 += p * wv[1]; }
    const f32x2 ps = *(const f32x2*)(a.pool_scale + l * MIXW + g * 128 + 2 * lane);
    bf16* Y = (bf16*)(a.ws + WS_Y);
    *(unsigned*)(Y + (size_t)t * D + 512 + g * 128 + 2 * lane) = pk2(o0 * ps[0], o1 * ps[1]);
    asm volatile("s_waitcnt lgkmcnt(0)" ::: "memory");
}
__device__ __forceinline__ void naive_conv(const Args& a, int l, int t, int lane) {
    const bf16* P = (const bf16*)(a.ws + WS_PROJ); const bf16* Ch = P + 4 * PROJ_T; const bf16* Cb = P + 5 * PROJ_T; const bf16* Cc = P + 6 * PROJ_T;
    const int s = t & (SEQ - 1), c0 = lane * 8;
    float acc[8] = {0.f, 0.f, 0.f, 0.f, 0.f, 0.f, 0.f, 0.f};
#pragma unroll
    for (int j = 0; j < 3; ++j) { const int dt = 2 - j;
        if (s - dt >= 0) { const v4u hv = *(const v4u*)(Ch + (size_t)(t - dt) * MIXW + c0), cv = *(const v4u*)(Cc + (size_t)(t - dt) * MIXW + c0);
            const float* w = a.conv_w + ((size_t)l * 3 + j) * MIXW + c0; const f32x4 w0 = *(const f32x4*)w, w1 = *(const f32x4*)(w + 4);
            acc[0] += w0[0] * bflo(hv.x) * bflo(cv.x); acc[1] += w0[1] * bfhi(hv.x) * bfhi(cv.x); acc[2] += w0[2] * bflo(hv.y) * bflo(cv.y); acc[3] += w0[3] * bfhi(hv.y) * bfhi(cv.y);
            acc[4] += w1[0] * bflo(hv.z) * bflo(cv.z); acc[5] += w1[1] * bfhi(hv.z) * bfhi(cv.z); acc[6] += w1[2] * bflo(hv.w) * bflo(cv.w); acc[7] += w1[3] * bfhi(hv.w) * bfhi(cv.w); } }
    const v4u bv = *(const v4u*)(Cb + (size_t)t * MIXW + c0);
    v4u o; o.x = pk2(acc[0] * bflo(bv.x), acc[1] * bfhi(bv.x)); o.y = pk2(acc[2] * bflo(bv.y), acc[3] * bfhi(bv.y)); o.z = pk2(acc[4] * bflo(bv.z), acc[5] * bfhi(bv.z)); o.w = pk2(acc[6] * bflo(bv.w), acc[7] * bfhi(bv.w));
    *(v4u*)((bf16*)(a.ws + WS_Y) + (size_t)t * D + 1024 + c0) = o;
}
__device__ __forceinline__ void mixers_naive(const Args& a, int l, LAS unsigned char* lds, int gw, int NGW, int wave, int lane) {
    LAS float* sc = (LAS float*)(lds + wave * 8192);
    for (int i = gw; i < M * 4; i += NGW) { const int t = M * 4 - 1 - i; const int h = t & 3, tok = t >> 2; naive_attn<0>(a, l, tok >> 11, h, tok & (SEQ - 1), sc, lane); }
    for (int i = gw; i < M * 4; i += NGW) { const int h = i & 3, tok = i >> 2; naive_attn<1>(a, l, tok >> 11, h, tok & (SEQ - 1), sc, lane); }
    for (int i = gw; i < M * 4; i += NGW) naive_pool(a, l, i >> 2, i & 3, sc, lane);
    for (int i = gw; i < M; i += NGW) naive_conv(a, l, i, lane);
}

#ifndef PROBE
#define PROBE 0
#endif
__device__ __forceinline__ float gelu_tanh(float x) { const float u = 1.5957691216057308f * (x + 0.044715f * x * x * x); return x / (1.0f + __expf(-u)); }
constexpr int PEER_TOK = 32;
constexpr int PL_IDX = 0, PL_GATE = PEER_TOK * 128 * 4, PL_TAB = 2 * PEER_TOK * 128 * 4;
__device__ __forceinline__ int f2key(float f) { const int b = __builtin_bit_cast(int, f); return b ^ ((b >> 31) & 0x7fffffff); }
__device__ __forceinline__ float key2f(int k) { return __builtin_bit_cast(float, k ^ ((k >> 31) & 0x7fffffff)); }
#define CE_DESC(x, y) do { const int hi_ = (x) > (y) ? (x) : (y), lo_ = (x) > (y) ? (y) : (x); (x) = hi_; (y) = lo_; } while (0)
__device__ __forceinline__ void sort16_desc(int* v) {
#pragma unroll
    for (int k = 2; k <= 16; k <<= 1)
#pragma unroll
        for (int j = k >> 1; j > 0; j >>= 1)
#pragma unroll
            for (int i = 0; i < 16; ++i) { const int l = i ^ j; if (l > i) { if ((i & k) == 0) CE_DESC(v[i], v[l]); else CE_DESC(v[l], v[i]); } }
}
__device__ __forceinline__ void merge_top16(int* a, const int* b) {
#pragma unroll
    for (int i = 0; i < 16; ++i) a[i] = a[i] > b[15 - i] ? a[i] : b[15 - i];
#pragma unroll
    for (int j = 8; j > 0; j >>= 1)
#pragma unroll
        for (int i = 0; i < 16; ++i) { const int l = i ^ j; if (l > i) CE_DESC(a[i], a[l]); }
}
__device__ __forceinline__ void top16_of_64(int* v) {
    sort16_desc(v); sort16_desc(v + 16); sort16_desc(v + 32); sort16_desc(v + 48);
    merge_top16(v, v + 16); merge_top16(v + 32, v + 48); merge_top16(v, v + 32);
}
constexpr int cand_slot(int i, int j) {
    int n = 0;
    for (int a = 0; a < 16; ++a) for (int b = 0; b < 16; ++b) { if ((a + 1) * (b + 1) <= 16) { if (a == i && b == j) return n; ++n; } }
    return -1;
}
__device__ __forceinline__ void peer_retrieve(const Args& a, int l, int t0, int h, LAS char* lds, int wave) {
    typedef short bf16x8 __attribute__((ext_vector_type(8)));
    typedef float f32x16 __attribute__((ext_vector_type(16)));
    int lane; asm volatile("v_mbcnt_lo_u32_b32 %0, -1, 0\n\tv_mbcnt_hi_u32_b32 %0, -1, %0" : "=v"(lane));
    const int r32 = lane & 31, hi = lane >> 5, hi4 = hi * 4;
    const bf16* Q = (const bf16*)(a.ws + WS_Q) + (size_t)(t0 + r32) * D + h * 256 + hi * 8;
    const bf16* PK = (const bf16*)(a.ws + WS_PK) + ((size_t)(l * 8 + h) * 2) * 128 * 128 + (size_t)r32 * 128 + hi * 8;
    int top[2][16];
#pragma unroll
    for (int p = 0; p < 2; ++p) {
        f32x16 acc[4] = {};
        bf16x8 qf[8];
#pragma unroll
        for (int cs = 0; cs < 8; ++cs) qf[cs] = *(const bf16x8*)(Q + p * 128 + cs * 16);
#pragma unroll
        for (int kb = 0; kb < 4; ++kb) { bf16x8 kf[8];
#pragma unroll
            for (int cs = 0; cs < 8; ++cs) kf[cs] = *(const bf16x8*)(PK + (size_t)p * 128 * 128 + (size_t)kb * 32 * 128 + cs * 16);
#pragma unroll
            for (int cs = 0; cs < 8; ++cs) acc[kb] = __builtin_amdgcn_mfma_f32_32x32x16_bf16(kf[cs], qf[cs], acc[kb], 0, 0, 0); }
        int v[64];
#pragma unroll
        for (int kb = 0; kb < 4; ++kb)
#pragma unroll
            for (int r = 0; r < 16; ++r) { const int c = kb * 32 + (r & 3) + 8 * (r >> 2);
                v[kb * 16 + r] = (f2key(acc[kb][r]) & ~127) | (c | hi4); }
        top16_of_64(v);
        int mine[16], other[16];
#pragma unroll
        for (int i = 0; i < 16; ++i) { auto rr = __builtin_amdgcn_permlane32_swap((unsigned)v[i], (unsigned)v[i], false, false); mine[i] = (int)rr[0]; other[i] = (int)rr[1]; }
        merge_top16(mine, other);
#pragma unroll
        for (int i = 0; i < 16; ++i) top[p][i] = mine[i];
    }
    LAS int* tab = (LAS int*)(lds + PL_TAB) + (wave * 64 + lane) * 32;
    float sA[16], sB[16];
#pragma unroll
    for (int i = 0; i < 16; ++i) { sA[i] = key2f(top[0][i] & ~127); sB[i] = key2f(top[1][i] & ~127); tab[i] = top[0][i] & 127; tab[16 + i] = top[1][i] & 127; }
    int c[64];
#pragma unroll
    for (int n = 0; n < 64; ++n) c[n] = (int)0x80000000;
#pragma unroll
    for (int i = 0; i < 16; ++i)
#pragma unroll
        for (int j = 0; j < 16; ++j) if ((i + 1) * (j + 1) <= 16) c[cand_slot(i, j)] = (f2key(sA[i] + sB[j]) & ~255) | (16 * i + j);
    top16_of_64(c);
    float ex[16]; float sum = 0.f; const float mx = key2f(c[0] & ~255);
#pragma unroll
    for (int w = 0; w < 16; ++w) { ex[w] = __expf(key2f(c[w] & ~255) - mx); sum += ex[w]; }
    const float inv = 1.0f / sum;
    asm volatile("s_waitcnt lgkmcnt(0)" ::: "memory");
    LAS int* oi = (LAS int*)(lds + PL_IDX) + r32 * 128 + h * 16; LAS float* og = (LAS float*)(lds + PL_GATE) + r32 * 128 + h * 16;
#pragma unroll
    for (int w = 0; w < 16; ++w) { const int id = c[w] & 255; const int e = tab[id >> 4] * 128 + tab[16 + (id & 15)];
        if ((w >> 3) == hi) { oi[w] = e; og[w] = ex[w] * inv; } }
}
__device__ __forceinline__ void peer_token(const Args& a, int l, int t, bool last_layer, LAS char* lds, int tl, bool dry = false) {
    int lane; asm volatile("v_mbcnt_lo_u32_b32 %0, -1, 0\n\tv_mbcnt_hi_u32_b32 %0, -1, %0" : "=v"(lane));
    unsigned char* ws = a.ws;
    const int idxv[2] = {((const LAS int*)(lds + PL_IDX))[tl * 128 + lane], ((const LAS int*)(lds + PL_IDX))[tl * 128 + 64 + lane]};
    const float gatv[2] = {((const LAS float*)(lds + PL_GATE))[tl * 128 + lane], ((const LAS float*)(lds + PL_GATE))[tl * 128 + 64 + lane]};
    asm volatile("v_mbcnt_lo_u32_b32 %0, -1, 0\n\tv_mbcnt_hi_u32_b32 %0, -1, %0" : "=v"(lane));
    const unsigned long long* ssa1 = (const unsigned long long*)(ws + WS_SSA) + l * M;
    const float rs = rsqrtf(ssa_to_f(ssa1[t]) * (1.0f / D) + EPS);
    const bf16* HB = (const bf16*)(ws + WS_HB) + (size_t)t * D; const float* gn = a.norm_ffn + l * D;
    int xh[8], xl[8]; float sx;
    {
        float xf[32]; float am = 0.f;
#pragma unroll
        for (int i = 0; i < 2; ++i) { const int k0 = 16 * lane + 1024 * i; const v4u h0 = *(const v4u*)(HB + k0), h1 = *(const v4u*)(HB + k0 + 8);
            const unsigned hw[8] = {h0.x, h0.y, h0.z, h0.w, h1.x, h1.y, h1.z, h1.w};
#pragma unroll
            for (int q = 0; q < 4; ++q) { const f32x4 g = *(const f32x4*)(gn + k0 + 4 * q);
                xf[16 * i + 4 * q + 0] = bflo(hw[2 * q]) * rs * g[0]; xf[16 * i + 4 * q + 1] = bfhi(hw[2 * q]) * rs * g[1];
                xf[16 * i + 4 * q + 2] = bflo(hw[2 * q + 1]) * rs * g[2]; xf[16 * i + 4 * q + 3] = bfhi(hw[2 * q + 1]) * rs * g[3]; } }
#pragma unroll
        for (int k = 0; k < 32; ++k) am = fmaxf(am, fabsf(xf[k]));
        am = wave_max(am, lane);
        sx = am * (1.0f / 127.0f); const float inv = am > 0.f ? 127.0f / am : 0.f;
#pragma unroll
        for (int d = 0; d < 8; ++d) { unsigned ph = 0, pl = 0;
#pragma unroll
            for (int b = 0; b < 4; ++b) { const float s = xf[4 * d + b] * inv, hq = rintf(s), lq = rintf((s - hq) * 128.0f);
                ph |= ((unsigned)((int)hq & 255)) << (8 * b); pl |= ((unsigned)((int)lq & 255)) << (8 * b); }
            xh[d] = (int)ph; xl[d] = (int)pl; }
    }
    const unsigned char* PU = ws + WS_PU + (size_t)l * PE_BYTES; const unsigned char* PV = ws + WS_PV + (size_t)l * PE_BYTES;
    const float* SU = (const float*)(ws + WS_SU) + l * PEER_E; const float* SV = (const float*)(ws + WS_SV) + l * PEER_E;
    const float suv[2] = {SU[idxv[0]], SU[idxv[1]]}, svv[2] = {SV[idxv[0]], SV[idxv[1]]};
    const __amdgpu_buffer_rsrc_t rU = __builtin_amdgcn_make_buffer_rsrc((void*)PU, 0, 0x7fffffff, 0x00020000), rV = __builtin_amdgcn_make_buffer_rsrc((void*)PV, 0, 0x7fffffff, 0x00020000);
    const int lo16 = 16 * lane;
#define PEER_LOADG(buf, T, g) do { const int sel_ = ((g) & 8) ? idxv[1] : idxv[0]; _Pragma("unroll") for (int j = 0; j < 8; ++j) { \
        const int e_ = __builtin_amdgcn_readlane(sel_, ((g) & 7) * 8 + j); \
        buf[j][0] = __builtin_amdgcn_raw_buffer_load_b128(T, lo16, e_ * D, 0); buf[j][1] = __builtin_amdgcn_raw_buffer_load_b128(T, lo16 + 1024, e_ * D, 0); } } while (0)
    float actv[2] = {0.f, 0.f};
    {
        v4u bA[8][2], bB[8][2];
#define PEER_UCOMP(buf, g) do { float p_[8]; _Pragma("unroll") for (int j = 0; j < 8; ++j) { int dh = 0, dl = 0; \
            _Pragma("unroll") for (int i = 0; i < 2; ++i) { \
                dh = __builtin_amdgcn_sdot4((int)buf[j][i].x, xh[4 * i + 0], dh, false); dl = __builtin_amdgcn_sdot4((int)buf[j][i].x, xl[4 * i + 0], dl, false); \
                dh = __builtin_amdgcn_sdot4((int)buf[j][i].y, xh[4 * i + 1], dh, false); dl = __builtin_amdgcn_sdot4((int)buf[j][i].y, xl[4 * i + 1], dl, false); \
                dh = __builtin_amdgcn_sdot4((int)buf[j][i].z, xh[4 * i + 2], dh, false); dl = __builtin_amdgcn_sdot4((int)buf[j][i].z, xl[4 * i + 2], dl, false); \
                dh = __builtin_amdgcn_sdot4((int)buf[j][i].w, xh[4 * i + 3], dh, false); dl = __builtin_amdgcn_sdot4((int)buf[j][i].w, xl[4 * i + 3], dl, false); } \
            p_[j] = (float)dh + (float)dl * (1.0f / 128.0f); } \
        float q_[4]; _Pragma("unroll") for (int k = 0; k < 4; ++k) { auto r_ = __builtin_amdgcn_permlane32_swap(__float_as_uint(p_[2 * k]), __float_as_uint(p_[2 * k + 1]), false, false); q_[k] = __uint_as_float(r_[0]) + __uint_as_float(r_[1]); } \
        float s_[2]; _Pragma("unroll") for (int k = 0; k < 2; ++k) { auto r_ = __builtin_amdgcn_permlane16_swap(__float_as_uint(q_[2 * k]), __float_as_uint(q_[2 * k + 1]), false, false); s_[k] = __uint_as_float(r_[0]) + __uint_as_float(r_[1]); } \
        _Pragma("unroll") for (int k = 0; k < 2; ++k) { s_[k] += shf(s_[k], lane ^ 8); s_[k] += shf(s_[k], lane ^ 4); s_[k] += shf(s_[k], lane ^ 2); s_[k] += shf(s_[k], lane ^ 1); } \
          \
        const int src_ = 16 * (((lane & 1) << 1) | ((lane >> 1) & 1)); const float v0_ = shf(s_[0], src_), v1_ = shf(s_[1], src_); \
        if ((lane >> 3) == ((g) & 7)) { const float v_ = (lane & 4) ? v1_ : v0_; if ((g) & 8) actv[1] = v_; else actv[0] = v_; } } while (0)
        PEER_LOADG(bA, rU, 0);
        for (int g = 0; g < 16; g += 2) {
            PEER_LOADG(bB, rU, g + 1);
            PEER_UCOMP(bA, g);
            if (g + 2 < 16) PEER_LOADG(bA, rU, g + 2);
            PEER_UCOMP(bB, g + 1);
        }
#undef PEER_UCOMP
    }
    float coef[2]; float csum;
    { const float a0 = actv[0] * suv[0] * sx, a1 = actv[1] * suv[1] * sx;
      coef[0] = gelu_tanh(a0) * gatv[0] * svv[0]; coef[1] = gelu_tanh(a1) * gatv[1] * svv[1]; csum = wave_sum(coef[0] + coef[1], lane); }
    float y[4][8];
#pragma unroll
    for (int i = 0; i < 4; ++i)
#pragma unroll
        for (int k = 0; k < 8; ++k) y[i][k] = 0.f;
    {
        v4u bA[8][2], bB[8][2];
#define PEER_VCOMP(buf, g) do { const float csel_ = ((g) & 8) ? coef[1] : coef[0]; _Pragma("unroll") for (int j = 0; j < 8; ++j) { \
            const float c_ = __builtin_bit_cast(float, __builtin_amdgcn_readlane(__builtin_bit_cast(int, csel_), ((g) & 7) * 8 + j)); \
            _Pragma("unroll") for (int i = 0; i < 2; ++i) { const unsigned w_[4] = {buf[j][i].x, buf[j][i].y, buf[j][i].z, buf[j][i].w}; \
                _Pragma("unroll") for (int d = 0; d < 4; ++d) { \
                    y[2 * i + (d >> 1)][4 * (d & 1) + 0] += c_ * (float)(w_[d] & 255u); y[2 * i + (d >> 1)][4 * (d & 1) + 1] += c_ * (float)((w_[d] >> 8) & 255u); \
                    y[2 * i + (d >> 1)][4 * (d & 1) + 2] += c_ * (float)((w_[d] >> 16) & 255u); y[2 * i + (d >> 1)][4 * (d & 1) + 3] += c_ * (float)(w_[d] >> 24); } } } } while (0)
        PEER_LOADG(bA, rV, 0);
        for (int g = 0; g < 16; g += 2) {
            PEER_LOADG(bB, rV, g + 1);
            PEER_VCOMP(bA, g);
            if (g + 2 < 16) PEER_LOADG(bA, rV, g + 2);
            PEER_VCOMP(bB, g + 1);
        }
#undef PEER_VCOMP
    }
#undef PEER_LOADG
    { const float corr = 128.0f * csum;
#pragma unroll
      for (int i = 0; i < 4; ++i)
#pragma unroll
          for (int k = 0; k < 8; ++k) y[i][k] -= corr; }
    float* H = (float*)(ws + WS_H) + (size_t)t * D; bf16* HBw = (bf16*)(ws + WS_HB) + (size_t)t * D;
    float s = 0.f;
#pragma unroll
    for (int q = 0; q < 4; ++q) { const int k0 = 16 * lane + 1024 * (q >> 1) + 8 * (q & 1); const f32x4 h0 = *(const f32x4*)(H + k0), h1 = *(const f32x4*)(H + k0 + 4);
#pragma unroll
        for (int k = 0; k < 4; ++k) { y[q][k] += h0[k]; y[q][4 + k] += h1[k]; }
#pragma unroll
        for (int k = 0; k < 8; ++k) s += y[q][k] * y[q][k]; }
    s = wave_sum(s, lane);
    if (dry) { H = (float*)(ws + WS_R) + (size_t)t * D; HBw = (bf16*)(ws + WS_R + 64 * MiB) + (size_t)t * D; }
    if (!last_layer || dry) {
        float* ssqn = (float*)(ws + WS_SSQ) + (l + 1) * M; if (lane == 0 && !dry) ssqn[t] = s;
#pragma unroll
        for (int q = 0; q < 4; ++q) { const int k0 = 16 * lane + 1024 * (q >> 1) + 8 * (q & 1); *(f32x4*)(H + k0) = (f32x4){y[q][0], y[q][1], y[q][2], y[q][3]}; *(f32x4*)(H + k0 + 4) = (f32x4){y[q][4], y[q][5], y[q][6], y[q][7]};
            v4u o; o.x = pk2(y[q][0], y[q][1]); o.y = pk2(y[q][2], y[q][3]); o.z = pk2(y[q][4], y[q][5]); o.w = pk2(y[q][6], y[q][7]); *(v4u*)(HBw + k0) = o; }
    } else {
        const float rf = rsqrtf(s * (1.0f / D) + EPS); float* O = a.out + (size_t)t * D;
#pragma unroll
        for (int q = 0; q < 4; ++q) { const int k0 = 16 * lane + 1024 * (q >> 1) + 8 * (q & 1); const f32x4 g0 = *(const f32x4*)(a.norm_final + k0), g1 = *(const f32x4*)(a.norm_final + k0 + 4);
            *(f32x4*)(O + k0) = (f32x4){y[q][0] * rf * g0[0], y[q][1] * rf * g0[1], y[q][2] * rf * g0[2], y[q][3] * rf * g0[3]};
            *(f32x4*)(O + k0 + 4) = (f32x4){y[q][4] * rf * g1[0], y[q][5] * rf * g1[1], y[q][6] * rf * g1[2], y[q][7] * rf * g1[3]}; }
    }
}

#define LANE_ID(x) asm volatile("v_mbcnt_lo_u32_b32 %0, -1, 0\n\tv_mbcnt_hi_u32_b32 %0, -1, %0" : "=v"(x))
__global__ void __launch_bounds__(NT, 2) mk_fwd(ArgsK a_in) {
    extern __shared__ __attribute__((aligned(16))) unsigned char lds_raw[];
    LAS unsigned char* lds = (LAS unsigned char*)lds_raw;
    cg::grid_group grid = cg::this_grid();
    grid.sync();
    const int wave0 = __builtin_amdgcn_readfirstlane(threadIdx.x >> 6);
    const int G = gridDim.x;
    const CAS ArgsK* ka = (const CAS ArgsK*)__builtin_amdgcn_kernarg_segment_ptr();
    size_t zoff = 0;
#define PHASE_BEGIN() int lane; LANE_ID(lane); int blk = blockIdx.x, Gp = G, wv = wave0; asm volatile("" : "+s"(zoff), "+s"(ka), "+s"(blk), "+s"(Gp), "+s"(wv)); const int wave = wv, gw = blk * NWAVES + wv, NGW = Gp * NWAVES; (void)gw; (void)NGW; const Args a = load_args(ka, zoff); unsigned char* const ws = a.ws; (void)ws
    volatile LAS unsigned* bst = (volatile LAS unsigned*)(lds + RING_BYTES + 1024);
    if (PROBE == 3) { PHASE_BEGIN(); p0_prologue(a, lds, gw, NGW, wave, lane); }
    { PHASE_BEGIN(); if (wave == 0 && lane == 0) { bst[0] = 0u; bst[1] = 0u; (void)xb_add((unsigned*)(ws + WS_BAR) + XB_XCNT(xb_xcc_id()), 1u); }
      p0_prologue(a, lds, gw, NGW, wave, lane); }
#define GRID_BAR() do { asm volatile("" : "+s"(zoff)); unsigned char* wsb_ = (unsigned char*)ka->ws + zoff; int wvb_ = wave0; asm volatile("" : "+s"(wvb_)); xcd_barrier((unsigned*)(wsb_ + WS_BAR), xb_xcc_id(), (unsigned)G, bst, wvb_); } while (0)
    GRID_BAR();
    int depth_rt = DEPTH; asm volatile("" : "+s"(depth_rt));
    for (int lc = 0; lc < depth_rt; ++lc) {
        int l = lc; asm volatile("" : "+s"(l));
        for (int rep = 0; rep < (PROBE == 4 ? 2 : 1); ++rep)
        {
            PHASE_BEGIN();
            float* ssq_mix = (float*)(ws + WS_SSQ) + l * M;
            pg8::Gemm g{(const bf16*)(ws + WS_HB), (const bf16*)(ws + WS_WIN + l * WIN_BYTES), M, NPROJ, D}; pg8::StaticOrder S; S.init(M, NPROJ, Gp, blk);
            EpiProj E{(bf16*)(ws + WS_PROJ), (bf16*)(ws + WS_R), (const float*)(ws + WS_BINR) + l * NPROJ, ssq_mix};
            pg8::gemm_phase<EpiProj, pg8::StaticOrder, true>(lds, g, S, E, wave);
            forget_logits(a, l, gw, NGW, lane);
        }
        GRID_BAR();
        if (PROBE == 5) { PHASE_BEGIN(); mixers_fast(a, l + 2, (LAS char*)lds, wave, lane, Gp, blk); }
        { PHASE_BEGIN(); mixers_fast(a, l, (LAS char*)lds, wave, lane, Gp, blk); }
        GRID_BAR();
        {
            PHASE_BEGIN();
            pg8::Gemm g{(const bf16*)(ws + WS_Y), (const bf16*)(ws + WS_WBR + l * SQ_BYTES), M, D, D}; pg8::StaticOrder S; S.init(M, D, Gp, blk);
            EpiMerge E{(const bf16*)(ws + WS_R), (bf16*)(ws + WS_MRG)};
            pg8::gemm_phase<EpiMerge, pg8::StaticOrder, false>(lds, g, S, E, wave);
        }
        GRID_BAR();
        {
            PHASE_BEGIN();
            pg8::Gemm g{(const bf16*)(ws + WS_MRG), (const bf16*)(ws + WS_WOUT + l * SQ_BYTES), M, D, D}; pg8::StaticOrder S; S.init(M, D, Gp, blk);
            EpiRes E{(float*)(ws + WS_H), (bf16*)(ws + WS_HB), (unsigned long long*)(ws + WS_SSA) + l * M};
            pg8::gemm_phase<EpiRes, pg8::StaticOrder, false>(lds, g, S, E, wave);
        }
        GRID_BAR();
        {
            PHASE_BEGIN();
            pg8::Gemm g{(const bf16*)(ws + WS_HB), (const bf16*)(ws + WS_WQ + l * SQ_BYTES), M, D, D}; pg8::StaticOrder S; S.init(M, D, Gp, blk);
            EpiQ E{(bf16*)(ws + WS_Q), (const unsigned long long*)(ws + WS_SSA) + l * M};
            pg8::gemm_phase<EpiQ, pg8::StaticOrder, false>(lds, g, S, E, wave);
        }
        GRID_BAR();
        for (int rep = 0; rep < (PROBE == 1 ? 2 : 1); ++rep)
        {
            PHASE_BEGIN(); (void)lane;
            for (int t0 = blk * PEER_TOK; t0 < M; t0 += Gp * PEER_TOK) {
                for (int rr = 0; rr < (PROBE == 2 ? 2 : 1); ++rr) peer_retrieve(a, l, t0, wave, (LAS char*)lds, wave);
                __syncthreads();
                for (int k = 0; k < PEER_TOK / NWAVES; ++k) { const int tl = wave * (PEER_TOK / NWAVES) + k; peer_token(a, l, t0 + tl, l == depth_rt - 1, (LAS char*)lds, tl, PROBE == 1 && rep == 0); }
                __syncthreads();
            }
        }
        if (l + 1 < depth_rt) GRID_BAR();
    }
}

extern "C" void kernel_launch(void* const* d_in, const int* in_sizes, int n_in, void* d_out, int out_size, void* d_ws, size_t ws_size, hipStream_t stream) {
    static int grid = 0;
    if (grid == 0) {
        int dev = 0, cus = 0, per_cu = 0;
        if (n_in != 16 || out_size != M * D || ws_size < WS_END) { fprintf(stderr, "kernel_launch: unexpected shapes (n_in %d out %d ws %zu)\n", n_in, out_size, ws_size); grid = -1; return; }
        (void)hipGetDevice(&dev);
        (void)hipDeviceGetAttribute(&cus, hipDeviceAttributeMultiprocessorCount, dev);
        (void)hipFuncSetAttribute((const void*)mk_fwd, hipFuncAttributeMaxDynamicSharedMemorySize, LDS_BYTES);
        (void)hipOccupancyMaxActiveBlocksPerMultiprocessor(&per_cu, (const void*)mk_fwd, NT, LDS_BYTES);
        if (per_cu < 1) { fprintf(stderr, "kernel_launch: occupancy query says %d blocks per CU\n", per_cu); }
        grid = cus;
        if (grid > 256) grid = 256;
    }
    if (grid < 0) return;
    (void)hipMemsetAsync((char*)d_ws + WS_CTL, 0, CTL_ZERO_BYTES, stream);
    ArgsK a{};
    const GAS float** p = (const GAS float**)&a;
    for (int i = 0; i < 16; ++i) p[i] = (const GAS float*)d_in[i];
    a.out = (GAS float*)d_out; a.ws = (GAS unsigned char*)d_ws;
    void* args[] = {&a};
    hipError_t e = hipLaunchCooperativeKernel((const void*)mk_fwd, dim3(grid), dim3(NT), args, LDS_BYTES, stream);
    if (e != hipSuccess) fprintf(stderr, "cooperative launch failed: %s (grid %d)\n", hipGetErrorString(e), grid);
}
```

```cpp
#include <hip/hip_runtime.h>
#include <hip/hip_cooperative_groups.h>
#include <cstdio>
#include <cstdint>
namespace cg = cooperative_groups;
namespace pg8 {
#define PG8_LAS __attribute__((address_space(3)))
typedef unsigned short bf16_t;
typedef short bf16x8 __attribute__((ext_vector_type(8)));
typedef float f32x4 __attribute__((ext_vector_type(4)));
typedef unsigned u32x4 __attribute__((ext_vector_type(4)));
typedef unsigned u32x2 __attribute__((ext_vector_type(2)));
constexpr int BM = 256, BK = 64, HALF = 128, HTB = HALF * BK * 2  , STAGE_BYTES = 8 * HTB, NXCD = 8, WGM = 8;

__host__ __device__ __forceinline__ int lds_byte(int r, int c) { const int st = (r >> 4) * 2 + (c >> 5), rr = r & 15, cc = c & 31, ob = rr * 64 + cc * 2; return st * 1024 + (ob ^ (((ob >> 9) & 1) << 5)); }
__host__ __device__ __forceinline__ void stage_rc(int b, int& R, int& C) { const int st = b / 1024, sb = b % 1024, swz = sb ^ (((sb >> 9) & 1) << 5); R = (st >> 1) * 16 + swz / 64; C = (st & 1) * 32 + (swz % 64) / 2; }
__host__ __device__ __forceinline__ int perm32(int rho) { const int n = rho >> 4, i = rho & 15; return 8 * (i >> 2) + 4 * n + (i & 3); }

struct Unit { int pm, pn; };
struct Gemm { const bf16_t* A; const bf16_t* Bt; int M, N, K; };

struct StaticOrder {
    int nM, nN, nwg, G, c;
    __host__ __device__ void init(int M, int N, int G_, int c_) { nM = M / BM; nN = N / BM; nwg = nM * nN; G = G_; c = c_; }
    __host__ __device__ bool next(int i, Unit& u) const {
        const long L = (long)i * G + c; if (L >= nwg) return false;
        int wgid = (int)L; { const int q = nwg / NXCD, r = nwg % NXCD, xcd = wgid % NXCD, off = wgid / NXCD; wgid = (xcd < r ? xcd * (q + 1) : r * (q + 1) + (xcd - r) * q) + off; }
        const int nig = WGM * nN, gid = wgid / nig, fm = gid * WGM, gsz = (nM - fm) < WGM ? (nM - fm) : WGM;
        u.pm = fm + ((wgid % nig) % gsz); u.pn = (wgid % nig) / gsz; return true;
    }
};

__device__ __forceinline__ unsigned cvt_pk_bf16(float lo, float hi) { unsigned r; asm volatile("v_cvt_pk_bf16_f32 %0, %1, %2" : "=v"(r) : "v"(lo), "v"(hi)); return r; }

template <class Epi, class Sched, bool ALIGN_EPI = false>
__device__ __forceinline__ void gemm_phase(PG8_LAS unsigned char* lds, const Gemm g, const Sched& S, const Epi& E, int wid) {
    int lane_; asm volatile("v_mbcnt_lo_u32_b32 %0, -1, 0\n\tv_mbcnt_hi_u32_b32 %0, -1, %0" : "=v"(lane_));
    const int lane = lane_, tid = wid * 64 + lane, wr = wid >> 2, wc = wid & 3, fr = lane & 15, fq = lane >> 4;
    const int K = g.K, nt = K / BK;
    unsigned voffA[2], voffB[2];
#pragma unroll
    for (int i = 0; i < 2; ++i) { int R, C; stage_rc(tid * 16 + i * 8192, R, C); const int Rb = Epi::PERM ? ((R & ~31) + perm32(R & 31)) : R;
        voffA[i] = (unsigned)(R * K + C) * 2u; voffB[i] = (unsigned)(Rb * K + C) * 2u; }
    const size_t kstep = (size_t)(BK * 2);
    const size_t hstep = (size_t)HALF * K * 2;
    const size_t tstep = 2 * hstep;
    const unsigned ldsw = (unsigned)wid * 1024u;
    const int aoff = lds_byte(wr * 64 + fr, fq * 8), boff = lds_byte(wc * 32 + fr, fq * 8);
#define PG8_SA(b, h) (((b) * 2 + (h)) * HTB)
#define PG8_SB(b, h) ((4 + (b) * 2 + (h)) * HTB)
#define PG8_STAGE(bufoff, gbase, voff) do { _Pragma("unroll") for (int _i = 0; _i < 2; ++_i) \
        __builtin_amdgcn_global_load_lds((const unsigned*)((const char*)(gbase) + (voff)[_i]), (PG8_LAS unsigned*)(lds + (bufoff) + ldsw + _i * 8192), 16, 0, 0); } while (0)
#define PG8_LDA(dst, b, h) do { _Pragma("unroll") for (int m = 0; m < 4; ++m) _Pragma("unroll") for (int k = 0; k < 2; ++k) dst[m][k] = *(const PG8_LAS bf16x8*)(lds + PG8_SA(b, h) + aoff + m * 2048 + k * 1024); } while (0)
#define PG8_LDB(dst, b, h) do { _Pragma("unroll") for (int n = 0; n < 2; ++n) _Pragma("unroll") for (int k = 0; k < 2; ++k) dst[n][k] = *(const PG8_LAS bf16x8*)(lds + PG8_SB(b, h) + boff + n * 2048 + k * 1024); } while (0)
#define PG8_MMA(ai, bj, At, Bt) do { __builtin_amdgcn_s_setprio(1); _Pragma("unroll") for (int m = 0; m < 4; ++m) _Pragma("unroll") for (int n = 0; n < 2; ++n) _Pragma("unroll") for (int k = 0; k < 2; ++k) \
        acc[ai][bj][m][n] = __builtin_amdgcn_mfma_f32_16x16x32_bf16(Bt[n][k], At[m][k], acc[ai][bj][m][n], 0, 0, 0); __builtin_amdgcn_s_setprio(0); } while (0)
#define PG8_WAIT_V(n) asm volatile("s_waitcnt vmcnt(" #n ")" ::: "memory")
#define PG8_WAIT_L(n) asm volatile("s_waitcnt lgkmcnt(" #n ")" ::: "memory")
#define PG8_BAR __builtin_amdgcn_s_barrier()
#define PG8_SCHED __builtin_amdgcn_sched_barrier(0)
    Unit cur, nxt; int ui = 0;
    if (!S.next(0, cur)) return;
    f32x4 acc[2][2][4][2];
#pragma unroll
    for (int a = 0; a < 2; ++a)
#pragma unroll
        for (int b = 0; b < 2; ++b)
#pragma unroll
            for (int m = 0; m < 4; ++m)
#pragma unroll
                for (int n = 0; n < 2; ++n) acc[a][b][m][n] = (f32x4){0.f, 0.f, 0.f, 0.f};
    bf16x8 At[4][2], B0[2][2], B1[2][2];
    const char* cA = (const char*)g.A + (size_t)cur.pm * tstep; const char* cB = (const char*)g.Bt + (size_t)cur.pn * tstep;
    PG8_STAGE(PG8_SB(0, 0), cB, voffB); PG8_STAGE(PG8_SB(0, 1), cB + hstep, voffB); PG8_STAGE(PG8_SA(0, 0), cA, voffA); PG8_STAGE(PG8_SA(0, 1), cA + hstep, voffA);
    if (wr == 1) PG8_BAR;
    PG8_WAIT_V(2); PG8_BAR;
    PG8_STAGE(PG8_SB(1, 0), cB + kstep, voffB); PG8_STAGE(PG8_SA(1, 0), cA + kstep, voffA); PG8_STAGE(PG8_SB(1, 1), cB + hstep + kstep, voffB);
    PG8_WAIT_V(6); PG8_BAR;
    for (;;) {
        const bool has_next = S.next(ui + 1, nxt);
        const char* nA = has_next ? (const char*)g.A + (size_t)nxt.pm * tstep : cA; const char* nB = has_next ? (const char*)g.Bt + (size_t)nxt.pn * tstep : cB;
        const int seglen = Epi::HOOK ? 8 : nt;
        for (int t0 = 0; t0 < nt; t0 += seglen) {
        if constexpr (Epi::HOOK) { if (t0 > 0) E.hook(acc, cur, t0 >> 3, wr, wc, fr, fq); }
        for (int t = t0; t < t0 + seglen; t += 2) {
            const bool last = (t == nt - 2);
            const char* a1 = cA + (size_t)(t + 1) * kstep;
            const char* a2 = last ? nA : cA + (size_t)(t + 2) * kstep; const char* b2 = last ? nB : cB + (size_t)(t + 2) * kstep;
            const char* a3 = a2 + kstep; const char* b3 = b2 + kstep;
            PG8_LDB(B0, 0, 0); PG8_LDB(B1, 0, 1); PG8_SCHED; PG8_LDA(At, 0, 0); PG8_STAGE(PG8_SA(1, 1), a1 + hstep, voffA);
            PG8_WAIT_V(8); PG8_WAIT_L(0); PG8_BAR; PG8_MMA(0, 0, At, B0); PG8_MMA(0, 1, At, B1); PG8_BAR; PG8_SCHED;
            PG8_LDA(At, 0, 1); PG8_STAGE(PG8_SB(0, 0), b2, voffB); PG8_STAGE(PG8_SB(0, 1), b2 + hstep, voffB); PG8_STAGE(PG8_SA(0, 0), a2, voffA);
            PG8_WAIT_V(8); PG8_WAIT_L(0); PG8_BAR; PG8_MMA(1, 0, At, B0); PG8_MMA(1, 1, At, B1); PG8_BAR; PG8_SCHED;
            PG8_LDB(B0, 1, 0); PG8_LDB(B1, 1, 1); PG8_SCHED; PG8_LDA(At, 1, 0); PG8_STAGE(PG8_SA(0, 1), a2 + hstep, voffA);
            PG8_WAIT_V(8); PG8_WAIT_L(0); PG8_BAR; PG8_MMA(0, 0, At, B0); PG8_MMA(0, 1, At, B1); PG8_BAR; PG8_SCHED;
            PG8_LDA(At, 1, 1); PG8_STAGE(PG8_SB(1, 0), b3, voffB); PG8_STAGE(PG8_SB(1, 1), b3 + hstep, voffB); PG8_STAGE(PG8_SA(1, 0), a3, voffA);
            PG8_WAIT_V(8); PG8_WAIT_L(0); PG8_BAR; PG8_MMA(1, 0, At, B0); PG8_MMA(1, 1, At, B1); PG8_BAR; PG8_SCHED;
        }
        }
        if constexpr (ALIGN_EPI) { if (wr == 0) PG8_BAR; }
        E(acc, cur, wr, wc, fr, fq);
        if (!has_next) break;
#pragma unroll
        for (int a = 0; a < 2; ++a)
#pragma unroll
            for (int b = 0; b < 2; ++b)
#pragma unroll
                for (int m = 0; m < 4; ++m)
#pragma unroll
                    for (int n = 0; n < 2; ++n) acc[a][b][m][n] = (f32x4){0.f, 0.f, 0.f, 0.f};
        cur = nxt; cA = nA; cB = nB; ++ui;
        if constexpr (ALIGN_EPI) { if (wr == 1) PG8_BAR; }
    }
    PG8_WAIT_V(0);
    if constexpr (!ALIGN_EPI) { if (wr == 0) PG8_BAR; }
    PG8_BAR;
#undef PG8_SA
#undef PG8_SB
#undef PG8_STAGE
#undef PG8_LDA
#undef PG8_LDB
#undef PG8_MMA
#undef PG8_WAIT_V
#undef PG8_WAIT_L
#undef PG8_BAR
#undef PG8_SCHED
}
}
constexpr int NWAVES = 8, NT = NWAVES * 64;
constexpr int M = 8192, D = 2048, SEQ = 2048, NBATCH = 4, DEPTH = 2;
constexpr int INW = 13316, NPROJ = 13312, MIXW = 512, HD = 128;
constexpr int PEER_E = 16384;
constexpr float EPS = 1e-6f;
constexpr float ATT_SCALE = 0.08838834764831845f;

constexpr size_t MiB = 1u << 20;
constexpr size_t WS_CTL = 0, CTL_ZERO_BYTES = 1 * MiB;
constexpr size_t WS_SSQ = 0;
constexpr size_t WS_SSA = 256 * 1024;
constexpr size_t WS_WF = 1 * MiB;
constexpr size_t WS_BINR = WS_WF + 64 * 1024;
constexpr size_t WS_LOGF = 2 * MiB;
constexpr size_t WS_CUM = 3 * MiB;
constexpr size_t WS_WIN = 8 * MiB;
constexpr size_t WIN_BYTES = (size_t)NPROJ * D * 2;
constexpr size_t WS_WBR = 112 * MiB, WS_WOUT = 128 * MiB, WS_WQ = 144 * MiB;
constexpr size_t SQ_BYTES = (size_t)D * D * 2;
constexpr size_t WS_PU = 160 * MiB, WS_PV = 288 * MiB;
constexpr size_t PE_BYTES = (size_t)PEER_E * D;
constexpr size_t WS_PK = 6 * MiB;
constexpr size_t WS_SU = 5 * MiB, WS_SV = 5 * MiB + 256 * 1024;
constexpr size_t WS_H = 416 * MiB;
constexpr size_t WS_HB = 480 * MiB;
constexpr size_t WS_PROJ = 512 * MiB;
constexpr size_t PROJ_T = (size_t)M * MIXW;
constexpr size_t WS_R = 592 * MiB;
constexpr size_t R_PLANE = (size_t)M * D;
constexpr size_t WS_Y = 720 * MiB;
constexpr size_t WS_MRG = 752 * MiB;
constexpr size_t WS_Q = 784 * MiB;
constexpr size_t WS_END = 816 * MiB;

constexpr int RING_BYTES = 131072;
constexpr int LDS_BYTES = 147456;

typedef unsigned short bf16;
typedef unsigned v4u __attribute__((ext_vector_type(4)));
typedef unsigned v2u __attribute__((ext_vector_type(2)));
typedef float f32x4 __attribute__((ext_vector_type(4)));
typedef float f32x2 __attribute__((ext_vector_type(2)));
using bf16x2 = __attribute__((ext_vector_type(2))) __bf16;
#define LAS __attribute__((address_space(3)))

__device__ __forceinline__ unsigned f2bf(float f) { unsigned u = __builtin_bit_cast(unsigned, f); return (u + 0x7fffu + ((u >> 16) & 1u)) >> 16; }
__device__ __forceinline__ unsigned pk2(float lo, float hi) { return f2bf(lo) | (f2bf(hi) << 16); }
__device__ __forceinline__ float bflo(unsigned w) { return __builtin_bit_cast(float, w << 16); }
__device__ __forceinline__ float bfhi(unsigned w) { return __builtin_bit_cast(float, w & 0xffff0000u); }
__device__ __forceinline__ float bf2f(bf16 b) { return __builtin_bit_cast(float, ((unsigned)b) << 16); }
__device__ __forceinline__ float shf(float v, int src) { return __builtin_bit_cast(float, __builtin_amdgcn_ds_bpermute(src << 2, __builtin_bit_cast(int, v))); }
__device__ __forceinline__ int shi(int v, int src) { return __builtin_amdgcn_ds_bpermute(src << 2, v); }
__device__ __forceinline__ float wave_sum(float v, int lane) {
#pragma unroll
    for (int o = 1; o < 64; o <<= 1) v += shf(v, lane ^ o);
    return v;
}
__device__ __forceinline__ float wave_max(float v, int lane) {
#pragma unroll
    for (int o = 1; o < 64; o <<= 1) v = fmaxf(v, shf(v, lane ^ o));
    return v;
}
__device__ __forceinline__ float ssa_to_f(unsigned long long v) { return (float)((double)v * (1.0 / 4294967296.0)); }
__device__ __forceinline__ float dot2_bf16(unsigned w, unsigned x, float acc) { return __builtin_amdgcn_fdot2_f32_bf16(__builtin_bit_cast(bf16x2, w), __builtin_bit_cast(bf16x2, x), acc, false); }

struct Args {
    const float *x, *norm_mix, *w_in, *b_in, *pool_w, *pool_scale, *conv_w, *rel_bias, *w_branch, *w_out, *norm_ffn, *peer_wq, *peer_keys, *peer_u, *peer_v, *norm_final;
    float* out; unsigned char* ws;
};
#define GAS __attribute__((address_space(1)))
#define CAS __attribute__((address_space(4)))
struct ArgsK {
    const GAS float *x, *norm_mix, *w_in, *b_in, *pool_w, *pool_scale, *conv_w, *rel_bias, *w_branch, *w_out, *norm_ffn, *peer_wq, *peer_keys, *peer_u, *peer_v, *norm_final;
    GAS float* out; GAS unsigned char* ws;
};
__device__ __forceinline__ Args load_args(const CAS ArgsK* k, size_t zoff) {
    Args a;
    a.x = (const float*)k->x; a.norm_mix = (const float*)k->norm_mix; a.w_in = (const float*)k->w_in; a.b_in = (const float*)k->b_in; a.pool_w = (const float*)k->pool_w;
    a.pool_scale = (const float*)k->pool_scale; a.conv_w = (const float*)k->conv_w; a.rel_bias = (const float*)k->rel_bias; a.w_branch = (const float*)k->w_branch;
    a.w_out = (const float*)k->w_out; a.norm_ffn = (const float*)k->norm_ffn; a.peer_wq = (const float*)k->peer_wq; a.peer_keys = (const float*)k->peer_keys;
    a.peer_u = (const float*)k->peer_u; a.peer_v = (const float*)k->peer_v; a.norm_final = (const float*)k->norm_final; a.out = (float*)k->out; a.ws = (unsigned char*)(k->ws + zoff);
    return a;
}

using pg8::f32x4; using pg8::Unit;
struct EpiProj {
    static constexpr bool PERM = true, HOOK = false;
    bf16* P; bf16* R; const float* bias; const float* ssq;
    __device__ __forceinline__ void operator()(f32x4 (&acc)[2][2][4][2], const Unit& u, int wr, int wc, int fr, int fq) const {
        const int row0 = u.pm * 256 + wr * 64 + fr, cl0 = wc * 32 + 8 * fq, bcol0 = u.pn * 256 + cl0;
        f32x4 bv[2][2];
#pragma unroll
        for (int bj = 0; bj < 2; ++bj)
#pragma unroll
            for (int n = 0; n < 2; ++n) bv[bj][n] = *(const f32x4*)(bias + bcol0 + bj * 128 + 4 * n);
        if (u.pn < 20) {
            bf16* base = P + (size_t)(u.pn >> 1) * PROJ_T + (u.pn & 1) * 256 + cl0;
#pragma unroll
            for (int ai = 0; ai < 2; ++ai)
#pragma unroll
                for (int m = 0; m < 4; ++m) { const int row = row0 + ai * 128 + m * 16; const float rs = rsqrtf(ssq[row] * (1.0f / D) + EPS);
                    bf16* rowp = base + (size_t)row * MIXW;
#pragma unroll
                    for (int bj = 0; bj < 2; ++bj) { const f32x4 v0 = acc[ai][bj][m][0] * rs + bv[bj][0], v1 = acc[ai][bj][m][1] * rs + bv[bj][1];
                        pg8::u32x4 w; w.x = pg8::cvt_pk_bf16(v0[0], v0[1]); w.y = pg8::cvt_pk_bf16(v0[2], v0[3]); w.z = pg8::cvt_pk_bf16(v1[0], v1[1]); w.w = pg8::cvt_pk_bf16(v1[2], v1[3]);
                        *(pg8::u32x4*)(rowp + bj * 128) = w; } }
        } else {
            const int d0 = 64 * (u.pn - 20) + 16 * wc + 4 * fq;
#pragma unroll
            for (int ai = 0; ai < 2; ++ai)
#pragma unroll
                for (int m = 0; m < 4; ++m) { const int row = row0 + ai * 128 + m * 16; const float rs = rsqrtf(ssq[row] * (1.0f / D) + EPS);
                    float r[4][4];
#pragma unroll
                    for (int j = 0; j < 4; ++j) { float e[4], ie[4];
#pragma unroll
                        for (int g = 0; g < 4; ++g) { const float z = acc[ai][g >> 1][m][g & 1][j] * rs + bv[g >> 1][g & 1][j];
                            e[g] = fminf(1.0f + __builtin_amdgcn_exp2f(-1.4426950408889634f * z), 1e18f); ie[g] = __builtin_amdgcn_rcpf(e[g]); }
                        r[0][j] = e[1] * ie[0]; r[1][j] = e[2] * ie[1]; r[2][j] = e[3] * ie[2]; r[3][j] = ie[3]; }
#pragma unroll
                    for (int g = 0; g < 4; ++g) { pg8::u32x2 w; w.x = pg8::cvt_pk_bf16(r[g][0], r[g][1]); w.y = pg8::cvt_pk_bf16(r[g][2], r[g][3]);
                        *(pg8::u32x2*)(R + (size_t)g * R_PLANE + (size_t)row * D + d0) = w; } }
        }
    }
};
struct EpiMerge {
    static constexpr bool PERM = true, HOOK = true;
    const bf16* R; bf16* O;
    template <int NB  >
    __device__ __forceinline__ void scale(f32x4 (&acc)[2][2][4][2], const Unit& u, int plane, int wr, int wc, int fr, int fq) const {
        const __amdgpu_buffer_rsrc_t rs = __builtin_amdgcn_make_buffer_rsrc((void*)(R + (size_t)plane * R_PLANE), 0, 0x7fffffff, 0x00020000);
        int voff = (fr * D + 8 * fq) * 2; asm volatile("" : "+v"(voff));
        const int sbase = ((u.pm * 256 + wr * 64) * D + u.pn * 256 + wc * 32) * 2;
#pragma unroll
        for (int b0 = 0; b0 < 8; b0 += NB) {
            pg8::u32x4 w[NB][2];
#pragma unroll
            for (int i = 0; i < NB; ++i)
#pragma unroll
                for (int bj = 0; bj < 2; ++bj) { const int ai = (b0 + i) >> 2, m = (b0 + i) & 3;
                    w[i][bj] = __builtin_amdgcn_raw_buffer_load_b128(rs, voff + bj * 256, sbase + (ai * 128 + m * 16) * D * 2, 0); }
#pragma unroll
            for (int i = 0; i < NB; ++i)
#pragma unroll
                for (int bj = 0; bj < 2; ++bj) { const int ai = (b0 + i) >> 2, m = (b0 + i) & 3; const pg8::u32x4 v = w[i][bj];
                    acc[ai][bj][m][0] *= (f32x4){bflo(v.x), bfhi(v.x), bflo(v.y), bfhi(v.y)};
                    acc[ai][bj][m][1] *= (f32x4){bflo(v.z), bfhi(v.z), bflo(v.w), bfhi(v.w)};
                    asm volatile("" : "+v"(acc[ai][bj][m][0]), "+v"(acc[ai][bj][m][1])); }
            asm volatile("" ::: "memory"); }
    }
    __device__ __forceinline__ void hook(f32x4 (&acc)[2][2][4][2], const Unit& u, int g, int wr, int wc, int fr, int fq) const { scale<4>(acc, u, g - 1, wr, wc, fr, fq); }
    __device__ __forceinline__ void operator()(f32x4 (&acc)[2][2][4][2], const Unit& u, int wr, int wc, int fr, int fq) const {
        scale<4>(acc, u, 3, wr, wc, fr, fq);
        const int row0 = u.pm * 256 + wr * 64 + fr, col0 = u.pn * 256 + wc * 32 + 8 * fq;
#pragma unroll
        for (int ai = 0; ai < 2; ++ai)
#pragma unroll
            for (int m = 0; m < 4; ++m) { bf16* rowp = O + (size_t)(row0 + ai * 128 + m * 16) * D + col0;
#pragma unroll
                for (int bj = 0; bj < 2; ++bj) { const f32x4 v0 = acc[ai][bj][m][0], v1 = acc[ai][bj][m][1];
                    pg8::u32x4 w; w.x = pg8::cvt_pk_bf16(v0[0], v0[1]); w.y = pg8::cvt_pk_bf16(v0[2], v0[3]); w.z = pg8::cvt_pk_bf16(v1[0], v1[1]); w.w = pg8::cvt_pk_bf16(v1[2], v1[3]);
                    *(pg8::u32x4*)(rowp + bj * 128) = w; } }
    }
};
struct EpiRes {
    static constexpr bool PERM = false, HOOK = false;
    float* H; bf16* HB; unsigned long long* ssa;
    __device__ __forceinline__ void operator()(f32x4 (&acc)[2][2][4][2], const Unit& u, int wr, int wc, int fr, int fq) const {
        const int row0 = u.pm * 256 + wr * 64 + fr, col0 = u.pn * 256 + wc * 32 + 4 * fq;
#pragma unroll
        for (int ai = 0; ai < 2; ++ai)
#pragma unroll
            for (int m = 0; m < 4; ++m) { const int row = row0 + ai * 128 + m * 16; const size_t off = (size_t)row * D + col0; float s = 0.f;
#pragma unroll
                for (int bj = 0; bj < 2; ++bj)
#pragma unroll
                    for (int n = 0; n < 2; ++n) { const size_t o = off + bj * 128 + n * 16; const f32x4 h = *(const f32x4*)(H + o) + acc[ai][bj][m][n];
                        *(f32x4*)(H + o) = h; pg8::u32x2 w; w.x = pg8::cvt_pk_bf16(h[0], h[1]); w.y = pg8::cvt_pk_bf16(h[2], h[3]); *(pg8::u32x2*)(HB + o) = w;
                        s += (h[0] * h[0] + h[1] * h[1]) + (h[2] * h[2] + h[3] * h[3]); }
                { const int ln = fq * 16 + fr; s += shf(s, ln ^ 16); s += shf(s, ln ^ 32); }
                if (fq == 0) atomicAdd(ssa + row, (unsigned long long)((double)s * 4294967296.0)); }
    }
};
struct EpiQ {
    static constexpr bool PERM = true, HOOK = false;
    bf16* O; const unsigned long long* ssa;
    __device__ __forceinline__ void operator()(f32x4 (&acc)[2][2][4][2], const Unit& u, int wr, int wc, int fr, int fq) const {
        const int row0 = u.pm * 256 + wr * 64 + fr, col0 = u.pn * 256 + wc * 32 + 8 * fq;
#pragma unroll
        for (int ai = 0; ai < 2; ++ai)
#pragma unroll
            for (int m = 0; m < 4; ++m) { const int row = row0 + ai * 128 + m * 16; const float rs = rsqrtf(ssa_to_f(ssa[row]) * (1.0f / D) + EPS);
                bf16* rowp = O + (size_t)row * D + col0;
#pragma unroll
                for (int bj = 0; bj < 2; ++bj) { const f32x4 v0 = acc[ai][bj][m][0] * rs, v1 = acc[ai][bj][m][1] * rs;
                    pg8::u32x4 w; w.x = pg8::cvt_pk_bf16(v0[0], v0[1]); w.y = pg8::cvt_pk_bf16(v0[2], v0[3]); w.z = pg8::cvt_pk_bf16(v1[0], v1[1]); w.w = pg8::cvt_pk_bf16(v1[2], v1[3]);
                    *(pg8::u32x4*)(rowp + bj * 128) = w; } }
    }
};

__device__ __forceinline__ int colmap_in(int j) {
    if (j < 1536) return j;
    if (j < 5120) return j + 4;
    const int c = (j - 5120) & 255, T = (j - 5120) >> 8;
    const int g = 2 * (c >> 7) + ((c >> 2) & 1), d = 64 * T + 16 * ((c >> 5) & 3) + 4 * ((c >> 3) & 3) + (c & 3);
    return 5124 + g * 2048 + d;
}
template <bool MAP>
__device__ __forceinline__ void tr_item(const float* W, int ldw, const float* scale, bf16* WT, int ldt, int dcol0, LAS float* scr, int k0, int n0, int lane) {
    const int q = lane & 7, r8 = lane >> 3, sc = MAP ? colmap_in(n0 + 4 * q) : (n0 + 4 * q);
    f32x4 v[8];
#pragma unroll
    for (int i = 0; i < 8; ++i) v[i] = *(const f32x4*)(W + (size_t)(k0 + 8 * i + r8) * ldw + sc);
    f32x4 s0 = {1.f, 1.f, 1.f, 1.f}, s1 = s0;
    if (scale) { s0 = *(const f32x4*)(scale + k0 + 8 * q); s1 = *(const f32x4*)(scale + k0 + 8 * q + 4); }
#pragma unroll
    for (int i = 0; i < 8; ++i)
#pragma unroll
        for (int e = 0; e < 4; ++e) scr[(8 * i + r8) * 33 + 4 * q + e] = v[i][e];
    asm volatile("s_waitcnt lgkmcnt(0)" ::: "memory");
    const int c = q;
#pragma unroll
    for (int j = 0; j < 4; ++j) { const int n = r8 + 8 * j; const LAS float* s = scr + (8 * c) * 33 + n;
        v4u o; o.x = pk2(s[0 * 33] * s0[0], s[1 * 33] * s0[1]); o.y = pk2(s[2 * 33] * s0[2], s[3 * 33] * s0[3]); o.z = pk2(s[4 * 33] * s1[0], s[5 * 33] * s1[1]); o.w = pk2(s[6 * 33] * s1[2], s[7 * 33] * s1[3]);
        *(v4u*)(WT + (size_t)(n0 + n) * ldt + dcol0 + k0 + 8 * c) = o; }
    asm volatile("s_waitcnt lgkmcnt(0)" ::: "memory");
}
constexpr size_t WS_BAR = 512 * 1024;
#define XB_TMO      128
#define XB_XCNT(j)  (256  + 64 * (j))
#define XB_XSUB(j)  (1280 + 64 * (j))
#define XB_XGEN(j)  (2304 + 64 * (j))
#define XB_TOP      3328
#define XB_TOPGEN   3392
#define XCD_BAR_WORDS 3456
#define XB_SPIN_CAP (1u << 23)
__device__ __forceinline__ unsigned xb_ld(unsigned* p)              { return __hip_atomic_load(p, __ATOMIC_RELAXED, __HIP_MEMORY_SCOPE_AGENT); }
__device__ __forceinline__ unsigned xb_add(unsigned* p, unsigned v) { return __hip_atomic_fetch_add(p, v, __ATOMIC_RELAXED, __HIP_MEMORY_SCOPE_AGENT); }
__device__ __forceinline__ unsigned xb_xcc_id() { return (unsigned)__builtin_amdgcn_s_getreg((3 << 11) | 20) & 0xFu; }
#define XB_SPIN(cond, bar) do { unsigned _sp = 0; while (cond) { __builtin_amdgcn_s_sleep(1); \
    if ((++_sp & 255u) == 0u) { if (xb_ld(&(bar)[XB_TMO])) break; if (_sp > XB_SPIN_CAP) { atomicAdd(&(bar)[XB_TMO], 1u); break; } } } } while (0)
__device__ __forceinline__ void xcd_barrier_complete(unsigned* bar, unsigned x, unsigned G, unsigned& nloc, unsigned& nx) {
    unsigned sum, cnt, mine, sp = 0u;
    for (;;) {
        sum = 0u; cnt = 0u; mine = 0u;
#pragma unroll
        for (unsigned j = 0; j < 16; ++j) { const unsigned c = xb_ld(&bar[XB_XCNT(j)]); sum += c; cnt += (c > 0u) ? 1u : 0u; mine = (j == x) ? c : mine; }
        if (sum == G) break;
        __builtin_amdgcn_s_sleep(1);
        if ((++sp & 255u) == 0u) { if (xb_ld(&bar[XB_TMO])) break; if (sp > XB_SPIN_CAP) { atomicAdd(&bar[XB_TMO], 1u); break; } }
    }
    nloc = mine > 0u ? mine : 1u; nx = cnt > 0u ? cnt : 1u;
}
__device__ __forceinline__ void xcd_barrier(unsigned* bar, unsigned x, unsigned G, volatile LAS unsigned* st, int wave) {
    asm volatile("s_waitcnt vmcnt(0)" ::: "memory");
    __syncthreads();
    int lane; asm volatile("v_mbcnt_lo_u32_b32 %0, -1, 0\n\tv_mbcnt_hi_u32_b32 %0, -1, %0" : "=v"(lane));
    if (wave == 0 && lane == 0) {
        __builtin_amdgcn_s_waitcnt(0);
        unsigned nloc = st[0], nx = st[1];
        if (nloc == 0u) { xcd_barrier_complete(bar, x, G, nloc, nx); st[0] = nloc; st[1] = nx; }
        const unsigned old = xb_add(&bar[XB_XSUB(x)], 1u);
        const unsigned gen = old / nloc;
        if (old + 1u == (gen + 1u) * nloc) {
            __builtin_amdgcn_fence(__ATOMIC_RELEASE, "agent");
            asm volatile("s_waitcnt vmcnt(0)" ::: "memory");
            const unsigned og = xb_add(&bar[XB_TOP], 1u);
            const unsigned tg = og / nx;
            if (og + 1u == (tg + 1u) * nx) xb_add(&bar[XB_TOPGEN], 1u);
            else XB_SPIN(xb_ld(&bar[XB_TOPGEN]) == tg, bar);
            __builtin_amdgcn_fence(__ATOMIC_ACQUIRE, "agent");
            xb_add(&bar[XB_XGEN(x)], 1u);
            asm volatile("s_waitcnt vmcnt(0)" ::: "memory");
        } else {
            XB_SPIN(xb_ld(&bar[XB_XGEN(x)]) == gen, bar);
            __builtin_amdgcn_fence(__ATOMIC_ACQUIRE, "agent");
            asm volatile("s_waitcnt vmcnt(0)" ::: "memory");
        }
    }
    __syncthreads();
}
namespace att {
constexpr int D = 128, NW = 8, QBLK = 32, KVBLK = 64, QB = NW * QBLK;
constexpr int PITCH = 512, OPITCH = 2048;
constexpr float SCALE = 0.08838834764831845f, THR = 8.f;
constexpr int SHM_V = KVBLK * D * 2, SHM_K = KVBLK * D * 2;
constexpr int OFF_WS = 2 * SHM_V + 2 * SHM_K, OFF_CUM = OFF_WS + NW * 64 * 4, OFF_REL = OFF_CUM + 2048 * 4, LDS_END = OFF_REL + 320 * 4;
typedef unsigned short bf16;
typedef short bf16x8 __attribute__((ext_vector_type(8)));
typedef short s16x4 __attribute__((ext_vector_type(4)));
typedef float f32x16 __attribute__((ext_vector_type(16)));
typedef float f32x4 __attribute__((ext_vector_type(4)));
typedef unsigned u32x4 __attribute__((ext_vector_type(4)));
#define ALDS __attribute__((address_space(3)))

#define KSWZ(row, colB) ((row) * 256 + ((colB) ^ (((row) & 7) << 4)))
#define SBAR() __builtin_amdgcn_sched_barrier(0)
__device__ __forceinline__ int v_st(int k, int c) { const int kk = (k & ~0xC) | ((k & 4) << 1) | ((k & 8) >> 1); return ((kk >> 3) * 4 + (c >> 5)) * 512 + ((kk & 7) * 32 + (c & 31)) * 2; }
__device__ __forceinline__ int v_rd_base(int lane) { return ((lane & 3) << 3) | (((lane >> 2) & 3) << 6) | (((lane >> 4) & 1) << 5) | (((lane >> 5) & 1) << 8); }
constexpr int v_rd_off(int d0, int ks, int half) { return d0 * 512 + ks * 4096 + half * 2048; }
__device__ __forceinline__ int crow(int r, int hi) { return (r & 3) + 8 * (r >> 2) + 4 * hi; }
__device__ __forceinline__ unsigned cvtpk(float lo, float hi) { unsigned r; asm volatile("v_cvt_pk_bf16_f32 %0, %1, %2" : "=v"(r) : "v"(lo), "v"(hi)); return r; }
__device__ __forceinline__ bf16x8 load8(const bf16* p) { return *reinterpret_cast<const bf16x8*>(p); }

__device__ __forceinline__ void mask_tile(f32x16& p0, f32x16& p1, int dq) {
    const float NEG = -__builtin_inff();
#pragma unroll
    for (int r = 0; r < 16; ++r) { const int c = (r & 3) + 8 * (r >> 2);
        if (dq - c < 0) p0[r] = NEG;
        if (dq - c - 32 < 0) p1[r] = NEG; }
}
__device__ __forceinline__ void partialSM(f32x16& p0, f32x16& p1, float& m_reg, float& mn, float& alpha) {
    float pmax = p0[0];
#pragma unroll
    for (int r = 1; r < 16; ++r) pmax = fmaxf(pmax, p0[r]);
#pragma unroll
    for (int r = 0; r < 16; ++r) pmax = fmaxf(pmax, p1[r]);
    { auto rr = __builtin_amdgcn_permlane32_swap(__float_as_uint(pmax), __float_as_uint(pmax), false, false);
      pmax = fmaxf(__uint_as_float(rr[0]), __uint_as_float(rr[1])); }
    constexpr float C2 = 1.4426950408889634f * SCALE;
    if (__builtin_expect(__all((pmax - m_reg) * SCALE <= THR), 1)) { mn = m_reg; alpha = 1.f; }
    else { mn = fmaxf(m_reg, pmax); alpha = __builtin_amdgcn_exp2f((m_reg - mn) * C2); m_reg = mn; }
    const float mnL = -mn * C2;
#pragma unroll
    for (int r = 0; r < 16; ++r) p0[r] = fmaf(p0[r], C2, mnL);
#pragma unroll
    for (int r = 0; r < 16; ++r) p1[r] = fmaf(p1[r], C2, mnL);
#pragma unroll
    for (int r = 0; r < 16; ++r) p0[r] = __builtin_amdgcn_exp2f(p0[r]);
}
__device__ __forceinline__ void finishSM(f32x16& p0, f32x16& p1, float alpha, float& l_reg, bf16x8& pa0, bf16x8& pa1, bf16x8& pa2, bf16x8& pa3) {
#pragma unroll
    for (int r = 0; r < 16; ++r) p1[r] = __builtin_amdgcn_exp2f(p1[r]);
    float ps = 0;
#pragma unroll
    for (int r = 0; r < 16; ++r) ps += p0[r];
#pragma unroll
    for (int r = 0; r < 16; ++r) ps += p1[r];
    { auto rr = __builtin_amdgcn_permlane32_swap(__float_as_uint(ps), __float_as_uint(ps), false, false);
      ps = __uint_as_float(rr[0]) + __uint_as_float(rr[1]); }
    l_reg = l_reg * alpha + ps;
#define PK4(P, B_, OUT) do { unsigned a0 = cvtpk(P[B_+0], P[B_+1]), a1 = cvtpk(P[B_+2], P[B_+3]);                          \
        unsigned b0 = cvtpk(P[B_+4], P[B_+5]), b1 = cvtpk(P[B_+6], P[B_+7]);                                             \
        auto r0 = __builtin_amdgcn_permlane32_swap(a0, b0, false, false); auto r1 = __builtin_amdgcn_permlane32_swap(a1, b1, false, false); \
        u32x4 w = {r0[0], r1[0], r0[1], r1[1]}; OUT = *reinterpret_cast<bf16x8*>(&w); } while (0)
    PK4(p0, 0, pa0); PK4(p0, 8, pa1); PK4(p1, 0, pa2); PK4(p1, 8, pa3);
#undef PK4
}
template <int KB>
__device__ __forceinline__ void qkt(f32x16& p0, f32x16& p1, const ALDS char* K_lds, int r32, int hi, const bf16x8* qr, bool act) {
    if (!act) { const float NEG = -__builtin_inff();
#pragma unroll
        for (int r = 0; r < 16; ++r) { p0[r] = NEG; p1[r] = NEG; } return; }
    p0 = f32x16{}; p1 = f32x16{};
    const ALDS char* kb[4];
#pragma unroll
    for (int dd = 0; dd < 4; ++dd) kb[dd] = K_lds + KB * SHM_K + KSWZ(r32, (dd * 16 + hi * 8) * 2);
#pragma unroll
    for (int d0 = 0; d0 < 8; ++d0) { const ALDS char* a = kb[d0 & 3] + (d0 >> 2) * 128;
        bf16x8 b0 = *(const ALDS bf16x8*)(a);
        bf16x8 b1 = *(const ALDS bf16x8*)(a + 32 * 256);
        p0 = __builtin_amdgcn_mfma_f32_32x32x16_bf16(b0, qr[d0], p0, 0, 0, 0);
        p1 = __builtin_amdgcn_mfma_f32_32x32x16_bf16(b1, qr[d0], p1, 0, 0, 0); }
}
template <int VB>
__device__ __forceinline__ void pv_tile(f32x16* o, int vb0, bf16x8 pa0, bf16x8 pa1, bf16x8 pa2, bf16x8 pa3, bool act) {
    if (!act) return;
#define TRRD(dst, off) asm volatile("ds_read_b64_tr_b16 %0, %1 offset:%2" : "=&v"(dst) : "v"(vb0), "i"(off) : "memory")
#define PV_D0(d0) do { s16x4 l0, l1, l2, l3, h0, h1, h2, h3; constexpr int b_ = VB * SHM_V + v_rd_off(d0, 0, 0); \
        TRRD(l0, b_); TRRD(h0, b_ + 2048); TRRD(l1, b_ + 4096); TRRD(h1, b_ + 6144); TRRD(l2, b_ + 8192); TRRD(h2, b_ + 10240); TRRD(l3, b_ + 12288); TRRD(h3, b_ + 14336); \
        asm volatile("s_waitcnt lgkmcnt(0)" ::: "memory"); SBAR(); \
        o[d0] = __builtin_amdgcn_mfma_f32_32x32x16_bf16(pa0, (bf16x8){l0[0], l0[1], l0[2], l0[3], h0[0], h0[1], h0[2], h0[3]}, o[d0], 0, 0, 0);   \
        o[d0] = __builtin_amdgcn_mfma_f32_32x32x16_bf16(pa1, (bf16x8){l1[0], l1[1], l1[2], l1[3], h1[0], h1[1], h1[2], h1[3]}, o[d0], 0, 0, 0);   \
        o[d0] = __builtin_amdgcn_mfma_f32_32x32x16_bf16(pa2, (bf16x8){l2[0], l2[1], l2[2], l2[3], h2[0], h2[1], h2[2], h2[3]}, o[d0], 0, 0, 0);   \
        o[d0] = __builtin_amdgcn_mfma_f32_32x32x16_bf16(pa3, (bf16x8){l3[0], l3[1], l3[2], l3[3], h3[0], h3[1], h3[2], h3[3]}, o[d0], 0, 0, 0); } while (0)
    PV_D0(0); PV_D0(1); PV_D0(2); PV_D0(3);
#undef PV_D0
#undef TRRD
}
template <int MODE>
__device__ __forceinline__ void bias_mask(f32x16& p0, f32x16& p1, const ALDS char* lds, int kb, int qlo, int qpos, int hi, float cqs, bool act) {
    if (!act) return;
    if (MODE == 0) {
        const ALDS float* cs = (const ALDS float*)(lds + OFF_CUM) + kb + 4 * hi;
#pragma unroll
        for (int g = 0; g < 4; ++g) { const f32x4 c0 = *(const ALDS f32x4*)(cs + 8 * g), c1 = *(const ALDS f32x4*)(cs + 32 + 8 * g);
#pragma unroll
            for (int e = 0; e < 4; ++e) { p0[4 * g + e] += cqs - c0[e]; p1[4 * g + e] += cqs - c1[e]; } }
        if (kb + KVBLK - 1 > qlo) mask_tile(p0, p1, qpos - 4 * hi - kb);
    } else {
        const ALDS float* tb = (const ALDS float*)(lds + OFF_REL);
        if (qlo - (kb + KVBLK - 1) >= 256) { const float c = tb[319];
#pragma unroll
            for (int r = 0; r < 16; ++r) { p0[r] += c; p1[r] += c; } }
        else { const int d0 = qpos - kb - 4 * hi + 63;
#pragma unroll
            for (int r = 0; r < 16; ++r) { const int c = (r & 3) + 8 * (r >> 2);
                int i0 = d0 - c, i1 = d0 - c - 32; i0 = i0 > 319 ? 319 : i0; i1 = i1 > 319 ? 319 : i1; i1 = i1 < 0 ? 0 : i1; i0 = i0 < 0 ? 0 : i0;
                p0[r] += tb[i0]; p1[r] += tb[i1]; } }
    }
}

struct Seam { bf16x8 qr[8]; bf16x8 st_v0, st_v1, st_k0, st_k1; };
#define VMW() asm volatile("s_waitcnt vmcnt(0)" ::: "memory")
#define BL8(rs, vo, so) __builtin_bit_cast(bf16x8, __builtin_amdgcn_raw_buffer_load_b128(rs, vo, so, 0))
#define SLOAD_H(Kp, Vp, k0) do { S.st_v0 = BL8(rP, kvoff, (Vp) + (k0) * (PITCH * 2)); S.st_v1 = BL8(rP, kvoff, (Vp) + ((k0) + 32) * (PITCH * 2));              \
                         S.st_k0 = BL8(rP, kvoff, (Kp) + (k0) * (PITCH * 2)); S.st_k1 = BL8(rP, kvoff, (Kp) + ((k0) + 32) * (PITCH * 2)); } while (0)
#define SWRITE_HK(bf) do { *(ALDS bf16x8*)(K_lds + (bf) * SHM_K + kws) = S.st_k0; *(ALDS bf16x8*)(K_lds + (bf) * SHM_K + kws + 32 * 256) = S.st_k1; } while (0)
#define SWRITE_HV(bf) do { *(ALDS bf16x8*)(V_lds + (bf) * SHM_V + vst0) = S.st_v0; *(ALDS bf16x8*)(V_lds + (bf) * SHM_V + vst1) = S.st_v1; } while (0)
#define SWRITE_H(bf) do { SWRITE_HV(bf); SWRITE_HK(bf); } while (0)

template <int MODE>
__device__ __forceinline__ void attn_unit(const bf16* Pb, int Qo, int Kh, int Vh, bf16* Yb, int Oo, int P0, int j_lo, int j_hi, ALDS char* lds, int wid, int lane) {
    const int tid = wid * 64 + lane, r32 = lane & 31, hi = lane >> 5;
    const int NT = j_hi - j_lo;
    const int qlo = P0 + wid * QBLK, qpos = qlo + r32;
    ALDS char* V_lds = lds; ALDS char* K_lds = lds + 2 * SHM_V;
    ALDS float* ws = (ALDS float*)(lds + OFF_WS) + wid * 64; ALDS float* li_l = ws; ALDS float* al_l = ws + 32;
    float m_reg = -1e30f, l_reg = 0; f32x16 o[4] = {};
    const int sr = tid >> 4, sc = (tid & 15) * 8, vst0 = v_st(sr, sc), vst1 = v_st(32 + sr, sc), kws = KSWZ(sr, sc * 2);
    const int vb0 = (int)(unsigned)(size_t)V_lds + v_rd_base(lane);
    Seam S;
    const __amdgpu_buffer_rsrc_t rP = __builtin_amdgcn_make_buffer_rsrc((void*)Pb, 0, 0x7fffffff, 0x00020000);
    const __amdgpu_buffer_rsrc_t rO = __builtin_amdgcn_make_buffer_rsrc((void*)Yb, 0, 0x7fffffff, 0x00020000);
    const int kvoff = (sr * PITCH + sc) * 2;
#define KBASE(t) ((j_lo + (t)) * KVBLK)
#define ACT(t) (MODE == 0 ? (KBASE(t) <= qlo + QBLK - 1) : ((j_lo + (t)) <= (qlo >> 6) && (j_lo + (t)) + 8 >= (qlo >> 6)))
#define RESC(a) do { if (__any((a) < 1.f)) { if (hi == 0) al_l[r32] = (a); asm volatile("s_waitcnt lgkmcnt(0)" ::: "memory");              \
                     for (int d_ = 0; d_ < 4; ++d_) for (int r = 0; r < 16; ++r) o[d_][r] *= al_l[crow(r, hi)]; } } while (0)
#define MASKT(P0_, P1_, t) bias_mask<MODE>(P0_, P1_, lds, KBASE(t), qlo, qpos, hi, cq_, ACT(t))
    {
        const int kb0 = j_lo * KVBLK;
#pragma unroll
        for (int d0 = 0; d0 < 8; ++d0) S.qr[d0] = BL8(rP, (r32 * PITCH + hi * 8) * 2 + d0 * 32, Qo + wid * (QBLK * PITCH * 2));
        SLOAD_H(Kh, Vh, kb0); VMW(); SWRITE_HK(0);
        __syncthreads();
    }
    const float cq_ = MODE == 0 ? ((const ALDS float*)(lds + OFF_CUM))[qpos] : 0.f;
    f32x16 pA0, pA1, pB0, pB1; float mnA, mnB, alA, alB; bf16x8 pa0, pa1, pa2, pa3;
    SWRITE_HV(0); SBAR();
    if (NT > 1) { SLOAD_H(Kh, Vh, KBASE(1)); }
    SBAR(); qkt<0>(pA0, pA1, K_lds, r32, hi, S.qr, ACT(0));
    MASKT(pA0, pA1, 0); partialSM(pA0, pA1, m_reg, mnA, alA);
    if (NT > 1) { VMW(); SWRITE_H(1); }
    __syncthreads();
#define HALF_STEP(PX0, PX1, mnX, alX, PY0, PY1, alY, t, KB, VB, SB) do {                                                      \
        SBAR(); qkt<KB>(PX0, PX1, K_lds, r32, hi, S.qr, ACT(t));                                                              \
        finishSM(PY0, PY1, alY, l_reg, pa0, pa1, pa2, pa3); SBAR();                                                           \
        if ((t) + 1 < NT) { SLOAD_H(Kh, Vh, KBASE((t) + 1)); SBAR(); }                                                        \
        pv_tile<VB>(o, vb0, pa0, pa1, pa2, pa3, ACT((t) - 1)); MASKT(PX0, PX1, (t)); partialSM(PX0, PX1, m_reg, mnX, alX);    \
        __syncthreads();                                                                                                      \
        if ((t) + 1 < NT) { VMW(); SWRITE_H(SB); }                                                                            \
        RESC(alX); __syncthreads(); } while (0)
    for (int t = 1; t + 1 < NT; t += 2) {
        HALF_STEP(pB0, pB1, mnB, alB, pA0, pA1, alA, t, 1, 0, 0);
        HALF_STEP(pA0, pA1, mnA, alA, pB0, pB1, alB, t + 1, 0, 1, 1);
    }
    const bool even = (NT & 1) == 0;
    if (even) { SBAR(); qkt<1>(pB0, pB1, K_lds, r32, hi, S.qr, ACT(NT - 1)); SBAR(); }
    finishSM(pA0, pA1, alA, l_reg, pa0, pa1, pa2, pa3); SBAR();
    pv_tile<0>(o, vb0, pa0, pa1, pa2, pa3, ACT(even ? NT - 2 : NT - 1));
    if (even) { MASKT(pB0, pB1, NT - 1); partialSM(pB0, pB1, m_reg, mnB, alB); __syncthreads(); RESC(alB);
        finishSM(pB0, pB1, alB, l_reg, pa0, pa1, pa2, pa3); SBAR(); pv_tile<1>(o, vb0, pa0, pa1, pa2, pa3, ACT(NT - 1)); }
    SBAR();
    if (hi == 0) li_l[r32] = l_reg; asm volatile("s_waitcnt lgkmcnt(0)" ::: "memory");
    float rli[16];
#pragma unroll
    for (int r = 0; r < 16; ++r) rli[r] = __builtin_amdgcn_rcpf(li_l[crow(r, hi)]);
    const int ovoff = (4 * hi * OPITCH + r32) * 2, osoff = Oo + wid * (QBLK * OPITCH * 2);
#pragma unroll
    for (int r = 0; r < 16; ++r) { const int orow = (r & 3) + 8 * (r >> 2);
#pragma unroll
        for (int d0 = 0; d0 < 4; ++d0) { const float v = o[d0][r] * rli[r];
            const float vn = __builtin_bit_cast(float, __builtin_amdgcn_ds_bpermute((lane ^ 1) << 2, __builtin_bit_cast(int, v)));
            if ((r32 & 1) == 0) __builtin_amdgcn_raw_buffer_store_b32(cvtpk(v, vn), rO, ovoff + d0 * 64, osoff + orow * (OPITCH * 2), 0); } }
    __syncthreads();
#undef RESC
#undef KBASE
#undef ACT
#undef MASKT
#undef HALF_STEP
}
#undef BL8
#undef VMW
#undef SLOAD_H
#undef SWRITE_HK
#undef SWRITE_HV
#undef SWRITE_H
#undef KSWZ
#undef SBAR
}
constexpr size_t WS_QCTR = 768 * 1024;
constexpr size_t WS_POOLW = 4 * MiB;
constexpr int N_ATT_UNITS = 256, N_POOL_UNITS = 512, N_CONV_UNITS = 128;

__device__ __forceinline__ void stage_cum(const Args& a, int b, int h, LAS char* lds, int wave, int lane) {
    const float* logf = (const float*)(a.ws + WS_LOGF) + ((size_t)b * SEQ) * 4 + h;
    const int tid = wave * 64 + lane;
    float v[4];
#pragma unroll
    for (int e = 0; e < 4; ++e) v[e] = logf[(size_t)(4 * tid + e) * 4];
    v[1] += v[0]; v[2] += v[1]; v[3] += v[2];
    float incl = v[3];
#pragma unroll
    for (int o = 1; o < 64; o <<= 1) { const float t = shf(incl, lane >= o ? lane - o : lane); if (lane >= o) incl += t; }
    LAS float* wt = (LAS float*)(lds + att::OFF_WS);
    if (lane == 63) wt[wave] = incl;
    __syncthreads();
    float base = incl - v[3];
    for (int w = 0; w < wave; ++w) base += wt[w];
    LAS float* cs = (LAS float*)(lds + att::OFF_CUM);
    const float inv = 1.0f / ATT_SCALE;
    *(LAS f32x4*)(cs + 4 * tid) = (f32x4){(base + v[0]) * inv, (base + v[1]) * inv, (base + v[2]) * inv, (base + v[3]) * inv};
    __syncthreads();
}
__device__ __forceinline__ void attention_item(const Args& a, int l, int u, LAS char* lds, int wave) {
    int lane; asm volatile("v_mbcnt_lo_u32_b32 %0, -1, 0\n\tv_mbcnt_hi_u32_b32 %0, -1, %0" : "=v"(lane));
    const bf16* P = (const bf16*)(a.ws + WS_PROJ); bf16* Y = (bf16*)(a.ws + WS_Y);
    const int mode = u >> 7, v = u & 127, qb = 7 - (v >> 4), bh = v & 15, b = bh >> 2, h = bh & 3;
    const size_t row0 = (size_t)b * SEQ; const int P0 = qb * 256;
    if (mode == 0) {
        stage_cum(a, b, h, lds, wave, lane);
        att::attn_unit<0>(P, (int)((0 * PROJ_T + (row0 + P0) * MIXW + h * HD) * 2), (int)((1 * PROJ_T + row0 * MIXW + h * HD) * 2), (int)((2 * PROJ_T + row0 * MIXW + h * HD) * 2),
                          Y, (int)(((row0 + P0) * D + h * HD) * 2), P0, 0, 4 * qb + 4, lds, wave, lane);
    } else {
        const int tid = wave * 64 + lane;
        if (tid < 320) ((LAS float*)(lds + att::OFF_REL))[tid] = a.rel_bias[((size_t)l * 4 + h) * 320 + tid] * (1.0f / ATT_SCALE);
        const int jlo = 4 * qb - 8 < 0 ? 0 : 4 * qb - 8;
        att::attn_unit<1>(P, (int)((7 * PROJ_T + (row0 + P0) * MIXW + h * HD) * 2), (int)((8 * PROJ_T + row0 * MIXW + h * HD) * 2), (int)((9 * PROJ_T + row0 * MIXW + h * HD) * 2),
                          Y, (int)(((row0 + P0) * D + 1536 + h * HD) * 2), P0, jlo, 4 * qb + 4, lds, wave, lane);
    }
}
__device__ __forceinline__ void pool_item(const Args& a, int l, int u, LAS char* lds, int wave) {
    int lane; asm volatile("v_mbcnt_lo_u32_b32 %0, -1, 0\n\tv_mbcnt_hi_u32_b32 %0, -1, %0" : "=v"(lane));
    const int g = u & 3, T0 = (u >> 2) * 64, tid = wave * 64 + lane;
    const bf16* Pin = (const bf16*)(a.ws + WS_PROJ) + 3 * PROJ_T + g * 128;
    {
        const int cp = tid & 63, run = tid >> 6, w = 2 << g, t0 = T0 + run * 8, s0 = t0 & (SEQ - 1);
        const bf16* col = Pin + 2 * cp;
        float s_lo = 0.f, s_hi = 0.f;
        for (int j = 1; j < w; ++j) if (s0 - j >= 0) { const unsigned x = *(const unsigned*)(col + (size_t)(t0 - j) * MIXW); s_lo += bflo(x); s_hi += bfhi(x); }
#pragma unroll
        for (int i = 0; i < 8; ++i) { const unsigned x = *(const unsigned*)(col + (size_t)(t0 + i) * MIXW); s_lo += bflo(x); s_hi += bfhi(x);
            const int s = s0 + i; const int cnt = s + 1 < w ? s + 1 : w; const float inv = 1.0f / (float)cnt;
            *(LAS unsigned*)(lds + (run * 8 + i) * 272 + 4 * cp) = pk2(s_lo * inv - bflo(x), s_hi * inv - bfhi(x));
            if (s - w + 1 >= 0) { const unsigned y = *(const unsigned*)(col + (size_t)(t0 + i - w + 1) * MIXW); s_lo -= bflo(y); s_hi -= bfhi(y); } }
    }
    __syncthreads();
    {
        typedef short bf16x8 __attribute__((ext_vector_type(8)));
        const bf16* Wt = (const bf16*)(a.ws + WS_POOLW) + ((size_t)l * 4 + g) * 128 * 128;
        const int rt = (wave & 3) * 16, db = (wave >> 2) * 64, fr = lane & 15, kg = lane >> 4;
        f32x4 acc[4] = {};
#pragma unroll
        for (int ks = 0; ks < 4; ++ks) { const bf16x8 af = *(const LAS bf16x8*)(lds + (rt + fr) * 272 + (ks * 32 + kg * 8) * 2);
#pragma unroll
            for (int nt = 0; nt < 4; ++nt) { const bf16x8 bfr = *(const bf16x8*)(Wt + (size_t)(db + nt * 16 + fr) * 128 + ks * 32 + kg * 8);
                acc[nt] = __builtin_amdgcn_mfma_f32_16x16x32_bf16(bfr, af, acc[nt], 0, 0, 0); } }
        bf16* Y = (bf16*)(a.ws + WS_Y) + (size_t)(T0 + rt + fr) * D + 512 + g * 128;
#pragma unroll
        for (int nt = 0; nt < 4; ++nt) { const int d = db + nt * 16 + kg * 4; const f32x4 sc = *(const f32x4*)(a.pool_scale + l * MIXW + g * 128 + d);
            v2u w; w.x = pk2(acc[nt][0] * sc[0], acc[nt][1] * sc[1]); w.y = pk2(acc[nt][2] * sc[2], acc[nt][3] * sc[3]); *(v2u*)(Y + d) = w; }
    }
    __syncthreads();
}
__device__ __forceinline__ void conv_item(const Args& a, int l, int u, int wave) {
    int lane; asm volatile("v_mbcnt_lo_u32_b32 %0, -1, 0\n\tv_mbcnt_hi_u32_b32 %0, -1, %0" : "=v"(lane));
    const bf16* P = (const bf16*)(a.ws + WS_PROJ); const bf16* Ch = P + 4 * PROJ_T; const bf16* Cb = P + 5 * PROJ_T; const bf16* Cc = P + 6 * PROJ_T;
    const int tid = wave * 64 + lane, c0 = (tid & 63) * 8, t0 = u * 64 + (tid >> 6) * 8, s0 = t0 & (SEQ - 1);
    float wgt[3][8];
#pragma unroll
    for (int j = 0; j < 3; ++j) { const float* w = a.conv_w + ((size_t)l * 3 + j) * MIXW + c0; const f32x4 w0 = *(const f32x4*)w, w1 = *(const f32x4*)(w + 4);
#pragma unroll
        for (int k = 0; k < 4; ++k) { wgt[j][k] = w0[k]; wgt[j][4 + k] = w1[k]; } }
    float z2[8], z1[8];
#pragma unroll
    for (int k = 0; k < 8; ++k) { z2[k] = 0.f; z1[k] = 0.f; }
#pragma unroll
    for (int i = -2; i < 8; ++i) {
        float z[8];
        if (s0 + i >= 0) { const v4u hv = *(const v4u*)(Ch + (size_t)(t0 + i) * MIXW + c0), cv = *(const v4u*)(Cc + (size_t)(t0 + i) * MIXW + c0);
            z[0] = bflo(hv.x) * bflo(cv.x); z[1] = bfhi(hv.x) * bfhi(cv.x); z[2] = bflo(hv.y) * bflo(cv.y); z[3] = bfhi(hv.y) * bfhi(cv.y);
            z[4] = bflo(hv.z) * bflo(cv.z); z[5] = bfhi(hv.z) * bfhi(cv.z); z[6] = bflo(hv.w) * bflo(cv.w); z[7] = bfhi(hv.w) * bfhi(cv.w); }
        else {
#pragma unroll
            for (int k = 0; k < 8; ++k) z[k] = 0.f; }
        if (i >= 0) { const v4u bv = *(const v4u*)(Cb + (size_t)(t0 + i) * MIXW + c0); float o[8];
            const float bb[8] = {bflo(bv.x), bfhi(bv.x), bflo(bv.y), bfhi(bv.y), bflo(bv.z), bfhi(bv.z), bflo(bv.w), bfhi(bv.w)};
#pragma unroll
            for (int k = 0; k < 8; ++k) o[k] = bb[k] * (wgt[0][k] * z2[k] + wgt[1][k] * z1[k] + wgt[2][k] * z[k]);
            v4u ov; ov.x = pk2(o[0], o[1]); ov.y = pk2(o[2], o[3]); ov.z = pk2(o[4], o[5]); ov.w = pk2(o[6], o[7]);
            *(v4u*)((bf16*)(a.ws + WS_Y) + (size_t)(t0 + i) * D + 1024 + c0) = ov; }
#pragma unroll
        for (int k = 0; k < 8; ++k) { z2[k] = z1[k]; z1[k] = z[k]; }
    }
}
__device__ __forceinline__ void mixers_fast(const Args& a, int lq, LAS char* lds, int wave, int lane, int G, int blk) {
    const int l = lq & 1;
    for (int u = blk; u < N_ATT_UNITS; u += G) attention_item(a, l, u, lds, wave);
    unsigned* head = (unsigned*)(a.ws + WS_QCTR) + 64 * lq;
    volatile LAS unsigned* slot = (volatile LAS unsigned*)(lds + att::LDS_END);
    for (;;) {
        if (wave == 0 && lane == 0) *slot = __hip_atomic_fetch_add(head, 1u, __ATOMIC_RELAXED, __HIP_MEMORY_SCOPE_AGENT);
        __syncthreads();
        const unsigned it = *slot;
        __syncthreads();
        if (it >= (unsigned)(N_POOL_UNITS + N_CONV_UNITS)) break;
        if (it < (unsigned)N_POOL_UNITS) pool_item(a, l, (int)it, lds, wave); else conv_item(a, l, (int)it - N_POOL_UNITS, wave);
    }
}
__device__ __forceinline__ void p0_prologue(const Args& a, LAS unsigned char* lds, int gw, int NGW, int wave, int lane) {
    unsigned char* ws = a.ws;
    LAS float* scr = (LAS float*)(lds + wave * 16384);
    constexpr int I_WIN = (D / 64) * (NPROJ / 32), I_SQ = (D / 64) * (D / 32), I_BR = (MIXW / 64) * (D / 32);
    constexpr int I_LAYER = I_WIN + 4 * I_BR + 2 * I_SQ;
    for (int it = gw; it < DEPTH * I_LAYER; it += NGW) {
        const int l = it / I_LAYER; int r = it - l * I_LAYER;
        if (r < I_WIN) { const int kb = r / (NPROJ / 32), nb = r % (NPROJ / 32);
            tr_item<true>(a.w_in + (size_t)l * D * INW, INW, a.norm_mix + l * D, (bf16*)(ws + WS_WIN + l * WIN_BYTES), D, 0, scr, 64 * kb, 32 * nb, lane); continue; }
        r -= I_WIN;
        if (r < 4 * I_BR) { const int g = r / I_BR, rr = r % I_BR, kb = rr / (D / 32), nb = rr % (D / 32);
            tr_item<false>(a.w_branch + ((size_t)l * 4 + g) * MIXW * D, D, nullptr, (bf16*)(ws + WS_WBR + l * SQ_BYTES), D, g * MIXW, scr, 64 * kb, 32 * nb, lane); continue; }
        r -= 4 * I_BR;
        if (r < I_SQ) { const int kb = r / (D / 32), nb = r % (D / 32);
            tr_item<false>(a.w_out + (size_t)l * D * D, D, nullptr, (bf16*)(ws + WS_WOUT + l * SQ_BYTES), D, 0, scr, 64 * kb, 32 * nb, lane); continue; }
        r -= I_SQ;
        { const int kb = r / (D / 32), nb = r % (D / 32);
            tr_item<false>(a.peer_wq + (size_t)l * D * D, D, a.norm_ffn + l * D, (bf16*)(ws + WS_WQ + l * SQ_BYTES), D, 0, scr, 64 * kb, 32 * nb, lane); }
    }
    for (int it = gw; it < DEPTH * 4 * 8; it += NGW) { const int lg = it >> 3, r = it & 7;
        tr_item<false>(a.pool_w + (size_t)lg * 128 * 128, 128, nullptr, (bf16*)(ws + WS_POOLW) + (size_t)lg * 128 * 128, 128, 0, scr, 64 * (r >> 2), 32 * (r & 3), lane); }
    {
        constexpr int NR = 2 * DEPTH * PEER_E;
        f32x4 nv[8];
        if (gw < NR) { const int t = gw / (DEPTH * PEER_E), row = gw - t * (DEPTH * PEER_E); const float* src = (t ? a.peer_v : a.peer_u) + (size_t)row * D + 4 * lane;
#pragma unroll
            for (int j = 0; j < 8; ++j) nv[j] = *(const f32x4*)(src + 256 * j); }
        for (int r = gw; r < NR; r += NGW) { const int t = r / (DEPTH * PEER_E), row = r - t * (DEPTH * PEER_E);
            f32x4 v[8]; float am = 0.f;
#pragma unroll
            for (int j = 0; j < 8; ++j) v[j] = nv[j];
            { const int r2 = r + NGW; if (r2 < NR) { const int t2 = r2 / (DEPTH * PEER_E), row2 = r2 - t2 * (DEPTH * PEER_E); const float* src = (t2 ? a.peer_v : a.peer_u) + (size_t)row2 * D + 4 * lane;
#pragma unroll
                for (int j = 0; j < 8; ++j) nv[j] = *(const f32x4*)(src + 256 * j); } }
#pragma unroll
            for (int j = 0; j < 8; ++j) am = fmaxf(am, fmaxf(fmaxf(fabsf(v[j][0]), fabsf(v[j][1])), fmaxf(fabsf(v[j][2]), fabsf(v[j][3]))));
            am = wave_max(am, lane);
            const float inv = am > 0.f ? 127.0f / am : 0.f, off = t ? 128.f : 0.f;
            unsigned char* dst = ws + (t ? WS_PV : WS_PU) + (size_t)row * D + 4 * lane;
#pragma unroll
            for (int j = 0; j < 8; ++j) { const int q0 = (int)(rintf(v[j][0] * inv) + off), q1 = (int)(rintf(v[j][1] * inv) + off), q2 = (int)(rintf(v[j][2] * inv) + off), q3 = (int)(rintf(v[j][3] * inv) + off);
                *(unsigned*)(dst + 256 * j) = (unsigned)(q0 & 255) | ((unsigned)(q1 & 255) << 8) | ((unsigned)(q2 & 255) << 16) | ((unsigned)(q3 & 255) << 24); }
            if (lane == 0) ((float*)(ws + (t ? WS_SV : WS_SU)))[row] = am * (1.0f / 127.0f); }
    }
    { bf16* pk = (bf16*)(ws + WS_PK); const size_t n8 = (size_t)DEPTH * 8 * 2 * 128 * 128 / 8;
      for (size_t i = (size_t)gw * 64 + lane; i < n8; i += (size_t)NGW * 64) { const f32x4 v0 = *(const f32x4*)(a.peer_keys + i * 8), v1 = *(const f32x4*)(a.peer_keys + i * 8 + 4);
          v4u o; o.x = pk2(v0[0], v0[1]); o.y = pk2(v0[2], v0[3]); o.z = pk2(v1[0], v1[1]); o.w = pk2(v1[2], v1[3]); *(v4u*)(pk + i * 8) = o; } }
    {
        float* wf = (float*)(ws + WS_WF); float* binr = (float*)(ws + WS_BINR);
        const int gt = gw * 64 + lane, NGT = NGW * 64;
        for (int i = gt; i < DEPTH * 4 * D; i += NGT) { const int l = i / (4 * D), h = (i / D) & 3, k = i % D; wf[i] = a.w_in[(size_t)l * D * INW + (size_t)k * INW + 1536 + h] * a.norm_mix[l * D + k]; }
        for (int i = gt; i < DEPTH * NPROJ; i += NGT) { const int l = i / NPROJ, j = i % NPROJ; binr[i] = a.b_in[l * INW + colmap_in(j)]; }
    }
    {
        float* H = (float*)(ws + WS_H); bf16* HB = (bf16*)(ws + WS_HB); float* ssq = (float*)(ws + WS_SSQ);
        for (int m = gw; m < M; m += NGW) { float s = 0.f;
#pragma unroll
            for (int j = 0; j < 8; ++j) { const size_t o = (size_t)m * D + j * 256 + lane * 4; const f32x4 v = *(const f32x4*)(a.x + o); *(f32x4*)(H + o) = v;
                v2u w; w.x = pk2(v[0], v[1]); w.y = pk2(v[2], v[3]); *(v2u*)(HB + o) = w; s += (v[0] * v[0] + v[1] * v[1]) + (v[2] * v[2] + v[3] * v[3]); }
            s = wave_sum(s, lane); if (lane == 0) ssq[m] = s; }
    }
}

__device__ __forceinline__ void forget_logits(const Args& a, int l, int gw, int NGW, int lane) {
    unsigned char* ws = a.ws; const bf16* HB = (const bf16*)(ws + WS_HB); const float* wf = (const float*)(ws + WS_WF) + l * 4 * D; const float* ssq = (const float*)(ws + WS_SSQ) + l * M;
    float* logf = (float*)(ws + WS_LOGF);
    for (int m = gw; m < M; m += NGW) {
        float d[4] = {0.f, 0.f, 0.f, 0.f};
#pragma unroll
        for (int j = 0; j < 4; ++j) { const int k0 = j * 512 + lane * 8; const v4u xv = *(const v4u*)(HB + (size_t)m * D + k0);
            const float x[8] = {bflo(xv.x), bfhi(xv.x), bflo(xv.y), bfhi(xv.y), bflo(xv.z), bfhi(xv.z), bflo(xv.w), bfhi(xv.w)};
#pragma unroll
            for (int h = 0; h < 4; ++h) { const f32x4 w0 = *(const f32x4*)(wf + h * D + k0), w1 = *(const f32x4*)(wf + h * D + k0 + 4);
                d[h] += x[0] * w0[0] + x[1] * w0[1] + x[2] * w0[2] + x[3] * w0[3] + x[4] * w1[0] + x[5] * w1[1] + x[6] * w1[2] + x[7] * w1[3]; } }
        const float rs = rsqrtf(ssq[m] * (1.0f / D) + EPS);
#pragma unroll
        for (int h = 0; h < 4; ++h) { const float z = wave_sum(d[h], lane) * rs + a.b_in[l * INW + 1536 + h];
            const float ls = fminf(z, 0.f) - log1pf(__expf(-fabsf(z)));
            if (lane == h) logf[m * 4 + h] = ls; }
    }
}
__device__ __forceinline__ void cum_scan(const Args& a, int gw, int lane) {
    if (gw >= 16) return;
    const float* logf = (const float*)(a.ws + WS_LOGF); float* cum = (float*)(a.ws + WS_CUM);
    const int b = gw >> 2, h = gw & 3; float run = 0.f;
    for (int c = 0; c < SEQ / 64; ++c) { float v = logf[(size_t)(b * SEQ + c * 64 + lane) * 4 + h];
#pragma unroll
        for (int o = 1; o < 64; o <<= 1) { const float t = shf(v, lane >= o ? lane - o : lane); if (lane >= o) v += t; }
        v += run; cum[(size_t)gw * SEQ + c * 64 + lane] = v; run = shf(v, 63); }
}

template <int MODE>
__device__ __forceinline__ void naive_attn(const Args& a, int l, int b, int h, int s, LAS float* sc, int lane) {
    const unsigned char* ws = a.ws; const bf16* P = (const bf16*)(ws + WS_PROJ);
    const bf16* Qp = P + (MODE ? 7 : 0) * PROJ_T; const bf16* Kp = P + (MODE ? 8 : 1) * PROJ_T; const bf16* Vp = P + (MODE ? 9 : 2) * PROJ_T;
    const float* cum = (const float*)(ws + WS_CUM) + (size_t)(b * 4 + h) * SEQ;
    const float* rb = a.rel_bias + ((size_t)l * 4 + h) * 320;
    const size_t tb = (size_t)b * SEQ;
    int klo = 0, khi = s;
    if (MODE) { const int c = s >> 6; klo = (c - 8) * 64; if (klo < 0) klo = 0; khi = c * 64 + 63; }
    const bf16* qrow = Qp + (tb + s) * MIXW + h * HD;
    float mx = -3.0e38f;
    for (int kb = klo; kb <= khi; kb += 64) { const int k = kb + lane;
        if (k <= khi) { const bf16* krow = Kp + (tb + k) * MIXW + h * HD; float d = 0.f;
#pragma unroll 4
            for (int c8 = 0; c8 < 16; ++c8) { const v4u qv = *(const v4u*)(qrow + c8 * 8), kv = *(const v4u*)(krow + c8 * 8);
                d = dot2_bf16(qv.x, kv.x, d); d = dot2_bf16(qv.y, kv.y, d); d = dot2_bf16(qv.z, kv.z, d); d = dot2_bf16(qv.w, kv.w, d); }
            float bias;
            if (MODE == 0) bias = cum[s] - cum[k];
            else { int rel = s - k; rel = rel < -63 ? -63 : (rel > 256 ? 256 : rel); bias = rb[rel + 63]; }
            const float lg = d * ATT_SCALE + bias; sc[k - klo] = lg; mx = fmaxf(mx, lg); } }
    mx = wave_max(mx, lane);
    asm volatile("s_waitcnt lgkmcnt(0)" ::: "memory");
    float sum = 0.f;
    for (int kb = klo; kb <= khi; kb += 64) { const int k = kb + lane; if (k <= khi) { const float p = __expf(sc[k - klo] - mx); sc[k - klo] = p; sum += p; } }
    sum = wave_sum(sum, lane);
    asm volatile("s_waitcnt lgkmcnt(0)" ::: "memory");
    float o0 = 0.f, o1 = 0.f;
    for (int k = klo; k <= khi; ++k) { const float p = sc[k - klo]; const unsigned v = *(const unsigned*)(Vp + (tb + k) * MIXW + h * HD + 2 * lane); o0 += p * bflo(v); o1 += p * bfhi(v); }
    const float inv = 1.0f / sum;
    bf16* Y = (bf16*)(a.ws + WS_Y);
    *(unsigned*)(Y + (tb + s) * D + (MODE ? 1536 : 0) + h * HD + 2 * lane) = pk2(o0 * inv, o1 * inv);
    asm volatile("s_waitcnt lgkmcnt(0)" ::: "memory");
}
__device__ __forceinline__ void naive_pool(const Args& a, int l, int t, int g, LAS float* sc, int lane) {
    const bf16* Pin = (const bf16*)(a.ws + WS_PROJ) + 3 * PROJ_T;
    const int s = t & (SEQ - 1), w = 2 << g; const int cnt = (s + 1 < w) ? s + 1 : w;
    float s0 = 0.f, s1 = 0.f;
    for (int j = 0; j < cnt; ++j) { const unsigned v = *(const unsigned*)(Pin + (size_t)(t - j) * MIXW + g * 128 + 2 * lane); s0 += bflo(v); s1 += bfhi(v); }
    const unsigned v0 = *(const unsigned*)(Pin + (size_t)t * MIXW + g * 128 + 2 * lane);
    const float inv = 1.0f / (float)cnt;
    sc[2 * lane] = s0 * inv - bflo(v0); sc[2 * lane + 1] = s1 * inv - bfhi(v0);
    asm volatile("s_waitcnt lgkmcnt(0)" ::: "memory");
    const float* W = a.pool_w + ((size_t)l * 4 + g) * 128 * 128;
    float o0 = 0.f, o1 = 0.f;
    for (int c = 0; c < 128; ++c) { const float p = sc[c]; const f32x2 wv = *(const f32x2*)(W + c * 128 + 2 * lane); o0 += p * wv[0]; o1 += p * wv[1]; }
    const f32x2 ps = *(const f32x2*)(a.pool_scale + l * MIXW + g * 128 + 2 * lane);
    bf16* Y = (bf16*)(a.ws + WS_Y);
    *(unsigned*)(Y + (size_t)t * D + 512 + g * 128 + 2 * lane) = pk2(o0 * ps[0], o1 * ps[1]);
    asm volatile("s_waitcnt lgkmcnt(0)" ::: "memory");
}
__device__ __forceinline__ void naive_conv(const Args& a, int l, int t, int lane) {
    const bf16* P = (const bf16*)(a.ws + WS_PROJ); const bf16* Ch = P + 4 * PROJ_T; const bf16* Cb = P + 5 * PROJ_T; const bf16* Cc = P + 6 * PROJ_T;
    const int s = t & (SEQ - 1), c0 = lane * 8;
    float acc[8] = {0.f, 0.f, 0.f, 0.f, 0.f, 0.f, 0.f, 0.f};
#pragma unroll
    for (int j = 0; j < 3; ++j) { const int dt = 2 - j;
        if (s - dt >= 0) { const v4u hv = *(const v4u*)(Ch + (size_t)(t - dt) * MIXW + c0), cv = *(const v4u*)(Cc + (size_t)(t - dt) * MIXW + c0);
            const float* w = a.conv_w + ((size_t)l * 3 + j) * MIXW + c0; const f32x4 w0 = *(const f32x4*)w, w1 = *(const f32x4*)(w + 4);
            acc[0] += w0[0] * bflo(hv.x) * bflo(cv.x); acc[1] += w0[1] * bfhi(hv.x) * bfhi(cv.x); acc[2] += w0[2] * bflo(hv.y) * bflo(cv.y); acc[3] += w0[3] * bfhi(hv.y) * bfhi(cv.y);
            acc[4] += w1[0] * bflo(hv.z) * bflo(cv.z); acc[5] += w1[1] * bfhi(hv.z) * bfhi(cv.z); acc[6] += w1[2] * bflo(hv.w) * bflo(cv.w); acc[7] += w1[3] * bfhi(hv.w) * bfhi(cv.w); } }
    const v4u bv = *(const v4u*)(Cb + (size_t)t * MIXW + c0);
    v4u o; o.x = pk2(acc[0] * bflo(bv.x), acc[1] * bfhi(bv.x)); o.y = pk2(acc[2] * bflo(bv.y), acc[3] * bfhi(bv.y)); o.z = pk2(acc[4] * bflo(bv.z), acc[5] * bfhi(bv.z)); o.w = pk2(acc[6] * bflo(bv.w), acc[7] * bfhi(bv.w));
    *(v4u*)((bf16*)(a.ws + WS_Y) + (size_t)t * D + 1024 + c0) = o;
}
__device__ __forceinline__ void mixers_naive(const Args& a, int l, LAS unsigned char* lds, int gw, int NGW, int wave, int lane) {
    LAS float* sc = (LAS float*)(lds + wave * 8192);
    for (int i = gw; i < M * 4; i += NGW) { const int t = M * 4 - 1 - i; const int h = t & 3, tok = t >> 2; naive_attn<0>(a, l, tok >> 11, h, tok & (SEQ - 1), sc, lane); }
    for (int i = gw; i < M * 4; i += NGW) { const int h = i & 3, tok = i >> 2; naive_attn<1>(a, l, tok >> 11, h, tok & (SEQ - 1), sc, lane); }
    for (int i = gw; i < M * 4; i += NGW) naive_pool(a, l, i >> 2, i & 3, sc, lane);
    for (int i = gw; i < M; i += NGW) naive_conv(a, l, i, lane);
}

#ifndef PROBE
#define PROBE 0
#endif
__device__ __forceinline__ float gelu_tanh(float x) { const float u = 1.5957691216057308f * (x + 0.044715f * x * x * x); return x / (1.0f + __expf(-u)); }
constexpr int PEER_TOK = 32;
constexpr int PL_IDX = 0, PL_GATE = PEER_TOK * 128 * 4, PL_TAB = 2 * PEER_TOK * 128 * 4;
__device__ __forceinline__ int f2key(float f) { const int b = __builtin_bit_cast(int, f); return b ^ ((b >> 31) & 0x7fffffff); }
__device__ __forceinline__ float key2f(int k) { return __builtin_bit_cast(float, k ^ ((k >> 31) & 0x7fffffff)); }
#define CE_DESC(x, y) do { const int hi_ = (x) > (y) ? (x) : (y), lo_ = (x) > (y) ? (y) : (x); (x) = hi_; (y) = lo_; } while (0)
__device__ __forceinline__ void sort16_desc(int* v) {
#pragma unroll
    for (int k = 2; k <= 16; k <<= 1)
#pragma unroll
        for (int j = k >> 1; j > 0; j >>= 1)
#pragma unroll
            for (int i = 0; i < 16; ++i) { const int l = i ^ j; if (l > i) { if ((i & k) == 0) CE_DESC(v[i], v[l]); else CE_DESC(v[l], v[i]); } }
}
__device__ __forceinline__ void merge_top16(int* a, const int* b) {
#pragma unroll
    for (int i = 0; i < 16; ++i) a[i] = a[i] > b[15 - i] ? a[i] : b[15 - i];
#pragma unroll
    for (int j = 8; j > 0; j >>= 1)
#pragma unroll
        for (int i = 0; i < 16; ++i) { const int l = i ^ j; if (l > i) CE_DESC(a[i], a[l]); }
}
__device__ __forceinline__ void top16_of_64(int* v) {
    sort16_desc(v); sort16_desc(v + 16); sort16_desc(v + 32); sort16_desc(v + 48);
    merge_top16(v, v + 16); merge_top16(v + 32, v + 48); merge_top16(v, v + 32);
}
constexpr int cand_slot(int i, int j) {
    int n = 0;
    for (int a = 0; a < 16; ++a) for (int b = 0; b < 16; ++b) { if ((a + 1) * (b + 1) <= 16) { if (a == i && b == j) return n; ++n; } }
    return -1;
}
__device__ __forceinline__ void peer_retrieve(const Args& a, int l, int t0, int h, LAS char* lds, int wave) {
    typedef short bf16x8 __attribute__((ext_vector_type(8)));
    typedef float f32x16 __attribute__((ext_vector_type(16)));
    int lane; asm volatile("v_mbcnt_lo_u32_b32 %0, -1, 0\n\tv_mbcnt_hi_u32_b32 %0, -1, %0" : "=v"(lane));
    const int r32 = lane & 31, hi = lane >> 5, hi4 = hi * 4;
    const bf16* Q = (const bf16*)(a.ws + WS_Q) + (size_t)(t0 + r32) * D + h * 256 + hi * 8;
    const bf16* PK = (const bf16*)(a.ws + WS_PK) + ((size_t)(l * 8 + h) * 2) * 128 * 128 + (size_t)r32 * 128 + hi * 8;
    int top[2][16];
#pragma unroll
    for (int p = 0; p < 2; ++p) {
        f32x16 acc[4] = {};
        bf16x8 qf[8];
#pragma unroll
        for (int cs = 0; cs < 8; ++cs) qf[cs] = *(const bf16x8*)(Q + p * 128 + cs * 16);
#pragma unroll
        for (int kb = 0; kb < 4; ++kb) { bf16x8 kf[8];
#pragma unroll
            for (int cs = 0; cs < 8; ++cs) kf[cs] = *(const bf16x8*)(PK + (size_t)p * 128 * 128 + (size_t)kb * 32 * 128 + cs * 16);
#pragma unroll
            for (int cs = 0; cs < 8; ++cs) acc[kb] = __builtin_amdgcn_mfma_f32_32x32x16_bf16(kf[cs], qf[cs], acc[kb], 0, 0, 0); }
        int v[64];
#pragma unroll
        for (int kb = 0; kb < 4; ++kb)
#pragma unroll
            for (int r = 0; r < 16; ++r) { const int c = kb * 32 + (r & 3) + 8 * (r >> 2);
                v[kb * 16 + r] = (f2key(acc[kb][r]) & ~127) | (c | hi4); }
        top16_of_64(v);
        int mine[16], other[16];
#pragma unroll
        for (int i = 0; i < 16; ++i) { auto rr = __builtin_amdgcn_permlane32_swap((unsigned)v[i], (unsigned)v[i], false, false); mine[i] = (int)rr[0]; other[i] = (int)rr[1]; }
        merge_top16(mine, other);
#pragma unroll
        for (int i = 0; i < 16; ++i) top[p][i] = mine[i];
    }
    LAS int* tab = (LAS int*)(lds + PL_TAB) + (wave * 64 + lane) * 32;
    float sA[16], sB[16];
#pragma unroll
    for (int i = 0; i < 16; ++i) { sA[i] = key2f(top[0][i] & ~127); sB[i] = key2f(top[1][i] & ~127); tab[i] = top[0][i] & 127; tab[16 + i] = top[1][i] & 127; }
    int c[64];
#pragma unroll
    for (int n = 0; n < 64; ++n) c[n] = (int)0x80000000;
#pragma unroll
    for (int i = 0; i < 16; ++i)
#pragma unroll
        for (int j = 0; j < 16; ++j) if ((i + 1) * (j + 1) <= 16) c[cand_slot(i, j)] = (f2key(sA[i] + sB[j]) & ~255) | (16 * i + j);
    top16_of_64(c);
    float ex[16]; float sum = 0.f; const float mx = key2f(c[0] & ~255);
#pragma unroll
    for (int w = 0; w < 16; ++w) { ex[w] = __expf(key2f(c[w] & ~255) - mx); sum += ex[w]; }
    const float inv = 1.0f / sum;
    asm volatile("s_waitcnt lgkmcnt(0)" ::: "memory");
    LAS int* oi = (LAS int*)(lds + PL_IDX) + r32 * 128 + h * 16; LAS float* og = (LAS float*)(lds + PL_GATE) + r32 * 128 + h * 16;
#pragma unroll
    for (int w = 0; w < 16; ++w) { const int id = c[w] & 255; const int e = tab[id >> 4] * 128 + tab[16 + (id & 15)];
        if ((w >> 3) == hi) { oi[w] = e; og[w] = ex[w] * inv; } }
}
__device__ __forceinline__ void peer_token(const Args& a, int l, int t, bool last_layer, LAS char* lds, int tl, bool dry = false) {
    int lane; asm volatile("v_mbcnt_lo_u32_b32 %0, -1, 0\n\tv_mbcnt_hi_u32_b32 %0, -1, %0" : "=v"(lane));
    unsigned char* ws = a.ws;
    const int idxv[2] = {((const LAS int*)(lds + PL_IDX))[tl * 128 + lane], ((const LAS int*)(lds + PL_IDX))[tl * 128 + 64 + lane]};
    const float gatv[2] = {((const LAS float*)(lds + PL_GATE))[tl * 128 + lane], ((const LAS float*)(lds + PL_GATE))[tl * 128 + 64 + lane]};
    asm volatile("v_mbcnt_lo_u32_b32 %0, -1, 0\n\tv_mbcnt_hi_u32_b32 %0, -1, %0" : "=v"(lane));
    const unsigned long long* ssa1 = (const unsigned long long*)(ws + WS_SSA) + l * M;
    const float rs = rsqrtf(ssa_to_f(ssa1[t]) * (1.0f / D) + EPS);
    const bf16* HB = (const bf16*)(ws + WS_HB) + (size_t)t * D; const float* gn = a.norm_ffn + l * D;
    int xh[8], xl[8]; float sx;
    {
        float xf[32]; float am = 0.f;
#pragma unroll
        for (int i = 0; i < 2; ++i) { const int k0 = 16 * lane + 1024 * i; const v4u h0 = *(const v4u*)(HB + k0), h1 = *(const v4u*)(HB + k0 + 8);
            const unsigned hw[8] = {h0.x, h0.y, h0.z, h0.w, h1.x, h1.y, h1.z, h1.w};
#pragma unroll
            for (int q = 0; q < 4; ++q) { const f32x4 g = *(const f32x4*)(gn + k0 + 4 * q);
                xf[16 * i + 4 * q + 0] = bflo(hw[2 * q]) * rs * g[0]; xf[16 * i + 4 * q + 1] = bfhi(hw[2 * q]) * rs * g[1];
                xf[16 * i + 4 * q + 2] = bflo(hw[2 * q + 1]) * rs * g[2]; xf[16 * i + 4 * q + 3] = bfhi(hw[2 * q + 1]) * rs * g[3]; } }
#pragma unroll
        for (int k = 0; k < 32; ++k) am = fmaxf(am, fabsf(xf[k]));
        am = wave_max(am, lane);
        sx = am * (1.0f / 127.0f); const float inv = am > 0.f ? 127.0f / am : 0.f;
#pragma unroll
        for (int d = 0; d < 8; ++d) { unsigned ph = 0, pl = 0;
#pragma unroll
            for (int b = 0; b < 4; ++b) { const float s = xf[4 * d + b] * inv, hq = rintf(s), lq = rintf((s - hq) * 128.0f);
                ph |= ((unsigned)((int)hq & 255)) << (8 * b); pl |= ((unsigned)((int)lq & 255)) << (8 * b); }
            xh[d] = (int)ph; xl[d] = (int)pl; }
    }
    const unsigned char* PU = ws + WS_PU + (size_t)l * PE_BYTES; const unsigned char* PV = ws + WS_PV + (size_t)l * PE_BYTES;
    const float* SU = (const float*)(ws + WS_SU) + l * PEER_E; const float* SV = (const float*)(ws + WS_SV) + l * PEER_E;
    const float suv[2] = {SU[idxv[0]], SU[idxv[1]]}, svv[2] = {SV[idxv[0]], SV[idxv[1]]};
    const __amdgpu_buffer_rsrc_t rU = __builtin_amdgcn_make_buffer_rsrc((void*)PU, 0, 0x7fffffff, 0x00020000), rV = __builtin_amdgcn_make_buffer_rsrc((void*)PV, 0, 0x7fffffff, 0x00020000);
    const int lo16 = 16 * lane;
#define PEER_LOADG(buf, T, g) do { const int sel_ = ((g) & 8) ? idxv[1] : idxv[0]; _Pragma("unroll") for (int j = 0; j < 8; ++j) { \
        const int e_ = __builtin_amdgcn_readlane(sel_, ((g) & 7) * 8 + j); \
        buf[j][0] = __builtin_amdgcn_raw_buffer_load_b128(T, lo16, e_ * D, 0); buf[j][1] = __builtin_amdgcn_raw_buffer_load_b128(T, lo16 + 1024, e_ * D, 0); } } while (0)
    float actv[2] = {0.f, 0.f};
    {
        v4u bA[8][2], bB[8][2];
#define PEER_UCOMP(buf, g) do { float p_[8]; _Pragma("unroll") for (int j = 0; j < 8; ++j) { int dh = 0, dl = 0; \
            _Pragma("unroll") for (int i = 0; i < 2; ++i) { \
                dh = __builtin_amdgcn_sdot4((int)buf[j][i].x, xh[4 * i + 0], dh, false); dl = __builtin_amdgcn_sdot4((int)buf[j][i].x, xl[4 * i + 0], dl, false); \
                dh = __builtin_amdgcn_sdot4((int)buf[j][i].y, xh[4 * i + 1], dh, false); dl = __builtin_amdgcn_sdot4((int)buf[j][i].y, xl[4 * i + 1], dl, false); \
                dh = __builtin_amdgcn_sdot4((int)buf[j][i].z, xh[4 * i + 2], dh, false); dl = __builtin_amdgcn_sdot4((int)buf[j][i].z, xl[4 * i + 2], dl, false); \
                dh = __builtin_amdgcn_sdot4((int)buf[j][i].w, xh[4 * i + 3], dh, false); dl = __builtin_amdgcn_sdot4((int)buf[j][i].w, xl[4 * i + 3], dl, false); } \
            p_[j] = (float)dh + (float)dl * (1.0f / 128.0f); } \
        float q_[4]; _Pragma("unroll") for (int k = 0; k < 4; ++k) { auto r_ = __builtin_amdgcn_permlane32_swap(__float_as_uint(p_[2 * k]), __float_as_uint(p_[2 * k + 1]), false, false); q_[k] = __uint_as_float(r_[0]) + __uint_as_float(r_[1]); } \
        float s_[2]; _Pragma("unroll") for (int k = 0; k < 2; ++k) { auto r_ = __builtin_amdgcn_permlane16_swap(__float_as_uint(q_[2 * k]), __float_as_uint(q_[2 * k + 1]), false, false); s_[k] = __uint_as_float(r_[0]) + __uint_as_float(r_[1]); } \
        _Pragma("unroll") for (int k = 0; k < 2; ++k) { s_[k] += shf(s_[k], lane ^ 8); s_[k] += shf(s_[k], lane ^ 4); s_[k] += shf(s_[k], lane ^ 2); s_[k] += shf(s_[k], lane ^ 1); } \
          \
        const int src_ = 16 * (((lane & 1) << 1) | ((lane >> 1) & 1)); const float v0_ = shf(s_[0], src_), v1_ = shf(s_[1], src_); \
        if ((lane >> 3) == ((g) & 7)) { const float v_ = (lane & 4) ? v1_ : v0_; if ((g) & 8) actv[1] = v_; else actv[0] = v_; } } while (0)
        PEER_LOADG(bA, rU, 0);
        for (int g = 0; g < 16; g += 2) {
            PEER_LOADG(bB, rU, g + 1);
            PEER_UCOMP(bA, g);
            if (g + 2 < 16) PEER_LOADG(bA, rU, g + 2);
            PEER_UCOMP(bB, g + 1);
        }
#undef PEER_UCOMP
    }
    float coef[2]; float csum;
    { const float a0 = actv[0] * suv[0] * sx, a1 = actv[1] * suv[1] * sx;
      coef[0] = gelu_tanh(a0) * gatv[0] * svv[0]; coef[1] = gelu_tanh(a1) * gatv[1] * svv[1]; csum = wave_sum(coef[0] + coef[1], lane); }
    float y[4][8];
#pragma unroll
    for (int i = 0; i < 4; ++i)
#pragma unroll
        for (int k = 0; k < 8; ++k) y[i][k] = 0.f;
    {
        v4u bA[8][2], bB[8][2];
#define PEER_VCOMP(buf, g) do { const float csel_ = ((g) & 8) ? coef[1] : coef[0]; _Pragma("unroll") for (int j = 0; j < 8; ++j) { \
            const float c_ = __builtin_bit_cast(float, __builtin_amdgcn_readlane(__builtin_bit_cast(int, csel_), ((g) & 7) * 8 + j)); \
            _Pragma("unroll") for (int i = 0; i < 2; ++i) { const unsigned w_[4] = {buf[j][i].x, buf[j][i].y, buf[j][i].z, buf[j][i].w}; \
                _Pragma("unroll") for (int d = 0; d < 4; ++d) { \
                    y[2 * i + (d >> 1)][4 * (d & 1) + 0] += c_ * (float)(w_[d] & 255u); y[2 * i + (d >> 1)][4 * (d & 1) + 1] += c_ * (float)((w_[d] >> 8) & 255u); \
                    y[2 * i + (d >> 1)][4 * (d & 1) + 2] += c_ * (float)((w_[d] >> 16) & 255u); y[2 * i + (d >> 1)][4 * (d & 1) + 3] += c_ * (float)(w_[d] >> 24); } } } } while (0)
        PEER_LOADG(bA, rV, 0);
        for (int g = 0; g < 16; g += 2) {
            PEER_LOADG(bB, rV, g + 1);
            PEER_VCOMP(bA, g);
            if (g + 2 < 16) PEER_LOADG(bA, rV, g + 2);
            PEER_VCOMP(bB, g + 1);
        }
#undef PEER_VCOMP
    }
#undef PEER_LOADG
    { const float corr = 128.0f * csum;
#pragma unroll
      for (int i = 0; i < 4; ++i)
#pragma unroll
          for (int k = 0; k < 8; ++k) y[i][k] -= corr; }
    float* H = (float*)(ws + WS_H) + (size_t)t * D; bf16* HBw = (bf16*)(ws + WS_HB) + (size_t)t * D;
    float s = 0.f;
#pragma unroll
    for (int q = 0; q < 4; ++q) { const int k0 = 16 * lane + 1024 * (q >> 1) + 8 * (q & 1); const f32x4 h0 = *(const f32x4*)(H + k0), h1 = *(const f32x4*)(H + k0 + 4);
#pragma unroll
        for (int k = 0; k < 4; ++k) { y[q][k] += h0[k]; y[q][4 + k] += h1[k]; }
#pragma unroll
        for (int k = 0; k < 8; ++k) s += y[q][k] * y[q][k]; }
    s = wave_sum(s, lane);
    if (dry) { H = (float*)(ws + WS_R) + (size_t)t * D; HBw = (bf16*)(ws + WS_R + 64 * MiB) + (size_t)t * D; }
    if (!last_layer || dry) {
        float* ssqn = (float*)(ws + WS_SSQ) + (l + 1) * M; if (lane == 0 && !dry) ssqn[t] = s;
#pragma unroll
        for (int q = 0; q < 4; ++q) { const int k0 = 16 * lane + 1024 * (q >> 1) + 8 * (q & 1); *(f32x4*)(H + k0) = (f32x4){y[q][0], y[q][1], y[q][2], y[q][3]}; *(f32x4*)(H + k0 + 4) = (f32x4){y[q][4], y[q][5], y[q][6], y[q][7]};
            v4u o; o.x = pk2(y[q][0], y[q][1]); o.y = pk2(y[q][2], y[q][3]); o.z = pk2(y[q][4], y[q][5]); o.w = pk2(y[q][6], y[q][7]); *(v4u*)(HBw + k0) = o; }
    } else {
        const float rf = rsqrtf(s * (1.0f / D) + EPS); float* O = a.out + (size_t)t * D;
#pragma unroll
        for (int q = 0; q < 4; ++q) { const int k0 = 16 * lane + 1024 * (q >> 1) + 8 * (q & 1); const f32x4 g0 = *(const f32x4*)(a.norm_final + k0), g1 = *(const f32x4*)(a.norm_final + k0 + 4);
            *(f32x4*)(O + k0) = (f32x4){y[q][0] * rf * g0[0], y[q][1] * rf * g0[1], y[q][2] * rf * g0[2], y[q][3] * rf * g0[3]};
            *(f32x4*)(O + k0 + 4) = (f32x4){y[q][4] * rf * g1[0], y[q][5] * rf * g1[1], y[q][6] * rf * g1[2], y[q][7] * rf * g1[3]}; }
    }
}

#define LANE_ID(x) asm volatile("v_mbcnt_lo_u32_b32 %0, -1, 0\n\tv_mbcnt_hi_u32_b32 %0, -1, %0" : "=v"(x))
__global__ void __launch_bounds__(NT, 2) mk_fwd(ArgsK a_in) {
    extern __shared__ __attribute__((aligned(16))) unsigned char lds_raw[];
    LAS unsigned char* lds = (LAS unsigned char*)lds_raw;
    cg::grid_group grid = cg::this_grid();
    grid.sync();
    const int wave0 = __builtin_amdgcn_readfirstlane(threadIdx.x >> 6);
    const int G = gridDim.x;
    const CAS ArgsK* ka = (const CAS ArgsK*)__builtin_amdgcn_kernarg_segment_ptr();
    size_t zoff = 0;
#define PHASE_BEGIN() int lane; LANE_ID(lane); int blk = blockIdx.x, Gp = G, wv = wave0; asm volatile("" : "+s"(zoff), "+s"(ka), "+s"(blk), "+s"(Gp), "+s"(wv)); const int wave = wv, gw = blk * NWAVES + wv, NGW = Gp * NWAVES; (void)gw; (void)NGW; const Args a = load_args(ka, zoff); unsigned char* const ws = a.ws; (void)ws
    volatile LAS unsigned* bst = (volatile LAS unsigned*)(lds + RING_BYTES + 1024);
    if (PROBE == 3) { PHASE_BEGIN(); p0_prologue(a, lds, gw, NGW, wave, lane); }
    { PHASE_BEGIN(); if (wave == 0 && lane == 0) { bst[0] = 0u; bst[1] = 0u; (void)xb_add((unsigned*)(ws + WS_BAR) + XB_XCNT(xb_xcc_id()), 1u); }
      p0_prologue(a, lds, gw, NGW, wave, lane); }
#define GRID_BAR() do { asm volatile("" : "+s"(zoff)); unsigned char* wsb_ = (unsigned char*)ka->ws + zoff; int wvb_ = wave0; asm volatile("" : "+s"(wvb_)); xcd_barrier((unsigned*)(wsb_ + WS_BAR), xb_xcc_id(), (unsigned)G, bst, wvb_); if (PROBE == 9) xcd_barrier((unsigned*)(wsb_ + WS_BAR), xb_xcc_id(), (unsigned)G, bst, wvb_); } while (0)
    GRID_BAR();
    int depth_rt = DEPTH; asm volatile("" : "+s"(depth_rt));
    for (int lc = 0; lc < depth_rt; ++lc) {
        int l = lc; asm volatile("" : "+s"(l));
        for (int rep = 0; rep < (PROBE == 4 ? 2 : 1); ++rep)
        {
            PHASE_BEGIN();
            float* ssq_mix = (float*)(ws + WS_SSQ) + l * M;
            pg8::Gemm g{(const bf16*)(ws + WS_HB), (const bf16*)(ws + WS_WIN + l * WIN_BYTES), M, NPROJ, D}; pg8::StaticOrder S; S.init(M, NPROJ, Gp, blk);
            EpiProj E{(bf16*)(ws + WS_PROJ), (bf16*)(ws + WS_R), (const float*)(ws + WS_BINR) + l * NPROJ, ssq_mix};
            pg8::gemm_phase<EpiProj, pg8::StaticOrder, true>(lds, g, S, E, wave);
            for (int r2 = 0; r2 < (PROBE == 8 ? 2 : 1); ++r2) forget_logits(a, l, gw, NGW, lane);
        }
        GRID_BAR();
        if (PROBE == 5) { PHASE_BEGIN(); mixers_fast(a, l + 2, (LAS char*)lds, wave, lane, Gp, blk); }
        { PHASE_BEGIN(); mixers_fast(a, l, (LAS char*)lds, wave, lane, Gp, blk); }
        GRID_BAR();
        for (int rep = 0; rep < (PROBE == 6 ? 2 : 1); ++rep)
        {
            PHASE_BEGIN();
            pg8::Gemm g{(const bf16*)(ws + WS_Y), (const bf16*)(ws + WS_WBR + l * SQ_BYTES), M, D, D}; pg8::StaticOrder S; S.init(M, D, Gp, blk);
            EpiMerge E{(const bf16*)(ws + WS_R), (bf16*)(ws + WS_MRG)};
            pg8::gemm_phase<EpiMerge, pg8::StaticOrder, false>(lds, g, S, E, wave);
        }
        GRID_BAR();
        {
            PHASE_BEGIN();
            pg8::Gemm g{(const bf16*)(ws + WS_MRG), (const bf16*)(ws + WS_WOUT + l * SQ_BYTES), M, D, D}; pg8::StaticOrder S; S.init(M, D, Gp, blk);
            EpiRes E{(float*)(ws + WS_H), (bf16*)(ws + WS_HB), (unsigned long long*)(ws + WS_SSA) + l * M};
            pg8::gemm_phase<EpiRes, pg8::StaticOrder, false>(lds, g, S, E, wave);
        }
        GRID_BAR();
        for (int rep = 0; rep < (PROBE == 7 ? 2 : 1); ++rep)
        {
            PHASE_BEGIN();
            pg8::Gemm g{(const bf16*)(ws + WS_HB), (const bf16*)(ws + WS_WQ + l * SQ_BYTES), M, D, D}; pg8::StaticOrder S; S.init(M, D, Gp, blk);
            EpiQ E{(bf16*)(ws + WS_Q), (const unsigned long long*)(ws + WS_SSA) + l * M};
            pg8::gemm_phase<EpiQ, pg8::StaticOrder, false>(lds, g, S, E, wave);
        }
        GRID_BAR();
        for (int rep = 0; rep < (PROBE == 1 ? 2 : 1); ++rep)
        {
            PHASE_BEGIN(); (void)lane;
            for (int t0 = blk * PEER_TOK; t0 < M; t0 += Gp * PEER_TOK) {
                for (int rr = 0; rr < (PROBE == 2 ? 2 : 1); ++rr) peer_retrieve(a, l, t0, wave, (LAS char*)lds, wave);
                __syncthreads();
                for (int k = 0; k < PEER_TOK / NWAVES; ++k) { const int tl = wave * (PEER_TOK / NWAVES) + k; peer_token(a, l, t0 + tl, l == depth_rt - 1, (LAS char*)lds, tl, PROBE == 1 && rep == 0); }
                __syncthreads();
            }
        }
        if (l + 1 < depth_rt) GRID_BAR();
    }
}

extern "C" void kernel_launch(void* const* d_in, const int* in_sizes, int n_in, void* d_out, int out_size, void* d_ws, size_t ws_size, hipStream_t stream) {
    static int grid = 0;
    if (grid == 0) {
        int dev = 0, cus = 0, per_cu = 0;
        if (n_in != 16 || out_size != M * D || ws_size < WS_END) { fprintf(stderr, "kernel_launch: unexpected shapes (n_in %d out %d ws %zu)\n", n_in, out_size, ws_size); grid = -1; return; }
        (void)hipGetDevice(&dev);
        (void)hipDeviceGetAttribute(&cus, hipDeviceAttributeMultiprocessorCount, dev);
        (void)hipFuncSetAttribute((const void*)mk_fwd, hipFuncAttributeMaxDynamicSharedMemorySize, LDS_BYTES);
        (void)hipOccupancyMaxActiveBlocksPerMultiprocessor(&per_cu, (const void*)mk_fwd, NT, LDS_BYTES);
        if (per_cu < 1) { fprintf(stderr, "kernel_launch: occupancy query says %d blocks per CU\n", per_cu); }
        grid = cus;
        if (grid > 256) grid = 256;
    }
    if (grid < 0) return;
    (void)hipMemsetAsync((char*)d_ws + WS_CTL, 0, CTL_ZERO_BYTES, stream);
    ArgsK a{};
    const GAS float** p = (const GAS float**)&a;
    for (int i = 0; i < 16; ++i) p[i] = (const GAS float*)d_in[i];
    a.out = (GAS float*)d_out; a.ws = (GAS unsigned char*)d_ws;
    void* args[] = {&a};
    hipError_t e = hipLaunchCooperativeKernel((const void*)mk_fwd, dim3(grid), dim3(NT), args, LDS_BYTES, stream);
    if (e != hipSuccess) fprintf(stderr, "cooperative launch failed: %s (grid %d)\n", hipGetErrorString(e), grid);
}
```

```cpp
#include <hip/hip_runtime.h>
#include <hip/hip_cooperative_groups.h>
#include <cstdio>
#include <cstdint>
namespace cg = cooperative_groups;
namespace pg8 {
#define PG8_LAS __attribute__((address_space(3)))
typedef unsigned short bf16_t;
typedef short bf16x8 __attribute__((ext_vector_type(8)));
typedef float f32x4 __attribute__((ext_vector_type(4)));
typedef unsigned u32x4 __attribute__((ext_vector_type(4)));
typedef unsigned u32x2 __attribute__((ext_vector_type(2)));
constexpr int BM = 256, BK = 64, HALF = 128, HTB = HALF * BK * 2  , STAGE_BYTES = 8 * HTB, NXCD = 8, WGM = 8;

__host__ __device__ __forceinline__ int lds_byte(int r, int c) { const int st = (r >> 4) * 2 + (c >> 5), rr = r & 15, cc = c & 31, ob = rr * 64 + cc * 2; return st * 1024 + (ob ^ (((ob >> 9) & 1) << 5)); }
__host__ __device__ __forceinline__ void stage_rc(int b, int& R, int& C) { const int st = b / 1024, sb = b % 1024, swz = sb ^ (((sb >> 9) & 1) << 5); R = (st >> 1) * 16 + swz / 64; C = (st & 1) * 32 + (swz % 64) / 2; }
__host__ __device__ __forceinline__ int perm32(int rho) { const int n = rho >> 4, i = rho & 15; return 8 * (i >> 2) + 4 * n + (i & 3); }

struct Unit { int pm, pn; };
struct Gemm { const bf16_t* A; const bf16_t* Bt; int M, N, K; };

struct StaticOrder {
    int nM, nN, nwg, G, c;
    __host__ __device__ void init(int M, int N, int G_, int c_) { nM = M / BM; nN = N / BM; nwg = nM * nN; G = G_; c = c_; }
    __host__ __device__ bool next(int i, Unit& u) const {
        const long L = (long)i * G + c; if (L >= nwg) return false;
        int wgid = (int)L; { const int q = nwg / NXCD, r = nwg % NXCD, xcd = wgid % NXCD, off = wgid / NXCD; wgid = (xcd < r ? xcd * (q + 1) : r * (q + 1) + (xcd - r) * q) + off; }
        const int nig = WGM * nN, gid = wgid / nig, fm = gid * WGM, gsz = (nM - fm) < WGM ? (nM - fm) : WGM;
        u.pm = fm + ((wgid % nig) % gsz); u.pn = (wgid % nig) / gsz; return true;
    }
};

__device__ __forceinline__ unsigned cvt_pk_bf16(float lo, float hi) { unsigned r; asm volatile("v_cvt_pk_bf16_f32 %0, %1, %2" : "=v"(r) : "v"(lo), "v"(hi)); return r; }

template <class Epi, class Sched, bool ALIGN_EPI = false>
__device__ __forceinline__ void gemm_phase(PG8_LAS unsigned char* lds, const Gemm g, const Sched& S, const Epi& E, int wid) {
    int lane_; asm volatile("v_mbcnt_lo_u32_b32 %0, -1, 0\n\tv_mbcnt_hi_u32_b32 %0, -1, %0" : "=v"(lane_));
    const int lane = lane_, tid = wid * 64 + lane, wr = wid >> 2, wc = wid & 3, fr = lane & 15, fq = lane >> 4;
    const int K = g.K, nt = K / BK;
    unsigned voffA[2], voffB[2];
#pragma unroll
    for (int i = 0; i < 2; ++i) { int R, C; stage_rc(tid * 16 + i * 8192, R, C); const int Rb = Epi::PERM ? ((R & ~31) + perm32(R & 31)) : R;
        voffA[i] = (unsigned)(R * K + C) * 2u; voffB[i] = (unsigned)(Rb * K + C) * 2u; }
    const size_t kstep = (size_t)(BK * 2);
    const size_t hstep = (size_t)HALF * K * 2;
    const size_t tstep = 2 * hstep;
    const unsigned ldsw = (unsigned)wid * 1024u;
    const int aoff = lds_byte(wr * 64 + fr, fq * 8), boff = lds_byte(wc * 32 + fr, fq * 8);
#define PG8_SA(b, h) (((b) * 2 + (h)) * HTB)
#define PG8_SB(b, h) ((4 + (b) * 2 + (h)) * HTB)
#define PG8_STAGE(bufoff, gbase, voff) do { _Pragma("unroll") for (int _i = 0; _i < 2; ++_i) \
        __builtin_amdgcn_global_load_lds((const unsigned*)((const char*)(gbase) + (voff)[_i]), (PG8_LAS unsigned*)(lds + (bufoff) + ldsw + _i * 8192), 16, 0, 0); } while (0)
#define PG8_LDA(dst, b, h) do { _Pragma("unroll") for (int m = 0; m < 4; ++m) _Pragma("unroll") for (int k = 0; k < 2; ++k) dst[m][k] = *(const PG8_LAS bf16x8*)(lds + PG8_SA(b, h) + aoff + m * 2048 + k * 1024); } while (0)
#define PG8_LDB(dst, b, h) do { _Pragma("unroll") for (int n = 0; n < 2; ++n) _Pragma("unroll") for (int k = 0; k < 2; ++k) dst[n][k] = *(const PG8_LAS bf16x8*)(lds + PG8_SB(b, h) + boff + n * 2048 + k * 1024); } while (0)
#define PG8_MMA(ai, bj, At, Bt) do { __builtin_amdgcn_s_setprio(1); _Pragma("unroll") for (int m = 0; m < 4; ++m) _Pragma("unroll") for (int n = 0; n < 2; ++n) _Pragma("unroll") for (int k = 0; k < 2; ++k) \
        acc[ai][bj][m][n] = __builtin_amdgcn_mfma_f32_16x16x32_bf16(Bt[n][k], At[m][k], acc[ai][bj][m][n], 0, 0, 0); __builtin_amdgcn_s_setprio(0); } while (0)
#define PG8_WAIT_V(n) asm volatile("s_waitcnt vmcnt(" #n ")" ::: "memory")
#define PG8_WAIT_L(n) asm volatile("s_waitcnt lgkmcnt(" #n ")" ::: "memory")
#define PG8_BAR __builtin_amdgcn_s_barrier()
#define PG8_SCHED __builtin_amdgcn_sched_barrier(0)
    Unit cur, nxt; int ui = 0;
    if (!S.next(0, cur)) return;
    f32x4 acc[2][2][4][2];
#pragma unroll
    for (int a = 0; a < 2; ++a)
#pragma unroll
        for (int b = 0; b < 2; ++b)
#pragma unroll
            for (int m = 0; m < 4; ++m)
#pragma unroll
                for (int n = 0; n < 2; ++n) acc[a][b][m][n] = (f32x4){0.f, 0.f, 0.f, 0.f};
    bf16x8 At[4][2], B0[2][2], B1[2][2];
    const char* cA = (const char*)g.A + (size_t)cur.pm * tstep; const char* cB = (const char*)g.Bt + (size_t)cur.pn * tstep;
    PG8_STAGE(PG8_SB(0, 0), cB, voffB); PG8_STAGE(PG8_SB(0, 1), cB + hstep, voffB); PG8_STAGE(PG8_SA(0, 0), cA, voffA); PG8_STAGE(PG8_SA(0, 1), cA + hstep, voffA);
    if (wr == 1) PG8_BAR;
    PG8_WAIT_V(2); PG8_BAR;
    PG8_STAGE(PG8_SB(1, 0), cB + kstep, voffB); PG8_STAGE(PG8_SA(1, 0), cA + kstep, voffA); PG8_STAGE(PG8_SB(1, 1), cB + hstep + kstep, voffB);
    PG8_WAIT_V(6); PG8_BAR;
    for (;;) {
        const bool has_next = S.next(ui + 1, nxt);
        const char* nA = has_next ? (const char*)g.A + (size_t)nxt.pm * tstep : cA; const char* nB = has_next ? (const char*)g.Bt + (size_t)nxt.pn * tstep : cB;
        const int seglen = Epi::HOOK ? 8 : nt;
        for (int t0 = 0; t0 < nt; t0 += seglen) {
        if constexpr (Epi::HOOK) { if (t0 > 0) E.hook(acc, cur, t0 >> 3, wr, wc, fr, fq); }
        for (int t = t0; t < t0 + seglen; t += 2) {
            const bool last = (t == nt - 2);
            const char* a1 = cA + (size_t)(t + 1) * kstep;
            const char* a2 = last ? nA : cA + (size_t)(t + 2) * kstep; const char* b2 = last ? nB : cB + (size_t)(t + 2) * kstep;
            const char* a3 = a2 + kstep; const char* b3 = b2 + kstep;
            PG8_LDB(B0, 0, 0); PG8_LDB(B1, 0, 1); PG8_SCHED; PG8_LDA(At, 0, 0); PG8_STAGE(PG8_SA(1, 1), a1 + hstep, voffA);
            PG8_WAIT_V(8); PG8_WAIT_L(0); PG8_BAR; PG8_MMA(0, 0, At, B0); PG8_MMA(0, 1, At, B1); PG8_BAR; PG8_SCHED;
            PG8_LDA(At, 0, 1); PG8_STAGE(PG8_SB(0, 0), b2, voffB); PG8_STAGE(PG8_SB(0, 1), b2 + hstep, voffB); PG8_STAGE(PG8_SA(0, 0), a2, voffA);
            PG8_WAIT_V(8); PG8_WAIT_L(0); PG8_BAR; PG8_MMA(1, 0, At, B0); PG8_MMA(1, 1, At, B1); PG8_BAR; PG8_SCHED;
            PG8_LDB(B0, 1, 0); PG8_LDB(B1, 1, 1); PG8_SCHED; PG8_LDA(At, 1, 0); PG8_STAGE(PG8_SA(0, 1), a2 + hstep, voffA);
            PG8_WAIT_V(8); PG8_WAIT_L(0); PG8_BAR; PG8_MMA(0, 0, At, B0); PG8_MMA(0, 1, At, B1); PG8_BAR; PG8_SCHED;
            PG8_LDA(At, 1, 1); PG8_STAGE(PG8_SB(1, 0), b3, voffB); PG8_STAGE(PG8_SB(1, 1), b3 + hstep, voffB); PG8_STAGE(PG8_SA(1, 0), a3, voffA);
            PG8_WAIT_V(8); PG8_WAIT_L(0); PG8_BAR; PG8_MMA(1, 0, At, B0); PG8_MMA(1, 1, At, B1); PG8_BAR; PG8_SCHED;
        }
        }
        if constexpr (ALIGN_EPI) { if (wr == 0) PG8_BAR; }
        E(acc, cur, wr, wc, fr, fq);
        if (!has_next) break;
#pragma unroll
        for (int a = 0; a < 2; ++a)
#pragma unroll
            for (int b = 0; b < 2; ++b)
#pragma unroll
                for (int m = 0; m < 4; ++m)
#pragma unroll
                    for (int n = 0; n < 2; ++n) acc[a][b][m][n] = (f32x4){0.f, 0.f, 0.f, 0.f};
        cur = nxt; cA = nA; cB = nB; ++ui;
        if constexpr (ALIGN_EPI) { if (wr == 1) PG8_BAR; }
    }
    PG8_WAIT_V(0);
    if constexpr (!ALIGN_EPI) { if (wr == 0) PG8_BAR; }
    PG8_BAR;
#undef PG8_SA
#undef PG8_SB
#undef PG8_STAGE
#undef PG8_LDA
#undef PG8_LDB
#undef PG8_MMA
#undef PG8_WAIT_V
#undef PG8_WAIT_L
#undef PG8_BAR
#undef PG8_SCHED
}
}
constexpr int NWAVES = 8, NT = NWAVES * 64;
constexpr int M = 8192, D = 2048, SEQ = 2048, NBATCH = 4, DEPTH = 2;
constexpr int INW = 13316, NPROJ = 13312, MIXW = 512, HD = 128;
constexpr int PEER_E = 16384;
constexpr float EPS = 1e-6f;
constexpr float ATT_SCALE = 0.08838834764831845f;

constexpr size_t MiB = 1u << 20;
constexpr size_t WS_CTL = 0, CTL_ZERO_BYTES = 1 * MiB;
constexpr size_t WS_SSQ = 0;
constexpr size_t WS_SSA = 256 * 1024;
constexpr size_t WS_WF = 1 * MiB;
constexpr size_t WS_BINR = WS_WF + 64 * 1024;
constexpr size_t WS_LOGF = 2 * MiB;
constexpr size_t WS_CUM = 3 * MiB;
constexpr size_t WS_WIN = 8 * MiB;
constexpr size_t WIN_BYTES = (size_t)NPROJ * D * 2;
constexpr size_t WS_WBR = 112 * MiB, WS_WOUT = 128 * MiB, WS_WQ = 144 * MiB;
constexpr size_t SQ_BYTES = (size_t)D * D * 2;
constexpr size_t WS_PU = 160 * MiB, WS_PV = 288 * MiB;
constexpr size_t PE_BYTES = (size_t)PEER_E * D;
constexpr size_t WS_PK = 6 * MiB;
constexpr size_t WS_SU = 5 * MiB, WS_SV = 5 * MiB + 256 * 1024;
constexpr size_t WS_H = 416 * MiB;
constexpr size_t WS_HB = 480 * MiB;
constexpr size_t WS_PROJ = 512 * MiB;
constexpr size_t PROJ_T = (size_t)M * MIXW;
constexpr size_t WS_R = 592 * MiB;
constexpr size_t R_PLANE = (size_t)M * D;
constexpr size_t WS_Y = 720 * MiB;
constexpr size_t WS_MRG = 752 * MiB;
constexpr size_t WS_Q = 784 * MiB;
constexpr size_t WS_END = 816 * MiB;

constexpr int RING_BYTES = 131072;
constexpr int LDS_BYTES = 147456;

typedef unsigned short bf16;
typedef unsigned v4u __attribute__((ext_vector_type(4)));
typedef unsigned v2u __attribute__((ext_vector_type(2)));
typedef float f32x4 __attribute__((ext_vector_type(4)));
typedef float f32x2 __attribute__((ext_vector_type(2)));
using bf16x2 = __attribute__((ext_vector_type(2))) __bf16;
#define LAS __attribute__((address_space(3)))

__device__ __forceinline__ unsigned f2bf(float f) { unsigned u = __builtin_bit_cast(unsigned, f); return (u + 0x7fffu + ((u >> 16) & 1u)) >> 16; }
__device__ __forceinline__ unsigned pk2(float lo, float hi) { return f2bf(lo) | (f2bf(hi) << 16); }
__device__ __forceinline__ float bflo(unsigned w) { return __builtin_bit_cast(float, w << 16); }
__device__ __forceinline__ float bfhi(unsigned w) { return __builtin_bit_cast(float, w & 0xffff0000u); }
__device__ __forceinline__ float bf2f(bf16 b) { return __builtin_bit_cast(float, ((unsigned)b) << 16); }
__device__ __forceinline__ float shf(float v, int src) { return __builtin_bit_cast(float, __builtin_amdgcn_ds_bpermute(src << 2, __builtin_bit_cast(int, v))); }
__device__ __forceinline__ int shi(int v, int src) { return __builtin_amdgcn_ds_bpermute(src << 2, v); }
__device__ __forceinline__ float wave_sum(float v, int lane) {
#pragma unroll
    for (int o = 1; o < 64; o <<= 1) v += shf(v, lane ^ o);
    return v;
}
__device__ __forceinline__ float wave_max(float v, int lane) {
#pragma unroll
    for (int o = 1; o < 64; o <<= 1) v = fmaxf(v, shf(v, lane ^ o));
    return v;
}
__device__ __forceinline__ float ssa_to_f(unsigned long long v) { return (float)((double)v * (1.0 / 4294967296.0)); }
__device__ __forceinline__ float dot2_bf16(unsigned w, unsigned x, float acc) { return __builtin_amdgcn_fdot2_f32_bf16(__builtin_bit_cast(bf16x2, w), __builtin_bit_cast(bf16x2, x), acc, false); }

#define LANE_ID(x) asm volatile("v_mbcnt_lo_u32_b32 %0, -1, 0\n\tv_mbcnt_hi_u32_b32 %0, -1, %0" : "=v"(x))
struct Args {
    const float *x, *norm_mix, *w_in, *b_in, *pool_w, *pool_scale, *conv_w, *rel_bias, *w_branch, *w_out, *norm_ffn, *peer_wq, *peer_keys, *peer_u, *peer_v, *norm_final;
    float* out; unsigned char* ws;
};
#define GAS __attribute__((address_space(1)))
#define CAS __attribute__((address_space(4)))
struct ArgsK {
    const GAS float *x, *norm_mix, *w_in, *b_in, *pool_w, *pool_scale, *conv_w, *rel_bias, *w_branch, *w_out, *norm_ffn, *peer_wq, *peer_keys, *peer_u, *peer_v, *norm_final;
    GAS float* out; GAS unsigned char* ws;
};
__device__ __forceinline__ Args load_args(const CAS ArgsK* k, size_t zoff) {
    Args a;
    a.x = (const float*)k->x; a.norm_mix = (const float*)k->norm_mix; a.w_in = (const float*)k->w_in; a.b_in = (const float*)k->b_in; a.pool_w = (const float*)k->pool_w;
    a.pool_scale = (const float*)k->pool_scale; a.conv_w = (const float*)k->conv_w; a.rel_bias = (const float*)k->rel_bias; a.w_branch = (const float*)k->w_branch;
    a.w_out = (const float*)k->w_out; a.norm_ffn = (const float*)k->norm_ffn; a.peer_wq = (const float*)k->peer_wq; a.peer_keys = (const float*)k->peer_keys;
    a.peer_u = (const float*)k->peer_u; a.peer_v = (const float*)k->peer_v; a.norm_final = (const float*)k->norm_final; a.out = (float*)k->out; a.ws = (unsigned char*)(k->ws + zoff);
    return a;
}

using pg8::f32x4; using pg8::Unit;
struct EpiProj {
    static constexpr bool PERM = true, HOOK = false;
    bf16* P; bf16* R; const float* bias; const unsigned long long* ssq;
    __device__ __forceinline__ void operator()(f32x4 (&acc)[2][2][4][2], const Unit& u, int wr, int wc, int fr, int fq) const {
        const int row0 = u.pm * 256 + wr * 64 + fr, cl0 = wc * 32 + 8 * fq, bcol0 = u.pn * 256 + cl0;
        f32x4 bv[2][2];
#pragma unroll
        for (int bj = 0; bj < 2; ++bj)
#pragma unroll
            for (int n = 0; n < 2; ++n) bv[bj][n] = *(const f32x4*)(bias + bcol0 + bj * 128 + 4 * n);
        if (u.pn < 20) {
            bf16* base = P + (size_t)(u.pn >> 1) * PROJ_T + (u.pn & 1) * 256 + cl0;
#pragma unroll
            for (int ai = 0; ai < 2; ++ai)
#pragma unroll
                for (int m = 0; m < 4; ++m) { const int row = row0 + ai * 128 + m * 16; const float rs = rsqrtf(ssa_to_f(ssq[row]) * (1.0f / D) + EPS);
                    bf16* rowp = base + (size_t)row * MIXW;
#pragma unroll
                    for (int bj = 0; bj < 2; ++bj) { const f32x4 v0 = acc[ai][bj][m][0] * rs + bv[bj][0], v1 = acc[ai][bj][m][1] * rs + bv[bj][1];
                        pg8::u32x4 w; w.x = pg8::cvt_pk_bf16(v0[0], v0[1]); w.y = pg8::cvt_pk_bf16(v0[2], v0[3]); w.z = pg8::cvt_pk_bf16(v1[0], v1[1]); w.w = pg8::cvt_pk_bf16(v1[2], v1[3]);
                        *(pg8::u32x4*)(rowp + bj * 128) = w; } }
        } else {
            const int d0 = 64 * (u.pn - 20) + 16 * wc + 4 * fq;
#pragma unroll
            for (int ai = 0; ai < 2; ++ai)
#pragma unroll
                for (int m = 0; m < 4; ++m) { const int row = row0 + ai * 128 + m * 16; const float rs = rsqrtf(ssa_to_f(ssq[row]) * (1.0f / D) + EPS);
                    float r[4][4];
#pragma unroll
                    for (int j = 0; j < 4; ++j) { float e[4], ie[4];
#pragma unroll
                        for (int g = 0; g < 4; ++g) { const float z = acc[ai][g >> 1][m][g & 1][j] * rs + bv[g >> 1][g & 1][j];
                            e[g] = fminf(1.0f + __builtin_amdgcn_exp2f(-1.4426950408889634f * z), 1e18f); ie[g] = __builtin_amdgcn_rcpf(e[g]); }
                        r[0][j] = e[1] * ie[0]; r[1][j] = e[2] * ie[1]; r[2][j] = e[3] * ie[2]; r[3][j] = ie[3]; }
#pragma unroll
                    for (int g = 0; g < 4; ++g) { pg8::u32x2 w; w.x = pg8::cvt_pk_bf16(r[g][0], r[g][1]); w.y = pg8::cvt_pk_bf16(r[g][2], r[g][3]);
                        *(pg8::u32x2*)(R + (size_t)g * R_PLANE + (size_t)row * D + d0) = w; } }
        }
    }
};
struct EpiMerge {
    static constexpr bool PERM = true, HOOK = true;
    const bf16* R; bf16* O;
    template <int NB  >
    __device__ __forceinline__ void scale(f32x4 (&acc)[2][2][4][2], const Unit& u, int plane, int wr, int wc, int fr, int fq) const {
        const __amdgpu_buffer_rsrc_t rs = __builtin_amdgcn_make_buffer_rsrc((void*)(R + (size_t)plane * R_PLANE), 0, 0x7fffffff, 0x00020000);
        int voff = (fr * D + 8 * fq) * 2; asm volatile("" : "+v"(voff));
        const int sbase = ((u.pm * 256 + wr * 64) * D + u.pn * 256 + wc * 32) * 2;
#pragma unroll
        for (int b0 = 0; b0 < 8; b0 += NB) {
            pg8::u32x4 w[NB][2];
#pragma unroll
            for (int i = 0; i < NB; ++i)
#pragma unroll
                for (int bj = 0; bj < 2; ++bj) { const int ai = (b0 + i) >> 2, m = (b0 + i) & 3;
                    w[i][bj] = __builtin_amdgcn_raw_buffer_load_b128(rs, voff + bj * 256, sbase + (ai * 128 + m * 16) * D * 2, 0); }
#pragma unroll
            for (int i = 0; i < NB; ++i)
#pragma unroll
                for (int bj = 0; bj < 2; ++bj) { const int ai = (b0 + i) >> 2, m = (b0 + i) & 3; const pg8::u32x4 v = w[i][bj];
                    acc[ai][bj][m][0] *= (f32x4){bflo(v.x), bfhi(v.x), bflo(v.y), bfhi(v.y)};
                    acc[ai][bj][m][1] *= (f32x4){bflo(v.z), bfhi(v.z), bflo(v.w), bfhi(v.w)};
                    asm volatile("" : "+v"(acc[ai][bj][m][0]), "+v"(acc[ai][bj][m][1])); }
            asm volatile("" ::: "memory"); }
    }
    __device__ __forceinline__ void hook(f32x4 (&acc)[2][2][4][2], const Unit& u, int g, int wr, int wc, int fr, int fq) const { scale<4>(acc, u, g - 1, wr, wc, fr, fq); }
    __device__ __forceinline__ void operator()(f32x4 (&acc)[2][2][4][2], const Unit& u, int wr, int wc, int fr, int fq) const {
        scale<4>(acc, u, 3, wr, wc, fr, fq);
        const int row0 = u.pm * 256 + wr * 64 + fr, col0 = u.pn * 256 + wc * 32 + 8 * fq;
#pragma unroll
        for (int ai = 0; ai < 2; ++ai)
#pragma unroll
            for (int m = 0; m < 4; ++m) { bf16* rowp = O + (size_t)(row0 + ai * 128 + m * 16) * D + col0;
#pragma unroll
                for (int bj = 0; bj < 2; ++bj) { const f32x4 v0 = acc[ai][bj][m][0], v1 = acc[ai][bj][m][1];
                    pg8::u32x4 w; w.x = pg8::cvt_pk_bf16(v0[0], v0[1]); w.y = pg8::cvt_pk_bf16(v0[2], v0[3]); w.z = pg8::cvt_pk_bf16(v1[0], v1[1]); w.w = pg8::cvt_pk_bf16(v1[2], v1[3]);
                    *(pg8::u32x4*)(rowp + bj * 128) = w; } }
    }
};
struct EpiRes {
    static constexpr bool PERM = false, HOOK = false;
    float* H; bf16* HB; unsigned long long* ssa;
    __device__ __forceinline__ void operator()(f32x4 (&acc)[2][2][4][2], const Unit& u, int wr, int wc, int fr, int fq) const {
        const int row0 = u.pm * 256 + wr * 64 + fr, col0 = u.pn * 256 + wc * 32 + 4 * fq;
#pragma unroll
        for (int ai = 0; ai < 2; ++ai)
#pragma unroll
            for (int m = 0; m < 4; ++m) { const int row = row0 + ai * 128 + m * 16; const size_t off = (size_t)row * D + col0; float s = 0.f;
#pragma unroll
                for (int bj = 0; bj < 2; ++bj)
#pragma unroll
                    for (int n = 0; n < 2; ++n) { const size_t o = off + bj * 128 + n * 16; const f32x4 h = *(const f32x4*)(H + o) + acc[ai][bj][m][n];
                        *(f32x4*)(H + o) = h; pg8::u32x2 w; w.x = pg8::cvt_pk_bf16(h[0], h[1]); w.y = pg8::cvt_pk_bf16(h[2], h[3]); *(pg8::u32x2*)(HB + o) = w;
                        s += (h[0] * h[0] + h[1] * h[1]) + (h[2] * h[2] + h[3] * h[3]); }
                { const int ln = fq * 16 + fr; s += shf(s, ln ^ 16); s += shf(s, ln ^ 32); }
                if (fq == 0) atomicAdd(ssa + row, (unsigned long long)((double)s * 4294967296.0)); }
    }
};
struct EpiQ {
    static constexpr bool PERM = true, HOOK = false;
    bf16* O; const unsigned long long* ssa;
    __device__ __forceinline__ void operator()(f32x4 (&acc)[2][2][4][2], const Unit& u, int wr, int wc, int fr, int fq) const {
        const int row0 = u.pm * 256 + wr * 64 + fr, col0 = u.pn * 256 + wc * 32 + 8 * fq;
#pragma unroll
        for (int ai = 0; ai < 2; ++ai)
#pragma unroll
            for (int m = 0; m < 4; ++m) { const int row = row0 + ai * 128 + m * 16; const float rs = rsqrtf(ssa_to_f(ssa[row]) * (1.0f / D) + EPS);
                bf16* rowp = O + (size_t)row * D + col0;
#pragma unroll
                for (int bj = 0; bj < 2; ++bj) { const f32x4 v0 = acc[ai][bj][m][0] * rs, v1 = acc[ai][bj][m][1] * rs;
                    pg8::u32x4 w; w.x = pg8::cvt_pk_bf16(v0[0], v0[1]); w.y = pg8::cvt_pk_bf16(v0[2], v0[3]); w.z = pg8::cvt_pk_bf16(v1[0], v1[1]); w.w = pg8::cvt_pk_bf16(v1[2], v1[3]);
                    *(pg8::u32x4*)(rowp + bj * 128) = w; } }
    }
};

__device__ __forceinline__ int colmap_in(int j) {
    if (j < 1536) return j;
    if (j < 5120) return j + 4;
    const int c = (j - 5120) & 255, T = (j - 5120) >> 8;
    const int g = 2 * (c >> 7) + ((c >> 2) & 1), d = 64 * T + 16 * ((c >> 5) & 3) + 4 * ((c >> 3) & 3) + (c & 3);
    return 5124 + g * 2048 + d;
}
template <bool MAP>
__device__ __forceinline__ void tr_item(const float* W, int ldw, const float* scale, bf16* WT, int ldt, int dcol0, LAS float* scr, int k0, int n0, int lane) {
    const int q = lane & 7, r8 = lane >> 3, sc = MAP ? colmap_in(n0 + 4 * q) : (n0 + 4 * q);
    f32x4 v[8];
#pragma unroll
    for (int i = 0; i < 8; ++i) v[i] = *(const f32x4*)(W + (size_t)(k0 + 8 * i + r8) * ldw + sc);
    f32x4 s0 = {1.f, 1.f, 1.f, 1.f}, s1 = s0;
    if (scale) { s0 = *(const f32x4*)(scale + k0 + 8 * q); s1 = *(const f32x4*)(scale + k0 + 8 * q + 4); }
#pragma unroll
    for (int i = 0; i < 8; ++i)
#pragma unroll
        for (int e = 0; e < 4; ++e) scr[(8 * i + r8) * 33 + 4 * q + e] = v[i][e];
    asm volatile("s_waitcnt lgkmcnt(0)" ::: "memory");
    const int c = q;
#pragma unroll
    for (int j = 0; j < 4; ++j) { const int n = r8 + 8 * j; const LAS float* s = scr + (8 * c) * 33 + n;
        v4u o; o.x = pk2(s[0 * 33] * s0[0], s[1 * 33] * s0[1]); o.y = pk2(s[2 * 33] * s0[2], s[3 * 33] * s0[3]); o.z = pk2(s[4 * 33] * s1[0], s[5 * 33] * s1[1]); o.w = pk2(s[6 * 33] * s1[2], s[7 * 33] * s1[3]);
        *(v4u*)(WT + (size_t)(n0 + n) * ldt + dcol0 + k0 + 8 * c) = o; }
    asm volatile("s_waitcnt lgkmcnt(0)" ::: "memory");
}
constexpr size_t WS_BAR = 512 * 1024;
#define XB_TMO      128
#define XB_XCNT(j)  (256  + 64 * (j))
#define XB_XSUB(j)  (1280 + 64 * (j))
#define XB_XGEN(j)  (2304 + 64 * (j))
#define XB_TOP      3328
#define XB_TOPGEN   3392
#define XCD_BAR_WORDS 3456
#define XB_SPIN_CAP (1u << 23)
__device__ __forceinline__ unsigned xb_ld(unsigned* p)              { return __hip_atomic_load(p, __ATOMIC_RELAXED, __HIP_MEMORY_SCOPE_AGENT); }
__device__ __forceinline__ unsigned xb_add(unsigned* p, unsigned v) { return __hip_atomic_fetch_add(p, v, __ATOMIC_RELAXED, __HIP_MEMORY_SCOPE_AGENT); }
__device__ __forceinline__ unsigned xb_xcc_id() { return (unsigned)__builtin_amdgcn_s_getreg((3 << 11) | 20) & 0xFu; }
#define XB_SPIN(cond, bar) do { unsigned _sp = 0; while (cond) { __builtin_amdgcn_s_sleep(1); \
    if ((++_sp & 255u) == 0u) { if (xb_ld(&(bar)[XB_TMO])) break; if (_sp > XB_SPIN_CAP) { atomicAdd(&(bar)[XB_TMO], 1u); break; } } } } while (0)
__device__ __forceinline__ void xcd_barrier_complete(unsigned* bar, unsigned x, unsigned G, unsigned& nloc, unsigned& nx) {
    unsigned sum, cnt, mine, sp = 0u;
    for (;;) {
        sum = 0u; cnt = 0u; mine = 0u;
#pragma unroll
        for (unsigned j = 0; j < 16; ++j) { const unsigned c = xb_ld(&bar[XB_XCNT(j)]); sum += c; cnt += (c > 0u) ? 1u : 0u; mine = (j == x) ? c : mine; }
        if (sum == G) break;
        __builtin_amdgcn_s_sleep(1);
        if ((++sp & 255u) == 0u) { if (xb_ld(&bar[XB_TMO])) break; if (sp > XB_SPIN_CAP) { atomicAdd(&bar[XB_TMO], 1u); break; } }
    }
    nloc = mine > 0u ? mine : 1u; nx = cnt > 0u ? cnt : 1u;
}
__device__ __forceinline__ void xcd_barrier(unsigned* bar, unsigned x, unsigned G, volatile LAS unsigned* st, int wave) {
    asm volatile("s_waitcnt vmcnt(0)" ::: "memory");
    __syncthreads();
    int lane; asm volatile("v_mbcnt_lo_u32_b32 %0, -1, 0\n\tv_mbcnt_hi_u32_b32 %0, -1, %0" : "=v"(lane));
    if (wave == 0 && lane == 0) {
        __builtin_amdgcn_s_waitcnt(0);
        unsigned nloc = st[0], nx = st[1];
        if (nloc == 0u) { xcd_barrier_complete(bar, x, G, nloc, nx); st[0] = nloc; st[1] = nx; }
        const unsigned old = xb_add(&bar[XB_XSUB(x)], 1u);
        const unsigned gen = old / nloc;
        if (old + 1u == (gen + 1u) * nloc) {
            __builtin_amdgcn_fence(__ATOMIC_RELEASE, "agent");
            asm volatile("s_waitcnt vmcnt(0)" ::: "memory");
            const unsigned og = xb_add(&bar[XB_TOP], 1u);
            const unsigned tg = og / nx;
            if (og + 1u == (tg + 1u) * nx) xb_add(&bar[XB_TOPGEN], 1u);
            else XB_SPIN(xb_ld(&bar[XB_TOPGEN]) == tg, bar);
            __builtin_amdgcn_fence(__ATOMIC_ACQUIRE, "agent");
            xb_add(&bar[XB_XGEN(x)], 1u);
            asm volatile("s_waitcnt vmcnt(0)" ::: "memory");
        } else {
            XB_SPIN(xb_ld(&bar[XB_XGEN(x)]) == gen, bar);
            __builtin_amdgcn_fence(__ATOMIC_ACQUIRE, "agent");
            asm volatile("s_waitcnt vmcnt(0)" ::: "memory");
        }
    }
    __syncthreads();
}
namespace att {
constexpr int D = 128, NW = 8, QBLK = 32, KVBLK = 64, QB = NW * QBLK;
constexpr int PITCH = 512, OPITCH = 2048;
constexpr float SCALE = 0.08838834764831845f, THR = 8.f;
constexpr int SHM_V = KVBLK * D * 2, SHM_K = KVBLK * D * 2;
constexpr int OFF_WS = 2 * SHM_V + 2 * SHM_K, OFF_CUM = OFF_WS + NW * 64 * 4, OFF_REL = OFF_CUM + 2048 * 4, LDS_END = OFF_REL + 320 * 4;
typedef unsigned short bf16;
typedef short bf16x8 __attribute__((ext_vector_type(8)));
typedef short s16x4 __attribute__((ext_vector_type(4)));
typedef float f32x16 __attribute__((ext_vector_type(16)));
typedef float f32x4 __attribute__((ext_vector_type(4)));
typedef unsigned u32x4 __attribute__((ext_vector_type(4)));
#define ALDS __attribute__((address_space(3)))

#define KSWZ(row, colB) ((row) * 256 + ((colB) ^ (((row) & 7) << 4)))
#define SBAR() __builtin_amdgcn_sched_barrier(0)
__device__ __forceinline__ int v_st(int k, int c) { const int kk = (k & ~0xC) | ((k & 4) << 1) | ((k & 8) >> 1); return ((kk >> 3) * 4 + (c >> 5)) * 512 + ((kk & 7) * 32 + (c & 31)) * 2; }
__device__ __forceinline__ int v_rd_base(int lane) { return ((lane & 3) << 3) | (((lane >> 2) & 3) << 6) | (((lane >> 4) & 1) << 5) | (((lane >> 5) & 1) << 8); }
constexpr int v_rd_off(int d0, int ks, int half) { return d0 * 512 + ks * 4096 + half * 2048; }
__device__ __forceinline__ int crow(int r, int hi) { return (r & 3) + 8 * (r >> 2) + 4 * hi; }
__device__ __forceinline__ unsigned cvtpk(float lo, float hi) { unsigned r; asm volatile("v_cvt_pk_bf16_f32 %0, %1, %2" : "=v"(r) : "v"(lo), "v"(hi)); return r; }
__device__ __forceinline__ bf16x8 load8(const bf16* p) { return *reinterpret_cast<const bf16x8*>(p); }

__device__ __forceinline__ void mask_tile(f32x16& p0, f32x16& p1, int dq) {
    const float NEG = -__builtin_inff();
#pragma unroll
    for (int r = 0; r < 16; ++r) { const int c = (r & 3) + 8 * (r >> 2);
        if (dq - c < 0) p0[r] = NEG;
        if (dq - c - 32 < 0) p1[r] = NEG; }
}
__device__ __forceinline__ void partialSM(f32x16& p0, f32x16& p1, float& m_reg, float& mn, float& alpha) {
    float pmax = p0[0];
#pragma unroll
    for (int r = 1; r < 16; ++r) pmax = fmaxf(pmax, p0[r]);
#pragma unroll
    for (int r = 0; r < 16; ++r) pmax = fmaxf(pmax, p1[r]);
    { auto rr = __builtin_amdgcn_permlane32_swap(__float_as_uint(pmax), __float_as_uint(pmax), false, false);
      pmax = fmaxf(__uint_as_float(rr[0]), __uint_as_float(rr[1])); }
    constexpr float C2 = 1.4426950408889634f * SCALE;
    if (__builtin_expect(__all((pmax - m_reg) * SCALE <= THR), 1)) { mn = m_reg; alpha = 1.f; }
    else { mn = fmaxf(m_reg, pmax); alpha = __builtin_amdgcn_exp2f((m_reg - mn) * C2); m_reg = mn; }
    const float mnL = -mn * C2;
#pragma unroll
    for (int r = 0; r < 16; ++r) p0[r] = fmaf(p0[r], C2, mnL);
#pragma unroll
    for (int r = 0; r < 16; ++r) p1[r] = fmaf(p1[r], C2, mnL);
#pragma unroll
    for (int r = 0; r < 16; ++r) p0[r] = __builtin_amdgcn_exp2f(p0[r]);
}
__device__ __forceinline__ void finishSM(f32x16& p0, f32x16& p1, float alpha, float& l_reg, bf16x8& pa0, bf16x8& pa1, bf16x8& pa2, bf16x8& pa3) {
#pragma unroll
    for (int r = 0; r < 16; ++r) p1[r] = __builtin_amdgcn_exp2f(p1[r]);
    float ps = 0;
#pragma unroll
    for (int r = 0; r < 16; ++r) ps += p0[r];
#pragma unroll
    for (int r = 0; r < 16; ++r) ps += p1[r];
    { auto rr = __builtin_amdgcn_permlane32_swap(__float_as_uint(ps), __float_as_uint(ps), false, false);
      ps = __uint_as_float(rr[0]) + __uint_as_float(rr[1]); }
    l_reg = l_reg * alpha + ps;
#define PK4(P, B_, OUT) do { unsigned a0 = cvtpk(P[B_+0], P[B_+1]), a1 = cvtpk(P[B_+2], P[B_+3]);                          \
        unsigned b0 = cvtpk(P[B_+4], P[B_+5]), b1 = cvtpk(P[B_+6], P[B_+7]);                                             \
        auto r0 = __builtin_amdgcn_permlane32_swap(a0, b0, false, false); auto r1 = __builtin_amdgcn_permlane32_swap(a1, b1, false, false); \
        u32x4 w = {r0[0], r1[0], r0[1], r1[1]}; OUT = *reinterpret_cast<bf16x8*>(&w); } while (0)
    PK4(p0, 0, pa0); PK4(p0, 8, pa1); PK4(p1, 0, pa2); PK4(p1, 8, pa3);
#undef PK4
}
template <int KB>
__device__ __forceinline__ void qkt(f32x16& p0, f32x16& p1, const ALDS char* K_lds, int r32, int hi, const bf16x8* qr, bool act) {
    if (!act) { const float NEG = -__builtin_inff();
#pragma unroll
        for (int r = 0; r < 16; ++r) { p0[r] = NEG; p1[r] = NEG; } return; }
    p0 = f32x16{}; p1 = f32x16{};
    const ALDS char* kb[4];
#pragma unroll
    for (int dd = 0; dd < 4; ++dd) kb[dd] = K_lds + KB * SHM_K + KSWZ(r32, (dd * 16 + hi * 8) * 2);
#pragma unroll
    for (int d0 = 0; d0 < 8; ++d0) { const ALDS char* a = kb[d0 & 3] + (d0 >> 2) * 128;
        bf16x8 b0 = *(const ALDS bf16x8*)(a);
        bf16x8 b1 = *(const ALDS bf16x8*)(a + 32 * 256);
        p0 = __builtin_amdgcn_mfma_f32_32x32x16_bf16(b0, qr[d0], p0, 0, 0, 0);
        p1 = __builtin_amdgcn_mfma_f32_32x32x16_bf16(b1, qr[d0], p1, 0, 0, 0); }
}
template <int VB>
__device__ __forceinline__ void pv_tile(f32x16* o, int vb0, bf16x8 pa0, bf16x8 pa1, bf16x8 pa2, bf16x8 pa3, bool act) {
    if (!act) return;
#define TRRD(dst, off) asm volatile("ds_read_b64_tr_b16 %0, %1 offset:%2" : "=&v"(dst) : "v"(vb0), "i"(off) : "memory")
#define PV_D0(d0) do { s16x4 l0, l1, l2, l3, h0, h1, h2, h3; constexpr int b_ = VB * SHM_V + v_rd_off(d0, 0, 0); \
        TRRD(l0, b_); TRRD(h0, b_ + 2048); TRRD(l1, b_ + 4096); TRRD(h1, b_ + 6144); TRRD(l2, b_ + 8192); TRRD(h2, b_ + 10240); TRRD(l3, b_ + 12288); TRRD(h3, b_ + 14336); \
        asm volatile("s_waitcnt lgkmcnt(0)" ::: "memory"); SBAR(); \
        o[d0] = __builtin_amdgcn_mfma_f32_32x32x16_bf16(pa0, (bf16x8){l0[0], l0[1], l0[2], l0[3], h0[0], h0[1], h0[2], h0[3]}, o[d0], 0, 0, 0);   \
        o[d0] = __builtin_amdgcn_mfma_f32_32x32x16_bf16(pa1, (bf16x8){l1[0], l1[1], l1[2], l1[3], h1[0], h1[1], h1[2], h1[3]}, o[d0], 0, 0, 0);   \
        o[d0] = __builtin_amdgcn_mfma_f32_32x32x16_bf16(pa2, (bf16x8){l2[0], l2[1], l2[2], l2[3], h2[0], h2[1], h2[2], h2[3]}, o[d0], 0, 0, 0);   \
        o[d0] = __builtin_amdgcn_mfma_f32_32x32x16_bf16(pa3, (bf16x8){l3[0], l3[1], l3[2], l3[3], h3[0], h3[1], h3[2], h3[3]}, o[d0], 0, 0, 0); } while (0)
    PV_D0(0); PV_D0(1); PV_D0(2); PV_D0(3);
#undef PV_D0
#undef TRRD
}
template <int MODE>
__device__ __forceinline__ void bias_mask(f32x16& p0, f32x16& p1, const ALDS char* lds, int kb, int qlo, int qpos, int hi, float cqs, bool act) {
    if (!act) return;
    if (MODE == 0) {
        const ALDS float* cs = (const ALDS float*)(lds + OFF_CUM) + kb + 4 * hi;
#pragma unroll
        for (int g = 0; g < 4; ++g) { const f32x4 c0 = *(const ALDS f32x4*)(cs + 8 * g), c1 = *(const ALDS f32x4*)(cs + 32 + 8 * g);
#pragma unroll
            for (int e = 0; e < 4; ++e) { p0[4 * g + e] += cqs - c0[e]; p1[4 * g + e] += cqs - c1[e]; } }
        if (kb + KVBLK - 1 > qlo) mask_tile(p0, p1, qpos - 4 * hi - kb);
    } else {
        const ALDS float* tb = (const ALDS float*)(lds + OFF_REL);
        if (qlo - (kb + KVBLK - 1) >= 256) { const float c = tb[319];
#pragma unroll
            for (int r = 0; r < 16; ++r) { p0[r] += c; p1[r] += c; } }
        else { const int d0 = qpos - kb - 4 * hi + 63;
#pragma unroll
            for (int r = 0; r < 16; ++r) { const int c = (r & 3) + 8 * (r >> 2);
                int i0 = d0 - c, i1 = d0 - c - 32; i0 = i0 > 319 ? 319 : i0; i1 = i1 > 319 ? 319 : i1; i1 = i1 < 0 ? 0 : i1; i0 = i0 < 0 ? 0 : i0;
                p0[r] += tb[i0]; p1[r] += tb[i1]; } }
    }
}

struct Seam { bf16x8 qr[8]; bf16x8 st_v0, st_v1, st_k0, st_k1; };
#define VMW() asm volatile("s_waitcnt vmcnt(0)" ::: "memory")
#define BL8(rs, vo, so) __builtin_bit_cast(bf16x8, __builtin_amdgcn_raw_buffer_load_b128(rs, vo, so, 0))
#define SLOAD_H(Kp, Vp, k0) do { S.st_v0 = BL8(rP, kvoff, (Vp) + (k0) * (PITCH * 2)); S.st_v1 = BL8(rP, kvoff, (Vp) + ((k0) + 32) * (PITCH * 2));              \
                         S.st_k0 = BL8(rP, kvoff, (Kp) + (k0) * (PITCH * 2)); S.st_k1 = BL8(rP, kvoff, (Kp) + ((k0) + 32) * (PITCH * 2)); } while (0)
#define SWRITE_HK(bf) do { *(ALDS bf16x8*)(K_lds + (bf) * SHM_K + kws) = S.st_k0; *(ALDS bf16x8*)(K_lds + (bf) * SHM_K + kws + 32 * 256) = S.st_k1; } while (0)
#define SWRITE_HV(bf) do { *(ALDS bf16x8*)(V_lds + (bf) * SHM_V + vst0) = S.st_v0; *(ALDS bf16x8*)(V_lds + (bf) * SHM_V + vst1) = S.st_v1; } while (0)
#define SWRITE_H(bf) do { SWRITE_HV(bf); SWRITE_HK(bf); } while (0)

template <int MODE>
__device__ __forceinline__ void attn_unit(const bf16* Pb, int Qo, int Kh, int Vh, bf16* Yb, int Oo, int P0, int j_lo, int j_hi, ALDS char* lds, int wid, int lane) {
    const int tid = wid * 64 + lane, r32 = lane & 31, hi = lane >> 5;
    const int NT = j_hi - j_lo;
    const int qlo = P0 + wid * QBLK, qpos = qlo + r32;
    ALDS char* V_lds = lds; ALDS char* K_lds = lds + 2 * SHM_V;
    ALDS float* ws = (ALDS float*)(lds + OFF_WS) + wid * 64; ALDS float* li_l = ws; ALDS float* al_l = ws + 32;
    float m_reg = -1e30f, l_reg = 0; f32x16 o[4] = {};
    const int sr = tid >> 4, sc = (tid & 15) * 8, vst0 = v_st(sr, sc), vst1 = v_st(32 + sr, sc), kws = KSWZ(sr, sc * 2);
    const int vb0 = (int)(unsigned)(size_t)V_lds + v_rd_base(lane);
    Seam S;
    const __amdgpu_buffer_rsrc_t rP = __builtin_amdgcn_make_buffer_rsrc((void*)Pb, 0, 0x7fffffff, 0x00020000);
    const __amdgpu_buffer_rsrc_t rO = __builtin_amdgcn_make_buffer_rsrc((void*)Yb, 0, 0x7fffffff, 0x00020000);
    const int kvoff = (sr * PITCH + sc) * 2;
#define KBASE(t) ((j_lo + (t)) * KVBLK)
#define ACT(t) (MODE == 0 ? (KBASE(t) <= qlo + QBLK - 1) : ((j_lo + (t)) <= (qlo >> 6) && (j_lo + (t)) + 8 >= (qlo >> 6)))
#define RESC(a) do { if (__any((a) < 1.f)) { if (hi == 0) al_l[r32] = (a); asm volatile("s_waitcnt lgkmcnt(0)" ::: "memory");              \
                     for (int d_ = 0; d_ < 4; ++d_) for (int r = 0; r < 16; ++r) o[d_][r] *= al_l[crow(r, hi)]; } } while (0)
#define MASKT(P0_, P1_, t) bias_mask<MODE>(P0_, P1_, lds, KBASE(t), qlo, qpos, hi, cq_, ACT(t))
    {
        const int kb0 = j_lo * KVBLK;
#pragma unroll
        for (int d0 = 0; d0 < 8; ++d0) S.qr[d0] = BL8(rP, (r32 * PITCH + hi * 8) * 2 + d0 * 32, Qo + wid * (QBLK * PITCH * 2));
        SLOAD_H(Kh, Vh, kb0); VMW(); SWRITE_HK(0);
        __syncthreads();
    }
    const float cq_ = MODE == 0 ? ((const ALDS float*)(lds + OFF_CUM))[qpos] : 0.f;
    f32x16 pA0, pA1, pB0, pB1; float mnA, mnB, alA, alB; bf16x8 pa0, pa1, pa2, pa3;
    SWRITE_HV(0); SBAR();
    if (NT > 1) { SLOAD_H(Kh, Vh, KBASE(1)); }
    SBAR(); qkt<0>(pA0, pA1, K_lds, r32, hi, S.qr, ACT(0));
    MASKT(pA0, pA1, 0); partialSM(pA0, pA1, m_reg, mnA, alA);
    if (NT > 1) { VMW(); SWRITE_H(1); }
    __syncthreads();
#define HALF_STEP(PX0, PX1, mnX, alX, PY0, PY1, alY, t, KB, VB, SB) do {                                                      \
        SBAR(); qkt<KB>(PX0, PX1, K_lds, r32, hi, S.qr, ACT(t));                                                              \
        finishSM(PY0, PY1, alY, l_reg, pa0, pa1, pa2, pa3); SBAR();                                                           \
        if ((t) + 1 < NT) { SLOAD_H(Kh, Vh, KBASE((t) + 1)); SBAR(); }                                                        \
        pv_tile<VB>(o, vb0, pa0, pa1, pa2, pa3, ACT((t) - 1)); MASKT(PX0, PX1, (t)); partialSM(PX0, PX1, m_reg, mnX, alX);    \
        __syncthreads();                                                                                                      \
        if ((t) + 1 < NT) { VMW(); SWRITE_H(SB); }                                                                            \
        RESC(alX); __syncthreads(); } while (0)
    for (int t = 1; t + 1 < NT; t += 2) {
        HALF_STEP(pB0, pB1, mnB, alB, pA0, pA1, alA, t, 1, 0, 0);
        HALF_STEP(pA0, pA1, mnA, alA, pB0, pB1, alB, t + 1, 0, 1, 1);
    }
    const bool even = (NT & 1) == 0;
    if (even) { SBAR(); qkt<1>(pB0, pB1, K_lds, r32, hi, S.qr, ACT(NT - 1)); SBAR(); }
    finishSM(pA0, pA1, alA, l_reg, pa0, pa1, pa2, pa3); SBAR();
    pv_tile<0>(o, vb0, pa0, pa1, pa2, pa3, ACT(even ? NT - 2 : NT - 1));
    if (even) { MASKT(pB0, pB1, NT - 1); partialSM(pB0, pB1, m_reg, mnB, alB); __syncthreads(); RESC(alB);
        finishSM(pB0, pB1, alB, l_reg, pa0, pa1, pa2, pa3); SBAR(); pv_tile<1>(o, vb0, pa0, pa1, pa2, pa3, ACT(NT - 1)); }
    SBAR();
    if (hi == 0) li_l[r32] = l_reg; asm volatile("s_waitcnt lgkmcnt(0)" ::: "memory");
    float rli[16];
#pragma unroll
    for (int r = 0; r < 16; ++r) rli[r] = __builtin_amdgcn_rcpf(li_l[crow(r, hi)]);
    const int ovoff = (4 * hi * OPITCH + r32) * 2, osoff = Oo + wid * (QBLK * OPITCH * 2);
#pragma unroll
    for (int r = 0; r < 16; ++r) { const int orow = (r & 3) + 8 * (r >> 2);
#pragma unroll
        for (int d0 = 0; d0 < 4; ++d0) { const float v = o[d0][r] * rli[r];
            const float vn = __builtin_bit_cast(float, __builtin_amdgcn_ds_bpermute((lane ^ 1) << 2, __builtin_bit_cast(int, v)));
            if ((r32 & 1) == 0) __builtin_amdgcn_raw_buffer_store_b32(cvtpk(v, vn), rO, ovoff + d0 * 64, osoff + orow * (OPITCH * 2), 0); } }
    __syncthreads();
#undef RESC
#undef KBASE
#undef ACT
#undef MASKT
#undef HALF_STEP
}
#undef BL8
#undef VMW
#undef SLOAD_H
#undef SWRITE_HK
#undef SWRITE_HV
#undef SWRITE_H
#undef KSWZ
#undef SBAR
}
constexpr size_t WS_QCTR = 768 * 1024;
constexpr size_t WS_POOLW = 4 * MiB;
constexpr int N_ATT_UNITS = 256, N_POOL_UNITS = 512, N_CONV_UNITS = 128;

__device__ __forceinline__ void stage_cum(const Args& a, int b, int h, LAS char* lds, int wave, int lane) {
    const float* logf = (const float*)(a.ws + WS_LOGF) + ((size_t)b * SEQ) * 4 + h;
    const int tid = wave * 64 + lane;
    float v[4];
#pragma unroll
    for (int e = 0; e < 4; ++e) v[e] = logf[(size_t)(4 * tid + e) * 4];
    v[1] += v[0]; v[2] += v[1]; v[3] += v[2];
    float incl = v[3];
#pragma unroll
    for (int o = 1; o < 64; o <<= 1) { const float t = shf(incl, lane >= o ? lane - o : lane); if (lane >= o) incl += t; }
    LAS float* wt = (LAS float*)(lds + att::OFF_WS);
    if (lane == 63) wt[wave] = incl;
    __syncthreads();
    float base = incl - v[3];
    for (int w = 0; w < wave; ++w) base += wt[w];
    LAS float* cs = (LAS float*)(lds + att::OFF_CUM);
    const float inv = 1.0f / ATT_SCALE;
    *(LAS f32x4*)(cs + 4 * tid) = (f32x4){(base + v[0]) * inv, (base + v[1]) * inv, (base + v[2]) * inv, (base + v[3]) * inv};
    __syncthreads();
}
__device__ __forceinline__ void attention_item(const Args& a, int l, int u, LAS char* lds, int wave) {
    int lane; asm volatile("v_mbcnt_lo_u32_b32 %0, -1, 0\n\tv_mbcnt_hi_u32_b32 %0, -1, %0" : "=v"(lane));
    const bf16* P = (const bf16*)(a.ws + WS_PROJ); bf16* Y = (bf16*)(a.ws + WS_Y);
    const int mode = u >> 7, v = u & 127, qb = 7 - (v >> 4), bh = v & 15, b = bh >> 2, h = bh & 3;
    const size_t row0 = (size_t)b * SEQ; const int P0 = qb * 256;
    if (mode == 0) {
        stage_cum(a, b, h, lds, wave, lane);
        att::attn_unit<0>(P, (int)((0 * PROJ_T + (row0 + P0) * MIXW + h * HD) * 2), (int)((1 * PROJ_T + row0 * MIXW + h * HD) * 2), (int)((2 * PROJ_T + row0 * MIXW + h * HD) * 2),
                          Y, (int)(((row0 + P0) * D + h * HD) * 2), P0, 0, 4 * qb + 4, lds, wave, lane);
    } else {
        const int tid = wave * 64 + lane;
        if (tid < 320) ((LAS float*)(lds + att::OFF_REL))[tid] = a.rel_bias[((size_t)l * 4 + h) * 320 + tid] * (1.0f / ATT_SCALE);
        const int jlo = 4 * qb - 8 < 0 ? 0 : 4 * qb - 8;
        att::attn_unit<1>(P, (int)((7 * PROJ_T + (row0 + P0) * MIXW + h * HD) * 2), (int)((8 * PROJ_T + row0 * MIXW + h * HD) * 2), (int)((9 * PROJ_T + row0 * MIXW + h * HD) * 2),
                          Y, (int)(((row0 + P0) * D + 1536 + h * HD) * 2), P0, jlo, 4 * qb + 4, lds, wave, lane);
    }
}
__device__ __forceinline__ void pool_item(const Args& a, int l, int u, LAS char* lds, int wave) {
    int lane; asm volatile("v_mbcnt_lo_u32_b32 %0, -1, 0\n\tv_mbcnt_hi_u32_b32 %0, -1, %0" : "=v"(lane));
    const int g = u & 3, T0 = (u >> 2) * 64, tid = wave * 64 + lane;
    const bf16* Pin = (const bf16*)(a.ws + WS_PROJ) + 3 * PROJ_T + g * 128;
    {
        const int cp = tid & 63, run = tid >> 6, w = 2 << g, t0 = T0 + run * 8, s0 = t0 & (SEQ - 1);
        const bf16* col = Pin + 2 * cp;
        float s_lo = 0.f, s_hi = 0.f;
        for (int j = 1; j < w; ++j) if (s0 - j >= 0) { const unsigned x = *(const unsigned*)(col + (size_t)(t0 - j) * MIXW); s_lo += bflo(x); s_hi += bfhi(x); }
#pragma unroll
        for (int i = 0; i < 8; ++i) { const unsigned x = *(const unsigned*)(col + (size_t)(t0 + i) * MIXW); s_lo += bflo(x); s_hi += bfhi(x);
            const int s = s0 + i; const int cnt = s + 1 < w ? s + 1 : w; const float inv = 1.0f / (float)cnt;
            *(LAS unsigned*)(lds + (run * 8 + i) * 272 + 4 * cp) = pk2(s_lo * inv - bflo(x), s_hi * inv - bfhi(x));
            if (s - w + 1 >= 0) { const unsigned y = *(const unsigned*)(col + (size_t)(t0 + i - w + 1) * MIXW); s_lo -= bflo(y); s_hi -= bfhi(y); } }
    }
    __syncthreads();
    {
        typedef short bf16x8 __attribute__((ext_vector_type(8)));
        const bf16* Wt = (const bf16*)(a.ws + WS_POOLW) + ((size_t)l * 4 + g) * 128 * 128;
        const int rt = (wave & 3) * 16, db = (wave >> 2) * 64, fr = lane & 15, kg = lane >> 4;
        f32x4 acc[4] = {};
#pragma unroll
        for (int ks = 0; ks < 4; ++ks) { const bf16x8 af = *(const LAS bf16x8*)(lds + (rt + fr) * 272 + (ks * 32 + kg * 8) * 2);
#pragma unroll
            for (int nt = 0; nt < 4; ++nt) { const bf16x8 bfr = *(const bf16x8*)(Wt + (size_t)(db + nt * 16 + fr) * 128 + ks * 32 + kg * 8);
                acc[nt] = __builtin_amdgcn_mfma_f32_16x16x32_bf16(bfr, af, acc[nt], 0, 0, 0); } }
        bf16* Y = (bf16*)(a.ws + WS_Y) + (size_t)(T0 + rt + fr) * D + 512 + g * 128;
#pragma unroll
        for (int nt = 0; nt < 4; ++nt) { const int d = db + nt * 16 + kg * 4; const f32x4 sc = *(const f32x4*)(a.pool_scale + l * MIXW + g * 128 + d);
            v2u w; w.x = pk2(acc[nt][0] * sc[0], acc[nt][1] * sc[1]); w.y = pk2(acc[nt][2] * sc[2], acc[nt][3] * sc[3]); *(v2u*)(Y + d) = w; }
    }
    __syncthreads();
}
__device__ __forceinline__ void conv_item(const Args& a, int l, int u, int wave) {
    int lane; asm volatile("v_mbcnt_lo_u32_b32 %0, -1, 0\n\tv_mbcnt_hi_u32_b32 %0, -1, %0" : "=v"(lane));
    const bf16* P = (const bf16*)(a.ws + WS_PROJ); const bf16* Ch = P + 4 * PROJ_T; const bf16* Cb = P + 5 * PROJ_T; const bf16* Cc = P + 6 * PROJ_T;
    const int tid = wave * 64 + lane, c0 = (tid & 63) * 8, t0 = u * 64 + (tid >> 6) * 8, s0 = t0 & (SEQ - 1);
    float wgt[3][8];
#pragma unroll
    for (int j = 0; j < 3; ++j) { const float* w = a.conv_w + ((size_t)l * 3 + j) * MIXW + c0; const f32x4 w0 = *(const f32x4*)w, w1 = *(const f32x4*)(w + 4);
#pragma unroll
        for (int k = 0; k < 4; ++k) { wgt[j][k] = w0[k]; wgt[j][4 + k] = w1[k]; } }
    float z2[8], z1[8];
#pragma unroll
    for (int k = 0; k < 8; ++k) { z2[k] = 0.f; z1[k] = 0.f; }
#pragma unroll
    for (int i = -2; i < 8; ++i) {
        float z[8];
        if (s0 + i >= 0) { const v4u hv = *(const v4u*)(Ch + (size_t)(t0 + i) * MIXW + c0), cv = *(const v4u*)(Cc + (size_t)(t0 + i) * MIXW + c0);
            z[0] = bflo(hv.x) * bflo(cv.x); z[1] = bfhi(hv.x) * bfhi(cv.x); z[2] = bflo(hv.y) * bflo(cv.y); z[3] = bfhi(hv.y) * bfhi(cv.y);
            z[4] = bflo(hv.z) * bflo(cv.z); z[5] = bfhi(hv.z) * bfhi(cv.z); z[6] = bflo(hv.w) * bflo(cv.w); z[7] = bfhi(hv.w) * bfhi(cv.w); }
        else {
#pragma unroll
            for (int k = 0; k < 8; ++k) z[k] = 0.f; }
        if (i >= 0) { const v4u bv = *(const v4u*)(Cb + (size_t)(t0 + i) * MIXW + c0); float o[8];
            const float bb[8] = {bflo(bv.x), bfhi(bv.x), bflo(bv.y), bfhi(bv.y), bflo(bv.z), bfhi(bv.z), bflo(bv.w), bfhi(bv.w)};
#pragma unroll
            for (int k = 0; k < 8; ++k) o[k] = bb[k] * (wgt[0][k] * z2[k] + wgt[1][k] * z1[k] + wgt[2][k] * z[k]);
            v4u ov; ov.x = pk2(o[0], o[1]); ov.y = pk2(o[2], o[3]); ov.z = pk2(o[4], o[5]); ov.w = pk2(o[6], o[7]);
            *(v4u*)((bf16*)(a.ws + WS_Y) + (size_t)(t0 + i) * D + 1024 + c0) = ov; }
#pragma unroll
        for (int k = 0; k < 8; ++k) { z2[k] = z1[k]; z1[k] = z[k]; }
    }
}
__device__ __forceinline__ void mixers_fast(const Args& a, int lq, LAS char* lds, int wave, int lane, int G, int blk) {
    const int l = lq & 1;
    for (int u = blk; u < N_ATT_UNITS; u += G) attention_item(a, l, u, lds, wave);
    unsigned* head = (unsigned*)(a.ws + WS_QCTR) + 64 * lq;
    volatile LAS unsigned* slot = (volatile LAS unsigned*)(lds + att::LDS_END);
    for (;;) {
        if (wave == 0 && lane == 0) *slot = __hip_atomic_fetch_add(head, 1u, __ATOMIC_RELAXED, __HIP_MEMORY_SCOPE_AGENT);
        __syncthreads();
        const unsigned it = *slot;
        __syncthreads();
        if (it >= (unsigned)(N_POOL_UNITS + N_CONV_UNITS)) break;
        if (it < (unsigned)N_POOL_UNITS) pool_item(a, l, (int)it, lds, wave); else conv_item(a, l, (int)it - N_POOL_UNITS, wave);
    }
}
__device__ __forceinline__ void p0_prologue(const Args& a, LAS unsigned char* lds, int gw, int NGW, int wave, int lane) {
    unsigned char* ws = a.ws;
    LAS float* scr = (LAS float*)(lds + wave * 16384);
    constexpr int I_WIN = (D / 64) * (NPROJ / 32), I_SQ = (D / 64) * (D / 32), I_BR = (MIXW / 64) * (D / 32);
    constexpr int I_LAYER = I_WIN + 4 * I_BR + 2 * I_SQ;
    for (int it = gw; it < DEPTH * I_LAYER; it += NGW) {
        const int l = it / I_LAYER; int r = it - l * I_LAYER;
        if (r < I_WIN) { const int kb = r / (NPROJ / 32), nb = r % (NPROJ / 32);
            tr_item<true>(a.w_in + (size_t)l * D * INW, INW, a.norm_mix + l * D, (bf16*)(ws + WS_WIN + l * WIN_BYTES), D, 0, scr, 64 * kb, 32 * nb, lane); continue; }
        r -= I_WIN;
        if (r < 4 * I_BR) { const int g = r / I_BR, rr = r % I_BR, kb = rr / (D / 32), nb = rr % (D / 32);
            tr_item<false>(a.w_branch + ((size_t)l * 4 + g) * MIXW * D, D, nullptr, (bf16*)(ws + WS_WBR + l * SQ_BYTES), D, g * MIXW, scr, 64 * kb, 32 * nb, lane); continue; }
        r -= 4 * I_BR;
        if (r < I_SQ) { const int kb = r / (D / 32), nb = r % (D / 32);
            tr_item<false>(a.w_out + (size_t)l * D * D, D, nullptr, (bf16*)(ws + WS_WOUT + l * SQ_BYTES), D, 0, scr, 64 * kb, 32 * nb, lane); continue; }
        r -= I_SQ;
        { const int kb = r / (D / 32), nb = r % (D / 32);
            tr_item<false>(a.peer_wq + (size_t)l * D * D, D, a.norm_ffn + l * D, (bf16*)(ws + WS_WQ + l * SQ_BYTES), D, 0, scr, 64 * kb, 32 * nb, lane); }
    }
    for (int it = gw; it < DEPTH * 4 * 8; it += NGW) { const int lg = it >> 3, r = it & 7;
        tr_item<false>(a.pool_w + (size_t)lg * 128 * 128, 128, nullptr, (bf16*)(ws + WS_POOLW) + (size_t)lg * 128 * 128, 128, 0, scr, 64 * (r >> 2), 32 * (r & 3), lane); }
    {
        constexpr int NR = 2 * DEPTH * PEER_E;
        f32x4 nv[8];
        if (gw < NR) { const int t = gw / (DEPTH * PEER_E), row = gw - t * (DEPTH * PEER_E); const float* src = (t ? a.peer_v : a.peer_u) + (size_t)row * D + 4 * lane;
#pragma unroll
            for (int j = 0; j < 8; ++j) nv[j] = *(const f32x4*)(src + 256 * j); }
        for (int r = gw; r < NR; r += NGW) { const int t = r / (DEPTH * PEER_E), row = r - t * (DEPTH * PEER_E);
            f32x4 v[8]; float am = 0.f;
#pragma unroll
            for (int j = 0; j < 8; ++j) v[j] = nv[j];
            { const int r2 = r + NGW; if (r2 < NR) { const int t2 = r2 / (DEPTH * PEER_E), row2 = r2 - t2 * (DEPTH * PEER_E); const float* src = (t2 ? a.peer_v : a.peer_u) + (size_t)row2 * D + 4 * lane;
#pragma unroll
                for (int j = 0; j < 8; ++j) nv[j] = *(const f32x4*)(src + 256 * j); } }
#pragma unroll
            for (int j = 0; j < 8; ++j) am = fmaxf(am, fmaxf(fmaxf(fabsf(v[j][0]), fabsf(v[j][1])), fmaxf(fabsf(v[j][2]), fabsf(v[j][3]))));
            am = wave_max(am, lane);
            const float inv = am > 0.f ? 127.0f / am : 0.f, off = t ? 128.f : 0.f;
            unsigned char* dst = ws + (t ? WS_PV : WS_PU) + (size_t)row * D + 4 * lane;
#pragma unroll
            for (int j = 0; j < 8; ++j) { const int q0 = (int)(rintf(v[j][0] * inv) + off), q1 = (int)(rintf(v[j][1] * inv) + off), q2 = (int)(rintf(v[j][2] * inv) + off), q3 = (int)(rintf(v[j][3] * inv) + off);
                *(unsigned*)(dst + 256 * j) = (unsigned)(q0 & 255) | ((unsigned)(q1 & 255) << 8) | ((unsigned)(q2 & 255) << 16) | ((unsigned)(q3 & 255) << 24); }
            if (lane == 0) ((float*)(ws + (t ? WS_SV : WS_SU)))[row] = am * (1.0f / 127.0f); }
    }
    { bf16* pk = (bf16*)(ws + WS_PK); const size_t n8 = (size_t)DEPTH * 8 * 2 * 128 * 128 / 8;
      for (size_t i = (size_t)gw * 64 + lane; i < n8; i += (size_t)NGW * 64) { const f32x4 v0 = *(const f32x4*)(a.peer_keys + i * 8), v1 = *(const f32x4*)(a.peer_keys + i * 8 + 4);
          v4u o; o.x = pk2(v0[0], v0[1]); o.y = pk2(v0[2], v0[3]); o.z = pk2(v1[0], v1[1]); o.w = pk2(v1[2], v1[3]); *(v4u*)(pk + i * 8) = o; } }
    {
        float* wf = (float*)(ws + WS_WF); float* binr = (float*)(ws + WS_BINR);
        const int gt = gw * 64 + lane, NGT = NGW * 64;
        for (int i = gt; i < DEPTH * 4 * D; i += NGT) { const int l = i / (4 * D), h = (i / D) & 3, k = i % D; wf[i] = a.w_in[(size_t)l * D * INW + (size_t)k * INW + 1536 + h] * a.norm_mix[l * D + k]; }
        for (int i = gt; i < DEPTH * NPROJ; i += NGT) { const int l = i / NPROJ, j = i % NPROJ; binr[i] = a.b_in[l * INW + colmap_in(j)]; }
    }
    {
        float* H = (float*)(ws + WS_H); bf16* HB = (bf16*)(ws + WS_HB); unsigned long long* ssq = (unsigned long long*)(ws + WS_SSQ);
        for (int m = gw; m < M; m += NGW) { float s = 0.f;
#pragma unroll
            for (int j = 0; j < 8; ++j) { const size_t o = (size_t)m * D + j * 256 + lane * 4; const f32x4 v = *(const f32x4*)(a.x + o); *(f32x4*)(H + o) = v;
                v2u w; w.x = pk2(v[0], v[1]); w.y = pk2(v[2], v[3]); *(v2u*)(HB + o) = w; s += (v[0] * v[0] + v[1] * v[1]) + (v[2] * v[2] + v[3] * v[3]); }
            s = wave_sum(s, lane); if (lane == 0) ssq[m] = (unsigned long long)((double)s * 4294967296.0); }
    }
}

__device__ __forceinline__ void forget_logits(const Args& a, int l, int gw, int NGW, int lane) {
    unsigned char* ws = a.ws; const bf16* HB = (const bf16*)(ws + WS_HB); const float* wf = (const float*)(ws + WS_WF) + l * 4 * D; const unsigned long long* ssq = (const unsigned long long*)(ws + WS_SSQ) + l * M;
    float* logf = (float*)(ws + WS_LOGF);
    for (int m = gw; m < M; m += NGW) {
        float d[4] = {0.f, 0.f, 0.f, 0.f};
#pragma unroll
        for (int j = 0; j < 4; ++j) { const int k0 = j * 512 + lane * 8; const v4u xv = *(const v4u*)(HB + (size_t)m * D + k0);
            const float x[8] = {bflo(xv.x), bfhi(xv.x), bflo(xv.y), bfhi(xv.y), bflo(xv.z), bfhi(xv.z), bflo(xv.w), bfhi(xv.w)};
#pragma unroll
            for (int h = 0; h < 4; ++h) { const f32x4 w0 = *(const f32x4*)(wf + h * D + k0), w1 = *(const f32x4*)(wf + h * D + k0 + 4);
                d[h] += x[0] * w0[0] + x[1] * w0[1] + x[2] * w0[2] + x[3] * w0[3] + x[4] * w1[0] + x[5] * w1[1] + x[6] * w1[2] + x[7] * w1[3]; } }
        const float rs = rsqrtf(ssa_to_f(ssq[m]) * (1.0f / D) + EPS);
#pragma unroll
        for (int h = 0; h < 4; ++h) { const float z = wave_sum(d[h], lane) * rs + a.b_in[l * INW + 1536 + h];
            const float ls = fminf(z, 0.f) - log1pf(__expf(-fabsf(z)));
            if (lane == h) logf[m * 4 + h] = ls; }
    }
}
__device__ __forceinline__ void cum_scan(const Args& a, int gw, int lane) {
    if (gw >= 16) return;
    const float* logf = (const float*)(a.ws + WS_LOGF); float* cum = (float*)(a.ws + WS_CUM);
    const int b = gw >> 2, h = gw & 3; float run = 0.f;
    for (int c = 0; c < SEQ / 64; ++c) { float v = logf[(size_t)(b * SEQ + c * 64 + lane) * 4 + h];
#pragma unroll
        for (int o = 1; o < 64; o <<= 1) { const float t = shf(v, lane >= o ? lane - o : lane); if (lane >= o) v += t; }
        v += run; cum[(size_t)gw * SEQ + c * 64 + lane] = v; run = shf(v, 63); }
}

template <int MODE>
__device__ __forceinline__ void naive_attn(const Args& a, int l, int b, int h, int s, LAS float* sc, int lane) {
    const unsigned char* ws = a.ws; const bf16* P = (const bf16*)(ws + WS_PROJ);
    const bf16* Qp = P + (MODE ? 7 : 0) * PROJ_T; const bf16* Kp = P + (MODE ? 8 : 1) * PROJ_T; const bf16* Vp = P + (MODE ? 9 : 2) * PROJ_T;
    const float* cum = (const float*)(ws + WS_CUM) + (size_t)(b * 4 + h) * SEQ;
    const float* rb = a.rel_bias + ((size_t)l * 4 + h) * 320;
    const size_t tb = (size_t)b * SEQ;
    int klo = 0, khi = s;
    if (MODE) { const int c = s >> 6; klo = (c - 8) * 64; if (klo < 0) klo = 0; khi = c * 64 + 63; }
    const bf16* qrow = Qp + (tb + s) * MIXW + h * HD;
    float mx = -3.0e38f;
    for (int kb = klo; kb <= khi; kb += 64) { const int k = kb + lane;
        if (k <= khi) { const bf16* krow = Kp + (tb + k) * MIXW + h * HD; float d = 0.f;
#pragma unroll 4
            for (int c8 = 0; c8 < 16; ++c8) { const v4u qv = *(const v4u*)(qrow + c8 * 8), kv = *(const v4u*)(krow + c8 * 8);
                d = dot2_bf16(qv.x, kv.x, d); d = dot2_bf16(qv.y, kv.y, d); d = dot2_bf16(qv.z, kv.z, d); d = dot2_bf16(qv.w, kv.w, d); }
            float bias;
            if (MODE == 0) bias = cum[s] - cum[k];
            else { int rel = s - k; rel = rel < -63 ? -63 : (rel > 256 ? 256 : rel); bias = rb[rel + 63]; }
            const float lg = d * ATT_SCALE + bias; sc[k - klo] = lg; mx = fmaxf(mx, lg); } }
    mx = wave_max(mx, lane);
    asm volatile("s_waitcnt lgkmcnt(0)" ::: "memory");
    float sum = 0.f;
    for (int kb = klo; kb <= khi; kb += 64) { const int k = kb + lane; if (k <= khi) { const float p = __expf(sc[k - klo] - mx); sc[k - klo] = p; sum += p; } }
    sum = wave_sum(sum, lane);
    asm volatile("s_waitcnt lgkmcnt(0)" ::: "memory");
    float o0 = 0.f, o1 = 0.f;
    for (int k = klo; k <= khi; ++k) { const float p = sc[k - klo]; const unsigned v = *(const unsigned*)(Vp + (tb + k) * MIXW + h * HD + 2 * lane); o0 += p * bflo(v); o1 += p * bfhi(v); }
    const float inv = 1.0f / sum;
    bf16* Y = (bf16*)(a.ws + WS_Y);
    *(unsigned*)(Y + (tb + s) * D + (MODE ? 1536 : 0) + h * HD + 2 * lane) = pk2(o0 * inv, o1 * inv);
    asm volatile("s_waitcnt lgkmcnt(0)" ::: "memory");
}
__device__ __forceinline__ void naive_pool(const Args& a, int l, int t, int g, LAS float* sc, int lane) {
    const bf16* Pin = (const bf16*)(a.ws + WS_PROJ) + 3 * PROJ_T;
    const int s = t & (SEQ - 1), w = 2 << g; const int cnt = (s + 1 < w) ? s + 1 : w;
    float s0 = 0.f, s1 = 0.f;
    for (int j = 0; j < cnt; ++j) { const unsigned v = *(const unsigned*)(Pin + (size_t)(t - j) * MIXW + g * 128 + 2 * lane); s0 += bflo(v); s1 += bfhi(v); }
    const unsigned v0 = *(const unsigned*)(Pin + (size_t)t * MIXW + g * 128 + 2 * lane);
    const float inv = 1.0f / (float)cnt;
    sc[2 * lane] = s0 * inv - bflo(v0); sc[2 * lane + 1] = s1 * inv - bfhi(v0);
    asm volatile("s_waitcnt lgkmcnt(0)" ::: "memory");
    const float* W = a.pool_w + ((size_t)l * 4 + g) * 128 * 128;
    float o0 = 0.f, o1 = 0.f;
    for (int c = 0; c < 128; ++c) { const float p = sc[c]; const f32x2 wv = *(const f32x2*)(W + c * 128 + 2 * lane); o0 += p * wv[0]; o1 += p * wv[1]; }
    const f32x2 ps = *(const f32x2*)(a.pool_scale + l * MIXW + g * 128 + 2 * lane);
    bf16* Y = (bf16*)(a.ws + WS_Y);
    *(unsigned*)(Y + (size_t)t * D + 512 + g * 128 + 2 * lane) = pk2(o0 * ps[0], o1 * ps[1]);
    asm volatile("s_waitcnt lgkmcnt(0)" ::: "memory");
}
__device__ __forceinline__ void naive_conv(const Args& a, int l, int t, int lane) {
    const bf16* P = (const bf16*)(a.ws + WS_PROJ); const bf16* Ch = P + 4 * PROJ_T; const bf16* Cb = P + 5 * PROJ_T; const bf16* Cc = P + 6 * PROJ_T;
    const int s = t & (SEQ - 1), c0 = lane * 8;
    float acc[8] = {0.f, 0.f, 0.f, 0.f, 0.f, 0.f, 0.f, 0.f};
#pragma unroll
    for (int j = 0; j < 3; ++j) { const int dt = 2 - j;
        if (s - dt >= 0) { const v4u hv = *(const v4u*)(Ch + (size_t)(t - dt) * MIXW + c0), cv = *(const v4u*)(Cc + (size_t)(t - dt) * MIXW + c0);
            const float* w = a.conv_w + ((size_t)l * 3 + j) * MIXW + c0; const f32x4 w0 = *(const f32x4*)w, w1 = *(const f32x4*)(w + 4);
            acc[0] += w0[0] * bflo(hv.x) * bflo(cv.x); acc[1] += w0[1] * bfhi(hv.x) * bfhi(cv.x); acc[2] += w0[2] * bflo(hv.y) * bflo(cv.y); acc[3] += w0[3] * bfhi(hv.y) * bfhi(cv.y);
            acc[4] += w1[0] * bflo(hv.z) * bflo(cv.z); acc[5] += w1[1] * bfhi(hv.z) * bfhi(cv.z); acc[6] += w1[2] * bflo(hv.w) * bflo(cv.w); acc[7] += w1[3] * bfhi(hv.w) * bfhi(cv.w); } }
    const v4u bv = *(const v4u*)(Cb + (size_t)t * MIXW + c0);
    v4u o; o.x = pk2(acc[0] * bflo(bv.x), acc[1] * bfhi(bv.x)); o.y = pk2(acc[2] * bflo(bv.y), acc[3] * bfhi(bv.y)); o.z = pk2(acc[4] * bflo(bv.z), acc[5] * bfhi(bv.z)); o.w = pk2(acc[6] * bflo(bv.w), acc[7] * bfhi(bv.w));
    *(v4u*)((bf16*)(a.ws + WS_Y) + (size_t)t * D + 1024 + c0) = o;
}
__device__ __forceinline__ void mixers_naive(const Args& a, int l, LAS unsigned char* lds, int gw, int NGW, int wave, int lane) {
    LAS float* sc = (LAS float*)(lds + wave * 8192);
    for (int i = gw; i < M * 4; i += NGW) { const int t = M * 4 - 1 - i; const int h = t & 3, tok = t >> 2; naive_attn<0>(a, l, tok >> 11, h, tok & (SEQ - 1), sc, lane); }
    for (int i = gw; i < M * 4; i += NGW) { const int h = i & 3, tok = i >> 2; naive_attn<1>(a, l, tok >> 11, h, tok & (SEQ - 1), sc, lane); }
    for (int i = gw; i < M * 4; i += NGW) naive_pool(a, l, i >> 2, i & 3, sc, lane);
    for (int i = gw; i < M; i += NGW) naive_conv(a, l, i, lane);
}

#ifndef PROBE
#define PROBE 0
#endif
__device__ __forceinline__ float gelu_tanh(float x) { const float u = 1.5957691216057308f * (x + 0.044715f * x * x * x); return x / (1.0f + __expf(-u)); }
constexpr int PEER_TOK = 32;
constexpr int PL_IDX = 0, PL_GATE = PEER_TOK * 128 * 4, PL_TAB = 2 * PEER_TOK * 128 * 4;
__device__ __forceinline__ int f2key(float f) { const int b = __builtin_bit_cast(int, f); return b ^ ((b >> 31) & 0x7fffffff); }
__device__ __forceinline__ float key2f(int k) { return __builtin_bit_cast(float, k ^ ((k >> 31) & 0x7fffffff)); }
#define CE_DESC(x, y) do { const int hi_ = (x) > (y) ? (x) : (y), lo_ = (x) > (y) ? (y) : (x); (x) = hi_; (y) = lo_; } while (0)
__device__ __forceinline__ void sort16_desc(int* v) {
#pragma unroll
    for (int k = 2; k <= 16; k <<= 1)
#pragma unroll
        for (int j = k >> 1; j > 0; j >>= 1)
#pragma unroll
            for (int i = 0; i < 16; ++i) { const int l = i ^ j; if (l > i) { if ((i & k) == 0) CE_DESC(v[i], v[l]); else CE_DESC(v[l], v[i]); } }
}
__device__ __forceinline__ void merge_top16(int* a, const int* b) {
#pragma unroll
    for (int i = 0; i < 16; ++i) a[i] = a[i] > b[15 - i] ? a[i] : b[15 - i];
#pragma unroll
    for (int j = 8; j > 0; j >>= 1)
#pragma unroll
        for (int i = 0; i < 16; ++i) { const int l = i ^ j; if (l > i) CE_DESC(a[i], a[l]); }
}
__device__ __forceinline__ void top16_of_64(int* v) {
    sort16_desc(v); sort16_desc(v + 16); sort16_desc(v + 32); sort16_desc(v + 48);
    merge_top16(v, v + 16); merge_top16(v + 32, v + 48); merge_top16(v, v + 32);
}
constexpr int cand_slot(int i, int j) {
    int n = 0;
    for (int a = 0; a < 16; ++a) for (int b = 0; b < 16; ++b) { if ((a + 1) * (b + 1) <= 16) { if (a == i && b == j) return n; ++n; } }
    return -1;
}
__device__ __forceinline__ void peer_retrieve(const Args& a, int l, int t0, int h, LAS char* lds, int wave) {
    typedef short bf16x8 __attribute__((ext_vector_type(8)));
    typedef float f32x16 __attribute__((ext_vector_type(16)));
    int lane; asm volatile("v_mbcnt_lo_u32_b32 %0, -1, 0\n\tv_mbcnt_hi_u32_b32 %0, -1, %0" : "=v"(lane));
    const int r32 = lane & 31, hi = lane >> 5, hi4 = hi * 4;
    const bf16* Q = (const bf16*)(a.ws + WS_Q) + (size_t)(t0 + r32) * D + h * 256 + hi * 8;
    const bf16* PK = (const bf16*)(a.ws + WS_PK) + ((size_t)(l * 8 + h) * 2) * 128 * 128 + (size_t)r32 * 128 + hi * 8;
    int top[2][16];
#pragma unroll
    for (int p = 0; p < 2; ++p) {
        f32x16 acc[4] = {};
        bf16x8 qf[8];
#pragma unroll
        for (int cs = 0; cs < 8; ++cs) qf[cs] = *(const bf16x8*)(Q + p * 128 + cs * 16);
#pragma unroll
        for (int kb = 0; kb < 4; ++kb) { bf16x8 kf[8];
#pragma unroll
            for (int cs = 0; cs < 8; ++cs) kf[cs] = *(const bf16x8*)(PK + (size_t)p * 128 * 128 + (size_t)kb * 32 * 128 + cs * 16);
#pragma unroll
            for (int cs = 0; cs < 8; ++cs) acc[kb] = __builtin_amdgcn_mfma_f32_32x32x16_bf16(kf[cs], qf[cs], acc[kb], 0, 0, 0); }
        int v[64];
#pragma unroll
        for (int kb = 0; kb < 4; ++kb)
#pragma unroll
            for (int r = 0; r < 16; ++r) { const int c = kb * 32 + (r & 3) + 8 * (r >> 2);
                v[kb * 16 + r] = (f2key(acc[kb][r]) & ~127) | (c | hi4); }
        top16_of_64(v);
        int mine[16], other[16];
#pragma unroll
        for (int i = 0; i < 16; ++i) { auto rr = __builtin_amdgcn_permlane32_swap((unsigned)v[i], (unsigned)v[i], false, false); mine[i] = (int)rr[0]; other[i] = (int)rr[1]; }
        merge_top16(mine, other);
#pragma unroll
        for (int i = 0; i < 16; ++i) top[p][i] = mine[i];
    }
    LAS int* tab = (LAS int*)(lds + PL_TAB) + (wave * 64 + lane) * 32;
    float sA[16], sB[16];
#pragma unroll
    for (int i = 0; i < 16; ++i) { sA[i] = key2f(top[0][i] & ~127); sB[i] = key2f(top[1][i] & ~127); tab[i] = top[0][i] & 127; tab[16 + i] = top[1][i] & 127; }
    int c[64];
#pragma unroll
    for (int n = 0; n < 64; ++n) c[n] = (int)0x80000000;
#pragma unroll
    for (int i = 0; i < 16; ++i)
#pragma unroll
        for (int j = 0; j < 16; ++j) if ((i + 1) * (j + 1) <= 16) c[cand_slot(i, j)] = (f2key(sA[i] + sB[j]) & ~255) | (16 * i + j);
    top16_of_64(c);
    float ex[16]; float sum = 0.f; const float mx = key2f(c[0] & ~255);
#pragma unroll
    for (int w = 0; w < 16; ++w) { ex[w] = __expf(key2f(c[w] & ~255) - mx); sum += ex[w]; }
    const float inv = 1.0f / sum;
    asm volatile("s_waitcnt lgkmcnt(0)" ::: "memory");
    LAS int* oi = (LAS int*)(lds + PL_IDX) + r32 * 128 + h * 16; LAS float* og = (LAS float*)(lds + PL_GATE) + r32 * 128 + h * 16;
#pragma unroll
    for (int w = 0; w < 16; ++w) { const int id = c[w] & 255; const int e = tab[id >> 4] * 128 + tab[16 + (id & 15)];
        if ((w >> 3) == hi) { oi[w] = e; og[w] = ex[w] * inv; } }
}
constexpr size_t WS_IDX = 816 * MiB;
constexpr size_t WS_GATE = 820 * MiB;
constexpr size_t WS_XQ = 824 * MiB;
constexpr size_t WS_SX = 856 * MiB;
constexpr size_t WS_PART = 857 * MiB;
constexpr size_t WS_SUT = 890 * MiB;
constexpr size_t WS_END2 = 894 * MiB;
constexpr int NSLICE = 8, SLW = D / NSLICE;
#define DPP_ROR(x, n) __builtin_bit_cast(float, __builtin_amdgcn_update_dpp(0, __builtin_bit_cast(int, (x)), 0x120 + (n), 0xf, 0xf, false))
__device__ __forceinline__ void peer_publish(const Args& a, int l, int t, LAS char* lds, int tl) {
    int lane; LANE_ID(lane);
    unsigned char* ws = a.ws;
    { int* gi = (int*)(ws + WS_IDX) + (size_t)t * 128; float* gg = (float*)(ws + WS_GATE) + (size_t)t * 128; float* gs = (float*)(ws + WS_SUT) + (size_t)t * 128;
      const float* SU = (const float*)(ws + WS_SU) + l * PEER_E; const float* SV = (const float*)(ws + WS_SV) + l * PEER_E;
      const int i0 = ((const LAS int*)(lds + PL_IDX))[tl * 128 + lane], i1 = ((const LAS int*)(lds + PL_IDX))[tl * 128 + 64 + lane];
      gi[lane] = i0; gi[64 + lane] = i1; gs[lane] = SU[i0]; gs[64 + lane] = SU[i1];
      gg[lane] = ((const LAS float*)(lds + PL_GATE))[tl * 128 + lane] * SV[i0]; gg[64 + lane] = ((const LAS float*)(lds + PL_GATE))[tl * 128 + 64 + lane] * SV[i1]; }
    const unsigned long long* ssa1 = (const unsigned long long*)(ws + WS_SSA) + l * M;
    const float rs = rsqrtf(ssa_to_f(ssa1[t]) * (1.0f / D) + EPS);
    const bf16* HB = (const bf16*)(ws + WS_HB) + (size_t)t * D; const float* gn = a.norm_ffn + l * D;
    float xf[32]; float am = 0.f;
#pragma unroll
    for (int i = 0; i < 2; ++i) { const int k0 = 16 * lane + 1024 * i; const v4u h0 = *(const v4u*)(HB + k0), h1 = *(const v4u*)(HB + k0 + 8);
        const unsigned hw[8] = {h0.x, h0.y, h0.z, h0.w, h1.x, h1.y, h1.z, h1.w};
#pragma unroll
        for (int q = 0; q < 4; ++q) { const f32x4 g = *(const f32x4*)(gn + k0 + 4 * q);
            xf[16 * i + 4 * q + 0] = bflo(hw[2 * q]) * rs * g[0]; xf[16 * i + 4 * q + 1] = bfhi(hw[2 * q]) * rs * g[1];
            xf[16 * i + 4 * q + 2] = bflo(hw[2 * q + 1]) * rs * g[2]; xf[16 * i + 4 * q + 3] = bfhi(hw[2 * q + 1]) * rs * g[3]; } }
#pragma unroll
    for (int k = 0; k < 32; ++k) am = fmaxf(am, fabsf(xf[k]));
    am = wave_max(am, lane);
    const float inv = am > 0.f ? 127.0f / am : 0.f;
    if (lane == 0) ((float*)(ws + WS_SX))[t] = am * (1.0f / 127.0f);
    unsigned char* xq = ws + WS_XQ + (size_t)t * 4096;
#pragma unroll
    for (int i = 0; i < 2; ++i) { v4u ph, pl;
#pragma unroll
        for (int d = 0; d < 4; ++d) { unsigned wh = 0, wl = 0;
#pragma unroll
            for (int b = 0; b < 4; ++b) { const float sv = xf[16 * i + 4 * d + b] * inv, hq = rintf(sv), lq = rintf((sv - hq) * 128.0f);
                wh |= ((unsigned)((int)hq & 255)) << (8 * b); wl |= ((unsigned)((int)lq & 255)) << (8 * b); }
            ph[d] = wh; pl[d] = wl; }
        *(v4u*)(xq + 16 * lane + 1024 * i) = ph; *(v4u*)(xq + 2048 + 16 * lane + 1024 * i) = pl; }
}
struct PeerItems { int pos, npop, rank, nloc, wave;
    __device__ __forceinline__ int nblk() const { return (M / PEER_TOK - rank + nloc - 1) / nloc; }
    __device__ __forceinline__ int count() const { return ((NSLICE - pos + npop - 1) / npop) * nblk() * (PEER_TOK / NWAVES); }
    __device__ __forceinline__ void get(int n, int& s, int& t) const { constexpr int per = PEER_TOK / NWAVES; const int k = n % per, r = n / per, nb = nblk();
        s = pos + (r / nb) * npop; t = (rank + (r % nb) * nloc) * PEER_TOK + wave * per + k; } };
__device__ __forceinline__ void peer_u_wave(const Args& a, int l, const PeerItems& it) {
    int lane; LANE_ID(lane);
    unsigned char* ws = a.ws; const int sub = lane & 15, grp = lane >> 4;
    const __amdgpu_buffer_rsrc_t rU = __builtin_amdgcn_make_buffer_rsrc((void*)(ws + WS_PU + (size_t)l * PE_BYTES), 0, 0x7fffffff, 0x00020000);
    const __amdgpu_buffer_rsrc_t rW = __builtin_amdgcn_make_buffer_rsrc((void*)ws, 0, 0x7fffffff, 0x00020000);
    const int N = it.count(); if (N <= 0) return;
    int s, t; it.get(0, s, t);
    int idc[2], idn[2] = {0, 0}; v4u xhc, xlc, xhn = {}, xln = {}; v4u wA[8], wB[8];
#define PU_META(I0, I1, XH, XL, S_, T_) do { I0 = (int)__builtin_amdgcn_raw_buffer_load_b32(rW, 4 * lane, (int)WS_IDX + (T_) * 512, 0); I1 = (int)__builtin_amdgcn_raw_buffer_load_b32(rW, 4 * lane, (int)WS_IDX + (T_) * 512 + 256, 0); \
        XH = __builtin_amdgcn_raw_buffer_load_b128(rW, 16 * sub, (int)WS_XQ + (T_) * 4096 + SLW * (S_), 0); XL = __builtin_amdgcn_raw_buffer_load_b128(rW, 16 * sub, (int)WS_XQ + (T_) * 4096 + 2048 + SLW * (S_), 0); } while (0)
#define PU_ISSUE(W, ID, Q, S_) do { _Pragma("unroll") for (int j = 0; j < 8; ++j) { const int e_ = shi(ID[(Q) >> 1], 4 * ((8 * (Q) + j) & 15) + grp); W[j] = __builtin_amdgcn_raw_buffer_load_b128(rU, e_ * D + SLW * (S_) + 16 * sub, 0, 0); } } while (0)
#define PU_COMP(W, Q) do { _Pragma("unroll") for (int j = 0; j < 8; ++j) { int dh = 0, dl = 0; \
            dh = __builtin_amdgcn_sdot4((int)W[j].x, (int)xhc.x, dh, false); dl = __builtin_amdgcn_sdot4((int)W[j].x, (int)xlc.x, dl, false); \
            dh = __builtin_amdgcn_sdot4((int)W[j].y, (int)xhc.y, dh, false); dl = __builtin_amdgcn_sdot4((int)W[j].y, (int)xlc.y, dl, false); \
            dh = __builtin_amdgcn_sdot4((int)W[j].z, (int)xhc.z, dh, false); dl = __builtin_amdgcn_sdot4((int)W[j].z, (int)xlc.z, dl, false); \
            dh = __builtin_amdgcn_sdot4((int)W[j].w, (int)xhc.w, dh, false); dl = __builtin_amdgcn_sdot4((int)W[j].w, (int)xlc.w, dl, false); \
            float p_ = (float)dh + (float)dl * (1.0f / 128.0f); \
            p_ += DPP_ROR(p_, 8); p_ += DPP_ROR(p_, 4); p_ += DPP_ROR(p_, 2); p_ += DPP_ROR(p_, 1); \
            if (sub == ((8 * (Q) + j) & 15)) { if ((Q) >> 1) acc1 = p_; else acc0 = p_; } __builtin_amdgcn_sched_barrier(0); } } while (0)
    PU_META(idc[0], idc[1], xhc, xlc, s, t); PU_ISSUE(wA, idc, 0, s); PU_ISSUE(wB, idc, 1, s);
    for (int n = 0; n < N; ++n) {
        int sn = s, tn = t; const bool more = n + 1 < N;
        if (more) it.get(n + 1, sn, tn);
        PU_META(idn[0], idn[1], xhn, xln, sn, tn);
        float acc0 = 0.f, acc1 = 0.f;
        __builtin_amdgcn_sched_barrier(0);
        PU_COMP(wA, 0); PU_ISSUE(wA, idc, 2, s); __builtin_amdgcn_sched_barrier(0);
        PU_COMP(wB, 1); PU_ISSUE(wB, idc, 3, s); __builtin_amdgcn_sched_barrier(0);
        PU_COMP(wA, 2); PU_ISSUE(wA, idn, 0, sn); __builtin_amdgcn_sched_barrier(0);
        PU_COMP(wB, 3); PU_ISSUE(wB, idn, 1, sn); __builtin_amdgcn_sched_barrier(0);
        __builtin_amdgcn_raw_buffer_store_b32(__builtin_bit_cast(unsigned, acc0), rW, (4 * sub + grp) * 4, (int)WS_PART + (s * M + t) * 512, 0);
        __builtin_amdgcn_raw_buffer_store_b32(__builtin_bit_cast(unsigned, acc1), rW, (4 * sub + grp) * 4 + 256, (int)WS_PART + (s * M + t) * 512, 0);
        s = sn; t = tn; idc[0] = idn[0]; idc[1] = idn[1]; xhc = xhn; xlc = xln;
    }
#undef PU_META
#undef PU_ISSUE
#undef PU_COMP
}
__device__ __forceinline__ void peer_v_wave(const Args& a, int l, const PeerItems& it) {
    int lane; LANE_ID(lane);
    unsigned char* ws = a.ws; const int sub = lane & 15, grp = lane >> 4;
    const __amdgpu_buffer_rsrc_t rV = __builtin_amdgcn_make_buffer_rsrc((void*)(ws + WS_PV + (size_t)l * PE_BYTES), 0, 0x7fffffff, 0x00020000);
    const __amdgpu_buffer_rsrc_t rW = __builtin_amdgcn_make_buffer_rsrc((void*)ws, 0, 0x7fffffff, 0x00020000);
    const int N = it.count(); if (N <= 0) return;
    int s, t; it.get(0, s, t);
    struct Meta { int id[2]; float gate[2], su[2], pa[2], sx; f32x4 h1; };
    Meta mc, mn; v4u wA[8], wB[8];
    const int l4 = 4 * lane;
#define WLD(off_s) __builtin_amdgcn_raw_buffer_load_b32(rW, l4, (int)(off_s), 0)
#define PV_META(MM, S_, T_) do { const int r_ = (T_) * 512; MM.id[0] = (int)WLD(WS_IDX + r_); MM.id[1] = (int)WLD(WS_IDX + r_ + 256); \
        MM.gate[0] = __builtin_bit_cast(float, WLD(WS_GATE + r_)); MM.gate[1] = __builtin_bit_cast(float, WLD(WS_GATE + r_ + 256)); MM.su[0] = __builtin_bit_cast(float, WLD(WS_SUT + r_)); MM.su[1] = __builtin_bit_cast(float, WLD(WS_SUT + r_ + 256)); \
        float a0_ = 0.f, a1_ = 0.f; _Pragma("unroll") for (int q = 0; q < NSLICE; ++q) { const int po_ = (int)WS_PART + (q * M + (T_)) * 512; a0_ += __builtin_bit_cast(float, WLD(po_)); a1_ += __builtin_bit_cast(float, WLD(po_ + 256)); } \
        MM.pa[0] = a0_; MM.pa[1] = a1_; MM.sx = ((const float*)(ws + WS_SX))[T_]; \
        MM.h1 = __builtin_bit_cast(f32x4, __builtin_amdgcn_raw_buffer_load_b128(rW, (16 * sub + 4 * grp) * 4, (int)WS_H + ((T_) * D + SLW * (S_)) * 4, 0)); } while (0)
#define PV_ISSUE(W, ID, Q, S_) do { _Pragma("unroll") for (int j = 0; j < 8; ++j) { const int e_ = shi(ID[(Q) >> 1], 4 * ((8 * (Q) + j) & 15) + grp); W[j] = __builtin_amdgcn_raw_buffer_load_b128(rV, e_ * D + SLW * (S_) + 16 * sub, 0, 0); } } while (0)
#define PV_COMP(W, Q) do { _Pragma("unroll") for (int j = 0; j < 8; ++j) { const float c_ = shf(coef[(Q) >> 1], 4 * ((8 * (Q) + j) & 15) + grp); const f32x2 c2_ = {c_, c_}; const unsigned ww_[4] = {W[j].x, W[j].y, W[j].z, W[j].w}; \
            _Pragma("unroll") for (int d = 0; d < 4; ++d) { y[2 * d] = __builtin_elementwise_fma(c2_, (f32x2){(float)(ww_[d] & 255u), (float)((ww_[d] >> 8) & 255u)}, y[2 * d]); \
                y[2 * d + 1] = __builtin_elementwise_fma(c2_, (f32x2){(float)((ww_[d] >> 16) & 255u), (float)(ww_[d] >> 24)}, y[2 * d + 1]); } __builtin_amdgcn_sched_barrier(0); } } while (0)
    PV_META(mc, s, t); PV_ISSUE(wA, mc.id, 0, s); PV_ISSUE(wB, mc.id, 1, s);
    for (int n = 0; n < N; ++n) {
        int sn = s, tn = t; const bool more = n + 1 < N;
        if (more) it.get(n + 1, sn, tn);
        PV_META(mn, sn, tn);
        float coef[2];
#pragma unroll
        for (int hf = 0; hf < 2; ++hf) coef[hf] = gelu_tanh(mc.pa[hf] * mc.su[hf] * mc.sx) * mc.gate[hf];
        const float corr = 128.0f * wave_sum(coef[0] + coef[1], lane);
        f32x2 y[8];
#pragma unroll
        for (int k = 0; k < 8; ++k) y[k] = (f32x2){0.f, 0.f};
        __builtin_amdgcn_sched_barrier(0);
        PV_COMP(wA, 0); PV_ISSUE(wA, mc.id, 2, s); __builtin_amdgcn_sched_barrier(0);
        PV_COMP(wB, 1); PV_ISSUE(wB, mc.id, 3, s); __builtin_amdgcn_sched_barrier(0);
        PV_COMP(wA, 2); PV_ISSUE(wA, mn.id, 0, sn); __builtin_amdgcn_sched_barrier(0);
        PV_COMP(wB, 3); PV_ISSUE(wB, mn.id, 1, sn); __builtin_amdgcn_sched_barrier(0);
#pragma unroll
        for (int k = 0; k < 8; ++k) { y[k][0] += shf(y[k][0], lane ^ 16); y[k][1] += shf(y[k][1], lane ^ 16); y[k][0] += shf(y[k][0], lane ^ 32); y[k][1] += shf(y[k][1], lane ^ 32); }
        const f32x2 ya = grp == 0 ? y[0] : grp == 1 ? y[2] : grp == 2 ? y[4] : y[6], yb = grp == 0 ? y[1] : grp == 1 ? y[3] : grp == 2 ? y[5] : y[7];
        const f32x4 h2 = {mc.h1[0] + ya[0] - corr, mc.h1[1] + ya[1] - corr, mc.h1[2] + yb[0] - corr, mc.h1[3] + yb[1] - corr};
        __builtin_amdgcn_raw_buffer_store_b128(__builtin_bit_cast(v4u, h2), rW, (16 * sub + 4 * grp) * 4, (int)WS_H + (t * D + SLW * s) * 4, 0);
        v2u hb; hb.x = pk2(h2[0], h2[1]); hb.y = pk2(h2[2], h2[3]);
        __builtin_amdgcn_raw_buffer_store_b64(hb, rW, (16 * sub + 4 * grp) * 2, (int)WS_HB + (t * D + SLW * s) * 2, 0);
        const float sq = wave_sum((h2[0] * h2[0] + h2[1] * h2[1]) + (h2[2] * h2[2] + h2[3] * h2[3]), lane);
        if (lane == 0) atomicAdd((unsigned long long*)(ws + WS_SSQ) + (size_t)(l + 1) * M + t, (unsigned long long)((double)sq * 4294967296.0));
        s = sn; t = tn; mc = mn;
    }
#undef PV_META
#undef WLD
#undef PV_ISSUE
#undef PV_COMP
}
__device__ __forceinline__ void final_norm_row(const Args& a, int t) {
    int lane; LANE_ID(lane);
    const float* H = (const float*)(a.ws + WS_H) + (size_t)t * D; float* O = a.out + (size_t)t * D;
    const float rf = rsqrtf(ssa_to_f(((const unsigned long long*)(a.ws + WS_SSQ))[(size_t)DEPTH * M + t]) * (1.0f / D) + EPS);
#pragma unroll
    for (int j = 0; j < 8; ++j) { const int k0 = 4 * lane + 256 * j; const f32x4 h = *(const f32x4*)(H + k0), g = *(const f32x4*)(a.norm_final + k0);
        *(f32x4*)(O + k0) = (f32x4){h[0] * rf * g[0], h[1] * rf * g[1], h[2] * rf * g[2], h[3] * rf * g[3]}; }
}

__global__ void __launch_bounds__(NT, 2) mk_fwd(ArgsK a_in) {
    extern __shared__ __attribute__((aligned(16))) unsigned char lds_raw[];
    LAS unsigned char* lds = (LAS unsigned char*)lds_raw;
    cg::grid_group grid = cg::this_grid();
    grid.sync();
    const int wave0 = __builtin_amdgcn_readfirstlane(threadIdx.x >> 6);
    const int G = gridDim.x;
    const CAS ArgsK* ka = (const CAS ArgsK*)__builtin_amdgcn_kernarg_segment_ptr();
    size_t zoff = 0;
#define PHASE_BEGIN() int lane; LANE_ID(lane); int blk = blockIdx.x, Gp = G, wv = wave0; asm volatile("" : "+s"(zoff), "+s"(ka), "+s"(blk), "+s"(Gp), "+s"(wv)); const int wave = wv, gw = blk * NWAVES + wv, NGW = Gp * NWAVES; (void)gw; (void)NGW; const Args a = load_args(ka, zoff); unsigned char* const ws = a.ws; (void)ws
    volatile LAS unsigned* bst = (volatile LAS unsigned*)(lds + RING_BYTES + 1024);
    if (PROBE == 3) { PHASE_BEGIN(); p0_prologue(a, lds, gw, NGW, wave, lane); }
    volatile LAS unsigned* xinfo = bst + 4;
    { PHASE_BEGIN(); if (wave == 0 && lane == 0) { bst[0] = 0u; bst[1] = 0u; xinfo[2] = xb_add((unsigned*)(ws + WS_BAR) + XB_XCNT(xb_xcc_id()), 1u); }
      p0_prologue(a, lds, gw, NGW, wave, lane); }
#define GRID_BAR() do { asm volatile("" : "+s"(zoff)); unsigned char* wsb_ = (unsigned char*)ka->ws + zoff; int wvb_ = wave0; asm volatile("" : "+s"(wvb_)); xcd_barrier((unsigned*)(wsb_ + WS_BAR), xb_xcc_id(), (unsigned)G, bst, wvb_); if (PROBE == 9) xcd_barrier((unsigned*)(wsb_ + WS_BAR), xb_xcc_id(), (unsigned)G, bst, wvb_); } while (0)
    GRID_BAR();
    {
        PHASE_BEGIN();
        if (wave == 0 && lane == 0) { unsigned* bar = (unsigned*)(ws + WS_BAR); const unsigned x = xb_xcc_id(); unsigned pos = 0, npop = 0, mine = 1;
            for (unsigned j = 0; j < 16; ++j) { const unsigned c = xb_ld(&bar[XB_XCNT(j)]); if (c) { ++npop; if (j < x) ++pos; } if (j == x) mine = c ? c : 1u; }
            xinfo[0] = pos; xinfo[1] = npop ? npop : 1u; xinfo[3] = mine; }
        __syncthreads();
    }
    int depth_rt = DEPTH; asm volatile("" : "+s"(depth_rt));
    for (int lc = 0; lc < depth_rt; ++lc) {
        int l = lc; asm volatile("" : "+s"(l));
        for (int rep = 0; rep < (PROBE == 4 ? 2 : 1); ++rep)
        {
            PHASE_BEGIN();
            const unsigned long long* ssq_mix = (const unsigned long long*)(ws + WS_SSQ) + l * M;
            pg8::Gemm g{(const bf16*)(ws + WS_HB), (const bf16*)(ws + WS_WIN + l * WIN_BYTES), M, NPROJ, D}; pg8::StaticOrder S; S.init(M, NPROJ, Gp, blk);
            EpiProj E{(bf16*)(ws + WS_PROJ), (bf16*)(ws + WS_R), (const float*)(ws + WS_BINR) + l * NPROJ, ssq_mix};
            pg8::gemm_phase<EpiProj, pg8::StaticOrder, true>(lds, g, S, E, wave);
            for (int r2 = 0; r2 < (PROBE == 8 ? 2 : 1); ++r2) forget_logits(a, l, gw, NGW, lane);
        }
        GRID_BAR();
        if (PROBE == 5) { PHASE_BEGIN(); mixers_fast(a, l + 2, (LAS char*)lds, wave, lane, Gp, blk); }
        { PHASE_BEGIN(); mixers_fast(a, l, (LAS char*)lds, wave, lane, Gp, blk); }
        GRID_BAR();
        for (int rep = 0; rep < (PROBE == 6 ? 2 : 1); ++rep)
        {
            PHASE_BEGIN();
            pg8::Gemm g{(const bf16*)(ws + WS_Y), (const bf16*)(ws + WS_WBR + l * SQ_BYTES), M, D, D}; pg8::StaticOrder S; S.init(M, D, Gp, blk);
            EpiMerge E{(const bf16*)(ws + WS_R), (bf16*)(ws + WS_MRG)};
            pg8::gemm_phase<EpiMerge, pg8::StaticOrder, false>(lds, g, S, E, wave);
        }
        GRID_BAR();
        {
            PHASE_BEGIN();
            pg8::Gemm g{(const bf16*)(ws + WS_MRG), (const bf16*)(ws + WS_WOUT + l * SQ_BYTES), M, D, D}; pg8::StaticOrder S; S.init(M, D, Gp, blk);
            EpiRes E{(float*)(ws + WS_H), (bf16*)(ws + WS_HB), (unsigned long long*)(ws + WS_SSA) + l * M};
            pg8::gemm_phase<EpiRes, pg8::StaticOrder, false>(lds, g, S, E, wave);
        }
        GRID_BAR();
        for (int rep = 0; rep < (PROBE == 7 ? 2 : 1); ++rep)
        {
            PHASE_BEGIN();
            pg8::Gemm g{(const bf16*)(ws + WS_HB), (const bf16*)(ws + WS_WQ + l * SQ_BYTES), M, D, D}; pg8::StaticOrder S; S.init(M, D, Gp, blk);
            EpiQ E{(bf16*)(ws + WS_Q), (const unsigned long long*)(ws + WS_SSA) + l * M};
            pg8::gemm_phase<EpiQ, pg8::StaticOrder, false>(lds, g, S, E, wave);
        }
        GRID_BAR();
        {
            PHASE_BEGIN(); (void)lane;
            for (int t0 = blk * PEER_TOK; t0 < M; t0 += Gp * PEER_TOK) {
                peer_retrieve(a, l, t0, wave, (LAS char*)lds, wave);
                __syncthreads();
                for (int k = 0; k < PEER_TOK / NWAVES; ++k) { const int tl = wave * (PEER_TOK / NWAVES) + k; peer_publish(a, l, t0 + tl, (LAS char*)lds, tl); }
                __syncthreads();
            }
        }
        GRID_BAR();
        {
            PHASE_BEGIN(); (void)lane;
            const int pos = __builtin_amdgcn_readfirstlane((int)xinfo[0]), npop = __builtin_amdgcn_readfirstlane((int)xinfo[1]), rank = __builtin_amdgcn_readfirstlane((int)xinfo[2]), nloc = __builtin_amdgcn_readfirstlane((int)xinfo[3]);
            const PeerItems it{pos, npop, rank, nloc, wave}; peer_u_wave(a, l, it);
        }
        GRID_BAR();
        {
            PHASE_BEGIN(); (void)lane;
            const int pos = __builtin_amdgcn_readfirstlane((int)xinfo[0]), npop = __builtin_amdgcn_readfirstlane((int)xinfo[1]), rank = __builtin_amdgcn_readfirstlane((int)xinfo[2]), nloc = __builtin_amdgcn_readfirstlane((int)xinfo[3]);
            const PeerItems it{pos, npop, rank, nloc, wave}; peer_v_wave(a, l, it);
        }
        GRID_BAR();
    }
    {
        PHASE_BEGIN(); (void)lane;
        for (int t = gw; t < M; t += NGW) final_norm_row(a, t);
    }
}

extern "C" void kernel_launch(void* const* d_in, const int* in_sizes, int n_in, void* d_out, int out_size, void* d_ws, size_t ws_size, hipStream_t stream) {
    static int grid = 0;
    if (grid == 0) {
        int dev = 0, cus = 0, per_cu = 0;
        if (n_in != 16 || out_size != M * D || ws_size < WS_END2) { fprintf(stderr, "kernel_launch: unexpected shapes (n_in %d out %d ws %zu)\n", n_in, out_size, ws_size); grid = -1; return; }
        (void)hipGetDevice(&dev);
        (void)hipDeviceGetAttribute(&cus, hipDeviceAttributeMultiprocessorCount, dev);
        (void)hipFuncSetAttribute((const void*)mk_fwd, hipFuncAttributeMaxDynamicSharedMemorySize, LDS_BYTES);
        (void)hipOccupancyMaxActiveBlocksPerMultiprocessor(&per_cu, (const void*)mk_fwd, NT, LDS_BYTES);
        if (per_cu < 1) { fprintf(stderr, "kernel_launch: occupancy query says %d blocks per CU\n", per_cu); }
        grid = cus;
        if (grid > 256) grid = 256;
    }
    if (grid < 0) return;
    (void)hipMemsetAsync((char*)d_ws + WS_CTL, 0, CTL_ZERO_BYTES, stream);
    ArgsK a{};
    const GAS float** p = (const GAS float**)&a;
    for (int i = 0; i < 16; ++i) p[i] = (const GAS float*)d_in[i];
    a.out = (GAS float*)d_out; a.ws = (GAS unsigned char*)d_ws;
    void* args[] = {&a};
    hipError_t e = hipLaunchCooperativeKernel((const void*)mk_fwd, dim3(grid), dim3(NT), args, LDS_BYTES, stream);
    if (e != hipSuccess) fprintf(stderr, "cooperative launch failed: %s (grid %d)\n", hipGetErrorString(e), grid);
}
```

```cpp
#include <hip/hip_runtime.h>
#include <hip/hip_cooperative_groups.h>
#include <cstdio>
#include <cstdint>
namespace cg = cooperative_groups;
namespace pg8 {
#define PG8_LAS __attribute__((address_space(3)))
typedef unsigned short bf16_t;
typedef short bf16x8 __attribute__((ext_vector_type(8)));
typedef float f32x4 __attribute__((ext_vector_type(4)));
typedef unsigned u32x4 __attribute__((ext_vector_type(4)));
typedef unsigned u32x2 __attribute__((ext_vector_type(2)));
constexpr int BM = 256, BK = 64, HALF = 128, HTB = HALF * BK * 2  , STAGE_BYTES = 8 * HTB, NXCD = 8, WGM = 8;

__host__ __device__ __forceinline__ int lds_byte(int r, int c) { const int st = (r >> 4) * 2 + (c >> 5), rr = r & 15, cc = c & 31, ob = rr * 64 + cc * 2; return st * 1024 + (ob ^ (((ob >> 9) & 1) << 5)); }
__host__ __device__ __forceinline__ void stage_rc(int b, int& R, int& C) { const int st = b / 1024, sb = b % 1024, swz = sb ^ (((sb >> 9) & 1) << 5); R = (st >> 1) * 16 + swz / 64; C = (st & 1) * 32 + (swz % 64) / 2; }
__host__ __device__ __forceinline__ int perm32(int rho) { const int n = rho >> 4, i = rho & 15; return 8 * (i >> 2) + 4 * n + (i & 3); }

struct Unit { int pm, pn; };
struct Gemm { const bf16_t* A; const bf16_t* Bt; int M, N, K; };

struct StaticOrder {
    int nM, nN, nwg, G, c;
    __host__ __device__ void init(int M, int N, int G_, int c_) { nM = M / BM; nN = N / BM; nwg = nM * nN; G = G_; c = c_; }
    __host__ __device__ bool next(int i, Unit& u) const {
        const long L = (long)i * G + c; if (L >= nwg) return false;
        int wgid = (int)L; { const int q = nwg / NXCD, r = nwg % NXCD, xcd = wgid % NXCD, off = wgid / NXCD; wgid = (xcd < r ? xcd * (q + 1) : r * (q + 1) + (xcd - r) * q) + off; }
        const int nig = WGM * nN, gid = wgid / nig, fm = gid * WGM, gsz = (nM - fm) < WGM ? (nM - fm) : WGM;
        u.pm = fm + ((wgid % nig) % gsz); u.pn = (wgid % nig) / gsz; return true;
    }
};

__device__ __forceinline__ unsigned cvt_pk_bf16(float lo, float hi) { unsigned r; asm volatile("v_cvt_pk_bf16_f32 %0, %1, %2" : "=v"(r) : "v"(lo), "v"(hi)); return r; }

template <class Epi, class Sched, bool ALIGN_EPI = false>
__device__ __forceinline__ void gemm_phase(PG8_LAS unsigned char* lds, const Gemm g, const Sched& S, const Epi& E, int wid) {
    int lane_; asm volatile("v_mbcnt_lo_u32_b32 %0, -1, 0\n\tv_mbcnt_hi_u32_b32 %0, -1, %0" : "=v"(lane_));
    const int lane = lane_, tid = wid * 64 + lane, wr = wid >> 2, wc = wid & 3, fr = lane & 15, fq = lane >> 4;
    const int K = g.K, nt = K / BK;
    unsigned voffA[2], voffB[2];
#pragma unroll
    for (int i = 0; i < 2; ++i) { int R, C; stage_rc(tid * 16 + i * 8192, R, C); const int Rb = Epi::PERM ? ((R & ~31) + perm32(R & 31)) : R;
        voffA[i] = (unsigned)(R * K + C) * 2u; voffB[i] = (unsigned)(Rb * K + C) * 2u; }
    const size_t kstep = (size_t)(BK * 2);
    const size_t hstep = (size_t)HALF * K * 2;
    const size_t tstep = 2 * hstep;
    const unsigned ldsw = (unsigned)wid * 1024u;
    const int aoff = lds_byte(wr * 64 + fr, fq * 8), boff = lds_byte(wc * 32 + fr, fq * 8);
#define PG8_SA(b, h) (((b) * 2 + (h)) * HTB)
#define PG8_SB(b, h) ((4 + (b) * 2 + (h)) * HTB)
#define PG8_STAGE(bufoff, gbase, voff) do { _Pragma("unroll") for (int _i = 0; _i < 2; ++_i) \
        __builtin_amdgcn_global_load_lds((const unsigned*)((const char*)(gbase) + (voff)[_i]), (PG8_LAS unsigned*)(lds + (bufoff) + ldsw + _i * 8192), 16, 0, 0); } while (0)
#define PG8_LDA(dst, b, h) do { _Pragma("unroll") for (int m = 0; m < 4; ++m) _Pragma("unroll") for (int k = 0; k < 2; ++k) dst[m][k] = *(const PG8_LAS bf16x8*)(lds + PG8_SA(b, h) + aoff + m * 2048 + k * 1024); } while (0)
#define PG8_LDB(dst, b, h) do { _Pragma("unroll") for (int n = 0; n < 2; ++n) _Pragma("unroll") for (int k = 0; k < 2; ++k) dst[n][k] = *(const PG8_LAS bf16x8*)(lds + PG8_SB(b, h) + boff + n * 2048 + k * 1024); } while (0)
#define PG8_MMA(ai, bj, At, Bt) do { __builtin_amdgcn_s_setprio(1); _Pragma("unroll") for (int m = 0; m < 4; ++m) _Pragma("unroll") for (int n = 0; n < 2; ++n) _Pragma("unroll") for (int k = 0; k < 2; ++k) \
        acc[ai][bj][m][n] = __builtin_amdgcn_mfma_f32_16x16x32_bf16(Bt[n][k], At[m][k], acc[ai][bj][m][n], 0, 0, 0); __builtin_amdgcn_s_setprio(0); } while (0)
#define PG8_WAIT_V(n) asm volatile("s_waitcnt vmcnt(" #n ")" ::: "memory")
#define PG8_WAIT_L(n) asm volatile("s_waitcnt lgkmcnt(" #n ")" ::: "memory")
#define PG8_BAR __builtin_amdgcn_s_barrier()
#define PG8_SCHED __builtin_amdgcn_sched_barrier(0)
    Unit cur, nxt; int ui = 0;
    if (!S.next(0, cur)) return;
    f32x4 acc[2][2][4][2];
#pragma unroll
    for (int a = 0; a < 2; ++a)
#pragma unroll
        for (int b = 0; b < 2; ++b)
#pragma unroll
            for (int m = 0; m < 4; ++m)
#pragma unroll
                for (int n = 0; n < 2; ++n) acc[a][b][m][n] = (f32x4){0.f, 0.f, 0.f, 0.f};
    bf16x8 At[4][2], B0[2][2], B1[2][2];
    const char* cA = (const char*)g.A + (size_t)cur.pm * tstep; const char* cB = (const char*)g.Bt + (size_t)cur.pn * tstep;
    PG8_STAGE(PG8_SB(0, 0), cB, voffB); PG8_STAGE(PG8_SB(0, 1), cB + hstep, voffB); PG8_STAGE(PG8_SA(0, 0), cA, voffA); PG8_STAGE(PG8_SA(0, 1), cA + hstep, voffA);
    if (wr == 1) PG8_BAR;
    PG8_WAIT_V(2); PG8_BAR;
    PG8_STAGE(PG8_SB(1, 0), cB + kstep, voffB); PG8_STAGE(PG8_SA(1, 0), cA + kstep, voffA); PG8_STAGE(PG8_SB(1, 1), cB + hstep + kstep, voffB);
    PG8_WAIT_V(6); PG8_BAR;
    for (;;) {
        const bool has_next = S.next(ui + 1, nxt);
        const char* nA = has_next ? (const char*)g.A + (size_t)nxt.pm * tstep : cA; const char* nB = has_next ? (const char*)g.Bt + (size_t)nxt.pn * tstep : cB;
        const int seglen = Epi::HOOK ? 8 : nt;
        for (int t0 = 0; t0 < nt; t0 += seglen) {
        if constexpr (Epi::HOOK) { if (t0 > 0) E.hook(acc, cur, t0 >> 3, wr, wc, fr, fq); }
        for (int t = t0; t < t0 + seglen; t += 2) {
            const bool last = (t == nt - 2);
            const char* a1 = cA + (size_t)(t + 1) * kstep;
            const char* a2 = last ? nA : cA + (size_t)(t + 2) * kstep; const char* b2 = last ? nB : cB + (size_t)(t + 2) * kstep;
            const char* a3 = a2 + kstep; const char* b3 = b2 + kstep;
            PG8_LDB(B0, 0, 0); PG8_LDB(B1, 0, 1); PG8_SCHED; PG8_LDA(At, 0, 0); PG8_STAGE(PG8_SA(1, 1), a1 + hstep, voffA);
            PG8_WAIT_V(8); PG8_WAIT_L(0); PG8_BAR; PG8_MMA(0, 0, At, B0); PG8_MMA(0, 1, At, B1); PG8_BAR; PG8_SCHED;
            PG8_LDA(At, 0, 1); PG8_STAGE(PG8_SB(0, 0), b2, voffB); PG8_STAGE(PG8_SB(0, 1), b2 + hstep, voffB); PG8_STAGE(PG8_SA(0, 0), a2, voffA);
            PG8_WAIT_V(8); PG8_WAIT_L(0); PG8_BAR; PG8_MMA(1, 0, At, B0); PG8_MMA(1, 1, At, B1); PG8_BAR; PG8_SCHED;
            PG8_LDB(B0, 1, 0); PG8_LDB(B1, 1, 1); PG8_SCHED; PG8_LDA(At, 1, 0); PG8_STAGE(PG8_SA(0, 1), a2 + hstep, voffA);
            PG8_WAIT_V(8); PG8_WAIT_L(0); PG8_BAR; PG8_MMA(0, 0, At, B0); PG8_MMA(0, 1, At, B1); PG8_BAR; PG8_SCHED;
            PG8_LDA(At, 1, 1); PG8_STAGE(PG8_SB(1, 0), b3, voffB); PG8_STAGE(PG8_SB(1, 1), b3 + hstep, voffB); PG8_STAGE(PG8_SA(1, 0), a3, voffA);
            PG8_WAIT_V(8); PG8_WAIT_L(0); PG8_BAR; PG8_MMA(1, 0, At, B0); PG8_MMA(1, 1, At, B1); PG8_BAR; PG8_SCHED;
        }
        }
        if constexpr (ALIGN_EPI) { if (wr == 0) PG8_BAR; }
        E(acc, cur, wr, wc, fr, fq);
        if (!has_next) break;
#pragma unroll
        for (int a = 0; a < 2; ++a)
#pragma unroll
            for (int b = 0; b < 2; ++b)
#pragma unroll
                for (int m = 0; m < 4; ++m)
#pragma unroll
                    for (int n = 0; n < 2; ++n) acc[a][b][m][n] = (f32x4){0.f, 0.f, 0.f, 0.f};
        cur = nxt; cA = nA; cB = nB; ++ui;
        if constexpr (ALIGN_EPI) { if (wr == 1) PG8_BAR; }
    }
    PG8_WAIT_V(0);
    if constexpr (!ALIGN_EPI) { if (wr == 0) PG8_BAR; }
    PG8_BAR;
#undef PG8_SA
#undef PG8_SB
#undef PG8_STAGE
#undef PG8_LDA
#undef PG8_LDB
#undef PG8_MMA
#undef PG8_WAIT_V
#undef PG8_WAIT_L
#undef PG8_BAR
#undef PG8_SCHED
}
}
constexpr int NWAVES = 8, NT = NWAVES * 64;
constexpr int M = 8192, D = 2048, SEQ = 2048, NBATCH = 4, DEPTH = 2;
constexpr int INW = 13316, NPROJ = 13312, MIXW = 512, HD = 128;
constexpr int PEER_E = 16384;
constexpr float EPS = 1e-6f;
constexpr float ATT_SCALE = 0.08838834764831845f;

constexpr size_t MiB = 1u << 20;
constexpr size_t WS_CTL = 0, CTL_ZERO_BYTES = 1 * MiB;
constexpr size_t WS_SSQ = 0;
constexpr size_t WS_SSA = 256 * 1024;
constexpr size_t WS_WF = 1 * MiB;
constexpr size_t WS_BINR = WS_WF + 64 * 1024;
constexpr size_t WS_LOGF = 2 * MiB;
constexpr size_t WS_CUM = 3 * MiB;
constexpr size_t WS_WIN = 8 * MiB;
constexpr size_t WIN_BYTES = (size_t)NPROJ * D * 2;
constexpr size_t WS_WBR = 112 * MiB, WS_WOUT = 128 * MiB, WS_WQ = 144 * MiB;
constexpr size_t SQ_BYTES = (size_t)D * D * 2;
constexpr size_t WS_PU = 160 * MiB, WS_PV = 288 * MiB;
constexpr size_t PE_BYTES = (size_t)PEER_E * D;
constexpr size_t WS_PK = 6 * MiB;
constexpr size_t WS_SU = 5 * MiB, WS_SV = 5 * MiB + 256 * 1024;
constexpr size_t WS_H = 416 * MiB;
constexpr size_t WS_HB = 480 * MiB;
constexpr size_t WS_PROJ = 512 * MiB;
constexpr size_t PROJ_T = (size_t)M * MIXW;
constexpr size_t WS_R = 592 * MiB;
constexpr size_t R_PLANE = (size_t)M * D;
constexpr size_t WS_Y = 720 * MiB;
constexpr size_t WS_MRG = 752 * MiB;
constexpr size_t WS_Q = 784 * MiB;
constexpr size_t WS_END = 816 * MiB;

constexpr int RING_BYTES = 131072;
constexpr int LDS_BYTES = 147456;

typedef unsigned short bf16;
typedef unsigned v4u __attribute__((ext_vector_type(4)));
typedef unsigned v2u __attribute__((ext_vector_type(2)));
typedef float f32x4 __attribute__((ext_vector_type(4)));
typedef float f32x2 __attribute__((ext_vector_type(2)));
using bf16x2 = __attribute__((ext_vector_type(2))) __bf16;
#define LAS __attribute__((address_space(3)))

__device__ __forceinline__ unsigned f2bf(float f) { unsigned u = __builtin_bit_cast(unsigned, f); return (u + 0x7fffu + ((u >> 16) & 1u)) >> 16; }
__device__ __forceinline__ unsigned pk2(float lo, float hi) { return f2bf(lo) | (f2bf(hi) << 16); }
__device__ __forceinline__ float bflo(unsigned w) { return __builtin_bit_cast(float, w << 16); }
__device__ __forceinline__ float bfhi(unsigned w) { return __builtin_bit_cast(float, w & 0xffff0000u); }
__device__ __forceinline__ float bf2f(bf16 b) { return __builtin_bit_cast(float, ((unsigned)b) << 16); }
__device__ __forceinline__ float shf(float v, int src) { return __builtin_bit_cast(float, __builtin_amdgcn_ds_bpermute(src << 2, __builtin_bit_cast(int, v))); }
__device__ __forceinline__ int shi(int v, int src) { return __builtin_amdgcn_ds_bpermute(src << 2, v); }
__device__ __forceinline__ float wave_sum(float v, int lane) {
#pragma unroll
    for (int o = 1; o < 64; o <<= 1) v += shf(v, lane ^ o);
    return v;
}
__device__ __forceinline__ float wave_max(float v, int lane) {
#pragma unroll
    for (int o = 1; o < 64; o <<= 1) v = fmaxf(v, shf(v, lane ^ o));
    return v;
}
__device__ __forceinline__ float ssa_to_f(unsigned long long v) { return (float)((double)v * (1.0 / 4294967296.0)); }
__device__ __forceinline__ float dot2_bf16(unsigned w, unsigned x, float acc) { return __builtin_amdgcn_fdot2_f32_bf16(__builtin_bit_cast(bf16x2, w), __builtin_bit_cast(bf16x2, x), acc, false); }

#define LANE_ID(x) asm volatile("v_mbcnt_lo_u32_b32 %0, -1, 0\n\tv_mbcnt_hi_u32_b32 %0, -1, %0" : "=v"(x))
struct Args {
    const float *x, *norm_mix, *w_in, *b_in, *pool_w, *pool_scale, *conv_w, *rel_bias, *w_branch, *w_out, *norm_ffn, *peer_wq, *peer_keys, *peer_u, *peer_v, *norm_final;
    float* out; unsigned char* ws;
};
#define GAS __attribute__((address_space(1)))
#define CAS __attribute__((address_space(4)))
struct ArgsK {
    const GAS float *x, *norm_mix, *w_in, *b_in, *pool_w, *pool_scale, *conv_w, *rel_bias, *w_branch, *w_out, *norm_ffn, *peer_wq, *peer_keys, *peer_u, *peer_v, *norm_final;
    GAS float* out; GAS unsigned char* ws;
};
__device__ __forceinline__ Args load_args(const CAS ArgsK* k, size_t zoff) {
    Args a;
    a.x = (const float*)k->x; a.norm_mix = (const float*)k->norm_mix; a.w_in = (const float*)k->w_in; a.b_in = (const float*)k->b_in; a.pool_w = (const float*)k->pool_w;
    a.pool_scale = (const float*)k->pool_scale; a.conv_w = (const float*)k->conv_w; a.rel_bias = (const float*)k->rel_bias; a.w_branch = (const float*)k->w_branch;
    a.w_out = (const float*)k->w_out; a.norm_ffn = (const float*)k->norm_ffn; a.peer_wq = (const float*)k->peer_wq; a.peer_keys = (const float*)k->peer_keys;
    a.peer_u = (const float*)k->peer_u; a.peer_v = (const float*)k->peer_v; a.norm_final = (const float*)k->norm_final; a.out = (float*)k->out; a.ws = (unsigned char*)(k->ws + zoff);
    return a;
}

using pg8::f32x4; using pg8::Unit;
struct EpiProj {
    static constexpr bool PERM = true, HOOK = false;
    bf16* P; bf16* R; const float* bias; const unsigned long long* ssq;
    __device__ __forceinline__ void operator()(f32x4 (&acc)[2][2][4][2], const Unit& u, int wr, int wc, int fr, int fq) const {
        const int row0 = u.pm * 256 + wr * 64 + fr, cl0 = wc * 32 + 8 * fq, bcol0 = u.pn * 256 + cl0;
        f32x4 bv[2][2];
#pragma unroll
        for (int bj = 0; bj < 2; ++bj)
#pragma unroll
            for (int n = 0; n < 2; ++n) bv[bj][n] = *(const f32x4*)(bias + bcol0 + bj * 128 + 4 * n);
        if (u.pn < 20) {
            bf16* base = P + (size_t)(u.pn >> 1) * PROJ_T + (u.pn & 1) * 256 + cl0;
#pragma unroll
            for (int ai = 0; ai < 2; ++ai)
#pragma unroll
                for (int m = 0; m < 4; ++m) { const int row = row0 + ai * 128 + m * 16; const float rs = rsqrtf(ssa_to_f(ssq[row]) * (1.0f / D) + EPS);
                    bf16* rowp = base + (size_t)row * MIXW;
#pragma unroll
                    for (int bj = 0; bj < 2; ++bj) { const f32x4 v0 = acc[ai][bj][m][0] * rs + bv[bj][0], v1 = acc[ai][bj][m][1] * rs + bv[bj][1];
                        pg8::u32x4 w; w.x = pg8::cvt_pk_bf16(v0[0], v0[1]); w.y = pg8::cvt_pk_bf16(v0[2], v0[3]); w.z = pg8::cvt_pk_bf16(v1[0], v1[1]); w.w = pg8::cvt_pk_bf16(v1[2], v1[3]);
                        *(pg8::u32x4*)(rowp + bj * 128) = w; } }
        } else {
            const int d0 = 64 * (u.pn - 20) + 16 * wc + 4 * fq;
#pragma unroll
            for (int ai = 0; ai < 2; ++ai)
#pragma unroll
                for (int m = 0; m < 4; ++m) { const int row = row0 + ai * 128 + m * 16; const float rs = rsqrtf(ssa_to_f(ssq[row]) * (1.0f / D) + EPS);
                    float r[4][4];
#pragma unroll
                    for (int j = 0; j < 4; ++j) { float e[4], ie[4];
#pragma unroll
                        for (int g = 0; g < 4; ++g) { const float z = acc[ai][g >> 1][m][g & 1][j] * rs + bv[g >> 1][g & 1][j];
                            e[g] = fminf(1.0f + __builtin_amdgcn_exp2f(-1.4426950408889634f * z), 1e18f); ie[g] = __builtin_amdgcn_rcpf(e[g]); }
                        r[0][j] = e[1] * ie[0]; r[1][j] = e[2] * ie[1]; r[2][j] = e[3] * ie[2]; r[3][j] = ie[3]; }
#pragma unroll
                    for (int g = 0; g < 4; ++g) { pg8::u32x2 w; w.x = pg8::cvt_pk_bf16(r[g][0], r[g][1]); w.y = pg8::cvt_pk_bf16(r[g][2], r[g][3]);
                        *(pg8::u32x2*)(R + (size_t)g * R_PLANE + (size_t)row * D + d0) = w; } }
        }
    }
};
struct EpiMerge {
    static constexpr bool PERM = true, HOOK = true;
    const bf16* R; bf16* O;
    template <int NB  >
    __device__ __forceinline__ void scale(f32x4 (&acc)[2][2][4][2], const Unit& u, int plane, int wr, int wc, int fr, int fq) const {
        const __amdgpu_buffer_rsrc_t rs = __builtin_amdgcn_make_buffer_rsrc((void*)(R + (size_t)plane * R_PLANE), 0, 0x7fffffff, 0x00020000);
        int voff = (fr * D + 8 * fq) * 2; asm volatile("" : "+v"(voff));
        const int sbase = ((u.pm * 256 + wr * 64) * D + u.pn * 256 + wc * 32) * 2;
#pragma unroll
        for (int b0 = 0; b0 < 8; b0 += NB) {
            pg8::u32x4 w[NB][2];
#pragma unroll
            for (int i = 0; i < NB; ++i)
#pragma unroll
                for (int bj = 0; bj < 2; ++bj) { const int ai = (b0 + i) >> 2, m = (b0 + i) & 3;
                    w[i][bj] = __builtin_amdgcn_raw_buffer_load_b128(rs, voff + bj * 256, sbase + (ai * 128 + m * 16) * D * 2, 0); }
#pragma unroll
            for (int i = 0; i < NB; ++i)
#pragma unroll
                for (int bj = 0; bj < 2; ++bj) { const int ai = (b0 + i) >> 2, m = (b0 + i) & 3; const pg8::u32x4 v = w[i][bj];
                    acc[ai][bj][m][0] *= (f32x4){bflo(v.x), bfhi(v.x), bflo(v.y), bfhi(v.y)};
                    acc[ai][bj][m][1] *= (f32x4){bflo(v.z), bfhi(v.z), bflo(v.w), bfhi(v.w)};
                    asm volatile("" : "+v"(acc[ai][bj][m][0]), "+v"(acc[ai][bj][m][1])); }
            asm volatile("" ::: "memory"); }
    }
    __device__ __forceinline__ void hook(f32x4 (&acc)[2][2][4][2], const Unit& u, int g, int wr, int wc, int fr, int fq) const { scale<4>(acc, u, g - 1, wr, wc, fr, fq); }
    __device__ __forceinline__ void operator()(f32x4 (&acc)[2][2][4][2], const Unit& u, int wr, int wc, int fr, int fq) const {
        scale<4>(acc, u, 3, wr, wc, fr, fq);
        const int row0 = u.pm * 256 + wr * 64 + fr, col0 = u.pn * 256 + wc * 32 + 8 * fq;
#pragma unroll
        for (int ai = 0; ai < 2; ++ai)
#pragma unroll
            for (int m = 0; m < 4; ++m) { bf16* rowp = O + (size_t)(row0 + ai * 128 + m * 16) * D + col0;
#pragma unroll
                for (int bj = 0; bj < 2; ++bj) { const f32x4 v0 = acc[ai][bj][m][0], v1 = acc[ai][bj][m][1];
                    pg8::u32x4 w; w.x = pg8::cvt_pk_bf16(v0[0], v0[1]); w.y = pg8::cvt_pk_bf16(v0[2], v0[3]); w.z = pg8::cvt_pk_bf16(v1[0], v1[1]); w.w = pg8::cvt_pk_bf16(v1[2], v1[3]);
                    *(pg8::u32x4*)(rowp + bj * 128) = w; } }
    }
};
struct EpiRes {
    static constexpr bool PERM = false, HOOK = false;
    float* H; bf16* HB; unsigned long long* ssa;
    __device__ __forceinline__ void operator()(f32x4 (&acc)[2][2][4][2], const Unit& u, int wr, int wc, int fr, int fq) const {
        const int row0 = u.pm * 256 + wr * 64 + fr, col0 = u.pn * 256 + wc * 32 + 4 * fq;
#pragma unroll
        for (int ai = 0; ai < 2; ++ai)
#pragma unroll
            for (int m = 0; m < 4; ++m) { const int row = row0 + ai * 128 + m * 16; const size_t off = (size_t)row * D + col0; float s = 0.f;
#pragma unroll
                for (int bj = 0; bj < 2; ++bj)
#pragma unroll
                    for (int n = 0; n < 2; ++n) { const size_t o = off + bj * 128 + n * 16; const f32x4 h = *(const f32x4*)(H + o) + acc[ai][bj][m][n];
                        *(f32x4*)(H + o) = h; pg8::u32x2 w; w.x = pg8::cvt_pk_bf16(h[0], h[1]); w.y = pg8::cvt_pk_bf16(h[2], h[3]); *(pg8::u32x2*)(HB + o) = w;
                        s += (h[0] * h[0] + h[1] * h[1]) + (h[2] * h[2] + h[3] * h[3]); }
                { const int ln = fq * 16 + fr; s += shf(s, ln ^ 16); s += shf(s, ln ^ 32); }
                if (fq == 0) atomicAdd(ssa + row, (unsigned long long)((double)s * 4294967296.0)); }
    }
};
struct EpiQ {
    static constexpr bool PERM = true, HOOK = false;
    bf16* O; const unsigned long long* ssa;
    __device__ __forceinline__ void operator()(f32x4 (&acc)[2][2][4][2], const Unit& u, int wr, int wc, int fr, int fq) const {
        const int row0 = u.pm * 256 + wr * 64 + fr, col0 = u.pn * 256 + wc * 32 + 8 * fq;
#pragma unroll
        for (int ai = 0; ai < 2; ++ai)
#pragma unroll
            for (int m = 0; m < 4; ++m) { const int row = row0 + ai * 128 + m * 16; const float rs = rsqrtf(ssa_to_f(ssa[row]) * (1.0f / D) + EPS);
                bf16* rowp = O + (size_t)row * D + col0;
#pragma unroll
                for (int bj = 0; bj < 2; ++bj) { const f32x4 v0 = acc[ai][bj][m][0] * rs, v1 = acc[ai][bj][m][1] * rs;
                    pg8::u32x4 w; w.x = pg8::cvt_pk_bf16(v0[0], v0[1]); w.y = pg8::cvt_pk_bf16(v0[2], v0[3]); w.z = pg8::cvt_pk_bf16(v1[0], v1[1]); w.w = pg8::cvt_pk_bf16(v1[2], v1[3]);
                    *(pg8::u32x4*)(rowp + bj * 128) = w; } }
    }
};

__device__ __forceinline__ int colmap_in(int j) {
    if (j < 1536) return j;
    if (j < 5120) return j + 4;
    const int c = (j - 5120) & 255, T = (j - 5120) >> 8;
    const int g = 2 * (c >> 7) + ((c >> 2) & 1), d = 64 * T + 16 * ((c >> 5) & 3) + 4 * ((c >> 3) & 3) + (c & 3);
    return 5124 + g * 2048 + d;
}
template <bool MAP>
__device__ __forceinline__ void tr_item(const float* W, int ldw, const float* scale, bf16* WT, int ldt, int dcol0, LAS float* scr, int k0, int n0, int lane) {
    const int q = lane & 7, r8 = lane >> 3, sc = MAP ? colmap_in(n0 + 4 * q) : (n0 + 4 * q);
    f32x4 v[8];
#pragma unroll
    for (int i = 0; i < 8; ++i) v[i] = *(const f32x4*)(W + (size_t)(k0 + 8 * i + r8) * ldw + sc);
    f32x4 s0 = {1.f, 1.f, 1.f, 1.f}, s1 = s0;
    if (scale) { s0 = *(const f32x4*)(scale + k0 + 8 * q); s1 = *(const f32x4*)(scale + k0 + 8 * q + 4); }
#pragma unroll
    for (int i = 0; i < 8; ++i)
#pragma unroll
        for (int e = 0; e < 4; ++e) scr[(8 * i + r8) * 33 + 4 * q + e] = v[i][e];
    asm volatile("s_waitcnt lgkmcnt(0)" ::: "memory");
    const int c = q;
#pragma unroll
    for (int j = 0; j < 4; ++j) { const int n = r8 + 8 * j; const LAS float* s = scr + (8 * c) * 33 + n;
        v4u o; o.x = pk2(s[0 * 33] * s0[0], s[1 * 33] * s0[1]); o.y = pk2(s[2 * 33] * s0[2], s[3 * 33] * s0[3]); o.z = pk2(s[4 * 33] * s1[0], s[5 * 33] * s1[1]); o.w = pk2(s[6 * 33] * s1[2], s[7 * 33] * s1[3]);
        *(v4u*)(WT + (size_t)(n0 + n) * ldt + dcol0 + k0 + 8 * c) = o; }
    asm volatile("s_waitcnt lgkmcnt(0)" ::: "memory");
}
constexpr size_t WS_BAR = 512 * 1024;
#define XB_TMO      128
#define XB_XCNT(j)  (256  + 64 * (j))
#define XB_XSUB(j)  (1280 + 64 * (j))
#define XB_XGEN(j)  (2304 + 64 * (j))
#define XB_TOP      3328
#define XB_TOPGEN   3392
#define XCD_BAR_WORDS 3456
#define XB_SPIN_CAP (1u << 23)
__device__ __forceinline__ unsigned xb_ld(unsigned* p)              { return __hip_atomic_load(p, __ATOMIC_RELAXED, __HIP_MEMORY_SCOPE_AGENT); }
__device__ __forceinline__ unsigned xb_add(unsigned* p, unsigned v) { return __hip_atomic_fetch_add(p, v, __ATOMIC_RELAXED, __HIP_MEMORY_SCOPE_AGENT); }
__device__ __forceinline__ unsigned xb_xcc_id() { return (unsigned)__builtin_amdgcn_s_getreg((3 << 11) | 20) & 0xFu; }
#define XB_SPIN(cond, bar) do { unsigned _sp = 0; while (cond) { __builtin_amdgcn_s_sleep(1); \
    if ((++_sp & 255u) == 0u) { if (xb_ld(&(bar)[XB_TMO])) break; if (_sp > XB_SPIN_CAP) { atomicAdd(&(bar)[XB_TMO], 1u); break; } } } } while (0)
__device__ __forceinline__ void xcd_barrier_complete(unsigned* bar, unsigned x, unsigned G, unsigned& nloc, unsigned& nx) {
    unsigned sum, cnt, mine, sp = 0u;
    for (;;) {
        sum = 0u; cnt = 0u; mine = 0u;
#pragma unroll
        for (unsigned j = 0; j < 16; ++j) { const unsigned c = xb_ld(&bar[XB_XCNT(j)]); sum += c; cnt += (c > 0u) ? 1u : 0u; mine = (j == x) ? c : mine; }
        if (sum == G) break;
        __builtin_amdgcn_s_sleep(1);
        if ((++sp & 255u) == 0u) { if (xb_ld(&bar[XB_TMO])) break; if (sp > XB_SPIN_CAP) { atomicAdd(&bar[XB_TMO], 1u); break; } }
    }
    nloc = mine > 0u ? mine : 1u; nx = cnt > 0u ? cnt : 1u;
}
__device__ __forceinline__ void xcd_barrier(unsigned* bar, unsigned x, unsigned G, volatile LAS unsigned* st, int wave) {
    asm volatile("s_waitcnt vmcnt(0)" ::: "memory");
    __syncthreads();
    int lane; asm volatile("v_mbcnt_lo_u32_b32 %0, -1, 0\n\tv_mbcnt_hi_u32_b32 %0, -1, %0" : "=v"(lane));
    if (wave == 0 && lane == 0) {
        __builtin_amdgcn_s_waitcnt(0);
        unsigned nloc = st[0], nx = st[1];
        if (nloc == 0u) { xcd_barrier_complete(bar, x, G, nloc, nx); st[0] = nloc; st[1] = nx; }
        const unsigned old = xb_add(&bar[XB_XSUB(x)], 1u);
        const unsigned gen = old / nloc;
        if (old + 1u == (gen + 1u) * nloc) {
            __builtin_amdgcn_fence(__ATOMIC_RELEASE, "agent");
            asm volatile("s_waitcnt vmcnt(0)" ::: "memory");
            const unsigned og = xb_add(&bar[XB_TOP], 1u);
            const unsigned tg = og / nx;
            if (og + 1u == (tg + 1u) * nx) xb_add(&bar[XB_TOPGEN], 1u);
            else XB_SPIN(xb_ld(&bar[XB_TOPGEN]) == tg, bar);
            __builtin_amdgcn_fence(__ATOMIC_ACQUIRE, "agent");
            xb_add(&bar[XB_XGEN(x)], 1u);
            asm volatile("s_waitcnt vmcnt(0)" ::: "memory");
        } else {
            XB_SPIN(xb_ld(&bar[XB_XGEN(x)]) == gen, bar);
            __builtin_amdgcn_fence(__ATOMIC_ACQUIRE, "agent");
            asm volatile("s_waitcnt vmcnt(0)" ::: "memory");
        }
    }
    __syncthreads();
}
namespace att {
constexpr int D = 128, NW = 8, QBLK = 32, KVBLK = 64, QB = NW * QBLK;
constexpr int PITCH = 512, OPITCH = 2048;
constexpr float SCALE = 0.08838834764831845f, THR = 8.f;
constexpr int SHM_V = KVBLK * D * 2, SHM_K = KVBLK * D * 2;
constexpr int OFF_WS = 2 * SHM_V + 2 * SHM_K, OFF_CUM = OFF_WS + NW * 64 * 4, OFF_REL = OFF_CUM + 2048 * 4, LDS_END = OFF_REL + 320 * 4;
typedef unsigned short bf16;
typedef short bf16x8 __attribute__((ext_vector_type(8)));
typedef short s16x4 __attribute__((ext_vector_type(4)));
typedef float f32x16 __attribute__((ext_vector_type(16)));
typedef float f32x4 __attribute__((ext_vector_type(4)));
typedef unsigned u32x4 __attribute__((ext_vector_type(4)));
#define ALDS __attribute__((address_space(3)))

#define KSWZ(row, colB) ((row) * 256 + ((colB) ^ (((row) & 7) << 4)))
#define SBAR() __builtin_amdgcn_sched_barrier(0)
__device__ __forceinline__ int v_st(int k, int c) { const int kk = (k & ~0xC) | ((k & 4) << 1) | ((k & 8) >> 1); return ((kk >> 3) * 4 + (c >> 5)) * 512 + ((kk & 7) * 32 + (c & 31)) * 2; }
__device__ __forceinline__ int v_rd_base(int lane) { return ((lane & 3) << 3) | (((lane >> 2) & 3) << 6) | (((lane >> 4) & 1) << 5) | (((lane >> 5) & 1) << 8); }
constexpr int v_rd_off(int d0, int ks, int half) { return d0 * 512 + ks * 4096 + half * 2048; }
__device__ __forceinline__ int crow(int r, int hi) { return (r & 3) + 8 * (r >> 2) + 4 * hi; }
__device__ __forceinline__ unsigned cvtpk(float lo, float hi) { unsigned r; asm volatile("v_cvt_pk_bf16_f32 %0, %1, %2" : "=v"(r) : "v"(lo), "v"(hi)); return r; }
__device__ __forceinline__ bf16x8 load8(const bf16* p) { return *reinterpret_cast<const bf16x8*>(p); }

__device__ __forceinline__ void mask_tile(f32x16& p0, f32x16& p1, int dq) {
    const float NEG = -__builtin_inff();
#pragma unroll
    for (int r = 0; r < 16; ++r) { const int c = (r & 3) + 8 * (r >> 2);
        if (dq - c < 0) p0[r] = NEG;
        if (dq - c - 32 < 0) p1[r] = NEG; }
}
__device__ __forceinline__ void partialSM(f32x16& p0, f32x16& p1, float& m_reg, float& mn, float& alpha) {
    float pmax = p0[0];
#pragma unroll
    for (int r = 1; r < 16; ++r) pmax = fmaxf(pmax, p0[r]);
#pragma unroll
    for (int r = 0; r < 16; ++r) pmax = fmaxf(pmax, p1[r]);
    { auto rr = __builtin_amdgcn_permlane32_swap(__float_as_uint(pmax), __float_as_uint(pmax), false, false);
      pmax = fmaxf(__uint_as_float(rr[0]), __uint_as_float(rr[1])); }
    constexpr float C2 = 1.4426950408889634f * SCALE;
    if (__builtin_expect(__all((pmax - m_reg) * SCALE <= THR), 1)) { mn = m_reg; alpha = 1.f; }
    else { mn = fmaxf(m_reg, pmax); alpha = __builtin_amdgcn_exp2f((m_reg - mn) * C2); m_reg = mn; }
    const float mnL = -mn * C2;
#pragma unroll
    for (int r = 0; r < 16; ++r) p0[r] = fmaf(p0[r], C2, mnL);
#pragma unroll
    for (int r = 0; r < 16; ++r) p1[r] = fmaf(p1[r], C2, mnL);
#pragma unroll
    for (int r = 0; r < 16; ++r) p0[r] = __builtin_amdgcn_exp2f(p0[r]);
}
__device__ __forceinline__ void finishSM(f32x16& p0, f32x16& p1, float alpha, float& l_reg, bf16x8& pa0, bf16x8& pa1, bf16x8& pa2, bf16x8& pa3) {
#pragma unroll
    for (int r = 0; r < 16; ++r) p1[r] = __builtin_amdgcn_exp2f(p1[r]);
    float ps = 0;
#pragma unroll
    for (int r = 0; r < 16; ++r) ps += p0[r];
#pragma unroll
    for (int r = 0; r < 16; ++r) ps += p1[r];
    { auto rr = __builtin_amdgcn_permlane32_swap(__float_as_uint(ps), __float_as_uint(ps), false, false);
      ps = __uint_as_float(rr[0]) + __uint_as_float(rr[1]); }
    l_reg = l_reg * alpha + ps;
#define PK4(P, B_, OUT) do { unsigned a0 = cvtpk(P[B_+0], P[B_+1]), a1 = cvtpk(P[B_+2], P[B_+3]);                          \
        unsigned b0 = cvtpk(P[B_+4], P[B_+5]), b1 = cvtpk(P[B_+6], P[B_+7]);                                             \
        auto r0 = __builtin_amdgcn_permlane32_swap(a0, b0, false, false); auto r1 = __builtin_amdgcn_permlane32_swap(a1, b1, false, false); \
        u32x4 w = {r0[0], r1[0], r0[1], r1[1]}; OUT = *reinterpret_cast<bf16x8*>(&w); } while (0)
    PK4(p0, 0, pa0); PK4(p0, 8, pa1); PK4(p1, 0, pa2); PK4(p1, 8, pa3);
#undef PK4
}
template <int KB>
__device__ __forceinline__ void qkt(f32x16& p0, f32x16& p1, const ALDS char* K_lds, int r32, int hi, const bf16x8* qr, bool act) {
    if (!act) { const float NEG = -__builtin_inff();
#pragma unroll
        for (int r = 0; r < 16; ++r) { p0[r] = NEG; p1[r] = NEG; } return; }
    p0 = f32x16{}; p1 = f32x16{};
    const ALDS char* kb[4];
#pragma unroll
    for (int dd = 0; dd < 4; ++dd) kb[dd] = K_lds + KB * SHM_K + KSWZ(r32, (dd * 16 + hi * 8) * 2);
#pragma unroll
    for (int d0 = 0; d0 < 8; ++d0) { const ALDS char* a = kb[d0 & 3] + (d0 >> 2) * 128;
        bf16x8 b0 = *(const ALDS bf16x8*)(a);
        bf16x8 b1 = *(const ALDS bf16x8*)(a + 32 * 256);
        p0 = __builtin_amdgcn_mfma_f32_32x32x16_bf16(b0, qr[d0], p0, 0, 0, 0);
        p1 = __builtin_amdgcn_mfma_f32_32x32x16_bf16(b1, qr[d0], p1, 0, 0, 0); }
}
template <int VB>
__device__ __forceinline__ void pv_tile(f32x16* o, int vb0, bf16x8 pa0, bf16x8 pa1, bf16x8 pa2, bf16x8 pa3, bool act) {
    if (!act) return;
#define TRRD(dst, off) asm volatile("ds_read_b64_tr_b16 %0, %1 offset:%2" : "=&v"(dst) : "v"(vb0), "i"(off) : "memory")
#define PV_D0(d0) do { s16x4 l0, l1, l2, l3, h0, h1, h2, h3; constexpr int b_ = VB * SHM_V + v_rd_off(d0, 0, 0); \
        TRRD(l0, b_); TRRD(h0, b_ + 2048); TRRD(l1, b_ + 4096); TRRD(h1, b_ + 6144); TRRD(l2, b_ + 8192); TRRD(h2, b_ + 10240); TRRD(l3, b_ + 12288); TRRD(h3, b_ + 14336); \
        asm volatile("s_waitcnt lgkmcnt(0)" ::: "memory"); SBAR(); \
        o[d0] = __builtin_amdgcn_mfma_f32_32x32x16_bf16(pa0, (bf16x8){l0[0], l0[1], l0[2], l0[3], h0[0], h0[1], h0[2], h0[3]}, o[d0], 0, 0, 0);   \
        o[d0] = __builtin_amdgcn_mfma_f32_32x32x16_bf16(pa1, (bf16x8){l1[0], l1[1], l1[2], l1[3], h1[0], h1[1], h1[2], h1[3]}, o[d0], 0, 0, 0);   \
        o[d0] = __builtin_amdgcn_mfma_f32_32x32x16_bf16(pa2, (bf16x8){l2[0], l2[1], l2[2], l2[3], h2[0], h2[1], h2[2], h2[3]}, o[d0], 0, 0, 0);   \
        o[d0] = __builtin_amdgcn_mfma_f32_32x32x16_bf16(pa3, (bf16x8){l3[0], l3[1], l3[2], l3[3], h3[0], h3[1], h3[2], h3[3]}, o[d0], 0, 0, 0); } while (0)
    PV_D0(0); PV_D0(1); PV_D0(2); PV_D0(3);
#undef PV_D0
#undef TRRD
}
template <int MODE>
__device__ __forceinline__ void bias_mask(f32x16& p0, f32x16& p1, const ALDS char* lds, int kb, int qlo, int qpos, int hi, float cqs, bool act) {
    if (!act) return;
    if (MODE == 0) {
        const ALDS float* cs = (const ALDS float*)(lds + OFF_CUM) + kb + 4 * hi;
#pragma unroll
        for (int g = 0; g < 4; ++g) { const f32x4 c0 = *(const ALDS f32x4*)(cs + 8 * g), c1 = *(const ALDS f32x4*)(cs + 32 + 8 * g);
#pragma unroll
            for (int e = 0; e < 4; ++e) { p0[4 * g + e] += cqs - c0[e]; p1[4 * g + e] += cqs - c1[e]; } }
        if (kb + KVBLK - 1 > qlo) mask_tile(p0, p1, qpos - 4 * hi - kb);
    } else {
        const ALDS float* tb = (const ALDS float*)(lds + OFF_REL);
        if (qlo - (kb + KVBLK - 1) >= 256) { const float c = tb[319];
#pragma unroll
            for (int r = 0; r < 16; ++r) { p0[r] += c; p1[r] += c; } }
        else { const int d0 = qpos - kb - 4 * hi + 63;
#pragma unroll
            for (int r = 0; r < 16; ++r) { const int c = (r & 3) + 8 * (r >> 2);
                int i0 = d0 - c, i1 = d0 - c - 32; i0 = i0 > 319 ? 319 : i0; i1 = i1 > 319 ? 319 : i1; i1 = i1 < 0 ? 0 : i1; i0 = i0 < 0 ? 0 : i0;
                p0[r] += tb[i0]; p1[r] += tb[i1]; } }
    }
}

struct Seam { bf16x8 qr[8]; bf16x8 st_v0, st_v1, st_k0, st_k1; };
#define VMW() asm volatile("s_waitcnt vmcnt(0)" ::: "memory")
#define BL8(rs, vo, so) __builtin_bit_cast(bf16x8, __builtin_amdgcn_raw_buffer_load_b128(rs, vo, so, 0))
#define SLOAD_H(Kp, Vp, k0) do { S.st_v0 = BL8(rP, kvoff, (Vp) + (k0) * (PITCH * 2)); S.st_v1 = BL8(rP, kvoff, (Vp) + ((k0) + 32) * (PITCH * 2));              \
                         S.st_k0 = BL8(rP, kvoff, (Kp) + (k0) * (PITCH * 2)); S.st_k1 = BL8(rP, kvoff, (Kp) + ((k0) + 32) * (PITCH * 2)); } while (0)
#define SWRITE_HK(bf) do { *(ALDS bf16x8*)(K_lds + (bf) * SHM_K + kws) = S.st_k0; *(ALDS bf16x8*)(K_lds + (bf) * SHM_K + kws + 32 * 256) = S.st_k1; } while (0)
#define SWRITE_HV(bf) do { *(ALDS bf16x8*)(V_lds + (bf) * SHM_V + vst0) = S.st_v0; *(ALDS bf16x8*)(V_lds + (bf) * SHM_V + vst1) = S.st_v1; } while (0)
#define SWRITE_H(bf) do { SWRITE_HV(bf); SWRITE_HK(bf); } while (0)

template <int MODE>
__device__ __forceinline__ void attn_unit(const bf16* Pb, int Qo, int Kh, int Vh, bf16* Yb, int Oo, int P0, int j_lo, int j_hi, ALDS char* lds, int wid, int lane) {
    const int tid = wid * 64 + lane, r32 = lane & 31, hi = lane >> 5;
    const int NT = j_hi - j_lo;
    const int qlo = P0 + wid * QBLK, qpos = qlo + r32;
    ALDS char* V_lds = lds; ALDS char* K_lds = lds + 2 * SHM_V;
    ALDS float* ws = (ALDS float*)(lds + OFF_WS) + wid * 64; ALDS float* li_l = ws; ALDS float* al_l = ws + 32;
    float m_reg = -1e30f, l_reg = 0; f32x16 o[4] = {};
    const int sr = tid >> 4, sc = (tid & 15) * 8, vst0 = v_st(sr, sc), vst1 = v_st(32 + sr, sc), kws = KSWZ(sr, sc * 2);
    const int vb0 = (int)(unsigned)(size_t)V_lds + v_rd_base(lane);
    Seam S;
    const __amdgpu_buffer_rsrc_t rP = __builtin_amdgcn_make_buffer_rsrc((void*)Pb, 0, 0x7fffffff, 0x00020000);
    const __amdgpu_buffer_rsrc_t rO = __builtin_amdgcn_make_buffer_rsrc((void*)Yb, 0, 0x7fffffff, 0x00020000);
    const int kvoff = (sr * PITCH + sc) * 2;
#define KBASE(t) ((j_lo + (t)) * KVBLK)
#define ACT(t) (MODE == 0 ? (KBASE(t) <= qlo + QBLK - 1) : ((j_lo + (t)) <= (qlo >> 6) && (j_lo + (t)) + 8 >= (qlo >> 6)))
#define RESC(a) do { if (__any((a) < 1.f)) { if (hi == 0) al_l[r32] = (a); asm volatile("s_waitcnt lgkmcnt(0)" ::: "memory");              \
                     for (int d_ = 0; d_ < 4; ++d_) for (int r = 0; r < 16; ++r) o[d_][r] *= al_l[crow(r, hi)]; } } while (0)
#define MASKT(P0_, P1_, t) bias_mask<MODE>(P0_, P1_, lds, KBASE(t), qlo, qpos, hi, cq_, ACT(t))
    {
        const int kb0 = j_lo * KVBLK;
#pragma unroll
        for (int d0 = 0; d0 < 8; ++d0) S.qr[d0] = BL8(rP, (r32 * PITCH + hi * 8) * 2 + d0 * 32, Qo + wid * (QBLK * PITCH * 2));
        SLOAD_H(Kh, Vh, kb0); VMW(); SWRITE_HK(0);
        __syncthreads();
    }
    const float cq_ = MODE == 0 ? ((const ALDS float*)(lds + OFF_CUM))[qpos] : 0.f;
    f32x16 pA0, pA1, pB0, pB1; float mnA, mnB, alA, alB; bf16x8 pa0, pa1, pa2, pa3;
    SWRITE_HV(0); SBAR();
    if (NT > 1) { SLOAD_H(Kh, Vh, KBASE(1)); }
    SBAR(); qkt<0>(pA0, pA1, K_lds, r32, hi, S.qr, ACT(0));
    MASKT(pA0, pA1, 0); partialSM(pA0, pA1, m_reg, mnA, alA);
    if (NT > 1) { VMW(); SWRITE_H(1); }
    __syncthreads();
#define HALF_STEP(PX0, PX1, mnX, alX, PY0, PY1, alY, t, KB, VB, SB) do {                                                      \
        SBAR(); qkt<KB>(PX0, PX1, K_lds, r32, hi, S.qr, ACT(t));                                                              \
        finishSM(PY0, PY1, alY, l_reg, pa0, pa1, pa2, pa3); SBAR();                                                           \
        if ((t) + 1 < NT) { SLOAD_H(Kh, Vh, KBASE((t) + 1)); SBAR(); }                                                        \
        pv_tile<VB>(o, vb0, pa0, pa1, pa2, pa3, ACT((t) - 1)); MASKT(PX0, PX1, (t)); partialSM(PX0, PX1, m_reg, mnX, alX);    \
        __syncthreads();                                                                                                      \
        if ((t) + 1 < NT) { VMW(); SWRITE_H(SB); }                                                                            \
        RESC(alX); __syncthreads(); } while (0)
    for (int t = 1; t + 1 < NT; t += 2) {
        HALF_STEP(pB0, pB1, mnB, alB, pA0, pA1, alA, t, 1, 0, 0);
        HALF_STEP(pA0, pA1, mnA, alA, pB0, pB1, alB, t + 1, 0, 1, 1);
    }
    const bool even = (NT & 1) == 0;
    if (even) { SBAR(); qkt<1>(pB0, pB1, K_lds, r32, hi, S.qr, ACT(NT - 1)); SBAR(); }
    finishSM(pA0, pA1, alA, l_reg, pa0, pa1, pa2, pa3); SBAR();
    pv_tile<0>(o, vb0, pa0, pa1, pa2, pa3, ACT(even ? NT - 2 : NT - 1));
    if (even) { MASKT(pB0, pB1, NT - 1); partialSM(pB0, pB1, m_reg, mnB, alB); __syncthreads(); RESC(alB);
        finishSM(pB0, pB1, alB, l_reg, pa0, pa1, pa2, pa3); SBAR(); pv_tile<1>(o, vb0, pa0, pa1, pa2, pa3, ACT(NT - 1)); }
    SBAR();
    if (hi == 0) li_l[r32] = l_reg; asm volatile("s_waitcnt lgkmcnt(0)" ::: "memory");
    float rli[16];
#pragma unroll
    for (int r = 0; r < 16; ++r) rli[r] = __builtin_amdgcn_rcpf(li_l[crow(r, hi)]);
    const int ovoff = (4 * hi * OPITCH + r32) * 2, osoff = Oo + wid * (QBLK * OPITCH * 2);
#pragma unroll
    for (int r = 0; r < 16; ++r) { const int orow = (r & 3) + 8 * (r >> 2);
#pragma unroll
        for (int d0 = 0; d0 < 4; ++d0) { const float v = o[d0][r] * rli[r];
            const float vn = __builtin_bit_cast(float, __builtin_amdgcn_ds_bpermute((lane ^ 1) << 2, __builtin_bit_cast(int, v)));
            if ((r32 & 1) == 0) __builtin_amdgcn_raw_buffer_store_b32(cvtpk(v, vn), rO, ovoff + d0 * 64, osoff + orow * (OPITCH * 2), 0); } }
    __syncthreads();
#undef RESC
#undef KBASE
#undef ACT
#undef MASKT
#undef HALF_STEP
}
#undef BL8
#undef VMW
#undef SLOAD_H
#undef SWRITE_HK
#undef SWRITE_HV
#undef SWRITE_H
#undef KSWZ
#undef SBAR
}
constexpr size_t WS_QCTR = 768 * 1024;
constexpr size_t WS_POOLW = 4 * MiB;
constexpr int N_ATT_UNITS = 256, N_POOL_UNITS = 512, N_CONV_UNITS = 128;

__device__ __forceinline__ void stage_cum(const Args& a, int b, int h, LAS char* lds, int wave, int lane) {
    const float* logf = (const float*)(a.ws + WS_LOGF) + ((size_t)b * SEQ) * 4 + h;
    const int tid = wave * 64 + lane;
    float v[4];
#pragma unroll
    for (int e = 0; e < 4; ++e) v[e] = logf[(size_t)(4 * tid + e) * 4];
    v[1] += v[0]; v[2] += v[1]; v[3] += v[2];
    float incl = v[3];
#pragma unroll
    for (int o = 1; o < 64; o <<= 1) { const float t = shf(incl, lane >= o ? lane - o : lane); if (lane >= o) incl += t; }
    LAS float* wt = (LAS float*)(lds + att::OFF_WS);
    if (lane == 63) wt[wave] = incl;
    __syncthreads();
    float base = incl - v[3];
    for (int w = 0; w < wave; ++w) base += wt[w];
    LAS float* cs = (LAS float*)(lds + att::OFF_CUM);
    const float inv = 1.0f / ATT_SCALE;
    *(LAS f32x4*)(cs + 4 * tid) = (f32x4){(base + v[0]) * inv, (base + v[1]) * inv, (base + v[2]) * inv, (base + v[3]) * inv};
    __syncthreads();
}
__device__ __forceinline__ void attention_item(const Args& a, int l, int u, LAS char* lds, int wave) {
    int lane; asm volatile("v_mbcnt_lo_u32_b32 %0, -1, 0\n\tv_mbcnt_hi_u32_b32 %0, -1, %0" : "=v"(lane));
    const bf16* P = (const bf16*)(a.ws + WS_PROJ); bf16* Y = (bf16*)(a.ws + WS_Y);
    const int mode = u >> 7, v = u & 127, qb = 7 - (v >> 4), bh = v & 15, b = bh >> 2, h = bh & 3;
    const size_t row0 = (size_t)b * SEQ; const int P0 = qb * 256;
    if (mode == 0) {
        stage_cum(a, b, h, lds, wave, lane);
        att::attn_unit<0>(P, (int)((0 * PROJ_T + (row0 + P0) * MIXW + h * HD) * 2), (int)((1 * PROJ_T + row0 * MIXW + h * HD) * 2), (int)((2 * PROJ_T + row0 * MIXW + h * HD) * 2),
                          Y, (int)(((row0 + P0) * D + h * HD) * 2), P0, 0, 4 * qb + 4, lds, wave, lane);
    } else {
        const int tid = wave * 64 + lane;
        if (tid < 320) ((LAS float*)(lds + att::OFF_REL))[tid] = a.rel_bias[((size_t)l * 4 + h) * 320 + tid] * (1.0f / ATT_SCALE);
        const int jlo = 4 * qb - 8 < 0 ? 0 : 4 * qb - 8;
        att::attn_unit<1>(P, (int)((7 * PROJ_T + (row0 + P0) * MIXW + h * HD) * 2), (int)((8 * PROJ_T + row0 * MIXW + h * HD) * 2), (int)((9 * PROJ_T + row0 * MIXW + h * HD) * 2),
                          Y, (int)(((row0 + P0) * D + 1536 + h * HD) * 2), P0, jlo, 4 * qb + 4, lds, wave, lane);
    }
}
__device__ __forceinline__ void pool_item(const Args& a, int l, int u, LAS char* lds, int wave) {
    int lane; asm volatile("v_mbcnt_lo_u32_b32 %0, -1, 0\n\tv_mbcnt_hi_u32_b32 %0, -1, %0" : "=v"(lane));
    const int g = u & 3, T0 = (u >> 2) * 64, tid = wave * 64 + lane;
    const bf16* Pin = (const bf16*)(a.ws + WS_PROJ) + 3 * PROJ_T + g * 128;
    {
        const int cp = tid & 63, run = tid >> 6, w = 2 << g, t0 = T0 + run * 8, s0 = t0 & (SEQ - 1);
        const bf16* col = Pin + 2 * cp;
        float s_lo = 0.f, s_hi = 0.f;
        for (int j = 1; j < w; ++j) if (s0 - j >= 0) { const unsigned x = *(const unsigned*)(col + (size_t)(t0 - j) * MIXW); s_lo += bflo(x); s_hi += bfhi(x); }
#pragma unroll
        for (int i = 0; i < 8; ++i) { const unsigned x = *(const unsigned*)(col + (size_t)(t0 + i) * MIXW); s_lo += bflo(x); s_hi += bfhi(x);
            const int s = s0 + i; const int cnt = s + 1 < w ? s + 1 : w; const float inv = 1.0f / (float)cnt;
            *(LAS unsigned*)(lds + (run * 8 + i) * 272 + 4 * cp) = pk2(s_lo * inv - bflo(x), s_hi * inv - bfhi(x));
            if (s - w + 1 >= 0) { const unsigned y = *(const unsigned*)(col + (size_t)(t0 + i - w + 1) * MIXW); s_lo -= bflo(y); s_hi -= bfhi(y); } }
    }
    __syncthreads();
    {
        typedef short bf16x8 __attribute__((ext_vector_type(8)));
        const bf16* Wt = (const bf16*)(a.ws + WS_POOLW) + ((size_t)l * 4 + g) * 128 * 128;
        const int rt = (wave & 3) * 16, db = (wave >> 2) * 64, fr = lane & 15, kg = lane >> 4;
        f32x4 acc[4] = {};
#pragma unroll
        for (int ks = 0; ks < 4; ++ks) { const bf16x8 af = *(const LAS bf16x8*)(lds + (rt + fr) * 272 + (ks * 32 + kg * 8) * 2);
#pragma unroll
            for (int nt = 0; nt < 4; ++nt) { const bf16x8 bfr = *(const bf16x8*)(Wt + (size_t)(db + nt * 16 + fr) * 128 + ks * 32 + kg * 8);
                acc[nt] = __builtin_amdgcn_mfma_f32_16x16x32_bf16(bfr, af, acc[nt], 0, 0, 0); } }
        bf16* Y = (bf16*)(a.ws + WS_Y) + (size_t)(T0 + rt + fr) * D + 512 + g * 128;
#pragma unroll
        for (int nt = 0; nt < 4; ++nt) { const int d = db + nt * 16 + kg * 4; const f32x4 sc = *(const f32x4*)(a.pool_scale + l * MIXW + g * 128 + d);
            v2u w; w.x = pk2(acc[nt][0] * sc[0], acc[nt][1] * sc[1]); w.y = pk2(acc[nt][2] * sc[2], acc[nt][3] * sc[3]); *(v2u*)(Y + d) = w; }
    }
    __syncthreads();
}
__device__ __forceinline__ void conv_item(const Args& a, int l, int u, int wave) {
    int lane; asm volatile("v_mbcnt_lo_u32_b32 %0, -1, 0\n\tv_mbcnt_hi_u32_b32 %0, -1, %0" : "=v"(lane));
    const bf16* P = (const bf16*)(a.ws + WS_PROJ); const bf16* Ch = P + 4 * PROJ_T; const bf16* Cb = P + 5 * PROJ_T; const bf16* Cc = P + 6 * PROJ_T;
    const int tid = wave * 64 + lane, c0 = (tid & 63) * 8, t0 = u * 64 + (tid >> 6) * 8, s0 = t0 & (SEQ - 1);
    float wgt[3][8];
#pragma unroll
    for (int j = 0; j < 3; ++j) { const float* w = a.conv_w + ((size_t)l * 3 + j) * MIXW + c0; const f32x4 w0 = *(const f32x4*)w, w1 = *(const f32x4*)(w + 4);
#pragma unroll
        for (int k = 0; k < 4; ++k) { wgt[j][k] = w0[k]; wgt[j][4 + k] = w1[k]; } }
    float z2[8], z1[8];
#pragma unroll
    for (int k = 0; k < 8; ++k) { z2[k] = 0.f; z1[k] = 0.f; }
#pragma unroll
    for (int i = -2; i < 8; ++i) {
        float z[8];
        if (s0 + i >= 0) { const v4u hv = *(const v4u*)(Ch + (size_t)(t0 + i) * MIXW + c0), cv = *(const v4u*)(Cc + (size_t)(t0 + i) * MIXW + c0);
            z[0] = bflo(hv.x) * bflo(cv.x); z[1] = bfhi(hv.x) * bfhi(cv.x); z[2] = bflo(hv.y) * bflo(cv.y); z[3] = bfhi(hv.y) * bfhi(cv.y);
            z[4] = bflo(hv.z) * bflo(cv.z); z[5] = bfhi(hv.z) * bfhi(cv.z); z[6] = bflo(hv.w) * bflo(cv.w); z[7] = bfhi(hv.w) * bfhi(cv.w); }
        else {
#pragma unroll
            for (int k = 0; k < 8; ++k) z[k] = 0.f; }
        if (i >= 0) { const v4u bv = *(const v4u*)(Cb + (size_t)(t0 + i) * MIXW + c0); float o[8];
            const float bb[8] = {bflo(bv.x), bfhi(bv.x), bflo(bv.y), bfhi(bv.y), bflo(bv.z), bfhi(bv.z), bflo(bv.w), bfhi(bv.w)};
#pragma unroll
            for (int k = 0; k < 8; ++k) o[k] = bb[k] * (wgt[0][k] * z2[k] + wgt[1][k] * z1[k] + wgt[2][k] * z[k]);
            v4u ov; ov.x = pk2(o[0], o[1]); ov.y = pk2(o[2], o[3]); ov.z = pk2(o[4], o[5]); ov.w = pk2(o[6], o[7]);
            *(v4u*)((bf16*)(a.ws + WS_Y) + (size_t)(t0 + i) * D + 1024 + c0) = ov; }
#pragma unroll
        for (int k = 0; k < 8; ++k) { z2[k] = z1[k]; z1[k] = z[k]; }
    }
}
__device__ __forceinline__ void mixers_fast(const Args& a, int lq, LAS char* lds, int wave, int lane, int G, int blk) {
    const int l = lq & 1;
    for (int u = blk; u < N_ATT_UNITS; u += G) attention_item(a, l, u, lds, wave);
    unsigned* head = (unsigned*)(a.ws + WS_QCTR) + 64 * lq;
    volatile LAS unsigned* slot = (volatile LAS unsigned*)(lds + att::LDS_END);
    for (;;) {
        if (wave == 0 && lane == 0) *slot = __hip_atomic_fetch_add(head, 1u, __ATOMIC_RELAXED, __HIP_MEMORY_SCOPE_AGENT);
        __syncthreads();
        const unsigned it = *slot;
        __syncthreads();
        if (it >= (unsigned)(N_POOL_UNITS + N_CONV_UNITS)) break;
        if (it < (unsigned)N_POOL_UNITS) pool_item(a, l, (int)it, lds, wave); else conv_item(a, l, (int)it - N_POOL_UNITS, wave);
    }
}
__device__ __forceinline__ void p0_prologue(const Args& a, LAS unsigned char* lds, int gw, int NGW, int wave, int lane) {
    unsigned char* ws = a.ws;
    LAS float* scr = (LAS float*)(lds + wave * 16384);
    constexpr int I_WIN = (D / 64) * (NPROJ / 32), I_SQ = (D / 64) * (D / 32), I_BR = (MIXW / 64) * (D / 32);
    constexpr int I_LAYER = I_WIN + 4 * I_BR + 2 * I_SQ;
    for (int it = gw; it < DEPTH * I_LAYER; it += NGW) {
        const int l = it / I_LAYER; int r = it - l * I_LAYER;
        if (r < I_WIN) { const int kb = r / (NPROJ / 32), nb = r % (NPROJ / 32);
            tr_item<true>(a.w_in + (size_t)l * D * INW, INW, a.norm_mix + l * D, (bf16*)(ws + WS_WIN + l * WIN_BYTES), D, 0, scr, 64 * kb, 32 * nb, lane); continue; }
        r -= I_WIN;
        if (r < 4 * I_BR) { const int g = r / I_BR, rr = r % I_BR, kb = rr / (D / 32), nb = rr % (D / 32);
            tr_item<false>(a.w_branch + ((size_t)l * 4 + g) * MIXW * D, D, nullptr, (bf16*)(ws + WS_WBR + l * SQ_BYTES), D, g * MIXW, scr, 64 * kb, 32 * nb, lane); continue; }
        r -= 4 * I_BR;
        if (r < I_SQ) { const int kb = r / (D / 32), nb = r % (D / 32);
            tr_item<false>(a.w_out + (size_t)l * D * D, D, nullptr, (bf16*)(ws + WS_WOUT + l * SQ_BYTES), D, 0, scr, 64 * kb, 32 * nb, lane); continue; }
        r -= I_SQ;
        { const int kb = r / (D / 32), nb = r % (D / 32);
            tr_item<false>(a.peer_wq + (size_t)l * D * D, D, a.norm_ffn + l * D, (bf16*)(ws + WS_WQ + l * SQ_BYTES), D, 0, scr, 64 * kb, 32 * nb, lane); }
    }
    for (int it = gw; it < DEPTH * 4 * 8; it += NGW) { const int lg = it >> 3, r = it & 7;
        tr_item<false>(a.pool_w + (size_t)lg * 128 * 128, 128, nullptr, (bf16*)(ws + WS_POOLW) + (size_t)lg * 128 * 128, 128, 0, scr, 64 * (r >> 2), 32 * (r & 3), lane); }
    {
        constexpr int NR = 2 * DEPTH * PEER_E;
        f32x4 nv[8];
        if (gw < NR) { const int t = gw / (DEPTH * PEER_E), row = gw - t * (DEPTH * PEER_E); const float* src = (t ? a.peer_v : a.peer_u) + (size_t)row * D + 4 * lane;
#pragma unroll
            for (int j = 0; j < 8; ++j) nv[j] = *(const f32x4*)(src + 256 * j); }
        for (int r = gw; r < NR; r += NGW) { const int t = r / (DEPTH * PEER_E), row = r - t * (DEPTH * PEER_E);
            f32x4 v[8]; float am = 0.f;
#pragma unroll
            for (int j = 0; j < 8; ++j) v[j] = nv[j];
            { const int r2 = r + NGW; if (r2 < NR) { const int t2 = r2 / (DEPTH * PEER_E), row2 = r2 - t2 * (DEPTH * PEER_E); const float* src = (t2 ? a.peer_v : a.peer_u) + (size_t)row2 * D + 4 * lane;
#pragma unroll
                for (int j = 0; j < 8; ++j) nv[j] = *(const f32x4*)(src + 256 * j); } }
#pragma unroll
            for (int j = 0; j < 8; ++j) am = fmaxf(am, fmaxf(fmaxf(fabsf(v[j][0]), fabsf(v[j][1])), fmaxf(fabsf(v[j][2]), fabsf(v[j][3]))));
            am = wave_max(am, lane);
            const float inv = am > 0.f ? 127.0f / am : 0.f, off = 0.f;
            unsigned char* dst = ws + (t ? WS_PV : WS_PU) + (size_t)row * D + 4 * lane;
#pragma unroll
            for (int j = 0; j < 8; ++j) { const int q0 = (int)(rintf(v[j][0] * inv) + off), q1 = (int)(rintf(v[j][1] * inv) + off), q2 = (int)(rintf(v[j][2] * inv) + off), q3 = (int)(rintf(v[j][3] * inv) + off);
                *(unsigned*)(dst + 256 * j) = (unsigned)(q0 & 255) | ((unsigned)(q1 & 255) << 8) | ((unsigned)(q2 & 255) << 16) | ((unsigned)(q3 & 255) << 24); }
            if (lane == 0) ((float*)(ws + (t ? WS_SV : WS_SU)))[row] = am * (1.0f / 127.0f); }
    }
    { bf16* pk = (bf16*)(ws + WS_PK); const size_t n8 = (size_t)DEPTH * 8 * 2 * 128 * 128 / 8;
      for (size_t i = (size_t)gw * 64 + lane; i < n8; i += (size_t)NGW * 64) { const f32x4 v0 = *(const f32x4*)(a.peer_keys + i * 8), v1 = *(const f32x4*)(a.peer_keys + i * 8 + 4);
          v4u o; o.x = pk2(v0[0], v0[1]); o.y = pk2(v0[2], v0[3]); o.z = pk2(v1[0], v1[1]); o.w = pk2(v1[2], v1[3]); *(v4u*)(pk + i * 8) = o; } }
    {
        float* wf = (float*)(ws + WS_WF); float* binr = (float*)(ws + WS_BINR);
        const int gt = gw * 64 + lane, NGT = NGW * 64;
        for (int i = gt; i < DEPTH * 4 * D; i += NGT) { const int l = i / (4 * D), h = (i / D) & 3, k = i % D; wf[i] = a.w_in[(size_t)l * D * INW + (size_t)k * INW + 1536 + h] * a.norm_mix[l * D + k]; }
        for (int i = gt; i < DEPTH * NPROJ; i += NGT) { const int l = i / NPROJ, j = i % NPROJ; binr[i] = a.b_in[l * INW + colmap_in(j)]; }
    }
    {
        float* H = (float*)(ws + WS_H); bf16* HB = (bf16*)(ws + WS_HB); unsigned long long* ssq = (unsigned long long*)(ws + WS_SSQ);
        for (int m = gw; m < M; m += NGW) { float s = 0.f;
#pragma unroll
            for (int j = 0; j < 8; ++j) { const size_t o = (size_t)m * D + j * 256 + lane * 4; const f32x4 v = *(const f32x4*)(a.x + o); *(f32x4*)(H + o) = v;
                v2u w; w.x = pk2(v[0], v[1]); w.y = pk2(v[2], v[3]); *(v2u*)(HB + o) = w; s += (v[0] * v[0] + v[1] * v[1]) + (v[2] * v[2] + v[3] * v[3]); }
            s = wave_sum(s, lane); if (lane == 0) ssq[m] = (unsigned long long)((double)s * 4294967296.0); }
    }
}

__device__ __forceinline__ void forget_logits(const Args& a, int l, int gw, int NGW, int lane) {
    unsigned char* ws = a.ws; const bf16* HB = (const bf16*)(ws + WS_HB); const float* wf = (const float*)(ws + WS_WF) + l * 4 * D; const unsigned long long* ssq = (const unsigned long long*)(ws + WS_SSQ) + l * M;
    float* logf = (float*)(ws + WS_LOGF);
    for (int m = gw; m < M; m += NGW) {
        float d[4] = {0.f, 0.f, 0.f, 0.f};
#pragma unroll
        for (int j = 0; j < 4; ++j) { const int k0 = j * 512 + lane * 8; const v4u xv = *(const v4u*)(HB + (size_t)m * D + k0);
            const float x[8] = {bflo(xv.x), bfhi(xv.x), bflo(xv.y), bfhi(xv.y), bflo(xv.z), bfhi(xv.z), bflo(xv.w), bfhi(xv.w)};
#pragma unroll
            for (int h = 0; h < 4; ++h) { const f32x4 w0 = *(const f32x4*)(wf + h * D + k0), w1 = *(const f32x4*)(wf + h * D + k0 + 4);
                d[h] += x[0] * w0[0] + x[1] * w0[1] + x[2] * w0[2] + x[3] * w0[3] + x[4] * w1[0] + x[5] * w1[1] + x[6] * w1[2] + x[7] * w1[3]; } }
        const float rs = rsqrtf(ssa_to_f(ssq[m]) * (1.0f / D) + EPS);
#pragma unroll
        for (int h = 0; h < 4; ++h) { const float z = wave_sum(d[h], lane) * rs + a.b_in[l * INW + 1536 + h];
            const float ls = fminf(z, 0.f) - log1pf(__expf(-fabsf(z)));
            if (lane == h) logf[m * 4 + h] = ls; }
    }
}
__device__ __forceinline__ void cum_scan(const Args& a, int gw, int lane) {
    if (gw >= 16) return;
    const float* logf = (const float*)(a.ws + WS_LOGF); float* cum = (float*)(a.ws + WS_CUM);
    const int b = gw >> 2, h = gw & 3; float run = 0.f;
    for (int c = 0; c < SEQ / 64; ++c) { float v = logf[(size_t)(b * SEQ + c * 64 + lane) * 4 + h];
#pragma unroll
        for (int o = 1; o < 64; o <<= 1) { const float t = shf(v, lane >= o ? lane - o : lane); if (lane >= o) v += t; }
        v += run; cum[(size_t)gw * SEQ + c * 64 + lane] = v; run = shf(v, 63); }
}

template <int MODE>
__device__ __forceinline__ void naive_attn(const Args& a, int l, int b, int h, int s, LAS float* sc, int lane) {
    const unsigned char* ws = a.ws; const bf16* P = (const bf16*)(ws + WS_PROJ);
    const bf16* Qp = P + (MODE ? 7 : 0) * PROJ_T; const bf16* Kp = P + (MODE ? 8 : 1) * PROJ_T; const bf16* Vp = P + (MODE ? 9 : 2) * PROJ_T;
    const float* cum = (const float*)(ws + WS_CUM) + (size_t)(b * 4 + h) * SEQ;
    const float* rb = a.rel_bias + ((size_t)l * 4 + h) * 320;
    const size_t tb = (size_t)b * SEQ;
    int klo = 0, khi = s;
    if (MODE) { const int c = s >> 6; klo = (c - 8) * 64; if (klo < 0) klo = 0; khi = c * 64 + 63; }
    const bf16* qrow = Qp + (tb + s) * MIXW + h * HD;
    float mx = -3.0e38f;
    for (int kb = klo; kb <= khi; kb += 64) { const int k = kb + lane;
        if (k <= khi) { const bf16* krow = Kp + (tb + k) * MIXW + h * HD; float d = 0.f;
#pragma unroll 4
            for (int c8 = 0; c8 < 16; ++c8) { const v4u qv = *(const v4u*)(qrow + c8 * 8), kv = *(const v4u*)(krow + c8 * 8);
                d = dot2_bf16(qv.x, kv.x, d); d = dot2_bf16(qv.y, kv.y, d); d = dot2_bf16(qv.z, kv.z, d); d = dot2_bf16(qv.w, kv.w, d); }
            float bias;
            if (MODE == 0) bias = cum[s] - cum[k];
            else { int rel = s - k; rel = rel < -63 ? -63 : (rel > 256 ? 256 : rel); bias = rb[rel + 63]; }
            const float lg = d * ATT_SCALE + bias; sc[k - klo] = lg; mx = fmaxf(mx, lg); } }
    mx = wave_max(mx, lane);
    asm volatile("s_waitcnt lgkmcnt(0)" ::: "memory");
    float sum = 0.f;
    for (int kb = klo; kb <= khi; kb += 64) { const int k = kb + lane; if (k <= khi) { const float p = __expf(sc[k - klo] - mx); sc[k - klo] = p; sum += p; } }
    sum = wave_sum(sum, lane);
    asm volatile("s_waitcnt lgkmcnt(0)" ::: "memory");
    float o0 = 0.f, o1 = 0.f;
    for (int k = klo; k <= khi; ++k) { const float p = sc[k - klo]; const unsigned v = *(const unsigned*)(Vp + (tb + k) * MIXW + h * HD + 2 * lane); o0 += p * bflo(v); o1 += p * bfhi(v); }
    const float inv = 1.0f / sum;
    bf16* Y = (bf16*)(a.ws + WS_Y);
    *(unsigned*)(Y + (tb + s) * D + (MODE ? 1536 : 0) + h * HD + 2 * lane) = pk2(o0 * inv, o1 * inv);
    asm volatile("s_waitcnt lgkmcnt(0)" ::: "memory");
}
__device__ __forceinline__ void naive_pool(const Args& a, int l, int t, int g, LAS float* sc, int lane) {
    const bf16* Pin = (const bf16*)(a.ws + WS_PROJ) + 3 * PROJ_T;
    const int s = t & (SEQ - 1), w = 2 << g; const int cnt = (s + 1 < w) ? s + 1 : w;
    float s0 = 0.f, s1 = 0.f;
    for (int j = 0; j < cnt; ++j) { const unsigned v = *(const unsigned*)(Pin + (size_t)(t - j) * MIXW + g * 128 + 2 * lane); s0 += bflo(v); s1 += bfhi(v); }
    const unsigned v0 = *(const unsigned*)(Pin + (size_t)t * MIXW + g * 128 + 2 * lane);
    const float inv = 1.0f / (float)cnt;
    sc[2 * lane] = s0 * inv - bflo(v0); sc[2 * lane + 1] = s1 * inv - bfhi(v0);
    asm volatile("s_waitcnt lgkmcnt(0)" ::: "memory");
    const float* W = a.pool_w + ((size_t)l * 4 + g) * 128 * 128;
    float o0 = 0.f, o1 = 0.f;
    for (int c = 0; c < 128; ++c) { const float p = sc[c]; const f32x2 wv = *(const f32x2*)(W + c * 128 + 2 * lane); o0 += p * wv[0]; o1 += p * wv[1]; }
    const f32x2 ps = *(const f32x2*)(a.pool_scale + l * MIXW + g * 128 + 2 * lane);
    bf16* Y = (bf16*)(a.ws + WS_Y);
    *(unsigned*)(Y + (size_t)t * D + 512 + g * 128 + 2 * lane) = pk2(o0 * ps[0], o1 * ps[1]);
    asm volatile("s_waitcnt lgkmcnt(0)" ::: "memory");
}
__device__ __forceinline__ void naive_conv(const Args& a, int l, int t, int lane) {
    const bf16* P = (const bf16*)(a.ws + WS_PROJ); const bf16* Ch = P + 4 * PROJ_T; const bf16* Cb = P + 5 * PROJ_T; const bf16* Cc = P + 6 * PROJ_T;
    const int s = t & (SEQ - 1), c0 = lane * 8;
    float acc[8] = {0.f, 0.f, 0.f, 0.f, 0.f, 0.f, 0.f, 0.f};
#pragma unroll
    for (int j = 0; j < 3; ++j) { const int dt = 2 - j;
        if (s - dt >= 0) { const v4u hv = *(const v4u*)(Ch + (size_t)(t - dt) * MIXW + c0), cv = *(const v4u*)(Cc + (size_t)(t - dt) * MIXW + c0);
            const float* w = a.conv_w + ((size_t)l * 3 + j) * MIXW + c0; const f32x4 w0 = *(const f32x4*)w, w1 = *(const f32x4*)(w + 4);
            acc[0] += w0[0] * bflo(hv.x) * bflo(cv.x); acc[1] += w0[1] * bfhi(hv.x) * bfhi(cv.x); acc[2] += w0[2] * bflo(hv.y) * bflo(cv.y); acc[3] += w0[3] * bfhi(hv.y) * bfhi(cv.y);
            acc[4] += w1[0] * bflo(hv.z) * bflo(cv.z); acc[5] += w1[1] * bfhi(hv.z) * bfhi(cv.z); acc[6] += w1[2] * bflo(hv.w) * bflo(cv.w); acc[7] += w1[3] * bfhi(hv.w) * bfhi(cv.w); } }
    const v4u bv = *(const v4u*)(Cb + (size_t)t * MIXW + c0);
    v4u o; o.x = pk2(acc[0] * bflo(bv.x), acc[1] * bfhi(bv.x)); o.y = pk2(acc[2] * bflo(bv.y), acc[3] * bfhi(bv.y)); o.z = pk2(acc[4] * bflo(bv.z), acc[5] * bfhi(bv.z)); o.w = pk2(acc[6] * bflo(bv.w), acc[7] * bfhi(bv.w));
    *(v4u*)((bf16*)(a.ws + WS_Y) + (size_t)t * D + 1024 + c0) = o;
}
__device__ __forceinline__ void mixers_naive(const Args& a, int l, LAS unsigned char* lds, int gw, int NGW, int wave, int lane) {
    LAS float* sc = (LAS float*)(lds + wave * 8192);
    for (int i = gw; i < M * 4; i += NGW) { const int t = M * 4 - 1 - i; const int h = t & 3, tok = t >> 2; naive_attn<0>(a, l, tok >> 11, h, tok & (SEQ - 1), sc, lane); }
    for (int i = gw; i < M * 4; i += NGW) { const int h = i & 3, tok = i >> 2; naive_attn<1>(a, l, tok >> 11, h, tok & (SEQ - 1), sc, lane); }
    for (int i = gw; i < M * 4; i += NGW) naive_pool(a, l, i >> 2, i & 3, sc, lane);
    for (int i = gw; i < M; i += NGW) naive_conv(a, l, i, lane);
}

#ifndef PROBE
#define PROBE 0
#endif
__device__ __forceinline__ float gelu_tanh(float x) { const float u = 1.5957691216057308f * (x + 0.044715f * x * x * x); return x / (1.0f + __expf(-u)); }
constexpr int PEER_TOK = 32;
constexpr int PL_IDX = 0, PL_GATE = PEER_TOK * 128 * 4, PL_TAB = 2 * PEER_TOK * 128 * 4;
__device__ __forceinline__ int f2key(float f) { const int b = __builtin_bit_cast(int, f); return b ^ ((b >> 31) & 0x7fffffff); }
__device__ __forceinline__ float key2f(int k) { return __builtin_bit_cast(float, k ^ ((k >> 31) & 0x7fffffff)); }
#define CE_DESC(x, y) do { const int hi_ = (x) > (y) ? (x) : (y), lo_ = (x) > (y) ? (y) : (x); (x) = hi_; (y) = lo_; } while (0)
__device__ __forceinline__ void sort16_desc(int* v) {
#pragma unroll
    for (int k = 2; k <= 16; k <<= 1)
#pragma unroll
        for (int j = k >> 1; j > 0; j >>= 1)
#pragma unroll
            for (int i = 0; i < 16; ++i) { const int l = i ^ j; if (l > i) { if ((i & k) == 0) CE_DESC(v[i], v[l]); else CE_DESC(v[l], v[i]); } }
}
__device__ __forceinline__ void merge_top16(int* a, const int* b) {
#pragma unroll
    for (int i = 0; i < 16; ++i) a[i] = a[i] > b[15 - i] ? a[i] : b[15 - i];
#pragma unroll
    for (int j = 8; j > 0; j >>= 1)
#pragma unroll
        for (int i = 0; i < 16; ++i) { const int l = i ^ j; if (l > i) CE_DESC(a[i], a[l]); }
}
__device__ __forceinline__ void top16_of_64(int* v) {
    sort16_desc(v); sort16_desc(v + 16); sort16_desc(v + 32); sort16_desc(v + 48);
    merge_top16(v, v + 16); merge_top16(v + 32, v + 48); merge_top16(v, v + 32);
}
constexpr int cand_slot(int i, int j) {
    int n = 0;
    for (int a = 0; a < 16; ++a) for (int b = 0; b < 16; ++b) { if ((a + 1) * (b + 1) <= 16) { if (a == i && b == j) return n; ++n; } }
    return -1;
}
__device__ __forceinline__ void peer_retrieve(const Args& a, int l, int t0, int h, LAS char* lds, int wave) {
    typedef short bf16x8 __attribute__((ext_vector_type(8)));
    typedef float f32x16 __attribute__((ext_vector_type(16)));
    int lane; asm volatile("v_mbcnt_lo_u32_b32 %0, -1, 0\n\tv_mbcnt_hi_u32_b32 %0, -1, %0" : "=v"(lane));
    const int r32 = lane & 31, hi = lane >> 5, hi4 = hi * 4;
    const bf16* Q = (const bf16*)(a.ws + WS_Q) + (size_t)(t0 + r32) * D + h * 256 + hi * 8;
    const bf16* PK = (const bf16*)(a.ws + WS_PK) + ((size_t)(l * 8 + h) * 2) * 128 * 128 + (size_t)r32 * 128 + hi * 8;
    int top[2][16];
#pragma unroll
    for (int p = 0; p < 2; ++p) {
        f32x16 acc[4] = {};
        bf16x8 qf[8];
#pragma unroll
        for (int cs = 0; cs < 8; ++cs) qf[cs] = *(const bf16x8*)(Q + p * 128 + cs * 16);
#pragma unroll
        for (int kb = 0; kb < 4; ++kb) { bf16x8 kf[8];
#pragma unroll
            for (int cs = 0; cs < 8; ++cs) kf[cs] = *(const bf16x8*)(PK + (size_t)p * 128 * 128 + (size_t)kb * 32 * 128 + cs * 16);
#pragma unroll
            for (int cs = 0; cs < 8; ++cs) acc[kb] = __builtin_amdgcn_mfma_f32_32x32x16_bf16(kf[cs], qf[cs], acc[kb], 0, 0, 0); }
        int v[64];
#pragma unroll
        for (int kb = 0; kb < 4; ++kb)
#pragma unroll
            for (int r = 0; r < 16; ++r) { const int c = kb * 32 + (r & 3) + 8 * (r >> 2);
                v[kb * 16 + r] = (f2key(acc[kb][r]) & ~127) | (c | hi4); }
        top16_of_64(v);
        int mine[16], other[16];
#pragma unroll
        for (int i = 0; i < 16; ++i) { auto rr = __builtin_amdgcn_permlane32_swap((unsigned)v[i], (unsigned)v[i], false, false); mine[i] = (int)rr[0]; other[i] = (int)rr[1]; }
        merge_top16(mine, other);
#pragma unroll
        for (int i = 0; i < 16; ++i) top[p][i] = mine[i];
    }
    LAS int* tab = (LAS int*)(lds + PL_TAB) + (wave * 64 + lane) * 32;
    float sA[16], sB[16];
#pragma unroll
    for (int i = 0; i < 16; ++i) { sA[i] = key2f(top[0][i] & ~127); sB[i] = key2f(top[1][i] & ~127); tab[i] = top[0][i] & 127; tab[16 + i] = top[1][i] & 127; }
    int c[64];
#pragma unroll
    for (int n = 0; n < 64; ++n) c[n] = (int)0x80000000;
#pragma unroll
    for (int i = 0; i < 16; ++i)
#pragma unroll
        for (int j = 0; j < 16; ++j) if ((i + 1) * (j + 1) <= 16) c[cand_slot(i, j)] = (f2key(sA[i] + sB[j]) & ~255) | (16 * i + j);
    top16_of_64(c);
    float ex[16]; float sum = 0.f; const float mx = key2f(c[0] & ~255);
#pragma unroll
    for (int w = 0; w < 16; ++w) { ex[w] = __expf(key2f(c[w] & ~255) - mx); sum += ex[w]; }
    const float inv = 1.0f / sum;
    asm volatile("s_waitcnt lgkmcnt(0)" ::: "memory");
    LAS int* oi = (LAS int*)(lds + PL_IDX) + r32 * 128 + h * 16; LAS float* og = (LAS float*)(lds + PL_GATE) + r32 * 128 + h * 16;
#pragma unroll
    for (int w = 0; w < 16; ++w) { const int id = c[w] & 255; const int e = tab[id >> 4] * 128 + tab[16 + (id & 15)];
        if ((w >> 3) == hi) { oi[w] = e; og[w] = ex[w] * inv; } }
}
constexpr size_t WS_IDX = 816 * MiB;
constexpr size_t WS_GATE = 820 * MiB;
constexpr size_t WS_XQ = 824 * MiB;
constexpr size_t WS_SX = 856 * MiB;
constexpr size_t WS_PART = 857 * MiB;
constexpr size_t WS_SUT = 890 * MiB;
constexpr size_t WS_END2 = 894 * MiB;
#ifndef PEER_NB
#define PEER_NB 8
#endif
constexpr int NSLICE = 8, SLW = D / NSLICE;
#define DPP_ROR(x, n) __builtin_bit_cast(float, __builtin_amdgcn_update_dpp(0, __builtin_bit_cast(int, (x)), 0x120 + (n), 0xf, 0xf, false))
__device__ __forceinline__ void peer_publish(const Args& a, int l, int t, LAS char* lds, int tl) {
    int lane; LANE_ID(lane);
    unsigned char* ws = a.ws;
    { int* gi = (int*)(ws + WS_IDX) + (size_t)t * 128; float* gg = (float*)(ws + WS_GATE) + (size_t)t * 128; float* gs = (float*)(ws + WS_SUT) + (size_t)t * 128;
      const float* SU = (const float*)(ws + WS_SU) + l * PEER_E; const float* SV = (const float*)(ws + WS_SV) + l * PEER_E;
      const int i0 = ((const LAS int*)(lds + PL_IDX))[tl * 128 + lane], i1 = ((const LAS int*)(lds + PL_IDX))[tl * 128 + 64 + lane];
      gi[lane] = i0; gi[64 + lane] = i1; gs[lane] = SU[i0]; gs[64 + lane] = SU[i1];
      gg[lane] = ((const LAS float*)(lds + PL_GATE))[tl * 128 + lane] * SV[i0]; gg[64 + lane] = ((const LAS float*)(lds + PL_GATE))[tl * 128 + 64 + lane] * SV[i1]; }
    const unsigned long long* ssa1 = (const unsigned long long*)(ws + WS_SSA) + l * M;
    const float rs = rsqrtf(ssa_to_f(ssa1[t]) * (1.0f / D) + EPS);
    const bf16* HB = (const bf16*)(ws + WS_HB) + (size_t)t * D; const float* gn = a.norm_ffn + l * D;
    float xf[32]; float am = 0.f;
#pragma unroll
    for (int i = 0; i < 2; ++i) { const int k0 = 16 * lane + 1024 * i; const v4u h0 = *(const v4u*)(HB + k0), h1 = *(const v4u*)(HB + k0 + 8);
        const unsigned hw[8] = {h0.x, h0.y, h0.z, h0.w, h1.x, h1.y, h1.z, h1.w};
#pragma unroll
        for (int q = 0; q < 4; ++q) { const f32x4 g = *(const f32x4*)(gn + k0 + 4 * q);
            xf[16 * i + 4 * q + 0] = bflo(hw[2 * q]) * rs * g[0]; xf[16 * i + 4 * q + 1] = bfhi(hw[2 * q]) * rs * g[1];
            xf[16 * i + 4 * q + 2] = bflo(hw[2 * q + 1]) * rs * g[2]; xf[16 * i + 4 * q + 3] = bfhi(hw[2 * q + 1]) * rs * g[3]; } }
#pragma unroll
    for (int k = 0; k < 32; ++k) am = fmaxf(am, fabsf(xf[k]));
    am = wave_max(am, lane);
    const float inv = am > 0.f ? 127.0f / am : 0.f;
    if (lane == 0) ((float*)(ws + WS_SX))[t] = am * (1.0f / 127.0f);
    unsigned char* xq = ws + WS_XQ + (size_t)t * 4096;
#pragma unroll
    for (int i = 0; i < 2; ++i) { v4u ph, pl;
#pragma unroll
        for (int d = 0; d < 4; ++d) { unsigned wh = 0, wl = 0;
#pragma unroll
            for (int b = 0; b < 4; ++b) { const float sv = xf[16 * i + 4 * d + b] * inv, hq = rintf(sv), lq = rintf((sv - hq) * 128.0f);
                wh |= ((unsigned)((int)hq & 255)) << (8 * b); wl |= ((unsigned)((int)lq & 255)) << (8 * b); }
            ph[d] = wh; pl[d] = wl; }
        *(v4u*)(xq + 16 * lane + 1024 * i) = ph; *(v4u*)(xq + 2048 + 16 * lane + 1024 * i) = pl; }
}
struct PeerItems { int pos, npop, rank, nloc, wave;
    __device__ __forceinline__ int nblk() const { return (M / PEER_TOK - rank + nloc - 1) / nloc; }
    __device__ __forceinline__ int count() const { return ((NSLICE - pos + npop - 1) / npop) * nblk() * (PEER_TOK / NWAVES); }
    __device__ __forceinline__ void get(int n, int& s, int& t) const { constexpr int per = PEER_TOK / NWAVES; const int k = n % per, r = n / per, nb = nblk();
        s = pos + (r / nb) * npop; t = (rank + (r % nb) * nloc) * PEER_TOK + wave * per + k; } };
__device__ __forceinline__ void peer_u_wave(const Args& a, int l, const PeerItems& it) {
    int lane; LANE_ID(lane);
    unsigned char* ws = a.ws; const int sub = lane & 15, grp = lane >> 4;
    const __amdgpu_buffer_rsrc_t rU = __builtin_amdgcn_make_buffer_rsrc((void*)(ws + WS_PU + (size_t)l * PE_BYTES), 0, 0x7fffffff, 0x00020000);
    const __amdgpu_buffer_rsrc_t rW = __builtin_amdgcn_make_buffer_rsrc((void*)ws, 0, 0x7fffffff, 0x00020000);
    const int N = it.count(); if (N <= 0) return;
    int s, t; it.get(0, s, t);
    int idc[2], idn[2] = {0, 0}; v4u xhc, xlc, xhn = {}, xln = {}; v4u wA[PEER_NB], wB[PEER_NB];
#define PU_META(I0, I1, XH, XL, S_, T_) do { I0 = (int)__builtin_amdgcn_raw_buffer_load_b32(rW, 4 * lane, (int)WS_IDX + (T_) * 512, 0); I1 = (int)__builtin_amdgcn_raw_buffer_load_b32(rW, 4 * lane, (int)WS_IDX + (T_) * 512 + 256, 0); \
        XH = __builtin_amdgcn_raw_buffer_load_b128(rW, 16 * sub, (int)WS_XQ + (T_) * 4096 + SLW * (S_), 0); XL = __builtin_amdgcn_raw_buffer_load_b128(rW, 16 * sub, (int)WS_XQ + (T_) * 4096 + 2048 + SLW * (S_), 0); } while (0)
#define PU_ISSUE(W, ID, Q, S_) do { _Pragma("unroll") for (int j = 0; j < PEER_NB; ++j) { const int e_ = shi(ID[(PEER_NB * (Q) + j) >> 4], 4 * ((PEER_NB * (Q) + j) & 15) + grp); W[j] = __builtin_amdgcn_raw_buffer_load_b128(rU, e_ * D + SLW * (S_) + 16 * sub, 0, 0); } } while (0)
#define PU_COMP(W, Q) do { _Pragma("unroll") for (int j = 0; j < PEER_NB; ++j) { int dh = 0, dl = 0; \
            dh = __builtin_amdgcn_sdot4((int)W[j].x, (int)xhc.x, dh, false); dl = __builtin_amdgcn_sdot4((int)W[j].x, (int)xlc.x, dl, false); \
            dh = __builtin_amdgcn_sdot4((int)W[j].y, (int)xhc.y, dh, false); dl = __builtin_amdgcn_sdot4((int)W[j].y, (int)xlc.y, dl, false); \
            dh = __builtin_amdgcn_sdot4((int)W[j].z, (int)xhc.z, dh, false); dl = __builtin_amdgcn_sdot4((int)W[j].z, (int)xlc.z, dl, false); \
            dh = __builtin_amdgcn_sdot4((int)W[j].w, (int)xhc.w, dh, false); dl = __builtin_amdgcn_sdot4((int)W[j].w, (int)xlc.w, dl, false); \
            float p_ = (float)dh + (float)dl * (1.0f / 128.0f); \
            p_ += DPP_ROR(p_, 8); p_ += DPP_ROR(p_, 4); p_ += DPP_ROR(p_, 2); p_ += DPP_ROR(p_, 1); \
            if (sub == ((PEER_NB * (Q) + j) & 15)) { if ((PEER_NB * (Q) + j) >> 4) acc1 = p_; else acc0 = p_; } __builtin_amdgcn_sched_barrier(0); } } while (0)
    PU_META(idc[0], idc[1], xhc, xlc, s, t); PU_ISSUE(wA, idc, 0, s); PU_ISSUE(wB, idc, 1, s);
    for (int n = 0; n < N; ++n) {
        int sn = s, tn = t; const bool more = n + 1 < N;
        if (more) it.get(n + 1, sn, tn);
        PU_META(idn[0], idn[1], xhn, xln, sn, tn);
        float acc0 = 0.f, acc1 = 0.f;
        __builtin_amdgcn_sched_barrier(0);
#if PEER_NB == 8
        PU_COMP(wA, 0); PU_ISSUE(wA, idc, 2, s); __builtin_amdgcn_sched_barrier(0);
        PU_COMP(wB, 1); PU_ISSUE(wB, idc, 3, s); __builtin_amdgcn_sched_barrier(0);
        PU_COMP(wA, 2); PU_ISSUE(wA, idn, 0, sn); __builtin_amdgcn_sched_barrier(0);
        PU_COMP(wB, 3); PU_ISSUE(wB, idn, 1, sn); __builtin_amdgcn_sched_barrier(0);
#else
        PU_COMP(wA, 0); PU_ISSUE(wA, idn, 0, sn); __builtin_amdgcn_sched_barrier(0);
        PU_COMP(wB, 1); PU_ISSUE(wB, idn, 1, sn); __builtin_amdgcn_sched_barrier(0);
#endif
        __builtin_amdgcn_raw_buffer_store_b32(__builtin_bit_cast(unsigned, acc0), rW, (4 * sub + grp) * 4, (int)WS_PART + (s * M + t) * 512, 0);
        __builtin_amdgcn_raw_buffer_store_b32(__builtin_bit_cast(unsigned, acc1), rW, (4 * sub + grp) * 4 + 256, (int)WS_PART + (s * M + t) * 512, 0);
        s = sn; t = tn; idc[0] = idn[0]; idc[1] = idn[1]; xhc = xhn; xlc = xln;
    }
#undef PU_META
#undef PU_ISSUE
#undef PU_COMP
}
__device__ __forceinline__ void peer_v_wave(const Args& a, int l, const PeerItems& it) {
    int lane; LANE_ID(lane);
    unsigned char* ws = a.ws; const int sub = lane & 15, grp = lane >> 4;
    const __amdgpu_buffer_rsrc_t rV = __builtin_amdgcn_make_buffer_rsrc((void*)(ws + WS_PV + (size_t)l * PE_BYTES), 0, 0x7fffffff, 0x00020000);
    const __amdgpu_buffer_rsrc_t rW = __builtin_amdgcn_make_buffer_rsrc((void*)ws, 0, 0x7fffffff, 0x00020000);
    const int N = it.count(); if (N <= 0) return;
    int s, t; it.get(0, s, t);
    struct Meta { int id[2]; float gate[2], su[2], pa[2], sx; f32x4 h1; };
    Meta mc, mn; v4u wA[PEER_NB], wB[PEER_NB];
    const int l4 = 4 * lane;
#define WLD(off_s) __builtin_amdgcn_raw_buffer_load_b32(rW, l4, (int)(off_s), 0)
#define PV_META(MM, S_, T_) do { const int r_ = (T_) * 512; MM.id[0] = (int)WLD(WS_IDX + r_); MM.id[1] = (int)WLD(WS_IDX + r_ + 256); \
        MM.gate[0] = __builtin_bit_cast(float, WLD(WS_GATE + r_)); MM.gate[1] = __builtin_bit_cast(float, WLD(WS_GATE + r_ + 256)); MM.su[0] = __builtin_bit_cast(float, WLD(WS_SUT + r_)); MM.su[1] = __builtin_bit_cast(float, WLD(WS_SUT + r_ + 256)); \
        float a0_ = 0.f, a1_ = 0.f; _Pragma("unroll") for (int q = 0; q < NSLICE; ++q) { const int po_ = (int)WS_PART + (q * M + (T_)) * 512; a0_ += __builtin_bit_cast(float, WLD(po_)); a1_ += __builtin_bit_cast(float, WLD(po_ + 256)); } \
        MM.pa[0] = a0_; MM.pa[1] = a1_; MM.sx = ((const float*)(ws + WS_SX))[T_]; \
        MM.h1 = __builtin_bit_cast(f32x4, __builtin_amdgcn_raw_buffer_load_b128(rW, (16 * sub + 4 * grp) * 4, (int)WS_H + ((T_) * D + SLW * (S_)) * 4, 0)); } while (0)
#define PV_ISSUE(W, ID, Q, S_) do { _Pragma("unroll") for (int j = 0; j < PEER_NB; ++j) { const int e_ = shi(ID[(PEER_NB * (Q) + j) >> 4], 4 * ((PEER_NB * (Q) + j) & 15) + grp); W[j] = __builtin_amdgcn_raw_buffer_load_b128(rV, e_ * D + SLW * (S_) + 16 * sub, 0, 0); } } while (0)
#define PV_COMP(W, Q) do { _Pragma("unroll") for (int j4 = 0; j4 < PEER_NB; j4 += 4) { \
            unsigned cp_ = 0; _Pragma("unroll") for (int jj = 0; jj < 4; ++jj) { const int i_ = PEER_NB * (Q) + j4 + jj; cp_ |= ((unsigned)shi(c8[i_ >> 4], 4 * (i_ & 15) + grp) & 255u) << (8 * jj); } \
            _Pragma("unroll") for (int d = 0; d < 4; ++d) { const unsigned a_ = W[j4][d], b_ = W[j4 + 1][d], c_ = W[j4 + 2][d], d_ = W[j4 + 3][d]; \
                const unsigned x0_ = __builtin_amdgcn_perm(b_, a_, 0x05010400u), x1_ = __builtin_amdgcn_perm(b_, a_, 0x07030602u), y0_ = __builtin_amdgcn_perm(d_, c_, 0x05010400u), y1_ = __builtin_amdgcn_perm(d_, c_, 0x07030602u); \
                yi[4 * d + 0] = __builtin_amdgcn_sdot4((int)__builtin_amdgcn_perm(y0_, x0_, 0x05040100u), (int)cp_, yi[4 * d + 0], false); \
                yi[4 * d + 1] = __builtin_amdgcn_sdot4((int)__builtin_amdgcn_perm(y0_, x0_, 0x07060302u), (int)cp_, yi[4 * d + 1], false); \
                yi[4 * d + 2] = __builtin_amdgcn_sdot4((int)__builtin_amdgcn_perm(y1_, x1_, 0x05040100u), (int)cp_, yi[4 * d + 2], false); \
                yi[4 * d + 3] = __builtin_amdgcn_sdot4((int)__builtin_amdgcn_perm(y1_, x1_, 0x07060302u), (int)cp_, yi[4 * d + 3], false); } \
            __builtin_amdgcn_sched_barrier(0); } } while (0)
    PV_META(mc, s, t); PV_ISSUE(wA, mc.id, 0, s); PV_ISSUE(wB, mc.id, 1, s);
    for (int n = 0; n < N; ++n) {
        int sn = s, tn = t; const bool more = n + 1 < N;
        if (more) it.get(n + 1, sn, tn);
        PV_META(mn, sn, tn);
        float coef[2];
#pragma unroll
        for (int hf = 0; hf < 2; ++hf) coef[hf] = gelu_tanh(mc.pa[hf] * mc.su[hf] * mc.sx) * mc.gate[hf];
        const float cmax = wave_max(fmaxf(fabsf(coef[0]), fabsf(coef[1])), lane); const float cinv = cmax > 0.f ? 127.0f / cmax : 0.f, cs = cmax * (1.0f / 127.0f);
        const int c8[2] = {(int)rintf(coef[0] * cinv), (int)rintf(coef[1] * cinv)};
        int yi[16];
#pragma unroll
        for (int k = 0; k < 16; ++k) yi[k] = 0;
        __builtin_amdgcn_sched_barrier(0);
#if PEER_NB == 8
        PV_COMP(wA, 0); PV_ISSUE(wA, mc.id, 2, s); __builtin_amdgcn_sched_barrier(0);
        PV_COMP(wB, 1); PV_ISSUE(wB, mc.id, 3, s); __builtin_amdgcn_sched_barrier(0);
        PV_COMP(wA, 2); PV_ISSUE(wA, mn.id, 0, sn); __builtin_amdgcn_sched_barrier(0);
        PV_COMP(wB, 3); PV_ISSUE(wB, mn.id, 1, sn); __builtin_amdgcn_sched_barrier(0);
#else
        PV_COMP(wA, 0); PV_ISSUE(wA, mn.id, 0, sn); __builtin_amdgcn_sched_barrier(0);
        PV_COMP(wB, 1); PV_ISSUE(wB, mn.id, 1, sn); __builtin_amdgcn_sched_barrier(0);
#endif
#pragma unroll
        for (int k = 0; k < 16; ++k) { yi[k] += shi(yi[k], lane ^ 16); yi[k] += shi(yi[k], lane ^ 32); }
        int yq[4];
#pragma unroll
        for (int k = 0; k < 4; ++k) yq[k] = grp == 0 ? yi[k] : grp == 1 ? yi[4 + k] : grp == 2 ? yi[8 + k] : yi[12 + k];
        const f32x4 h2 = {mc.h1[0] + cs * (float)yq[0], mc.h1[1] + cs * (float)yq[1], mc.h1[2] + cs * (float)yq[2], mc.h1[3] + cs * (float)yq[3]};
        __builtin_amdgcn_raw_buffer_store_b128(__builtin_bit_cast(v4u, h2), rW, (16 * sub + 4 * grp) * 4, (int)WS_H + (t * D + SLW * s) * 4, 0);
        v2u hb; hb.x = pk2(h2[0], h2[1]); hb.y = pk2(h2[2], h2[3]);
        __builtin_amdgcn_raw_buffer_store_b64(hb, rW, (16 * sub + 4 * grp) * 2, (int)WS_HB + (t * D + SLW * s) * 2, 0);
        const float sq = wave_sum((h2[0] * h2[0] + h2[1] * h2[1]) + (h2[2] * h2[2] + h2[3] * h2[3]), lane);
        if (lane == 0) atomicAdd((unsigned long long*)(ws + WS_SSQ) + (size_t)(l + 1) * M + t, (unsigned long long)((double)sq * 4294967296.0));
        s = sn; t = tn; mc = mn;
    }
#undef PV_META
#undef WLD
#undef PV_ISSUE
#undef PV_COMP
}
__device__ __forceinline__ void final_norm_row(const Args& a, int t) {
    int lane; LANE_ID(lane);
    const float* H = (const float*)(a.ws + WS_H) + (size_t)t * D; float* O = a.out + (size_t)t * D;
    const float rf = rsqrtf(ssa_to_f(((const unsigned long long*)(a.ws + WS_SSQ))[(size_t)DEPTH * M + t]) * (1.0f / D) + EPS);
#pragma unroll
    for (int j = 0; j < 8; ++j) { const int k0 = 4 * lane + 256 * j; const f32x4 h = *(const f32x4*)(H + k0), g = *(const f32x4*)(a.norm_final + k0);
        *(f32x4*)(O + k0) = (f32x4){h[0] * rf * g[0], h[1] * rf * g[1], h[2] * rf * g[2], h[3] * rf * g[3]}; }
}

__global__ void __launch_bounds__(NT, 2) mk_fwd(ArgsK a_in) {
    extern __shared__ __attribute__((aligned(16))) unsigned char lds_raw[];
    LAS unsigned char* lds = (LAS unsigned char*)lds_raw;
    cg::grid_group grid = cg::this_grid();
    grid.sync();
    const int wave0 = __builtin_amdgcn_readfirstlane(threadIdx.x >> 6);
    const int G = gridDim.x;
    const CAS ArgsK* ka = (const CAS ArgsK*)__builtin_amdgcn_kernarg_segment_ptr();
    size_t zoff = 0;
#define PHASE_BEGIN() int lane; LANE_ID(lane); int blk = blockIdx.x, Gp = G, wv = wave0; asm volatile("" : "+s"(zoff), "+s"(ka), "+s"(blk), "+s"(Gp), "+s"(wv)); const int wave = wv, gw = blk * NWAVES + wv, NGW = Gp * NWAVES; (void)gw; (void)NGW; const Args a = load_args(ka, zoff); unsigned char* const ws = a.ws; (void)ws
    volatile LAS unsigned* bst = (volatile LAS unsigned*)(lds + RING_BYTES + 1024);
    if (PROBE == 3) { PHASE_BEGIN(); p0_prologue(a, lds, gw, NGW, wave, lane); }
    volatile LAS unsigned* xinfo = bst + 4;
    { PHASE_BEGIN(); if (wave == 0 && lane == 0) { bst[0] = 0u; bst[1] = 0u; xinfo[2] = xb_add((unsigned*)(ws + WS_BAR) + XB_XCNT(xb_xcc_id()), 1u); }
      p0_prologue(a, lds, gw, NGW, wave, lane); }
#define GRID_BAR() do { asm volatile("" : "+s"(zoff)); unsigned char* wsb_ = (unsigned char*)ka->ws + zoff; int wvb_ = wave0; asm volatile("" : "+s"(wvb_)); xcd_barrier((unsigned*)(wsb_ + WS_BAR), xb_xcc_id(), (unsigned)G, bst, wvb_); if (PROBE == 9) xcd_barrier((unsigned*)(wsb_ + WS_BAR), xb_xcc_id(), (unsigned)G, bst, wvb_); } while (0)
    GRID_BAR();
    {
        PHASE_BEGIN();
        if (wave == 0 && lane == 0) { unsigned* bar = (unsigned*)(ws + WS_BAR); const unsigned x = xb_xcc_id(); unsigned pos = 0, npop = 0, mine = 1;
            for (unsigned j = 0; j < 16; ++j) { const unsigned c = xb_ld(&bar[XB_XCNT(j)]); if (c) { ++npop; if (j < x) ++pos; } if (j == x) mine = c ? c : 1u; }
            xinfo[0] = pos; xinfo[1] = npop ? npop : 1u; xinfo[3] = mine; }
        __syncthreads();
    }
    int depth_rt = DEPTH; asm volatile("" : "+s"(depth_rt));
    for (int lc = 0; lc < depth_rt; ++lc) {
        int l = lc; asm volatile("" : "+s"(l));
        for (int rep = 0; rep < (PROBE == 4 ? 2 : 1); ++rep)
        {
            PHASE_BEGIN();
            const unsigned long long* ssq_mix = (const unsigned long long*)(ws + WS_SSQ) + l * M;
            pg8::Gemm g{(const bf16*)(ws + WS_HB), (const bf16*)(ws + WS_WIN + l * WIN_BYTES), M, NPROJ, D}; pg8::StaticOrder S; S.init(M, NPROJ, Gp, blk);
            EpiProj E{(bf16*)(ws + WS_PROJ), (bf16*)(ws + WS_R), (const float*)(ws + WS_BINR) + l * NPROJ, ssq_mix};
            pg8::gemm_phase<EpiProj, pg8::StaticOrder, true>(lds, g, S, E, wave);
            for (int r2 = 0; r2 < (PROBE == 8 ? 2 : 1); ++r2) forget_logits(a, l, gw, NGW, lane);
        }
        GRID_BAR();
        if (PROBE == 5) { PHASE_BEGIN(); mixers_fast(a, l + 2, (LAS char*)lds, wave, lane, Gp, blk); }
        { PHASE_BEGIN(); mixers_fast(a, l, (LAS char*)lds, wave, lane, Gp, blk); }
        GRID_BAR();
        for (int rep = 0; rep < (PROBE == 6 ? 2 : 1); ++rep)
        {
            PHASE_BEGIN();
            pg8::Gemm g{(const bf16*)(ws + WS_Y), (const bf16*)(ws + WS_WBR + l * SQ_BYTES), M, D, D}; pg8::StaticOrder S; S.init(M, D, Gp, blk);
            EpiMerge E{(const bf16*)(ws + WS_R), (bf16*)(ws + WS_MRG)};
            pg8::gemm_phase<EpiMerge, pg8::StaticOrder, false>(lds, g, S, E, wave);
        }
        GRID_BAR();
        {
            PHASE_BEGIN();
            pg8::Gemm g{(const bf16*)(ws + WS_MRG), (const bf16*)(ws + WS_WOUT + l * SQ_BYTES), M, D, D}; pg8::StaticOrder S; S.init(M, D, Gp, blk);
            EpiRes E{(float*)(ws + WS_H), (bf16*)(ws + WS_HB), (unsigned long long*)(ws + WS_SSA) + l * M};
            pg8::gemm_phase<EpiRes, pg8::StaticOrder, false>(lds, g, S, E, wave);
        }
        GRID_BAR();
        for (int rep = 0; rep < (PROBE == 7 ? 2 : 1); ++rep)
        {
            PHASE_BEGIN();
            pg8::Gemm g{(const bf16*)(ws + WS_HB), (const bf16*)(ws + WS_WQ + l * SQ_BYTES), M, D, D}; pg8::StaticOrder S; S.init(M, D, Gp, blk);
            EpiQ E{(bf16*)(ws + WS_Q), (const unsigned long long*)(ws + WS_SSA) + l * M};
            pg8::gemm_phase<EpiQ, pg8::StaticOrder, false>(lds, g, S, E, wave);
        }
        GRID_BAR();
        for (int rep = 0; rep < (PROBE == 2 ? 2 : 1); ++rep)
        {
            PHASE_BEGIN(); (void)lane;
            for (int t0 = blk * PEER_TOK; t0 < M; t0 += Gp * PEER_TOK) {
                peer_retrieve(a, l, t0, wave, (LAS char*)lds, wave);
                __syncthreads();
                for (int k = 0; k < PEER_TOK / NWAVES; ++k) { const int tl = wave * (PEER_TOK / NWAVES) + k; peer_publish(a, l, t0 + tl, (LAS char*)lds, tl); }
                __syncthreads();
            }
        }
        GRID_BAR();
        for (int rep = 0; rep < (PROBE == 1 ? 2 : 1); ++rep)
        {
            PHASE_BEGIN(); (void)lane;
            const int pos = __builtin_amdgcn_readfirstlane((int)xinfo[0]), npop = __builtin_amdgcn_readfirstlane((int)xinfo[1]), rank = __builtin_amdgcn_readfirstlane((int)xinfo[2]), nloc = __builtin_amdgcn_readfirstlane((int)xinfo[3]);
            const PeerItems it{pos, npop, rank, nloc, wave}; peer_u_wave(a, l, it);
        }
        GRID_BAR();
        {
            PHASE_BEGIN(); (void)lane;
            const int pos = __builtin_amdgcn_readfirstlane((int)xinfo[0]), npop = __builtin_amdgcn_readfirstlane((int)xinfo[1]), rank = __builtin_amdgcn_readfirstlane((int)xinfo[2]), nloc = __builtin_amdgcn_readfirstlane((int)xinfo[3]);
            const PeerItems it{pos, npop, rank, nloc, wave}; peer_v_wave(a, l, it);
        }
        GRID_BAR();
    }
    {
        PHASE_BEGIN(); (void)lane;
        for (int t = gw; t < M; t += NGW) final_norm_row(a, t);
    }
}

extern "C" void kernel_launch(void* const* d_in, const int* in_sizes, int n_in, void* d_out, int out_size, void* d_ws, size_t ws_size, hipStream_t stream) {
    static int grid = 0;
    if (grid == 0) {
        int dev = 0, cus = 0, per_cu = 0;
        if (n_in != 16 || out_size != M * D || ws_size < WS_END2) { fprintf(stderr, "kernel_launch: unexpected shapes (n_in %d out %d ws %zu)\n", n_in, out_size, ws_size); grid = -1; return; }
        (void)hipGetDevice(&dev);
        (void)hipDeviceGetAttribute(&cus, hipDeviceAttributeMultiprocessorCount, dev);
        (void)hipFuncSetAttribute((const void*)mk_fwd, hipFuncAttributeMaxDynamicSharedMemorySize, LDS_BYTES);
        (void)hipOccupancyMaxActiveBlocksPerMultiprocessor(&per_cu, (const void*)mk_fwd, NT, LDS_BYTES);
        if (per_cu < 1) { fprintf(stderr, "kernel_launch: occupancy query says %d blocks per CU\n", per_cu); }
        grid = cus;
        if (grid > 256) grid = 256;
    }
    if (grid < 0) return;
    (void)hipMemsetAsync((char*)d_ws + WS_CTL, 0, CTL_ZERO_BYTES, stream);
    ArgsK a{};
    const GAS float** p = (const GAS float**)&a;
    for (int i = 0; i < 16; ++i) p[i] = (const GAS float*)d_in[i];
    a.out = (GAS float*)d_out; a.ws = (GAS unsigned char*)d_ws;
    void* args[] = {&a};
    hipError_t e = hipLaunchCooperativeKernel((const void*)mk_fwd, dim3(grid), dim3(NT), args, LDS_BYTES, stream);
    if (e != hipSuccess) fprintf(stderr, "cooperative launch failed: %s (grid %d)\n", hipGetErrorString(e), grid);
}
```

```cpp
#include <hip/hip_runtime.h>
#include <hip/hip_cooperative_groups.h>
#include <cstdio>
#include <cstdint>
namespace cg = cooperative_groups;
namespace pg8 {
#define PG8_LAS __attribute__((address_space(3)))
typedef unsigned short bf16_t;
typedef short bf16x8 __attribute__((ext_vector_type(8)));
typedef float f32x4 __attribute__((ext_vector_type(4)));
typedef unsigned u32x4 __attribute__((ext_vector_type(4)));
typedef unsigned u32x2 __attribute__((ext_vector_type(2)));
typedef int i32x4 __attribute__((ext_vector_type(4)));
constexpr int BM = 256, BK = 64, HALF = 128, HTB = HALF * BK * 2  , STAGE_BYTES = 8 * HTB, NXCD = 8, WGM = 8;

__host__ __device__ __forceinline__ int lds_byte(int r, int c) { const int st = (r >> 4) * 2 + (c >> 5), rr = r & 15, cc = c & 31, ob = rr * 64 + cc * 2; return st * 1024 + (ob ^ (((ob >> 9) & 1) << 5)); }
__host__ __device__ __forceinline__ void stage_rc(int b, int& R, int& C) { const int st = b / 1024, sb = b % 1024, swz = sb ^ (((sb >> 9) & 1) << 5); R = (st >> 1) * 16 + swz / 64; C = (st & 1) * 32 + (swz % 64) / 2; }
__host__ __device__ __forceinline__ int perm32(int rho) { const int n = rho >> 4, i = rho & 15; return 8 * (i >> 2) + 4 * n + (i & 3); }

struct Unit { int pm, pn; };
struct Gemm { const bf16_t* A; const bf16_t* Bt; int M, N, K; };

struct StaticOrder {
    int nM, nN, nwg, G, c;
    __host__ __device__ void init(int M, int N, int G_, int c_) { nM = M / BM; nN = N / BM; nwg = nM * nN; G = G_; c = c_; }
    __host__ __device__ bool next(int i, Unit& u) const {
        const long L = (long)i * G + c; if (L >= nwg) return false;
        int wgid = (int)L; { const int q = nwg / NXCD, r = nwg % NXCD, xcd = wgid % NXCD, off = wgid / NXCD; wgid = (xcd < r ? xcd * (q + 1) : r * (q + 1) + (xcd - r) * q) + off; }
        const int nig = WGM * nN, gid = wgid / nig, fm = gid * WGM, gsz = (nM - fm) < WGM ? (nM - fm) : WGM;
        u.pm = fm + ((wgid % nig) % gsz); u.pn = (wgid % nig) / gsz; return true;
    }
};

__device__ __forceinline__ unsigned cvt_pk_bf16(float lo, float hi) { unsigned r; asm volatile("v_cvt_pk_bf16_f32 %0, %1, %2" : "=v"(r) : "v"(lo), "v"(hi)); return r; }

template <class Epi, class Sched, bool ALIGN_EPI = false, bool I8 = false>
__device__ __forceinline__ void gemm_phase(PG8_LAS unsigned char* lds, const Gemm g, const Sched& S, const Epi& E, int wid) {
    int lane_; asm volatile("v_mbcnt_lo_u32_b32 %0, -1, 0\n\tv_mbcnt_hi_u32_b32 %0, -1, %0" : "=v"(lane_));
    const int lane = lane_, tid = wid * 64 + lane, wr = wid >> 2, wc = wid & 3, fr = lane & 15, fq = lane >> 4;
    const int K = g.K, nt = K / BK;
    unsigned voffA[2], voffB[2];
#pragma unroll
    for (int i = 0; i < 2; ++i) { int R, C; stage_rc(tid * 16 + i * 8192, R, C); const int Rb = Epi::PERM ? ((R & ~31) + perm32(R & 31)) : R;
        voffA[i] = (unsigned)(R * K + C) * 2u; voffB[i] = (unsigned)(Rb * K + C) * 2u; }
    const size_t kstep = (size_t)(BK * 2);
    const size_t hstep = (size_t)HALF * K * 2;
    const size_t tstep = 2 * hstep;
    const unsigned ldsw = (unsigned)wid * 1024u;
    const int aoff = lds_byte(wr * 64 + fr, fq * 8), boff = lds_byte(wc * 32 + fr, fq * 8);
#define PG8_SA(b, h) (((b) * 2 + (h)) * HTB)
#define PG8_SB(b, h) ((4 + (b) * 2 + (h)) * HTB)
#define PG8_STAGE(bufoff, gbase, voff) do { _Pragma("unroll") for (int _i = 0; _i < 2; ++_i) \
        __builtin_amdgcn_global_load_lds((const unsigned*)((const char*)(gbase) + (voff)[_i]), (PG8_LAS unsigned*)(lds + (bufoff) + ldsw + _i * 8192), 16, 0, 0); } while (0)
#define PG8_LDA(dst, b, h) do { _Pragma("unroll") for (int m = 0; m < 4; ++m) _Pragma("unroll") for (int k = 0; k < 2; ++k) dst[m][k] = *(const PG8_LAS bf16x8*)(lds + PG8_SA(b, h) + aoff + m * 2048 + k * 1024); } while (0)
#define PG8_LDB(dst, b, h) do { _Pragma("unroll") for (int n = 0; n < 2; ++n) _Pragma("unroll") for (int k = 0; k < 2; ++k) dst[n][k] = *(const PG8_LAS bf16x8*)(lds + PG8_SB(b, h) + boff + n * 2048 + k * 1024); } while (0)
#define PG8_MMA(ai, bj, At, Bt) do { __builtin_amdgcn_s_setprio(1); _Pragma("unroll") for (int m = 0; m < 4; ++m) _Pragma("unroll") for (int n = 0; n < 2; ++n) _Pragma("unroll") for (int k = 0; k < 2; ++k) \
        { if constexpr (I8) acc[ai][bj][m][n] = __builtin_bit_cast(f32x4, __builtin_amdgcn_mfma_i32_16x16x64_i8(__builtin_bit_cast(i32x4, Bt[n][k]), __builtin_bit_cast(i32x4, At[m][k]), __builtin_bit_cast(i32x4, acc[ai][bj][m][n]), 0, 0, 0)); \
          else acc[ai][bj][m][n] = __builtin_amdgcn_mfma_f32_16x16x32_bf16(Bt[n][k], At[m][k], acc[ai][bj][m][n], 0, 0, 0); } __builtin_amdgcn_s_setprio(0); } while (0)
#define PG8_WAIT_V(n) asm volatile("s_waitcnt vmcnt(" #n ")" ::: "memory")
#define PG8_WAIT_L(n) asm volatile("s_waitcnt lgkmcnt(" #n ")" ::: "memory")
#define PG8_BAR __builtin_amdgcn_s_barrier()
#define PG8_SCHED __builtin_amdgcn_sched_barrier(0)
    Unit cur, nxt; int ui = 0;
    if (!S.next(0, cur)) return;
    f32x4 acc[2][2][4][2];
#pragma unroll
    for (int a = 0; a < 2; ++a)
#pragma unroll
        for (int b = 0; b < 2; ++b)
#pragma unroll
            for (int m = 0; m < 4; ++m)
#pragma unroll
                for (int n = 0; n < 2; ++n) acc[a][b][m][n] = (f32x4){0.f, 0.f, 0.f, 0.f};
    bf16x8 At[4][2], B0[2][2], B1[2][2];
    const char* cA = (const char*)g.A + (size_t)cur.pm * tstep; const char* cB = (const char*)g.Bt + (size_t)cur.pn * tstep;
    PG8_STAGE(PG8_SB(0, 0), cB, voffB); PG8_STAGE(PG8_SB(0, 1), cB + hstep, voffB); PG8_STAGE(PG8_SA(0, 0), cA, voffA); PG8_STAGE(PG8_SA(0, 1), cA + hstep, voffA);
    if (wr == 1) PG8_BAR;
    PG8_WAIT_V(2); PG8_BAR;
    PG8_STAGE(PG8_SB(1, 0), cB + kstep, voffB); PG8_STAGE(PG8_SA(1, 0), cA + kstep, voffA); PG8_STAGE(PG8_SB(1, 1), cB + hstep + kstep, voffB);
    PG8_WAIT_V(6); PG8_BAR;
    for (;;) {
        const bool has_next = S.next(ui + 1, nxt);
        const char* nA = has_next ? (const char*)g.A + (size_t)nxt.pm * tstep : cA; const char* nB = has_next ? (const char*)g.Bt + (size_t)nxt.pn * tstep : cB;
        const int seglen = Epi::HOOK ? 8 : nt;
        for (int t0 = 0; t0 < nt; t0 += seglen) {
        if constexpr (Epi::HOOK) { if (t0 > 0) E.hook(acc, cur, t0 >> 3, wr, wc, fr, fq); }
        for (int t = t0; t < t0 + seglen; t += 2) {
            const bool last = (t == nt - 2);
            const char* a1 = cA + (size_t)(t + 1) * kstep;
            const char* a2 = last ? nA : cA + (size_t)(t + 2) * kstep; const char* b2 = last ? nB : cB + (size_t)(t + 2) * kstep;
            const char* a3 = a2 + kstep; const char* b3 = b2 + kstep;
            PG8_LDB(B0, 0, 0); PG8_LDB(B1, 0, 1); PG8_SCHED; PG8_LDA(At, 0, 0); PG8_STAGE(PG8_SA(1, 1), a1 + hstep, voffA);
            PG8_WAIT_V(8); PG8_WAIT_L(0); PG8_BAR; PG8_MMA(0, 0, At, B0); PG8_MMA(0, 1, At, B1); PG8_BAR; PG8_SCHED;
            PG8_LDA(At, 0, 1); PG8_STAGE(PG8_SB(0, 0), b2, voffB); PG8_STAGE(PG8_SB(0, 1), b2 + hstep, voffB); PG8_STAGE(PG8_SA(0, 0), a2, voffA);
            PG8_WAIT_V(8); PG8_WAIT_L(0); PG8_BAR; PG8_MMA(1, 0, At, B0); PG8_MMA(1, 1, At, B1); PG8_BAR; PG8_SCHED;
            PG8_LDB(B0, 1, 0); PG8_LDB(B1, 1, 1); PG8_SCHED; PG8_LDA(At, 1, 0); PG8_STAGE(PG8_SA(0, 1), a2 + hstep, voffA);
            PG8_WAIT_V(8); PG8_WAIT_L(0); PG8_BAR; PG8_MMA(0, 0, At, B0); PG8_MMA(0, 1, At, B1); PG8_BAR; PG8_SCHED;
            PG8_LDA(At, 1, 1); PG8_STAGE(PG8_SB(1, 0), b3, voffB); PG8_STAGE(PG8_SB(1, 1), b3 + hstep, voffB); PG8_STAGE(PG8_SA(1, 0), a3, voffA);
            PG8_WAIT_V(8); PG8_WAIT_L(0); PG8_BAR; PG8_MMA(1, 0, At, B0); PG8_MMA(1, 1, At, B1); PG8_BAR; PG8_SCHED;
        }
        }
        if constexpr (ALIGN_EPI) { if (wr == 0) PG8_BAR; }
        E(acc, cur, wr, wc, fr, fq);
        if (!has_next) break;
#pragma unroll
        for (int a = 0; a < 2; ++a)
#pragma unroll
            for (int b = 0; b < 2; ++b)
#pragma unroll
                for (int m = 0; m < 4; ++m)
#pragma unroll
                    for (int n = 0; n < 2; ++n) acc[a][b][m][n] = (f32x4){0.f, 0.f, 0.f, 0.f};
        cur = nxt; cA = nA; cB = nB; ++ui;
        if constexpr (ALIGN_EPI) { if (wr == 1) PG8_BAR; }
    }
    PG8_WAIT_V(0);
    if constexpr (!ALIGN_EPI) { if (wr == 0) PG8_BAR; }
    PG8_BAR;
#undef PG8_SA
#undef PG8_SB
#undef PG8_STAGE
#undef PG8_LDA
#undef PG8_LDB
#undef PG8_MMA
#undef PG8_WAIT_V
#undef PG8_WAIT_L
#undef PG8_BAR
#undef PG8_SCHED
}
}
#ifndef PROBE
#define PROBE 0
#endif
#ifndef PROBE11_THR
#define PROBE11_THR 1000000u
#endif
constexpr int NWAVES = 8, NT = NWAVES * 64;
constexpr int M = 8192, D = 2048, SEQ = 2048, NBATCH = 4, DEPTH = 2;
constexpr int INW = 13316, NPROJ = 13312, MIXW = 512, HD = 128;
constexpr int PEER_E = 16384;
constexpr float EPS = 1e-6f;
constexpr float ATT_SCALE = 0.08838834764831845f;

constexpr size_t MiB = 1u << 20;
constexpr size_t WS_CTL = 0, CTL_ZERO_BYTES = 1 * MiB;
constexpr size_t WS_SSQ = 0;
constexpr size_t WS_SSA = 256 * 1024;
constexpr size_t WS_WF = 1 * MiB;
constexpr size_t WS_BINR = WS_WF + 64 * 1024;
constexpr size_t WS_LOGF = 2 * MiB;
constexpr size_t WS_CUM = 3 * MiB;
constexpr size_t WS_WIN = 8 * MiB;
constexpr size_t WIN_BYTES = (size_t)NPROJ * D;
constexpr size_t WS_SW = 7 * MiB;
constexpr size_t WS_CMAX = 384 * 1024;
constexpr size_t WS_HB8 = 64 * MiB;
constexpr size_t WS_SA = 7 * MiB + 512 * 1024;
constexpr size_t WS_WBR = 112 * MiB, WS_WOUT = 128 * MiB, WS_WQ = 144 * MiB;
constexpr size_t SQ_BYTES = (size_t)D * D * 2;
constexpr size_t WS_PU = 160 * MiB, WS_PV = 288 * MiB;
constexpr size_t PE_BYTES = (size_t)PEER_E * D;
constexpr size_t WS_PK = 6 * MiB;
constexpr size_t WS_SU = 5 * MiB, WS_SV = 5 * MiB + 256 * 1024;
constexpr size_t WS_H = 416 * MiB;
constexpr size_t WS_HB = 480 * MiB;
constexpr size_t WS_PROJ = 512 * MiB;
constexpr size_t PROJ_T = (size_t)M * MIXW;
constexpr size_t WS_R = 592 * MiB;
constexpr size_t R_PLANE = (size_t)M * D;
constexpr size_t WS_Y = 720 * MiB;
constexpr size_t WS_MRG = 752 * MiB;
constexpr size_t WS_Q = 784 * MiB;
constexpr size_t WS_END = 816 * MiB;

constexpr int RING_BYTES = 131072;
constexpr int LDS_BYTES = 147456;

typedef unsigned short bf16;
typedef unsigned v4u __attribute__((ext_vector_type(4)));
typedef unsigned v2u __attribute__((ext_vector_type(2)));
typedef float f32x4 __attribute__((ext_vector_type(4)));
typedef float f32x2 __attribute__((ext_vector_type(2)));
using bf16x2 = __attribute__((ext_vector_type(2))) __bf16;
#define LAS __attribute__((address_space(3)))

__device__ __forceinline__ unsigned f2bf(float f) { unsigned u = __builtin_bit_cast(unsigned, f); return (u + 0x7fffu + ((u >> 16) & 1u)) >> 16; }
__device__ __forceinline__ unsigned pk2(float lo, float hi) { return f2bf(lo) | (f2bf(hi) << 16); }
__device__ __forceinline__ float bflo(unsigned w) { return __builtin_bit_cast(float, w << 16); }
__device__ __forceinline__ float bfhi(unsigned w) { return __builtin_bit_cast(float, w & 0xffff0000u); }
__device__ __forceinline__ float bf2f(bf16 b) { return __builtin_bit_cast(float, ((unsigned)b) << 16); }
__device__ __forceinline__ float shf(float v, int src) { return __builtin_bit_cast(float, __builtin_amdgcn_ds_bpermute(src << 2, __builtin_bit_cast(int, v))); }
__device__ __forceinline__ int shi(int v, int src) { return __builtin_amdgcn_ds_bpermute(src << 2, v); }
__device__ __forceinline__ float wave_sum(float v, int lane) {
#pragma unroll
    for (int o = 1; o < 64; o <<= 1) v += shf(v, lane ^ o);
    return v;
}
__device__ __forceinline__ float wave_max(float v, int lane) {
#pragma unroll
    for (int o = 1; o < 64; o <<= 1) v = fmaxf(v, shf(v, lane ^ o));
    return v;
}
__device__ __forceinline__ float ssa_to_f(unsigned long long v) { return (float)((double)v * (1.0 / 4294967296.0)); }
__device__ __forceinline__ float dot2_bf16(unsigned w, unsigned x, float acc) { return __builtin_amdgcn_fdot2_f32_bf16(__builtin_bit_cast(bf16x2, w), __builtin_bit_cast(bf16x2, x), acc, false); }

#define LANE_ID(x) asm volatile("v_mbcnt_lo_u32_b32 %0, -1, 0\n\tv_mbcnt_hi_u32_b32 %0, -1, %0" : "=v"(x))
struct Args {
    const float *x, *norm_mix, *w_in, *b_in, *pool_w, *pool_scale, *conv_w, *rel_bias, *w_branch, *w_out, *norm_ffn, *peer_wq, *peer_keys, *peer_u, *peer_v, *norm_final;
    float* out; unsigned char* ws;
};
#define GAS __attribute__((address_space(1)))
#define CAS __attribute__((address_space(4)))
struct ArgsK {
    const GAS float *x, *norm_mix, *w_in, *b_in, *pool_w, *pool_scale, *conv_w, *rel_bias, *w_branch, *w_out, *norm_ffn, *peer_wq, *peer_keys, *peer_u, *peer_v, *norm_final;
    GAS float* out; GAS unsigned char* ws;
};
__device__ __forceinline__ Args load_args(const CAS ArgsK* k, size_t zoff) {
    Args a;
    a.x = (const float*)k->x; a.norm_mix = (const float*)k->norm_mix; a.w_in = (const float*)k->w_in; a.b_in = (const float*)k->b_in; a.pool_w = (const float*)k->pool_w;
    a.pool_scale = (const float*)k->pool_scale; a.conv_w = (const float*)k->conv_w; a.rel_bias = (const float*)k->rel_bias; a.w_branch = (const float*)k->w_branch;
    a.w_out = (const float*)k->w_out; a.norm_ffn = (const float*)k->norm_ffn; a.peer_wq = (const float*)k->peer_wq; a.peer_keys = (const float*)k->peer_keys;
    a.peer_u = (const float*)k->peer_u; a.peer_v = (const float*)k->peer_v; a.norm_final = (const float*)k->norm_final; a.out = (float*)k->out; a.ws = (unsigned char*)(k->ws + zoff);
    return a;
}

using pg8::f32x4; using pg8::Unit;
struct EpiProj {
    static constexpr bool PERM = true, HOOK = false;
    bf16* P; bf16* R; const float* bias; const unsigned long long* ssq; const float* sa; const float* sw;
    __device__ __forceinline__ void operator()(f32x4 (&acc)[2][2][4][2], const Unit& u, int wr, int wc, int fr, int fq) const {
        const int row0 = u.pm * 256 + wr * 64 + fr, cl0 = wc * 32 + 8 * fq, bcol0 = u.pn * 256 + cl0;
        f32x4 bv[2][2], wv[2][2];
#pragma unroll
        for (int bj = 0; bj < 2; ++bj)
#pragma unroll
            for (int n = 0; n < 2; ++n) { bv[bj][n] = *(const f32x4*)(bias + bcol0 + bj * 128 + 4 * n); wv[bj][n] = *(const f32x4*)(sw + bcol0 + bj * 128 + 4 * n); }
#define ACCF(ai, bj, m, n) (sa ? __builtin_convertvector(__builtin_bit_cast(pg8::i32x4, acc[ai][bj][m][n]), f32x4) : acc[ai][bj][m][n])
        if (u.pn < 20) {
            bf16* base = P + (size_t)(u.pn >> 1) * PROJ_T + (u.pn & 1) * 256 + cl0;
#pragma unroll
            for (int ai = 0; ai < 2; ++ai)
#pragma unroll
                for (int m = 0; m < 4; ++m) { const int row = row0 + ai * 128 + m * 16; const float rs = rsqrtf(ssa_to_f(ssq[row]) * (1.0f / D) + EPS) * (sa ? sa[row] : 1.0f);
                    bf16* rowp = base + (size_t)row * MIXW;
#pragma unroll
                    for (int bj = 0; bj < 2; ++bj) { const f32x4 v0 = ACCF(ai, bj, m, 0) * rs * (sa ? wv[bj][0] : (f32x4){1.f, 1.f, 1.f, 1.f}) + bv[bj][0], v1 = ACCF(ai, bj, m, 1) * rs * (sa ? wv[bj][1] : (f32x4){1.f, 1.f, 1.f, 1.f}) + bv[bj][1];
                        pg8::u32x4 w; w.x = pg8::cvt_pk_bf16(v0[0], v0[1]); w.y = pg8::cvt_pk_bf16(v0[2], v0[3]); w.z = pg8::cvt_pk_bf16(v1[0], v1[1]); w.w = pg8::cvt_pk_bf16(v1[2], v1[3]);
                        *(pg8::u32x4*)(rowp + bj * 128) = w; } }
        } else {
            const int d0 = 64 * (u.pn - 20) + 16 * wc + 4 * fq;
#pragma unroll
            for (int ai = 0; ai < 2; ++ai)
#pragma unroll
                for (int m = 0; m < 4; ++m) { const int row = row0 + ai * 128 + m * 16; const float rs = rsqrtf(ssa_to_f(ssq[row]) * (1.0f / D) + EPS) * (sa ? sa[row] : 1.0f);
                    float r[4][4]; const f32x4 af[4] = {ACCF(ai, 0, m, 0), ACCF(ai, 0, m, 1), ACCF(ai, 1, m, 0), ACCF(ai, 1, m, 1)};
#pragma unroll
                    for (int j = 0; j < 4; ++j) { float e[4], ie[4];
#pragma unroll
                        for (int g = 0; g < 4; ++g) { const float z = (sa ? af[g][j] * wv[g >> 1][g & 1][j] : acc[ai][g >> 1][m][g & 1][j]) * rs + bv[g >> 1][g & 1][j];
                            e[g] = fminf(1.0f + __builtin_amdgcn_exp2f(-1.4426950408889634f * z), 1e18f); ie[g] = __builtin_amdgcn_rcpf(e[g]); }
                        r[0][j] = e[1] * ie[0]; r[1][j] = e[2] * ie[1]; r[2][j] = e[3] * ie[2]; r[3][j] = ie[3]; }
#pragma unroll
                    for (int g = 0; g < 4; ++g) { pg8::u32x2 w; w.x = pg8::cvt_pk_bf16(r[g][0], r[g][1]); w.y = pg8::cvt_pk_bf16(r[g][2], r[g][3]);
                        *(pg8::u32x2*)(R + (size_t)g * R_PLANE + (size_t)row * D + d0) = w; } }
        }
    }
};
#undef ACCF
struct EpiCmp {
    static constexpr bool PERM = true, HOOK = false;
    const bf16* P; const float* bias; const unsigned long long* ssq; const float* sa; const float* sw; unsigned* cnt; const bf16* Rg;
    __device__ __forceinline__ void operator()(f32x4 (&acc)[2][2][4][2], const Unit& u, int wr, int wc, int fr, int fq) const {
        const int row0 = u.pm * 256 + wr * 64 + fr, cl0 = wc * 32 + 8 * fq, bcol0 = u.pn * 256 + cl0;
        if (u.pn >= 20) {
            const int d0 = 64 * (u.pn - 20) + 16 * wc + 4 * fq; unsigned bad = 0;
#pragma unroll
            for (int ai = 0; ai < 2; ++ai)
#pragma unroll
                for (int m = 0; m < 4; ++m) { const int row = row0 + ai * 128 + m * 16; const float rs = rsqrtf(ssa_to_f(ssq[row]) * (1.0f / D) + EPS) * sa[row];
#pragma unroll
                    for (int j = 0; j < 4; ++j) { const int col = bcol0 + 1 * 128 + 4 * 1 + j; const float z = __builtin_convertvector(__builtin_bit_cast(pg8::i32x4, acc[ai][1][m][1]), f32x4)[j] * rs * sw[col] + bias[col];
                        const float g3 = 1.0f / (1.0f + __expf(-z)); const float ref = bf2f(Rg[3 * R_PLANE + (size_t)row * D + d0 + j]); if (fabsf(g3 - ref) > 0.05f) ++bad; } }
            if (bad) atomicAdd(cnt, bad);
            return; }
        const bf16* base = P + (size_t)(u.pn >> 1) * PROJ_T + (u.pn & 1) * 256 + cl0; unsigned bad = 0;
#pragma unroll
        for (int ai = 0; ai < 2; ++ai)
#pragma unroll
            for (int m = 0; m < 4; ++m) { const int row = row0 + ai * 128 + m * 16; const float rs = rsqrtf(ssa_to_f(ssq[row]) * (1.0f / D) + EPS) * sa[row];
#pragma unroll
                for (int bj = 0; bj < 2; ++bj)
#pragma unroll
                    for (int n = 0; n < 2; ++n)
#pragma unroll
                        for (int j = 0; j < 4; ++j) { const int col = bcol0 + bj * 128 + 4 * n + j; const float v = __builtin_convertvector(__builtin_bit_cast(pg8::i32x4, acc[ai][bj][m][n]), f32x4)[j] * rs * sw[col] + bias[col];
                            const float ref = bf2f(base[(size_t)row * MIXW + bj * 128 + 4 * n + j]); if (fabsf(v - ref) > 0.1f * fabsf(ref) + 0.05f) ++bad; } }
        if (bad) atomicAdd(cnt, bad);
    }
};
struct EpiMerge {
    static constexpr bool PERM = true, HOOK = true;
    const bf16* R; bf16* O;
    template <int NB  >
    __device__ __forceinline__ void scale(f32x4 (&acc)[2][2][4][2], const Unit& u, int plane, int wr, int wc, int fr, int fq) const {
        const __amdgpu_buffer_rsrc_t rs = __builtin_amdgcn_make_buffer_rsrc((void*)(R + (size_t)plane * R_PLANE), 0, 0x7fffffff, 0x00020000);
        int voff = (fr * D + 8 * fq) * 2; asm volatile("" : "+v"(voff));
        const int sbase = ((u.pm * 256 + wr * 64) * D + u.pn * 256 + wc * 32) * 2;
#pragma unroll
        for (int b0 = 0; b0 < 8; b0 += NB) {
            pg8::u32x4 w[NB][2];
#pragma unroll
            for (int i = 0; i < NB; ++i)
#pragma unroll
                for (int bj = 0; bj < 2; ++bj) { const int ai = (b0 + i) >> 2, m = (b0 + i) & 3;
                    w[i][bj] = __builtin_amdgcn_raw_buffer_load_b128(rs, voff + bj * 256, sbase + (ai * 128 + m * 16) * D * 2, 0); }
#pragma unroll
            for (int i = 0; i < NB; ++i)
#pragma unroll
                for (int bj = 0; bj < 2; ++bj) { const int ai = (b0 + i) >> 2, m = (b0 + i) & 3; const pg8::u32x4 v = w[i][bj];
                    acc[ai][bj][m][0] *= (f32x4){bflo(v.x), bfhi(v.x), bflo(v.y), bfhi(v.y)};
                    acc[ai][bj][m][1] *= (f32x4){bflo(v.z), bfhi(v.z), bflo(v.w), bfhi(v.w)};
                    asm volatile("" : "+v"(acc[ai][bj][m][0]), "+v"(acc[ai][bj][m][1])); }
            asm volatile("" ::: "memory"); }
    }
    __device__ __forceinline__ void hook(f32x4 (&acc)[2][2][4][2], const Unit& u, int g, int wr, int wc, int fr, int fq) const { scale<4>(acc, u, g - 1, wr, wc, fr, fq); }
    __device__ __forceinline__ void operator()(f32x4 (&acc)[2][2][4][2], const Unit& u, int wr, int wc, int fr, int fq) const {
        scale<4>(acc, u, 3, wr, wc, fr, fq);
        const int row0 = u.pm * 256 + wr * 64 + fr, col0 = u.pn * 256 + wc * 32 + 8 * fq;
#pragma unroll
        for (int ai = 0; ai < 2; ++ai)
#pragma unroll
            for (int m = 0; m < 4; ++m) { bf16* rowp = O + (size_t)(row0 + ai * 128 + m * 16) * D + col0;
#pragma unroll
                for (int bj = 0; bj < 2; ++bj) { const f32x4 v0 = acc[ai][bj][m][0], v1 = acc[ai][bj][m][1];
                    pg8::u32x4 w; w.x = pg8::cvt_pk_bf16(v0[0], v0[1]); w.y = pg8::cvt_pk_bf16(v0[2], v0[3]); w.z = pg8::cvt_pk_bf16(v1[0], v1[1]); w.w = pg8::cvt_pk_bf16(v1[2], v1[3]);
                    *(pg8::u32x4*)(rowp + bj * 128) = w; } }
    }
};
struct EpiRes {
    static constexpr bool PERM = false, HOOK = false;
    float* H; bf16* HB; unsigned long long* ssa;
    __device__ __forceinline__ void operator()(f32x4 (&acc)[2][2][4][2], const Unit& u, int wr, int wc, int fr, int fq) const {
        const int row0 = u.pm * 256 + wr * 64 + fr, col0 = u.pn * 256 + wc * 32 + 4 * fq;
#pragma unroll
        for (int ai = 0; ai < 2; ++ai)
#pragma unroll
            for (int m = 0; m < 4; ++m) { const int row = row0 + ai * 128 + m * 16; const size_t off = (size_t)row * D + col0; float s = 0.f;
#pragma unroll
                for (int bj = 0; bj < 2; ++bj)
#pragma unroll
                    for (int n = 0; n < 2; ++n) { const size_t o = off + bj * 128 + n * 16; const f32x4 h = *(const f32x4*)(H + o) + acc[ai][bj][m][n];
                        *(f32x4*)(H + o) = h; pg8::u32x2 w; w.x = pg8::cvt_pk_bf16(h[0], h[1]); w.y = pg8::cvt_pk_bf16(h[2], h[3]); *(pg8::u32x2*)(HB + o) = w;
                        s += (h[0] * h[0] + h[1] * h[1]) + (h[2] * h[2] + h[3] * h[3]); }
                { const int ln = fq * 16 + fr; s += shf(s, ln ^ 16); s += shf(s, ln ^ 32); }
                if (fq == 0) atomicAdd(ssa + row, (unsigned long long)((double)s * 4294967296.0)); }
    }
};
struct EpiQ {
    static constexpr bool PERM = true, HOOK = false;
    bf16* O; const unsigned long long* ssa;
    __device__ __forceinline__ void operator()(f32x4 (&acc)[2][2][4][2], const Unit& u, int wr, int wc, int fr, int fq) const {
        const int row0 = u.pm * 256 + wr * 64 + fr, col0 = u.pn * 256 + wc * 32 + 8 * fq;
#pragma unroll
        for (int ai = 0; ai < 2; ++ai)
#pragma unroll
            for (int m = 0; m < 4; ++m) { const int row = row0 + ai * 128 + m * 16; const float rs = rsqrtf(ssa_to_f(ssa[row]) * (1.0f / D) + EPS);
                bf16* rowp = O + (size_t)row * D + col0;
#pragma unroll
                for (int bj = 0; bj < 2; ++bj) { const f32x4 v0 = acc[ai][bj][m][0] * rs, v1 = acc[ai][bj][m][1] * rs;
                    pg8::u32x4 w; w.x = pg8::cvt_pk_bf16(v0[0], v0[1]); w.y = pg8::cvt_pk_bf16(v0[2], v0[3]); w.z = pg8::cvt_pk_bf16(v1[0], v1[1]); w.w = pg8::cvt_pk_bf16(v1[2], v1[3]);
                    *(pg8::u32x4*)(rowp + bj * 128) = w; } }
    }
};

__device__ __forceinline__ int colmap_in(int j) {
    if (j < 1536) return j;
    if (j < 5120) return j + 4;
    const int c = (j - 5120) & 255, T = (j - 5120) >> 8;
    const int g = 2 * (c >> 7) + ((c >> 2) & 1), d = 64 * T + 16 * ((c >> 5) & 3) + 4 * ((c >> 3) & 3) + (c & 3);
    return 5124 + g * 2048 + d;
}
__device__ __forceinline__ void tr_item_i8(const float* W, const float* gain, const unsigned* cmax, unsigned char* WT, LAS float* scr, int k0, int n0, int lane) {
    const int q = lane & 7, r8 = lane >> 3, sc = colmap_in(n0 + 4 * q);
    f32x4 v[8];
#pragma unroll
    for (int i = 0; i < 8; ++i) v[i] = *(const f32x4*)(W + (size_t)(k0 + 8 * i + r8) * INW + sc);
    f32x4 inv;
#pragma unroll
    for (int e = 0; e < 4; ++e) { const float cm = __builtin_bit_cast(float, cmax[sc + e]); inv[e] = cm > 0.f ? 127.0f / cm : 0.f; }
#pragma unroll
    for (int i = 0; i < 8; ++i) { const float g = gain[k0 + 8 * i + r8];
#pragma unroll
        for (int e = 0; e < 4; ++e) scr[(8 * i + r8) * 33 + 4 * q + e] = v[i][e] * g * inv[e]; }
    asm volatile("s_waitcnt lgkmcnt(0)" ::: "memory");
    const int n = lane >> 1, hf = lane & 1;
    v4u o[2];
#pragma unroll
    for (int w = 0; w < 8; ++w) { unsigned pk = 0;
#pragma unroll
        for (int b = 0; b < 4; ++b) pk |= ((unsigned)((int)rintf(scr[(32 * hf + 4 * w + b) * 33 + n]) & 255)) << (8 * b);
        o[w >> 2][w & 3] = pk; }
    unsigned char* dst = WT + (size_t)(n0 + n) * D + k0 + 32 * hf;
    *(v4u*)dst = o[0]; *(v4u*)(dst + 16) = o[1];
    asm volatile("s_waitcnt lgkmcnt(0)" ::: "memory");
}
template <bool MAP>
__device__ __forceinline__ void tr_item(const float* W, int ldw, const float* scale, bf16* WT, int ldt, int dcol0, LAS float* scr, int k0, int n0, int lane) {
    const int q = lane & 7, r8 = lane >> 3, sc = MAP ? colmap_in(n0 + 4 * q) : (n0 + 4 * q);
    f32x4 v[8];
#pragma unroll
    for (int i = 0; i < 8; ++i) v[i] = *(const f32x4*)(W + (size_t)(k0 + 8 * i + r8) * ldw + sc);
    f32x4 s0 = {1.f, 1.f, 1.f, 1.f}, s1 = s0;
    if (scale) { s0 = *(const f32x4*)(scale + k0 + 8 * q); s1 = *(const f32x4*)(scale + k0 + 8 * q + 4); }
#pragma unroll
    for (int i = 0; i < 8; ++i)
#pragma unroll
        for (int e = 0; e < 4; ++e) scr[(8 * i + r8) * 33 + 4 * q + e] = v[i][e];
    asm volatile("s_waitcnt lgkmcnt(0)" ::: "memory");
    const int c = q;
#pragma unroll
    for (int j = 0; j < 4; ++j) { const int n = r8 + 8 * j; const LAS float* s = scr + (8 * c) * 33 + n;
        v4u o; o.x = pk2(s[0 * 33] * s0[0], s[1 * 33] * s0[1]); o.y = pk2(s[2 * 33] * s0[2], s[3 * 33] * s0[3]); o.z = pk2(s[4 * 33] * s1[0], s[5 * 33] * s1[1]); o.w = pk2(s[6 * 33] * s1[2], s[7 * 33] * s1[3]);
        *(v4u*)(WT + (size_t)(n0 + n) * ldt + dcol0 + k0 + 8 * c) = o; }
    asm volatile("s_waitcnt lgkmcnt(0)" ::: "memory");
}
constexpr size_t WS_BAR = 512 * 1024;
#define XB_TMO      128
#define XB_XCNT(j)  (256  + 64 * (j))
#define XB_XSUB(j)  (1280 + 64 * (j))
#define XB_XGEN(j)  (2304 + 64 * (j))
#define XB_TOP      3328
#define XB_TOPGEN   3392
#define XCD_BAR_WORDS 3456
#define XB_SPIN_CAP (1u << 23)
__device__ __forceinline__ unsigned xb_ld(unsigned* p)              { return __hip_atomic_load(p, __ATOMIC_RELAXED, __HIP_MEMORY_SCOPE_AGENT); }
__device__ __forceinline__ unsigned xb_add(unsigned* p, unsigned v) { return __hip_atomic_fetch_add(p, v, __ATOMIC_RELAXED, __HIP_MEMORY_SCOPE_AGENT); }
__device__ __forceinline__ unsigned xb_xcc_id() { return (unsigned)__builtin_amdgcn_s_getreg((3 << 11) | 20) & 0xFu; }
#define XB_SPIN(cond, bar) do { unsigned _sp = 0; while (cond) { __builtin_amdgcn_s_sleep(1); \
    if ((++_sp & 255u) == 0u) { if (xb_ld(&(bar)[XB_TMO])) break; if (_sp > XB_SPIN_CAP) { atomicAdd(&(bar)[XB_TMO], 1u); break; } } } } while (0)
__device__ __forceinline__ void xcd_barrier_complete(unsigned* bar, unsigned x, unsigned G, unsigned& nloc, unsigned& nx) {
    unsigned sum, cnt, mine, sp = 0u;
    for (;;) {
        sum = 0u; cnt = 0u; mine = 0u;
#pragma unroll
        for (unsigned j = 0; j < 16; ++j) { const unsigned c = xb_ld(&bar[XB_XCNT(j)]); sum += c; cnt += (c > 0u) ? 1u : 0u; mine = (j == x) ? c : mine; }
        if (sum == G) break;
        __builtin_amdgcn_s_sleep(1);
        if ((++sp & 255u) == 0u) { if (xb_ld(&bar[XB_TMO])) break; if (sp > XB_SPIN_CAP) { atomicAdd(&bar[XB_TMO], 1u); break; } }
    }
    nloc = mine > 0u ? mine : 1u; nx = cnt > 0u ? cnt : 1u;
}
__device__ __forceinline__ void xcd_barrier(unsigned* bar, unsigned x, unsigned G, volatile LAS unsigned* st, int wave) {
    asm volatile("s_waitcnt vmcnt(0)" ::: "memory");
    __syncthreads();
    int lane; asm volatile("v_mbcnt_lo_u32_b32 %0, -1, 0\n\tv_mbcnt_hi_u32_b32 %0, -1, %0" : "=v"(lane));
    if (wave == 0 && lane == 0) {
        __builtin_amdgcn_s_waitcnt(0);
        unsigned nloc = st[0], nx = st[1];
        if (nloc == 0u) { xcd_barrier_complete(bar, x, G, nloc, nx); st[0] = nloc; st[1] = nx; }
        const unsigned old = xb_add(&bar[XB_XSUB(x)], 1u);
        const unsigned gen = old / nloc;
        if (old + 1u == (gen + 1u) * nloc) {
            __builtin_amdgcn_fence(__ATOMIC_RELEASE, "agent");
            asm volatile("s_waitcnt vmcnt(0)" ::: "memory");
            const unsigned og = xb_add(&bar[XB_TOP], 1u);
            const unsigned tg = og / nx;
            if (og + 1u == (tg + 1u) * nx) xb_add(&bar[XB_TOPGEN], 1u);
            else XB_SPIN(xb_ld(&bar[XB_TOPGEN]) == tg, bar);
            __builtin_amdgcn_fence(__ATOMIC_ACQUIRE, "agent");
            xb_add(&bar[XB_XGEN(x)], 1u);
            asm volatile("s_waitcnt vmcnt(0)" ::: "memory");
        } else {
            XB_SPIN(xb_ld(&bar[XB_XGEN(x)]) == gen, bar);
            __builtin_amdgcn_fence(__ATOMIC_ACQUIRE, "agent");
            asm volatile("s_waitcnt vmcnt(0)" ::: "memory");
        }
    }
    __syncthreads();
}
namespace att {
constexpr int D = 128, NW = 8, QBLK = 32, KVBLK = 64, QB = NW * QBLK;
constexpr int PITCH = 512, OPITCH = 2048;
constexpr float SCALE = 0.08838834764831845f, THR = 8.f;
constexpr int SHM_V = KVBLK * D * 2, SHM_K = KVBLK * D * 2;
constexpr int OFF_WS = 2 * SHM_V + 2 * SHM_K, OFF_CUM = OFF_WS + NW * 64 * 4, OFF_REL = OFF_CUM + 2048 * 4, LDS_END = OFF_REL + 320 * 4;
typedef unsigned short bf16;
typedef short bf16x8 __attribute__((ext_vector_type(8)));
typedef short s16x4 __attribute__((ext_vector_type(4)));
typedef float f32x16 __attribute__((ext_vector_type(16)));
typedef float f32x4 __attribute__((ext_vector_type(4)));
typedef unsigned u32x4 __attribute__((ext_vector_type(4)));
#define ALDS __attribute__((address_space(3)))

#define KSWZ(row, colB) ((row) * 256 + ((colB) ^ (((row) & 7) << 4)))
#define SBAR() __builtin_amdgcn_sched_barrier(0)
__device__ __forceinline__ int v_st(int k, int c) { const int kk = (k & ~0xC) | ((k & 4) << 1) | ((k & 8) >> 1); return ((kk >> 3) * 4 + (c >> 5)) * 512 + ((kk & 7) * 32 + (c & 31)) * 2; }
__device__ __forceinline__ int v_rd_base(int lane) { return ((lane & 3) << 3) | (((lane >> 2) & 3) << 6) | (((lane >> 4) & 1) << 5) | (((lane >> 5) & 1) << 8); }
constexpr int v_rd_off(int d0, int ks, int half) { return d0 * 512 + ks * 4096 + half * 2048; }
__device__ __forceinline__ int crow(int r, int hi) { return (r & 3) + 8 * (r >> 2) + 4 * hi; }
__device__ __forceinline__ unsigned cvtpk(float lo, float hi) { unsigned r; asm volatile("v_cvt_pk_bf16_f32 %0, %1, %2" : "=v"(r) : "v"(lo), "v"(hi)); return r; }
__device__ __forceinline__ bf16x8 load8(const bf16* p) { return *reinterpret_cast<const bf16x8*>(p); }

__device__ __forceinline__ void mask_tile(f32x16& p0, f32x16& p1, int dq) {
    const float NEG = -__builtin_inff();
#pragma unroll
    for (int r = 0; r < 16; ++r) { const int c = (r & 3) + 8 * (r >> 2);
        if (dq - c < 0) p0[r] = NEG;
        if (dq - c - 32 < 0) p1[r] = NEG; }
}
__device__ __forceinline__ void partialSM(f32x16& p0, f32x16& p1, float& m_reg, float& mn, float& alpha) {
    float pmax = p0[0];
#pragma unroll
    for (int r = 1; r < 16; ++r) pmax = fmaxf(pmax, p0[r]);
#pragma unroll
    for (int r = 0; r < 16; ++r) pmax = fmaxf(pmax, p1[r]);
    { auto rr = __builtin_amdgcn_permlane32_swap(__float_as_uint(pmax), __float_as_uint(pmax), false, false);
      pmax = fmaxf(__uint_as_float(rr[0]), __uint_as_float(rr[1])); }
    constexpr float C2 = 1.4426950408889634f * SCALE;
    if (__builtin_expect(__all((pmax - m_reg) * SCALE <= THR), 1)) { mn = m_reg; alpha = 1.f; }
    else { mn = fmaxf(m_reg, pmax); alpha = __builtin_amdgcn_exp2f((m_reg - mn) * C2); m_reg = mn; }
    const float mnL = -mn * C2;
#pragma unroll
    for (int r = 0; r < 16; ++r) p0[r] = fmaf(p0[r], C2, mnL);
#pragma unroll
    for (int r = 0; r < 16; ++r) p1[r] = fmaf(p1[r], C2, mnL);
#pragma unroll
    for (int r = 0; r < 16; ++r) p0[r] = __builtin_amdgcn_exp2f(p0[r]);
}
__device__ __forceinline__ void finishSM(f32x16& p0, f32x16& p1, float alpha, float& l_reg, bf16x8& pa0, bf16x8& pa1, bf16x8& pa2, bf16x8& pa3) {
#pragma unroll
    for (int r = 0; r < 16; ++r) p1[r] = __builtin_amdgcn_exp2f(p1[r]);
    float ps = 0;
#pragma unroll
    for (int r = 0; r < 16; ++r) ps += p0[r];
#pragma unroll
    for (int r = 0; r < 16; ++r) ps += p1[r];
    { auto rr = __builtin_amdgcn_permlane32_swap(__float_as_uint(ps), __float_as_uint(ps), false, false);
      ps = __uint_as_float(rr[0]) + __uint_as_float(rr[1]); }
    l_reg = l_reg * alpha + ps;
#define PK4(P, B_, OUT) do { unsigned a0 = cvtpk(P[B_+0], P[B_+1]), a1 = cvtpk(P[B_+2], P[B_+3]);                          \
        unsigned b0 = cvtpk(P[B_+4], P[B_+5]), b1 = cvtpk(P[B_+6], P[B_+7]);                                             \
        auto r0 = __builtin_amdgcn_permlane32_swap(a0, b0, false, false); auto r1 = __builtin_amdgcn_permlane32_swap(a1, b1, false, false); \
        u32x4 w = {r0[0], r1[0], r0[1], r1[1]}; OUT = *reinterpret_cast<bf16x8*>(&w); } while (0)
    PK4(p0, 0, pa0); PK4(p0, 8, pa1); PK4(p1, 0, pa2); PK4(p1, 8, pa3);
#undef PK4
}
template <int KB>
__device__ __forceinline__ void qkt(f32x16& p0, f32x16& p1, const ALDS char* K_lds, int r32, int hi, const bf16x8* qr, bool act) {
    if (!act) { const float NEG = -__builtin_inff();
#pragma unroll
        for (int r = 0; r < 16; ++r) { p0[r] = NEG; p1[r] = NEG; } return; }
    p0 = f32x16{}; p1 = f32x16{};
    const ALDS char* kb[4];
#pragma unroll
    for (int dd = 0; dd < 4; ++dd) kb[dd] = K_lds + KB * SHM_K + KSWZ(r32, (dd * 16 + hi * 8) * 2);
#pragma unroll
    for (int d0 = 0; d0 < 8; ++d0) { const ALDS char* a = kb[d0 & 3] + (d0 >> 2) * 128;
        bf16x8 b0 = *(const ALDS bf16x8*)(a);
        bf16x8 b1 = *(const ALDS bf16x8*)(a + 32 * 256);
        p0 = __builtin_amdgcn_mfma_f32_32x32x16_bf16(b0, qr[d0], p0, 0, 0, 0);
        p1 = __builtin_amdgcn_mfma_f32_32x32x16_bf16(b1, qr[d0], p1, 0, 0, 0); }
}
template <int VB>
__device__ __forceinline__ void pv_tile(f32x16* o, int vb0, bf16x8 pa0, bf16x8 pa1, bf16x8 pa2, bf16x8 pa3, bool act) {
    if (!act) return;
#define TRRD(dst, off) asm volatile("ds_read_b64_tr_b16 %0, %1 offset:%2" : "=&v"(dst) : "v"(vb0), "i"(off) : "memory")
#define PV_D0(d0) do { s16x4 l0, l1, l2, l3, h0, h1, h2, h3; constexpr int b_ = VB * SHM_V + v_rd_off(d0, 0, 0); \
        TRRD(l0, b_); TRRD(h0, b_ + 2048); TRRD(l1, b_ + 4096); TRRD(h1, b_ + 6144); TRRD(l2, b_ + 8192); TRRD(h2, b_ + 10240); TRRD(l3, b_ + 12288); TRRD(h3, b_ + 14336); \
        asm volatile("s_waitcnt lgkmcnt(0)" ::: "memory"); SBAR(); \
        o[d0] = __builtin_amdgcn_mfma_f32_32x32x16_bf16(pa0, (bf16x8){l0[0], l0[1], l0[2], l0[3], h0[0], h0[1], h0[2], h0[3]}, o[d0], 0, 0, 0);   \
        o[d0] = __builtin_amdgcn_mfma_f32_32x32x16_bf16(pa1, (bf16x8){l1[0], l1[1], l1[2], l1[3], h1[0], h1[1], h1[2], h1[3]}, o[d0], 0, 0, 0);   \
        o[d0] = __builtin_amdgcn_mfma_f32_32x32x16_bf16(pa2, (bf16x8){l2[0], l2[1], l2[2], l2[3], h2[0], h2[1], h2[2], h2[3]}, o[d0], 0, 0, 0);   \
        o[d0] = __builtin_amdgcn_mfma_f32_32x32x16_bf16(pa3, (bf16x8){l3[0], l3[1], l3[2], l3[3], h3[0], h3[1], h3[2], h3[3]}, o[d0], 0, 0, 0); } while (0)
    PV_D0(0); PV_D0(1); PV_D0(2); PV_D0(3);
#undef PV_D0
#undef TRRD
}
template <int MODE>
__device__ __forceinline__ void bias_mask(f32x16& p0, f32x16& p1, const ALDS char* lds, int kb, int qlo, int qpos, int hi, float cqs, bool act) {
    if (!act) return;
    if (MODE == 0) {
        const ALDS float* cs = (const ALDS float*)(lds + OFF_CUM) + kb + 4 * hi;
#pragma unroll
        for (int g = 0; g < 4; ++g) { const f32x4 c0 = *(const ALDS f32x4*)(cs + 8 * g), c1 = *(const ALDS f32x4*)(cs + 32 + 8 * g);
#pragma unroll
            for (int e = 0; e < 4; ++e) { p0[4 * g + e] += cqs - c0[e]; p1[4 * g + e] += cqs - c1[e]; } }
        if (kb + KVBLK - 1 > qlo) mask_tile(p0, p1, qpos - 4 * hi - kb);
    } else {
        const ALDS float* tb = (const ALDS float*)(lds + OFF_REL);
        if (qlo - (kb + KVBLK - 1) >= 256) { const float c = tb[319];
#pragma unroll
            for (int r = 0; r < 16; ++r) { p0[r] += c; p1[r] += c; } }
        else { const int d0 = qpos - kb - 4 * hi + 63;
#pragma unroll
            for (int r = 0; r < 16; ++r) { const int c = (r & 3) + 8 * (r >> 2);
                int i0 = d0 - c, i1 = d0 - c - 32; i0 = i0 > 319 ? 319 : i0; i1 = i1 > 319 ? 319 : i1; i1 = i1 < 0 ? 0 : i1; i0 = i0 < 0 ? 0 : i0;
                p0[r] += tb[i0]; p1[r] += tb[i1]; } }
    }
}

struct Seam { bf16x8 qr[8]; bf16x8 st_v0, st_v1, st_k0, st_k1; };
#define VMW() asm volatile("s_waitcnt vmcnt(0)" ::: "memory")
#define BL8(rs, vo, so) __builtin_bit_cast(bf16x8, __builtin_amdgcn_raw_buffer_load_b128(rs, vo, so, 0))
#define SLOAD_H(Kp, Vp, k0) do { S.st_v0 = BL8(rP, kvoff, (Vp) + (k0) * (PITCH * 2)); S.st_v1 = BL8(rP, kvoff, (Vp) + ((k0) + 32) * (PITCH * 2));              \
                         S.st_k0 = BL8(rP, kvoff, (Kp) + (k0) * (PITCH * 2)); S.st_k1 = BL8(rP, kvoff, (Kp) + ((k0) + 32) * (PITCH * 2)); } while (0)
#define SWRITE_HK(bf) do { *(ALDS bf16x8*)(K_lds + (bf) * SHM_K + kws) = S.st_k0; *(ALDS bf16x8*)(K_lds + (bf) * SHM_K + kws + 32 * 256) = S.st_k1; } while (0)
#define SWRITE_HV(bf) do { *(ALDS bf16x8*)(V_lds + (bf) * SHM_V + vst0) = S.st_v0; *(ALDS bf16x8*)(V_lds + (bf) * SHM_V + vst1) = S.st_v1; } while (0)
#define SWRITE_H(bf) do { SWRITE_HV(bf); SWRITE_HK(bf); } while (0)

template <int MODE>
__device__ __forceinline__ void attn_unit(const bf16* Pb, int Qo, int Kh, int Vh, bf16* Yb, int Oo, int P0, int j_lo, int j_hi, ALDS char* lds, int wid, int lane) {
    const int tid = wid * 64 + lane, r32 = lane & 31, hi = lane >> 5;
    const int NT = j_hi - j_lo;
    const int qlo = P0 + wid * QBLK, qpos = qlo + r32;
    ALDS char* V_lds = lds; ALDS char* K_lds = lds + 2 * SHM_V;
    ALDS float* ws = (ALDS float*)(lds + OFF_WS) + wid * 64; ALDS float* li_l = ws; ALDS float* al_l = ws + 32;
    float m_reg = -1e30f, l_reg = 0; f32x16 o[4] = {};
    const int sr = tid >> 4, sc = (tid & 15) * 8, vst0 = v_st(sr, sc), vst1 = v_st(32 + sr, sc), kws = KSWZ(sr, sc * 2);
    const int vb0 = (int)(unsigned)(size_t)V_lds + v_rd_base(lane);
    Seam S;
    const __amdgpu_buffer_rsrc_t rP = __builtin_amdgcn_make_buffer_rsrc((void*)Pb, 0, 0x7fffffff, 0x00020000);
    const __amdgpu_buffer_rsrc_t rO = __builtin_amdgcn_make_buffer_rsrc((void*)Yb, 0, 0x7fffffff, 0x00020000);
    const int kvoff = (sr * PITCH + sc) * 2;
#define KBASE(t) ((j_lo + (t)) * KVBLK)
#define ACT(t) (MODE == 0 ? (KBASE(t) <= qlo + QBLK - 1) : ((j_lo + (t)) <= (qlo >> 6) && (j_lo + (t)) + 8 >= (qlo >> 6)))
#define RESC(a) do { if (__any((a) < 1.f)) { if (hi == 0) al_l[r32] = (a); asm volatile("s_waitcnt lgkmcnt(0)" ::: "memory");              \
                     for (int d_ = 0; d_ < 4; ++d_) for (int r = 0; r < 16; ++r) o[d_][r] *= al_l[crow(r, hi)]; } } while (0)
#define MASKT(P0_, P1_, t) bias_mask<MODE>(P0_, P1_, lds, KBASE(t), qlo, qpos, hi, cq_, ACT(t))
    {
        const int kb0 = j_lo * KVBLK;
#pragma unroll
        for (int d0 = 0; d0 < 8; ++d0) S.qr[d0] = BL8(rP, (r32 * PITCH + hi * 8) * 2 + d0 * 32, Qo + wid * (QBLK * PITCH * 2));
        SLOAD_H(Kh, Vh, kb0); VMW(); SWRITE_HK(0);
        __syncthreads();
    }
    const float cq_ = MODE == 0 ? ((const ALDS float*)(lds + OFF_CUM))[qpos] : 0.f;
    f32x16 pA0, pA1, pB0, pB1; float mnA, mnB, alA, alB; bf16x8 pa0, pa1, pa2, pa3;
    SWRITE_HV(0); SBAR();
    if (NT > 1) { SLOAD_H(Kh, Vh, KBASE(1)); }
    SBAR(); qkt<0>(pA0, pA1, K_lds, r32, hi, S.qr, ACT(0));
    MASKT(pA0, pA1, 0); partialSM(pA0, pA1, m_reg, mnA, alA);
    if (NT > 1) { VMW(); SWRITE_H(1); }
    __syncthreads();
#define HALF_STEP(PX0, PX1, mnX, alX, PY0, PY1, alY, t, KB, VB, SB) do {                                                      \
        SBAR(); qkt<KB>(PX0, PX1, K_lds, r32, hi, S.qr, ACT(t));                                                              \
        finishSM(PY0, PY1, alY, l_reg, pa0, pa1, pa2, pa3); SBAR();                                                           \
        if ((t) + 1 < NT) { SLOAD_H(Kh, Vh, KBASE((t) + 1)); SBAR(); }                                                        \
        pv_tile<VB>(o, vb0, pa0, pa1, pa2, pa3, ACT((t) - 1)); MASKT(PX0, PX1, (t)); partialSM(PX0, PX1, m_reg, mnX, alX);    \
        __syncthreads();                                                                                                      \
        if ((t) + 1 < NT) { VMW(); SWRITE_H(SB); }                                                                            \
        RESC(alX); __syncthreads(); } while (0)
    for (int t = 1; t + 1 < NT; t += 2) {
        HALF_STEP(pB0, pB1, mnB, alB, pA0, pA1, alA, t, 1, 0, 0);
        HALF_STEP(pA0, pA1, mnA, alA, pB0, pB1, alB, t + 1, 0, 1, 1);
    }
    const bool even = (NT & 1) == 0;
    if (even) { SBAR(); qkt<1>(pB0, pB1, K_lds, r32, hi, S.qr, ACT(NT - 1)); SBAR(); }
    finishSM(pA0, pA1, alA, l_reg, pa0, pa1, pa2, pa3); SBAR();
    pv_tile<0>(o, vb0, pa0, pa1, pa2, pa3, ACT(even ? NT - 2 : NT - 1));
    if (even) { MASKT(pB0, pB1, NT - 1); partialSM(pB0, pB1, m_reg, mnB, alB); __syncthreads(); RESC(alB);
        finishSM(pB0, pB1, alB, l_reg, pa0, pa1, pa2, pa3); SBAR(); pv_tile<1>(o, vb0, pa0, pa1, pa2, pa3, ACT(NT - 1)); }
    SBAR();
    if (hi == 0) li_l[r32] = l_reg; asm volatile("s_waitcnt lgkmcnt(0)" ::: "memory");
    float rli[16];
#pragma unroll
    for (int r = 0; r < 16; ++r) rli[r] = __builtin_amdgcn_rcpf(li_l[crow(r, hi)]);
    const int ovoff = (4 * hi * OPITCH + r32) * 2, osoff = Oo + wid * (QBLK * OPITCH * 2);
#pragma unroll
    for (int r = 0; r < 16; ++r) { const int orow = (r & 3) + 8 * (r >> 2);
#pragma unroll
        for (int d0 = 0; d0 < 4; ++d0) { const float v = o[d0][r] * rli[r];
            const float vn = __builtin_bit_cast(float, __builtin_amdgcn_ds_bpermute((lane ^ 1) << 2, __builtin_bit_cast(int, v)));
            if ((r32 & 1) == 0) __builtin_amdgcn_raw_buffer_store_b32(cvtpk(v, vn), rO, ovoff + d0 * 64, osoff + orow * (OPITCH * 2), 0); } }
    __syncthreads();
#undef RESC
#undef KBASE
#undef ACT
#undef MASKT
#undef HALF_STEP
}
#undef BL8
#undef VMW
#undef SLOAD_H
#undef SWRITE_HK
#undef SWRITE_HV
#undef SWRITE_H
#undef KSWZ
#undef SBAR
}
constexpr size_t WS_QCTR = 768 * 1024;
constexpr size_t WS_POOLW = 4 * MiB;
constexpr int N_ATT_UNITS = 256, N_POOL_UNITS = 512, N_CONV_UNITS = 128;

__device__ __forceinline__ void stage_cum(const Args& a, int b, int h, LAS char* lds, int wave, int lane) {
    const float* logf = (const float*)(a.ws + WS_LOGF) + ((size_t)b * SEQ) * 4 + h;
    const int tid = wave * 64 + lane;
    float v[4];
#pragma unroll
    for (int e = 0; e < 4; ++e) v[e] = logf[(size_t)(4 * tid + e) * 4];
    v[1] += v[0]; v[2] += v[1]; v[3] += v[2];
    float incl = v[3];
#pragma unroll
    for (int o = 1; o < 64; o <<= 1) { const float t = shf(incl, lane >= o ? lane - o : lane); if (lane >= o) incl += t; }
    LAS float* wt = (LAS float*)(lds + att::OFF_WS);
    if (lane == 63) wt[wave] = incl;
    __syncthreads();
    float base = incl - v[3];
    for (int w = 0; w < wave; ++w) base += wt[w];
    LAS float* cs = (LAS float*)(lds + att::OFF_CUM);
    const float inv = 1.0f / ATT_SCALE;
    *(LAS f32x4*)(cs + 4 * tid) = (f32x4){(base + v[0]) * inv, (base + v[1]) * inv, (base + v[2]) * inv, (base + v[3]) * inv};
    __syncthreads();
}
__device__ __forceinline__ void attention_item(const Args& a, int l, int u, LAS char* lds, int wave) {
    int lane; asm volatile("v_mbcnt_lo_u32_b32 %0, -1, 0\n\tv_mbcnt_hi_u32_b32 %0, -1, %0" : "=v"(lane));
    const bf16* P = (const bf16*)(a.ws + WS_PROJ); bf16* Y = (bf16*)(a.ws + WS_Y);
    const int mode = u >> 7, v = u & 127, qb = 7 - (v >> 4), bh = v & 15, b = bh >> 2, h = bh & 3;
    const size_t row0 = (size_t)b * SEQ; const int P0 = qb * 256;
    if (mode == 0) {
        stage_cum(a, b, h, lds, wave, lane);
        att::attn_unit<0>(P, (int)((0 * PROJ_T + (row0 + P0) * MIXW + h * HD) * 2), (int)((1 * PROJ_T + row0 * MIXW + h * HD) * 2), (int)((2 * PROJ_T + row0 * MIXW + h * HD) * 2),
                          Y, (int)(((row0 + P0) * D + h * HD) * 2), P0, 0, 4 * qb + 4, lds, wave, lane);
    } else {
        const int tid = wave * 64 + lane;
        if (tid < 320) ((LAS float*)(lds + att::OFF_REL))[tid] = a.rel_bias[((size_t)l * 4 + h) * 320 + tid] * (1.0f / ATT_SCALE);
        const int jlo = 4 * qb - 8 < 0 ? 0 : 4 * qb - 8;
        att::attn_unit<1>(P, (int)((7 * PROJ_T + (row0 + P0) * MIXW + h * HD) * 2), (int)((8 * PROJ_T + row0 * MIXW + h * HD) * 2), (int)((9 * PROJ_T + row0 * MIXW + h * HD) * 2),
                          Y, (int)(((row0 + P0) * D + 1536 + h * HD) * 2), P0, jlo, 4 * qb + 4, lds, wave, lane);
    }
}
__device__ __forceinline__ void pool_item(const Args& a, int l, int u, LAS char* lds, int wave) {
    int lane; asm volatile("v_mbcnt_lo_u32_b32 %0, -1, 0\n\tv_mbcnt_hi_u32_b32 %0, -1, %0" : "=v"(lane));
    const int g = u & 3, T0 = (u >> 2) * 64, tid = wave * 64 + lane;
    const bf16* Pin = (const bf16*)(a.ws + WS_PROJ) + 3 * PROJ_T + g * 128;
    {
        const int cp = tid & 63, run = tid >> 6, w = 2 << g, t0 = T0 + run * 8, s0 = t0 & (SEQ - 1);
        const bf16* col = Pin + 2 * cp;
        float s_lo = 0.f, s_hi = 0.f;
        for (int j = 1; j < w; ++j) if (s0 - j >= 0) { const unsigned x = *(const unsigned*)(col + (size_t)(t0 - j) * MIXW); s_lo += bflo(x); s_hi += bfhi(x); }
#pragma unroll
        for (int i = 0; i < 8; ++i) { const unsigned x = *(const unsigned*)(col + (size_t)(t0 + i) * MIXW); s_lo += bflo(x); s_hi += bfhi(x);
            const int s = s0 + i; const int cnt = s + 1 < w ? s + 1 : w; const float inv = 1.0f / (float)cnt;
            *(LAS unsigned*)(lds + (run * 8 + i) * 272 + 4 * cp) = pk2(s_lo * inv - bflo(x), s_hi * inv - bfhi(x));
            if (s - w + 1 >= 0) { const unsigned y = *(const unsigned*)(col + (size_t)(t0 + i - w + 1) * MIXW); s_lo -= bflo(y); s_hi -= bfhi(y); } }
    }
    __syncthreads();
    {
        typedef short bf16x8 __attribute__((ext_vector_type(8)));
        const bf16* Wt = (const bf16*)(a.ws + WS_POOLW) + ((size_t)l * 4 + g) * 128 * 128;
        const int rt = (wave & 3) * 16, db = (wave >> 2) * 64, fr = lane & 15, kg = lane >> 4;
        f32x4 acc[4] = {};
#pragma unroll
        for (int ks = 0; ks < 4; ++ks) { const bf16x8 af = *(const LAS bf16x8*)(lds + (rt + fr) * 272 + (ks * 32 + kg * 8) * 2);
#pragma unroll
            for (int nt = 0; nt < 4; ++nt) { const bf16x8 bfr = *(const bf16x8*)(Wt + (size_t)(db + nt * 16 + fr) * 128 + ks * 32 + kg * 8);
                acc[nt] = __builtin_amdgcn_mfma_f32_16x16x32_bf16(bfr, af, acc[nt], 0, 0, 0); } }
        bf16* Y = (bf16*)(a.ws + WS_Y) + (size_t)(T0 + rt + fr) * D + 512 + g * 128;
#pragma unroll
        for (int nt = 0; nt < 4; ++nt) { const int d = db + nt * 16 + kg * 4; const f32x4 sc = *(const f32x4*)(a.pool_scale + l * MIXW + g * 128 + d);
            v2u w; w.x = pk2(acc[nt][0] * sc[0], acc[nt][1] * sc[1]); w.y = pk2(acc[nt][2] * sc[2], acc[nt][3] * sc[3]); *(v2u*)(Y + d) = w; }
    }
    __syncthreads();
}
__device__ __forceinline__ void conv_item(const Args& a, int l, int u, int wave) {
    int lane; asm volatile("v_mbcnt_lo_u32_b32 %0, -1, 0\n\tv_mbcnt_hi_u32_b32 %0, -1, %0" : "=v"(lane));
    const bf16* P = (const bf16*)(a.ws + WS_PROJ); const bf16* Ch = P + 4 * PROJ_T; const bf16* Cb = P + 5 * PROJ_T; const bf16* Cc = P + 6 * PROJ_T;
    const int tid = wave * 64 + lane, c0 = (tid & 63) * 8, t0 = u * 64 + (tid >> 6) * 8, s0 = t0 & (SEQ - 1);
    float wgt[3][8];
#pragma unroll
    for (int j = 0; j < 3; ++j) { const float* w = a.conv_w + ((size_t)l * 3 + j) * MIXW + c0; const f32x4 w0 = *(const f32x4*)w, w1 = *(const f32x4*)(w + 4);
#pragma unroll
        for (int k = 0; k < 4; ++k) { wgt[j][k] = w0[k]; wgt[j][4 + k] = w1[k]; } }
    float z2[8], z1[8];
#pragma unroll
    for (int k = 0; k < 8; ++k) { z2[k] = 0.f; z1[k] = 0.f; }
#pragma unroll
    for (int i = -2; i < 8; ++i) {
        float z[8];
        if (s0 + i >= 0) { const v4u hv = *(const v4u*)(Ch + (size_t)(t0 + i) * MIXW + c0), cv = *(const v4u*)(Cc + (size_t)(t0 + i) * MIXW + c0);
            z[0] = bflo(hv.x) * bflo(cv.x); z[1] = bfhi(hv.x) * bfhi(cv.x); z[2] = bflo(hv.y) * bflo(cv.y); z[3] = bfhi(hv.y) * bfhi(cv.y);
            z[4] = bflo(hv.z) * bflo(cv.z); z[5] = bfhi(hv.z) * bfhi(cv.z); z[6] = bflo(hv.w) * bflo(cv.w); z[7] = bfhi(hv.w) * bfhi(cv.w); }
        else {
#pragma unroll
            for (int k = 0; k < 8; ++k) z[k] = 0.f; }
        if (i >= 0) { const v4u bv = *(const v4u*)(Cb + (size_t)(t0 + i) * MIXW + c0); float o[8];
            const float bb[8] = {bflo(bv.x), bfhi(bv.x), bflo(bv.y), bfhi(bv.y), bflo(bv.z), bfhi(bv.z), bflo(bv.w), bfhi(bv.w)};
#pragma unroll
            for (int k = 0; k < 8; ++k) o[k] = bb[k] * (wgt[0][k] * z2[k] + wgt[1][k] * z1[k] + wgt[2][k] * z[k]);
            v4u ov; ov.x = pk2(o[0], o[1]); ov.y = pk2(o[2], o[3]); ov.z = pk2(o[4], o[5]); ov.w = pk2(o[6], o[7]);
            *(v4u*)((bf16*)(a.ws + WS_Y) + (size_t)(t0 + i) * D + 1024 + c0) = ov; }
#pragma unroll
        for (int k = 0; k < 8; ++k) { z2[k] = z1[k]; z1[k] = z[k]; }
    }
}
__device__ __forceinline__ void mixers_fast(const Args& a, int lq, LAS char* lds, int wave, int lane, int G, int blk) {
    const int l = lq & 1;
    for (int u = blk; u < N_ATT_UNITS; u += G) attention_item(a, l, u, lds, wave);
    unsigned* head = (unsigned*)(a.ws + WS_QCTR) + 64 * lq;
    volatile LAS unsigned* slot = (volatile LAS unsigned*)(lds + att::LDS_END);
    for (;;) {
        if (wave == 0 && lane == 0) *slot = __hip_atomic_fetch_add(head, 1u, __ATOMIC_RELAXED, __HIP_MEMORY_SCOPE_AGENT);
        __syncthreads();
        const unsigned it = *slot;
        __syncthreads();
        if (it >= (unsigned)(N_POOL_UNITS + N_CONV_UNITS)) break;
        if (it < (unsigned)N_POOL_UNITS) pool_item(a, l, (int)it, lds, wave); else conv_item(a, l, (int)it - N_POOL_UNITS, wave);
    }
}
__device__ __forceinline__ void p0_prologue(const Args& a, LAS unsigned char* lds, int gw, int NGW, int wave, int lane) {
    unsigned char* ws = a.ws;
    LAS float* scr = (LAS float*)(lds + wave * 16384);
    constexpr int I_SQ = (D / 64) * (D / 32), I_BR = (MIXW / 64) * (D / 32);
    constexpr int I_LAYER = 4 * I_BR + 2 * I_SQ;
    for (int it = gw; it < DEPTH * I_LAYER; it += NGW) {
        const int l = it / I_LAYER; int r = it - l * I_LAYER;
        if (r < 4 * I_BR) { const int g = r / I_BR, rr = r % I_BR, kb = rr / (D / 32), nb = rr % (D / 32);
            tr_item<false>(a.w_branch + ((size_t)l * 4 + g) * MIXW * D, D, nullptr, (bf16*)(ws + WS_WBR + l * SQ_BYTES), D, g * MIXW, scr, 64 * kb, 32 * nb, lane); continue; }
        r -= 4 * I_BR;
        if (r < I_SQ) { const int kb = r / (D / 32), nb = r % (D / 32);
            tr_item<false>(a.w_out + (size_t)l * D * D, D, nullptr, (bf16*)(ws + WS_WOUT + l * SQ_BYTES), D, 0, scr, 64 * kb, 32 * nb, lane); continue; }
        r -= I_SQ;
        { const int kb = r / (D / 32), nb = r % (D / 32);
            tr_item<false>(a.peer_wq + (size_t)l * D * D, D, a.norm_ffn + l * D, (bf16*)(ws + WS_WQ + l * SQ_BYTES), D, 0, scr, 64 * kb, 32 * nb, lane); }
    }
    if (PROBE == 10 || PROBE == 11) { constexpr int I_WIN = (D / 64) * (NPROJ / 32);
        for (int it = gw; it < DEPTH * I_WIN; it += NGW) { const int l = it / I_WIN, r = it % I_WIN, kb = r / (NPROJ / 32), nb = r % (NPROJ / 32);
            tr_item<true>(a.w_in + (size_t)l * D * INW, INW, a.norm_mix + l * D, (bf16*)(ws + 896 * MiB + (size_t)l * NPROJ * D * 2), D, 0, scr, 64 * kb, 32 * nb, lane); } }
    {
        constexpr int NCC = (INW + 255) / 256;
        for (int it = gw; it < DEPTH * 32 * NCC; it += NGW) { const int l = it / (32 * NCC), r = it % (32 * NCC), kc = r / NCC, cc = r % NCC; const int c0 = cc * 256 + 4 * lane;
            if (c0 + 3 < INW) { const float* W = a.w_in + (size_t)l * D * INW + (size_t)(kc * 64) * INW + c0; const float* g = a.norm_mix + l * D + kc * 64;
                float m0 = 0.f, m1 = 0.f, m2 = 0.f, m3 = 0.f;
#pragma unroll 8
                for (int k = 0; k < 64; ++k) { const f32x4 w = *(const f32x4*)(W + (size_t)k * INW); const float gk = fabsf(g[k]);
                    m0 = fmaxf(m0, fabsf(w[0]) * gk); m1 = fmaxf(m1, fabsf(w[1]) * gk); m2 = fmaxf(m2, fabsf(w[2]) * gk); m3 = fmaxf(m3, fabsf(w[3]) * gk); }
                unsigned* cm = (unsigned*)(ws + WS_CMAX) + l * INW + c0;
                const unsigned u0 = __float_as_uint(m0), u1 = __float_as_uint(m1), u2 = __float_as_uint(m2), u3 = __float_as_uint(m3);
                __hip_atomic_fetch_max(cm + 0, u0, __ATOMIC_RELAXED, __HIP_MEMORY_SCOPE_AGENT); __hip_atomic_fetch_max(cm + 1, u1, __ATOMIC_RELAXED, __HIP_MEMORY_SCOPE_AGENT);
                __hip_atomic_fetch_max(cm + 2, u2, __ATOMIC_RELAXED, __HIP_MEMORY_SCOPE_AGENT); __hip_atomic_fetch_max(cm + 3, u3, __ATOMIC_RELAXED, __HIP_MEMORY_SCOPE_AGENT); } }
    }
    for (int it = gw; it < DEPTH * 4 * 8; it += NGW) { const int lg = it >> 3, r = it & 7;
        tr_item<false>(a.pool_w + (size_t)lg * 128 * 128, 128, nullptr, (bf16*)(ws + WS_POOLW) + (size_t)lg * 128 * 128, 128, 0, scr, 64 * (r >> 2), 32 * (r & 3), lane); }
    {
        constexpr int NR = 2 * DEPTH * PEER_E;
        f32x4 nv[8];
        if (gw < NR) { const int t = gw / (DEPTH * PEER_E), row = gw - t * (DEPTH * PEER_E); const float* src = (t ? a.peer_v : a.peer_u) + (size_t)row * D + 4 * lane;
#pragma unroll
            for (int j = 0; j < 8; ++j) nv[j] = *(const f32x4*)(src + 256 * j); }
        for (int r = gw; r < NR; r += NGW) { const int t = r / (DEPTH * PEER_E), row = r - t * (DEPTH * PEER_E);
            f32x4 v[8]; float am = 0.f;
#pragma unroll
            for (int j = 0; j < 8; ++j) v[j] = nv[j];
            { const int r2 = r + NGW; if (r2 < NR) { const int t2 = r2 / (DEPTH * PEER_E), row2 = r2 - t2 * (DEPTH * PEER_E); const float* src = (t2 ? a.peer_v : a.peer_u) + (size_t)row2 * D + 4 * lane;
#pragma unroll
                for (int j = 0; j < 8; ++j) nv[j] = *(const f32x4*)(src + 256 * j); } }
#pragma unroll
            for (int j = 0; j < 8; ++j) am = fmaxf(am, fmaxf(fmaxf(fabsf(v[j][0]), fabsf(v[j][1])), fmaxf(fabsf(v[j][2]), fabsf(v[j][3]))));
            am = wave_max(am, lane);
            const float inv = am > 0.f ? 127.0f / am : 0.f, off = 0.f;
            unsigned char* dst = ws + (t ? WS_PV : WS_PU) + (size_t)row * D + 4 * lane;
#pragma unroll
            for (int j = 0; j < 8; ++j) { const int q0 = (int)(rintf(v[j][0] * inv) + off), q1 = (int)(rintf(v[j][1] * inv) + off), q2 = (int)(rintf(v[j][2] * inv) + off), q3 = (int)(rintf(v[j][3] * inv) + off);
                *(unsigned*)(dst + 256 * j) = (unsigned)(q0 & 255) | ((unsigned)(q1 & 255) << 8) | ((unsigned)(q2 & 255) << 16) | ((unsigned)(q3 & 255) << 24); }
            if (lane == 0) ((float*)(ws + (t ? WS_SV : WS_SU)))[row] = am * (1.0f / 127.0f); }
    }
    { bf16* pk = (bf16*)(ws + WS_PK); const size_t n8 = (size_t)DEPTH * 8 * 2 * 128 * 128 / 8;
      for (size_t i = (size_t)gw * 64 + lane; i < n8; i += (size_t)NGW * 64) { const f32x4 v0 = *(const f32x4*)(a.peer_keys + i * 8), v1 = *(const f32x4*)(a.peer_keys + i * 8 + 4);
          v4u o; o.x = pk2(v0[0], v0[1]); o.y = pk2(v0[2], v0[3]); o.z = pk2(v1[0], v1[1]); o.w = pk2(v1[2], v1[3]); *(v4u*)(pk + i * 8) = o; } }
    {
        float* wf = (float*)(ws + WS_WF); float* binr = (float*)(ws + WS_BINR);
        const int gt = gw * 64 + lane, NGT = NGW * 64;
        for (int i = gt; i < DEPTH * 4 * D; i += NGT) { const int l = i / (4 * D), h = (i / D) & 3, k = i % D; wf[i] = a.w_in[(size_t)l * D * INW + (size_t)k * INW + 1536 + h] * a.norm_mix[l * D + k]; }
        for (int i = gt; i < DEPTH * NPROJ; i += NGT) { const int l = i / NPROJ, j = i % NPROJ; binr[i] = a.b_in[l * INW + colmap_in(j)]; }
    }
    {
        float* H = (float*)(ws + WS_H); bf16* HB = (bf16*)(ws + WS_HB); unsigned long long* ssq = (unsigned long long*)(ws + WS_SSQ);
        for (int m = gw; m < M; m += NGW) { float s = 0.f, am = 0.f; f32x4 v[8];
#pragma unroll
            for (int j = 0; j < 8; ++j) { const size_t o = (size_t)m * D + j * 256 + lane * 4; v[j] = *(const f32x4*)(a.x + o); *(f32x4*)(H + o) = v[j];
                v2u w; w.x = pk2(v[j][0], v[j][1]); w.y = pk2(v[j][2], v[j][3]); *(v2u*)(HB + o) = w; s += (v[j][0] * v[j][0] + v[j][1] * v[j][1]) + (v[j][2] * v[j][2] + v[j][3] * v[j][3]);
                am = fmaxf(am, fmaxf(fmaxf(fabsf(v[j][0]), fabsf(v[j][1])), fmaxf(fabsf(v[j][2]), fabsf(v[j][3])))); }
            s = wave_sum(s, lane); am = wave_max(am, lane); if (lane == 0) { ssq[m] = (unsigned long long)((double)s * 4294967296.0); ((float*)(ws + WS_SA))[m] = am * (1.0f / 127.0f); }
            const float inv = am > 0.f ? 127.0f / am : 0.f; unsigned char* q8 = ws + WS_HB8 + (size_t)m * D + 4 * lane;
#pragma unroll
            for (int j = 0; j < 8; ++j) *(unsigned*)(q8 + 256 * j) = ((unsigned)((int)rintf(v[j][0] * inv) & 255)) | ((unsigned)((int)rintf(v[j][1] * inv) & 255) << 8) | ((unsigned)((int)rintf(v[j][2] * inv) & 255) << 16) | ((unsigned)((int)rintf(v[j][3] * inv) & 255) << 24); }
    }
}
__device__ __forceinline__ void p0_win_i8(const Args& a, LAS unsigned char* lds, int gw, int NGW, int wave, int lane) {
    unsigned char* ws = a.ws; LAS float* scr = (LAS float*)(lds + wave * 16384);
    constexpr int I_WIN = (D / 64) * (NPROJ / 32);
    for (int it = gw; it < DEPTH * I_WIN; it += NGW) { const int l = it / I_WIN, r = it % I_WIN, kb = r / (NPROJ / 32), nb = r % (NPROJ / 32);
        tr_item_i8(a.w_in + (size_t)l * D * INW, a.norm_mix + l * D, (const unsigned*)(ws + WS_CMAX) + l * INW, ws + WS_WIN + l * WIN_BYTES, scr, 64 * kb, 32 * nb, lane); }
    float* sw = (float*)(ws + WS_SW); const int gt = gw * 64 + lane, NGT = NGW * 64;
    for (int i = gt; i < DEPTH * NPROJ; i += NGT) { const int l = i / NPROJ, j = i % NPROJ; sw[i] = __builtin_bit_cast(float, ((const unsigned*)(ws + WS_CMAX))[l * INW + colmap_in(j)]) * (1.0f / 127.0f); }
}
__device__ __forceinline__ void quant_rows(const Args& a, int gw, int NGW, int lane) {
    unsigned char* ws = a.ws; const float* H = (const float*)(ws + WS_H);
    for (int m = gw; m < M; m += NGW) { float am = 0.f; f32x4 v[8];
#pragma unroll
        for (int j = 0; j < 8; ++j) { v[j] = *(const f32x4*)(H + (size_t)m * D + j * 256 + lane * 4); am = fmaxf(am, fmaxf(fmaxf(fabsf(v[j][0]), fabsf(v[j][1])), fmaxf(fabsf(v[j][2]), fabsf(v[j][3])))); }
        am = wave_max(am, lane); if (lane == 0) ((float*)(ws + WS_SA))[m] = am * (1.0f / 127.0f);
        const float inv = am > 0.f ? 127.0f / am : 0.f; unsigned char* q8 = ws + WS_HB8 + (size_t)m * D + 4 * lane;
#pragma unroll
        for (int j = 0; j < 8; ++j) *(unsigned*)(q8 + 256 * j) = ((unsigned)((int)rintf(v[j][0] * inv) & 255)) | ((unsigned)((int)rintf(v[j][1] * inv) & 255) << 8) | ((unsigned)((int)rintf(v[j][2] * inv) & 255) << 16) | ((unsigned)((int)rintf(v[j][3] * inv) & 255) << 24); }
}

__device__ __forceinline__ void forget_logits(const Args& a, int l, int gw, int NGW, int lane) {
    unsigned char* ws = a.ws; const bf16* HB = (const bf16*)(ws + WS_HB); const float* wf = (const float*)(ws + WS_WF) + l * 4 * D; const unsigned long long* ssq = (const unsigned long long*)(ws + WS_SSQ) + l * M;
    float* logf = (float*)(ws + WS_LOGF);
    for (int m = gw; m < M; m += NGW) {
        float d[4] = {0.f, 0.f, 0.f, 0.f};
#pragma unroll
        for (int j = 0; j < 4; ++j) { const int k0 = j * 512 + lane * 8; const v4u xv = *(const v4u*)(HB + (size_t)m * D + k0);
            const float x[8] = {bflo(xv.x), bfhi(xv.x), bflo(xv.y), bfhi(xv.y), bflo(xv.z), bfhi(xv.z), bflo(xv.w), bfhi(xv.w)};
#pragma unroll
            for (int h = 0; h < 4; ++h) { const f32x4 w0 = *(const f32x4*)(wf + h * D + k0), w1 = *(const f32x4*)(wf + h * D + k0 + 4);
                d[h] += x[0] * w0[0] + x[1] * w0[1] + x[2] * w0[2] + x[3] * w0[3] + x[4] * w1[0] + x[5] * w1[1] + x[6] * w1[2] + x[7] * w1[3]; } }
        const float rs = rsqrtf(ssa_to_f(ssq[m]) * (1.0f / D) + EPS);
#pragma unroll
        for (int h = 0; h < 4; ++h) { const float z = wave_sum(d[h], lane) * rs + a.b_in[l * INW + 1536 + h];
            const float ls = fminf(z, 0.f) - log1pf(__expf(-fabsf(z)));
            if (lane == h) logf[m * 4 + h] = ls; }
    }
}
__device__ __forceinline__ void cum_scan(const Args& a, int gw, int lane) {
    if (gw >= 16) return;
    const float* logf = (const float*)(a.ws + WS_LOGF); float* cum = (float*)(a.ws + WS_CUM);
    const int b = gw >> 2, h = gw & 3; float run = 0.f;
    for (int c = 0; c < SEQ / 64; ++c) { float v = logf[(size_t)(b * SEQ + c * 64 + lane) * 4 + h];
#pragma unroll
        for (int o = 1; o < 64; o <<= 1) { const float t = shf(v, lane >= o ? lane - o : lane); if (lane >= o) v += t; }
        v += run; cum[(size_t)gw * SEQ + c * 64 + lane] = v; run = shf(v, 63); }
}

template <int MODE>
__device__ __forceinline__ void naive_attn(const Args& a, int l, int b, int h, int s, LAS float* sc, int lane) {
    const unsigned char* ws = a.ws; const bf16* P = (const bf16*)(ws + WS_PROJ);
    const bf16* Qp = P + (MODE ? 7 : 0) * PROJ_T; const bf16* Kp = P + (MODE ? 8 : 1) * PROJ_T; const bf16* Vp = P + (MODE ? 9 : 2) * PROJ_T;
    const float* cum = (const float*)(ws + WS_CUM) + (size_t)(b * 4 + h) * SEQ;
    const float* rb = a.rel_bias + ((size_t)l * 4 + h) * 320;
    const size_t tb = (size_t)b * SEQ;
    int klo = 0, khi = s;
    if (MODE) { const int c = s >> 6; klo = (c - 8) * 64; if (klo < 0) klo = 0; khi = c * 64 + 63; }
    const bf16* qrow = Qp + (tb + s) * MIXW + h * HD;
    float mx = -3.0e38f;
    for (int kb = klo; kb <= khi; kb += 64) { const int k = kb + lane;
        if (k <= khi) { const bf16* krow = Kp + (tb + k) * MIXW + h * HD; float d = 0.f;
#pragma unroll 4
            for (int c8 = 0; c8 < 16; ++c8) { const v4u qv = *(const v4u*)(qrow + c8 * 8), kv = *(const v4u*)(krow + c8 * 8);
                d = dot2_bf16(qv.x, kv.x, d); d = dot2_bf16(qv.y, kv.y, d); d = dot2_bf16(qv.z, kv.z, d); d = dot2_bf16(qv.w, kv.w, d); }
            float bias;
            if (MODE == 0) bias = cum[s] - cum[k];
            else { int rel = s - k; rel = rel < -63 ? -63 : (rel > 256 ? 256 : rel); bias = rb[rel + 63]; }
            const float lg = d * ATT_SCALE + bias; sc[k - klo] = lg; mx = fmaxf(mx, lg); } }
    mx = wave_max(mx, lane);
    asm volatile("s_waitcnt lgkmcnt(0)" ::: "memory");
    float sum = 0.f;
    for (int kb = klo; kb <= khi; kb += 64) { const int k = kb + lane; if (k <= khi) { const float p = __expf(sc[k - klo] - mx); sc[k - klo] = p; sum += p; } }
    sum = wave_sum(sum, lane);
    asm volatile("s_waitcnt lgkmcnt(0)" ::: "memory");
    float o0 = 0.f, o1 = 0.f;
    for (int k = klo; k <= khi; ++k) { const float p = sc[k - klo]; const unsigned v = *(const unsigned*)(Vp + (tb + k) * MIXW + h * HD + 2 * lane); o0 += p * bflo(v); o1 += p * bfhi(v); }
    const float inv = 1.0f / sum;
    bf16* Y = (bf16*)(a.ws + WS_Y);
    *(unsigned*)(Y + (tb + s) * D + (MODE ? 1536 : 0) + h * HD + 2 * lane) = pk2(o0 * inv, o1 * inv);
    asm volatile("s_waitcnt lgkmcnt(0)" ::: "memory");
}
__device__ __forceinline__ void naive_pool(const Args& a, int l, int t, int g, LAS float* sc, int lane) {
    const bf16* Pin = (const bf16*)(a.ws + WS_PROJ) + 3 * PROJ_T;
    const int s = t & (SEQ - 1), w = 2 << g; const int cnt = (s + 1 < w) ? s + 1 : w;
    float s0 = 0.f, s1 = 0.f;
    for (int j = 0; j < cnt; ++j) { const unsigned v = *(const unsigned*)(Pin + (size_t)(t - j) * MIXW + g * 128 + 2 * lane); s0 += bflo(v); s1 += bfhi(v); }
    const unsigned v0 = *(const unsigned*)(Pin + (size_t)t * MIXW + g * 128 + 2 * lane);
    const float inv = 1.0f / (float)cnt;
    sc[2 * lane] = s0 * inv - bflo(v0); sc[2 * lane + 1] = s1 * inv - bfhi(v0);
    asm volatile("s_waitcnt lgkmcnt(0)" ::: "memory");
    const float* W = a.pool_w + ((size_t)l * 4 + g) * 128 * 128;
    float o0 = 0.f, o1 = 0.f;
    for (int c = 0; c < 128; ++c) { const float p = sc[c]; const f32x2 wv = *(const f32x2*)(W + c * 128 + 2 * lane); o0 += p * wv[0]; o1 += p * wv[1]; }
    const f32x2 ps = *(const f32x2*)(a.pool_scale + l * MIXW + g * 128 + 2 * lane);
    bf16* Y = (bf16*)(a.ws + WS_Y);
    *(unsigned*)(Y + (size_t)t * D + 512 + g * 128 + 2 * lane) = pk2(o0 * ps[0], o1 * ps[1]);
    asm volatile("s_waitcnt lgkmcnt(0)" ::: "memory");
}
__device__ __forceinline__ void naive_conv(const Args& a, int l, int t, int lane) {
    const bf16* P = (const bf16*)(a.ws + WS_PROJ); const bf16* Ch = P + 4 * PROJ_T; const bf16* Cb = P + 5 * PROJ_T; const bf16* Cc = P + 6 * PROJ_T;
    const int s = t & (SEQ - 1), c0 = lane * 8;
    float acc[8] = {0.f, 0.f, 0.f, 0.f, 0.f, 0.f, 0.f, 0.f};
#pragma unroll
    for (int j = 0; j < 3; ++j) { const int dt = 2 - j;
        if (s - dt >= 0) { const v4u hv = *(const v4u*)(Ch + (size_t)(t - dt) * MIXW + c0), cv = *(const v4u*)(Cc + (size_t)(t - dt) * MIXW + c0);
            const float* w = a.conv_w + ((size_t)l * 3 + j) * MIXW + c0; const f32x4 w0 = *(const f32x4*)w, w1 = *(const f32x4*)(w + 4);
            acc[0] += w0[0] * bflo(hv.x) * bflo(cv.x); acc[1] += w0[1] * bfhi(hv.x) * bfhi(cv.x); acc[2] += w0[2] * bflo(hv.y) * bflo(cv.y); acc[3] += w0[3] * bfhi(hv.y) * bfhi(cv.y);
            acc[4] += w1[0] * bflo(hv.z) * bflo(cv.z); acc[5] += w1[1] * bfhi(hv.z) * bfhi(cv.z); acc[6] += w1[2] * bflo(hv.w) * bflo(cv.w); acc[7] += w1[3] * bfhi(hv.w) * bfhi(cv.w); } }
    const v4u bv = *(const v4u*)(Cb + (size_t)t * MIXW + c0);
    v4u o; o.x = pk2(acc[0] * bflo(bv.x), acc[1] * bfhi(bv.x)); o.y = pk2(acc[2] * bflo(bv.y), acc[3] * bfhi(bv.y)); o.z = pk2(acc[4] * bflo(bv.z), acc[5] * bfhi(bv.z)); o.w = pk2(acc[6] * bflo(bv.w), acc[7] * bfhi(bv.w));
    *(v4u*)((bf16*)(a.ws + WS_Y) + (size_t)t * D + 1024 + c0) = o;
}
__device__ __forceinline__ void mixers_naive(const Args& a, int l, LAS unsigned char* lds, int gw, int NGW, int wave, int lane) {
    LAS float* sc = (LAS float*)(lds + wave * 8192);
    for (int i = gw; i < M * 4; i += NGW) { const int t = M * 4 - 1 - i; const int h = t & 3, tok = t >> 2; naive_attn<0>(a, l, tok >> 11, h, tok & (SEQ - 1), sc, lane); }
    for (int i = gw; i < M * 4; i += NGW) { const int h = i & 3, tok = i >> 2; naive_attn<1>(a, l, tok >> 11, h, tok & (SEQ - 1), sc, lane); }
    for (int i = gw; i < M * 4; i += NGW) naive_pool(a, l, i >> 2, i & 3, sc, lane);
    for (int i = gw; i < M; i += NGW) naive_conv(a, l, i, lane);
}

__device__ __forceinline__ float gelu_tanh(float x) { const float u = 1.5957691216057308f * (x + 0.044715f * x * x * x); return x / (1.0f + __expf(-u)); }
constexpr int PEER_TOK = 32;
constexpr int PL_IDX = 0, PL_GATE = PEER_TOK * 128 * 4, PL_TAB = 2 * PEER_TOK * 128 * 4;
__device__ __forceinline__ int f2key(float f) { const int b = __builtin_bit_cast(int, f); return b ^ ((b >> 31) & 0x7fffffff); }
__device__ __forceinline__ float key2f(int k) { return __builtin_bit_cast(float, k ^ ((k >> 31) & 0x7fffffff)); }
#define CE_DESC(x, y) do { const int hi_ = (x) > (y) ? (x) : (y), lo_ = (x) > (y) ? (y) : (x); (x) = hi_; (y) = lo_; } while (0)
__device__ __forceinline__ void sort16_desc(int* v) {
#pragma unroll
    for (int k = 2; k <= 16; k <<= 1)
#pragma unroll
        for (int j = k >> 1; j > 0; j >>= 1)
#pragma unroll
            for (int i = 0; i < 16; ++i) { const int l = i ^ j; if (l > i) { if ((i & k) == 0) CE_DESC(v[i], v[l]); else CE_DESC(v[l], v[i]); } }
}
__device__ __forceinline__ void merge_top16(int* a, const int* b) {
#pragma unroll
    for (int i = 0; i < 16; ++i) a[i] = a[i] > b[15 - i] ? a[i] : b[15 - i];
#pragma unroll
    for (int j = 8; j > 0; j >>= 1)
#pragma unroll
        for (int i = 0; i < 16; ++i) { const int l = i ^ j; if (l > i) CE_DESC(a[i], a[l]); }
}
__device__ __forceinline__ void top16_of_64(int* v) {
    sort16_desc(v); sort16_desc(v + 16); sort16_desc(v + 32); sort16_desc(v + 48);
    merge_top16(v, v + 16); merge_top16(v + 32, v + 48); merge_top16(v, v + 32);
}
constexpr int cand_slot(int i, int j) {
    int n = 0;
    for (int a = 0; a < 16; ++a) for (int b = 0; b < 16; ++b) { if ((a + 1) * (b + 1) <= 16) { if (a == i && b == j) return n; ++n; } }
    return -1;
}
__device__ __forceinline__ void peer_retrieve(const Args& a, int l, int t0, int h, LAS char* lds, int wave) {
    typedef short bf16x8 __attribute__((ext_vector_type(8)));
    typedef float f32x16 __attribute__((ext_vector_type(16)));
    int lane; asm volatile("v_mbcnt_lo_u32_b32 %0, -1, 0\n\tv_mbcnt_hi_u32_b32 %0, -1, %0" : "=v"(lane));
    const int r32 = lane & 31, hi = lane >> 5, hi4 = hi * 4;
    const bf16* Q = (const bf16*)(a.ws + WS_Q) + (size_t)(t0 + r32) * D + h * 256 + hi * 8;
    const bf16* PK = (const bf16*)(a.ws + WS_PK) + ((size_t)(l * 8 + h) * 2) * 128 * 128 + (size_t)r32 * 128 + hi * 8;
    int top[2][16];
#pragma unroll
    for (int p = 0; p < 2; ++p) {
        f32x16 acc[4] = {};
        bf16x8 qf[8];
#pragma unroll
        for (int cs = 0; cs < 8; ++cs) qf[cs] = *(const bf16x8*)(Q + p * 128 + cs * 16);
#pragma unroll
        for (int kb = 0; kb < 4; ++kb) { bf16x8 kf[8];
#pragma unroll
            for (int cs = 0; cs < 8; ++cs) kf[cs] = *(const bf16x8*)(PK + (size_t)p * 128 * 128 + (size_t)kb * 32 * 128 + cs * 16);
#pragma unroll
            for (int cs = 0; cs < 8; ++cs) acc[kb] = __builtin_amdgcn_mfma_f32_32x32x16_bf16(kf[cs], qf[cs], acc[kb], 0, 0, 0); }
        int v[64];
#pragma unroll
        for (int kb = 0; kb < 4; ++kb)
#pragma unroll
            for (int r = 0; r < 16; ++r) { const int c = kb * 32 + (r & 3) + 8 * (r >> 2);
                v[kb * 16 + r] = (f2key(acc[kb][r]) & ~127) | (c | hi4); }
        top16_of_64(v);
        int mine[16], other[16];
#pragma unroll
        for (int i = 0; i < 16; ++i) { auto rr = __builtin_amdgcn_permlane32_swap((unsigned)v[i], (unsigned)v[i], false, false); mine[i] = (int)rr[0]; other[i] = (int)rr[1]; }
        merge_top16(mine, other);
#pragma unroll
        for (int i = 0; i < 16; ++i) top[p][i] = mine[i];
    }
    LAS int* tab = (LAS int*)(lds + PL_TAB) + (wave * 64 + lane) * 32;
    float sA[16], sB[16];
#pragma unroll
    for (int i = 0; i < 16; ++i) { sA[i] = key2f(top[0][i] & ~127); sB[i] = key2f(top[1][i] & ~127); tab[i] = top[0][i] & 127; tab[16 + i] = top[1][i] & 127; }
    int c[64];
#pragma unroll
    for (int n = 0; n < 64; ++n) c[n] = (int)0x80000000;
#pragma unroll
    for (int i = 0; i < 16; ++i)
#pragma unroll
        for (int j = 0; j < 16; ++j) if ((i + 1) * (j + 1) <= 16) c[cand_slot(i, j)] = (f2key(sA[i] + sB[j]) & ~255) | (16 * i + j);
    top16_of_64(c);
    float ex[16]; float sum = 0.f; const float mx = key2f(c[0] & ~255);
#pragma unroll
    for (int w = 0; w < 16; ++w) { ex[w] = __expf(key2f(c[w] & ~255) - mx); sum += ex[w]; }
    const float inv = 1.0f / sum;
    asm volatile("s_waitcnt lgkmcnt(0)" ::: "memory");
    LAS int* oi = (LAS int*)(lds + PL_IDX) + r32 * 128 + h * 16; LAS float* og = (LAS float*)(lds + PL_GATE) + r32 * 128 + h * 16;
#pragma unroll
    for (int w = 0; w < 16; ++w) { const int id = c[w] & 255; const int e = tab[id >> 4] * 128 + tab[16 + (id & 15)];
        if ((w >> 3) == hi) { oi[w] = e; og[w] = ex[w] * inv; } }
}
constexpr size_t WS_IDX = 816 * MiB;
constexpr size_t WS_GATE = 820 * MiB;
constexpr size_t WS_XQ = 824 * MiB;
constexpr size_t WS_SX = 856 * MiB;
constexpr size_t WS_PART = 857 * MiB;
constexpr size_t WS_SUT = 890 * MiB;
constexpr size_t WS_END2 = 894 * MiB;
#ifndef PEER_NB
#define PEER_NB 8
#endif
constexpr int NSLICE = 8, SLW = D / NSLICE;
#define DPP_ROR(x, n) __builtin_bit_cast(float, __builtin_amdgcn_update_dpp(0, __builtin_bit_cast(int, (x)), 0x120 + (n), 0xf, 0xf, false))
__device__ __forceinline__ void peer_publish(const Args& a, int l, int t, LAS char* lds, int tl) {
    int lane; LANE_ID(lane);
    unsigned char* ws = a.ws;
    { int* gi = (int*)(ws + WS_IDX) + (size_t)t * 128; float* gg = (float*)(ws + WS_GATE) + (size_t)t * 128; float* gs = (float*)(ws + WS_SUT) + (size_t)t * 128;
      const float* SU = (const float*)(ws + WS_SU) + l * PEER_E; const float* SV = (const float*)(ws + WS_SV) + l * PEER_E;
      const int i0 = ((const LAS int*)(lds + PL_IDX))[tl * 128 + lane], i1 = ((const LAS int*)(lds + PL_IDX))[tl * 128 + 64 + lane];
      gi[lane] = i0; gi[64 + lane] = i1; gs[lane] = SU[i0]; gs[64 + lane] = SU[i1];
      gg[lane] = ((const LAS float*)(lds + PL_GATE))[tl * 128 + lane] * SV[i0]; gg[64 + lane] = ((const LAS float*)(lds + PL_GATE))[tl * 128 + 64 + lane] * SV[i1]; }
    const unsigned long long* ssa1 = (const unsigned long long*)(ws + WS_SSA) + l * M;
    const float rs = rsqrtf(ssa_to_f(ssa1[t]) * (1.0f / D) + EPS);
    const bf16* HB = (const bf16*)(ws + WS_HB) + (size_t)t * D; const float* gn = a.norm_ffn + l * D;
    float xf[32]; float am = 0.f;
#pragma unroll
    for (int i = 0; i < 2; ++i) { const int k0 = 16 * lane + 1024 * i; const v4u h0 = *(const v4u*)(HB + k0), h1 = *(const v4u*)(HB + k0 + 8);
        const unsigned hw[8] = {h0.x, h0.y, h0.z, h0.w, h1.x, h1.y, h1.z, h1.w};
#pragma unroll
        for (int q = 0; q < 4; ++q) { const f32x4 g = *(const f32x4*)(gn + k0 + 4 * q);
            xf[16 * i + 4 * q + 0] = bflo(hw[2 * q]) * rs * g[0]; xf[16 * i + 4 * q + 1] = bfhi(hw[2 * q]) * rs * g[1];
            xf[16 * i + 4 * q + 2] = bflo(hw[2 * q + 1]) * rs * g[2]; xf[16 * i + 4 * q + 3] = bfhi(hw[2 * q + 1]) * rs * g[3]; } }
#pragma unroll
    for (int k = 0; k < 32; ++k) am = fmaxf(am, fabsf(xf[k]));
    am = wave_max(am, lane);
    const float inv = am > 0.f ? 127.0f / am : 0.f;
    if (lane == 0) ((float*)(ws + WS_SX))[t] = am * (1.0f / 127.0f);
    unsigned char* xq = ws + WS_XQ + (size_t)t * 4096;
#pragma unroll
    for (int i = 0; i < 2; ++i) { v4u ph, pl;
#pragma unroll
        for (int d = 0; d < 4; ++d) { unsigned wh = 0, wl = 0;
#pragma unroll
            for (int b = 0; b < 4; ++b) { const float sv = xf[16 * i + 4 * d + b] * inv, hq = rintf(sv), lq = rintf((sv - hq) * 128.0f);
                wh |= ((unsigned)((int)hq & 255)) << (8 * b); wl |= ((unsigned)((int)lq & 255)) << (8 * b); }
            ph[d] = wh; pl[d] = wl; }
        *(v4u*)(xq + 16 * lane + 1024 * i) = ph; *(v4u*)(xq + 2048 + 16 * lane + 1024 * i) = pl; }
}
struct PeerItems { int pos, npop, rank, nloc, wave;
    __device__ __forceinline__ int nblk() const { return (M / PEER_TOK - rank + nloc - 1) / nloc; }
    __device__ __forceinline__ int count() const { return ((NSLICE - pos + npop - 1) / npop) * nblk() * (PEER_TOK / NWAVES); }
    __device__ __forceinline__ void get(int n, int& s, int& t) const { constexpr int per = PEER_TOK / NWAVES; const int k = n % per, r = n / per, nb = nblk();
        s = pos + (r / nb) * npop; t = (rank + (r % nb) * nloc) * PEER_TOK + wave * per + k; } };
__device__ __forceinline__ void peer_u_wave(const Args& a, int l, const PeerItems& it) {
    int lane; LANE_ID(lane);
    unsigned char* ws = a.ws; const int sub = lane & 15, grp = lane >> 4;
    const __amdgpu_buffer_rsrc_t rU = __builtin_amdgcn_make_buffer_rsrc((void*)(ws + WS_PU + (size_t)l * PE_BYTES), 0, 0x7fffffff, 0x00020000);
    const __amdgpu_buffer_rsrc_t rW = __builtin_amdgcn_make_buffer_rsrc((void*)ws, 0, 0x7fffffff, 0x00020000);
    const int N = it.count(); if (N <= 0) return;
    int s, t; it.get(0, s, t);
    int idc[2], idn[2] = {0, 0}; v4u xhc, xlc, xhn = {}, xln = {}; v4u wA[PEER_NB], wB[PEER_NB];
#define PU_META(I0, I1, XH, XL, S_, T_) do { I0 = (int)__builtin_amdgcn_raw_buffer_load_b32(rW, 4 * lane, (int)WS_IDX + (T_) * 512, 0); I1 = (int)__builtin_amdgcn_raw_buffer_load_b32(rW, 4 * lane, (int)WS_IDX + (T_) * 512 + 256, 0); \
        XH = __builtin_amdgcn_raw_buffer_load_b128(rW, 16 * sub, (int)WS_XQ + (T_) * 4096 + SLW * (S_), 0); XL = __builtin_amdgcn_raw_buffer_load_b128(rW, 16 * sub, (int)WS_XQ + (T_) * 4096 + 2048 + SLW * (S_), 0); } while (0)
#define PU_ISSUE(W, ID, Q, S_) do { _Pragma("unroll") for (int j = 0; j < PEER_NB; ++j) { const int e_ = shi(ID[(PEER_NB * (Q) + j) >> 4], 4 * ((PEER_NB * (Q) + j) & 15) + grp); W[j] = __builtin_amdgcn_raw_buffer_load_b128(rU, e_ * D + SLW * (S_) + 16 * sub, 0, 0); } } while (0)
#define PU_COMP(W, Q) do { _Pragma("unroll") for (int j = 0; j < PEER_NB; ++j) { int dh = 0, dl = 0; \
            dh = __builtin_amdgcn_sdot4((int)W[j].x, (int)xhc.x, dh, false); dl = __builtin_amdgcn_sdot4((int)W[j].x, (int)xlc.x, dl, false); \
            dh = __builtin_amdgcn_sdot4((int)W[j].y, (int)xhc.y, dh, false); dl = __builtin_amdgcn_sdot4((int)W[j].y, (int)xlc.y, dl, false); \
            dh = __builtin_amdgcn_sdot4((int)W[j].z, (int)xhc.z, dh, false); dl = __builtin_amdgcn_sdot4((int)W[j].z, (int)xlc.z, dl, false); \
            dh = __builtin_amdgcn_sdot4((int)W[j].w, (int)xhc.w, dh, false); dl = __builtin_amdgcn_sdot4((int)W[j].w, (int)xlc.w, dl, false); \
            float p_ = (float)dh + (float)dl * (1.0f / 128.0f); \
            p_ += DPP_ROR(p_, 8); p_ += DPP_ROR(p_, 4); p_ += DPP_ROR(p_, 2); p_ += DPP_ROR(p_, 1); \
            if (sub == ((PEER_NB * (Q) + j) & 15)) { if ((PEER_NB * (Q) + j) >> 4) acc1 = p_; else acc0 = p_; } __builtin_amdgcn_sched_barrier(0); } } while (0)
    PU_META(idc[0], idc[1], xhc, xlc, s, t); PU_ISSUE(wA, idc, 0, s); PU_ISSUE(wB, idc, 1, s);
    for (int n = 0; n < N; ++n) {
        int sn = s, tn = t; const bool more = n + 1 < N;
        if (more) it.get(n + 1, sn, tn);
        PU_META(idn[0], idn[1], xhn, xln, sn, tn);
        float acc0 = 0.f, acc1 = 0.f;
        __builtin_amdgcn_sched_barrier(0);
#if PEER_NB == 8
        PU_COMP(wA, 0); PU_ISSUE(wA, idc, 2, s); __builtin_amdgcn_sched_barrier(0);
        PU_COMP(wB, 1); PU_ISSUE(wB, idc, 3, s); __builtin_amdgcn_sched_barrier(0);
        PU_COMP(wA, 2); PU_ISSUE(wA, idn, 0, sn); __builtin_amdgcn_sched_barrier(0);
        PU_COMP(wB, 3); PU_ISSUE(wB, idn, 1, sn); __builtin_amdgcn_sched_barrier(0);
#else
        PU_COMP(wA, 0); PU_ISSUE(wA, idn, 0, sn); __builtin_amdgcn_sched_barrier(0);
        PU_COMP(wB, 1); PU_ISSUE(wB, idn, 1, sn); __builtin_amdgcn_sched_barrier(0);
#endif
        __builtin_amdgcn_raw_buffer_store_b32(__builtin_bit_cast(unsigned, acc0), rW, (4 * sub + grp) * 4, (int)WS_PART + (s * M + t) * 512, 0);
        __builtin_amdgcn_raw_buffer_store_b32(__builtin_bit_cast(unsigned, acc1), rW, (4 * sub + grp) * 4 + 256, (int)WS_PART + (s * M + t) * 512, 0);
        s = sn; t = tn; idc[0] = idn[0]; idc[1] = idn[1]; xhc = xhn; xlc = xln;
    }
#undef PU_META
#undef PU_ISSUE
#undef PU_COMP
}
__device__ __forceinline__ void peer_v_wave(const Args& a, int l, const PeerItems& it) {
    int lane; LANE_ID(lane);
    unsigned char* ws = a.ws; const int sub = lane & 15, grp = lane >> 4;
    const __amdgpu_buffer_rsrc_t rV = __builtin_amdgcn_make_buffer_rsrc((void*)(ws + WS_PV + (size_t)l * PE_BYTES), 0, 0x7fffffff, 0x00020000);
    const __amdgpu_buffer_rsrc_t rW = __builtin_amdgcn_make_buffer_rsrc((void*)ws, 0, 0x7fffffff, 0x00020000);
    const int N = it.count(); if (N <= 0) return;
    int s, t; it.get(0, s, t);
    struct Meta { int id[2]; float gate[2], su[2], pa[2], sx; f32x4 h1; };
    Meta mc, mn; v4u wA[PEER_NB], wB[PEER_NB];
    const int l4 = 4 * lane;
#define WLD(off_s) __builtin_amdgcn_raw_buffer_load_b32(rW, l4, (int)(off_s), 0)
#define PV_META(MM, S_, T_) do { const int r_ = (T_) * 512; MM.id[0] = (int)WLD(WS_IDX + r_); MM.id[1] = (int)WLD(WS_IDX + r_ + 256); \
        MM.gate[0] = __builtin_bit_cast(float, WLD(WS_GATE + r_)); MM.gate[1] = __builtin_bit_cast(float, WLD(WS_GATE + r_ + 256)); MM.su[0] = __builtin_bit_cast(float, WLD(WS_SUT + r_)); MM.su[1] = __builtin_bit_cast(float, WLD(WS_SUT + r_ + 256)); \
        float a0_ = 0.f, a1_ = 0.f; _Pragma("unroll") for (int q = 0; q < NSLICE; ++q) { const int po_ = (int)WS_PART + (q * M + (T_)) * 512; a0_ += __builtin_bit_cast(float, WLD(po_)); a1_ += __builtin_bit_cast(float, WLD(po_ + 256)); } \
        MM.pa[0] = a0_; MM.pa[1] = a1_; MM.sx = ((const float*)(ws + WS_SX))[T_]; \
        MM.h1 = __builtin_bit_cast(f32x4, __builtin_amdgcn_raw_buffer_load_b128(rW, (16 * sub + 4 * grp) * 4, (int)WS_H + ((T_) * D + SLW * (S_)) * 4, 0)); } while (0)
#define PV_ISSUE(W, ID, Q, S_) do { _Pragma("unroll") for (int j = 0; j < PEER_NB; ++j) { const int e_ = shi(ID[(PEER_NB * (Q) + j) >> 4], 4 * ((PEER_NB * (Q) + j) & 15) + grp); W[j] = __builtin_amdgcn_raw_buffer_load_b128(rV, e_ * D + SLW * (S_) + 16 * sub, 0, 0); } } while (0)
#define PV_COMP(W, Q) do { _Pragma("unroll") for (int j4 = 0; j4 < PEER_NB; j4 += 4) { \
            unsigned cp_ = 0; _Pragma("unroll") for (int jj = 0; jj < 4; ++jj) { const int i_ = PEER_NB * (Q) + j4 + jj; cp_ |= ((unsigned)shi(c8[i_ >> 4], 4 * (i_ & 15) + grp) & 255u) << (8 * jj); } \
            _Pragma("unroll") for (int d = 0; d < 4; ++d) { const unsigned a_ = W[j4][d], b_ = W[j4 + 1][d], c_ = W[j4 + 2][d], d_ = W[j4 + 3][d]; \
                const unsigned x0_ = __builtin_amdgcn_perm(b_, a_, 0x05010400u), x1_ = __builtin_amdgcn_perm(b_, a_, 0x07030602u), y0_ = __builtin_amdgcn_perm(d_, c_, 0x05010400u), y1_ = __builtin_amdgcn_perm(d_, c_, 0x07030602u); \
                yi[4 * d + 0] = __builtin_amdgcn_sdot4((int)__builtin_amdgcn_perm(y0_, x0_, 0x05040100u), (int)cp_, yi[4 * d + 0], false); \
                yi[4 * d + 1] = __builtin_amdgcn_sdot4((int)__builtin_amdgcn_perm(y0_, x0_, 0x07060302u), (int)cp_, yi[4 * d + 1], false); \
                yi[4 * d + 2] = __builtin_amdgcn_sdot4((int)__builtin_amdgcn_perm(y1_, x1_, 0x05040100u), (int)cp_, yi[4 * d + 2], false); \
                yi[4 * d + 3] = __builtin_amdgcn_sdot4((int)__builtin_amdgcn_perm(y1_, x1_, 0x07060302u), (int)cp_, yi[4 * d + 3], false); } \
            __builtin_amdgcn_sched_barrier(0); } } while (0)
    PV_META(mc, s, t); PV_ISSUE(wA, mc.id, 0, s); PV_ISSUE(wB, mc.id, 1, s);
    for (int n = 0; n < N; ++n) {
        int sn = s, tn = t; const bool more = n + 1 < N;
        if (more) it.get(n + 1, sn, tn);
        PV_META(mn, sn, tn);
        float coef[2];
#pragma unroll
        for (int hf = 0; hf < 2; ++hf) coef[hf] = gelu_tanh(mc.pa[hf] * mc.su[hf] * mc.sx) * mc.gate[hf];
        const float cmax = wave_max(fmaxf(fabsf(coef[0]), fabsf(coef[1])), lane); const float cinv = cmax > 0.f ? 127.0f / cmax : 0.f, cs = cmax * (1.0f / 127.0f);
        const int c8[2] = {(int)rintf(coef[0] * cinv), (int)rintf(coef[1] * cinv)};
        int yi[16];
#pragma unroll
        for (int k = 0; k < 16; ++k) yi[k] = 0;
        __builtin_amdgcn_sched_barrier(0);
#if PEER_NB == 8
        PV_COMP(wA, 0); PV_ISSUE(wA, mc.id, 2, s); __builtin_amdgcn_sched_barrier(0);
        PV_COMP(wB, 1); PV_ISSUE(wB, mc.id, 3, s); __builtin_amdgcn_sched_barrier(0);
        PV_COMP(wA, 2); PV_ISSUE(wA, mn.id, 0, sn); __builtin_amdgcn_sched_barrier(0);
        PV_COMP(wB, 3); PV_ISSUE(wB, mn.id, 1, sn); __builtin_amdgcn_sched_barrier(0);
#else
        PV_COMP(wA, 0); PV_ISSUE(wA, mn.id, 0, sn); __builtin_amdgcn_sched_barrier(0);
        PV_COMP(wB, 1); PV_ISSUE(wB, mn.id, 1, sn); __builtin_amdgcn_sched_barrier(0);
#endif
#pragma unroll
        for (int k = 0; k < 16; ++k) { yi[k] += shi(yi[k], lane ^ 16); yi[k] += shi(yi[k], lane ^ 32); }
        int yq[4];
#pragma unroll
        for (int k = 0; k < 4; ++k) yq[k] = grp == 0 ? yi[k] : grp == 1 ? yi[4 + k] : grp == 2 ? yi[8 + k] : yi[12 + k];
        const f32x4 h2 = {mc.h1[0] + cs * (float)yq[0], mc.h1[1] + cs * (float)yq[1], mc.h1[2] + cs * (float)yq[2], mc.h1[3] + cs * (float)yq[3]};
        __builtin_amdgcn_raw_buffer_store_b128(__builtin_bit_cast(v4u, h2), rW, (16 * sub + 4 * grp) * 4, (int)WS_H + (t * D + SLW * s) * 4, 0);
        v2u hb; hb.x = pk2(h2[0], h2[1]); hb.y = pk2(h2[2], h2[3]);
        __builtin_amdgcn_raw_buffer_store_b64(hb, rW, (16 * sub + 4 * grp) * 2, (int)WS_HB + (t * D + SLW * s) * 2, 0);
        const float sq = wave_sum((h2[0] * h2[0] + h2[1] * h2[1]) + (h2[2] * h2[2] + h2[3] * h2[3]), lane);
        if (lane == 0) atomicAdd((unsigned long long*)(ws + WS_SSQ) + (size_t)(l + 1) * M + t, (unsigned long long)((double)sq * 4294967296.0));
        s = sn; t = tn; mc = mn;
    }
#undef PV_META
#undef WLD
#undef PV_ISSUE
#undef PV_COMP
}
__device__ __forceinline__ void final_norm_row(const Args& a, int t) {
    int lane; LANE_ID(lane);
    const float* H = (const float*)(a.ws + WS_H) + (size_t)t * D; float* O = a.out + (size_t)t * D;
    const float rf = rsqrtf(ssa_to_f(((const unsigned long long*)(a.ws + WS_SSQ))[(size_t)DEPTH * M + t]) * (1.0f / D) + EPS);
#pragma unroll
    for (int j = 0; j < 8; ++j) { const int k0 = 4 * lane + 256 * j; const f32x4 h = *(const f32x4*)(H + k0), g = *(const f32x4*)(a.norm_final + k0);
        *(f32x4*)(O + k0) = (f32x4){h[0] * rf * g[0], h[1] * rf * g[1], h[2] * rf * g[2], h[3] * rf * g[3]}; }
}

__global__ void __launch_bounds__(NT, 2) mk_fwd(ArgsK a_in) {
    extern __shared__ __attribute__((aligned(16))) unsigned char lds_raw[];
    LAS unsigned char* lds = (LAS unsigned char*)lds_raw;
    cg::grid_group grid = cg::this_grid();
    grid.sync();
    const int wave0 = __builtin_amdgcn_readfirstlane(threadIdx.x >> 6);
    const int G = gridDim.x;
    const CAS ArgsK* ka = (const CAS ArgsK*)__builtin_amdgcn_kernarg_segment_ptr();
    size_t zoff = 0;
#define PHASE_BEGIN() int lane; LANE_ID(lane); int blk = blockIdx.x, Gp = G, wv = wave0; asm volatile("" : "+s"(zoff), "+s"(ka), "+s"(blk), "+s"(Gp), "+s"(wv)); const int wave = wv, gw = blk * NWAVES + wv, NGW = Gp * NWAVES; (void)gw; (void)NGW; const Args a = load_args(ka, zoff); unsigned char* const ws = a.ws; (void)ws
    volatile LAS unsigned* bst = (volatile LAS unsigned*)(lds + RING_BYTES + 1024);
    if (PROBE == 3) { PHASE_BEGIN(); p0_prologue(a, lds, gw, NGW, wave, lane); }
#define GRID_BAR() do { asm volatile("" : "+s"(zoff)); unsigned char* wsb_ = (unsigned char*)ka->ws + zoff; int wvb_ = wave0; asm volatile("" : "+s"(wvb_)); xcd_barrier((unsigned*)(wsb_ + WS_BAR), xb_xcc_id(), (unsigned)G, bst, wvb_); if (PROBE == 9) xcd_barrier((unsigned*)(wsb_ + WS_BAR), xb_xcc_id(), (unsigned)G, bst, wvb_); } while (0)
    volatile LAS unsigned* xinfo = bst + 4;
    { PHASE_BEGIN(); if (wave == 0 && lane == 0) { bst[0] = 0u; bst[1] = 0u; xinfo[2] = xb_add((unsigned*)(ws + WS_BAR) + XB_XCNT(xb_xcc_id()), 1u); }
      p0_prologue(a, lds, gw, NGW, wave, lane); }
    GRID_BAR(); if (PROBE == 13) { GRID_BAR(); grid.sync(); }
    { PHASE_BEGIN(); p0_win_i8(a, lds, gw, NGW, wave, lane); }
    GRID_BAR(); if (PROBE == 13) { GRID_BAR(); grid.sync(); }
    {
        PHASE_BEGIN();
        if (wave == 0 && lane == 0) { unsigned* bar = (unsigned*)(ws + WS_BAR); const unsigned x = xb_xcc_id(); unsigned pos = 0, npop = 0, mine = 1;
            for (unsigned j = 0; j < 16; ++j) { const unsigned c = xb_ld(&bar[XB_XCNT(j)]); if (c) { ++npop; if (j < x) ++pos; } if (j == x) mine = c ? c : 1u; }
            xinfo[0] = pos; xinfo[1] = npop ? npop : 1u; xinfo[3] = mine; }
        __syncthreads();
    }
    int depth_rt = DEPTH; asm volatile("" : "+s"(depth_rt));
    for (int lc = 0; lc < depth_rt; ++lc) {
        int l = lc; asm volatile("" : "+s"(l));
        if (l > 0) { { PHASE_BEGIN(); quant_rows(a, gw, NGW, lane); } GRID_BAR(); }
        for (int rep = 0; rep < (PROBE == 4 ? 2 : 1); ++rep)
        {
            PHASE_BEGIN();
            const unsigned long long* ssq_mix = (const unsigned long long*)(ws + WS_SSQ) + l * M;
            pg8::Gemm g{(const bf16*)(ws + WS_HB8), (const bf16*)(ws + WS_WIN + l * WIN_BYTES), M, NPROJ, D / 2}; pg8::StaticOrder S; S.init(M, NPROJ, Gp, blk);
            EpiProj E{(bf16*)(ws + WS_PROJ), (bf16*)(ws + WS_R), (const float*)(ws + WS_BINR) + l * NPROJ, ssq_mix, (const float*)(ws + WS_SA), (const float*)(ws + WS_SW) + l * NPROJ};
            if (PROBE == 10) { pg8::Gemm g2{(const bf16*)(ws + WS_HB), (const bf16*)(ws + 896 * MiB + (size_t)l * NPROJ * D * 2), M, NPROJ, D}; EpiProj E2 = E; E2.sa = nullptr;
                pg8::gemm_phase<EpiProj, pg8::StaticOrder, true, false>(lds, g2, S, E2, wave); }
            else if (PROBE == 12) {
                pg8::gemm_phase<EpiProj, pg8::StaticOrder, true, true>(lds, g, S, E, wave);
                asm volatile("s_waitcnt vmcnt(0)" ::: "memory"); __syncthreads();
                EpiCmp E3{(const bf16*)(ws + WS_PROJ), (const float*)(ws + WS_BINR) + l * NPROJ, ssq_mix, (const float*)(ws + WS_SA), (const float*)(ws + WS_SW) + l * NPROJ, (unsigned*)(ws + WS_QCTR) + 64 * 8, (const bf16*)(ws + WS_R)};
                pg8::gemm_phase<EpiCmp, pg8::StaticOrder, true, true>(lds, g, S, E3, wave); }
            else if (PROBE == 11) { pg8::Gemm g2{(const bf16*)(ws + WS_HB), (const bf16*)(ws + 896 * MiB + (size_t)l * NPROJ * D * 2), M, NPROJ, D}; EpiProj E2 = E; E2.sa = nullptr;
                pg8::gemm_phase<EpiProj, pg8::StaticOrder, true, false>(lds, g2, S, E2, wave);
                asm volatile("s_waitcnt vmcnt(0)" ::: "memory"); __syncthreads();
                EpiCmp E3{(const bf16*)(ws + WS_PROJ), (const float*)(ws + WS_BINR) + l * NPROJ, ssq_mix, (const float*)(ws + WS_SA), (const float*)(ws + WS_SW) + l * NPROJ, (unsigned*)(ws + WS_QCTR) + 64 * 8, (const bf16*)(ws + WS_R)};
                pg8::gemm_phase<EpiCmp, pg8::StaticOrder, true, true>(lds, g, S, E3, wave); }
            else pg8::gemm_phase<EpiProj, pg8::StaticOrder, true, true>(lds, g, S, E, wave);
            for (int r2 = 0; r2 < (PROBE == 8 ? 2 : 1); ++r2) forget_logits(a, l, gw, NGW, lane);
        }
        GRID_BAR();
        if (PROBE == 5) { PHASE_BEGIN(); mixers_fast(a, l + 2, (LAS char*)lds, wave, lane, Gp, blk); }
        { PHASE_BEGIN(); mixers_fast(a, l, (LAS char*)lds, wave, lane, Gp, blk); }
        GRID_BAR();
        for (int rep = 0; rep < (PROBE == 6 ? 2 : 1); ++rep)
        {
            PHASE_BEGIN();
            pg8::Gemm g{(const bf16*)(ws + WS_Y), (const bf16*)(ws + WS_WBR + l * SQ_BYTES), M, D, D}; pg8::StaticOrder S; S.init(M, D, Gp, blk);
            EpiMerge E{(const bf16*)(ws + WS_R), (bf16*)(ws + WS_MRG)};
            pg8::gemm_phase<EpiMerge, pg8::StaticOrder, false>(lds, g, S, E, wave);
        }
        GRID_BAR();
        {
            PHASE_BEGIN();
            pg8::Gemm g{(const bf16*)(ws + WS_MRG), (const bf16*)(ws + WS_WOUT + l * SQ_BYTES), M, D, D}; pg8::StaticOrder S; S.init(M, D, Gp, blk);
            EpiRes E{(float*)(ws + WS_H), (bf16*)(ws + WS_HB), (unsigned long long*)(ws + WS_SSA) + l * M};
            pg8::gemm_phase<EpiRes, pg8::StaticOrder, false>(lds, g, S, E, wave);
        }
        GRID_BAR();
        for (int rep = 0; rep < (PROBE == 7 ? 2 : 1); ++rep)
        {
            PHASE_BEGIN();
            pg8::Gemm g{(const bf16*)(ws + WS_HB), (const bf16*)(ws + WS_WQ + l * SQ_BYTES), M, D, D}; pg8::StaticOrder S; S.init(M, D, Gp, blk);
            EpiQ E{(bf16*)(ws + WS_Q), (const unsigned long long*)(ws + WS_SSA) + l * M};
            pg8::gemm_phase<EpiQ, pg8::StaticOrder, false>(lds, g, S, E, wave);
        }
        GRID_BAR();
        for (int rep = 0; rep < (PROBE == 2 ? 2 : 1); ++rep)
        {
            PHASE_BEGIN(); (void)lane;
            for (int t0 = blk * PEER_TOK; t0 < M; t0 += Gp * PEER_TOK) {
                peer_retrieve(a, l, t0, wave, (LAS char*)lds, wave);
                __syncthreads();
                for (int k = 0; k < PEER_TOK / NWAVES; ++k) { const int tl = wave * (PEER_TOK / NWAVES) + k; peer_publish(a, l, t0 + tl, (LAS char*)lds, tl); }
                __syncthreads();
            }
        }
        GRID_BAR();
        for (int rep = 0; rep < (PROBE == 1 ? 2 : 1); ++rep)
        {
            PHASE_BEGIN(); (void)lane;
            const int pos = __builtin_amdgcn_readfirstlane((int)xinfo[0]), npop = __builtin_amdgcn_readfirstlane((int)xinfo[1]), rank = __builtin_amdgcn_readfirstlane((int)xinfo[2]), nloc = __builtin_amdgcn_readfirstlane((int)xinfo[3]);
            const PeerItems it{pos, npop, rank, nloc, wave}; peer_u_wave(a, l, it);
        }
        GRID_BAR();
        {
            PHASE_BEGIN(); (void)lane;
            const int pos = __builtin_amdgcn_readfirstlane((int)xinfo[0]), npop = __builtin_amdgcn_readfirstlane((int)xinfo[1]), rank = __builtin_amdgcn_readfirstlane((int)xinfo[2]), nloc = __builtin_amdgcn_readfirstlane((int)xinfo[3]);
            const PeerItems it{pos, npop, rank, nloc, wave}; peer_v_wave(a, l, it);
        }
        GRID_BAR();
    }
    {
        PHASE_BEGIN(); (void)lane;
        for (int t = gw; t < M; t += NGW) final_norm_row(a, t);
        if (PROBE == 11 || PROBE == 12) { const unsigned bad = *((const unsigned*)(ws + WS_QCTR) + 64 * 8); if (bad > PROBE11_THR && gw == 0 && lane == 0) a.out[0] = __builtin_nanf(""); }
    }
}

extern "C" void kernel_launch(void* const* d_in, const int* in_sizes, int n_in, void* d_out, int out_size, void* d_ws, size_t ws_size, hipStream_t stream) {
    static int grid = 0;
    if (grid == 0) {
        int dev = 0, cus = 0, per_cu = 0;
        if (n_in != 16 || out_size != M * D || ws_size < WS_END2) { fprintf(stderr, "kernel_launch: unexpected shapes (n_in %d out %d ws %zu)\n", n_in, out_size, ws_size); grid = -1; return; }
        (void)hipGetDevice(&dev);
        (void)hipDeviceGetAttribute(&cus, hipDeviceAttributeMultiprocessorCount, dev);
        (void)hipFuncSetAttribute((const void*)mk_fwd, hipFuncAttributeMaxDynamicSharedMemorySize, LDS_BYTES);
        (void)hipOccupancyMaxActiveBlocksPerMultiprocessor(&per_cu, (const void*)mk_fwd, NT, LDS_BYTES);
        if (per_cu < 1) { fprintf(stderr, "kernel_launch: occupancy query says %d blocks per CU\n", per_cu); }
        grid = cus;
        if (grid > 256) grid = 256;
    }
    if (grid < 0) return;
    (void)hipMemsetAsync((char*)d_ws + WS_CTL, 0, CTL_ZERO_BYTES, stream);
    ArgsK a{};
    const GAS float** p = (const GAS float**)&a;
    for (int i = 0; i < 16; ++i) p[i] = (const GAS float*)d_in[i];
    a.out = (GAS float*)d_out; a.ws = (GAS unsigned char*)d_ws;
    void* args[] = {&a};
    hipError_t e = hipLaunchCooperativeKernel((const void*)mk_fwd, dim3(grid), dim3(NT), args, LDS_BYTES, stream);
    if (e != hipSuccess) fprintf(stderr, "cooperative launch failed: %s (grid %d)\n", hipGetErrorString(e), grid);
}
```

```cpp
#include <hip/hip_runtime.h>
#include <hip/hip_cooperative_groups.h>
#include <cstdio>
#include <cstdint>
namespace cg = cooperative_groups;
namespace pg8 {
#define PG8_LAS __attribute__((address_space(3)))
typedef unsigned short bf16_t;
typedef short bf16x8 __attribute__((ext_vector_type(8)));
typedef float f32x4 __attribute__((ext_vector_type(4)));
typedef unsigned u32x4 __attribute__((ext_vector_type(4)));
typedef unsigned u32x2 __attribute__((ext_vector_type(2)));
typedef int i32x4 __attribute__((ext_vector_type(4)));
constexpr int BM = 256, BK = 64, HALF = 128, HTB = HALF * BK * 2  , STAGE_BYTES = 8 * HTB, NXCD = 8, WGM = 8;

__host__ __device__ __forceinline__ int lds_byte(int r, int c) { const int st = (r >> 4) * 2 + (c >> 5), rr = r & 15, cc = c & 31, ob = rr * 64 + cc * 2; return st * 1024 + (ob ^ (((ob >> 9) & 1) << 5)); }
__host__ __device__ __forceinline__ void stage_rc(int b, int& R, int& C) { const int st = b / 1024, sb = b % 1024, swz = sb ^ (((sb >> 9) & 1) << 5); R = (st >> 1) * 16 + swz / 64; C = (st & 1) * 32 + (swz % 64) / 2; }
__host__ __device__ __forceinline__ int perm32(int rho) { const int n = rho >> 4, i = rho & 15; return 8 * (i >> 2) + 4 * n + (i & 3); }

struct Unit { int pm, pn; };
struct Gemm { const bf16_t* A; const bf16_t* Bt; int M, N, K; };

struct StaticOrder {
    int nM, nN, nwg, G, c;
    __host__ __device__ void init(int M, int N, int G_, int c_) { nM = M / BM; nN = N / BM; nwg = nM * nN; G = G_; c = c_; }
    __host__ __device__ bool next(int i, Unit& u) const {
        const long L = (long)i * G + c; if (L >= nwg) return false;
        int wgid = (int)L; { const int q = nwg / NXCD, r = nwg % NXCD, xcd = wgid % NXCD, off = wgid / NXCD; wgid = (xcd < r ? xcd * (q + 1) : r * (q + 1) + (xcd - r) * q) + off; }
        const int nig = WGM * nN, gid = wgid / nig, fm = gid * WGM, gsz = (nM - fm) < WGM ? (nM - fm) : WGM;
        u.pm = fm + ((wgid % nig) % gsz); u.pn = (wgid % nig) / gsz; return true;
    }
};

__device__ __forceinline__ unsigned cvt_pk_bf16(float lo, float hi) { unsigned r; asm volatile("v_cvt_pk_bf16_f32 %0, %1, %2" : "=v"(r) : "v"(lo), "v"(hi)); return r; }

template <class Epi, class Sched, bool ALIGN_EPI = false, bool I8 = false>
__device__ __forceinline__ void gemm_phase(PG8_LAS unsigned char* lds, const Gemm g, const Sched& S, const Epi& E, int wid) {
    int lane_; asm volatile("v_mbcnt_lo_u32_b32 %0, -1, 0\n\tv_mbcnt_hi_u32_b32 %0, -1, %0" : "=v"(lane_));
    const int lane = lane_, tid = wid * 64 + lane, wr = wid >> 2, wc = wid & 3, fr = lane & 15, fq = lane >> 4;
    const int K = g.K, nt = K / BK;
    unsigned voffA, voffB;
    { int R, C; stage_rc(tid * 16, R, C); const int Rb = Epi::PERM ? ((R & ~31) + perm32(R & 31)) : R; voffA = (unsigned)(R * K + C) * 2u; voffB = (unsigned)(Rb * K + C) * 2u; }
    const size_t p2step = (size_t)64 * K * 2;
    const size_t kstep = (size_t)(BK * 2);
    const size_t hstep = (size_t)HALF * K * 2;
    const size_t tstep = 2 * hstep;
    const unsigned ldsw = (unsigned)wid * 1024u;
    const int aoff = lds_byte(wr * 64 + fr, fq * 8), boff = lds_byte(wc * 32 + fr, fq * 8);
#define PG8_SA(b, h) (((b) * 2 + (h)) * HTB)
#define PG8_SB(b, h) ((4 + (b) * 2 + (h)) * HTB)
#define PG8_STAGE(bufoff, gbase, voff) do { _Pragma("unroll") for (int _i = 0; _i < 2; ++_i) \
        __builtin_amdgcn_global_load_lds((const unsigned*)((const char*)(gbase) + _i * p2step + (voff)), (PG8_LAS unsigned*)(lds + (bufoff) + ldsw + _i * 8192), 16, 0, 0); } while (0)
#define PG8_LDA(dst, b, h) do { _Pragma("unroll") for (int m = 0; m < 4; ++m) _Pragma("unroll") for (int k = 0; k < 2; ++k) dst[m][k] = *(const PG8_LAS bf16x8*)(lds + PG8_SA(b, h) + aoff + m * 2048 + k * 1024); } while (0)
#define PG8_LDB(dst, b, h) do { _Pragma("unroll") for (int n = 0; n < 2; ++n) _Pragma("unroll") for (int k = 0; k < 2; ++k) dst[n][k] = *(const PG8_LAS bf16x8*)(lds + PG8_SB(b, h) + boff + n * 2048 + k * 1024); } while (0)
#define PG8_MMA(ai, bj, At, Bt) do { __builtin_amdgcn_s_setprio(1); _Pragma("unroll") for (int m = 0; m < 4; ++m) _Pragma("unroll") for (int n = 0; n < 2; ++n) _Pragma("unroll") for (int k = 0; k < 2; ++k) \
        { if constexpr (I8) acc[ai][bj][m][n] = __builtin_bit_cast(f32x4, __builtin_amdgcn_mfma_i32_16x16x64_i8(__builtin_bit_cast(i32x4, Bt[n][k]), __builtin_bit_cast(i32x4, At[m][k]), __builtin_bit_cast(i32x4, acc[ai][bj][m][n]), 0, 0, 0)); \
          else acc[ai][bj][m][n] = __builtin_amdgcn_mfma_f32_16x16x32_bf16(Bt[n][k], At[m][k], acc[ai][bj][m][n], 0, 0, 0); } __builtin_amdgcn_s_setprio(0); } while (0)
#define PG8_WAIT_V(n) asm volatile("s_waitcnt vmcnt(" #n ")" ::: "memory")
#define PG8_WAIT_L(n) asm volatile("s_waitcnt lgkmcnt(" #n ")" ::: "memory")
#define PG8_BAR __builtin_amdgcn_s_barrier()
#define PG8_SCHED __builtin_amdgcn_sched_barrier(0)
    Unit cur, nxt; int ui = 0;
    if (!S.next(0, cur)) return;
    f32x4 acc[2][2][4][2];
#pragma unroll
    for (int a = 0; a < 2; ++a)
#pragma unroll
        for (int b = 0; b < 2; ++b)
#pragma unroll
            for (int m = 0; m < 4; ++m)
#pragma unroll
                for (int n = 0; n < 2; ++n) acc[a][b][m][n] = (f32x4){0.f, 0.f, 0.f, 0.f};
    bf16x8 At[4][2], B0[2][2], B1[2][2];
    typename Epi::Pre pre = {};
    const char* cA = (const char*)g.A + (size_t)cur.pm * tstep; const char* cB = (const char*)g.Bt + (size_t)cur.pn * tstep;
    PG8_STAGE(PG8_SB(0, 0), cB, voffB); PG8_STAGE(PG8_SB(0, 1), cB + hstep, voffB); PG8_STAGE(PG8_SA(0, 0), cA, voffA); PG8_STAGE(PG8_SA(0, 1), cA + hstep, voffA);
    if (wr == 1) PG8_BAR;
    PG8_WAIT_V(2); PG8_BAR;
    PG8_STAGE(PG8_SB(1, 0), cB + kstep, voffB); PG8_STAGE(PG8_SA(1, 0), cA + kstep, voffA); PG8_STAGE(PG8_SB(1, 1), cB + hstep + kstep, voffB);
    PG8_WAIT_V(6); PG8_BAR;
    for (;;) {
        const bool has_next = S.next(ui + 1, nxt);
        const char* nA = has_next ? (const char*)g.A + (size_t)nxt.pm * tstep : cA; const char* nB = has_next ? (const char*)g.Bt + (size_t)nxt.pn * tstep : cB;
        const int seglen = Epi::HOOK ? 8 : nt;
        for (int t0 = 0; t0 < nt; t0 += seglen) {
        if constexpr (Epi::HOOK) { if (t0 > 0) { int ln_; asm volatile("v_mbcnt_lo_u32_b32 %0, -1, 0\n\tv_mbcnt_hi_u32_b32 %0, -1, %0" : "=v"(ln_)); E.hook(acc, cur, t0 >> 3, wr, wc, ln_ & 15, ln_ >> 4); } }
        for (int t = t0; t < t0 + seglen; t += 2) {
            const bool last = (t == nt - 2);
            if constexpr (Epi::PRELOAD) { if (last) { int ln_; asm volatile("v_mbcnt_lo_u32_b32 %0, -1, 0\n\tv_mbcnt_hi_u32_b32 %0, -1, %0" : "=v"(ln_)); E.preload(pre, cur, wr, wc, ln_ & 15, ln_ >> 4); } }
            const char* a1 = cA + (size_t)(t + 1) * kstep;
            const char* a2 = last ? nA : cA + (size_t)(t + 2) * kstep; const char* b2 = last ? nB : cB + (size_t)(t + 2) * kstep;
            const char* a3 = a2 + kstep; const char* b3 = b2 + kstep;
            PG8_LDB(B0, 0, 0); PG8_LDB(B1, 0, 1); PG8_SCHED; PG8_LDA(At, 0, 0); PG8_STAGE(PG8_SA(1, 1), a1 + hstep, voffA);
            PG8_WAIT_V(8); PG8_WAIT_L(0); PG8_BAR; PG8_MMA(0, 0, At, B0); PG8_MMA(0, 1, At, B1); PG8_BAR; PG8_SCHED;
            PG8_LDA(At, 0, 1); PG8_STAGE(PG8_SB(0, 0), b2, voffB); PG8_STAGE(PG8_SB(0, 1), b2 + hstep, voffB); PG8_STAGE(PG8_SA(0, 0), a2, voffA);
            PG8_WAIT_V(8); PG8_WAIT_L(0); PG8_BAR; PG8_MMA(1, 0, At, B0); PG8_MMA(1, 1, At, B1); PG8_BAR; PG8_SCHED;
            PG8_LDB(B0, 1, 0); PG8_LDB(B1, 1, 1); PG8_SCHED; PG8_LDA(At, 1, 0); PG8_STAGE(PG8_SA(0, 1), a2 + hstep, voffA);
            PG8_WAIT_V(8); PG8_WAIT_L(0); PG8_BAR; PG8_MMA(0, 0, At, B0); PG8_MMA(0, 1, At, B1); PG8_BAR; PG8_SCHED;
            PG8_LDA(At, 1, 1); PG8_STAGE(PG8_SB(1, 0), b3, voffB); PG8_STAGE(PG8_SB(1, 1), b3 + hstep, voffB); PG8_STAGE(PG8_SA(1, 0), a3, voffA);
            PG8_WAIT_V(8); PG8_WAIT_L(0); PG8_BAR; PG8_MMA(1, 0, At, B0); PG8_MMA(1, 1, At, B1); PG8_BAR; PG8_SCHED;
        }
        }
        if constexpr (ALIGN_EPI) { if (wr == 0) PG8_BAR; }
        { int ln_; asm volatile("v_mbcnt_lo_u32_b32 %0, -1, 0\n\tv_mbcnt_hi_u32_b32 %0, -1, %0" : "=v"(ln_));
          if constexpr (Epi::PRELOAD) E(acc, cur, wr, wc, ln_ & 15, ln_ >> 4, pre); else E(acc, cur, wr, wc, ln_ & 15, ln_ >> 4); }
        if (!has_next) break;
#pragma unroll
        for (int a = 0; a < 2; ++a)
#pragma unroll
            for (int b = 0; b < 2; ++b)
#pragma unroll
                for (int m = 0; m < 4; ++m)
#pragma unroll
                    for (int n = 0; n < 2; ++n) acc[a][b][m][n] = (f32x4){0.f, 0.f, 0.f, 0.f};
        cur = nxt; cA = nA; cB = nB; ++ui;
        if constexpr (ALIGN_EPI) { if (wr == 1) PG8_BAR; }
    }
    PG8_WAIT_V(0);
    if constexpr (!ALIGN_EPI) { if (wr == 0) PG8_BAR; }
    PG8_BAR;
#undef PG8_SA
#undef PG8_SB
#undef PG8_STAGE
#undef PG8_LDA
#undef PG8_LDB
#undef PG8_MMA
#undef PG8_WAIT_V
#undef PG8_WAIT_L
#undef PG8_BAR
#undef PG8_SCHED
}
}
#ifndef PROBE
#define PROBE 0
#endif
#ifndef PROBE11_THR
#define PROBE11_THR 1000000u
#endif
constexpr int NWAVES = 8, NT = NWAVES * 64;
constexpr int M = 8192, D = 2048, SEQ = 2048, NBATCH = 4, DEPTH = 2;
constexpr int INW = 13316, NPROJ = 13312, MIXW = 512, HD = 128;
constexpr int PEER_E = 16384;
constexpr float EPS = 1e-6f;
constexpr float ATT_SCALE = 0.08838834764831845f;

constexpr size_t MiB = 1u << 20;
constexpr size_t WS_CTL = 0, CTL_ZERO_BYTES = 1 * MiB;
constexpr size_t WS_SSQ = 0;
constexpr size_t WS_SSA = 256 * 1024;
constexpr size_t WS_WF = 1 * MiB;
constexpr size_t WS_BINR = WS_WF + 64 * 1024;
constexpr size_t WS_LOGF = 2 * MiB;
constexpr size_t WS_CUM = 3 * MiB;
constexpr size_t WS_WIN = 8 * MiB;
constexpr size_t WIN_BYTES = (size_t)NPROJ * D;
constexpr size_t WS_SW = 7 * MiB;
constexpr size_t WS_CMAX = 384 * 1024;
constexpr size_t WS_HB8 = 64 * MiB;
constexpr size_t WS_SA = 7 * MiB + 512 * 1024;
constexpr size_t WS_WBR = 112 * MiB, WS_WOUT = 128 * MiB, WS_WQ = 144 * MiB;
constexpr size_t SQ_BYTES = (size_t)D * D * 2;
constexpr size_t WS_PU = 160 * MiB, WS_PV = 288 * MiB;
constexpr size_t PE_BYTES = (size_t)PEER_E * D;
constexpr size_t WS_PK = 6 * MiB;
constexpr size_t WS_SU = 5 * MiB, WS_SV = 5 * MiB + 256 * 1024;
constexpr size_t WS_H = 416 * MiB;
constexpr size_t WS_HB = 480 * MiB;
constexpr size_t WS_PROJ = 512 * MiB;
constexpr size_t PROJ_T = (size_t)M * MIXW;
constexpr size_t WS_R = 592 * MiB;
constexpr size_t R_PLANE = (size_t)M * D;
constexpr size_t WS_Y = 720 * MiB;
constexpr size_t WS_MRG = 752 * MiB;
constexpr size_t WS_Q = 784 * MiB;
constexpr size_t WS_END = 816 * MiB;

constexpr int RING_BYTES = 131072;
constexpr int LDS_BYTES = 147456;

typedef unsigned short bf16;
typedef unsigned v4u __attribute__((ext_vector_type(4)));
typedef unsigned v2u __attribute__((ext_vector_type(2)));
typedef float f32x4 __attribute__((ext_vector_type(4)));
typedef float f32x2 __attribute__((ext_vector_type(2)));
using bf16x2 = __attribute__((ext_vector_type(2))) __bf16;
#define LAS __attribute__((address_space(3)))

__device__ __forceinline__ unsigned f2bf(float f) { unsigned u = __builtin_bit_cast(unsigned, f); return (u + 0x7fffu + ((u >> 16) & 1u)) >> 16; }
__device__ __forceinline__ unsigned pk2(float lo, float hi) { return f2bf(lo) | (f2bf(hi) << 16); }
__device__ __forceinline__ float bflo(unsigned w) { return __builtin_bit_cast(float, w << 16); }
__device__ __forceinline__ float bfhi(unsigned w) { return __builtin_bit_cast(float, w & 0xffff0000u); }
__device__ __forceinline__ float bf2f(bf16 b) { return __builtin_bit_cast(float, ((unsigned)b) << 16); }
__device__ __forceinline__ float shf(float v, int src) { return __builtin_bit_cast(float, __builtin_amdgcn_ds_bpermute(src << 2, __builtin_bit_cast(int, v))); }
__device__ __forceinline__ int shi(int v, int src) { return __builtin_amdgcn_ds_bpermute(src << 2, v); }
__device__ __forceinline__ float wave_sum(float v, int lane) {
#pragma unroll
    for (int o = 1; o < 64; o <<= 1) v += shf(v, lane ^ o);
    return v;
}
__device__ __forceinline__ float wave_max(float v, int lane) {
#pragma unroll
    for (int o = 1; o < 64; o <<= 1) v = fmaxf(v, shf(v, lane ^ o));
    return v;
}
__device__ __forceinline__ float ssa_to_f(unsigned long long v) { return (float)((double)v * (1.0 / 4294967296.0)); }
__device__ __forceinline__ float dot2_bf16(unsigned w, unsigned x, float acc) { return __builtin_amdgcn_fdot2_f32_bf16(__builtin_bit_cast(bf16x2, w), __builtin_bit_cast(bf16x2, x), acc, false); }

#define LANE_ID(x) asm volatile("v_mbcnt_lo_u32_b32 %0, -1, 0\n\tv_mbcnt_hi_u32_b32 %0, -1, %0" : "=v"(x))
struct Args {
    const float *x, *norm_mix, *w_in, *b_in, *pool_w, *pool_scale, *conv_w, *rel_bias, *w_branch, *w_out, *norm_ffn, *peer_wq, *peer_keys, *peer_u, *peer_v, *norm_final;
    float* out; unsigned char* ws;
};
#define GAS __attribute__((address_space(1)))
#define CAS __attribute__((address_space(4)))
struct ArgsK {
    const GAS float *x, *norm_mix, *w_in, *b_in, *pool_w, *pool_scale, *conv_w, *rel_bias, *w_branch, *w_out, *norm_ffn, *peer_wq, *peer_keys, *peer_u, *peer_v, *norm_final;
    GAS float* out; GAS unsigned char* ws;
};
__device__ __forceinline__ Args load_args(const CAS ArgsK* k, size_t zoff) {
    Args a;
    a.x = (const float*)k->x; a.norm_mix = (const float*)k->norm_mix; a.w_in = (const float*)k->w_in; a.b_in = (const float*)k->b_in; a.pool_w = (const float*)k->pool_w;
    a.pool_scale = (const float*)k->pool_scale; a.conv_w = (const float*)k->conv_w; a.rel_bias = (const float*)k->rel_bias; a.w_branch = (const float*)k->w_branch;
    a.w_out = (const float*)k->w_out; a.norm_ffn = (const float*)k->norm_ffn; a.peer_wq = (const float*)k->peer_wq; a.peer_keys = (const float*)k->peer_keys;
    a.peer_u = (const float*)k->peer_u; a.peer_v = (const float*)k->peer_v; a.norm_final = (const float*)k->norm_final; a.out = (float*)k->out; a.ws = (unsigned char*)(k->ws + zoff);
    return a;
}

using pg8::f32x4; using pg8::Unit;
constexpr size_t WS_G = 896 * MiB;
constexpr size_t WS_SWH = 7 * MiB + 256 * 1024, WS_BIH = 7 * MiB + 384 * 1024;
constexpr size_t WS_RSA = 7 * MiB + 768 * 1024;
struct EpiProj {
    static constexpr bool PERM = true, HOOK = false, PRELOAD = true;
    struct Pre { pg8::u32x4 sw[2], bi[2]; float rs[2][4]; };
    unsigned char* wsb; const bf16* biash; const float* rsa; const bf16* swh;
    __device__ __forceinline__ void preload(Pre& p, const Unit& u, int wr, int wc, int fr, int fq) const {
        const int row0 = u.pm * 256 + wr * 64 + fr, bcol0 = u.pn * 256 + wc * 32 + 8 * fq;
#pragma unroll
        for (int bj = 0; bj < 2; ++bj) { p.sw[bj] = *(const pg8::u32x4*)(swh + bcol0 + bj * 128); p.bi[bj] = *(const pg8::u32x4*)(biash + bcol0 + bj * 128); }
#pragma unroll
        for (int ai = 0; ai < 2; ++ai)
#pragma unroll
            for (int m = 0; m < 4; ++m) p.rs[ai][m] = rsa[row0 + ai * 128 + m * 16];
    }
    __device__ __forceinline__ void operator()(f32x4 (&acc)[2][2][4][2], const Unit& u, int wr, int wc, int fr, int fq, const Pre& p) const {
        const int cl0 = wc * 32 + 8 * fq;
#define ACCF(ai, bj, m, n) __builtin_convertvector(__builtin_bit_cast(pg8::i32x4, acc[ai][bj][m][n]), f32x4)
        const __amdgpu_buffer_rsrc_t rW = __builtin_amdgcn_make_buffer_rsrc((void*)wsb, 0, 0x7fffffff, 0x00020000);
        int sbase, ldb;
        if (u.pn < 20) { sbase = (int)WS_PROJ + ((u.pn >> 1) * (int)PROJ_T + (u.pn & 1) * 256) * 2; ldb = MIXW * 2; } else { sbase = (int)WS_G + (u.pn - 20) * 512; ldb = 4 * D * 2; }
        const int voff = fr * ldb + cl0 * 2; sbase += (u.pm * 256 + wr * 64) * ldb;
#pragma unroll
        for (int bj = 0; bj < 2; ++bj) { const f32x4 w0 = {bflo(p.sw[bj].x), bfhi(p.sw[bj].x), bflo(p.sw[bj].y), bfhi(p.sw[bj].y)}, w1 = {bflo(p.sw[bj].z), bfhi(p.sw[bj].z), bflo(p.sw[bj].w), bfhi(p.sw[bj].w)};
            const f32x4 b0 = {bflo(p.bi[bj].x), bfhi(p.bi[bj].x), bflo(p.bi[bj].y), bfhi(p.bi[bj].y)}, b1 = {bflo(p.bi[bj].z), bfhi(p.bi[bj].z), bflo(p.bi[bj].w), bfhi(p.bi[bj].w)};
#pragma unroll
            for (int ai = 0; ai < 2; ++ai)
#pragma unroll
                for (int m = 0; m < 4; ++m) { const float rs = p.rs[ai][m]; const f32x4 v0 = ACCF(ai, bj, m, 0) * rs * w0 + b0, v1 = ACCF(ai, bj, m, 1) * rs * w1 + b1;
                    pg8::u32x4 w; w.x = pg8::cvt_pk_bf16(v0[0], v0[1]); w.y = pg8::cvt_pk_bf16(v0[2], v0[3]); w.z = pg8::cvt_pk_bf16(v1[0], v1[1]); w.w = pg8::cvt_pk_bf16(v1[2], v1[3]);
                    __builtin_amdgcn_raw_buffer_store_b128(w, rW, voff + bj * 256, sbase + (ai * 128 + m * 16) * ldb, 0); } }
    }
};
#undef ACCF
struct EpiSum {
    static constexpr bool PERM = true, HOOK = false; static constexpr bool PRELOAD = false; struct Pre {};
    float* dummy;
    __device__ __forceinline__ void operator()(f32x4 (&acc)[2][2][4][2], const Unit& u, int wr, int wc, int fr, int fq) const {
        f32x4 s = {0.f, 0.f, 0.f, 0.f};
#pragma unroll
        for (int ai = 0; ai < 2; ++ai)
#pragma unroll
            for (int bj = 0; bj < 2; ++bj)
#pragma unroll
                for (int m = 0; m < 4; ++m)
#pragma unroll
                    for (int n = 0; n < 2; ++n) s += acc[ai][bj][m][n];
        dummy[((u.pm * 64 + u.pn) * 8 + wr * 4 + wc) * 64 + fq * 16 + fr] = (s[0] + s[1]) + (s[2] + s[3]);
    }
};
template <int MODE> struct EpiSt {
    static constexpr bool PERM = true, HOOK = false, PRELOAD = false; struct Pre {};
    unsigned char* wsb;
    __device__ __forceinline__ void operator()(f32x4 (&acc)[2][2][4][2], const Unit& u, int wr, int wc, int fr, int fq) const {
        const __amdgpu_buffer_rsrc_t rW = __builtin_amdgcn_make_buffer_rsrc((void*)wsb, 0, 0x7fffffff, 0x00020000);
        const int ldb = 4 * D * 2; int sbase = (int)WS_R + (u.pn % 32) * 512 + (u.pm * 256 + wr * 64) * ldb;
        const int ln = fq * 16 + fr; const int r = MODE ? (ln >> 2) : fr, cg = MODE ? (ln & 3) : fq;
        const int voff = r * ldb + (wc * 32 + 8 * cg) * 2;
#pragma unroll
        for (int bj = 0; bj < 2; ++bj)
#pragma unroll
            for (int ai = 0; ai < 2; ++ai)
#pragma unroll
                for (int m = 0; m < 4; ++m) { pg8::u32x4 w = __builtin_bit_cast(pg8::u32x4, acc[ai][bj][m][0] + acc[ai][bj][m][1]);
                    __builtin_amdgcn_raw_buffer_store_b128(w, rW, voff + bj * 256, sbase + (ai * 128 + m * 16) * ldb, 0); }
    }
};
struct EpiMerge {
    static constexpr bool PERM = true, HOOK = true; static constexpr bool PRELOAD = false; struct Pre {};
    const bf16* R; bf16* O;
    template <int NB  >
    __device__ __forceinline__ void scale(f32x4 (&acc)[2][2][4][2], const Unit& u, int plane, int wr, int wc, int fr, int fq) const {
        const __amdgpu_buffer_rsrc_t rs = __builtin_amdgcn_make_buffer_rsrc((void*)(R + (size_t)plane * R_PLANE), 0, 0x7fffffff, 0x00020000);
        int voff = (fr * D + 8 * fq) * 2; asm volatile("" : "+v"(voff));
        const int sbase = ((u.pm * 256 + wr * 64) * D + u.pn * 256 + wc * 32) * 2;
#pragma unroll
        for (int b0 = 0; b0 < 8; b0 += NB) {
            pg8::u32x4 w[NB][2];
#pragma unroll
            for (int i = 0; i < NB; ++i)
#pragma unroll
                for (int bj = 0; bj < 2; ++bj) { const int ai = (b0 + i) >> 2, m = (b0 + i) & 3;
                    w[i][bj] = __builtin_amdgcn_raw_buffer_load_b128(rs, voff + bj * 256, sbase + (ai * 128 + m * 16) * D * 2, 0); }
#pragma unroll
            for (int i = 0; i < NB; ++i)
#pragma unroll
                for (int bj = 0; bj < 2; ++bj) { const int ai = (b0 + i) >> 2, m = (b0 + i) & 3; const pg8::u32x4 v = w[i][bj];
                    acc[ai][bj][m][0] *= (f32x4){bflo(v.x), bfhi(v.x), bflo(v.y), bfhi(v.y)};
                    acc[ai][bj][m][1] *= (f32x4){bflo(v.z), bfhi(v.z), bflo(v.w), bfhi(v.w)};
                    asm volatile("" : "+v"(acc[ai][bj][m][0]), "+v"(acc[ai][bj][m][1])); }
            asm volatile("" ::: "memory"); }
    }
    __device__ __forceinline__ void hook(f32x4 (&acc)[2][2][4][2], const Unit& u, int g, int wr, int wc, int fr, int fq) const { scale<4>(acc, u, g - 1, wr, wc, fr, fq); }
    __device__ __forceinline__ void operator()(f32x4 (&acc)[2][2][4][2], const Unit& u, int wr, int wc, int fr, int fq) const {
        scale<4>(acc, u, 3, wr, wc, fr, fq);
        const int row0 = u.pm * 256 + wr * 64 + fr, col0 = u.pn * 256 + wc * 32 + 8 * fq;
#pragma unroll
        for (int ai = 0; ai < 2; ++ai)
#pragma unroll
            for (int m = 0; m < 4; ++m) { bf16* rowp = O + (size_t)(row0 + ai * 128 + m * 16) * D + col0;
#pragma unroll
                for (int bj = 0; bj < 2; ++bj) { const f32x4 v0 = acc[ai][bj][m][0], v1 = acc[ai][bj][m][1];
                    pg8::u32x4 w; w.x = pg8::cvt_pk_bf16(v0[0], v0[1]); w.y = pg8::cvt_pk_bf16(v0[2], v0[3]); w.z = pg8::cvt_pk_bf16(v1[0], v1[1]); w.w = pg8::cvt_pk_bf16(v1[2], v1[3]);
                    *(pg8::u32x4*)(rowp + bj * 128) = w; } }
    }
};
struct EpiRes {
    static constexpr bool PERM = false, HOOK = false; static constexpr bool PRELOAD = false; struct Pre {};
    float* H; bf16* HB; unsigned long long* ssa;
    __device__ __forceinline__ void operator()(f32x4 (&acc)[2][2][4][2], const Unit& u, int wr, int wc, int fr, int fq) const {
        const int row0 = u.pm * 256 + wr * 64 + fr, col0 = u.pn * 256 + wc * 32 + 4 * fq;
#pragma unroll
        for (int ai = 0; ai < 2; ++ai)
#pragma unroll
            for (int m = 0; m < 4; ++m) { const int row = row0 + ai * 128 + m * 16; const size_t off = (size_t)row * D + col0; float s = 0.f;
#pragma unroll
                for (int bj = 0; bj < 2; ++bj)
#pragma unroll
                    for (int n = 0; n < 2; ++n) { const size_t o = off + bj * 128 + n * 16; const f32x4 h = *(const f32x4*)(H + o) + acc[ai][bj][m][n];
                        *(f32x4*)(H + o) = h; pg8::u32x2 w; w.x = pg8::cvt_pk_bf16(h[0], h[1]); w.y = pg8::cvt_pk_bf16(h[2], h[3]); *(pg8::u32x2*)(HB + o) = w;
                        s += (h[0] * h[0] + h[1] * h[1]) + (h[2] * h[2] + h[3] * h[3]); }
                { const int ln = fq * 16 + fr; s += shf(s, ln ^ 16); s += shf(s, ln ^ 32); }
                if (fq == 0) atomicAdd(ssa + row, (unsigned long long)((double)s * 4294967296.0)); }
    }
};
struct EpiQ {
    static constexpr bool PERM = true, HOOK = false; static constexpr bool PRELOAD = false; struct Pre {};
    bf16* O; const unsigned long long* ssa;
    __device__ __forceinline__ void operator()(f32x4 (&acc)[2][2][4][2], const Unit& u, int wr, int wc, int fr, int fq) const {
        const int row0 = u.pm * 256 + wr * 64 + fr, col0 = u.pn * 256 + wc * 32 + 8 * fq;
#pragma unroll
        for (int ai = 0; ai < 2; ++ai)
#pragma unroll
            for (int m = 0; m < 4; ++m) { const int row = row0 + ai * 128 + m * 16; const float rs = rsqrtf(ssa_to_f(ssa[row]) * (1.0f / D) + EPS);
                bf16* rowp = O + (size_t)row * D + col0;
#pragma unroll
                for (int bj = 0; bj < 2; ++bj) { const f32x4 v0 = acc[ai][bj][m][0] * rs, v1 = acc[ai][bj][m][1] * rs;
                    pg8::u32x4 w; w.x = pg8::cvt_pk_bf16(v0[0], v0[1]); w.y = pg8::cvt_pk_bf16(v0[2], v0[3]); w.z = pg8::cvt_pk_bf16(v1[0], v1[1]); w.w = pg8::cvt_pk_bf16(v1[2], v1[3]);
                    *(pg8::u32x4*)(rowp + bj * 128) = w; } }
    }
};

__device__ __forceinline__ int colmap_in(int j) { return j < 1536 ? j : j + 4; }
__device__ __forceinline__ void tr_item_i8(const float* W, const float* gain, const unsigned* cmax, unsigned char* WT, LAS float* scr, int k0, int n0, int lane) {
    const int q = lane & 7, r8 = lane >> 3, sc = colmap_in(n0 + 4 * q);
    f32x4 v[8];
#pragma unroll
    for (int i = 0; i < 8; ++i) v[i] = *(const f32x4*)(W + (size_t)(k0 + 8 * i + r8) * INW + sc);
    f32x4 inv;
#pragma unroll
    for (int e = 0; e < 4; ++e) { const float cm = __builtin_bit_cast(float, cmax[sc + e]); inv[e] = cm > 0.f ? 127.0f / cm : 0.f; }
#pragma unroll
    for (int i = 0; i < 8; ++i) { const float g = gain[k0 + 8 * i + r8];
#pragma unroll
        for (int e = 0; e < 4; ++e) scr[(8 * i + r8) * 33 + 4 * q + e] = v[i][e] * g * inv[e]; }
    asm volatile("s_waitcnt lgkmcnt(0)" ::: "memory");
    const int n = lane >> 1, hf = lane & 1;
    v4u o[2];
#pragma unroll
    for (int w = 0; w < 8; ++w) { unsigned pk = 0;
#pragma unroll
        for (int b = 0; b < 4; ++b) pk |= ((unsigned)((int)rintf(scr[(32 * hf + 4 * w + b) * 33 + n]) & 255)) << (8 * b);
        o[w >> 2][w & 3] = pk; }
    unsigned char* dst = WT + (size_t)(n0 + n) * D + k0 + 32 * hf;
    *(v4u*)dst = o[0]; *(v4u*)(dst + 16) = o[1];
    asm volatile("s_waitcnt lgkmcnt(0)" ::: "memory");
}
template <bool MAP>
__device__ __forceinline__ void tr_item(const float* W, int ldw, const float* scale, bf16* WT, int ldt, int dcol0, LAS float* scr, int k0, int n0, int lane) {
    const int q = lane & 7, r8 = lane >> 3, sc = MAP ? colmap_in(n0 + 4 * q) : (n0 + 4 * q);
    f32x4 v[8];
#pragma unroll
    for (int i = 0; i < 8; ++i) v[i] = *(const f32x4*)(W + (size_t)(k0 + 8 * i + r8) * ldw + sc);
    f32x4 s0 = {1.f, 1.f, 1.f, 1.f}, s1 = s0;
    if (scale) { s0 = *(const f32x4*)(scale + k0 + 8 * q); s1 = *(const f32x4*)(scale + k0 + 8 * q + 4); }
#pragma unroll
    for (int i = 0; i < 8; ++i)
#pragma unroll
        for (int e = 0; e < 4; ++e) scr[(8 * i + r8) * 33 + 4 * q + e] = v[i][e];
    asm volatile("s_waitcnt lgkmcnt(0)" ::: "memory");
    const int c = q;
#pragma unroll
    for (int j = 0; j < 4; ++j) { const int n = r8 + 8 * j; const LAS float* s = scr + (8 * c) * 33 + n;
        v4u o; o.x = pk2(s[0 * 33] * s0[0], s[1 * 33] * s0[1]); o.y = pk2(s[2 * 33] * s0[2], s[3 * 33] * s0[3]); o.z = pk2(s[4 * 33] * s1[0], s[5 * 33] * s1[1]); o.w = pk2(s[6 * 33] * s1[2], s[7 * 33] * s1[3]);
        *(v4u*)(WT + (size_t)(n0 + n) * ldt + dcol0 + k0 + 8 * c) = o; }
    asm volatile("s_waitcnt lgkmcnt(0)" ::: "memory");
}
constexpr size_t WS_BAR = 512 * 1024;
#define XB_TMO      128
#define XB_XCNT(j)  (256  + 64 * (j))
#define XB_XSUB(j)  (1280 + 64 * (j))
#define XB_XGEN(j)  (2304 + 64 * (j))
#define XB_TOP      3328
#define XB_TOPGEN   3392
#define XCD_BAR_WORDS 3456
#define XB_SPIN_CAP (1u << 23)
__device__ __forceinline__ unsigned xb_ld(unsigned* p)              { return __hip_atomic_load(p, __ATOMIC_RELAXED, __HIP_MEMORY_SCOPE_AGENT); }
__device__ __forceinline__ unsigned xb_add(unsigned* p, unsigned v) { return __hip_atomic_fetch_add(p, v, __ATOMIC_RELAXED, __HIP_MEMORY_SCOPE_AGENT); }
__device__ __forceinline__ unsigned xb_xcc_id() { return (unsigned)__builtin_amdgcn_s_getreg((3 << 11) | 20) & 0xFu; }
#define XB_SPIN(cond, bar) do { unsigned _sp = 0; while (cond) { __builtin_amdgcn_s_sleep(1); \
    if ((++_sp & 255u) == 0u) { if (xb_ld(&(bar)[XB_TMO])) break; if (_sp > XB_SPIN_CAP) { atomicAdd(&(bar)[XB_TMO], 1u); break; } } } } while (0)
__device__ __forceinline__ void xcd_barrier_complete(unsigned* bar, unsigned x, unsigned G, unsigned& nloc, unsigned& nx) {
    unsigned sum, cnt, mine, sp = 0u;
    for (;;) {
        sum = 0u; cnt = 0u; mine = 0u;
#pragma unroll
        for (unsigned j = 0; j < 16; ++j) { const unsigned c = xb_ld(&bar[XB_XCNT(j)]); sum += c; cnt += (c > 0u) ? 1u : 0u; mine = (j == x) ? c : mine; }
        if (sum == G) break;
        __builtin_amdgcn_s_sleep(1);
        if ((++sp & 255u) == 0u) { if (xb_ld(&bar[XB_TMO])) break; if (sp > XB_SPIN_CAP) { atomicAdd(&bar[XB_TMO], 1u); break; } }
    }
    nloc = mine > 0u ? mine : 1u; nx = cnt > 0u ? cnt : 1u;
}
__device__ __forceinline__ void xcd_barrier(unsigned* bar, unsigned x, unsigned G, volatile LAS unsigned* st, int wave) {
    asm volatile("s_waitcnt vmcnt(0)" ::: "memory");
    __syncthreads();
    int lane; asm volatile("v_mbcnt_lo_u32_b32 %0, -1, 0\n\tv_mbcnt_hi_u32_b32 %0, -1, %0" : "=v"(lane));
    if (wave == 0 && lane == 0) {
        __builtin_amdgcn_s_waitcnt(0);
        unsigned nloc = st[0], nx = st[1];
        if (nloc == 0u) { xcd_barrier_complete(bar, x, G, nloc, nx); st[0] = nloc; st[1] = nx; }
        const unsigned old = xb_add(&bar[XB_XSUB(x)], 1u);
        const unsigned gen = old / nloc;
        if (old + 1u == (gen + 1u) * nloc) {
            __builtin_amdgcn_fence(__ATOMIC_RELEASE, "agent");
            asm volatile("s_waitcnt vmcnt(0)" ::: "memory");
            const unsigned og = xb_add(&bar[XB_TOP], 1u);
            const unsigned tg = og / nx;
            if (og + 1u == (tg + 1u) * nx) xb_add(&bar[XB_TOPGEN], 1u);
            else XB_SPIN(xb_ld(&bar[XB_TOPGEN]) == tg, bar);
            __builtin_amdgcn_fence(__ATOMIC_ACQUIRE, "agent");
            xb_add(&bar[XB_XGEN(x)], 1u);
            asm volatile("s_waitcnt vmcnt(0)" ::: "memory");
        } else {
            XB_SPIN(xb_ld(&bar[XB_XGEN(x)]) == gen, bar);
            __builtin_amdgcn_fence(__ATOMIC_ACQUIRE, "agent");
            asm volatile("s_waitcnt vmcnt(0)" ::: "memory");
        }
    }
    __syncthreads();
}
namespace att {
constexpr int D = 128, NW = 8, QBLK = 32, KVBLK = 64, QB = NW * QBLK;
constexpr int PITCH = 512, OPITCH = 2048;
constexpr float SCALE = 0.08838834764831845f, THR = 8.f;
constexpr int SHM_V = KVBLK * D * 2, SHM_K = KVBLK * D * 2;
constexpr int OFF_WS = 2 * SHM_V + 2 * SHM_K, OFF_CUM = OFF_WS + NW * 64 * 4, OFF_REL = OFF_CUM + 2048 * 4, LDS_END = OFF_REL + 320 * 4;
typedef unsigned short bf16;
typedef short bf16x8 __attribute__((ext_vector_type(8)));
typedef short s16x4 __attribute__((ext_vector_type(4)));
typedef float f32x16 __attribute__((ext_vector_type(16)));
typedef float f32x4 __attribute__((ext_vector_type(4)));
typedef unsigned u32x4 __attribute__((ext_vector_type(4)));
#define ALDS __attribute__((address_space(3)))

#define KSWZ(row, colB) ((row) * 256 + ((colB) ^ (((row) & 7) << 4)))
#define SBAR() __builtin_amdgcn_sched_barrier(0)
__device__ __forceinline__ int v_st(int k, int c) { const int kk = (k & ~0xC) | ((k & 4) << 1) | ((k & 8) >> 1); return ((kk >> 3) * 4 + (c >> 5)) * 512 + ((kk & 7) * 32 + (c & 31)) * 2; }
__device__ __forceinline__ int v_rd_base(int lane) { return ((lane & 3) << 3) | (((lane >> 2) & 3) << 6) | (((lane >> 4) & 1) << 5) | (((lane >> 5) & 1) << 8); }
constexpr int v_rd_off(int d0, int ks, int half) { return d0 * 512 + ks * 4096 + half * 2048; }
__device__ __forceinline__ int crow(int r, int hi) { return (r & 3) + 8 * (r >> 2) + 4 * hi; }
__device__ __forceinline__ unsigned cvtpk(float lo, float hi) { unsigned r; asm volatile("v_cvt_pk_bf16_f32 %0, %1, %2" : "=v"(r) : "v"(lo), "v"(hi)); return r; }
__device__ __forceinline__ bf16x8 load8(const bf16* p) { return *reinterpret_cast<const bf16x8*>(p); }

__device__ __forceinline__ void mask_tile(f32x16& p0, f32x16& p1, int dq) {
    const float NEG = -__builtin_inff();
#pragma unroll
    for (int r = 0; r < 16; ++r) { const int c = (r & 3) + 8 * (r >> 2);
        if (dq - c < 0) p0[r] = NEG;
        if (dq - c - 32 < 0) p1[r] = NEG; }
}
__device__ __forceinline__ void partialSM(f32x16& p0, f32x16& p1, float& m_reg, float& mn, float& alpha) {
    float pmax = p0[0];
#pragma unroll
    for (int r = 1; r < 16; ++r) pmax = fmaxf(pmax, p0[r]);
#pragma unroll
    for (int r = 0; r < 16; ++r) pmax = fmaxf(pmax, p1[r]);
    { auto rr = __builtin_amdgcn_permlane32_swap(__float_as_uint(pmax), __float_as_uint(pmax), false, false);
      pmax = fmaxf(__uint_as_float(rr[0]), __uint_as_float(rr[1])); }
    constexpr float C2 = 1.4426950408889634f * SCALE;
    if (__builtin_expect(__all((pmax - m_reg) * SCALE <= THR), 1)) { mn = m_reg; alpha = 1.f; }
    else { mn = fmaxf(m_reg, pmax); alpha = __builtin_amdgcn_exp2f((m_reg - mn) * C2); m_reg = mn; }
    const float mnL = -mn * C2;
#pragma unroll
    for (int r = 0; r < 16; ++r) p0[r] = fmaf(p0[r], C2, mnL);
#pragma unroll
    for (int r = 0; r < 16; ++r) p1[r] = fmaf(p1[r], C2, mnL);
#pragma unroll
    for (int r = 0; r < 16; ++r) p0[r] = __builtin_amdgcn_exp2f(p0[r]);
}
__device__ __forceinline__ void finishSM(f32x16& p0, f32x16& p1, float alpha, float& l_reg, bf16x8& pa0, bf16x8& pa1, bf16x8& pa2, bf16x8& pa3) {
#pragma unroll
    for (int r = 0; r < 16; ++r) p1[r] = __builtin_amdgcn_exp2f(p1[r]);
    float ps = 0;
#pragma unroll
    for (int r = 0; r < 16; ++r) ps += p0[r];
#pragma unroll
    for (int r = 0; r < 16; ++r) ps += p1[r];
    { auto rr = __builtin_amdgcn_permlane32_swap(__float_as_uint(ps), __float_as_uint(ps), false, false);
      ps = __uint_as_float(rr[0]) + __uint_as_float(rr[1]); }
    l_reg = l_reg * alpha + ps;
#define PK4(P, B_, OUT) do { unsigned a0 = cvtpk(P[B_+0], P[B_+1]), a1 = cvtpk(P[B_+2], P[B_+3]);                          \
        unsigned b0 = cvtpk(P[B_+4], P[B_+5]), b1 = cvtpk(P[B_+6], P[B_+7]);                                             \
        auto r0 = __builtin_amdgcn_permlane32_swap(a0, b0, false, false); auto r1 = __builtin_amdgcn_permlane32_swap(a1, b1, false, false); \
        u32x4 w = {r0[0], r1[0], r0[1], r1[1]}; OUT = *reinterpret_cast<bf16x8*>(&w); } while (0)
    PK4(p0, 0, pa0); PK4(p0, 8, pa1); PK4(p1, 0, pa2); PK4(p1, 8, pa3);
#undef PK4
}
template <int KB>
__device__ __forceinline__ void qkt(f32x16& p0, f32x16& p1, const ALDS char* K_lds, int r32, int hi, const bf16x8* qr, bool act) {
    if (!act) { const float NEG = -__builtin_inff();
#pragma unroll
        for (int r = 0; r < 16; ++r) { p0[r] = NEG; p1[r] = NEG; } return; }
    p0 = f32x16{}; p1 = f32x16{};
    const ALDS char* kb[4];
#pragma unroll
    for (int dd = 0; dd < 4; ++dd) kb[dd] = K_lds + KB * SHM_K + KSWZ(r32, (dd * 16 + hi * 8) * 2);
#pragma unroll
    for (int d0 = 0; d0 < 8; ++d0) { const ALDS char* a = kb[d0 & 3] + (d0 >> 2) * 128;
        bf16x8 b0 = *(const ALDS bf16x8*)(a);
        bf16x8 b1 = *(const ALDS bf16x8*)(a + 32 * 256);
        p0 = __builtin_amdgcn_mfma_f32_32x32x16_bf16(b0, qr[d0], p0, 0, 0, 0);
        p1 = __builtin_amdgcn_mfma_f32_32x32x16_bf16(b1, qr[d0], p1, 0, 0, 0); }
}
template <int VB>
__device__ __forceinline__ void pv_tile(f32x16* o, int vb0, bf16x8 pa0, bf16x8 pa1, bf16x8 pa2, bf16x8 pa3, bool act) {
    if (!act) return;
#define TRRD(dst, off) asm volatile("ds_read_b64_tr_b16 %0, %1 offset:%2" : "=&v"(dst) : "v"(vb0), "i"(off) : "memory")
#define PV_D0(d0) do { s16x4 l0, l1, l2, l3, h0, h1, h2, h3; constexpr int b_ = VB * SHM_V + v_rd_off(d0, 0, 0); \
        TRRD(l0, b_); TRRD(h0, b_ + 2048); TRRD(l1, b_ + 4096); TRRD(h1, b_ + 6144); TRRD(l2, b_ + 8192); TRRD(h2, b_ + 10240); TRRD(l3, b_ + 12288); TRRD(h3, b_ + 14336); \
        asm volatile("s_waitcnt lgkmcnt(0)" ::: "memory"); SBAR(); \
        o[d0] = __builtin_amdgcn_mfma_f32_32x32x16_bf16(pa0, (bf16x8){l0[0], l0[1], l0[2], l0[3], h0[0], h0[1], h0[2], h0[3]}, o[d0], 0, 0, 0);   \
        o[d0] = __builtin_amdgcn_mfma_f32_32x32x16_bf16(pa1, (bf16x8){l1[0], l1[1], l1[2], l1[3], h1[0], h1[1], h1[2], h1[3]}, o[d0], 0, 0, 0);   \
        o[d0] = __builtin_amdgcn_mfma_f32_32x32x16_bf16(pa2, (bf16x8){l2[0], l2[1], l2[2], l2[3], h2[0], h2[1], h2[2], h2[3]}, o[d0], 0, 0, 0);   \
        o[d0] = __builtin_amdgcn_mfma_f32_32x32x16_bf16(pa3, (bf16x8){l3[0], l3[1], l3[2], l3[3], h3[0], h3[1], h3[2], h3[3]}, o[d0], 0, 0, 0); } while (0)
    PV_D0(0); PV_D0(1); PV_D0(2); PV_D0(3);
#undef PV_D0
#undef TRRD
}
template <int MODE>
__device__ __forceinline__ void bias_mask(f32x16& p0, f32x16& p1, const ALDS char* lds, int kb, int qlo, int qpos, int hi, float cqs, bool act) {
    if (!act) return;
    if (MODE == 0) {
        const ALDS float* cs = (const ALDS float*)(lds + OFF_CUM) + kb + 4 * hi;
#pragma unroll
        for (int g = 0; g < 4; ++g) { const f32x4 c0 = *(const ALDS f32x4*)(cs + 8 * g), c1 = *(const ALDS f32x4*)(cs + 32 + 8 * g);
#pragma unroll
            for (int e = 0; e < 4; ++e) { p0[4 * g + e] += cqs - c0[e]; p1[4 * g + e] += cqs - c1[e]; } }
        if (kb + KVBLK - 1 > qlo) mask_tile(p0, p1, qpos - 4 * hi - kb);
    } else {
        const ALDS float* tb = (const ALDS float*)(lds + OFF_REL);
        if (qlo - (kb + KVBLK - 1) >= 256) { const float c = tb[319];
#pragma unroll
            for (int r = 0; r < 16; ++r) { p0[r] += c; p1[r] += c; } }
        else { const int d0 = qpos - kb - 4 * hi + 63;
#pragma unroll
            for (int r = 0; r < 16; ++r) { const int c = (r & 3) + 8 * (r >> 2);
                int i0 = d0 - c, i1 = d0 - c - 32; i0 = i0 > 319 ? 319 : i0; i1 = i1 > 319 ? 319 : i1; i1 = i1 < 0 ? 0 : i1; i0 = i0 < 0 ? 0 : i0;
                p0[r] += tb[i0]; p1[r] += tb[i1]; } }
    }
}

struct Seam { bf16x8 qr[8]; bf16x8 st_v0, st_v1, st_k0, st_k1; };
#define VMW() asm volatile("s_waitcnt vmcnt(0)" ::: "memory")
#define BL8(rs, vo, so) __builtin_bit_cast(bf16x8, __builtin_amdgcn_raw_buffer_load_b128(rs, vo, so, 0))
#define SLOAD_H(Kp, Vp, k0) do { S.st_v0 = BL8(rP, kvoff, (Vp) + (k0) * (PITCH * 2)); S.st_v1 = BL8(rP, kvoff, (Vp) + ((k0) + 32) * (PITCH * 2));              \
                         S.st_k0 = BL8(rP, kvoff, (Kp) + (k0) * (PITCH * 2)); S.st_k1 = BL8(rP, kvoff, (Kp) + ((k0) + 32) * (PITCH * 2)); } while (0)
#define SWRITE_HK(bf) do { *(ALDS bf16x8*)(K_lds + (bf) * SHM_K + kws) = S.st_k0; *(ALDS bf16x8*)(K_lds + (bf) * SHM_K + kws + 32 * 256) = S.st_k1; } while (0)
#define SWRITE_HV(bf) do { *(ALDS bf16x8*)(V_lds + (bf) * SHM_V + vst0) = S.st_v0; *(ALDS bf16x8*)(V_lds + (bf) * SHM_V + vst1) = S.st_v1; } while (0)
#define SWRITE_H(bf) do { SWRITE_HV(bf); SWRITE_HK(bf); } while (0)

template <int MODE>
__device__ __forceinline__ void attn_unit(const bf16* Pb, int Qo, int Kh, int Vh, bf16* Yb, int Oo, int P0, int j_lo, int j_hi, ALDS char* lds, int wid, int lane) {
    const int tid = wid * 64 + lane, r32 = lane & 31, hi = lane >> 5;
    const int NT = j_hi - j_lo;
    const int qlo = P0 + wid * QBLK, qpos = qlo + r32;
    ALDS char* V_lds = lds; ALDS char* K_lds = lds + 2 * SHM_V;
    ALDS float* ws = (ALDS float*)(lds + OFF_WS) + wid * 64; ALDS float* li_l = ws; ALDS float* al_l = ws + 32;
    float m_reg = -1e30f, l_reg = 0; f32x16 o[4] = {};
    const int sr = tid >> 4, sc = (tid & 15) * 8, vst0 = v_st(sr, sc), vst1 = v_st(32 + sr, sc), kws = KSWZ(sr, sc * 2);
    const int vb0 = (int)(unsigned)(size_t)V_lds + v_rd_base(lane);
    Seam S;
    const __amdgpu_buffer_rsrc_t rP = __builtin_amdgcn_make_buffer_rsrc((void*)Pb, 0, 0x7fffffff, 0x00020000);
    const __amdgpu_buffer_rsrc_t rO = __builtin_amdgcn_make_buffer_rsrc((void*)Yb, 0, 0x7fffffff, 0x00020000);
    const int kvoff = (sr * PITCH + sc) * 2;
#define KBASE(t) ((j_lo + (t)) * KVBLK)
#define ACT(t) (MODE == 0 ? (KBASE(t) <= qlo + QBLK - 1) : ((j_lo + (t)) <= (qlo >> 6) && (j_lo + (t)) + 8 >= (qlo >> 6)))
#define RESC(a) do { if (__any((a) < 1.f)) { if (hi == 0) al_l[r32] = (a); asm volatile("s_waitcnt lgkmcnt(0)" ::: "memory");              \
                     for (int d_ = 0; d_ < 4; ++d_) for (int r = 0; r < 16; ++r) o[d_][r] *= al_l[crow(r, hi)]; } } while (0)
#define MASKT(P0_, P1_, t) bias_mask<MODE>(P0_, P1_, lds, KBASE(t), qlo, qpos, hi, cq_, ACT(t))
    {
        const int kb0 = j_lo * KVBLK;
#pragma unroll
        for (int d0 = 0; d0 < 8; ++d0) S.qr[d0] = BL8(rP, (r32 * PITCH + hi * 8) * 2 + d0 * 32, Qo + wid * (QBLK * PITCH * 2));
        SLOAD_H(Kh, Vh, kb0); VMW(); SWRITE_HK(0);
        __syncthreads();
    }
    const float cq_ = MODE == 0 ? ((const ALDS float*)(lds + OFF_CUM))[qpos] : 0.f;
    f32x16 pA0, pA1, pB0, pB1; float mnA, mnB, alA, alB; bf16x8 pa0, pa1, pa2, pa3;
    SWRITE_HV(0); SBAR();
    if (NT > 1) { SLOAD_H(Kh, Vh, KBASE(1)); }
    SBAR(); qkt<0>(pA0, pA1, K_lds, r32, hi, S.qr, ACT(0));
    MASKT(pA0, pA1, 0); partialSM(pA0, pA1, m_reg, mnA, alA);
    if (NT > 1) { VMW(); SWRITE_H(1); }
    __syncthreads();
#define HALF_STEP(PX0, PX1, mnX, alX, PY0, PY1, alY, t, KB, VB, SB) do {                                                      \
        SBAR(); qkt<KB>(PX0, PX1, K_lds, r32, hi, S.qr, ACT(t));                                                              \
        finishSM(PY0, PY1, alY, l_reg, pa0, pa1, pa2, pa3); SBAR();                                                           \
        if ((t) + 1 < NT) { SLOAD_H(Kh, Vh, KBASE((t) + 1)); SBAR(); }                                                        \
        pv_tile<VB>(o, vb0, pa0, pa1, pa2, pa3, ACT((t) - 1)); MASKT(PX0, PX1, (t)); partialSM(PX0, PX1, m_reg, mnX, alX);    \
        __syncthreads();                                                                                                      \
        if ((t) + 1 < NT) { VMW(); SWRITE_H(SB); }                                                                            \
        RESC(alX); __syncthreads(); } while (0)
    for (int t = 1; t + 1 < NT; t += 2) {
        HALF_STEP(pB0, pB1, mnB, alB, pA0, pA1, alA, t, 1, 0, 0);
        HALF_STEP(pA0, pA1, mnA, alA, pB0, pB1, alB, t + 1, 0, 1, 1);
    }
    const bool even = (NT & 1) == 0;
    if (even) { SBAR(); qkt<1>(pB0, pB1, K_lds, r32, hi, S.qr, ACT(NT - 1)); SBAR(); }
    finishSM(pA0, pA1, alA, l_reg, pa0, pa1, pa2, pa3); SBAR();
    pv_tile<0>(o, vb0, pa0, pa1, pa2, pa3, ACT(even ? NT - 2 : NT - 1));
    if (even) { MASKT(pB0, pB1, NT - 1); partialSM(pB0, pB1, m_reg, mnB, alB); __syncthreads(); RESC(alB);
        finishSM(pB0, pB1, alB, l_reg, pa0, pa1, pa2, pa3); SBAR(); pv_tile<1>(o, vb0, pa0, pa1, pa2, pa3, ACT(NT - 1)); }
    SBAR();
    if (hi == 0) li_l[r32] = l_reg; asm volatile("s_waitcnt lgkmcnt(0)" ::: "memory");
    float rli[16];
#pragma unroll
    for (int r = 0; r < 16; ++r) rli[r] = __builtin_amdgcn_rcpf(li_l[crow(r, hi)]);
    const int ovoff = (4 * hi * OPITCH + r32) * 2, osoff = Oo + wid * (QBLK * OPITCH * 2);
#pragma unroll
    for (int r = 0; r < 16; ++r) { const int orow = (r & 3) + 8 * (r >> 2);
#pragma unroll
        for (int d0 = 0; d0 < 4; ++d0) { const float v = o[d0][r] * rli[r];
            const float vn = __builtin_bit_cast(float, __builtin_amdgcn_ds_bpermute((lane ^ 1) << 2, __builtin_bit_cast(int, v)));
            if ((r32 & 1) == 0) __builtin_amdgcn_raw_buffer_store_b32(cvtpk(v, vn), rO, ovoff + d0 * 64, osoff + orow * (OPITCH * 2), 0); } }
    __syncthreads();
#undef RESC
#undef KBASE
#undef ACT
#undef MASKT
#undef HALF_STEP
}
#undef BL8
#undef VMW
#undef SLOAD_H
#undef SWRITE_HK
#undef SWRITE_HV
#undef SWRITE_H
#undef KSWZ
#undef SBAR
}
constexpr size_t WS_QCTR = 768 * 1024;
constexpr size_t WS_POOLW = 4 * MiB;
constexpr int N_ATT_UNITS = 256, N_POOL_UNITS = 512, N_CONV_UNITS = 128, N_GATE_UNITS = 512;

__device__ __forceinline__ void stage_cum(const Args& a, int b, int h, LAS char* lds, int wave, int lane) {
    const float* logf = (const float*)(a.ws + WS_LOGF) + ((size_t)b * SEQ) * 4 + h;
    const int tid = wave * 64 + lane;
    float v[4];
#pragma unroll
    for (int e = 0; e < 4; ++e) v[e] = logf[(size_t)(4 * tid + e) * 4];
    v[1] += v[0]; v[2] += v[1]; v[3] += v[2];
    float incl = v[3];
#pragma unroll
    for (int o = 1; o < 64; o <<= 1) { const float t = shf(incl, lane >= o ? lane - o : lane); if (lane >= o) incl += t; }
    LAS float* wt = (LAS float*)(lds + att::OFF_WS);
    if (lane == 63) wt[wave] = incl;
    __syncthreads();
    float base = incl - v[3];
    for (int w = 0; w < wave; ++w) base += wt[w];
    LAS float* cs = (LAS float*)(lds + att::OFF_CUM);
    const float inv = 1.0f / ATT_SCALE;
    *(LAS f32x4*)(cs + 4 * tid) = (f32x4){(base + v[0]) * inv, (base + v[1]) * inv, (base + v[2]) * inv, (base + v[3]) * inv};
    __syncthreads();
}
__device__ __forceinline__ void attention_item(const Args& a, int l, int u, LAS char* lds, int wave) {
    int lane; asm volatile("v_mbcnt_lo_u32_b32 %0, -1, 0\n\tv_mbcnt_hi_u32_b32 %0, -1, %0" : "=v"(lane));
    const bf16* P = (const bf16*)(a.ws + WS_PROJ); bf16* Y = (bf16*)(a.ws + WS_Y);
    const int mode = u >> 7, v = u & 127, qb = 7 - (v >> 4), bh = v & 15, b = bh >> 2, h = bh & 3;
    const size_t row0 = (size_t)b * SEQ; const int P0 = qb * 256;
    if (mode == 0) {
        stage_cum(a, b, h, lds, wave, lane);
        att::attn_unit<0>(P, (int)((0 * PROJ_T + (row0 + P0) * MIXW + h * HD) * 2), (int)((1 * PROJ_T + row0 * MIXW + h * HD) * 2), (int)((2 * PROJ_T + row0 * MIXW + h * HD) * 2),
                          Y, (int)(((row0 + P0) * D + h * HD) * 2), P0, 0, 4 * qb + 4, lds, wave, lane);
    } else {
        const int tid = wave * 64 + lane;
        if (tid < 320) ((LAS float*)(lds + att::OFF_REL))[tid] = a.rel_bias[((size_t)l * 4 + h) * 320 + tid] * (1.0f / ATT_SCALE);
        const int jlo = 4 * qb - 8 < 0 ? 0 : 4 * qb - 8;
        att::attn_unit<1>(P, (int)((7 * PROJ_T + (row0 + P0) * MIXW + h * HD) * 2), (int)((8 * PROJ_T + row0 * MIXW + h * HD) * 2), (int)((9 * PROJ_T + row0 * MIXW + h * HD) * 2),
                          Y, (int)(((row0 + P0) * D + 1536 + h * HD) * 2), P0, jlo, 4 * qb + 4, lds, wave, lane);
    }
}
__device__ __forceinline__ void pool_item(const Args& a, int l, int u, LAS char* lds, int wave) {
    int lane; asm volatile("v_mbcnt_lo_u32_b32 %0, -1, 0\n\tv_mbcnt_hi_u32_b32 %0, -1, %0" : "=v"(lane));
    const int g = u & 3, T0 = (u >> 2) * 64, tid = wave * 64 + lane;
    const bf16* Pin = (const bf16*)(a.ws + WS_PROJ) + 3 * PROJ_T + g * 128;
    {
        const int cp = tid & 63, run = tid >> 6, w = 2 << g, t0 = T0 + run * 8, s0 = t0 & (SEQ - 1);
        const bf16* col = Pin + 2 * cp;
        float s_lo = 0.f, s_hi = 0.f;
        for (int j = 1; j < w; ++j) if (s0 - j >= 0) { const unsigned x = *(const unsigned*)(col + (size_t)(t0 - j) * MIXW); s_lo += bflo(x); s_hi += bfhi(x); }
#pragma unroll
        for (int i = 0; i < 8; ++i) { const unsigned x = *(const unsigned*)(col + (size_t)(t0 + i) * MIXW); s_lo += bflo(x); s_hi += bfhi(x);
            const int s = s0 + i; const int cnt = s + 1 < w ? s + 1 : w; const float inv = 1.0f / (float)cnt;
            *(LAS unsigned*)(lds + (run * 8 + i) * 272 + 4 * cp) = pk2(s_lo * inv - bflo(x), s_hi * inv - bfhi(x));
            if (s - w + 1 >= 0) { const unsigned y = *(const unsigned*)(col + (size_t)(t0 + i - w + 1) * MIXW); s_lo -= bflo(y); s_hi -= bfhi(y); } }
    }
    __syncthreads();
    {
        typedef short bf16x8 __attribute__((ext_vector_type(8)));
        const bf16* Wt = (const bf16*)(a.ws + WS_POOLW) + ((size_t)l * 4 + g) * 128 * 128;
        const int rt = (wave & 3) * 16, db = (wave >> 2) * 64, fr = lane & 15, kg = lane >> 4;
        f32x4 acc[4] = {};
#pragma unroll
        for (int ks = 0; ks < 4; ++ks) { const bf16x8 af = *(const LAS bf16x8*)(lds + (rt + fr) * 272 + (ks * 32 + kg * 8) * 2);
#pragma unroll
            for (int nt = 0; nt < 4; ++nt) { const bf16x8 bfr = *(const bf16x8*)(Wt + (size_t)(db + nt * 16 + fr) * 128 + ks * 32 + kg * 8);
                acc[nt] = __builtin_amdgcn_mfma_f32_16x16x32_bf16(bfr, af, acc[nt], 0, 0, 0); } }
        bf16* Y = (bf16*)(a.ws + WS_Y) + (size_t)(T0 + rt + fr) * D + 512 + g * 128;
#pragma unroll
        for (int nt = 0; nt < 4; ++nt) { const int d = db + nt * 16 + kg * 4; const f32x4 sc = *(const f32x4*)(a.pool_scale + l * MIXW + g * 128 + d);
            v2u w; w.x = pk2(acc[nt][0] * sc[0], acc[nt][1] * sc[1]); w.y = pk2(acc[nt][2] * sc[2], acc[nt][3] * sc[3]); *(v2u*)(Y + d) = w; }
    }
    __syncthreads();
}
__device__ __forceinline__ void conv_item(const Args& a, int l, int u, int wave) {
    int lane; asm volatile("v_mbcnt_lo_u32_b32 %0, -1, 0\n\tv_mbcnt_hi_u32_b32 %0, -1, %0" : "=v"(lane));
    const bf16* P = (const bf16*)(a.ws + WS_PROJ); const bf16* Ch = P + 4 * PROJ_T; const bf16* Cb = P + 5 * PROJ_T; const bf16* Cc = P + 6 * PROJ_T;
    const int tid = wave * 64 + lane, c0 = (tid & 63) * 8, t0 = u * 64 + (tid >> 6) * 8, s0 = t0 & (SEQ - 1);
    float wgt[3][8];
#pragma unroll
    for (int j = 0; j < 3; ++j) { const float* w = a.conv_w + ((size_t)l * 3 + j) * MIXW + c0; const f32x4 w0 = *(const f32x4*)w, w1 = *(const f32x4*)(w + 4);
#pragma unroll
        for (int k = 0; k < 4; ++k) { wgt[j][k] = w0[k]; wgt[j][4 + k] = w1[k]; } }
    float z2[8], z1[8];
#pragma unroll
    for (int k = 0; k < 8; ++k) { z2[k] = 0.f; z1[k] = 0.f; }
#pragma unroll
    for (int i = -2; i < 8; ++i) {
        float z[8];
        if (s0 + i >= 0) { const v4u hv = *(const v4u*)(Ch + (size_t)(t0 + i) * MIXW + c0), cv = *(const v4u*)(Cc + (size_t)(t0 + i) * MIXW + c0);
            z[0] = bflo(hv.x) * bflo(cv.x); z[1] = bfhi(hv.x) * bfhi(cv.x); z[2] = bflo(hv.y) * bflo(cv.y); z[3] = bfhi(hv.y) * bfhi(cv.y);
            z[4] = bflo(hv.z) * bflo(cv.z); z[5] = bfhi(hv.z) * bfhi(cv.z); z[6] = bflo(hv.w) * bflo(cv.w); z[7] = bfhi(hv.w) * bfhi(cv.w); }
        else {
#pragma unroll
            for (int k = 0; k < 8; ++k) z[k] = 0.f; }
        if (i >= 0) { const v4u bv = *(const v4u*)(Cb + (size_t)(t0 + i) * MIXW + c0); float o[8];
            const float bb[8] = {bflo(bv.x), bfhi(bv.x), bflo(bv.y), bfhi(bv.y), bflo(bv.z), bfhi(bv.z), bflo(bv.w), bfhi(bv.w)};
#pragma unroll
            for (int k = 0; k < 8; ++k) o[k] = bb[k] * (wgt[0][k] * z2[k] + wgt[1][k] * z1[k] + wgt[2][k] * z[k]);
            v4u ov; ov.x = pk2(o[0], o[1]); ov.y = pk2(o[2], o[3]); ov.z = pk2(o[4], o[5]); ov.w = pk2(o[6], o[7]);
            *(v4u*)((bf16*)(a.ws + WS_Y) + (size_t)(t0 + i) * D + 1024 + c0) = ov; }
#pragma unroll
        for (int k = 0; k < 8; ++k) { z2[k] = z1[k]; z1[k] = z[k]; }
    }
}
__device__ __forceinline__ void gate_item(const Args& a, int u, int wave) {
    int lane; asm volatile("v_mbcnt_lo_u32_b32 %0, -1, 0\n\tv_mbcnt_hi_u32_b32 %0, -1, %0" : "=v"(lane));
    const bf16* G = (const bf16*)(a.ws + WS_G); bf16* R = (bf16*)(a.ws + WS_R);
    const int tid = wave * 64 + lane;
#pragma unroll 2
    for (int i = 0; i < 8; ++i) { const int e = tid + 512 * i, row = u * 16 + (e >> 8), d0 = (e & 255) * 8;
        const bf16* gp = G + (size_t)row * (4 * D) + d0; v4u z[4];
#pragma unroll
        for (int g = 0; g < 4; ++g) z[g] = *(const v4u*)(gp + g * D);
        float E[4][8], I[4][8];
#pragma unroll
        for (int g = 0; g < 4; ++g) { const unsigned w[4] = {z[g].x, z[g].y, z[g].z, z[g].w};
#pragma unroll
            for (int k = 0; k < 4; ++k) { E[g][2 * k] = fminf(1.0f + __builtin_amdgcn_exp2f(-1.4426950408889634f * bflo(w[k])), 1e18f); E[g][2 * k + 1] = fminf(1.0f + __builtin_amdgcn_exp2f(-1.4426950408889634f * bfhi(w[k])), 1e18f); }
#pragma unroll
            for (int k = 0; k < 8; ++k) I[g][k] = __builtin_amdgcn_rcpf(E[g][k]); }
#pragma unroll
        for (int g = 0; g < 4; ++g) { float r[8];
#pragma unroll
            for (int k = 0; k < 8; ++k) r[k] = g < 3 ? E[g + 1][k] * I[g][k] : I[3][k];
            v4u o; o.x = pk2(r[0], r[1]); o.y = pk2(r[2], r[3]); o.z = pk2(r[4], r[5]); o.w = pk2(r[6], r[7]);
            *(v4u*)(R + (size_t)g * R_PLANE + (size_t)row * D + d0) = o; } }
}
__device__ __forceinline__ void mixers_fast(const Args& a, int lq, LAS char* lds, int wave, int lane, int G, int blk) {
    const int l = lq & 1;
    for (int u = blk; u < N_ATT_UNITS; u += G) attention_item(a, l, u, lds, wave);
    unsigned* head = (unsigned*)(a.ws + WS_QCTR) + 64 * lq;
    volatile LAS unsigned* slot = (volatile LAS unsigned*)(lds + att::LDS_END);
    for (;;) {
        if (wave == 0 && lane == 0) *slot = __hip_atomic_fetch_add(head, 1u, __ATOMIC_RELAXED, __HIP_MEMORY_SCOPE_AGENT);
        __syncthreads();
        const unsigned it = *slot;
        __syncthreads();
        if (it >= (unsigned)(N_POOL_UNITS + N_CONV_UNITS + N_GATE_UNITS)) break;
        if (it < (unsigned)N_POOL_UNITS) pool_item(a, l, (int)it, lds, wave); else if (it < (unsigned)(N_POOL_UNITS + N_CONV_UNITS)) conv_item(a, l, (int)it - N_POOL_UNITS, wave); else gate_item(a, (int)it - N_POOL_UNITS - N_CONV_UNITS, wave);
    }
}
__device__ __forceinline__ void p0_cmax(const Args& a, int gw, int NGW, int lane) {
    unsigned char* ws = a.ws;
    {
        constexpr int NCC = (INW + 255) / 256;
        for (int it = gw; it < DEPTH * 32 * NCC; it += NGW) { const int l = it / (32 * NCC), r = it % (32 * NCC), kc = r / NCC, cc = r % NCC; const int c0 = cc * 256 + 4 * lane;
            if (c0 + 3 < INW) { const float* W = a.w_in + (size_t)l * D * INW + (size_t)(kc * 64) * INW + c0; const float* g = a.norm_mix + l * D + kc * 64;
                float m0 = 0.f, m1 = 0.f, m2 = 0.f, m3 = 0.f;
#pragma unroll 8
                for (int k = 0; k < 64; ++k) { const f32x4 w = *(const f32x4*)(W + (size_t)k * INW); const float gk = fabsf(g[k]);
                    m0 = fmaxf(m0, fabsf(w[0]) * gk); m1 = fmaxf(m1, fabsf(w[1]) * gk); m2 = fmaxf(m2, fabsf(w[2]) * gk); m3 = fmaxf(m3, fabsf(w[3]) * gk); }
                unsigned* cm = (unsigned*)(ws + WS_CMAX) + l * INW + c0;
                const unsigned u0 = __float_as_uint(m0), u1 = __float_as_uint(m1), u2 = __float_as_uint(m2), u3 = __float_as_uint(m3);
                __hip_atomic_fetch_max(cm + 0, u0, __ATOMIC_RELAXED, __HIP_MEMORY_SCOPE_AGENT); __hip_atomic_fetch_max(cm + 1, u1, __ATOMIC_RELAXED, __HIP_MEMORY_SCOPE_AGENT);
                __hip_atomic_fetch_max(cm + 2, u2, __ATOMIC_RELAXED, __HIP_MEMORY_SCOPE_AGENT); __hip_atomic_fetch_max(cm + 3, u3, __ATOMIC_RELAXED, __HIP_MEMORY_SCOPE_AGENT); } }
    }
}
__device__ __forceinline__ void p0_prologue(const Args& a, LAS unsigned char* lds, int gw, int NGW, int wave, int lane) {
    unsigned char* ws = a.ws;
    LAS float* scr = (LAS float*)(lds + wave * 16384);
    constexpr int I_SQ = (D / 64) * (D / 32), I_BR = (MIXW / 64) * (D / 32);
    constexpr int I_LAYER = 4 * I_BR + 2 * I_SQ;
    for (int it = gw; it < DEPTH * I_LAYER; it += NGW) {
        const int l = it / I_LAYER; int r = it - l * I_LAYER;
        if (r < 4 * I_BR) { const int g = r / I_BR, rr = r % I_BR, kb = rr / (D / 32), nb = rr % (D / 32);
            tr_item<false>(a.w_branch + ((size_t)l * 4 + g) * MIXW * D, D, nullptr, (bf16*)(ws + WS_WBR + l * SQ_BYTES), D, g * MIXW, scr, 64 * kb, 32 * nb, lane); continue; }
        r -= 4 * I_BR;
        if (r < I_SQ) { const int kb = r / (D / 32), nb = r % (D / 32);
            tr_item<false>(a.w_out + (size_t)l * D * D, D, nullptr, (bf16*)(ws + WS_WOUT + l * SQ_BYTES), D, 0, scr, 64 * kb, 32 * nb, lane); continue; }
        r -= I_SQ;
        { const int kb = r / (D / 32), nb = r % (D / 32);
            tr_item<false>(a.peer_wq + (size_t)l * D * D, D, a.norm_ffn + l * D, (bf16*)(ws + WS_WQ + l * SQ_BYTES), D, 0, scr, 64 * kb, 32 * nb, lane); }
    }
    for (int it = gw; it < DEPTH * 4 * 8; it += NGW) { const int lg = it >> 3, r = it & 7;
        tr_item<false>(a.pool_w + (size_t)lg * 128 * 128, 128, nullptr, (bf16*)(ws + WS_POOLW) + (size_t)lg * 128 * 128, 128, 0, scr, 64 * (r >> 2), 32 * (r & 3), lane); }
    {
        constexpr int NR = 2 * DEPTH * PEER_E;
        f32x4 nv[8];
        if (gw < NR) { const int t = gw / (DEPTH * PEER_E), row = gw - t * (DEPTH * PEER_E); const float* src = (t ? a.peer_v : a.peer_u) + (size_t)row * D + 4 * lane;
#pragma unroll
            for (int j = 0; j < 8; ++j) nv[j] = *(const f32x4*)(src + 256 * j); }
        for (int r = gw; r < NR; r += NGW) { const int t = r / (DEPTH * PEER_E), row = r - t * (DEPTH * PEER_E);
            f32x4 v[8]; float am = 0.f;
#pragma unroll
            for (int j = 0; j < 8; ++j) v[j] = nv[j];
            { const int r2 = r + NGW; if (r2 < NR) { const int t2 = r2 / (DEPTH * PEER_E), row2 = r2 - t2 * (DEPTH * PEER_E); const float* src = (t2 ? a.peer_v : a.peer_u) + (size_t)row2 * D + 4 * lane;
#pragma unroll
                for (int j = 0; j < 8; ++j) nv[j] = *(const f32x4*)(src + 256 * j); } }
#pragma unroll
            for (int j = 0; j < 8; ++j) am = fmaxf(am, fmaxf(fmaxf(fabsf(v[j][0]), fabsf(v[j][1])), fmaxf(fabsf(v[j][2]), fabsf(v[j][3]))));
            am = wave_max(am, lane);
            const float inv = am > 0.f ? 127.0f / am : 0.f, off = 0.f;
            unsigned char* dst = ws + (t ? WS_PV : WS_PU) + (size_t)row * D + 4 * lane;
#pragma unroll
            for (int j = 0; j < 8; ++j) { const int q0 = (int)(rintf(v[j][0] * inv) + off), q1 = (int)(rintf(v[j][1] * inv) + off), q2 = (int)(rintf(v[j][2] * inv) + off), q3 = (int)(rintf(v[j][3] * inv) + off);
                *(unsigned*)(dst + 256 * j) = (unsigned)(q0 & 255) | ((unsigned)(q1 & 255) << 8) | ((unsigned)(q2 & 255) << 16) | ((unsigned)(q3 & 255) << 24); }
            if (lane == 0) ((float*)(ws + (t ? WS_SV : WS_SU)))[row] = am * (1.0f / 127.0f); }
    }
    { bf16* pk = (bf16*)(ws + WS_PK); const size_t n8 = (size_t)DEPTH * 8 * 2 * 128 * 128 / 8;
      for (size_t i = (size_t)gw * 64 + lane; i < n8; i += (size_t)NGW * 64) { const f32x4 v0 = *(const f32x4*)(a.peer_keys + i * 8), v1 = *(const f32x4*)(a.peer_keys + i * 8 + 4);
          v4u o; o.x = pk2(v0[0], v0[1]); o.y = pk2(v0[2], v0[3]); o.z = pk2(v1[0], v1[1]); o.w = pk2(v1[2], v1[3]); *(v4u*)(pk + i * 8) = o; } }
    {
        float* wf = (float*)(ws + WS_WF); float* binr = (float*)(ws + WS_BINR);
        const int gt = gw * 64 + lane, NGT = NGW * 64;
        for (int i = gt; i < DEPTH * 4 * D; i += NGT) { const int l = i / (4 * D), h = (i / D) & 3, k = i % D; wf[i] = a.w_in[(size_t)l * D * INW + (size_t)k * INW + 1536 + h] * a.norm_mix[l * D + k]; }
        for (int i = gt; i < DEPTH * NPROJ; i += NGT) { const int l = i / NPROJ, j = i % NPROJ; binr[i] = a.b_in[l * INW + colmap_in(j)]; }
    }
    {
        float* H = (float*)(ws + WS_H); bf16* HB = (bf16*)(ws + WS_HB); unsigned long long* ssq = (unsigned long long*)(ws + WS_SSQ);
        for (int m = gw; m < M; m += NGW) { float s = 0.f, am = 0.f; f32x4 v[8];
#pragma unroll
            for (int j = 0; j < 8; ++j) { const size_t o = (size_t)m * D + j * 256 + lane * 4; v[j] = *(const f32x4*)(a.x + o); *(f32x4*)(H + o) = v[j];
                v2u w; w.x = pk2(v[j][0], v[j][1]); w.y = pk2(v[j][2], v[j][3]); *(v2u*)(HB + o) = w; s += (v[j][0] * v[j][0] + v[j][1] * v[j][1]) + (v[j][2] * v[j][2] + v[j][3] * v[j][3]);
                am = fmaxf(am, fmaxf(fmaxf(fabsf(v[j][0]), fabsf(v[j][1])), fmaxf(fabsf(v[j][2]), fabsf(v[j][3])))); }
            s = wave_sum(s, lane); am = wave_max(am, lane); if (lane == 0) { ssq[m] = (unsigned long long)((double)s * 4294967296.0); ((float*)(ws + WS_RSA))[m] = rsqrtf(s * (1.0f / D) + EPS) * am * (1.0f / 127.0f); }
            const float inv = am > 0.f ? 127.0f / am : 0.f; unsigned char* q8 = ws + WS_HB8 + (size_t)m * D + 4 * lane;
#pragma unroll
            for (int j = 0; j < 8; ++j) *(unsigned*)(q8 + 256 * j) = ((unsigned)((int)rintf(v[j][0] * inv) & 255)) | ((unsigned)((int)rintf(v[j][1] * inv) & 255) << 8) | ((unsigned)((int)rintf(v[j][2] * inv) & 255) << 16) | ((unsigned)((int)rintf(v[j][3] * inv) & 255) << 24); }
    }
}
__device__ __forceinline__ void p0_win_i8(const Args& a, LAS unsigned char* lds, int gw, int NGW, int wave, int lane) {
    unsigned char* ws = a.ws; LAS float* scr = (LAS float*)(lds + wave * 16384);
    constexpr int I_WIN = (D / 64) * (NPROJ / 32);
    for (int it = gw; it < DEPTH * I_WIN; it += NGW) { const int l = it / I_WIN, r = it % I_WIN, kb = r / (NPROJ / 32), nb = r % (NPROJ / 32);
        tr_item_i8(a.w_in + (size_t)l * D * INW, a.norm_mix + l * D, (const unsigned*)(ws + WS_CMAX) + l * INW, ws + WS_WIN + l * WIN_BYTES, scr, 64 * kb, 32 * nb, lane); }
    float* sw = (float*)(ws + WS_SW); const int gt = gw * 64 + lane, NGT = NGW * 64;
    bf16* swh = (bf16*)(ws + WS_SWH); bf16* bih = (bf16*)(ws + WS_BIH);
    for (int i = gt; i < DEPTH * NPROJ; i += NGT) { const int l = i / NPROJ, j = i % NPROJ; const float s = __builtin_bit_cast(float, ((const unsigned*)(ws + WS_CMAX))[l * INW + colmap_in(j)]) * (1.0f / 127.0f);
        sw[i] = s; swh[i] = (bf16)f2bf(s); bih[i] = (bf16)f2bf(a.b_in[l * INW + colmap_in(j)]); }
}
__device__ __forceinline__ void quant_rows(const Args& a, int l, int gw, int NGW, int lane) {
    unsigned char* ws = a.ws; const float* H = (const float*)(ws + WS_H);
    for (int m = gw; m < M; m += NGW) { float am = 0.f; f32x4 v[8];
#pragma unroll
        for (int j = 0; j < 8; ++j) { v[j] = *(const f32x4*)(H + (size_t)m * D + j * 256 + lane * 4); am = fmaxf(am, fmaxf(fmaxf(fabsf(v[j][0]), fabsf(v[j][1])), fmaxf(fabsf(v[j][2]), fabsf(v[j][3])))); }
        am = wave_max(am, lane); if (lane == 0) ((float*)(ws + WS_RSA))[m] = rsqrtf(ssa_to_f(((const unsigned long long*)(ws + WS_SSQ))[(size_t)l * M + m]) * (1.0f / D) + EPS) * am * (1.0f / 127.0f);
        const float inv = am > 0.f ? 127.0f / am : 0.f; unsigned char* q8 = ws + WS_HB8 + (size_t)m * D + 4 * lane;
#pragma unroll
        for (int j = 0; j < 8; ++j) *(unsigned*)(q8 + 256 * j) = ((unsigned)((int)rintf(v[j][0] * inv) & 255)) | ((unsigned)((int)rintf(v[j][1] * inv) & 255) << 8) | ((unsigned)((int)rintf(v[j][2] * inv) & 255) << 16) | ((unsigned)((int)rintf(v[j][3] * inv) & 255) << 24); }
}

__device__ __forceinline__ void forget_logits(const Args& a, int l, int gw, int NGW, int lane) {
    unsigned char* ws = a.ws; const bf16* HB = (const bf16*)(ws + WS_HB); const float* wf = (const float*)(ws + WS_WF) + l * 4 * D; const unsigned long long* ssq = (const unsigned long long*)(ws + WS_SSQ) + l * M;
    float* logf = (float*)(ws + WS_LOGF);
    for (int m = gw; m < M; m += NGW) {
        float d[4] = {0.f, 0.f, 0.f, 0.f};
#pragma unroll
        for (int j = 0; j < 4; ++j) { const int k0 = j * 512 + lane * 8; const v4u xv = *(const v4u*)(HB + (size_t)m * D + k0);
            const float x[8] = {bflo(xv.x), bfhi(xv.x), bflo(xv.y), bfhi(xv.y), bflo(xv.z), bfhi(xv.z), bflo(xv.w), bfhi(xv.w)};
#pragma unroll
            for (int h = 0; h < 4; ++h) { const f32x4 w0 = *(const f32x4*)(wf + h * D + k0), w1 = *(const f32x4*)(wf + h * D + k0 + 4);
                d[h] += x[0] * w0[0] + x[1] * w0[1] + x[2] * w0[2] + x[3] * w0[3] + x[4] * w1[0] + x[5] * w1[1] + x[6] * w1[2] + x[7] * w1[3]; } }
        const float rs = rsqrtf(ssa_to_f(ssq[m]) * (1.0f / D) + EPS);
#pragma unroll
        for (int h = 0; h < 4; ++h) { const float z = wave_sum(d[h], lane) * rs + a.b_in[l * INW + 1536 + h];
            const float ls = fminf(z, 0.f) - log1pf(__expf(-fabsf(z)));
            if (lane == h) logf[m * 4 + h] = ls; }
    }
}
__device__ __forceinline__ void cum_scan(const Args& a, int gw, int lane) {
    if (gw >= 16) return;
    const float* logf = (const float*)(a.ws + WS_LOGF); float* cum = (float*)(a.ws + WS_CUM);
    const int b = gw >> 2, h = gw & 3; float run = 0.f;
    for (int c = 0; c < SEQ / 64; ++c) { float v = logf[(size_t)(b * SEQ + c * 64 + lane) * 4 + h];
#pragma unroll
        for (int o = 1; o < 64; o <<= 1) { const float t = shf(v, lane >= o ? lane - o : lane); if (lane >= o) v += t; }
        v += run; cum[(size_t)gw * SEQ + c * 64 + lane] = v; run = shf(v, 63); }
}

template <int MODE>
__device__ __forceinline__ void naive_attn(const Args& a, int l, int b, int h, int s, LAS float* sc, int lane) {
    const unsigned char* ws = a.ws; const bf16* P = (const bf16*)(ws + WS_PROJ);
    const bf16* Qp = P + (MODE ? 7 : 0) * PROJ_T; const bf16* Kp = P + (MODE ? 8 : 1) * PROJ_T; const bf16* Vp = P + (MODE ? 9 : 2) * PROJ_T;
    const float* cum = (const float*)(ws + WS_CUM) + (size_t)(b * 4 + h) * SEQ;
    const float* rb = a.rel_bias + ((size_t)l * 4 + h) * 320;
    const size_t tb = (size_t)b * SEQ;
    int klo = 0, khi = s;
    if (MODE) { const int c = s >> 6; klo = (c - 8) * 64; if (klo < 0) klo = 0; khi = c * 64 + 63; }
    const bf16* qrow = Qp + (tb + s) * MIXW + h * HD;
    float mx = -3.0e38f;
    for (int kb = klo; kb <= khi; kb += 64) { const int k = kb + lane;
        if (k <= khi) { const bf16* krow = Kp + (tb + k) * MIXW + h * HD; float d = 0.f;
#pragma unroll 4
            for (int c8 = 0; c8 < 16; ++c8) { const v4u qv = *(const v4u*)(qrow + c8 * 8), kv = *(const v4u*)(krow + c8 * 8);
                d = dot2_bf16(qv.x, kv.x, d); d = dot2_bf16(qv.y, kv.y, d); d = dot2_bf16(qv.z, kv.z, d); d = dot2_bf16(qv.w, kv.w, d); }
            float bias;
            if (MODE == 0) bias = cum[s] - cum[k];
            else { int rel = s - k; rel = rel < -63 ? -63 : (rel > 256 ? 256 : rel); bias = rb[rel + 63]; }
            const float lg = d * ATT_SCALE + bias; sc[k - klo] = lg; mx = fmaxf(mx, lg); } }
    mx = wave_max(mx, lane);
    asm volatile("s_waitcnt lgkmcnt(0)" ::: "memory");
    float sum = 0.f;
    for (int kb = klo; kb <= khi; kb += 64) { const int k = kb + lane; if (k <= khi) { const float p = __expf(sc[k - klo] - mx); sc[k - klo] = p; sum += p; } }
    sum = wave_sum(sum, lane);
    asm volatile("s_waitcnt lgkmcnt(0)" ::: "memory");
    float o0 = 0.f, o1 = 0.f;
    for (int k = klo; k <= khi; ++k) { const float p = sc[k - klo]; const unsigned v = *(const unsigned*)(Vp + (tb + k) * MIXW + h * HD + 2 * lane); o0 += p * bflo(v); o1 += p * bfhi(v); }
    const float inv = 1.0f / sum;
    bf16* Y = (bf16*)(a.ws + WS_Y);
    *(unsigned*)(Y + (tb + s) * D + (MODE ? 1536 : 0) + h * HD + 2 * lane) = pk2(o0 * inv, o1 * inv);
    asm volatile("s_waitcnt lgkmcnt(0)" ::: "memory");
}
__device__ __forceinline__ void naive_pool(const Args& a, int l, int t, int g, LAS float* sc, int lane) {
    const bf16* Pin = (const bf16*)(a.ws + WS_PROJ) + 3 * PROJ_T;
    const int s = t & (SEQ - 1), w = 2 << g; const int cnt = (s + 1 < w) ? s + 1 : w;
    float s0 = 0.f, s1 = 0.f;
    for (int j = 0; j < cnt; ++j) { const unsigned v = *(const unsigned*)(Pin + (size_t)(t - j) * MIXW + g * 128 + 2 * lane); s0 += bflo(v); s1 += bfhi(v); }
    const unsigned v0 = *(const unsigned*)(Pin + (size_t)t * MIXW + g * 128 + 2 * lane);
    const float inv = 1.0f / (float)cnt;
    sc[2 * lane] = s0 * inv - bflo(v0); sc[2 * lane + 1] = s1 * inv - bfhi(v0);
    asm volatile("s_waitcnt lgkmcnt(0)" ::: "memory");
    const float* W = a.pool_w + ((size_t)l * 4 + g) * 128 * 128;
    float o0 = 0.f, o1 = 0.f;
    for (int c = 0; c < 128; ++c) { const float p = sc[c]; const f32x2 wv = *(const f32x2*)(W + c * 128 + 2 * lane); o0 += p * wv[0]; o1 += p * wv[1]; }
    const f32x2 ps = *(const f32x2*)(a.pool_scale + l * MIXW + g * 128 + 2 * lane);
    bf16* Y = (bf16*)(a.ws + WS_Y);
    *(unsigned*)(Y + (size_t)t * D + 512 + g * 128 + 2 * lane) = pk2(o0 * ps[0], o1 * ps[1]);
    asm volatile("s_waitcnt lgkmcnt(0)" ::: "memory");
}
__device__ __forceinline__ void naive_conv(const Args& a, int l, int t, int lane) {
    const bf16* P = (const bf16*)(a.ws + WS_PROJ); const bf16* Ch = P + 4 * PROJ_T; const bf16* Cb = P + 5 * PROJ_T; const bf16* Cc = P + 6 * PROJ_T;
    const int s = t & (SEQ - 1), c0 = lane * 8;
    float acc[8] = {0.f, 0.f, 0.f, 0.f, 0.f, 0.f, 0.f, 0.f};
#pragma unroll
    for (int j = 0; j < 3; ++j) { const int dt = 2 - j;
        if (s - dt >= 0) { const v4u hv = *(const v4u*)(Ch + (size_t)(t - dt) * MIXW + c0), cv = *(const v4u*)(Cc + (size_t)(t - dt) * MIXW + c0);
            const float* w = a.conv_w + ((size_t)l * 3 + j) * MIXW + c0; const f32x4 w0 = *(const f32x4*)w, w1 = *(const f32x4*)(w + 4);
            acc[0] += w0[0] * bflo(hv.x) * bflo(cv.x); acc[1] += w0[1] * bfhi(hv.x) * bfhi(cv.x); acc[2] += w0[2] * bflo(hv.y) * bflo(cv.y); acc[3] += w0[3] * bfhi(hv.y) * bfhi(cv.y);
            acc[4] += w1[0] * bflo(hv.z) * bflo(cv.z); acc[5] += w1[1] * bfhi(hv.z) * bfhi(cv.z); acc[6] += w1[2] * bflo(hv.w) * bflo(cv.w); acc[7] += w1[3] * bfhi(hv.w) * bfhi(cv.w); } }
    const v4u bv = *(const v4u*)(Cb + (size_t)t * MIXW + c0);
    v4u o; o.x = pk2(acc[0] * bflo(bv.x), acc[1] * bfhi(bv.x)); o.y = pk2(acc[2] * bflo(bv.y), acc[3] * bfhi(bv.y)); o.z = pk2(acc[4] * bflo(bv.z), acc[5] * bfhi(bv.z)); o.w = pk2(acc[6] * bflo(bv.w), acc[7] * bfhi(bv.w));
    *(v4u*)((bf16*)(a.ws + WS_Y) + (size_t)t * D + 1024 + c0) = o;
}
__device__ __forceinline__ void mixers_naive(const Args& a, int l, LAS unsigned char* lds, int gw, int NGW, int wave, int lane) {
    LAS float* sc = (LAS float*)(lds + wave * 8192);
    for (int i = gw; i < M * 4; i += NGW) { const int t = M * 4 - 1 - i; const int h = t & 3, tok = t >> 2; naive_attn<0>(a, l, tok >> 11, h, tok & (SEQ - 1), sc, lane); }
    for (int i = gw; i < M * 4; i += NGW) { const int h = i & 3, tok = i >> 2; naive_attn<1>(a, l, tok >> 11, h, tok & (SEQ - 1), sc, lane); }
    for (int i = gw; i < M * 4; i += NGW) naive_pool(a, l, i >> 2, i & 3, sc, lane);
    for (int i = gw; i < M; i += NGW) naive_conv(a, l, i, lane);
}

__device__ __forceinline__ float gelu_tanh(float x) { const float u = 1.5957691216057308f * (x + 0.044715f * x * x * x); return x / (1.0f + __expf(-u)); }
constexpr int PEER_TOK = 32;
constexpr int PL_IDX = 0, PL_GATE = PEER_TOK * 128 * 4, PL_TAB = 2 * PEER_TOK * 128 * 4;
__device__ __forceinline__ int f2key(float f) { const int b = __builtin_bit_cast(int, f); return b ^ ((b >> 31) & 0x7fffffff); }
__device__ __forceinline__ float key2f(int k) { return __builtin_bit_cast(float, k ^ ((k >> 31) & 0x7fffffff)); }
#define CE_DESC(x, y) do { const int hi_ = (x) > (y) ? (x) : (y), lo_ = (x) > (y) ? (y) : (x); (x) = hi_; (y) = lo_; } while (0)
__device__ __forceinline__ void sort16_desc(int* v) {
#pragma unroll
    for (int k = 2; k <= 16; k <<= 1)
#pragma unroll
        for (int j = k >> 1; j > 0; j >>= 1)
#pragma unroll
            for (int i = 0; i < 16; ++i) { const int l = i ^ j; if (l > i) { if ((i & k) == 0) CE_DESC(v[i], v[l]); else CE_DESC(v[l], v[i]); } }
}
__device__ __forceinline__ void merge_top16(int* a, const int* b) {
#pragma unroll
    for (int i = 0; i < 16; ++i) a[i] = a[i] > b[15 - i] ? a[i] : b[15 - i];
#pragma unroll
    for (int j = 8; j > 0; j >>= 1)
#pragma unroll
        for (int i = 0; i < 16; ++i) { const int l = i ^ j; if (l > i) CE_DESC(a[i], a[l]); }
}
__device__ __forceinline__ void top16_of_64(int* v) {
    sort16_desc(v); sort16_desc(v + 16); sort16_desc(v + 32); sort16_desc(v + 48);
    merge_top16(v, v + 16); merge_top16(v + 32, v + 48); merge_top16(v, v + 32);
}
constexpr int cand_slot(int i, int j) {
    int n = 0;
    for (int a = 0; a < 16; ++a) for (int b = 0; b < 16; ++b) { if ((a + 1) * (b + 1) <= 16) { if (a == i && b == j) return n; ++n; } }
    return -1;
}
__device__ __forceinline__ void peer_retrieve(const Args& a, int l, int t0, int h, LAS char* lds, int wave) {
    typedef short bf16x8 __attribute__((ext_vector_type(8)));
    typedef float f32x16 __attribute__((ext_vector_type(16)));
    int lane; asm volatile("v_mbcnt_lo_u32_b32 %0, -1, 0\n\tv_mbcnt_hi_u32_b32 %0, -1, %0" : "=v"(lane));
    const int r32 = lane & 31, hi = lane >> 5, hi4 = hi * 4;
    const bf16* Q = (const bf16*)(a.ws + WS_Q) + (size_t)(t0 + r32) * D + h * 256 + hi * 8;
    const bf16* PK = (const bf16*)(a.ws + WS_PK) + ((size_t)(l * 8 + h) * 2) * 128 * 128 + (size_t)r32 * 128 + hi * 8;
    int top[2][16];
#pragma unroll
    for (int p = 0; p < 2; ++p) {
        f32x16 acc[4] = {};
        bf16x8 qf[8];
#pragma unroll
        for (int cs = 0; cs < 8; ++cs) qf[cs] = *(const bf16x8*)(Q + p * 128 + cs * 16);
#pragma unroll
        for (int kb = 0; kb < 4; ++kb) { bf16x8 kf[8];
#pragma unroll
            for (int cs = 0; cs < 8; ++cs) kf[cs] = *(const bf16x8*)(PK + (size_t)p * 128 * 128 + (size_t)kb * 32 * 128 + cs * 16);
#pragma unroll
            for (int cs = 0; cs < 8; ++cs) acc[kb] = __builtin_amdgcn_mfma_f32_32x32x16_bf16(kf[cs], qf[cs], acc[kb], 0, 0, 0); }
        int v[64];
#pragma unroll
        for (int kb = 0; kb < 4; ++kb)
#pragma unroll
            for (int r = 0; r < 16; ++r) { const int c = kb * 32 + (r & 3) + 8 * (r >> 2);
                v[kb * 16 + r] = (f2key(acc[kb][r]) & ~127) | (c | hi4); }
        top16_of_64(v);
        int mine[16], other[16];
#pragma unroll
        for (int i = 0; i < 16; ++i) { auto rr = __builtin_amdgcn_permlane32_swap((unsigned)v[i], (unsigned)v[i], false, false); mine[i] = (int)rr[0]; other[i] = (int)rr[1]; }
        merge_top16(mine, other);
#pragma unroll
        for (int i = 0; i < 16; ++i) top[p][i] = mine[i];
    }
    LAS int* tab = (LAS int*)(lds + PL_TAB) + (wave * 64 + lane) * 32;
    float sA[16], sB[16];
#pragma unroll
    for (int i = 0; i < 16; ++i) { sA[i] = key2f(top[0][i] & ~127); sB[i] = key2f(top[1][i] & ~127); tab[i] = top[0][i] & 127; tab[16 + i] = top[1][i] & 127; }
    int c[64];
#pragma unroll
    for (int n = 0; n < 64; ++n) c[n] = (int)0x80000000;
#pragma unroll
    for (int i = 0; i < 16; ++i)
#pragma unroll
        for (int j = 0; j < 16; ++j) if ((i + 1) * (j + 1) <= 16) c[cand_slot(i, j)] = (f2key(sA[i] + sB[j]) & ~255) | (16 * i + j);
    top16_of_64(c);
    float ex[16]; float sum = 0.f; const float mx = key2f(c[0] & ~255);
#pragma unroll
    for (int w = 0; w < 16; ++w) { ex[w] = __expf(key2f(c[w] & ~255) - mx); sum += ex[w]; }
    const float inv = 1.0f / sum;
    asm volatile("s_waitcnt lgkmcnt(0)" ::: "memory");
    LAS int* oi = (LAS int*)(lds + PL_IDX) + r32 * 128 + h * 16; LAS float* og = (LAS float*)(lds + PL_GATE) + r32 * 128 + h * 16;
#pragma unroll
    for (int w = 0; w < 16; ++w) { const int id = c[w] & 255; const int e = tab[id >> 4] * 128 + tab[16 + (id & 15)];
        if ((w >> 3) == hi) { oi[w] = e; og[w] = ex[w] * inv; } }
}
constexpr size_t WS_IDX = 816 * MiB;
constexpr size_t WS_GATE = 820 * MiB;
constexpr size_t WS_XQ = 824 * MiB;
constexpr size_t WS_SX = 856 * MiB;
constexpr size_t WS_PART = 857 * MiB;
constexpr size_t WS_SUT = 890 * MiB;
constexpr size_t WS_END2 = 1024 * MiB;
#ifndef PEER_NB
#define PEER_NB 8
#endif
constexpr int NSLICE = 8, SLW = D / NSLICE;
#define DPP_ROR(x, n) __builtin_bit_cast(float, __builtin_amdgcn_update_dpp(0, __builtin_bit_cast(int, (x)), 0x120 + (n), 0xf, 0xf, false))
__device__ __forceinline__ void peer_publish(const Args& a, int l, int t, LAS char* lds, int tl) {
    int lane; LANE_ID(lane);
    unsigned char* ws = a.ws;
    { int* gi = (int*)(ws + WS_IDX) + (size_t)t * 128; float* gg = (float*)(ws + WS_GATE) + (size_t)t * 128; float* gs = (float*)(ws + WS_SUT) + (size_t)t * 128;
      const float* SU = (const float*)(ws + WS_SU) + l * PEER_E; const float* SV = (const float*)(ws + WS_SV) + l * PEER_E;
      const int i0 = ((const LAS int*)(lds + PL_IDX))[tl * 128 + lane], i1 = ((const LAS int*)(lds + PL_IDX))[tl * 128 + 64 + lane];
      gi[lane] = i0; gi[64 + lane] = i1; gs[lane] = SU[i0]; gs[64 + lane] = SU[i1];
      gg[lane] = ((const LAS float*)(lds + PL_GATE))[tl * 128 + lane] * SV[i0]; gg[64 + lane] = ((const LAS float*)(lds + PL_GATE))[tl * 128 + 64 + lane] * SV[i1]; }
    const unsigned long long* ssa1 = (const unsigned long long*)(ws + WS_SSA) + l * M;
    const float rs = rsqrtf(ssa_to_f(ssa1[t]) * (1.0f / D) + EPS);
    const bf16* HB = (const bf16*)(ws + WS_HB) + (size_t)t * D; const float* gn = a.norm_ffn + l * D;
    float xf[32]; float am = 0.f;
#pragma unroll
    for (int i = 0; i < 2; ++i) { const int k0 = 16 * lane + 1024 * i; const v4u h0 = *(const v4u*)(HB + k0), h1 = *(const v4u*)(HB + k0 + 8);
        const unsigned hw[8] = {h0.x, h0.y, h0.z, h0.w, h1.x, h1.y, h1.z, h1.w};
#pragma unroll
        for (int q = 0; q < 4; ++q) { const f32x4 g = *(const f32x4*)(gn + k0 + 4 * q);
            xf[16 * i + 4 * q + 0] = bflo(hw[2 * q]) * rs * g[0]; xf[16 * i + 4 * q + 1] = bfhi(hw[2 * q]) * rs * g[1];
            xf[16 * i + 4 * q + 2] = bflo(hw[2 * q + 1]) * rs * g[2]; xf[16 * i + 4 * q + 3] = bfhi(hw[2 * q + 1]) * rs * g[3]; } }
#pragma unroll
    for (int k = 0; k < 32; ++k) am = fmaxf(am, fabsf(xf[k]));
    am = wave_max(am, lane);
    const float inv = am > 0.f ? 127.0f / am : 0.f;
    if (lane == 0) ((float*)(ws + WS_SX))[t] = am * (1.0f / 127.0f);
    unsigned char* xq = ws + WS_XQ + (size_t)t * 4096;
#pragma unroll
    for (int i = 0; i < 2; ++i) { v4u ph, pl;
#pragma unroll
        for (int d = 0; d < 4; ++d) { unsigned wh = 0, wl = 0;
#pragma unroll
            for (int b = 0; b < 4; ++b) { const float sv = xf[16 * i + 4 * d + b] * inv, hq = rintf(sv), lq = rintf((sv - hq) * 128.0f);
                wh |= ((unsigned)((int)hq & 255)) << (8 * b); wl |= ((unsigned)((int)lq & 255)) << (8 * b); }
            ph[d] = wh; pl[d] = wl; }
        *(v4u*)(xq + 16 * lane + 1024 * i) = ph; *(v4u*)(xq + 2048 + 16 * lane + 1024 * i) = pl; }
}
struct PeerItems { int pos, npop, rank, nloc, wave;
    __device__ __forceinline__ int nblk() const { return (M / PEER_TOK - rank + nloc - 1) / nloc; }
    __device__ __forceinline__ int count() const { return ((NSLICE - pos + npop - 1) / npop) * nblk() * (PEER_TOK / NWAVES); }
    __device__ __forceinline__ void get(int n, int& s, int& t) const { constexpr int per = PEER_TOK / NWAVES; const int k = n % per, r = n / per, nb = nblk();
        s = pos + (r / nb) * npop; t = (rank + (r % nb) * nloc) * PEER_TOK + wave * per + k; } };
__device__ __forceinline__ void peer_u_wave(const Args& a, int l, const PeerItems& it) {
    int lane; LANE_ID(lane);
    unsigned char* ws = a.ws; const int sub = lane & 15, grp = lane >> 4;
    const __amdgpu_buffer_rsrc_t rU = __builtin_amdgcn_make_buffer_rsrc((void*)(ws + WS_PU + (size_t)l * PE_BYTES), 0, 0x7fffffff, 0x00020000);
    const __amdgpu_buffer_rsrc_t rW = __builtin_amdgcn_make_buffer_rsrc((void*)ws, 0, 0x7fffffff, 0x00020000);
    const int N = it.count(); if (N <= 0) return;
    int s, t; it.get(0, s, t);
    int idc[2], idn[2] = {0, 0}; v4u xhc, xlc, xhn = {}, xln = {}; v4u wA[PEER_NB], wB[PEER_NB];
#define PU_META(I0, I1, XH, XL, S_, T_) do { I0 = (int)__builtin_amdgcn_raw_buffer_load_b32(rW, 4 * lane, (int)WS_IDX + (T_) * 512, 0); I1 = (int)__builtin_amdgcn_raw_buffer_load_b32(rW, 4 * lane, (int)WS_IDX + (T_) * 512 + 256, 0); \
        XH = __builtin_amdgcn_raw_buffer_load_b128(rW, 16 * sub, (int)WS_XQ + (T_) * 4096 + SLW * (S_), 0); XL = __builtin_amdgcn_raw_buffer_load_b128(rW, 16 * sub, (int)WS_XQ + (T_) * 4096 + 2048 + SLW * (S_), 0); } while (0)
#define PU_ISSUE(W, ID, Q, S_) do { _Pragma("unroll") for (int j = 0; j < PEER_NB; ++j) { const int e_ = shi(ID[(PEER_NB * (Q) + j) >> 4], 4 * ((PEER_NB * (Q) + j) & 15) + grp); W[j] = __builtin_amdgcn_raw_buffer_load_b128(rU, e_ * D + SLW * (S_) + 16 * sub, 0, 0); } } while (0)
#define PU_COMP(W, Q) do { _Pragma("unroll") for (int j = 0; j < PEER_NB; ++j) { int dh = 0, dl = 0; \
            dh = __builtin_amdgcn_sdot4((int)W[j].x, (int)xhc.x, dh, false); dl = __builtin_amdgcn_sdot4((int)W[j].x, (int)xlc.x, dl, false); \
            dh = __builtin_amdgcn_sdot4((int)W[j].y, (int)xhc.y, dh, false); dl = __builtin_amdgcn_sdot4((int)W[j].y, (int)xlc.y, dl, false); \
            dh = __builtin_amdgcn_sdot4((int)W[j].z, (int)xhc.z, dh, false); dl = __builtin_amdgcn_sdot4((int)W[j].z, (int)xlc.z, dl, false); \
            dh = __builtin_amdgcn_sdot4((int)W[j].w, (int)xhc.w, dh, false); dl = __builtin_amdgcn_sdot4((int)W[j].w, (int)xlc.w, dl, false); \
            float p_ = (float)dh + (float)dl * (1.0f / 128.0f); \
            p_ += DPP_ROR(p_, 8); p_ += DPP_ROR(p_, 4); p_ += DPP_ROR(p_, 2); p_ += DPP_ROR(p_, 1); \
            if (sub == ((PEER_NB * (Q) + j) & 15)) { if ((PEER_NB * (Q) + j) >> 4) acc1 = p_; else acc0 = p_; } __builtin_amdgcn_sched_barrier(0); } } while (0)
    PU_META(idc[0], idc[1], xhc, xlc, s, t); PU_ISSUE(wA, idc, 0, s); PU_ISSUE(wB, idc, 1, s);
    for (int n = 0; n < N; ++n) {
        int sn = s, tn = t; const bool more = n + 1 < N;
        if (more) it.get(n + 1, sn, tn);
        PU_META(idn[0], idn[1], xhn, xln, sn, tn);
        float acc0 = 0.f, acc1 = 0.f;
        __builtin_amdgcn_sched_barrier(0);
#if PEER_NB == 8
        PU_COMP(wA, 0); PU_ISSUE(wA, idc, 2, s); __builtin_amdgcn_sched_barrier(0);
        PU_COMP(wB, 1); PU_ISSUE(wB, idc, 3, s); __builtin_amdgcn_sched_barrier(0);
        PU_COMP(wA, 2); PU_ISSUE(wA, idn, 0, sn); __builtin_amdgcn_sched_barrier(0);
        PU_COMP(wB, 3); PU_ISSUE(wB, idn, 1, sn); __builtin_amdgcn_sched_barrier(0);
#else
        PU_COMP(wA, 0); PU_ISSUE(wA, idn, 0, sn); __builtin_amdgcn_sched_barrier(0);
        PU_COMP(wB, 1); PU_ISSUE(wB, idn, 1, sn); __builtin_amdgcn_sched_barrier(0);
#endif
        __builtin_amdgcn_raw_buffer_store_b32(__builtin_bit_cast(unsigned, acc0), rW, (4 * sub + grp) * 4, (int)WS_PART + (s * M + t) * 512, 0);
        __builtin_amdgcn_raw_buffer_store_b32(__builtin_bit_cast(unsigned, acc1), rW, (4 * sub + grp) * 4 + 256, (int)WS_PART + (s * M + t) * 512, 0);
        s = sn; t = tn; idc[0] = idn[0]; idc[1] = idn[1]; xhc = xhn; xlc = xln;
    }
#undef PU_META
#undef PU_ISSUE
#undef PU_COMP
}
__device__ __forceinline__ void peer_v_wave(const Args& a, int l, const PeerItems& it) {
    int lane; LANE_ID(lane);
    unsigned char* ws = a.ws; const int sub = lane & 15, grp = lane >> 4;
    const __amdgpu_buffer_rsrc_t rV = __builtin_amdgcn_make_buffer_rsrc((void*)(ws + WS_PV + (size_t)l * PE_BYTES), 0, 0x7fffffff, 0x00020000);
    const __amdgpu_buffer_rsrc_t rW = __builtin_amdgcn_make_buffer_rsrc((void*)ws, 0, 0x7fffffff, 0x00020000);
    const int N = it.count(); if (N <= 0) return;
    int s, t; it.get(0, s, t);
    struct Meta { int id[2]; float gate[2], su[2], pa[2], sx; f32x4 h1; };
    Meta mc, mn; v4u wA[PEER_NB], wB[PEER_NB];
    const int l4 = 4 * lane;
#define WLD(off_s) __builtin_amdgcn_raw_buffer_load_b32(rW, l4, (int)(off_s), 0)
#define PV_META(MM, S_, T_) do { const int r_ = (T_) * 512; MM.id[0] = (int)WLD(WS_IDX + r_); MM.id[1] = (int)WLD(WS_IDX + r_ + 256); \
        MM.gate[0] = __builtin_bit_cast(float, WLD(WS_GATE + r_)); MM.gate[1] = __builtin_bit_cast(float, WLD(WS_GATE + r_ + 256)); MM.su[0] = __builtin_bit_cast(float, WLD(WS_SUT + r_)); MM.su[1] = __builtin_bit_cast(float, WLD(WS_SUT + r_ + 256)); \
        float a0_ = 0.f, a1_ = 0.f; _Pragma("unroll") for (int q = 0; q < NSLICE; ++q) { const int po_ = (int)WS_PART + (q * M + (T_)) * 512; a0_ += __builtin_bit_cast(float, WLD(po_)); a1_ += __builtin_bit_cast(float, WLD(po_ + 256)); } \
        MM.pa[0] = a0_; MM.pa[1] = a1_; MM.sx = ((const float*)(ws + WS_SX))[T_]; \
        MM.h1 = __builtin_bit_cast(f32x4, __builtin_amdgcn_raw_buffer_load_b128(rW, (16 * sub + 4 * grp) * 4, (int)WS_H + ((T_) * D + SLW * (S_)) * 4, 0)); } while (0)
#define PV_ISSUE(W, ID, Q, S_) do { _Pragma("unroll") for (int j = 0; j < PEER_NB; ++j) { const int e_ = shi(ID[(PEER_NB * (Q) + j) >> 4], 4 * ((PEER_NB * (Q) + j) & 15) + grp); W[j] = __builtin_amdgcn_raw_buffer_load_b128(rV, e_ * D + SLW * (S_) + 16 * sub, 0, 0); } } while (0)
#define PV_COMP(W, Q) do { _Pragma("unroll") for (int j4 = 0; j4 < PEER_NB; j4 += 4) { \
            unsigned cp_ = 0; _Pragma("unroll") for (int jj = 0; jj < 4; ++jj) { const int i_ = PEER_NB * (Q) + j4 + jj; cp_ |= ((unsigned)shi(c8[i_ >> 4], 4 * (i_ & 15) + grp) & 255u) << (8 * jj); } \
            _Pragma("unroll") for (int d = 0; d < 4; ++d) { const unsigned a_ = W[j4][d], b_ = W[j4 + 1][d], c_ = W[j4 + 2][d], d_ = W[j4 + 3][d]; \
                const unsigned x0_ = __builtin_amdgcn_perm(b_, a_, 0x05010400u), x1_ = __builtin_amdgcn_perm(b_, a_, 0x07030602u), y0_ = __builtin_amdgcn_perm(d_, c_, 0x05010400u), y1_ = __builtin_amdgcn_perm(d_, c_, 0x07030602u); \
                yi[4 * d + 0] = __builtin_amdgcn_sdot4((int)__builtin_amdgcn_perm(y0_, x0_, 0x05040100u), (int)cp_, yi[4 * d + 0], false); \
                yi[4 * d + 1] = __builtin_amdgcn_sdot4((int)__builtin_amdgcn_perm(y0_, x0_, 0x07060302u), (int)cp_, yi[4 * d + 1], false); \
                yi[4 * d + 2] = __builtin_amdgcn_sdot4((int)__builtin_amdgcn_perm(y1_, x1_, 0x05040100u), (int)cp_, yi[4 * d + 2], false); \
                yi[4 * d + 3] = __builtin_amdgcn_sdot4((int)__builtin_amdgcn_perm(y1_, x1_, 0x07060302u), (int)cp_, yi[4 * d + 3], false); } \
            __builtin_amdgcn_sched_barrier(0); } } while (0)
    PV_META(mc, s, t); PV_ISSUE(wA, mc.id, 0, s); PV_ISSUE(wB, mc.id, 1, s);
    for (int n = 0; n < N; ++n) {
        int sn = s, tn = t; const bool more = n + 1 < N;
        if (more) it.get(n + 1, sn, tn);
        PV_META(mn, sn, tn);
        float coef[2];
#pragma unroll
        for (int hf = 0; hf < 2; ++hf) coef[hf] = gelu_tanh(mc.pa[hf] * mc.su[hf] * mc.sx) * mc.gate[hf];
        const float cmax = wave_max(fmaxf(fabsf(coef[0]), fabsf(coef[1])), lane); const float cinv = cmax > 0.f ? 127.0f / cmax : 0.f, cs = cmax * (1.0f / 127.0f);
        const int c8[2] = {(int)rintf(coef[0] * cinv), (int)rintf(coef[1] * cinv)};
        int yi[16];
#pragma unroll
        for (int k = 0; k < 16; ++k) yi[k] = 0;
        __builtin_amdgcn_sched_barrier(0);
#if PEER_NB == 8
        PV_COMP(wA, 0); PV_ISSUE(wA, mc.id, 2, s); __builtin_amdgcn_sched_barrier(0);
        PV_COMP(wB, 1); PV_ISSUE(wB, mc.id, 3, s); __builtin_amdgcn_sched_barrier(0);
        PV_COMP(wA, 2); PV_ISSUE(wA, mn.id, 0, sn); __builtin_amdgcn_sched_barrier(0);
        PV_COMP(wB, 3); PV_ISSUE(wB, mn.id, 1, sn); __builtin_amdgcn_sched_barrier(0);
#else
        PV_COMP(wA, 0); PV_ISSUE(wA, mn.id, 0, sn); __builtin_amdgcn_sched_barrier(0);
        PV_COMP(wB, 1); PV_ISSUE(wB, mn.id, 1, sn); __builtin_amdgcn_sched_barrier(0);
#endif
#pragma unroll
        for (int k = 0; k < 16; ++k) { yi[k] += shi(yi[k], lane ^ 16); yi[k] += shi(yi[k], lane ^ 32); }
        int yq[4];
#pragma unroll
        for (int k = 0; k < 4; ++k) yq[k] = grp == 0 ? yi[k] : grp == 1 ? yi[4 + k] : grp == 2 ? yi[8 + k] : yi[12 + k];
        const f32x4 h2 = {mc.h1[0] + cs * (float)yq[0], mc.h1[1] + cs * (float)yq[1], mc.h1[2] + cs * (float)yq[2], mc.h1[3] + cs * (float)yq[3]};
        __builtin_amdgcn_raw_buffer_store_b128(__builtin_bit_cast(v4u, h2), rW, (16 * sub + 4 * grp) * 4, (int)WS_H + (t * D + SLW * s) * 4, 0);
        v2u hb; hb.x = pk2(h2[0], h2[1]); hb.y = pk2(h2[2], h2[3]);
        __builtin_amdgcn_raw_buffer_store_b64(hb, rW, (16 * sub + 4 * grp) * 2, (int)WS_HB + (t * D + SLW * s) * 2, 0);
        const float sq = wave_sum((h2[0] * h2[0] + h2[1] * h2[1]) + (h2[2] * h2[2] + h2[3] * h2[3]), lane);
        if (lane == 0) atomicAdd((unsigned long long*)(ws + WS_SSQ) + (size_t)(l + 1) * M + t, (unsigned long long)((double)sq * 4294967296.0));
        s = sn; t = tn; mc = mn;
    }
#undef PV_META
#undef WLD
#undef PV_ISSUE
#undef PV_COMP
}
__device__ __forceinline__ void final_norm_row(const Args& a, int t) {
    int lane; LANE_ID(lane);
    const float* H = (const float*)(a.ws + WS_H) + (size_t)t * D; float* O = a.out + (size_t)t * D;
    const float rf = rsqrtf(ssa_to_f(((const unsigned long long*)(a.ws + WS_SSQ))[(size_t)DEPTH * M + t]) * (1.0f / D) + EPS);
#pragma unroll
    for (int j = 0; j < 8; ++j) { const int k0 = 4 * lane + 256 * j; const f32x4 h = *(const f32x4*)(H + k0), g = *(const f32x4*)(a.norm_final + k0);
        *(f32x4*)(O + k0) = (f32x4){h[0] * rf * g[0], h[1] * rf * g[1], h[2] * rf * g[2], h[3] * rf * g[3]}; }
}

__global__ void __launch_bounds__(NT, 2) mk_fwd(ArgsK a_in) {
    extern __shared__ __attribute__((aligned(16))) unsigned char lds_raw[];
    LAS unsigned char* lds = (LAS unsigned char*)lds_raw;
    cg::grid_group grid = cg::this_grid();
    grid.sync();
    const int wave0 = __builtin_amdgcn_readfirstlane(threadIdx.x >> 6);
    const int G = gridDim.x;
    const CAS ArgsK* ka = (const CAS ArgsK*)__builtin_amdgcn_kernarg_segment_ptr();
    size_t zoff = 0;
#define PHASE_BEGIN() int lane; LANE_ID(lane); int blk = blockIdx.x, Gp = G, wv = wave0; asm volatile("" : "+s"(zoff), "+s"(ka), "+s"(blk), "+s"(Gp), "+s"(wv)); const int wave = wv, gw = blk * NWAVES + wv, NGW = Gp * NWAVES; (void)gw; (void)NGW; const Args a = load_args(ka, zoff); unsigned char* const ws = a.ws; (void)ws
    volatile LAS unsigned* bst = (volatile LAS unsigned*)(lds + RING_BYTES + 1024);
    if (PROBE == 3) { PHASE_BEGIN(); p0_prologue(a, lds, gw, NGW, wave, lane); }
#define GRID_BAR() do { asm volatile("" : "+s"(zoff)); unsigned char* wsb_ = (unsigned char*)ka->ws + zoff; int wvb_ = wave0; asm volatile("" : "+s"(wvb_)); xcd_barrier((unsigned*)(wsb_ + WS_BAR), xb_xcc_id(), (unsigned)G, bst, wvb_); if (PROBE == 9) xcd_barrier((unsigned*)(wsb_ + WS_BAR), xb_xcc_id(), (unsigned)G, bst, wvb_); } while (0)
    volatile LAS unsigned* xinfo = bst + 4;
    { PHASE_BEGIN(); if (wave == 0 && lane == 0) { bst[0] = 0u; bst[1] = 0u; xinfo[2] = xb_add((unsigned*)(ws + WS_BAR) + XB_XCNT(xb_xcc_id()), 1u); }
      p0_cmax(a, gw, NGW, lane); }
    GRID_BAR();
    { PHASE_BEGIN(); p0_win_i8(a, lds, gw, NGW, wave, lane); p0_prologue(a, lds, gw, NGW, wave, lane); }
    GRID_BAR();
    {
        PHASE_BEGIN();
        if (wave == 0 && lane == 0) { unsigned* bar = (unsigned*)(ws + WS_BAR); const unsigned x = xb_xcc_id(); unsigned pos = 0, npop = 0, mine = 1;
            for (unsigned j = 0; j < 16; ++j) { const unsigned c = xb_ld(&bar[XB_XCNT(j)]); if (c) { ++npop; if (j < x) ++pos; } if (j == x) mine = c ? c : 1u; }
            xinfo[0] = pos; xinfo[1] = npop ? npop : 1u; xinfo[3] = mine; }
        __syncthreads();
    }
    int depth_rt = DEPTH; asm volatile("" : "+s"(depth_rt));
    for (int lc = 0; lc < depth_rt; ++lc) {
        int l = lc; asm volatile("" : "+s"(l));
        if (l > 0) { { PHASE_BEGIN(); quant_rows(a, l, gw, NGW, lane); } GRID_BAR(); }
        for (int rep = 0; rep < (PROBE == 4 ? 2 : 1); ++rep)
        {
            PHASE_BEGIN();
            pg8::Gemm g{(const bf16*)(ws + WS_HB8), (const bf16*)(ws + WS_WIN + l * WIN_BYTES), M, NPROJ, D / 2}; pg8::StaticOrder S; S.init(M, NPROJ, Gp, blk);
            EpiProj E{ws, (const bf16*)(ws + WS_BIH) + l * NPROJ, (const float*)(ws + WS_RSA), (const bf16*)(ws + WS_SWH) + l * NPROJ};
            if (PROBE == 15) { pg8::gemm_phase<EpiProj, pg8::StaticOrder, true, true>(lds, g, S, E, wave); EpiSt<0> E4{ws}; pg8::gemm_phase<EpiSt<0>, pg8::StaticOrder, true, true>(lds, g, S, E4, wave); }
            else if (PROBE == 16) { pg8::gemm_phase<EpiProj, pg8::StaticOrder, true, true>(lds, g, S, E, wave); EpiSt<1> E4{ws}; pg8::gemm_phase<EpiSt<1>, pg8::StaticOrder, true, true>(lds, g, S, E4, wave); }
            else if (PROBE == 14) { pg8::gemm_phase<EpiProj, pg8::StaticOrder, true, true>(lds, g, S, E, wave); EpiSum E4{(float*)(ws + WS_R)}; pg8::gemm_phase<EpiSum, pg8::StaticOrder, true, true>(lds, g, S, E4, wave); }
            else pg8::gemm_phase<EpiProj, pg8::StaticOrder, true, true>(lds, g, S, E, wave);
            for (int r2 = 0; r2 < (PROBE == 8 ? 2 : 1); ++r2) forget_logits(a, l, gw, NGW, lane);
        }
        GRID_BAR();
        if (PROBE == 5) { PHASE_BEGIN(); mixers_fast(a, l + 2, (LAS char*)lds, wave, lane, Gp, blk); }
        { PHASE_BEGIN(); mixers_fast(a, l, (LAS char*)lds, wave, lane, Gp, blk); }
        GRID_BAR();
        for (int rep = 0; rep < (PROBE == 6 ? 2 : 1); ++rep)
        {
            PHASE_BEGIN();
            pg8::Gemm g{(const bf16*)(ws + WS_Y), (const bf16*)(ws + WS_WBR + l * SQ_BYTES), M, D, D}; pg8::StaticOrder S; S.init(M, D, Gp, blk);
            EpiMerge E{(const bf16*)(ws + WS_R), (bf16*)(ws + WS_MRG)};
            pg8::gemm_phase<EpiMerge, pg8::StaticOrder, false>(lds, g, S, E, wave);
        }
        GRID_BAR();
        {
            PHASE_BEGIN();
            pg8::Gemm g{(const bf16*)(ws + WS_MRG), (const bf16*)(ws + WS_WOUT + l * SQ_BYTES), M, D, D}; pg8::StaticOrder S; S.init(M, D, Gp, blk);
            EpiRes E{(float*)(ws + WS_H), (bf16*)(ws + WS_HB), (unsigned long long*)(ws + WS_SSA) + l * M};
            pg8::gemm_phase<EpiRes, pg8::StaticOrder, false>(lds, g, S, E, wave);
        }
        GRID_BAR();
        for (int rep = 0; rep < (PROBE == 7 ? 2 : 1); ++rep)
        {
            PHASE_BEGIN();
            pg8::Gemm g{(const bf16*)(ws + WS_HB), (const bf16*)(ws + WS_WQ + l * SQ_BYTES), M, D, D}; pg8::StaticOrder S; S.init(M, D, Gp, blk);
            EpiQ E{(bf16*)(ws + WS_Q), (const unsigned long long*)(ws + WS_SSA) + l * M};
            pg8::gemm_phase<EpiQ, pg8::StaticOrder, false>(lds, g, S, E, wave);
        }
        GRID_BAR();
        for (int rep = 0; rep < (PROBE == 2 ? 2 : 1); ++rep)
        {
            PHASE_BEGIN(); (void)lane;
            for (int t0 = blk * PEER_TOK; t0 < M; t0 += Gp * PEER_TOK) {
                peer_retrieve(a, l, t0, wave, (LAS char*)lds, wave);
                __syncthreads();
                for (int k = 0; k < PEER_TOK / NWAVES; ++k) { const int tl = wave * (PEER_TOK / NWAVES) + k; peer_publish(a, l, t0 + tl, (LAS char*)lds, tl); }
                __syncthreads();
            }
        }
        GRID_BAR();
        for (int rep = 0; rep < (PROBE == 1 ? 2 : 1); ++rep)
        {
            PHASE_BEGIN(); (void)lane;
            const int pos = __builtin_amdgcn_readfirstlane((int)xinfo[0]), npop = __builtin_amdgcn_readfirstlane((int)xinfo[1]), rank = __builtin_amdgcn_readfirstlane((int)xinfo[2]), nloc = __builtin_amdgcn_readfirstlane((int)xinfo[3]);
            const PeerItems it{pos, npop, rank, nloc, wave}; peer_u_wave(a, l, it);
        }
        GRID_BAR();
        {
            PHASE_BEGIN(); (void)lane;
            const int pos = __builtin_amdgcn_readfirstlane((int)xinfo[0]), npop = __builtin_amdgcn_readfirstlane((int)xinfo[1]), rank = __builtin_amdgcn_readfirstlane((int)xinfo[2]), nloc = __builtin_amdgcn_readfirstlane((int)xinfo[3]);
            const PeerItems it{pos, npop, rank, nloc, wave}; peer_v_wave(a, l, it);
        }
        GRID_BAR();
    }
    {
        PHASE_BEGIN(); (void)lane;
        for (int t = gw; t < M; t += NGW) final_norm_row(a, t);
    }
}

extern "C" void kernel_launch(void* const* d_in, const int* in_sizes, int n_in, void* d_out, int out_size, void* d_ws, size_t ws_size, hipStream_t stream) {
    static int grid = 0;
    if (grid == 0) {
        int dev = 0, cus = 0, per_cu = 0;
        if (n_in != 16 || out_size != M * D || ws_size < WS_END2) { fprintf(stderr, "kernel_launch: unexpected shapes (n_in %d out %d ws %zu)\n", n_in, out_size, ws_size); grid = -1; return; }
        (void)hipGetDevice(&dev);
        (void)hipDeviceGetAttribute(&cus, hipDeviceAttributeMultiprocessorCount, dev);
        (void)hipFuncSetAttribute((const void*)mk_fwd, hipFuncAttributeMaxDynamicSharedMemorySize, LDS_BYTES);
        (void)hipOccupancyMaxActiveBlocksPerMultiprocessor(&per_cu, (const void*)mk_fwd, NT, LDS_BYTES);
        if (per_cu < 1) { fprintf(stderr, "kernel_launch: occupancy query says %d blocks per CU\n", per_cu); }
        grid = cus;
        if (grid > 256) grid = 256;
    }
    if (grid < 0) return;
    (void)hipMemsetAsync((char*)d_ws + WS_CTL, 0, CTL_ZERO_BYTES, stream);
    ArgsK a{};
    const GAS float** p = (const GAS float**)&a;
    for (int i = 0; i < 16; ++i) p[i] = (const GAS float*)d_in[i];
    a.out = (GAS float*)d_out; a.ws = (GAS unsigned char*)d_ws;
    void* args[] = {&a};
    hipError_t e = hipLaunchCooperativeKernel((const void*)mk_fwd, dim3(grid), dim3(NT), args, LDS_BYTES, stream);
    if (e != hipSuccess) fprintf(stderr, "cooperative launch failed: %s (grid %d)\n", hipGetErrorString(e), grid);
}
```

```cpp
#include <hip/hip_runtime.h>
#include <hip/hip_cooperative_groups.h>
#include <cstdio>
#include <cstdint>
namespace cg = cooperative_groups;
namespace pg8 {
#define PG8_LAS __attribute__((address_space(3)))
typedef unsigned short bf16_t;
typedef short bf16x8 __attribute__((ext_vector_type(8)));
typedef float f32x4 __attribute__((ext_vector_type(4)));
typedef unsigned u32x4 __attribute__((ext_vector_type(4)));
typedef unsigned u32x2 __attribute__((ext_vector_type(2)));
typedef int i32x4 __attribute__((ext_vector_type(4)));
constexpr int BM = 256, BK = 64, HALF = 128, HTB = HALF * BK * 2  , STAGE_BYTES = 8 * HTB, NXCD = 8, WGM = 8;

__host__ __device__ __forceinline__ int lds_byte(int r, int c) { const int st = (r >> 4) * 2 + (c >> 5), rr = r & 15, cc = c & 31, ob = rr * 64 + cc * 2; return st * 1024 + (ob ^ (((ob >> 9) & 1) << 5)); }
__host__ __device__ __forceinline__ void stage_rc(int b, int& R, int& C) { const int st = b / 1024, sb = b % 1024, swz = sb ^ (((sb >> 9) & 1) << 5); R = (st >> 1) * 16 + swz / 64; C = (st & 1) * 32 + (swz % 64) / 2; }
__host__ __device__ __forceinline__ int perm32(int rho) { const int n = rho >> 4, i = rho & 15; return 8 * (i >> 2) + 4 * n + (i & 3); }

struct Unit { int pm, pn; };
struct Gemm { const bf16_t* A; const bf16_t* Bt; int M, N, K; };

struct StaticOrder {
    int nM, nN, nwg, G, c;
    __host__ __device__ void init(int M, int N, int G_, int c_) { nM = M / BM; nN = N / BM; nwg = nM * nN; G = G_; c = c_; }
    __host__ __device__ bool next(int i, Unit& u) const {
        const long L = (long)i * G + c; if (L >= nwg) return false;
        int wgid = (int)L; { const int q = nwg / NXCD, r = nwg % NXCD, xcd = wgid % NXCD, off = wgid / NXCD; wgid = (xcd < r ? xcd * (q + 1) : r * (q + 1) + (xcd - r) * q) + off; }
        const int nig = WGM * nN, gid = wgid / nig, fm = gid * WGM, gsz = (nM - fm) < WGM ? (nM - fm) : WGM;
        u.pm = fm + ((wgid % nig) % gsz); u.pn = (wgid % nig) / gsz; return true;
    }
};

__device__ __forceinline__ unsigned cvt_pk_bf16(float lo, float hi) { unsigned r; asm volatile("v_cvt_pk_bf16_f32 %0, %1, %2" : "=v"(r) : "v"(lo), "v"(hi)); return r; }

template <class Epi, class Sched, bool ALIGN_EPI = false, bool I8 = false>
__device__ __forceinline__ void gemm_phase(PG8_LAS unsigned char* lds, const Gemm g, const Sched& S, const Epi& E, int wid) {
    int lane_; asm volatile("v_mbcnt_lo_u32_b32 %0, -1, 0\n\tv_mbcnt_hi_u32_b32 %0, -1, %0" : "=v"(lane_));
    const int lane = lane_, tid = wid * 64 + lane, wr = wid >> 2, wc = wid & 3, fr = lane & 15, fq = lane >> 4;
    const int K = g.K, nt = K / BK;
    unsigned voffA, voffB;
    { int R, C; stage_rc(tid * 16, R, C); const int Rb = Epi::PERM ? ((R & ~31) + perm32(R & 31)) : R; voffA = (unsigned)(R * K + C) * 2u; voffB = (unsigned)(Rb * K + C) * 2u; }
    const size_t p2step = (size_t)64 * K * 2;
    const size_t kstep = (size_t)(BK * 2);
    const size_t hstep = (size_t)HALF * K * 2;
    const size_t tstep = 2 * hstep;
    const unsigned ldsw = (unsigned)wid * 1024u;
    const int aoff = lds_byte(wr * 64 + fr, fq * 8), boff = lds_byte(wc * 32 + fr, fq * 8);
#define PG8_SA(b, h) (((b) * 2 + (h)) * HTB)
#define PG8_SB(b, h) ((4 + (b) * 2 + (h)) * HTB)
#define PG8_STAGE(bufoff, gbase, voff) do { _Pragma("unroll") for (int _i = 0; _i < 2; ++_i) \
        __builtin_amdgcn_global_load_lds((const unsigned*)((const char*)(gbase) + _i * p2step + (voff)), (PG8_LAS unsigned*)(lds + (bufoff) + ldsw + _i * 8192), 16, 0, 0); } while (0)
#define PG8_LDA(dst, b, h) do { _Pragma("unroll") for (int m = 0; m < 4; ++m) _Pragma("unroll") for (int k = 0; k < 2; ++k) dst[m][k] = *(const PG8_LAS bf16x8*)(lds + PG8_SA(b, h) + aoff + m * 2048 + k * 1024); } while (0)
#define PG8_LDB(dst, b, h) do { _Pragma("unroll") for (int n = 0; n < 2; ++n) _Pragma("unroll") for (int k = 0; k < 2; ++k) dst[n][k] = *(const PG8_LAS bf16x8*)(lds + PG8_SB(b, h) + boff + n * 2048 + k * 1024); } while (0)
#define PG8_MMA(ai, bj, At, Bt) do { __builtin_amdgcn_s_setprio(1); _Pragma("unroll") for (int m = 0; m < 4; ++m) _Pragma("unroll") for (int n = 0; n < 2; ++n) _Pragma("unroll") for (int k = 0; k < 2; ++k) \
        { if constexpr (I8) acc[ai][bj][m][n] = __builtin_bit_cast(f32x4, __builtin_amdgcn_mfma_i32_16x16x64_i8(__builtin_bit_cast(i32x4, Bt[n][k]), __builtin_bit_cast(i32x4, At[m][k]), __builtin_bit_cast(i32x4, acc[ai][bj][m][n]), 0, 0, 0)); \
          else acc[ai][bj][m][n] = __builtin_amdgcn_mfma_f32_16x16x32_bf16(Bt[n][k], At[m][k], acc[ai][bj][m][n], 0, 0, 0); } __builtin_amdgcn_s_setprio(0); } while (0)
#define PG8_WAIT_V(n) asm volatile("s_waitcnt vmcnt(" #n ")" ::: "memory")
#define PG8_WAIT_L(n) asm volatile("s_waitcnt lgkmcnt(" #n ")" ::: "memory")
#define PG8_BAR __builtin_amdgcn_s_barrier()
#define PG8_SCHED __builtin_amdgcn_sched_barrier(0)
    Unit cur, nxt; int ui = 0;
    if (!S.next(0, cur)) return;
    f32x4 acc[2][2][4][2];
#pragma unroll
    for (int a = 0; a < 2; ++a)
#pragma unroll
        for (int b = 0; b < 2; ++b)
#pragma unroll
            for (int m = 0; m < 4; ++m)
#pragma unroll
                for (int n = 0; n < 2; ++n) acc[a][b][m][n] = (f32x4){0.f, 0.f, 0.f, 0.f};
    bf16x8 At[4][2], B0[2][2], B1[2][2];
    typename Epi::Pre pre = {};
    const char* cA = (const char*)g.A + (size_t)cur.pm * tstep; const char* cB = (const char*)g.Bt + (size_t)cur.pn * tstep;
    PG8_STAGE(PG8_SB(0, 0), cB, voffB); PG8_STAGE(PG8_SB(0, 1), cB + hstep, voffB); PG8_STAGE(PG8_SA(0, 0), cA, voffA); PG8_STAGE(PG8_SA(0, 1), cA + hstep, voffA);
    if (wr == 1) PG8_BAR;
    PG8_WAIT_V(2); PG8_BAR;
    PG8_STAGE(PG8_SB(1, 0), cB + kstep, voffB); PG8_STAGE(PG8_SA(1, 0), cA + kstep, voffA); PG8_STAGE(PG8_SB(1, 1), cB + hstep + kstep, voffB);
    PG8_WAIT_V(6); PG8_BAR;
    for (;;) {
        const bool has_next = S.next(ui + 1, nxt);
        const char* nA = has_next ? (const char*)g.A + (size_t)nxt.pm * tstep : cA; const char* nB = has_next ? (const char*)g.Bt + (size_t)nxt.pn * tstep : cB;
        const int seglen = Epi::HOOK ? 8 : nt;
        for (int t0 = 0; t0 < nt; t0 += seglen) {
        if constexpr (Epi::HOOK) { if (t0 > 0) { int ln_; asm volatile("v_mbcnt_lo_u32_b32 %0, -1, 0\n\tv_mbcnt_hi_u32_b32 %0, -1, %0" : "=v"(ln_)); E.hook(acc, cur, t0 >> 3, wr, wc, ln_ & 15, ln_ >> 4); } }
        for (int t = t0; t < t0 + seglen; t += 2) {
            const bool last = (t == nt - 2);
            if constexpr (Epi::PRELOAD) { if (last) { int ln_; asm volatile("v_mbcnt_lo_u32_b32 %0, -1, 0\n\tv_mbcnt_hi_u32_b32 %0, -1, %0" : "=v"(ln_)); E.preload(pre, cur, wr, wc, ln_ & 15, ln_ >> 4); } }
            const char* a1 = cA + (size_t)(t + 1) * kstep;
            const char* a2 = last ? nA : cA + (size_t)(t + 2) * kstep; const char* b2 = last ? nB : cB + (size_t)(t + 2) * kstep;
            const char* a3 = a2 + kstep; const char* b3 = b2 + kstep;
            PG8_LDB(B0, 0, 0); PG8_LDB(B1, 0, 1); PG8_SCHED; PG8_LDA(At, 0, 0); PG8_STAGE(PG8_SA(1, 1), a1 + hstep, voffA);
            PG8_WAIT_V(8); PG8_WAIT_L(0); PG8_BAR; PG8_MMA(0, 0, At, B0); PG8_MMA(0, 1, At, B1); PG8_BAR; PG8_SCHED;
            PG8_LDA(At, 0, 1); PG8_STAGE(PG8_SB(0, 0), b2, voffB); PG8_STAGE(PG8_SB(0, 1), b2 + hstep, voffB); PG8_STAGE(PG8_SA(0, 0), a2, voffA);
            PG8_WAIT_V(8); PG8_WAIT_L(0); PG8_BAR; PG8_MMA(1, 0, At, B0); PG8_MMA(1, 1, At, B1); PG8_BAR; PG8_SCHED;
            PG8_LDB(B0, 1, 0); PG8_LDB(B1, 1, 1); PG8_SCHED; PG8_LDA(At, 1, 0); PG8_STAGE(PG8_SA(0, 1), a2 + hstep, voffA);
            PG8_WAIT_V(8); PG8_WAIT_L(0); PG8_BAR; PG8_MMA(0, 0, At, B0); PG8_MMA(0, 1, At, B1); PG8_BAR; PG8_SCHED;
            PG8_LDA(At, 1, 1); PG8_STAGE(PG8_SB(1, 0), b3, voffB); PG8_STAGE(PG8_SB(1, 1), b3 + hstep, voffB); PG8_STAGE(PG8_SA(1, 0), a3, voffA);
            PG8_WAIT_V(8); PG8_WAIT_L(0); PG8_BAR; PG8_MMA(1, 0, At, B0); PG8_MMA(1, 1, At, B1); PG8_BAR; PG8_SCHED;
        }
        }
        if constexpr (ALIGN_EPI) { if (wr == 0) PG8_BAR; }
        { int ln_; asm volatile("v_mbcnt_lo_u32_b32 %0, -1, 0\n\tv_mbcnt_hi_u32_b32 %0, -1, %0" : "=v"(ln_));
          if constexpr (Epi::PRELOAD) E(acc, cur, wr, wc, ln_ & 15, ln_ >> 4, pre); else E(acc, cur, wr, wc, ln_ & 15, ln_ >> 4); }
        if (!has_next) break;
#pragma unroll
        for (int a = 0; a < 2; ++a)
#pragma unroll
            for (int b = 0; b < 2; ++b)
#pragma unroll
                for (int m = 0; m < 4; ++m)
#pragma unroll
                    for (int n = 0; n < 2; ++n) acc[a][b][m][n] = (f32x4){0.f, 0.f, 0.f, 0.f};
        cur = nxt; cA = nA; cB = nB; ++ui;
        if constexpr (ALIGN_EPI) { if (wr == 1) PG8_BAR; }
    }
    PG8_WAIT_V(0);
    if constexpr (!ALIGN_EPI) { if (wr == 0) PG8_BAR; }
    PG8_BAR;
#undef PG8_SA
#undef PG8_SB
#undef PG8_STAGE
#undef PG8_LDA
#undef PG8_LDB
#undef PG8_MMA
#undef PG8_WAIT_V
#undef PG8_WAIT_L
#undef PG8_BAR
#undef PG8_SCHED
}
}
#ifndef PROBE
#define PROBE 0
#endif
#ifndef PROBE11_THR
#define PROBE11_THR 1000000u
#endif
constexpr int NWAVES = 8, NT = NWAVES * 64;
constexpr int M = 8192, D = 2048, SEQ = 2048, NBATCH = 4, DEPTH = 2;
constexpr int INW = 13316, NPROJ = 13312, MIXW = 512, HD = 128;
constexpr int PEER_E = 16384;
constexpr float EPS = 1e-6f;
constexpr float ATT_SCALE = 0.08838834764831845f;

constexpr size_t MiB = 1u << 20;
constexpr size_t WS_CTL = 0, CTL_ZERO_BYTES = 1 * MiB;
constexpr size_t WS_SSQ = 0;
constexpr size_t WS_SSA = 256 * 1024;
constexpr size_t WS_WF = 1 * MiB;
constexpr size_t WS_BINR = WS_WF + 64 * 1024;
constexpr size_t WS_LOGF = 2 * MiB;
constexpr size_t WS_CUM = 3 * MiB;
constexpr size_t WS_WIN = 8 * MiB;
constexpr size_t WIN_BYTES = (size_t)NPROJ * D;
constexpr size_t WS_SW = 7 * MiB;
constexpr size_t WS_CMAX = 384 * 1024;
constexpr size_t WS_HB8 = 64 * MiB;
constexpr size_t WS_SA = 7 * MiB + 512 * 1024;
constexpr size_t WS_WBR = 112 * MiB, WS_WOUT = 128 * MiB, WS_WQ = 144 * MiB;
constexpr size_t SQ_BYTES = (size_t)D * D * 2;
constexpr size_t WS_PU = 160 * MiB, WS_PV = 288 * MiB;
constexpr size_t PE_BYTES = (size_t)PEER_E * D;
constexpr size_t WS_PK = 6 * MiB;
constexpr size_t WS_SU = 5 * MiB, WS_SV = 5 * MiB + 256 * 1024;
constexpr size_t WS_H = 416 * MiB;
constexpr size_t WS_HB = 480 * MiB;
constexpr size_t WS_PROJ = 512 * MiB;
constexpr size_t PROJ_T = (size_t)M * MIXW;
constexpr size_t WS_R = 592 * MiB;
constexpr size_t R_PLANE = (size_t)M * D;
constexpr size_t WS_Y = 720 * MiB;
constexpr size_t WS_MRG = 752 * MiB;
constexpr size_t WS_Q = 784 * MiB;
constexpr size_t WS_END = 816 * MiB;

constexpr int RING_BYTES = 131072;
constexpr int LDS_BYTES = 147456;

typedef unsigned short bf16;
typedef unsigned v4u __attribute__((ext_vector_type(4)));
typedef unsigned v2u __attribute__((ext_vector_type(2)));
typedef float f32x4 __attribute__((ext_vector_type(4)));
typedef float f32x2 __attribute__((ext_vector_type(2)));
using bf16x2 = __attribute__((ext_vector_type(2))) __bf16;
#define LAS __attribute__((address_space(3)))

__device__ __forceinline__ unsigned f2bf(float f) { unsigned u = __builtin_bit_cast(unsigned, f); return (u + 0x7fffu + ((u >> 16) & 1u)) >> 16; }
__device__ __forceinline__ unsigned pk2(float lo, float hi) { return f2bf(lo) | (f2bf(hi) << 16); }
__device__ __forceinline__ float bflo(unsigned w) { return __builtin_bit_cast(float, w << 16); }
__device__ __forceinline__ float bfhi(unsigned w) { return __builtin_bit_cast(float, w & 0xffff0000u); }
__device__ __forceinline__ float bf2f(bf16 b) { return __builtin_bit_cast(float, ((unsigned)b) << 16); }
__device__ __forceinline__ float shf(float v, int src) { return __builtin_bit_cast(float, __builtin_amdgcn_ds_bpermute(src << 2, __builtin_bit_cast(int, v))); }
__device__ __forceinline__ int shi(int v, int src) { return __builtin_amdgcn_ds_bpermute(src << 2, v); }
__device__ __forceinline__ float wave_sum(float v, int lane) {
#pragma unroll
    for (int o = 1; o < 64; o <<= 1) v += shf(v, lane ^ o);
    return v;
}
__device__ __forceinline__ float wave_max(float v, int lane) {
#pragma unroll
    for (int o = 1; o < 64; o <<= 1) v = fmaxf(v, shf(v, lane ^ o));
    return v;
}
__device__ __forceinline__ float ssa_to_f(unsigned long long v) { return (float)((double)v * (1.0 / 4294967296.0)); }
__device__ __forceinline__ float dot2_bf16(unsigned w, unsigned x, float acc) { return __builtin_amdgcn_fdot2_f32_bf16(__builtin_bit_cast(bf16x2, w), __builtin_bit_cast(bf16x2, x), acc, false); }

#define LANE_ID(x) asm volatile("v_mbcnt_lo_u32_b32 %0, -1, 0\n\tv_mbcnt_hi_u32_b32 %0, -1, %0" : "=v"(x))
struct Args {
    const float *x, *norm_mix, *w_in, *b_in, *pool_w, *pool_scale, *conv_w, *rel_bias, *w_branch, *w_out, *norm_ffn, *peer_wq, *peer_keys, *peer_u, *peer_v, *norm_final;
    float* out; unsigned char* ws;
};
#define GAS __attribute__((address_space(1)))
#define CAS __attribute__((address_space(4)))
struct ArgsK {
    const GAS float *x, *norm_mix, *w_in, *b_in, *pool_w, *pool_scale, *conv_w, *rel_bias, *w_branch, *w_out, *norm_ffn, *peer_wq, *peer_keys, *peer_u, *peer_v, *norm_final;
    GAS float* out; GAS unsigned char* ws;
};
__device__ __forceinline__ Args load_args(const CAS ArgsK* k, size_t zoff) {
    Args a;
    a.x = (const float*)k->x; a.norm_mix = (const float*)k->norm_mix; a.w_in = (const float*)k->w_in; a.b_in = (const float*)k->b_in; a.pool_w = (const float*)k->pool_w;
    a.pool_scale = (const float*)k->pool_scale; a.conv_w = (const float*)k->conv_w; a.rel_bias = (const float*)k->rel_bias; a.w_branch = (const float*)k->w_branch;
    a.w_out = (const float*)k->w_out; a.norm_ffn = (const float*)k->norm_ffn; a.peer_wq = (const float*)k->peer_wq; a.peer_keys = (const float*)k->peer_keys;
    a.peer_u = (const float*)k->peer_u; a.peer_v = (const float*)k->peer_v; a.norm_final = (const float*)k->norm_final; a.out = (float*)k->out; a.ws = (unsigned char*)(k->ws + zoff);
    return a;
}

using pg8::f32x4; using pg8::Unit;
constexpr size_t WS_G = 896 * MiB;
constexpr size_t WS_SWH = 7 * MiB + 256 * 1024, WS_BIH = 7 * MiB + 384 * 1024;
constexpr size_t WS_RSA = 7 * MiB + 768 * 1024;
struct EpiProj {
    static constexpr bool PERM = true, HOOK = false, PRELOAD = true;
    struct Pre { pg8::u32x4 sw[2], bi[2]; float rs[2][4]; };
    unsigned char* wsb; const bf16* biash; const float* rsa; const bf16* swh;
    __device__ __forceinline__ void preload(Pre& p, const Unit& u, int wr, int wc, int fr, int fq) const {
        const int row0 = u.pm * 256 + wr * 64 + fr, bcol0 = u.pn * 256 + wc * 32 + 8 * fq;
#pragma unroll
        for (int bj = 0; bj < 2; ++bj) { p.sw[bj] = *(const pg8::u32x4*)(swh + bcol0 + bj * 128); p.bi[bj] = *(const pg8::u32x4*)(biash + bcol0 + bj * 128); }
#pragma unroll
        for (int ai = 0; ai < 2; ++ai)
#pragma unroll
            for (int m = 0; m < 4; ++m) p.rs[ai][m] = rsa[row0 + ai * 128 + m * 16];
    }
    __device__ __forceinline__ void operator()(f32x4 (&acc)[2][2][4][2], const Unit& u, int wr, int wc, int fr, int fq, const Pre& p) const {
        const int cl0 = wc * 32 + 8 * fq;
#define ACCF(ai, bj, m, n) __builtin_convertvector(__builtin_bit_cast(pg8::i32x4, acc[ai][bj][m][n]), f32x4)
        const __amdgpu_buffer_rsrc_t rW = __builtin_amdgcn_make_buffer_rsrc((void*)wsb, 0, 0x7fffffff, 0x00020000);
        int sbase, ldb;
        if (u.pn < 20) { sbase = (int)WS_PROJ + ((u.pn >> 1) * (int)PROJ_T + (u.pn & 1) * 256) * 2; ldb = MIXW * 2; } else { sbase = (int)WS_G + (u.pn - 20) * 512; ldb = 4 * D * 2; }
        const int voff = fr * ldb + cl0 * 2; sbase += (u.pm * 256 + wr * 64) * ldb;
#pragma unroll
        for (int bj = 0; bj < 2; ++bj) { const f32x4 w0 = {bflo(p.sw[bj].x), bfhi(p.sw[bj].x), bflo(p.sw[bj].y), bfhi(p.sw[bj].y)}, w1 = {bflo(p.sw[bj].z), bfhi(p.sw[bj].z), bflo(p.sw[bj].w), bfhi(p.sw[bj].w)};
            const f32x4 b0 = {bflo(p.bi[bj].x), bfhi(p.bi[bj].x), bflo(p.bi[bj].y), bfhi(p.bi[bj].y)}, b1 = {bflo(p.bi[bj].z), bfhi(p.bi[bj].z), bflo(p.bi[bj].w), bfhi(p.bi[bj].w)};
#pragma unroll
            for (int ai = 0; ai < 2; ++ai)
#pragma unroll
                for (int m = 0; m < 4; ++m) { const float rs = p.rs[ai][m]; f32x4 v0 = ACCF(ai, bj, m, 0) * rs * w0 + b0, v1 = ACCF(ai, bj, m, 1) * rs * w1 + b1;
                    if (u.pn >= 20) {
                        v0 = (f32x4){fminf(1.0f + __builtin_amdgcn_exp2f(-1.4426950408889634f * v0[0]), 1e18f), fminf(1.0f + __builtin_amdgcn_exp2f(-1.4426950408889634f * v0[1]), 1e18f), fminf(1.0f + __builtin_amdgcn_exp2f(-1.4426950408889634f * v0[2]), 1e18f), fminf(1.0f + __builtin_amdgcn_exp2f(-1.4426950408889634f * v0[3]), 1e18f)};
                        v1 = (f32x4){fminf(1.0f + __builtin_amdgcn_exp2f(-1.4426950408889634f * v1[0]), 1e18f), fminf(1.0f + __builtin_amdgcn_exp2f(-1.4426950408889634f * v1[1]), 1e18f), fminf(1.0f + __builtin_amdgcn_exp2f(-1.4426950408889634f * v1[2]), 1e18f), fminf(1.0f + __builtin_amdgcn_exp2f(-1.4426950408889634f * v1[3]), 1e18f)}; }
                    pg8::u32x4 w; w.x = pg8::cvt_pk_bf16(v0[0], v0[1]); w.y = pg8::cvt_pk_bf16(v0[2], v0[3]); w.z = pg8::cvt_pk_bf16(v1[0], v1[1]); w.w = pg8::cvt_pk_bf16(v1[2], v1[3]);
                    __builtin_amdgcn_raw_buffer_store_b128(w, rW, voff + bj * 256, sbase + (ai * 128 + m * 16) * ldb, 0); } }
    }
};
#undef ACCF
struct EpiSum {
    static constexpr bool PERM = true, HOOK = false; static constexpr bool PRELOAD = false; struct Pre {};
    float* dummy;
    __device__ __forceinline__ void operator()(f32x4 (&acc)[2][2][4][2], const Unit& u, int wr, int wc, int fr, int fq) const {
        f32x4 s = {0.f, 0.f, 0.f, 0.f};
#pragma unroll
        for (int ai = 0; ai < 2; ++ai)
#pragma unroll
            for (int bj = 0; bj < 2; ++bj)
#pragma unroll
                for (int m = 0; m < 4; ++m)
#pragma unroll
                    for (int n = 0; n < 2; ++n) s += acc[ai][bj][m][n];
        dummy[((u.pm * 64 + u.pn) * 8 + wr * 4 + wc) * 64 + fq * 16 + fr] = (s[0] + s[1]) + (s[2] + s[3]);
    }
};
template <int MODE> struct EpiSt {
    static constexpr bool PERM = true, HOOK = false, PRELOAD = false; struct Pre {};
    unsigned char* wsb;
    __device__ __forceinline__ void operator()(f32x4 (&acc)[2][2][4][2], const Unit& u, int wr, int wc, int fr, int fq) const {
        const __amdgpu_buffer_rsrc_t rW = __builtin_amdgcn_make_buffer_rsrc((void*)wsb, 0, 0x7fffffff, 0x00020000);
        const int ldb = 4 * D * 2; int sbase = (int)WS_R + (u.pn % 32) * 512 + (u.pm * 256 + wr * 64) * ldb;
        const int ln = fq * 16 + fr; const int r = MODE ? (ln >> 2) : fr, cg = MODE ? (ln & 3) : fq;
        const int voff = r * ldb + (wc * 32 + 8 * cg) * 2;
#pragma unroll
        for (int bj = 0; bj < 2; ++bj)
#pragma unroll
            for (int ai = 0; ai < 2; ++ai)
#pragma unroll
                for (int m = 0; m < 4; ++m) { pg8::u32x4 w = __builtin_bit_cast(pg8::u32x4, acc[ai][bj][m][0] + acc[ai][bj][m][1]);
                    __builtin_amdgcn_raw_buffer_store_b128(w, rW, voff + bj * 256, sbase + (ai * 128 + m * 16) * ldb, 0); }
    }
};
struct EpiMerge {
    static constexpr bool PERM = true, HOOK = true; static constexpr bool PRELOAD = false; struct Pre {};
    const bf16* G; bf16* O;
    struct Bt { pg8::u32x4 n[2][2], d[2][2]; };
    __device__ __forceinline__ void scale(f32x4 (&acc)[2][2][4][2], const Unit& u, int g, int wr, int wc, int fr, int fq) const {
        const __amdgpu_buffer_rsrc_t rs = __builtin_amdgcn_make_buffer_rsrc((void*)G, 0, 0x7fffffff, 0x00020000);
        int voff = (fr * 4 * D + 8 * fq) * 2; asm volatile("" : "+v"(voff));
        const int sden = ((u.pm * 256 + wr * 64) * 4 * D + (g - 1) * D + u.pn * 256 + wc * 32) * 2, snum = sden + D * 2;
        const bool fin = g == 4;
#define MG_LOAD(B, b0) do { _Pragma("unroll") for (int i = 0; i < 2; ++i) _Pragma("unroll") for (int bj = 0; bj < 2; ++bj) { const int ai_ = ((b0) + i) >> 2, m_ = ((b0) + i) & 3, so_ = (ai_ * 128 + m_ * 16) * 4 * D * 2; \
            B.d[i][bj] = __builtin_amdgcn_raw_buffer_load_b128(rs, voff + bj * 256, sden + so_, 0); if (!fin) B.n[i][bj] = __builtin_amdgcn_raw_buffer_load_b128(rs, voff + bj * 256, snum + so_, 0); } } while (0)
#define MG_APPLY(B, b0) do { _Pragma("unroll") for (int i = 0; i < 2; ++i) _Pragma("unroll") for (int bj = 0; bj < 2; ++bj) { const int ai_ = ((b0) + i) >> 2, m_ = ((b0) + i) & 3; const pg8::u32x4 dv = B.d[i][bj], nv = B.n[i][bj]; \
            f32x4 r0 = {__builtin_amdgcn_rcpf(bflo(dv.x)), __builtin_amdgcn_rcpf(bfhi(dv.x)), __builtin_amdgcn_rcpf(bflo(dv.y)), __builtin_amdgcn_rcpf(bfhi(dv.y))}, r1 = {__builtin_amdgcn_rcpf(bflo(dv.z)), __builtin_amdgcn_rcpf(bfhi(dv.z)), __builtin_amdgcn_rcpf(bflo(dv.w)), __builtin_amdgcn_rcpf(bfhi(dv.w))}; \
            if (!fin) { r0 *= (f32x4){bflo(nv.x), bfhi(nv.x), bflo(nv.y), bfhi(nv.y)}; r1 *= (f32x4){bflo(nv.z), bfhi(nv.z), bflo(nv.w), bfhi(nv.w)}; } \
            acc[ai_][bj][m_][0] *= r0; acc[ai_][bj][m_][1] *= r1; asm volatile("" : "+v"(acc[ai_][bj][m_][0]), "+v"(acc[ai_][bj][m_][1])); } } while (0)
        Bt A = {}, B = {};
        MG_LOAD(A, 0);
        MG_LOAD(B, 2); MG_APPLY(A, 0); asm volatile("" ::: "memory");
        MG_LOAD(A, 4); MG_APPLY(B, 2); asm volatile("" ::: "memory");
        MG_LOAD(B, 6); MG_APPLY(A, 4); asm volatile("" ::: "memory");
        MG_APPLY(B, 6); asm volatile("" ::: "memory");
#undef MG_LOAD
#undef MG_APPLY
    }
    __device__ __forceinline__ void hook(f32x4 (&acc)[2][2][4][2], const Unit& u, int g, int wr, int wc, int fr, int fq) const { scale(acc, u, g, wr, wc, fr, fq); }
    __device__ __forceinline__ void operator()(f32x4 (&acc)[2][2][4][2], const Unit& u, int wr, int wc, int fr, int fq) const {
        scale(acc, u, 4, wr, wc, fr, fq);
        const int row0 = u.pm * 256 + wr * 64 + fr, col0 = u.pn * 256 + wc * 32 + 8 * fq;
#pragma unroll
        for (int ai = 0; ai < 2; ++ai)
#pragma unroll
            for (int m = 0; m < 4; ++m) { bf16* rowp = O + (size_t)(row0 + ai * 128 + m * 16) * D + col0;
#pragma unroll
                for (int bj = 0; bj < 2; ++bj) { const f32x4 v0 = acc[ai][bj][m][0], v1 = acc[ai][bj][m][1];
                    pg8::u32x4 w; w.x = pg8::cvt_pk_bf16(v0[0], v0[1]); w.y = pg8::cvt_pk_bf16(v0[2], v0[3]); w.z = pg8::cvt_pk_bf16(v1[0], v1[1]); w.w = pg8::cvt_pk_bf16(v1[2], v1[3]);
                    *(pg8::u32x4*)(rowp + bj * 128) = w; } }
    }
};
struct EpiRes {
    static constexpr bool PERM = false, HOOK = false; static constexpr bool PRELOAD = false; struct Pre {};
    float* H; bf16* HB; unsigned long long* ssa;
    __device__ __forceinline__ void operator()(f32x4 (&acc)[2][2][4][2], const Unit& u, int wr, int wc, int fr, int fq) const {
        const int row0 = u.pm * 256 + wr * 64 + fr, col0 = u.pn * 256 + wc * 32 + 4 * fq;
#pragma unroll
        for (int ai = 0; ai < 2; ++ai)
#pragma unroll
            for (int m = 0; m < 4; ++m) { const int row = row0 + ai * 128 + m * 16; const size_t off = (size_t)row * D + col0; float s = 0.f;
#pragma unroll
                for (int bj = 0; bj < 2; ++bj)
#pragma unroll
                    for (int n = 0; n < 2; ++n) { const size_t o = off + bj * 128 + n * 16; const f32x4 h = *(const f32x4*)(H + o) + acc[ai][bj][m][n];
                        *(f32x4*)(H + o) = h; pg8::u32x2 w; w.x = pg8::cvt_pk_bf16(h[0], h[1]); w.y = pg8::cvt_pk_bf16(h[2], h[3]); *(pg8::u32x2*)(HB + o) = w;
                        s += (h[0] * h[0] + h[1] * h[1]) + (h[2] * h[2] + h[3] * h[3]); }
                { const int ln = fq * 16 + fr; s += shf(s, ln ^ 16); s += shf(s, ln ^ 32); }
                if (fq == 0) atomicAdd(ssa + row, (unsigned long long)((double)s * 4294967296.0)); }
    }
};
struct EpiQ {
    static constexpr bool PERM = true, HOOK = false; static constexpr bool PRELOAD = false; struct Pre {};
    bf16* O; const unsigned long long* ssa;
    __device__ __forceinline__ void operator()(f32x4 (&acc)[2][2][4][2], const Unit& u, int wr, int wc, int fr, int fq) const {
        const int row0 = u.pm * 256 + wr * 64 + fr, col0 = u.pn * 256 + wc * 32 + 8 * fq;
#pragma unroll
        for (int ai = 0; ai < 2; ++ai)
#pragma unroll
            for (int m = 0; m < 4; ++m) { const int row = row0 + ai * 128 + m * 16; const float rs = rsqrtf(ssa_to_f(ssa[row]) * (1.0f / D) + EPS);
                bf16* rowp = O + (size_t)row * D + col0;
#pragma unroll
                for (int bj = 0; bj < 2; ++bj) { const f32x4 v0 = acc[ai][bj][m][0] * rs, v1 = acc[ai][bj][m][1] * rs;
                    pg8::u32x4 w; w.x = pg8::cvt_pk_bf16(v0[0], v0[1]); w.y = pg8::cvt_pk_bf16(v0[2], v0[3]); w.z = pg8::cvt_pk_bf16(v1[0], v1[1]); w.w = pg8::cvt_pk_bf16(v1[2], v1[3]);
                    *(pg8::u32x4*)(rowp + bj * 128) = w; } }
    }
};

__device__ __forceinline__ int colmap_in(int j) { return j < 1536 ? j : j + 4; }
__device__ __forceinline__ void tr_item_i8(const float* W, const float* gain, const unsigned* cmax, unsigned char* WT, LAS float* scr, int k0, int n0, int lane) {
    const int q = lane & 7, r8 = lane >> 3, sc = colmap_in(n0 + 4 * q);
    f32x4 v[8];
#pragma unroll
    for (int i = 0; i < 8; ++i) v[i] = *(const f32x4*)(W + (size_t)(k0 + 8 * i + r8) * INW + sc);
    f32x4 inv;
#pragma unroll
    for (int e = 0; e < 4; ++e) { const float cm = __builtin_bit_cast(float, cmax[sc + e]); inv[e] = cm > 0.f ? 127.0f / cm : 0.f; }
#pragma unroll
    for (int i = 0; i < 8; ++i) { const float g = gain[k0 + 8 * i + r8];
#pragma unroll
        for (int e = 0; e < 4; ++e) scr[(8 * i + r8) * 33 + 4 * q + e] = v[i][e] * g * inv[e]; }
    asm volatile("s_waitcnt lgkmcnt(0)" ::: "memory");
    const int n = lane >> 1, hf = lane & 1;
    v4u o[2];
#pragma unroll
    for (int w = 0; w < 8; ++w) { unsigned pk = 0;
#pragma unroll
        for (int b = 0; b < 4; ++b) pk |= ((unsigned)((int)rintf(scr[(32 * hf + 4 * w + b) * 33 + n]) & 255)) << (8 * b);
        o[w >> 2][w & 3] = pk; }
    unsigned char* dst = WT + (size_t)(n0 + n) * D + k0 + 32 * hf;
    *(v4u*)dst = o[0]; *(v4u*)(dst + 16) = o[1];
    asm volatile("s_waitcnt lgkmcnt(0)" ::: "memory");
}
template <bool MAP>
__device__ __forceinline__ void tr_item(const float* W, int ldw, const float* scale, bf16* WT, int ldt, int dcol0, LAS float* scr, int k0, int n0, int lane) {
    const int q = lane & 7, r8 = lane >> 3, sc = MAP ? colmap_in(n0 + 4 * q) : (n0 + 4 * q);
    f32x4 v[8];
#pragma unroll
    for (int i = 0; i < 8; ++i) v[i] = *(const f32x4*)(W + (size_t)(k0 + 8 * i + r8) * ldw + sc);
    f32x4 s0 = {1.f, 1.f, 1.f, 1.f}, s1 = s0;
    if (scale) { s0 = *(const f32x4*)(scale + k0 + 8 * q); s1 = *(const f32x4*)(scale + k0 + 8 * q + 4); }
#pragma unroll
    for (int i = 0; i < 8; ++i)
#pragma unroll
        for (int e = 0; e < 4; ++e) scr[(8 * i + r8) * 33 + 4 * q + e] = v[i][e];
    asm volatile("s_waitcnt lgkmcnt(0)" ::: "memory");
    const int c = q;
#pragma unroll
    for (int j = 0; j < 4; ++j) { const int n = r8 + 8 * j; const LAS float* s = scr + (8 * c) * 33 + n;
        v4u o; o.x = pk2(s[0 * 33] * s0[0], s[1 * 33] * s0[1]); o.y = pk2(s[2 * 33] * s0[2], s[3 * 33] * s0[3]); o.z = pk2(s[4 * 33] * s1[0], s[5 * 33] * s1[1]); o.w = pk2(s[6 * 33] * s1[2], s[7 * 33] * s1[3]);
        *(v4u*)(WT + (size_t)(n0 + n) * ldt + dcol0 + k0 + 8 * c) = o; }
    asm volatile("s_waitcnt lgkmcnt(0)" ::: "memory");
}
constexpr size_t WS_BAR = 512 * 1024;
#define XB_TMO      128
#define XB_XCNT(j)  (256  + 64 * (j))
#define XB_XSUB(j)  (1280 + 64 * (j))
#define XB_XGEN(j)  (2304 + 64 * (j))
#define XB_TOP      3328
#define XB_TOPGEN   3392
#define XCD_BAR_WORDS 3456
#define XB_SPIN_CAP (1u << 23)
__device__ __forceinline__ unsigned xb_ld(unsigned* p)              { return __hip_atomic_load(p, __ATOMIC_RELAXED, __HIP_MEMORY_SCOPE_AGENT); }
__device__ __forceinline__ unsigned xb_add(unsigned* p, unsigned v) { return __hip_atomic_fetch_add(p, v, __ATOMIC_RELAXED, __HIP_MEMORY_SCOPE_AGENT); }
__device__ __forceinline__ unsigned xb_xcc_id() { return (unsigned)__builtin_amdgcn_s_getreg((3 << 11) | 20) & 0xFu; }
#define XB_SPIN(cond, bar) do { unsigned _sp = 0; while (cond) { __builtin_amdgcn_s_sleep(1); \
    if ((++_sp & 255u) == 0u) { if (xb_ld(&(bar)[XB_TMO])) break; if (_sp > XB_SPIN_CAP) { atomicAdd(&(bar)[XB_TMO], 1u); break; } } } } while (0)
__device__ __forceinline__ void xcd_barrier_complete(unsigned* bar, unsigned x, unsigned G, unsigned& nloc, unsigned& nx) {
    unsigned sum, cnt, mine, sp = 0u;
    for (;;) {
        sum = 0u; cnt = 0u; mine = 0u;
#pragma unroll
        for (unsigned j = 0; j < 16; ++j) { const unsigned c = xb_ld(&bar[XB_XCNT(j)]); sum += c; cnt += (c > 0u) ? 1u : 0u; mine = (j == x) ? c : mine; }
        if (sum == G) break;
        __builtin_amdgcn_s_sleep(1);
        if ((++sp & 255u) == 0u) { if (xb_ld(&bar[XB_TMO])) break; if (sp > XB_SPIN_CAP) { atomicAdd(&bar[XB_TMO], 1u); break; } }
    }
    nloc = mine > 0u ? mine : 1u; nx = cnt > 0u ? cnt : 1u;
}
__device__ __forceinline__ void xcd_barrier(unsigned* bar, unsigned x, unsigned G, volatile LAS unsigned* st, int wave) {
    asm volatile("s_waitcnt vmcnt(0)" ::: "memory");
    __syncthreads();
    int lane; asm volatile("v_mbcnt_lo_u32_b32 %0, -1, 0\n\tv_mbcnt_hi_u32_b32 %0, -1, %0" : "=v"(lane));
    if (wave == 0 && lane == 0) {
        __builtin_amdgcn_s_waitcnt(0);
        unsigned nloc = st[0], nx = st[1];
        if (nloc == 0u) { xcd_barrier_complete(bar, x, G, nloc, nx); st[0] = nloc; st[1] = nx; }
        const unsigned old = xb_add(&bar[XB_XSUB(x)], 1u);
        const unsigned gen = old / nloc;
        if (old + 1u == (gen + 1u) * nloc) {
            __builtin_amdgcn_fence(__ATOMIC_RELEASE, "agent");
            asm volatile("s_waitcnt vmcnt(0)" ::: "memory");
            const unsigned og = xb_add(&bar[XB_TOP], 1u);
            const unsigned tg = og / nx;
            if (og + 1u == (tg + 1u) * nx) xb_add(&bar[XB_TOPGEN], 1u);
            else XB_SPIN(xb_ld(&bar[XB_TOPGEN]) == tg, bar);
            __builtin_amdgcn_fence(__ATOMIC_ACQUIRE, "agent");
            xb_add(&bar[XB_XGEN(x)], 1u);
            asm volatile("s_waitcnt vmcnt(0)" ::: "memory");
        } else {
            XB_SPIN(xb_ld(&bar[XB_XGEN(x)]) == gen, bar);
            __builtin_amdgcn_fence(__ATOMIC_ACQUIRE, "agent");
            asm volatile("s_waitcnt vmcnt(0)" ::: "memory");
        }
    }
    __syncthreads();
}
namespace att {
constexpr int D = 128, NW = 8, QBLK = 32, KVBLK = 64, QB = NW * QBLK;
constexpr int PITCH = 512, OPITCH = 2048;
constexpr float SCALE = 0.08838834764831845f, THR = 8.f;
constexpr int SHM_V = KVBLK * D * 2, SHM_K = KVBLK * D * 2;
constexpr int OFF_WS = 2 * SHM_V + 2 * SHM_K, OFF_CUM = OFF_WS + NW * 64 * 4, OFF_REL = OFF_CUM + 2048 * 4, LDS_END = OFF_REL + 320 * 4;
typedef unsigned short bf16;
typedef short bf16x8 __attribute__((ext_vector_type(8)));
typedef short s16x4 __attribute__((ext_vector_type(4)));
typedef float f32x16 __attribute__((ext_vector_type(16)));
typedef float f32x4 __attribute__((ext_vector_type(4)));
typedef unsigned u32x4 __attribute__((ext_vector_type(4)));
#define ALDS __attribute__((address_space(3)))

#define KSWZ(row, colB) ((row) * 256 + ((colB) ^ (((row) & 7) << 4)))
#define SBAR() __builtin_amdgcn_sched_barrier(0)
__device__ __forceinline__ int v_st(int k, int c) { const int kk = (k & ~0xC) | ((k & 4) << 1) | ((k & 8) >> 1); return ((kk >> 3) * 4 + (c >> 5)) * 512 + ((kk & 7) * 32 + (c & 31)) * 2; }
__device__ __forceinline__ int v_rd_base(int lane) { return ((lane & 3) << 3) | (((lane >> 2) & 3) << 6) | (((lane >> 4) & 1) << 5) | (((lane >> 5) & 1) << 8); }
constexpr int v_rd_off(int d0, int ks, int half) { return d0 * 512 + ks * 4096 + half * 2048; }
__device__ __forceinline__ int crow(int r, int hi) { return (r & 3) + 8 * (r >> 2) + 4 * hi; }
__device__ __forceinline__ unsigned cvtpk(float lo, float hi) { unsigned r; asm volatile("v_cvt_pk_bf16_f32 %0, %1, %2" : "=v"(r) : "v"(lo), "v"(hi)); return r; }
__device__ __forceinline__ bf16x8 load8(const bf16* p) { return *reinterpret_cast<const bf16x8*>(p); }

__device__ __forceinline__ void mask_tile(f32x16& p0, f32x16& p1, int dq) {
    const float NEG = -__builtin_inff();
#pragma unroll
    for (int r = 0; r < 16; ++r) { const int c = (r & 3) + 8 * (r >> 2);
        if (dq - c < 0) p0[r] = NEG;
        if (dq - c - 32 < 0) p1[r] = NEG; }
}
__device__ __forceinline__ void partialSM(f32x16& p0, f32x16& p1, float& m_reg, float& mn, float& alpha) {
    float pmax = p0[0];
#pragma unroll
    for (int r = 1; r < 16; ++r) pmax = fmaxf(pmax, p0[r]);
#pragma unroll
    for (int r = 0; r < 16; ++r) pmax = fmaxf(pmax, p1[r]);
    { auto rr = __builtin_amdgcn_permlane32_swap(__float_as_uint(pmax), __float_as_uint(pmax), false, false);
      pmax = fmaxf(__uint_as_float(rr[0]), __uint_as_float(rr[1])); }
    constexpr float C2 = 1.4426950408889634f * SCALE;
    if (__builtin_expect(__all((pmax - m_reg) * SCALE <= THR), 1)) { mn = m_reg; alpha = 1.f; }
    else { mn = fmaxf(m_reg, pmax); alpha = __builtin_amdgcn_exp2f((m_reg - mn) * C2); m_reg = mn; }
    const float mnL = -mn * C2;
#pragma unroll
    for (int r = 0; r < 16; ++r) p0[r] = fmaf(p0[r], C2, mnL);
#pragma unroll
    for (int r = 0; r < 16; ++r) p1[r] = fmaf(p1[r], C2, mnL);
#pragma unroll
    for (int r = 0; r < 16; ++r) p0[r] = __builtin_amdgcn_exp2f(p0[r]);
}
__device__ __forceinline__ void finishSM(f32x16& p0, f32x16& p1, float alpha, float& l_reg, bf16x8& pa0, bf16x8& pa1, bf16x8& pa2, bf16x8& pa3) {
#pragma unroll
    for (int r = 0; r < 16; ++r) p1[r] = __builtin_amdgcn_exp2f(p1[r]);
    float ps = 0;
#pragma unroll
    for (int r = 0; r < 16; ++r) ps += p0[r];
#pragma unroll
    for (int r = 0; r < 16; ++r) ps += p1[r];
    { auto rr = __builtin_amdgcn_permlane32_swap(__float_as_uint(ps), __float_as_uint(ps), false, false);
      ps = __uint_as_float(rr[0]) + __uint_as_float(rr[1]); }
    l_reg = l_reg * alpha + ps;
#define PK4(P, B_, OUT) do { unsigned a0 = cvtpk(P[B_+0], P[B_+1]), a1 = cvtpk(P[B_+2], P[B_+3]);                          \
        unsigned b0 = cvtpk(P[B_+4], P[B_+5]), b1 = cvtpk(P[B_+6], P[B_+7]);                                             \
        auto r0 = __builtin_amdgcn_permlane32_swap(a0, b0, false, false); auto r1 = __builtin_amdgcn_permlane32_swap(a1, b1, false, false); \
        u32x4 w = {r0[0], r1[0], r0[1], r1[1]}; OUT = *reinterpret_cast<bf16x8*>(&w); } while (0)
    PK4(p0, 0, pa0); PK4(p0, 8, pa1); PK4(p1, 0, pa2); PK4(p1, 8, pa3);
#undef PK4
}
template <int KB>
__device__ __forceinline__ void qkt(f32x16& p0, f32x16& p1, const ALDS char* K_lds, int r32, int hi, const bf16x8* qr, bool act) {
    if (!act) { const float NEG = -__builtin_inff();
#pragma unroll
        for (int r = 0; r < 16; ++r) { p0[r] = NEG; p1[r] = NEG; } return; }
    p0 = f32x16{}; p1 = f32x16{};
    const ALDS char* kb[4];
#pragma unroll
    for (int dd = 0; dd < 4; ++dd) kb[dd] = K_lds + KB * SHM_K + KSWZ(r32, (dd * 16 + hi * 8) * 2);
#pragma unroll
    for (int d0 = 0; d0 < 8; ++d0) { const ALDS char* a = kb[d0 & 3] + (d0 >> 2) * 128;
        bf16x8 b0 = *(const ALDS bf16x8*)(a);
        bf16x8 b1 = *(const ALDS bf16x8*)(a + 32 * 256);
        p0 = __builtin_amdgcn_mfma_f32_32x32x16_bf16(b0, qr[d0], p0, 0, 0, 0);
        p1 = __builtin_amdgcn_mfma_f32_32x32x16_bf16(b1, qr[d0], p1, 0, 0, 0); }
}
template <int VB>
__device__ __forceinline__ void pv_tile(f32x16* o, int vb0, bf16x8 pa0, bf16x8 pa1, bf16x8 pa2, bf16x8 pa3, bool act) {
    if (!act) return;
#define TRRD(dst, off) asm volatile("ds_read_b64_tr_b16 %0, %1 offset:%2" : "=&v"(dst) : "v"(vb0), "i"(off) : "memory")
#define PV_D0(d0) do { s16x4 l0, l1, l2, l3, h0, h1, h2, h3; constexpr int b_ = VB * SHM_V + v_rd_off(d0, 0, 0); \
        TRRD(l0, b_); TRRD(h0, b_ + 2048); TRRD(l1, b_ + 4096); TRRD(h1, b_ + 6144); TRRD(l2, b_ + 8192); TRRD(h2, b_ + 10240); TRRD(l3, b_ + 12288); TRRD(h3, b_ + 14336); \
        asm volatile("s_waitcnt lgkmcnt(0)" ::: "memory"); SBAR(); \
        o[d0] = __builtin_amdgcn_mfma_f32_32x32x16_bf16(pa0, (bf16x8){l0[0], l0[1], l0[2], l0[3], h0[0], h0[1], h0[2], h0[3]}, o[d0], 0, 0, 0);   \
        o[d0] = __builtin_amdgcn_mfma_f32_32x32x16_bf16(pa1, (bf16x8){l1[0], l1[1], l1[2], l1[3], h1[0], h1[1], h1[2], h1[3]}, o[d0], 0, 0, 0);   \
        o[d0] = __builtin_amdgcn_mfma_f32_32x32x16_bf16(pa2, (bf16x8){l2[0], l2[1], l2[2], l2[3], h2[0], h2[1], h2[2], h2[3]}, o[d0], 0, 0, 0);   \
        o[d0] = __builtin_amdgcn_mfma_f32_32x32x16_bf16(pa3, (bf16x8){l3[0], l3[1], l3[2], l3[3], h3[0], h3[1], h3[2], h3[3]}, o[d0], 0, 0, 0); } while (0)
    PV_D0(0); PV_D0(1); PV_D0(2); PV_D0(3);
#undef PV_D0
#undef TRRD
}
template <int MODE>
__device__ __forceinline__ void bias_mask(f32x16& p0, f32x16& p1, const ALDS char* lds, int kb, int qlo, int qpos, int hi, float cqs, bool act) {
    if (!act) return;
    if (MODE == 0) {
        const ALDS float* cs = (const ALDS float*)(lds + OFF_CUM) + kb + 4 * hi;
#pragma unroll
        for (int g = 0; g < 4; ++g) { const f32x4 c0 = *(const ALDS f32x4*)(cs + 8 * g), c1 = *(const ALDS f32x4*)(cs + 32 + 8 * g);
#pragma unroll
            for (int e = 0; e < 4; ++e) { p0[4 * g + e] += cqs - c0[e]; p1[4 * g + e] += cqs - c1[e]; } }
        if (kb + KVBLK - 1 > qlo) mask_tile(p0, p1, qpos - 4 * hi - kb);
    } else {
        const ALDS float* tb = (const ALDS float*)(lds + OFF_REL);
        if (qlo - (kb + KVBLK - 1) >= 256) { const float c = tb[319];
#pragma unroll
            for (int r = 0; r < 16; ++r) { p0[r] += c; p1[r] += c; } }
        else { const int d0 = qpos - kb - 4 * hi + 63;
#pragma unroll
            for (int r = 0; r < 16; ++r) { const int c = (r & 3) + 8 * (r >> 2);
                int i0 = d0 - c, i1 = d0 - c - 32; i0 = i0 > 319 ? 319 : i0; i1 = i1 > 319 ? 319 : i1; i1 = i1 < 0 ? 0 : i1; i0 = i0 < 0 ? 0 : i0;
                p0[r] += tb[i0]; p1[r] += tb[i1]; } }
    }
}

struct Seam { bf16x8 qr[8]; bf16x8 st_v0, st_v1, st_k0, st_k1; };
#define VMW() asm volatile("s_waitcnt vmcnt(0)" ::: "memory")
#define BL8(rs, vo, so) __builtin_bit_cast(bf16x8, __builtin_amdgcn_raw_buffer_load_b128(rs, vo, so, 0))
#define SLOAD_H(Kp, Vp, k0) do { S.st_v0 = BL8(rP, kvoff, (Vp) + (k0) * (PITCH * 2)); S.st_v1 = BL8(rP, kvoff, (Vp) + ((k0) + 32) * (PITCH * 2));              \
                         S.st_k0 = BL8(rP, kvoff, (Kp) + (k0) * (PITCH * 2)); S.st_k1 = BL8(rP, kvoff, (Kp) + ((k0) + 32) * (PITCH * 2)); } while (0)
#define SWRITE_HK(bf) do { *(ALDS bf16x8*)(K_lds + (bf) * SHM_K + kws) = S.st_k0; *(ALDS bf16x8*)(K_lds + (bf) * SHM_K + kws + 32 * 256) = S.st_k1; } while (0)
#define SWRITE_HV(bf) do { *(ALDS bf16x8*)(V_lds + (bf) * SHM_V + vst0) = S.st_v0; *(ALDS bf16x8*)(V_lds + (bf) * SHM_V + vst1) = S.st_v1; } while (0)
#define SWRITE_H(bf) do { SWRITE_HV(bf); SWRITE_HK(bf); } while (0)

template <int MODE>
__device__ __forceinline__ void attn_unit(const bf16* Pb, int Qo, int Kh, int Vh, bf16* Yb, int Oo, int P0, int j_lo, int j_hi, ALDS char* lds, int wid, int lane) {
    const int tid = wid * 64 + lane, r32 = lane & 31, hi = lane >> 5;
    const int NT = j_hi - j_lo;
    const int qlo = P0 + wid * QBLK, qpos = qlo + r32;
    ALDS char* V_lds = lds; ALDS char* K_lds = lds + 2 * SHM_V;
    ALDS float* ws = (ALDS float*)(lds + OFF_WS) + wid * 64; ALDS float* li_l = ws; ALDS float* al_l = ws + 32;
    float m_reg = -1e30f, l_reg = 0; f32x16 o[4] = {};
    const int sr = tid >> 4, sc = (tid & 15) * 8, vst0 = v_st(sr, sc), vst1 = v_st(32 + sr, sc), kws = KSWZ(sr, sc * 2);
    const int vb0 = (int)(unsigned)(size_t)V_lds + v_rd_base(lane);
    Seam S;
    const __amdgpu_buffer_rsrc_t rP = __builtin_amdgcn_make_buffer_rsrc((void*)Pb, 0, 0x7fffffff, 0x00020000);
    const __amdgpu_buffer_rsrc_t rO = __builtin_amdgcn_make_buffer_rsrc((void*)Yb, 0, 0x7fffffff, 0x00020000);
    const int kvoff = (sr * PITCH + sc) * 2;
#define KBASE(t) ((j_lo + (t)) * KVBLK)
#define ACT(t) (MODE == 0 ? (KBASE(t) <= qlo + QBLK - 1) : ((j_lo + (t)) <= (qlo >> 6) && (j_lo + (t)) + 8 >= (qlo >> 6)))
#define RESC(a) do { if (__any((a) < 1.f)) { if (hi == 0) al_l[r32] = (a); asm volatile("s_waitcnt lgkmcnt(0)" ::: "memory");              \
                     for (int d_ = 0; d_ < 4; ++d_) for (int r = 0; r < 16; ++r) o[d_][r] *= al_l[crow(r, hi)]; } } while (0)
#define MASKT(P0_, P1_, t) bias_mask<MODE>(P0_, P1_, lds, KBASE(t), qlo, qpos, hi, cq_, ACT(t))
    {
        const int kb0 = j_lo * KVBLK;
#pragma unroll
        for (int d0 = 0; d0 < 8; ++d0) S.qr[d0] = BL8(rP, (r32 * PITCH + hi * 8) * 2 + d0 * 32, Qo + wid * (QBLK * PITCH * 2));
        SLOAD_H(Kh, Vh, kb0); VMW(); SWRITE_HK(0);
        __syncthreads();
    }
    const float cq_ = MODE == 0 ? ((const ALDS float*)(lds + OFF_CUM))[qpos] : 0.f;
    f32x16 pA0, pA1, pB0, pB1; float mnA, mnB, alA, alB; bf16x8 pa0, pa1, pa2, pa3;
    SWRITE_HV(0); SBAR();
    if (NT > 1) { SLOAD_H(Kh, Vh, KBASE(1)); }
    SBAR(); qkt<0>(pA0, pA1, K_lds, r32, hi, S.qr, ACT(0));
    MASKT(pA0, pA1, 0); partialSM(pA0, pA1, m_reg, mnA, alA);
    if (NT > 1) { VMW(); SWRITE_H(1); }
    __syncthreads();
#define HALF_STEP(PX0, PX1, mnX, alX, PY0, PY1, alY, t, KB, VB, SB) do {                                                      \
        SBAR(); qkt<KB>(PX0, PX1, K_lds, r32, hi, S.qr, ACT(t));                                                              \
        finishSM(PY0, PY1, alY, l_reg, pa0, pa1, pa2, pa3); SBAR();                                                           \
        if ((t) + 1 < NT) { SLOAD_H(Kh, Vh, KBASE((t) + 1)); SBAR(); }                                                        \
        pv_tile<VB>(o, vb0, pa0, pa1, pa2, pa3, ACT((t) - 1)); MASKT(PX0, PX1, (t)); partialSM(PX0, PX1, m_reg, mnX, alX);    \
        __syncthreads();                                                                                                      \
        if ((t) + 1 < NT) { VMW(); SWRITE_H(SB); }                                                                            \
        RESC(alX); __syncthreads(); } while (0)
    for (int t = 1; t + 1 < NT; t += 2) {
        HALF_STEP(pB0, pB1, mnB, alB, pA0, pA1, alA, t, 1, 0, 0);
        HALF_STEP(pA0, pA1, mnA, alA, pB0, pB1, alB, t + 1, 0, 1, 1);
    }
    const bool even = (NT & 1) == 0;
    if (even) { SBAR(); qkt<1>(pB0, pB1, K_lds, r32, hi, S.qr, ACT(NT - 1)); SBAR(); }
    finishSM(pA0, pA1, alA, l_reg, pa0, pa1, pa2, pa3); SBAR();
    pv_tile<0>(o, vb0, pa0, pa1, pa2, pa3, ACT(even ? NT - 2 : NT - 1));
    if (even) { MASKT(pB0, pB1, NT - 1); partialSM(pB0, pB1, m_reg, mnB, alB); __syncthreads(); RESC(alB);
        finishSM(pB0, pB1, alB, l_reg, pa0, pa1, pa2, pa3); SBAR(); pv_tile<1>(o, vb0, pa0, pa1, pa2, pa3, ACT(NT - 1)); }
    SBAR();
    if (hi == 0) li_l[r32] = l_reg; asm volatile("s_waitcnt lgkmcnt(0)" ::: "memory");
    float rli[16];
#pragma unroll
    for (int r = 0; r < 16; ++r) rli[r] = __builtin_amdgcn_rcpf(li_l[crow(r, hi)]);
    const int ovoff = (4 * hi * OPITCH + r32) * 2, osoff = Oo + wid * (QBLK * OPITCH * 2);
#pragma unroll
    for (int r = 0; r < 16; ++r) { const int orow = (r & 3) + 8 * (r >> 2);
#pragma unroll
        for (int d0 = 0; d0 < 4; ++d0) { const float v = o[d0][r] * rli[r];
            const float vn = __builtin_bit_cast(float, __builtin_amdgcn_ds_bpermute((lane ^ 1) << 2, __builtin_bit_cast(int, v)));
            if ((r32 & 1) == 0) __builtin_amdgcn_raw_buffer_store_b32(cvtpk(v, vn), rO, ovoff + d0 * 64, osoff + orow * (OPITCH * 2), 0); } }
    __syncthreads();
#undef RESC
#undef KBASE
#undef ACT
#undef MASKT
#undef HALF_STEP
}
#undef BL8
#undef VMW
#undef SLOAD_H
#undef SWRITE_HK
#undef SWRITE_HV
#undef SWRITE_H
#undef KSWZ
#undef SBAR
}
constexpr size_t WS_QCTR = 768 * 1024;
constexpr size_t WS_POOLW = 4 * MiB;
constexpr int N_ATT_UNITS = 256, N_POOL_UNITS = 512, N_CONV_UNITS = 128, N_GATE_UNITS = 512;

__device__ __forceinline__ void stage_cum(const Args& a, int b, int h, LAS char* lds, int wave, int lane) {
    const float* logf = (const float*)(a.ws + WS_LOGF) + ((size_t)b * SEQ) * 4 + h;
    const int tid = wave * 64 + lane;
    float v[4];
#pragma unroll
    for (int e = 0; e < 4; ++e) v[e] = logf[(size_t)(4 * tid + e) * 4];
    v[1] += v[0]; v[2] += v[1]; v[3] += v[2];
    float incl = v[3];
#pragma unroll
    for (int o = 1; o < 64; o <<= 1) { const float t = shf(incl, lane >= o ? lane - o : lane); if (lane >= o) incl += t; }
    LAS float* wt = (LAS float*)(lds + att::OFF_WS);
    if (lane == 63) wt[wave] = incl;
    __syncthreads();
    float base = incl - v[3];
    for (int w = 0; w < wave; ++w) base += wt[w];
    LAS float* cs = (LAS float*)(lds + att::OFF_CUM);
    const float inv = 1.0f / ATT_SCALE;
    *(LAS f32x4*)(cs + 4 * tid) = (f32x4){(base + v[0]) * inv, (base + v[1]) * inv, (base + v[2]) * inv, (base + v[3]) * inv};
    __syncthreads();
}
__device__ __forceinline__ void attention_item(const Args& a, int l, int u, LAS char* lds, int wave) {
    int lane; asm volatile("v_mbcnt_lo_u32_b32 %0, -1, 0\n\tv_mbcnt_hi_u32_b32 %0, -1, %0" : "=v"(lane));
    const bf16* P = (const bf16*)(a.ws + WS_PROJ); bf16* Y = (bf16*)(a.ws + WS_Y);
    const int mode = u >> 7, v = u & 127, qb = 7 - (v >> 4), bh = v & 15, b = bh >> 2, h = bh & 3;
    const size_t row0 = (size_t)b * SEQ; const int P0 = qb * 256;
    if (mode == 0) {
        stage_cum(a, b, h, lds, wave, lane);
        att::attn_unit<0>(P, (int)((0 * PROJ_T + (row0 + P0) * MIXW + h * HD) * 2), (int)((1 * PROJ_T + row0 * MIXW + h * HD) * 2), (int)((2 * PROJ_T + row0 * MIXW + h * HD) * 2),
                          Y, (int)(((row0 + P0) * D + h * HD) * 2), P0, 0, 4 * qb + 4, lds, wave, lane);
    } else {
        const int tid = wave * 64 + lane;
        if (tid < 320) ((LAS float*)(lds + att::OFF_REL))[tid] = a.rel_bias[((size_t)l * 4 + h) * 320 + tid] * (1.0f / ATT_SCALE);
        const int jlo = 4 * qb - 8 < 0 ? 0 : 4 * qb - 8;
        att::attn_unit<1>(P, (int)((7 * PROJ_T + (row0 + P0) * MIXW + h * HD) * 2), (int)((8 * PROJ_T + row0 * MIXW + h * HD) * 2), (int)((9 * PROJ_T + row0 * MIXW + h * HD) * 2),
                          Y, (int)(((row0 + P0) * D + 1536 + h * HD) * 2), P0, jlo, 4 * qb + 4, lds, wave, lane);
    }
}
__device__ __forceinline__ void pool_item(const Args& a, int l, int u, LAS char* lds, int wave) {
    int lane; asm volatile("v_mbcnt_lo_u32_b32 %0, -1, 0\n\tv_mbcnt_hi_u32_b32 %0, -1, %0" : "=v"(lane));
    const int g = u & 3, T0 = (u >> 2) * 64, tid = wave * 64 + lane;
    const bf16* Pin = (const bf16*)(a.ws + WS_PROJ) + 3 * PROJ_T + g * 128;
    {
        const int cp = tid & 63, run = tid >> 6, w = 2 << g, t0 = T0 + run * 8, s0 = t0 & (SEQ - 1);
        const bf16* col = Pin + 2 * cp;
        float s_lo = 0.f, s_hi = 0.f;
        for (int j = 1; j < w; ++j) if (s0 - j >= 0) { const unsigned x = *(const unsigned*)(col + (size_t)(t0 - j) * MIXW); s_lo += bflo(x); s_hi += bfhi(x); }
#pragma unroll
        for (int i = 0; i < 8; ++i) { const unsigned x = *(const unsigned*)(col + (size_t)(t0 + i) * MIXW); s_lo += bflo(x); s_hi += bfhi(x);
            const int s = s0 + i; const int cnt = s + 1 < w ? s + 1 : w; const float inv = 1.0f / (float)cnt;
            *(LAS unsigned*)(lds + (run * 8 + i) * 272 + 4 * cp) = pk2(s_lo * inv - bflo(x), s_hi * inv - bfhi(x));
            if (s - w + 1 >= 0) { const unsigned y = *(const unsigned*)(col + (size_t)(t0 + i - w + 1) * MIXW); s_lo -= bflo(y); s_hi -= bfhi(y); } }
    }
    __syncthreads();
    {
        typedef short bf16x8 __attribute__((ext_vector_type(8)));
        const bf16* Wt = (const bf16*)(a.ws + WS_POOLW) + ((size_t)l * 4 + g) * 128 * 128;
        const int rt = (wave & 3) * 16, db = (wave >> 2) * 64, fr = lane & 15, kg = lane >> 4;
        f32x4 acc[4] = {};
#pragma unroll
        for (int ks = 0; ks < 4; ++ks) { const bf16x8 af = *(const LAS bf16x8*)(lds + (rt + fr) * 272 + (ks * 32 + kg * 8) * 2);
#pragma unroll
            for (int nt = 0; nt < 4; ++nt) { const bf16x8 bfr = *(const bf16x8*)(Wt + (size_t)(db + nt * 16 + fr) * 128 + ks * 32 + kg * 8);
                acc[nt] = __builtin_amdgcn_mfma_f32_16x16x32_bf16(bfr, af, acc[nt], 0, 0, 0); } }
        bf16* Y = (bf16*)(a.ws + WS_Y) + (size_t)(T0 + rt + fr) * D + 512 + g * 128;
#pragma unroll
        for (int nt = 0; nt < 4; ++nt) { const int d = db + nt * 16 + kg * 4; const f32x4 sc = *(const f32x4*)(a.pool_scale + l * MIXW + g * 128 + d);
            v2u w; w.x = pk2(acc[nt][0] * sc[0], acc[nt][1] * sc[1]); w.y = pk2(acc[nt][2] * sc[2], acc[nt][3] * sc[3]); *(v2u*)(Y + d) = w; }
    }
    __syncthreads();
}
__device__ __forceinline__ void conv_item(const Args& a, int l, int u, int wave) {
    int lane; asm volatile("v_mbcnt_lo_u32_b32 %0, -1, 0\n\tv_mbcnt_hi_u32_b32 %0, -1, %0" : "=v"(lane));
    const bf16* P = (const bf16*)(a.ws + WS_PROJ); const bf16* Ch = P + 4 * PROJ_T; const bf16* Cb = P + 5 * PROJ_T; const bf16* Cc = P + 6 * PROJ_T;
    const int tid = wave * 64 + lane, c0 = (tid & 63) * 8, t0 = u * 64 + (tid >> 6) * 8, s0 = t0 & (SEQ - 1);
    float wgt[3][8];
#pragma unroll
    for (int j = 0; j < 3; ++j) { const float* w = a.conv_w + ((size_t)l * 3 + j) * MIXW + c0; const f32x4 w0 = *(const f32x4*)w, w1 = *(const f32x4*)(w + 4);
#pragma unroll
        for (int k = 0; k < 4; ++k) { wgt[j][k] = w0[k]; wgt[j][4 + k] = w1[k]; } }
    float z2[8], z1[8];
#pragma unroll
    for (int k = 0; k < 8; ++k) { z2[k] = 0.f; z1[k] = 0.f; }
#pragma unroll
    for (int i = -2; i < 8; ++i) {
        float z[8];
        if (s0 + i >= 0) { const v4u hv = *(const v4u*)(Ch + (size_t)(t0 + i) * MIXW + c0), cv = *(const v4u*)(Cc + (size_t)(t0 + i) * MIXW + c0);
            z[0] = bflo(hv.x) * bflo(cv.x); z[1] = bfhi(hv.x) * bfhi(cv.x); z[2] = bflo(hv.y) * bflo(cv.y); z[3] = bfhi(hv.y) * bfhi(cv.y);
            z[4] = bflo(hv.z) * bflo(cv.z); z[5] = bfhi(hv.z) * bfhi(cv.z); z[6] = bflo(hv.w) * bflo(cv.w); z[7] = bfhi(hv.w) * bfhi(cv.w); }
        else {
#pragma unroll
            for (int k = 0; k < 8; ++k) z[k] = 0.f; }
        if (i >= 0) { const v4u bv = *(const v4u*)(Cb + (size_t)(t0 + i) * MIXW + c0); float o[8];
            const float bb[8] = {bflo(bv.x), bfhi(bv.x), bflo(bv.y), bfhi(bv.y), bflo(bv.z), bfhi(bv.z), bflo(bv.w), bfhi(bv.w)};
#pragma unroll
            for (int k = 0; k < 8; ++k) o[k] = bb[k] * (wgt[0][k] * z2[k] + wgt[1][k] * z1[k] + wgt[2][k] * z[k]);
            v4u ov; ov.x = pk2(o[0], o[1]); ov.y = pk2(o[2], o[3]); ov.z = pk2(o[4], o[5]); ov.w = pk2(o[6], o[7]);
            *(v4u*)((bf16*)(a.ws + WS_Y) + (size_t)(t0 + i) * D + 1024 + c0) = ov; }
#pragma unroll
        for (int k = 0; k < 8; ++k) { z2[k] = z1[k]; z1[k] = z[k]; }
    }
}
__device__ __forceinline__ void gate_item(const Args& a, int u, int wave) {
    int lane; asm volatile("v_mbcnt_lo_u32_b32 %0, -1, 0\n\tv_mbcnt_hi_u32_b32 %0, -1, %0" : "=v"(lane));
    const bf16* G = (const bf16*)(a.ws + WS_G); bf16* R = (bf16*)(a.ws + WS_R);
    const int tid = wave * 64 + lane;
#pragma unroll 2
    for (int i = 0; i < 8; ++i) { const int e = tid + 512 * i, row = u * 16 + (e >> 8), d0 = (e & 255) * 8;
        const bf16* gp = G + (size_t)row * (4 * D) + d0; v4u z[4];
#pragma unroll
        for (int g = 0; g < 4; ++g) z[g] = *(const v4u*)(gp + g * D);
        float E[4][8], I[4][8];
#pragma unroll
        for (int g = 0; g < 4; ++g) { const unsigned w[4] = {z[g].x, z[g].y, z[g].z, z[g].w};
#pragma unroll
            for (int k = 0; k < 4; ++k) { E[g][2 * k] = fminf(1.0f + __builtin_amdgcn_exp2f(-1.4426950408889634f * bflo(w[k])), 1e18f); E[g][2 * k + 1] = fminf(1.0f + __builtin_amdgcn_exp2f(-1.4426950408889634f * bfhi(w[k])), 1e18f); }
#pragma unroll
            for (int k = 0; k < 8; ++k) I[g][k] = __builtin_amdgcn_rcpf(E[g][k]); }
#pragma unroll
        for (int g = 0; g < 4; ++g) { float r[8];
#pragma unroll
            for (int k = 0; k < 8; ++k) r[k] = g < 3 ? E[g + 1][k] * I[g][k] : I[3][k];
            v4u o; o.x = pk2(r[0], r[1]); o.y = pk2(r[2], r[3]); o.z = pk2(r[4], r[5]); o.w = pk2(r[6], r[7]);
            *(v4u*)(R + (size_t)g * R_PLANE + (size_t)row * D + d0) = o; } }
}
__device__ __forceinline__ void mixers_fast(const Args& a, int lq, LAS char* lds, int wave, int lane, int G, int blk) {
    const int l = lq & 1;
    for (int u = blk; u < N_ATT_UNITS; u += G) attention_item(a, l, u, lds, wave);
    unsigned* head = (unsigned*)(a.ws + WS_QCTR) + 64 * lq;
    volatile LAS unsigned* slot = (volatile LAS unsigned*)(lds + att::LDS_END);
    for (;;) {
        if (wave == 0 && lane == 0) *slot = __hip_atomic_fetch_add(head, 1u, __ATOMIC_RELAXED, __HIP_MEMORY_SCOPE_AGENT);
        __syncthreads();
        const unsigned it = *slot;
        __syncthreads();
        if (it >= (unsigned)(N_POOL_UNITS + N_CONV_UNITS)) break;
        if (it < (unsigned)N_POOL_UNITS) pool_item(a, l, (int)it, lds, wave); else if (it < (unsigned)(N_POOL_UNITS + N_CONV_UNITS)) conv_item(a, l, (int)it - N_POOL_UNITS, wave); else gate_item(a, (int)it - N_POOL_UNITS - N_CONV_UNITS, wave);
    }
}
__device__ __forceinline__ void p0_cmax(const Args& a, int gw, int NGW, int lane) {
    unsigned char* ws = a.ws;
    {
        constexpr int NCC = (INW + 255) / 256;
        for (int it = gw; it < DEPTH * 32 * NCC; it += NGW) { const int l = it / (32 * NCC), r = it % (32 * NCC), kc = r / NCC, cc = r % NCC; const int c0 = cc * 256 + 4 * lane;
            if (c0 + 3 < INW) { const float* W = a.w_in + (size_t)l * D * INW + (size_t)(kc * 64) * INW + c0; const float* g = a.norm_mix + l * D + kc * 64;
                float m0 = 0.f, m1 = 0.f, m2 = 0.f, m3 = 0.f;
#pragma unroll 8
                for (int k = 0; k < 64; ++k) { const f32x4 w = *(const f32x4*)(W + (size_t)k * INW); const float gk = fabsf(g[k]);
                    m0 = fmaxf(m0, fabsf(w[0]) * gk); m1 = fmaxf(m1, fabsf(w[1]) * gk); m2 = fmaxf(m2, fabsf(w[2]) * gk); m3 = fmaxf(m3, fabsf(w[3]) * gk); }
                unsigned* cm = (unsigned*)(ws + WS_CMAX) + l * INW + c0;
                const unsigned u0 = __float_as_uint(m0), u1 = __float_as_uint(m1), u2 = __float_as_uint(m2), u3 = __float_as_uint(m3);
                __hip_atomic_fetch_max(cm + 0, u0, __ATOMIC_RELAXED, __HIP_MEMORY_SCOPE_AGENT); __hip_atomic_fetch_max(cm + 1, u1, __ATOMIC_RELAXED, __HIP_MEMORY_SCOPE_AGENT);
                __hip_atomic_fetch_max(cm + 2, u2, __ATOMIC_RELAXED, __HIP_MEMORY_SCOPE_AGENT); __hip_atomic_fetch_max(cm + 3, u3, __ATOMIC_RELAXED, __HIP_MEMORY_SCOPE_AGENT); } }
    }
}
__device__ __forceinline__ void p0_prologue(const Args& a, LAS unsigned char* lds, int gw, int NGW, int wave, int lane) {
    unsigned char* ws = a.ws;
    LAS float* scr = (LAS float*)(lds + wave * 16384);
    constexpr int I_SQ = (D / 64) * (D / 32), I_BR = (MIXW / 64) * (D / 32);
    constexpr int I_LAYER = 4 * I_BR + 2 * I_SQ;
    for (int it = gw; it < DEPTH * I_LAYER; it += NGW) {
        const int l = it / I_LAYER; int r = it - l * I_LAYER;
        if (r < 4 * I_BR) { const int g = r / I_BR, rr = r % I_BR, kb = rr / (D / 32), nb = rr % (D / 32);
            tr_item<false>(a.w_branch + ((size_t)l * 4 + g) * MIXW * D, D, nullptr, (bf16*)(ws + WS_WBR + l * SQ_BYTES), D, g * MIXW, scr, 64 * kb, 32 * nb, lane); continue; }
        r -= 4 * I_BR;
        if (r < I_SQ) { const int kb = r / (D / 32), nb = r % (D / 32);
            tr_item<false>(a.w_out + (size_t)l * D * D, D, nullptr, (bf16*)(ws + WS_WOUT + l * SQ_BYTES), D, 0, scr, 64 * kb, 32 * nb, lane); continue; }
        r -= I_SQ;
        { const int kb = r / (D / 32), nb = r % (D / 32);
            tr_item<false>(a.peer_wq + (size_t)l * D * D, D, a.norm_ffn + l * D, (bf16*)(ws + WS_WQ + l * SQ_BYTES), D, 0, scr, 64 * kb, 32 * nb, lane); }
    }
    for (int it = gw; it < DEPTH * 4 * 8; it += NGW) { const int lg = it >> 3, r = it & 7;
        tr_item<false>(a.pool_w + (size_t)lg * 128 * 128, 128, nullptr, (bf16*)(ws + WS_POOLW) + (size_t)lg * 128 * 128, 128, 0, scr, 64 * (r >> 2), 32 * (r & 3), lane); }
    {
        constexpr int NR = 2 * DEPTH * PEER_E;
        f32x4 nv[8];
        if (gw < NR) { const int t = gw / (DEPTH * PEER_E), row = gw - t * (DEPTH * PEER_E); const float* src = (t ? a.peer_v : a.peer_u) + (size_t)row * D + 4 * lane;
#pragma unroll
            for (int j = 0; j < 8; ++j) nv[j] = *(const f32x4*)(src + 256 * j); }
        for (int r = gw; r < NR; r += NGW) { const int t = r / (DEPTH * PEER_E), row = r - t * (DEPTH * PEER_E);
            f32x4 v[8]; float am = 0.f;
#pragma unroll
            for (int j = 0; j < 8; ++j) v[j] = nv[j];
            { const int r2 = r + NGW; if (r2 < NR) { const int t2 = r2 / (DEPTH * PEER_E), row2 = r2 - t2 * (DEPTH * PEER_E); const float* src = (t2 ? a.peer_v : a.peer_u) + (size_t)row2 * D + 4 * lane;
#pragma unroll
                for (int j = 0; j < 8; ++j) nv[j] = *(const f32x4*)(src + 256 * j); } }
#pragma unroll
            for (int j = 0; j < 8; ++j) am = fmaxf(am, fmaxf(fmaxf(fabsf(v[j][0]), fabsf(v[j][1])), fmaxf(fabsf(v[j][2]), fabsf(v[j][3]))));
            am = wave_max(am, lane);
            const float inv = am > 0.f ? 127.0f / am : 0.f, off = 0.f;
            unsigned char* dst = ws + (t ? WS_PV : WS_PU) + (size_t)row * D + 4 * lane;
#pragma unroll
            for (int j = 0; j < 8; ++j) { const int q0 = (int)(rintf(v[j][0] * inv) + off), q1 = (int)(rintf(v[j][1] * inv) + off), q2 = (int)(rintf(v[j][2] * inv) + off), q3 = (int)(rintf(v[j][3] * inv) + off);
                *(unsigned*)(dst + 256 * j) = (unsigned)(q0 & 255) | ((unsigned)(q1 & 255) << 8) | ((unsigned)(q2 & 255) << 16) | ((unsigned)(q3 & 255) << 24); }
            if (lane == 0) ((float*)(ws + (t ? WS_SV : WS_SU)))[row] = am * (1.0f / 127.0f); }
    }
    { bf16* pk = (bf16*)(ws + WS_PK); const size_t n8 = (size_t)DEPTH * 8 * 2 * 128 * 128 / 8;
      for (size_t i = (size_t)gw * 64 + lane; i < n8; i += (size_t)NGW * 64) { const f32x4 v0 = *(const f32x4*)(a.peer_keys + i * 8), v1 = *(const f32x4*)(a.peer_keys + i * 8 + 4);
          v4u o; o.x = pk2(v0[0], v0[1]); o.y = pk2(v0[2], v0[3]); o.z = pk2(v1[0], v1[1]); o.w = pk2(v1[2], v1[3]); *(v4u*)(pk + i * 8) = o; } }
    {
        float* wf = (float*)(ws + WS_WF); float* binr = (float*)(ws + WS_BINR);
        const int gt = gw * 64 + lane, NGT = NGW * 64;
        for (int i = gt; i < DEPTH * 4 * D; i += NGT) { const int l = i / (4 * D), h = (i / D) & 3, k = i % D; wf[i] = a.w_in[(size_t)l * D * INW + (size_t)k * INW + 1536 + h] * a.norm_mix[l * D + k]; }
        for (int i = gt; i < DEPTH * NPROJ; i += NGT) { const int l = i / NPROJ, j = i % NPROJ; binr[i] = a.b_in[l * INW + colmap_in(j)]; }
    }
    {
        float* H = (float*)(ws + WS_H); bf16* HB = (bf16*)(ws + WS_HB); unsigned long long* ssq = (unsigned long long*)(ws + WS_SSQ);
        for (int m = gw; m < M; m += NGW) { float s = 0.f, am = 0.f; f32x4 v[8];
#pragma unroll
            for (int j = 0; j < 8; ++j) { const size_t o = (size_t)m * D + j * 256 + lane * 4; v[j] = *(const f32x4*)(a.x + o); *(f32x4*)(H + o) = v[j];
                v2u w; w.x = pk2(v[j][0], v[j][1]); w.y = pk2(v[j][2], v[j][3]); *(v2u*)(HB + o) = w; s += (v[j][0] * v[j][0] + v[j][1] * v[j][1]) + (v[j][2] * v[j][2] + v[j][3] * v[j][3]);
                am = fmaxf(am, fmaxf(fmaxf(fabsf(v[j][0]), fabsf(v[j][1])), fmaxf(fabsf(v[j][2]), fabsf(v[j][3])))); }
            s = wave_sum(s, lane); am = wave_max(am, lane); if (lane == 0) { ssq[m] = (unsigned long long)((double)s * 4294967296.0); ((float*)(ws + WS_RSA))[m] = rsqrtf(s * (1.0f / D) + EPS) * am * (1.0f / 127.0f); }
            const float inv = am > 0.f ? 127.0f / am : 0.f; unsigned char* q8 = ws + WS_HB8 + (size_t)m * D + 4 * lane;
#pragma unroll
            for (int j = 0; j < 8; ++j) *(unsigned*)(q8 + 256 * j) = ((unsigned)((int)rintf(v[j][0] * inv) & 255)) | ((unsigned)((int)rintf(v[j][1] * inv) & 255) << 8) | ((unsigned)((int)rintf(v[j][2] * inv) & 255) << 16) | ((unsigned)((int)rintf(v[j][3] * inv) & 255) << 24); }
    }
}
__device__ __forceinline__ void p0_win_i8(const Args& a, LAS unsigned char* lds, int gw, int NGW, int wave, int lane) {
    unsigned char* ws = a.ws; LAS float* scr = (LAS float*)(lds + wave * 16384);
    constexpr int I_WIN = (D / 64) * (NPROJ / 32);
    for (int it = gw; it < DEPTH * I_WIN; it += NGW) { const int l = it / I_WIN, r = it % I_WIN, kb = r / (NPROJ / 32), nb = r % (NPROJ / 32);
        tr_item_i8(a.w_in + (size_t)l * D * INW, a.norm_mix + l * D, (const unsigned*)(ws + WS_CMAX) + l * INW, ws + WS_WIN + l * WIN_BYTES, scr, 64 * kb, 32 * nb, lane); }
    float* sw = (float*)(ws + WS_SW); const int gt = gw * 64 + lane, NGT = NGW * 64;
    bf16* swh = (bf16*)(ws + WS_SWH); bf16* bih = (bf16*)(ws + WS_BIH);
    for (int i = gt; i < DEPTH * NPROJ; i += NGT) { const int l = i / NPROJ, j = i % NPROJ; const float s = __builtin_bit_cast(float, ((const unsigned*)(ws + WS_CMAX))[l * INW + colmap_in(j)]) * (1.0f / 127.0f);
        sw[i] = s; swh[i] = (bf16)f2bf(s); bih[i] = (bf16)f2bf(a.b_in[l * INW + colmap_in(j)]); }
}
__device__ __forceinline__ void quant_rows(const Args& a, int l, int gw, int NGW, int lane) {
    unsigned char* ws = a.ws; const float* H = (const float*)(ws + WS_H);
    for (int m = gw; m < M; m += NGW) { float am = 0.f; f32x4 v[8];
#pragma unroll
        for (int j = 0; j < 8; ++j) { v[j] = *(const f32x4*)(H + (size_t)m * D + j * 256 + lane * 4); am = fmaxf(am, fmaxf(fmaxf(fabsf(v[j][0]), fabsf(v[j][1])), fmaxf(fabsf(v[j][2]), fabsf(v[j][3])))); }
        am = wave_max(am, lane); if (lane == 0) ((float*)(ws + WS_RSA))[m] = rsqrtf(ssa_to_f(((const unsigned long long*)(ws + WS_SSQ))[(size_t)l * M + m]) * (1.0f / D) + EPS) * am * (1.0f / 127.0f);
        const float inv = am > 0.f ? 127.0f / am : 0.f; unsigned char* q8 = ws + WS_HB8 + (size_t)m * D + 4 * lane;
#pragma unroll
        for (int j = 0; j < 8; ++j) *(unsigned*)(q8 + 256 * j) = ((unsigned)((int)rintf(v[j][0] * inv) & 255)) | ((unsigned)((int)rintf(v[j][1] * inv) & 255) << 8) | ((unsigned)((int)rintf(v[j][2] * inv) & 255) << 16) | ((unsigned)((int)rintf(v[j][3] * inv) & 255) << 24); }
}

__device__ __forceinline__ void forget_logits(const Args& a, int l, int gw, int NGW, int lane) {
    unsigned char* ws = a.ws; const bf16* HB = (const bf16*)(ws + WS_HB); const float* wf = (const float*)(ws + WS_WF) + l * 4 * D; const unsigned long long* ssq = (const unsigned long long*)(ws + WS_SSQ) + l * M;
    float* logf = (float*)(ws + WS_LOGF);
    for (int m = gw; m < M; m += NGW) {
        float d[4] = {0.f, 0.f, 0.f, 0.f};
#pragma unroll
        for (int j = 0; j < 4; ++j) { const int k0 = j * 512 + lane * 8; const v4u xv = *(const v4u*)(HB + (size_t)m * D + k0);
            const float x[8] = {bflo(xv.x), bfhi(xv.x), bflo(xv.y), bfhi(xv.y), bflo(xv.z), bfhi(xv.z), bflo(xv.w), bfhi(xv.w)};
#pragma unroll
            for (int h = 0; h < 4; ++h) { const f32x4 w0 = *(const f32x4*)(wf + h * D + k0), w1 = *(const f32x4*)(wf + h * D + k0 + 4);
                d[h] += x[0] * w0[0] + x[1] * w0[1] + x[2] * w0[2] + x[3] * w0[3] + x[4] * w1[0] + x[5] * w1[1] + x[6] * w1[2] + x[7] * w1[3]; } }
        const float rs = rsqrtf(ssa_to_f(ssq[m]) * (1.0f / D) + EPS);
#pragma unroll
        for (int h = 0; h < 4; ++h) { const float z = wave_sum(d[h], lane) * rs + a.b_in[l * INW + 1536 + h];
            const float ls = fminf(z, 0.f) - log1pf(__expf(-fabsf(z)));
            if (lane == h) logf[m * 4 + h] = ls; }
    }
}
__device__ __forceinline__ void cum_scan(const Args& a, int gw, int lane) {
    if (gw >= 16) return;
    const float* logf = (const float*)(a.ws + WS_LOGF); float* cum = (float*)(a.ws + WS_CUM);
    const int b = gw >> 2, h = gw & 3; float run = 0.f;
    for (int c = 0; c < SEQ / 64; ++c) { float v = logf[(size_t)(b * SEQ + c * 64 + lane) * 4 + h];
#pragma unroll
        for (int o = 1; o < 64; o <<= 1) { const float t = shf(v, lane >= o ? lane - o : lane); if (lane >= o) v += t; }
        v += run; cum[(size_t)gw * SEQ + c * 64 + lane] = v; run = shf(v, 63); }
}

template <int MODE>
__device__ __forceinline__ void naive_attn(const Args& a, int l, int b, int h, int s, LAS float* sc, int lane) {
    const unsigned char* ws = a.ws; const bf16* P = (const bf16*)(ws + WS_PROJ);
    const bf16* Qp = P + (MODE ? 7 : 0) * PROJ_T; const bf16* Kp = P + (MODE ? 8 : 1) * PROJ_T; const bf16* Vp = P + (MODE ? 9 : 2) * PROJ_T;
    const float* cum = (const float*)(ws + WS_CUM) + (size_t)(b * 4 + h) * SEQ;
    const float* rb = a.rel_bias + ((size_t)l * 4 + h) * 320;
    const size_t tb = (size_t)b * SEQ;
    int klo = 0, khi = s;
    if (MODE) { const int c = s >> 6; klo = (c - 8) * 64; if (klo < 0) klo = 0; khi = c * 64 + 63; }
    const bf16* qrow = Qp + (tb + s) * MIXW + h * HD;
    float mx = -3.0e38f;
    for (int kb = klo; kb <= khi; kb += 64) { const int k = kb + lane;
        if (k <= khi) { const bf16* krow = Kp + (tb + k) * MIXW + h * HD; float d = 0.f;
#pragma unroll 4
            for (int c8 = 0; c8 < 16; ++c8) { const v4u qv = *(const v4u*)(qrow + c8 * 8), kv = *(const v4u*)(krow + c8 * 8);
                d = dot2_bf16(qv.x, kv.x, d); d = dot2_bf16(qv.y, kv.y, d); d = dot2_bf16(qv.z, kv.z, d); d = dot2_bf16(qv.w, kv.w, d); }
            float bias;
            if (MODE == 0) bias = cum[s] - cum[k];
            else { int rel = s - k; rel = rel < -63 ? -63 : (rel > 256 ? 256 : rel); bias = rb[rel + 63]; }
            const float lg = d * ATT_SCALE + bias; sc[k - klo] = lg; mx = fmaxf(mx, lg); } }
    mx = wave_max(mx, lane);
    asm volatile("s_waitcnt lgkmcnt(0)" ::: "memory");
    float sum = 0.f;
    for (int kb = klo; kb <= khi; kb += 64) { const int k = kb + lane; if (k <= khi) { const float p = __expf(sc[k - klo] - mx); sc[k - klo] = p; sum += p; } }
    sum = wave_sum(sum, lane);
    asm volatile("s_waitcnt lgkmcnt(0)" ::: "memory");
    float o0 = 0.f, o1 = 0.f;
    for (int k = klo; k <= khi; ++k) { const float p = sc[k - klo]; const unsigned v = *(const unsigned*)(Vp + (tb + k) * MIXW + h * HD + 2 * lane); o0 += p * bflo(v); o1 += p * bfhi(v); }
    const float inv = 1.0f / sum;
    bf16* Y = (bf16*)(a.ws + WS_Y);
    *(unsigned*)(Y + (tb + s) * D + (MODE ? 1536 : 0) + h * HD + 2 * lane) = pk2(o0 * inv, o1 * inv);
    asm volatile("s_waitcnt lgkmcnt(0)" ::: "memory");
}
__device__ __forceinline__ void naive_pool(const Args& a, int l, int t, int g, LAS float* sc, int lane) {
    const bf16* Pin = (const bf16*)(a.ws + WS_PROJ) + 3 * PROJ_T;
    const int s = t & (SEQ - 1), w = 2 << g; const int cnt = (s + 1 < w) ? s + 1 : w;
    float s0 = 0.f, s1 = 0.f;
    for (int j = 0; j < cnt; ++j) { const unsigned v = *(const unsigned*)(Pin + (size_t)(t - j) * MIXW + g * 128 + 2 * lane); s0 += bflo(v); s1 += bfhi(v); }
    const unsigned v0 = *(const unsigned*)(Pin + (size_t)t * MIXW + g * 128 + 2 * lane);
    const float inv = 1.0f / (float)cnt;
    sc[2 * lane] = s0 * inv - bflo(v0); sc[2 * lane + 1] = s1 * inv - bfhi(v0);
    asm volatile("s_waitcnt lgkmcnt(0)" ::: "memory");
    const float* W = a.pool_w + ((size_t)l * 4 + g) * 128 * 128;
    float o0 = 0.f, o1 = 0.f;
    for (int c = 0; c < 128; ++c) { const float p = sc[c]; const f32x2 wv = *(const f32x2*)(W + c * 128 + 2 * lane); o0 += p * wv[0]; o1 += p * wv[1]; }
    const f32x2 ps = *(const f32x2*)(a.pool_scale + l * MIXW + g * 128 + 2 * lane);
    bf16* Y = (bf16*)(a.ws + WS_Y);
    *(unsigned*)(Y + (size_t)t * D + 512 + g * 128 + 2 * lane) = pk2(o0 * ps[0], o1 * ps[1]);
    asm volatile("s_waitcnt lgkmcnt(0)" ::: "memory");
}
__device__ __forceinline__ void naive_conv(const Args& a, int l, int t, int lane) {
    const bf16* P = (const bf16*)(a.ws + WS_PROJ); const bf16* Ch = P + 4 * PROJ_T; const bf16* Cb = P + 5 * PROJ_T; const bf16* Cc = P + 6 * PROJ_T;
    const int s = t & (SEQ - 1), c0 = lane * 8;
    float acc[8] = {0.f, 0.f, 0.f, 0.f, 0.f, 0.f, 0.f, 0.f};
#pragma unroll
    for (int j = 0; j < 3; ++j) { const int dt = 2 - j;
        if (s - dt >= 0) { const v4u hv = *(const v4u*)(Ch + (size_t)(t - dt) * MIXW + c0), cv = *(const v4u*)(Cc + (size_t)(t - dt) * MIXW + c0);
            const float* w = a.conv_w + ((size_t)l * 3 + j) * MIXW + c0; const f32x4 w0 = *(const f32x4*)w, w1 = *(const f32x4*)(w + 4);
            acc[0] += w0[0] * bflo(hv.x) * bflo(cv.x); acc[1] += w0[1] * bfhi(hv.x) * bfhi(cv.x); acc[2] += w0[2] * bflo(hv.y) * bflo(cv.y); acc[3] += w0[3] * bfhi(hv.y) * bfhi(cv.y);
            acc[4] += w1[0] * bflo(hv.z) * bflo(cv.z); acc[5] += w1[1] * bfhi(hv.z) * bfhi(cv.z); acc[6] += w1[2] * bflo(hv.w) * bflo(cv.w); acc[7] += w1[3] * bfhi(hv.w) * bfhi(cv.w); } }
    const v4u bv = *(const v4u*)(Cb + (size_t)t * MIXW + c0);
    v4u o; o.x = pk2(acc[0] * bflo(bv.x), acc[1] * bfhi(bv.x)); o.y = pk2(acc[2] * bflo(bv.y), acc[3] * bfhi(bv.y)); o.z = pk2(acc[4] * bflo(bv.z), acc[5] * bfhi(bv.z)); o.w = pk2(acc[6] * bflo(bv.w), acc[7] * bfhi(bv.w));
    *(v4u*)((bf16*)(a.ws + WS_Y) + (size_t)t * D + 1024 + c0) = o;
}
__device__ __forceinline__ void mixers_naive(const Args& a, int l, LAS unsigned char* lds, int gw, int NGW, int wave, int lane) {
    LAS float* sc = (LAS float*)(lds + wave * 8192);
    for (int i = gw; i < M * 4; i += NGW) { const int t = M * 4 - 1 - i; const int h = t & 3, tok = t >> 2; naive_attn<0>(a, l, tok >> 11, h, tok & (SEQ - 1), sc, lane); }
    for (int i = gw; i < M * 4; i += NGW) { const int h = i & 3, tok = i >> 2; naive_attn<1>(a, l, tok >> 11, h, tok & (SEQ - 1), sc, lane); }
    for (int i = gw; i < M * 4; i += NGW) naive_pool(a, l, i >> 2, i & 3, sc, lane);
    for (int i = gw; i < M; i += NGW) naive_conv(a, l, i, lane);
}

__device__ __forceinline__ float gelu_tanh(float x) { const float u = 1.5957691216057308f * (x + 0.044715f * x * x * x); return x / (1.0f + __expf(-u)); }
constexpr int PEER_TOK = 32;
constexpr int PL_IDX = 0, PL_GATE = PEER_TOK * 128 * 4, PL_TAB = 2 * PEER_TOK * 128 * 4;
__device__ __forceinline__ int f2key(float f) { const int b = __builtin_bit_cast(int, f); return b ^ ((b >> 31) & 0x7fffffff); }
__device__ __forceinline__ float key2f(int k) { return __builtin_bit_cast(float, k ^ ((k >> 31) & 0x7fffffff)); }
#define CE_DESC(x, y) do { const int hi_ = (x) > (y) ? (x) : (y), lo_ = (x) > (y) ? (y) : (x); (x) = hi_; (y) = lo_; } while (0)
__device__ __forceinline__ void sort16_desc(int* v) {
#pragma unroll
    for (int k = 2; k <= 16; k <<= 1)
#pragma unroll
        for (int j = k >> 1; j > 0; j >>= 1)
#pragma unroll
            for (int i = 0; i < 16; ++i) { const int l = i ^ j; if (l > i) { if ((i & k) == 0) CE_DESC(v[i], v[l]); else CE_DESC(v[l], v[i]); } }
}
__device__ __forceinline__ void merge_top16(int* a, const int* b) {
#pragma unroll
    for (int i = 0; i < 16; ++i) a[i] = a[i] > b[15 - i] ? a[i] : b[15 - i];
#pragma unroll
    for (int j = 8; j > 0; j >>= 1)
#pragma unroll
        for (int i = 0; i < 16; ++i) { const int l = i ^ j; if (l > i) CE_DESC(a[i], a[l]); }
}
__device__ __forceinline__ void top16_of_64(int* v) {
    sort16_desc(v); sort16_desc(v + 16); sort16_desc(v + 32); sort16_desc(v + 48);
    merge_top16(v, v + 16); merge_top16(v + 32, v + 48); merge_top16(v, v + 32);
}
constexpr int cand_slot(int i, int j) {
    int n = 0;
    for (int a = 0; a < 16; ++a) for (int b = 0; b < 16; ++b) { if ((a + 1) * (b + 1) <= 16) { if (a == i && b == j) return n; ++n; } }
    return -1;
}
__device__ __forceinline__ void peer_retrieve(const Args& a, int l, int t0, int h, LAS char* lds, int wave) {
    typedef short bf16x8 __attribute__((ext_vector_type(8)));
    typedef float f32x16 __attribute__((ext_vector_type(16)));
    int lane; asm volatile("v_mbcnt_lo_u32_b32 %0, -1, 0\n\tv_mbcnt_hi_u32_b32 %0, -1, %0" : "=v"(lane));
    const int r32 = lane & 31, hi = lane >> 5, hi4 = hi * 4;
    const bf16* Q = (const bf16*)(a.ws + WS_Q) + (size_t)(t0 + r32) * D + h * 256 + hi * 8;
    const bf16* PK = (const bf16*)(a.ws + WS_PK) + ((size_t)(l * 8 + h) * 2) * 128 * 128 + (size_t)r32 * 128 + hi * 8;
    int top[2][16];
#pragma unroll
    for (int p = 0; p < 2; ++p) {
        f32x16 acc[4] = {};
        bf16x8 qf[8];
#pragma unroll
        for (int cs = 0; cs < 8; ++cs) qf[cs] = *(const bf16x8*)(Q + p * 128 + cs * 16);
#pragma unroll
        for (int kb = 0; kb < 4; ++kb) { bf16x8 kf[8];
#pragma unroll
            for (int cs = 0; cs < 8; ++cs) kf[cs] = *(const bf16x8*)(PK + (size_t)p * 128 * 128 + (size_t)kb * 32 * 128 + cs * 16);
#pragma unroll
            for (int cs = 0; cs < 8; ++cs) acc[kb] = __builtin_amdgcn_mfma_f32_32x32x16_bf16(kf[cs], qf[cs], acc[kb], 0, 0, 0); }
        int v[64];
#pragma unroll
        for (int kb = 0; kb < 4; ++kb)
#pragma unroll
            for (int r = 0; r < 16; ++r) { const int c = kb * 32 + (r & 3) + 8 * (r >> 2);
                v[kb * 16 + r] = (f2key(acc[kb][r]) & ~127) | (c | hi4); }
        top16_of_64(v);
        int mine[16], other[16];
#pragma unroll
        for (int i = 0; i < 16; ++i) { auto rr = __builtin_amdgcn_permlane32_swap((unsigned)v[i], (unsigned)v[i], false, false); mine[i] = (int)rr[0]; other[i] = (int)rr[1]; }
        merge_top16(mine, other);
#pragma unroll
        for (int i = 0; i < 16; ++i) top[p][i] = mine[i];
    }
    LAS int* tab = (LAS int*)(lds + PL_TAB) + (wave * 64 + lane) * 32;
    float sA[16], sB[16];
#pragma unroll
    for (int i = 0; i < 16; ++i) { sA[i] = key2f(top[0][i] & ~127); sB[i] = key2f(top[1][i] & ~127); tab[i] = top[0][i] & 127; tab[16 + i] = top[1][i] & 127; }
    int c[64];
#pragma unroll
    for (int n = 0; n < 64; ++n) c[n] = (int)0x80000000;
#pragma unroll
    for (int i = 0; i < 16; ++i)
#pragma unroll
        for (int j = 0; j < 16; ++j) if ((i + 1) * (j + 1) <= 16) c[cand_slot(i, j)] = (f2key(sA[i] + sB[j]) & ~255) | (16 * i + j);
    top16_of_64(c);
    float ex[16]; float sum = 0.f; const float mx = key2f(c[0] & ~255);
#pragma unroll
    for (int w = 0; w < 16; ++w) { ex[w] = __expf(key2f(c[w] & ~255) - mx); sum += ex[w]; }
    const float inv = 1.0f / sum;
    asm volatile("s_waitcnt lgkmcnt(0)" ::: "memory");
    LAS int* oi = (LAS int*)(lds + PL_IDX) + r32 * 128 + h * 16; LAS float* og = (LAS float*)(lds + PL_GATE) + r32 * 128 + h * 16;
#pragma unroll
    for (int w = 0; w < 16; ++w) { const int id = c[w] & 255; const int e = tab[id >> 4] * 128 + tab[16 + (id & 15)];
        if ((w >> 3) == hi) { oi[w] = e; og[w] = ex[w] * inv; } }
}
constexpr size_t WS_IDX = 816 * MiB;
constexpr size_t WS_GATE = 820 * MiB;
constexpr size_t WS_XQ = 824 * MiB;
constexpr size_t WS_SX = 856 * MiB;
constexpr size_t WS_PART = 857 * MiB;
constexpr size_t WS_SUT = 890 * MiB;
constexpr size_t WS_END2 = 1024 * MiB;
#ifndef PEER_NB
#define PEER_NB 8
#endif
constexpr int NSLICE = 8, SLW = D / NSLICE;
#define DPP_ROR(x, n) __builtin_bit_cast(float, __builtin_amdgcn_update_dpp(0, __builtin_bit_cast(int, (x)), 0x120 + (n), 0xf, 0xf, false))
__device__ __forceinline__ void peer_publish(const Args& a, int l, int t, LAS char* lds, int tl) {
    int lane; LANE_ID(lane);
    unsigned char* ws = a.ws;
    { int* gi = (int*)(ws + WS_IDX) + (size_t)t * 128; float* gg = (float*)(ws + WS_GATE) + (size_t)t * 128; float* gs = (float*)(ws + WS_SUT) + (size_t)t * 128;
      const float* SU = (const float*)(ws + WS_SU) + l * PEER_E; const float* SV = (const float*)(ws + WS_SV) + l * PEER_E;
      const int i0 = ((const LAS int*)(lds + PL_IDX))[tl * 128 + lane], i1 = ((const LAS int*)(lds + PL_IDX))[tl * 128 + 64 + lane];
      gi[lane] = i0; gi[64 + lane] = i1; gs[lane] = SU[i0]; gs[64 + lane] = SU[i1];
      gg[lane] = ((const LAS float*)(lds + PL_GATE))[tl * 128 + lane] * SV[i0]; gg[64 + lane] = ((const LAS float*)(lds + PL_GATE))[tl * 128 + 64 + lane] * SV[i1]; }
    const unsigned long long* ssa1 = (const unsigned long long*)(ws + WS_SSA) + l * M;
    const float rs = rsqrtf(ssa_to_f(ssa1[t]) * (1.0f / D) + EPS);
    const bf16* HB = (const bf16*)(ws + WS_HB) + (size_t)t * D; const float* gn = a.norm_ffn + l * D;
    float xf[32]; float am = 0.f;
#pragma unroll
    for (int i = 0; i < 2; ++i) { const int k0 = 16 * lane + 1024 * i; const v4u h0 = *(const v4u*)(HB + k0), h1 = *(const v4u*)(HB + k0 + 8);
        const unsigned hw[8] = {h0.x, h0.y, h0.z, h0.w, h1.x, h1.y, h1.z, h1.w};
#pragma unroll
        for (int q = 0; q < 4; ++q) { const f32x4 g = *(const f32x4*)(gn + k0 + 4 * q);
            xf[16 * i + 4 * q + 0] = bflo(hw[2 * q]) * rs * g[0]; xf[16 * i + 4 * q + 1] = bfhi(hw[2 * q]) * rs * g[1];
            xf[16 * i + 4 * q + 2] = bflo(hw[2 * q + 1]) * rs * g[2]; xf[16 * i + 4 * q + 3] = bfhi(hw[2 * q + 1]) * rs * g[3]; } }
#pragma unroll
    for (int k = 0; k < 32; ++k) am = fmaxf(am, fabsf(xf[k]));
    am = wave_max(am, lane);
    const float inv = am > 0.f ? 127.0f / am : 0.f;
    if (lane == 0) ((float*)(ws + WS_SX))[t] = am * (1.0f / 127.0f);
    unsigned char* xq = ws + WS_XQ + (size_t)t * 4096;
#pragma unroll
    for (int i = 0; i < 2; ++i) { v4u ph, pl;
#pragma unroll
        for (int d = 0; d < 4; ++d) { unsigned wh = 0, wl = 0;
#pragma unroll
            for (int b = 0; b < 4; ++b) { const float sv = xf[16 * i + 4 * d + b] * inv, hq = rintf(sv), lq = rintf((sv - hq) * 128.0f);
                wh |= ((unsigned)((int)hq & 255)) << (8 * b); wl |= ((unsigned)((int)lq & 255)) << (8 * b); }
            ph[d] = wh; pl[d] = wl; }
        *(v4u*)(xq + 16 * lane + 1024 * i) = ph; *(v4u*)(xq + 2048 + 16 * lane + 1024 * i) = pl; }
}
struct PeerItems { int pos, npop, rank, nloc, wave;
    __device__ __forceinline__ int nblk() const { return (M / PEER_TOK - rank + nloc - 1) / nloc; }
    __device__ __forceinline__ int count() const { return ((NSLICE - pos + npop - 1) / npop) * nblk() * (PEER_TOK / NWAVES); }
    __device__ __forceinline__ void get(int n, int& s, int& t) const { constexpr int per = PEER_TOK / NWAVES; const int k = n % per, r = n / per, nb = nblk();
        s = pos + (r / nb) * npop; t = (rank + (r % nb) * nloc) * PEER_TOK + wave * per + k; } };
__device__ __forceinline__ void peer_u_wave(const Args& a, int l, const PeerItems& it) {
    int lane; LANE_ID(lane);
    unsigned char* ws = a.ws; const int sub = lane & 15, grp = lane >> 4;
    const __amdgpu_buffer_rsrc_t rU = __builtin_amdgcn_make_buffer_rsrc((void*)(ws + WS_PU + (size_t)l * PE_BYTES), 0, 0x7fffffff, 0x00020000);
    const __amdgpu_buffer_rsrc_t rW = __builtin_amdgcn_make_buffer_rsrc((void*)ws, 0, 0x7fffffff, 0x00020000);
    const int N = it.count(); if (N <= 0) return;
    int s, t; it.get(0, s, t);
    int idc[2], idn[2] = {0, 0}; v4u xhc, xlc, xhn = {}, xln = {}; v4u wA[PEER_NB], wB[PEER_NB];
#define PU_META(I0, I1, XH, XL, S_, T_) do { I0 = (int)__builtin_amdgcn_raw_buffer_load_b32(rW, 4 * lane, (int)WS_IDX + (T_) * 512, 0); I1 = (int)__builtin_amdgcn_raw_buffer_load_b32(rW, 4 * lane, (int)WS_IDX + (T_) * 512 + 256, 0); \
        XH = __builtin_amdgcn_raw_buffer_load_b128(rW, 16 * sub, (int)WS_XQ + (T_) * 4096 + SLW * (S_), 0); XL = __builtin_amdgcn_raw_buffer_load_b128(rW, 16 * sub, (int)WS_XQ + (T_) * 4096 + 2048 + SLW * (S_), 0); } while (0)
#define PU_ISSUE(W, ID, Q, S_) do { _Pragma("unroll") for (int j = 0; j < PEER_NB; ++j) { const int e_ = shi(ID[(PEER_NB * (Q) + j) >> 4], 4 * ((PEER_NB * (Q) + j) & 15) + grp); W[j] = __builtin_amdgcn_raw_buffer_load_b128(rU, e_ * D + SLW * (S_) + 16 * sub, 0, 0); } } while (0)
#define PU_COMP(W, Q) do { _Pragma("unroll") for (int j = 0; j < PEER_NB; ++j) { int dh = 0, dl = 0; \
            dh = __builtin_amdgcn_sdot4((int)W[j].x, (int)xhc.x, dh, false); dl = __builtin_amdgcn_sdot4((int)W[j].x, (int)xlc.x, dl, false); \
            dh = __builtin_amdgcn_sdot4((int)W[j].y, (int)xhc.y, dh, false); dl = __builtin_amdgcn_sdot4((int)W[j].y, (int)xlc.y, dl, false); \
            dh = __builtin_amdgcn_sdot4((int)W[j].z, (int)xhc.z, dh, false); dl = __builtin_amdgcn_sdot4((int)W[j].z, (int)xlc.z, dl, false); \
            dh = __builtin_amdgcn_sdot4((int)W[j].w, (int)xhc.w, dh, false); dl = __builtin_amdgcn_sdot4((int)W[j].w, (int)xlc.w, dl, false); \
            float p_ = (float)dh + (float)dl * (1.0f / 128.0f); \
            p_ += DPP_ROR(p_, 8); p_ += DPP_ROR(p_, 4); p_ += DPP_ROR(p_, 2); p_ += DPP_ROR(p_, 1); \
            if (sub == ((PEER_NB * (Q) + j) & 15)) { if ((PEER_NB * (Q) + j) >> 4) acc1 = p_; else acc0 = p_; } __builtin_amdgcn_sched_barrier(0); } } while (0)
    PU_META(idc[0], idc[1], xhc, xlc, s, t); PU_ISSUE(wA, idc, 0, s); PU_ISSUE(wB, idc, 1, s);
    for (int n = 0; n < N; ++n) {
        int sn = s, tn = t; const bool more = n + 1 < N;
        if (more) it.get(n + 1, sn, tn);
        PU_META(idn[0], idn[1], xhn, xln, sn, tn);
        float acc0 = 0.f, acc1 = 0.f;
        __builtin_amdgcn_sched_barrier(0);
#if PEER_NB == 8
        PU_COMP(wA, 0); PU_ISSUE(wA, idc, 2, s); __builtin_amdgcn_sched_barrier(0);
        PU_COMP(wB, 1); PU_ISSUE(wB, idc, 3, s); __builtin_amdgcn_sched_barrier(0);
        PU_COMP(wA, 2); PU_ISSUE(wA, idn, 0, sn); __builtin_amdgcn_sched_barrier(0);
        PU_COMP(wB, 3); PU_ISSUE(wB, idn, 1, sn); __builtin_amdgcn_sched_barrier(0);
#else
        PU_COMP(wA, 0); PU_ISSUE(wA, idn, 0, sn); __builtin_amdgcn_sched_barrier(0);
        PU_COMP(wB, 1); PU_ISSUE(wB, idn, 1, sn); __builtin_amdgcn_sched_barrier(0);
#endif
        __builtin_amdgcn_raw_buffer_store_b32(__builtin_bit_cast(unsigned, acc0), rW, (4 * sub + grp) * 4, (int)WS_PART + (s * M + t) * 512, 0);
        __builtin_amdgcn_raw_buffer_store_b32(__builtin_bit_cast(unsigned, acc1), rW, (4 * sub + grp) * 4 + 256, (int)WS_PART + (s * M + t) * 512, 0);
        s = sn; t = tn; idc[0] = idn[0]; idc[1] = idn[1]; xhc = xhn; xlc = xln;
    }
#undef PU_META
#undef PU_ISSUE
#undef PU_COMP
}
__device__ __forceinline__ void peer_v_wave(const Args& a, int l, const PeerItems& it) {
    int lane; LANE_ID(lane);
    unsigned char* ws = a.ws; const int sub = lane & 15, grp = lane >> 4;
    const __amdgpu_buffer_rsrc_t rV = __builtin_amdgcn_make_buffer_rsrc((void*)(ws + WS_PV + (size_t)l * PE_BYTES), 0, 0x7fffffff, 0x00020000);
    const __amdgpu_buffer_rsrc_t rW = __builtin_amdgcn_make_buffer_rsrc((void*)ws, 0, 0x7fffffff, 0x00020000);
    const int N = it.count(); if (N <= 0) return;
    int s, t; it.get(0, s, t);
    struct Meta { int id[2]; float gate[2], su[2], pa[2], sx; f32x4 h1; };
    Meta mc, mn; v4u wA[PEER_NB], wB[PEER_NB];
    const int l4 = 4 * lane;
#define WLD(off_s) __builtin_amdgcn_raw_buffer_load_b32(rW, l4, (int)(off_s), 0)
#define PV_META(MM, S_, T_) do { const int r_ = (T_) * 512; MM.id[0] = (int)WLD(WS_IDX + r_); MM.id[1] = (int)WLD(WS_IDX + r_ + 256); \
        MM.gate[0] = __builtin_bit_cast(float, WLD(WS_GATE + r_)); MM.gate[1] = __builtin_bit_cast(float, WLD(WS_GATE + r_ + 256)); MM.su[0] = __builtin_bit_cast(float, WLD(WS_SUT + r_)); MM.su[1] = __builtin_bit_cast(float, WLD(WS_SUT + r_ + 256)); \
        float a0_ = 0.f, a1_ = 0.f; _Pragma("unroll") for (int q = 0; q < NSLICE; ++q) { const int po_ = (int)WS_PART + (q * M + (T_)) * 512; a0_ += __builtin_bit_cast(float, WLD(po_)); a1_ += __builtin_bit_cast(float, WLD(po_ + 256)); } \
        MM.pa[0] = a0_; MM.pa[1] = a1_; MM.sx = ((const float*)(ws + WS_SX))[T_]; \
        MM.h1 = __builtin_bit_cast(f32x4, __builtin_amdgcn_raw_buffer_load_b128(rW, (16 * sub + 4 * grp) * 4, (int)WS_H + ((T_) * D + SLW * (S_)) * 4, 0)); } while (0)
#define PV_ISSUE(W, ID, Q, S_) do { _Pragma("unroll") for (int j = 0; j < PEER_NB; ++j) { const int e_ = shi(ID[(PEER_NB * (Q) + j) >> 4], 4 * ((PEER_NB * (Q) + j) & 15) + grp); W[j] = __builtin_amdgcn_raw_buffer_load_b128(rV, e_ * D + SLW * (S_) + 16 * sub, 0, 0); } } while (0)
#define PV_COMP(W, Q) do { _Pragma("unroll") for (int j4 = 0; j4 < PEER_NB; j4 += 4) { \
            unsigned cp_ = 0; _Pragma("unroll") for (int jj = 0; jj < 4; ++jj) { const int i_ = PEER_NB * (Q) + j4 + jj; cp_ |= ((unsigned)shi(c8[i_ >> 4], 4 * (i_ & 15) + grp) & 255u) << (8 * jj); } \
            _Pragma("unroll") for (int d = 0; d < 4; ++d) { const unsigned a_ = W[j4][d], b_ = W[j4 + 1][d], c_ = W[j4 + 2][d], d_ = W[j4 + 3][d]; \
                const unsigned x0_ = __builtin_amdgcn_perm(b_, a_, 0x05010400u), x1_ = __builtin_amdgcn_perm(b_, a_, 0x07030602u), y0_ = __builtin_amdgcn_perm(d_, c_, 0x05010400u), y1_ = __builtin_amdgcn_perm(d_, c_, 0x07030602u); \
                yi[4 * d + 0] = __builtin_amdgcn_sdot4((int)__builtin_amdgcn_perm(y0_, x0_, 0x05040100u), (int)cp_, yi[4 * d + 0], false); \
                yi[4 * d + 1] = __builtin_amdgcn_sdot4((int)__builtin_amdgcn_perm(y0_, x0_, 0x07060302u), (int)cp_, yi[4 * d + 1], false); \
                yi[4 * d + 2] = __builtin_amdgcn_sdot4((int)__builtin_amdgcn_perm(y1_, x1_, 0x05040100u), (int)cp_, yi[4 * d + 2], false); \
                yi[4 * d + 3] = __builtin_amdgcn_sdot4((int)__builtin_amdgcn_perm(y1_, x1_, 0x07060302u), (int)cp_, yi[4 * d + 3], false); } \
            __builtin_amdgcn_sched_barrier(0); } } while (0)
    PV_META(mc, s, t); PV_ISSUE(wA, mc.id, 0, s); PV_ISSUE(wB, mc.id, 1, s);
    for (int n = 0; n < N; ++n) {
        int sn = s, tn = t; const bool more = n + 1 < N;
        if (more) it.get(n + 1, sn, tn);
        PV_META(mn, sn, tn);
        float coef[2];
#pragma unroll
        for (int hf = 0; hf < 2; ++hf) coef[hf] = gelu_tanh(mc.pa[hf] * mc.su[hf] * mc.sx) * mc.gate[hf];
        const float cmax = wave_max(fmaxf(fabsf(coef[0]), fabsf(coef[1])), lane); const float cinv = cmax > 0.f ? 127.0f / cmax : 0.f, cs = cmax * (1.0f / 127.0f);
        const int c8[2] = {(int)rintf(coef[0] * cinv), (int)rintf(coef[1] * cinv)};
        int yi[16];
#pragma unroll
        for (int k = 0; k < 16; ++k) yi[k] = 0;
        __builtin_amdgcn_sched_barrier(0);
#if PEER_NB == 8
        PV_COMP(wA, 0); PV_ISSUE(wA, mc.id, 2, s); __builtin_amdgcn_sched_barrier(0);
        PV_COMP(wB, 1); PV_ISSUE(wB, mc.id, 3, s); __builtin_amdgcn_sched_barrier(0);
        PV_COMP(wA, 2); PV_ISSUE(wA, mn.id, 0, sn); __builtin_amdgcn_sched_barrier(0);
        PV_COMP(wB, 3); PV_ISSUE(wB, mn.id, 1, sn); __builtin_amdgcn_sched_barrier(0);
#else
        PV_COMP(wA, 0); PV_ISSUE(wA, mn.id, 0, sn); __builtin_amdgcn_sched_barrier(0);
        PV_COMP(wB, 1); PV_ISSUE(wB, mn.id, 1, sn); __builtin_amdgcn_sched_barrier(0);
#endif
#pragma unroll
        for (int k = 0; k < 16; ++k) { yi[k] += shi(yi[k], lane ^ 16); yi[k] += shi(yi[k], lane ^ 32); }
        int yq[4];
#pragma unroll
        for (int k = 0; k < 4; ++k) yq[k] = grp == 0 ? yi[k] : grp == 1 ? yi[4 + k] : grp == 2 ? yi[8 + k] : yi[12 + k];
        const f32x4 h2 = {mc.h1[0] + cs * (float)yq[0], mc.h1[1] + cs * (float)yq[1], mc.h1[2] + cs * (float)yq[2], mc.h1[3] + cs * (float)yq[3]};
        __builtin_amdgcn_raw_buffer_store_b128(__builtin_bit_cast(v4u, h2), rW, (16 * sub + 4 * grp) * 4, (int)WS_H + (t * D + SLW * s) * 4, 0);
        v2u hb; hb.x = pk2(h2[0], h2[1]); hb.y = pk2(h2[2], h2[3]);
        __builtin_amdgcn_raw_buffer_store_b64(hb, rW, (16 * sub + 4 * grp) * 2, (int)WS_HB + (t * D + SLW * s) * 2, 0);
        const float sq = wave_sum((h2[0] * h2[0] + h2[1] * h2[1]) + (h2[2] * h2[2] + h2[3] * h2[3]), lane);
        if (lane == 0) atomicAdd((unsigned long long*)(ws + WS_SSQ) + (size_t)(l + 1) * M + t, (unsigned long long)((double)sq * 4294967296.0));
        s = sn; t = tn; mc = mn;
    }
#undef PV_META
#undef WLD
#undef PV_ISSUE
#undef PV_COMP
}
__device__ __forceinline__ void final_norm_row(const Args& a, int t) {
    int lane; LANE_ID(lane);
    const float* H = (const float*)(a.ws + WS_H) + (size_t)t * D; float* O = a.out + (size_t)t * D;
    const float rf = rsqrtf(ssa_to_f(((const unsigned long long*)(a.ws + WS_SSQ))[(size_t)DEPTH * M + t]) * (1.0f / D) + EPS);
#pragma unroll
    for (int j = 0; j < 8; ++j) { const int k0 = 4 * lane + 256 * j; const f32x4 h = *(const f32x4*)(H + k0), g = *(const f32x4*)(a.norm_final + k0);
        *(f32x4*)(O + k0) = (f32x4){h[0] * rf * g[0], h[1] * rf * g[1], h[2] * rf * g[2], h[3] * rf * g[3]}; }
}

__global__ void __launch_bounds__(NT, 2) mk_fwd(ArgsK a_in) {
    extern __shared__ __attribute__((aligned(16))) unsigned char lds_raw[];
    LAS unsigned char* lds = (LAS unsigned char*)lds_raw;
    cg::grid_group grid = cg::this_grid();
    grid.sync();
    const int wave0 = __builtin_amdgcn_readfirstlane(threadIdx.x >> 6);
    const int G = gridDim.x;
    const CAS ArgsK* ka = (const CAS ArgsK*)__builtin_amdgcn_kernarg_segment_ptr();
    size_t zoff = 0;
#define PHASE_BEGIN() int lane; LANE_ID(lane); int blk = blockIdx.x, Gp = G, wv = wave0; asm volatile("" : "+s"(zoff), "+s"(ka), "+s"(blk), "+s"(Gp), "+s"(wv)); const int wave = wv, gw = blk * NWAVES + wv, NGW = Gp * NWAVES; (void)gw; (void)NGW; const Args a = load_args(ka, zoff); unsigned char* const ws = a.ws; (void)ws
    volatile LAS unsigned* bst = (volatile LAS unsigned*)(lds + RING_BYTES + 1024);
    if (PROBE == 3) { PHASE_BEGIN(); p0_prologue(a, lds, gw, NGW, wave, lane); }
#define GRID_BAR() do { asm volatile("" : "+s"(zoff)); unsigned char* wsb_ = (unsigned char*)ka->ws + zoff; int wvb_ = wave0; asm volatile("" : "+s"(wvb_)); xcd_barrier((unsigned*)(wsb_ + WS_BAR), xb_xcc_id(), (unsigned)G, bst, wvb_); if (PROBE == 9) xcd_barrier((unsigned*)(wsb_ + WS_BAR), xb_xcc_id(), (unsigned)G, bst, wvb_); } while (0)
    volatile LAS unsigned* xinfo = bst + 4;
    { PHASE_BEGIN(); if (wave == 0 && lane == 0) { bst[0] = 0u; bst[1] = 0u; xinfo[2] = xb_add((unsigned*)(ws + WS_BAR) + XB_XCNT(xb_xcc_id()), 1u); }
      p0_cmax(a, gw, NGW, lane); }
    GRID_BAR();
    { PHASE_BEGIN(); p0_win_i8(a, lds, gw, NGW, wave, lane); p0_prologue(a, lds, gw, NGW, wave, lane); }
    GRID_BAR();
    {
        PHASE_BEGIN();
        if (wave == 0 && lane == 0) { unsigned* bar = (unsigned*)(ws + WS_BAR); const unsigned x = xb_xcc_id(); unsigned pos = 0, npop = 0, mine = 1;
            for (unsigned j = 0; j < 16; ++j) { const unsigned c = xb_ld(&bar[XB_XCNT(j)]); if (c) { ++npop; if (j < x) ++pos; } if (j == x) mine = c ? c : 1u; }
            xinfo[0] = pos; xinfo[1] = npop ? npop : 1u; xinfo[3] = mine; }
        __syncthreads();
    }
    int depth_rt = DEPTH; asm volatile("" : "+s"(depth_rt));
    for (int lc = 0; lc < depth_rt; ++lc) {
        int l = lc; asm volatile("" : "+s"(l));
        if (l > 0) { { PHASE_BEGIN(); quant_rows(a, l, gw, NGW, lane); } GRID_BAR(); }
        for (int rep = 0; rep < (PROBE == 4 ? 2 : 1); ++rep)
        {
            PHASE_BEGIN();
            pg8::Gemm g{(const bf16*)(ws + WS_HB8), (const bf16*)(ws + WS_WIN + l * WIN_BYTES), M, NPROJ, D / 2}; pg8::StaticOrder S; S.init(M, NPROJ, Gp, blk);
            EpiProj E{ws, (const bf16*)(ws + WS_BIH) + l * NPROJ, (const float*)(ws + WS_RSA), (const bf16*)(ws + WS_SWH) + l * NPROJ};
            if (PROBE == 15) { pg8::gemm_phase<EpiProj, pg8::StaticOrder, true, true>(lds, g, S, E, wave); EpiSt<0> E4{ws}; pg8::gemm_phase<EpiSt<0>, pg8::StaticOrder, true, true>(lds, g, S, E4, wave); }
            else if (PROBE == 16) { pg8::gemm_phase<EpiProj, pg8::StaticOrder, true, true>(lds, g, S, E, wave); EpiSt<1> E4{ws}; pg8::gemm_phase<EpiSt<1>, pg8::StaticOrder, true, true>(lds, g, S, E4, wave); }
            else if (PROBE == 14) { pg8::gemm_phase<EpiProj, pg8::StaticOrder, true, true>(lds, g, S, E, wave); EpiSum E4{(float*)(ws + WS_R)}; pg8::gemm_phase<EpiSum, pg8::StaticOrder, true, true>(lds, g, S, E4, wave); }
            else pg8::gemm_phase<EpiProj, pg8::StaticOrder, true, true>(lds, g, S, E, wave);
            for (int r2 = 0; r2 < (PROBE == 8 ? 2 : 1); ++r2) forget_logits(a, l, gw, NGW, lane);
        }
        GRID_BAR();
        if (PROBE == 5) { PHASE_BEGIN(); mixers_fast(a, l + 2, (LAS char*)lds, wave, lane, Gp, blk); }
        { PHASE_BEGIN(); mixers_fast(a, l, (LAS char*)lds, wave, lane, Gp, blk); }
        GRID_BAR();
        for (int rep = 0; rep < (PROBE == 6 ? 2 : 1); ++rep)
        {
            PHASE_BEGIN();
            pg8::Gemm g{(const bf16*)(ws + WS_Y), (const bf16*)(ws + WS_WBR + l * SQ_BYTES), M, D, D}; pg8::StaticOrder S; S.init(M, D, Gp, blk);
            EpiMerge E{(const bf16*)(ws + WS_G), (bf16*)(ws + WS_MRG)};
            pg8::gemm_phase<EpiMerge, pg8::StaticOrder, false>(lds, g, S, E, wave);
        }
        GRID_BAR();
        {
            PHASE_BEGIN();
            pg8::Gemm g{(const bf16*)(ws + WS_MRG), (const bf16*)(ws + WS_WOUT + l * SQ_BYTES), M, D, D}; pg8::StaticOrder S; S.init(M, D, Gp, blk);
            EpiRes E{(float*)(ws + WS_H), (bf16*)(ws + WS_HB), (unsigned long long*)(ws + WS_SSA) + l * M};
            pg8::gemm_phase<EpiRes, pg8::StaticOrder, false>(lds, g, S, E, wave);
        }
        GRID_BAR();
        for (int rep = 0; rep < (PROBE == 7 ? 2 : 1); ++rep)
        {
            PHASE_BEGIN();
            pg8::Gemm g{(const bf16*)(ws + WS_HB), (const bf16*)(ws + WS_WQ + l * SQ_BYTES), M, D, D}; pg8::StaticOrder S; S.init(M, D, Gp, blk);
            EpiQ E{(bf16*)(ws + WS_Q), (const unsigned long long*)(ws + WS_SSA) + l * M};
            pg8::gemm_phase<EpiQ, pg8::StaticOrder, false>(lds, g, S, E, wave);
        }
        GRID_BAR();
        for (int rep = 0; rep < (PROBE == 2 ? 2 : 1); ++rep)
        {
            PHASE_BEGIN(); (void)lane;
            for (int t0 = blk * PEER_TOK; t0 < M; t0 += Gp * PEER_TOK) {
                peer_retrieve(a, l, t0, wave, (LAS char*)lds, wave);
                __syncthreads();
                for (int k = 0; k < PEER_TOK / NWAVES; ++k) { const int tl = wave * (PEER_TOK / NWAVES) + k; peer_publish(a, l, t0 + tl, (LAS char*)lds, tl); }
                __syncthreads();
            }
        }
        GRID_BAR();
        for (int rep = 0; rep < (PROBE == 1 ? 2 : 1); ++rep)
        {
            PHASE_BEGIN(); (void)lane;
            const int pos = __builtin_amdgcn_readfirstlane((int)xinfo[0]), npop = __builtin_amdgcn_readfirstlane((int)xinfo[1]), rank = __builtin_amdgcn_readfirstlane((int)xinfo[2]), nloc = __builtin_amdgcn_readfirstlane((int)xinfo[3]);
            const PeerItems it{pos, npop, rank, nloc, wave}; peer_u_wave(a, l, it);
        }
        GRID_BAR();
        {
            PHASE_BEGIN(); (void)lane;
            const int pos = __builtin_amdgcn_readfirstlane((int)xinfo[0]), npop = __builtin_amdgcn_readfirstlane((int)xinfo[1]), rank = __builtin_amdgcn_readfirstlane((int)xinfo[2]), nloc = __builtin_amdgcn_readfirstlane((int)xinfo[3]);
            const PeerItems it{pos, npop, rank, nloc, wave}; peer_v_wave(a, l, it);
        }
        GRID_BAR();
    }
    {
        PHASE_BEGIN(); (void)lane;
        for (int t = gw; t < M; t += NGW) final_norm_row(a, t);
    }
}

extern "C" void kernel_launch(void* const* d_in, const int* in_sizes, int n_in, void* d_out, int out_size, void* d_ws, size_t ws_size, hipStream_t stream) {
    static int grid = 0;
    if (grid == 0) {
        int dev = 0, cus = 0, per_cu = 0;
        if (n_in != 16 || out_size != M * D || ws_size < WS_END2) { fprintf(stderr, "kernel_launch: unexpected shapes (n_in %d out %d ws %zu)\n", n_in, out_size, ws_size); grid = -1; return; }
        (void)hipGetDevice(&dev);
        (void)hipDeviceGetAttribute(&cus, hipDeviceAttributeMultiprocessorCount, dev);
        (void)hipFuncSetAttribute((const void*)mk_fwd, hipFuncAttributeMaxDynamicSharedMemorySize, LDS_BYTES);
        (void)hipOccupancyMaxActiveBlocksPerMultiprocessor(&per_cu, (const void*)mk_fwd, NT, LDS_BYTES);
        if (per_cu < 1) { fprintf(stderr, "kernel_launch: occupancy query says %d blocks per CU\n", per_cu); }
        grid = cus;
        if (grid > 256) grid = 256;
    }
    if (grid < 0) return;
    (void)hipMemsetAsync((char*)d_ws + WS_CTL, 0, CTL_ZERO_BYTES, stream);
    ArgsK a{};
    const GAS float** p = (const GAS float**)&a;
    for (int i = 0; i < 16; ++i) p[i] = (const GAS float*)d_in[i];
    a.out = (GAS float*)d_out; a.ws = (GAS unsigned char*)d_ws;
    void* args[] = {&a};
    hipError_t e = hipLaunchCooperativeKernel((const void*)mk_fwd, dim3(grid), dim3(NT), args, LDS_BYTES, stream);
    if (e != hipSuccess) fprintf(stderr, "cooperative launch failed: %s (grid %d)\n", hipGetErrorString(e), grid);
}
```

```cpp
#include <hip/hip_runtime.h>
#include <hip/hip_cooperative_groups.h>
#include <cstdio>
#include <cstdint>
namespace cg = cooperative_groups;
namespace pg8 {
#define PG8_LAS __attribute__((address_space(3)))
typedef unsigned short bf16_t;
typedef short bf16x8 __attribute__((ext_vector_type(8)));
typedef float f32x4 __attribute__((ext_vector_type(4)));
typedef unsigned u32x4 __attribute__((ext_vector_type(4)));
typedef unsigned u32x2 __attribute__((ext_vector_type(2)));
typedef int i32x4 __attribute__((ext_vector_type(4)));
constexpr int BM = 256, BK = 64, HALF = 128, HTB = HALF * BK * 2  , STAGE_BYTES = 8 * HTB, NXCD = 8, WGM = 8;

__host__ __device__ __forceinline__ int lds_byte(int r, int c) { const int st = (r >> 4) * 2 + (c >> 5), rr = r & 15, cc = c & 31, ob = rr * 64 + cc * 2; return st * 1024 + (ob ^ (((ob >> 9) & 1) << 5)); }
__host__ __device__ __forceinline__ void stage_rc(int b, int& R, int& C) { const int st = b / 1024, sb = b % 1024, swz = sb ^ (((sb >> 9) & 1) << 5); R = (st >> 1) * 16 + swz / 64; C = (st & 1) * 32 + (swz % 64) / 2; }
__host__ __device__ __forceinline__ int perm32(int rho) { const int n = rho >> 4, i = rho & 15; return 8 * (i >> 2) + 4 * n + (i & 3); }

struct Unit { int pm, pn; };
struct Gemm { const bf16_t* A; const bf16_t* Bt; int M, N, K; };

struct StaticOrder {
    int nM, nN, nwg, G, c;
    __host__ __device__ void init(int M, int N, int G_, int c_) { nM = M / BM; nN = N / BM; nwg = nM * nN; G = G_; c = c_; }
    __host__ __device__ bool next(int i, Unit& u) const {
        const long L = (long)i * G + c; if (L >= nwg) return false;
        int wgid = (int)L; { const int q = nwg / NXCD, r = nwg % NXCD, xcd = wgid % NXCD, off = wgid / NXCD; wgid = (xcd < r ? xcd * (q + 1) : r * (q + 1) + (xcd - r) * q) + off; }
        const int nig = WGM * nN, gid = wgid / nig, fm = gid * WGM, gsz = (nM - fm) < WGM ? (nM - fm) : WGM;
        u.pm = fm + ((wgid % nig) % gsz); u.pn = (wgid % nig) / gsz; return true;
    }
};

__device__ __forceinline__ unsigned cvt_pk_bf16(float lo, float hi) { unsigned r; asm volatile("v_cvt_pk_bf16_f32 %0, %1, %2" : "=v"(r) : "v"(lo), "v"(hi)); return r; }

template <class Epi, class Sched, bool ALIGN_EPI = false, bool I8 = false>
__device__ __forceinline__ void gemm_phase(PG8_LAS unsigned char* lds, const Gemm g, const Sched& S, const Epi& E, int wid) {
    int lane_; asm volatile("v_mbcnt_lo_u32_b32 %0, -1, 0\n\tv_mbcnt_hi_u32_b32 %0, -1, %0" : "=v"(lane_));
    const int lane = lane_, tid = wid * 64 + lane, wr = wid >> 2, wc = wid & 3, fr = lane & 15, fq = lane >> 4;
    const int K = g.K, nt = K / BK;
    unsigned voffA, voffB;
    { int R, C; stage_rc(tid * 16, R, C); const int Rb = Epi::PERM ? ((R & ~31) + perm32(R & 31)) : R; voffA = (unsigned)(R * K + C) * 2u; voffB = (unsigned)(Rb * K + C) * 2u; }
    const size_t p2step = (size_t)64 * K * 2;
    const size_t kstep = (size_t)(BK * 2);
    const size_t hstep = (size_t)HALF * K * 2;
    const size_t tstep = 2 * hstep;
    const unsigned ldsw = (unsigned)wid * 1024u;
    const int aoff = lds_byte(wr * 64 + fr, fq * 8), boff = lds_byte(wc * 32 + fr, fq * 8);
#define PG8_SA(b, h) (((b) * 2 + (h)) * HTB)
#define PG8_SB(b, h) ((4 + (b) * 2 + (h)) * HTB)
#define PG8_STAGE(bufoff, gbase, voff) do { _Pragma("unroll") for (int _i = 0; _i < 2; ++_i) \
        __builtin_amdgcn_global_load_lds((const unsigned*)((const char*)(gbase) + _i * p2step + (voff)), (PG8_LAS unsigned*)(lds + (bufoff) + ldsw + _i * 8192), 16, 0, 0); } while (0)
#define PG8_LDA(dst, b, h) do { _Pragma("unroll") for (int m = 0; m < 4; ++m) _Pragma("unroll") for (int k = 0; k < 2; ++k) dst[m][k] = *(const PG8_LAS bf16x8*)(lds + PG8_SA(b, h) + aoff + m * 2048 + k * 1024); } while (0)
#define PG8_LDB(dst, b, h) do { _Pragma("unroll") for (int n = 0; n < 2; ++n) _Pragma("unroll") for (int k = 0; k < 2; ++k) dst[n][k] = *(const PG8_LAS bf16x8*)(lds + PG8_SB(b, h) + boff + n * 2048 + k * 1024); } while (0)
#define PG8_MMA(ai, bj, At, Bt) do { __builtin_amdgcn_s_setprio(1); _Pragma("unroll") for (int m = 0; m < 4; ++m) _Pragma("unroll") for (int n = 0; n < 2; ++n) _Pragma("unroll") for (int k = 0; k < 2; ++k) \
        { if constexpr (I8) acc[ai][bj][m][n] = __builtin_bit_cast(f32x4, __builtin_amdgcn_mfma_i32_16x16x64_i8(__builtin_bit_cast(i32x4, Bt[n][k]), __builtin_bit_cast(i32x4, At[m][k]), __builtin_bit_cast(i32x4, acc[ai][bj][m][n]), 0, 0, 0)); \
          else acc[ai][bj][m][n] = __builtin_amdgcn_mfma_f32_16x16x32_bf16(Bt[n][k], At[m][k], acc[ai][bj][m][n], 0, 0, 0); } __builtin_amdgcn_s_setprio(0); } while (0)
#define PG8_WAIT_V(n) asm volatile("s_waitcnt vmcnt(" #n ")" ::: "memory")
#define PG8_WAIT_L(n) asm volatile("s_waitcnt lgkmcnt(" #n ")" ::: "memory")
#define PG8_BAR __builtin_amdgcn_s_barrier()
#define PG8_SCHED __builtin_amdgcn_sched_barrier(0)
    Unit cur, nxt; int ui = 0;
    if (!S.next(0, cur)) return;
    f32x4 acc[2][2][4][2];
#pragma unroll
    for (int a = 0; a < 2; ++a)
#pragma unroll
        for (int b = 0; b < 2; ++b)
#pragma unroll
            for (int m = 0; m < 4; ++m)
#pragma unroll
                for (int n = 0; n < 2; ++n) acc[a][b][m][n] = (f32x4){0.f, 0.f, 0.f, 0.f};
    bf16x8 At[4][2], B0[2][2], B1[2][2];
    typename Epi::Pre pre = {};
    const char* cA = (const char*)g.A + (size_t)cur.pm * tstep; const char* cB = (const char*)g.Bt + (size_t)cur.pn * tstep;
    PG8_STAGE(PG8_SB(0, 0), cB, voffB); PG8_STAGE(PG8_SB(0, 1), cB + hstep, voffB); PG8_STAGE(PG8_SA(0, 0), cA, voffA); PG8_STAGE(PG8_SA(0, 1), cA + hstep, voffA);
    if (wr == 1) PG8_BAR;
    PG8_WAIT_V(2); PG8_BAR;
    PG8_STAGE(PG8_SB(1, 0), cB + kstep, voffB); PG8_STAGE(PG8_SA(1, 0), cA + kstep, voffA); PG8_STAGE(PG8_SB(1, 1), cB + hstep + kstep, voffB);
    PG8_WAIT_V(6); PG8_BAR;
    for (;;) {
        const bool has_next = S.next(ui + 1, nxt);
        const char* nA = has_next ? (const char*)g.A + (size_t)nxt.pm * tstep : cA; const char* nB = has_next ? (const char*)g.Bt + (size_t)nxt.pn * tstep : cB;
        const int seglen = Epi::HOOK ? 8 : nt;
        for (int t0 = 0; t0 < nt; t0 += seglen) {
        if constexpr (Epi::HOOK) { if (t0 > 0) { int ln_; asm volatile("v_mbcnt_lo_u32_b32 %0, -1, 0\n\tv_mbcnt_hi_u32_b32 %0, -1, %0" : "=v"(ln_)); E.hook(acc, cur, t0 >> 3, wr, wc, ln_ & 15, ln_ >> 4); } }
        for (int t = t0; t < t0 + seglen; t += 2) {
            const bool last = (t == nt - 2);
            if constexpr (Epi::PRELOAD) { if (last) { int ln_; asm volatile("v_mbcnt_lo_u32_b32 %0, -1, 0\n\tv_mbcnt_hi_u32_b32 %0, -1, %0" : "=v"(ln_)); E.preload(pre, cur, wr, wc, ln_ & 15, ln_ >> 4); } }
            const char* a1 = cA + (size_t)(t + 1) * kstep;
            const char* a2 = last ? nA : cA + (size_t)(t + 2) * kstep; const char* b2 = last ? nB : cB + (size_t)(t + 2) * kstep;
            const char* a3 = a2 + kstep; const char* b3 = b2 + kstep;
            PG8_LDB(B0, 0, 0); PG8_LDB(B1, 0, 1); PG8_SCHED; PG8_LDA(At, 0, 0); PG8_STAGE(PG8_SA(1, 1), a1 + hstep, voffA);
            PG8_WAIT_V(8); PG8_WAIT_L(0); PG8_BAR; PG8_MMA(0, 0, At, B0); PG8_MMA(0, 1, At, B1); PG8_BAR; PG8_SCHED;
            PG8_LDA(At, 0, 1); PG8_STAGE(PG8_SB(0, 0), b2, voffB); PG8_STAGE(PG8_SB(0, 1), b2 + hstep, voffB); PG8_STAGE(PG8_SA(0, 0), a2, voffA);
            PG8_WAIT_V(8); PG8_WAIT_L(0); PG8_BAR; PG8_MMA(1, 0, At, B0); PG8_MMA(1, 1, At, B1); PG8_BAR; PG8_SCHED;
            PG8_LDB(B0, 1, 0); PG8_LDB(B1, 1, 1); PG8_SCHED; PG8_LDA(At, 1, 0); PG8_STAGE(PG8_SA(0, 1), a2 + hstep, voffA);
            PG8_WAIT_V(8); PG8_WAIT_L(0); PG8_BAR; PG8_MMA(0, 0, At, B0); PG8_MMA(0, 1, At, B1); PG8_BAR; PG8_SCHED;
            PG8_LDA(At, 1, 1); PG8_STAGE(PG8_SB(1, 0), b3, voffB); PG8_STAGE(PG8_SB(1, 1), b3 + hstep, voffB); PG8_STAGE(PG8_SA(1, 0), a3, voffA);
            PG8_WAIT_V(8); PG8_WAIT_L(0); PG8_BAR; PG8_MMA(1, 0, At, B0); PG8_MMA(1, 1, At, B1); PG8_BAR; PG8_SCHED;
        }
        }
        if constexpr (ALIGN_EPI) { if (wr == 0) PG8_BAR; }
        { int ln_; asm volatile("v_mbcnt_lo_u32_b32 %0, -1, 0\n\tv_mbcnt_hi_u32_b32 %0, -1, %0" : "=v"(ln_));
          if constexpr (Epi::PRELOAD) E(acc, cur, wr, wc, ln_ & 15, ln_ >> 4, pre); else E(acc, cur, wr, wc, ln_ & 15, ln_ >> 4); }
        if (!has_next) break;
#pragma unroll
        for (int a = 0; a < 2; ++a)
#pragma unroll
            for (int b = 0; b < 2; ++b)
#pragma unroll
                for (int m = 0; m < 4; ++m)
#pragma unroll
                    for (int n = 0; n < 2; ++n) acc[a][b][m][n] = (f32x4){0.f, 0.f, 0.f, 0.f};
        cur = nxt; cA = nA; cB = nB; ++ui;
        if constexpr (ALIGN_EPI) { if (wr == 1) PG8_BAR; }
    }
    PG8_WAIT_V(0);
    if constexpr (!ALIGN_EPI) { if (wr == 0) PG8_BAR; }
    PG8_BAR;
#undef PG8_SA
#undef PG8_SB
#undef PG8_STAGE
#undef PG8_LDA
#undef PG8_LDB
#undef PG8_MMA
#undef PG8_WAIT_V
#undef PG8_WAIT_L
#undef PG8_BAR
#undef PG8_SCHED
}
}
#ifndef PROBE
#define PROBE 0
#endif
#ifndef PROBE11_THR
#define PROBE11_THR 1000000u
#endif
constexpr int NWAVES = 8, NT = NWAVES * 64;
constexpr int M = 8192, D = 2048, SEQ = 2048, NBATCH = 4, DEPTH = 2;
constexpr int INW = 13316, NPROJ = 13312, MIXW = 512, HD = 128;
constexpr int PEER_E = 16384;
constexpr float EPS = 1e-6f;
constexpr float ATT_SCALE = 0.08838834764831845f;

constexpr size_t MiB = 1u << 20;
constexpr size_t WS_CTL = 0, CTL_ZERO_BYTES = 1 * MiB;
constexpr size_t WS_SSQ = 0;
constexpr size_t WS_SSA = 256 * 1024;
constexpr size_t WS_WF = 1 * MiB;
constexpr size_t WS_BINR = WS_WF + 64 * 1024;
constexpr size_t WS_LOGF = 2 * MiB;
constexpr size_t WS_CUM = 3 * MiB;
constexpr size_t WS_WIN = 8 * MiB;
constexpr size_t WIN_BYTES = (size_t)NPROJ * D;
constexpr size_t WS_SW = 7 * MiB;
constexpr size_t WS_CMAX = 384 * 1024;
constexpr size_t WS_HB8 = 64 * MiB;
constexpr size_t WS_SA = 7 * MiB + 512 * 1024;
constexpr size_t WS_WBR = 112 * MiB, WS_WOUT = 128 * MiB, WS_WQ = 144 * MiB;
constexpr size_t SQ_BYTES = (size_t)D * D * 2;
constexpr size_t WS_PU = 160 * MiB, WS_PV = 288 * MiB;
constexpr size_t PE_BYTES = (size_t)PEER_E * D;
constexpr size_t WS_PK = 6 * MiB;
constexpr size_t WS_SU = 5 * MiB, WS_SV = 5 * MiB + 256 * 1024;
constexpr size_t WS_H = 416 * MiB;
constexpr size_t WS_HB = 480 * MiB;
constexpr size_t WS_PROJ = 512 * MiB;
constexpr size_t PROJ_T = (size_t)M * MIXW;
constexpr size_t WS_R = 592 * MiB;
constexpr size_t R_PLANE = (size_t)M * D;
constexpr size_t WS_Y = 720 * MiB;
constexpr size_t WS_MRG = 752 * MiB;
constexpr size_t WS_Q = 784 * MiB;
constexpr size_t WS_END = 816 * MiB;

constexpr int RING_BYTES = 131072;
constexpr int LDS_BYTES = 147456;

typedef unsigned short bf16;
typedef unsigned v4u __attribute__((ext_vector_type(4)));
typedef unsigned v2u __attribute__((ext_vector_type(2)));
typedef float f32x4 __attribute__((ext_vector_type(4)));
typedef float f32x2 __attribute__((ext_vector_type(2)));
using bf16x2 = __attribute__((ext_vector_type(2))) __bf16;
#define LAS __attribute__((address_space(3)))

__device__ __forceinline__ unsigned f2bf(float f) { unsigned u = __builtin_bit_cast(unsigned, f); return (u + 0x7fffu + ((u >> 16) & 1u)) >> 16; }
__device__ __forceinline__ unsigned pk2(float lo, float hi) { return f2bf(lo) | (f2bf(hi) << 16); }
__device__ __forceinline__ float bflo(unsigned w) { return __builtin_bit_cast(float, w << 16); }
__device__ __forceinline__ float bfhi(unsigned w) { return __builtin_bit_cast(float, w & 0xffff0000u); }
__device__ __forceinline__ float bf2f(bf16 b) { return __builtin_bit_cast(float, ((unsigned)b) << 16); }
__device__ __forceinline__ float shf(float v, int src) { return __builtin_bit_cast(float, __builtin_amdgcn_ds_bpermute(src << 2, __builtin_bit_cast(int, v))); }
__device__ __forceinline__ int shi(int v, int src) { return __builtin_amdgcn_ds_bpermute(src << 2, v); }
__device__ __forceinline__ float wave_sum(float v, int lane) {
#pragma unroll
    for (int o = 1; o < 64; o <<= 1) v += shf(v, lane ^ o);
    return v;
}
__device__ __forceinline__ float wave_max(float v, int lane) {
#pragma unroll
    for (int o = 1; o < 64; o <<= 1) v = fmaxf(v, shf(v, lane ^ o));
    return v;
}
__device__ __forceinline__ float ssa_to_f(unsigned long long v) { return (float)((double)v * (1.0 / 4294967296.0)); }
__device__ __forceinline__ float dot2_bf16(unsigned w, unsigned x, float acc) { return __builtin_amdgcn_fdot2_f32_bf16(__builtin_bit_cast(bf16x2, w), __builtin_bit_cast(bf16x2, x), acc, false); }

#define LANE_ID(x) asm volatile("v_mbcnt_lo_u32_b32 %0, -1, 0\n\tv_mbcnt_hi_u32_b32 %0, -1, %0" : "=v"(x))
struct Args {
    const float *x, *norm_mix, *w_in, *b_in, *pool_w, *pool_scale, *conv_w, *rel_bias, *w_branch, *w_out, *norm_ffn, *peer_wq, *peer_keys, *peer_u, *peer_v, *norm_final;
    float* out; unsigned char* ws;
};
#define GAS __attribute__((address_space(1)))
#define CAS __attribute__((address_space(4)))
struct ArgsK {
    const GAS float *x, *norm_mix, *w_in, *b_in, *pool_w, *pool_scale, *conv_w, *rel_bias, *w_branch, *w_out, *norm_ffn, *peer_wq, *peer_keys, *peer_u, *peer_v, *norm_final;
    GAS float* out; GAS unsigned char* ws;
};
__device__ __forceinline__ Args load_args(const CAS ArgsK* k, size_t zoff) {
    Args a;
    a.x = (const float*)k->x; a.norm_mix = (const float*)k->norm_mix; a.w_in = (const float*)k->w_in; a.b_in = (const float*)k->b_in; a.pool_w = (const float*)k->pool_w;
    a.pool_scale = (const float*)k->pool_scale; a.conv_w = (const float*)k->conv_w; a.rel_bias = (const float*)k->rel_bias; a.w_branch = (const float*)k->w_branch;
    a.w_out = (const float*)k->w_out; a.norm_ffn = (const float*)k->norm_ffn; a.peer_wq = (const float*)k->peer_wq; a.peer_keys = (const float*)k->peer_keys;
    a.peer_u = (const float*)k->peer_u; a.peer_v = (const float*)k->peer_v; a.norm_final = (const float*)k->norm_final; a.out = (float*)k->out; a.ws = (unsigned char*)(k->ws + zoff);
    return a;
}

using pg8::f32x4; using pg8::Unit;
constexpr size_t WS_G = 896 * MiB;
constexpr size_t WS_SWH = 7 * MiB + 256 * 1024, WS_BIH = 7 * MiB + 384 * 1024;
constexpr size_t WS_RSA = 7 * MiB + 768 * 1024;
struct EpiProj {
    static constexpr bool PERM = true, HOOK = false, PRELOAD = true;
    struct Pre { pg8::u32x4 sw[2], bi[2]; float rs[2][4]; };
    unsigned char* wsb; const bf16* biash; const float* rsa; const bf16* swh;
    __device__ __forceinline__ void preload(Pre& p, const Unit& u, int wr, int wc, int fr, int fq) const {
        const int row0 = u.pm * 256 + wr * 64 + fr, bcol0 = u.pn * 256 + wc * 32 + 8 * fq;
#pragma unroll
        for (int bj = 0; bj < 2; ++bj) { p.sw[bj] = *(const pg8::u32x4*)(swh + bcol0 + bj * 128); p.bi[bj] = *(const pg8::u32x4*)(biash + bcol0 + bj * 128); }
#pragma unroll
        for (int ai = 0; ai < 2; ++ai)
#pragma unroll
            for (int m = 0; m < 4; ++m) p.rs[ai][m] = rsa[row0 + ai * 128 + m * 16];
    }
    __device__ __forceinline__ void operator()(f32x4 (&acc)[2][2][4][2], const Unit& u, int wr, int wc, int fr, int fq, const Pre& p) const {
        const int cl0 = wc * 32 + 8 * fq;
#define ACCF(ai, bj, m, n) __builtin_convertvector(__builtin_bit_cast(pg8::i32x4, acc[ai][bj][m][n]), f32x4)
        const __amdgpu_buffer_rsrc_t rW = __builtin_amdgcn_make_buffer_rsrc((void*)wsb, 0, 0x7fffffff, 0x00020000);
        int sbase, ldb;
        if (u.pn < 20) { sbase = (int)WS_PROJ + ((u.pn >> 1) * (int)PROJ_T + (u.pn & 1) * 256) * 2; ldb = MIXW * 2; } else { sbase = (int)WS_G + (u.pn - 20) * 512; ldb = 4 * D * 2; }
        const int voff = fr * ldb + cl0 * 2; sbase += (u.pm * 256 + wr * 64) * ldb;
#pragma unroll
        for (int bj = 0; bj < 2; ++bj) { const f32x4 w0 = {bflo(p.sw[bj].x), bfhi(p.sw[bj].x), bflo(p.sw[bj].y), bfhi(p.sw[bj].y)}, w1 = {bflo(p.sw[bj].z), bfhi(p.sw[bj].z), bflo(p.sw[bj].w), bfhi(p.sw[bj].w)};
            const f32x4 b0 = {bflo(p.bi[bj].x), bfhi(p.bi[bj].x), bflo(p.bi[bj].y), bfhi(p.bi[bj].y)}, b1 = {bflo(p.bi[bj].z), bfhi(p.bi[bj].z), bflo(p.bi[bj].w), bfhi(p.bi[bj].w)};
#pragma unroll
            for (int ai = 0; ai < 2; ++ai)
#pragma unroll
                for (int m = 0; m < 4; ++m) { const float rs = p.rs[ai][m]; f32x4 v0 = ACCF(ai, bj, m, 0) * rs * w0 + b0, v1 = ACCF(ai, bj, m, 1) * rs * w1 + b1;
                    if (u.pn >= 20) {
                        v0 = (f32x4){fminf(1.0f + __builtin_amdgcn_exp2f(-1.4426950408889634f * v0[0]), 1e18f), fminf(1.0f + __builtin_amdgcn_exp2f(-1.4426950408889634f * v0[1]), 1e18f), fminf(1.0f + __builtin_amdgcn_exp2f(-1.4426950408889634f * v0[2]), 1e18f), fminf(1.0f + __builtin_amdgcn_exp2f(-1.4426950408889634f * v0[3]), 1e18f)};
                        v1 = (f32x4){fminf(1.0f + __builtin_amdgcn_exp2f(-1.4426950408889634f * v1[0]), 1e18f), fminf(1.0f + __builtin_amdgcn_exp2f(-1.4426950408889634f * v1[1]), 1e18f), fminf(1.0f + __builtin_amdgcn_exp2f(-1.4426950408889634f * v1[2]), 1e18f), fminf(1.0f + __builtin_amdgcn_exp2f(-1.4426950408889634f * v1[3]), 1e18f)}; }
                    pg8::u32x4 w; w.x = pg8::cvt_pk_bf16(v0[0], v0[1]); w.y = pg8::cvt_pk_bf16(v0[2], v0[3]); w.z = pg8::cvt_pk_bf16(v1[0], v1[1]); w.w = pg8::cvt_pk_bf16(v1[2], v1[3]);
                    __builtin_amdgcn_raw_buffer_store_b128(w, rW, voff + bj * 256, sbase + (ai * 128 + m * 16) * ldb, 0); } }
    }
};
#undef ACCF
struct EpiSum {
    static constexpr bool PERM = true, HOOK = false; static constexpr bool PRELOAD = false; struct Pre {};
    float* dummy;
    __device__ __forceinline__ void operator()(f32x4 (&acc)[2][2][4][2], const Unit& u, int wr, int wc, int fr, int fq) const {
        f32x4 s = {0.f, 0.f, 0.f, 0.f};
#pragma unroll
        for (int ai = 0; ai < 2; ++ai)
#pragma unroll
            for (int bj = 0; bj < 2; ++bj)
#pragma unroll
                for (int m = 0; m < 4; ++m)
#pragma unroll
                    for (int n = 0; n < 2; ++n) s += acc[ai][bj][m][n];
        dummy[((u.pm * 64 + u.pn) * 8 + wr * 4 + wc) * 64 + fq * 16 + fr] = (s[0] + s[1]) + (s[2] + s[3]);
    }
};
template <int MODE> struct EpiSt {
    static constexpr bool PERM = true, HOOK = false, PRELOAD = false; struct Pre {};
    unsigned char* wsb;
    __device__ __forceinline__ void operator()(f32x4 (&acc)[2][2][4][2], const Unit& u, int wr, int wc, int fr, int fq) const {
        const __amdgpu_buffer_rsrc_t rW = __builtin_amdgcn_make_buffer_rsrc((void*)wsb, 0, 0x7fffffff, 0x00020000);
        const int ldb = 4 * D * 2; int sbase = (int)WS_R + (u.pn % 32) * 512 + (u.pm * 256 + wr * 64) * ldb;
        const int ln = fq * 16 + fr; const int r = MODE ? (ln >> 2) : fr, cg = MODE ? (ln & 3) : fq;
        const int voff = r * ldb + (wc * 32 + 8 * cg) * 2;
#pragma unroll
        for (int bj = 0; bj < 2; ++bj)
#pragma unroll
            for (int ai = 0; ai < 2; ++ai)
#pragma unroll
                for (int m = 0; m < 4; ++m) { pg8::u32x4 w = __builtin_bit_cast(pg8::u32x4, acc[ai][bj][m][0] + acc[ai][bj][m][1]);
                    __builtin_amdgcn_raw_buffer_store_b128(w, rW, voff + bj * 256, sbase + (ai * 128 + m * 16) * ldb, 0); }
    }
};
struct EpiMerge {
    static constexpr bool PERM = true, HOOK = true; static constexpr bool PRELOAD = false; struct Pre {};
    const bf16* G; bf16* O;
    struct Bt { pg8::u32x4 n[2][2], d[2][2]; };
    __device__ __forceinline__ void scale(f32x4 (&acc)[2][2][4][2], const Unit& u, int g, int wr, int wc, int fr, int fq) const {
        const __amdgpu_buffer_rsrc_t rs = __builtin_amdgcn_make_buffer_rsrc((void*)G, 0, 0x7fffffff, 0x00020000);
        int voff = (fr * 4 * D + 8 * fq) * 2; asm volatile("" : "+v"(voff));
        const int sden = ((u.pm * 256 + wr * 64) * 4 * D + (g - 1) * D + u.pn * 256 + wc * 32) * 2, snum = sden + D * 2;
        const bool fin = g == 4;
#define MG_LOAD(B, b0) do { _Pragma("unroll") for (int i = 0; i < 2; ++i) _Pragma("unroll") for (int bj = 0; bj < 2; ++bj) { const int ai_ = ((b0) + i) >> 2, m_ = ((b0) + i) & 3, so_ = (ai_ * 128 + m_ * 16) * 4 * D * 2; \
            B.d[i][bj] = __builtin_amdgcn_raw_buffer_load_b128(rs, voff + bj * 256, sden + so_, 0); if (!fin) B.n[i][bj] = __builtin_amdgcn_raw_buffer_load_b128(rs, voff + bj * 256, snum + so_, 0); } } while (0)
#define MG_APPLY(B, b0) do { _Pragma("unroll") for (int i = 0; i < 2; ++i) _Pragma("unroll") for (int bj = 0; bj < 2; ++bj) { const int ai_ = ((b0) + i) >> 2, m_ = ((b0) + i) & 3; const pg8::u32x4 dv = B.d[i][bj], nv = B.n[i][bj]; \
            f32x4 r0 = {__builtin_amdgcn_rcpf(bflo(dv.x)), __builtin_amdgcn_rcpf(bfhi(dv.x)), __builtin_amdgcn_rcpf(bflo(dv.y)), __builtin_amdgcn_rcpf(bfhi(dv.y))}, r1 = {__builtin_amdgcn_rcpf(bflo(dv.z)), __builtin_amdgcn_rcpf(bfhi(dv.z)), __builtin_amdgcn_rcpf(bflo(dv.w)), __builtin_amdgcn_rcpf(bfhi(dv.w))}; \
            if (!fin) { r0 *= (f32x4){bflo(nv.x), bfhi(nv.x), bflo(nv.y), bfhi(nv.y)}; r1 *= (f32x4){bflo(nv.z), bfhi(nv.z), bflo(nv.w), bfhi(nv.w)}; } \
            acc[ai_][bj][m_][0] *= r0; acc[ai_][bj][m_][1] *= r1; asm volatile("" : "+v"(acc[ai_][bj][m_][0]), "+v"(acc[ai_][bj][m_][1])); } } while (0)
        Bt A = {}, B = {};
        MG_LOAD(A, 0);
        MG_LOAD(B, 2); MG_APPLY(A, 0); asm volatile("" ::: "memory");
        MG_LOAD(A, 4); MG_APPLY(B, 2); asm volatile("" ::: "memory");
        MG_LOAD(B, 6); MG_APPLY(A, 4); asm volatile("" ::: "memory");
        MG_APPLY(B, 6); asm volatile("" ::: "memory");
#undef MG_LOAD
#undef MG_APPLY
    }
    __device__ __forceinline__ void hook(f32x4 (&acc)[2][2][4][2], const Unit& u, int g, int wr, int wc, int fr, int fq) const { scale(acc, u, g, wr, wc, fr, fq); }
    __device__ __forceinline__ void operator()(f32x4 (&acc)[2][2][4][2], const Unit& u, int wr, int wc, int fr, int fq) const {
        scale(acc, u, 4, wr, wc, fr, fq);
        const int row0 = u.pm * 256 + wr * 64 + fr, col0 = u.pn * 256 + wc * 32 + 8 * fq;
#pragma unroll
        for (int ai = 0; ai < 2; ++ai)
#pragma unroll
            for (int m = 0; m < 4; ++m) { bf16* rowp = O + (size_t)(row0 + ai * 128 + m * 16) * D + col0;
#pragma unroll
                for (int bj = 0; bj < 2; ++bj) { const f32x4 v0 = acc[ai][bj][m][0], v1 = acc[ai][bj][m][1];
                    pg8::u32x4 w; w.x = pg8::cvt_pk_bf16(v0[0], v0[1]); w.y = pg8::cvt_pk_bf16(v0[2], v0[3]); w.z = pg8::cvt_pk_bf16(v1[0], v1[1]); w.w = pg8::cvt_pk_bf16(v1[2], v1[3]);
                    *(pg8::u32x4*)(rowp + bj * 128) = w; } }
    }
};
struct EpiRes {
    static constexpr bool PERM = false, HOOK = false; static constexpr bool PRELOAD = false; struct Pre {};
    const float* Hin; float* H; bf16* HB; unsigned long long* ssa;
    __device__ __forceinline__ void operator()(f32x4 (&acc)[2][2][4][2], const Unit& u, int wr, int wc, int fr, int fq) const {
        const int row0 = u.pm * 256 + wr * 64 + fr, col0 = u.pn * 256 + wc * 32 + 4 * fq;
#pragma unroll
        for (int ai = 0; ai < 2; ++ai)
#pragma unroll
            for (int m = 0; m < 4; ++m) { const int row = row0 + ai * 128 + m * 16; const size_t off = (size_t)row * D + col0; float s = 0.f;
#pragma unroll
                for (int bj = 0; bj < 2; ++bj)
#pragma unroll
                    for (int n = 0; n < 2; ++n) { const size_t o = off + bj * 128 + n * 16; const f32x4 h = *(const f32x4*)(Hin + o) + acc[ai][bj][m][n];
                        *(f32x4*)(H + o) = h; pg8::u32x2 w; w.x = pg8::cvt_pk_bf16(h[0], h[1]); w.y = pg8::cvt_pk_bf16(h[2], h[3]); *(pg8::u32x2*)(HB + o) = w;
                        s += (h[0] * h[0] + h[1] * h[1]) + (h[2] * h[2] + h[3] * h[3]); }
                { const int ln = fq * 16 + fr; s += shf(s, ln ^ 16); s += shf(s, ln ^ 32); }
                if (fq == 0) atomicAdd(ssa + row, (unsigned long long)((double)s * 4294967296.0)); }
    }
};
struct EpiQ {
    static constexpr bool PERM = true, HOOK = false; static constexpr bool PRELOAD = false; struct Pre {};
    bf16* O; const unsigned long long* ssa;
    __device__ __forceinline__ void operator()(f32x4 (&acc)[2][2][4][2], const Unit& u, int wr, int wc, int fr, int fq) const {
        const int row0 = u.pm * 256 + wr * 64 + fr, col0 = u.pn * 256 + wc * 32 + 8 * fq;
#pragma unroll
        for (int ai = 0; ai < 2; ++ai)
#pragma unroll
            for (int m = 0; m < 4; ++m) { const int row = row0 + ai * 128 + m * 16; const float rs = rsqrtf(ssa_to_f(ssa[row]) * (1.0f / D) + EPS);
                bf16* rowp = O + (size_t)row * D + col0;
#pragma unroll
                for (int bj = 0; bj < 2; ++bj) { const f32x4 v0 = acc[ai][bj][m][0] * rs, v1 = acc[ai][bj][m][1] * rs;
                    pg8::u32x4 w; w.x = pg8::cvt_pk_bf16(v0[0], v0[1]); w.y = pg8::cvt_pk_bf16(v0[2], v0[3]); w.z = pg8::cvt_pk_bf16(v1[0], v1[1]); w.w = pg8::cvt_pk_bf16(v1[2], v1[3]);
                    *(pg8::u32x4*)(rowp + bj * 128) = w; } }
    }
};

__device__ __forceinline__ int colmap_in(int j) { return j < 1536 ? j : j + 4; }
__device__ __forceinline__ void tr_item_i8(const float* W, const float* gain, const unsigned* cmax, unsigned char* WT, LAS float* scr, int k0, int n0, int lane) {
    const int q = lane & 7, r8 = lane >> 3, sc = colmap_in(n0 + 4 * q);
    f32x4 v[8];
#pragma unroll
    for (int i = 0; i < 8; ++i) v[i] = *(const f32x4*)(W + (size_t)(k0 + 8 * i + r8) * INW + sc);
    f32x4 inv;
#pragma unroll
    for (int e = 0; e < 4; ++e) { const float cm = __builtin_bit_cast(float, cmax[sc + e]); inv[e] = cm > 0.f ? 127.0f / cm : 0.f; }
#pragma unroll
    for (int i = 0; i < 8; ++i) { const float g = gain[k0 + 8 * i + r8];
#pragma unroll
        for (int e = 0; e < 4; ++e) scr[(8 * i + r8) * 33 + 4 * q + e] = v[i][e] * g * inv[e]; }
    asm volatile("s_waitcnt lgkmcnt(0)" ::: "memory");
    const int n = lane >> 1, hf = lane & 1;
    v4u o[2];
#pragma unroll
    for (int w = 0; w < 8; ++w) { unsigned pk = 0;
#pragma unroll
        for (int b = 0; b < 4; ++b) pk |= ((unsigned)((int)rintf(scr[(32 * hf + 4 * w + b) * 33 + n]) & 255)) << (8 * b);
        o[w >> 2][w & 3] = pk; }
    unsigned char* dst = WT + (size_t)(n0 + n) * D + k0 + 32 * hf;
    *(v4u*)dst = o[0]; *(v4u*)(dst + 16) = o[1];
    asm volatile("s_waitcnt lgkmcnt(0)" ::: "memory");
}
template <bool MAP>
__device__ __forceinline__ void tr_item(const float* W, int ldw, const float* scale, bf16* WT, int ldt, int dcol0, LAS float* scr, int k0, int n0, int lane) {
    const int q = lane & 7, r8 = lane >> 3, sc = MAP ? colmap_in(n0 + 4 * q) : (n0 + 4 * q);
    f32x4 v[8];
#pragma unroll
    for (int i = 0; i < 8; ++i) v[i] = *(const f32x4*)(W + (size_t)(k0 + 8 * i + r8) * ldw + sc);
    f32x4 s0 = {1.f, 1.f, 1.f, 1.f}, s1 = s0;
    if (scale) { s0 = *(const f32x4*)(scale + k0 + 8 * q); s1 = *(const f32x4*)(scale + k0 + 8 * q + 4); }
#pragma unroll
    for (int i = 0; i < 8; ++i)
#pragma unroll
        for (int e = 0; e < 4; ++e) scr[(8 * i + r8) * 33 + 4 * q + e] = v[i][e];
    asm volatile("s_waitcnt lgkmcnt(0)" ::: "memory");
    const int c = q;
#pragma unroll
    for (int j = 0; j < 4; ++j) { const int n = r8 + 8 * j; const LAS float* s = scr + (8 * c) * 33 + n;
        v4u o; o.x = pk2(s[0 * 33] * s0[0], s[1 * 33] * s0[1]); o.y = pk2(s[2 * 33] * s0[2], s[3 * 33] * s0[3]); o.z = pk2(s[4 * 33] * s1[0], s[5 * 33] * s1[1]); o.w = pk2(s[6 * 33] * s1[2], s[7 * 33] * s1[3]);
        *(v4u*)(WT + (size_t)(n0 + n) * ldt + dcol0 + k0 + 8 * c) = o; }
    asm volatile("s_waitcnt lgkmcnt(0)" ::: "memory");
}
constexpr size_t WS_BAR = 512 * 1024;
#define XB_TMO      128
#define XB_XCNT(j)  (256  + 64 * (j))
#define XB_XSUB(j)  (1280 + 64 * (j))
#define XB_XGEN(j)  (2304 + 64 * (j))
#define XB_TOP      3328
#define XB_TOPGEN   3392
#define XCD_BAR_WORDS 3456
#define XB_SPIN_CAP (1u << 23)
__device__ __forceinline__ unsigned xb_ld(unsigned* p)              { return __hip_atomic_load(p, __ATOMIC_RELAXED, __HIP_MEMORY_SCOPE_AGENT); }
__device__ __forceinline__ unsigned xb_add(unsigned* p, unsigned v) { return __hip_atomic_fetch_add(p, v, __ATOMIC_RELAXED, __HIP_MEMORY_SCOPE_AGENT); }
__device__ __forceinline__ unsigned xb_xcc_id() { return (unsigned)__builtin_amdgcn_s_getreg((3 << 11) | 20) & 0xFu; }
#define XB_SPIN(cond, bar) do { unsigned _sp = 0; while (cond) { __builtin_amdgcn_s_sleep(1); \
    if ((++_sp & 255u) == 0u) { if (xb_ld(&(bar)[XB_TMO])) break; if (_sp > XB_SPIN_CAP) { atomicAdd(&(bar)[XB_TMO], 1u); break; } } } } while (0)
__device__ __forceinline__ void xcd_barrier_complete(unsigned* bar, unsigned x, unsigned G, unsigned& nloc, unsigned& nx) {
    unsigned sum, cnt, mine, sp = 0u;
    for (;;) {
        sum = 0u; cnt = 0u; mine = 0u;
#pragma unroll
        for (unsigned j = 0; j < 16; ++j) { const unsigned c = xb_ld(&bar[XB_XCNT(j)]); sum += c; cnt += (c > 0u) ? 1u : 0u; mine = (j == x) ? c : mine; }
        if (sum == G) break;
        __builtin_amdgcn_s_sleep(1);
        if ((++sp & 255u) == 0u) { if (xb_ld(&bar[XB_TMO])) break; if (sp > XB_SPIN_CAP) { atomicAdd(&bar[XB_TMO], 1u); break; } }
    }
    nloc = mine > 0u ? mine : 1u; nx = cnt > 0u ? cnt : 1u;
}
__device__ __forceinline__ void xcd_barrier(unsigned* bar, unsigned x, unsigned G, volatile LAS unsigned* st, int wave) {
    asm volatile("s_waitcnt vmcnt(0)" ::: "memory");
    __syncthreads();
    int lane; asm volatile("v_mbcnt_lo_u32_b32 %0, -1, 0\n\tv_mbcnt_hi_u32_b32 %0, -1, %0" : "=v"(lane));
    if (wave == 0 && lane == 0) {
        __builtin_amdgcn_s_waitcnt(0);
        unsigned nloc = st[0], nx = st[1];
        if (nloc == 0u) { xcd_barrier_complete(bar, x, G, nloc, nx); st[0] = nloc; st[1] = nx; }
        const unsigned old = xb_add(&bar[XB_XSUB(x)], 1u);
        const unsigned gen = old / nloc;
        if (old + 1u == (gen + 1u) * nloc) {
            __builtin_amdgcn_fence(__ATOMIC_RELEASE, "agent");
            asm volatile("s_waitcnt vmcnt(0)" ::: "memory");
            const unsigned og = xb_add(&bar[XB_TOP], 1u);
            const unsigned tg = og / nx;
            if (og + 1u == (tg + 1u) * nx) xb_add(&bar[XB_TOPGEN], 1u);
            else XB_SPIN(xb_ld(&bar[XB_TOPGEN]) == tg, bar);
            __builtin_amdgcn_fence(__ATOMIC_ACQUIRE, "agent");
            xb_add(&bar[XB_XGEN(x)], 1u);
            asm volatile("s_waitcnt vmcnt(0)" ::: "memory");
        } else {
            XB_SPIN(xb_ld(&bar[XB_XGEN(x)]) == gen, bar);
            __builtin_amdgcn_fence(__ATOMIC_ACQUIRE, "agent");
            asm volatile("s_waitcnt vmcnt(0)" ::: "memory");
        }
    }
    __syncthreads();
}
namespace att {
constexpr int D = 128, NW = 8, QBLK = 32, KVBLK = 64, QB = NW * QBLK;
constexpr int PITCH = 512, OPITCH = 2048;
constexpr float SCALE = 0.08838834764831845f, THR = 8.f;
constexpr int SHM_V = KVBLK * D * 2, SHM_K = KVBLK * D * 2;
constexpr int OFF_WS = 2 * SHM_V + 2 * SHM_K, OFF_CUM = OFF_WS + NW * 64 * 4, OFF_REL = OFF_CUM + 2048 * 4, LDS_END = OFF_REL + 320 * 4;
typedef unsigned short bf16;
typedef short bf16x8 __attribute__((ext_vector_type(8)));
typedef short s16x4 __attribute__((ext_vector_type(4)));
typedef float f32x16 __attribute__((ext_vector_type(16)));
typedef float f32x4 __attribute__((ext_vector_type(4)));
typedef unsigned u32x4 __attribute__((ext_vector_type(4)));
#define ALDS __attribute__((address_space(3)))

#define KSWZ(row, colB) ((row) * 256 + ((colB) ^ (((row) & 7) << 4)))
#define SBAR() __builtin_amdgcn_sched_barrier(0)
__device__ __forceinline__ int v_st(int k, int c) { const int kk = (k & ~0xC) | ((k & 4) << 1) | ((k & 8) >> 1); return ((kk >> 3) * 4 + (c >> 5)) * 512 + ((kk & 7) * 32 + (c & 31)) * 2; }
__device__ __forceinline__ int v_rd_base(int lane) { return ((lane & 3) << 3) | (((lane >> 2) & 3) << 6) | (((lane >> 4) & 1) << 5) | (((lane >> 5) & 1) << 8); }
constexpr int v_rd_off(int d0, int ks, int half) { return d0 * 512 + ks * 4096 + half * 2048; }
__device__ __forceinline__ int crow(int r, int hi) { return (r & 3) + 8 * (r >> 2) + 4 * hi; }
__device__ __forceinline__ unsigned cvtpk(float lo, float hi) { unsigned r; asm volatile("v_cvt_pk_bf16_f32 %0, %1, %2" : "=v"(r) : "v"(lo), "v"(hi)); return r; }
__device__ __forceinline__ bf16x8 load8(const bf16* p) { return *reinterpret_cast<const bf16x8*>(p); }

__device__ __forceinline__ void mask_tile(f32x16& p0, f32x16& p1, int dq) {
    const float NEG = -__builtin_inff();
#pragma unroll
    for (int r = 0; r < 16; ++r) { const int c = (r & 3) + 8 * (r >> 2);
        if (dq - c < 0) p0[r] = NEG;
        if (dq - c - 32 < 0) p1[r] = NEG; }
}
__device__ __forceinline__ void partialSM(f32x16& p0, f32x16& p1, float& m_reg, float& mn, float& alpha) {
    float pmax = p0[0];
#pragma unroll
    for (int r = 1; r < 16; ++r) pmax = fmaxf(pmax, p0[r]);
#pragma unroll
    for (int r = 0; r < 16; ++r) pmax = fmaxf(pmax, p1[r]);
    { auto rr = __builtin_amdgcn_permlane32_swap(__float_as_uint(pmax), __float_as_uint(pmax), false, false);
      pmax = fmaxf(__uint_as_float(rr[0]), __uint_as_float(rr[1])); }
    constexpr float C2 = 1.4426950408889634f * SCALE;
    if (__builtin_expect(__all((pmax - m_reg) * SCALE <= THR), 1)) { mn = m_reg; alpha = 1.f; }
    else { mn = fmaxf(m_reg, pmax); alpha = __builtin_amdgcn_exp2f((m_reg - mn) * C2); m_reg = mn; }
    const float mnL = -mn * C2;
#pragma unroll
    for (int r = 0; r < 16; ++r) p0[r] = fmaf(p0[r], C2, mnL);
#pragma unroll
    for (int r = 0; r < 16; ++r) p1[r] = fmaf(p1[r], C2, mnL);
#pragma unroll
    for (int r = 0; r < 16; ++r) p0[r] = __builtin_amdgcn_exp2f(p0[r]);
}
__device__ __forceinline__ void finishSM(f32x16& p0, f32x16& p1, float alpha, float& l_reg, bf16x8& pa0, bf16x8& pa1, bf16x8& pa2, bf16x8& pa3) {
#pragma unroll
    for (int r = 0; r < 16; ++r) p1[r] = __builtin_amdgcn_exp2f(p1[r]);
    float ps = 0;
#pragma unroll
    for (int r = 0; r < 16; ++r) ps += p0[r];
#pragma unroll
    for (int r = 0; r < 16; ++r) ps += p1[r];
    { auto rr = __builtin_amdgcn_permlane32_swap(__float_as_uint(ps), __float_as_uint(ps), false, false);
      ps = __uint_as_float(rr[0]) + __uint_as_float(rr[1]); }
    l_reg = l_reg * alpha + ps;
#define PK4(P, B_, OUT) do { unsigned a0 = cvtpk(P[B_+0], P[B_+1]), a1 = cvtpk(P[B_+2], P[B_+3]);                          \
        unsigned b0 = cvtpk(P[B_+4], P[B_+5]), b1 = cvtpk(P[B_+6], P[B_+7]);                                             \
        auto r0 = __builtin_amdgcn_permlane32_swap(a0, b0, false, false); auto r1 = __builtin_amdgcn_permlane32_swap(a1, b1, false, false); \
        u32x4 w = {r0[0], r1[0], r0[1], r1[1]}; OUT = *reinterpret_cast<bf16x8*>(&w); } while (0)
    PK4(p0, 0, pa0); PK4(p0, 8, pa1); PK4(p1, 0, pa2); PK4(p1, 8, pa3);
#undef PK4
}
template <int KB>
__device__ __forceinline__ void qkt(f32x16& p0, f32x16& p1, const ALDS char* K_lds, int r32, int hi, const bf16x8* qr, bool act) {
    if (!act) { const float NEG = -__builtin_inff();
#pragma unroll
        for (int r = 0; r < 16; ++r) { p0[r] = NEG; p1[r] = NEG; } return; }
    p0 = f32x16{}; p1 = f32x16{};
    const ALDS char* kb[4];
#pragma unroll
    for (int dd = 0; dd < 4; ++dd) kb[dd] = K_lds + KB * SHM_K + KSWZ(r32, (dd * 16 + hi * 8) * 2);
#pragma unroll
    for (int d0 = 0; d0 < 8; ++d0) { const ALDS char* a = kb[d0 & 3] + (d0 >> 2) * 128;
        bf16x8 b0 = *(const ALDS bf16x8*)(a);
        bf16x8 b1 = *(const ALDS bf16x8*)(a + 32 * 256);
        p0 = __builtin_amdgcn_mfma_f32_32x32x16_bf16(b0, qr[d0], p0, 0, 0, 0);
        p1 = __builtin_amdgcn_mfma_f32_32x32x16_bf16(b1, qr[d0], p1, 0, 0, 0); }
}
template <int VB>
__device__ __forceinline__ void pv_tile(f32x16* o, int vb0, bf16x8 pa0, bf16x8 pa1, bf16x8 pa2, bf16x8 pa3, bool act) {
    if (!act) return;
#define TRRD(dst, off) asm volatile("ds_read_b64_tr_b16 %0, %1 offset:%2" : "=&v"(dst) : "v"(vb0), "i"(off) : "memory")
#define PV_D0(d0) do { s16x4 l0, l1, l2, l3, h0, h1, h2, h3; constexpr int b_ = VB * SHM_V + v_rd_off(d0, 0, 0); \
        TRRD(l0, b_); TRRD(h0, b_ + 2048); TRRD(l1, b_ + 4096); TRRD(h1, b_ + 6144); TRRD(l2, b_ + 8192); TRRD(h2, b_ + 10240); TRRD(l3, b_ + 12288); TRRD(h3, b_ + 14336); \
        asm volatile("s_waitcnt lgkmcnt(0)" ::: "memory"); SBAR(); \
        o[d0] = __builtin_amdgcn_mfma_f32_32x32x16_bf16(pa0, (bf16x8){l0[0], l0[1], l0[2], l0[3], h0[0], h0[1], h0[2], h0[3]}, o[d0], 0, 0, 0);   \
        o[d0] = __builtin_amdgcn_mfma_f32_32x32x16_bf16(pa1, (bf16x8){l1[0], l1[1], l1[2], l1[3], h1[0], h1[1], h1[2], h1[3]}, o[d0], 0, 0, 0);   \
        o[d0] = __builtin_amdgcn_mfma_f32_32x32x16_bf16(pa2, (bf16x8){l2[0], l2[1], l2[2], l2[3], h2[0], h2[1], h2[2], h2[3]}, o[d0], 0, 0, 0);   \
        o[d0] = __builtin_amdgcn_mfma_f32_32x32x16_bf16(pa3, (bf16x8){l3[0], l3[1], l3[2], l3[3], h3[0], h3[1], h3[2], h3[3]}, o[d0], 0, 0, 0); } while (0)
    PV_D0(0); PV_D0(1); PV_D0(2); PV_D0(3);
#undef PV_D0
#undef TRRD
}
template <int MODE>
__device__ __forceinline__ void bias_mask(f32x16& p0, f32x16& p1, const ALDS char* lds, int kb, int qlo, int qpos, int hi, float cqs, bool act) {
    if (!act) return;
    if (MODE == 0) {
        const ALDS float* cs = (const ALDS float*)(lds + OFF_CUM) + kb + 4 * hi;
#pragma unroll
        for (int g = 0; g < 4; ++g) { const f32x4 c0 = *(const ALDS f32x4*)(cs + 8 * g), c1 = *(const ALDS f32x4*)(cs + 32 + 8 * g);
#pragma unroll
            for (int e = 0; e < 4; ++e) { p0[4 * g + e] += cqs - c0[e]; p1[4 * g + e] += cqs - c1[e]; } }
        if (kb + KVBLK - 1 > qlo) mask_tile(p0, p1, qpos - 4 * hi - kb);
    } else {
        const ALDS float* tb = (const ALDS float*)(lds + OFF_REL);
        if (qlo - (kb + KVBLK - 1) >= 256) { const float c = tb[319];
#pragma unroll
            for (int r = 0; r < 16; ++r) { p0[r] += c; p1[r] += c; } }
        else { const int d0 = qpos - kb - 4 * hi + 63;
#pragma unroll
            for (int r = 0; r < 16; ++r) { const int c = (r & 3) + 8 * (r >> 2);
                int i0 = d0 - c, i1 = d0 - c - 32; i0 = i0 > 319 ? 319 : i0; i1 = i1 > 319 ? 319 : i1; i1 = i1 < 0 ? 0 : i1; i0 = i0 < 0 ? 0 : i0;
                p0[r] += tb[i0]; p1[r] += tb[i1]; } }
    }
}

struct Seam { bf16x8 qr[8]; bf16x8 st_v0, st_v1, st_k0, st_k1; };
#define VMW() asm volatile("s_waitcnt vmcnt(0)" ::: "memory")
#define BL8(rs, vo, so) __builtin_bit_cast(bf16x8, __builtin_amdgcn_raw_buffer_load_b128(rs, vo, so, 0))
#define SLOAD_H(Kp, Vp, k0) do { S.st_v0 = BL8(rP, kvoff, (Vp) + (k0) * (PITCH * 2)); S.st_v1 = BL8(rP, kvoff, (Vp) + ((k0) + 32) * (PITCH * 2));              \
                         S.st_k0 = BL8(rP, kvoff, (Kp) + (k0) * (PITCH * 2)); S.st_k1 = BL8(rP, kvoff, (Kp) + ((k0) + 32) * (PITCH * 2)); } while (0)
#define SWRITE_HK(bf) do { *(ALDS bf16x8*)(K_lds + (bf) * SHM_K + kws) = S.st_k0; *(ALDS bf16x8*)(K_lds + (bf) * SHM_K + kws + 32 * 256) = S.st_k1; } while (0)
#define SWRITE_HV(bf) do { *(ALDS bf16x8*)(V_lds + (bf) * SHM_V + vst0) = S.st_v0; *(ALDS bf16x8*)(V_lds + (bf) * SHM_V + vst1) = S.st_v1; } while (0)
#define SWRITE_H(bf) do { SWRITE_HV(bf); SWRITE_HK(bf); } while (0)

template <int MODE>
__device__ __forceinline__ void attn_unit(const bf16* Pb, int Qo, int Kh, int Vh, bf16* Yb, int Oo, int P0, int j_lo, int j_hi, ALDS char* lds, int wid, int lane) {
    const int tid = wid * 64 + lane, r32 = lane & 31, hi = lane >> 5;
    const int NT = j_hi - j_lo;
    const int qlo = P0 + wid * QBLK, qpos = qlo + r32;
    ALDS char* V_lds = lds; ALDS char* K_lds = lds + 2 * SHM_V;
    ALDS float* ws = (ALDS float*)(lds + OFF_WS) + wid * 64; ALDS float* li_l = ws; ALDS float* al_l = ws + 32;
    float m_reg = -1e30f, l_reg = 0; f32x16 o[4] = {};
    const int sr = tid >> 4, sc = (tid & 15) * 8, vst0 = v_st(sr, sc), vst1 = v_st(32 + sr, sc), kws = KSWZ(sr, sc * 2);
    const int vb0 = (int)(unsigned)(size_t)V_lds + v_rd_base(lane);
    Seam S;
    const __amdgpu_buffer_rsrc_t rP = __builtin_amdgcn_make_buffer_rsrc((void*)Pb, 0, 0x7fffffff, 0x00020000);
    const __amdgpu_buffer_rsrc_t rO = __builtin_amdgcn_make_buffer_rsrc((void*)Yb, 0, 0x7fffffff, 0x00020000);
    const int kvoff = (sr * PITCH + sc) * 2;
#define KBASE(t) ((j_lo + (t)) * KVBLK)
#define ACT(t) (MODE == 0 ? (KBASE(t) <= qlo + QBLK - 1) : ((j_lo + (t)) <= (qlo >> 6) && (j_lo + (t)) + 8 >= (qlo >> 6)))
#define RESC(a) do { if (__any((a) < 1.f)) { if (hi == 0) al_l[r32] = (a); asm volatile("s_waitcnt lgkmcnt(0)" ::: "memory");              \
                     for (int d_ = 0; d_ < 4; ++d_) for (int r = 0; r < 16; ++r) o[d_][r] *= al_l[crow(r, hi)]; } } while (0)
#define MASKT(P0_, P1_, t) bias_mask<MODE>(P0_, P1_, lds, KBASE(t), qlo, qpos, hi, cq_, ACT(t))
    {
        const int kb0 = j_lo * KVBLK;
#pragma unroll
        for (int d0 = 0; d0 < 8; ++d0) S.qr[d0] = BL8(rP, (r32 * PITCH + hi * 8) * 2 + d0 * 32, Qo + wid * (QBLK * PITCH * 2));
        SLOAD_H(Kh, Vh, kb0); VMW(); SWRITE_HK(0);
        __syncthreads();
    }
    const float cq_ = MODE == 0 ? ((const ALDS float*)(lds + OFF_CUM))[qpos] : 0.f;
    f32x16 pA0, pA1, pB0, pB1; float mnA, mnB, alA, alB; bf16x8 pa0, pa1, pa2, pa3;
    SWRITE_HV(0); SBAR();
    if (NT > 1) { SLOAD_H(Kh, Vh, KBASE(1)); }
    SBAR(); qkt<0>(pA0, pA1, K_lds, r32, hi, S.qr, ACT(0));
    MASKT(pA0, pA1, 0); partialSM(pA0, pA1, m_reg, mnA, alA);
    if (NT > 1) { VMW(); SWRITE_H(1); }
    __syncthreads();
#define HALF_STEP(PX0, PX1, mnX, alX, PY0, PY1, alY, t, KB, VB, SB) do {                                                      \
        SBAR(); qkt<KB>(PX0, PX1, K_lds, r32, hi, S.qr, ACT(t));                                                              \
        finishSM(PY0, PY1, alY, l_reg, pa0, pa1, pa2, pa3); SBAR();                                                           \
        if ((t) + 1 < NT) { SLOAD_H(Kh, Vh, KBASE((t) + 1)); SBAR(); }                                                        \
        pv_tile<VB>(o, vb0, pa0, pa1, pa2, pa3, ACT((t) - 1)); MASKT(PX0, PX1, (t)); partialSM(PX0, PX1, m_reg, mnX, alX);    \
        __syncthreads();                                                                                                      \
        if ((t) + 1 < NT) { VMW(); SWRITE_H(SB); }                                                                            \
        RESC(alX); __syncthreads(); } while (0)
    for (int t = 1; t + 1 < NT; t += 2) {
        HALF_STEP(pB0, pB1, mnB, alB, pA0, pA1, alA, t, 1, 0, 0);
        HALF_STEP(pA0, pA1, mnA, alA, pB0, pB1, alB, t + 1, 0, 1, 1);
    }
    const bool even = (NT & 1) == 0;
    if (even) { SBAR(); qkt<1>(pB0, pB1, K_lds, r32, hi, S.qr, ACT(NT - 1)); SBAR(); }
    finishSM(pA0, pA1, alA, l_reg, pa0, pa1, pa2, pa3); SBAR();
    pv_tile<0>(o, vb0, pa0, pa1, pa2, pa3, ACT(even ? NT - 2 : NT - 1));
    if (even) { MASKT(pB0, pB1, NT - 1); partialSM(pB0, pB1, m_reg, mnB, alB); __syncthreads(); RESC(alB);
        finishSM(pB0, pB1, alB, l_reg, pa0, pa1, pa2, pa3); SBAR(); pv_tile<1>(o, vb0, pa0, pa1, pa2, pa3, ACT(NT - 1)); }
    SBAR();
    if (hi == 0) li_l[r32] = l_reg; asm volatile("s_waitcnt lgkmcnt(0)" ::: "memory");
    float rli[16];
#pragma unroll
    for (int r = 0; r < 16; ++r) rli[r] = __builtin_amdgcn_rcpf(li_l[crow(r, hi)]);
    const int ovoff = (4 * hi * OPITCH + r32) * 2, osoff = Oo + wid * (QBLK * OPITCH * 2);
#pragma unroll
    for (int r = 0; r < 16; ++r) { const int orow = (r & 3) + 8 * (r >> 2);
#pragma unroll
        for (int d0 = 0; d0 < 4; ++d0) { const float v = o[d0][r] * rli[r];
            const float vn = __builtin_bit_cast(float, __builtin_amdgcn_ds_bpermute((lane ^ 1) << 2, __builtin_bit_cast(int, v)));
            if ((r32 & 1) == 0) __builtin_amdgcn_raw_buffer_store_b32(cvtpk(v, vn), rO, ovoff + d0 * 64, osoff + orow * (OPITCH * 2), 0); } }
    __syncthreads();
#undef RESC
#undef KBASE
#undef ACT
#undef MASKT
#undef HALF_STEP
}
#undef BL8
#undef VMW
#undef SLOAD_H
#undef SWRITE_HK
#undef SWRITE_HV
#undef SWRITE_H
#undef KSWZ
#undef SBAR
}
constexpr size_t WS_QCTR = 768 * 1024;
constexpr size_t WS_POOLW = 4 * MiB;
constexpr int N_ATT_UNITS = 256, N_POOL_UNITS = 512, N_CONV_UNITS = 128, N_GATE_UNITS = 512;

__device__ __forceinline__ void stage_cum(const Args& a, int b, int h, LAS char* lds, int wave, int lane) {
    const float* logf = (const float*)(a.ws + WS_LOGF) + ((size_t)b * SEQ) * 4 + h;
    const int tid = wave * 64 + lane;
    float v[4];
#pragma unroll
    for (int e = 0; e < 4; ++e) v[e] = logf[(size_t)(4 * tid + e) * 4];
    v[1] += v[0]; v[2] += v[1]; v[3] += v[2];
    float incl = v[3];
#pragma unroll
    for (int o = 1; o < 64; o <<= 1) { const float t = shf(incl, lane >= o ? lane - o : lane); if (lane >= o) incl += t; }
    LAS float* wt = (LAS float*)(lds + att::OFF_WS);
    if (lane == 63) wt[wave] = incl;
    __syncthreads();
    float base = incl - v[3];
    for (int w = 0; w < wave; ++w) base += wt[w];
    LAS float* cs = (LAS float*)(lds + att::OFF_CUM);
    const float inv = 1.0f / ATT_SCALE;
    *(LAS f32x4*)(cs + 4 * tid) = (f32x4){(base + v[0]) * inv, (base + v[1]) * inv, (base + v[2]) * inv, (base + v[3]) * inv};
    __syncthreads();
}
__device__ __forceinline__ void attention_item(const Args& a, int l, int u, LAS char* lds, int wave) {
    int lane; asm volatile("v_mbcnt_lo_u32_b32 %0, -1, 0\n\tv_mbcnt_hi_u32_b32 %0, -1, %0" : "=v"(lane));
    const bf16* P = (const bf16*)(a.ws + WS_PROJ); bf16* Y = (bf16*)(a.ws + WS_Y);
    const int mode = u >> 7, v = u & 127, qb = 7 - (v >> 4), bh = v & 15, b = bh >> 2, h = bh & 3;
    const size_t row0 = (size_t)b * SEQ; const int P0 = qb * 256;
    if (mode == 0) {
        stage_cum(a, b, h, lds, wave, lane);
        att::attn_unit<0>(P, (int)((0 * PROJ_T + (row0 + P0) * MIXW + h * HD) * 2), (int)((1 * PROJ_T + row0 * MIXW + h * HD) * 2), (int)((2 * PROJ_T + row0 * MIXW + h * HD) * 2),
                          Y, (int)(((row0 + P0) * D + h * HD) * 2), P0, 0, 4 * qb + 4, lds, wave, lane);
    } else {
        const int tid = wave * 64 + lane;
        if (tid < 320) ((LAS float*)(lds + att::OFF_REL))[tid] = a.rel_bias[((size_t)l * 4 + h) * 320 + tid] * (1.0f / ATT_SCALE);
        const int jlo = 4 * qb - 8 < 0 ? 0 : 4 * qb - 8;
        att::attn_unit<1>(P, (int)((7 * PROJ_T + (row0 + P0) * MIXW + h * HD) * 2), (int)((8 * PROJ_T + row0 * MIXW + h * HD) * 2), (int)((9 * PROJ_T + row0 * MIXW + h * HD) * 2),
                          Y, (int)(((row0 + P0) * D + 1536 + h * HD) * 2), P0, jlo, 4 * qb + 4, lds, wave, lane);
    }
}
__device__ __forceinline__ void pool_item(const Args& a, int l, int u, LAS char* lds, int wave) {
    int lane; asm volatile("v_mbcnt_lo_u32_b32 %0, -1, 0\n\tv_mbcnt_hi_u32_b32 %0, -1, %0" : "=v"(lane));
    const int g = u & 3, T0 = (u >> 2) * 64, tid = wave * 64 + lane;
    const bf16* Pin = (const bf16*)(a.ws + WS_PROJ) + 3 * PROJ_T + g * 128;
    {
        const int cp = tid & 63, run = tid >> 6, w = 2 << g, t0 = T0 + run * 8, s0 = t0 & (SEQ - 1);
        const bf16* col = Pin + 2 * cp;
        float s_lo = 0.f, s_hi = 0.f;
        for (int j = 1; j < w; ++j) if (s0 - j >= 0) { const unsigned x = *(const unsigned*)(col + (size_t)(t0 - j) * MIXW); s_lo += bflo(x); s_hi += bfhi(x); }
#pragma unroll
        for (int i = 0; i < 8; ++i) { const unsigned x = *(const unsigned*)(col + (size_t)(t0 + i) * MIXW); s_lo += bflo(x); s_hi += bfhi(x);
            const int s = s0 + i; const int cnt = s + 1 < w ? s + 1 : w; const float inv = 1.0f / (float)cnt;
            *(LAS unsigned*)(lds + (run * 8 + i) * 272 + 4 * cp) = pk2(s_lo * inv - bflo(x), s_hi * inv - bfhi(x));
            if (s - w + 1 >= 0) { const unsigned y = *(const unsigned*)(col + (size_t)(t0 + i - w + 1) * MIXW); s_lo -= bflo(y); s_hi -= bfhi(y); } }
    }
    __syncthreads();
    {
        typedef short bf16x8 __attribute__((ext_vector_type(8)));
        const bf16* Wt = (const bf16*)(a.ws + WS_POOLW) + ((size_t)l * 4 + g) * 128 * 128;
        const int rt = (wave & 3) * 16, db = (wave >> 2) * 64, fr = lane & 15, kg = lane >> 4;
        f32x4 acc[4] = {};
#pragma unroll
        for (int ks = 0; ks < 4; ++ks) { const bf16x8 af = *(const LAS bf16x8*)(lds + (rt + fr) * 272 + (ks * 32 + kg * 8) * 2);
#pragma unroll
            for (int nt = 0; nt < 4; ++nt) { const bf16x8 bfr = *(const bf16x8*)(Wt + (size_t)(db + nt * 16 + fr) * 128 + ks * 32 + kg * 8);
                acc[nt] = __builtin_amdgcn_mfma_f32_16x16x32_bf16(bfr, af, acc[nt], 0, 0, 0); } }
        bf16* Y = (bf16*)(a.ws + WS_Y) + (size_t)(T0 + rt + fr) * D + 512 + g * 128;
#pragma unroll
        for (int nt = 0; nt < 4; ++nt) { const int d = db + nt * 16 + kg * 4; const f32x4 sc = *(const f32x4*)(a.pool_scale + l * MIXW + g * 128 + d);
            v2u w; w.x = pk2(acc[nt][0] * sc[0], acc[nt][1] * sc[1]); w.y = pk2(acc[nt][2] * sc[2], acc[nt][3] * sc[3]); *(v2u*)(Y + d) = w; }
    }
    __syncthreads();
}
__device__ __forceinline__ void conv_item(const Args& a, int l, int u, int wave) {
    int lane; asm volatile("v_mbcnt_lo_u32_b32 %0, -1, 0\n\tv_mbcnt_hi_u32_b32 %0, -1, %0" : "=v"(lane));
    const bf16* P = (const bf16*)(a.ws + WS_PROJ); const bf16* Ch = P + 4 * PROJ_T; const bf16* Cb = P + 5 * PROJ_T; const bf16* Cc = P + 6 * PROJ_T;
    const int tid = wave * 64 + lane, c0 = (tid & 63) * 8, t0 = u * 64 + (tid >> 6) * 8, s0 = t0 & (SEQ - 1);
    float wgt[3][8];
#pragma unroll
    for (int j = 0; j < 3; ++j) { const float* w = a.conv_w + ((size_t)l * 3 + j) * MIXW + c0; const f32x4 w0 = *(const f32x4*)w, w1 = *(const f32x4*)(w + 4);
#pragma unroll
        for (int k = 0; k < 4; ++k) { wgt[j][k] = w0[k]; wgt[j][4 + k] = w1[k]; } }
    float z2[8], z1[8];
#pragma unroll
    for (int k = 0; k < 8; ++k) { z2[k] = 0.f; z1[k] = 0.f; }
#pragma unroll
    for (int i = -2; i < 8; ++i) {
        float z[8];
        if (s0 + i >= 0) { const v4u hv = *(const v4u*)(Ch + (size_t)(t0 + i) * MIXW + c0), cv = *(const v4u*)(Cc + (size_t)(t0 + i) * MIXW + c0);
            z[0] = bflo(hv.x) * bflo(cv.x); z[1] = bfhi(hv.x) * bfhi(cv.x); z[2] = bflo(hv.y) * bflo(cv.y); z[3] = bfhi(hv.y) * bfhi(cv.y);
            z[4] = bflo(hv.z) * bflo(cv.z); z[5] = bfhi(hv.z) * bfhi(cv.z); z[6] = bflo(hv.w) * bflo(cv.w); z[7] = bfhi(hv.w) * bfhi(cv.w); }
        else {
#pragma unroll
            for (int k = 0; k < 8; ++k) z[k] = 0.f; }
        if (i >= 0) { const v4u bv = *(const v4u*)(Cb + (size_t)(t0 + i) * MIXW + c0); float o[8];
            const float bb[8] = {bflo(bv.x), bfhi(bv.x), bflo(bv.y), bfhi(bv.y), bflo(bv.z), bfhi(bv.z), bflo(bv.w), bfhi(bv.w)};
#pragma unroll
            for (int k = 0; k < 8; ++k) o[k] = bb[k] * (wgt[0][k] * z2[k] + wgt[1][k] * z1[k] + wgt[2][k] * z[k]);
            v4u ov; ov.x = pk2(o[0], o[1]); ov.y = pk2(o[2], o[3]); ov.z = pk2(o[4], o[5]); ov.w = pk2(o[6], o[7]);
            *(v4u*)((bf16*)(a.ws + WS_Y) + (size_t)(t0 + i) * D + 1024 + c0) = ov; }
#pragma unroll
        for (int k = 0; k < 8; ++k) { z2[k] = z1[k]; z1[k] = z[k]; }
    }
}
__device__ __forceinline__ void gate_item(const Args& a, int u, int wave) {
    int lane; asm volatile("v_mbcnt_lo_u32_b32 %0, -1, 0\n\tv_mbcnt_hi_u32_b32 %0, -1, %0" : "=v"(lane));
    const bf16* G = (const bf16*)(a.ws + WS_G); bf16* R = (bf16*)(a.ws + WS_R);
    const int tid = wave * 64 + lane;
#pragma unroll 2
    for (int i = 0; i < 8; ++i) { const int e = tid + 512 * i, row = u * 16 + (e >> 8), d0 = (e & 255) * 8;
        const bf16* gp = G + (size_t)row * (4 * D) + d0; v4u z[4];
#pragma unroll
        for (int g = 0; g < 4; ++g) z[g] = *(const v4u*)(gp + g * D);
        float E[4][8], I[4][8];
#pragma unroll
        for (int g = 0; g < 4; ++g) { const unsigned w[4] = {z[g].x, z[g].y, z[g].z, z[g].w};
#pragma unroll
            for (int k = 0; k < 4; ++k) { E[g][2 * k] = fminf(1.0f + __builtin_amdgcn_exp2f(-1.4426950408889634f * bflo(w[k])), 1e18f); E[g][2 * k + 1] = fminf(1.0f + __builtin_amdgcn_exp2f(-1.4426950408889634f * bfhi(w[k])), 1e18f); }
#pragma unroll
            for (int k = 0; k < 8; ++k) I[g][k] = __builtin_amdgcn_rcpf(E[g][k]); }
#pragma unroll
        for (int g = 0; g < 4; ++g) { float r[8];
#pragma unroll
            for (int k = 0; k < 8; ++k) r[k] = g < 3 ? E[g + 1][k] * I[g][k] : I[3][k];
            v4u o; o.x = pk2(r[0], r[1]); o.y = pk2(r[2], r[3]); o.z = pk2(r[4], r[5]); o.w = pk2(r[6], r[7]);
            *(v4u*)(R + (size_t)g * R_PLANE + (size_t)row * D + d0) = o; } }
}
__device__ __forceinline__ void mixers_fast(const Args& a, int lq, LAS char* lds, int wave, int lane, int G, int blk) {
    const int l = lq & 1;
    for (int u = blk; u < N_ATT_UNITS; u += G) attention_item(a, l, u, lds, wave);
    unsigned* head = (unsigned*)(a.ws + WS_QCTR) + 64 * lq;
    volatile LAS unsigned* slot = (volatile LAS unsigned*)(lds + att::LDS_END);
    for (;;) {
        if (wave == 0 && lane == 0) *slot = __hip_atomic_fetch_add(head, 1u, __ATOMIC_RELAXED, __HIP_MEMORY_SCOPE_AGENT);
        __syncthreads();
        const unsigned it = *slot;
        __syncthreads();
        if (it >= (unsigned)(N_POOL_UNITS + N_CONV_UNITS)) break;
        if (it < (unsigned)N_POOL_UNITS) pool_item(a, l, (int)it, lds, wave); else if (it < (unsigned)(N_POOL_UNITS + N_CONV_UNITS)) conv_item(a, l, (int)it - N_POOL_UNITS, wave); else gate_item(a, (int)it - N_POOL_UNITS - N_CONV_UNITS, wave);
    }
}
__device__ __forceinline__ void p0_cmax(const Args& a, int gw, int NGW, int lane) {
    unsigned char* ws = a.ws;
    {
        constexpr int NCC = (INW + 255) / 256;
        for (int it = gw; it < DEPTH * 32 * NCC; it += NGW) { const int l = it / (32 * NCC), r = it % (32 * NCC), kc = r / NCC, cc = r % NCC; const int c0 = cc * 256 + 4 * lane;
            if (c0 + 3 < INW) { const float* W = a.w_in + (size_t)l * D * INW + (size_t)(kc * 64) * INW + c0; const float* g = a.norm_mix + l * D + kc * 64;
                float m0 = 0.f, m1 = 0.f, m2 = 0.f, m3 = 0.f;
#pragma unroll 8
                for (int k = 0; k < 64; ++k) { const f32x4 w = *(const f32x4*)(W + (size_t)k * INW); const float gk = fabsf(g[k]);
                    m0 = fmaxf(m0, fabsf(w[0]) * gk); m1 = fmaxf(m1, fabsf(w[1]) * gk); m2 = fmaxf(m2, fabsf(w[2]) * gk); m3 = fmaxf(m3, fabsf(w[3]) * gk); }
                unsigned* cm = (unsigned*)(ws + WS_CMAX) + l * INW + c0;
                const unsigned u0 = __float_as_uint(m0), u1 = __float_as_uint(m1), u2 = __float_as_uint(m2), u3 = __float_as_uint(m3);
                __hip_atomic_fetch_max(cm + 0, u0, __ATOMIC_RELAXED, __HIP_MEMORY_SCOPE_AGENT); __hip_atomic_fetch_max(cm + 1, u1, __ATOMIC_RELAXED, __HIP_MEMORY_SCOPE_AGENT);
                __hip_atomic_fetch_max(cm + 2, u2, __ATOMIC_RELAXED, __HIP_MEMORY_SCOPE_AGENT); __hip_atomic_fetch_max(cm + 3, u3, __ATOMIC_RELAXED, __HIP_MEMORY_SCOPE_AGENT); } }
    }
}
__device__ __forceinline__ void p0_prologue(const Args& a, LAS unsigned char* lds, int gw, int NGW, int wave, int lane) {
    unsigned char* ws = a.ws;
    LAS float* scr = (LAS float*)(lds + wave * 16384);
    constexpr int I_SQ = (D / 64) * (D / 32), I_BR = (MIXW / 64) * (D / 32);
    constexpr int I_LAYER = 4 * I_BR + 2 * I_SQ;
    for (int it = gw; it < DEPTH * I_LAYER; it += NGW) {
        const int l = it / I_LAYER; int r = it - l * I_LAYER;
        if (r < 4 * I_BR) { const int g = r / I_BR, rr = r % I_BR, kb = rr / (D / 32), nb = rr % (D / 32);
            tr_item<false>(a.w_branch + ((size_t)l * 4 + g) * MIXW * D, D, nullptr, (bf16*)(ws + WS_WBR + l * SQ_BYTES), D, g * MIXW, scr, 64 * kb, 32 * nb, lane); continue; }
        r -= 4 * I_BR;
        if (r < I_SQ) { const int kb = r / (D / 32), nb = r % (D / 32);
            tr_item<false>(a.w_out + (size_t)l * D * D, D, nullptr, (bf16*)(ws + WS_WOUT + l * SQ_BYTES), D, 0, scr, 64 * kb, 32 * nb, lane); continue; }
        r -= I_SQ;
        { const int kb = r / (D / 32), nb = r % (D / 32);
            tr_item<false>(a.peer_wq + (size_t)l * D * D, D, a.norm_ffn + l * D, (bf16*)(ws + WS_WQ + l * SQ_BYTES), D, 0, scr, 64 * kb, 32 * nb, lane); }
    }
    for (int it = gw; it < DEPTH * 4 * 8; it += NGW) { const int lg = it >> 3, r = it & 7;
        tr_item<false>(a.pool_w + (size_t)lg * 128 * 128, 128, nullptr, (bf16*)(ws + WS_POOLW) + (size_t)lg * 128 * 128, 128, 0, scr, 64 * (r >> 2), 32 * (r & 3), lane); }
    {
        constexpr int NR = 2 * DEPTH * PEER_E;
        f32x4 nv[8];
        if (gw < NR) { const int t = gw / (DEPTH * PEER_E), row = gw - t * (DEPTH * PEER_E); const float* src = (t ? a.peer_v : a.peer_u) + (size_t)row * D + 4 * lane;
#pragma unroll
            for (int j = 0; j < 8; ++j) nv[j] = *(const f32x4*)(src + 256 * j); }
        for (int r = gw; r < NR; r += NGW) { const int t = r / (DEPTH * PEER_E), row = r - t * (DEPTH * PEER_E);
            f32x4 v[8]; float am = 0.f;
#pragma unroll
            for (int j = 0; j < 8; ++j) v[j] = nv[j];
            { const int r2 = r + NGW; if (r2 < NR) { const int t2 = r2 / (DEPTH * PEER_E), row2 = r2 - t2 * (DEPTH * PEER_E); const float* src = (t2 ? a.peer_v : a.peer_u) + (size_t)row2 * D + 4 * lane;
#pragma unroll
                for (int j = 0; j < 8; ++j) nv[j] = *(const f32x4*)(src + 256 * j); } }
#pragma unroll
            for (int j = 0; j < 8; ++j) am = fmaxf(am, fmaxf(fmaxf(fabsf(v[j][0]), fabsf(v[j][1])), fmaxf(fabsf(v[j][2]), fabsf(v[j][3]))));
            am = wave_max(am, lane);
            const float inv = am > 0.f ? 127.0f / am : 0.f, off = 0.f;
            unsigned char* dst = ws + (t ? WS_PV : WS_PU) + (size_t)row * D + 4 * lane;
#pragma unroll
            for (int j = 0; j < 8; ++j) { const int q0 = (int)(rintf(v[j][0] * inv) + off), q1 = (int)(rintf(v[j][1] * inv) + off), q2 = (int)(rintf(v[j][2] * inv) + off), q3 = (int)(rintf(v[j][3] * inv) + off);
                *(unsigned*)(dst + 256 * j) = (unsigned)(q0 & 255) | ((unsigned)(q1 & 255) << 8) | ((unsigned)(q2 & 255) << 16) | ((unsigned)(q3 & 255) << 24); }
            if (lane == 0) ((float*)(ws + (t ? WS_SV : WS_SU)))[row] = am * (1.0f / 127.0f); }
    }
    { bf16* pk = (bf16*)(ws + WS_PK); const size_t n8 = (size_t)DEPTH * 8 * 2 * 128 * 128 / 8;
      for (size_t i = (size_t)gw * 64 + lane; i < n8; i += (size_t)NGW * 64) { const f32x4 v0 = *(const f32x4*)(a.peer_keys + i * 8), v1 = *(const f32x4*)(a.peer_keys + i * 8 + 4);
          v4u o; o.x = pk2(v0[0], v0[1]); o.y = pk2(v0[2], v0[3]); o.z = pk2(v1[0], v1[1]); o.w = pk2(v1[2], v1[3]); *(v4u*)(pk + i * 8) = o; } }
    {
        float* wf = (float*)(ws + WS_WF); float* binr = (float*)(ws + WS_BINR);
        const int gt = gw * 64 + lane, NGT = NGW * 64;
        for (int i = gt; i < DEPTH * 4 * D; i += NGT) { const int l = i / (4 * D), h = (i / D) & 3, k = i % D; wf[i] = a.w_in[(size_t)l * D * INW + (size_t)k * INW + 1536 + h] * a.norm_mix[l * D + k]; }
        for (int i = gt; i < DEPTH * NPROJ; i += NGT) { const int l = i / NPROJ, j = i % NPROJ; binr[i] = a.b_in[l * INW + colmap_in(j)]; }
    }
    {
        unsigned long long* ssq = (unsigned long long*)(ws + WS_SSQ);
        for (int m = gw; m < M; m += NGW) { float s = 0.f, am = 0.f; f32x4 v[8];
#pragma unroll
            for (int j = 0; j < 8; ++j) { const size_t o = (size_t)m * D + j * 256 + lane * 4; v[j] = *(const f32x4*)(a.x + o); s += (v[j][0] * v[j][0] + v[j][1] * v[j][1]) + (v[j][2] * v[j][2] + v[j][3] * v[j][3]);
                am = fmaxf(am, fmaxf(fmaxf(fabsf(v[j][0]), fabsf(v[j][1])), fmaxf(fabsf(v[j][2]), fabsf(v[j][3])))); }
            s = wave_sum(s, lane); am = wave_max(am, lane); if (lane == 0) { ssq[m] = (unsigned long long)((double)s * 4294967296.0); ((float*)(ws + WS_RSA))[m] = rsqrtf(s * (1.0f / D) + EPS) * am * (1.0f / 127.0f); }
            const float inv = am > 0.f ? 127.0f / am : 0.f; unsigned char* q8 = ws + WS_HB8 + (size_t)m * D + 4 * lane;
#pragma unroll
            for (int j = 0; j < 8; ++j) *(unsigned*)(q8 + 256 * j) = ((unsigned)((int)rintf(v[j][0] * inv) & 255)) | ((unsigned)((int)rintf(v[j][1] * inv) & 255) << 8) | ((unsigned)((int)rintf(v[j][2] * inv) & 255) << 16) | ((unsigned)((int)rintf(v[j][3] * inv) & 255) << 24); }
    }
}
__device__ __forceinline__ void p0_win_i8(const Args& a, LAS unsigned char* lds, int gw, int NGW, int wave, int lane) {
    unsigned char* ws = a.ws; LAS float* scr = (LAS float*)(lds + wave * 16384);
    constexpr int I_WIN = (D / 64) * (NPROJ / 32);
    for (int it = gw; it < DEPTH * I_WIN; it += NGW) { const int l = it / I_WIN, r = it % I_WIN, kb = r / (NPROJ / 32), nb = r % (NPROJ / 32);
        tr_item_i8(a.w_in + (size_t)l * D * INW, a.norm_mix + l * D, (const unsigned*)(ws + WS_CMAX) + l * INW, ws + WS_WIN + l * WIN_BYTES, scr, 64 * kb, 32 * nb, lane); }
    float* sw = (float*)(ws + WS_SW); const int gt = gw * 64 + lane, NGT = NGW * 64;
    bf16* swh = (bf16*)(ws + WS_SWH); bf16* bih = (bf16*)(ws + WS_BIH);
    for (int i = gt; i < DEPTH * NPROJ; i += NGT) { const int l = i / NPROJ, j = i % NPROJ; const float s = __builtin_bit_cast(float, ((const unsigned*)(ws + WS_CMAX))[l * INW + colmap_in(j)]) * (1.0f / 127.0f);
        sw[i] = s; swh[i] = (bf16)f2bf(s); bih[i] = (bf16)f2bf(a.b_in[l * INW + colmap_in(j)]); }
}
__device__ __forceinline__ void quant_rows(const Args& a, int l, int gw, int NGW, int lane) {
    unsigned char* ws = a.ws; const float* H = (const float*)(ws + WS_H);
    for (int m = gw; m < M; m += NGW) { float am = 0.f; f32x4 v[8];
#pragma unroll
        for (int j = 0; j < 8; ++j) { v[j] = *(const f32x4*)(H + (size_t)m * D + j * 256 + lane * 4); am = fmaxf(am, fmaxf(fmaxf(fabsf(v[j][0]), fabsf(v[j][1])), fmaxf(fabsf(v[j][2]), fabsf(v[j][3])))); }
        am = wave_max(am, lane); if (lane == 0) ((float*)(ws + WS_RSA))[m] = rsqrtf(ssa_to_f(((const unsigned long long*)(ws + WS_SSQ))[(size_t)l * M + m]) * (1.0f / D) + EPS) * am * (1.0f / 127.0f);
        const float inv = am > 0.f ? 127.0f / am : 0.f; unsigned char* q8 = ws + WS_HB8 + (size_t)m * D + 4 * lane;
#pragma unroll
        for (int j = 0; j < 8; ++j) *(unsigned*)(q8 + 256 * j) = ((unsigned)((int)rintf(v[j][0] * inv) & 255)) | ((unsigned)((int)rintf(v[j][1] * inv) & 255) << 8) | ((unsigned)((int)rintf(v[j][2] * inv) & 255) << 16) | ((unsigned)((int)rintf(v[j][3] * inv) & 255) << 24); }
}

__device__ __forceinline__ void forget_logits(const Args& a, int l, int gw, int NGW, int lane) {
    unsigned char* ws = a.ws; const bf16* HB = (const bf16*)(ws + WS_HB); const float* wf = (const float*)(ws + WS_WF) + l * 4 * D; const unsigned long long* ssq = (const unsigned long long*)(ws + WS_SSQ) + l * M;
    float* logf = (float*)(ws + WS_LOGF);
    for (int m = gw; m < M; m += NGW) {
        float d[4] = {0.f, 0.f, 0.f, 0.f};
#pragma unroll
        for (int j = 0; j < 4; ++j) { const int k0 = j * 512 + lane * 8; float x[8];
            if (l == 0) { const f32x4 x0 = *(const f32x4*)(a.x + (size_t)m * D + k0), x1 = *(const f32x4*)(a.x + (size_t)m * D + k0 + 4); x[0] = x0[0]; x[1] = x0[1]; x[2] = x0[2]; x[3] = x0[3]; x[4] = x1[0]; x[5] = x1[1]; x[6] = x1[2]; x[7] = x1[3]; }
            else { const v4u xv = *(const v4u*)(HB + (size_t)m * D + k0); x[0] = bflo(xv.x); x[1] = bfhi(xv.x); x[2] = bflo(xv.y); x[3] = bfhi(xv.y); x[4] = bflo(xv.z); x[5] = bfhi(xv.z); x[6] = bflo(xv.w); x[7] = bfhi(xv.w); }
#pragma unroll
            for (int h = 0; h < 4; ++h) { const f32x4 w0 = *(const f32x4*)(wf + h * D + k0), w1 = *(const f32x4*)(wf + h * D + k0 + 4);
                d[h] += x[0] * w0[0] + x[1] * w0[1] + x[2] * w0[2] + x[3] * w0[3] + x[4] * w1[0] + x[5] * w1[1] + x[6] * w1[2] + x[7] * w1[3]; } }
        const float rs = rsqrtf(ssa_to_f(ssq[m]) * (1.0f / D) + EPS);
#pragma unroll
        for (int h = 0; h < 4; ++h) { const float z = wave_sum(d[h], lane) * rs + a.b_in[l * INW + 1536 + h];
            const float ls = fminf(z, 0.f) - log1pf(__expf(-fabsf(z)));
            if (lane == h) logf[m * 4 + h] = ls; }
    }
}
__device__ __forceinline__ void cum_scan(const Args& a, int gw, int lane) {
    if (gw >= 16) return;
    const float* logf = (const float*)(a.ws + WS_LOGF); float* cum = (float*)(a.ws + WS_CUM);
    const int b = gw >> 2, h = gw & 3; float run = 0.f;
    for (int c = 0; c < SEQ / 64; ++c) { float v = logf[(size_t)(b * SEQ + c * 64 + lane) * 4 + h];
#pragma unroll
        for (int o = 1; o < 64; o <<= 1) { const float t = shf(v, lane >= o ? lane - o : lane); if (lane >= o) v += t; }
        v += run; cum[(size_t)gw * SEQ + c * 64 + lane] = v; run = shf(v, 63); }
}

template <int MODE>
__device__ __forceinline__ void naive_attn(const Args& a, int l, int b, int h, int s, LAS float* sc, int lane) {
    const unsigned char* ws = a.ws; const bf16* P = (const bf16*)(ws + WS_PROJ);
    const bf16* Qp = P + (MODE ? 7 : 0) * PROJ_T; const bf16* Kp = P + (MODE ? 8 : 1) * PROJ_T; const bf16* Vp = P + (MODE ? 9 : 2) * PROJ_T;
    const float* cum = (const float*)(ws + WS_CUM) + (size_t)(b * 4 + h) * SEQ;
    const float* rb = a.rel_bias + ((size_t)l * 4 + h) * 320;
    const size_t tb = (size_t)b * SEQ;
    int klo = 0, khi = s;
    if (MODE) { const int c = s >> 6; klo = (c - 8) * 64; if (klo < 0) klo = 0; khi = c * 64 + 63; }
    const bf16* qrow = Qp + (tb + s) * MIXW + h * HD;
    float mx = -3.0e38f;
    for (int kb = klo; kb <= khi; kb += 64) { const int k = kb + lane;
        if (k <= khi) { const bf16* krow = Kp + (tb + k) * MIXW + h * HD; float d = 0.f;
#pragma unroll 4
            for (int c8 = 0; c8 < 16; ++c8) { const v4u qv = *(const v4u*)(qrow + c8 * 8), kv = *(const v4u*)(krow + c8 * 8);
                d = dot2_bf16(qv.x, kv.x, d); d = dot2_bf16(qv.y, kv.y, d); d = dot2_bf16(qv.z, kv.z, d); d = dot2_bf16(qv.w, kv.w, d); }
            float bias;
            if (MODE == 0) bias = cum[s] - cum[k];
            else { int rel = s - k; rel = rel < -63 ? -63 : (rel > 256 ? 256 : rel); bias = rb[rel + 63]; }
            const float lg = d * ATT_SCALE + bias; sc[k - klo] = lg; mx = fmaxf(mx, lg); } }
    mx = wave_max(mx, lane);
    asm volatile("s_waitcnt lgkmcnt(0)" ::: "memory");
    float sum = 0.f;
    for (int kb = klo; kb <= khi; kb += 64) { const int k = kb + lane; if (k <= khi) { const float p = __expf(sc[k - klo] - mx); sc[k - klo] = p; sum += p; } }
    sum = wave_sum(sum, lane);
    asm volatile("s_waitcnt lgkmcnt(0)" ::: "memory");
    float o0 = 0.f, o1 = 0.f;
    for (int k = klo; k <= khi; ++k) { const float p = sc[k - klo]; const unsigned v = *(const unsigned*)(Vp + (tb + k) * MIXW + h * HD + 2 * lane); o0 += p * bflo(v); o1 += p * bfhi(v); }
    const float inv = 1.0f / sum;
    bf16* Y = (bf16*)(a.ws + WS_Y);
    *(unsigned*)(Y + (tb + s) * D + (MODE ? 1536 : 0) + h * HD + 2 * lane) = pk2(o0 * inv, o1 * inv);
    asm volatile("s_waitcnt lgkmcnt(0)" ::: "memory");
}
__device__ __forceinline__ void naive_pool(const Args& a, int l, int t, int g, LAS float* sc, int lane) {
    const bf16* Pin = (const bf16*)(a.ws + WS_PROJ) + 3 * PROJ_T;
    const int s = t & (SEQ - 1), w = 2 << g; const int cnt = (s + 1 < w) ? s + 1 : w;
    float s0 = 0.f, s1 = 0.f;
    for (int j = 0; j < cnt; ++j) { const unsigned v = *(const unsigned*)(Pin + (size_t)(t - j) * MIXW + g * 128 + 2 * lane); s0 += bflo(v); s1 += bfhi(v); }
    const unsigned v0 = *(const unsigned*)(Pin + (size_t)t * MIXW + g * 128 + 2 * lane);
    const float inv = 1.0f / (float)cnt;
    sc[2 * lane] = s0 * inv - bflo(v0); sc[2 * lane + 1] = s1 * inv - bfhi(v0);
    asm volatile("s_waitcnt lgkmcnt(0)" ::: "memory");
    const float* W = a.pool_w + ((size_t)l * 4 + g) * 128 * 128;
    float o0 = 0.f, o1 = 0.f;
    for (int c = 0; c < 128; ++c) { const float p = sc[c]; const f32x2 wv = *(const f32x2*)(W + c * 128 + 2 * lane); o0 += p * wv[0]; o1 += p * wv[1]; }
    const f32x2 ps = *(const f32x2*)(a.pool_scale + l * MIXW + g * 128 + 2 * lane);
    bf16* Y = (bf16*)(a.ws + WS_Y);
    *(unsigned*)(Y + (size_t)t * D + 512 + g * 128 + 2 * lane) = pk2(o0 * ps[0], o1 * ps[1]);
    asm volatile("s_waitcnt lgkmcnt(0)" ::: "memory");
}
__device__ __forceinline__ void naive_conv(const Args& a, int l, int t, int lane) {
    const bf16* P = (const bf16*)(a.ws + WS_PROJ); const bf16* Ch = P + 4 * PROJ_T; const bf16* Cb = P + 5 * PROJ_T; const bf16* Cc = P + 6 * PROJ_T;
    const int s = t & (SEQ - 1), c0 = lane * 8;
    float acc[8] = {0.f, 0.f, 0.f, 0.f, 0.f, 0.f, 0.f, 0.f};
#pragma unroll
    for (int j = 0; j < 3; ++j) { const int dt = 2 - j;
        if (s - dt >= 0) { const v4u hv = *(const v4u*)(Ch + (size_t)(t - dt) * MIXW + c0), cv = *(const v4u*)(Cc + (size_t)(t - dt) * MIXW + c0);
            const float* w = a.conv_w + ((size_t)l * 3 + j) * MIXW + c0; const f32x4 w0 = *(const f32x4*)w, w1 = *(const f32x4*)(w + 4);
            acc[0] += w0[0] * bflo(hv.x) * bflo(cv.x); acc[1] += w0[1] * bfhi(hv.x) * bfhi(cv.x); acc[2] += w0[2] * bflo(hv.y) * bflo(cv.y); acc[3] += w0[3] * bfhi(hv.y) * bfhi(cv.y);
            acc[4] += w1[0] * bflo(hv.z) * bflo(cv.z); acc[5] += w1[1] * bfhi(hv.z) * bfhi(cv.z); acc[6] += w1[2] * bflo(hv.w) * bflo(cv.w); acc[7] += w1[3] * bfhi(hv.w) * bfhi(cv.w); } }
    const v4u bv = *(const v4u*)(Cb + (size_t)t * MIXW + c0);
    v4u o; o.x = pk2(acc[0] * bflo(bv.x), acc[1] * bfhi(bv.x)); o.y = pk2(acc[2] * bflo(bv.y), acc[3] * bfhi(bv.y)); o.z = pk2(acc[4] * bflo(bv.z), acc[5] * bfhi(bv.z)); o.w = pk2(acc[6] * bflo(bv.w), acc[7] * bfhi(bv.w));
    *(v4u*)((bf16*)(a.ws + WS_Y) + (size_t)t * D + 1024 + c0) = o;
}
__device__ __forceinline__ void mixers_naive(const Args& a, int l, LAS unsigned char* lds, int gw, int NGW, int wave, int lane) {
    LAS float* sc = (LAS float*)(lds + wave * 8192);
    for (int i = gw; i < M * 4; i += NGW) { const int t = M * 4 - 1 - i; const int h = t & 3, tok = t >> 2; naive_attn<0>(a, l, tok >> 11, h, tok & (SEQ - 1), sc, lane); }
    for (int i = gw; i < M * 4; i += NGW) { const int h = i & 3, tok = i >> 2; naive_attn<1>(a, l, tok >> 11, h, tok & (SEQ - 1), sc, lane); }
    for (int i = gw; i < M * 4; i += NGW) naive_pool(a, l, i >> 2, i & 3, sc, lane);
    for (int i = gw; i < M; i += NGW) naive_conv(a, l, i, lane);
}

__device__ __forceinline__ float gelu_tanh(float x) { const float u = 1.5957691216057308f * (x + 0.044715f * x * x * x); return x / (1.0f + __expf(-u)); }
constexpr int PEER_TOK = 32;
constexpr int PL_IDX = 0, PL_GATE = PEER_TOK * 128 * 4, PL_TAB = 2 * PEER_TOK * 128 * 4;
__device__ __forceinline__ int f2key(float f) { const int b = __builtin_bit_cast(int, f); return b ^ ((b >> 31) & 0x7fffffff); }
__device__ __forceinline__ float key2f(int k) { return __builtin_bit_cast(float, k ^ ((k >> 31) & 0x7fffffff)); }
#define CE_DESC(x, y) do { const int hi_ = (x) > (y) ? (x) : (y), lo_ = (x) > (y) ? (y) : (x); (x) = hi_; (y) = lo_; } while (0)
__device__ __forceinline__ void sort16_desc(int* v) {
#pragma unroll
    for (int k = 2; k <= 16; k <<= 1)
#pragma unroll
        for (int j = k >> 1; j > 0; j >>= 1)
#pragma unroll
            for (int i = 0; i < 16; ++i) { const int l = i ^ j; if (l > i) { if ((i & k) == 0) CE_DESC(v[i], v[l]); else CE_DESC(v[l], v[i]); } }
}
__device__ __forceinline__ void merge_top16(int* a, const int* b) {
#pragma unroll
    for (int i = 0; i < 16; ++i) a[i] = a[i] > b[15 - i] ? a[i] : b[15 - i];
#pragma unroll
    for (int j = 8; j > 0; j >>= 1)
#pragma unroll
        for (int i = 0; i < 16; ++i) { const int l = i ^ j; if (l > i) CE_DESC(a[i], a[l]); }
}
__device__ __forceinline__ void top16_of_64(int* v) {
    sort16_desc(v); sort16_desc(v + 16); sort16_desc(v + 32); sort16_desc(v + 48);
    merge_top16(v, v + 16); merge_top16(v + 32, v + 48); merge_top16(v, v + 32);
}
constexpr int cand_slot(int i, int j) {
    int n = 0;
    for (int a = 0; a < 16; ++a) for (int b = 0; b < 16; ++b) { if ((a + 1) * (b + 1) <= 16) { if (a == i && b == j) return n; ++n; } }
    return -1;
}
__device__ __forceinline__ void peer_retrieve(const Args& a, int l, int t0, int h, LAS char* lds, int wave) {
    typedef short bf16x8 __attribute__((ext_vector_type(8)));
    typedef float f32x16 __attribute__((ext_vector_type(16)));
    int lane; asm volatile("v_mbcnt_lo_u32_b32 %0, -1, 0\n\tv_mbcnt_hi_u32_b32 %0, -1, %0" : "=v"(lane));
    const int r32 = lane & 31, hi = lane >> 5, hi4 = hi * 4;
    const bf16* Q = (const bf16*)(a.ws + WS_Q) + (size_t)(t0 + r32) * D + h * 256 + hi * 8;
    const bf16* PK = (const bf16*)(a.ws + WS_PK) + ((size_t)(l * 8 + h) * 2) * 128 * 128 + (size_t)r32 * 128 + hi * 8;
    int top[2][16];
#pragma unroll
    for (int p = 0; p < 2; ++p) {
        f32x16 acc[4] = {};
        bf16x8 qf[8];
#pragma unroll
        for (int cs = 0; cs < 8; ++cs) qf[cs] = *(const bf16x8*)(Q + p * 128 + cs * 16);
#pragma unroll
        for (int kb = 0; kb < 4; ++kb) { bf16x8 kf[8];
#pragma unroll
            for (int cs = 0; cs < 8; ++cs) kf[cs] = *(const bf16x8*)(PK + (size_t)p * 128 * 128 + (size_t)kb * 32 * 128 + cs * 16);
#pragma unroll
            for (int cs = 0; cs < 8; ++cs) acc[kb] = __builtin_amdgcn_mfma_f32_32x32x16_bf16(kf[cs], qf[cs], acc[kb], 0, 0, 0); }
        int v[64];
#pragma unroll
        for (int kb = 0; kb < 4; ++kb)
#pragma unroll
            for (int r = 0; r < 16; ++r) { const int c = kb * 32 + (r & 3) + 8 * (r >> 2);
                v[kb * 16 + r] = (f2key(acc[kb][r]) & ~127) | (c | hi4); }
        top16_of_64(v);
        int mine[16], other[16];
#pragma unroll
        for (int i = 0; i < 16; ++i) { auto rr = __builtin_amdgcn_permlane32_swap((unsigned)v[i], (unsigned)v[i], false, false); mine[i] = (int)rr[0]; other[i] = (int)rr[1]; }
        merge_top16(mine, other);
#pragma unroll
        for (int i = 0; i < 16; ++i) top[p][i] = mine[i];
    }
    LAS int* tab = (LAS int*)(lds + PL_TAB) + (wave * 64 + lane) * 32;
    float sA[16], sB[16];
#pragma unroll
    for (int i = 0; i < 16; ++i) { sA[i] = key2f(top[0][i] & ~127); sB[i] = key2f(top[1][i] & ~127); tab[i] = top[0][i] & 127; tab[16 + i] = top[1][i] & 127; }
    int c[64];
#pragma unroll
    for (int n = 0; n < 64; ++n) c[n] = (int)0x80000000;
#pragma unroll
    for (int i = 0; i < 16; ++i)
#pragma unroll
        for (int j = 0; j < 16; ++j) if ((i + 1) * (j + 1) <= 16) c[cand_slot(i, j)] = (f2key(sA[i] + sB[j]) & ~255) | (16 * i + j);
    top16_of_64(c);
    float ex[16]; float sum = 0.f; const float mx = key2f(c[0] & ~255);
#pragma unroll
    for (int w = 0; w < 16; ++w) { ex[w] = __expf(key2f(c[w] & ~255) - mx); sum += ex[w]; }
    const float inv = 1.0f / sum;
    asm volatile("s_waitcnt lgkmcnt(0)" ::: "memory");
    LAS int* oi = (LAS int*)(lds + PL_IDX) + r32 * 128 + h * 16; LAS float* og = (LAS float*)(lds + PL_GATE) + r32 * 128 + h * 16;
#pragma unroll
    for (int w = 0; w < 16; ++w) { const int id = c[w] & 255; const int e = tab[id >> 4] * 128 + tab[16 + (id & 15)];
        if ((w >> 3) == hi) { oi[w] = e; og[w] = ex[w] * inv; } }
}
constexpr size_t WS_IDX = 816 * MiB;
constexpr size_t WS_GATE = 820 * MiB;
constexpr size_t WS_XQ = 824 * MiB;
constexpr size_t WS_SX = 856 * MiB;
constexpr size_t WS_PART = 857 * MiB;
constexpr size_t WS_SUT = 890 * MiB;
constexpr size_t WS_END2 = 1024 * MiB;
#ifndef PEER_NB
#define PEER_NB 8
#endif
constexpr int NSLICE = 8, SLW = D / NSLICE;
#define DPP_ROR(x, n) __builtin_bit_cast(float, __builtin_amdgcn_update_dpp(0, __builtin_bit_cast(int, (x)), 0x120 + (n), 0xf, 0xf, false))
__device__ __forceinline__ void peer_publish(const Args& a, int l, int t, LAS char* lds, int tl) {
    int lane; LANE_ID(lane);
    unsigned char* ws = a.ws;
    { int* gi = (int*)(ws + WS_IDX) + (size_t)t * 128; float* gg = (float*)(ws + WS_GATE) + (size_t)t * 128; float* gs = (float*)(ws + WS_SUT) + (size_t)t * 128;
      const float* SU = (const float*)(ws + WS_SU) + l * PEER_E; const float* SV = (const float*)(ws + WS_SV) + l * PEER_E;
      const int i0 = ((const LAS int*)(lds + PL_IDX))[tl * 128 + lane], i1 = ((const LAS int*)(lds + PL_IDX))[tl * 128 + 64 + lane];
      gi[lane] = i0; gi[64 + lane] = i1; gs[lane] = SU[i0]; gs[64 + lane] = SU[i1];
      gg[lane] = ((const LAS float*)(lds + PL_GATE))[tl * 128 + lane] * SV[i0]; gg[64 + lane] = ((const LAS float*)(lds + PL_GATE))[tl * 128 + 64 + lane] * SV[i1]; }
    const unsigned long long* ssa1 = (const unsigned long long*)(ws + WS_SSA) + l * M;
    const float rs = rsqrtf(ssa_to_f(ssa1[t]) * (1.0f / D) + EPS);
    const bf16* HB = (const bf16*)(ws + WS_HB) + (size_t)t * D; const float* gn = a.norm_ffn + l * D;
    float xf[32]; float am = 0.f;
#pragma unroll
    for (int i = 0; i < 2; ++i) { const int k0 = 16 * lane + 1024 * i; const v4u h0 = *(const v4u*)(HB + k0), h1 = *(const v4u*)(HB + k0 + 8);
        const unsigned hw[8] = {h0.x, h0.y, h0.z, h0.w, h1.x, h1.y, h1.z, h1.w};
#pragma unroll
        for (int q = 0; q < 4; ++q) { const f32x4 g = *(const f32x4*)(gn + k0 + 4 * q);
            xf[16 * i + 4 * q + 0] = bflo(hw[2 * q]) * rs * g[0]; xf[16 * i + 4 * q + 1] = bfhi(hw[2 * q]) * rs * g[1];
            xf[16 * i + 4 * q + 2] = bflo(hw[2 * q + 1]) * rs * g[2]; xf[16 * i + 4 * q + 3] = bfhi(hw[2 * q + 1]) * rs * g[3]; } }
#pragma unroll
    for (int k = 0; k < 32; ++k) am = fmaxf(am, fabsf(xf[k]));
    am = wave_max(am, lane);
    const float inv = am > 0.f ? 127.0f / am : 0.f;
    if (lane == 0) ((float*)(ws + WS_SX))[t] = am * (1.0f / 127.0f);
    unsigned char* xq = ws + WS_XQ + (size_t)t * 4096;
#pragma unroll
    for (int i = 0; i < 2; ++i) { v4u ph, pl;
#pragma unroll
        for (int d = 0; d < 4; ++d) { unsigned wh = 0, wl = 0;
#pragma unroll
            for (int b = 0; b < 4; ++b) { const float sv = xf[16 * i + 4 * d + b] * inv, hq = rintf(sv), lq = rintf((sv - hq) * 128.0f);
                wh |= ((unsigned)((int)hq & 255)) << (8 * b); wl |= ((unsigned)((int)lq & 255)) << (8 * b); }
            ph[d] = wh; pl[d] = wl; }
        *(v4u*)(xq + 16 * lane + 1024 * i) = ph; *(v4u*)(xq + 2048 + 16 * lane + 1024 * i) = pl; }
}
struct PeerItems { int pos, npop, rank, nloc, wave;
    __device__ __forceinline__ int nblk() const { return (M / PEER_TOK - rank + nloc - 1) / nloc; }
    __device__ __forceinline__ int count() const { return ((NSLICE - pos + npop - 1) / npop) * nblk() * (PEER_TOK / NWAVES); }
    __device__ __forceinline__ void get(int n, int& s, int& t) const { constexpr int per = PEER_TOK / NWAVES; const int k = n % per, r = n / per, nb = nblk();
        s = pos + (r / nb) * npop; t = (rank + (r % nb) * nloc) * PEER_TOK + wave * per + k; } };
__device__ __forceinline__ void peer_u_wave(const Args& a, int l, const PeerItems& it) {
    int lane; LANE_ID(lane);
    unsigned char* ws = a.ws; const int sub = lane & 15, grp = lane >> 4;
    const __amdgpu_buffer_rsrc_t rU = __builtin_amdgcn_make_buffer_rsrc((void*)(ws + WS_PU + (size_t)l * PE_BYTES), 0, 0x7fffffff, 0x00020000);
    const __amdgpu_buffer_rsrc_t rW = __builtin_amdgcn_make_buffer_rsrc((void*)ws, 0, 0x7fffffff, 0x00020000);
    const int N = it.count(); if (N <= 0) return;
    int s, t; it.get(0, s, t);
    int idc[2], idn[2] = {0, 0}; v4u xhc, xlc, xhn = {}, xln = {}; v4u wA[PEER_NB], wB[PEER_NB];
#define PU_META(I0, I1, XH, XL, S_, T_) do { I0 = (int)__builtin_amdgcn_raw_buffer_load_b32(rW, 4 * lane, (int)WS_IDX + (T_) * 512, 0); I1 = (int)__builtin_amdgcn_raw_buffer_load_b32(rW, 4 * lane, (int)WS_IDX + (T_) * 512 + 256, 0); \
        XH = __builtin_amdgcn_raw_buffer_load_b128(rW, 16 * sub, (int)WS_XQ + (T_) * 4096 + SLW * (S_), 0); XL = __builtin_amdgcn_raw_buffer_load_b128(rW, 16 * sub, (int)WS_XQ + (T_) * 4096 + 2048 + SLW * (S_), 0); } while (0)
#define PU_ISSUE(W, ID, Q, S_) do { _Pragma("unroll") for (int j = 0; j < PEER_NB; ++j) { const int e_ = shi(ID[(PEER_NB * (Q) + j) >> 4], 4 * ((PEER_NB * (Q) + j) & 15) + grp); W[j] = __builtin_amdgcn_raw_buffer_load_b128(rU, e_ * D + SLW * (S_) + 16 * sub, 0, 0); } } while (0)
#define PU_COMP(W, Q) do { _Pragma("unroll") for (int j = 0; j < PEER_NB; ++j) { int dh = 0, dl = 0; \
            dh = __builtin_amdgcn_sdot4((int)W[j].x, (int)xhc.x, dh, false); dl = __builtin_amdgcn_sdot4((int)W[j].x, (int)xlc.x, dl, false); \
            dh = __builtin_amdgcn_sdot4((int)W[j].y, (int)xhc.y, dh, false); dl = __builtin_amdgcn_sdot4((int)W[j].y, (int)xlc.y, dl, false); \
            dh = __builtin_amdgcn_sdot4((int)W[j].z, (int)xhc.z, dh, false); dl = __builtin_amdgcn_sdot4((int)W[j].z, (int)xlc.z, dl, false); \
            dh = __builtin_amdgcn_sdot4((int)W[j].w, (int)xhc.w, dh, false); dl = __builtin_amdgcn_sdot4((int)W[j].w, (int)xlc.w, dl, false); \
            float p_ = (float)dh + (float)dl * (1.0f / 128.0f); \
            p_ += DPP_ROR(p_, 8); p_ += DPP_ROR(p_, 4); p_ += DPP_ROR(p_, 2); p_ += DPP_ROR(p_, 1); \
            if (sub == ((PEER_NB * (Q) + j) & 15)) { if ((PEER_NB * (Q) + j) >> 4) acc1 = p_; else acc0 = p_; } __builtin_amdgcn_sched_barrier(0); } } while (0)
    PU_META(idc[0], idc[1], xhc, xlc, s, t); PU_ISSUE(wA, idc, 0, s); PU_ISSUE(wB, idc, 1, s);
    for (int n = 0; n < N; ++n) {
        int sn = s, tn = t; const bool more = n + 1 < N;
        if (more) it.get(n + 1, sn, tn);
        PU_META(idn[0], idn[1], xhn, xln, sn, tn);
        float acc0 = 0.f, acc1 = 0.f;
        __builtin_amdgcn_sched_barrier(0);
#if PEER_NB == 8
        PU_COMP(wA, 0); PU_ISSUE(wA, idc, 2, s); __builtin_amdgcn_sched_barrier(0);
        PU_COMP(wB, 1); PU_ISSUE(wB, idc, 3, s); __builtin_amdgcn_sched_barrier(0);
        PU_COMP(wA, 2); PU_ISSUE(wA, idn, 0, sn); __builtin_amdgcn_sched_barrier(0);
        PU_COMP(wB, 3); PU_ISSUE(wB, idn, 1, sn); __builtin_amdgcn_sched_barrier(0);
#else
        PU_COMP(wA, 0); PU_ISSUE(wA, idn, 0, sn); __builtin_amdgcn_sched_barrier(0);
        PU_COMP(wB, 1); PU_ISSUE(wB, idn, 1, sn); __builtin_amdgcn_sched_barrier(0);
#endif
        __builtin_amdgcn_raw_buffer_store_b32(__builtin_bit_cast(unsigned, acc0), rW, (4 * sub + grp) * 4, (int)WS_PART + (s * M + t) * 512, 0);
        __builtin_amdgcn_raw_buffer_store_b32(__builtin_bit_cast(unsigned, acc1), rW, (4 * sub + grp) * 4 + 256, (int)WS_PART + (s * M + t) * 512, 0);
        s = sn; t = tn; idc[0] = idn[0]; idc[1] = idn[1]; xhc = xhn; xlc = xln;
    }
#undef PU_META
#undef PU_ISSUE
#undef PU_COMP
}
__device__ __forceinline__ void peer_v_wave(const Args& a, int l, const PeerItems& it) {
    int lane; LANE_ID(lane);
    unsigned char* ws = a.ws; const int sub = lane & 15, grp = lane >> 4;
    const __amdgpu_buffer_rsrc_t rV = __builtin_amdgcn_make_buffer_rsrc((void*)(ws + WS_PV + (size_t)l * PE_BYTES), 0, 0x7fffffff, 0x00020000);
    const __amdgpu_buffer_rsrc_t rW = __builtin_amdgcn_make_buffer_rsrc((void*)ws, 0, 0x7fffffff, 0x00020000);
    const int N = it.count(); if (N <= 0) return;
    int s, t; it.get(0, s, t);
    struct Meta { int id[2]; float gate[2], su[2], pa[2], sx; f32x4 h1; };
    Meta mc, mn; v4u wA[PEER_NB], wB[PEER_NB];
    const int l4 = 4 * lane;
#define WLD(off_s) __builtin_amdgcn_raw_buffer_load_b32(rW, l4, (int)(off_s), 0)
#define PV_META(MM, S_, T_) do { const int r_ = (T_) * 512; MM.id[0] = (int)WLD(WS_IDX + r_); MM.id[1] = (int)WLD(WS_IDX + r_ + 256); \
        MM.gate[0] = __builtin_bit_cast(float, WLD(WS_GATE + r_)); MM.gate[1] = __builtin_bit_cast(float, WLD(WS_GATE + r_ + 256)); MM.su[0] = __builtin_bit_cast(float, WLD(WS_SUT + r_)); MM.su[1] = __builtin_bit_cast(float, WLD(WS_SUT + r_ + 256)); \
        float a0_ = 0.f, a1_ = 0.f; _Pragma("unroll") for (int q = 0; q < NSLICE; ++q) { const int po_ = (int)WS_PART + (q * M + (T_)) * 512; a0_ += __builtin_bit_cast(float, WLD(po_)); a1_ += __builtin_bit_cast(float, WLD(po_ + 256)); } \
        MM.pa[0] = a0_; MM.pa[1] = a1_; MM.sx = ((const float*)(ws + WS_SX))[T_]; \
        MM.h1 = __builtin_bit_cast(f32x4, __builtin_amdgcn_raw_buffer_load_b128(rW, (16 * sub + 4 * grp) * 4, (int)WS_H + ((T_) * D + SLW * (S_)) * 4, 0)); } while (0)
#define PV_ISSUE(W, ID, Q, S_) do { _Pragma("unroll") for (int j = 0; j < PEER_NB; ++j) { const int e_ = shi(ID[(PEER_NB * (Q) + j) >> 4], 4 * ((PEER_NB * (Q) + j) & 15) + grp); W[j] = __builtin_amdgcn_raw_buffer_load_b128(rV, e_ * D + SLW * (S_) + 16 * sub, 0, 0); } } while (0)
#define PV_COMP(W, Q) do { _Pragma("unroll") for (int j4 = 0; j4 < PEER_NB; j4 += 4) { \
            unsigned cp_ = 0; _Pragma("unroll") for (int jj = 0; jj < 4; ++jj) { const int i_ = PEER_NB * (Q) + j4 + jj; cp_ |= ((unsigned)shi(c8[i_ >> 4], 4 * (i_ & 15) + grp) & 255u) << (8 * jj); } \
            _Pragma("unroll") for (int d = 0; d < 4; ++d) { const unsigned a_ = W[j4][d], b_ = W[j4 + 1][d], c_ = W[j4 + 2][d], d_ = W[j4 + 3][d]; \
                const unsigned x0_ = __builtin_amdgcn_perm(b_, a_, 0x05010400u), x1_ = __builtin_amdgcn_perm(b_, a_, 0x07030602u), y0_ = __builtin_amdgcn_perm(d_, c_, 0x05010400u), y1_ = __builtin_amdgcn_perm(d_, c_, 0x07030602u); \
                yi[4 * d + 0] = __builtin_amdgcn_sdot4((int)__builtin_amdgcn_perm(y0_, x0_, 0x05040100u), (int)cp_, yi[4 * d + 0], false); \
                yi[4 * d + 1] = __builtin_amdgcn_sdot4((int)__builtin_amdgcn_perm(y0_, x0_, 0x07060302u), (int)cp_, yi[4 * d + 1], false); \
                yi[4 * d + 2] = __builtin_amdgcn_sdot4((int)__builtin_amdgcn_perm(y1_, x1_, 0x05040100u), (int)cp_, yi[4 * d + 2], false); \
                yi[4 * d + 3] = __builtin_amdgcn_sdot4((int)__builtin_amdgcn_perm(y1_, x1_, 0x07060302u), (int)cp_, yi[4 * d + 3], false); } \
            __builtin_amdgcn_sched_barrier(0); } } while (0)
    PV_META(mc, s, t); PV_ISSUE(wA, mc.id, 0, s); PV_ISSUE(wB, mc.id, 1, s);
    for (int n = 0; n < N; ++n) {
        int sn = s, tn = t; const bool more = n + 1 < N;
        if (more) it.get(n + 1, sn, tn);
        PV_META(mn, sn, tn);
        float coef[2];
#pragma unroll
        for (int hf = 0; hf < 2; ++hf) coef[hf] = gelu_tanh(mc.pa[hf] * mc.su[hf] * mc.sx) * mc.gate[hf];
        const float cmax = wave_max(fmaxf(fabsf(coef[0]), fabsf(coef[1])), lane); const float cinv = cmax > 0.f ? 127.0f / cmax : 0.f, cs = cmax * (1.0f / 127.0f);
        const int c8[2] = {(int)rintf(coef[0] * cinv), (int)rintf(coef[1] * cinv)};
        int yi[16];
#pragma unroll
        for (int k = 0; k < 16; ++k) yi[k] = 0;
        __builtin_amdgcn_sched_barrier(0);
#if PEER_NB == 8
        PV_COMP(wA, 0); PV_ISSUE(wA, mc.id, 2, s); __builtin_amdgcn_sched_barrier(0);
        PV_COMP(wB, 1); PV_ISSUE(wB, mc.id, 3, s); __builtin_amdgcn_sched_barrier(0);
        PV_COMP(wA, 2); PV_ISSUE(wA, mn.id, 0, sn); __builtin_amdgcn_sched_barrier(0);
        PV_COMP(wB, 3); PV_ISSUE(wB, mn.id, 1, sn); __builtin_amdgcn_sched_barrier(0);
#else
        PV_COMP(wA, 0); PV_ISSUE(wA, mn.id, 0, sn); __builtin_amdgcn_sched_barrier(0);
        PV_COMP(wB, 1); PV_ISSUE(wB, mn.id, 1, sn); __builtin_amdgcn_sched_barrier(0);
#endif
#pragma unroll
        for (int k = 0; k < 16; ++k) { yi[k] += shi(yi[k], lane ^ 16); yi[k] += shi(yi[k], lane ^ 32); }
        int yq[4];
#pragma unroll
        for (int k = 0; k < 4; ++k) yq[k] = grp == 0 ? yi[k] : grp == 1 ? yi[4 + k] : grp == 2 ? yi[8 + k] : yi[12 + k];
        const f32x4 h2 = {mc.h1[0] + cs * (float)yq[0], mc.h1[1] + cs * (float)yq[1], mc.h1[2] + cs * (float)yq[2], mc.h1[3] + cs * (float)yq[3]};
        __builtin_amdgcn_raw_buffer_store_b128(__builtin_bit_cast(v4u, h2), rW, (16 * sub + 4 * grp) * 4, (int)WS_H + (t * D + SLW * s) * 4, 0);
        v2u hb; hb.x = pk2(h2[0], h2[1]); hb.y = pk2(h2[2], h2[3]);
        __builtin_amdgcn_raw_buffer_store_b64(hb, rW, (16 * sub + 4 * grp) * 2, (int)WS_HB + (t * D + SLW * s) * 2, 0);
        const float sq = wave_sum((h2[0] * h2[0] + h2[1] * h2[1]) + (h2[2] * h2[2] + h2[3] * h2[3]), lane);
        if (lane == 0) atomicAdd((unsigned long long*)(ws + WS_SSQ) + (size_t)(l + 1) * M + t, (unsigned long long)((double)sq * 4294967296.0));
        s = sn; t = tn; mc = mn;
    }
#undef PV_META
#undef WLD
#undef PV_ISSUE
#undef PV_COMP
}
__device__ __forceinline__ void final_norm_row(const Args& a, int t) {
    int lane; LANE_ID(lane);
    const float* H = (const float*)(a.ws + WS_H) + (size_t)t * D; float* O = a.out + (size_t)t * D;
    const float rf = rsqrtf(ssa_to_f(((const unsigned long long*)(a.ws + WS_SSQ))[(size_t)DEPTH * M + t]) * (1.0f / D) + EPS);
#pragma unroll
    for (int j = 0; j < 8; ++j) { const int k0 = 4 * lane + 256 * j; const f32x4 h = *(const f32x4*)(H + k0), g = *(const f32x4*)(a.norm_final + k0);
        *(f32x4*)(O + k0) = (f32x4){h[0] * rf * g[0], h[1] * rf * g[1], h[2] * rf * g[2], h[3] * rf * g[3]}; }
}

__global__ void __launch_bounds__(NT, 2) mk_fwd(ArgsK a_in) {
    extern __shared__ __attribute__((aligned(16))) unsigned char lds_raw[];
    LAS unsigned char* lds = (LAS unsigned char*)lds_raw;
    cg::grid_group grid = cg::this_grid();
    grid.sync();
    const int wave0 = __builtin_amdgcn_readfirstlane(threadIdx.x >> 6);
    const int G = gridDim.x;
    const CAS ArgsK* ka = (const CAS ArgsK*)__builtin_amdgcn_kernarg_segment_ptr();
    size_t zoff = 0;
#define PHASE_BEGIN() int lane; LANE_ID(lane); int blk = blockIdx.x, Gp = G, wv = wave0; asm volatile("" : "+s"(zoff), "+s"(ka), "+s"(blk), "+s"(Gp), "+s"(wv)); const int wave = wv, gw = blk * NWAVES + wv, NGW = Gp * NWAVES; (void)gw; (void)NGW; const Args a = load_args(ka, zoff); unsigned char* const ws = a.ws; (void)ws
    volatile LAS unsigned* bst = (volatile LAS unsigned*)(lds + RING_BYTES + 1024);
    if (PROBE == 3) { PHASE_BEGIN(); p0_prologue(a, lds, gw, NGW, wave, lane); }
#define GRID_BAR() do { asm volatile("" : "+s"(zoff)); unsigned char* wsb_ = (unsigned char*)ka->ws + zoff; int wvb_ = wave0; asm volatile("" : "+s"(wvb_)); xcd_barrier((unsigned*)(wsb_ + WS_BAR), xb_xcc_id(), (unsigned)G, bst, wvb_); if (PROBE == 9) xcd_barrier((unsigned*)(wsb_ + WS_BAR), xb_xcc_id(), (unsigned)G, bst, wvb_); } while (0)
    volatile LAS unsigned* xinfo = bst + 4;
    { PHASE_BEGIN(); if (wave == 0 && lane == 0) { bst[0] = 0u; bst[1] = 0u; xinfo[2] = xb_add((unsigned*)(ws + WS_BAR) + XB_XCNT(xb_xcc_id()), 1u); }
      p0_cmax(a, gw, NGW, lane); }
    GRID_BAR();
    { PHASE_BEGIN(); p0_win_i8(a, lds, gw, NGW, wave, lane); p0_prologue(a, lds, gw, NGW, wave, lane); }
    GRID_BAR();
    {
        PHASE_BEGIN();
        if (wave == 0 && lane == 0) { unsigned* bar = (unsigned*)(ws + WS_BAR); const unsigned x = xb_xcc_id(); unsigned pos = 0, npop = 0, mine = 1;
            for (unsigned j = 0; j < 16; ++j) { const unsigned c = xb_ld(&bar[XB_XCNT(j)]); if (c) { ++npop; if (j < x) ++pos; } if (j == x) mine = c ? c : 1u; }
            xinfo[0] = pos; xinfo[1] = npop ? npop : 1u; xinfo[3] = mine; }
        __syncthreads();
    }
    int depth_rt = DEPTH; asm volatile("" : "+s"(depth_rt));
    for (int lc = 0; lc < depth_rt; ++lc) {
        int l = lc; asm volatile("" : "+s"(l));
        if (l > 0) { { PHASE_BEGIN(); quant_rows(a, l, gw, NGW, lane); } GRID_BAR(); }
        for (int rep = 0; rep < (PROBE == 4 ? 2 : 1); ++rep)
        {
            PHASE_BEGIN();
            pg8::Gemm g{(const bf16*)(ws + WS_HB8), (const bf16*)(ws + WS_WIN + l * WIN_BYTES), M, NPROJ, D / 2}; pg8::StaticOrder S; S.init(M, NPROJ, Gp, blk);
            EpiProj E{ws, (const bf16*)(ws + WS_BIH) + l * NPROJ, (const float*)(ws + WS_RSA), (const bf16*)(ws + WS_SWH) + l * NPROJ};
            if (PROBE == 15) { pg8::gemm_phase<EpiProj, pg8::StaticOrder, true, true>(lds, g, S, E, wave); EpiSt<0> E4{ws}; pg8::gemm_phase<EpiSt<0>, pg8::StaticOrder, true, true>(lds, g, S, E4, wave); }
            else if (PROBE == 16) { pg8::gemm_phase<EpiProj, pg8::StaticOrder, true, true>(lds, g, S, E, wave); EpiSt<1> E4{ws}; pg8::gemm_phase<EpiSt<1>, pg8::StaticOrder, true, true>(lds, g, S, E4, wave); }
            else if (PROBE == 14) { pg8::gemm_phase<EpiProj, pg8::StaticOrder, true, true>(lds, g, S, E, wave); EpiSum E4{(float*)(ws + WS_R)}; pg8::gemm_phase<EpiSum, pg8::StaticOrder, true, true>(lds, g, S, E4, wave); }
            else pg8::gemm_phase<EpiProj, pg8::StaticOrder, true, true>(lds, g, S, E, wave);
            for (int r2 = 0; r2 < (PROBE == 8 ? 2 : 1); ++r2) forget_logits(a, l, gw, NGW, lane);
        }
        GRID_BAR();
        if (PROBE == 5) { PHASE_BEGIN(); mixers_fast(a, l + 2, (LAS char*)lds, wave, lane, Gp, blk); }
        { PHASE_BEGIN(); mixers_fast(a, l, (LAS char*)lds, wave, lane, Gp, blk); }
        GRID_BAR();
        for (int rep = 0; rep < (PROBE == 6 ? 2 : 1); ++rep)
        {
            PHASE_BEGIN();
            pg8::Gemm g{(const bf16*)(ws + WS_Y), (const bf16*)(ws + WS_WBR + l * SQ_BYTES), M, D, D}; pg8::StaticOrder S; S.init(M, D, Gp, blk);
            EpiMerge E{(const bf16*)(ws + WS_G), (bf16*)(ws + WS_MRG)};
            pg8::gemm_phase<EpiMerge, pg8::StaticOrder, false>(lds, g, S, E, wave);
        }
        GRID_BAR();
        {
            PHASE_BEGIN();
            pg8::Gemm g{(const bf16*)(ws + WS_MRG), (const bf16*)(ws + WS_WOUT + l * SQ_BYTES), M, D, D}; pg8::StaticOrder S; S.init(M, D, Gp, blk);
            EpiRes E{l == 0 ? a.x : (const float*)(ws + WS_H), (float*)(ws + WS_H), (bf16*)(ws + WS_HB), (unsigned long long*)(ws + WS_SSA) + l * M};
            pg8::gemm_phase<EpiRes, pg8::StaticOrder, false>(lds, g, S, E, wave);
        }
        GRID_BAR();
        for (int rep = 0; rep < (PROBE == 7 ? 2 : 1); ++rep)
        {
            PHASE_BEGIN();
            pg8::Gemm g{(const bf16*)(ws + WS_HB), (const bf16*)(ws + WS_WQ + l * SQ_BYTES), M, D, D}; pg8::StaticOrder S; S.init(M, D, Gp, blk);
            EpiQ E{(bf16*)(ws + WS_Q), (const unsigned long long*)(ws + WS_SSA) + l * M};
            pg8::gemm_phase<EpiQ, pg8::StaticOrder, false>(lds, g, S, E, wave);
        }
        GRID_BAR();
        for (int rep = 0; rep < (PROBE == 2 ? 2 : 1); ++rep)
        {
            PHASE_BEGIN(); (void)lane;
            for (int t0 = blk * PEER_TOK; t0 < M; t0 += Gp * PEER_TOK) {
                peer_retrieve(a, l, t0, wave, (LAS char*)lds, wave);
                __syncthreads();
                for (int k = 0; k < PEER_TOK / NWAVES; ++k) { const int tl = wave * (PEER_TOK / NWAVES) + k; peer_publish(a, l, t0 + tl, (LAS char*)lds, tl); }
                __syncthreads();
            }
        }
        GRID_BAR();
        for (int rep = 0; rep < (PROBE == 1 ? 2 : 1); ++rep)
        {
            PHASE_BEGIN(); (void)lane;
            const int pos = __builtin_amdgcn_readfirstlane((int)xinfo[0]), npop = __builtin_amdgcn_readfirstlane((int)xinfo[1]), rank = __builtin_amdgcn_readfirstlane((int)xinfo[2]), nloc = __builtin_amdgcn_readfirstlane((int)xinfo[3]);
            const PeerItems it{pos, npop, rank, nloc, wave}; peer_u_wave(a, l, it);
        }
        GRID_BAR();
        {
            PHASE_BEGIN(); (void)lane;
            const int pos = __builtin_amdgcn_readfirstlane((int)xinfo[0]), npop = __builtin_amdgcn_readfirstlane((int)xinfo[1]), rank = __builtin_amdgcn_readfirstlane((int)xinfo[2]), nloc = __builtin_amdgcn_readfirstlane((int)xinfo[3]);
            const PeerItems it{pos, npop, rank, nloc, wave}; peer_v_wave(a, l, it);
        }
        GRID_BAR();
    }
    {
        PHASE_BEGIN(); (void)lane;
        for (int t = gw; t < M; t += NGW) final_norm_row(a, t);
    }
}

extern "C" void kernel_launch(void* const* d_in, const int* in_sizes, int n_in, void* d_out, int out_size, void* d_ws, size_t ws_size, hipStream_t stream) {
    static int grid = 0;
    if (grid == 0) {
        int dev = 0, cus = 0, per_cu = 0;
        if (n_in != 16 || out_size != M * D || ws_size < WS_END2) { fprintf(stderr, "kernel_launch: unexpected shapes (n_in %d out %d ws %zu)\n", n_in, out_size, ws_size); grid = -1; return; }
        (void)hipGetDevice(&dev);
        (void)hipDeviceGetAttribute(&cus, hipDeviceAttributeMultiprocessorCount, dev);
        (void)hipFuncSetAttribute((const void*)mk_fwd, hipFuncAttributeMaxDynamicSharedMemorySize, LDS_BYTES);
        (void)hipOccupancyMaxActiveBlocksPerMultiprocessor(&per_cu, (const void*)mk_fwd, NT, LDS_BYTES);
        if (per_cu < 1) { fprintf(stderr, "kernel_launch: occupancy query says %d blocks per CU\n", per_cu); }
        grid = cus;
        if (grid > 256) grid = 256;
    }
    if (grid < 0) return;
    (void)hipMemsetAsync((char*)d_ws + WS_CTL, 0, CTL_ZERO_BYTES, stream);
    ArgsK a{};
    const GAS float** p = (const GAS float**)&a;
    for (int i = 0; i < 16; ++i) p[i] = (const GAS float*)d_in[i];
    a.out = (GAS float*)d_out; a.ws = (GAS unsigned char*)d_ws;
    void* args[] = {&a};
    hipError_t e = hipLaunchCooperativeKernel((const void*)mk_fwd, dim3(grid), dim3(NT), args, LDS_BYTES, stream);
    if (e != hipSuccess) fprintf(stderr, "cooperative launch failed: %s (grid %d)\n", hipGetErrorString(e), grid);
}
```

```cpp
#include <hip/hip_runtime.h>
#include <hip/hip_cooperative_groups.h>
#include <cstdio>
#include <cstdint>
namespace cg = cooperative_groups;
namespace pg8 {
#define PG8_LAS __attribute__((address_space(3)))
typedef unsigned short bf16_t;
typedef short bf16x8 __attribute__((ext_vector_type(8)));
typedef float f32x4 __attribute__((ext_vector_type(4)));
typedef unsigned u32x4 __attribute__((ext_vector_type(4)));
typedef unsigned u32x2 __attribute__((ext_vector_type(2)));
typedef int i32x4 __attribute__((ext_vector_type(4)));
constexpr int BM = 256, BK = 64, HALF = 128, HTB = HALF * BK * 2  , STAGE_BYTES = 8 * HTB, NXCD = 8, WGM = 8;

__host__ __device__ __forceinline__ int lds_byte(int r, int c) { const int st = (r >> 4) * 2 + (c >> 5), rr = r & 15, cc = c & 31, ob = rr * 64 + cc * 2; return st * 1024 + (ob ^ (((ob >> 9) & 1) << 5)); }
__host__ __device__ __forceinline__ void stage_rc(int b, int& R, int& C) { const int st = b / 1024, sb = b % 1024, swz = sb ^ (((sb >> 9) & 1) << 5); R = (st >> 1) * 16 + swz / 64; C = (st & 1) * 32 + (swz % 64) / 2; }
__host__ __device__ __forceinline__ int perm32(int rho) { const int n = rho >> 4, i = rho & 15; return 8 * (i >> 2) + 4 * n + (i & 3); }

struct Unit { int pm, pn; };
struct Gemm { const bf16_t* A; const bf16_t* Bt; int M, N, K; };

struct StaticOrder {
    int nM, nN, nwg, G, c;
    __host__ __device__ void init(int M, int N, int G_, int c_) { nM = M / BM; nN = N / BM; nwg = nM * nN; G = G_; c = c_; }
    __host__ __device__ bool next(int i, Unit& u) const {
        const long L = (long)i * G + c; if (L >= nwg) return false;
        int wgid = (int)L; { const int q = nwg / NXCD, r = nwg % NXCD, xcd = wgid % NXCD, off = wgid / NXCD; wgid = (xcd < r ? xcd * (q + 1) : r * (q + 1) + (xcd - r) * q) + off; }
        const int nig = WGM * nN, gid = wgid / nig, fm = gid * WGM, gsz = (nM - fm) < WGM ? (nM - fm) : WGM;
        u.pm = fm + ((wgid % nig) % gsz); u.pn = (wgid % nig) / gsz; return true;
    }
};

__device__ __forceinline__ unsigned cvt_pk_bf16(float lo, float hi) { unsigned r; asm volatile("v_cvt_pk_bf16_f32 %0, %1, %2" : "=v"(r) : "v"(lo), "v"(hi)); return r; }

template <class Epi, class Sched, bool ALIGN_EPI = false, bool I8 = false>
__device__ __forceinline__ void gemm_phase(PG8_LAS unsigned char* lds, const Gemm g, const Sched& S, const Epi& E, int wid) {
    int lane_; asm volatile("v_mbcnt_lo_u32_b32 %0, -1, 0\n\tv_mbcnt_hi_u32_b32 %0, -1, %0" : "=v"(lane_));
    const int lane = lane_, tid = wid * 64 + lane, wr = wid >> 2, wc = wid & 3, fr = lane & 15, fq = lane >> 4;
    const int K = g.K, nt = K / BK;
    unsigned voffA, voffB;
    { int R, C; stage_rc(tid * 16, R, C); const int Rb = Epi::PERM ? ((R & ~31) + perm32(R & 31)) : R; voffA = (unsigned)(R * K + C) * 2u; voffB = (unsigned)(Rb * K + C) * 2u; }
    const size_t p2step = (size_t)64 * K * 2;
    const size_t kstep = (size_t)(BK * 2);
    const size_t hstep = (size_t)HALF * K * 2;
    const size_t tstep = 2 * hstep;
    const unsigned ldsw = (unsigned)wid * 1024u;
    const int aoff = lds_byte(wr * 64 + fr, fq * 8), boff = lds_byte(wc * 32 + fr, fq * 8);
#define PG8_SA(b, h) (((b) * 2 + (h)) * HTB)
#define PG8_SB(b, h) ((4 + (b) * 2 + (h)) * HTB)
#define PG8_STAGE(bufoff, gbase, voff) do { _Pragma("unroll") for (int _i = 0; _i < 2; ++_i) \
        __builtin_amdgcn_global_load_lds((const unsigned*)((const char*)(gbase) + _i * p2step + (voff)), (PG8_LAS unsigned*)(lds + (bufoff) + ldsw + _i * 8192), 16, 0, 0); } while (0)
#define PG8_LDA(dst, b, h) do { _Pragma("unroll") for (int m = 0; m < 4; ++m) _Pragma("unroll") for (int k = 0; k < 2; ++k) dst[m][k] = *(const PG8_LAS bf16x8*)(lds + PG8_SA(b, h) + aoff + m * 2048 + k * 1024); } while (0)
#define PG8_LDB(dst, b, h) do { _Pragma("unroll") for (int n = 0; n < 2; ++n) _Pragma("unroll") for (int k = 0; k < 2; ++k) dst[n][k] = *(const PG8_LAS bf16x8*)(lds + PG8_SB(b, h) + boff + n * 2048 + k * 1024); } while (0)
#define PG8_MMA(ai, bj, At, Bt) do { __builtin_amdgcn_s_setprio(1); _Pragma("unroll") for (int m = 0; m < 4; ++m) _Pragma("unroll") for (int n = 0; n < 2; ++n) _Pragma("unroll") for (int k = 0; k < 2; ++k) \
        { if constexpr (I8) acc[ai][bj][m][n] = __builtin_bit_cast(f32x4, __builtin_amdgcn_mfma_i32_16x16x64_i8(__builtin_bit_cast(i32x4, Bt[n][k]), __builtin_bit_cast(i32x4, At[m][k]), __builtin_bit_cast(i32x4, acc[ai][bj][m][n]), 0, 0, 0)); \
          else acc[ai][bj][m][n] = __builtin_amdgcn_mfma_f32_16x16x32_bf16(Bt[n][k], At[m][k], acc[ai][bj][m][n], 0, 0, 0); } __builtin_amdgcn_s_setprio(0); } while (0)
#define PG8_WAIT_V(n) asm volatile("s_waitcnt vmcnt(" #n ")" ::: "memory")
#define PG8_WAIT_L(n) asm volatile("s_waitcnt lgkmcnt(" #n ")" ::: "memory")
#define PG8_BAR __builtin_amdgcn_s_barrier()
#define PG8_SCHED __builtin_amdgcn_sched_barrier(0)
    Unit cur, nxt; int ui = 0;
    if (!S.next(0, cur)) return;
    f32x4 acc[2][2][4][2];
#pragma unroll
    for (int a = 0; a < 2; ++a)
#pragma unroll
        for (int b = 0; b < 2; ++b)
#pragma unroll
            for (int m = 0; m < 4; ++m)
#pragma unroll
                for (int n = 0; n < 2; ++n) acc[a][b][m][n] = (f32x4){0.f, 0.f, 0.f, 0.f};
    bf16x8 At[4][2], B0[2][2], B1[2][2];
    typename Epi::Pre pre = {};
    const char* cA = (const char*)g.A + (size_t)cur.pm * tstep; const char* cB = (const char*)g.Bt + (size_t)cur.pn * tstep;
    PG8_STAGE(PG8_SB(0, 0), cB, voffB); PG8_STAGE(PG8_SB(0, 1), cB + hstep, voffB); PG8_STAGE(PG8_SA(0, 0), cA, voffA); PG8_STAGE(PG8_SA(0, 1), cA + hstep, voffA);
    if (wr == 1) PG8_BAR;
    PG8_WAIT_V(2); PG8_BAR;
    PG8_STAGE(PG8_SB(1, 0), cB + kstep, voffB); PG8_STAGE(PG8_SA(1, 0), cA + kstep, voffA); PG8_STAGE(PG8_SB(1, 1), cB + hstep + kstep, voffB);
    PG8_WAIT_V(6); PG8_BAR;
    for (;;) {
        const bool has_next = S.next(ui + 1, nxt);
        const char* nA = has_next ? (const char*)g.A + (size_t)nxt.pm * tstep : cA; const char* nB = has_next ? (const char*)g.Bt + (size_t)nxt.pn * tstep : cB;
        const int seglen = Epi::HOOK ? 8 : nt;
        for (int t0 = 0; t0 < nt; t0 += seglen) {
        if constexpr (Epi::HOOK) { if (t0 > 0) { int ln_; asm volatile("v_mbcnt_lo_u32_b32 %0, -1, 0\n\tv_mbcnt_hi_u32_b32 %0, -1, %0" : "=v"(ln_)); E.hook(acc, cur, t0 >> 3, wr, wc, ln_ & 15, ln_ >> 4); } }
        for (int t = t0; t < t0 + seglen; t += 2) {
            const bool last = (t == nt - 2);
            if constexpr (Epi::PRELOAD) { if (last) { int ln_; asm volatile("v_mbcnt_lo_u32_b32 %0, -1, 0\n\tv_mbcnt_hi_u32_b32 %0, -1, %0" : "=v"(ln_)); E.preload(pre, cur, wr, wc, ln_ & 15, ln_ >> 4); } }
            const char* a1 = cA + (size_t)(t + 1) * kstep;
            const char* a2 = last ? nA : cA + (size_t)(t + 2) * kstep; const char* b2 = last ? nB : cB + (size_t)(t + 2) * kstep;
            const char* a3 = a2 + kstep; const char* b3 = b2 + kstep;
            PG8_LDB(B0, 0, 0); PG8_LDB(B1, 0, 1); PG8_SCHED; PG8_LDA(At, 0, 0); PG8_STAGE(PG8_SA(1, 1), a1 + hstep, voffA);
            PG8_WAIT_V(8); PG8_WAIT_L(0); PG8_BAR; PG8_MMA(0, 0, At, B0); PG8_MMA(0, 1, At, B1); PG8_BAR; PG8_SCHED;
            PG8_LDA(At, 0, 1); PG8_STAGE(PG8_SB(0, 0), b2, voffB); PG8_STAGE(PG8_SB(0, 1), b2 + hstep, voffB); PG8_STAGE(PG8_SA(0, 0), a2, voffA);
            PG8_WAIT_V(8); PG8_WAIT_L(0); PG8_BAR; PG8_MMA(1, 0, At, B0); PG8_MMA(1, 1, At, B1); PG8_BAR; PG8_SCHED;
            PG8_LDB(B0, 1, 0); PG8_LDB(B1, 1, 1); PG8_SCHED; PG8_LDA(At, 1, 0); PG8_STAGE(PG8_SA(0, 1), a2 + hstep, voffA);
            PG8_WAIT_V(8); PG8_WAIT_L(0); PG8_BAR; PG8_MMA(0, 0, At, B0); PG8_MMA(0, 1, At, B1); PG8_BAR; PG8_SCHED;
            PG8_LDA(At, 1, 1); PG8_STAGE(PG8_SB(1, 0), b3, voffB); PG8_STAGE(PG8_SB(1, 1), b3 + hstep, voffB); PG8_STAGE(PG8_SA(1, 0), a3, voffA);
            PG8_WAIT_V(8); PG8_WAIT_L(0); PG8_BAR; PG8_MMA(1, 0, At, B0); PG8_MMA(1, 1, At, B1); PG8_BAR; PG8_SCHED;
        }
        }
        if constexpr (ALIGN_EPI) { if (wr == 0) PG8_BAR; }
        { int ln_; asm volatile("v_mbcnt_lo_u32_b32 %0, -1, 0\n\tv_mbcnt_hi_u32_b32 %0, -1, %0" : "=v"(ln_));
          if constexpr (Epi::PRELOAD) E(acc, cur, wr, wc, ln_ & 15, ln_ >> 4, pre); else E(acc, cur, wr, wc, ln_ & 15, ln_ >> 4); }
        if (!has_next) break;
#pragma unroll
        for (int a = 0; a < 2; ++a)
#pragma unroll
            for (int b = 0; b < 2; ++b)
#pragma unroll
                for (int m = 0; m < 4; ++m)
#pragma unroll
                    for (int n = 0; n < 2; ++n) acc[a][b][m][n] = (f32x4){0.f, 0.f, 0.f, 0.f};
        cur = nxt; cA = nA; cB = nB; ++ui;
        if constexpr (ALIGN_EPI) { if (wr == 1) PG8_BAR; }
    }
    PG8_WAIT_V(0);
    if constexpr (!ALIGN_EPI) { if (wr == 0) PG8_BAR; }
    PG8_BAR;
#undef PG8_SA
#undef PG8_SB
#undef PG8_STAGE
#undef PG8_LDA
#undef PG8_LDB
#undef PG8_MMA
#undef PG8_WAIT_V
#undef PG8_WAIT_L
#undef PG8_BAR
#undef PG8_SCHED
}
}
constexpr int NWAVES = 8, NT = NWAVES * 64;
constexpr int M = 8192, D = 2048, SEQ = 2048, NBATCH = 4, DEPTH = 2;
constexpr int INW = 13316, NPROJ = 13312, MIXW = 512, HD = 128;
constexpr int PEER_E = 16384;
constexpr float EPS = 1e-6f;
constexpr float ATT_SCALE = 0.08838834764831845f;

constexpr size_t MiB = 1u << 20;
constexpr size_t WS_CTL = 0, CTL_ZERO_BYTES = 1 * MiB;
constexpr size_t WS_SSQ = 0;
constexpr size_t WS_SSA = 256 * 1024;
constexpr size_t WS_WF = 1 * MiB;
constexpr size_t WS_BINR = WS_WF + 64 * 1024;
constexpr size_t WS_LOGF = 2 * MiB;
constexpr size_t WS_CUM = 3 * MiB;
constexpr size_t WS_WIN = 8 * MiB;
constexpr size_t WIN_BYTES = (size_t)NPROJ * D;
constexpr size_t WS_SW = 7 * MiB;
constexpr size_t WS_CMAX = 384 * 1024;
constexpr size_t WS_HB8 = 64 * MiB;
constexpr size_t WS_SA = 7 * MiB + 512 * 1024;
constexpr size_t WS_WBR = 112 * MiB, WS_WOUT = 128 * MiB, WS_WQ = 144 * MiB;
constexpr size_t SQ_BYTES = (size_t)D * D * 2;
constexpr size_t WS_PU = 160 * MiB, WS_PV = 288 * MiB;
constexpr size_t PE_BYTES = (size_t)PEER_E * D;
constexpr size_t WS_PK = 6 * MiB;
constexpr size_t WS_SU = 5 * MiB, WS_SV = 5 * MiB + 256 * 1024;
constexpr size_t WS_H = 416 * MiB;
constexpr size_t WS_HB = 480 * MiB;
constexpr size_t WS_PROJ = 512 * MiB;
constexpr size_t PROJ_T = (size_t)M * MIXW;
constexpr size_t WS_R = 592 * MiB;
constexpr size_t R_PLANE = (size_t)M * D;
constexpr size_t WS_Y = 720 * MiB;
constexpr size_t WS_MRG = 752 * MiB;
constexpr size_t WS_Q = 784 * MiB;
constexpr size_t WS_END = 816 * MiB;

constexpr int RING_BYTES = 131072;
constexpr int LDS_BYTES = 147456;

typedef unsigned short bf16;
typedef unsigned v4u __attribute__((ext_vector_type(4)));
typedef unsigned v2u __attribute__((ext_vector_type(2)));
typedef float f32x4 __attribute__((ext_vector_type(4)));
typedef float f32x2 __attribute__((ext_vector_type(2)));
using bf16x2 = __attribute__((ext_vector_type(2))) __bf16;
#define LAS __attribute__((address_space(3)))

__device__ __forceinline__ unsigned f2bf(float f) { unsigned u = __builtin_bit_cast(unsigned, f); return (u + 0x7fffu + ((u >> 16) & 1u)) >> 16; }
__device__ __forceinline__ unsigned pk2(float lo, float hi) { return f2bf(lo) | (f2bf(hi) << 16); }
__device__ __forceinline__ float bflo(unsigned w) { return __builtin_bit_cast(float, w << 16); }
__device__ __forceinline__ float bfhi(unsigned w) { return __builtin_bit_cast(float, w & 0xffff0000u); }
__device__ __forceinline__ float bf2f(bf16 b) { return __builtin_bit_cast(float, ((unsigned)b) << 16); }
__device__ __forceinline__ float shf(float v, int src) { return __builtin_bit_cast(float, __builtin_amdgcn_ds_bpermute(src << 2, __builtin_bit_cast(int, v))); }
__device__ __forceinline__ int shi(int v, int src) { return __builtin_amdgcn_ds_bpermute(src << 2, v); }
__device__ __forceinline__ float wave_sum(float v, int lane) {
#pragma unroll
    for (int o = 1; o < 64; o <<= 1) v += shf(v, lane ^ o);
    return v;
}
__device__ __forceinline__ float wave_max(float v, int lane) {
#pragma unroll
    for (int o = 1; o < 64; o <<= 1) v = fmaxf(v, shf(v, lane ^ o));
    return v;
}
__device__ __forceinline__ float ssa_to_f(unsigned long long v) { return (float)((double)v * (1.0 / 4294967296.0)); }
__device__ __forceinline__ float dot2_bf16(unsigned w, unsigned x, float acc) { return __builtin_amdgcn_fdot2_f32_bf16(__builtin_bit_cast(bf16x2, w), __builtin_bit_cast(bf16x2, x), acc, false); }

#define LANE_ID(x) asm volatile("v_mbcnt_lo_u32_b32 %0, -1, 0\n\tv_mbcnt_hi_u32_b32 %0, -1, %0" : "=v"(x))
struct Args {
    const float *x, *norm_mix, *w_in, *b_in, *pool_w, *pool_scale, *conv_w, *rel_bias, *w_branch, *w_out, *norm_ffn, *peer_wq, *peer_keys, *peer_u, *peer_v, *norm_final;
    float* out; unsigned char* ws;
};
#define GAS __attribute__((address_space(1)))
#define CAS __attribute__((address_space(4)))
struct ArgsK {
    const GAS float *x, *norm_mix, *w_in, *b_in, *pool_w, *pool_scale, *conv_w, *rel_bias, *w_branch, *w_out, *norm_ffn, *peer_wq, *peer_keys, *peer_u, *peer_v, *norm_final;
    GAS float* out; GAS unsigned char* ws;
};
__device__ __forceinline__ Args load_args(const CAS ArgsK* k, size_t zoff) {
    Args a;
    a.x = (const float*)k->x; a.norm_mix = (const float*)k->norm_mix; a.w_in = (const float*)k->w_in; a.b_in = (const float*)k->b_in; a.pool_w = (const float*)k->pool_w;
    a.pool_scale = (const float*)k->pool_scale; a.conv_w = (const float*)k->conv_w; a.rel_bias = (const float*)k->rel_bias; a.w_branch = (const float*)k->w_branch;
    a.w_out = (const float*)k->w_out; a.norm_ffn = (const float*)k->norm_ffn; a.peer_wq = (const float*)k->peer_wq; a.peer_keys = (const float*)k->peer_keys;
    a.peer_u = (const float*)k->peer_u; a.peer_v = (const float*)k->peer_v; a.norm_final = (const float*)k->norm_final; a.out = (float*)k->out; a.ws = (unsigned char*)(k->ws + zoff);
    return a;
}

using pg8::f32x4; using pg8::Unit;
constexpr size_t WS_G = 896 * MiB;
constexpr size_t WS_SWH = 7 * MiB + 256 * 1024, WS_BIH = 7 * MiB + 384 * 1024;
constexpr size_t WS_RSA = 7 * MiB + 768 * 1024;
struct EpiProj {
    static constexpr bool PERM = true, HOOK = false, PRELOAD = true;
    struct Pre { pg8::u32x4 sw[2], bi[2]; float rs[2][4]; };
    unsigned char* wsb; const bf16* biash; const float* rsa; const bf16* swh;
    __device__ __forceinline__ void preload(Pre& p, const Unit& u, int wr, int wc, int fr, int fq) const {
        const int row0 = u.pm * 256 + wr * 64 + fr, bcol0 = u.pn * 256 + wc * 32 + 8 * fq;
#pragma unroll
        for (int bj = 0; bj < 2; ++bj) { p.sw[bj] = *(const pg8::u32x4*)(swh + bcol0 + bj * 128); p.bi[bj] = *(const pg8::u32x4*)(biash + bcol0 + bj * 128); }
#pragma unroll
        for (int ai = 0; ai < 2; ++ai)
#pragma unroll
            for (int m = 0; m < 4; ++m) p.rs[ai][m] = rsa[row0 + ai * 128 + m * 16];
    }
    __device__ __forceinline__ void operator()(f32x4 (&acc)[2][2][4][2], const Unit& u, int wr, int wc, int fr, int fq, const Pre& p) const {
        const int cl0 = wc * 32 + 8 * fq;
#define ACCF(ai, bj, m, n) __builtin_convertvector(__builtin_bit_cast(pg8::i32x4, acc[ai][bj][m][n]), f32x4)
        const __amdgpu_buffer_rsrc_t rW = __builtin_amdgcn_make_buffer_rsrc((void*)wsb, 0, 0x7fffffff, 0x00020000);
        int sbase, ldb;
        if (u.pn < 20) { sbase = (int)WS_PROJ + ((u.pn >> 1) * (int)PROJ_T + (u.pn & 1) * 256) * 2; ldb = MIXW * 2; } else { sbase = (int)WS_G + (u.pn - 20) * 512; ldb = 4 * D * 2; }
        const int voff = fr * ldb + cl0 * 2; sbase += (u.pm * 256 + wr * 64) * ldb;
#pragma unroll
        for (int bj = 0; bj < 2; ++bj) { const f32x4 w0 = {bflo(p.sw[bj].x), bfhi(p.sw[bj].x), bflo(p.sw[bj].y), bfhi(p.sw[bj].y)}, w1 = {bflo(p.sw[bj].z), bfhi(p.sw[bj].z), bflo(p.sw[bj].w), bfhi(p.sw[bj].w)};
            const f32x4 b0 = {bflo(p.bi[bj].x), bfhi(p.bi[bj].x), bflo(p.bi[bj].y), bfhi(p.bi[bj].y)}, b1 = {bflo(p.bi[bj].z), bfhi(p.bi[bj].z), bflo(p.bi[bj].w), bfhi(p.bi[bj].w)};
#pragma unroll
            for (int ai = 0; ai < 2; ++ai)
#pragma unroll
                for (int m = 0; m < 4; ++m) { const float rs = p.rs[ai][m]; f32x4 v0 = ACCF(ai, bj, m, 0) * rs * w0 + b0, v1 = ACCF(ai, bj, m, 1) * rs * w1 + b1;
                    if (u.pn >= 20) {
                        v0 = (f32x4){fminf(1.0f + __builtin_amdgcn_exp2f(-1.4426950408889634f * v0[0]), 1e18f), fminf(1.0f + __builtin_amdgcn_exp2f(-1.4426950408889634f * v0[1]), 1e18f), fminf(1.0f + __builtin_amdgcn_exp2f(-1.4426950408889634f * v0[2]), 1e18f), fminf(1.0f + __builtin_amdgcn_exp2f(-1.4426950408889634f * v0[3]), 1e18f)};
                        v1 = (f32x4){fminf(1.0f + __builtin_amdgcn_exp2f(-1.4426950408889634f * v1[0]), 1e18f), fminf(1.0f + __builtin_amdgcn_exp2f(-1.4426950408889634f * v1[1]), 1e18f), fminf(1.0f + __builtin_amdgcn_exp2f(-1.4426950408889634f * v1[2]), 1e18f), fminf(1.0f + __builtin_amdgcn_exp2f(-1.4426950408889634f * v1[3]), 1e18f)}; }
                    pg8::u32x4 w; w.x = pg8::cvt_pk_bf16(v0[0], v0[1]); w.y = pg8::cvt_pk_bf16(v0[2], v0[3]); w.z = pg8::cvt_pk_bf16(v1[0], v1[1]); w.w = pg8::cvt_pk_bf16(v1[2], v1[3]);
                    __builtin_amdgcn_raw_buffer_store_b128(w, rW, voff + bj * 256, sbase + (ai * 128 + m * 16) * ldb, 0); } }
    }
};
#undef ACCF
struct EpiMerge {
    static constexpr bool PERM = true, HOOK = true; static constexpr bool PRELOAD = false; struct Pre {};
    const bf16* G; bf16* O;
    struct Bt { pg8::u32x4 n[2][2], d[2][2]; };
    __device__ __forceinline__ void scale(f32x4 (&acc)[2][2][4][2], const Unit& u, int g, int wr, int wc, int fr, int fq) const {
        const __amdgpu_buffer_rsrc_t rs = __builtin_amdgcn_make_buffer_rsrc((void*)G, 0, 0x7fffffff, 0x00020000);
        int voff = (fr * 4 * D + 8 * fq) * 2; asm volatile("" : "+v"(voff));
        const int sden = ((u.pm * 256 + wr * 64) * 4 * D + (g - 1) * D + u.pn * 256 + wc * 32) * 2, snum = sden + D * 2;
        const bool fin = g == 4;
#define MG_LOAD(B, b0) do { _Pragma("unroll") for (int i = 0; i < 2; ++i) _Pragma("unroll") for (int bj = 0; bj < 2; ++bj) { const int ai_ = ((b0) + i) >> 2, m_ = ((b0) + i) & 3, so_ = (ai_ * 128 + m_ * 16) * 4 * D * 2; \
            B.d[i][bj] = __builtin_amdgcn_raw_buffer_load_b128(rs, voff + bj * 256, sden + so_, 0); if (!fin) B.n[i][bj] = __builtin_amdgcn_raw_buffer_load_b128(rs, voff + bj * 256, snum + so_, 0); } } while (0)
#define MG_APPLY(B, b0) do { _Pragma("unroll") for (int i = 0; i < 2; ++i) _Pragma("unroll") for (int bj = 0; bj < 2; ++bj) { const int ai_ = ((b0) + i) >> 2, m_ = ((b0) + i) & 3; const pg8::u32x4 dv = B.d[i][bj], nv = B.n[i][bj]; \
            f32x4 r0 = {__builtin_amdgcn_rcpf(bflo(dv.x)), __builtin_amdgcn_rcpf(bfhi(dv.x)), __builtin_amdgcn_rcpf(bflo(dv.y)), __builtin_amdgcn_rcpf(bfhi(dv.y))}, r1 = {__builtin_amdgcn_rcpf(bflo(dv.z)), __builtin_amdgcn_rcpf(bfhi(dv.z)), __builtin_amdgcn_rcpf(bflo(dv.w)), __builtin_amdgcn_rcpf(bfhi(dv.w))}; \
            if (!fin) { r0 *= (f32x4){bflo(nv.x), bfhi(nv.x), bflo(nv.y), bfhi(nv.y)}; r1 *= (f32x4){bflo(nv.z), bfhi(nv.z), bflo(nv.w), bfhi(nv.w)}; } \
            acc[ai_][bj][m_][0] *= r0; acc[ai_][bj][m_][1] *= r1; asm volatile("" : "+v"(acc[ai_][bj][m_][0]), "+v"(acc[ai_][bj][m_][1])); } } while (0)
        Bt A = {}, B = {};
        MG_LOAD(A, 0);
        MG_LOAD(B, 2); MG_APPLY(A, 0); asm volatile("" ::: "memory");
        MG_LOAD(A, 4); MG_APPLY(B, 2); asm volatile("" ::: "memory");
        MG_LOAD(B, 6); MG_APPLY(A, 4); asm volatile("" ::: "memory");
        MG_APPLY(B, 6); asm volatile("" ::: "memory");
#undef MG_LOAD
#undef MG_APPLY
    }
    __device__ __forceinline__ void hook(f32x4 (&acc)[2][2][4][2], const Unit& u, int g, int wr, int wc, int fr, int fq) const { scale(acc, u, g, wr, wc, fr, fq); }
    __device__ __forceinline__ void operator()(f32x4 (&acc)[2][2][4][2], const Unit& u, int wr, int wc, int fr, int fq) const {
        scale(acc, u, 4, wr, wc, fr, fq);
        const int row0 = u.pm * 256 + wr * 64 + fr, col0 = u.pn * 256 + wc * 32 + 8 * fq;
#pragma unroll
        for (int ai = 0; ai < 2; ++ai)
#pragma unroll
            for (int m = 0; m < 4; ++m) { bf16* rowp = O + (size_t)(row0 + ai * 128 + m * 16) * D + col0;
#pragma unroll
                for (int bj = 0; bj < 2; ++bj) { const f32x4 v0 = acc[ai][bj][m][0], v1 = acc[ai][bj][m][1];
                    pg8::u32x4 w; w.x = pg8::cvt_pk_bf16(v0[0], v0[1]); w.y = pg8::cvt_pk_bf16(v0[2], v0[3]); w.z = pg8::cvt_pk_bf16(v1[0], v1[1]); w.w = pg8::cvt_pk_bf16(v1[2], v1[3]);
                    *(pg8::u32x4*)(rowp + bj * 128) = w; } }
    }
};
struct EpiRes {
    static constexpr bool PERM = false, HOOK = false; static constexpr bool PRELOAD = false; struct Pre {};
    const float* Hin; float* H; bf16* HB; unsigned long long* ssa;
    __device__ __forceinline__ void operator()(f32x4 (&acc)[2][2][4][2], const Unit& u, int wr, int wc, int fr, int fq) const {
        const int row0 = u.pm * 256 + wr * 64 + fr, col0 = u.pn * 256 + wc * 32 + 4 * fq;
#pragma unroll
        for (int ai = 0; ai < 2; ++ai)
#pragma unroll
            for (int m = 0; m < 4; ++m) { const int row = row0 + ai * 128 + m * 16; const size_t off = (size_t)row * D + col0; float s = 0.f;
#pragma unroll
                for (int bj = 0; bj < 2; ++bj)
#pragma unroll
                    for (int n = 0; n < 2; ++n) { const size_t o = off + bj * 128 + n * 16; const f32x4 h = *(const f32x4*)(Hin + o) + acc[ai][bj][m][n];
                        *(f32x4*)(H + o) = h; pg8::u32x2 w; w.x = pg8::cvt_pk_bf16(h[0], h[1]); w.y = pg8::cvt_pk_bf16(h[2], h[3]); *(pg8::u32x2*)(HB + o) = w;
                        s += (h[0] * h[0] + h[1] * h[1]) + (h[2] * h[2] + h[3] * h[3]); }
                { const int ln = fq * 16 + fr; s += shf(s, ln ^ 16); s += shf(s, ln ^ 32); }
                if (fq == 0) atomicAdd(ssa + row, (unsigned long long)((double)s * 4294967296.0)); }
    }
};
struct EpiQ {
    static constexpr bool PERM = true, HOOK = false; static constexpr bool PRELOAD = false; struct Pre {};
    bf16* O; const unsigned long long* ssa;
    __device__ __forceinline__ void operator()(f32x4 (&acc)[2][2][4][2], const Unit& u, int wr, int wc, int fr, int fq) const {
        const int row0 = u.pm * 256 + wr * 64 + fr, col0 = u.pn * 256 + wc * 32 + 8 * fq;
#pragma unroll
        for (int ai = 0; ai < 2; ++ai)
#pragma unroll
            for (int m = 0; m < 4; ++m) { const int row = row0 + ai * 128 + m * 16; const float rs = rsqrtf(ssa_to_f(ssa[row]) * (1.0f / D) + EPS);
                bf16* rowp = O + (size_t)row * D + col0;
#pragma unroll
                for (int bj = 0; bj < 2; ++bj) { const f32x4 v0 = acc[ai][bj][m][0] * rs, v1 = acc[ai][bj][m][1] * rs;
                    pg8::u32x4 w; w.x = pg8::cvt_pk_bf16(v0[0], v0[1]); w.y = pg8::cvt_pk_bf16(v0[2], v0[3]); w.z = pg8::cvt_pk_bf16(v1[0], v1[1]); w.w = pg8::cvt_pk_bf16(v1[2], v1[3]);
                    *(pg8::u32x4*)(rowp + bj * 128) = w; } }
    }
};

__device__ __forceinline__ int colmap_in(int j) { return j < 1536 ? j : j + 4; }
__device__ __forceinline__ void tr_item_i8(const float* W, const float* gain, const unsigned* cmax, unsigned char* WT, LAS float* scr, int k0, int n0, int lane) {
    const int q = lane & 7, r8 = lane >> 3, sc = colmap_in(n0 + 4 * q);
    f32x4 v[8];
#pragma unroll
    for (int i = 0; i < 8; ++i) v[i] = *(const f32x4*)(W + (size_t)(k0 + 8 * i + r8) * INW + sc);
    f32x4 inv;
#pragma unroll
    for (int e = 0; e < 4; ++e) { const float cm = __builtin_bit_cast(float, cmax[sc + e]); inv[e] = cm > 0.f ? 127.0f / cm : 0.f; }
#pragma unroll
    for (int i = 0; i < 8; ++i) { const float g = gain[k0 + 8 * i + r8];
#pragma unroll
        for (int e = 0; e < 4; ++e) scr[(8 * i + r8) * 33 + 4 * q + e] = v[i][e] * g * inv[e]; }
    asm volatile("s_waitcnt lgkmcnt(0)" ::: "memory");
    const int n = lane >> 1, hf = lane & 1;
    v4u o[2];
#pragma unroll
    for (int w = 0; w < 8; ++w) { unsigned pk = 0;
#pragma unroll
        for (int b = 0; b < 4; ++b) pk |= ((unsigned)((int)rintf(scr[(32 * hf + 4 * w + b) * 33 + n]) & 255)) << (8 * b);
        o[w >> 2][w & 3] = pk; }
    unsigned char* dst = WT + (size_t)(n0 + n) * D + k0 + 32 * hf;
    *(v4u*)dst = o[0]; *(v4u*)(dst + 16) = o[1];
    asm volatile("s_waitcnt lgkmcnt(0)" ::: "memory");
}
template <bool MAP>
__device__ __forceinline__ void tr_item(const float* W, int ldw, const float* scale, bf16* WT, int ldt, int dcol0, LAS float* scr, int k0, int n0, int lane) {
    const int q = lane & 7, r8 = lane >> 3, sc = MAP ? colmap_in(n0 + 4 * q) : (n0 + 4 * q);
    f32x4 v[8];
#pragma unroll
    for (int i = 0; i < 8; ++i) v[i] = *(const f32x4*)(W + (size_t)(k0 + 8 * i + r8) * ldw + sc);
    f32x4 s0 = {1.f, 1.f, 1.f, 1.f}, s1 = s0;
    if (scale) { s0 = *(const f32x4*)(scale + k0 + 8 * q); s1 = *(const f32x4*)(scale + k0 + 8 * q + 4); }
#pragma unroll
    for (int i = 0; i < 8; ++i)
#pragma unroll
        for (int e = 0; e < 4; ++e) scr[(8 * i + r8) * 33 + 4 * q + e] = v[i][e];
    asm volatile("s_waitcnt lgkmcnt(0)" ::: "memory");
    const int c = q;
#pragma unroll
    for (int j = 0; j < 4; ++j) { const int n = r8 + 8 * j; const LAS float* s = scr + (8 * c) * 33 + n;
        v4u o; o.x = pk2(s[0 * 33] * s0[0], s[1 * 33] * s0[1]); o.y = pk2(s[2 * 33] * s0[2], s[3 * 33] * s0[3]); o.z = pk2(s[4 * 33] * s1[0], s[5 * 33] * s1[1]); o.w = pk2(s[6 * 33] * s1[2], s[7 * 33] * s1[3]);
        *(v4u*)(WT + (size_t)(n0 + n) * ldt + dcol0 + k0 + 8 * c) = o; }
    asm volatile("s_waitcnt lgkmcnt(0)" ::: "memory");
}
constexpr size_t WS_BAR = 512 * 1024;
#define XB_TMO      128
#define XB_XCNT(j)  (256  + 64 * (j))
#define XB_XSUB(j)  (1280 + 64 * (j))
#define XB_XGEN(j)  (2304 + 64 * (j))
#define XB_TOP      3328
#define XB_TOPGEN   3392
#define XCD_BAR_WORDS 3456
#define XB_SPIN_CAP (1u << 23)
__device__ __forceinline__ unsigned xb_ld(unsigned* p)              { return __hip_atomic_load(p, __ATOMIC_RELAXED, __HIP_MEMORY_SCOPE_AGENT); }
__device__ __forceinline__ unsigned xb_add(unsigned* p, unsigned v) { return __hip_atomic_fetch_add(p, v, __ATOMIC_RELAXED, __HIP_MEMORY_SCOPE_AGENT); }
__device__ __forceinline__ unsigned xb_xcc_id() { return (unsigned)__builtin_amdgcn_s_getreg((3 << 11) | 20) & 0xFu; }
#define XB_SPIN(cond, bar) do { unsigned _sp = 0; while (cond) { __builtin_amdgcn_s_sleep(1); \
    if ((++_sp & 255u) == 0u) { if (xb_ld(&(bar)[XB_TMO])) break; if (_sp > XB_SPIN_CAP) { atomicAdd(&(bar)[XB_TMO], 1u); break; } } } } while (0)
__device__ __forceinline__ void xcd_barrier_complete(unsigned* bar, unsigned x, unsigned G, unsigned& nloc, unsigned& nx) {
    unsigned sum, cnt, mine, sp = 0u;
    for (;;) {
        sum = 0u; cnt = 0u; mine = 0u;
#pragma unroll
        for (unsigned j = 0; j < 16; ++j) { const unsigned c = xb_ld(&bar[XB_XCNT(j)]); sum += c; cnt += (c > 0u) ? 1u : 0u; mine = (j == x) ? c : mine; }
        if (sum == G) break;
        __builtin_amdgcn_s_sleep(1);
        if ((++sp & 255u) == 0u) { if (xb_ld(&bar[XB_TMO])) break; if (sp > XB_SPIN_CAP) { atomicAdd(&bar[XB_TMO], 1u); break; } }
    }
    nloc = mine > 0u ? mine : 1u; nx = cnt > 0u ? cnt : 1u;
}
__device__ __forceinline__ void xcd_barrier(unsigned* bar, unsigned x, unsigned G, volatile LAS unsigned* st, int wave) {
    asm volatile("s_waitcnt vmcnt(0)" ::: "memory");
    __syncthreads();
    int lane; asm volatile("v_mbcnt_lo_u32_b32 %0, -1, 0\n\tv_mbcnt_hi_u32_b32 %0, -1, %0" : "=v"(lane));
    if (wave == 0 && lane == 0) {
        __builtin_amdgcn_s_waitcnt(0);
        unsigned nloc = st[0], nx = st[1];
        if (nloc == 0u) { xcd_barrier_complete(bar, x, G, nloc, nx); st[0] = nloc; st[1] = nx; }
        const unsigned old = xb_add(&bar[XB_XSUB(x)], 1u);
        const unsigned gen = old / nloc;
        if (old + 1u == (gen + 1u) * nloc) {
            __builtin_amdgcn_fence(__ATOMIC_RELEASE, "agent");
            asm volatile("s_waitcnt vmcnt(0)" ::: "memory");
            const unsigned og = xb_add(&bar[XB_TOP], 1u);
            const unsigned tg = og / nx;
            if (og + 1u == (tg + 1u) * nx) xb_add(&bar[XB_TOPGEN], 1u);
            else XB_SPIN(xb_ld(&bar[XB_TOPGEN]) == tg, bar);
            __builtin_amdgcn_fence(__ATOMIC_ACQUIRE, "agent");
            xb_add(&bar[XB_XGEN(x)], 1u);
            asm volatile("s_waitcnt vmcnt(0)" ::: "memory");
        } else {
            XB_SPIN(xb_ld(&bar[XB_XGEN(x)]) == gen, bar);
            __builtin_amdgcn_fence(__ATOMIC_ACQUIRE, "agent");
            asm volatile("s_waitcnt vmcnt(0)" ::: "memory");
        }
    }
    __syncthreads();
}
namespace att {
constexpr int D = 128, NW = 8, QBLK = 32, KVBLK = 64, QB = NW * QBLK;
constexpr int PITCH = 512, OPITCH = 2048;
constexpr float SCALE = 0.08838834764831845f, THR = 8.f;
constexpr int SHM_V = KVBLK * D * 2, SHM_K = KVBLK * D * 2;
constexpr int OFF_WS = 2 * SHM_V + 2 * SHM_K, OFF_CUM = OFF_WS + NW * 64 * 4, OFF_REL = OFF_CUM + 2048 * 4, LDS_END = OFF_REL + 320 * 4;
typedef unsigned short bf16;
typedef short bf16x8 __attribute__((ext_vector_type(8)));
typedef short s16x4 __attribute__((ext_vector_type(4)));
typedef float f32x16 __attribute__((ext_vector_type(16)));
typedef float f32x4 __attribute__((ext_vector_type(4)));
typedef unsigned u32x4 __attribute__((ext_vector_type(4)));
#define ALDS __attribute__((address_space(3)))

#define KSWZ(row, colB) ((row) * 256 + ((colB) ^ (((row) & 7) << 4)))
#define SBAR() __builtin_amdgcn_sched_barrier(0)
__device__ __forceinline__ int v_st(int k, int c) { const int kk = (k & ~0xC) | ((k & 4) << 1) | ((k & 8) >> 1); return ((kk >> 3) * 4 + (c >> 5)) * 512 + ((kk & 7) * 32 + (c & 31)) * 2; }
__device__ __forceinline__ int v_rd_base(int lane) { return ((lane & 3) << 3) | (((lane >> 2) & 3) << 6) | (((lane >> 4) & 1) << 5) | (((lane >> 5) & 1) << 8); }
constexpr int v_rd_off(int d0, int ks, int half) { return d0 * 512 + ks * 4096 + half * 2048; }
__device__ __forceinline__ int crow(int r, int hi) { return (r & 3) + 8 * (r >> 2) + 4 * hi; }
__device__ __forceinline__ unsigned cvtpk(float lo, float hi) { unsigned r; asm volatile("v_cvt_pk_bf16_f32 %0, %1, %2" : "=v"(r) : "v"(lo), "v"(hi)); return r; }
__device__ __forceinline__ bf16x8 load8(const bf16* p) { return *reinterpret_cast<const bf16x8*>(p); }

__device__ __forceinline__ void mask_tile(f32x16& p0, f32x16& p1, int dq) {
    const float NEG = -__builtin_inff();
#pragma unroll
    for (int r = 0; r < 16; ++r) { const int c = (r & 3) + 8 * (r >> 2);
        if (dq - c < 0) p0[r] = NEG;
        if (dq - c - 32 < 0) p1[r] = NEG; }
}
__device__ __forceinline__ void partialSM(f32x16& p0, f32x16& p1, float& m_reg, float& mn, float& alpha) {
    float pmax = p0[0];
#pragma unroll
    for (int r = 1; r < 16; ++r) pmax = fmaxf(pmax, p0[r]);
#pragma unroll
    for (int r = 0; r < 16; ++r) pmax = fmaxf(pmax, p1[r]);
    { auto rr = __builtin_amdgcn_permlane32_swap(__float_as_uint(pmax), __float_as_uint(pmax), false, false);
      pmax = fmaxf(__uint_as_float(rr[0]), __uint_as_float(rr[1])); }
    constexpr float C2 = 1.4426950408889634f * SCALE;
    if (__builtin_expect(__all((pmax - m_reg) * SCALE <= THR), 1)) { mn = m_reg; alpha = 1.f; }
    else { mn = fmaxf(m_reg, pmax); alpha = __builtin_amdgcn_exp2f((m_reg - mn) * C2); m_reg = mn; }
    const float mnL = -mn * C2;
#pragma unroll
    for (int r = 0; r < 16; ++r) p0[r] = fmaf(p0[r], C2, mnL);
#pragma unroll
    for (int r = 0; r < 16; ++r) p1[r] = fmaf(p1[r], C2, mnL);
#pragma unroll
    for (int r = 0; r < 16; ++r) p0[r] = __builtin_amdgcn_exp2f(p0[r]);
}
__device__ __forceinline__ void finishSM(f32x16& p0, f32x16& p1, float alpha, float& l_reg, bf16x8& pa0, bf16x8& pa1, bf16x8& pa2, bf16x8& pa3) {
#pragma unroll
    for (int r = 0; r < 16; ++r) p1[r] = __builtin_amdgcn_exp2f(p1[r]);
    float ps = 0;
#pragma unroll
    for (int r = 0; r < 16; ++r) ps += p0[r];
#pragma unroll
    for (int r = 0; r < 16; ++r) ps += p1[r];
    { auto rr = __builtin_amdgcn_permlane32_swap(__float_as_uint(ps), __float_as_uint(ps), false, false);
      ps = __uint_as_float(rr[0]) + __uint_as_float(rr[1]); }
    l_reg = l_reg * alpha + ps;
#define PK4(P, B_, OUT) do { unsigned a0 = cvtpk(P[B_+0], P[B_+1]), a1 = cvtpk(P[B_+2], P[B_+3]);                          \
        unsigned b0 = cvtpk(P[B_+4], P[B_+5]), b1 = cvtpk(P[B_+6], P[B_+7]);                                             \
        auto r0 = __builtin_amdgcn_permlane32_swap(a0, b0, false, false); auto r1 = __builtin_amdgcn_permlane32_swap(a1, b1, false, false); \
        u32x4 w = {r0[0], r1[0], r0[1], r1[1]}; OUT = *reinterpret_cast<bf16x8*>(&w); } while (0)
    PK4(p0, 0, pa0); PK4(p0, 8, pa1); PK4(p1, 0, pa2); PK4(p1, 8, pa3);
#undef PK4
}
template <int KB>
__device__ __forceinline__ void qkt(f32x16& p0, f32x16& p1, const ALDS char* K_lds, int r32, int hi, const bf16x8* qr, bool act) {
    if (!act) { const float NEG = -__builtin_inff();
#pragma unroll
        for (int r = 0; r < 16; ++r) { p0[r] = NEG; p1[r] = NEG; } return; }
    p0 = f32x16{}; p1 = f32x16{};
    const ALDS char* kb[4];
#pragma unroll
    for (int dd = 0; dd < 4; ++dd) kb[dd] = K_lds + KB * SHM_K + KSWZ(r32, (dd * 16 + hi * 8) * 2);
#pragma unroll
    for (int d0 = 0; d0 < 8; ++d0) { const ALDS char* a = kb[d0 & 3] + (d0 >> 2) * 128;
        bf16x8 b0 = *(const ALDS bf16x8*)(a);
        bf16x8 b1 = *(const ALDS bf16x8*)(a + 32 * 256);
        p0 = __builtin_amdgcn_mfma_f32_32x32x16_bf16(b0, qr[d0], p0, 0, 0, 0);
        p1 = __builtin_amdgcn_mfma_f32_32x32x16_bf16(b1, qr[d0], p1, 0, 0, 0); }
}
template <int VB>
__device__ __forceinline__ void pv_tile(f32x16* o, int vb0, bf16x8 pa0, bf16x8 pa1, bf16x8 pa2, bf16x8 pa3, bool act) {
    if (!act) return;
#define TRRD(dst, off) asm volatile("ds_read_b64_tr_b16 %0, %1 offset:%2" : "=&v"(dst) : "v"(vb0), "i"(off) : "memory")
#define PV_D0(d0) do { s16x4 l0, l1, l2, l3, h0, h1, h2, h3; constexpr int b_ = VB * SHM_V + v_rd_off(d0, 0, 0); \
        TRRD(l0, b_); TRRD(h0, b_ + 2048); TRRD(l1, b_ + 4096); TRRD(h1, b_ + 6144); TRRD(l2, b_ + 8192); TRRD(h2, b_ + 10240); TRRD(l3, b_ + 12288); TRRD(h3, b_ + 14336); \
        asm volatile("s_waitcnt lgkmcnt(0)" ::: "memory"); SBAR(); \
        o[d0] = __builtin_amdgcn_mfma_f32_32x32x16_bf16(pa0, (bf16x8){l0[0], l0[1], l0[2], l0[3], h0[0], h0[1], h0[2], h0[3]}, o[d0], 0, 0, 0);   \
        o[d0] = __builtin_amdgcn_mfma_f32_32x32x16_bf16(pa1, (bf16x8){l1[0], l1[1], l1[2], l1[3], h1[0], h1[1], h1[2], h1[3]}, o[d0], 0, 0, 0);   \
        o[d0] = __builtin_amdgcn_mfma_f32_32x32x16_bf16(pa2, (bf16x8){l2[0], l2[1], l2[2], l2[3], h2[0], h2[1], h2[2], h2[3]}, o[d0], 0, 0, 0);   \
        o[d0] = __builtin_amdgcn_mfma_f32_32x32x16_bf16(pa3, (bf16x8){l3[0], l3[1], l3[2], l3[3], h3[0], h3[1], h3[2], h3[3]}, o[d0], 0, 0, 0); } while (0)
    PV_D0(0); PV_D0(1); PV_D0(2); PV_D0(3);
#undef PV_D0
#undef TRRD
}
template <int MODE>
__device__ __forceinline__ void bias_mask(f32x16& p0, f32x16& p1, const ALDS char* lds, int kb, int qlo, int qpos, int hi, float cqs, bool act) {
    if (!act) return;
    if (MODE == 0) {
        const ALDS float* cs = (const ALDS float*)(lds + OFF_CUM) + kb + 4 * hi;
#pragma unroll
        for (int g = 0; g < 4; ++g) { const f32x4 c0 = *(const ALDS f32x4*)(cs + 8 * g), c1 = *(const ALDS f32x4*)(cs + 32 + 8 * g);
#pragma unroll
            for (int e = 0; e < 4; ++e) { p0[4 * g + e] += cqs - c0[e]; p1[4 * g + e] += cqs - c1[e]; } }
        if (kb + KVBLK - 1 > qlo) mask_tile(p0, p1, qpos - 4 * hi - kb);
    } else {
        const ALDS float* tb = (const ALDS float*)(lds + OFF_REL);
        if (qlo - (kb + KVBLK - 1) >= 256) { const float c = tb[319];
#pragma unroll
            for (int r = 0; r < 16; ++r) { p0[r] += c; p1[r] += c; } }
        else { const int d0 = qpos - kb - 4 * hi + 63;
#pragma unroll
            for (int r = 0; r < 16; ++r) { const int c = (r & 3) + 8 * (r >> 2);
                int i0 = d0 - c, i1 = d0 - c - 32; i0 = i0 > 319 ? 319 : i0; i1 = i1 > 319 ? 319 : i1; i1 = i1 < 0 ? 0 : i1; i0 = i0 < 0 ? 0 : i0;
                p0[r] += tb[i0]; p1[r] += tb[i1]; } }
    }
}

struct Seam { bf16x8 qr[8]; bf16x8 st_v0, st_v1, st_k0, st_k1; };
#define VMW() asm volatile("s_waitcnt vmcnt(0)" ::: "memory")
#define BL8(rs, vo, so) __builtin_bit_cast(bf16x8, __builtin_amdgcn_raw_buffer_load_b128(rs, vo, so, 0))
#define SLOAD_H(Kp, Vp, k0) do { S.st_v0 = BL8(rP, kvoff, (Vp) + (k0) * (PITCH * 2)); S.st_v1 = BL8(rP, kvoff, (Vp) + ((k0) + 32) * (PITCH * 2));              \
                         S.st_k0 = BL8(rP, kvoff, (Kp) + (k0) * (PITCH * 2)); S.st_k1 = BL8(rP, kvoff, (Kp) + ((k0) + 32) * (PITCH * 2)); } while (0)
#define SWRITE_HK(bf) do { *(ALDS bf16x8*)(K_lds + (bf) * SHM_K + kws) = S.st_k0; *(ALDS bf16x8*)(K_lds + (bf) * SHM_K + kws + 32 * 256) = S.st_k1; } while (0)
#define SWRITE_HV(bf) do { *(ALDS bf16x8*)(V_lds + (bf) * SHM_V + vst0) = S.st_v0; *(ALDS bf16x8*)(V_lds + (bf) * SHM_V + vst1) = S.st_v1; } while (0)
#define SWRITE_H(bf) do { SWRITE_HV(bf); SWRITE_HK(bf); } while (0)

template <int MODE>
__device__ __forceinline__ void attn_unit(const bf16* Pb, int Qo, int Kh, int Vh, bf16* Yb, int Oo, int P0, int j_lo, int j_hi, ALDS char* lds, int wid, int lane) {
    const int tid = wid * 64 + lane, r32 = lane & 31, hi = lane >> 5;
    const int NT = j_hi - j_lo;
    const int qlo = P0 + wid * QBLK, qpos = qlo + r32;
    ALDS char* V_lds = lds; ALDS char* K_lds = lds + 2 * SHM_V;
    ALDS float* ws = (ALDS float*)(lds + OFF_WS) + wid * 64; ALDS float* li_l = ws; ALDS float* al_l = ws + 32;
    float m_reg = -1e30f, l_reg = 0; f32x16 o[4] = {};
    const int sr = tid >> 4, sc = (tid & 15) * 8, vst0 = v_st(sr, sc), vst1 = v_st(32 + sr, sc), kws = KSWZ(sr, sc * 2);
    const int vb0 = (int)(unsigned)(size_t)V_lds + v_rd_base(lane);
    Seam S;
    const __amdgpu_buffer_rsrc_t rP = __builtin_amdgcn_make_buffer_rsrc((void*)Pb, 0, 0x7fffffff, 0x00020000);
    const __amdgpu_buffer_rsrc_t rO = __builtin_amdgcn_make_buffer_rsrc((void*)Yb, 0, 0x7fffffff, 0x00020000);
    const int kvoff = (sr * PITCH + sc) * 2;
#define KBASE(t) ((j_lo + (t)) * KVBLK)
#define ACT(t) (MODE == 0 ? (KBASE(t) <= qlo + QBLK - 1) : ((j_lo + (t)) <= (qlo >> 6) && (j_lo + (t)) + 8 >= (qlo >> 6)))
#define RESC(a) do { if (__any((a) < 1.f)) { if (hi == 0) al_l[r32] = (a); asm volatile("s_waitcnt lgkmcnt(0)" ::: "memory");              \
                     for (int d_ = 0; d_ < 4; ++d_) for (int r = 0; r < 16; ++r) o[d_][r] *= al_l[crow(r, hi)]; } } while (0)
#define MASKT(P0_, P1_, t) bias_mask<MODE>(P0_, P1_, lds, KBASE(t), qlo, qpos, hi, cq_, ACT(t))
    {
        const int kb0 = j_lo * KVBLK;
#pragma unroll
        for (int d0 = 0; d0 < 8; ++d0) S.qr[d0] = BL8(rP, (r32 * PITCH + hi * 8) * 2 + d0 * 32, Qo + wid * (QBLK * PITCH * 2));
        SLOAD_H(Kh, Vh, kb0); VMW(); SWRITE_HK(0);
        __syncthreads();
    }
    const float cq_ = MODE == 0 ? ((const ALDS float*)(lds + OFF_CUM))[qpos] : 0.f;
    f32x16 pA0, pA1, pB0, pB1; float mnA, mnB, alA, alB; bf16x8 pa0, pa1, pa2, pa3;
    SWRITE_HV(0); SBAR();
    if (NT > 1) { SLOAD_H(Kh, Vh, KBASE(1)); }
    SBAR(); qkt<0>(pA0, pA1, K_lds, r32, hi, S.qr, ACT(0));
    MASKT(pA0, pA1, 0); partialSM(pA0, pA1, m_reg, mnA, alA);
    if (NT > 1) { VMW(); SWRITE_H(1); }
    __syncthreads();
#define HALF_STEP(PX0, PX1, mnX, alX, PY0, PY1, alY, t, KB, VB, SB) do {                                                      \
        SBAR(); qkt<KB>(PX0, PX1, K_lds, r32, hi, S.qr, ACT(t));                                                              \
        finishSM(PY0, PY1, alY, l_reg, pa0, pa1, pa2, pa3); SBAR();                                                           \
        if ((t) + 1 < NT) { SLOAD_H(Kh, Vh, KBASE((t) + 1)); SBAR(); }                                                        \
        pv_tile<VB>(o, vb0, pa0, pa1, pa2, pa3, ACT((t) - 1)); MASKT(PX0, PX1, (t)); partialSM(PX0, PX1, m_reg, mnX, alX);    \
        __syncthreads();                                                                                                      \
        if ((t) + 1 < NT) { VMW(); SWRITE_H(SB); }                                                                            \
        RESC(alX); __syncthreads(); } while (0)
    for (int t = 1; t + 1 < NT; t += 2) {
        HALF_STEP(pB0, pB1, mnB, alB, pA0, pA1, alA, t, 1, 0, 0);
        HALF_STEP(pA0, pA1, mnA, alA, pB0, pB1, alB, t + 1, 0, 1, 1);
    }
    const bool even = (NT & 1) == 0;
    if (even) { SBAR(); qkt<1>(pB0, pB1, K_lds, r32, hi, S.qr, ACT(NT - 1)); SBAR(); }
    finishSM(pA0, pA1, alA, l_reg, pa0, pa1, pa2, pa3); SBAR();
    pv_tile<0>(o, vb0, pa0, pa1, pa2, pa3, ACT(even ? NT - 2 : NT - 1));
    if (even) { MASKT(pB0, pB1, NT - 1); partialSM(pB0, pB1, m_reg, mnB, alB); __syncthreads(); RESC(alB);
        finishSM(pB0, pB1, alB, l_reg, pa0, pa1, pa2, pa3); SBAR(); pv_tile<1>(o, vb0, pa0, pa1, pa2, pa3, ACT(NT - 1)); }
    SBAR();
    if (hi == 0) li_l[r32] = l_reg; asm volatile("s_waitcnt lgkmcnt(0)" ::: "memory");
    float rli[16];
#pragma unroll
    for (int r = 0; r < 16; ++r) rli[r] = __builtin_amdgcn_rcpf(li_l[crow(r, hi)]);
    const int ovoff = (4 * hi * OPITCH + r32) * 2, osoff = Oo + wid * (QBLK * OPITCH * 2);
#pragma unroll
    for (int r = 0; r < 16; ++r) { const int orow = (r & 3) + 8 * (r >> 2);
#pragma unroll
        for (int d0 = 0; d0 < 4; ++d0) { const float v = o[d0][r] * rli[r];
            const float vn = __builtin_bit_cast(float, __builtin_amdgcn_ds_bpermute((lane ^ 1) << 2, __builtin_bit_cast(int, v)));
            if ((r32 & 1) == 0) __builtin_amdgcn_raw_buffer_store_b32(cvtpk(v, vn), rO, ovoff + d0 * 64, osoff + orow * (OPITCH * 2), 0); } }
    __syncthreads();
#undef RESC
#undef KBASE
#undef ACT
#undef MASKT
#undef HALF_STEP
}
#undef BL8
#undef VMW
#undef SLOAD_H
#undef SWRITE_HK
#undef SWRITE_HV
#undef SWRITE_H
#undef KSWZ
#undef SBAR
}
constexpr size_t WS_QCTR = 768 * 1024;
constexpr size_t WS_POOLW = 4 * MiB;
constexpr int N_ATT_UNITS = 256, N_POOL_UNITS = 512, N_CONV_UNITS = 128;

__device__ __forceinline__ void stage_cum(const Args& a, int b, int h, LAS char* lds, int wave, int lane) {
    const float* logf = (const float*)(a.ws + WS_LOGF) + ((size_t)b * SEQ) * 4 + h;
    const int tid = wave * 64 + lane;
    float v[4];
#pragma unroll
    for (int e = 0; e < 4; ++e) v[e] = logf[(size_t)(4 * tid + e) * 4];
    v[1] += v[0]; v[2] += v[1]; v[3] += v[2];
    float incl = v[3];
#pragma unroll
    for (int o = 1; o < 64; o <<= 1) { const float t = shf(incl, lane >= o ? lane - o : lane); if (lane >= o) incl += t; }
    LAS float* wt = (LAS float*)(lds + att::OFF_WS);
    if (lane == 63) wt[wave] = incl;
    __syncthreads();
    float base = incl - v[3];
    for (int w = 0; w < wave; ++w) base += wt[w];
    LAS float* cs = (LAS float*)(lds + att::OFF_CUM);
    const float inv = 1.0f / ATT_SCALE;
    *(LAS f32x4*)(cs + 4 * tid) = (f32x4){(base + v[0]) * inv, (base + v[1]) * inv, (base + v[2]) * inv, (base + v[3]) * inv};
    __syncthreads();
}
__device__ __forceinline__ void attention_item(const Args& a, int l, int u, LAS char* lds, int wave) {
    int lane; asm volatile("v_mbcnt_lo_u32_b32 %0, -1, 0\n\tv_mbcnt_hi_u32_b32 %0, -1, %0" : "=v"(lane));
    const bf16* P = (const bf16*)(a.ws + WS_PROJ); bf16* Y = (bf16*)(a.ws + WS_Y);
    const int mode = u >> 7, v = u & 127, qb = 7 - (v >> 4), bh = v & 15, b = bh >> 2, h = bh & 3;
    const size_t row0 = (size_t)b * SEQ; const int P0 = qb * 256;
    if (mode == 0) {
        stage_cum(a, b, h, lds, wave, lane);
        att::attn_unit<0>(P, (int)((0 * PROJ_T + (row0 + P0) * MIXW + h * HD) * 2), (int)((1 * PROJ_T + row0 * MIXW + h * HD) * 2), (int)((2 * PROJ_T + row0 * MIXW + h * HD) * 2),
                          Y, (int)(((row0 + P0) * D + h * HD) * 2), P0, 0, 4 * qb + 4, lds, wave, lane);
    } else {
        const int tid = wave * 64 + lane;
        if (tid < 320) ((LAS float*)(lds + att::OFF_REL))[tid] = a.rel_bias[((size_t)l * 4 + h) * 320 + tid] * (1.0f / ATT_SCALE);
        const int jlo = 4 * qb - 8 < 0 ? 0 : 4 * qb - 8;
        att::attn_unit<1>(P, (int)((7 * PROJ_T + (row0 + P0) * MIXW + h * HD) * 2), (int)((8 * PROJ_T + row0 * MIXW + h * HD) * 2), (int)((9 * PROJ_T + row0 * MIXW + h * HD) * 2),
                          Y, (int)(((row0 + P0) * D + 1536 + h * HD) * 2), P0, jlo, 4 * qb + 4, lds, wave, lane);
    }
}
__device__ __forceinline__ void pool_item(const Args& a, int l, int u, LAS char* lds, int wave) {
    int lane; asm volatile("v_mbcnt_lo_u32_b32 %0, -1, 0\n\tv_mbcnt_hi_u32_b32 %0, -1, %0" : "=v"(lane));
    const int g = u & 3, T0 = (u >> 2) * 64, tid = wave * 64 + lane;
    const bf16* Pin = (const bf16*)(a.ws + WS_PROJ) + 3 * PROJ_T + g * 128;
    {
        const int cp = tid & 63, run = tid >> 6, w = 2 << g, t0 = T0 + run * 8, s0 = t0 & (SEQ - 1);
        const bf16* col = Pin + 2 * cp;
        float s_lo = 0.f, s_hi = 0.f;
        for (int j = 1; j < w; ++j) if (s0 - j >= 0) { const unsigned x = *(const unsigned*)(col + (size_t)(t0 - j) * MIXW); s_lo += bflo(x); s_hi += bfhi(x); }
#pragma unroll
        for (int i = 0; i < 8; ++i) { const unsigned x = *(const unsigned*)(col + (size_t)(t0 + i) * MIXW); s_lo += bflo(x); s_hi += bfhi(x);
            const int s = s0 + i; const int cnt = s + 1 < w ? s + 1 : w; const float inv = 1.0f / (float)cnt;
            *(LAS unsigned*)(lds + (run * 8 + i) * 272 + 4 * cp) = pk2(s_lo * inv - bflo(x), s_hi * inv - bfhi(x));
            if (s - w + 1 >= 0) { const unsigned y = *(const unsigned*)(col + (size_t)(t0 + i - w + 1) * MIXW); s_lo -= bflo(y); s_hi -= bfhi(y); } }
    }
    __syncthreads();
    {
        typedef short bf16x8 __attribute__((ext_vector_type(8)));
        const bf16* Wt = (const bf16*)(a.ws + WS_POOLW) + ((size_t)l * 4 + g) * 128 * 128;
        const int rt = (wave & 3) * 16, db = (wave >> 2) * 64, fr = lane & 15, kg = lane >> 4;
        f32x4 acc[4] = {};
#pragma unroll
        for (int ks = 0; ks < 4; ++ks) { const bf16x8 af = *(const LAS bf16x8*)(lds + (rt + fr) * 272 + (ks * 32 + kg * 8) * 2);
#pragma unroll
            for (int nt = 0; nt < 4; ++nt) { const bf16x8 bfr = *(const bf16x8*)(Wt + (size_t)(db + nt * 16 + fr) * 128 + ks * 32 + kg * 8);
                acc[nt] = __builtin_amdgcn_mfma_f32_16x16x32_bf16(bfr, af, acc[nt], 0, 0, 0); } }
        bf16* Y = (bf16*)(a.ws + WS_Y) + (size_t)(T0 + rt + fr) * D + 512 + g * 128;
#pragma unroll
        for (int nt = 0; nt < 4; ++nt) { const int d = db + nt * 16 + kg * 4; const f32x4 sc = *(const f32x4*)(a.pool_scale + l * MIXW + g * 128 + d);
            v2u w; w.x = pk2(acc[nt][0] * sc[0], acc[nt][1] * sc[1]); w.y = pk2(acc[nt][2] * sc[2], acc[nt][3] * sc[3]); *(v2u*)(Y + d) = w; }
    }
    __syncthreads();
}
__device__ __forceinline__ void conv_item(const Args& a, int l, int u, int wave) {
    int lane; asm volatile("v_mbcnt_lo_u32_b32 %0, -1, 0\n\tv_mbcnt_hi_u32_b32 %0, -1, %0" : "=v"(lane));
    const bf16* P = (const bf16*)(a.ws + WS_PROJ); const bf16* Ch = P + 4 * PROJ_T; const bf16* Cb = P + 5 * PROJ_T; const bf16* Cc = P + 6 * PROJ_T;
    const int tid = wave * 64 + lane, c0 = (tid & 63) * 8, t0 = u * 64 + (tid >> 6) * 8, s0 = t0 & (SEQ - 1);
    float wgt[3][8];
#pragma unroll
    for (int j = 0; j < 3; ++j) { const float* w = a.conv_w + ((size_t)l * 3 + j) * MIXW + c0; const f32x4 w0 = *(const f32x4*)w, w1 = *(const f32x4*)(w + 4);
#pragma unroll
        for (int k = 0; k < 4; ++k) { wgt[j][k] = w0[k]; wgt[j][4 + k] = w1[k]; } }
    float z2[8], z1[8];
#pragma unroll
    for (int k = 0; k < 8; ++k) { z2[k] = 0.f; z1[k] = 0.f; }
#pragma unroll
    for (int i = -2; i < 8; ++i) {
        float z[8];
        if (s0 + i >= 0) { const v4u hv = *(const v4u*)(Ch + (size_t)(t0 + i) * MIXW + c0), cv = *(const v4u*)(Cc + (size_t)(t0 + i) * MIXW + c0);
            z[0] = bflo(hv.x) * bflo(cv.x); z[1] = bfhi(hv.x) * bfhi(cv.x); z[2] = bflo(hv.y) * bflo(cv.y); z[3] = bfhi(hv.y) * bfhi(cv.y);
            z[4] = bflo(hv.z) * bflo(cv.z); z[5] = bfhi(hv.z) * bfhi(cv.z); z[6] = bflo(hv.w) * bflo(cv.w); z[7] = bfhi(hv.w) * bfhi(cv.w); }
        else {
#pragma unroll
            for (int k = 0; k < 8; ++k) z[k] = 0.f; }
        if (i >= 0) { const v4u bv = *(const v4u*)(Cb + (size_t)(t0 + i) * MIXW + c0); float o[8];
            const float bb[8] = {bflo(bv.x), bfhi(bv.x), bflo(bv.y), bfhi(bv.y), bflo(bv.z), bfhi(bv.z), bflo(bv.w), bfhi(bv.w)};
#pragma unroll
            for (int k = 0; k < 8; ++k) o[k] = bb[k] * (wgt[0][k] * z2[k] + wgt[1][k] * z1[k] + wgt[2][k] * z[k]);
            v4u ov; ov.x = pk2(o[0], o[1]); ov.y = pk2(o[2], o[3]); ov.z = pk2(o[4], o[5]); ov.w = pk2(o[6], o[7]);
            *(v4u*)((bf16*)(a.ws + WS_Y) + (size_t)(t0 + i) * D + 1024 + c0) = ov; }
#pragma unroll
        for (int k = 0; k < 8; ++k) { z2[k] = z1[k]; z1[k] = z[k]; }
    }
}
__device__ __forceinline__ void mixers_fast(const Args& a, int lq, LAS char* lds, int wave, int lane, int G, int blk) {
    const int l = lq & 1;
    for (int u = blk; u < N_ATT_UNITS; u += G) attention_item(a, l, u, lds, wave);
    unsigned* head = (unsigned*)(a.ws + WS_QCTR) + 64 * lq;
    volatile LAS unsigned* slot = (volatile LAS unsigned*)(lds + att::LDS_END);
    for (;;) {
        if (wave == 0 && lane == 0) *slot = __hip_atomic_fetch_add(head, 1u, __ATOMIC_RELAXED, __HIP_MEMORY_SCOPE_AGENT);
        __syncthreads();
        const unsigned it = *slot;
        __syncthreads();
        if (it >= (unsigned)(N_POOL_UNITS + N_CONV_UNITS)) break;
        if (it < (unsigned)N_POOL_UNITS) pool_item(a, l, (int)it, lds, wave); else conv_item(a, l, (int)it - N_POOL_UNITS, wave);
    }
}
__device__ __forceinline__ void p0_cmax(const Args& a, int gw, int NGW, int lane) {
    unsigned char* ws = a.ws;
    {
        constexpr int NCC = (INW + 255) / 256;
        for (int it = gw; it < DEPTH * 32 * NCC; it += NGW) { const int l = it / (32 * NCC), r = it % (32 * NCC), kc = r / NCC, cc = r % NCC; const int c0 = cc * 256 + 4 * lane;
            if (c0 + 3 < INW) { const float* W = a.w_in + (size_t)l * D * INW + (size_t)(kc * 64) * INW + c0; const float* g = a.norm_mix + l * D + kc * 64;
                float m0 = 0.f, m1 = 0.f, m2 = 0.f, m3 = 0.f;
#pragma unroll 8
                for (int k = 0; k < 64; ++k) { const f32x4 w = *(const f32x4*)(W + (size_t)k * INW); const float gk = fabsf(g[k]);
                    m0 = fmaxf(m0, fabsf(w[0]) * gk); m1 = fmaxf(m1, fabsf(w[1]) * gk); m2 = fmaxf(m2, fabsf(w[2]) * gk); m3 = fmaxf(m3, fabsf(w[3]) * gk); }
                unsigned* cm = (unsigned*)(ws + WS_CMAX) + l * INW + c0;
                const unsigned u0 = __float_as_uint(m0), u1 = __float_as_uint(m1), u2 = __float_as_uint(m2), u3 = __float_as_uint(m3);
                __hip_atomic_fetch_max(cm + 0, u0, __ATOMIC_RELAXED, __HIP_MEMORY_SCOPE_AGENT); __hip_atomic_fetch_max(cm + 1, u1, __ATOMIC_RELAXED, __HIP_MEMORY_SCOPE_AGENT);
                __hip_atomic_fetch_max(cm + 2, u2, __ATOMIC_RELAXED, __HIP_MEMORY_SCOPE_AGENT); __hip_atomic_fetch_max(cm + 3, u3, __ATOMIC_RELAXED, __HIP_MEMORY_SCOPE_AGENT); } }
    }
}
__device__ __forceinline__ void p0_prologue(const Args& a, LAS unsigned char* lds, int gw, int NGW, int wave, int lane) {
    unsigned char* ws = a.ws;
    LAS float* scr = (LAS float*)(lds + wave * 16384);
    constexpr int I_SQ = (D / 64) * (D / 32), I_BR = (MIXW / 64) * (D / 32);
    constexpr int I_LAYER = 4 * I_BR + 2 * I_SQ;
    for (int it = gw; it < DEPTH * I_LAYER; it += NGW) {
        const int l = it / I_LAYER; int r = it - l * I_LAYER;
        if (r < 4 * I_BR) { const int g = r / I_BR, rr = r % I_BR, kb = rr / (D / 32), nb = rr % (D / 32);
            tr_item<false>(a.w_branch + ((size_t)l * 4 + g) * MIXW * D, D, nullptr, (bf16*)(ws + WS_WBR + l * SQ_BYTES), D, g * MIXW, scr, 64 * kb, 32 * nb, lane); continue; }
        r -= 4 * I_BR;
        if (r < I_SQ) { const int kb = r / (D / 32), nb = r % (D / 32);
            tr_item<false>(a.w_out + (size_t)l * D * D, D, nullptr, (bf16*)(ws + WS_WOUT + l * SQ_BYTES), D, 0, scr, 64 * kb, 32 * nb, lane); continue; }
        r -= I_SQ;
        { const int kb = r / (D / 32), nb = r % (D / 32);
            tr_item<false>(a.peer_wq + (size_t)l * D * D, D, a.norm_ffn + l * D, (bf16*)(ws + WS_WQ + l * SQ_BYTES), D, 0, scr, 64 * kb, 32 * nb, lane); }
    }
    for (int it = gw; it < DEPTH * 4 * 8; it += NGW) { const int lg = it >> 3, r = it & 7;
        tr_item<false>(a.pool_w + (size_t)lg * 128 * 128, 128, nullptr, (bf16*)(ws + WS_POOLW) + (size_t)lg * 128 * 128, 128, 0, scr, 64 * (r >> 2), 32 * (r & 3), lane); }
    {
        constexpr int NR = 2 * DEPTH * PEER_E;
        f32x4 nv[8];
        if (gw < NR) { const int t = gw / (DEPTH * PEER_E), row = gw - t * (DEPTH * PEER_E); const float* src = (t ? a.peer_v : a.peer_u) + (size_t)row * D + 4 * lane;
#pragma unroll
            for (int j = 0; j < 8; ++j) nv[j] = *(const f32x4*)(src + 256 * j); }
        for (int r = gw; r < NR; r += NGW) { const int t = r / (DEPTH * PEER_E), row = r - t * (DEPTH * PEER_E);
            f32x4 v[8]; float am = 0.f;
#pragma unroll
            for (int j = 0; j < 8; ++j) v[j] = nv[j];
            { const int r2 = r + NGW; if (r2 < NR) { const int t2 = r2 / (DEPTH * PEER_E), row2 = r2 - t2 * (DEPTH * PEER_E); const float* src = (t2 ? a.peer_v : a.peer_u) + (size_t)row2 * D + 4 * lane;
#pragma unroll
                for (int j = 0; j < 8; ++j) nv[j] = *(const f32x4*)(src + 256 * j); } }
#pragma unroll
            for (int j = 0; j < 8; ++j) am = fmaxf(am, fmaxf(fmaxf(fabsf(v[j][0]), fabsf(v[j][1])), fmaxf(fabsf(v[j][2]), fabsf(v[j][3]))));
            am = wave_max(am, lane);
            const float inv = am > 0.f ? 127.0f / am : 0.f, off = 0.f;
            unsigned char* dst = ws + (t ? WS_PV : WS_PU) + (size_t)row * D + 4 * lane;
#pragma unroll
            for (int j = 0; j < 8; ++j) { const int q0 = (int)(rintf(v[j][0] * inv) + off), q1 = (int)(rintf(v[j][1] * inv) + off), q2 = (int)(rintf(v[j][2] * inv) + off), q3 = (int)(rintf(v[j][3] * inv) + off);
                *(unsigned*)(dst + 256 * j) = (unsigned)(q0 & 255) | ((unsigned)(q1 & 255) << 8) | ((unsigned)(q2 & 255) << 16) | ((unsigned)(q3 & 255) << 24); }
            if (lane == 0) ((float*)(ws + (t ? WS_SV : WS_SU)))[row] = am * (1.0f / 127.0f); }
    }
    { bf16* pk = (bf16*)(ws + WS_PK); const size_t n8 = (size_t)DEPTH * 8 * 2 * 128 * 128 / 8;
      for (size_t i = (size_t)gw * 64 + lane; i < n8; i += (size_t)NGW * 64) { const f32x4 v0 = *(const f32x4*)(a.peer_keys + i * 8), v1 = *(const f32x4*)(a.peer_keys + i * 8 + 4);
          v4u o; o.x = pk2(v0[0], v0[1]); o.y = pk2(v0[2], v0[3]); o.z = pk2(v1[0], v1[1]); o.w = pk2(v1[2], v1[3]); *(v4u*)(pk + i * 8) = o; } }
    {
        float* wf = (float*)(ws + WS_WF); float* binr = (float*)(ws + WS_BINR);
        const int gt = gw * 64 + lane, NGT = NGW * 64;
        for (int i = gt; i < DEPTH * 4 * D; i += NGT) { const int l = i / (4 * D), h = (i / D) & 3, k = i % D; wf[i] = a.w_in[(size_t)l * D * INW + (size_t)k * INW + 1536 + h] * a.norm_mix[l * D + k]; }
        for (int i = gt; i < DEPTH * NPROJ; i += NGT) { const int l = i / NPROJ, j = i % NPROJ; binr[i] = a.b_in[l * INW + colmap_in(j)]; }
    }
    {
        unsigned long long* ssq = (unsigned long long*)(ws + WS_SSQ);
        for (int m = gw; m < M; m += NGW) { float s = 0.f, am = 0.f; f32x4 v[8];
#pragma unroll
            for (int j = 0; j < 8; ++j) { const size_t o = (size_t)m * D + j * 256 + lane * 4; v[j] = *(const f32x4*)(a.x + o); s += (v[j][0] * v[j][0] + v[j][1] * v[j][1]) + (v[j][2] * v[j][2] + v[j][3] * v[j][3]);
                am = fmaxf(am, fmaxf(fmaxf(fabsf(v[j][0]), fabsf(v[j][1])), fmaxf(fabsf(v[j][2]), fabsf(v[j][3])))); }
            s = wave_sum(s, lane); am = wave_max(am, lane); if (lane == 0) { ssq[m] = (unsigned long long)((double)s * 4294967296.0); ((float*)(ws + WS_RSA))[m] = rsqrtf(s * (1.0f / D) + EPS) * am * (1.0f / 127.0f); }
            const float inv = am > 0.f ? 127.0f / am : 0.f; unsigned char* q8 = ws + WS_HB8 + (size_t)m * D + 4 * lane;
#pragma unroll
            for (int j = 0; j < 8; ++j) *(unsigned*)(q8 + 256 * j) = ((unsigned)((int)rintf(v[j][0] * inv) & 255)) | ((unsigned)((int)rintf(v[j][1] * inv) & 255) << 8) | ((unsigned)((int)rintf(v[j][2] * inv) & 255) << 16) | ((unsigned)((int)rintf(v[j][3] * inv) & 255) << 24); }
    }
}
__device__ __forceinline__ void p0_win_i8(const Args& a, LAS unsigned char* lds, int gw, int NGW, int wave, int lane) {
    unsigned char* ws = a.ws; LAS float* scr = (LAS float*)(lds + wave * 16384);
    constexpr int I_WIN = (D / 64) * (NPROJ / 32);
    for (int it = gw; it < DEPTH * I_WIN; it += NGW) { const int l = it / I_WIN, r = it % I_WIN, kb = r / (NPROJ / 32), nb = r % (NPROJ / 32);
        tr_item_i8(a.w_in + (size_t)l * D * INW, a.norm_mix + l * D, (const unsigned*)(ws + WS_CMAX) + l * INW, ws + WS_WIN + l * WIN_BYTES, scr, 64 * kb, 32 * nb, lane); }
    float* sw = (float*)(ws + WS_SW); const int gt = gw * 64 + lane, NGT = NGW * 64;
    bf16* swh = (bf16*)(ws + WS_SWH); bf16* bih = (bf16*)(ws + WS_BIH);
    for (int i = gt; i < DEPTH * NPROJ; i += NGT) { const int l = i / NPROJ, j = i % NPROJ; const float s = __builtin_bit_cast(float, ((const unsigned*)(ws + WS_CMAX))[l * INW + colmap_in(j)]) * (1.0f / 127.0f);
        sw[i] = s; swh[i] = (bf16)f2bf(s); bih[i] = (bf16)f2bf(a.b_in[l * INW + colmap_in(j)]); }
}
__device__ __forceinline__ void quant_rows(const Args& a, int l, int gw, int NGW, int lane) {
    unsigned char* ws = a.ws; const float* H = (const float*)(ws + WS_H);
    for (int m = gw; m < M; m += NGW) { float am = 0.f; f32x4 v[8];
#pragma unroll
        for (int j = 0; j < 8; ++j) { v[j] = *(const f32x4*)(H + (size_t)m * D + j * 256 + lane * 4); am = fmaxf(am, fmaxf(fmaxf(fabsf(v[j][0]), fabsf(v[j][1])), fmaxf(fabsf(v[j][2]), fabsf(v[j][3])))); }
        am = wave_max(am, lane); if (lane == 0) ((float*)(ws + WS_RSA))[m] = rsqrtf(ssa_to_f(((const unsigned long long*)(ws + WS_SSQ))[(size_t)l * M + m]) * (1.0f / D) + EPS) * am * (1.0f / 127.0f);
        const float inv = am > 0.f ? 127.0f / am : 0.f; unsigned char* q8 = ws + WS_HB8 + (size_t)m * D + 4 * lane;
#pragma unroll
        for (int j = 0; j < 8; ++j) *(unsigned*)(q8 + 256 * j) = ((unsigned)((int)rintf(v[j][0] * inv) & 255)) | ((unsigned)((int)rintf(v[j][1] * inv) & 255) << 8) | ((unsigned)((int)rintf(v[j][2] * inv) & 255) << 16) | ((unsigned)((int)rintf(v[j][3] * inv) & 255) << 24); }
}

__device__ __forceinline__ void forget_logits(const Args& a, int l, int gw, int NGW, int lane) {
    unsigned char* ws = a.ws; const bf16* HB = (const bf16*)(ws + WS_HB); const float* wf = (const float*)(ws + WS_WF) + l * 4 * D; const unsigned long long* ssq = (const unsigned long long*)(ws + WS_SSQ) + l * M;
    float* logf = (float*)(ws + WS_LOGF);
    for (int m = gw; m < M; m += NGW) {
        float d[4] = {0.f, 0.f, 0.f, 0.f};
#pragma unroll
        for (int j = 0; j < 4; ++j) { const int k0 = j * 512 + lane * 8; float x[8];
            if (l == 0) { const f32x4 x0 = *(const f32x4*)(a.x + (size_t)m * D + k0), x1 = *(const f32x4*)(a.x + (size_t)m * D + k0 + 4); x[0] = x0[0]; x[1] = x0[1]; x[2] = x0[2]; x[3] = x0[3]; x[4] = x1[0]; x[5] = x1[1]; x[6] = x1[2]; x[7] = x1[3]; }
            else { const v4u xv = *(const v4u*)(HB + (size_t)m * D + k0); x[0] = bflo(xv.x); x[1] = bfhi(xv.x); x[2] = bflo(xv.y); x[3] = bfhi(xv.y); x[4] = bflo(xv.z); x[5] = bfhi(xv.z); x[6] = bflo(xv.w); x[7] = bfhi(xv.w); }
#pragma unroll
            for (int h = 0; h < 4; ++h) { const f32x4 w0 = *(const f32x4*)(wf + h * D + k0), w1 = *(const f32x4*)(wf + h * D + k0 + 4);
                d[h] += x[0] * w0[0] + x[1] * w0[1] + x[2] * w0[2] + x[3] * w0[3] + x[4] * w1[0] + x[5] * w1[1] + x[6] * w1[2] + x[7] * w1[3]; } }
        const float rs = rsqrtf(ssa_to_f(ssq[m]) * (1.0f / D) + EPS);
#pragma unroll
        for (int h = 0; h < 4; ++h) { const float z = wave_sum(d[h], lane) * rs + a.b_in[l * INW + 1536 + h];
            const float ls = fminf(z, 0.f) - log1pf(__expf(-fabsf(z)));
            if (lane == h) logf[m * 4 + h] = ls; }
    }
}
__device__ __forceinline__ float gelu_tanh(float x) { const float u = 1.5957691216057308f * (x + 0.044715f * x * x * x); return x / (1.0f + __expf(-u)); }
constexpr int PEER_TOK = 32;
constexpr int PL_IDX = 0, PL_GATE = PEER_TOK * 128 * 4, PL_TAB = 2 * PEER_TOK * 128 * 4;
__device__ __forceinline__ int f2key(float f) { const int b = __builtin_bit_cast(int, f); return b ^ ((b >> 31) & 0x7fffffff); }
__device__ __forceinline__ float key2f(int k) { return __builtin_bit_cast(float, k ^ ((k >> 31) & 0x7fffffff)); }
#define CE_DESC(x, y) do { const int hi_ = (x) > (y) ? (x) : (y), lo_ = (x) > (y) ? (y) : (x); (x) = hi_; (y) = lo_; } while (0)
__device__ __forceinline__ void sort16_desc(int* v) {
#pragma unroll
    for (int k = 2; k <= 16; k <<= 1)
#pragma unroll
        for (int j = k >> 1; j > 0; j >>= 1)
#pragma unroll
            for (int i = 0; i < 16; ++i) { const int l = i ^ j; if (l > i) { if ((i & k) == 0) CE_DESC(v[i], v[l]); else CE_DESC(v[l], v[i]); } }
}
__device__ __forceinline__ void merge_top16(int* a, const int* b) {
#pragma unroll
    for (int i = 0; i < 16; ++i) a[i] = a[i] > b[15 - i] ? a[i] : b[15 - i];
#pragma unroll
    for (int j = 8; j > 0; j >>= 1)
#pragma unroll
        for (int i = 0; i < 16; ++i) { const int l = i ^ j; if (l > i) CE_DESC(a[i], a[l]); }
}
__device__ __forceinline__ void top16_of_64(int* v) {
    sort16_desc(v); sort16_desc(v + 16); sort16_desc(v + 32); sort16_desc(v + 48);
    merge_top16(v, v + 16); merge_top16(v + 32, v + 48); merge_top16(v, v + 32);
}
constexpr int cand_slot(int i, int j) {
    int n = 0;
    for (int a = 0; a < 16; ++a) for (int b = 0; b < 16; ++b) { if ((a + 1) * (b + 1) <= 16) { if (a == i && b == j) return n; ++n; } }
    return -1;
}
__device__ __forceinline__ void peer_retrieve(const Args& a, int l, int t0, int h, LAS char* lds, int wave) {
    typedef short bf16x8 __attribute__((ext_vector_type(8)));
    typedef float f32x16 __attribute__((ext_vector_type(16)));
    int lane; asm volatile("v_mbcnt_lo_u32_b32 %0, -1, 0\n\tv_mbcnt_hi_u32_b32 %0, -1, %0" : "=v"(lane));
    const int r32 = lane & 31, hi = lane >> 5, hi4 = hi * 4;
    const bf16* Q = (const bf16*)(a.ws + WS_Q) + (size_t)(t0 + r32) * D + h * 256 + hi * 8;
    const bf16* PK = (const bf16*)(a.ws + WS_PK) + ((size_t)(l * 8 + h) * 2) * 128 * 128 + (size_t)r32 * 128 + hi * 8;
    int top[2][16];
#pragma unroll
    for (int p = 0; p < 2; ++p) {
        f32x16 acc[4] = {};
        bf16x8 qf[8];
#pragma unroll
        for (int cs = 0; cs < 8; ++cs) qf[cs] = *(const bf16x8*)(Q + p * 128 + cs * 16);
#pragma unroll
        for (int kb = 0; kb < 4; ++kb) { bf16x8 kf[8];
#pragma unroll
            for (int cs = 0; cs < 8; ++cs) kf[cs] = *(const bf16x8*)(PK + (size_t)p * 128 * 128 + (size_t)kb * 32 * 128 + cs * 16);
#pragma unroll
            for (int cs = 0; cs < 8; ++cs) acc[kb] = __builtin_amdgcn_mfma_f32_32x32x16_bf16(kf[cs], qf[cs], acc[kb], 0, 0, 0); }
        int v[64];
#pragma unroll
        for (int kb = 0; kb < 4; ++kb)
#pragma unroll
            for (int r = 0; r < 16; ++r) { const int c = kb * 32 + (r & 3) + 8 * (r >> 2);
                v[kb * 16 + r] = (f2key(acc[kb][r]) & ~127) | (c | hi4); }
        top16_of_64(v);
        int mine[16], other[16];
#pragma unroll
        for (int i = 0; i < 16; ++i) { auto rr = __builtin_amdgcn_permlane32_swap((unsigned)v[i], (unsigned)v[i], false, false); mine[i] = (int)rr[0]; other[i] = (int)rr[1]; }
        merge_top16(mine, other);
#pragma unroll
        for (int i = 0; i < 16; ++i) top[p][i] = mine[i];
    }
    LAS int* tab = (LAS int*)(lds + PL_TAB) + (wave * 64 + lane) * 32;
    float sA[16], sB[16];
#pragma unroll
    for (int i = 0; i < 16; ++i) { sA[i] = key2f(top[0][i] & ~127); sB[i] = key2f(top[1][i] & ~127); tab[i] = top[0][i] & 127; tab[16 + i] = top[1][i] & 127; }
    int c[64];
#pragma unroll
    for (int n = 0; n < 64; ++n) c[n] = (int)0x80000000;
#pragma unroll
    for (int i = 0; i < 16; ++i)
#pragma unroll
        for (int j = 0; j < 16; ++j) if ((i + 1) * (j + 1) <= 16) c[cand_slot(i, j)] = (f2key(sA[i] + sB[j]) & ~255) | (16 * i + j);
    top16_of_64(c);
    float ex[16]; float sum = 0.f; const float mx = key2f(c[0] & ~255);
#pragma unroll
    for (int w = 0; w < 16; ++w) { ex[w] = __expf(key2f(c[w] & ~255) - mx); sum += ex[w]; }
    const float inv = 1.0f / sum;
    asm volatile("s_waitcnt lgkmcnt(0)" ::: "memory");
    LAS int* oi = (LAS int*)(lds + PL_IDX) + r32 * 128 + h * 16; LAS float* og = (LAS float*)(lds + PL_GATE) + r32 * 128 + h * 16;
#pragma unroll
    for (int w = 0; w < 16; ++w) { const int id = c[w] & 255; const int e = tab[id >> 4] * 128 + tab[16 + (id & 15)];
        if ((w >> 3) == hi) { oi[w] = e; og[w] = ex[w] * inv; } }
}
constexpr size_t WS_IDX = 816 * MiB;
constexpr size_t WS_GATE = 820 * MiB;
constexpr size_t WS_XQ = 824 * MiB;
constexpr size_t WS_SX = 856 * MiB;
constexpr size_t WS_PART = 857 * MiB;
constexpr size_t WS_SUT = 890 * MiB;
constexpr size_t WS_END2 = 1024 * MiB;
#ifndef PEER_NB
#define PEER_NB 8
#endif
constexpr int NSLICE = 8, SLW = D / NSLICE;
#define DPP_ROR(x, n) __builtin_bit_cast(float, __builtin_amdgcn_update_dpp(0, __builtin_bit_cast(int, (x)), 0x120 + (n), 0xf, 0xf, false))
__device__ __forceinline__ void peer_publish(const Args& a, int l, int t, LAS char* lds, int tl) {
    int lane; LANE_ID(lane);
    unsigned char* ws = a.ws;
    { int* gi = (int*)(ws + WS_IDX) + (size_t)t * 128; float* gg = (float*)(ws + WS_GATE) + (size_t)t * 128; float* gs = (float*)(ws + WS_SUT) + (size_t)t * 128;
      const float* SU = (const float*)(ws + WS_SU) + l * PEER_E; const float* SV = (const float*)(ws + WS_SV) + l * PEER_E;
      const int i0 = ((const LAS int*)(lds + PL_IDX))[tl * 128 + lane], i1 = ((const LAS int*)(lds + PL_IDX))[tl * 128 + 64 + lane];
      gi[lane] = i0; gi[64 + lane] = i1; gs[lane] = SU[i0]; gs[64 + lane] = SU[i1];
      gg[lane] = ((const LAS float*)(lds + PL_GATE))[tl * 128 + lane] * SV[i0]; gg[64 + lane] = ((const LAS float*)(lds + PL_GATE))[tl * 128 + 64 + lane] * SV[i1]; }
    const unsigned long long* ssa1 = (const unsigned long long*)(ws + WS_SSA) + l * M;
    const float rs = rsqrtf(ssa_to_f(ssa1[t]) * (1.0f / D) + EPS);
    const bf16* HB = (const bf16*)(ws + WS_HB) + (size_t)t * D; const float* gn = a.norm_ffn + l * D;
    float xf[32]; float am = 0.f;
#pragma unroll
    for (int i = 0; i < 2; ++i) { const int k0 = 16 * lane + 1024 * i; const v4u h0 = *(const v4u*)(HB + k0), h1 = *(const v4u*)(HB + k0 + 8);
        const unsigned hw[8] = {h0.x, h0.y, h0.z, h0.w, h1.x, h1.y, h1.z, h1.w};
#pragma unroll
        for (int q = 0; q < 4; ++q) { const f32x4 g = *(const f32x4*)(gn + k0 + 4 * q);
            xf[16 * i + 4 * q + 0] = bflo(hw[2 * q]) * rs * g[0]; xf[16 * i + 4 * q + 1] = bfhi(hw[2 * q]) * rs * g[1];
            xf[16 * i + 4 * q + 2] = bflo(hw[2 * q + 1]) * rs * g[2]; xf[16 * i + 4 * q + 3] = bfhi(hw[2 * q + 1]) * rs * g[3]; } }
#pragma unroll
    for (int k = 0; k < 32; ++k) am = fmaxf(am, fabsf(xf[k]));
    am = wave_max(am, lane);
    const float inv = am > 0.f ? 127.0f / am : 0.f;
    if (lane == 0) ((float*)(ws + WS_SX))[t] = am * (1.0f / 127.0f);
    unsigned char* xq = ws + WS_XQ + (size_t)t * 4096;
#pragma unroll
    for (int i = 0; i < 2; ++i) { v4u ph, pl;
#pragma unroll
        for (int d = 0; d < 4; ++d) { unsigned wh = 0, wl = 0;
#pragma unroll
            for (int b = 0; b < 4; ++b) { const float sv = xf[16 * i + 4 * d + b] * inv, hq = rintf(sv), lq = rintf((sv - hq) * 128.0f);
                wh |= ((unsigned)((int)hq & 255)) << (8 * b); wl |= ((unsigned)((int)lq & 255)) << (8 * b); }
            ph[d] = wh; pl[d] = wl; }
        *(v4u*)(xq + 16 * lane + 1024 * i) = ph; *(v4u*)(xq + 2048 + 16 * lane + 1024 * i) = pl; }
}
struct PeerItems { int pos, npop, rank, nloc, wave;
    __device__ __forceinline__ int nblk() const { return (M / PEER_TOK - rank + nloc - 1) / nloc; }
    __device__ __forceinline__ int count() const { return ((NSLICE - pos + npop - 1) / npop) * nblk() * (PEER_TOK / NWAVES); }
    __device__ __forceinline__ void get(int n, int& s, int& t) const { constexpr int per = PEER_TOK / NWAVES; const int k = n % per, r = n / per, nb = nblk();
        s = pos + (r / nb) * npop; t = (rank + (r % nb) * nloc) * PEER_TOK + wave * per + k; } };
__device__ __forceinline__ void peer_u_wave(const Args& a, int l, const PeerItems& it) {
    int lane; LANE_ID(lane);
    unsigned char* ws = a.ws; const int sub = lane & 15, grp = lane >> 4;
    const __amdgpu_buffer_rsrc_t rU = __builtin_amdgcn_make_buffer_rsrc((void*)(ws + WS_PU + (size_t)l * PE_BYTES), 0, 0x7fffffff, 0x00020000);
    const __amdgpu_buffer_rsrc_t rW = __builtin_amdgcn_make_buffer_rsrc((void*)ws, 0, 0x7fffffff, 0x00020000);
    const int N = it.count(); if (N <= 0) return;
    int s, t; it.get(0, s, t);
    int idc[2], idn[2] = {0, 0}; v4u xhc, xlc, xhn = {}, xln = {}; v4u wA[PEER_NB], wB[PEER_NB];
#define PU_META(I0, I1, XH, XL, S_, T_) do { I0 = (int)__builtin_amdgcn_raw_buffer_load_b32(rW, 4 * lane, (int)WS_IDX + (T_) * 512, 0); I1 = (int)__builtin_amdgcn_raw_buffer_load_b32(rW, 4 * lane, (int)WS_IDX + (T_) * 512 + 256, 0); \
        XH = __builtin_amdgcn_raw_buffer_load_b128(rW, 16 * sub, (int)WS_XQ + (T_) * 4096 + SLW * (S_), 0); XL = __builtin_amdgcn_raw_buffer_load_b128(rW, 16 * sub, (int)WS_XQ + (T_) * 4096 + 2048 + SLW * (S_), 0); } while (0)
#define PU_ISSUE(W, ID, Q, S_) do { _Pragma("unroll") for (int j = 0; j < PEER_NB; ++j) { const int e_ = shi(ID[(PEER_NB * (Q) + j) >> 4], 4 * ((PEER_NB * (Q) + j) & 15) + grp); W[j] = __builtin_amdgcn_raw_buffer_load_b128(rU, e_ * D + SLW * (S_) + 16 * sub, 0, 0); } } while (0)
#define PU_COMP(W, Q) do { _Pragma("unroll") for (int j = 0; j < PEER_NB; ++j) { int dh = 0, dl = 0; \
            dh = __builtin_amdgcn_sdot4((int)W[j].x, (int)xhc.x, dh, false); dl = __builtin_amdgcn_sdot4((int)W[j].x, (int)xlc.x, dl, false); \
            dh = __builtin_amdgcn_sdot4((int)W[j].y, (int)xhc.y, dh, false); dl = __builtin_amdgcn_sdot4((int)W[j].y, (int)xlc.y, dl, false); \
            dh = __builtin_amdgcn_sdot4((int)W[j].z, (int)xhc.z, dh, false); dl = __builtin_amdgcn_sdot4((int)W[j].z, (int)xlc.z, dl, false); \
            dh = __builtin_amdgcn_sdot4((int)W[j].w, (int)xhc.w, dh, false); dl = __builtin_amdgcn_sdot4((int)W[j].w, (int)xlc.w, dl, false); \
            float p_ = (float)dh + (float)dl * (1.0f / 128.0f); \
            p_ += DPP_ROR(p_, 8); p_ += DPP_ROR(p_, 4); p_ += DPP_ROR(p_, 2); p_ += DPP_ROR(p_, 1); \
            if (sub == ((PEER_NB * (Q) + j) & 15)) { if ((PEER_NB * (Q) + j) >> 4) acc1 = p_; else acc0 = p_; } __builtin_amdgcn_sched_barrier(0); } } while (0)
    PU_META(idc[0], idc[1], xhc, xlc, s, t); PU_ISSUE(wA, idc, 0, s); PU_ISSUE(wB, idc, 1, s);
    for (int n = 0; n < N; ++n) {
        int sn = s, tn = t; const bool more = n + 1 < N;
        if (more) it.get(n + 1, sn, tn);
        PU_META(idn[0], idn[1], xhn, xln, sn, tn);
        float acc0 = 0.f, acc1 = 0.f;
        __builtin_amdgcn_sched_barrier(0);
#if PEER_NB == 8
        PU_COMP(wA, 0); PU_ISSUE(wA, idc, 2, s); __builtin_amdgcn_sched_barrier(0);
        PU_COMP(wB, 1); PU_ISSUE(wB, idc, 3, s); __builtin_amdgcn_sched_barrier(0);
        PU_COMP(wA, 2); PU_ISSUE(wA, idn, 0, sn); __builtin_amdgcn_sched_barrier(0);
        PU_COMP(wB, 3); PU_ISSUE(wB, idn, 1, sn); __builtin_amdgcn_sched_barrier(0);
#else
        PU_COMP(wA, 0); PU_ISSUE(wA, idn, 0, sn); __builtin_amdgcn_sched_barrier(0);
        PU_COMP(wB, 1); PU_ISSUE(wB, idn, 1, sn); __builtin_amdgcn_sched_barrier(0);
#endif
        __builtin_amdgcn_raw_buffer_store_b32(__builtin_bit_cast(unsigned, acc0), rW, (4 * sub + grp) * 4, (int)WS_PART + (s * M + t) * 512, 0);
        __builtin_amdgcn_raw_buffer_store_b32(__builtin_bit_cast(unsigned, acc1), rW, (4 * sub + grp) * 4 + 256, (int)WS_PART + (s * M + t) * 512, 0);
        s = sn; t = tn; idc[0] = idn[0]; idc[1] = idn[1]; xhc = xhn; xlc = xln;
    }
#undef PU_META
#undef PU_ISSUE
#undef PU_COMP
}
__device__ __forceinline__ void peer_v_wave(const Args& a, int l, const PeerItems& it) {
    int lane; LANE_ID(lane);
    unsigned char* ws = a.ws; const int sub = lane & 15, grp = lane >> 4;
    const __amdgpu_buffer_rsrc_t rV = __builtin_amdgcn_make_buffer_rsrc((void*)(ws + WS_PV + (size_t)l * PE_BYTES), 0, 0x7fffffff, 0x00020000);
    const __amdgpu_buffer_rsrc_t rW = __builtin_amdgcn_make_buffer_rsrc((void*)ws, 0, 0x7fffffff, 0x00020000);
    const int N = it.count(); if (N <= 0) return;
    int s, t; it.get(0, s, t);
    struct Meta { int id[2]; float gate[2], su[2], pa[2], sx; f32x4 h1; };
    Meta mc, mn; v4u wA[PEER_NB], wB[PEER_NB];
    const int l4 = 4 * lane;
#define WLD(off_s) __builtin_amdgcn_raw_buffer_load_b32(rW, l4, (int)(off_s), 0)
#define PV_META(MM, S_, T_) do { const int r_ = (T_) * 512; MM.id[0] = (int)WLD(WS_IDX + r_); MM.id[1] = (int)WLD(WS_IDX + r_ + 256); \
        MM.gate[0] = __builtin_bit_cast(float, WLD(WS_GATE + r_)); MM.gate[1] = __builtin_bit_cast(float, WLD(WS_GATE + r_ + 256)); MM.su[0] = __builtin_bit_cast(float, WLD(WS_SUT + r_)); MM.su[1] = __builtin_bit_cast(float, WLD(WS_SUT + r_ + 256)); \
        float a0_ = 0.f, a1_ = 0.f; _Pragma("unroll") for (int q = 0; q < NSLICE; ++q) { const int po_ = (int)WS_PART + (q * M + (T_)) * 512; a0_ += __builtin_bit_cast(float, WLD(po_)); a1_ += __builtin_bit_cast(float, WLD(po_ + 256)); } \
        MM.pa[0] = a0_; MM.pa[1] = a1_; MM.sx = ((const float*)(ws + WS_SX))[T_]; \
        MM.h1 = __builtin_bit_cast(f32x4, __builtin_amdgcn_raw_buffer_load_b128(rW, (16 * sub + 4 * grp) * 4, (int)WS_H + ((T_) * D + SLW * (S_)) * 4, 0)); } while (0)
#define PV_ISSUE(W, ID, Q, S_) do { _Pragma("unroll") for (int j = 0; j < PEER_NB; ++j) { const int e_ = shi(ID[(PEER_NB * (Q) + j) >> 4], 4 * ((PEER_NB * (Q) + j) & 15) + grp); W[j] = __builtin_amdgcn_raw_buffer_load_b128(rV, e_ * D + SLW * (S_) + 16 * sub, 0, 0); } } while (0)
#define PV_COMP(W, Q) do { _Pragma("unroll") for (int j4 = 0; j4 < PEER_NB; j4 += 4) { \
            unsigned cp_ = 0; _Pragma("unroll") for (int jj = 0; jj < 4; ++jj) { const int i_ = PEER_NB * (Q) + j4 + jj; cp_ |= ((unsigned)shi(c8[i_ >> 4], 4 * (i_ & 15) + grp) & 255u) << (8 * jj); } \
            _Pragma("unroll") for (int d = 0; d < 4; ++d) { const unsigned a_ = W[j4][d], b_ = W[j4 + 1][d], c_ = W[j4 + 2][d], d_ = W[j4 + 3][d]; \
                const unsigned x0_ = __builtin_amdgcn_perm(b_, a_, 0x05010400u), x1_ = __builtin_amdgcn_perm(b_, a_, 0x07030602u), y0_ = __builtin_amdgcn_perm(d_, c_, 0x05010400u), y1_ = __builtin_amdgcn_perm(d_, c_, 0x07030602u); \
                yi[4 * d + 0] = __builtin_amdgcn_sdot4((int)__builtin_amdgcn_perm(y0_, x0_, 0x05040100u), (int)cp_, yi[4 * d + 0], false); \
                yi[4 * d + 1] = __builtin_amdgcn_sdot4((int)__builtin_amdgcn_perm(y0_, x0_, 0x07060302u), (int)cp_, yi[4 * d + 1], false); \
                yi[4 * d + 2] = __builtin_amdgcn_sdot4((int)__builtin_amdgcn_perm(y1_, x1_, 0x05040100u), (int)cp_, yi[4 * d + 2], false); \
                yi[4 * d + 3] = __builtin_amdgcn_sdot4((int)__builtin_amdgcn_perm(y1_, x1_, 0x07060302u), (int)cp_, yi[4 * d + 3], false); } \
            __builtin_amdgcn_sched_barrier(0); } } while (0)
    PV_META(mc, s, t); PV_ISSUE(wA, mc.id, 0, s); PV_ISSUE(wB, mc.id, 1, s);
    for (int n = 0; n < N; ++n) {
        int sn = s, tn = t; const bool more = n + 1 < N;
        if (more) it.get(n + 1, sn, tn);
        PV_META(mn, sn, tn);
        float coef[2];
#pragma unroll
        for (int hf = 0; hf < 2; ++hf) coef[hf] = gelu_tanh(mc.pa[hf] * mc.su[hf] * mc.sx) * mc.gate[hf];
        const float cmax = wave_max(fmaxf(fabsf(coef[0]), fabsf(coef[1])), lane); const float cinv = cmax > 0.f ? 127.0f / cmax : 0.f, cs = cmax * (1.0f / 127.0f);
        const int c8[2] = {(int)rintf(coef[0] * cinv), (int)rintf(coef[1] * cinv)};
        int yi[16];
#pragma unroll
        for (int k = 0; k < 16; ++k) yi[k] = 0;
        __builtin_amdgcn_sched_barrier(0);
#if PEER_NB == 8
        PV_COMP(wA, 0); PV_ISSUE(wA, mc.id, 2, s); __builtin_amdgcn_sched_barrier(0);
        PV_COMP(wB, 1); PV_ISSUE(wB, mc.id, 3, s); __builtin_amdgcn_sched_barrier(0);
        PV_COMP(wA, 2); PV_ISSUE(wA, mn.id, 0, sn); __builtin_amdgcn_sched_barrier(0);
        PV_COMP(wB, 3); PV_ISSUE(wB, mn.id, 1, sn); __builtin_amdgcn_sched_barrier(0);
#else
        PV_COMP(wA, 0); PV_ISSUE(wA, mn.id, 0, sn); __builtin_amdgcn_sched_barrier(0);
        PV_COMP(wB, 1); PV_ISSUE(wB, mn.id, 1, sn); __builtin_amdgcn_sched_barrier(0);
#endif
#pragma unroll
        for (int k = 0; k < 16; ++k) { yi[k] += shi(yi[k], lane ^ 16); yi[k] += shi(yi[k], lane ^ 32); }
        int yq[4];
#pragma unroll
        for (int k = 0; k < 4; ++k) yq[k] = grp == 0 ? yi[k] : grp == 1 ? yi[4 + k] : grp == 2 ? yi[8 + k] : yi[12 + k];
        const f32x4 h2 = {mc.h1[0] + cs * (float)yq[0], mc.h1[1] + cs * (float)yq[1], mc.h1[2] + cs * (float)yq[2], mc.h1[3] + cs * (float)yq[3]};
        __builtin_amdgcn_raw_buffer_store_b128(__builtin_bit_cast(v4u, h2), rW, (16 * sub + 4 * grp) * 4, (int)WS_H + (t * D + SLW * s) * 4, 0);
        v2u hb; hb.x = pk2(h2[0], h2[1]); hb.y = pk2(h2[2], h2[3]);
        __builtin_amdgcn_raw_buffer_store_b64(hb, rW, (16 * sub + 4 * grp) * 2, (int)WS_HB + (t * D + SLW * s) * 2, 0);
        const float sq = wave_sum((h2[0] * h2[0] + h2[1] * h2[1]) + (h2[2] * h2[2] + h2[3] * h2[3]), lane);
        if (lane == 0) atomicAdd((unsigned long long*)(ws + WS_SSQ) + (size_t)(l + 1) * M + t, (unsigned long long)((double)sq * 4294967296.0));
        s = sn; t = tn; mc = mn;
    }
#undef PV_META
#undef WLD
#undef PV_ISSUE
#undef PV_COMP
}
__device__ __forceinline__ void final_norm_row(const Args& a, int t) {
    int lane; LANE_ID(lane);
    const float* H = (const float*)(a.ws + WS_H) + (size_t)t * D; float* O = a.out + (size_t)t * D;
    const float rf = rsqrtf(ssa_to_f(((const unsigned long long*)(a.ws + WS_SSQ))[(size_t)DEPTH * M + t]) * (1.0f / D) + EPS);
#pragma unroll
    for (int j = 0; j < 8; ++j) { const int k0 = 4 * lane + 256 * j; const f32x4 h = *(const f32x4*)(H + k0), g = *(const f32x4*)(a.norm_final + k0);
        *(f32x4*)(O + k0) = (f32x4){h[0] * rf * g[0], h[1] * rf * g[1], h[2] * rf * g[2], h[3] * rf * g[3]}; }
}

__global__ void __launch_bounds__(NT, 2) mk_fwd(ArgsK a_in) {
    extern __shared__ __attribute__((aligned(16))) unsigned char lds_raw[];
    LAS unsigned char* lds = (LAS unsigned char*)lds_raw;
    cg::grid_group grid = cg::this_grid();
    grid.sync();
    const int wave0 = __builtin_amdgcn_readfirstlane(threadIdx.x >> 6);
    const int G = gridDim.x;
    const CAS ArgsK* ka = (const CAS ArgsK*)__builtin_amdgcn_kernarg_segment_ptr();
    size_t zoff = 0;
#define PHASE_BEGIN() int lane; LANE_ID(lane); int blk = blockIdx.x, Gp = G, wv = wave0; asm volatile("" : "+s"(zoff), "+s"(ka), "+s"(blk), "+s"(Gp), "+s"(wv)); const int wave = wv, gw = blk * NWAVES + wv, NGW = Gp * NWAVES; (void)gw; (void)NGW; const Args a = load_args(ka, zoff); unsigned char* const ws = a.ws; (void)ws
    volatile LAS unsigned* bst = (volatile LAS unsigned*)(lds + RING_BYTES + 1024);
#define GRID_BAR() do { asm volatile("" : "+s"(zoff)); unsigned char* wsb_ = (unsigned char*)ka->ws + zoff; int wvb_ = wave0; asm volatile("" : "+s"(wvb_)); xcd_barrier((unsigned*)(wsb_ + WS_BAR), xb_xcc_id(), (unsigned)G, bst, wvb_); } while (0)
    volatile LAS unsigned* xinfo = bst + 4;
    { PHASE_BEGIN(); if (wave == 0 && lane == 0) { bst[0] = 0u; bst[1] = 0u; xinfo[2] = xb_add((unsigned*)(ws + WS_BAR) + XB_XCNT(xb_xcc_id()), 1u); }
      p0_cmax(a, gw, NGW, lane); }
    GRID_BAR();
    { PHASE_BEGIN(); p0_win_i8(a, lds, gw, NGW, wave, lane); p0_prologue(a, lds, gw, NGW, wave, lane); }
    GRID_BAR();
    {
        PHASE_BEGIN();
        if (wave == 0 && lane == 0) { unsigned* bar = (unsigned*)(ws + WS_BAR); const unsigned x = xb_xcc_id(); unsigned pos = 0, npop = 0, mine = 1;
            for (unsigned j = 0; j < 16; ++j) { const unsigned c = xb_ld(&bar[XB_XCNT(j)]); if (c) { ++npop; if (j < x) ++pos; } if (j == x) mine = c ? c : 1u; }
            xinfo[0] = pos; xinfo[1] = npop ? npop : 1u; xinfo[3] = mine; }
        __syncthreads();
    }
    int depth_rt = DEPTH; asm volatile("" : "+s"(depth_rt));
    for (int lc = 0; lc < depth_rt; ++lc) {
        int l = lc; asm volatile("" : "+s"(l));
        if (l > 0) { { PHASE_BEGIN(); quant_rows(a, l, gw, NGW, lane); } GRID_BAR(); }
        {
            PHASE_BEGIN();
            pg8::Gemm g{(const bf16*)(ws + WS_HB8), (const bf16*)(ws + WS_WIN + l * WIN_BYTES), M, NPROJ, D / 2}; pg8::StaticOrder S; S.init(M, NPROJ, Gp, blk);
            EpiProj E{ws, (const bf16*)(ws + WS_BIH) + l * NPROJ, (const float*)(ws + WS_RSA), (const bf16*)(ws + WS_SWH) + l * NPROJ};
            pg8::gemm_phase<EpiProj, pg8::StaticOrder, true, true>(lds, g, S, E, wave);
            forget_logits(a, l, gw, NGW, lane);
        }
        GRID_BAR();
        { PHASE_BEGIN(); mixers_fast(a, l, (LAS char*)lds, wave, lane, Gp, blk); }
        GRID_BAR();
        {
            PHASE_BEGIN();
            pg8::Gemm g{(const bf16*)(ws + WS_Y), (const bf16*)(ws + WS_WBR + l * SQ_BYTES), M, D, D}; pg8::StaticOrder S; S.init(M, D, Gp, blk);
            EpiMerge E{(const bf16*)(ws + WS_G), (bf16*)(ws + WS_MRG)};
            pg8::gemm_phase<EpiMerge, pg8::StaticOrder, false>(lds, g, S, E, wave);
        }
        GRID_BAR();
        {
            PHASE_BEGIN();
            pg8::Gemm g{(const bf16*)(ws + WS_MRG), (const bf16*)(ws + WS_WOUT + l * SQ_BYTES), M, D, D}; pg8::StaticOrder S; S.init(M, D, Gp, blk);
            EpiRes E{l == 0 ? a.x : (const float*)(ws + WS_H), (float*)(ws + WS_H), (bf16*)(ws + WS_HB), (unsigned long long*)(ws + WS_SSA) + l * M};
            pg8::gemm_phase<EpiRes, pg8::StaticOrder, false>(lds, g, S, E, wave);
        }
        GRID_BAR();
        {
            PHASE_BEGIN();
            pg8::Gemm g{(const bf16*)(ws + WS_HB), (const bf16*)(ws + WS_WQ + l * SQ_BYTES), M, D, D}; pg8::StaticOrder S; S.init(M, D, Gp, blk);
            EpiQ E{(bf16*)(ws + WS_Q), (const unsigned long long*)(ws + WS_SSA) + l * M};
            pg8::gemm_phase<EpiQ, pg8::StaticOrder, false>(lds, g, S, E, wave);
        }
        GRID_BAR();
        {
            PHASE_BEGIN(); (void)lane;
            for (int t0 = blk * PEER_TOK; t0 < M; t0 += Gp * PEER_TOK) {
                peer_retrieve(a, l, t0, wave, (LAS char*)lds, wave);
                __syncthreads();
                for (int k = 0; k < PEER_TOK / NWAVES; ++k) { const int tl = wave * (PEER_TOK / NWAVES) + k; peer_publish(a, l, t0 + tl, (LAS char*)lds, tl); }
                __syncthreads();
            }
        }
        GRID_BAR();
        {
            PHASE_BEGIN(); (void)lane;
            const int pos = __builtin_amdgcn_readfirstlane((int)xinfo[0]), npop = __builtin_amdgcn_readfirstlane((int)xinfo[1]), rank = __builtin_amdgcn_readfirstlane((int)xinfo[2]), nloc = __builtin_amdgcn_readfirstlane((int)xinfo[3]);
            const PeerItems it{pos, npop, rank, nloc, wave}; peer_u_wave(a, l, it);
        }
        GRID_BAR();
        {
            PHASE_BEGIN(); (void)lane;
            const int pos = __builtin_amdgcn_readfirstlane((int)xinfo[0]), npop = __builtin_amdgcn_readfirstlane((int)xinfo[1]), rank = __builtin_amdgcn_readfirstlane((int)xinfo[2]), nloc = __builtin_amdgcn_readfirstlane((int)xinfo[3]);
            const PeerItems it{pos, npop, rank, nloc, wave}; peer_v_wave(a, l, it);
        }
        GRID_BAR();
    }
    {
        PHASE_BEGIN(); (void)lane;
        for (int t = gw; t < M; t += NGW) final_norm_row(a, t);
    }
}

extern "C" void kernel_launch(void* const* d_in, const int* in_sizes, int n_in, void* d_out, int out_size, void* d_ws, size_t ws_size, hipStream_t stream) {
    static int grid = 0;
    if (grid == 0) {
        int dev = 0, cus = 0, per_cu = 0;
        if (n_in != 16 || out_size != M * D || ws_size < WS_END2) { fprintf(stderr, "kernel_launch: unexpected shapes (n_in %d out %d ws %zu)\n", n_in, out_size, ws_size); grid = -1; return; }
        (void)hipGetDevice(&dev);
        (void)hipDeviceGetAttribute(&cus, hipDeviceAttributeMultiprocessorCount, dev);
        (void)hipFuncSetAttribute((const void*)mk_fwd, hipFuncAttributeMaxDynamicSharedMemorySize, LDS_BYTES);
        (void)hipOccupancyMaxActiveBlocksPerMultiprocessor(&per_cu, (const void*)mk_fwd, NT, LDS_BYTES);
        if (per_cu < 1) { fprintf(stderr, "kernel_launch: occupancy query says %d blocks per CU\n", per_cu); }
        grid = cus;
        if (grid > 256) grid = 256;
    }
    if (grid < 0) return;
    (void)hipMemsetAsync((char*)d_ws + WS_CTL, 0, CTL_ZERO_BYTES, stream);
    ArgsK a{};
    const GAS float** p = (const GAS float**)&a;
    for (int i = 0; i < 16; ++i) p[i] = (const GAS float*)d_in[i];
    a.out = (GAS float*)d_out; a.ws = (GAS unsigned char*)d_ws;
    void* args[] = {&a};
    hipError_t e = hipLaunchCooperativeKernel((const void*)mk_fwd, dim3(grid), dim3(NT), args, LDS_BYTES, stream);
    if (e != hipSuccess) fprintf(stderr, "cooperative launch failed: %s (grid %d)\n", hipGetErrorString(e), grid);
}
```

```cpp
#include <hip/hip_runtime.h>
#include <hip/hip_cooperative_groups.h>
#include <cstdio>
#include <cstdint>
namespace cg = cooperative_groups;
namespace pg8 {
#define PG8_LAS __attribute__((address_space(3)))
typedef unsigned short bf16_t;
typedef short bf16x8 __attribute__((ext_vector_type(8)));
typedef float f32x4 __attribute__((ext_vector_type(4)));
typedef unsigned u32x4 __attribute__((ext_vector_type(4)));
typedef unsigned u32x2 __attribute__((ext_vector_type(2)));
typedef int i32x4 __attribute__((ext_vector_type(4)));
constexpr int BM = 256, BK = 64, HALF = 128, HTB = HALF * BK * 2  , STAGE_BYTES = 8 * HTB, NXCD = 8, WGM = 8;

__host__ __device__ __forceinline__ int lds_byte(int r, int c) { const int st = (r >> 4) * 2 + (c >> 5), rr = r & 15, cc = c & 31, ob = rr * 64 + cc * 2; return st * 1024 + (ob ^ (((ob >> 9) & 1) << 5)); }
__host__ __device__ __forceinline__ void stage_rc(int b, int& R, int& C) { const int st = b / 1024, sb = b % 1024, swz = sb ^ (((sb >> 9) & 1) << 5); R = (st >> 1) * 16 + swz / 64; C = (st & 1) * 32 + (swz % 64) / 2; }
__host__ __device__ __forceinline__ int perm32(int rho) { const int n = rho >> 4, i = rho & 15; return 8 * (i >> 2) + 4 * n + (i & 3); }

struct Unit { int pm, pn; };
struct Gemm { const bf16_t* A; const bf16_t* Bt; int M, N, K; };

struct StaticOrder {
    int nM, nN, nwg, G, c;
    __host__ __device__ void init(int M, int N, int G_, int c_) { nM = M / BM; nN = N / BM; nwg = nM * nN; G = G_; c = c_; }
    __host__ __device__ bool next(int i, Unit& u) const {
        const long L = (long)i * G + c; if (L >= nwg) return false;
        int wgid = (int)L; { const int q = nwg / NXCD, r = nwg % NXCD, xcd = wgid % NXCD, off = wgid / NXCD; wgid = (xcd < r ? xcd * (q + 1) : r * (q + 1) + (xcd - r) * q) + off; }
        const int nig = WGM * nN, gid = wgid / nig, fm = gid * WGM, gsz = (nM - fm) < WGM ? (nM - fm) : WGM;
        u.pm = fm + ((wgid % nig) % gsz); u.pn = (wgid % nig) / gsz; return true;
    }
};

__device__ __forceinline__ unsigned cvt_pk_bf16(float lo, float hi) { unsigned r; asm volatile("v_cvt_pk_bf16_f32 %0, %1, %2" : "=v"(r) : "v"(lo), "v"(hi)); return r; }

template <class Epi, class Sched, bool ALIGN_EPI = false, bool I8 = false>
__device__ __forceinline__ void gemm_phase(PG8_LAS unsigned char* lds, const Gemm g, const Sched& S, const Epi& E, int wid) {
    int lane_; asm volatile("v_mbcnt_lo_u32_b32 %0, -1, 0\n\tv_mbcnt_hi_u32_b32 %0, -1, %0" : "=v"(lane_));
    const int lane = lane_, tid = wid * 64 + lane, wr = wid >> 2, wc = wid & 3, fr = lane & 15, fq = lane >> 4;
    const int K = g.K, nt = K / BK;
    unsigned voffA, voffB;
    { int R, C; stage_rc(tid * 16, R, C); const int Rb = Epi::PERM ? ((R & ~31) + perm32(R & 31)) : R; voffA = (unsigned)(R * K + C) * 2u; voffB = (unsigned)(Rb * K + C) * 2u; }
    const size_t p2step = (size_t)64 * K * 2;
    const size_t kstep = (size_t)(BK * 2);
    const size_t hstep = (size_t)HALF * K * 2;
    const size_t tstep = 2 * hstep;
    const unsigned ldsw = (unsigned)wid * 1024u;
    const int aoff = lds_byte(wr * 64 + fr, fq * 8), boff = lds_byte(wc * 32 + fr, fq * 8);
#define PG8_SA(b, h) (((b) * 2 + (h)) * HTB)
#define PG8_SB(b, h) ((4 + (b) * 2 + (h)) * HTB)
#define PG8_STAGE(bufoff, gbase, voff) do { _Pragma("unroll") for (int _i = 0; _i < 2; ++_i) \
        __builtin_amdgcn_global_load_lds((const unsigned*)((const char*)(gbase) + _i * p2step + (voff)), (PG8_LAS unsigned*)(lds + (bufoff) + ldsw + _i * 8192), 16, 0, 0); } while (0)
#define PG8_LDA(dst, b, h) do { _Pragma("unroll") for (int m = 0; m < 4; ++m) _Pragma("unroll") for (int k = 0; k < 2; ++k) dst[m][k] = *(const PG8_LAS bf16x8*)(lds + PG8_SA(b, h) + aoff + m * 2048 + k * 1024); } while (0)
#define PG8_LDB(dst, b, h) do { _Pragma("unroll") for (int n = 0; n < 2; ++n) _Pragma("unroll") for (int k = 0; k < 2; ++k) dst[n][k] = *(const PG8_LAS bf16x8*)(lds + PG8_SB(b, h) + boff + n * 2048 + k * 1024); } while (0)
#define PG8_MMA(ai, bj, At, Bt) do { __builtin_amdgcn_s_setprio(1); _Pragma("unroll") for (int m = 0; m < 4; ++m) _Pragma("unroll") for (int n = 0; n < 2; ++n) _Pragma("unroll") for (int k = 0; k < 2; ++k) \
        { if constexpr (I8) acc[ai][bj][m][n] = __builtin_bit_cast(f32x4, __builtin_amdgcn_mfma_i32_16x16x64_i8(__builtin_bit_cast(i32x4, Bt[n][k]), __builtin_bit_cast(i32x4, At[m][k]), __builtin_bit_cast(i32x4, acc[ai][bj][m][n]), 0, 0, 0)); \
          else acc[ai][bj][m][n] = __builtin_amdgcn_mfma_f32_16x16x32_bf16(Bt[n][k], At[m][k], acc[ai][bj][m][n], 0, 0, 0); } __builtin_amdgcn_s_setprio(0); } while (0)
#define PG8_WAIT_V(n) asm volatile("s_waitcnt vmcnt(" #n ")" ::: "memory")
#define PG8_WAIT_L(n) asm volatile("s_waitcnt lgkmcnt(" #n ")" ::: "memory")
#define PG8_BAR __builtin_amdgcn_s_barrier()
#define PG8_SCHED __builtin_amdgcn_sched_barrier(0)
    Unit cur, nxt; int ui = 0;
    if (!S.next(0, cur)) return;
    f32x4 acc[2][2][4][2];
#pragma unroll
    for (int a = 0; a < 2; ++a)
#pragma unroll
        for (int b = 0; b < 2; ++b)
#pragma unroll
            for (int m = 0; m < 4; ++m)
#pragma unroll
                for (int n = 0; n < 2; ++n) acc[a][b][m][n] = (f32x4){0.f, 0.f, 0.f, 0.f};
    bf16x8 At[4][2], B0[2][2], B1[2][2];
    typename Epi::Pre pre = {};
    const char* cA = (const char*)g.A + (size_t)cur.pm * tstep; const char* cB = (const char*)g.Bt + (size_t)cur.pn * tstep;
    PG8_STAGE(PG8_SB(0, 0), cB, voffB); PG8_STAGE(PG8_SB(0, 1), cB + hstep, voffB); PG8_STAGE(PG8_SA(0, 0), cA, voffA); PG8_STAGE(PG8_SA(0, 1), cA + hstep, voffA);
    if (wr == 1) PG8_BAR;
    PG8_WAIT_V(2); PG8_BAR;
    PG8_STAGE(PG8_SB(1, 0), cB + kstep, voffB); PG8_STAGE(PG8_SA(1, 0), cA + kstep, voffA); PG8_STAGE(PG8_SB(1, 1), cB + hstep + kstep, voffB);
    PG8_WAIT_V(6); PG8_BAR;
    for (;;) {
        const bool has_next = S.next(ui + 1, nxt);
        const char* nA = has_next ? (const char*)g.A + (size_t)nxt.pm * tstep : cA; const char* nB = has_next ? (const char*)g.Bt + (size_t)nxt.pn * tstep : cB;
        const int seglen = Epi::HOOK ? 8 : nt;
        for (int t0 = 0; t0 < nt; t0 += seglen) {
        if constexpr (Epi::HOOK) { if (t0 > 0) { int ln_; asm volatile("v_mbcnt_lo_u32_b32 %0, -1, 0\n\tv_mbcnt_hi_u32_b32 %0, -1, %0" : "=v"(ln_)); E.hook(acc, cur, t0 >> 3, wr, wc, ln_ & 15, ln_ >> 4); } }
        for (int t = t0; t < t0 + seglen; t += 2) {
            const bool last = (t == nt - 2);
            if constexpr (Epi::PRELOAD) { if (last) { int ln_; asm volatile("v_mbcnt_lo_u32_b32 %0, -1, 0\n\tv_mbcnt_hi_u32_b32 %0, -1, %0" : "=v"(ln_)); E.preload(pre, cur, wr, wc, ln_ & 15, ln_ >> 4); } }
            const char* a1 = cA + (size_t)(t + 1) * kstep;
            const char* a2 = last ? nA : cA + (size_t)(t + 2) * kstep; const char* b2 = last ? nB : cB + (size_t)(t + 2) * kstep;
            const char* a3 = a2 + kstep; const char* b3 = b2 + kstep;
            PG8_LDB(B0, 0, 0); PG8_LDB(B1, 0, 1); PG8_SCHED; PG8_LDA(At, 0, 0); PG8_STAGE(PG8_SA(1, 1), a1 + hstep, voffA);
            PG8_WAIT_V(8); PG8_WAIT_L(0); PG8_BAR; PG8_MMA(0, 0, At, B0); PG8_MMA(0, 1, At, B1); PG8_BAR; PG8_SCHED;
            PG8_LDA(At, 0, 1); PG8_STAGE(PG8_SB(0, 0), b2, voffB); PG8_STAGE(PG8_SB(0, 1), b2 + hstep, voffB); PG8_STAGE(PG8_SA(0, 0), a2, voffA);
            PG8_WAIT_V(8); PG8_WAIT_L(0); PG8_BAR; PG8_MMA(1, 0, At, B0); PG8_MMA(1, 1, At, B1); PG8_BAR; PG8_SCHED;
            PG8_LDB(B0, 1, 0); PG8_LDB(B1, 1, 1); PG8_SCHED; PG8_LDA(At, 1, 0); PG8_STAGE(PG8_SA(0, 1), a2 + hstep, voffA);
            PG8_WAIT_V(8); PG8_WAIT_L(0); PG8_BAR; PG8_MMA(0, 0, At, B0); PG8_MMA(0, 1, At, B1); PG8_BAR; PG8_SCHED;
            PG8_LDA(At, 1, 1); PG8_STAGE(PG8_SB(1, 0), b3, voffB); PG8_STAGE(PG8_SB(1, 1), b3 + hstep, voffB); PG8_STAGE(PG8_SA(1, 0), a3, voffA);
            PG8_WAIT_V(8); PG8_WAIT_L(0); PG8_BAR; PG8_MMA(1, 0, At, B0); PG8_MMA(1, 1, At, B1); PG8_BAR; PG8_SCHED;
        }
        }
        if constexpr (ALIGN_EPI) { if (wr == 0) PG8_BAR; }
        { int ln_; asm volatile("v_mbcnt_lo_u32_b32 %0, -1, 0\n\tv_mbcnt_hi_u32_b32 %0, -1, %0" : "=v"(ln_));
          if constexpr (Epi::PRELOAD) E(acc, cur, wr, wc, ln_ & 15, ln_ >> 4, pre); else E(acc, cur, wr, wc, ln_ & 15, ln_ >> 4); }
        if (!has_next) break;
#pragma unroll
        for (int a = 0; a < 2; ++a)
#pragma unroll
            for (int b = 0; b < 2; ++b)
#pragma unroll
                for (int m = 0; m < 4; ++m)
#pragma unroll
                    for (int n = 0; n < 2; ++n) acc[a][b][m][n] = (f32x4){0.f, 0.f, 0.f, 0.f};
        cur = nxt; cA = nA; cB = nB; ++ui;
        if constexpr (ALIGN_EPI) { if (wr == 1) PG8_BAR; }
    }
    PG8_WAIT_V(0);
    if constexpr (!ALIGN_EPI) { if (wr == 0) PG8_BAR; }
    PG8_BAR;
#undef PG8_SA
#undef PG8_SB
#undef PG8_STAGE
#undef PG8_LDA
#undef PG8_LDB
#undef PG8_MMA
#undef PG8_WAIT_V
#undef PG8_WAIT_L
#undef PG8_BAR
#undef PG8_SCHED
}
}
constexpr int NWAVES = 8, NT = NWAVES * 64;
constexpr int M = 8192, D = 2048, SEQ = 2048, NBATCH = 4, DEPTH = 2;
constexpr int INW = 13316, NPROJ = 13312, MIXW = 512, HD = 128;
constexpr int PEER_E = 16384;
constexpr float EPS = 1e-6f;
constexpr float ATT_SCALE = 0.08838834764831845f;

constexpr size_t MiB = 1u << 20;
constexpr size_t WS_CTL = 0, CTL_ZERO_BYTES = 1 * MiB;
constexpr size_t WS_SSQ = 0;
constexpr size_t WS_SSA = 256 * 1024;
constexpr size_t WS_WF = 1 * MiB;
constexpr size_t WS_BINR = WS_WF + 64 * 1024;
constexpr size_t WS_LOGF = 2 * MiB;
constexpr size_t WS_CUM = 3 * MiB;
constexpr size_t WS_WIN = 8 * MiB;
constexpr size_t WIN_BYTES = (size_t)NPROJ * D;
constexpr size_t WS_SW = 7 * MiB;
constexpr size_t WS_CMAX = 384 * 1024;
constexpr size_t WS_HB8 = 64 * MiB;
constexpr size_t WS_SA = 7 * MiB + 512 * 1024;
constexpr size_t WS_WBR = 112 * MiB, WS_WOUT = 128 * MiB, WS_WQ = 144 * MiB;
constexpr size_t SQ_BYTES = (size_t)D * D * 2;
constexpr size_t WS_PU = 160 * MiB, WS_PV = 288 * MiB;
constexpr size_t PE_BYTES = (size_t)PEER_E * D;
constexpr size_t WS_PK = 6 * MiB;
constexpr size_t WS_SU = 5 * MiB, WS_SV = 5 * MiB + 256 * 1024;
constexpr size_t WS_HB = 480 * MiB;
constexpr size_t WS_PROJ = 512 * MiB;
constexpr size_t PROJ_T = (size_t)M * MIXW;
constexpr size_t WS_R = 592 * MiB;
constexpr size_t R_PLANE = (size_t)M * D;
constexpr size_t WS_Y = 720 * MiB;
constexpr size_t WS_MRG = 752 * MiB;
constexpr size_t WS_Q = 784 * MiB;
constexpr size_t WS_END = 816 * MiB;

constexpr int RING_BYTES = 131072;
constexpr int LDS_BYTES = 147456;

typedef unsigned short bf16;
typedef unsigned v4u __attribute__((ext_vector_type(4)));
typedef unsigned v2u __attribute__((ext_vector_type(2)));
typedef float f32x4 __attribute__((ext_vector_type(4)));
typedef float f32x2 __attribute__((ext_vector_type(2)));
using bf16x2 = __attribute__((ext_vector_type(2))) __bf16;
#define LAS __attribute__((address_space(3)))

__device__ __forceinline__ unsigned f2bf(float f) { unsigned u = __builtin_bit_cast(unsigned, f); return (u + 0x7fffu + ((u >> 16) & 1u)) >> 16; }
__device__ __forceinline__ unsigned pk2(float lo, float hi) { return f2bf(lo) | (f2bf(hi) << 16); }
__device__ __forceinline__ float bflo(unsigned w) { return __builtin_bit_cast(float, w << 16); }
__device__ __forceinline__ float bfhi(unsigned w) { return __builtin_bit_cast(float, w & 0xffff0000u); }
__device__ __forceinline__ float bf2f(bf16 b) { return __builtin_bit_cast(float, ((unsigned)b) << 16); }
__device__ __forceinline__ float shf(float v, int src) { return __builtin_bit_cast(float, __builtin_amdgcn_ds_bpermute(src << 2, __builtin_bit_cast(int, v))); }
__device__ __forceinline__ int shi(int v, int src) { return __builtin_amdgcn_ds_bpermute(src << 2, v); }
__device__ __forceinline__ float wave_sum(float v, int lane) {
#pragma unroll
    for (int o = 1; o < 64; o <<= 1) v += shf(v, lane ^ o);
    return v;
}
__device__ __forceinline__ float wave_max(float v, int lane) {
#pragma unroll
    for (int o = 1; o < 64; o <<= 1) v = fmaxf(v, shf(v, lane ^ o));
    return v;
}
__device__ __forceinline__ float ssa_to_f(unsigned long long v) { return (float)((double)v * (1.0 / 4294967296.0)); }
__device__ __forceinline__ float dot2_bf16(unsigned w, unsigned x, float acc) { return __builtin_amdgcn_fdot2_f32_bf16(__builtin_bit_cast(bf16x2, w), __builtin_bit_cast(bf16x2, x), acc, false); }

#define LANE_ID(x) asm volatile("v_mbcnt_lo_u32_b32 %0, -1, 0\n\tv_mbcnt_hi_u32_b32 %0, -1, %0" : "=v"(x))
struct Args {
    const float *x, *norm_mix, *w_in, *b_in, *pool_w, *pool_scale, *conv_w, *rel_bias, *w_branch, *w_out, *norm_ffn, *peer_wq, *peer_keys, *peer_u, *peer_v, *norm_final;
    float* out; unsigned char* ws;
};
#define GAS __attribute__((address_space(1)))
#define CAS __attribute__((address_space(4)))
struct ArgsK {
    const GAS float *x, *norm_mix, *w_in, *b_in, *pool_w, *pool_scale, *conv_w, *rel_bias, *w_branch, *w_out, *norm_ffn, *peer_wq, *peer_keys, *peer_u, *peer_v, *norm_final;
    GAS float* out; GAS unsigned char* ws;
};
__device__ __forceinline__ Args load_args(const CAS ArgsK* k, size_t zoff) {
    Args a;
    a.x = (const float*)k->x; a.norm_mix = (const float*)k->norm_mix; a.w_in = (const float*)k->w_in; a.b_in = (const float*)k->b_in; a.pool_w = (const float*)k->pool_w;
    a.pool_scale = (const float*)k->pool_scale; a.conv_w = (const float*)k->conv_w; a.rel_bias = (const float*)k->rel_bias; a.w_branch = (const float*)k->w_branch;
    a.w_out = (const float*)k->w_out; a.norm_ffn = (const float*)k->norm_ffn; a.peer_wq = (const float*)k->peer_wq; a.peer_keys = (const float*)k->peer_keys;
    a.peer_u = (const float*)k->peer_u; a.peer_v = (const float*)k->peer_v; a.norm_final = (const float*)k->norm_final; a.out = (float*)k->out; a.ws = (unsigned char*)(k->ws + zoff);
    return a;
}

using pg8::f32x4; using pg8::Unit;
constexpr size_t WS_G = 896 * MiB;
constexpr size_t WS_SWH = 7 * MiB + 256 * 1024, WS_BIH = 7 * MiB + 384 * 1024;
constexpr size_t WS_RSA = 7 * MiB + 768 * 1024;
struct EpiProj {
    static constexpr bool PERM = true, HOOK = false, PRELOAD = true;
    struct Pre { pg8::u32x4 sw[2], bi[2]; float rs[2][4]; };
    unsigned char* wsb; const bf16* biash; const float* rsa; const bf16* swh;
    __device__ __forceinline__ void preload(Pre& p, const Unit& u, int wr, int wc, int fr, int fq) const {
        const int row0 = u.pm * 256 + wr * 64 + fr, bcol0 = u.pn * 256 + wc * 32 + 8 * fq;
#pragma unroll
        for (int bj = 0; bj < 2; ++bj) { p.sw[bj] = *(const pg8::u32x4*)(swh + bcol0 + bj * 128); p.bi[bj] = *(const pg8::u32x4*)(biash + bcol0 + bj * 128); }
#pragma unroll
        for (int ai = 0; ai < 2; ++ai)
#pragma unroll
            for (int m = 0; m < 4; ++m) p.rs[ai][m] = rsa[row0 + ai * 128 + m * 16];
    }
    __device__ __forceinline__ void operator()(f32x4 (&acc)[2][2][4][2], const Unit& u, int wr, int wc, int fr, int fq, const Pre& p) const {
        const int cl0 = wc * 32 + 8 * fq;
#define ACCF(ai, bj, m, n) __builtin_convertvector(__builtin_bit_cast(pg8::i32x4, acc[ai][bj][m][n]), f32x4)
        const __amdgpu_buffer_rsrc_t rW = __builtin_amdgcn_make_buffer_rsrc((void*)wsb, 0, 0x7fffffff, 0x00020000);
        int sbase, ldb;
        if (u.pn < 20) { sbase = (int)WS_PROJ + ((u.pn >> 1) * (int)PROJ_T + (u.pn & 1) * 256) * 2; ldb = MIXW * 2; } else { sbase = (int)WS_G + (u.pn - 20) * 512; ldb = 4 * D * 2; }
        const int voff = fr * ldb + cl0 * 2; sbase += (u.pm * 256 + wr * 64) * ldb;
#pragma unroll
        for (int bj = 0; bj < 2; ++bj) { const f32x4 w0 = {bflo(p.sw[bj].x), bfhi(p.sw[bj].x), bflo(p.sw[bj].y), bfhi(p.sw[bj].y)}, w1 = {bflo(p.sw[bj].z), bfhi(p.sw[bj].z), bflo(p.sw[bj].w), bfhi(p.sw[bj].w)};
            const f32x4 b0 = {bflo(p.bi[bj].x), bfhi(p.bi[bj].x), bflo(p.bi[bj].y), bfhi(p.bi[bj].y)}, b1 = {bflo(p.bi[bj].z), bfhi(p.bi[bj].z), bflo(p.bi[bj].w), bfhi(p.bi[bj].w)};
#pragma unroll
            for (int ai = 0; ai < 2; ++ai)
#pragma unroll
                for (int m = 0; m < 4; ++m) { const float rs = p.rs[ai][m]; f32x4 v0 = ACCF(ai, bj, m, 0) * rs * w0 + b0, v1 = ACCF(ai, bj, m, 1) * rs * w1 + b1;
                    if (u.pn >= 20) {
                        v0 = (f32x4){fminf(1.0f + __builtin_amdgcn_exp2f(-1.4426950408889634f * v0[0]), 1e18f), fminf(1.0f + __builtin_amdgcn_exp2f(-1.4426950408889634f * v0[1]), 1e18f), fminf(1.0f + __builtin_amdgcn_exp2f(-1.4426950408889634f * v0[2]), 1e18f), fminf(1.0f + __builtin_amdgcn_exp2f(-1.4426950408889634f * v0[3]), 1e18f)};
                        v1 = (f32x4){fminf(1.0f + __builtin_amdgcn_exp2f(-1.4426950408889634f * v1[0]), 1e18f), fminf(1.0f + __builtin_amdgcn_exp2f(-1.4426950408889634f * v1[1]), 1e18f), fminf(1.0f + __builtin_amdgcn_exp2f(-1.4426950408889634f * v1[2]), 1e18f), fminf(1.0f + __builtin_amdgcn_exp2f(-1.4426950408889634f * v1[3]), 1e18f)}; }
                    pg8::u32x4 w; w.x = pg8::cvt_pk_bf16(v0[0], v0[1]); w.y = pg8::cvt_pk_bf16(v0[2], v0[3]); w.z = pg8::cvt_pk_bf16(v1[0], v1[1]); w.w = pg8::cvt_pk_bf16(v1[2], v1[3]);
                    __builtin_amdgcn_raw_buffer_store_b128(w, rW, voff + bj * 256, sbase + (ai * 128 + m * 16) * ldb, 0); } }
    }
};
#undef ACCF
struct EpiMerge {
    static constexpr bool PERM = true, HOOK = true; static constexpr bool PRELOAD = false; struct Pre {};
    const bf16* G; bf16* O;
    struct Bt { pg8::u32x4 n[2][2], d[2][2]; };
    __device__ __forceinline__ void scale(f32x4 (&acc)[2][2][4][2], const Unit& u, int g, int wr, int wc, int fr, int fq) const {
        const __amdgpu_buffer_rsrc_t rs = __builtin_amdgcn_make_buffer_rsrc((void*)G, 0, 0x7fffffff, 0x00020000);
        int voff = (fr * 4 * D + 8 * fq) * 2; asm volatile("" : "+v"(voff));
        const int sden = ((u.pm * 256 + wr * 64) * 4 * D + (g - 1) * D + u.pn * 256 + wc * 32) * 2, snum = sden + D * 2;
        const bool fin = g == 4;
#define MG_LOAD(B, b0) do { _Pragma("unroll") for (int i = 0; i < 2; ++i) _Pragma("unroll") for (int bj = 0; bj < 2; ++bj) { const int ai_ = ((b0) + i) >> 2, m_ = ((b0) + i) & 3, so_ = (ai_ * 128 + m_ * 16) * 4 * D * 2; \
            B.d[i][bj] = __builtin_amdgcn_raw_buffer_load_b128(rs, voff + bj * 256, sden + so_, 0); if (!fin) B.n[i][bj] = __builtin_amdgcn_raw_buffer_load_b128(rs, voff + bj * 256, snum + so_, 0); } } while (0)
#define MG_APPLY(B, b0) do { _Pragma("unroll") for (int i = 0; i < 2; ++i) _Pragma("unroll") for (int bj = 0; bj < 2; ++bj) { const int ai_ = ((b0) + i) >> 2, m_ = ((b0) + i) & 3; const pg8::u32x4 dv = B.d[i][bj], nv = B.n[i][bj]; \
            f32x4 r0 = {__builtin_amdgcn_rcpf(bflo(dv.x)), __builtin_amdgcn_rcpf(bfhi(dv.x)), __builtin_amdgcn_rcpf(bflo(dv.y)), __builtin_amdgcn_rcpf(bfhi(dv.y))}, r1 = {__builtin_amdgcn_rcpf(bflo(dv.z)), __builtin_amdgcn_rcpf(bfhi(dv.z)), __builtin_amdgcn_rcpf(bflo(dv.w)), __builtin_amdgcn_rcpf(bfhi(dv.w))}; \
            if (!fin) { r0 *= (f32x4){bflo(nv.x), bfhi(nv.x), bflo(nv.y), bfhi(nv.y)}; r1 *= (f32x4){bflo(nv.z), bfhi(nv.z), bflo(nv.w), bfhi(nv.w)}; } \
            acc[ai_][bj][m_][0] *= r0; acc[ai_][bj][m_][1] *= r1; asm volatile("" : "+v"(acc[ai_][bj][m_][0]), "+v"(acc[ai_][bj][m_][1])); } } while (0)
        Bt A = {}, B = {};
        MG_LOAD(A, 0);
        MG_LOAD(B, 2); MG_APPLY(A, 0); asm volatile("" ::: "memory");
        MG_LOAD(A, 4); MG_APPLY(B, 2); asm volatile("" ::: "memory");
        MG_LOAD(B, 6); MG_APPLY(A, 4); asm volatile("" ::: "memory");
        MG_APPLY(B, 6); asm volatile("" ::: "memory");
#undef MG_LOAD
#undef MG_APPLY
    }
    __device__ __forceinline__ void hook(f32x4 (&acc)[2][2][4][2], const Unit& u, int g, int wr, int wc, int fr, int fq) const { scale(acc, u, g, wr, wc, fr, fq); }
    __device__ __forceinline__ void operator()(f32x4 (&acc)[2][2][4][2], const Unit& u, int wr, int wc, int fr, int fq) const {
        scale(acc, u, 4, wr, wc, fr, fq);
        const int row0 = u.pm * 256 + wr * 64 + fr, col0 = u.pn * 256 + wc * 32 + 8 * fq;
#pragma unroll
        for (int ai = 0; ai < 2; ++ai)
#pragma unroll
            for (int m = 0; m < 4; ++m) { bf16* rowp = O + (size_t)(row0 + ai * 128 + m * 16) * D + col0;
#pragma unroll
                for (int bj = 0; bj < 2; ++bj) { const f32x4 v0 = acc[ai][bj][m][0], v1 = acc[ai][bj][m][1];
                    pg8::u32x4 w; w.x = pg8::cvt_pk_bf16(v0[0], v0[1]); w.y = pg8::cvt_pk_bf16(v0[2], v0[3]); w.z = pg8::cvt_pk_bf16(v1[0], v1[1]); w.w = pg8::cvt_pk_bf16(v1[2], v1[3]);
                    *(pg8::u32x4*)(rowp + bj * 128) = w; } }
    }
};
struct EpiRes {
    static constexpr bool PERM = true, HOOK = false; static constexpr bool PRELOAD = false; struct Pre {};
    const float* X; bf16* HB; unsigned long long* ssa;
    __device__ __forceinline__ void operator()(f32x4 (&acc)[2][2][4][2], const Unit& u, int wr, int wc, int fr, int fq) const {
        const int row0 = u.pm * 256 + wr * 64 + fr, col0 = u.pn * 256 + wc * 32 + 8 * fq;
#pragma unroll
        for (int ai = 0; ai < 2; ++ai)
#pragma unroll
            for (int m = 0; m < 4; ++m) { const int row = row0 + ai * 128 + m * 16; const size_t off = (size_t)row * D + col0; float s = 0.f;
#pragma unroll
                for (int bj = 0; bj < 2; ++bj) { const size_t o = off + bj * 128; f32x4 h0, h1;
                    if (X != nullptr) { h0 = *(const f32x4*)(X + o); h1 = *(const f32x4*)(X + o + 4); }
                    else { const pg8::u32x4 w = *(const pg8::u32x4*)(HB + o); h0 = (f32x4){bflo(w.x), bfhi(w.x), bflo(w.y), bfhi(w.y)}; h1 = (f32x4){bflo(w.z), bfhi(w.z), bflo(w.w), bfhi(w.w)}; }
                    h0 += acc[ai][bj][m][0]; h1 += acc[ai][bj][m][1];
                    pg8::u32x4 w; w.x = pg8::cvt_pk_bf16(h0[0], h0[1]); w.y = pg8::cvt_pk_bf16(h0[2], h0[3]); w.z = pg8::cvt_pk_bf16(h1[0], h1[1]); w.w = pg8::cvt_pk_bf16(h1[2], h1[3]);
                    *(pg8::u32x4*)(HB + o) = w;
                    s += ((h0[0] * h0[0] + h0[1] * h0[1]) + (h0[2] * h0[2] + h0[3] * h0[3])) + ((h1[0] * h1[0] + h1[1] * h1[1]) + (h1[2] * h1[2] + h1[3] * h1[3])); }
                { const int ln = fq * 16 + fr; s += shf(s, ln ^ 16); s += shf(s, ln ^ 32); }
                if (fq == 0) atomicAdd(ssa + row, (unsigned long long)((double)s * 4294967296.0)); }
    }
};
struct EpiQ {
    static constexpr bool PERM = true, HOOK = false; static constexpr bool PRELOAD = false; struct Pre {};
    bf16* O; const unsigned long long* ssa;
    __device__ __forceinline__ void operator()(f32x4 (&acc)[2][2][4][2], const Unit& u, int wr, int wc, int fr, int fq) const {
        const int row0 = u.pm * 256 + wr * 64 + fr, col0 = u.pn * 256 + wc * 32 + 8 * fq;
#pragma unroll
        for (int ai = 0; ai < 2; ++ai)
#pragma unroll
            for (int m = 0; m < 4; ++m) { const int row = row0 + ai * 128 + m * 16; const float rs = rsqrtf(ssa_to_f(ssa[row]) * (1.0f / D) + EPS);
                bf16* rowp = O + (size_t)row * D + col0;
#pragma unroll
                for (int bj = 0; bj < 2; ++bj) { const f32x4 v0 = acc[ai][bj][m][0] * rs, v1 = acc[ai][bj][m][1] * rs;
                    pg8::u32x4 w; w.x = pg8::cvt_pk_bf16(v0[0], v0[1]); w.y = pg8::cvt_pk_bf16(v0[2], v0[3]); w.z = pg8::cvt_pk_bf16(v1[0], v1[1]); w.w = pg8::cvt_pk_bf16(v1[2], v1[3]);
                    *(pg8::u32x4*)(rowp + bj * 128) = w; } }
    }
};

__device__ __forceinline__ int colmap_in(int j) { return j < 1536 ? j : j + 4; }
__device__ __forceinline__ void tr_item_i8(const float* W, const float* gain, const unsigned* cmax, unsigned char* WT, LAS float* scr, int k0, int n0, int lane) {
    const int q = lane & 7, r8 = lane >> 3, sc = colmap_in(n0 + 4 * q);
    f32x4 v[8];
#pragma unroll
    for (int i = 0; i < 8; ++i) v[i] = *(const f32x4*)(W + (size_t)(k0 + 8 * i + r8) * INW + sc);
    f32x4 inv;
#pragma unroll
    for (int e = 0; e < 4; ++e) { const float cm = __builtin_bit_cast(float, cmax[sc + e]); inv[e] = cm > 0.f ? 127.0f / cm : 0.f; }
#pragma unroll
    for (int i = 0; i < 8; ++i) { const float g = gain[k0 + 8 * i + r8];
#pragma unroll
        for (int e = 0; e < 4; ++e) scr[(8 * i + r8) * 33 + 4 * q + e] = v[i][e] * g * inv[e]; }
    asm volatile("s_waitcnt lgkmcnt(0)" ::: "memory");
    const int n = lane >> 1, hf = lane & 1;
    v4u o[2];
#pragma unroll
    for (int w = 0; w < 8; ++w) { unsigned pk = 0;
#pragma unroll
        for (int b = 0; b < 4; ++b) pk |= ((unsigned)((int)rintf(scr[(32 * hf + 4 * w + b) * 33 + n]) & 255)) << (8 * b);
        o[w >> 2][w & 3] = pk; }
    unsigned char* dst = WT + (size_t)(n0 + n) * D + k0 + 32 * hf;
    *(v4u*)dst = o[0]; *(v4u*)(dst + 16) = o[1];
    asm volatile("s_waitcnt lgkmcnt(0)" ::: "memory");
}
template <bool MAP>
__device__ __forceinline__ void tr_item(const float* W, int ldw, const float* scale, bf16* WT, int ldt, int dcol0, LAS float* scr, int k0, int n0, int lane) {
    const int q = lane & 7, r8 = lane >> 3, sc = MAP ? colmap_in(n0 + 4 * q) : (n0 + 4 * q);
    f32x4 v[8];
#pragma unroll
    for (int i = 0; i < 8; ++i) v[i] = *(const f32x4*)(W + (size_t)(k0 + 8 * i + r8) * ldw + sc);
    f32x4 s0 = {1.f, 1.f, 1.f, 1.f}, s1 = s0;
    if (scale) { s0 = *(const f32x4*)(scale + k0 + 8 * q); s1 = *(const f32x4*)(scale + k0 + 8 * q + 4); }
#pragma unroll
    for (int i = 0; i < 8; ++i)
#pragma unroll
        for (int e = 0; e < 4; ++e) scr[(8 * i + r8) * 33 + 4 * q + e] = v[i][e];
    asm volatile("s_waitcnt lgkmcnt(0)" ::: "memory");
    const int c = q;
#pragma unroll
    for (int j = 0; j < 4; ++j) { const int n = r8 + 8 * j; const LAS float* s = scr + (8 * c) * 33 + n;
        v4u o; o.x = pk2(s[0 * 33] * s0[0], s[1 * 33] * s0[1]); o.y = pk2(s[2 * 33] * s0[2], s[3 * 33] * s0[3]); o.z = pk2(s[4 * 33] * s1[0], s[5 * 33] * s1[1]); o.w = pk2(s[6 * 33] * s1[2], s[7 * 33] * s1[3]);
        *(v4u*)(WT + (size_t)(n0 + n) * ldt + dcol0 + k0 + 8 * c) = o; }
    asm volatile("s_waitcnt lgkmcnt(0)" ::: "memory");
}
constexpr size_t WS_BAR = 512 * 1024;
#define XB_TMO      128
#define XB_XCNT(j)  (256  + 64 * (j))
#define XB_XSUB(j)  (1280 + 64 * (j))
#define XB_XGEN(j)  (2304 + 64 * (j))
#define XB_TOP      3328
#define XB_TOPGEN   3392
#define XCD_BAR_WORDS 3456
#define XB_SPIN_CAP (1u << 23)
__device__ __forceinline__ unsigned xb_ld(unsigned* p)              { return __hip_atomic_load(p, __ATOMIC_RELAXED, __HIP_MEMORY_SCOPE_AGENT); }
__device__ __forceinline__ unsigned xb_add(unsigned* p, unsigned v) { return __hip_atomic_fetch_add(p, v, __ATOMIC_RELAXED, __HIP_MEMORY_SCOPE_AGENT); }
__device__ __forceinline__ unsigned xb_xcc_id() { return (unsigned)__builtin_amdgcn_s_getreg((3 << 11) | 20) & 0xFu; }
#define XB_SPIN(cond, bar) do { unsigned _sp = 0; while (cond) { __builtin_amdgcn_s_sleep(1); \
    if ((++_sp & 255u) == 0u) { if (xb_ld(&(bar)[XB_TMO])) break; if (_sp > XB_SPIN_CAP) { atomicAdd(&(bar)[XB_TMO], 1u); break; } } } } while (0)
__device__ __forceinline__ void xcd_barrier_complete(unsigned* bar, unsigned x, unsigned G, unsigned& nloc, unsigned& nx) {
    unsigned sum, cnt, mine, sp = 0u;
    for (;;) {
        sum = 0u; cnt = 0u; mine = 0u;
#pragma unroll
        for (unsigned j = 0; j < 16; ++j) { const unsigned c = xb_ld(&bar[XB_XCNT(j)]); sum += c; cnt += (c > 0u) ? 1u : 0u; mine = (j == x) ? c : mine; }
        if (sum == G) break;
        __builtin_amdgcn_s_sleep(1);
        if ((++sp & 255u) == 0u) { if (xb_ld(&bar[XB_TMO])) break; if (sp > XB_SPIN_CAP) { atomicAdd(&bar[XB_TMO], 1u); break; } }
    }
    nloc = mine > 0u ? mine : 1u; nx = cnt > 0u ? cnt : 1u;
}
__device__ __forceinline__ void xcd_barrier(unsigned* bar, unsigned x, unsigned G, volatile LAS unsigned* st, int wave) {
    asm volatile("s_waitcnt vmcnt(0)" ::: "memory");
    __syncthreads();
    int lane; asm volatile("v_mbcnt_lo_u32_b32 %0, -1, 0\n\tv_mbcnt_hi_u32_b32 %0, -1, %0" : "=v"(lane));
    if (wave == 0 && lane == 0) {
        __builtin_amdgcn_s_waitcnt(0);
        unsigned nloc = st[0], nx = st[1];
        if (nloc == 0u) { xcd_barrier_complete(bar, x, G, nloc, nx); st[0] = nloc; st[1] = nx; }
        const unsigned old = xb_add(&bar[XB_XSUB(x)], 1u);
        const unsigned gen = old / nloc;
        if (old + 1u == (gen + 1u) * nloc) {
            __builtin_amdgcn_fence(__ATOMIC_RELEASE, "agent");
            asm volatile("s_waitcnt vmcnt(0)" ::: "memory");
            const unsigned og = xb_add(&bar[XB_TOP], 1u);
            const unsigned tg = og / nx;
            if (og + 1u == (tg + 1u) * nx) xb_add(&bar[XB_TOPGEN], 1u);
            else XB_SPIN(xb_ld(&bar[XB_TOPGEN]) == tg, bar);
            __builtin_amdgcn_fence(__ATOMIC_ACQUIRE, "agent");
            xb_add(&bar[XB_XGEN(x)], 1u);
            asm volatile("s_waitcnt vmcnt(0)" ::: "memory");
        } else {
            XB_SPIN(xb_ld(&bar[XB_XGEN(x)]) == gen, bar);
            __builtin_amdgcn_fence(__ATOMIC_ACQUIRE, "agent");
            asm volatile("s_waitcnt vmcnt(0)" ::: "memory");
        }
    }
    __syncthreads();
}
namespace att {
constexpr int D = 128, NW = 8, QBLK = 32, KVBLK = 64, QB = NW * QBLK;
constexpr int PITCH = 512, OPITCH = 2048;
constexpr float SCALE = 0.08838834764831845f, THR = 8.f;
constexpr int SHM_V = KVBLK * D * 2, SHM_K = KVBLK * D * 2;
constexpr int OFF_WS = 2 * SHM_V + 2 * SHM_K, OFF_CUM = OFF_WS + NW * 64 * 4, OFF_REL = OFF_CUM + 2048 * 4, LDS_END = OFF_REL + 320 * 4;
typedef unsigned short bf16;
typedef short bf16x8 __attribute__((ext_vector_type(8)));
typedef short s16x4 __attribute__((ext_vector_type(4)));
typedef float f32x16 __attribute__((ext_vector_type(16)));
typedef float f32x4 __attribute__((ext_vector_type(4)));
typedef unsigned u32x4 __attribute__((ext_vector_type(4)));
#define ALDS __attribute__((address_space(3)))

#define KSWZ(row, colB) ((row) * 256 + ((colB) ^ (((row) & 7) << 4)))
#define SBAR() __builtin_amdgcn_sched_barrier(0)
__device__ __forceinline__ int v_st(int k, int c) { const int kk = (k & ~0xC) | ((k & 4) << 1) | ((k & 8) >> 1); return ((kk >> 3) * 4 + (c >> 5)) * 512 + ((kk & 7) * 32 + (c & 31)) * 2; }
__device__ __forceinline__ int v_rd_base(int lane) { return ((lane & 3) << 3) | (((lane >> 2) & 3) << 6) | (((lane >> 4) & 1) << 5) | (((lane >> 5) & 1) << 8); }
constexpr int v_rd_off(int d0, int ks, int half) { return d0 * 512 + ks * 4096 + half * 2048; }
__device__ __forceinline__ int crow(int r, int hi) { return (r & 3) + 8 * (r >> 2) + 4 * hi; }
__device__ __forceinline__ unsigned cvtpk(float lo, float hi) { unsigned r; asm volatile("v_cvt_pk_bf16_f32 %0, %1, %2" : "=v"(r) : "v"(lo), "v"(hi)); return r; }
__device__ __forceinline__ bf16x8 load8(const bf16* p) { return *reinterpret_cast<const bf16x8*>(p); }

__device__ __forceinline__ void mask_tile(f32x16& p0, f32x16& p1, int dq) {
    const float NEG = -__builtin_inff();
#pragma unroll
    for (int r = 0; r < 16; ++r) { const int c = (r & 3) + 8 * (r >> 2);
        if (dq - c < 0) p0[r] = NEG;
        if (dq - c - 32 < 0) p1[r] = NEG; }
}
__device__ __forceinline__ void partialSM(f32x16& p0, f32x16& p1, float& m_reg, float& mn, float& alpha) {
    float pmax = p0[0];
#pragma unroll
    for (int r = 1; r < 16; ++r) pmax = fmaxf(pmax, p0[r]);
#pragma unroll
    for (int r = 0; r < 16; ++r) pmax = fmaxf(pmax, p1[r]);
    { auto rr = __builtin_amdgcn_permlane32_swap(__float_as_uint(pmax), __float_as_uint(pmax), false, false);
      pmax = fmaxf(__uint_as_float(rr[0]), __uint_as_float(rr[1])); }
    constexpr float C2 = 1.4426950408889634f * SCALE;
    if (__builtin_expect(__all((pmax - m_reg) * SCALE <= THR), 1)) { mn = m_reg; alpha = 1.f; }
    else { mn = fmaxf(m_reg, pmax); alpha = __builtin_amdgcn_exp2f((m_reg - mn) * C2); m_reg = mn; }
    const float mnL = -mn * C2;
#pragma unroll
    for (int r = 0; r < 16; ++r) p0[r] = fmaf(p0[r], C2, mnL);
#pragma unroll
    for (int r = 0; r < 16; ++r) p1[r] = fmaf(p1[r], C2, mnL);
#pragma unroll
    for (int r = 0; r < 16; ++r) p0[r] = __builtin_amdgcn_exp2f(p0[r]);
}
__device__ __forceinline__ void finishSM(f32x16& p0, f32x16& p1, float alpha, float& l_reg, bf16x8& pa0, bf16x8& pa1, bf16x8& pa2, bf16x8& pa3) {
#pragma unroll
    for (int r = 0; r < 16; ++r) p1[r] = __builtin_amdgcn_exp2f(p1[r]);
    float ps = 0;
#pragma unroll
    for (int r = 0; r < 16; ++r) ps += p0[r];
#pragma unroll
    for (int r = 0; r < 16; ++r) ps += p1[r];
    { auto rr = __builtin_amdgcn_permlane32_swap(__float_as_uint(ps), __float_as_uint(ps), false, false);
      ps = __uint_as_float(rr[0]) + __uint_as_float(rr[1]); }
    l_reg = l_reg * alpha + ps;
#define PK4(P, B_, OUT) do { unsigned a0 = cvtpk(P[B_+0], P[B_+1]), a1 = cvtpk(P[B_+2], P[B_+3]);                          \
        unsigned b0 = cvtpk(P[B_+4], P[B_+5]), b1 = cvtpk(P[B_+6], P[B_+7]);                                             \
        auto r0 = __builtin_amdgcn_permlane32_swap(a0, b0, false, false); auto r1 = __builtin_amdgcn_permlane32_swap(a1, b1, false, false); \
        u32x4 w = {r0[0], r1[0], r0[1], r1[1]}; OUT = *reinterpret_cast<bf16x8*>(&w); } while (0)
    PK4(p0, 0, pa0); PK4(p0, 8, pa1); PK4(p1, 0, pa2); PK4(p1, 8, pa3);
#undef PK4
}
template <int KB>
__device__ __forceinline__ void qkt(f32x16& p0, f32x16& p1, const ALDS char* K_lds, int r32, int hi, const bf16x8* qr, bool act) {
    if (!act) { const float NEG = -__builtin_inff();
#pragma unroll
        for (int r = 0; r < 16; ++r) { p0[r] = NEG; p1[r] = NEG; } return; }
    p0 = f32x16{}; p1 = f32x16{};
    const ALDS char* kb[4];
#pragma unroll
    for (int dd = 0; dd < 4; ++dd) kb[dd] = K_lds + KB * SHM_K + KSWZ(r32, (dd * 16 + hi * 8) * 2);
#pragma unroll
    for (int d0 = 0; d0 < 8; ++d0) { const ALDS char* a = kb[d0 & 3] + (d0 >> 2) * 128;
        bf16x8 b0 = *(const ALDS bf16x8*)(a);
        bf16x8 b1 = *(const ALDS bf16x8*)(a + 32 * 256);
        p0 = __builtin_amdgcn_mfma_f32_32x32x16_bf16(b0, qr[d0], p0, 0, 0, 0);
        p1 = __builtin_amdgcn_mfma_f32_32x32x16_bf16(b1, qr[d0], p1, 0, 0, 0); }
}
template <int VB>
__device__ __forceinline__ void pv_tile(f32x16* o, int vb0, bf16x8 pa0, bf16x8 pa1, bf16x8 pa2, bf16x8 pa3, bool act) {
    if (!act) return;
#define TRRD(dst, off) asm volatile("ds_read_b64_tr_b16 %0, %1 offset:%2" : "=&v"(dst) : "v"(vb0), "i"(off) : "memory")
#define PV_D0(d0) do { s16x4 l0, l1, l2, l3, h0, h1, h2, h3; constexpr int b_ = VB * SHM_V + v_rd_off(d0, 0, 0); \
        TRRD(l0, b_); TRRD(h0, b_ + 2048); TRRD(l1, b_ + 4096); TRRD(h1, b_ + 6144); TRRD(l2, b_ + 8192); TRRD(h2, b_ + 10240); TRRD(l3, b_ + 12288); TRRD(h3, b_ + 14336); \
        asm volatile("s_waitcnt lgkmcnt(0)" ::: "memory"); SBAR(); \
        o[d0] = __builtin_amdgcn_mfma_f32_32x32x16_bf16(pa0, (bf16x8){l0[0], l0[1], l0[2], l0[3], h0[0], h0[1], h0[2], h0[3]}, o[d0], 0, 0, 0);   \
        o[d0] = __builtin_amdgcn_mfma_f32_32x32x16_bf16(pa1, (bf16x8){l1[0], l1[1], l1[2], l1[3], h1[0], h1[1], h1[2], h1[3]}, o[d0], 0, 0, 0);   \
        o[d0] = __builtin_amdgcn_mfma_f32_32x32x16_bf16(pa2, (bf16x8){l2[0], l2[1], l2[2], l2[3], h2[0], h2[1], h2[2], h2[3]}, o[d0], 0, 0, 0);   \
        o[d0] = __builtin_amdgcn_mfma_f32_32x32x16_bf16(pa3, (bf16x8){l3[0], l3[1], l3[2], l3[3], h3[0], h3[1], h3[2], h3[3]}, o[d0], 0, 0, 0); } while (0)
    PV_D0(0); PV_D0(1); PV_D0(2); PV_D0(3);
#undef PV_D0
#undef TRRD
}
template <int MODE>
__device__ __forceinline__ void bias_mask(f32x16& p0, f32x16& p1, const ALDS char* lds, int kb, int qlo, int qpos, int hi, float cqs, bool act) {
    if (!act) return;
    if (MODE == 0) {
        const ALDS float* cs = (const ALDS float*)(lds + OFF_CUM) + kb + 4 * hi;
#pragma unroll
        for (int g = 0; g < 4; ++g) { const f32x4 c0 = *(const ALDS f32x4*)(cs + 8 * g), c1 = *(const ALDS f32x4*)(cs + 32 + 8 * g);
#pragma unroll
            for (int e = 0; e < 4; ++e) { p0[4 * g + e] += cqs - c0[e]; p1[4 * g + e] += cqs - c1[e]; } }
        if (kb + KVBLK - 1 > qlo) mask_tile(p0, p1, qpos - 4 * hi - kb);
    } else {
        const ALDS float* tb = (const ALDS float*)(lds + OFF_REL);
        if (qlo - (kb + KVBLK - 1) >= 256) { const float c = tb[319];
#pragma unroll
            for (int r = 0; r < 16; ++r) { p0[r] += c; p1[r] += c; } }
        else { const int d0 = qpos - kb - 4 * hi + 63;
#pragma unroll
            for (int r = 0; r < 16; ++r) { const int c = (r & 3) + 8 * (r >> 2);
                int i0 = d0 - c, i1 = d0 - c - 32; i0 = i0 > 319 ? 319 : i0; i1 = i1 > 319 ? 319 : i1; i1 = i1 < 0 ? 0 : i1; i0 = i0 < 0 ? 0 : i0;
                p0[r] += tb[i0]; p1[r] += tb[i1]; } }
    }
}

struct Seam { bf16x8 qr[8]; bf16x8 st_v0, st_v1, st_k0, st_k1; };
#define VMW() asm volatile("s_waitcnt vmcnt(0)" ::: "memory")
#define BL8(rs, vo, so) __builtin_bit_cast(bf16x8, __builtin_amdgcn_raw_buffer_load_b128(rs, vo, so, 0))
#define SLOAD_H(Kp, Vp, k0) do { S.st_v0 = BL8(rP, kvoff, (Vp) + (k0) * (PITCH * 2)); S.st_v1 = BL8(rP, kvoff, (Vp) + ((k0) + 32) * (PITCH * 2));              \
                         S.st_k0 = BL8(rP, kvoff, (Kp) + (k0) * (PITCH * 2)); S.st_k1 = BL8(rP, kvoff, (Kp) + ((k0) + 32) * (PITCH * 2)); } while (0)
#define SWRITE_HK(bf) do { *(ALDS bf16x8*)(K_lds + (bf) * SHM_K + kws) = S.st_k0; *(ALDS bf16x8*)(K_lds + (bf) * SHM_K + kws + 32 * 256) = S.st_k1; } while (0)
#define SWRITE_HV(bf) do { *(ALDS bf16x8*)(V_lds + (bf) * SHM_V + vst0) = S.st_v0; *(ALDS bf16x8*)(V_lds + (bf) * SHM_V + vst1) = S.st_v1; } while (0)
#define SWRITE_H(bf) do { SWRITE_HV(bf); SWRITE_HK(bf); } while (0)

template <int MODE>
__device__ __forceinline__ void attn_unit(const bf16* Pb, int Qo, int Kh, int Vh, bf16* Yb, int Oo, int P0, int j_lo, int j_hi, ALDS char* lds, int wid, int lane) {
    const int tid = wid * 64 + lane, r32 = lane & 31, hi = lane >> 5;
    const int NT = j_hi - j_lo;
    const int qlo = P0 + wid * QBLK, qpos = qlo + r32;
    ALDS char* V_lds = lds; ALDS char* K_lds = lds + 2 * SHM_V;
    ALDS float* ws = (ALDS float*)(lds + OFF_WS) + wid * 64; ALDS float* li_l = ws; ALDS float* al_l = ws + 32;
    float m_reg = -1e30f, l_reg = 0; f32x16 o[4] = {};
    const int sr = tid >> 4, sc = (tid & 15) * 8, vst0 = v_st(sr, sc), vst1 = v_st(32 + sr, sc), kws = KSWZ(sr, sc * 2);
    const int vb0 = (int)(unsigned)(size_t)V_lds + v_rd_base(lane);
    Seam S;
    const __amdgpu_buffer_rsrc_t rP = __builtin_amdgcn_make_buffer_rsrc((void*)Pb, 0, 0x7fffffff, 0x00020000);
    const __amdgpu_buffer_rsrc_t rO = __builtin_amdgcn_make_buffer_rsrc((void*)Yb, 0, 0x7fffffff, 0x00020000);
    const int kvoff = (sr * PITCH + sc) * 2;
#define KBASE(t) ((j_lo + (t)) * KVBLK)
#define ACT(t) (MODE == 0 ? (KBASE(t) <= qlo + QBLK - 1) : ((j_lo + (t)) <= (qlo >> 6) && (j_lo + (t)) + 8 >= (qlo >> 6)))
#define RESC(a) do { if (__any((a) < 1.f)) { if (hi == 0) al_l[r32] = (a); asm volatile("s_waitcnt lgkmcnt(0)" ::: "memory");              \
                     for (int d_ = 0; d_ < 4; ++d_) for (int r = 0; r < 16; ++r) o[d_][r] *= al_l[crow(r, hi)]; } } while (0)
#define MASKT(P0_, P1_, t) bias_mask<MODE>(P0_, P1_, lds, KBASE(t), qlo, qpos, hi, cq_, ACT(t))
    {
        const int kb0 = j_lo * KVBLK;
#pragma unroll
        for (int d0 = 0; d0 < 8; ++d0) S.qr[d0] = BL8(rP, (r32 * PITCH + hi * 8) * 2 + d0 * 32, Qo + wid * (QBLK * PITCH * 2));
        SLOAD_H(Kh, Vh, kb0); VMW(); SWRITE_HK(0);
        __syncthreads();
    }
    const float cq_ = MODE == 0 ? ((const ALDS float*)(lds + OFF_CUM))[qpos] : 0.f;
    f32x16 pA0, pA1, pB0, pB1; float mnA, mnB, alA, alB; bf16x8 pa0, pa1, pa2, pa3;
    SWRITE_HV(0); SBAR();
    if (NT > 1) { SLOAD_H(Kh, Vh, KBASE(1)); }
    SBAR(); qkt<0>(pA0, pA1, K_lds, r32, hi, S.qr, ACT(0));
    MASKT(pA0, pA1, 0); partialSM(pA0, pA1, m_reg, mnA, alA);
    if (NT > 1) { VMW(); SWRITE_H(1); }
    __syncthreads();
#define HALF_STEP(PX0, PX1, mnX, alX, PY0, PY1, alY, t, KB, VB, SB) do {                                                      \
        SBAR(); qkt<KB>(PX0, PX1, K_lds, r32, hi, S.qr, ACT(t));                                                              \
        finishSM(PY0, PY1, alY, l_reg, pa0, pa1, pa2, pa3); SBAR();                                                           \
        if ((t) + 1 < NT) { SLOAD_H(Kh, Vh, KBASE((t) + 1)); SBAR(); }                                                        \
        pv_tile<VB>(o, vb0, pa0, pa1, pa2, pa3, ACT((t) - 1)); MASKT(PX0, PX1, (t)); partialSM(PX0, PX1, m_reg, mnX, alX);    \
        __syncthreads();                                                                                                      \
        if ((t) + 1 < NT) { VMW(); SWRITE_H(SB); }                                                                            \
        RESC(alX); __syncthreads(); } while (0)
    for (int t = 1; t + 1 < NT; t += 2) {
        HALF_STEP(pB0, pB1, mnB, alB, pA0, pA1, alA, t, 1, 0, 0);
        HALF_STEP(pA0, pA1, mnA, alA, pB0, pB1, alB, t + 1, 0, 1, 1);
    }
    const bool even = (NT & 1) == 0;
    if (even) { SBAR(); qkt<1>(pB0, pB1, K_lds, r32, hi, S.qr, ACT(NT - 1)); SBAR(); }
    finishSM(pA0, pA1, alA, l_reg, pa0, pa1, pa2, pa3); SBAR();
    pv_tile<0>(o, vb0, pa0, pa1, pa2, pa3, ACT(even ? NT - 2 : NT - 1));
    if (even) { MASKT(pB0, pB1, NT - 1); partialSM(pB0, pB1, m_reg, mnB, alB); __syncthreads(); RESC(alB);
        finishSM(pB0, pB1, alB, l_reg, pa0, pa1, pa2, pa3); SBAR(); pv_tile<1>(o, vb0, pa0, pa1, pa2, pa3, ACT(NT - 1)); }
    SBAR();
    if (hi == 0) li_l[r32] = l_reg; asm volatile("s_waitcnt lgkmcnt(0)" ::: "memory");
    float rli[16];
#pragma unroll
    for (int r = 0; r < 16; ++r) rli[r] = __builtin_amdgcn_rcpf(li_l[crow(r, hi)]);
    const int ovoff = (4 * hi * OPITCH + r32) * 2, osoff = Oo + wid * (QBLK * OPITCH * 2);
#pragma unroll
    for (int r = 0; r < 16; ++r) { const int orow = (r & 3) + 8 * (r >> 2);
#pragma unroll
        for (int d0 = 0; d0 < 4; ++d0) { const float v = o[d0][r] * rli[r];
            const float vn = __builtin_bit_cast(float, __builtin_amdgcn_ds_bpermute((lane ^ 1) << 2, __builtin_bit_cast(int, v)));
            if ((r32 & 1) == 0) __builtin_amdgcn_raw_buffer_store_b32(cvtpk(v, vn), rO, ovoff + d0 * 64, osoff + orow * (OPITCH * 2), 0); } }
    __syncthreads();
#undef RESC
#undef KBASE
#undef ACT
#undef MASKT
#undef HALF_STEP
}
#undef BL8
#undef VMW
#undef SLOAD_H
#undef SWRITE_HK
#undef SWRITE_HV
#undef SWRITE_H
#undef KSWZ
#undef SBAR
}
constexpr size_t WS_QCTR = 768 * 1024;
constexpr size_t WS_POOLW = 4 * MiB;
constexpr int N_ATT_UNITS = 256, N_POOL_UNITS = 512, N_CONV_UNITS = 128;

__device__ __forceinline__ void stage_cum(const Args& a, int b, int h, LAS char* lds, int wave, int lane) {
    const float* logf = (const float*)(a.ws + WS_LOGF) + ((size_t)b * SEQ) * 4 + h;
    const int tid = wave * 64 + lane;
    float v[4];
#pragma unroll
    for (int e = 0; e < 4; ++e) v[e] = logf[(size_t)(4 * tid + e) * 4];
    v[1] += v[0]; v[2] += v[1]; v[3] += v[2];
    float incl = v[3];
#pragma unroll
    for (int o = 1; o < 64; o <<= 1) { const float t = shf(incl, lane >= o ? lane - o : lane); if (lane >= o) incl += t; }
    LAS float* wt = (LAS float*)(lds + att::OFF_WS);
    if (lane == 63) wt[wave] = incl;
    __syncthreads();
    float base = incl - v[3];
    for (int w = 0; w < wave; ++w) base += wt[w];
    LAS float* cs = (LAS float*)(lds + att::OFF_CUM);
    const float inv = 1.0f / ATT_SCALE;
    *(LAS f32x4*)(cs + 4 * tid) = (f32x4){(base + v[0]) * inv, (base + v[1]) * inv, (base + v[2]) * inv, (base + v[3]) * inv};
    __syncthreads();
}
__device__ __forceinline__ void attention_item(const Args& a, int l, int u, LAS char* lds, int wave) {
    int lane; asm volatile("v_mbcnt_lo_u32_b32 %0, -1, 0\n\tv_mbcnt_hi_u32_b32 %0, -1, %0" : "=v"(lane));
    const bf16* P = (const bf16*)(a.ws + WS_PROJ); bf16* Y = (bf16*)(a.ws + WS_Y);
    const int mode = u >> 7, v = u & 127, qb = 7 - (v >> 4), bh = v & 15, b = bh >> 2, h = bh & 3;
    const size_t row0 = (size_t)b * SEQ; const int P0 = qb * 256;
    if (mode == 0) {
        stage_cum(a, b, h, lds, wave, lane);
        att::attn_unit<0>(P, (int)((0 * PROJ_T + (row0 + P0) * MIXW + h * HD) * 2), (int)((1 * PROJ_T + row0 * MIXW + h * HD) * 2), (int)((2 * PROJ_T + row0 * MIXW + h * HD) * 2),
                          Y, (int)(((row0 + P0) * D + h * HD) * 2), P0, 0, 4 * qb + 4, lds, wave, lane);
    } else {
        const int tid = wave * 64 + lane;
        if (tid < 320) ((LAS float*)(lds + att::OFF_REL))[tid] = a.rel_bias[((size_t)l * 4 + h) * 320 + tid] * (1.0f / ATT_SCALE);
        const int jlo = 4 * qb - 8 < 0 ? 0 : 4 * qb - 8;
        att::attn_unit<1>(P, (int)((7 * PROJ_T + (row0 + P0) * MIXW + h * HD) * 2), (int)((8 * PROJ_T + row0 * MIXW + h * HD) * 2), (int)((9 * PROJ_T + row0 * MIXW + h * HD) * 2),
                          Y, (int)(((row0 + P0) * D + 1536 + h * HD) * 2), P0, jlo, 4 * qb + 4, lds, wave, lane);
    }
}
__device__ __forceinline__ void pool_item(const Args& a, int l, int u, LAS char* lds, int wave) {
    int lane; asm volatile("v_mbcnt_lo_u32_b32 %0, -1, 0\n\tv_mbcnt_hi_u32_b32 %0, -1, %0" : "=v"(lane));
    const int g = u & 3, T0 = (u >> 2) * 64, tid = wave * 64 + lane;
    const bf16* Pin = (const bf16*)(a.ws + WS_PROJ) + 3 * PROJ_T + g * 128;
    {
        const int cp = tid & 63, run = tid >> 6, w = 2 << g, t0 = T0 + run * 8, s0 = t0 & (SEQ - 1);
        const bf16* col = Pin + 2 * cp;
        float s_lo = 0.f, s_hi = 0.f;
        for (int j = 1; j < w; ++j) if (s0 - j >= 0) { const unsigned x = *(const unsigned*)(col + (size_t)(t0 - j) * MIXW); s_lo += bflo(x); s_hi += bfhi(x); }
#pragma unroll
        for (int i = 0; i < 8; ++i) { const unsigned x = *(const unsigned*)(col + (size_t)(t0 + i) * MIXW); s_lo += bflo(x); s_hi += bfhi(x);
            const int s = s0 + i; const int cnt = s + 1 < w ? s + 1 : w; const float inv = 1.0f / (float)cnt;
            *(LAS unsigned*)(lds + (run * 8 + i) * 272 + 4 * cp) = pk2(s_lo * inv - bflo(x), s_hi * inv - bfhi(x));
            if (s - w + 1 >= 0) { const unsigned y = *(const unsigned*)(col + (size_t)(t0 + i - w + 1) * MIXW); s_lo -= bflo(y); s_hi -= bfhi(y); } }
    }
    __syncthreads();
    {
        typedef short bf16x8 __attribute__((ext_vector_type(8)));
        const bf16* Wt = (const bf16*)(a.ws + WS_POOLW) + ((size_t)l * 4 + g) * 128 * 128;
        const int rt = (wave & 3) * 16, db = (wave >> 2) * 64, fr = lane & 15, kg = lane >> 4;
        f32x4 acc[4] = {};
#pragma unroll
        for (int ks = 0; ks < 4; ++ks) { const bf16x8 af = *(const LAS bf16x8*)(lds + (rt + fr) * 272 + (ks * 32 + kg * 8) * 2);
#pragma unroll
            for (int nt = 0; nt < 4; ++nt) { const bf16x8 bfr = *(const bf16x8*)(Wt + (size_t)(db + nt * 16 + fr) * 128 + ks * 32 + kg * 8);
                acc[nt] = __builtin_amdgcn_mfma_f32_16x16x32_bf16(bfr, af, acc[nt], 0, 0, 0); } }
        bf16* Y = (bf16*)(a.ws + WS_Y) + (size_t)(T0 + rt + fr) * D + 512 + g * 128;
#pragma unroll
        for (int nt = 0; nt < 4; ++nt) { const int d = db + nt * 16 + kg * 4; const f32x4 sc = *(const f32x4*)(a.pool_scale + l * MIXW + g * 128 + d);
            v2u w; w.x = pk2(acc[nt][0] * sc[0], acc[nt][1] * sc[1]); w.y = pk2(acc[nt][2] * sc[2], acc[nt][3] * sc[3]); *(v2u*)(Y + d) = w; }
    }
    __syncthreads();
}
__device__ __forceinline__ void conv_item(const Args& a, int l, int u, int wave) {
    int lane; asm volatile("v_mbcnt_lo_u32_b32 %0, -1, 0\n\tv_mbcnt_hi_u32_b32 %0, -1, %0" : "=v"(lane));
    const bf16* P = (const bf16*)(a.ws + WS_PROJ); const bf16* Ch = P + 4 * PROJ_T; const bf16* Cb = P + 5 * PROJ_T; const bf16* Cc = P + 6 * PROJ_T;
    const int tid = wave * 64 + lane, c0 = (tid & 63) * 8, t0 = u * 64 + (tid >> 6) * 8, s0 = t0 & (SEQ - 1);
    float wgt[3][8];
#pragma unroll
    for (int j = 0; j < 3; ++j) { const float* w = a.conv_w + ((size_t)l * 3 + j) * MIXW + c0; const f32x4 w0 = *(const f32x4*)w, w1 = *(const f32x4*)(w + 4);
#pragma unroll
        for (int k = 0; k < 4; ++k) { wgt[j][k] = w0[k]; wgt[j][4 + k] = w1[k]; } }
    float z2[8], z1[8];
#pragma unroll
    for (int k = 0; k < 8; ++k) { z2[k] = 0.f; z1[k] = 0.f; }
#pragma unroll
    for (int i = -2; i < 8; ++i) {
        float z[8];
        if (s0 + i >= 0) { const v4u hv = *(const v4u*)(Ch + (size_t)(t0 + i) * MIXW + c0), cv = *(const v4u*)(Cc + (size_t)(t0 + i) * MIXW + c0);
            z[0] = bflo(hv.x) * bflo(cv.x); z[1] = bfhi(hv.x) * bfhi(cv.x); z[2] = bflo(hv.y) * bflo(cv.y); z[3] = bfhi(hv.y) * bfhi(cv.y);
            z[4] = bflo(hv.z) * bflo(cv.z); z[5] = bfhi(hv.z) * bfhi(cv.z); z[6] = bflo(hv.w) * bflo(cv.w); z[7] = bfhi(hv.w) * bfhi(cv.w); }
        else {
#pragma unroll
            for (int k = 0; k < 8; ++k) z[k] = 0.f; }
        if (i >= 0) { const v4u bv = *(const v4u*)(Cb + (size_t)(t0 + i) * MIXW + c0); float o[8];
            const float bb[8] = {bflo(bv.x), bfhi(bv.x), bflo(bv.y), bfhi(bv.y), bflo(bv.z), bfhi(bv.z), bflo(bv.w), bfhi(bv.w)};
#pragma unroll
            for (int k = 0; k < 8; ++k) o[k] = bb[k] * (wgt[0][k] * z2[k] + wgt[1][k] * z1[k] + wgt[2][k] * z[k]);
            v4u ov; ov.x = pk2(o[0], o[1]); ov.y = pk2(o[2], o[3]); ov.z = pk2(o[4], o[5]); ov.w = pk2(o[6], o[7]);
            *(v4u*)((bf16*)(a.ws + WS_Y) + (size_t)(t0 + i) * D + 1024 + c0) = ov; }
#pragma unroll
        for (int k = 0; k < 8; ++k) { z2[k] = z1[k]; z1[k] = z[k]; }
    }
}
__device__ __forceinline__ void mixers_fast(const Args& a, int lq, LAS char* lds, int wave, int lane, int G, int blk) {
    const int l = lq & 1;
    for (int u = blk; u < N_ATT_UNITS; u += G) attention_item(a, l, u, lds, wave);
    unsigned* head = (unsigned*)(a.ws + WS_QCTR) + 64 * lq;
    volatile LAS unsigned* slot = (volatile LAS unsigned*)(lds + att::LDS_END);
    for (;;) {
        if (wave == 0 && lane == 0) *slot = __hip_atomic_fetch_add(head, 1u, __ATOMIC_RELAXED, __HIP_MEMORY_SCOPE_AGENT);
        __syncthreads();
        const unsigned it = *slot;
        __syncthreads();
        if (it >= (unsigned)(N_POOL_UNITS + N_CONV_UNITS)) break;
        if (it < (unsigned)N_POOL_UNITS) pool_item(a, l, (int)it, lds, wave); else conv_item(a, l, (int)it - N_POOL_UNITS, wave);
    }
}
__device__ __forceinline__ void p0_cmax(const Args& a, int gw, int NGW, int lane) {
    unsigned char* ws = a.ws;
    {
        constexpr int NCC = (INW + 255) / 256;
        for (int it = gw; it < DEPTH * 32 * NCC; it += NGW) { const int l = it / (32 * NCC), r = it % (32 * NCC), kc = r / NCC, cc = r % NCC; const int c0 = cc * 256 + 4 * lane;
            if (c0 + 3 < INW) { const float* W = a.w_in + (size_t)l * D * INW + (size_t)(kc * 64) * INW + c0; const float* g = a.norm_mix + l * D + kc * 64;
                float m0 = 0.f, m1 = 0.f, m2 = 0.f, m3 = 0.f;
#pragma unroll 8
                for (int k = 0; k < 64; ++k) { const f32x4 w = *(const f32x4*)(W + (size_t)k * INW); const float gk = fabsf(g[k]);
                    m0 = fmaxf(m0, fabsf(w[0]) * gk); m1 = fmaxf(m1, fabsf(w[1]) * gk); m2 = fmaxf(m2, fabsf(w[2]) * gk); m3 = fmaxf(m3, fabsf(w[3]) * gk); }
                unsigned* cm = (unsigned*)(ws + WS_CMAX) + l * INW + c0;
                const unsigned u0 = __float_as_uint(m0), u1 = __float_as_uint(m1), u2 = __float_as_uint(m2), u3 = __float_as_uint(m3);
                __hip_atomic_fetch_max(cm + 0, u0, __ATOMIC_RELAXED, __HIP_MEMORY_SCOPE_AGENT); __hip_atomic_fetch_max(cm + 1, u1, __ATOMIC_RELAXED, __HIP_MEMORY_SCOPE_AGENT);
                __hip_atomic_fetch_max(cm + 2, u2, __ATOMIC_RELAXED, __HIP_MEMORY_SCOPE_AGENT); __hip_atomic_fetch_max(cm + 3, u3, __ATOMIC_RELAXED, __HIP_MEMORY_SCOPE_AGENT); } }
    }
}
__device__ __forceinline__ void p0_prologue(const Args& a, LAS unsigned char* lds, int gw, int NGW, int wave, int lane) {
    unsigned char* ws = a.ws;
    LAS float* scr = (LAS float*)(lds + wave * 16384);
    constexpr int I_SQ = (D / 64) * (D / 32), I_BR = (MIXW / 64) * (D / 32);
    constexpr int I_LAYER = 4 * I_BR + 2 * I_SQ;
    for (int it = gw; it < DEPTH * I_LAYER; it += NGW) {
        const int l = it / I_LAYER; int r = it - l * I_LAYER;
        if (r < 4 * I_BR) { const int g = r / I_BR, rr = r % I_BR, kb = rr / (D / 32), nb = rr % (D / 32);
            tr_item<false>(a.w_branch + ((size_t)l * 4 + g) * MIXW * D, D, nullptr, (bf16*)(ws + WS_WBR + l * SQ_BYTES), D, g * MIXW, scr, 64 * kb, 32 * nb, lane); continue; }
        r -= 4 * I_BR;
        if (r < I_SQ) { const int kb = r / (D / 32), nb = r % (D / 32);
            tr_item<false>(a.w_out + (size_t)l * D * D, D, nullptr, (bf16*)(ws + WS_WOUT + l * SQ_BYTES), D, 0, scr, 64 * kb, 32 * nb, lane); continue; }
        r -= I_SQ;
        { const int kb = r / (D / 32), nb = r % (D / 32);
            tr_item<false>(a.peer_wq + (size_t)l * D * D, D, a.norm_ffn + l * D, (bf16*)(ws + WS_WQ + l * SQ_BYTES), D, 0, scr, 64 * kb, 32 * nb, lane); }
    }
    for (int it = gw; it < DEPTH * 4 * 8; it += NGW) { const int lg = it >> 3, r = it & 7;
        tr_item<false>(a.pool_w + (size_t)lg * 128 * 128, 128, nullptr, (bf16*)(ws + WS_POOLW) + (size_t)lg * 128 * 128, 128, 0, scr, 64 * (r >> 2), 32 * (r & 3), lane); }
    {
        constexpr int NR = 2 * DEPTH * PEER_E;
        f32x4 nv[8];
        if (gw < NR) { const int t = gw / (DEPTH * PEER_E), row = gw - t * (DEPTH * PEER_E); const float* src = (t ? a.peer_v : a.peer_u) + (size_t)row * D + 4 * lane;
#pragma unroll
            for (int j = 0; j < 8; ++j) nv[j] = *(const f32x4*)(src + 256 * j); }
        for (int r = gw; r < NR; r += NGW) { const int t = r / (DEPTH * PEER_E), row = r - t * (DEPTH * PEER_E);
            f32x4 v[8]; float am = 0.f;
#pragma unroll
            for (int j = 0; j < 8; ++j) v[j] = nv[j];
            { const int r2 = r + NGW; if (r2 < NR) { const int t2 = r2 / (DEPTH * PEER_E), row2 = r2 - t2 * (DEPTH * PEER_E); const float* src = (t2 ? a.peer_v : a.peer_u) + (size_t)row2 * D + 4 * lane;
#pragma unroll
                for (int j = 0; j < 8; ++j) nv[j] = *(const f32x4*)(src + 256 * j); } }
#pragma unroll
            for (int j = 0; j < 8; ++j) am = fmaxf(am, fmaxf(fmaxf(fabsf(v[j][0]), fabsf(v[j][1])), fmaxf(fabsf(v[j][2]), fabsf(v[j][3]))));
            am = wave_max(am, lane);
            const float inv = am > 0.f ? 127.0f / am : 0.f, off = 0.f;
            unsigned char* dst = ws + (t ? WS_PV : WS_PU) + (size_t)row * D + 4 * lane;
#pragma unroll
            for (int j = 0; j < 8; ++j) { const int q0 = (int)(rintf(v[j][0] * inv) + off), q1 = (int)(rintf(v[j][1] * inv) + off), q2 = (int)(rintf(v[j][2] * inv) + off), q3 = (int)(rintf(v[j][3] * inv) + off);
                *(unsigned*)(dst + 256 * j) = (unsigned)(q0 & 255) | ((unsigned)(q1 & 255) << 8) | ((unsigned)(q2 & 255) << 16) | ((unsigned)(q3 & 255) << 24); }
            if (lane == 0) ((float*)(ws + (t ? WS_SV : WS_SU)))[row] = am * (1.0f / 127.0f); }
    }
    { bf16* pk = (bf16*)(ws + WS_PK); const size_t n8 = (size_t)DEPTH * 8 * 2 * 128 * 128 / 8;
      for (size_t i = (size_t)gw * 64 + lane; i < n8; i += (size_t)NGW * 64) { const f32x4 v0 = *(const f32x4*)(a.peer_keys + i * 8), v1 = *(const f32x4*)(a.peer_keys + i * 8 + 4);
          v4u o; o.x = pk2(v0[0], v0[1]); o.y = pk2(v0[2], v0[3]); o.z = pk2(v1[0], v1[1]); o.w = pk2(v1[2], v1[3]); *(v4u*)(pk + i * 8) = o; } }
    {
        float* wf = (float*)(ws + WS_WF); float* binr = (float*)(ws + WS_BINR);
        const int gt = gw * 64 + lane, NGT = NGW * 64;
        for (int i = gt; i < DEPTH * 4 * D; i += NGT) { const int l = i / (4 * D), h = (i / D) & 3, k = i % D; wf[i] = a.w_in[(size_t)l * D * INW + (size_t)k * INW + 1536 + h] * a.norm_mix[l * D + k]; }
        for (int i = gt; i < DEPTH * NPROJ; i += NGT) { const int l = i / NPROJ, j = i % NPROJ; binr[i] = a.b_in[l * INW + colmap_in(j)]; }
    }
    {
        unsigned long long* ssq = (unsigned long long*)(ws + WS_SSQ);
        for (int m = gw; m < M; m += NGW) { float s = 0.f, am = 0.f; f32x4 v[8];
#pragma unroll
            for (int j = 0; j < 8; ++j) { const size_t o = (size_t)m * D + j * 256 + lane * 4; v[j] = *(const f32x4*)(a.x + o); s += (v[j][0] * v[j][0] + v[j][1] * v[j][1]) + (v[j][2] * v[j][2] + v[j][3] * v[j][3]);
                am = fmaxf(am, fmaxf(fmaxf(fabsf(v[j][0]), fabsf(v[j][1])), fmaxf(fabsf(v[j][2]), fabsf(v[j][3])))); }
            s = wave_sum(s, lane); am = wave_max(am, lane); if (lane == 0) { ssq[m] = (unsigned long long)((double)s * 4294967296.0); ((float*)(ws + WS_RSA))[m] = rsqrtf(s * (1.0f / D) + EPS) * am * (1.0f / 127.0f); }
            const float inv = am > 0.f ? 127.0f / am : 0.f; unsigned char* q8 = ws + WS_HB8 + (size_t)m * D + 4 * lane;
#pragma unroll
            for (int j = 0; j < 8; ++j) *(unsigned*)(q8 + 256 * j) = ((unsigned)((int)rintf(v[j][0] * inv) & 255)) | ((unsigned)((int)rintf(v[j][1] * inv) & 255) << 8) | ((unsigned)((int)rintf(v[j][2] * inv) & 255) << 16) | ((unsigned)((int)rintf(v[j][3] * inv) & 255) << 24); }
    }
}
__device__ __forceinline__ void p0_win_i8(const Args& a, LAS unsigned char* lds, int gw, int NGW, int wave, int lane) {
    unsigned char* ws = a.ws; LAS float* scr = (LAS float*)(lds + wave * 16384);
    constexpr int I_WIN = (D / 64) * (NPROJ / 32);
    for (int it = gw; it < DEPTH * I_WIN; it += NGW) { const int l = it / I_WIN, r = it % I_WIN, kb = r / (NPROJ / 32), nb = r % (NPROJ / 32);
        tr_item_i8(a.w_in + (size_t)l * D * INW, a.norm_mix + l * D, (const unsigned*)(ws + WS_CMAX) + l * INW, ws + WS_WIN + l * WIN_BYTES, scr, 64 * kb, 32 * nb, lane); }
    float* sw = (float*)(ws + WS_SW); const int gt = gw * 64 + lane, NGT = NGW * 64;
    bf16* swh = (bf16*)(ws + WS_SWH); bf16* bih = (bf16*)(ws + WS_BIH);
    for (int i = gt; i < DEPTH * NPROJ; i += NGT) { const int l = i / NPROJ, j = i % NPROJ; const float s = __builtin_bit_cast(float, ((const unsigned*)(ws + WS_CMAX))[l * INW + colmap_in(j)]) * (1.0f / 127.0f);
        sw[i] = s; swh[i] = (bf16)f2bf(s); bih[i] = (bf16)f2bf(a.b_in[l * INW + colmap_in(j)]); }
}
__device__ __forceinline__ void quant_rows(const Args& a, int l, int gw, int NGW, int lane) {
    unsigned char* ws = a.ws; const bf16* HB = (const bf16*)(ws + WS_HB);
    for (int m = gw; m < M; m += NGW) { float am = 0.f; float v[4][8];
#pragma unroll
        for (int j = 0; j < 4; ++j) { const v4u w = *(const v4u*)(HB + (size_t)m * D + j * 512 + lane * 8);
            v[j][0] = bflo(w.x); v[j][1] = bfhi(w.x); v[j][2] = bflo(w.y); v[j][3] = bfhi(w.y); v[j][4] = bflo(w.z); v[j][5] = bfhi(w.z); v[j][6] = bflo(w.w); v[j][7] = bfhi(w.w);
#pragma unroll
            for (int e = 0; e < 8; ++e) am = fmaxf(am, fabsf(v[j][e])); }
        am = wave_max(am, lane); if (lane == 0) ((float*)(ws + WS_RSA))[m] = rsqrtf(ssa_to_f(((const unsigned long long*)(ws + WS_SSQ))[(size_t)l * M + m]) * (1.0f / D) + EPS) * am * (1.0f / 127.0f);
        const float inv = am > 0.f ? 127.0f / am : 0.f; unsigned char* q8 = ws + WS_HB8 + (size_t)m * D + 8 * lane;
#pragma unroll
        for (int j = 0; j < 4; ++j) { v2u o;
            o.x = ((unsigned)((int)rintf(v[j][0] * inv) & 255)) | ((unsigned)((int)rintf(v[j][1] * inv) & 255) << 8) | ((unsigned)((int)rintf(v[j][2] * inv) & 255) << 16) | ((unsigned)((int)rintf(v[j][3] * inv) & 255) << 24);
            o.y = ((unsigned)((int)rintf(v[j][4] * inv) & 255)) | ((unsigned)((int)rintf(v[j][5] * inv) & 255) << 8) | ((unsigned)((int)rintf(v[j][6] * inv) & 255) << 16) | ((unsigned)((int)rintf(v[j][7] * inv) & 255) << 24);
            *(v2u*)(q8 + 512 * j) = o; } }
}

__device__ __forceinline__ void forget_logits(const Args& a, int l, int gw, int NGW, int lane) {
    unsigned char* ws = a.ws; const bf16* HB = (const bf16*)(ws + WS_HB); const float* wf = (const float*)(ws + WS_WF) + l * 4 * D; const unsigned long long* ssq = (const unsigned long long*)(ws + WS_SSQ) + l * M;
    float* logf = (float*)(ws + WS_LOGF);
    for (int m = gw; m < M; m += NGW) {
        float d[4] = {0.f, 0.f, 0.f, 0.f};
#pragma unroll
        for (int j = 0; j < 4; ++j) { const int k0 = j * 512 + lane * 8; float x[8];
            if (l == 0) { const f32x4 x0 = *(const f32x4*)(a.x + (size_t)m * D + k0), x1 = *(const f32x4*)(a.x + (size_t)m * D + k0 + 4); x[0] = x0[0]; x[1] = x0[1]; x[2] = x0[2]; x[3] = x0[3]; x[4] = x1[0]; x[5] = x1[1]; x[6] = x1[2]; x[7] = x1[3]; }
            else { const v4u xv = *(const v4u*)(HB + (size_t)m * D + k0); x[0] = bflo(xv.x); x[1] = bfhi(xv.x); x[2] = bflo(xv.y); x[3] = bfhi(xv.y); x[4] = bflo(xv.z); x[5] = bfhi(xv.z); x[6] = bflo(xv.w); x[7] = bfhi(xv.w); }
#pragma unroll
            for (int h = 0; h < 4; ++h) { const f32x4 w0 = *(const f32x4*)(wf + h * D + k0), w1 = *(const f32x4*)(wf + h * D + k0 + 4);
                d[h] += x[0] * w0[0] + x[1] * w0[1] + x[2] * w0[2] + x[3] * w0[3] + x[4] * w1[0] + x[5] * w1[1] + x[6] * w1[2] + x[7] * w1[3]; } }
        const float rs = rsqrtf(ssa_to_f(ssq[m]) * (1.0f / D) + EPS);
#pragma unroll
        for (int h = 0; h < 4; ++h) { const float z = wave_sum(d[h], lane) * rs + a.b_in[l * INW + 1536 + h];
            const float ls = fminf(z, 0.f) - log1pf(__expf(-fabsf(z)));
            if (lane == h) logf[m * 4 + h] = ls; }
    }
}
__device__ __forceinline__ float gelu_tanh(float x) { const float u = 1.5957691216057308f * (x + 0.044715f * x * x * x); return x / (1.0f + __expf(-u)); }
constexpr int PEER_TOK = 32;
constexpr int PL_IDX = 0, PL_GATE = PEER_TOK * 128 * 4, PL_TAB = 2 * PEER_TOK * 128 * 4;
__device__ __forceinline__ int f2key(float f) { const int b = __builtin_bit_cast(int, f); return b ^ ((b >> 31) & 0x7fffffff); }
__device__ __forceinline__ float key2f(int k) { return __builtin_bit_cast(float, k ^ ((k >> 31) & 0x7fffffff)); }
#define CE_DESC(x, y) do { const int hi_ = (x) > (y) ? (x) : (y), lo_ = (x) > (y) ? (y) : (x); (x) = hi_; (y) = lo_; } while (0)
__device__ __forceinline__ void sort16_desc(int* v) {
#pragma unroll
    for (int k = 2; k <= 16; k <<= 1)
#pragma unroll
        for (int j = k >> 1; j > 0; j >>= 1)
#pragma unroll
            for (int i = 0; i < 16; ++i) { const int l = i ^ j; if (l > i) { if ((i & k) == 0) CE_DESC(v[i], v[l]); else CE_DESC(v[l], v[i]); } }
}
__device__ __forceinline__ void merge_top16(int* a, const int* b) {
#pragma unroll
    for (int i = 0; i < 16; ++i) a[i] = a[i] > b[15 - i] ? a[i] : b[15 - i];
#pragma unroll
    for (int j = 8; j > 0; j >>= 1)
#pragma unroll
        for (int i = 0; i < 16; ++i) { const int l = i ^ j; if (l > i) CE_DESC(a[i], a[l]); }
}
__device__ __forceinline__ void top16_of_64(int* v) {
    sort16_desc(v); sort16_desc(v + 16); sort16_desc(v + 32); sort16_desc(v + 48);
    merge_top16(v, v + 16); merge_top16(v + 32, v + 48); merge_top16(v, v + 32);
}
constexpr int cand_slot(int i, int j) {
    int n = 0;
    for (int a = 0; a < 16; ++a) for (int b = 0; b < 16; ++b) { if ((a + 1) * (b + 1) <= 16) { if (a == i && b == j) return n; ++n; } }
    return -1;
}
__device__ __forceinline__ void peer_retrieve(const Args& a, int l, int t0, int h, LAS char* lds, int wave) {
    typedef short bf16x8 __attribute__((ext_vector_type(8)));
    typedef float f32x16 __attribute__((ext_vector_type(16)));
    int lane; asm volatile("v_mbcnt_lo_u32_b32 %0, -1, 0\n\tv_mbcnt_hi_u32_b32 %0, -1, %0" : "=v"(lane));
    const int r32 = lane & 31, hi = lane >> 5, hi4 = hi * 4;
    const bf16* Q = (const bf16*)(a.ws + WS_Q) + (size_t)(t0 + r32) * D + h * 256 + hi * 8;
    const bf16* PK = (const bf16*)(a.ws + WS_PK) + ((size_t)(l * 8 + h) * 2) * 128 * 128 + (size_t)r32 * 128 + hi * 8;
    int top[2][16];
#pragma unroll
    for (int p = 0; p < 2; ++p) {
        f32x16 acc[4] = {};
        bf16x8 qf[8];
#pragma unroll
        for (int cs = 0; cs < 8; ++cs) qf[cs] = *(const bf16x8*)(Q + p * 128 + cs * 16);
#pragma unroll
        for (int kb = 0; kb < 4; ++kb) { bf16x8 kf[8];
#pragma unroll
            for (int cs = 0; cs < 8; ++cs) kf[cs] = *(const bf16x8*)(PK + (size_t)p * 128 * 128 + (size_t)kb * 32 * 128 + cs * 16);
#pragma unroll
            for (int cs = 0; cs < 8; ++cs) acc[kb] = __builtin_amdgcn_mfma_f32_32x32x16_bf16(kf[cs], qf[cs], acc[kb], 0, 0, 0); }
        int v[64];
#pragma unroll
        for (int kb = 0; kb < 4; ++kb)
#pragma unroll
            for (int r = 0; r < 16; ++r) { const int c = kb * 32 + (r & 3) + 8 * (r >> 2);
                v[kb * 16 + r] = (f2key(acc[kb][r]) & ~127) | (c | hi4); }
        top16_of_64(v);
        int mine[16], other[16];
#pragma unroll
        for (int i = 0; i < 16; ++i) { auto rr = __builtin_amdgcn_permlane32_swap((unsigned)v[i], (unsigned)v[i], false, false); mine[i] = (int)rr[0]; other[i] = (int)rr[1]; }
        merge_top16(mine, other);
#pragma unroll
        for (int i = 0; i < 16; ++i) top[p][i] = mine[i];
    }
    LAS int* tab = (LAS int*)(lds + PL_TAB) + (wave * 64 + lane) * 32;
    float sA[16], sB[16];
#pragma unroll
    for (int i = 0; i < 16; ++i) { sA[i] = key2f(top[0][i] & ~127); sB[i] = key2f(top[1][i] & ~127); tab[i] = top[0][i] & 127; tab[16 + i] = top[1][i] & 127; }
    int c[64];
#pragma unroll
    for (int n = 0; n < 64; ++n) c[n] = (int)0x80000000;
#pragma unroll
    for (int i = 0; i < 16; ++i)
#pragma unroll
        for (int j = 0; j < 16; ++j) if ((i + 1) * (j + 1) <= 16) c[cand_slot(i, j)] = (f2key(sA[i] + sB[j]) & ~255) | (16 * i + j);
    top16_of_64(c);
    float ex[16]; float sum = 0.f; const float mx = key2f(c[0] & ~255);
#pragma unroll
    for (int w = 0; w < 16; ++w) { ex[w] = __expf(key2f(c[w] & ~255) - mx); sum += ex[w]; }
    const float inv = 1.0f / sum;
    asm volatile("s_waitcnt lgkmcnt(0)" ::: "memory");
    LAS int* oi = (LAS int*)(lds + PL_IDX) + r32 * 128 + h * 16; LAS float* og = (LAS float*)(lds + PL_GATE) + r32 * 128 + h * 16;
#pragma unroll
    for (int w = 0; w < 16; ++w) { const int id = c[w] & 255; const int e = tab[id >> 4] * 128 + tab[16 + (id & 15)];
        if ((w >> 3) == hi) { oi[w] = e; og[w] = ex[w] * inv; } }
}
constexpr size_t WS_IDX = 816 * MiB;
constexpr size_t WS_GATE = 820 * MiB;
constexpr size_t WS_XQ = 824 * MiB;
constexpr size_t WS_SX = 856 * MiB;
constexpr size_t WS_PART = 857 * MiB;
constexpr size_t WS_SUT = 890 * MiB;
constexpr size_t WS_END2 = 1024 * MiB;
#ifndef PEER_NB
#define PEER_NB 8
#endif
constexpr int NSLICE = 8, SLW = D / NSLICE;
#define DPP_ROR(x, n) __builtin_bit_cast(float, __builtin_amdgcn_update_dpp(0, __builtin_bit_cast(int, (x)), 0x120 + (n), 0xf, 0xf, false))
__device__ __forceinline__ void peer_publish(const Args& a, int l, int t, LAS char* lds, int tl) {
    int lane; LANE_ID(lane);
    unsigned char* ws = a.ws;
    { int* gi = (int*)(ws + WS_IDX) + (size_t)t * 128; float* gg = (float*)(ws + WS_GATE) + (size_t)t * 128; float* gs = (float*)(ws + WS_SUT) + (size_t)t * 128;
      const float* SU = (const float*)(ws + WS_SU) + l * PEER_E; const float* SV = (const float*)(ws + WS_SV) + l * PEER_E;
      const int i0 = ((const LAS int*)(lds + PL_IDX))[tl * 128 + lane], i1 = ((const LAS int*)(lds + PL_IDX))[tl * 128 + 64 + lane];
      gi[lane] = i0; gi[64 + lane] = i1; gs[lane] = SU[i0]; gs[64 + lane] = SU[i1];
      gg[lane] = ((const LAS float*)(lds + PL_GATE))[tl * 128 + lane] * SV[i0]; gg[64 + lane] = ((const LAS float*)(lds + PL_GATE))[tl * 128 + 64 + lane] * SV[i1]; }
    const unsigned long long* ssa1 = (const unsigned long long*)(ws + WS_SSA) + l * M;
    const float rs = rsqrtf(ssa_to_f(ssa1[t]) * (1.0f / D) + EPS);
    const bf16* HB = (const bf16*)(ws + WS_HB) + (size_t)t * D; const float* gn = a.norm_ffn + l * D;
    float xf[32]; float am = 0.f;
#pragma unroll
    for (int i = 0; i < 2; ++i) { const int k0 = 16 * lane + 1024 * i; const v4u h0 = *(const v4u*)(HB + k0), h1 = *(const v4u*)(HB + k0 + 8);
        const unsigned hw[8] = {h0.x, h0.y, h0.z, h0.w, h1.x, h1.y, h1.z, h1.w};
#pragma unroll
        for (int q = 0; q < 4; ++q) { const f32x4 g = *(const f32x4*)(gn + k0 + 4 * q);
            xf[16 * i + 4 * q + 0] = bflo(hw[2 * q]) * rs * g[0]; xf[16 * i + 4 * q + 1] = bfhi(hw[2 * q]) * rs * g[1];
            xf[16 * i + 4 * q + 2] = bflo(hw[2 * q + 1]) * rs * g[2]; xf[16 * i + 4 * q + 3] = bfhi(hw[2 * q + 1]) * rs * g[3]; } }
#pragma unroll
    for (int k = 0; k < 32; ++k) am = fmaxf(am, fabsf(xf[k]));
    am = wave_max(am, lane);
    const float inv = am > 0.f ? 127.0f / am : 0.f;
    if (lane == 0) ((float*)(ws + WS_SX))[t] = am * (1.0f / 127.0f);
    unsigned char* xq = ws + WS_XQ + (size_t)t * 4096;
#pragma unroll
    for (int i = 0; i < 2; ++i) { v4u ph, pl;
#pragma unroll
        for (int d = 0; d < 4; ++d) { unsigned wh = 0, wl = 0;
#pragma unroll
            for (int b = 0; b < 4; ++b) { const float sv = xf[16 * i + 4 * d + b] * inv, hq = rintf(sv), lq = rintf((sv - hq) * 128.0f);
                wh |= ((unsigned)((int)hq & 255)) << (8 * b); wl |= ((unsigned)((int)lq & 255)) << (8 * b); }
            ph[d] = wh; pl[d] = wl; }
        *(v4u*)(xq + 16 * lane + 1024 * i) = ph; *(v4u*)(xq + 2048 + 16 * lane + 1024 * i) = pl; }
}
struct PeerItems { int pos, npop, rank, nloc, wave;
    __device__ __forceinline__ int nblk() const { return (M / PEER_TOK - rank + nloc - 1) / nloc; }
    __device__ __forceinline__ int count() const { return ((NSLICE - pos + npop - 1) / npop) * nblk() * (PEER_TOK / NWAVES); }
    __device__ __forceinline__ void get(int n, int& s, int& t) const { constexpr int per = PEER_TOK / NWAVES; const int k = n % per, r = n / per, nb = nblk();
        s = pos + (r / nb) * npop; t = (rank + (r % nb) * nloc) * PEER_TOK + wave * per + k; } };
__device__ __forceinline__ void peer_u_wave(const Args& a, int l, const PeerItems& it) {
    int lane; LANE_ID(lane);
    unsigned char* ws = a.ws; const int sub = lane & 15, grp = lane >> 4;
    const __amdgpu_buffer_rsrc_t rU = __builtin_amdgcn_make_buffer_rsrc((void*)(ws + WS_PU + (size_t)l * PE_BYTES), 0, 0x7fffffff, 0x00020000);
    const __amdgpu_buffer_rsrc_t rW = __builtin_amdgcn_make_buffer_rsrc((void*)ws, 0, 0x7fffffff, 0x00020000);
    const int N = it.count(); if (N <= 0) return;
    int s, t; it.get(0, s, t);
    int idc[2], idn[2] = {0, 0}; v4u xhc, xlc, xhn = {}, xln = {}; v4u wA[PEER_NB], wB[PEER_NB];
#define PU_META(I0, I1, XH, XL, S_, T_) do { I0 = (int)__builtin_amdgcn_raw_buffer_load_b32(rW, 4 * lane, (int)WS_IDX + (T_) * 512, 0); I1 = (int)__builtin_amdgcn_raw_buffer_load_b32(rW, 4 * lane, (int)WS_IDX + (T_) * 512 + 256, 0); \
        XH = __builtin_amdgcn_raw_buffer_load_b128(rW, 16 * sub, (int)WS_XQ + (T_) * 4096 + SLW * (S_), 0); XL = __builtin_amdgcn_raw_buffer_load_b128(rW, 16 * sub, (int)WS_XQ + (T_) * 4096 + 2048 + SLW * (S_), 0); } while (0)
#define PU_ISSUE(W, ID, Q, S_) do { _Pragma("unroll") for (int j = 0; j < PEER_NB; ++j) { const int e_ = shi(ID[(PEER_NB * (Q) + j) >> 4], 4 * ((PEER_NB * (Q) + j) & 15) + grp); W[j] = __builtin_amdgcn_raw_buffer_load_b128(rU, e_ * D + SLW * (S_) + 16 * sub, 0, 0); } } while (0)
#define PU_COMP(W, Q) do { _Pragma("unroll") for (int j = 0; j < PEER_NB; ++j) { int dh = 0, dl = 0; \
            dh = __builtin_amdgcn_sdot4((int)W[j].x, (int)xhc.x, dh, false); dl = __builtin_amdgcn_sdot4((int)W[j].x, (int)xlc.x, dl, false); \
            dh = __builtin_amdgcn_sdot4((int)W[j].y, (int)xhc.y, dh, false); dl = __builtin_amdgcn_sdot4((int)W[j].y, (int)xlc.y, dl, false); \
            dh = __builtin_amdgcn_sdot4((int)W[j].z, (int)xhc.z, dh, false); dl = __builtin_amdgcn_sdot4((int)W[j].z, (int)xlc.z, dl, false); \
            dh = __builtin_amdgcn_sdot4((int)W[j].w, (int)xhc.w, dh, false); dl = __builtin_amdgcn_sdot4((int)W[j].w, (int)xlc.w, dl, false); \
            float p_ = (float)dh + (float)dl * (1.0f / 128.0f); \
            p_ += DPP_ROR(p_, 8); p_ += DPP_ROR(p_, 4); p_ += DPP_ROR(p_, 2); p_ += DPP_ROR(p_, 1); \
            if (sub == ((PEER_NB * (Q) + j) & 15)) { if ((PEER_NB * (Q) + j) >> 4) acc1 = p_; else acc0 = p_; } __builtin_amdgcn_sched_barrier(0); } } while (0)
    PU_META(idc[0], idc[1], xhc, xlc, s, t); PU_ISSUE(wA, idc, 0, s); PU_ISSUE(wB, idc, 1, s);
    for (int n = 0; n < N; ++n) {
        int sn = s, tn = t; const bool more = n + 1 < N;
        if (more) it.get(n + 1, sn, tn);
        PU_META(idn[0], idn[1], xhn, xln, sn, tn);
        float acc0 = 0.f, acc1 = 0.f;
        __builtin_amdgcn_sched_barrier(0);
#if PEER_NB == 8
        PU_COMP(wA, 0); PU_ISSUE(wA, idc, 2, s); __builtin_amdgcn_sched_barrier(0);
        PU_COMP(wB, 1); PU_ISSUE(wB, idc, 3, s); __builtin_amdgcn_sched_barrier(0);
        PU_COMP(wA, 2); PU_ISSUE(wA, idn, 0, sn); __builtin_amdgcn_sched_barrier(0);
        PU_COMP(wB, 3); PU_ISSUE(wB, idn, 1, sn); __builtin_amdgcn_sched_barrier(0);
#else
        PU_COMP(wA, 0); PU_ISSUE(wA, idn, 0, sn); __builtin_amdgcn_sched_barrier(0);
        PU_COMP(wB, 1); PU_ISSUE(wB, idn, 1, sn); __builtin_amdgcn_sched_barrier(0);
#endif
        __builtin_amdgcn_raw_buffer_store_b32(__builtin_bit_cast(unsigned, acc0), rW, (4 * sub + grp) * 4, (int)WS_PART + (s * M + t) * 512, 0);
        __builtin_amdgcn_raw_buffer_store_b32(__builtin_bit_cast(unsigned, acc1), rW, (4 * sub + grp) * 4 + 256, (int)WS_PART + (s * M + t) * 512, 0);
        s = sn; t = tn; idc[0] = idn[0]; idc[1] = idn[1]; xhc = xhn; xlc = xln;
    }
#undef PU_META
#undef PU_ISSUE
#undef PU_COMP
}
__device__ __forceinline__ void peer_v_wave(const Args& a, int l, const PeerItems& it) {
    int lane; LANE_ID(lane);
    unsigned char* ws = a.ws; const int sub = lane & 15, grp = lane >> 4;
    const __amdgpu_buffer_rsrc_t rV = __builtin_amdgcn_make_buffer_rsrc((void*)(ws + WS_PV + (size_t)l * PE_BYTES), 0, 0x7fffffff, 0x00020000);
    const __amdgpu_buffer_rsrc_t rW = __builtin_amdgcn_make_buffer_rsrc((void*)ws, 0, 0x7fffffff, 0x00020000);
    const int N = it.count(); if (N <= 0) return;
    int s, t; it.get(0, s, t);
    struct Meta { int id[2]; float gate[2], su[2], pa[2], sx; v2u h1; };
    Meta mc, mn; v4u wA[PEER_NB], wB[PEER_NB];
    const int l4 = 4 * lane;
#define WLD(off_s) __builtin_amdgcn_raw_buffer_load_b32(rW, l4, (int)(off_s), 0)
#define PV_META(MM, S_, T_) do { const int r_ = (T_) * 512; MM.id[0] = (int)WLD(WS_IDX + r_); MM.id[1] = (int)WLD(WS_IDX + r_ + 256); \
        MM.gate[0] = __builtin_bit_cast(float, WLD(WS_GATE + r_)); MM.gate[1] = __builtin_bit_cast(float, WLD(WS_GATE + r_ + 256)); MM.su[0] = __builtin_bit_cast(float, WLD(WS_SUT + r_)); MM.su[1] = __builtin_bit_cast(float, WLD(WS_SUT + r_ + 256)); \
        float a0_ = 0.f, a1_ = 0.f; _Pragma("unroll") for (int q = 0; q < NSLICE; ++q) { const int po_ = (int)WS_PART + (q * M + (T_)) * 512; a0_ += __builtin_bit_cast(float, WLD(po_)); a1_ += __builtin_bit_cast(float, WLD(po_ + 256)); } \
        MM.pa[0] = a0_; MM.pa[1] = a1_; MM.sx = ((const float*)(ws + WS_SX))[T_]; \
        MM.h1 = __builtin_amdgcn_raw_buffer_load_b64(rW, (16 * sub + 4 * grp) * 2, (int)WS_HB + ((T_) * D + SLW * (S_)) * 2, 0); } while (0)
#define PV_ISSUE(W, ID, Q, S_) do { _Pragma("unroll") for (int j = 0; j < PEER_NB; ++j) { const int e_ = shi(ID[(PEER_NB * (Q) + j) >> 4], 4 * ((PEER_NB * (Q) + j) & 15) + grp); W[j] = __builtin_amdgcn_raw_buffer_load_b128(rV, e_ * D + SLW * (S_) + 16 * sub, 0, 0); } } while (0)
#define PV_COMP(W, Q) do { _Pragma("unroll") for (int j4 = 0; j4 < PEER_NB; j4 += 4) { \
            unsigned cp_ = 0; _Pragma("unroll") for (int jj = 0; jj < 4; ++jj) { const int i_ = PEER_NB * (Q) + j4 + jj; cp_ |= ((unsigned)shi(c8[i_ >> 4], 4 * (i_ & 15) + grp) & 255u) << (8 * jj); } \
            _Pragma("unroll") for (int d = 0; d < 4; ++d) { const unsigned a_ = W[j4][d], b_ = W[j4 + 1][d], c_ = W[j4 + 2][d], d_ = W[j4 + 3][d]; \
                const unsigned x0_ = __builtin_amdgcn_perm(b_, a_, 0x05010400u), x1_ = __builtin_amdgcn_perm(b_, a_, 0x07030602u), y0_ = __builtin_amdgcn_perm(d_, c_, 0x05010400u), y1_ = __builtin_amdgcn_perm(d_, c_, 0x07030602u); \
                yi[4 * d + 0] = __builtin_amdgcn_sdot4((int)__builtin_amdgcn_perm(y0_, x0_, 0x05040100u), (int)cp_, yi[4 * d + 0], false); \
                yi[4 * d + 1] = __builtin_amdgcn_sdot4((int)__builtin_amdgcn_perm(y0_, x0_, 0x07060302u), (int)cp_, yi[4 * d + 1], false); \
                yi[4 * d + 2] = __builtin_amdgcn_sdot4((int)__builtin_amdgcn_perm(y1_, x1_, 0x05040100u), (int)cp_, yi[4 * d + 2], false); \
                yi[4 * d + 3] = __builtin_amdgcn_sdot4((int)__builtin_amdgcn_perm(y1_, x1_, 0x07060302u), (int)cp_, yi[4 * d + 3], false); } \
            __builtin_amdgcn_sched_barrier(0); } } while (0)
    PV_META(mc, s, t); PV_ISSUE(wA, mc.id, 0, s); PV_ISSUE(wB, mc.id, 1, s);
    for (int n = 0; n < N; ++n) {
        int sn = s, tn = t; const bool more = n + 1 < N;
        if (more) it.get(n + 1, sn, tn);
        PV_META(mn, sn, tn);
        float coef[2];
#pragma unroll
        for (int hf = 0; hf < 2; ++hf) coef[hf] = gelu_tanh(mc.pa[hf] * mc.su[hf] * mc.sx) * mc.gate[hf];
        const float cmax = wave_max(fmaxf(fabsf(coef[0]), fabsf(coef[1])), lane); const float cinv = cmax > 0.f ? 127.0f / cmax : 0.f, cs = cmax * (1.0f / 127.0f);
        const int c8[2] = {(int)rintf(coef[0] * cinv), (int)rintf(coef[1] * cinv)};
        int yi[16];
#pragma unroll
        for (int k = 0; k < 16; ++k) yi[k] = 0;
        __builtin_amdgcn_sched_barrier(0);
#if PEER_NB == 8
        PV_COMP(wA, 0); PV_ISSUE(wA, mc.id, 2, s); __builtin_amdgcn_sched_barrier(0);
        PV_COMP(wB, 1); PV_ISSUE(wB, mc.id, 3, s); __builtin_amdgcn_sched_barrier(0);
        PV_COMP(wA, 2); PV_ISSUE(wA, mn.id, 0, sn); __builtin_amdgcn_sched_barrier(0);
        PV_COMP(wB, 3); PV_ISSUE(wB, mn.id, 1, sn); __builtin_amdgcn_sched_barrier(0);
#else
        PV_COMP(wA, 0); PV_ISSUE(wA, mn.id, 0, sn); __builtin_amdgcn_sched_barrier(0);
        PV_COMP(wB, 1); PV_ISSUE(wB, mn.id, 1, sn); __builtin_amdgcn_sched_barrier(0);
#endif
#pragma unroll
        for (int k = 0; k < 16; ++k) { yi[k] += shi(yi[k], lane ^ 16); yi[k] += shi(yi[k], lane ^ 32); }
        int yq[4];
#pragma unroll
        for (int k = 0; k < 4; ++k) yq[k] = grp == 0 ? yi[k] : grp == 1 ? yi[4 + k] : grp == 2 ? yi[8 + k] : yi[12 + k];
        const f32x4 h2 = {bflo(mc.h1.x) + cs * (float)yq[0], bfhi(mc.h1.x) + cs * (float)yq[1], bflo(mc.h1.y) + cs * (float)yq[2], bfhi(mc.h1.y) + cs * (float)yq[3]};
        v2u hb; hb.x = pk2(h2[0], h2[1]); hb.y = pk2(h2[2], h2[3]);
        __builtin_amdgcn_raw_buffer_store_b64(hb, rW, (16 * sub + 4 * grp) * 2, (int)WS_HB + (t * D + SLW * s) * 2, 0);
        const float sq = wave_sum((h2[0] * h2[0] + h2[1] * h2[1]) + (h2[2] * h2[2] + h2[3] * h2[3]), lane);
        if (lane == 0) atomicAdd((unsigned long long*)(ws + WS_SSQ) + (size_t)(l + 1) * M + t, (unsigned long long)((double)sq * 4294967296.0));
        s = sn; t = tn; mc = mn;
    }
#undef PV_META
#undef WLD
#undef PV_ISSUE
#undef PV_COMP
}
__device__ __forceinline__ void final_norm_row(const Args& a, int t) {
    int lane; LANE_ID(lane);
    const bf16* HB = (const bf16*)(a.ws + WS_HB) + (size_t)t * D; float* O = a.out + (size_t)t * D;
    const float rf = rsqrtf(ssa_to_f(((const unsigned long long*)(a.ws + WS_SSQ))[(size_t)DEPTH * M + t]) * (1.0f / D) + EPS);
#pragma unroll
    for (int j = 0; j < 8; ++j) { const int k0 = 4 * lane + 256 * j; const v2u w = *(const v2u*)(HB + k0); const f32x4 g = *(const f32x4*)(a.norm_final + k0);
        *(f32x4*)(O + k0) = (f32x4){bflo(w.x) * rf * g[0], bfhi(w.x) * rf * g[1], bflo(w.y) * rf * g[2], bfhi(w.y) * rf * g[3]}; }
}

__global__ void __launch_bounds__(NT, 2) mk_fwd(ArgsK a_in) {
    extern __shared__ __attribute__((aligned(16))) unsigned char lds_raw[];
    LAS unsigned char* lds = (LAS unsigned char*)lds_raw;
    cg::grid_group grid = cg::this_grid();
    grid.sync();
    const int wave0 = __builtin_amdgcn_readfirstlane(threadIdx.x >> 6);
    const int G = gridDim.x;
    const CAS ArgsK* ka = (const CAS ArgsK*)__builtin_amdgcn_kernarg_segment_ptr();
    size_t zoff = 0;
#define PHASE_BEGIN() int lane; LANE_ID(lane); int blk = blockIdx.x, Gp = G, wv = wave0; asm volatile("" : "+s"(zoff), "+s"(ka), "+s"(blk), "+s"(Gp), "+s"(wv)); const int wave = wv, gw = blk * NWAVES + wv, NGW = Gp * NWAVES; (void)gw; (void)NGW; const Args a = load_args(ka, zoff); unsigned char* const ws = a.ws; (void)ws
    volatile LAS unsigned* bst = (volatile LAS unsigned*)(lds + RING_BYTES + 1024);
#define GRID_BAR() do { asm volatile("" : "+s"(zoff)); unsigned char* wsb_ = (unsigned char*)ka->ws + zoff; int wvb_ = wave0; asm volatile("" : "+s"(wvb_)); xcd_barrier((unsigned*)(wsb_ + WS_BAR), xb_xcc_id(), (unsigned)G, bst, wvb_); } while (0)
    volatile LAS unsigned* xinfo = bst + 4;
    { PHASE_BEGIN(); if (wave == 0 && lane == 0) { bst[0] = 0u; bst[1] = 0u; xinfo[2] = xb_add((unsigned*)(ws + WS_BAR) + XB_XCNT(xb_xcc_id()), 1u); }
      p0_cmax(a, gw, NGW, lane); }
    GRID_BAR();
    { PHASE_BEGIN(); p0_win_i8(a, lds, gw, NGW, wave, lane); p0_prologue(a, lds, gw, NGW, wave, lane); }
    GRID_BAR();
    {
        PHASE_BEGIN();
        if (wave == 0 && lane == 0) { unsigned* bar = (unsigned*)(ws + WS_BAR); const unsigned x = xb_xcc_id(); unsigned pos = 0, npop = 0, mine = 1;
            for (unsigned j = 0; j < 16; ++j) { const unsigned c = xb_ld(&bar[XB_XCNT(j)]); if (c) { ++npop; if (j < x) ++pos; } if (j == x) mine = c ? c : 1u; }
            xinfo[0] = pos; xinfo[1] = npop ? npop : 1u; xinfo[3] = mine; }
        __syncthreads();
    }
    int depth_rt = DEPTH; asm volatile("" : "+s"(depth_rt));
    for (int lc = 0; lc < depth_rt; ++lc) {
        int l = lc; asm volatile("" : "+s"(l));
        if (l > 0) { { PHASE_BEGIN(); quant_rows(a, l, gw, NGW, lane); } GRID_BAR(); }
        {
            PHASE_BEGIN();
            pg8::Gemm g{(const bf16*)(ws + WS_HB8), (const bf16*)(ws + WS_WIN + l * WIN_BYTES), M, NPROJ, D / 2}; pg8::StaticOrder S; S.init(M, NPROJ, Gp, blk);
            EpiProj E{ws, (const bf16*)(ws + WS_BIH) + l * NPROJ, (const float*)(ws + WS_RSA), (const bf16*)(ws + WS_SWH) + l * NPROJ};
            pg8::gemm_phase<EpiProj, pg8::StaticOrder, true, true>(lds, g, S, E, wave);
            forget_logits(a, l, gw, NGW, lane);
        }
        GRID_BAR();
        { PHASE_BEGIN(); mixers_fast(a, l, (LAS char*)lds, wave, lane, Gp, blk); }
        GRID_BAR();
        {
            PHASE_BEGIN();
            pg8::Gemm g{(const bf16*)(ws + WS_Y), (const bf16*)(ws + WS_WBR + l * SQ_BYTES), M, D, D}; pg8::StaticOrder S; S.init(M, D, Gp, blk);
            EpiMerge E{(const bf16*)(ws + WS_G), (bf16*)(ws + WS_MRG)};
            pg8::gemm_phase<EpiMerge, pg8::StaticOrder, false>(lds, g, S, E, wave);
        }
        GRID_BAR();
        {
            PHASE_BEGIN();
            pg8::Gemm g{(const bf16*)(ws + WS_MRG), (const bf16*)(ws + WS_WOUT + l * SQ_BYTES), M, D, D}; pg8::StaticOrder S; S.init(M, D, Gp, blk);
            EpiRes E{l == 0 ? a.x : (const float*)nullptr, (bf16*)(ws + WS_HB), (unsigned long long*)(ws + WS_SSA) + l * M};
            pg8::gemm_phase<EpiRes, pg8::StaticOrder, false>(lds, g, S, E, wave);
        }
        GRID_BAR();
        {
            PHASE_BEGIN();
            pg8::Gemm g{(const bf16*)(ws + WS_HB), (const bf16*)(ws + WS_WQ + l * SQ_BYTES), M, D, D}; pg8::StaticOrder S; S.init(M, D, Gp, blk);
            EpiQ E{(bf16*)(ws + WS_Q), (const unsigned long long*)(ws + WS_SSA) + l * M};
            pg8::gemm_phase<EpiQ, pg8::StaticOrder, false>(lds, g, S, E, wave);
        }
        GRID_BAR();
        {
            PHASE_BEGIN(); (void)lane;
            for (int t0 = blk * PEER_TOK; t0 < M; t0 += Gp * PEER_TOK) {
                peer_retrieve(a, l, t0, wave, (LAS char*)lds, wave);
                __syncthreads();
                for (int k = 0; k < PEER_TOK / NWAVES; ++k) { const int tl = wave * (PEER_TOK / NWAVES) + k; peer_publish(a, l, t0 + tl, (LAS char*)lds, tl); }
                __syncthreads();
            }
        }
        GRID_BAR();
        {
            PHASE_BEGIN(); (void)lane;
            const int pos = __builtin_amdgcn_readfirstlane((int)xinfo[0]), npop = __builtin_amdgcn_readfirstlane((int)xinfo[1]), rank = __builtin_amdgcn_readfirstlane((int)xinfo[2]), nloc = __builtin_amdgcn_readfirstlane((int)xinfo[3]);
            const PeerItems it{pos, npop, rank, nloc, wave}; peer_u_wave(a, l, it);
        }
        GRID_BAR();
        {
            PHASE_BEGIN(); (void)lane;
            const int pos = __builtin_amdgcn_readfirstlane((int)xinfo[0]), npop = __builtin_amdgcn_readfirstlane((int)xinfo[1]), rank = __builtin_amdgcn_readfirstlane((int)xinfo[2]), nloc = __builtin_amdgcn_readfirstlane((int)xinfo[3]);
            const PeerItems it{pos, npop, rank, nloc, wave}; peer_v_wave(a, l, it);
        }
        GRID_BAR();
    }
    {
        PHASE_BEGIN(); (void)lane;
        for (int t = gw; t < M; t += NGW) final_norm_row(a, t);
    }
}

extern "C" void kernel_launch(void* const* d_in, const int* in_sizes, int n_in, void* d_out, int out_size, void* d_ws, size_t ws_size, hipStream_t stream) {
    static int grid = 0;
    if (grid == 0) {
        int dev = 0, cus = 0, per_cu = 0;
        if (n_in != 16 || out_size != M * D || ws_size < WS_END2) { fprintf(stderr, "kernel_launch: unexpected shapes (n_in %d out %d ws %zu)\n", n_in, out_size, ws_size); grid = -1; return; }
        (void)hipGetDevice(&dev);
        (void)hipDeviceGetAttribute(&cus, hipDeviceAttributeMultiprocessorCount, dev);
        (void)hipFuncSetAttribute((const void*)mk_fwd, hipFuncAttributeMaxDynamicSharedMemorySize, LDS_BYTES);
        (void)hipOccupancyMaxActiveBlocksPerMultiprocessor(&per_cu, (const void*)mk_fwd, NT, LDS_BYTES);
        if (per_cu < 1) { fprintf(stderr, "kernel_launch: occupancy query says %d blocks per CU\n", per_cu); }
        grid = cus;
        if (grid > 256) grid = 256;
    }
    if (grid < 0) return;
    (void)hipMemsetAsync((char*)d_ws + WS_CTL, 0, CTL_ZERO_BYTES, stream);
    ArgsK a{};
    const GAS float** p = (const GAS float**)&a;
    for (int i = 0; i < 16; ++i) p[i] = (const GAS float*)d_in[i];
    a.out = (GAS float*)d_out; a.ws = (GAS unsigned char*)d_ws;
    void* args[] = {&a};
    hipError_t e = hipLaunchCooperativeKernel((const void*)mk_fwd, dim3(grid), dim3(NT), args, LDS_BYTES, stream);
    if (e != hipSuccess) fprintf(stderr, "cooperative launch failed: %s (grid %d)\n", hipGetErrorString(e), grid);
}
```

```cpp
#include <hip/hip_runtime.h>
#include <hip/hip_cooperative_groups.h>
#include <cstdio>
#include <cstdint>
namespace cg = cooperative_groups;
namespace pg8 {
#define PG8_LAS __attribute__((address_space(3)))
typedef unsigned short bf16_t;
typedef short bf16x8 __attribute__((ext_vector_type(8)));
typedef float f32x4 __attribute__((ext_vector_type(4)));
typedef unsigned u32x4 __attribute__((ext_vector_type(4)));
typedef unsigned u32x2 __attribute__((ext_vector_type(2)));
typedef int i32x4 __attribute__((ext_vector_type(4)));
constexpr int BM = 256, BK = 64, HALF = 128, HTB = HALF * BK * 2  , STAGE_BYTES = 8 * HTB, NXCD = 8, WGM = 8;

__host__ __device__ __forceinline__ int lds_byte(int r, int c) { const int st = (r >> 4) * 2 + (c >> 5), rr = r & 15, cc = c & 31, ob = rr * 64 + cc * 2; return st * 1024 + (ob ^ (((ob >> 9) & 1) << 5)); }
__host__ __device__ __forceinline__ void stage_rc(int b, int& R, int& C) { const int st = b / 1024, sb = b % 1024, swz = sb ^ (((sb >> 9) & 1) << 5); R = (st >> 1) * 16 + swz / 64; C = (st & 1) * 32 + (swz % 64) / 2; }
__host__ __device__ __forceinline__ int perm32(int rho) { const int n = rho >> 4, i = rho & 15; return 8 * (i >> 2) + 4 * n + (i & 3); }

struct Unit { int pm, pn; };
struct Gemm { const bf16_t* A; const bf16_t* Bt; int M, N, K; };

struct StaticOrder {
    int nM, nN, nwg, G, c;
    __host__ __device__ void init(int M, int N, int G_, int c_) { nM = M / BM; nN = N / BM; nwg = nM * nN; G = G_; c = c_; }
    __host__ __device__ bool next(int i, Unit& u) const {
        const long L = (long)i * G + c; if (L >= nwg) return false;
        int wgid = (int)L; { const int q = nwg / NXCD, r = nwg % NXCD, xcd = wgid % NXCD, off = wgid / NXCD; wgid = (xcd < r ? xcd * (q + 1) : r * (q + 1) + (xcd - r) * q) + off; }
        const int nig = WGM * nN, gid = wgid / nig, fm = gid * WGM, gsz = (nM - fm) < WGM ? (nM - fm) : WGM;
        u.pm = fm + ((wgid % nig) % gsz); u.pn = (wgid % nig) / gsz; return true;
    }
};

__device__ __forceinline__ unsigned cvt_pk_bf16(float lo, float hi) { unsigned r; asm volatile("v_cvt_pk_bf16_f32 %0, %1, %2" : "=v"(r) : "v"(lo), "v"(hi)); return r; }

template <class Epi, class Sched, bool ALIGN_EPI = false, bool I8 = false>
__device__ __forceinline__ void gemm_phase(PG8_LAS unsigned char* lds, const Gemm g, const Sched& S, const Epi& E, int wid) {
    int lane_; asm volatile("v_mbcnt_lo_u32_b32 %0, -1, 0\n\tv_mbcnt_hi_u32_b32 %0, -1, %0" : "=v"(lane_));
    const int lane = lane_, tid = wid * 64 + lane, wr = wid >> 2, wc = wid & 3, fr = lane & 15, fq = lane >> 4;
    const int K = g.K, nt = K / BK;
    unsigned voffA, voffB;
    { int R, C; stage_rc(tid * 16, R, C); const int Rb = Epi::PERM ? ((R & ~31) + perm32(R & 31)) : R; voffA = (unsigned)(R * K + C) * 2u; voffB = (unsigned)(Rb * K + C) * 2u; }
    const size_t p2step = (size_t)64 * K * 2;
    const size_t kstep = (size_t)(BK * 2);
    const size_t hstep = (size_t)HALF * K * 2;
    const size_t tstep = 2 * hstep;
    const unsigned ldsw = (unsigned)wid * 1024u;
    const int aoff = lds_byte(wr * 64 + fr, fq * 8), boff = lds_byte(wc * 32 + fr, fq * 8);
#define PG8_SA(b, h) (((b) * 2 + (h)) * HTB)
#define PG8_SB(b, h) ((4 + (b) * 2 + (h)) * HTB)
#define PG8_STAGE(bufoff, gbase, voff) do { _Pragma("unroll") for (int _i = 0; _i < 2; ++_i) \
        __builtin_amdgcn_global_load_lds((const unsigned*)((const char*)(gbase) + _i * p2step + (voff)), (PG8_LAS unsigned*)(lds + (bufoff) + ldsw + _i * 8192), 16, 0, 0); } while (0)
#define PG8_LDA(dst, b, h) do { _Pragma("unroll") for (int m = 0; m < 4; ++m) _Pragma("unroll") for (int k = 0; k < 2; ++k) dst[m][k] = *(const PG8_LAS bf16x8*)(lds + PG8_SA(b, h) + aoff + m * 2048 + k * 1024); } while (0)
#define PG8_LDB(dst, b, h) do { _Pragma("unroll") for (int n = 0; n < 2; ++n) _Pragma("unroll") for (int k = 0; k < 2; ++k) dst[n][k] = *(const PG8_LAS bf16x8*)(lds + PG8_SB(b, h) + boff + n * 2048 + k * 1024); } while (0)
#define PG8_MMA(ai, bj, At, Bt) do { __builtin_amdgcn_s_setprio(1); _Pragma("unroll") for (int m = 0; m < 4; ++m) _Pragma("unroll") for (int n = 0; n < 2; ++n) _Pragma("unroll") for (int k = 0; k < 2; ++k) \
        { if constexpr (I8) acc[ai][bj][m][n] = __builtin_bit_cast(f32x4, __builtin_amdgcn_mfma_i32_16x16x64_i8(__builtin_bit_cast(i32x4, Bt[n][k]), __builtin_bit_cast(i32x4, At[m][k]), __builtin_bit_cast(i32x4, acc[ai][bj][m][n]), 0, 0, 0)); \
          else acc[ai][bj][m][n] = __builtin_amdgcn_mfma_f32_16x16x32_bf16(Bt[n][k], At[m][k], acc[ai][bj][m][n], 0, 0, 0); } __builtin_amdgcn_s_setprio(0); } while (0)
#define PG8_WAIT_V(n) asm volatile("s_waitcnt vmcnt(" #n ")" ::: "memory")
#define PG8_WAIT_L(n) asm volatile("s_waitcnt lgkmcnt(" #n ")" ::: "memory")
#define PG8_BAR __builtin_amdgcn_s_barrier()
#define PG8_SCHED __builtin_amdgcn_sched_barrier(0)
    Unit cur, nxt; int ui = 0;
    if (!S.next(0, cur)) return;
    f32x4 acc[2][2][4][2];
#pragma unroll
    for (int a = 0; a < 2; ++a)
#pragma unroll
        for (int b = 0; b < 2; ++b)
#pragma unroll
            for (int m = 0; m < 4; ++m)
#pragma unroll
                for (int n = 0; n < 2; ++n) acc[a][b][m][n] = (f32x4){0.f, 0.f, 0.f, 0.f};
    bf16x8 At[4][2], B0[2][2], B1[2][2];
    typename Epi::Pre pre = {};
    const char* cA = (const char*)g.A + (size_t)cur.pm * tstep; const char* cB = (const char*)g.Bt + (size_t)cur.pn * tstep;
    PG8_STAGE(PG8_SB(0, 0), cB, voffB); PG8_STAGE(PG8_SB(0, 1), cB + hstep, voffB); PG8_STAGE(PG8_SA(0, 0), cA, voffA); PG8_STAGE(PG8_SA(0, 1), cA + hstep, voffA);
    if (wr == 1) PG8_BAR;
    PG8_WAIT_V(2); PG8_BAR;
    PG8_STAGE(PG8_SB(1, 0), cB + kstep, voffB); PG8_STAGE(PG8_SA(1, 0), cA + kstep, voffA); PG8_STAGE(PG8_SB(1, 1), cB + hstep + kstep, voffB);
    PG8_WAIT_V(6); PG8_BAR;
    for (;;) {
        const bool has_next = S.next(ui + 1, nxt);
        const char* nA = has_next ? (const char*)g.A + (size_t)nxt.pm * tstep : cA; const char* nB = has_next ? (const char*)g.Bt + (size_t)nxt.pn * tstep : cB;
        const int seglen = Epi::HOOK ? 8 : nt;
        for (int t0 = 0; t0 < nt; t0 += seglen) {
        if constexpr (Epi::HOOK) { if (t0 > 0) { int ln_; asm volatile("v_mbcnt_lo_u32_b32 %0, -1, 0\n\tv_mbcnt_hi_u32_b32 %0, -1, %0" : "=v"(ln_)); E.hook(acc, cur, t0 >> 3, wr, wc, ln_ & 15, ln_ >> 4); } }
        for (int t = t0; t < t0 + seglen; t += 2) {
            const bool last = (t == nt - 2);
            if constexpr (Epi::PRELOAD) { if (last) { int ln_; asm volatile("v_mbcnt_lo_u32_b32 %0, -1, 0\n\tv_mbcnt_hi_u32_b32 %0, -1, %0" : "=v"(ln_)); E.preload(pre, cur, wr, wc, ln_ & 15, ln_ >> 4); } }
            const char* a1 = cA + (size_t)(t + 1) * kstep;
            const char* a2 = last ? nA : cA + (size_t)(t + 2) * kstep; const char* b2 = last ? nB : cB + (size_t)(t + 2) * kstep;
            const char* a3 = a2 + kstep; const char* b3 = b2 + kstep;
            PG8_LDB(B0, 0, 0); PG8_LDB(B1, 0, 1); PG8_SCHED; PG8_LDA(At, 0, 0); PG8_STAGE(PG8_SA(1, 1), a1 + hstep, voffA);
            PG8_WAIT_V(8); PG8_WAIT_L(0); PG8_BAR; PG8_MMA(0, 0, At, B0); PG8_MMA(0, 1, At, B1); PG8_BAR; PG8_SCHED;
            PG8_LDA(At, 0, 1); PG8_STAGE(PG8_SB(0, 0), b2, voffB); PG8_STAGE(PG8_SB(0, 1), b2 + hstep, voffB); PG8_STAGE(PG8_SA(0, 0), a2, voffA);
            PG8_WAIT_V(8); PG8_WAIT_L(0); PG8_BAR; PG8_MMA(1, 0, At, B0); PG8_MMA(1, 1, At, B1); PG8_BAR; PG8_SCHED;
            PG8_LDB(B0, 1, 0); PG8_LDB(B1, 1, 1); PG8_SCHED; PG8_LDA(At, 1, 0); PG8_STAGE(PG8_SA(0, 1), a2 + hstep, voffA);
            PG8_WAIT_V(8); PG8_WAIT_L(0); PG8_BAR; PG8_MMA(0, 0, At, B0); PG8_MMA(0, 1, At, B1); PG8_BAR; PG8_SCHED;
            PG8_LDA(At, 1, 1); PG8_STAGE(PG8_SB(1, 0), b3, voffB); PG8_STAGE(PG8_SB(1, 1), b3 + hstep, voffB); PG8_STAGE(PG8_SA(1, 0), a3, voffA);
            PG8_WAIT_V(8); PG8_WAIT_L(0); PG8_BAR; PG8_MMA(1, 0, At, B0); PG8_MMA(1, 1, At, B1); PG8_BAR; PG8_SCHED;
        }
        }
        if constexpr (ALIGN_EPI) { if (wr == 0) PG8_BAR; }
        { int ln_; asm volatile("v_mbcnt_lo_u32_b32 %0, -1, 0\n\tv_mbcnt_hi_u32_b32 %0, -1, %0" : "=v"(ln_));
          if constexpr (Epi::PRELOAD) E(acc, cur, wr, wc, ln_ & 15, ln_ >> 4, pre); else E(acc, cur, wr, wc, ln_ & 15, ln_ >> 4); }
        if (!has_next) break;
#pragma unroll
        for (int a = 0; a < 2; ++a)
#pragma unroll
            for (int b = 0; b < 2; ++b)
#pragma unroll
                for (int m = 0; m < 4; ++m)
#pragma unroll
                    for (int n = 0; n < 2; ++n) acc[a][b][m][n] = (f32x4){0.f, 0.f, 0.f, 0.f};
        cur = nxt; cA = nA; cB = nB; ++ui;
        if constexpr (ALIGN_EPI) { if (wr == 1) PG8_BAR; }
    }
    PG8_WAIT_V(0);
    if constexpr (!ALIGN_EPI) { if (wr == 0) PG8_BAR; }
    PG8_BAR;
#undef PG8_SA
#undef PG8_SB
#undef PG8_STAGE
#undef PG8_LDA
#undef PG8_LDB
#undef PG8_MMA
#undef PG8_WAIT_V
#undef PG8_WAIT_L
#undef PG8_BAR
#undef PG8_SCHED
}
}
constexpr int NWAVES = 8, NT = NWAVES * 64;
constexpr int M = 8192, D = 2048, SEQ = 2048, NBATCH = 4, DEPTH = 2;
constexpr int INW = 13316, NPROJ = 13312, MIXW = 512, HD = 128;
constexpr int PEER_E = 16384;
constexpr float EPS = 1e-6f;
constexpr float ATT_SCALE = 0.08838834764831845f;

constexpr size_t MiB = 1u << 20;
constexpr size_t WS_CTL = 0, CTL_ZERO_BYTES = 1 * MiB;
constexpr size_t WS_SSQ = 0;
constexpr size_t WS_SSA = 256 * 1024;
constexpr size_t WS_WF = 1 * MiB;
constexpr size_t WS_BINR = WS_WF + 64 * 1024;
constexpr size_t WS_LOGF = 2 * MiB;
constexpr size_t WS_CUM = 3 * MiB;
constexpr size_t WS_WIN = 8 * MiB;
constexpr size_t WIN_BYTES = (size_t)NPROJ * D;
constexpr size_t WS_SW = 7 * MiB;
constexpr size_t WS_CMAX = 384 * 1024;
constexpr size_t WS_HB8 = 64 * MiB;
constexpr size_t WS_SA = 7 * MiB + 512 * 1024;
constexpr size_t WS_WBR = 112 * MiB, WS_WOUT = 128 * MiB, WS_WQ = 144 * MiB;
constexpr size_t SQ_BYTES = (size_t)D * D * 2;
constexpr size_t WS_PU = 160 * MiB, WS_PV = 288 * MiB;
constexpr size_t PE_BYTES = (size_t)PEER_E * D;
constexpr size_t WS_PK = 6 * MiB;
constexpr size_t WS_SU = 5 * MiB, WS_SV = 5 * MiB + 256 * 1024;
constexpr size_t WS_HB = 480 * MiB;
constexpr size_t WS_PROJ = 512 * MiB;
constexpr size_t PROJ_T = (size_t)M * MIXW;
constexpr size_t WS_R = 592 * MiB;
constexpr size_t R_PLANE = (size_t)M * D;
constexpr size_t WS_Y = 720 * MiB;
constexpr size_t WS_MRG = 752 * MiB;
constexpr size_t WS_Q = 784 * MiB;
constexpr size_t WS_END = 816 * MiB;

constexpr int RING_BYTES = 131072;
constexpr int LDS_BYTES = 147456;

typedef unsigned short bf16;
typedef unsigned v4u __attribute__((ext_vector_type(4)));
typedef unsigned v2u __attribute__((ext_vector_type(2)));
typedef float f32x4 __attribute__((ext_vector_type(4)));
typedef float f32x2 __attribute__((ext_vector_type(2)));
using bf16x2 = __attribute__((ext_vector_type(2))) __bf16;
#define LAS __attribute__((address_space(3)))

__device__ __forceinline__ unsigned f2bf(float f) { unsigned u = __builtin_bit_cast(unsigned, f); return (u + 0x7fffu + ((u >> 16) & 1u)) >> 16; }
__device__ __forceinline__ unsigned pk2(float lo, float hi) { return f2bf(lo) | (f2bf(hi) << 16); }
__device__ __forceinline__ float bflo(unsigned w) { return __builtin_bit_cast(float, w << 16); }
__device__ __forceinline__ float bfhi(unsigned w) { return __builtin_bit_cast(float, w & 0xffff0000u); }
__device__ __forceinline__ float bf2f(bf16 b) { return __builtin_bit_cast(float, ((unsigned)b) << 16); }
__device__ __forceinline__ float shf(float v, int src) { return __builtin_bit_cast(float, __builtin_amdgcn_ds_bpermute(src << 2, __builtin_bit_cast(int, v))); }
__device__ __forceinline__ int shi(int v, int src) { return __builtin_amdgcn_ds_bpermute(src << 2, v); }
__device__ __forceinline__ float wave_sum(float v, int lane) {
#pragma unroll
    for (int o = 1; o < 64; o <<= 1) v += shf(v, lane ^ o);
    return v;
}
__device__ __forceinline__ float wave_max(float v, int lane) {
#pragma unroll
    for (int o = 1; o < 64; o <<= 1) v = fmaxf(v, shf(v, lane ^ o));
    return v;
}
__device__ __forceinline__ float ssa_to_f(unsigned long long v) { return (float)((double)v * (1.0 / 4294967296.0)); }
__device__ __forceinline__ float dot2_bf16(unsigned w, unsigned x, float acc) { return __builtin_amdgcn_fdot2_f32_bf16(__builtin_bit_cast(bf16x2, w), __builtin_bit_cast(bf16x2, x), acc, false); }

#define LANE_ID(x) asm volatile("v_mbcnt_lo_u32_b32 %0, -1, 0\n\tv_mbcnt_hi_u32_b32 %0, -1, %0" : "=v"(x))
struct Args {
    const float *x, *norm_mix, *w_in, *b_in, *pool_w, *pool_scale, *conv_w, *rel_bias, *w_branch, *w_out, *norm_ffn, *peer_wq, *peer_keys, *peer_u, *peer_v, *norm_final;
    float* out; unsigned char* ws;
};
#define GAS __attribute__((address_space(1)))
#define CAS __attribute__((address_space(4)))
struct ArgsK {
    const GAS float *x, *norm_mix, *w_in, *b_in, *pool_w, *pool_scale, *conv_w, *rel_bias, *w_branch, *w_out, *norm_ffn, *peer_wq, *peer_keys, *peer_u, *peer_v, *norm_final;
    GAS float* out; GAS unsigned char* ws;
};
__device__ __forceinline__ Args load_args(const CAS ArgsK* k, size_t zoff) {
    Args a;
    a.x = (const float*)k->x; a.norm_mix = (const float*)k->norm_mix; a.w_in = (const float*)k->w_in; a.b_in = (const float*)k->b_in; a.pool_w = (const float*)k->pool_w;
    a.pool_scale = (const float*)k->pool_scale; a.conv_w = (const float*)k->conv_w; a.rel_bias = (const float*)k->rel_bias; a.w_branch = (const float*)k->w_branch;
    a.w_out = (const float*)k->w_out; a.norm_ffn = (const float*)k->norm_ffn; a.peer_wq = (const float*)k->peer_wq; a.peer_keys = (const float*)k->peer_keys;
    a.peer_u = (const float*)k->peer_u; a.peer_v = (const float*)k->peer_v; a.norm_final = (const float*)k->norm_final; a.out = (float*)k->out; a.ws = (unsigned char*)(k->ws + zoff);
    return a;
}

using pg8::f32x4; using pg8::Unit;
constexpr size_t WS_G = 896 * MiB;
constexpr size_t WS_SWH = 7 * MiB + 256 * 1024, WS_BIH = 7 * MiB + 384 * 1024;
constexpr size_t WS_RSA = 7 * MiB + 768 * 1024;
struct EpiProj {
    static constexpr bool PERM = true, HOOK = false, PRELOAD = true;
    struct Pre { pg8::u32x4 sw[2], bi[2]; float rs[2][4]; };
    unsigned char* wsb; const bf16* biash; const float* rsa; const bf16* swh;
    __device__ __forceinline__ void preload(Pre& p, const Unit& u, int wr, int wc, int fr, int fq) const {
        const int row0 = u.pm * 256 + wr * 64 + fr, bcol0 = u.pn * 256 + wc * 32 + 8 * fq;
#pragma unroll
        for (int bj = 0; bj < 2; ++bj) { p.sw[bj] = *(const pg8::u32x4*)(swh + bcol0 + bj * 128); p.bi[bj] = *(const pg8::u32x4*)(biash + bcol0 + bj * 128); }
#pragma unroll
        for (int ai = 0; ai < 2; ++ai)
#pragma unroll
            for (int m = 0; m < 4; ++m) p.rs[ai][m] = rsa[row0 + ai * 128 + m * 16];
    }
    static __device__ __forceinline__ unsigned g8(float z) { const float t = __builtin_amdgcn_rcpf(__builtin_amdgcn_exp2f(__builtin_fmaf(z, -1.4426950408889634f, -8.0f)) + 0.00390625f);
        return (unsigned)(__builtin_amdgcn_fmed3f(t, 1.0f, 255.0f) + 0.5f); }
    static __device__ __forceinline__ unsigned g8x4(const f32x4& v) { return g8(v[0]) | (g8(v[1]) << 8) | (g8(v[2]) << 16) | (g8(v[3]) << 24); }
    __device__ __forceinline__ void operator()(f32x4 (&acc)[2][2][4][2], const Unit& u, int wr, int wc, int fr, int fq, const Pre& p) const {
        const int cl0 = wc * 32 + 8 * fq;
#define ACCF(ai, bj, m, n) __builtin_convertvector(__builtin_bit_cast(pg8::i32x4, acc[ai][bj][m][n]), f32x4)
        const __amdgpu_buffer_rsrc_t rW = __builtin_amdgcn_make_buffer_rsrc((void*)wsb, 0, 0x7fffffff, 0x00020000);
        int sbase, ldb, voff;
        if (u.pn < 20) { sbase = (int)WS_PROJ + ((u.pn >> 1) * (int)PROJ_T + (u.pn & 1) * 256) * 2; ldb = MIXW * 2; voff = fr * ldb + cl0 * 2; }
        else { sbase = (int)WS_G + (u.pn - 20) * 256; ldb = 4 * D; voff = fr * ldb + wc * 64 + fq * 16; }
        sbase += (u.pm * 256 + wr * 64) * ldb;
#pragma unroll
        for (int bj = 0; bj < 2; ++bj) { const f32x4 w0 = {bflo(p.sw[bj].x), bfhi(p.sw[bj].x), bflo(p.sw[bj].y), bfhi(p.sw[bj].y)}, w1 = {bflo(p.sw[bj].z), bfhi(p.sw[bj].z), bflo(p.sw[bj].w), bfhi(p.sw[bj].w)};
            const f32x4 b0 = {bflo(p.bi[bj].x), bfhi(p.bi[bj].x), bflo(p.bi[bj].y), bfhi(p.bi[bj].y)}, b1 = {bflo(p.bi[bj].z), bfhi(p.bi[bj].z), bflo(p.bi[bj].w), bfhi(p.bi[bj].w)};
#pragma unroll
            for (int ai = 0; ai < 2; ++ai)
#pragma unroll
                for (int m = 0; m < 4; ++m) { const float rs = p.rs[ai][m]; const f32x4 v0 = ACCF(ai, bj, m, 0) * rs * w0 + b0, v1 = ACCF(ai, bj, m, 1) * rs * w1 + b1;
                    if (u.pn >= 20) { v2u w; w.x = g8x4(v0); w.y = g8x4(v1);
                        __builtin_amdgcn_raw_buffer_store_b64(w, rW, voff + bj * 8, sbase + (ai * 128 + m * 16) * ldb, 0); }
                    else { pg8::u32x4 w; w.x = pg8::cvt_pk_bf16(v0[0], v0[1]); w.y = pg8::cvt_pk_bf16(v0[2], v0[3]); w.z = pg8::cvt_pk_bf16(v1[0], v1[1]); w.w = pg8::cvt_pk_bf16(v1[2], v1[3]);
                        __builtin_amdgcn_raw_buffer_store_b128(w, rW, voff + bj * 256, sbase + (ai * 128 + m * 16) * ldb, 0); } } }
    }
};
#undef ACCF
struct EpiMerge {
    static constexpr bool PERM = true, HOOK = true; static constexpr bool PRELOAD = false; struct Pre {};
    const unsigned char* G; bf16* O;
    struct Bt { pg8::u32x4 n[4], d[4]; };
    __device__ __forceinline__ void scale(f32x4 (&acc)[2][2][4][2], const Unit& u, int g, int wr, int wc, int fr, int fq) const {
        const __amdgpu_buffer_rsrc_t rs = __builtin_amdgcn_make_buffer_rsrc((void*)G, 0, 0x7fffffff, 0x00020000);
        int voff = fr * 4 * D + 16 * fq; asm volatile("" : "+v"(voff));
        const int sden = (u.pm * 256 + wr * 64) * 4 * D + (g - 1) * D + u.pn * 256 + wc * 64, snum = sden + D;
        const bool fin = g == 4;
#define UB(x, e) ((float)(((x) >> (8 * (e))) & 255u))
#define MG_LOAD(B, b0) do { _Pragma("unroll") for (int i = 0; i < 4; ++i) { const int ai_ = ((b0) + i) >> 2, m_ = ((b0) + i) & 3, so_ = (ai_ * 128 + m_ * 16) * 4 * D; \
            B.d[i] = __builtin_amdgcn_raw_buffer_load_b128(rs, voff, sden + so_, 0); if (!fin) B.n[i] = __builtin_amdgcn_raw_buffer_load_b128(rs, voff, snum + so_, 0); } } while (0)
#define MG_APPLY(B, b0) do { _Pragma("unroll") for (int i = 0; i < 4; ++i) { const int ai_ = ((b0) + i) >> 2, m_ = ((b0) + i) & 3; \
            _Pragma("unroll") for (int q = 0; q < 4; ++q) { const unsigned dq = B.d[i][q], nq = B.n[i][q]; \
                f32x4 r = {UB(dq, 0), UB(dq, 1), UB(dq, 2), UB(dq, 3)}; \
                if (!fin) r *= (f32x4){__builtin_amdgcn_rcpf(UB(nq, 0)), __builtin_amdgcn_rcpf(UB(nq, 1)), __builtin_amdgcn_rcpf(UB(nq, 2)), __builtin_amdgcn_rcpf(UB(nq, 3))}; else r *= 0.00390625f; \
                acc[ai_][q >> 1][m_][q & 1] *= r; asm volatile("" : "+v"(acc[ai_][q >> 1][m_][q & 1])); } } } while (0)
        Bt A = {}, B = {};
        MG_LOAD(A, 0); MG_LOAD(B, 4);
        MG_APPLY(A, 0); asm volatile("" ::: "memory");
        MG_APPLY(B, 4); asm volatile("" ::: "memory");
#undef MG_LOAD
#undef MG_APPLY
#undef UB
    }
    __device__ __forceinline__ void hook(f32x4 (&acc)[2][2][4][2], const Unit& u, int g, int wr, int wc, int fr, int fq) const { scale(acc, u, g, wr, wc, fr, fq); }
    __device__ __forceinline__ void operator()(f32x4 (&acc)[2][2][4][2], const Unit& u, int wr, int wc, int fr, int fq) const {
        scale(acc, u, 4, wr, wc, fr, fq);
        const int row0 = u.pm * 256 + wr * 64 + fr, col0 = u.pn * 256 + wc * 32 + 8 * fq;
#pragma unroll
        for (int ai = 0; ai < 2; ++ai)
#pragma unroll
            for (int m = 0; m < 4; ++m) { bf16* rowp = O + (size_t)(row0 + ai * 128 + m * 16) * D + col0;
#pragma unroll
                for (int bj = 0; bj < 2; ++bj) { const f32x4 v0 = acc[ai][bj][m][0], v1 = acc[ai][bj][m][1];
                    pg8::u32x4 w; w.x = pg8::cvt_pk_bf16(v0[0], v0[1]); w.y = pg8::cvt_pk_bf16(v0[2], v0[3]); w.z = pg8::cvt_pk_bf16(v1[0], v1[1]); w.w = pg8::cvt_pk_bf16(v1[2], v1[3]);
                    *(pg8::u32x4*)(rowp + bj * 128) = w; } }
    }
};
struct EpiRes {
    static constexpr bool PERM = true, HOOK = false; static constexpr bool PRELOAD = false; struct Pre {};
    const float* X; bf16* HB; unsigned long long* ssa;
    __device__ __forceinline__ void operator()(f32x4 (&acc)[2][2][4][2], const Unit& u, int wr, int wc, int fr, int fq) const {
        const int row0 = u.pm * 256 + wr * 64 + fr, col0 = u.pn * 256 + wc * 32 + 8 * fq;
#pragma unroll
        for (int ai = 0; ai < 2; ++ai)
#pragma unroll
            for (int m = 0; m < 4; ++m) { const int row = row0 + ai * 128 + m * 16; const size_t off = (size_t)row * D + col0; float s = 0.f;
#pragma unroll
                for (int bj = 0; bj < 2; ++bj) { const size_t o = off + bj * 128; f32x4 h0, h1;
                    if (X != nullptr) { h0 = *(const f32x4*)(X + o); h1 = *(const f32x4*)(X + o + 4); }
                    else { const pg8::u32x4 w = *(const pg8::u32x4*)(HB + o); h0 = (f32x4){bflo(w.x), bfhi(w.x), bflo(w.y), bfhi(w.y)}; h1 = (f32x4){bflo(w.z), bfhi(w.z), bflo(w.w), bfhi(w.w)}; }
                    h0 += acc[ai][bj][m][0]; h1 += acc[ai][bj][m][1];
                    pg8::u32x4 w; w.x = pg8::cvt_pk_bf16(h0[0], h0[1]); w.y = pg8::cvt_pk_bf16(h0[2], h0[3]); w.z = pg8::cvt_pk_bf16(h1[0], h1[1]); w.w = pg8::cvt_pk_bf16(h1[2], h1[3]);
                    *(pg8::u32x4*)(HB + o) = w;
                    s += ((h0[0] * h0[0] + h0[1] * h0[1]) + (h0[2] * h0[2] + h0[3] * h0[3])) + ((h1[0] * h1[0] + h1[1] * h1[1]) + (h1[2] * h1[2] + h1[3] * h1[3])); }
                { const int ln = fq * 16 + fr; s += shf(s, ln ^ 16); s += shf(s, ln ^ 32); }
                if (fq == 0) atomicAdd(ssa + row, (unsigned long long)((double)s * 4294967296.0)); }
    }
};
struct EpiQ {
    static constexpr bool PERM = true, HOOK = false; static constexpr bool PRELOAD = false; struct Pre {};
    bf16* O; const unsigned long long* ssa;
    __device__ __forceinline__ void operator()(f32x4 (&acc)[2][2][4][2], const Unit& u, int wr, int wc, int fr, int fq) const {
        const int row0 = u.pm * 256 + wr * 64 + fr, col0 = u.pn * 256 + wc * 32 + 8 * fq;
#pragma unroll
        for (int ai = 0; ai < 2; ++ai)
#pragma unroll
            for (int m = 0; m < 4; ++m) { const int row = row0 + ai * 128 + m * 16; const float rs = rsqrtf(ssa_to_f(ssa[row]) * (1.0f / D) + EPS);
                bf16* rowp = O + (size_t)row * D + col0;
#pragma unroll
                for (int bj = 0; bj < 2; ++bj) { const f32x4 v0 = acc[ai][bj][m][0] * rs, v1 = acc[ai][bj][m][1] * rs;
                    pg8::u32x4 w; w.x = pg8::cvt_pk_bf16(v0[0], v0[1]); w.y = pg8::cvt_pk_bf16(v0[2], v0[3]); w.z = pg8::cvt_pk_bf16(v1[0], v1[1]); w.w = pg8::cvt_pk_bf16(v1[2], v1[3]);
                    *(pg8::u32x4*)(rowp + bj * 128) = w; } }
    }
};

__device__ __forceinline__ int colmap_in(int j) { return j < 1536 ? j : j + 4; }
__device__ __forceinline__ void tr_item_i8(const float* W, const float* gain, const unsigned* cmax, unsigned char* WT, LAS float* scr, int k0, int n0, int lane) {
    const int q = lane & 7, r8 = lane >> 3, sc = colmap_in(n0 + 4 * q);
    f32x4 v[8];
#pragma unroll
    for (int i = 0; i < 8; ++i) v[i] = *(const f32x4*)(W + (size_t)(k0 + 8 * i + r8) * INW + sc);
    f32x4 inv;
#pragma unroll
    for (int e = 0; e < 4; ++e) { const float cm = __builtin_bit_cast(float, cmax[sc + e]); inv[e] = cm > 0.f ? 127.0f / cm : 0.f; }
#pragma unroll
    for (int i = 0; i < 8; ++i) { const float g = gain[k0 + 8 * i + r8];
#pragma unroll
        for (int e = 0; e < 4; ++e) scr[(8 * i + r8) * 33 + 4 * q + e] = v[i][e] * g * inv[e]; }
    asm volatile("s_waitcnt lgkmcnt(0)" ::: "memory");
    const int n = lane >> 1, hf = lane & 1;
    v4u o[2];
#pragma unroll
    for (int w = 0; w < 8; ++w) { unsigned pk = 0;
#pragma unroll
        for (int b = 0; b < 4; ++b) pk |= ((unsigned)((int)rintf(scr[(32 * hf + 4 * w + b) * 33 + n]) & 255)) << (8 * b);
        o[w >> 2][w & 3] = pk; }
    unsigned char* dst = WT + (size_t)(n0 + n) * D + k0 + 32 * hf;
    *(v4u*)dst = o[0]; *(v4u*)(dst + 16) = o[1];
    asm volatile("s_waitcnt lgkmcnt(0)" ::: "memory");
}
template <bool MAP>
__device__ __forceinline__ void tr_item(const float* W, int ldw, const float* scale, bf16* WT, int ldt, int dcol0, LAS float* scr, int k0, int n0, int lane) {
    const int q = lane & 7, r8 = lane >> 3, sc = MAP ? colmap_in(n0 + 4 * q) : (n0 + 4 * q);
    f32x4 v[8];
#pragma unroll
    for (int i = 0; i < 8; ++i) v[i] = *(const f32x4*)(W + (size_t)(k0 + 8 * i + r8) * ldw + sc);
    f32x4 s0 = {1.f, 1.f, 1.f, 1.f}, s1 = s0;
    if (scale) { s0 = *(const f32x4*)(scale + k0 + 8 * q); s1 = *(const f32x4*)(scale + k0 + 8 * q + 4); }
#pragma unroll
    for (int i = 0; i < 8; ++i)
#pragma unroll
        for (int e = 0; e < 4; ++e) scr[(8 * i + r8) * 33 + 4 * q + e] = v[i][e];
    asm volatile("s_waitcnt lgkmcnt(0)" ::: "memory");
    const int c = q;
#pragma unroll
    for (int j = 0; j < 4; ++j) { const int n = r8 + 8 * j; const LAS float* s = scr + (8 * c) * 33 + n;
        v4u o; o.x = pk2(s[0 * 33] * s0[0], s[1 * 33] * s0[1]); o.y = pk2(s[2 * 33] * s0[2], s[3 * 33] * s0[3]); o.z = pk2(s[4 * 33] * s1[0], s[5 * 33] * s1[1]); o.w = pk2(s[6 * 33] * s1[2], s[7 * 33] * s1[3]);
        *(v4u*)(WT + (size_t)(n0 + n) * ldt + dcol0 + k0 + 8 * c) = o; }
    asm volatile("s_waitcnt lgkmcnt(0)" ::: "memory");
}
constexpr size_t WS_BAR = 512 * 1024;
#define XB_TMO      128
#define XB_XCNT(j)  (256  + 64 * (j))
#define XB_XSUB(j)  (1280 + 64 * (j))
#define XB_XGEN(j)  (2304 + 64 * (j))
#define XB_TOP      3328
#define XB_TOPGEN   3392
#define XCD_BAR_WORDS 3456
#define XB_SPIN_CAP (1u << 23)
__device__ __forceinline__ unsigned xb_ld(unsigned* p)              { return __hip_atomic_load(p, __ATOMIC_RELAXED, __HIP_MEMORY_SCOPE_AGENT); }
__device__ __forceinline__ unsigned xb_add(unsigned* p, unsigned v) { return __hip_atomic_fetch_add(p, v, __ATOMIC_RELAXED, __HIP_MEMORY_SCOPE_AGENT); }
__device__ __forceinline__ unsigned xb_xcc_id() { return (unsigned)__builtin_amdgcn_s_getreg((3 << 11) | 20) & 0xFu; }
#define XB_SPIN(cond, bar) do { unsigned _sp = 0; while (cond) { __builtin_amdgcn_s_sleep(1); \
    if ((++_sp & 255u) == 0u) { if (xb_ld(&(bar)[XB_TMO])) break; if (_sp > XB_SPIN_CAP) { atomicAdd(&(bar)[XB_TMO], 1u); break; } } } } while (0)
__device__ __forceinline__ void xcd_barrier_complete(unsigned* bar, unsigned x, unsigned G, unsigned& nloc, unsigned& nx) {
    unsigned sum, cnt, mine, sp = 0u;
    for (;;) {
        sum = 0u; cnt = 0u; mine = 0u;
#pragma unroll
        for (unsigned j = 0; j < 16; ++j) { const unsigned c = xb_ld(&bar[XB_XCNT(j)]); sum += c; cnt += (c > 0u) ? 1u : 0u; mine = (j == x) ? c : mine; }
        if (sum == G) break;
        __builtin_amdgcn_s_sleep(1);
        if ((++sp & 255u) == 0u) { if (xb_ld(&bar[XB_TMO])) break; if (sp > XB_SPIN_CAP) { atomicAdd(&bar[XB_TMO], 1u); break; } }
    }
    nloc = mine > 0u ? mine : 1u; nx = cnt > 0u ? cnt : 1u;
}
__device__ __forceinline__ void xcd_barrier(unsigned* bar, unsigned x, unsigned G, volatile LAS unsigned* st, int wave) {
    asm volatile("s_waitcnt vmcnt(0)" ::: "memory");
    __syncthreads();
    int lane; asm volatile("v_mbcnt_lo_u32_b32 %0, -1, 0\n\tv_mbcnt_hi_u32_b32 %0, -1, %0" : "=v"(lane));
    if (wave == 0 && lane == 0) {
        __builtin_amdgcn_s_waitcnt(0);
        unsigned nloc = st[0], nx = st[1];
        if (nloc == 0u) { xcd_barrier_complete(bar, x, G, nloc, nx); st[0] = nloc; st[1] = nx; }
        const unsigned old = xb_add(&bar[XB_XSUB(x)], 1u);
        const unsigned gen = old / nloc;
        if (old + 1u == (gen + 1u) * nloc) {
            __builtin_amdgcn_fence(__ATOMIC_RELEASE, "agent");
            asm volatile("s_waitcnt vmcnt(0)" ::: "memory");
            const unsigned og = xb_add(&bar[XB_TOP], 1u);
            const unsigned tg = og / nx;
            if (og + 1u == (tg + 1u) * nx) xb_add(&bar[XB_TOPGEN], 1u);
            else XB_SPIN(xb_ld(&bar[XB_TOPGEN]) == tg, bar);
            __builtin_amdgcn_fence(__ATOMIC_ACQUIRE, "agent");
            xb_add(&bar[XB_XGEN(x)], 1u);
            asm volatile("s_waitcnt vmcnt(0)" ::: "memory");
        } else {
            XB_SPIN(xb_ld(&bar[XB_XGEN(x)]) == gen, bar);
            __builtin_amdgcn_fence(__ATOMIC_ACQUIRE, "agent");
            asm volatile("s_waitcnt vmcnt(0)" ::: "memory");
        }
    }
    __syncthreads();
}
namespace att {
constexpr int D = 128, NW = 8, QBLK = 32, KVBLK = 64, QB = NW * QBLK;
constexpr int PITCH = 512, OPITCH = 2048;
constexpr float SCALE = 0.08838834764831845f, THR = 8.f;
constexpr int SHM_V = KVBLK * D * 2, SHM_K = KVBLK * D * 2;
constexpr int OFF_WS = 2 * SHM_V + 2 * SHM_K, OFF_CUM = OFF_WS + NW * 64 * 4, OFF_REL = OFF_CUM + 2048 * 4, LDS_END = OFF_REL + 320 * 4;
typedef unsigned short bf16;
typedef short bf16x8 __attribute__((ext_vector_type(8)));
typedef short s16x4 __attribute__((ext_vector_type(4)));
typedef float f32x16 __attribute__((ext_vector_type(16)));
typedef float f32x4 __attribute__((ext_vector_type(4)));
typedef unsigned u32x4 __attribute__((ext_vector_type(4)));
#define ALDS __attribute__((address_space(3)))

#define KSWZ(row, colB) ((row) * 256 + ((colB) ^ (((row) & 7) << 4)))
#define SBAR() __builtin_amdgcn_sched_barrier(0)
__device__ __forceinline__ int v_st(int k, int c) { const int kk = (k & ~0xC) | ((k & 4) << 1) | ((k & 8) >> 1); return ((kk >> 3) * 4 + (c >> 5)) * 512 + ((kk & 7) * 32 + (c & 31)) * 2; }
__device__ __forceinline__ int v_rd_base(int lane) { return ((lane & 3) << 3) | (((lane >> 2) & 3) << 6) | (((lane >> 4) & 1) << 5) | (((lane >> 5) & 1) << 8); }
constexpr int v_rd_off(int d0, int ks, int half) { return d0 * 512 + ks * 4096 + half * 2048; }
__device__ __forceinline__ int crow(int r, int hi) { return (r & 3) + 8 * (r >> 2) + 4 * hi; }
__device__ __forceinline__ unsigned cvtpk(float lo, float hi) { unsigned r; asm volatile("v_cvt_pk_bf16_f32 %0, %1, %2" : "=v"(r) : "v"(lo), "v"(hi)); return r; }
__device__ __forceinline__ bf16x8 load8(const bf16* p) { return *reinterpret_cast<const bf16x8*>(p); }

__device__ __forceinline__ void mask_tile(f32x16& p0, f32x16& p1, int dq) {
    const float NEG = -__builtin_inff();
#pragma unroll
    for (int r = 0; r < 16; ++r) { const int c = (r & 3) + 8 * (r >> 2);
        if (dq - c < 0) p0[r] = NEG;
        if (dq - c - 32 < 0) p1[r] = NEG; }
}
__device__ __forceinline__ void partialSM(f32x16& p0, f32x16& p1, float& m_reg, float& mn, float& alpha) {
    float pmax = p0[0];
#pragma unroll
    for (int r = 1; r < 16; ++r) pmax = fmaxf(pmax, p0[r]);
#pragma unroll
    for (int r = 0; r < 16; ++r) pmax = fmaxf(pmax, p1[r]);
    { auto rr = __builtin_amdgcn_permlane32_swap(__float_as_uint(pmax), __float_as_uint(pmax), false, false);
      pmax = fmaxf(__uint_as_float(rr[0]), __uint_as_float(rr[1])); }
    constexpr float C2 = 1.4426950408889634f * SCALE;
    if (__builtin_expect(__all((pmax - m_reg) * SCALE <= THR), 1)) { mn = m_reg; alpha = 1.f; }
    else { mn = fmaxf(m_reg, pmax); alpha = __builtin_amdgcn_exp2f((m_reg - mn) * C2); m_reg = mn; }
    const float mnL = -mn * C2;
#pragma unroll
    for (int r = 0; r < 16; ++r) p0[r] = fmaf(p0[r], C2, mnL);
#pragma unroll
    for (int r = 0; r < 16; ++r) p1[r] = fmaf(p1[r], C2, mnL);
#pragma unroll
    for (int r = 0; r < 16; ++r) p0[r] = __builtin_amdgcn_exp2f(p0[r]);
}
__device__ __forceinline__ void finishSM(f32x16& p0, f32x16& p1, float alpha, float& l_reg, bf16x8& pa0, bf16x8& pa1, bf16x8& pa2, bf16x8& pa3) {
#pragma unroll
    for (int r = 0; r < 16; ++r) p1[r] = __builtin_amdgcn_exp2f(p1[r]);
    float ps = 0;
#pragma unroll
    for (int r = 0; r < 16; ++r) ps += p0[r];
#pragma unroll
    for (int r = 0; r < 16; ++r) ps += p1[r];
    { auto rr = __builtin_amdgcn_permlane32_swap(__float_as_uint(ps), __float_as_uint(ps), false, false);
      ps = __uint_as_float(rr[0]) + __uint_as_float(rr[1]); }
    l_reg = l_reg * alpha + ps;
#define PK4(P, B_, OUT) do { unsigned a0 = cvtpk(P[B_+0], P[B_+1]), a1 = cvtpk(P[B_+2], P[B_+3]);                          \
        unsigned b0 = cvtpk(P[B_+4], P[B_+5]), b1 = cvtpk(P[B_+6], P[B_+7]);                                             \
        auto r0 = __builtin_amdgcn_permlane32_swap(a0, b0, false, false); auto r1 = __builtin_amdgcn_permlane32_swap(a1, b1, false, false); \
        u32x4 w = {r0[0], r1[0], r0[1], r1[1]}; OUT = *reinterpret_cast<bf16x8*>(&w); } while (0)
    PK4(p0, 0, pa0); PK4(p0, 8, pa1); PK4(p1, 0, pa2); PK4(p1, 8, pa3);
#undef PK4
}
template <int KB>
__device__ __forceinline__ void qkt(f32x16& p0, f32x16& p1, const ALDS char* K_lds, int r32, int hi, const bf16x8* qr, bool act) {
    if (!act) { const float NEG = -__builtin_inff();
#pragma unroll
        for (int r = 0; r < 16; ++r) { p0[r] = NEG; p1[r] = NEG; } return; }
    p0 = f32x16{}; p1 = f32x16{};
    const ALDS char* kb[4];
#pragma unroll
    for (int dd = 0; dd < 4; ++dd) kb[dd] = K_lds + KB * SHM_K + KSWZ(r32, (dd * 16 + hi * 8) * 2);
#pragma unroll
    for (int d0 = 0; d0 < 8; ++d0) { const ALDS char* a = kb[d0 & 3] + (d0 >> 2) * 128;
        bf16x8 b0 = *(const ALDS bf16x8*)(a);
        bf16x8 b1 = *(const ALDS bf16x8*)(a + 32 * 256);
        p0 = __builtin_amdgcn_mfma_f32_32x32x16_bf16(b0, qr[d0], p0, 0, 0, 0);
        p1 = __builtin_amdgcn_mfma_f32_32x32x16_bf16(b1, qr[d0], p1, 0, 0, 0); }
}
template <int VB>
__device__ __forceinline__ void pv_tile(f32x16* o, int vb0, bf16x8 pa0, bf16x8 pa1, bf16x8 pa2, bf16x8 pa3, bool act) {
    if (!act) return;
#define TRRD(dst, off) asm volatile("ds_read_b64_tr_b16 %0, %1 offset:%2" : "=&v"(dst) : "v"(vb0), "i"(off) : "memory")
#define PV_D0(d0) do { s16x4 l0, l1, l2, l3, h0, h1, h2, h3; constexpr int b_ = VB * SHM_V + v_rd_off(d0, 0, 0); \
        TRRD(l0, b_); TRRD(h0, b_ + 2048); TRRD(l1, b_ + 4096); TRRD(h1, b_ + 6144); TRRD(l2, b_ + 8192); TRRD(h2, b_ + 10240); TRRD(l3, b_ + 12288); TRRD(h3, b_ + 14336); \
        asm volatile("s_waitcnt lgkmcnt(0)" ::: "memory"); SBAR(); \
        o[d0] = __builtin_amdgcn_mfma_f32_32x32x16_bf16(pa0, (bf16x8){l0[0], l0[1], l0[2], l0[3], h0[0], h0[1], h0[2], h0[3]}, o[d0], 0, 0, 0);   \
        o[d0] = __builtin_amdgcn_mfma_f32_32x32x16_bf16(pa1, (bf16x8){l1[0], l1[1], l1[2], l1[3], h1[0], h1[1], h1[2], h1[3]}, o[d0], 0, 0, 0);   \
        o[d0] = __builtin_amdgcn_mfma_f32_32x32x16_bf16(pa2, (bf16x8){l2[0], l2[1], l2[2], l2[3], h2[0], h2[1], h2[2], h2[3]}, o[d0], 0, 0, 0);   \
        o[d0] = __builtin_amdgcn_mfma_f32_32x32x16_bf16(pa3, (bf16x8){l3[0], l3[1], l3[2], l3[3], h3[0], h3[1], h3[2], h3[3]}, o[d0], 0, 0, 0); } while (0)
    PV_D0(0); PV_D0(1); PV_D0(2); PV_D0(3);
#undef PV_D0
#undef TRRD
}
template <int MODE>
__device__ __forceinline__ void bias_mask(f32x16& p0, f32x16& p1, const ALDS char* lds, int kb, int qlo, int qpos, int hi, float cqs, bool act) {
    if (!act) return;
    if (MODE == 0) {
        const ALDS float* cs = (const ALDS float*)(lds + OFF_CUM) + kb + 4 * hi;
#pragma unroll
        for (int g = 0; g < 4; ++g) { const f32x4 c0 = *(const ALDS f32x4*)(cs + 8 * g), c1 = *(const ALDS f32x4*)(cs + 32 + 8 * g);
#pragma unroll
            for (int e = 0; e < 4; ++e) { p0[4 * g + e] += cqs - c0[e]; p1[4 * g + e] += cqs - c1[e]; } }
        if (kb + KVBLK - 1 > qlo) mask_tile(p0, p1, qpos - 4 * hi - kb);
    } else {
        const ALDS float* tb = (const ALDS float*)(lds + OFF_REL);
        if (qlo - (kb + KVBLK - 1) >= 256) { const float c = tb[319];
#pragma unroll
            for (int r = 0; r < 16; ++r) { p0[r] += c; p1[r] += c; } }
        else { const int d0 = qpos - kb - 4 * hi + 63;
#pragma unroll
            for (int r = 0; r < 16; ++r) { const int c = (r & 3) + 8 * (r >> 2);
                int i0 = d0 - c, i1 = d0 - c - 32; i0 = i0 > 319 ? 319 : i0; i1 = i1 > 319 ? 319 : i1; i1 = i1 < 0 ? 0 : i1; i0 = i0 < 0 ? 0 : i0;
                p0[r] += tb[i0]; p1[r] += tb[i1]; } }
    }
}

struct Seam { bf16x8 qr[8]; bf16x8 st_v0, st_v1, st_k0, st_k1; };
#define VMW() asm volatile("s_waitcnt vmcnt(0)" ::: "memory")
#define BL8(rs, vo, so) __builtin_bit_cast(bf16x8, __builtin_amdgcn_raw_buffer_load_b128(rs, vo, so, 0))
#define SLOAD_H(Kp, Vp, k0) do { S.st_v0 = BL8(rP, kvoff, (Vp) + (k0) * (PITCH * 2)); S.st_v1 = BL8(rP, kvoff, (Vp) + ((k0) + 32) * (PITCH * 2));              \
                         S.st_k0 = BL8(rP, kvoff, (Kp) + (k0) * (PITCH * 2)); S.st_k1 = BL8(rP, kvoff, (Kp) + ((k0) + 32) * (PITCH * 2)); } while (0)
#define SWRITE_HK(bf) do { *(ALDS bf16x8*)(K_lds + (bf) * SHM_K + kws) = S.st_k0; *(ALDS bf16x8*)(K_lds + (bf) * SHM_K + kws + 32 * 256) = S.st_k1; } while (0)
#define SWRITE_HV(bf) do { *(ALDS bf16x8*)(V_lds + (bf) * SHM_V + vst0) = S.st_v0; *(ALDS bf16x8*)(V_lds + (bf) * SHM_V + vst1) = S.st_v1; } while (0)
#define SWRITE_H(bf) do { SWRITE_HV(bf); SWRITE_HK(bf); } while (0)

template <int MODE>
__device__ __forceinline__ void attn_unit(const bf16* Pb, int Qo, int Kh, int Vh, bf16* Yb, int Oo, int P0, int j_lo, int j_hi, ALDS char* lds, int wid, int lane) {
    const int tid = wid * 64 + lane, r32 = lane & 31, hi = lane >> 5;
    const int NT = j_hi - j_lo;
    const int qlo = P0 + wid * QBLK, qpos = qlo + r32;
    ALDS char* V_lds = lds; ALDS char* K_lds = lds + 2 * SHM_V;
    ALDS float* ws = (ALDS float*)(lds + OFF_WS) + wid * 64; ALDS float* li_l = ws; ALDS float* al_l = ws + 32;
    float m_reg = -1e30f, l_reg = 0; f32x16 o[4] = {};
    const int sr = tid >> 4, sc = (tid & 15) * 8, vst0 = v_st(sr, sc), vst1 = v_st(32 + sr, sc), kws = KSWZ(sr, sc * 2);
    const int vb0 = (int)(unsigned)(size_t)V_lds + v_rd_base(lane);
    Seam S;
    const __amdgpu_buffer_rsrc_t rP = __builtin_amdgcn_make_buffer_rsrc((void*)Pb, 0, 0x7fffffff, 0x00020000);
    const __amdgpu_buffer_rsrc_t rO = __builtin_amdgcn_make_buffer_rsrc((void*)Yb, 0, 0x7fffffff, 0x00020000);
    const int kvoff = (sr * PITCH + sc) * 2;
#define KBASE(t) ((j_lo + (t)) * KVBLK)
#define ACT(t) (MODE == 0 ? (KBASE(t) <= qlo + QBLK - 1) : ((j_lo + (t)) <= (qlo >> 6) && (j_lo + (t)) + 8 >= (qlo >> 6)))
#define RESC(a) do { if (__any((a) < 1.f)) { if (hi == 0) al_l[r32] = (a); asm volatile("s_waitcnt lgkmcnt(0)" ::: "memory");              \
                     for (int d_ = 0; d_ < 4; ++d_) for (int r = 0; r < 16; ++r) o[d_][r] *= al_l[crow(r, hi)]; } } while (0)
#define MASKT(P0_, P1_, t) bias_mask<MODE>(P0_, P1_, lds, KBASE(t), qlo, qpos, hi, cq_, ACT(t))
    {
        const int kb0 = j_lo * KVBLK;
#pragma unroll
        for (int d0 = 0; d0 < 8; ++d0) S.qr[d0] = BL8(rP, (r32 * PITCH + hi * 8) * 2 + d0 * 32, Qo + wid * (QBLK * PITCH * 2));
        SLOAD_H(Kh, Vh, kb0); VMW(); SWRITE_HK(0);
        __syncthreads();
    }
    const float cq_ = MODE == 0 ? ((const ALDS float*)(lds + OFF_CUM))[qpos] : 0.f;
    f32x16 pA0, pA1, pB0, pB1; float mnA, mnB, alA, alB; bf16x8 pa0, pa1, pa2, pa3;
    SWRITE_HV(0); SBAR();
    if (NT > 1) { SLOAD_H(Kh, Vh, KBASE(1)); }
    SBAR(); qkt<0>(pA0, pA1, K_lds, r32, hi, S.qr, ACT(0));
    MASKT(pA0, pA1, 0); partialSM(pA0, pA1, m_reg, mnA, alA);
    if (NT > 1) { VMW(); SWRITE_H(1); }
    __syncthreads();
#define HALF_STEP(PX0, PX1, mnX, alX, PY0, PY1, alY, t, KB, VB, SB) do {                                                      \
        SBAR(); qkt<KB>(PX0, PX1, K_lds, r32, hi, S.qr, ACT(t));                                                              \
        finishSM(PY0, PY1, alY, l_reg, pa0, pa1, pa2, pa3); SBAR();                                                           \
        if ((t) + 1 < NT) { SLOAD_H(Kh, Vh, KBASE((t) + 1)); SBAR(); }                                                        \
        pv_tile<VB>(o, vb0, pa0, pa1, pa2, pa3, ACT((t) - 1)); MASKT(PX0, PX1, (t)); partialSM(PX0, PX1, m_reg, mnX, alX);    \
        __syncthreads();                                                                                                      \
        if ((t) + 1 < NT) { VMW(); SWRITE_H(SB); }                                                                            \
        RESC(alX); __syncthreads(); } while (0)
    for (int t = 1; t + 1 < NT; t += 2) {
        HALF_STEP(pB0, pB1, mnB, alB, pA0, pA1, alA, t, 1, 0, 0);
        HALF_STEP(pA0, pA1, mnA, alA, pB0, pB1, alB, t + 1, 0, 1, 1);
    }
    const bool even = (NT & 1) == 0;
    if (even) { SBAR(); qkt<1>(pB0, pB1, K_lds, r32, hi, S.qr, ACT(NT - 1)); SBAR(); }
    finishSM(pA0, pA1, alA, l_reg, pa0, pa1, pa2, pa3); SBAR();
    pv_tile<0>(o, vb0, pa0, pa1, pa2, pa3, ACT(even ? NT - 2 : NT - 1));
    if (even) { MASKT(pB0, pB1, NT - 1); partialSM(pB0, pB1, m_reg, mnB, alB); __syncthreads(); RESC(alB);
        finishSM(pB0, pB1, alB, l_reg, pa0, pa1, pa2, pa3); SBAR(); pv_tile<1>(o, vb0, pa0, pa1, pa2, pa3, ACT(NT - 1)); }
    SBAR();
    if (hi == 0) li_l[r32] = l_reg; asm volatile("s_waitcnt lgkmcnt(0)" ::: "memory");
    float rli[16];
#pragma unroll
    for (int r = 0; r < 16; ++r) rli[r] = __builtin_amdgcn_rcpf(li_l[crow(r, hi)]);
    const int ovoff = (4 * hi * OPITCH + r32) * 2, osoff = Oo + wid * (QBLK * OPITCH * 2);
#pragma unroll
    for (int r = 0; r < 16; ++r) { const int orow = (r & 3) + 8 * (r >> 2);
#pragma unroll
        for (int d0 = 0; d0 < 4; ++d0) { const float v = o[d0][r] * rli[r];
            const float vn = __builtin_bit_cast(float, __builtin_amdgcn_ds_bpermute((lane ^ 1) << 2, __builtin_bit_cast(int, v)));
            if ((r32 & 1) == 0) __builtin_amdgcn_raw_buffer_store_b32(cvtpk(v, vn), rO, ovoff + d0 * 64, osoff + orow * (OPITCH * 2), 0); } }
    __syncthreads();
#undef RESC
#undef KBASE
#undef ACT
#undef MASKT
#undef HALF_STEP
}
#undef BL8
#undef VMW
#undef SLOAD_H
#undef SWRITE_HK
#undef SWRITE_HV
#undef SWRITE_H
#undef KSWZ
#undef SBAR
}
constexpr size_t WS_QCTR = 768 * 1024;
constexpr size_t WS_POOLW = 4 * MiB;
constexpr int N_ATT_UNITS = 256, N_POOL_UNITS = 512, N_CONV_UNITS = 128;

__device__ __forceinline__ void stage_cum(const Args& a, int b, int h, LAS char* lds, int wave, int lane) {
    const float* logf = (const float*)(a.ws + WS_LOGF) + ((size_t)b * SEQ) * 4 + h;
    const int tid = wave * 64 + lane;
    float v[4];
#pragma unroll
    for (int e = 0; e < 4; ++e) v[e] = logf[(size_t)(4 * tid + e) * 4];
    v[1] += v[0]; v[2] += v[1]; v[3] += v[2];
    float incl = v[3];
#pragma unroll
    for (int o = 1; o < 64; o <<= 1) { const float t = shf(incl, lane >= o ? lane - o : lane); if (lane >= o) incl += t; }
    LAS float* wt = (LAS float*)(lds + att::OFF_WS);
    if (lane == 63) wt[wave] = incl;
    __syncthreads();
    float base = incl - v[3];
    for (int w = 0; w < wave; ++w) base += wt[w];
    LAS float* cs = (LAS float*)(lds + att::OFF_CUM);
    const float inv = 1.0f / ATT_SCALE;
    *(LAS f32x4*)(cs + 4 * tid) = (f32x4){(base + v[0]) * inv, (base + v[1]) * inv, (base + v[2]) * inv, (base + v[3]) * inv};
    __syncthreads();
}
__device__ __forceinline__ void attention_item(const Args& a, int l, int u, LAS char* lds, int wave) {
    int lane; asm volatile("v_mbcnt_lo_u32_b32 %0, -1, 0\n\tv_mbcnt_hi_u32_b32 %0, -1, %0" : "=v"(lane));
    const bf16* P = (const bf16*)(a.ws + WS_PROJ); bf16* Y = (bf16*)(a.ws + WS_Y);
    const int mode = u >> 7, v = u & 127, qb = 7 - (v >> 4), bh = v & 15, b = bh >> 2, h = bh & 3;
    const size_t row0 = (size_t)b * SEQ; const int P0 = qb * 256;
    if (mode == 0) {
        stage_cum(a, b, h, lds, wave, lane);
        att::attn_unit<0>(P, (int)((0 * PROJ_T + (row0 + P0) * MIXW + h * HD) * 2), (int)((1 * PROJ_T + row0 * MIXW + h * HD) * 2), (int)((2 * PROJ_T + row0 * MIXW + h * HD) * 2),
                          Y, (int)(((row0 + P0) * D + h * HD) * 2), P0, 0, 4 * qb + 4, lds, wave, lane);
    } else {
        const int tid = wave * 64 + lane;
        if (tid < 320) ((LAS float*)(lds + att::OFF_REL))[tid] = a.rel_bias[((size_t)l * 4 + h) * 320 + tid] * (1.0f / ATT_SCALE);
        const int jlo = 4 * qb - 8 < 0 ? 0 : 4 * qb - 8;
        att::attn_unit<1>(P, (int)((7 * PROJ_T + (row0 + P0) * MIXW + h * HD) * 2), (int)((8 * PROJ_T + row0 * MIXW + h * HD) * 2), (int)((9 * PROJ_T + row0 * MIXW + h * HD) * 2),
                          Y, (int)(((row0 + P0) * D + 1536 + h * HD) * 2), P0, jlo, 4 * qb + 4, lds, wave, lane);
    }
}
__device__ __forceinline__ void pool_item(const Args& a, int l, int u, LAS char* lds, int wave) {
    int lane; asm volatile("v_mbcnt_lo_u32_b32 %0, -1, 0\n\tv_mbcnt_hi_u32_b32 %0, -1, %0" : "=v"(lane));
    const int g = u & 3, T0 = (u >> 2) * 64, tid = wave * 64 + lane;
    const bf16* Pin = (const bf16*)(a.ws + WS_PROJ) + 3 * PROJ_T + g * 128;
    {
        const int cp = tid & 63, run = tid >> 6, w = 2 << g, t0 = T0 + run * 8, s0 = t0 & (SEQ - 1);
        const bf16* col = Pin + 2 * cp;
        float s_lo = 0.f, s_hi = 0.f;
        for (int j = 1; j < w; ++j) if (s0 - j >= 0) { const unsigned x = *(const unsigned*)(col + (size_t)(t0 - j) * MIXW); s_lo += bflo(x); s_hi += bfhi(x); }
#pragma unroll
        for (int i = 0; i < 8; ++i) { const unsigned x = *(const unsigned*)(col + (size_t)(t0 + i) * MIXW); s_lo += bflo(x); s_hi += bfhi(x);
            const int s = s0 + i; const int cnt = s + 1 < w ? s + 1 : w; const float inv = 1.0f / (float)cnt;
            *(LAS unsigned*)(lds + (run * 8 + i) * 272 + 4 * cp) = pk2(s_lo * inv - bflo(x), s_hi * inv - bfhi(x));
            if (s - w + 1 >= 0) { const unsigned y = *(const unsigned*)(col + (size_t)(t0 + i - w + 1) * MIXW); s_lo -= bflo(y); s_hi -= bfhi(y); } }
    }
    __syncthreads();
    {
        typedef short bf16x8 __attribute__((ext_vector_type(8)));
        const bf16* Wt = (const bf16*)(a.ws + WS_POOLW) + ((size_t)l * 4 + g) * 128 * 128;
        const int rt = (wave & 3) * 16, db = (wave >> 2) * 64, fr = lane & 15, kg = lane >> 4;
        f32x4 acc[4] = {};
#pragma unroll
        for (int ks = 0; ks < 4; ++ks) { const bf16x8 af = *(const LAS bf16x8*)(lds + (rt + fr) * 272 + (ks * 32 + kg * 8) * 2);
#pragma unroll
            for (int nt = 0; nt < 4; ++nt) { const bf16x8 bfr = *(const bf16x8*)(Wt + (size_t)(db + nt * 16 + fr) * 128 + ks * 32 + kg * 8);
                acc[nt] = __builtin_amdgcn_mfma_f32_16x16x32_bf16(bfr, af, acc[nt], 0, 0, 0); } }
        bf16* Y = (bf16*)(a.ws + WS_Y) + (size_t)(T0 + rt + fr) * D + 512 + g * 128;
#pragma unroll
        for (int nt = 0; nt < 4; ++nt) { const int d = db + nt * 16 + kg * 4; const f32x4 sc = *(const f32x4*)(a.pool_scale + l * MIXW + g * 128 + d);
            v2u w; w.x = pk2(acc[nt][0] * sc[0], acc[nt][1] * sc[1]); w.y = pk2(acc[nt][2] * sc[2], acc[nt][3] * sc[3]); *(v2u*)(Y + d) = w; }
    }
    __syncthreads();
}
__device__ __forceinline__ void conv_item(const Args& a, int l, int u, int wave) {
    int lane; asm volatile("v_mbcnt_lo_u32_b32 %0, -1, 0\n\tv_mbcnt_hi_u32_b32 %0, -1, %0" : "=v"(lane));
    const bf16* P = (const bf16*)(a.ws + WS_PROJ); const bf16* Ch = P + 4 * PROJ_T; const bf16* Cb = P + 5 * PROJ_T; const bf16* Cc = P + 6 * PROJ_T;
    const int tid = wave * 64 + lane, c0 = (tid & 63) * 8, t0 = u * 64 + (tid >> 6) * 8, s0 = t0 & (SEQ - 1);
    float wgt[3][8];
#pragma unroll
    for (int j = 0; j < 3; ++j) { const float* w = a.conv_w + ((size_t)l * 3 + j) * MIXW + c0; const f32x4 w0 = *(const f32x4*)w, w1 = *(const f32x4*)(w + 4);
#pragma unroll
        for (int k = 0; k < 4; ++k) { wgt[j][k] = w0[k]; wgt[j][4 + k] = w1[k]; } }
    float z2[8], z1[8];
#pragma unroll
    for (int k = 0; k < 8; ++k) { z2[k] = 0.f; z1[k] = 0.f; }
#pragma unroll
    for (int i = -2; i < 8; ++i) {
        float z[8];
        if (s0 + i >= 0) { const v4u hv = *(const v4u*)(Ch + (size_t)(t0 + i) * MIXW + c0), cv = *(const v4u*)(Cc + (size_t)(t0 + i) * MIXW + c0);
            z[0] = bflo(hv.x) * bflo(cv.x); z[1] = bfhi(hv.x) * bfhi(cv.x); z[2] = bflo(hv.y) * bflo(cv.y); z[3] = bfhi(hv.y) * bfhi(cv.y);
            z[4] = bflo(hv.z) * bflo(cv.z); z[5] = bfhi(hv.z) * bfhi(cv.z); z[6] = bflo(hv.w) * bflo(cv.w); z[7] = bfhi(hv.w) * bfhi(cv.w); }
        else {
#pragma unroll
            for (int k = 0; k < 8; ++k) z[k] = 0.f; }
        if (i >= 0) { const v4u bv = *(const v4u*)(Cb + (size_t)(t0 + i) * MIXW + c0); float o[8];
            const float bb[8] = {bflo(bv.x), bfhi(bv.x), bflo(bv.y), bfhi(bv.y), bflo(bv.z), bfhi(bv.z), bflo(bv.w), bfhi(bv.w)};
#pragma unroll
            for (int k = 0; k < 8; ++k) o[k] = bb[k] * (wgt[0][k] * z2[k] + wgt[1][k] * z1[k] + wgt[2][k] * z[k]);
            v4u ov; ov.x = pk2(o[0], o[1]); ov.y = pk2(o[2], o[3]); ov.z = pk2(o[4], o[5]); ov.w = pk2(o[6], o[7]);
            *(v4u*)((bf16*)(a.ws + WS_Y) + (size_t)(t0 + i) * D + 1024 + c0) = ov; }
#pragma unroll
        for (int k = 0; k < 8; ++k) { z2[k] = z1[k]; z1[k] = z[k]; }
    }
}
__device__ __forceinline__ void mixers_fast(const Args& a, int lq, LAS char* lds, int wave, int lane, int G, int blk) {
    const int l = lq & 1;
    for (int u = blk; u < N_ATT_UNITS; u += G) attention_item(a, l, u, lds, wave);
    unsigned* head = (unsigned*)(a.ws + WS_QCTR) + 64 * lq;
    volatile LAS unsigned* slot = (volatile LAS unsigned*)(lds + att::LDS_END);
    for (;;) {
        if (wave == 0 && lane == 0) *slot = __hip_atomic_fetch_add(head, 1u, __ATOMIC_RELAXED, __HIP_MEMORY_SCOPE_AGENT);
        __syncthreads();
        const unsigned it = *slot;
        __syncthreads();
        if (it >= (unsigned)(N_POOL_UNITS + N_CONV_UNITS)) break;
        if (it < (unsigned)N_POOL_UNITS) pool_item(a, l, (int)it, lds, wave); else conv_item(a, l, (int)it - N_POOL_UNITS, wave);
    }
}
__device__ __forceinline__ void p0_cmax(const Args& a, int gw, int NGW, int lane) {
    unsigned char* ws = a.ws;
    {
        constexpr int NCC = (INW + 255) / 256;
        for (int it = gw; it < DEPTH * 32 * NCC; it += NGW) { const int l = it / (32 * NCC), r = it % (32 * NCC), kc = r / NCC, cc = r % NCC; const int c0 = cc * 256 + 4 * lane;
            if (c0 + 3 < INW) { const float* W = a.w_in + (size_t)l * D * INW + (size_t)(kc * 64) * INW + c0; const float* g = a.norm_mix + l * D + kc * 64;
                float m0 = 0.f, m1 = 0.f, m2 = 0.f, m3 = 0.f;
#pragma unroll 8
                for (int k = 0; k < 64; ++k) { const f32x4 w = *(const f32x4*)(W + (size_t)k * INW); const float gk = fabsf(g[k]);
                    m0 = fmaxf(m0, fabsf(w[0]) * gk); m1 = fmaxf(m1, fabsf(w[1]) * gk); m2 = fmaxf(m2, fabsf(w[2]) * gk); m3 = fmaxf(m3, fabsf(w[3]) * gk); }
                unsigned* cm = (unsigned*)(ws + WS_CMAX) + l * INW + c0;
                const unsigned u0 = __float_as_uint(m0), u1 = __float_as_uint(m1), u2 = __float_as_uint(m2), u3 = __float_as_uint(m3);
                __hip_atomic_fetch_max(cm + 0, u0, __ATOMIC_RELAXED, __HIP_MEMORY_SCOPE_AGENT); __hip_atomic_fetch_max(cm + 1, u1, __ATOMIC_RELAXED, __HIP_MEMORY_SCOPE_AGENT);
                __hip_atomic_fetch_max(cm + 2, u2, __ATOMIC_RELAXED, __HIP_MEMORY_SCOPE_AGENT); __hip_atomic_fetch_max(cm + 3, u3, __ATOMIC_RELAXED, __HIP_MEMORY_SCOPE_AGENT); } }
    }
}
__device__ __forceinline__ void p0_prologue(const Args& a, LAS unsigned char* lds, int gw, int NGW, int wave, int lane) {
    unsigned char* ws = a.ws;
    LAS float* scr = (LAS float*)(lds + wave * 16384);
    constexpr int I_SQ = (D / 64) * (D / 32), I_BR = (MIXW / 64) * (D / 32);
    constexpr int I_LAYER = 4 * I_BR + 2 * I_SQ;
    for (int it = gw; it < DEPTH * I_LAYER; it += NGW) {
        const int l = it / I_LAYER; int r = it - l * I_LAYER;
        if (r < 4 * I_BR) { const int g = r / I_BR, rr = r % I_BR, kb = rr / (D / 32), nb = rr % (D / 32);
            tr_item<false>(a.w_branch + ((size_t)l * 4 + g) * MIXW * D, D, nullptr, (bf16*)(ws + WS_WBR + l * SQ_BYTES), D, g * MIXW, scr, 64 * kb, 32 * nb, lane); continue; }
        r -= 4 * I_BR;
        if (r < I_SQ) { const int kb = r / (D / 32), nb = r % (D / 32);
            tr_item<false>(a.w_out + (size_t)l * D * D, D, nullptr, (bf16*)(ws + WS_WOUT + l * SQ_BYTES), D, 0, scr, 64 * kb, 32 * nb, lane); continue; }
        r -= I_SQ;
        { const int kb = r / (D / 32), nb = r % (D / 32);
            tr_item<false>(a.peer_wq + (size_t)l * D * D, D, a.norm_ffn + l * D, (bf16*)(ws + WS_WQ + l * SQ_BYTES), D, 0, scr, 64 * kb, 32 * nb, lane); }
    }
    for (int it = gw; it < DEPTH * 4 * 8; it += NGW) { const int lg = it >> 3, r = it & 7;
        tr_item<false>(a.pool_w + (size_t)lg * 128 * 128, 128, nullptr, (bf16*)(ws + WS_POOLW) + (size_t)lg * 128 * 128, 128, 0, scr, 64 * (r >> 2), 32 * (r & 3), lane); }
    {
        constexpr int NR = 2 * DEPTH * PEER_E;
        f32x4 nv[8];
        if (gw < NR) { const int t = gw / (DEPTH * PEER_E), row = gw - t * (DEPTH * PEER_E); const float* src = (t ? a.peer_v : a.peer_u) + (size_t)row * D + 4 * lane;
#pragma unroll
            for (int j = 0; j < 8; ++j) nv[j] = *(const f32x4*)(src + 256 * j); }
        for (int r = gw; r < NR; r += NGW) { const int t = r / (DEPTH * PEER_E), row = r - t * (DEPTH * PEER_E);
            f32x4 v[8]; float am = 0.f;
#pragma unroll
            for (int j = 0; j < 8; ++j) v[j] = nv[j];
            { const int r2 = r + NGW; if (r2 < NR) { const int t2 = r2 / (DEPTH * PEER_E), row2 = r2 - t2 * (DEPTH * PEER_E); const float* src = (t2 ? a.peer_v : a.peer_u) + (size_t)row2 * D + 4 * lane;
#pragma unroll
                for (int j = 0; j < 8; ++j) nv[j] = *(const f32x4*)(src + 256 * j); } }
#pragma unroll
            for (int j = 0; j < 8; ++j) am = fmaxf(am, fmaxf(fmaxf(fabsf(v[j][0]), fabsf(v[j][1])), fmaxf(fabsf(v[j][2]), fabsf(v[j][3]))));
            am = wave_max(am, lane);
            const float inv = am > 0.f ? 127.0f / am : 0.f, off = 0.f;
            unsigned char* dst = ws + (t ? WS_PV : WS_PU) + (size_t)row * D + 4 * lane;
#pragma unroll
            for (int j = 0; j < 8; ++j) { const int q0 = (int)(rintf(v[j][0] * inv) + off), q1 = (int)(rintf(v[j][1] * inv) + off), q2 = (int)(rintf(v[j][2] * inv) + off), q3 = (int)(rintf(v[j][3] * inv) + off);
                *(unsigned*)(dst + 256 * j) = (unsigned)(q0 & 255) | ((unsigned)(q1 & 255) << 8) | ((unsigned)(q2 & 255) << 16) | ((unsigned)(q3 & 255) << 24); }
            if (lane == 0) ((float*)(ws + (t ? WS_SV : WS_SU)))[row] = am * (1.0f / 127.0f); }
    }
    { bf16* pk = (bf16*)(ws + WS_PK); const size_t n8 = (size_t)DEPTH * 8 * 2 * 128 * 128 / 8;
      for (size_t i = (size_t)gw * 64 + lane; i < n8; i += (size_t)NGW * 64) { const f32x4 v0 = *(const f32x4*)(a.peer_keys + i * 8), v1 = *(const f32x4*)(a.peer_keys + i * 8 + 4);
          v4u o; o.x = pk2(v0[0], v0[1]); o.y = pk2(v0[2], v0[3]); o.z = pk2(v1[0], v1[1]); o.w = pk2(v1[2], v1[3]); *(v4u*)(pk + i * 8) = o; } }
    {
        float* wf = (float*)(ws + WS_WF); float* binr = (float*)(ws + WS_BINR);
        const int gt = gw * 64 + lane, NGT = NGW * 64;
        for (int i = gt; i < DEPTH * 4 * D; i += NGT) { const int l = i / (4 * D), h = (i / D) & 3, k = i % D; wf[i] = a.w_in[(size_t)l * D * INW + (size_t)k * INW + 1536 + h] * a.norm_mix[l * D + k]; }
        for (int i = gt; i < DEPTH * NPROJ; i += NGT) { const int l = i / NPROJ, j = i % NPROJ; binr[i] = a.b_in[l * INW + colmap_in(j)]; }
    }
    {
        unsigned long long* ssq = (unsigned long long*)(ws + WS_SSQ);
        for (int m = gw; m < M; m += NGW) { float s = 0.f, am = 0.f; f32x4 v[8];
#pragma unroll
            for (int j = 0; j < 8; ++j) { const size_t o = (size_t)m * D + j * 256 + lane * 4; v[j] = *(const f32x4*)(a.x + o); s += (v[j][0] * v[j][0] + v[j][1] * v[j][1]) + (v[j][2] * v[j][2] + v[j][3] * v[j][3]);
                am = fmaxf(am, fmaxf(fmaxf(fabsf(v[j][0]), fabsf(v[j][1])), fmaxf(fabsf(v[j][2]), fabsf(v[j][3])))); }
            s = wave_sum(s, lane); am = wave_max(am, lane); if (lane == 0) { ssq[m] = (unsigned long long)((double)s * 4294967296.0); ((float*)(ws + WS_RSA))[m] = rsqrtf(s * (1.0f / D) + EPS) * am * (1.0f / 127.0f); }
            const float inv = am > 0.f ? 127.0f / am : 0.f; unsigned char* q8 = ws + WS_HB8 + (size_t)m * D + 4 * lane;
#pragma unroll
            for (int j = 0; j < 8; ++j) *(unsigned*)(q8 + 256 * j) = ((unsigned)((int)rintf(v[j][0] * inv) & 255)) | ((unsigned)((int)rintf(v[j][1] * inv) & 255) << 8) | ((unsigned)((int)rintf(v[j][2] * inv) & 255) << 16) | ((unsigned)((int)rintf(v[j][3] * inv) & 255) << 24); }
    }
}
__device__ __forceinline__ void p0_win_i8(const Args& a, LAS unsigned char* lds, int gw, int NGW, int wave, int lane) {
    unsigned char* ws = a.ws; LAS float* scr = (LAS float*)(lds + wave * 16384);
    constexpr int I_WIN = (D / 64) * (NPROJ / 32);
    for (int it = gw; it < DEPTH * I_WIN; it += NGW) { const int l = it / I_WIN, r = it % I_WIN, kb = r / (NPROJ / 32), nb = r % (NPROJ / 32);
        tr_item_i8(a.w_in + (size_t)l * D * INW, a.norm_mix + l * D, (const unsigned*)(ws + WS_CMAX) + l * INW, ws + WS_WIN + l * WIN_BYTES, scr, 64 * kb, 32 * nb, lane); }
    float* sw = (float*)(ws + WS_SW); const int gt = gw * 64 + lane, NGT = NGW * 64;
    bf16* swh = (bf16*)(ws + WS_SWH); bf16* bih = (bf16*)(ws + WS_BIH);
    for (int i = gt; i < DEPTH * NPROJ; i += NGT) { const int l = i / NPROJ, j = i % NPROJ; const float s = __builtin_bit_cast(float, ((const unsigned*)(ws + WS_CMAX))[l * INW + colmap_in(j)]) * (1.0f / 127.0f);
        sw[i] = s; swh[i] = (bf16)f2bf(s); bih[i] = (bf16)f2bf(a.b_in[l * INW + colmap_in(j)]); }
}
__device__ __forceinline__ void quant_rows(const Args& a, int l, int gw, int NGW, int lane) {
    unsigned char* ws = a.ws; const bf16* HB = (const bf16*)(ws + WS_HB);
    for (int m = gw; m < M; m += NGW) { float am = 0.f; float v[4][8];
#pragma unroll
        for (int j = 0; j < 4; ++j) { const v4u w = *(const v4u*)(HB + (size_t)m * D + j * 512 + lane * 8);
            v[j][0] = bflo(w.x); v[j][1] = bfhi(w.x); v[j][2] = bflo(w.y); v[j][3] = bfhi(w.y); v[j][4] = bflo(w.z); v[j][5] = bfhi(w.z); v[j][6] = bflo(w.w); v[j][7] = bfhi(w.w);
#pragma unroll
            for (int e = 0; e < 8; ++e) am = fmaxf(am, fabsf(v[j][e])); }
        am = wave_max(am, lane); if (lane == 0) ((float*)(ws + WS_RSA))[m] = rsqrtf(ssa_to_f(((const unsigned long long*)(ws + WS_SSQ))[(size_t)l * M + m]) * (1.0f / D) + EPS) * am * (1.0f / 127.0f);
        const float inv = am > 0.f ? 127.0f / am : 0.f; unsigned char* q8 = ws + WS_HB8 + (size_t)m * D + 8 * lane;
#pragma unroll
        for (int j = 0; j < 4; ++j) { v2u o;
            o.x = ((unsigned)((int)rintf(v[j][0] * inv) & 255)) | ((unsigned)((int)rintf(v[j][1] * inv) & 255) << 8) | ((unsigned)((int)rintf(v[j][2] * inv) & 255) << 16) | ((unsigned)((int)rintf(v[j][3] * inv) & 255) << 24);
            o.y = ((unsigned)((int)rintf(v[j][4] * inv) & 255)) | ((unsigned)((int)rintf(v[j][5] * inv) & 255) << 8) | ((unsigned)((int)rintf(v[j][6] * inv) & 255) << 16) | ((unsigned)((int)rintf(v[j][7] * inv) & 255) << 24);
            *(v2u*)(q8 + 512 * j) = o; } }
}

__device__ __forceinline__ void forget_logits(const Args& a, int l, int gw, int NGW, int lane) {
    unsigned char* ws = a.ws; const bf16* HB = (const bf16*)(ws + WS_HB); const float* wf = (const float*)(ws + WS_WF) + l * 4 * D; const unsigned long long* ssq = (const unsigned long long*)(ws + WS_SSQ) + l * M;
    float* logf = (float*)(ws + WS_LOGF);
    for (int m = gw; m < M; m += NGW) {
        float d[4] = {0.f, 0.f, 0.f, 0.f};
#pragma unroll
        for (int j = 0; j < 4; ++j) { const int k0 = j * 512 + lane * 8; float x[8];
            if (l == 0) { const f32x4 x0 = *(const f32x4*)(a.x + (size_t)m * D + k0), x1 = *(const f32x4*)(a.x + (size_t)m * D + k0 + 4); x[0] = x0[0]; x[1] = x0[1]; x[2] = x0[2]; x[3] = x0[3]; x[4] = x1[0]; x[5] = x1[1]; x[6] = x1[2]; x[7] = x1[3]; }
            else { const v4u xv = *(const v4u*)(HB + (size_t)m * D + k0); x[0] = bflo(xv.x); x[1] = bfhi(xv.x); x[2] = bflo(xv.y); x[3] = bfhi(xv.y); x[4] = bflo(xv.z); x[5] = bfhi(xv.z); x[6] = bflo(xv.w); x[7] = bfhi(xv.w); }
#pragma unroll
            for (int h = 0; h < 4; ++h) { const f32x4 w0 = *(const f32x4*)(wf + h * D + k0), w1 = *(const f32x4*)(wf + h * D + k0 + 4);
                d[h] += x[0] * w0[0] + x[1] * w0[1] + x[2] * w0[2] + x[3] * w0[3] + x[4] * w1[0] + x[5] * w1[1] + x[6] * w1[2] + x[7] * w1[3]; } }
        const float rs = rsqrtf(ssa_to_f(ssq[m]) * (1.0f / D) + EPS);
#pragma unroll
        for (int h = 0; h < 4; ++h) { const float z = wave_sum(d[h], lane) * rs + a.b_in[l * INW + 1536 + h];
            const float ls = fminf(z, 0.f) - log1pf(__expf(-fabsf(z)));
            if (lane == h) logf[m * 4 + h] = ls; }
    }
}
__device__ __forceinline__ float gelu_tanh(float x) { const float u = 1.5957691216057308f * (x + 0.044715f * x * x * x); return x / (1.0f + __expf(-u)); }
constexpr int PEER_TOK = 32;
constexpr int PL_IDX = 0, PL_GATE = PEER_TOK * 128 * 4, PL_TAB = 2 * PEER_TOK * 128 * 4;
__device__ __forceinline__ int f2key(float f) { const int b = __builtin_bit_cast(int, f); return b ^ ((b >> 31) & 0x7fffffff); }
__device__ __forceinline__ float key2f(int k) { return __builtin_bit_cast(float, k ^ ((k >> 31) & 0x7fffffff)); }
#define CE_DESC(x, y) do { const int hi_ = (x) > (y) ? (x) : (y), lo_ = (x) > (y) ? (y) : (x); (x) = hi_; (y) = lo_; } while (0)
__device__ __forceinline__ void sort16_desc(int* v) {
#pragma unroll
    for (int k = 2; k <= 16; k <<= 1)
#pragma unroll
        for (int j = k >> 1; j > 0; j >>= 1)
#pragma unroll
            for (int i = 0; i < 16; ++i) { const int l = i ^ j; if (l > i) { if ((i & k) == 0) CE_DESC(v[i], v[l]); else CE_DESC(v[l], v[i]); } }
}
__device__ __forceinline__ void merge_top16(int* a, const int* b) {
#pragma unroll
    for (int i = 0; i < 16; ++i) a[i] = a[i] > b[15 - i] ? a[i] : b[15 - i];
#pragma unroll
    for (int j = 8; j > 0; j >>= 1)
#pragma unroll
        for (int i = 0; i < 16; ++i) { const int l = i ^ j; if (l > i) CE_DESC(a[i], a[l]); }
}
__device__ __forceinline__ void top16_of_64(int* v) {
    sort16_desc(v); sort16_desc(v + 16); sort16_desc(v + 32); sort16_desc(v + 48);
    merge_top16(v, v + 16); merge_top16(v + 32, v + 48); merge_top16(v, v + 32);
}
constexpr int cand_slot(int i, int j) {
    int n = 0;
    for (int a = 0; a < 16; ++a) for (int b = 0; b < 16; ++b) { if ((a + 1) * (b + 1) <= 16) { if (a == i && b == j) return n; ++n; } }
    return -1;
}
__device__ __forceinline__ void peer_retrieve(const Args& a, int l, int t0, int h, LAS char* lds, int wave) {
    typedef short bf16x8 __attribute__((ext_vector_type(8)));
    typedef float f32x16 __attribute__((ext_vector_type(16)));
    int lane; asm volatile("v_mbcnt_lo_u32_b32 %0, -1, 0\n\tv_mbcnt_hi_u32_b32 %0, -1, %0" : "=v"(lane));
    const int r32 = lane & 31, hi = lane >> 5, hi4 = hi * 4;
    const bf16* Q = (const bf16*)(a.ws + WS_Q) + (size_t)(t0 + r32) * D + h * 256 + hi * 8;
    const bf16* PK = (const bf16*)(a.ws + WS_PK) + ((size_t)(l * 8 + h) * 2) * 128 * 128 + (size_t)r32 * 128 + hi * 8;
    int top[2][16];
#pragma unroll
    for (int p = 0; p < 2; ++p) {
        f32x16 acc[4] = {};
        bf16x8 qf[8];
#pragma unroll
        for (int cs = 0; cs < 8; ++cs) qf[cs] = *(const bf16x8*)(Q + p * 128 + cs * 16);
#pragma unroll
        for (int kb = 0; kb < 4; ++kb) { bf16x8 kf[8];
#pragma unroll
            for (int cs = 0; cs < 8; ++cs) kf[cs] = *(const bf16x8*)(PK + (size_t)p * 128 * 128 + (size_t)kb * 32 * 128 + cs * 16);
#pragma unroll
            for (int cs = 0; cs < 8; ++cs) acc[kb] = __builtin_amdgcn_mfma_f32_32x32x16_bf16(kf[cs], qf[cs], acc[kb], 0, 0, 0); }
        int v[64];
#pragma unroll
        for (int kb = 0; kb < 4; ++kb)
#pragma unroll
            for (int r = 0; r < 16; ++r) { const int c = kb * 32 + (r & 3) + 8 * (r >> 2);
                v[kb * 16 + r] = (f2key(acc[kb][r]) & ~127) | (c | hi4); }
        top16_of_64(v);
        int mine[16], other[16];
#pragma unroll
        for (int i = 0; i < 16; ++i) { auto rr = __builtin_amdgcn_permlane32_swap((unsigned)v[i], (unsigned)v[i], false, false); mine[i] = (int)rr[0]; other[i] = (int)rr[1]; }
        merge_top16(mine, other);
#pragma unroll
        for (int i = 0; i < 16; ++i) top[p][i] = mine[i];
    }
    LAS int* tab = (LAS int*)(lds + PL_TAB) + (wave * 64 + lane) * 32;
    float sA[16], sB[16];
#pragma unroll
    for (int i = 0; i < 16; ++i) { sA[i] = key2f(top[0][i] & ~127); sB[i] = key2f(top[1][i] & ~127); tab[i] = top[0][i] & 127; tab[16 + i] = top[1][i] & 127; }
    int c[64];
#pragma unroll
    for (int n = 0; n < 64; ++n) c[n] = (int)0x80000000;
#pragma unroll
    for (int i = 0; i < 16; ++i)
#pragma unroll
        for (int j = 0; j < 16; ++j) if ((i + 1) * (j + 1) <= 16) c[cand_slot(i, j)] = (f2key(sA[i] + sB[j]) & ~255) | (16 * i + j);
    top16_of_64(c);
    float ex[16]; float sum = 0.f; const float mx = key2f(c[0] & ~255);
#pragma unroll
    for (int w = 0; w < 16; ++w) { ex[w] = __expf(key2f(c[w] & ~255) - mx); sum += ex[w]; }
    const float inv = 1.0f / sum;
    asm volatile("s_waitcnt lgkmcnt(0)" ::: "memory");
    LAS int* oi = (LAS int*)(lds + PL_IDX) + r32 * 128 + h * 16; LAS float* og = (LAS float*)(lds + PL_GATE) + r32 * 128 + h * 16;
#pragma unroll
    for (int w = 0; w < 16; ++w) { const int id = c[w] & 255; const int e = tab[id >> 4] * 128 + tab[16 + (id & 15)];
        if ((w >> 3) == hi) { oi[w] = e; og[w] = ex[w] * inv; } }
}
constexpr size_t WS_IDX = 816 * MiB;
constexpr size_t WS_GATE = 820 * MiB;
constexpr size_t WS_XQ = 824 * MiB;
constexpr size_t WS_SX = 856 * MiB;
constexpr size_t WS_PART = 857 * MiB;
constexpr size_t WS_SUT = 890 * MiB;
constexpr size_t WS_END2 = 1024 * MiB;
#ifndef PEER_NB
#define PEER_NB 8
#endif
constexpr int NSLICE = 8, SLW = D / NSLICE;
#define DPP_ROR(x, n) __builtin_bit_cast(float, __builtin_amdgcn_update_dpp(0, __builtin_bit_cast(int, (x)), 0x120 + (n), 0xf, 0xf, false))
__device__ __forceinline__ void peer_publish(const Args& a, int l, int t, LAS char* lds, int tl) {
    int lane; LANE_ID(lane);
    unsigned char* ws = a.ws;
    { int* gi = (int*)(ws + WS_IDX) + (size_t)t * 128; float* gg = (float*)(ws + WS_GATE) + (size_t)t * 128; float* gs = (float*)(ws + WS_SUT) + (size_t)t * 128;
      const float* SU = (const float*)(ws + WS_SU) + l * PEER_E; const float* SV = (const float*)(ws + WS_SV) + l * PEER_E;
      const int i0 = ((const LAS int*)(lds + PL_IDX))[tl * 128 + lane], i1 = ((const LAS int*)(lds + PL_IDX))[tl * 128 + 64 + lane];
      gi[lane] = i0; gi[64 + lane] = i1; gs[lane] = SU[i0]; gs[64 + lane] = SU[i1];
      gg[lane] = ((const LAS float*)(lds + PL_GATE))[tl * 128 + lane] * SV[i0]; gg[64 + lane] = ((const LAS float*)(lds + PL_GATE))[tl * 128 + 64 + lane] * SV[i1]; }
    const unsigned long long* ssa1 = (const unsigned long long*)(ws + WS_SSA) + l * M;
    const float rs = rsqrtf(ssa_to_f(ssa1[t]) * (1.0f / D) + EPS);
    const bf16* HB = (const bf16*)(ws + WS_HB) + (size_t)t * D; const float* gn = a.norm_ffn + l * D;
    float xf[32]; float am = 0.f;
#pragma unroll
    for (int i = 0; i < 2; ++i) { const int k0 = 16 * lane + 1024 * i; const v4u h0 = *(const v4u*)(HB + k0), h1 = *(const v4u*)(HB + k0 + 8);
        const unsigned hw[8] = {h0.x, h0.y, h0.z, h0.w, h1.x, h1.y, h1.z, h1.w};
#pragma unroll
        for (int q = 0; q < 4; ++q) { const f32x4 g = *(const f32x4*)(gn + k0 + 4 * q);
            xf[16 * i + 4 * q + 0] = bflo(hw[2 * q]) * rs * g[0]; xf[16 * i + 4 * q + 1] = bfhi(hw[2 * q]) * rs * g[1];
            xf[16 * i + 4 * q + 2] = bflo(hw[2 * q + 1]) * rs * g[2]; xf[16 * i + 4 * q + 3] = bfhi(hw[2 * q + 1]) * rs * g[3]; } }
#pragma unroll
    for (int k = 0; k < 32; ++k) am = fmaxf(am, fabsf(xf[k]));
    am = wave_max(am, lane);
    const float inv = am > 0.f ? 127.0f / am : 0.f;
    if (lane == 0) ((float*)(ws + WS_SX))[t] = am * (1.0f / 127.0f);
    unsigned char* xq = ws + WS_XQ + (size_t)t * 4096;
#pragma unroll
    for (int i = 0; i < 2; ++i) { v4u ph, pl;
#pragma unroll
        for (int d = 0; d < 4; ++d) { unsigned wh = 0, wl = 0;
#pragma unroll
            for (int b = 0; b < 4; ++b) { const float sv = xf[16 * i + 4 * d + b] * inv, hq = rintf(sv), lq = rintf((sv - hq) * 128.0f);
                wh |= ((unsigned)((int)hq & 255)) << (8 * b); wl |= ((unsigned)((int)lq & 255)) << (8 * b); }
            ph[d] = wh; pl[d] = wl; }
        *(v4u*)(xq + 16 * lane + 1024 * i) = ph; *(v4u*)(xq + 2048 + 16 * lane + 1024 * i) = pl; }
}
struct PeerItems { int pos, npop, rank, nloc, wave;
    __device__ __forceinline__ int nblk() const { return (M / PEER_TOK - rank + nloc - 1) / nloc; }
    __device__ __forceinline__ int count() const { return ((NSLICE - pos + npop - 1) / npop) * nblk() * (PEER_TOK / NWAVES); }
    __device__ __forceinline__ void get(int n, int& s, int& t) const { constexpr int per = PEER_TOK / NWAVES; const int k = n % per, r = n / per, nb = nblk();
        s = pos + (r / nb) * npop; t = (rank + (r % nb) * nloc) * PEER_TOK + wave * per + k; } };
__device__ __forceinline__ void peer_u_wave(const Args& a, int l, const PeerItems& it) {
    int lane; LANE_ID(lane);
    unsigned char* ws = a.ws; const int sub = lane & 15, grp = lane >> 4;
    const __amdgpu_buffer_rsrc_t rU = __builtin_amdgcn_make_buffer_rsrc((void*)(ws + WS_PU + (size_t)l * PE_BYTES), 0, 0x7fffffff, 0x00020000);
    const __amdgpu_buffer_rsrc_t rW = __builtin_amdgcn_make_buffer_rsrc((void*)ws, 0, 0x7fffffff, 0x00020000);
    const int N = it.count(); if (N <= 0) return;
    int s, t; it.get(0, s, t);
    int idc[2], idn[2] = {0, 0}; v4u xhc, xlc, xhn = {}, xln = {}; v4u wA[PEER_NB], wB[PEER_NB];
#define PU_META(I0, I1, XH, XL, S_, T_) do { I0 = (int)__builtin_amdgcn_raw_buffer_load_b32(rW, 4 * lane, (int)WS_IDX + (T_) * 512, 0); I1 = (int)__builtin_amdgcn_raw_buffer_load_b32(rW, 4 * lane, (int)WS_IDX + (T_) * 512 + 256, 0); \
        XH = __builtin_amdgcn_raw_buffer_load_b128(rW, 16 * sub, (int)WS_XQ + (T_) * 4096 + SLW * (S_), 0); XL = __builtin_amdgcn_raw_buffer_load_b128(rW, 16 * sub, (int)WS_XQ + (T_) * 4096 + 2048 + SLW * (S_), 0); } while (0)
#define PU_ISSUE(W, ID, Q, S_) do { _Pragma("unroll") for (int j = 0; j < PEER_NB; ++j) { const int e_ = shi(ID[(PEER_NB * (Q) + j) >> 4], 4 * ((PEER_NB * (Q) + j) & 15) + grp); W[j] = __builtin_amdgcn_raw_buffer_load_b128(rU, e_ * D + SLW * (S_) + 16 * sub, 0, 0); } } while (0)
#define PU_COMP(W, Q) do { _Pragma("unroll") for (int j = 0; j < PEER_NB; ++j) { int dh = 0, dl = 0; \
            dh = __builtin_amdgcn_sdot4((int)W[j].x, (int)xhc.x, dh, false); dl = __builtin_amdgcn_sdot4((int)W[j].x, (int)xlc.x, dl, false); \
            dh = __builtin_amdgcn_sdot4((int)W[j].y, (int)xhc.y, dh, false); dl = __builtin_amdgcn_sdot4((int)W[j].y, (int)xlc.y, dl, false); \
            dh = __builtin_amdgcn_sdot4((int)W[j].z, (int)xhc.z, dh, false); dl = __builtin_amdgcn_sdot4((int)W[j].z, (int)xlc.z, dl, false); \
            dh = __builtin_amdgcn_sdot4((int)W[j].w, (int)xhc.w, dh, false); dl = __builtin_amdgcn_sdot4((int)W[j].w, (int)xlc.w, dl, false); \
            float p_ = (float)dh + (float)dl * (1.0f / 128.0f); \
            p_ += DPP_ROR(p_, 8); p_ += DPP_ROR(p_, 4); p_ += DPP_ROR(p_, 2); p_ += DPP_ROR(p_, 1); \
            if (sub == ((PEER_NB * (Q) + j) & 15)) { if ((PEER_NB * (Q) + j) >> 4) acc1 = p_; else acc0 = p_; } __builtin_amdgcn_sched_barrier(0); } } while (0)
    PU_META(idc[0], idc[1], xhc, xlc, s, t); PU_ISSUE(wA, idc, 0, s); PU_ISSUE(wB, idc, 1, s);
    for (int n = 0; n < N; ++n) {
        int sn = s, tn = t; const bool more = n + 1 < N;
        if (more) it.get(n + 1, sn, tn);
        PU_META(idn[0], idn[1], xhn, xln, sn, tn);
        float acc0 = 0.f, acc1 = 0.f;
        __builtin_amdgcn_sched_barrier(0);
#if PEER_NB == 8
        PU_COMP(wA, 0); PU_ISSUE(wA, idc, 2, s); __builtin_amdgcn_sched_barrier(0);
        PU_COMP(wB, 1); PU_ISSUE(wB, idc, 3, s); __builtin_amdgcn_sched_barrier(0);
        PU_COMP(wA, 2); PU_ISSUE(wA, idn, 0, sn); __builtin_amdgcn_sched_barrier(0);
        PU_COMP(wB, 3); PU_ISSUE(wB, idn, 1, sn); __builtin_amdgcn_sched_barrier(0);
#else
        PU_COMP(wA, 0); PU_ISSUE(wA, idn, 0, sn); __builtin_amdgcn_sched_barrier(0);
        PU_COMP(wB, 1); PU_ISSUE(wB, idn, 1, sn); __builtin_amdgcn_sched_barrier(0);
#endif
        __builtin_amdgcn_raw_buffer_store_b32(__builtin_bit_cast(unsigned, acc0), rW, (4 * sub + grp) * 4, (int)WS_PART + (s * M + t) * 512, 0);
        __builtin_amdgcn_raw_buffer_store_b32(__builtin_bit_cast(unsigned, acc1), rW, (4 * sub + grp) * 4 + 256, (int)WS_PART + (s * M + t) * 512, 0);
        s = sn; t = tn; idc[0] = idn[0]; idc[1] = idn[1]; xhc = xhn; xlc = xln;
    }
#undef PU_META
#undef PU_ISSUE
#undef PU_COMP
}
__device__ __forceinline__ void peer_v_wave(const Args& a, int l, const PeerItems& it) {
    int lane; LANE_ID(lane);
    unsigned char* ws = a.ws; const int sub = lane & 15, grp = lane >> 4;
    const __amdgpu_buffer_rsrc_t rV = __builtin_amdgcn_make_buffer_rsrc((void*)(ws + WS_PV + (size_t)l * PE_BYTES), 0, 0x7fffffff, 0x00020000);
    const __amdgpu_buffer_rsrc_t rW = __builtin_amdgcn_make_buffer_rsrc((void*)ws, 0, 0x7fffffff, 0x00020000);
    const int N = it.count(); if (N <= 0) return;
    int s, t; it.get(0, s, t);
    struct Meta { int id[2]; float gate[2], su[2], pa[2], sx; v2u h1; };
    Meta mc, mn; v4u wA[PEER_NB], wB[PEER_NB];
    const int l4 = 4 * lane;
#define WLD(off_s) __builtin_amdgcn_raw_buffer_load_b32(rW, l4, (int)(off_s), 0)
#define PV_META(MM, S_, T_) do { const int r_ = (T_) * 512; MM.id[0] = (int)WLD(WS_IDX + r_); MM.id[1] = (int)WLD(WS_IDX + r_ + 256); \
        MM.gate[0] = __builtin_bit_cast(float, WLD(WS_GATE + r_)); MM.gate[1] = __builtin_bit_cast(float, WLD(WS_GATE + r_ + 256)); MM.su[0] = __builtin_bit_cast(float, WLD(WS_SUT + r_)); MM.su[1] = __builtin_bit_cast(float, WLD(WS_SUT + r_ + 256)); \
        float a0_ = 0.f, a1_ = 0.f; _Pragma("unroll") for (int q = 0; q < NSLICE; ++q) { const int po_ = (int)WS_PART + (q * M + (T_)) * 512; a0_ += __builtin_bit_cast(float, WLD(po_)); a1_ += __builtin_bit_cast(float, WLD(po_ + 256)); } \
        MM.pa[0] = a0_; MM.pa[1] = a1_; MM.sx = ((const float*)(ws + WS_SX))[T_]; \
        MM.h1 = __builtin_amdgcn_raw_buffer_load_b64(rW, (16 * sub + 4 * grp) * 2, (int)WS_HB + ((T_) * D + SLW * (S_)) * 2, 0); } while (0)
#define PV_ISSUE(W, ID, Q, S_) do { _Pragma("unroll") for (int j = 0; j < PEER_NB; ++j) { const int e_ = shi(ID[(PEER_NB * (Q) + j) >> 4], 4 * ((PEER_NB * (Q) + j) & 15) + grp); W[j] = __builtin_amdgcn_raw_buffer_load_b128(rV, e_ * D + SLW * (S_) + 16 * sub, 0, 0); } } while (0)
#define PV_COMP(W, Q) do { _Pragma("unroll") for (int j4 = 0; j4 < PEER_NB; j4 += 4) { \
            unsigned cp_ = 0; _Pragma("unroll") for (int jj = 0; jj < 4; ++jj) { const int i_ = PEER_NB * (Q) + j4 + jj; cp_ |= ((unsigned)shi(c8[i_ >> 4], 4 * (i_ & 15) + grp) & 255u) << (8 * jj); } \
            _Pragma("unroll") for (int d = 0; d < 4; ++d) { const unsigned a_ = W[j4][d], b_ = W[j4 + 1][d], c_ = W[j4 + 2][d], d_ = W[j4 + 3][d]; \
                const unsigned x0_ = __builtin_amdgcn_perm(b_, a_, 0x05010400u), x1_ = __builtin_amdgcn_perm(b_, a_, 0x07030602u), y0_ = __builtin_amdgcn_perm(d_, c_, 0x05010400u), y1_ = __builtin_amdgcn_perm(d_, c_, 0x07030602u); \
                yi[4 * d + 0] = __builtin_amdgcn_sdot4((int)__builtin_amdgcn_perm(y0_, x0_, 0x05040100u), (int)cp_, yi[4 * d + 0], false); \
                yi[4 * d + 1] = __builtin_amdgcn_sdot4((int)__builtin_amdgcn_perm(y0_, x0_, 0x07060302u), (int)cp_, yi[4 * d + 1], false); \
                yi[4 * d + 2] = __builtin_amdgcn_sdot4((int)__builtin_amdgcn_perm(y1_, x1_, 0x05040100u), (int)cp_, yi[4 * d + 2], false); \
                yi[4 * d + 3] = __builtin_amdgcn_sdot4((int)__builtin_amdgcn_perm(y1_, x1_, 0x07060302u), (int)cp_, yi[4 * d + 3], false); } \
            __builtin_amdgcn_sched_barrier(0); } } while (0)
    PV_META(mc, s, t); PV_ISSUE(wA, mc.id, 0, s); PV_ISSUE(wB, mc.id, 1, s);
    for (int n = 0; n < N; ++n) {
        int sn = s, tn = t; const bool more = n + 1 < N;
        if (more) it.get(n + 1, sn, tn);
        PV_META(mn, sn, tn);
        float coef[2];
#pragma unroll
        for (int hf = 0; hf < 2; ++hf) coef[hf] = gelu_tanh(mc.pa[hf] * mc.su[hf] * mc.sx) * mc.gate[hf];
        const float cmax = wave_max(fmaxf(fabsf(coef[0]), fabsf(coef[1])), lane); const float cinv = cmax > 0.f ? 127.0f / cmax : 0.f, cs = cmax * (1.0f / 127.0f);
        const int c8[2] = {(int)rintf(coef[0] * cinv), (int)rintf(coef[1] * cinv)};
        int yi[16];
#pragma unroll
        for (int k = 0; k < 16; ++k) yi[k] = 0;
        __builtin_amdgcn_sched_barrier(0);
#if PEER_NB == 8
        PV_COMP(wA, 0); PV_ISSUE(wA, mc.id, 2, s); __builtin_amdgcn_sched_barrier(0);
        PV_COMP(wB, 1); PV_ISSUE(wB, mc.id, 3, s); __builtin_amdgcn_sched_barrier(0);
        PV_COMP(wA, 2); PV_ISSUE(wA, mn.id, 0, sn); __builtin_amdgcn_sched_barrier(0);
        PV_COMP(wB, 3); PV_ISSUE(wB, mn.id, 1, sn); __builtin_amdgcn_sched_barrier(0);
#else
        PV_COMP(wA, 0); PV_ISSUE(wA, mn.id, 0, sn); __builtin_amdgcn_sched_barrier(0);
        PV_COMP(wB, 1); PV_ISSUE(wB, mn.id, 1, sn); __builtin_amdgcn_sched_barrier(0);
#endif
#pragma unroll
        for (int k = 0; k < 16; ++k) { yi[k] += shi(yi[k], lane ^ 16); yi[k] += shi(yi[k], lane ^ 32); }
        int yq[4];
#pragma unroll
        for (int k = 0; k < 4; ++k) yq[k] = grp == 0 ? yi[k] : grp == 1 ? yi[4 + k] : grp == 2 ? yi[8 + k] : yi[12 + k];
        const f32x4 h2 = {bflo(mc.h1.x) + cs * (float)yq[0], bfhi(mc.h1.x) + cs * (float)yq[1], bflo(mc.h1.y) + cs * (float)yq[2], bfhi(mc.h1.y) + cs * (float)yq[3]};
        v2u hb; hb.x = pk2(h2[0], h2[1]); hb.y = pk2(h2[2], h2[3]);
        __builtin_amdgcn_raw_buffer_store_b64(hb, rW, (16 * sub + 4 * grp) * 2, (int)WS_HB + (t * D + SLW * s) * 2, 0);
        const float sq = wave_sum((h2[0] * h2[0] + h2[1] * h2[1]) + (h2[2] * h2[2] + h2[3] * h2[3]), lane);
        if (lane == 0) atomicAdd((unsigned long long*)(ws + WS_SSQ) + (size_t)(l + 1) * M + t, (unsigned long long)((double)sq * 4294967296.0));
        s = sn; t = tn; mc = mn;
    }
#undef PV_META
#undef WLD
#undef PV_ISSUE
#undef PV_COMP
}
__device__ __forceinline__ void final_norm_row(const Args& a, int t) {
    int lane; LANE_ID(lane);
    const bf16* HB = (const bf16*)(a.ws + WS_HB) + (size_t)t * D; float* O = a.out + (size_t)t * D;
    const float rf = rsqrtf(ssa_to_f(((const unsigned long long*)(a.ws + WS_SSQ))[(size_t)DEPTH * M + t]) * (1.0f / D) + EPS);
#pragma unroll
    for (int j = 0; j < 8; ++j) { const int k0 = 4 * lane + 256 * j; const v2u w = *(const v2u*)(HB + k0); const f32x4 g = *(const f32x4*)(a.norm_final + k0);
        *(f32x4*)(O + k0) = (f32x4){bflo(w.x) * rf * g[0], bfhi(w.x) * rf * g[1], bflo(w.y) * rf * g[2], bfhi(w.y) * rf * g[3]}; }
}

__global__ void __launch_bounds__(NT, 2) mk_fwd(ArgsK a_in) {
    extern __shared__ __attribute__((aligned(16))) unsigned char lds_raw[];
    LAS unsigned char* lds = (LAS unsigned char*)lds_raw;
    cg::grid_group grid = cg::this_grid();
    grid.sync();
    const int wave0 = __builtin_amdgcn_readfirstlane(threadIdx.x >> 6);
    const int G = gridDim.x;
    const CAS ArgsK* ka = (const CAS ArgsK*)__builtin_amdgcn_kernarg_segment_ptr();
    size_t zoff = 0;
#define PHASE_BEGIN() int lane; LANE_ID(lane); int blk = blockIdx.x, Gp = G, wv = wave0; asm volatile("" : "+s"(zoff), "+s"(ka), "+s"(blk), "+s"(Gp), "+s"(wv)); const int wave = wv, gw = blk * NWAVES + wv, NGW = Gp * NWAVES; (void)gw; (void)NGW; const Args a = load_args(ka, zoff); unsigned char* const ws = a.ws; (void)ws
    volatile LAS unsigned* bst = (volatile LAS unsigned*)(lds + RING_BYTES + 1024);
#define GRID_BAR() do { asm volatile("" : "+s"(zoff)); unsigned char* wsb_ = (unsigned char*)ka->ws + zoff; int wvb_ = wave0; asm volatile("" : "+s"(wvb_)); xcd_barrier((unsigned*)(wsb_ + WS_BAR), xb_xcc_id(), (unsigned)G, bst, wvb_); } while (0)
    volatile LAS unsigned* xinfo = bst + 4;
    { PHASE_BEGIN(); if (wave == 0 && lane == 0) { bst[0] = 0u; bst[1] = 0u; xinfo[2] = xb_add((unsigned*)(ws + WS_BAR) + XB_XCNT(xb_xcc_id()), 1u); }
      p0_cmax(a, gw, NGW, lane); }
    GRID_BAR();
    { PHASE_BEGIN(); p0_win_i8(a, lds, gw, NGW, wave, lane); p0_prologue(a, lds, gw, NGW, wave, lane); }
    GRID_BAR();
    {
        PHASE_BEGIN();
        if (wave == 0 && lane == 0) { unsigned* bar = (unsigned*)(ws + WS_BAR); const unsigned x = xb_xcc_id(); unsigned pos = 0, npop = 0, mine = 1;
            for (unsigned j = 0; j < 16; ++j) { const unsigned c = xb_ld(&bar[XB_XCNT(j)]); if (c) { ++npop; if (j < x) ++pos; } if (j == x) mine = c ? c : 1u; }
            xinfo[0] = pos; xinfo[1] = npop ? npop : 1u; xinfo[3] = mine; }
        __syncthreads();
    }
    int depth_rt = DEPTH; asm volatile("" : "+s"(depth_rt));
    for (int lc = 0; lc < depth_rt; ++lc) {
        int l = lc; asm volatile("" : "+s"(l));
        if (l > 0) { { PHASE_BEGIN(); quant_rows(a, l, gw, NGW, lane); } GRID_BAR(); }
        {
            PHASE_BEGIN();
            pg8::Gemm g{(const bf16*)(ws + WS_HB8), (const bf16*)(ws + WS_WIN + l * WIN_BYTES), M, NPROJ, D / 2}; pg8::StaticOrder S; S.init(M, NPROJ, Gp, blk);
            EpiProj E{ws, (const bf16*)(ws + WS_BIH) + l * NPROJ, (const float*)(ws + WS_RSA), (const bf16*)(ws + WS_SWH) + l * NPROJ};
            pg8::gemm_phase<EpiProj, pg8::StaticOrder, true, true>(lds, g, S, E, wave);
            forget_logits(a, l, gw, NGW, lane);
        }
        GRID_BAR();
#if defined(PROBE) && (PROBE == 2 || PROBE == 4)
        { PHASE_BEGIN(); const unsigned char* Gb = ws + WS_G; const bf16* PJ = (const bf16*)(ws + WS_PROJ);
          for (size_t i = (size_t)gw * 64 + lane; i < (size_t)M * D; i += (size_t)NGW * 64) { const size_t t = i / D, d = i % D;
            if (PROBE == 2) a.out[i] = (float)Gb[t * 8192 + d] + 3.0f * (float)Gb[t * 8192 + 2048 + d] + 7.0f * (float)Gb[t * 8192 + 4096 + d] + 13.0f * (float)Gb[t * 8192 + 6144 + d];
            else { float sacc = 0.f; for (int q = 0; q < 10; ++q) if ((d >> 9) == (q & 3)) sacc += (float)(q + 1) * bflo((unsigned)(unsigned short)PJ[(size_t)q * PROJ_T + t * MIXW + (d & 511)]) ; a.out[i] = sacc; } }
          return; }
#endif
        { PHASE_BEGIN(); mixers_fast(a, l, (LAS char*)lds, wave, lane, Gp, blk); }
        GRID_BAR();
#if defined(PROBE) && PROBE == 3
        { PHASE_BEGIN(); const bf16* src = (const bf16*)(ws + WS_Y);
          for (size_t i = (size_t)gw * 64 + lane; i < (size_t)M * D; i += (size_t)NGW * 64) a.out[i] = bflo((unsigned)(unsigned short)src[i]);
          return; }
#endif
        {
            PHASE_BEGIN();
            pg8::Gemm g{(const bf16*)(ws + WS_Y), (const bf16*)(ws + WS_WBR + l * SQ_BYTES), M, D, D}; pg8::StaticOrder S; S.init(M, D, Gp, blk);
            EpiMerge E{(const unsigned char*)(ws + WS_G), (bf16*)(ws + WS_MRG)};
            pg8::gemm_phase<EpiMerge, pg8::StaticOrder, false>(lds, g, S, E, wave);
        }
        GRID_BAR();
#if defined(PROBE) && PROBE == 1
        { PHASE_BEGIN(); const bf16* src = (const bf16*)(ws + WS_MRG);
          for (size_t i = (size_t)gw * 64 + lane; i < (size_t)M * D; i += (size_t)NGW * 64) a.out[i] = bflo((unsigned)(unsigned short)src[i]);
          return; }
#endif
        {
            PHASE_BEGIN();
            pg8::Gemm g{(const bf16*)(ws + WS_MRG), (const bf16*)(ws + WS_WOUT + l * SQ_BYTES), M, D, D}; pg8::StaticOrder S; S.init(M, D, Gp, blk);
            EpiRes E{l == 0 ? a.x : (const float*)nullptr, (bf16*)(ws + WS_HB), (unsigned long long*)(ws + WS_SSA) + l * M};
            pg8::gemm_phase<EpiRes, pg8::StaticOrder, false>(lds, g, S, E, wave);
        }
        GRID_BAR();
        {
            PHASE_BEGIN();
            pg8::Gemm g{(const bf16*)(ws + WS_HB), (const bf16*)(ws + WS_WQ + l * SQ_BYTES), M, D, D}; pg8::StaticOrder S; S.init(M, D, Gp, blk);
            EpiQ E{(bf16*)(ws + WS_Q), (const unsigned long long*)(ws + WS_SSA) + l * M};
            pg8::gemm_phase<EpiQ, pg8::StaticOrder, false>(lds, g, S, E, wave);
        }
        GRID_BAR();
        {
            PHASE_BEGIN(); (void)lane;
            for (int t0 = blk * PEER_TOK; t0 < M; t0 += Gp * PEER_TOK) {
                peer_retrieve(a, l, t0, wave, (LAS char*)lds, wave);
                __syncthreads();
                for (int k = 0; k < PEER_TOK / NWAVES; ++k) { const int tl = wave * (PEER_TOK / NWAVES) + k; peer_publish(a, l, t0 + tl, (LAS char*)lds, tl); }
                __syncthreads();
            }
        }
        GRID_BAR();
        {
            PHASE_BEGIN(); (void)lane;
            const int pos = __builtin_amdgcn_readfirstlane((int)xinfo[0]), npop = __builtin_amdgcn_readfirstlane((int)xinfo[1]), rank = __builtin_amdgcn_readfirstlane((int)xinfo[2]), nloc = __builtin_amdgcn_readfirstlane((int)xinfo[3]);
            const PeerItems it{pos, npop, rank, nloc, wave}; peer_u_wave(a, l, it);
        }
        GRID_BAR();
        {
            PHASE_BEGIN(); (void)lane;
            const int pos = __builtin_amdgcn_readfirstlane((int)xinfo[0]), npop = __builtin_amdgcn_readfirstlane((int)xinfo[1]), rank = __builtin_amdgcn_readfirstlane((int)xinfo[2]), nloc = __builtin_amdgcn_readfirstlane((int)xinfo[3]);
            const PeerItems it{pos, npop, rank, nloc, wave}; peer_v_wave(a, l, it);
        }
        GRID_BAR();
    }
    {
        PHASE_BEGIN(); (void)lane;
        for (int t = gw; t < M; t += NGW) final_norm_row(a, t);
    }
}

extern "C" void kernel_launch(void* const* d_in, const int* in_sizes, int n_in, void* d_out, int out_size, void* d_ws, size_t ws_size, hipStream_t stream) {
    static int grid = 0;
    if (grid == 0) {
        int dev = 0, cus = 0, per_cu = 0;
        if (n_in != 16 || out_size != M * D || ws_size < WS_END2) { fprintf(stderr, "kernel_launch: unexpected shapes (n_in %d out %d ws %zu)\n", n_in, out_size, ws_size); grid = -1; return; }
        (void)hipGetDevice(&dev);
        (void)hipDeviceGetAttribute(&cus, hipDeviceAttributeMultiprocessorCount, dev);
        (void)hipFuncSetAttribute((const void*)mk_fwd, hipFuncAttributeMaxDynamicSharedMemorySize, LDS_BYTES);
        (void)hipOccupancyMaxActiveBlocksPerMultiprocessor(&per_cu, (const void*)mk_fwd, NT, LDS_BYTES);
        if (per_cu < 1) { fprintf(stderr, "kernel_launch: occupancy query says %d blocks per CU\n", per_cu); }
        grid = cus;
        if (grid > 256) grid = 256;
    }
    if (grid < 0) return;
    (void)hipMemsetAsync((char*)d_ws + WS_CTL, 0, CTL_ZERO_BYTES, stream);
    ArgsK a{};
    const GAS float** p = (const GAS float**)&a;
    for (int i = 0; i < 16; ++i) p[i] = (const GAS float*)d_in[i];
    a.out = (GAS float*)d_out; a.ws = (GAS unsigned char*)d_ws;
    void* args[] = {&a};
    hipError_t e = hipLaunchCooperativeKernel((const void*)mk_fwd, dim3(grid), dim3(NT), args, LDS_BYTES, stream);
    if (e != hipSuccess) fprintf(stderr, "cooperative launch failed: %s (grid %d)\n", hipGetErrorString(e), grid);
}
```

```cpp
#include <hip/hip_runtime.h>
#include <hip/hip_cooperative_groups.h>
#include <cstdio>
#include <cstdint>
namespace cg = cooperative_groups;
namespace pg8 {
#define PG8_LAS __attribute__((address_space(3)))
typedef unsigned short bf16_t;
typedef short bf16x8 __attribute__((ext_vector_type(8)));
typedef float f32x4 __attribute__((ext_vector_type(4)));
typedef unsigned u32x4 __attribute__((ext_vector_type(4)));
typedef unsigned u32x2 __attribute__((ext_vector_type(2)));
typedef int i32x4 __attribute__((ext_vector_type(4)));
constexpr int BM = 256, BK = 64, HALF = 128, HTB = HALF * BK * 2  , STAGE_BYTES = 8 * HTB, NXCD = 8, WGM = 8;

__host__ __device__ __forceinline__ int lds_byte(int r, int c) { const int st = (r >> 4) * 2 + (c >> 5), rr = r & 15, cc = c & 31, ob = rr * 64 + cc * 2; return st * 1024 + (ob ^ (((ob >> 9) & 1) << 5)); }
__host__ __device__ __forceinline__ void stage_rc(int b, int& R, int& C) { const int st = b / 1024, sb = b % 1024, swz = sb ^ (((sb >> 9) & 1) << 5); R = (st >> 1) * 16 + swz / 64; C = (st & 1) * 32 + (swz % 64) / 2; }
__host__ __device__ __forceinline__ int perm32(int rho) { const int n = rho >> 4, i = rho & 15; return 8 * (i >> 2) + 4 * n + (i & 3); }

struct Unit { int pm, pn; };
struct Gemm { const bf16_t* A; const bf16_t* Bt; int M, N, K; };

struct StaticOrder {
    int nM, nN, nwg, G, c;
    __host__ __device__ void init(int M, int N, int G_, int c_) { nM = M / BM; nN = N / BM; nwg = nM * nN; G = G_; c = c_; }
    __host__ __device__ bool next(int i, Unit& u) const {
        const long L = (long)i * G + c; if (L >= nwg) return false;
        int wgid = (int)L; { const int q = nwg / NXCD, r = nwg % NXCD, xcd = wgid % NXCD, off = wgid / NXCD; wgid = (xcd < r ? xcd * (q + 1) : r * (q + 1) + (xcd - r) * q) + off; }
        const int nig = WGM * nN, gid = wgid / nig, fm = gid * WGM, gsz = (nM - fm) < WGM ? (nM - fm) : WGM;
        u.pm = fm + ((wgid % nig) % gsz); u.pn = (wgid % nig) / gsz; return true;
    }
};

__device__ __forceinline__ unsigned cvt_pk_bf16(float lo, float hi) { unsigned r; asm volatile("v_cvt_pk_bf16_f32 %0, %1, %2" : "=v"(r) : "v"(lo), "v"(hi)); return r; }

template <class Epi, class Sched, bool ALIGN_EPI = false, bool I8 = false>
__device__ __forceinline__ void gemm_phase(PG8_LAS unsigned char* lds, const Gemm g, const Sched& S, const Epi& E, int wid) {
    int lane_; asm volatile("v_mbcnt_lo_u32_b32 %0, -1, 0\n\tv_mbcnt_hi_u32_b32 %0, -1, %0" : "=v"(lane_));
    const int lane = lane_, tid = wid * 64 + lane, wr = wid >> 2, wc = wid & 3, fr = lane & 15, fq = lane >> 4;
    const int K = g.K, nt = K / BK;
    unsigned voffA, voffB;
    { int R, C; stage_rc(tid * 16, R, C); const int Rb = Epi::PERM ? ((R & ~31) + perm32(R & 31)) : R; voffA = (unsigned)(R * K + C) * 2u; voffB = (unsigned)(Rb * K + C) * 2u; }
    const size_t p2step = (size_t)64 * K * 2;
    const size_t kstep = (size_t)(BK * 2);
    const size_t hstep = (size_t)HALF * K * 2;
    const size_t tstep = 2 * hstep;
    const unsigned ldsw = (unsigned)wid * 1024u;
    const int aoff = lds_byte(wr * 64 + fr, fq * 8), boff = lds_byte(wc * 32 + fr, fq * 8);
#define PG8_SA(b, h) (((b) * 2 + (h)) * HTB)
#define PG8_SB(b, h) ((4 + (b) * 2 + (h)) * HTB)
#define PG8_STAGE(bufoff, gbase, voff) do { _Pragma("unroll") for (int _i = 0; _i < 2; ++_i) \
        __builtin_amdgcn_global_load_lds((const unsigned*)((const char*)(gbase) + _i * p2step + (voff)), (PG8_LAS unsigned*)(lds + (bufoff) + ldsw + _i * 8192), 16, 0, 0); } while (0)
#define PG8_LDA(dst, b, h) do { _Pragma("unroll") for (int m = 0; m < 4; ++m) _Pragma("unroll") for (int k = 0; k < 2; ++k) dst[m][k] = *(const PG8_LAS bf16x8*)(lds + PG8_SA(b, h) + aoff + m * 2048 + k * 1024); } while (0)
#define PG8_LDB(dst, b, h) do { _Pragma("unroll") for (int n = 0; n < 2; ++n) _Pragma("unroll") for (int k = 0; k < 2; ++k) dst[n][k] = *(const PG8_LAS bf16x8*)(lds + PG8_SB(b, h) + boff + n * 2048 + k * 1024); } while (0)
#define PG8_MMA(ai, bj, At, Bt) do { __builtin_amdgcn_s_setprio(1); _Pragma("unroll") for (int m = 0; m < 4; ++m) _Pragma("unroll") for (int n = 0; n < 2; ++n) _Pragma("unroll") for (int k = 0; k < 2; ++k) \
        { if constexpr (I8) acc[ai][bj][m][n] = __builtin_bit_cast(f32x4, __builtin_amdgcn_mfma_i32_16x16x64_i8(__builtin_bit_cast(i32x4, Bt[n][k]), __builtin_bit_cast(i32x4, At[m][k]), __builtin_bit_cast(i32x4, acc[ai][bj][m][n]), 0, 0, 0)); \
          else acc[ai][bj][m][n] = __builtin_amdgcn_mfma_f32_16x16x32_bf16(Bt[n][k], At[m][k], acc[ai][bj][m][n], 0, 0, 0); } __builtin_amdgcn_s_setprio(0); } while (0)
#define PG8_WAIT_V(n) asm volatile("s_waitcnt vmcnt(" #n ")" ::: "memory")
#define PG8_WAIT_L(n) asm volatile("s_waitcnt lgkmcnt(" #n ")" ::: "memory")
#define PG8_BAR __builtin_amdgcn_s_barrier()
#define PG8_SCHED __builtin_amdgcn_sched_barrier(0)
    Unit cur, nxt; int ui = 0;
    if (!S.next(0, cur)) return;
    f32x4 acc[2][2][4][2];
#pragma unroll
    for (int a = 0; a < 2; ++a)
#pragma unroll
        for (int b = 0; b < 2; ++b)
#pragma unroll
            for (int m = 0; m < 4; ++m)
#pragma unroll
                for (int n = 0; n < 2; ++n) acc[a][b][m][n] = (f32x4){0.f, 0.f, 0.f, 0.f};
    bf16x8 At[4][2], B0[2][2], B1[2][2];
    typename Epi::Pre pre = {};
    const char* cA = (const char*)g.A + (size_t)cur.pm * tstep; const char* cB = (const char*)g.Bt + (size_t)cur.pn * tstep;
    PG8_STAGE(PG8_SB(0, 0), cB, voffB); PG8_STAGE(PG8_SB(0, 1), cB + hstep, voffB); PG8_STAGE(PG8_SA(0, 0), cA, voffA); PG8_STAGE(PG8_SA(0, 1), cA + hstep, voffA);
    if (wr == 1) PG8_BAR;
    PG8_WAIT_V(2); PG8_BAR;
    PG8_STAGE(PG8_SB(1, 0), cB + kstep, voffB); PG8_STAGE(PG8_SA(1, 0), cA + kstep, voffA); PG8_STAGE(PG8_SB(1, 1), cB + hstep + kstep, voffB);
    PG8_WAIT_V(6); PG8_BAR;
    for (;;) {
        const bool has_next = S.next(ui + 1, nxt);
        const char* nA = has_next ? (const char*)g.A + (size_t)nxt.pm * tstep : cA; const char* nB = has_next ? (const char*)g.Bt + (size_t)nxt.pn * tstep : cB;
        const int seglen = Epi::HOOK ? 8 : nt;
        for (int t0 = 0; t0 < nt; t0 += seglen) {
        if constexpr (Epi::HOOK) { if (t0 > 0) { int ln_; asm volatile("v_mbcnt_lo_u32_b32 %0, -1, 0\n\tv_mbcnt_hi_u32_b32 %0, -1, %0" : "=v"(ln_)); E.hook(acc, cur, t0 >> 3, wr, wc, ln_ & 15, ln_ >> 4); } }
        for (int t = t0; t < t0 + seglen; t += 2) {
            const bool last = (t == nt - 2);
            if constexpr (Epi::PRELOAD) { if (last) { int ln_; asm volatile("v_mbcnt_lo_u32_b32 %0, -1, 0\n\tv_mbcnt_hi_u32_b32 %0, -1, %0" : "=v"(ln_)); E.preload(pre, cur, wr, wc, ln_ & 15, ln_ >> 4); } }
            const char* a1 = cA + (size_t)(t + 1) * kstep;
            const char* a2 = last ? nA : cA + (size_t)(t + 2) * kstep; const char* b2 = last ? nB : cB + (size_t)(t + 2) * kstep;
            const char* a3 = a2 + kstep; const char* b3 = b2 + kstep;
            PG8_LDB(B0, 0, 0); PG8_LDB(B1, 0, 1); PG8_SCHED; PG8_LDA(At, 0, 0); PG8_STAGE(PG8_SA(1, 1), a1 + hstep, voffA);
            PG8_WAIT_V(8); PG8_WAIT_L(0); PG8_BAR; PG8_MMA(0, 0, At, B0); PG8_MMA(0, 1, At, B1); PG8_BAR; PG8_SCHED;
            PG8_LDA(At, 0, 1); PG8_STAGE(PG8_SB(0, 0), b2, voffB); PG8_STAGE(PG8_SB(0, 1), b2 + hstep, voffB); PG8_STAGE(PG8_SA(0, 0), a2, voffA);
            PG8_WAIT_V(8); PG8_WAIT_L(0); PG8_BAR; PG8_MMA(1, 0, At, B0); PG8_MMA(1, 1, At, B1); PG8_BAR; PG8_SCHED;
            PG8_LDB(B0, 1, 0); PG8_LDB(B1, 1, 1); PG8_SCHED; PG8_LDA(At, 1, 0); PG8_STAGE(PG8_SA(0, 1), a2 + hstep, voffA);
            PG8_WAIT_V(8); PG8_WAIT_L(0); PG8_BAR; PG8_MMA(0, 0, At, B0); PG8_MMA(0, 1, At, B1); PG8_BAR; PG8_SCHED;
            PG8_LDA(At, 1, 1); PG8_STAGE(PG8_SB(1, 0), b3, voffB); PG8_STAGE(PG8_SB(1, 1), b3 + hstep, voffB); PG8_STAGE(PG8_SA(1, 0), a3, voffA);
            PG8_WAIT_V(8); PG8_WAIT_L(0); PG8_BAR; PG8_MMA(1, 0, At, B0); PG8_MMA(1, 1, At, B1); PG8_BAR; PG8_SCHED;
        }
        }
        if constexpr (ALIGN_EPI) { if (wr == 0) PG8_BAR; }
        { int ln_; asm volatile("v_mbcnt_lo_u32_b32 %0, -1, 0\n\tv_mbcnt_hi_u32_b32 %0, -1, %0" : "=v"(ln_));
          if constexpr (Epi::PRELOAD) E(acc, cur, wr, wc, ln_ & 15, ln_ >> 4, pre); else E(acc, cur, wr, wc, ln_ & 15, ln_ >> 4); }
        if (!has_next) break;
#pragma unroll
        for (int a = 0; a < 2; ++a)
#pragma unroll
            for (int b = 0; b < 2; ++b)
#pragma unroll
                for (int m = 0; m < 4; ++m)
#pragma unroll
                    for (int n = 0; n < 2; ++n) acc[a][b][m][n] = (f32x4){0.f, 0.f, 0.f, 0.f};
        cur = nxt; cA = nA; cB = nB; ++ui;
        if constexpr (ALIGN_EPI) { if (wr == 1) PG8_BAR; }
    }
    PG8_WAIT_V(0);
    if constexpr (!ALIGN_EPI) { if (wr == 0) PG8_BAR; }
    PG8_BAR;
#undef PG8_SA
#undef PG8_SB
#undef PG8_STAGE
#undef PG8_LDA
#undef PG8_LDB
#undef PG8_MMA
#undef PG8_WAIT_V
#undef PG8_WAIT_L
#undef PG8_BAR
#undef PG8_SCHED
}
}
constexpr int NWAVES = 8, NT = NWAVES * 64;
constexpr int M = 8192, D = 2048, SEQ = 2048, NBATCH = 4, DEPTH = 2;
constexpr int INW = 13316, NPROJ = 13312, MIXW = 512, HD = 128;
constexpr int PEER_E = 16384;
constexpr float EPS = 1e-6f;
constexpr float ATT_SCALE = 0.08838834764831845f;

constexpr size_t MiB = 1u << 20;
constexpr size_t WS_CTL = 0, CTL_ZERO_BYTES = 1 * MiB;
constexpr size_t WS_SSQ = 0;
constexpr size_t WS_SSA = 256 * 1024;
constexpr size_t WS_WF = 1 * MiB;
constexpr size_t WS_BINR = WS_WF + 64 * 1024;
constexpr size_t WS_LOGF = 2 * MiB;
constexpr size_t WS_CUM = 3 * MiB;
constexpr size_t WS_WIN = 8 * MiB;
constexpr size_t WIN_BYTES = (size_t)NPROJ * D;
constexpr size_t WS_SW = 7 * MiB;
constexpr size_t WS_CMAX = 384 * 1024;
constexpr size_t WS_HB8 = 64 * MiB;
constexpr size_t WS_SA = 7 * MiB + 512 * 1024;
constexpr size_t WS_WBR = 112 * MiB, WS_WOUT = 128 * MiB, WS_WQ = 144 * MiB;
constexpr size_t SQ_BYTES = (size_t)D * D * 2;
constexpr size_t WS_PU = 160 * MiB, WS_PV = 288 * MiB;
constexpr size_t PE_BYTES = (size_t)PEER_E * D;
constexpr size_t WS_PK = 6 * MiB;
constexpr size_t WS_SU = 5 * MiB, WS_SV = 5 * MiB + 256 * 1024;
constexpr size_t WS_HB = 480 * MiB;
constexpr size_t WS_PROJ = 512 * MiB;
constexpr size_t PROJ_T = (size_t)M * MIXW;
constexpr size_t WS_R = 592 * MiB;
constexpr size_t R_PLANE = (size_t)M * D;
constexpr size_t WS_Y = 720 * MiB;
constexpr size_t WS_MRG = 752 * MiB;
constexpr size_t WS_Q = 784 * MiB;
constexpr size_t WS_END = 816 * MiB;

constexpr int RING_BYTES = 131072;
constexpr int LDS_BYTES = 147456;

typedef unsigned short bf16;
typedef unsigned v4u __attribute__((ext_vector_type(4)));
typedef unsigned v2u __attribute__((ext_vector_type(2)));
typedef float f32x4 __attribute__((ext_vector_type(4)));
typedef float f32x2 __attribute__((ext_vector_type(2)));
using bf16x2 = __attribute__((ext_vector_type(2))) __bf16;
#define LAS __attribute__((address_space(3)))

__device__ __forceinline__ unsigned f2bf(float f) { unsigned u = __builtin_bit_cast(unsigned, f); return (u + 0x7fffu + ((u >> 16) & 1u)) >> 16; }
__device__ __forceinline__ unsigned pk2(float lo, float hi) { return f2bf(lo) | (f2bf(hi) << 16); }
__device__ __forceinline__ float bflo(unsigned w) { return __builtin_bit_cast(float, w << 16); }
__device__ __forceinline__ float bfhi(unsigned w) { return __builtin_bit_cast(float, w & 0xffff0000u); }
__device__ __forceinline__ float bf2f(bf16 b) { return __builtin_bit_cast(float, ((unsigned)b) << 16); }
__device__ __forceinline__ float shf(float v, int src) { return __builtin_bit_cast(float, __builtin_amdgcn_ds_bpermute(src << 2, __builtin_bit_cast(int, v))); }
__device__ __forceinline__ int shi(int v, int src) { return __builtin_amdgcn_ds_bpermute(src << 2, v); }
__device__ __forceinline__ float wave_sum(float v, int lane) {
#pragma unroll
    for (int o = 1; o < 64; o <<= 1) v += shf(v, lane ^ o);
    return v;
}
__device__ __forceinline__ float wave_max(float v, int lane) {
#pragma unroll
    for (int o = 1; o < 64; o <<= 1) v = fmaxf(v, shf(v, lane ^ o));
    return v;
}
__device__ __forceinline__ float ssa_to_f(unsigned long long v) { return (float)((double)v * (1.0 / 4294967296.0)); }
__device__ __forceinline__ float dot2_bf16(unsigned w, unsigned x, float acc) { return __builtin_amdgcn_fdot2_f32_bf16(__builtin_bit_cast(bf16x2, w), __builtin_bit_cast(bf16x2, x), acc, false); }

#define LANE_ID(x) asm volatile("v_mbcnt_lo_u32_b32 %0, -1, 0\n\tv_mbcnt_hi_u32_b32 %0, -1, %0" : "=v"(x))
struct Args {
    const float *x, *norm_mix, *w_in, *b_in, *pool_w, *pool_scale, *conv_w, *rel_bias, *w_branch, *w_out, *norm_ffn, *peer_wq, *peer_keys, *peer_u, *peer_v, *norm_final;
    float* out; unsigned char* ws;
};
#define GAS __attribute__((address_space(1)))
#define CAS __attribute__((address_space(4)))
struct ArgsK {
    const GAS float *x, *norm_mix, *w_in, *b_in, *pool_w, *pool_scale, *conv_w, *rel_bias, *w_branch, *w_out, *norm_ffn, *peer_wq, *peer_keys, *peer_u, *peer_v, *norm_final;
    GAS float* out; GAS unsigned char* ws;
};
__device__ __forceinline__ Args load_args(const CAS ArgsK* k, size_t zoff) {
    Args a;
    a.x = (const float*)k->x; a.norm_mix = (const float*)k->norm_mix; a.w_in = (const float*)k->w_in; a.b_in = (const float*)k->b_in; a.pool_w = (const float*)k->pool_w;
    a.pool_scale = (const float*)k->pool_scale; a.conv_w = (const float*)k->conv_w; a.rel_bias = (const float*)k->rel_bias; a.w_branch = (const float*)k->w_branch;
    a.w_out = (const float*)k->w_out; a.norm_ffn = (const float*)k->norm_ffn; a.peer_wq = (const float*)k->peer_wq; a.peer_keys = (const float*)k->peer_keys;
    a.peer_u = (const float*)k->peer_u; a.peer_v = (const float*)k->peer_v; a.norm_final = (const float*)k->norm_final; a.out = (float*)k->out; a.ws = (unsigned char*)(k->ws + zoff);
    return a;
}

using pg8::f32x4; using pg8::Unit;
constexpr size_t WS_G = 896 * MiB;
constexpr size_t WS_SWH = 7 * MiB + 256 * 1024, WS_BIH = 7 * MiB + 384 * 1024;
constexpr size_t WS_RSA = 7 * MiB + 768 * 1024;
struct EpiProj {
    static constexpr bool PERM = true, HOOK = false, PRELOAD = true;
    struct Pre { pg8::u32x4 sw[2], bi[2]; float rs[2][4]; };
    unsigned char* wsb; const bf16* biash; const float* rsa; const bf16* swh;
    __device__ __forceinline__ void preload(Pre& p, const Unit& u, int wr, int wc, int fr, int fq) const {
        const int row0 = u.pm * 256 + wr * 64 + fr, bcol0 = u.pn * 256 + wc * 32 + 8 * fq;
#pragma unroll
        for (int bj = 0; bj < 2; ++bj) { p.sw[bj] = *(const pg8::u32x4*)(swh + bcol0 + bj * 128); p.bi[bj] = *(const pg8::u32x4*)(biash + bcol0 + bj * 128); }
#pragma unroll
        for (int ai = 0; ai < 2; ++ai)
#pragma unroll
            for (int m = 0; m < 4; ++m) p.rs[ai][m] = rsa[row0 + ai * 128 + m * 16];
    }
    static __device__ __forceinline__ unsigned g8(float z) { const float t = __builtin_amdgcn_rcpf(__builtin_amdgcn_exp2f(__builtin_fmaf(z, -1.4426950408889634f, -8.0f)) + 0.00390625f);
        return (unsigned)(__builtin_amdgcn_fmed3f(t, 1.0f, 255.0f) + 0.5f); }
    static __device__ __forceinline__ unsigned g8x4(const f32x4& v) { return g8(v[0]) | (g8(v[1]) << 8) | (g8(v[2]) << 16) | (g8(v[3]) << 24); }
    __device__ __forceinline__ void operator()(f32x4 (&acc)[2][2][4][2], const Unit& u, int wr, int wc, int fr, int fq, const Pre& p) const {
        const int cl0 = wc * 32 + 8 * fq;
#define ACCF(ai, bj, m, n) __builtin_convertvector(__builtin_bit_cast(pg8::i32x4, acc[ai][bj][m][n]), f32x4)
        const __amdgpu_buffer_rsrc_t rW = __builtin_amdgcn_make_buffer_rsrc((void*)wsb, 0, 0x7fffffff, 0x00020000);
        int sbase, ldb, voff;
        if (u.pn < 20) { sbase = (int)WS_PROJ + ((u.pn >> 1) * (int)PROJ_T + (u.pn & 1) * 256) * 2; ldb = MIXW * 2; voff = fr * ldb + cl0 * 2; }
        else { sbase = (int)WS_G + (u.pn - 20) * 256; ldb = 4 * D; voff = fr * ldb + wc * 64 + fq * 16; }
        sbase += (u.pm * 256 + wr * 64) * ldb;
#pragma unroll
        for (int bj = 0; bj < 2; ++bj) { const f32x4 w0 = {bflo(p.sw[bj].x), bfhi(p.sw[bj].x), bflo(p.sw[bj].y), bfhi(p.sw[bj].y)}, w1 = {bflo(p.sw[bj].z), bfhi(p.sw[bj].z), bflo(p.sw[bj].w), bfhi(p.sw[bj].w)};
            const f32x4 b0 = {bflo(p.bi[bj].x), bfhi(p.bi[bj].x), bflo(p.bi[bj].y), bfhi(p.bi[bj].y)}, b1 = {bflo(p.bi[bj].z), bfhi(p.bi[bj].z), bflo(p.bi[bj].w), bfhi(p.bi[bj].w)};
#pragma unroll
            for (int ai = 0; ai < 2; ++ai)
#pragma unroll
                for (int m = 0; m < 4; ++m) { const float rs = p.rs[ai][m]; const f32x4 v0 = ACCF(ai, bj, m, 0) * rs * w0 + b0, v1 = ACCF(ai, bj, m, 1) * rs * w1 + b1;
                    if (u.pn >= 20) { v2u w; w.x = g8x4(v0); w.y = g8x4(v1);
                        __builtin_amdgcn_raw_buffer_store_b64(w, rW, voff + bj * 8, sbase + (ai * 128 + m * 16) * ldb, 0); }
                    else { pg8::u32x4 w; w.x = pg8::cvt_pk_bf16(v0[0], v0[1]); w.y = pg8::cvt_pk_bf16(v0[2], v0[3]); w.z = pg8::cvt_pk_bf16(v1[0], v1[1]); w.w = pg8::cvt_pk_bf16(v1[2], v1[3]);
                        __builtin_amdgcn_raw_buffer_store_b128(w, rW, voff + bj * 256, sbase + (ai * 128 + m * 16) * ldb, 0); } } }
    }
};
#undef ACCF
struct EpiMerge {
    static constexpr bool PERM = true, HOOK = true; static constexpr bool PRELOAD = false; struct Pre {};
    const unsigned char* G; bf16* O;
    struct Bt { pg8::u32x4 n[4], d[4]; };
    __device__ __forceinline__ void scale(f32x4 (&acc)[2][2][4][2], const Unit& u, int g, int wr, int wc, int fr, int fq) const {
        const __amdgpu_buffer_rsrc_t rs = __builtin_amdgcn_make_buffer_rsrc((void*)G, 0, 0x7fffffff, 0x00020000);
        int voff = fr * 4 * D + 16 * fq; asm volatile("" : "+v"(voff));
        const int sden = (u.pm * 256 + wr * 64) * 4 * D + (g - 1) * D + u.pn * 256 + wc * 64, snum = sden + D;
        const bool fin = g == 4;
#define UB(x, e) ((float)(((x) >> (8 * (e))) & 255u))
#define MG_LOAD(B, b0) do { _Pragma("unroll") for (int i = 0; i < 4; ++i) { const int ai_ = ((b0) + i) >> 2, m_ = ((b0) + i) & 3, so_ = (ai_ * 128 + m_ * 16) * 4 * D; \
            B.d[i] = __builtin_amdgcn_raw_buffer_load_b128(rs, voff, sden + so_, 0); if (!fin) B.n[i] = __builtin_amdgcn_raw_buffer_load_b128(rs, voff, snum + so_, 0); } } while (0)
#define MG_APPLY(B, b0) do { _Pragma("unroll") for (int i = 0; i < 4; ++i) { const int ai_ = ((b0) + i) >> 2, m_ = ((b0) + i) & 3; \
            _Pragma("unroll") for (int q = 0; q < 4; ++q) { const unsigned dq = B.d[i][q], nq = B.n[i][q]; \
                f32x4 r = {UB(dq, 0), UB(dq, 1), UB(dq, 2), UB(dq, 3)}; \
                if (!fin) r *= (f32x4){__builtin_amdgcn_rcpf(UB(nq, 0)), __builtin_amdgcn_rcpf(UB(nq, 1)), __builtin_amdgcn_rcpf(UB(nq, 2)), __builtin_amdgcn_rcpf(UB(nq, 3))}; else r *= 0.00390625f; \
                acc[ai_][q >> 1][m_][q & 1] *= r; asm volatile("" : "+v"(acc[ai_][q >> 1][m_][q & 1])); } } } while (0)
        Bt A = {}, B = {};
        MG_LOAD(A, 0); MG_LOAD(B, 4);
        MG_APPLY(A, 0); asm volatile("" ::: "memory");
        MG_APPLY(B, 4); asm volatile("" ::: "memory");
#undef MG_LOAD
#undef MG_APPLY
#undef UB
    }
    __device__ __forceinline__ void hook(f32x4 (&acc)[2][2][4][2], const Unit& u, int g, int wr, int wc, int fr, int fq) const { scale(acc, u, g, wr, wc, fr, fq); }
    __device__ __forceinline__ void operator()(f32x4 (&acc)[2][2][4][2], const Unit& u, int wr, int wc, int fr, int fq) const {
        scale(acc, u, 4, wr, wc, fr, fq);
        const int row0 = u.pm * 256 + wr * 64 + fr, col0 = u.pn * 256 + wc * 32 + 8 * fq;
#pragma unroll
        for (int ai = 0; ai < 2; ++ai)
#pragma unroll
            for (int m = 0; m < 4; ++m) { bf16* rowp = O + (size_t)(row0 + ai * 128 + m * 16) * D + col0;
#pragma unroll
                for (int bj = 0; bj < 2; ++bj) { const f32x4 v0 = acc[ai][bj][m][0], v1 = acc[ai][bj][m][1];
                    pg8::u32x4 w; w.x = pg8::cvt_pk_bf16(v0[0], v0[1]); w.y = pg8::cvt_pk_bf16(v0[2], v0[3]); w.z = pg8::cvt_pk_bf16(v1[0], v1[1]); w.w = pg8::cvt_pk_bf16(v1[2], v1[3]);
                    *(pg8::u32x4*)(rowp + bj * 128) = w; } }
    }
};
struct EpiRes {
    static constexpr bool PERM = true, HOOK = false; static constexpr bool PRELOAD = false; struct Pre {};
    const float* X; bf16* HB; unsigned long long* ssa;
    __device__ __forceinline__ void operator()(f32x4 (&acc)[2][2][4][2], const Unit& u, int wr, int wc, int fr, int fq) const {
        const int row0 = u.pm * 256 + wr * 64 + fr, col0 = u.pn * 256 + wc * 32 + 8 * fq;
#pragma unroll
        for (int ai = 0; ai < 2; ++ai)
#pragma unroll
            for (int m = 0; m < 4; ++m) { const int row = row0 + ai * 128 + m * 16; const size_t off = (size_t)row * D + col0; float s = 0.f;
#pragma unroll
                for (int bj = 0; bj < 2; ++bj) { const size_t o = off + bj * 128; f32x4 h0, h1;
                    if (X != nullptr) { h0 = *(const f32x4*)(X + o); h1 = *(const f32x4*)(X + o + 4); }
                    else { const pg8::u32x4 w = *(const pg8::u32x4*)(HB + o); h0 = (f32x4){bflo(w.x), bfhi(w.x), bflo(w.y), bfhi(w.y)}; h1 = (f32x4){bflo(w.z), bfhi(w.z), bflo(w.w), bfhi(w.w)}; }
                    h0 += acc[ai][bj][m][0]; h1 += acc[ai][bj][m][1];
                    pg8::u32x4 w; w.x = pg8::cvt_pk_bf16(h0[0], h0[1]); w.y = pg8::cvt_pk_bf16(h0[2], h0[3]); w.z = pg8::cvt_pk_bf16(h1[0], h1[1]); w.w = pg8::cvt_pk_bf16(h1[2], h1[3]);
                    *(pg8::u32x4*)(HB + o) = w;
                    s += ((h0[0] * h0[0] + h0[1] * h0[1]) + (h0[2] * h0[2] + h0[3] * h0[3])) + ((h1[0] * h1[0] + h1[1] * h1[1]) + (h1[2] * h1[2] + h1[3] * h1[3])); }
                { const int ln = fq * 16 + fr; s += shf(s, ln ^ 16); s += shf(s, ln ^ 32); }
                if (fq == 0) atomicAdd(ssa + row, (unsigned long long)((double)s * 4294967296.0)); }
    }
};
struct EpiQ {
    static constexpr bool PERM = true, HOOK = false; static constexpr bool PRELOAD = false; struct Pre {};
    bf16* O; const unsigned long long* ssa;
    __device__ __forceinline__ void operator()(f32x4 (&acc)[2][2][4][2], const Unit& u, int wr, int wc, int fr, int fq) const {
        const int row0 = u.pm * 256 + wr * 64 + fr, col0 = u.pn * 256 + wc * 32 + 8 * fq;
#pragma unroll
        for (int ai = 0; ai < 2; ++ai)
#pragma unroll
            for (int m = 0; m < 4; ++m) { const int row = row0 + ai * 128 + m * 16; const float rs = rsqrtf(ssa_to_f(ssa[row]) * (1.0f / D) + EPS);
                bf16* rowp = O + (size_t)row * D + col0;
#pragma unroll
                for (int bj = 0; bj < 2; ++bj) { const f32x4 v0 = acc[ai][bj][m][0] * rs, v1 = acc[ai][bj][m][1] * rs;
                    pg8::u32x4 w; w.x = pg8::cvt_pk_bf16(v0[0], v0[1]); w.y = pg8::cvt_pk_bf16(v0[2], v0[3]); w.z = pg8::cvt_pk_bf16(v1[0], v1[1]); w.w = pg8::cvt_pk_bf16(v1[2], v1[3]);
                    *(pg8::u32x4*)(rowp + bj * 128) = w; } }
    }
};

__device__ __forceinline__ int colmap_in(int j) { return j < 1536 ? j : j + 4; }
__device__ __forceinline__ void tr_item_i8(const float* W, const float* gain, const unsigned* cmax, unsigned char* WT, LAS float* scr, int k0, int n0, int lane) {
    const int q = lane & 7, r8 = lane >> 3, sc = colmap_in(n0 + 4 * q);
    f32x4 v[8];
#pragma unroll
    for (int i = 0; i < 8; ++i) v[i] = *(const f32x4*)(W + (size_t)(k0 + 8 * i + r8) * INW + sc);
    f32x4 inv;
#pragma unroll
    for (int e = 0; e < 4; ++e) { const float cm = __builtin_bit_cast(float, cmax[sc + e]); inv[e] = cm > 0.f ? 127.0f / cm : 0.f; }
#pragma unroll
    for (int i = 0; i < 8; ++i) { const float g = gain[k0 + 8 * i + r8];
#pragma unroll
        for (int e = 0; e < 4; ++e) scr[(8 * i + r8) * 33 + 4 * q + e] = v[i][e] * g * inv[e]; }
    asm volatile("s_waitcnt lgkmcnt(0)" ::: "memory");
    const int n = lane >> 1, hf = lane & 1;
    v4u o[2];
#pragma unroll
    for (int w = 0; w < 8; ++w) { unsigned pk = 0;
#pragma unroll
        for (int b = 0; b < 4; ++b) pk |= ((unsigned)((int)rintf(scr[(32 * hf + 4 * w + b) * 33 + n]) & 255)) << (8 * b);
        o[w >> 2][w & 3] = pk; }
    unsigned char* dst = WT + (size_t)(n0 + n) * D + k0 + 32 * hf;
    *(v4u*)dst = o[0]; *(v4u*)(dst + 16) = o[1];
    asm volatile("s_waitcnt lgkmcnt(0)" ::: "memory");
}
template <bool MAP>
__device__ __forceinline__ void tr_item(const float* W, int ldw, const float* scale, bf16* WT, int ldt, int dcol0, LAS float* scr, int k0, int n0, int lane) {
    const int q = lane & 7, r8 = lane >> 3, sc = MAP ? colmap_in(n0 + 4 * q) : (n0 + 4 * q);
    f32x4 v[8];
#pragma unroll
    for (int i = 0; i < 8; ++i) v[i] = *(const f32x4*)(W + (size_t)(k0 + 8 * i + r8) * ldw + sc);
    f32x4 s0 = {1.f, 1.f, 1.f, 1.f}, s1 = s0;
    if (scale) { s0 = *(const f32x4*)(scale + k0 + 8 * q); s1 = *(const f32x4*)(scale + k0 + 8 * q + 4); }
#pragma unroll
    for (int i = 0; i < 8; ++i)
#pragma unroll
        for (int e = 0; e < 4; ++e) scr[(8 * i + r8) * 33 + 4 * q + e] = v[i][e];
    asm volatile("s_waitcnt lgkmcnt(0)" ::: "memory");
    const int c = q;
#pragma unroll
    for (int j = 0; j < 4; ++j) { const int n = r8 + 8 * j; const LAS float* s = scr + (8 * c) * 33 + n;
        v4u o; o.x = pk2(s[0 * 33] * s0[0], s[1 * 33] * s0[1]); o.y = pk2(s[2 * 33] * s0[2], s[3 * 33] * s0[3]); o.z = pk2(s[4 * 33] * s1[0], s[5 * 33] * s1[1]); o.w = pk2(s[6 * 33] * s1[2], s[7 * 33] * s1[3]);
        *(v4u*)(WT + (size_t)(n0 + n) * ldt + dcol0 + k0 + 8 * c) = o; }
    asm volatile("s_waitcnt lgkmcnt(0)" ::: "memory");
}
constexpr size_t WS_BAR = 512 * 1024;
#define XB_TMO      128
#define XB_XCNT(j)  (256  + 64 * (j))
#define XB_XSUB(j)  (1280 + 64 * (j))
#define XB_XGEN(j)  (2304 + 64 * (j))
#define XB_TOP      3328
#define XB_TOPGEN   3392
#define XCD_BAR_WORDS 3456
#define XB_SPIN_CAP (1u << 23)
__device__ __forceinline__ unsigned xb_ld(unsigned* p)              { return __hip_atomic_load(p, __ATOMIC_RELAXED, __HIP_MEMORY_SCOPE_AGENT); }
__device__ __forceinline__ unsigned xb_add(unsigned* p, unsigned v) { return __hip_atomic_fetch_add(p, v, __ATOMIC_RELAXED, __HIP_MEMORY_SCOPE_AGENT); }
__device__ __forceinline__ unsigned xb_xcc_id() { return (unsigned)__builtin_amdgcn_s_getreg((3 << 11) | 20) & 0xFu; }
#define XB_SPIN(cond, bar) do { unsigned _sp = 0; while (cond) { __builtin_amdgcn_s_sleep(1); \
    if ((++_sp & 255u) == 0u) { if (xb_ld(&(bar)[XB_TMO])) break; if (_sp > XB_SPIN_CAP) { atomicAdd(&(bar)[XB_TMO], 1u); break; } } } } while (0)
__device__ __forceinline__ void xcd_barrier_complete(unsigned* bar, unsigned x, unsigned G, unsigned& nloc, unsigned& nx) {
    unsigned sum, cnt, mine, sp = 0u;
    for (;;) {
        sum = 0u; cnt = 0u; mine = 0u;
#pragma unroll
        for (unsigned j = 0; j < 16; ++j) { const unsigned c = xb_ld(&bar[XB_XCNT(j)]); sum += c; cnt += (c > 0u) ? 1u : 0u; mine = (j == x) ? c : mine; }
        if (sum == G) break;
        __builtin_amdgcn_s_sleep(1);
        if ((++sp & 255u) == 0u) { if (xb_ld(&bar[XB_TMO])) break; if (sp > XB_SPIN_CAP) { atomicAdd(&bar[XB_TMO], 1u); break; } }
    }
    nloc = mine > 0u ? mine : 1u; nx = cnt > 0u ? cnt : 1u;
}
__device__ __forceinline__ void xcd_barrier(unsigned* bar, unsigned x, unsigned G, volatile LAS unsigned* st, int wave) {
    asm volatile("s_waitcnt vmcnt(0)" ::: "memory");
    __syncthreads();
    int lane; asm volatile("v_mbcnt_lo_u32_b32 %0, -1, 0\n\tv_mbcnt_hi_u32_b32 %0, -1, %0" : "=v"(lane));
    if (wave == 0 && lane == 0) {
        __builtin_amdgcn_s_waitcnt(0);
        unsigned nloc = st[0], nx = st[1];
        if (nloc == 0u) { xcd_barrier_complete(bar, x, G, nloc, nx); st[0] = nloc; st[1] = nx; }
        const unsigned old = xb_add(&bar[XB_XSUB(x)], 1u);
        const unsigned gen = old / nloc;
        if (old + 1u == (gen + 1u) * nloc) {
            __builtin_amdgcn_fence(__ATOMIC_RELEASE, "agent");
            asm volatile("s_waitcnt vmcnt(0)" ::: "memory");
            const unsigned og = xb_add(&bar[XB_TOP], 1u);
            const unsigned tg = og / nx;
            if (og + 1u == (tg + 1u) * nx) xb_add(&bar[XB_TOPGEN], 1u);
            else XB_SPIN(xb_ld(&bar[XB_TOPGEN]) == tg, bar);
            __builtin_amdgcn_fence(__ATOMIC_ACQUIRE, "agent");
            xb_add(&bar[XB_XGEN(x)], 1u);
            asm volatile("s_waitcnt vmcnt(0)" ::: "memory");
        } else {
            XB_SPIN(xb_ld(&bar[XB_XGEN(x)]) == gen, bar);
            __builtin_amdgcn_fence(__ATOMIC_ACQUIRE, "agent");
            asm volatile("s_waitcnt vmcnt(0)" ::: "memory");
        }
    }
    __syncthreads();
}
namespace att {
constexpr int D = 128, NW = 8, QBLK = 32, KVBLK = 64, QB = NW * QBLK;
constexpr int PITCH = 512, OPITCH = 2048;
constexpr float SCALE = 0.08838834764831845f, THR = 8.f;
constexpr int SHM_V = KVBLK * D * 2, SHM_K = KVBLK * D * 2;
constexpr int OFF_WS = 2 * SHM_V + 2 * SHM_K, OFF_CUM = OFF_WS + NW * 64 * 4, OFF_REL = OFF_CUM + 2048 * 4, LDS_END = OFF_REL + 320 * 4;
typedef unsigned short bf16;
typedef short bf16x8 __attribute__((ext_vector_type(8)));
typedef short s16x4 __attribute__((ext_vector_type(4)));
typedef float f32x16 __attribute__((ext_vector_type(16)));
typedef float f32x4 __attribute__((ext_vector_type(4)));
typedef unsigned u32x4 __attribute__((ext_vector_type(4)));
#define ALDS __attribute__((address_space(3)))

#define KSWZ(row, colB) ((row) * 256 + ((colB) ^ (((row) & 7) << 4)))
#define SBAR() __builtin_amdgcn_sched_barrier(0)
__device__ __forceinline__ int v_st(int k, int c) { const int kk = (k & ~0xC) | ((k & 4) << 1) | ((k & 8) >> 1); return ((kk >> 3) * 4 + (c >> 5)) * 512 + ((kk & 7) * 32 + (c & 31)) * 2; }
__device__ __forceinline__ int v_rd_base(int lane) { return ((lane & 3) << 3) | (((lane >> 2) & 3) << 6) | (((lane >> 4) & 1) << 5) | (((lane >> 5) & 1) << 8); }
constexpr int v_rd_off(int d0, int ks, int half) { return d0 * 512 + ks * 4096 + half * 2048; }
__device__ __forceinline__ int crow(int r, int hi) { return (r & 3) + 8 * (r >> 2) + 4 * hi; }
__device__ __forceinline__ unsigned cvtpk(float lo, float hi) { unsigned r; asm volatile("v_cvt_pk_bf16_f32 %0, %1, %2" : "=v"(r) : "v"(lo), "v"(hi)); return r; }
__device__ __forceinline__ bf16x8 load8(const bf16* p) { return *reinterpret_cast<const bf16x8*>(p); }

__device__ __forceinline__ void mask_tile(f32x16& p0, f32x16& p1, int dq) {
    const float NEG = -__builtin_inff();
#pragma unroll
    for (int r = 0; r < 16; ++r) { const int c = (r & 3) + 8 * (r >> 2);
        if (dq - c < 0) p0[r] = NEG;
        if (dq - c - 32 < 0) p1[r] = NEG; }
}
__device__ __forceinline__ void partialSM(f32x16& p0, f32x16& p1, float& m_reg, float& mn, float& alpha) {
    float pmax = p0[0];
#pragma unroll
    for (int r = 1; r < 16; ++r) pmax = fmaxf(pmax, p0[r]);
#pragma unroll
    for (int r = 0; r < 16; ++r) pmax = fmaxf(pmax, p1[r]);
    { auto rr = __builtin_amdgcn_permlane32_swap(__float_as_uint(pmax), __float_as_uint(pmax), false, false);
      pmax = fmaxf(__uint_as_float(rr[0]), __uint_as_float(rr[1])); }
    constexpr float C2 = 1.4426950408889634f * SCALE;
    if (__builtin_expect(__all((pmax - m_reg) * SCALE <= THR), 1)) { mn = m_reg; alpha = 1.f; }
    else { mn = fmaxf(m_reg, pmax); alpha = __builtin_amdgcn_exp2f((m_reg - mn) * C2); m_reg = mn; }
    const float mnL = -mn * C2;
#pragma unroll
    for (int r = 0; r < 16; ++r) p0[r] = fmaf(p0[r], C2, mnL);
#pragma unroll
    for (int r = 0; r < 16; ++r) p1[r] = fmaf(p1[r], C2, mnL);
#pragma unroll
    for (int r = 0; r < 16; ++r) p0[r] = __builtin_amdgcn_exp2f(p0[r]);
}
__device__ __forceinline__ void finishSM(f32x16& p0, f32x16& p1, float alpha, float& l_reg, bf16x8& pa0, bf16x8& pa1, bf16x8& pa2, bf16x8& pa3) {
#pragma unroll
    for (int r = 0; r < 16; ++r) p1[r] = __builtin_amdgcn_exp2f(p1[r]);
    float ps = 0;
#pragma unroll
    for (int r = 0; r < 16; ++r) ps += p0[r];
#pragma unroll
    for (int r = 0; r < 16; ++r) ps += p1[r];
    { auto rr = __builtin_amdgcn_permlane32_swap(__float_as_uint(ps), __float_as_uint(ps), false, false);
      ps = __uint_as_float(rr[0]) + __uint_as_float(rr[1]); }
    l_reg = l_reg * alpha + ps;
#define PK4(P, B_, OUT) do { unsigned a0 = cvtpk(P[B_+0], P[B_+1]), a1 = cvtpk(P[B_+2], P[B_+3]);                          \
        unsigned b0 = cvtpk(P[B_+4], P[B_+5]), b1 = cvtpk(P[B_+6], P[B_+7]);                                             \
        auto r0 = __builtin_amdgcn_permlane32_swap(a0, b0, false, false); auto r1 = __builtin_amdgcn_permlane32_swap(a1, b1, false, false); \
        u32x4 w = {r0[0], r1[0], r0[1], r1[1]}; OUT = *reinterpret_cast<bf16x8*>(&w); } while (0)
    PK4(p0, 0, pa0); PK4(p0, 8, pa1); PK4(p1, 0, pa2); PK4(p1, 8, pa3);
#undef PK4
}
template <int KB>
__device__ __forceinline__ void qkt(f32x16& p0, f32x16& p1, const ALDS char* K_lds, int r32, int hi, const bf16x8* qr, bool act) {
    if (!act) { const float NEG = -__builtin_inff();
#pragma unroll
        for (int r = 0; r < 16; ++r) { p0[r] = NEG; p1[r] = NEG; } return; }
    p0 = f32x16{}; p1 = f32x16{};
    const ALDS char* kb[4];
#pragma unroll
    for (int dd = 0; dd < 4; ++dd) kb[dd] = K_lds + KB * SHM_K + KSWZ(r32, (dd * 16 + hi * 8) * 2);
#pragma unroll
    for (int d0 = 0; d0 < 8; ++d0) { const ALDS char* a = kb[d0 & 3] + (d0 >> 2) * 128;
        bf16x8 b0 = *(const ALDS bf16x8*)(a);
        bf16x8 b1 = *(const ALDS bf16x8*)(a + 32 * 256);
        p0 = __builtin_amdgcn_mfma_f32_32x32x16_bf16(b0, qr[d0], p0, 0, 0, 0);
        p1 = __builtin_amdgcn_mfma_f32_32x32x16_bf16(b1, qr[d0], p1, 0, 0, 0); }
}
template <int VB>
__device__ __forceinline__ void pv_tile(f32x16* o, int vb0, bf16x8 pa0, bf16x8 pa1, bf16x8 pa2, bf16x8 pa3, bool act) {
    if (!act) return;
#define TRRD(dst, off) asm volatile("ds_read_b64_tr_b16 %0, %1 offset:%2" : "=&v"(dst) : "v"(vb0), "i"(off) : "memory")
#define PV_D0(d0) do { s16x4 l0, l1, l2, l3, h0, h1, h2, h3; constexpr int b_ = VB * SHM_V + v_rd_off(d0, 0, 0); \
        TRRD(l0, b_); TRRD(h0, b_ + 2048); TRRD(l1, b_ + 4096); TRRD(h1, b_ + 6144); TRRD(l2, b_ + 8192); TRRD(h2, b_ + 10240); TRRD(l3, b_ + 12288); TRRD(h3, b_ + 14336); \
        asm volatile("s_waitcnt lgkmcnt(0)" ::: "memory"); SBAR(); \
        o[d0] = __builtin_amdgcn_mfma_f32_32x32x16_bf16(pa0, (bf16x8){l0[0], l0[1], l0[2], l0[3], h0[0], h0[1], h0[2], h0[3]}, o[d0], 0, 0, 0);   \
        o[d0] = __builtin_amdgcn_mfma_f32_32x32x16_bf16(pa1, (bf16x8){l1[0], l1[1], l1[2], l1[3], h1[0], h1[1], h1[2], h1[3]}, o[d0], 0, 0, 0);   \
        o[d0] = __builtin_amdgcn_mfma_f32_32x32x16_bf16(pa2, (bf16x8){l2[0], l2[1], l2[2], l2[3], h2[0], h2[1], h2[2], h2[3]}, o[d0], 0, 0, 0);   \
        o[d0] = __builtin_amdgcn_mfma_f32_32x32x16_bf16(pa3, (bf16x8){l3[0], l3[1], l3[2], l3[3], h3[0], h3[1], h3[2], h3[3]}, o[d0], 0, 0, 0); } while (0)
    PV_D0(0); PV_D0(1); PV_D0(2); PV_D0(3);
#undef PV_D0
#undef TRRD
}
template <int MODE>
__device__ __forceinline__ void bias_mask(f32x16& p0, f32x16& p1, const ALDS char* lds, int kb, int qlo, int qpos, int hi, float cqs, bool act) {
    if (!act) return;
    if (MODE == 0) {
        const ALDS float* cs = (const ALDS float*)(lds + OFF_CUM) + kb + 4 * hi;
#pragma unroll
        for (int g = 0; g < 4; ++g) { const f32x4 c0 = *(const ALDS f32x4*)(cs + 8 * g), c1 = *(const ALDS f32x4*)(cs + 32 + 8 * g);
#pragma unroll
            for (int e = 0; e < 4; ++e) { p0[4 * g + e] += cqs - c0[e]; p1[4 * g + e] += cqs - c1[e]; } }
        if (kb + KVBLK - 1 > qlo) mask_tile(p0, p1, qpos - 4 * hi - kb);
    } else {
        const ALDS float* tb = (const ALDS float*)(lds + OFF_REL);
        if (qlo - (kb + KVBLK - 1) >= 256) { const float c = tb[319];
#pragma unroll
            for (int r = 0; r < 16; ++r) { p0[r] += c; p1[r] += c; } }
        else { const int d0 = qpos - kb - 4 * hi + 63;
#pragma unroll
            for (int r = 0; r < 16; ++r) { const int c = (r & 3) + 8 * (r >> 2);
                int i0 = d0 - c, i1 = d0 - c - 32; i0 = i0 > 319 ? 319 : i0; i1 = i1 > 319 ? 319 : i1; i1 = i1 < 0 ? 0 : i1; i0 = i0 < 0 ? 0 : i0;
                p0[r] += tb[i0]; p1[r] += tb[i1]; } }
    }
}

struct Seam { bf16x8 qr[8]; bf16x8 st_v0, st_v1, st_k0, st_k1; };
#define VMW() asm volatile("s_waitcnt vmcnt(0)" ::: "memory")
#define BL8(rs, vo, so) __builtin_bit_cast(bf16x8, __builtin_amdgcn_raw_buffer_load_b128(rs, vo, so, 0))
#define SLOAD_H(Kp, Vp, k0) do { S.st_v0 = BL8(rP, kvoff, (Vp) + (k0) * (PITCH * 2)); S.st_v1 = BL8(rP, kvoff, (Vp) + ((k0) + 32) * (PITCH * 2));              \
                         S.st_k0 = BL8(rP, kvoff, (Kp) + (k0) * (PITCH * 2)); S.st_k1 = BL8(rP, kvoff, (Kp) + ((k0) + 32) * (PITCH * 2)); } while (0)
#define SWRITE_HK(bf) do { *(ALDS bf16x8*)(K_lds + (bf) * SHM_K + kws) = S.st_k0; *(ALDS bf16x8*)(K_lds + (bf) * SHM_K + kws + 32 * 256) = S.st_k1; } while (0)
#define SWRITE_HV(bf) do { *(ALDS bf16x8*)(V_lds + (bf) * SHM_V + vst0) = S.st_v0; *(ALDS bf16x8*)(V_lds + (bf) * SHM_V + vst1) = S.st_v1; } while (0)
#define SWRITE_H(bf) do { SWRITE_HV(bf); SWRITE_HK(bf); } while (0)

template <int MODE>
__device__ __forceinline__ void attn_unit(const bf16* Pb, int Qo, int Kh, int Vh, bf16* Yb, int Oo, int P0, int j_lo, int j_hi, ALDS char* lds, int wid, int lane) {
    const int tid = wid * 64 + lane, r32 = lane & 31, hi = lane >> 5;
    const int NT = j_hi - j_lo;
    const int qlo = P0 + wid * QBLK, qpos = qlo + r32;
    ALDS char* V_lds = lds; ALDS char* K_lds = lds + 2 * SHM_V;
    ALDS float* ws = (ALDS float*)(lds + OFF_WS) + wid * 64; ALDS float* li_l = ws; ALDS float* al_l = ws + 32;
    float m_reg = -1e30f, l_reg = 0; f32x16 o[4] = {};
    const int sr = tid >> 4, sc = (tid & 15) * 8, vst0 = v_st(sr, sc), vst1 = v_st(32 + sr, sc), kws = KSWZ(sr, sc * 2);
    const int vb0 = (int)(unsigned)(size_t)V_lds + v_rd_base(lane);
    Seam S;
    const __amdgpu_buffer_rsrc_t rP = __builtin_amdgcn_make_buffer_rsrc((void*)Pb, 0, 0x7fffffff, 0x00020000);
    const __amdgpu_buffer_rsrc_t rO = __builtin_amdgcn_make_buffer_rsrc((void*)Yb, 0, 0x7fffffff, 0x00020000);
    const int kvoff = (sr * PITCH + sc) * 2;
#define KBASE(t) ((j_lo + (t)) * KVBLK)
#define ACT(t) (MODE == 0 ? (KBASE(t) <= qlo + QBLK - 1) : ((j_lo + (t)) <= (qlo >> 6) && (j_lo + (t)) + 8 >= (qlo >> 6)))
#define RESC(a) do { if (__any((a) < 1.f)) { if (hi == 0) al_l[r32] = (a); asm volatile("s_waitcnt lgkmcnt(0)" ::: "memory");              \
                     for (int d_ = 0; d_ < 4; ++d_) for (int r = 0; r < 16; ++r) o[d_][r] *= al_l[crow(r, hi)]; } } while (0)
#define MASKT(P0_, P1_, t) bias_mask<MODE>(P0_, P1_, lds, KBASE(t), qlo, qpos, hi, cq_, ACT(t))
    {
        const int kb0 = j_lo * KVBLK;
#pragma unroll
        for (int d0 = 0; d0 < 8; ++d0) S.qr[d0] = BL8(rP, (r32 * PITCH + hi * 8) * 2 + d0 * 32, Qo + wid * (QBLK * PITCH * 2));
        SLOAD_H(Kh, Vh, kb0); VMW(); SWRITE_HK(0);
        __syncthreads();
    }
    const float cq_ = MODE == 0 ? ((const ALDS float*)(lds + OFF_CUM))[qpos] : 0.f;
    f32x16 pA0, pA1, pB0, pB1; float mnA, mnB, alA, alB; bf16x8 pa0, pa1, pa2, pa3;
    SWRITE_HV(0); SBAR();
    if (NT > 1) { SLOAD_H(Kh, Vh, KBASE(1)); }
    SBAR(); qkt<0>(pA0, pA1, K_lds, r32, hi, S.qr, ACT(0));
    MASKT(pA0, pA1, 0); partialSM(pA0, pA1, m_reg, mnA, alA);
    if (NT > 1) { VMW(); SWRITE_H(1); }
    __syncthreads();
#define HALF_STEP(PX0, PX1, mnX, alX, PY0, PY1, alY, t, KB, VB, SB) do {                                                      \
        SBAR(); qkt<KB>(PX0, PX1, K_lds, r32, hi, S.qr, ACT(t));                                                              \
        finishSM(PY0, PY1, alY, l_reg, pa0, pa1, pa2, pa3); SBAR();                                                           \
        if ((t) + 1 < NT) { SLOAD_H(Kh, Vh, KBASE((t) + 1)); SBAR(); }                                                        \
        pv_tile<VB>(o, vb0, pa0, pa1, pa2, pa3, ACT((t) - 1)); MASKT(PX0, PX1, (t)); partialSM(PX0, PX1, m_reg, mnX, alX);    \
        __syncthreads();                                                                                                      \
        if ((t) + 1 < NT) { VMW(); SWRITE_H(SB); }                                                                            \
        RESC(alX); __syncthreads(); } while (0)
    for (int t = 1; t + 1 < NT; t += 2) {
        HALF_STEP(pB0, pB1, mnB, alB, pA0, pA1, alA, t, 1, 0, 0);
        HALF_STEP(pA0, pA1, mnA, alA, pB0, pB1, alB, t + 1, 0, 1, 1);
    }
    const bool even = (NT & 1) == 0;
    if (even) { SBAR(); qkt<1>(pB0, pB1, K_lds, r32, hi, S.qr, ACT(NT - 1)); SBAR(); }
    finishSM(pA0, pA1, alA, l_reg, pa0, pa1, pa2, pa3); SBAR();
    pv_tile<0>(o, vb0, pa0, pa1, pa2, pa3, ACT(even ? NT - 2 : NT - 1));
    if (even) { MASKT(pB0, pB1, NT - 1); partialSM(pB0, pB1, m_reg, mnB, alB); __syncthreads(); RESC(alB);
        finishSM(pB0, pB1, alB, l_reg, pa0, pa1, pa2, pa3); SBAR(); pv_tile<1>(o, vb0, pa0, pa1, pa2, pa3, ACT(NT - 1)); }
    SBAR();
    if (hi == 0) li_l[r32] = l_reg; asm volatile("s_waitcnt lgkmcnt(0)" ::: "memory");
    float rli[16];
#pragma unroll
    for (int r = 0; r < 16; ++r) rli[r] = __builtin_amdgcn_rcpf(li_l[crow(r, hi)]);
    const int ovoff = (4 * hi * OPITCH + r32) * 2, osoff = Oo + wid * (QBLK * OPITCH * 2);
#pragma unroll
    for (int r = 0; r < 16; ++r) { const int orow = (r & 3) + 8 * (r >> 2);
#pragma unroll
        for (int d0 = 0; d0 < 4; ++d0) { const float v = o[d0][r] * rli[r];
            const float vn = __builtin_bit_cast(float, __builtin_amdgcn_ds_bpermute((lane ^ 1) << 2, __builtin_bit_cast(int, v)));
            if ((r32 & 1) == 0) __builtin_amdgcn_raw_buffer_store_b32(cvtpk(v, vn), rO, ovoff + d0 * 64, osoff + orow * (OPITCH * 2), 0); } }
    __syncthreads();
#undef RESC
#undef KBASE
#undef ACT
#undef MASKT
#undef HALF_STEP
}
#undef BL8
#undef VMW
#undef SLOAD_H
#undef SWRITE_HK
#undef SWRITE_HV
#undef SWRITE_H
#undef KSWZ
#undef SBAR
}
constexpr size_t WS_QCTR = 768 * 1024;
constexpr size_t WS_POOLW = 4 * MiB;
constexpr int N_ATT_UNITS = 256, N_POOL_UNITS = 512, N_CONV_UNITS = 128;

__device__ __forceinline__ void stage_cum(const Args& a, int b, int h, LAS char* lds, int wave, int lane) {
    const float* logf = (const float*)(a.ws + WS_LOGF) + ((size_t)b * SEQ) * 4 + h;
    const int tid = wave * 64 + lane;
    float v[4];
#pragma unroll
    for (int e = 0; e < 4; ++e) v[e] = logf[(size_t)(4 * tid + e) * 4];
    v[1] += v[0]; v[2] += v[1]; v[3] += v[2];
    float incl = v[3];
#pragma unroll
    for (int o = 1; o < 64; o <<= 1) { const float t = shf(incl, lane >= o ? lane - o : lane); if (lane >= o) incl += t; }
    LAS float* wt = (LAS float*)(lds + att::OFF_WS);
    if (lane == 63) wt[wave] = incl;
    __syncthreads();
    float base = incl - v[3];
    for (int w = 0; w < wave; ++w) base += wt[w];
    LAS float* cs = (LAS float*)(lds + att::OFF_CUM);
    const float inv = 1.0f / ATT_SCALE;
    *(LAS f32x4*)(cs + 4 * tid) = (f32x4){(base + v[0]) * inv, (base + v[1]) * inv, (base + v[2]) * inv, (base + v[3]) * inv};
    __syncthreads();
}
__device__ __forceinline__ void attention_item(const Args& a, int l, int u, LAS char* lds, int wave) {
    int lane; asm volatile("v_mbcnt_lo_u32_b32 %0, -1, 0\n\tv_mbcnt_hi_u32_b32 %0, -1, %0" : "=v"(lane));
    const bf16* P = (const bf16*)(a.ws + WS_PROJ); bf16* Y = (bf16*)(a.ws + WS_Y);
    const int mode = u >> 7, v = u & 127, qb = 7 - (v >> 4), bh = v & 15, b = bh >> 2, h = bh & 3;
    const size_t row0 = (size_t)b * SEQ; const int P0 = qb * 256;
    if (mode == 0) {
        stage_cum(a, b, h, lds, wave, lane);
        att::attn_unit<0>(P, (int)((0 * PROJ_T + (row0 + P0) * MIXW + h * HD) * 2), (int)((1 * PROJ_T + row0 * MIXW + h * HD) * 2), (int)((2 * PROJ_T + row0 * MIXW + h * HD) * 2),
                          Y, (int)(((row0 + P0) * D + h * HD) * 2), P0, 0, 4 * qb + 4, lds, wave, lane);
    } else {
        const int tid = wave * 64 + lane;
        if (tid < 320) ((LAS float*)(lds + att::OFF_REL))[tid] = a.rel_bias[((size_t)l * 4 + h) * 320 + tid] * (1.0f / ATT_SCALE);
        const int jlo = 4 * qb - 8 < 0 ? 0 : 4 * qb - 8;
        att::attn_unit<1>(P, (int)((7 * PROJ_T + (row0 + P0) * MIXW + h * HD) * 2), (int)((8 * PROJ_T + row0 * MIXW + h * HD) * 2), (int)((9 * PROJ_T + row0 * MIXW + h * HD) * 2),
                          Y, (int)(((row0 + P0) * D + 1536 + h * HD) * 2), P0, jlo, 4 * qb + 4, lds, wave, lane);
    }
}
__device__ __forceinline__ void pool_item(const Args& a, int l, int u, LAS char* lds, int wave) {
    int lane; asm volatile("v_mbcnt_lo_u32_b32 %0, -1, 0\n\tv_mbcnt_hi_u32_b32 %0, -1, %0" : "=v"(lane));
    const int g = u & 3, T0 = (u >> 2) * 64, tid = wave * 64 + lane;
    const bf16* Pin = (const bf16*)(a.ws + WS_PROJ) + 3 * PROJ_T + g * 128;
    {
        const int cp = tid & 63, run = tid >> 6, w = 2 << g, t0 = T0 + run * 8, s0 = t0 & (SEQ - 1);
        const bf16* col = Pin + 2 * cp;
        float s_lo = 0.f, s_hi = 0.f;
        for (int j = 1; j < w; ++j) if (s0 - j >= 0) { const unsigned x = *(const unsigned*)(col + (size_t)(t0 - j) * MIXW); s_lo += bflo(x); s_hi += bfhi(x); }
#pragma unroll
        for (int i = 0; i < 8; ++i) { const unsigned x = *(const unsigned*)(col + (size_t)(t0 + i) * MIXW); s_lo += bflo(x); s_hi += bfhi(x);
            const int s = s0 + i; const int cnt = s + 1 < w ? s + 1 : w; const float inv = 1.0f / (float)cnt;
            *(LAS unsigned*)(lds + (run * 8 + i) * 272 + 4 * cp) = pk2(s_lo * inv - bflo(x), s_hi * inv - bfhi(x));
            if (s - w + 1 >= 0) { const unsigned y = *(const unsigned*)(col + (size_t)(t0 + i - w + 1) * MIXW); s_lo -= bflo(y); s_hi -= bfhi(y); } }
    }
    __syncthreads();
    {
        typedef short bf16x8 __attribute__((ext_vector_type(8)));
        const bf16* Wt = (const bf16*)(a.ws + WS_POOLW) + ((size_t)l * 4 + g) * 128 * 128;
        const int rt = (wave & 3) * 16, db = (wave >> 2) * 64, fr = lane & 15, kg = lane >> 4;
        f32x4 acc[4] = {};
#pragma unroll
        for (int ks = 0; ks < 4; ++ks) { const bf16x8 af = *(const LAS bf16x8*)(lds + (rt + fr) * 272 + (ks * 32 + kg * 8) * 2);
#pragma unroll
            for (int nt = 0; nt < 4; ++nt) { const bf16x8 bfr = *(const bf16x8*)(Wt + (size_t)(db + nt * 16 + fr) * 128 + ks * 32 + kg * 8);
                acc[nt] = __builtin_amdgcn_mfma_f32_16x16x32_bf16(bfr, af, acc[nt], 0, 0, 0); } }
        bf16* Y = (bf16*)(a.ws + WS_Y) + (size_t)(T0 + rt + fr) * D + 512 + g * 128;
#pragma unroll
        for (int nt = 0; nt < 4; ++nt) { const int d = db + nt * 16 + kg * 4; const f32x4 sc = *(const f32x4*)(a.pool_scale + l * MIXW + g * 128 + d);
            v2u w; w.x = pk2(acc[nt][0] * sc[0], acc[nt][1] * sc[1]); w.y = pk2(acc[nt][2] * sc[2], acc[nt][3] * sc[3]); *(v2u*)(Y + d) = w; }
    }
    __syncthreads();
}
__device__ __forceinline__ void conv_item(const Args& a, int l, int u, int wave) {
    int lane; asm volatile("v_mbcnt_lo_u32_b32 %0, -1, 0\n\tv_mbcnt_hi_u32_b32 %0, -1, %0" : "=v"(lane));
    const bf16* P = (const bf16*)(a.ws + WS_PROJ); const bf16* Ch = P + 4 * PROJ_T; const bf16* Cb = P + 5 * PROJ_T; const bf16* Cc = P + 6 * PROJ_T;
    const int tid = wave * 64 + lane, c0 = (tid & 63) * 8, t0 = u * 64 + (tid >> 6) * 8, s0 = t0 & (SEQ - 1);
    float wgt[3][8];
#pragma unroll
    for (int j = 0; j < 3; ++j) { const float* w = a.conv_w + ((size_t)l * 3 + j) * MIXW + c0; const f32x4 w0 = *(const f32x4*)w, w1 = *(const f32x4*)(w + 4);
#pragma unroll
        for (int k = 0; k < 4; ++k) { wgt[j][k] = w0[k]; wgt[j][4 + k] = w1[k]; } }
    float z2[8], z1[8];
#pragma unroll
    for (int k = 0; k < 8; ++k) { z2[k] = 0.f; z1[k] = 0.f; }
#pragma unroll
    for (int i = -2; i < 8; ++i) {
        float z[8];
        if (s0 + i >= 0) { const v4u hv = *(const v4u*)(Ch + (size_t)(t0 + i) * MIXW + c0), cv = *(const v4u*)(Cc + (size_t)(t0 + i) * MIXW + c0);
            z[0] = bflo(hv.x) * bflo(cv.x); z[1] = bfhi(hv.x) * bfhi(cv.x); z[2] = bflo(hv.y) * bflo(cv.y); z[3] = bfhi(hv.y) * bfhi(cv.y);
            z[4] = bflo(hv.z) * bflo(cv.z); z[5] = bfhi(hv.z) * bfhi(cv.z); z[6] = bflo(hv.w) * bflo(cv.w); z[7] = bfhi(hv.w) * bfhi(cv.w); }
        else {
#pragma unroll
            for (int k = 0; k < 8; ++k) z[k] = 0.f; }
        if (i >= 0) { const v4u bv = *(const v4u*)(Cb + (size_t)(t0 + i) * MIXW + c0); float o[8];
            const float bb[8] = {bflo(bv.x), bfhi(bv.x), bflo(bv.y), bfhi(bv.y), bflo(bv.z), bfhi(bv.z), bflo(bv.w), bfhi(bv.w)};
#pragma unroll
            for (int k = 0; k < 8; ++k) o[k] = bb[k] * (wgt[0][k] * z2[k] + wgt[1][k] * z1[k] + wgt[2][k] * z[k]);
            v4u ov; ov.x = pk2(o[0], o[1]); ov.y = pk2(o[2], o[3]); ov.z = pk2(o[4], o[5]); ov.w = pk2(o[6], o[7]);
            *(v4u*)((bf16*)(a.ws + WS_Y) + (size_t)(t0 + i) * D + 1024 + c0) = ov; }
#pragma unroll
        for (int k = 0; k < 8; ++k) { z2[k] = z1[k]; z1[k] = z[k]; }
    }
}
__device__ __forceinline__ void mixers_fast(const Args& a, int lq, LAS char* lds, int wave, int lane, int G, int blk) {
    const int l = lq & 1;
    for (int u = blk; u < N_ATT_UNITS; u += G) attention_item(a, l, u, lds, wave);
    unsigned* head = (unsigned*)(a.ws + WS_QCTR) + 64 * lq;
    volatile LAS unsigned* slot = (volatile LAS unsigned*)(lds + att::LDS_END);
    for (;;) {
        if (wave == 0 && lane == 0) *slot = __hip_atomic_fetch_add(head, 1u, __ATOMIC_RELAXED, __HIP_MEMORY_SCOPE_AGENT);
        __syncthreads();
        const unsigned it = *slot;
        __syncthreads();
        if (it >= (unsigned)(N_POOL_UNITS + N_CONV_UNITS)) break;
        if (it < (unsigned)N_POOL_UNITS) pool_item(a, l, (int)it, lds, wave); else conv_item(a, l, (int)it - N_POOL_UNITS, wave);
    }
}
__device__ __forceinline__ void p0_cmax(const Args& a, int gw, int NGW, int lane) {
    unsigned char* ws = a.ws;
    {
        constexpr int NCC = (INW + 255) / 256;
        for (int it = gw; it < DEPTH * 32 * NCC; it += NGW) { const int l = it / (32 * NCC), r = it % (32 * NCC), kc = r / NCC, cc = r % NCC; const int c0 = cc * 256 + 4 * lane;
            if (c0 + 3 < INW) { const float* W = a.w_in + (size_t)l * D * INW + (size_t)(kc * 64) * INW + c0; const float* g = a.norm_mix + l * D + kc * 64;
                float m0 = 0.f, m1 = 0.f, m2 = 0.f, m3 = 0.f;
#pragma unroll 8
                for (int k = 0; k < 64; ++k) { const f32x4 w = *(const f32x4*)(W + (size_t)k * INW); const float gk = fabsf(g[k]);
                    m0 = fmaxf(m0, fabsf(w[0]) * gk); m1 = fmaxf(m1, fabsf(w[1]) * gk); m2 = fmaxf(m2, fabsf(w[2]) * gk); m3 = fmaxf(m3, fabsf(w[3]) * gk); }
                unsigned* cm = (unsigned*)(ws + WS_CMAX) + l * INW + c0;
                const unsigned u0 = __float_as_uint(m0), u1 = __float_as_uint(m1), u2 = __float_as_uint(m2), u3 = __float_as_uint(m3);
                __hip_atomic_fetch_max(cm + 0, u0, __ATOMIC_RELAXED, __HIP_MEMORY_SCOPE_AGENT); __hip_atomic_fetch_max(cm + 1, u1, __ATOMIC_RELAXED, __HIP_MEMORY_SCOPE_AGENT);
                __hip_atomic_fetch_max(cm + 2, u2, __ATOMIC_RELAXED, __HIP_MEMORY_SCOPE_AGENT); __hip_atomic_fetch_max(cm + 3, u3, __ATOMIC_RELAXED, __HIP_MEMORY_SCOPE_AGENT); } }
    }
}
__device__ __forceinline__ void p0_prologue(const Args& a, LAS unsigned char* lds, int gw, int NGW, int wave, int lane) {
    unsigned char* ws = a.ws;
    LAS float* scr = (LAS float*)(lds + wave * 16384);
    constexpr int I_SQ = (D / 64) * (D / 32), I_BR = (MIXW / 64) * (D / 32);
    constexpr int I_LAYER = 4 * I_BR + 2 * I_SQ;
    for (int it = gw; it < DEPTH * I_LAYER; it += NGW) {
        const int l = it / I_LAYER; int r = it - l * I_LAYER;
        if (r < 4 * I_BR) { const int g = r / I_BR, rr = r % I_BR, kb = rr / (D / 32), nb = rr % (D / 32);
            tr_item<false>(a.w_branch + ((size_t)l * 4 + g) * MIXW * D, D, nullptr, (bf16*)(ws + WS_WBR + l * SQ_BYTES), D, g * MIXW, scr, 64 * kb, 32 * nb, lane); continue; }
        r -= 4 * I_BR;
        if (r < I_SQ) { const int kb = r / (D / 32), nb = r % (D / 32);
            tr_item<false>(a.w_out + (size_t)l * D * D, D, nullptr, (bf16*)(ws + WS_WOUT + l * SQ_BYTES), D, 0, scr, 64 * kb, 32 * nb, lane); continue; }
        r -= I_SQ;
        { const int kb = r / (D / 32), nb = r % (D / 32);
            tr_item<false>(a.peer_wq + (size_t)l * D * D, D, a.norm_ffn + l * D, (bf16*)(ws + WS_WQ + l * SQ_BYTES), D, 0, scr, 64 * kb, 32 * nb, lane); }
    }
    for (int it = gw; it < DEPTH * 4 * 8; it += NGW) { const int lg = it >> 3, r = it & 7;
        tr_item<false>(a.pool_w + (size_t)lg * 128 * 128, 128, nullptr, (bf16*)(ws + WS_POOLW) + (size_t)lg * 128 * 128, 128, 0, scr, 64 * (r >> 2), 32 * (r & 3), lane); }
    {
        constexpr int NR = 2 * DEPTH * PEER_E;
        f32x4 nv[8];
        if (gw < NR) { const int t = gw / (DEPTH * PEER_E), row = gw - t * (DEPTH * PEER_E); const float* src = (t ? a.peer_v : a.peer_u) + (size_t)row * D + 4 * lane;
#pragma unroll
            for (int j = 0; j < 8; ++j) nv[j] = *(const f32x4*)(src + 256 * j); }
        for (int r = gw; r < NR; r += NGW) { const int t = r / (DEPTH * PEER_E), row = r - t * (DEPTH * PEER_E);
            f32x4 v[8]; float am = 0.f;
#pragma unroll
            for (int j = 0; j < 8; ++j) v[j] = nv[j];
            { const int r2 = r + NGW; if (r2 < NR) { const int t2 = r2 / (DEPTH * PEER_E), row2 = r2 - t2 * (DEPTH * PEER_E); const float* src = (t2 ? a.peer_v : a.peer_u) + (size_t)row2 * D + 4 * lane;
#pragma unroll
                for (int j = 0; j < 8; ++j) nv[j] = *(const f32x4*)(src + 256 * j); } }
#pragma unroll
            for (int j = 0; j < 8; ++j) am = fmaxf(am, fmaxf(fmaxf(fabsf(v[j][0]), fabsf(v[j][1])), fmaxf(fabsf(v[j][2]), fabsf(v[j][3]))));
            am = wave_max(am, lane);
            const float inv = am > 0.f ? 127.0f / am : 0.f, off = 0.f;
            unsigned char* dst = ws + (t ? WS_PV : WS_PU) + (size_t)row * D + 4 * lane;
#pragma unroll
            for (int j = 0; j < 8; ++j) { const int q0 = (int)(rintf(v[j][0] * inv) + off), q1 = (int)(rintf(v[j][1] * inv) + off), q2 = (int)(rintf(v[j][2] * inv) + off), q3 = (int)(rintf(v[j][3] * inv) + off);
                *(unsigned*)(dst + 256 * j) = (unsigned)(q0 & 255) | ((unsigned)(q1 & 255) << 8) | ((unsigned)(q2 & 255) << 16) | ((unsigned)(q3 & 255) << 24); }
            if (lane == 0) ((float*)(ws + (t ? WS_SV : WS_SU)))[row] = am * (1.0f / 127.0f); }
    }
    { bf16* pk = (bf16*)(ws + WS_PK); const size_t n8 = (size_t)DEPTH * 8 * 2 * 128 * 128 / 8;
      for (size_t i = (size_t)gw * 64 + lane; i < n8; i += (size_t)NGW * 64) { const f32x4 v0 = *(const f32x4*)(a.peer_keys + i * 8), v1 = *(const f32x4*)(a.peer_keys + i * 8 + 4);
          v4u o; o.x = pk2(v0[0], v0[1]); o.y = pk2(v0[2], v0[3]); o.z = pk2(v1[0], v1[1]); o.w = pk2(v1[2], v1[3]); *(v4u*)(pk + i * 8) = o; } }
    {
        float* wf = (float*)(ws + WS_WF); float* binr = (float*)(ws + WS_BINR);
        const int gt = gw * 64 + lane, NGT = NGW * 64;
        for (int i = gt; i < DEPTH * 4 * D; i += NGT) { const int l = i / (4 * D), h = (i / D) & 3, k = i % D; wf[i] = a.w_in[(size_t)l * D * INW + (size_t)k * INW + 1536 + h] * a.norm_mix[l * D + k]; }
        for (int i = gt; i < DEPTH * NPROJ; i += NGT) { const int l = i / NPROJ, j = i % NPROJ; binr[i] = a.b_in[l * INW + colmap_in(j)]; }
    }
    {
        unsigned long long* ssq = (unsigned long long*)(ws + WS_SSQ);
        for (int m = gw; m < M; m += NGW) { float s = 0.f, am = 0.f; f32x4 v[8];
#pragma unroll
            for (int j = 0; j < 8; ++j) { const size_t o = (size_t)m * D + j * 256 + lane * 4; v[j] = *(const f32x4*)(a.x + o); s += (v[j][0] * v[j][0] + v[j][1] * v[j][1]) + (v[j][2] * v[j][2] + v[j][3] * v[j][3]);
                am = fmaxf(am, fmaxf(fmaxf(fabsf(v[j][0]), fabsf(v[j][1])), fmaxf(fabsf(v[j][2]), fabsf(v[j][3])))); }
            s = wave_sum(s, lane); am = wave_max(am, lane); if (lane == 0) { ssq[m] = (unsigned long long)((double)s * 4294967296.0); ((float*)(ws + WS_RSA))[m] = rsqrtf(s * (1.0f / D) + EPS) * am * (1.0f / 127.0f); }
            const float inv = am > 0.f ? 127.0f / am : 0.f; unsigned char* q8 = ws + WS_HB8 + (size_t)m * D + 4 * lane;
#pragma unroll
            for (int j = 0; j < 8; ++j) *(unsigned*)(q8 + 256 * j) = ((unsigned)((int)rintf(v[j][0] * inv) & 255)) | ((unsigned)((int)rintf(v[j][1] * inv) & 255) << 8) | ((unsigned)((int)rintf(v[j][2] * inv) & 255) << 16) | ((unsigned)((int)rintf(v[j][3] * inv) & 255) << 24); }
    }
}
__device__ __forceinline__ void p0_win_i8(const Args& a, LAS unsigned char* lds, int gw, int NGW, int wave, int lane) {
    unsigned char* ws = a.ws; LAS float* scr = (LAS float*)(lds + wave * 16384);
    constexpr int I_WIN = (D / 64) * (NPROJ / 32);
    for (int it = gw; it < DEPTH * I_WIN; it += NGW) { const int l = it / I_WIN, r = it % I_WIN, kb = r / (NPROJ / 32), nb = r % (NPROJ / 32);
        tr_item_i8(a.w_in + (size_t)l * D * INW, a.norm_mix + l * D, (const unsigned*)(ws + WS_CMAX) + l * INW, ws + WS_WIN + l * WIN_BYTES, scr, 64 * kb, 32 * nb, lane); }
    float* sw = (float*)(ws + WS_SW); const int gt = gw * 64 + lane, NGT = NGW * 64;
    bf16* swh = (bf16*)(ws + WS_SWH); bf16* bih = (bf16*)(ws + WS_BIH);
    for (int i = gt; i < DEPTH * NPROJ; i += NGT) { const int l = i / NPROJ, j = i % NPROJ; const float s = __builtin_bit_cast(float, ((const unsigned*)(ws + WS_CMAX))[l * INW + colmap_in(j)]) * (1.0f / 127.0f);
        sw[i] = s; swh[i] = (bf16)f2bf(s); bih[i] = (bf16)f2bf(a.b_in[l * INW + colmap_in(j)]); }
}
__device__ __forceinline__ void quant_rows(const Args& a, int l, int gw, int NGW, int lane) {
    unsigned char* ws = a.ws; const bf16* HB = (const bf16*)(ws + WS_HB);
    for (int m = gw; m < M; m += NGW) { float am = 0.f; float v[4][8];
#pragma unroll
        for (int j = 0; j < 4; ++j) { const v4u w = *(const v4u*)(HB + (size_t)m * D + j * 512 + lane * 8);
            v[j][0] = bflo(w.x); v[j][1] = bfhi(w.x); v[j][2] = bflo(w.y); v[j][3] = bfhi(w.y); v[j][4] = bflo(w.z); v[j][5] = bfhi(w.z); v[j][6] = bflo(w.w); v[j][7] = bfhi(w.w);
#pragma unroll
            for (int e = 0; e < 8; ++e) am = fmaxf(am, fabsf(v[j][e])); }
        am = wave_max(am, lane); if (lane == 0) ((float*)(ws + WS_RSA))[m] = rsqrtf(ssa_to_f(((const unsigned long long*)(ws + WS_SSQ))[(size_t)l * M + m]) * (1.0f / D) + EPS) * am * (1.0f / 127.0f);
        const float inv = am > 0.f ? 127.0f / am : 0.f; unsigned char* q8 = ws + WS_HB8 + (size_t)m * D + 8 * lane;
#pragma unroll
        for (int j = 0; j < 4; ++j) { v2u o;
            o.x = ((unsigned)((int)rintf(v[j][0] * inv) & 255)) | ((unsigned)((int)rintf(v[j][1] * inv) & 255) << 8) | ((unsigned)((int)rintf(v[j][2] * inv) & 255) << 16) | ((unsigned)((int)rintf(v[j][3] * inv) & 255) << 24);
            o.y = ((unsigned)((int)rintf(v[j][4] * inv) & 255)) | ((unsigned)((int)rintf(v[j][5] * inv) & 255) << 8) | ((unsigned)((int)rintf(v[j][6] * inv) & 255) << 16) | ((unsigned)((int)rintf(v[j][7] * inv) & 255) << 24);
            *(v2u*)(q8 + 512 * j) = o; } }
}

#define DPP_ROR(x, n) __builtin_bit_cast(float, __builtin_amdgcn_update_dpp(0, __builtin_bit_cast(int, (x)), 0x120 + (n), 0xf, 0xf, false))
__device__ __forceinline__ float wave_sum_swap(float x) {
    x += DPP_ROR(x, 8); x += DPP_ROR(x, 4); x += DPP_ROR(x, 2); x += DPP_ROR(x, 1);
    const int xi = __builtin_bit_cast(int, x);
    const float r0 = __builtin_bit_cast(float, __builtin_amdgcn_readlane(xi, 0)), r1 = __builtin_bit_cast(float, __builtin_amdgcn_readlane(xi, 16)),
                r2 = __builtin_bit_cast(float, __builtin_amdgcn_readlane(xi, 32)), r3 = __builtin_bit_cast(float, __builtin_amdgcn_readlane(xi, 48));
    return (r0 + r1) + (r2 + r3);
}
__device__ __forceinline__ void forget_logits(const Args& a, int l, int gw, int NGW, int lane) {
    unsigned char* ws = a.ws; const bf16* HB = (const bf16*)(ws + WS_HB); const float* wf = (const float*)(ws + WS_WF) + l * 4 * D; const unsigned long long* ssq = (const unsigned long long*)(ws + WS_SSQ) + l * M;
    float* logf = (float*)(ws + WS_LOGF);
    f32x4 w[4][4][2];
#pragma unroll
    for (int h = 0; h < 4; ++h)
#pragma unroll
        for (int j = 0; j < 4; ++j) { const int k0 = j * 512 + lane * 8; w[h][j][0] = *(const f32x4*)(wf + h * D + k0); w[h][j][1] = *(const f32x4*)(wf + h * D + k0 + 4); }
    float bias[4];
#pragma unroll
    for (int h = 0; h < 4; ++h) bias[h] = a.b_in[l * INW + 1536 + h];
    for (int m0 = gw; m0 < M; m0 += 2 * NGW) {
        const int m1 = m0 + NGW; const bool ok1 = m1 < M; const int mr[2] = {m0, ok1 ? m1 : m0};
        f32x4 x[2][4][2];
#pragma unroll
        for (int r = 0; r < 2; ++r)
#pragma unroll
            for (int j = 0; j < 4; ++j) { const int k0 = j * 512 + lane * 8;
                if (l == 0) { x[r][j][0] = *(const f32x4*)(a.x + (size_t)mr[r] * D + k0); x[r][j][1] = *(const f32x4*)(a.x + (size_t)mr[r] * D + k0 + 4); }
                else { const v4u xv = *(const v4u*)(HB + (size_t)mr[r] * D + k0); x[r][j][0] = (f32x4){bflo(xv.x), bfhi(xv.x), bflo(xv.y), bfhi(xv.y)}; x[r][j][1] = (f32x4){bflo(xv.z), bfhi(xv.z), bflo(xv.w), bfhi(xv.w)}; } }
#pragma unroll
        for (int r = 0; r < 2; ++r) { const float rs = rsqrtf(ssa_to_f(ssq[mr[r]]) * (1.0f / D) + EPS);
#pragma unroll
            for (int h = 0; h < 4; ++h) { f32x4 s4 = {0.f, 0.f, 0.f, 0.f};
#pragma unroll
                for (int j = 0; j < 4; ++j) { s4 += x[r][j][0] * w[h][j][0]; s4 += x[r][j][1] * w[h][j][1]; }
                const float z = wave_sum_swap((s4[0] + s4[1]) + (s4[2] + s4[3])) * rs + bias[h];
                const float ls = fminf(z, 0.f) - __logf(1.0f + __expf(-fabsf(z)));
                if (lane == h && (r == 0 || ok1)) logf[mr[r] * 4 + h] = ls; } }
    }
}
__device__ __forceinline__ float gelu_tanh(float x) { const float u = 1.5957691216057308f * (x + 0.044715f * x * x * x); return x / (1.0f + __expf(-u)); }
constexpr int PEER_TOK = 32;
constexpr int PL_IDX = 0, PL_GATE = PEER_TOK * 128 * 4, PL_TAB = 2 * PEER_TOK * 128 * 4;
__device__ __forceinline__ int f2key(float f) { const int b = __builtin_bit_cast(int, f); return b ^ ((b >> 31) & 0x7fffffff); }
__device__ __forceinline__ float key2f(int k) { return __builtin_bit_cast(float, k ^ ((k >> 31) & 0x7fffffff)); }
#define CE_DESC(x, y) do { const int hi_ = (x) > (y) ? (x) : (y), lo_ = (x) > (y) ? (y) : (x); (x) = hi_; (y) = lo_; } while (0)
__device__ __forceinline__ void sort16_desc(int* v) {
#pragma unroll
    for (int k = 2; k <= 16; k <<= 1)
#pragma unroll
        for (int j = k >> 1; j > 0; j >>= 1)
#pragma unroll
            for (int i = 0; i < 16; ++i) { const int l = i ^ j; if (l > i) { if ((i & k) == 0) CE_DESC(v[i], v[l]); else CE_DESC(v[l], v[i]); } }
}
__device__ __forceinline__ void merge_top16(int* a, const int* b) {
#pragma unroll
    for (int i = 0; i < 16; ++i) a[i] = a[i] > b[15 - i] ? a[i] : b[15 - i];
#pragma unroll
    for (int j = 8; j > 0; j >>= 1)
#pragma unroll
        for (int i = 0; i < 16; ++i) { const int l = i ^ j; if (l > i) CE_DESC(a[i], a[l]); }
}
__device__ __forceinline__ void top16_of_64(int* v) {
    sort16_desc(v); sort16_desc(v + 16); sort16_desc(v + 32); sort16_desc(v + 48);
    merge_top16(v, v + 16); merge_top16(v + 32, v + 48); merge_top16(v, v + 32);
}
constexpr int cand_slot(int i, int j) {
    int n = 0;
    for (int a = 0; a < 16; ++a) for (int b = 0; b < 16; ++b) { if ((a + 1) * (b + 1) <= 16) { if (a == i && b == j) return n; ++n; } }
    return -1;
}
__device__ __forceinline__ void peer_retrieve(const Args& a, int l, int t0, int h, LAS char* lds, int wave) {
    typedef short bf16x8 __attribute__((ext_vector_type(8)));
    typedef float f32x16 __attribute__((ext_vector_type(16)));
    int lane; asm volatile("v_mbcnt_lo_u32_b32 %0, -1, 0\n\tv_mbcnt_hi_u32_b32 %0, -1, %0" : "=v"(lane));
    const int r32 = lane & 31, hi = lane >> 5, hi4 = hi * 4;
    const bf16* Q = (const bf16*)(a.ws + WS_Q) + (size_t)(t0 + r32) * D + h * 256 + hi * 8;
    const bf16* PK = (const bf16*)(a.ws + WS_PK) + ((size_t)(l * 8 + h) * 2) * 128 * 128 + (size_t)r32 * 128 + hi * 8;
    int top[2][16];
#pragma unroll
    for (int p = 0; p < 2; ++p) {
        f32x16 acc[4] = {};
        bf16x8 qf[8];
#pragma unroll
        for (int cs = 0; cs < 8; ++cs) qf[cs] = *(const bf16x8*)(Q + p * 128 + cs * 16);
#pragma unroll
        for (int kb = 0; kb < 4; ++kb) { bf16x8 kf[8];
#pragma unroll
            for (int cs = 0; cs < 8; ++cs) kf[cs] = *(const bf16x8*)(PK + (size_t)p * 128 * 128 + (size_t)kb * 32 * 128 + cs * 16);
#pragma unroll
            for (int cs = 0; cs < 8; ++cs) acc[kb] = __builtin_amdgcn_mfma_f32_32x32x16_bf16(kf[cs], qf[cs], acc[kb], 0, 0, 0); }
        int v[64];
#pragma unroll
        for (int kb = 0; kb < 4; ++kb)
#pragma unroll
            for (int r = 0; r < 16; ++r) { const int c = kb * 32 + (r & 3) + 8 * (r >> 2);
                v[kb * 16 + r] = (f2key(acc[kb][r]) & ~127) | (c | hi4); }
        top16_of_64(v);
        int mine[16], other[16];
#pragma unroll
        for (int i = 0; i < 16; ++i) { auto rr = __builtin_amdgcn_permlane32_swap((unsigned)v[i], (unsigned)v[i], false, false); mine[i] = (int)rr[0]; other[i] = (int)rr[1]; }
        merge_top16(mine, other);
#pragma unroll
        for (int i = 0; i < 16; ++i) top[p][i] = mine[i];
    }
    LAS int* tab = (LAS int*)(lds + PL_TAB) + (wave * 64 + lane) * 32;
    float sA[16], sB[16];
#pragma unroll
    for (int i = 0; i < 16; ++i) { sA[i] = key2f(top[0][i] & ~127); sB[i] = key2f(top[1][i] & ~127); tab[i] = top[0][i] & 127; tab[16 + i] = top[1][i] & 127; }
    int c[64];
#pragma unroll
    for (int n = 0; n < 64; ++n) c[n] = (int)0x80000000;
#pragma unroll
    for (int i = 0; i < 16; ++i)
#pragma unroll
        for (int j = 0; j < 16; ++j) if ((i + 1) * (j + 1) <= 16) c[cand_slot(i, j)] = (f2key(sA[i] + sB[j]) & ~255) | (16 * i + j);
    top16_of_64(c);
    float ex[16]; float sum = 0.f; const float mx = key2f(c[0] & ~255);
#pragma unroll
    for (int w = 0; w < 16; ++w) { ex[w] = __expf(key2f(c[w] & ~255) - mx); sum += ex[w]; }
    const float inv = 1.0f / sum;
    asm volatile("s_waitcnt lgkmcnt(0)" ::: "memory");
    LAS int* oi = (LAS int*)(lds + PL_IDX) + r32 * 128 + h * 16; LAS float* og = (LAS float*)(lds + PL_GATE) + r32 * 128 + h * 16;
#pragma unroll
    for (int w = 0; w < 16; ++w) { const int id = c[w] & 255; const int e = tab[id >> 4] * 128 + tab[16 + (id & 15)];
        if ((w >> 3) == hi) { oi[w] = e; og[w] = ex[w] * inv; } }
}
constexpr size_t WS_IDX = 816 * MiB;
constexpr size_t WS_GATE = 820 * MiB;
constexpr size_t WS_XQ = 824 * MiB;
constexpr size_t WS_SX = 856 * MiB;
constexpr size_t WS_PART = 857 * MiB;
constexpr size_t WS_SUT = 890 * MiB;
constexpr size_t WS_END2 = 1024 * MiB;
#ifndef PEER_NB
#define PEER_NB 8
#endif
constexpr int NSLICE = 8, SLW = D / NSLICE;
__device__ __forceinline__ void peer_publish(const Args& a, int l, int t, LAS char* lds, int tl) {
    int lane; LANE_ID(lane);
    unsigned char* ws = a.ws;
    { int* gi = (int*)(ws + WS_IDX) + (size_t)t * 128; float* gg = (float*)(ws + WS_GATE) + (size_t)t * 128; float* gs = (float*)(ws + WS_SUT) + (size_t)t * 128;
      const float* SU = (const float*)(ws + WS_SU) + l * PEER_E; const float* SV = (const float*)(ws + WS_SV) + l * PEER_E;
      const int i0 = ((const LAS int*)(lds + PL_IDX))[tl * 128 + lane], i1 = ((const LAS int*)(lds + PL_IDX))[tl * 128 + 64 + lane];
      gi[lane] = i0; gi[64 + lane] = i1; gs[lane] = SU[i0]; gs[64 + lane] = SU[i1];
      gg[lane] = ((const LAS float*)(lds + PL_GATE))[tl * 128 + lane] * SV[i0]; gg[64 + lane] = ((const LAS float*)(lds + PL_GATE))[tl * 128 + 64 + lane] * SV[i1]; }
    const unsigned long long* ssa1 = (const unsigned long long*)(ws + WS_SSA) + l * M;
    const float rs = rsqrtf(ssa_to_f(ssa1[t]) * (1.0f / D) + EPS);
    const bf16* HB = (const bf16*)(ws + WS_HB) + (size_t)t * D; const float* gn = a.norm_ffn + l * D;
    float xf[32]; float am = 0.f;
#pragma unroll
    for (int i = 0; i < 2; ++i) { const int k0 = 16 * lane + 1024 * i; const v4u h0 = *(const v4u*)(HB + k0), h1 = *(const v4u*)(HB + k0 + 8);
        const unsigned hw[8] = {h0.x, h0.y, h0.z, h0.w, h1.x, h1.y, h1.z, h1.w};
#pragma unroll
        for (int q = 0; q < 4; ++q) { const f32x4 g = *(const f32x4*)(gn + k0 + 4 * q);
            xf[16 * i + 4 * q + 0] = bflo(hw[2 * q]) * rs * g[0]; xf[16 * i + 4 * q + 1] = bfhi(hw[2 * q]) * rs * g[1];
            xf[16 * i + 4 * q + 2] = bflo(hw[2 * q + 1]) * rs * g[2]; xf[16 * i + 4 * q + 3] = bfhi(hw[2 * q + 1]) * rs * g[3]; } }
#pragma unroll
    for (int k = 0; k < 32; ++k) am = fmaxf(am, fabsf(xf[k]));
    am = wave_max(am, lane);
    const float inv = am > 0.f ? 127.0f / am : 0.f;
    if (lane == 0) ((float*)(ws + WS_SX))[t] = am * (1.0f / 127.0f);
    unsigned char* xq = ws + WS_XQ + (size_t)t * 4096;
#pragma unroll
    for (int i = 0; i < 2; ++i) { v4u ph, pl;
#pragma unroll
        for (int d = 0; d < 4; ++d) { unsigned wh = 0, wl = 0;
#pragma unroll
            for (int b = 0; b < 4; ++b) { const float sv = xf[16 * i + 4 * d + b] * inv, hq = rintf(sv), lq = rintf((sv - hq) * 128.0f);
                wh |= ((unsigned)((int)hq & 255)) << (8 * b); wl |= ((unsigned)((int)lq & 255)) << (8 * b); }
            ph[d] = wh; pl[d] = wl; }
        *(v4u*)(xq + 16 * lane + 1024 * i) = ph; *(v4u*)(xq + 2048 + 16 * lane + 1024 * i) = pl; }
}
struct PeerItems { int pos, npop, rank, nloc, wave;
    __device__ __forceinline__ int nblk() const { return (M / PEER_TOK - rank + nloc - 1) / nloc; }
    __device__ __forceinline__ int count() const { return ((NSLICE - pos + npop - 1) / npop) * nblk() * (PEER_TOK / NWAVES); }
    __device__ __forceinline__ void get(int n, int& s, int& t) const { constexpr int per = PEER_TOK / NWAVES; const int k = n % per, r = n / per, nb = nblk();
        s = pos + (r / nb) * npop; t = (rank + (r % nb) * nloc) * PEER_TOK + wave * per + k; } };
__device__ __forceinline__ void peer_u_wave(const Args& a, int l, const PeerItems& it) {
    int lane; LANE_ID(lane);
    unsigned char* ws = a.ws; const int sub = lane & 15, grp = lane >> 4;
    const __amdgpu_buffer_rsrc_t rU = __builtin_amdgcn_make_buffer_rsrc((void*)(ws + WS_PU + (size_t)l * PE_BYTES), 0, 0x7fffffff, 0x00020000);
    const __amdgpu_buffer_rsrc_t rW = __builtin_amdgcn_make_buffer_rsrc((void*)ws, 0, 0x7fffffff, 0x00020000);
    const int N = it.count(); if (N <= 0) return;
    int s, t; it.get(0, s, t);
    int idc[2], idn[2] = {0, 0}; v4u xhc, xlc, xhn = {}, xln = {}; v4u wA[PEER_NB], wB[PEER_NB];
#define PU_META(I0, I1, XH, XL, S_, T_) do { I0 = (int)__builtin_amdgcn_raw_buffer_load_b32(rW, 4 * lane, (int)WS_IDX + (T_) * 512, 0); I1 = (int)__builtin_amdgcn_raw_buffer_load_b32(rW, 4 * lane, (int)WS_IDX + (T_) * 512 + 256, 0); \
        XH = __builtin_amdgcn_raw_buffer_load_b128(rW, 16 * sub, (int)WS_XQ + (T_) * 4096 + SLW * (S_), 0); XL = __builtin_amdgcn_raw_buffer_load_b128(rW, 16 * sub, (int)WS_XQ + (T_) * 4096 + 2048 + SLW * (S_), 0); } while (0)
#define PU_ISSUE(W, ID, Q, S_) do { _Pragma("unroll") for (int j = 0; j < PEER_NB; ++j) { const int e_ = shi(ID[(PEER_NB * (Q) + j) >> 4], 4 * ((PEER_NB * (Q) + j) & 15) + grp); W[j] = __builtin_amdgcn_raw_buffer_load_b128(rU, e_ * D + SLW * (S_) + 16 * sub, 0, 0); } } while (0)
#define PU_COMP(W, Q) do { _Pragma("unroll") for (int j = 0; j < PEER_NB; ++j) { int dh = 0, dl = 0; \
            dh = __builtin_amdgcn_sdot4((int)W[j].x, (int)xhc.x, dh, false); dl = __builtin_amdgcn_sdot4((int)W[j].x, (int)xlc.x, dl, false); \
            dh = __builtin_amdgcn_sdot4((int)W[j].y, (int)xhc.y, dh, false); dl = __builtin_amdgcn_sdot4((int)W[j].y, (int)xlc.y, dl, false); \
            dh = __builtin_amdgcn_sdot4((int)W[j].z, (int)xhc.z, dh, false); dl = __builtin_amdgcn_sdot4((int)W[j].z, (int)xlc.z, dl, false); \
            dh = __builtin_amdgcn_sdot4((int)W[j].w, (int)xhc.w, dh, false); dl = __builtin_amdgcn_sdot4((int)W[j].w, (int)xlc.w, dl, false); \
            float p_ = (float)dh + (float)dl * (1.0f / 128.0f); \
            p_ += DPP_ROR(p_, 8); p_ += DPP_ROR(p_, 4); p_ += DPP_ROR(p_, 2); p_ += DPP_ROR(p_, 1); \
            if (sub == ((PEER_NB * (Q) + j) & 15)) { if ((PEER_NB * (Q) + j) >> 4) acc1 = p_; else acc0 = p_; } __builtin_amdgcn_sched_barrier(0); } } while (0)
    PU_META(idc[0], idc[1], xhc, xlc, s, t); PU_ISSUE(wA, idc, 0, s); PU_ISSUE(wB, idc, 1, s);
    for (int n = 0; n < N; ++n) {
        int sn = s, tn = t; const bool more = n + 1 < N;
        if (more) it.get(n + 1, sn, tn);
        PU_META(idn[0], idn[1], xhn, xln, sn, tn);
        float acc0 = 0.f, acc1 = 0.f;
        __builtin_amdgcn_sched_barrier(0);
#if PEER_NB == 8
        PU_COMP(wA, 0); PU_ISSUE(wA, idc, 2, s); __builtin_amdgcn_sched_barrier(0);
        PU_COMP(wB, 1); PU_ISSUE(wB, idc, 3, s); __builtin_amdgcn_sched_barrier(0);
        PU_COMP(wA, 2); PU_ISSUE(wA, idn, 0, sn); __builtin_amdgcn_sched_barrier(0);
        PU_COMP(wB, 3); PU_ISSUE(wB, idn, 1, sn); __builtin_amdgcn_sched_barrier(0);
#else
        PU_COMP(wA, 0); PU_ISSUE(wA, idn, 0, sn); __builtin_amdgcn_sched_barrier(0);
        PU_COMP(wB, 1); PU_ISSUE(wB, idn, 1, sn); __builtin_amdgcn_sched_barrier(0);
#endif
        __builtin_amdgcn_raw_buffer_store_b32(__builtin_bit_cast(unsigned, acc0), rW, (4 * sub + grp) * 4, (int)WS_PART + (s * M + t) * 512, 0);
        __builtin_amdgcn_raw_buffer_store_b32(__builtin_bit_cast(unsigned, acc1), rW, (4 * sub + grp) * 4 + 256, (int)WS_PART + (s * M + t) * 512, 0);
        s = sn; t = tn; idc[0] = idn[0]; idc[1] = idn[1]; xhc = xhn; xlc = xln;
    }
#undef PU_META
#undef PU_ISSUE
#undef PU_COMP
}
__device__ __forceinline__ void peer_v_wave(const Args& a, int l, const PeerItems& it) {
    int lane; LANE_ID(lane);
    unsigned char* ws = a.ws; const int sub = lane & 15, grp = lane >> 4;
    const __amdgpu_buffer_rsrc_t rV = __builtin_amdgcn_make_buffer_rsrc((void*)(ws + WS_PV + (size_t)l * PE_BYTES), 0, 0x7fffffff, 0x00020000);
    const __amdgpu_buffer_rsrc_t rW = __builtin_amdgcn_make_buffer_rsrc((void*)ws, 0, 0x7fffffff, 0x00020000);
    const int N = it.count(); if (N <= 0) return;
    int s, t; it.get(0, s, t);
    struct Meta { int id[2]; float gate[2], su[2], pa[2], sx; v2u h1; };
    Meta mc, mn; v4u wA[PEER_NB], wB[PEER_NB];
    const int l4 = 4 * lane;
#define WLD(off_s) __builtin_amdgcn_raw_buffer_load_b32(rW, l4, (int)(off_s), 0)
#define PV_META(MM, S_, T_) do { const int r_ = (T_) * 512; MM.id[0] = (int)WLD(WS_IDX + r_); MM.id[1] = (int)WLD(WS_IDX + r_ + 256); \
        MM.gate[0] = __builtin_bit_cast(float, WLD(WS_GATE + r_)); MM.gate[1] = __builtin_bit_cast(float, WLD(WS_GATE + r_ + 256)); MM.su[0] = __builtin_bit_cast(float, WLD(WS_SUT + r_)); MM.su[1] = __builtin_bit_cast(float, WLD(WS_SUT + r_ + 256)); \
        float a0_ = 0.f, a1_ = 0.f; _Pragma("unroll") for (int q = 0; q < NSLICE; ++q) { const int po_ = (int)WS_PART + (q * M + (T_)) * 512; a0_ += __builtin_bit_cast(float, WLD(po_)); a1_ += __builtin_bit_cast(float, WLD(po_ + 256)); } \
        MM.pa[0] = a0_; MM.pa[1] = a1_; MM.sx = ((const float*)(ws + WS_SX))[T_]; \
        MM.h1 = __builtin_amdgcn_raw_buffer_load_b64(rW, (16 * sub + 4 * grp) * 2, (int)WS_HB + ((T_) * D + SLW * (S_)) * 2, 0); } while (0)
#define PV_ISSUE(W, ID, Q, S_) do { _Pragma("unroll") for (int j = 0; j < PEER_NB; ++j) { const int e_ = shi(ID[(PEER_NB * (Q) + j) >> 4], 4 * ((PEER_NB * (Q) + j) & 15) + grp); W[j] = __builtin_amdgcn_raw_buffer_load_b128(rV, e_ * D + SLW * (S_) + 16 * sub, 0, 0); } } while (0)
#define PV_COMP(W, Q) do { _Pragma("unroll") for (int j4 = 0; j4 < PEER_NB; j4 += 4) { \
            unsigned cp_ = 0; _Pragma("unroll") for (int jj = 0; jj < 4; ++jj) { const int i_ = PEER_NB * (Q) + j4 + jj; cp_ |= ((unsigned)shi(c8[i_ >> 4], 4 * (i_ & 15) + grp) & 255u) << (8 * jj); } \
            _Pragma("unroll") for (int d = 0; d < 4; ++d) { const unsigned a_ = W[j4][d], b_ = W[j4 + 1][d], c_ = W[j4 + 2][d], d_ = W[j4 + 3][d]; \
                const unsigned x0_ = __builtin_amdgcn_perm(b_, a_, 0x05010400u), x1_ = __builtin_amdgcn_perm(b_, a_, 0x07030602u), y0_ = __builtin_amdgcn_perm(d_, c_, 0x05010400u), y1_ = __builtin_amdgcn_perm(d_, c_, 0x07030602u); \
                yi[4 * d + 0] = __builtin_amdgcn_sdot4((int)__builtin_amdgcn_perm(y0_, x0_, 0x05040100u), (int)cp_, yi[4 * d + 0], false); \
                yi[4 * d + 1] = __builtin_amdgcn_sdot4((int)__builtin_amdgcn_perm(y0_, x0_, 0x07060302u), (int)cp_, yi[4 * d + 1], false); \
                yi[4 * d + 2] = __builtin_amdgcn_sdot4((int)__builtin_amdgcn_perm(y1_, x1_, 0x05040100u), (int)cp_, yi[4 * d + 2], false); \
                yi[4 * d + 3] = __builtin_amdgcn_sdot4((int)__builtin_amdgcn_perm(y1_, x1_, 0x07060302u), (int)cp_, yi[4 * d + 3], false); } \
            __builtin_amdgcn_sched_barrier(0); } } while (0)
    PV_META(mc, s, t); PV_ISSUE(wA, mc.id, 0, s); PV_ISSUE(wB, mc.id, 1, s);
    for (int n = 0; n < N; ++n) {
        int sn = s, tn = t; const bool more = n + 1 < N;
        if (more) it.get(n + 1, sn, tn);
        PV_META(mn, sn, tn);
        float coef[2];
#pragma unroll
        for (int hf = 0; hf < 2; ++hf) coef[hf] = gelu_tanh(mc.pa[hf] * mc.su[hf] * mc.sx) * mc.gate[hf];
        const float cmax = wave_max(fmaxf(fabsf(coef[0]), fabsf(coef[1])), lane); const float cinv = cmax > 0.f ? 127.0f / cmax : 0.f, cs = cmax * (1.0f / 127.0f);
        const int c8[2] = {(int)rintf(coef[0] * cinv), (int)rintf(coef[1] * cinv)};
        int yi[16];
#pragma unroll
        for (int k = 0; k < 16; ++k) yi[k] = 0;
        __builtin_amdgcn_sched_barrier(0);
#if PEER_NB == 8
        PV_COMP(wA, 0); PV_ISSUE(wA, mc.id, 2, s); __builtin_amdgcn_sched_barrier(0);
        PV_COMP(wB, 1); PV_ISSUE(wB, mc.id, 3, s); __builtin_amdgcn_sched_barrier(0);
        PV_COMP(wA, 2); PV_ISSUE(wA, mn.id, 0, sn); __builtin_amdgcn_sched_barrier(0);
        PV_COMP(wB, 3); PV_ISSUE(wB, mn.id, 1, sn); __builtin_amdgcn_sched_barrier(0);
#else
        PV_COMP(wA, 0); PV_ISSUE(wA, mn.id, 0, sn); __builtin_amdgcn_sched_barrier(0);
        PV_COMP(wB, 1); PV_ISSUE(wB, mn.id, 1, sn); __builtin_amdgcn_sched_barrier(0);
#endif
#pragma unroll
        for (int k = 0; k < 16; ++k) { yi[k] += shi(yi[k], lane ^ 16); yi[k] += shi(yi[k], lane ^ 32); }
        int yq[4];
#pragma unroll
        for (int k = 0; k < 4; ++k) yq[k] = grp == 0 ? yi[k] : grp == 1 ? yi[4 + k] : grp == 2 ? yi[8 + k] : yi[12 + k];
        const f32x4 h2 = {bflo(mc.h1.x) + cs * (float)yq[0], bfhi(mc.h1.x) + cs * (float)yq[1], bflo(mc.h1.y) + cs * (float)yq[2], bfhi(mc.h1.y) + cs * (float)yq[3]};
        v2u hb; hb.x = pk2(h2[0], h2[1]); hb.y = pk2(h2[2], h2[3]);
        __builtin_amdgcn_raw_buffer_store_b64(hb, rW, (16 * sub + 4 * grp) * 2, (int)WS_HB + (t * D + SLW * s) * 2, 0);
        const float sq = wave_sum((h2[0] * h2[0] + h2[1] * h2[1]) + (h2[2] * h2[2] + h2[3] * h2[3]), lane);
        if (lane == 0) atomicAdd((unsigned long long*)(ws + WS_SSQ) + (size_t)(l + 1) * M + t, (unsigned long long)((double)sq * 4294967296.0));
        s = sn; t = tn; mc = mn;
    }
#undef PV_META
#undef WLD
#undef PV_ISSUE
#undef PV_COMP
}
__device__ __forceinline__ void final_norm_row(const Args& a, int t) {
    int lane; LANE_ID(lane);
    const bf16* HB = (const bf16*)(a.ws + WS_HB) + (size_t)t * D; float* O = a.out + (size_t)t * D;
    const float rf = rsqrtf(ssa_to_f(((const unsigned long long*)(a.ws + WS_SSQ))[(size_t)DEPTH * M + t]) * (1.0f / D) + EPS);
#pragma unroll
    for (int j = 0; j < 8; ++j) { const int k0 = 4 * lane + 256 * j; const v2u w = *(const v2u*)(HB + k0); const f32x4 g = *(const f32x4*)(a.norm_final + k0);
        *(f32x4*)(O + k0) = (f32x4){bflo(w.x) * rf * g[0], bfhi(w.x) * rf * g[1], bflo(w.y) * rf * g[2], bfhi(w.y) * rf * g[3]}; }
}

__global__ void __launch_bounds__(NT, 2) mk_fwd(ArgsK a_in) {
    extern __shared__ __attribute__((aligned(16))) unsigned char lds_raw[];
    LAS unsigned char* lds = (LAS unsigned char*)lds_raw;
    cg::grid_group grid = cg::this_grid();
    grid.sync();
    const int wave0 = __builtin_amdgcn_readfirstlane(threadIdx.x >> 6);
    const int G = gridDim.x;
    const CAS ArgsK* ka = (const CAS ArgsK*)__builtin_amdgcn_kernarg_segment_ptr();
    size_t zoff = 0;
#define PHASE_BEGIN() int lane; LANE_ID(lane); int blk = blockIdx.x, Gp = G, wv = wave0; asm volatile("" : "+s"(zoff), "+s"(ka), "+s"(blk), "+s"(Gp), "+s"(wv)); const int wave = wv, gw = blk * NWAVES + wv, NGW = Gp * NWAVES; (void)gw; (void)NGW; const Args a = load_args(ka, zoff); unsigned char* const ws = a.ws; (void)ws
    volatile LAS unsigned* bst = (volatile LAS unsigned*)(lds + RING_BYTES + 1024);
#define GRID_BAR() do { asm volatile("" : "+s"(zoff)); unsigned char* wsb_ = (unsigned char*)ka->ws + zoff; int wvb_ = wave0; asm volatile("" : "+s"(wvb_)); xcd_barrier((unsigned*)(wsb_ + WS_BAR), xb_xcc_id(), (unsigned)G, bst, wvb_); } while (0)
    volatile LAS unsigned* xinfo = bst + 4;
    { PHASE_BEGIN(); if (wave == 0 && lane == 0) { bst[0] = 0u; bst[1] = 0u; xinfo[2] = xb_add((unsigned*)(ws + WS_BAR) + XB_XCNT(xb_xcc_id()), 1u); }
      p0_cmax(a, gw, NGW, lane); }
    GRID_BAR();
    { PHASE_BEGIN(); p0_win_i8(a, lds, gw, NGW, wave, lane); p0_prologue(a, lds, gw, NGW, wave, lane); }
    GRID_BAR();
    {
        PHASE_BEGIN();
        if (wave == 0 && lane == 0) { unsigned* bar = (unsigned*)(ws + WS_BAR); const unsigned x = xb_xcc_id(); unsigned pos = 0, npop = 0, mine = 1;
            for (unsigned j = 0; j < 16; ++j) { const unsigned c = xb_ld(&bar[XB_XCNT(j)]); if (c) { ++npop; if (j < x) ++pos; } if (j == x) mine = c ? c : 1u; }
            xinfo[0] = pos; xinfo[1] = npop ? npop : 1u; xinfo[3] = mine; }
        __syncthreads();
    }
    int depth_rt = DEPTH; asm volatile("" : "+s"(depth_rt));
    for (int lc = 0; lc < depth_rt; ++lc) {
        int l = lc; asm volatile("" : "+s"(l));
        if (l > 0) { { PHASE_BEGIN(); quant_rows(a, l, gw, NGW, lane); } GRID_BAR(); }
        {
            PHASE_BEGIN();
            pg8::Gemm g{(const bf16*)(ws + WS_HB8), (const bf16*)(ws + WS_WIN + l * WIN_BYTES), M, NPROJ, D / 2}; pg8::StaticOrder S; S.init(M, NPROJ, Gp, blk);
            EpiProj E{ws, (const bf16*)(ws + WS_BIH) + l * NPROJ, (const float*)(ws + WS_RSA), (const bf16*)(ws + WS_SWH) + l * NPROJ};
            pg8::gemm_phase<EpiProj, pg8::StaticOrder, true, true>(lds, g, S, E, wave);
            forget_logits(a, l, gw, NGW, lane);
        }
        GRID_BAR();
#if defined(PROBE) && (PROBE == 2 || PROBE == 4)
        { PHASE_BEGIN(); const unsigned char* Gb = ws + WS_G; const bf16* PJ = (const bf16*)(ws + WS_PROJ);
          for (size_t i = (size_t)gw * 64 + lane; i < (size_t)M * D; i += (size_t)NGW * 64) { const size_t t = i / D, d = i % D;
            if (PROBE == 2) a.out[i] = (float)Gb[t * 8192 + d] + 3.0f * (float)Gb[t * 8192 + 2048 + d] + 7.0f * (float)Gb[t * 8192 + 4096 + d] + 13.0f * (float)Gb[t * 8192 + 6144 + d];
            else { float sacc = 0.f; for (int q = 0; q < 10; ++q) if ((d >> 9) == (q & 3)) sacc += (float)(q + 1) * bflo((unsigned)(unsigned short)PJ[(size_t)q * PROJ_T + t * MIXW + (d & 511)]) ; a.out[i] = sacc; } }
          return; }
#endif
        { PHASE_BEGIN(); mixers_fast(a, l, (LAS char*)lds, wave, lane, Gp, blk); }
        GRID_BAR();
#if defined(PROBE) && PROBE == 3
        { PHASE_BEGIN(); const bf16* src = (const bf16*)(ws + WS_Y);
          for (size_t i = (size_t)gw * 64 + lane; i < (size_t)M * D; i += (size_t)NGW * 64) a.out[i] = bflo((unsigned)(unsigned short)src[i]);
          return; }
#endif
        {
            PHASE_BEGIN();
            pg8::Gemm g{(const bf16*)(ws + WS_Y), (const bf16*)(ws + WS_WBR + l * SQ_BYTES), M, D, D}; pg8::StaticOrder S; S.init(M, D, Gp, blk);
            EpiMerge E{(const unsigned char*)(ws + WS_G), (bf16*)(ws + WS_MRG)};
            pg8::gemm_phase<EpiMerge, pg8::StaticOrder, false>(lds, g, S, E, wave);
        }
        GRID_BAR();
#if defined(PROBE) && PROBE == 1
        { PHASE_BEGIN(); const bf16* src = (const bf16*)(ws + WS_MRG);
          for (size_t i = (size_t)gw * 64 + lane; i < (size_t)M * D; i += (size_t)NGW * 64) a.out[i] = bflo((unsigned)(unsigned short)src[i]);
          return; }
#endif
        {
            PHASE_BEGIN();
            pg8::Gemm g{(const bf16*)(ws + WS_MRG), (const bf16*)(ws + WS_WOUT + l * SQ_BYTES), M, D, D}; pg8::StaticOrder S; S.init(M, D, Gp, blk);
            EpiRes E{l == 0 ? a.x : (const float*)nullptr, (bf16*)(ws + WS_HB), (unsigned long long*)(ws + WS_SSA) + l * M};
            pg8::gemm_phase<EpiRes, pg8::StaticOrder, false>(lds, g, S, E, wave);
        }
        GRID_BAR();
        {
            PHASE_BEGIN();
            pg8::Gemm g{(const bf16*)(ws + WS_HB), (const bf16*)(ws + WS_WQ + l * SQ_BYTES), M, D, D}; pg8::StaticOrder S; S.init(M, D, Gp, blk);
            EpiQ E{(bf16*)(ws + WS_Q), (const unsigned long long*)(ws + WS_SSA) + l * M};
            pg8::gemm_phase<EpiQ, pg8::StaticOrder, false>(lds, g, S, E, wave);
        }
        GRID_BAR();
        {
            PHASE_BEGIN(); (void)lane;
            for (int t0 = blk * PEER_TOK; t0 < M; t0 += Gp * PEER_TOK) {
                peer_retrieve(a, l, t0, wave, (LAS char*)lds, wave);
                __syncthreads();
                for (int k = 0; k < PEER_TOK / NWAVES; ++k) { const int tl = wave * (PEER_TOK / NWAVES) + k; peer_publish(a, l, t0 + tl, (LAS char*)lds, tl); }
                __syncthreads();
            }
        }
        GRID_BAR();
        {
            PHASE_BEGIN(); (void)lane;
            const int pos = __builtin_amdgcn_readfirstlane((int)xinfo[0]), npop = __builtin_amdgcn_readfirstlane((int)xinfo[1]), rank = __builtin_amdgcn_readfirstlane((int)xinfo[2]), nloc = __builtin_amdgcn_readfirstlane((int)xinfo[3]);
            const PeerItems it{pos, npop, rank, nloc, wave}; peer_u_wave(a, l, it);
        }
        GRID_BAR();
        {
            PHASE_BEGIN(); (void)lane;
            const int pos = __builtin_amdgcn_readfirstlane((int)xinfo[0]), npop = __builtin_amdgcn_readfirstlane((int)xinfo[1]), rank = __builtin_amdgcn_readfirstlane((int)xinfo[2]), nloc = __builtin_amdgcn_readfirstlane((int)xinfo[3]);
            const PeerItems it{pos, npop, rank, nloc, wave}; peer_v_wave(a, l, it);
        }
        GRID_BAR();
    }
    {
        PHASE_BEGIN(); (void)lane;
        for (int t = gw; t < M; t += NGW) final_norm_row(a, t);
    }
}

extern "C" void kernel_launch(void* const* d_in, const int* in_sizes, int n_in, void* d_out, int out_size, void* d_ws, size_t ws_size, hipStream_t stream) {
    static int grid = 0;
    if (grid == 0) {
        int dev = 0, cus = 0, per_cu = 0;
        if (n_in != 16 || out_size != M * D || ws_size < WS_END2) { fprintf(stderr, "kernel_launch: unexpected shapes (n_in %d out %d ws %zu)\n", n_in, out_size, ws_size); grid = -1; return; }
        (void)hipGetDevice(&dev);
        (void)hipDeviceGetAttribute(&cus, hipDeviceAttributeMultiprocessorCount, dev);
        (void)hipFuncSetAttribute((const void*)mk_fwd, hipFuncAttributeMaxDynamicSharedMemorySize, LDS_BYTES);
        (void)hipOccupancyMaxActiveBlocksPerMultiprocessor(&per_cu, (const void*)mk_fwd, NT, LDS_BYTES);
        if (per_cu < 1) { fprintf(stderr, "kernel_launch: occupancy query says %d blocks per CU\n", per_cu); }
        grid = cus;
        if (grid > 256) grid = 256;
    }
    if (grid < 0) return;
    (void)hipMemsetAsync((char*)d_ws + WS_CTL, 0, CTL_ZERO_BYTES, stream);
    ArgsK a{};
    const GAS float** p = (const GAS float**)&a;
    for (int i = 0; i < 16; ++i) p[i] = (const GAS float*)d_in[i];
    a.out = (GAS float*)d_out; a.ws = (GAS unsigned char*)d_ws;
    void* args[] = {&a};
    hipError_t e = hipLaunchCooperativeKernel((const void*)mk_fwd, dim3(grid), dim3(NT), args, LDS_BYTES, stream);
    if (e != hipSuccess) fprintf(stderr, "cooperative launch failed: %s (grid %d)\n", hipGetErrorString(e), grid);
}
```

```cpp
#include <hip/hip_runtime.h>
#include <hip/hip_cooperative_groups.h>
#include <cstdio>
#include <cstdint>
namespace cg = cooperative_groups;
namespace pg8 {
#define PG8_LAS __attribute__((address_space(3)))
typedef unsigned short bf16_t;
typedef short bf16x8 __attribute__((ext_vector_type(8)));
typedef float f32x4 __attribute__((ext_vector_type(4)));
typedef unsigned u32x4 __attribute__((ext_vector_type(4)));
typedef unsigned u32x2 __attribute__((ext_vector_type(2)));
typedef int i32x4 __attribute__((ext_vector_type(4)));
constexpr int BM = 256, BK = 64, HALF = 128, HTB = HALF * BK * 2  , STAGE_BYTES = 8 * HTB, NXCD = 8, WGM = 8;

__host__ __device__ __forceinline__ int lds_byte(int r, int c) { const int st = (r >> 4) * 2 + (c >> 5), rr = r & 15, cc = c & 31, ob = rr * 64 + cc * 2; return st * 1024 + (ob ^ (((ob >> 9) & 1) << 5)); }
__host__ __device__ __forceinline__ void stage_rc(int b, int& R, int& C) { const int st = b / 1024, sb = b % 1024, swz = sb ^ (((sb >> 9) & 1) << 5); R = (st >> 1) * 16 + swz / 64; C = (st & 1) * 32 + (swz % 64) / 2; }
__host__ __device__ __forceinline__ int perm32(int rho) { const int n = rho >> 4, i = rho & 15; return 8 * (i >> 2) + 4 * n + (i & 3); }

struct Unit { int pm, pn; };
struct Gemm { const bf16_t* A; const bf16_t* Bt; int M, N, K; };

struct StaticOrder {
    int nM, nN, nwg, G, c;
    __host__ __device__ void init(int M, int N, int G_, int c_) { nM = M / BM; nN = N / BM; nwg = nM * nN; G = G_; c = c_; }
    __host__ __device__ bool next(int i, Unit& u) const {
        const long L = (long)i * G + c; if (L >= nwg) return false;
        int wgid = (int)L; { const int q = nwg / NXCD, r = nwg % NXCD, xcd = wgid % NXCD, off = wgid / NXCD; wgid = (xcd < r ? xcd * (q + 1) : r * (q + 1) + (xcd - r) * q) + off; }
        const int nig = WGM * nN, gid = wgid / nig, fm = gid * WGM, gsz = (nM - fm) < WGM ? (nM - fm) : WGM;
        u.pm = fm + ((wgid % nig) % gsz); u.pn = (wgid % nig) / gsz; return true;
    }
};

__device__ __forceinline__ unsigned cvt_pk_bf16(float lo, float hi) { unsigned r; asm volatile("v_cvt_pk_bf16_f32 %0, %1, %2" : "=v"(r) : "v"(lo), "v"(hi)); return r; }

template <class Epi, class Sched, bool ALIGN_EPI = false, bool I8 = false>
__device__ __forceinline__ void gemm_phase(PG8_LAS unsigned char* lds, const Gemm g, const Sched& S, const Epi& E, int wid) {
    int lane_; asm volatile("v_mbcnt_lo_u32_b32 %0, -1, 0\n\tv_mbcnt_hi_u32_b32 %0, -1, %0" : "=v"(lane_));
    const int lane = lane_, tid = wid * 64 + lane, wr = wid >> 2, wc = wid & 3, fr = lane & 15, fq = lane >> 4;
    const int K = g.K, nt = K / BK;
    unsigned voffA, voffB;
    { int R, C; stage_rc(tid * 16, R, C); const int Rb = Epi::PERM ? ((R & ~31) + perm32(R & 31)) : R; voffA = (unsigned)(R * K + C) * 2u; voffB = (unsigned)(Rb * K + C) * 2u; }
    const size_t p2step = (size_t)64 * K * 2;
    const size_t kstep = (size_t)(BK * 2);
    const size_t hstep = (size_t)HALF * K * 2;
    const size_t tstep = 2 * hstep;
    const unsigned ldsw = (unsigned)wid * 1024u;
    const int aoff = lds_byte(wr * 64 + fr, fq * 8), boff = lds_byte(wc * 32 + fr, fq * 8);
#define PG8_SA(b, h) (((b) * 2 + (h)) * HTB)
#define PG8_SB(b, h) ((4 + (b) * 2 + (h)) * HTB)
#define PG8_STAGE(bufoff, gbase, voff) do { _Pragma("unroll") for (int _i = 0; _i < 2; ++_i) \
        __builtin_amdgcn_global_load_lds((const unsigned*)((const char*)(gbase) + _i * p2step + (voff)), (PG8_LAS unsigned*)(lds + (bufoff) + ldsw + _i * 8192), 16, 0, 0); } while (0)
#define PG8_LDA(dst, b, h) do { _Pragma("unroll") for (int m = 0; m < 4; ++m) _Pragma("unroll") for (int k = 0; k < 2; ++k) dst[m][k] = *(const PG8_LAS bf16x8*)(lds + PG8_SA(b, h) + aoff + m * 2048 + k * 1024); } while (0)
#define PG8_LDB(dst, b, h) do { _Pragma("unroll") for (int n = 0; n < 2; ++n) _Pragma("unroll") for (int k = 0; k < 2; ++k) dst[n][k] = *(const PG8_LAS bf16x8*)(lds + PG8_SB(b, h) + boff + n * 2048 + k * 1024); } while (0)
#define PG8_MMA(ai, bj, At, Bt) do { __builtin_amdgcn_s_setprio(1); _Pragma("unroll") for (int m = 0; m < 4; ++m) _Pragma("unroll") for (int n = 0; n < 2; ++n) _Pragma("unroll") for (int k = 0; k < 2; ++k) \
        { if constexpr (I8) acc[ai][bj][m][n] = __builtin_bit_cast(f32x4, __builtin_amdgcn_mfma_i32_16x16x64_i8(__builtin_bit_cast(i32x4, Bt[n][k]), __builtin_bit_cast(i32x4, At[m][k]), __builtin_bit_cast(i32x4, acc[ai][bj][m][n]), 0, 0, 0)); \
          else acc[ai][bj][m][n] = __builtin_amdgcn_mfma_f32_16x16x32_bf16(Bt[n][k], At[m][k], acc[ai][bj][m][n], 0, 0, 0); } __builtin_amdgcn_s_setprio(0); } while (0)
#define PG8_WAIT_V(n) asm volatile("s_waitcnt vmcnt(" #n ")" ::: "memory")
#define PG8_WAIT_L(n) asm volatile("s_waitcnt lgkmcnt(" #n ")" ::: "memory")
#define PG8_BAR __builtin_amdgcn_s_barrier()
#define PG8_SCHED __builtin_amdgcn_sched_barrier(0)
    Unit cur, nxt; int ui = 0;
    if (!S.next(0, cur)) return;
    f32x4 acc[2][2][4][2];
#pragma unroll
    for (int a = 0; a < 2; ++a)
#pragma unroll
        for (int b = 0; b < 2; ++b)
#pragma unroll
            for (int m = 0; m < 4; ++m)
#pragma unroll
                for (int n = 0; n < 2; ++n) acc[a][b][m][n] = (f32x4){0.f, 0.f, 0.f, 0.f};
    bf16x8 At[4][2], B0[2][2], B1[2][2];
    typename Epi::Pre pre = {};
    const char* cA = (const char*)g.A + (size_t)cur.pm * tstep; const char* cB = (const char*)g.Bt + (size_t)cur.pn * tstep;
    PG8_STAGE(PG8_SB(0, 0), cB, voffB); PG8_STAGE(PG8_SB(0, 1), cB + hstep, voffB); PG8_STAGE(PG8_SA(0, 0), cA, voffA); PG8_STAGE(PG8_SA(0, 1), cA + hstep, voffA);
    if (wr == 1) PG8_BAR;
    PG8_WAIT_V(2); PG8_BAR;
    PG8_STAGE(PG8_SB(1, 0), cB + kstep, voffB); PG8_STAGE(PG8_SA(1, 0), cA + kstep, voffA); PG8_STAGE(PG8_SB(1, 1), cB + hstep + kstep, voffB);
    PG8_WAIT_V(6); PG8_BAR;
    for (;;) {
        const bool has_next = S.next(ui + 1, nxt);
        const char* nA = has_next ? (const char*)g.A + (size_t)nxt.pm * tstep : cA; const char* nB = has_next ? (const char*)g.Bt + (size_t)nxt.pn * tstep : cB;
        const int seglen = Epi::HOOK ? 8 : nt;
        for (int t0 = 0; t0 < nt; t0 += seglen) {
        if constexpr (Epi::HOOK) { if (t0 > 0) { int ln_; asm volatile("v_mbcnt_lo_u32_b32 %0, -1, 0\n\tv_mbcnt_hi_u32_b32 %0, -1, %0" : "=v"(ln_)); E.hook(acc, cur, t0 >> 3, wr, wc, ln_ & 15, ln_ >> 4); } }
        for (int t = t0; t < t0 + seglen; t += 2) {
            const bool last = (t == nt - 2);
            if constexpr (Epi::PRELOAD) { if (last) { int ln_; asm volatile("v_mbcnt_lo_u32_b32 %0, -1, 0\n\tv_mbcnt_hi_u32_b32 %0, -1, %0" : "=v"(ln_)); E.preload(pre, cur, wr, wc, ln_ & 15, ln_ >> 4); } }
            const char* a1 = cA + (size_t)(t + 1) * kstep;
            const char* a2 = last ? nA : cA + (size_t)(t + 2) * kstep; const char* b2 = last ? nB : cB + (size_t)(t + 2) * kstep;
            const char* a3 = a2 + kstep; const char* b3 = b2 + kstep;
            PG8_LDB(B0, 0, 0); PG8_LDB(B1, 0, 1); PG8_SCHED; PG8_LDA(At, 0, 0); PG8_STAGE(PG8_SA(1, 1), a1 + hstep, voffA);
            PG8_WAIT_V(8); PG8_WAIT_L(0); PG8_BAR; PG8_MMA(0, 0, At, B0); PG8_MMA(0, 1, At, B1); PG8_BAR; PG8_SCHED;
            PG8_LDA(At, 0, 1); PG8_STAGE(PG8_SB(0, 0), b2, voffB); PG8_STAGE(PG8_SB(0, 1), b2 + hstep, voffB); PG8_STAGE(PG8_SA(0, 0), a2, voffA);
            PG8_WAIT_V(8); PG8_WAIT_L(0); PG8_BAR; PG8_MMA(1, 0, At, B0); PG8_MMA(1, 1, At, B1); PG8_BAR; PG8_SCHED;
            PG8_LDB(B0, 1, 0); PG8_LDB(B1, 1, 1); PG8_SCHED; PG8_LDA(At, 1, 0); PG8_STAGE(PG8_SA(0, 1), a2 + hstep, voffA);
            PG8_WAIT_V(8); PG8_WAIT_L(0); PG8_BAR; PG8_MMA(0, 0, At, B0); PG8_MMA(0, 1, At, B1); PG8_BAR; PG8_SCHED;
            PG8_LDA(At, 1, 1); PG8_STAGE(PG8_SB(1, 0), b3, voffB); PG8_STAGE(PG8_SB(1, 1), b3 + hstep, voffB); PG8_STAGE(PG8_SA(1, 0), a3, voffA);
            PG8_WAIT_V(8); PG8_WAIT_L(0); PG8_BAR; PG8_MMA(1, 0, At, B0); PG8_MMA(1, 1, At, B1); PG8_BAR; PG8_SCHED;
        }
        }
        if constexpr (ALIGN_EPI) { if (wr == 0) PG8_BAR; }
        { int ln_; asm volatile("v_mbcnt_lo_u32_b32 %0, -1, 0\n\tv_mbcnt_hi_u32_b32 %0, -1, %0" : "=v"(ln_));
          if constexpr (Epi::PRELOAD) E(acc, cur, wr, wc, ln_ & 15, ln_ >> 4, pre); else E(acc, cur, wr, wc, ln_ & 15, ln_ >> 4); }
        if (!has_next) break;
#pragma unroll
        for (int a = 0; a < 2; ++a)
#pragma unroll
            for (int b = 0; b < 2; ++b)
#pragma unroll
                for (int m = 0; m < 4; ++m)
#pragma unroll
                    for (int n = 0; n < 2; ++n) acc[a][b][m][n] = (f32x4){0.f, 0.f, 0.f, 0.f};
        cur = nxt; cA = nA; cB = nB; ++ui;
        if constexpr (ALIGN_EPI) { if (wr == 1) PG8_BAR; }
    }
    PG8_WAIT_V(0);
    if constexpr (!ALIGN_EPI) { if (wr == 0) PG8_BAR; }
    PG8_BAR;
#undef PG8_SA
#undef PG8_SB
#undef PG8_STAGE
#undef PG8_LDA
#undef PG8_LDB
#undef PG8_MMA
#undef PG8_WAIT_V
#undef PG8_WAIT_L
#undef PG8_BAR
#undef PG8_SCHED
}
}
constexpr int NWAVES = 8, NT = NWAVES * 64;
constexpr int M = 8192, D = 2048, SEQ = 2048, NBATCH = 4, DEPTH = 2;
constexpr int INW = 13316, NPROJ = 13312, MIXW = 512, HD = 128;
constexpr int PEER_E = 16384;
constexpr float EPS = 1e-6f;
constexpr float ATT_SCALE = 0.08838834764831845f;

constexpr size_t MiB = 1u << 20;
constexpr size_t WS_CTL = 0, CTL_ZERO_BYTES = 1 * MiB;
constexpr size_t WS_SSQ = 0;
constexpr size_t WS_SSA = 256 * 1024;
constexpr size_t WS_WF = 1 * MiB;
constexpr size_t WS_BINR = WS_WF + 64 * 1024;
constexpr size_t WS_LOGF = 2 * MiB;
constexpr size_t WS_CUM = 3 * MiB;
constexpr size_t WS_WIN = 8 * MiB;
constexpr size_t WIN_BYTES = (size_t)NPROJ * D;
constexpr size_t WS_SW = 7 * MiB;
constexpr size_t WS_CMAX = 384 * 1024;
constexpr size_t WS_HB8 = 64 * MiB;
constexpr size_t WS_SA = 7 * MiB + 512 * 1024;
constexpr size_t WS_WBR = 112 * MiB, WS_WOUT = 128 * MiB, WS_WQ = 144 * MiB;
constexpr size_t SQ_BYTES = (size_t)D * D * 2;
constexpr size_t WS_PU = 160 * MiB, WS_PV = 288 * MiB;
constexpr size_t PE_BYTES = (size_t)PEER_E * D;
constexpr size_t WS_PK = 6 * MiB;
constexpr size_t WS_SU = 5 * MiB, WS_SV = 5 * MiB + 256 * 1024;
constexpr size_t WS_HB = 480 * MiB;
constexpr size_t WS_PROJ = 512 * MiB;
constexpr size_t PROJ_T = (size_t)M * MIXW;
constexpr size_t WS_R = 592 * MiB;
constexpr size_t R_PLANE = (size_t)M * D;
constexpr size_t WS_Y = 720 * MiB;
constexpr size_t WS_MRG = 752 * MiB;
constexpr size_t WS_Q = 784 * MiB;
constexpr size_t WS_END = 816 * MiB;

constexpr int RING_BYTES = 131072;
constexpr int LDS_BYTES = 147456;

typedef unsigned short bf16;
typedef unsigned v4u __attribute__((ext_vector_type(4)));
typedef unsigned v2u __attribute__((ext_vector_type(2)));
typedef float f32x4 __attribute__((ext_vector_type(4)));
typedef float f32x2 __attribute__((ext_vector_type(2)));
using bf16x2 = __attribute__((ext_vector_type(2))) __bf16;
#define LAS __attribute__((address_space(3)))

__device__ __forceinline__ unsigned f2bf(float f) { unsigned u = __builtin_bit_cast(unsigned, f); return (u + 0x7fffu + ((u >> 16) & 1u)) >> 16; }
__device__ __forceinline__ unsigned pk2(float lo, float hi) { return f2bf(lo) | (f2bf(hi) << 16); }
__device__ __forceinline__ float bflo(unsigned w) { return __builtin_bit_cast(float, w << 16); }
__device__ __forceinline__ float bfhi(unsigned w) { return __builtin_bit_cast(float, w & 0xffff0000u); }
__device__ __forceinline__ float bf2f(bf16 b) { return __builtin_bit_cast(float, ((unsigned)b) << 16); }
__device__ __forceinline__ float shf(float v, int src) { return __builtin_bit_cast(float, __builtin_amdgcn_ds_bpermute(src << 2, __builtin_bit_cast(int, v))); }
__device__ __forceinline__ int shi(int v, int src) { return __builtin_amdgcn_ds_bpermute(src << 2, v); }
#define DPP_ROR(x, n) __builtin_bit_cast(float, __builtin_amdgcn_update_dpp(0, __builtin_bit_cast(int, (x)), 0x120 + (n), 0xf, 0xf, false))
__device__ __forceinline__ float wave_sum(float v, int) {
    v += DPP_ROR(v, 8); v += DPP_ROR(v, 4); v += DPP_ROR(v, 2); v += DPP_ROR(v, 1);
    const int vi = __builtin_bit_cast(int, v);
    const float r0 = __builtin_bit_cast(float, __builtin_amdgcn_readlane(vi, 0)), r1 = __builtin_bit_cast(float, __builtin_amdgcn_readlane(vi, 16)),
                r2 = __builtin_bit_cast(float, __builtin_amdgcn_readlane(vi, 32)), r3 = __builtin_bit_cast(float, __builtin_amdgcn_readlane(vi, 48));
    return (r0 + r1) + (r2 + r3);
}
__device__ __forceinline__ float wave_max(float v, int) {
    v = fmaxf(v, DPP_ROR(v, 8)); v = fmaxf(v, DPP_ROR(v, 4)); v = fmaxf(v, DPP_ROR(v, 2)); v = fmaxf(v, DPP_ROR(v, 1));
    const int vi = __builtin_bit_cast(int, v);
    const float r0 = __builtin_bit_cast(float, __builtin_amdgcn_readlane(vi, 0)), r1 = __builtin_bit_cast(float, __builtin_amdgcn_readlane(vi, 16)),
                r2 = __builtin_bit_cast(float, __builtin_amdgcn_readlane(vi, 32)), r3 = __builtin_bit_cast(float, __builtin_amdgcn_readlane(vi, 48));
    return fmaxf(fmaxf(r0, r1), fmaxf(r2, r3));
}
__device__ __forceinline__ float ssa_to_f(unsigned long long v) { return (float)((double)v * (1.0 / 4294967296.0)); }
__device__ __forceinline__ float dot2_bf16(unsigned w, unsigned x, float acc) { return __builtin_amdgcn_fdot2_f32_bf16(__builtin_bit_cast(bf16x2, w), __builtin_bit_cast(bf16x2, x), acc, false); }

#define LANE_ID(x) asm volatile("v_mbcnt_lo_u32_b32 %0, -1, 0\n\tv_mbcnt_hi_u32_b32 %0, -1, %0" : "=v"(x))
struct Args {
    const float *x, *norm_mix, *w_in, *b_in, *pool_w, *pool_scale, *conv_w, *rel_bias, *w_branch, *w_out, *norm_ffn, *peer_wq, *peer_keys, *peer_u, *peer_v, *norm_final;
    float* out; unsigned char* ws;
};
#define GAS __attribute__((address_space(1)))
#define CAS __attribute__((address_space(4)))
struct ArgsK {
    const GAS float *x, *norm_mix, *w_in, *b_in, *pool_w, *pool_scale, *conv_w, *rel_bias, *w_branch, *w_out, *norm_ffn, *peer_wq, *peer_keys, *peer_u, *peer_v, *norm_final;
    GAS float* out; GAS unsigned char* ws;
};
__device__ __forceinline__ Args load_args(const CAS ArgsK* k, size_t zoff) {
    Args a;
    a.x = (const float*)k->x; a.norm_mix = (const float*)k->norm_mix; a.w_in = (const float*)k->w_in; a.b_in = (const float*)k->b_in; a.pool_w = (const float*)k->pool_w;
    a.pool_scale = (const float*)k->pool_scale; a.conv_w = (const float*)k->conv_w; a.rel_bias = (const float*)k->rel_bias; a.w_branch = (const float*)k->w_branch;
    a.w_out = (const float*)k->w_out; a.norm_ffn = (const float*)k->norm_ffn; a.peer_wq = (const float*)k->peer_wq; a.peer_keys = (const float*)k->peer_keys;
    a.peer_u = (const float*)k->peer_u; a.peer_v = (const float*)k->peer_v; a.norm_final = (const float*)k->norm_final; a.out = (float*)k->out; a.ws = (unsigned char*)(k->ws + zoff);
    return a;
}

using pg8::f32x4; using pg8::Unit;
constexpr size_t WS_G = 896 * MiB;
constexpr size_t WS_SWH = 7 * MiB + 256 * 1024, WS_BIH = 7 * MiB + 384 * 1024;
constexpr size_t WS_RSA = 7 * MiB + 768 * 1024;
struct EpiProj {
    static constexpr bool PERM = true, HOOK = false, PRELOAD = true;
    struct Pre { pg8::u32x4 sw[2], bi[2]; float rs[2][4]; };
    unsigned char* wsb; const bf16* biash; const float* rsa; const bf16* swh;
    __device__ __forceinline__ void preload(Pre& p, const Unit& u, int wr, int wc, int fr, int fq) const {
        const int row0 = u.pm * 256 + wr * 64 + fr, bcol0 = u.pn * 256 + wc * 32 + 8 * fq;
#pragma unroll
        for (int bj = 0; bj < 2; ++bj) { p.sw[bj] = *(const pg8::u32x4*)(swh + bcol0 + bj * 128); p.bi[bj] = *(const pg8::u32x4*)(biash + bcol0 + bj * 128); }
#pragma unroll
        for (int ai = 0; ai < 2; ++ai)
#pragma unroll
            for (int m = 0; m < 4; ++m) p.rs[ai][m] = rsa[row0 + ai * 128 + m * 16];
    }
    static __device__ __forceinline__ unsigned g8(float z) { const float t = __builtin_amdgcn_rcpf(__builtin_amdgcn_exp2f(__builtin_fmaf(z, -1.4426950408889634f, -8.0f)) + 0.00390625f);
        return (unsigned)(__builtin_amdgcn_fmed3f(t, 1.0f, 255.0f) + 0.5f); }
    static __device__ __forceinline__ unsigned g8x4(const f32x4& v) { return g8(v[0]) | (g8(v[1]) << 8) | (g8(v[2]) << 16) | (g8(v[3]) << 24); }
    __device__ __forceinline__ void operator()(f32x4 (&acc)[2][2][4][2], const Unit& u, int wr, int wc, int fr, int fq, const Pre& p) const {
        const int cl0 = wc * 32 + 8 * fq;
#define ACCF(ai, bj, m, n) __builtin_convertvector(__builtin_bit_cast(pg8::i32x4, acc[ai][bj][m][n]), f32x4)
        const __amdgpu_buffer_rsrc_t rW = __builtin_amdgcn_make_buffer_rsrc((void*)wsb, 0, 0x7fffffff, 0x00020000);
        int sbase, ldb, voff;
        if (u.pn < 20) { sbase = (int)WS_PROJ + ((u.pn >> 1) * (int)PROJ_T + (u.pn & 1) * 256) * 2; ldb = MIXW * 2; voff = fr * ldb + cl0 * 2; }
        else { sbase = (int)WS_G + (u.pn - 20) * 256; ldb = 4 * D; voff = fr * ldb + wc * 64 + fq * 16; }
        sbase += (u.pm * 256 + wr * 64) * ldb;
#pragma unroll
        for (int bj = 0; bj < 2; ++bj) { const f32x4 w0 = {bflo(p.sw[bj].x), bfhi(p.sw[bj].x), bflo(p.sw[bj].y), bfhi(p.sw[bj].y)}, w1 = {bflo(p.sw[bj].z), bfhi(p.sw[bj].z), bflo(p.sw[bj].w), bfhi(p.sw[bj].w)};
            const f32x4 b0 = {bflo(p.bi[bj].x), bfhi(p.bi[bj].x), bflo(p.bi[bj].y), bfhi(p.bi[bj].y)}, b1 = {bflo(p.bi[bj].z), bfhi(p.bi[bj].z), bflo(p.bi[bj].w), bfhi(p.bi[bj].w)};
#pragma unroll
            for (int ai = 0; ai < 2; ++ai)
#pragma unroll
                for (int m = 0; m < 4; ++m) { const float rs = p.rs[ai][m]; const f32x4 v0 = ACCF(ai, bj, m, 0) * rs * w0 + b0, v1 = ACCF(ai, bj, m, 1) * rs * w1 + b1;
                    if (u.pn >= 20) { v2u w; w.x = g8x4(v0); w.y = g8x4(v1);
                        __builtin_amdgcn_raw_buffer_store_b64(w, rW, voff + bj * 8, sbase + (ai * 128 + m * 16) * ldb, 0); }
                    else { pg8::u32x4 w; w.x = pg8::cvt_pk_bf16(v0[0], v0[1]); w.y = pg8::cvt_pk_bf16(v0[2], v0[3]); w.z = pg8::cvt_pk_bf16(v1[0], v1[1]); w.w = pg8::cvt_pk_bf16(v1[2], v1[3]);
                        __builtin_amdgcn_raw_buffer_store_b128(w, rW, voff + bj * 256, sbase + (ai * 128 + m * 16) * ldb, 0); } } }
    }
};
#undef ACCF
struct EpiMerge {
    static constexpr bool PERM = true, HOOK = true; static constexpr bool PRELOAD = false; struct Pre {};
    const unsigned char* G; bf16* O;
    struct Bt { pg8::u32x4 n[4], d[4]; };
    __device__ __forceinline__ void scale(f32x4 (&acc)[2][2][4][2], const Unit& u, int g, int wr, int wc, int fr, int fq) const {
        const __amdgpu_buffer_rsrc_t rs = __builtin_amdgcn_make_buffer_rsrc((void*)G, 0, 0x7fffffff, 0x00020000);
        int voff = fr * 4 * D + 16 * fq; asm volatile("" : "+v"(voff));
        const int sden = (u.pm * 256 + wr * 64) * 4 * D + (g - 1) * D + u.pn * 256 + wc * 64, snum = sden + D;
        const bool fin = g == 4;
#define UB(x, e) ((float)(((x) >> (8 * (e))) & 255u))
#define MG_LOAD(B, b0) do { _Pragma("unroll") for (int i = 0; i < 4; ++i) { const int ai_ = ((b0) + i) >> 2, m_ = ((b0) + i) & 3, so_ = (ai_ * 128 + m_ * 16) * 4 * D; \
            B.d[i] = __builtin_amdgcn_raw_buffer_load_b128(rs, voff, sden + so_, 0); if (!fin) B.n[i] = __builtin_amdgcn_raw_buffer_load_b128(rs, voff, snum + so_, 0); } } while (0)
#define MG_APPLY(B, b0) do { _Pragma("unroll") for (int i = 0; i < 4; ++i) { const int ai_ = ((b0) + i) >> 2, m_ = ((b0) + i) & 3; \
            _Pragma("unroll") for (int q = 0; q < 4; ++q) { const unsigned dq = B.d[i][q], nq = B.n[i][q]; \
                f32x4 r = {UB(dq, 0), UB(dq, 1), UB(dq, 2), UB(dq, 3)}; \
                if (!fin) r *= (f32x4){__builtin_amdgcn_rcpf(UB(nq, 0)), __builtin_amdgcn_rcpf(UB(nq, 1)), __builtin_amdgcn_rcpf(UB(nq, 2)), __builtin_amdgcn_rcpf(UB(nq, 3))}; else r *= 0.00390625f; \
                acc[ai_][q >> 1][m_][q & 1] *= r; asm volatile("" : "+v"(acc[ai_][q >> 1][m_][q & 1])); } } } while (0)
        Bt A = {}, B = {};
        MG_LOAD(A, 0); MG_LOAD(B, 4);
        MG_APPLY(A, 0); asm volatile("" ::: "memory");
        MG_APPLY(B, 4); asm volatile("" ::: "memory");
#undef MG_LOAD
#undef MG_APPLY
#undef UB
    }
    __device__ __forceinline__ void hook(f32x4 (&acc)[2][2][4][2], const Unit& u, int g, int wr, int wc, int fr, int fq) const { scale(acc, u, g, wr, wc, fr, fq); }
    __device__ __forceinline__ void operator()(f32x4 (&acc)[2][2][4][2], const Unit& u, int wr, int wc, int fr, int fq) const {
        scale(acc, u, 4, wr, wc, fr, fq);
        const int row0 = u.pm * 256 + wr * 64 + fr, col0 = u.pn * 256 + wc * 32 + 8 * fq;
#pragma unroll
        for (int ai = 0; ai < 2; ++ai)
#pragma unroll
            for (int m = 0; m < 4; ++m) { bf16* rowp = O + (size_t)(row0 + ai * 128 + m * 16) * D + col0;
#pragma unroll
                for (int bj = 0; bj < 2; ++bj) { const f32x4 v0 = acc[ai][bj][m][0], v1 = acc[ai][bj][m][1];
                    pg8::u32x4 w; w.x = pg8::cvt_pk_bf16(v0[0], v0[1]); w.y = pg8::cvt_pk_bf16(v0[2], v0[3]); w.z = pg8::cvt_pk_bf16(v1[0], v1[1]); w.w = pg8::cvt_pk_bf16(v1[2], v1[3]);
                    *(pg8::u32x4*)(rowp + bj * 128) = w; } }
    }
};
struct EpiRes {
    static constexpr bool PERM = true, HOOK = false; static constexpr bool PRELOAD = false; struct Pre {};
    const float* X; bf16* HB; unsigned long long* ssa;
    __device__ __forceinline__ void operator()(f32x4 (&acc)[2][2][4][2], const Unit& u, int wr, int wc, int fr, int fq) const {
        const int row0 = u.pm * 256 + wr * 64 + fr, col0 = u.pn * 256 + wc * 32 + 8 * fq;
#pragma unroll
        for (int ai = 0; ai < 2; ++ai)
#pragma unroll
            for (int m = 0; m < 4; ++m) { const int row = row0 + ai * 128 + m * 16; const size_t off = (size_t)row * D + col0; float s = 0.f;
#pragma unroll
                for (int bj = 0; bj < 2; ++bj) { const size_t o = off + bj * 128; f32x4 h0, h1;
                    if (X != nullptr) { h0 = *(const f32x4*)(X + o); h1 = *(const f32x4*)(X + o + 4); }
                    else { const pg8::u32x4 w = *(const pg8::u32x4*)(HB + o); h0 = (f32x4){bflo(w.x), bfhi(w.x), bflo(w.y), bfhi(w.y)}; h1 = (f32x4){bflo(w.z), bfhi(w.z), bflo(w.w), bfhi(w.w)}; }
                    h0 += acc[ai][bj][m][0]; h1 += acc[ai][bj][m][1];
                    pg8::u32x4 w; w.x = pg8::cvt_pk_bf16(h0[0], h0[1]); w.y = pg8::cvt_pk_bf16(h0[2], h0[3]); w.z = pg8::cvt_pk_bf16(h1[0], h1[1]); w.w = pg8::cvt_pk_bf16(h1[2], h1[3]);
                    *(pg8::u32x4*)(HB + o) = w;
                    s += ((h0[0] * h0[0] + h0[1] * h0[1]) + (h0[2] * h0[2] + h0[3] * h0[3])) + ((h1[0] * h1[0] + h1[1] * h1[1]) + (h1[2] * h1[2] + h1[3] * h1[3])); }
                { const int ln = fq * 16 + fr; s += shf(s, ln ^ 16); s += shf(s, ln ^ 32); }
                if (fq == 0) atomicAdd(ssa + row, (unsigned long long)((double)s * 4294967296.0)); }
    }
};
struct EpiQ {
    static constexpr bool PERM = true, HOOK = false; static constexpr bool PRELOAD = false; struct Pre {};
    bf16* O; const unsigned long long* ssa;
    __device__ __forceinline__ void operator()(f32x4 (&acc)[2][2][4][2], const Unit& u, int wr, int wc, int fr, int fq) const {
        const int row0 = u.pm * 256 + wr * 64 + fr, col0 = u.pn * 256 + wc * 32 + 8 * fq;
#pragma unroll
        for (int ai = 0; ai < 2; ++ai)
#pragma unroll
            for (int m = 0; m < 4; ++m) { const int row = row0 + ai * 128 + m * 16; const float rs = rsqrtf(ssa_to_f(ssa[row]) * (1.0f / D) + EPS);
                bf16* rowp = O + (size_t)row * D + col0;
#pragma unroll
                for (int bj = 0; bj < 2; ++bj) { const f32x4 v0 = acc[ai][bj][m][0] * rs, v1 = acc[ai][bj][m][1] * rs;
                    pg8::u32x4 w; w.x = pg8::cvt_pk_bf16(v0[0], v0[1]); w.y = pg8::cvt_pk_bf16(v0[2], v0[3]); w.z = pg8::cvt_pk_bf16(v1[0], v1[1]); w.w = pg8::cvt_pk_bf16(v1[2], v1[3]);
                    *(pg8::u32x4*)(rowp + bj * 128) = w; } }
    }
};

__device__ __forceinline__ int colmap_in(int j) { return j < 1536 ? j : j + 4; }
__device__ __forceinline__ void tr_item_i8(const float* W, const float* gain, const unsigned* cmax, unsigned char* WT, LAS float* scr, int k0, int n0, int lane) {
    const int q = lane & 7, r8 = lane >> 3, sc = colmap_in(n0 + 4 * q);
    f32x4 v[8];
#pragma unroll
    for (int i = 0; i < 8; ++i) v[i] = *(const f32x4*)(W + (size_t)(k0 + 8 * i + r8) * INW + sc);
    f32x4 inv;
#pragma unroll
    for (int e = 0; e < 4; ++e) { const float cm = __builtin_bit_cast(float, cmax[sc + e]); inv[e] = cm > 0.f ? 127.0f / cm : 0.f; }
#pragma unroll
    for (int i = 0; i < 8; ++i) { const float g = gain[k0 + 8 * i + r8];
#pragma unroll
        for (int e = 0; e < 4; ++e) scr[(8 * i + r8) * 33 + 4 * q + e] = v[i][e] * g * inv[e]; }
    asm volatile("s_waitcnt lgkmcnt(0)" ::: "memory");
    const int n = lane >> 1, hf = lane & 1;
    v4u o[2];
#pragma unroll
    for (int w = 0; w < 8; ++w) { unsigned pk = 0;
#pragma unroll
        for (int b = 0; b < 4; ++b) pk |= ((unsigned)((int)rintf(scr[(32 * hf + 4 * w + b) * 33 + n]) & 255)) << (8 * b);
        o[w >> 2][w & 3] = pk; }
    unsigned char* dst = WT + (size_t)(n0 + n) * D + k0 + 32 * hf;
    *(v4u*)dst = o[0]; *(v4u*)(dst + 16) = o[1];
    asm volatile("s_waitcnt lgkmcnt(0)" ::: "memory");
}
template <bool MAP>
__device__ __forceinline__ void tr_item(const float* W, int ldw, const float* scale, bf16* WT, int ldt, int dcol0, LAS float* scr, int k0, int n0, int lane) {
    const int q = lane & 7, r8 = lane >> 3, sc = MAP ? colmap_in(n0 + 4 * q) : (n0 + 4 * q);
    f32x4 v[8];
#pragma unroll
    for (int i = 0; i < 8; ++i) v[i] = *(const f32x4*)(W + (size_t)(k0 + 8 * i + r8) * ldw + sc);
    f32x4 s0 = {1.f, 1.f, 1.f, 1.f}, s1 = s0;
    if (scale) { s0 = *(const f32x4*)(scale + k0 + 8 * q); s1 = *(const f32x4*)(scale + k0 + 8 * q + 4); }
#pragma unroll
    for (int i = 0; i < 8; ++i)
#pragma unroll
        for (int e = 0; e < 4; ++e) scr[(8 * i + r8) * 33 + 4 * q + e] = v[i][e];
    asm volatile("s_waitcnt lgkmcnt(0)" ::: "memory");
    const int c = q;
#pragma unroll
    for (int j = 0; j < 4; ++j) { const int n = r8 + 8 * j; const LAS float* s = scr + (8 * c) * 33 + n;
        v4u o; o.x = pk2(s[0 * 33] * s0[0], s[1 * 33] * s0[1]); o.y = pk2(s[2 * 33] * s0[2], s[3 * 33] * s0[3]); o.z = pk2(s[4 * 33] * s1[0], s[5 * 33] * s1[1]); o.w = pk2(s[6 * 33] * s1[2], s[7 * 33] * s1[3]);
        *(v4u*)(WT + (size_t)(n0 + n) * ldt + dcol0 + k0 + 8 * c) = o; }
    asm volatile("s_waitcnt lgkmcnt(0)" ::: "memory");
}
constexpr size_t WS_BAR = 512 * 1024;
#define XB_TMO      128
#define XB_XCNT(j)  (256  + 64 * (j))
#define XB_XSUB(j)  (1280 + 64 * (j))
#define XB_XGEN(j)  (2304 + 64 * (j))
#define XB_TOP      3328
#define XB_TOPGEN   3392
#define XCD_BAR_WORDS 3456
#define XB_SPIN_CAP (1u << 23)
__device__ __forceinline__ unsigned xb_ld(unsigned* p)              { return __hip_atomic_load(p, __ATOMIC_RELAXED, __HIP_MEMORY_SCOPE_AGENT); }
__device__ __forceinline__ unsigned xb_add(unsigned* p, unsigned v) { return __hip_atomic_fetch_add(p, v, __ATOMIC_RELAXED, __HIP_MEMORY_SCOPE_AGENT); }
__device__ __forceinline__ unsigned xb_xcc_id() { return (unsigned)__builtin_amdgcn_s_getreg((3 << 11) | 20) & 0xFu; }
#define XB_SPIN(cond, bar) do { unsigned _sp = 0; while (cond) { __builtin_amdgcn_s_sleep(1); \
    if ((++_sp & 255u) == 0u) { if (xb_ld(&(bar)[XB_TMO])) break; if (_sp > XB_SPIN_CAP) { atomicAdd(&(bar)[XB_TMO], 1u); break; } } } } while (0)
__device__ __forceinline__ void xcd_barrier_complete(unsigned* bar, unsigned x, unsigned G, unsigned& nloc, unsigned& nx) {
    unsigned sum, cnt, mine, sp = 0u;
    for (;;) {
        sum = 0u; cnt = 0u; mine = 0u;
#pragma unroll
        for (unsigned j = 0; j < 16; ++j) { const unsigned c = xb_ld(&bar[XB_XCNT(j)]); sum += c; cnt += (c > 0u) ? 1u : 0u; mine = (j == x) ? c : mine; }
        if (sum == G) break;
        __builtin_amdgcn_s_sleep(1);
        if ((++sp & 255u) == 0u) { if (xb_ld(&bar[XB_TMO])) break; if (sp > XB_SPIN_CAP) { atomicAdd(&bar[XB_TMO], 1u); break; } }
    }
    nloc = mine > 0u ? mine : 1u; nx = cnt > 0u ? cnt : 1u;
}
__device__ __forceinline__ void xcd_barrier(unsigned* bar, unsigned x, unsigned G, volatile LAS unsigned* st, int wave) {
    asm volatile("s_waitcnt vmcnt(0)" ::: "memory");
    __syncthreads();
    int lane; asm volatile("v_mbcnt_lo_u32_b32 %0, -1, 0\n\tv_mbcnt_hi_u32_b32 %0, -1, %0" : "=v"(lane));
    if (wave == 0 && lane == 0) {
        __builtin_amdgcn_s_waitcnt(0);
        unsigned nloc = st[0], nx = st[1];
        if (nloc == 0u) { xcd_barrier_complete(bar, x, G, nloc, nx); st[0] = nloc; st[1] = nx; }
        const unsigned old = xb_add(&bar[XB_XSUB(x)], 1u);
        const unsigned gen = old / nloc;
        if (old + 1u == (gen + 1u) * nloc) {
            __builtin_amdgcn_fence(__ATOMIC_RELEASE, "agent");
            asm volatile("s_waitcnt vmcnt(0)" ::: "memory");
            const unsigned og = xb_add(&bar[XB_TOP], 1u);
            const unsigned tg = og / nx;
            if (og + 1u == (tg + 1u) * nx) xb_add(&bar[XB_TOPGEN], 1u);
            else XB_SPIN(xb_ld(&bar[XB_TOPGEN]) == tg, bar);
            __builtin_amdgcn_fence(__ATOMIC_ACQUIRE, "agent");
            xb_add(&bar[XB_XGEN(x)], 1u);
            asm volatile("s_waitcnt vmcnt(0)" ::: "memory");
        } else {
            XB_SPIN(xb_ld(&bar[XB_XGEN(x)]) == gen, bar);
            __builtin_amdgcn_fence(__ATOMIC_ACQUIRE, "agent");
            asm volatile("s_waitcnt vmcnt(0)" ::: "memory");
        }
    }
    __syncthreads();
}
namespace att {
constexpr int D = 128, NW = 8, QBLK = 32, KVBLK = 64, QB = NW * QBLK;
constexpr int PITCH = 512, OPITCH = 2048;
constexpr float SCALE = 0.08838834764831845f, THR = 8.f;
constexpr int SHM_V = KVBLK * D * 2, SHM_K = KVBLK * D * 2;
constexpr int OFF_WS = 2 * SHM_V + 2 * SHM_K, OFF_CUM = OFF_WS + NW * 64 * 4, OFF_REL = OFF_CUM + 2048 * 4, LDS_END = OFF_REL + 320 * 4;
typedef unsigned short bf16;
typedef short bf16x8 __attribute__((ext_vector_type(8)));
typedef short s16x4 __attribute__((ext_vector_type(4)));
typedef float f32x16 __attribute__((ext_vector_type(16)));
typedef float f32x4 __attribute__((ext_vector_type(4)));
typedef unsigned u32x4 __attribute__((ext_vector_type(4)));
#define ALDS __attribute__((address_space(3)))

#define KSWZ(row, colB) ((row) * 256 + ((colB) ^ (((row) & 7) << 4)))
#define SBAR() __builtin_amdgcn_sched_barrier(0)
__device__ __forceinline__ int v_st(int k, int c) { const int kk = (k & ~0xC) | ((k & 4) << 1) | ((k & 8) >> 1); return ((kk >> 3) * 4 + (c >> 5)) * 512 + ((kk & 7) * 32 + (c & 31)) * 2; }
__device__ __forceinline__ int v_rd_base(int lane) { return ((lane & 3) << 3) | (((lane >> 2) & 3) << 6) | (((lane >> 4) & 1) << 5) | (((lane >> 5) & 1) << 8); }
constexpr int v_rd_off(int d0, int ks, int half) { return d0 * 512 + ks * 4096 + half * 2048; }
__device__ __forceinline__ int crow(int r, int hi) { return (r & 3) + 8 * (r >> 2) + 4 * hi; }
__device__ __forceinline__ unsigned cvtpk(float lo, float hi) { unsigned r; asm volatile("v_cvt_pk_bf16_f32 %0, %1, %2" : "=v"(r) : "v"(lo), "v"(hi)); return r; }
__device__ __forceinline__ bf16x8 load8(const bf16* p) { return *reinterpret_cast<const bf16x8*>(p); }

__device__ __forceinline__ void mask_tile(f32x16& p0, f32x16& p1, int dq) {
    const float NEG = -__builtin_inff();
#pragma unroll
    for (int r = 0; r < 16; ++r) { const int c = (r & 3) + 8 * (r >> 2);
        if (dq - c < 0) p0[r] = NEG;
        if (dq - c - 32 < 0) p1[r] = NEG; }
}
__device__ __forceinline__ void partialSM(f32x16& p0, f32x16& p1, float& m_reg, float& mn, float& alpha) {
    float pmax = p0[0];
#pragma unroll
    for (int r = 1; r < 16; ++r) pmax = fmaxf(pmax, p0[r]);
#pragma unroll
    for (int r = 0; r < 16; ++r) pmax = fmaxf(pmax, p1[r]);
    { auto rr = __builtin_amdgcn_permlane32_swap(__float_as_uint(pmax), __float_as_uint(pmax), false, false);
      pmax = fmaxf(__uint_as_float(rr[0]), __uint_as_float(rr[1])); }
    constexpr float C2 = 1.4426950408889634f * SCALE;
    if (__builtin_expect(__all((pmax - m_reg) * SCALE <= THR), 1)) { mn = m_reg; alpha = 1.f; }
    else { mn = fmaxf(m_reg, pmax); alpha = __builtin_amdgcn_exp2f((m_reg - mn) * C2); m_reg = mn; }
    const float mnL = -mn * C2;
#pragma unroll
    for (int r = 0; r < 16; ++r) p0[r] = fmaf(p0[r], C2, mnL);
#pragma unroll
    for (int r = 0; r < 16; ++r) p1[r] = fmaf(p1[r], C2, mnL);
#pragma unroll
    for (int r = 0; r < 16; ++r) p0[r] = __builtin_amdgcn_exp2f(p0[r]);
}
__device__ __forceinline__ void finishSM(f32x16& p0, f32x16& p1, float alpha, float& l_reg, bf16x8& pa0, bf16x8& pa1, bf16x8& pa2, bf16x8& pa3) {
#pragma unroll
    for (int r = 0; r < 16; ++r) p1[r] = __builtin_amdgcn_exp2f(p1[r]);
    float ps = 0;
#pragma unroll
    for (int r = 0; r < 16; ++r) ps += p0[r];
#pragma unroll
    for (int r = 0; r < 16; ++r) ps += p1[r];
    { auto rr = __builtin_amdgcn_permlane32_swap(__float_as_uint(ps), __float_as_uint(ps), false, false);
      ps = __uint_as_float(rr[0]) + __uint_as_float(rr[1]); }
    l_reg = l_reg * alpha + ps;
#define PK4(P, B_, OUT) do { unsigned a0 = cvtpk(P[B_+0], P[B_+1]), a1 = cvtpk(P[B_+2], P[B_+3]);                          \
        unsigned b0 = cvtpk(P[B_+4], P[B_+5]), b1 = cvtpk(P[B_+6], P[B_+7]);                                             \
        auto r0 = __builtin_amdgcn_permlane32_swap(a0, b0, false, false); auto r1 = __builtin_amdgcn_permlane32_swap(a1, b1, false, false); \
        u32x4 w = {r0[0], r1[0], r0[1], r1[1]}; OUT = *reinterpret_cast<bf16x8*>(&w); } while (0)
    PK4(p0, 0, pa0); PK4(p0, 8, pa1); PK4(p1, 0, pa2); PK4(p1, 8, pa3);
#undef PK4
}
template <int KB>
__device__ __forceinline__ void qkt(f32x16& p0, f32x16& p1, const ALDS char* K_lds, int r32, int hi, const bf16x8* qr, bool act) {
    if (!act) { const float NEG = -__builtin_inff();
#pragma unroll
        for (int r = 0; r < 16; ++r) { p0[r] = NEG; p1[r] = NEG; } return; }
    p0 = f32x16{}; p1 = f32x16{};
    const ALDS char* kb[4];
#pragma unroll
    for (int dd = 0; dd < 4; ++dd) kb[dd] = K_lds + KB * SHM_K + KSWZ(r32, (dd * 16 + hi * 8) * 2);
#pragma unroll
    for (int d0 = 0; d0 < 8; ++d0) { const ALDS char* a = kb[d0 & 3] + (d0 >> 2) * 128;
        bf16x8 b0 = *(const ALDS bf16x8*)(a);
        bf16x8 b1 = *(const ALDS bf16x8*)(a + 32 * 256);
        p0 = __builtin_amdgcn_mfma_f32_32x32x16_bf16(b0, qr[d0], p0, 0, 0, 0);
        p1 = __builtin_amdgcn_mfma_f32_32x32x16_bf16(b1, qr[d0], p1, 0, 0, 0); }
}
template <int VB>
__device__ __forceinline__ void pv_tile(f32x16* o, int vb0, bf16x8 pa0, bf16x8 pa1, bf16x8 pa2, bf16x8 pa3, bool act) {
    if (!act) return;
#define TRRD(dst, off) asm volatile("ds_read_b64_tr_b16 %0, %1 offset:%2" : "=&v"(dst) : "v"(vb0), "i"(off) : "memory")
#define PV_D0(d0) do { s16x4 l0, l1, l2, l3, h0, h1, h2, h3; constexpr int b_ = VB * SHM_V + v_rd_off(d0, 0, 0); \
        TRRD(l0, b_); TRRD(h0, b_ + 2048); TRRD(l1, b_ + 4096); TRRD(h1, b_ + 6144); TRRD(l2, b_ + 8192); TRRD(h2, b_ + 10240); TRRD(l3, b_ + 12288); TRRD(h3, b_ + 14336); \
        asm volatile("s_waitcnt lgkmcnt(0)" ::: "memory"); SBAR(); \
        o[d0] = __builtin_amdgcn_mfma_f32_32x32x16_bf16(pa0, (bf16x8){l0[0], l0[1], l0[2], l0[3], h0[0], h0[1], h0[2], h0[3]}, o[d0], 0, 0, 0);   \
        o[d0] = __builtin_amdgcn_mfma_f32_32x32x16_bf16(pa1, (bf16x8){l1[0], l1[1], l1[2], l1[3], h1[0], h1[1], h1[2], h1[3]}, o[d0], 0, 0, 0);   \
        o[d0] = __builtin_amdgcn_mfma_f32_32x32x16_bf16(pa2, (bf16x8){l2[0], l2[1], l2[2], l2[3], h2[0], h2[1], h2[2], h2[3]}, o[d0], 0, 0, 0);   \
        o[d0] = __builtin_amdgcn_mfma_f32_32x32x16_bf16(pa3, (bf16x8){l3[0], l3[1], l3[2], l3[3], h3[0], h3[1], h3[2], h3[3]}, o[d0], 0, 0, 0); } while (0)
    PV_D0(0); PV_D0(1); PV_D0(2); PV_D0(3);
#undef PV_D0
#undef TRRD
}
template <int MODE>
__device__ __forceinline__ void bias_mask(f32x16& p0, f32x16& p1, const ALDS char* lds, int kb, int qlo, int qpos, int hi, float cqs, bool act) {
    if (!act) return;
    if (MODE == 0) {
        const ALDS float* cs = (const ALDS float*)(lds + OFF_CUM) + kb + 4 * hi;
#pragma unroll
        for (int g = 0; g < 4; ++g) { const f32x4 c0 = *(const ALDS f32x4*)(cs + 8 * g), c1 = *(const ALDS f32x4*)(cs + 32 + 8 * g);
#pragma unroll
            for (int e = 0; e < 4; ++e) { p0[4 * g + e] += cqs - c0[e]; p1[4 * g + e] += cqs - c1[e]; } }
        if (kb + KVBLK - 1 > qlo) mask_tile(p0, p1, qpos - 4 * hi - kb);
    } else {
        const ALDS float* tb = (const ALDS float*)(lds + OFF_REL);
        if (qlo - (kb + KVBLK - 1) >= 256) { const float c = tb[319];
#pragma unroll
            for (int r = 0; r < 16; ++r) { p0[r] += c; p1[r] += c; } }
        else { const int d0 = qpos - kb - 4 * hi + 63;
#pragma unroll
            for (int r = 0; r < 16; ++r) { const int c = (r & 3) + 8 * (r >> 2);
                int i0 = d0 - c, i1 = d0 - c - 32; i0 = i0 > 319 ? 319 : i0; i1 = i1 > 319 ? 319 : i1; i1 = i1 < 0 ? 0 : i1; i0 = i0 < 0 ? 0 : i0;
                p0[r] += tb[i0]; p1[r] += tb[i1]; } }
    }
}

struct Seam { bf16x8 qr[8]; bf16x8 st_v0, st_v1, st_k0, st_k1; };
#define VMW() asm volatile("s_waitcnt vmcnt(0)" ::: "memory")
#define BL8(rs, vo, so) __builtin_bit_cast(bf16x8, __builtin_amdgcn_raw_buffer_load_b128(rs, vo, so, 0))
#define SLOAD_H(Kp, Vp, k0) do { S.st_v0 = BL8(rP, kvoff, (Vp) + (k0) * (PITCH * 2)); S.st_v1 = BL8(rP, kvoff, (Vp) + ((k0) + 32) * (PITCH * 2));              \
                         S.st_k0 = BL8(rP, kvoff, (Kp) + (k0) * (PITCH * 2)); S.st_k1 = BL8(rP, kvoff, (Kp) + ((k0) + 32) * (PITCH * 2)); } while (0)
#define SWRITE_HK(bf) do { *(ALDS bf16x8*)(K_lds + (bf) * SHM_K + kws) = S.st_k0; *(ALDS bf16x8*)(K_lds + (bf) * SHM_K + kws + 32 * 256) = S.st_k1; } while (0)
#define SWRITE_HV(bf) do { *(ALDS bf16x8*)(V_lds + (bf) * SHM_V + vst0) = S.st_v0; *(ALDS bf16x8*)(V_lds + (bf) * SHM_V + vst1) = S.st_v1; } while (0)
#define SWRITE_H(bf) do { SWRITE_HV(bf); SWRITE_HK(bf); } while (0)

template <int MODE>
__device__ __forceinline__ void attn_unit(const bf16* Pb, int Qo, int Kh, int Vh, bf16* Yb, int Oo, int P0, int j_lo, int j_hi, ALDS char* lds, int wid, int lane) {
    const int tid = wid * 64 + lane, r32 = lane & 31, hi = lane >> 5;
    const int NT = j_hi - j_lo;
    const int qlo = P0 + wid * QBLK, qpos = qlo + r32;
    ALDS char* V_lds = lds; ALDS char* K_lds = lds + 2 * SHM_V;
    ALDS float* ws = (ALDS float*)(lds + OFF_WS) + wid * 64; ALDS float* li_l = ws; ALDS float* al_l = ws + 32;
    float m_reg = -1e30f, l_reg = 0; f32x16 o[4] = {};
    const int sr = tid >> 4, sc = (tid & 15) * 8, vst0 = v_st(sr, sc), vst1 = v_st(32 + sr, sc), kws = KSWZ(sr, sc * 2);
    const int vb0 = (int)(unsigned)(size_t)V_lds + v_rd_base(lane);
    Seam S;
    const __amdgpu_buffer_rsrc_t rP = __builtin_amdgcn_make_buffer_rsrc((void*)Pb, 0, 0x7fffffff, 0x00020000);
    const __amdgpu_buffer_rsrc_t rO = __builtin_amdgcn_make_buffer_rsrc((void*)Yb, 0, 0x7fffffff, 0x00020000);
    const int kvoff = (sr * PITCH + sc) * 2;
#define KBASE(t) ((j_lo + (t)) * KVBLK)
#define ACT(t) (MODE == 0 ? (KBASE(t) <= qlo + QBLK - 1) : ((j_lo + (t)) <= (qlo >> 6) && (j_lo + (t)) + 8 >= (qlo >> 6)))
#define RESC(a) do { if (__any((a) < 1.f)) { if (hi == 0) al_l[r32] = (a); asm volatile("s_waitcnt lgkmcnt(0)" ::: "memory");              \
                     for (int d_ = 0; d_ < 4; ++d_) for (int r = 0; r < 16; ++r) o[d_][r] *= al_l[crow(r, hi)]; } } while (0)
#define MASKT(P0_, P1_, t) bias_mask<MODE>(P0_, P1_, lds, KBASE(t), qlo, qpos, hi, cq_, ACT(t))
    {
        const int kb0 = j_lo * KVBLK;
#pragma unroll
        for (int d0 = 0; d0 < 8; ++d0) S.qr[d0] = BL8(rP, (r32 * PITCH + hi * 8) * 2 + d0 * 32, Qo + wid * (QBLK * PITCH * 2));
        SLOAD_H(Kh, Vh, kb0); VMW(); SWRITE_HK(0);
        __syncthreads();
    }
    const float cq_ = MODE == 0 ? ((const ALDS float*)(lds + OFF_CUM))[qpos] : 0.f;
    f32x16 pA0, pA1, pB0, pB1; float mnA, mnB, alA, alB; bf16x8 pa0, pa1, pa2, pa3;
    SWRITE_HV(0); SBAR();
    if (NT > 1) { SLOAD_H(Kh, Vh, KBASE(1)); }
    SBAR(); qkt<0>(pA0, pA1, K_lds, r32, hi, S.qr, ACT(0));
    MASKT(pA0, pA1, 0); partialSM(pA0, pA1, m_reg, mnA, alA);
    if (NT > 1) { VMW(); SWRITE_H(1); }
    __syncthreads();
#define HALF_STEP(PX0, PX1, mnX, alX, PY0, PY1, alY, t, KB, VB, SB) do {                                                      \
        SBAR(); qkt<KB>(PX0, PX1, K_lds, r32, hi, S.qr, ACT(t));                                                              \
        finishSM(PY0, PY1, alY, l_reg, pa0, pa1, pa2, pa3); SBAR();                                                           \
        if ((t) + 1 < NT) { SLOAD_H(Kh, Vh, KBASE((t) + 1)); SBAR(); }                                                        \
        pv_tile<VB>(o, vb0, pa0, pa1, pa2, pa3, ACT((t) - 1)); MASKT(PX0, PX1, (t)); partialSM(PX0, PX1, m_reg, mnX, alX);    \
        __syncthreads();                                                                                                      \
        if ((t) + 1 < NT) { VMW(); SWRITE_H(SB); }                                                                            \
        RESC(alX); __syncthreads(); } while (0)
    for (int t = 1; t + 1 < NT; t += 2) {
        HALF_STEP(pB0, pB1, mnB, alB, pA0, pA1, alA, t, 1, 0, 0);
        HALF_STEP(pA0, pA1, mnA, alA, pB0, pB1, alB, t + 1, 0, 1, 1);
    }
    const bool even = (NT & 1) == 0;
    if (even) { SBAR(); qkt<1>(pB0, pB1, K_lds, r32, hi, S.qr, ACT(NT - 1)); SBAR(); }
    finishSM(pA0, pA1, alA, l_reg, pa0, pa1, pa2, pa3); SBAR();
    pv_tile<0>(o, vb0, pa0, pa1, pa2, pa3, ACT(even ? NT - 2 : NT - 1));
    if (even) { MASKT(pB0, pB1, NT - 1); partialSM(pB0, pB1, m_reg, mnB, alB); __syncthreads(); RESC(alB);
        finishSM(pB0, pB1, alB, l_reg, pa0, pa1, pa2, pa3); SBAR(); pv_tile<1>(o, vb0, pa0, pa1, pa2, pa3, ACT(NT - 1)); }
    SBAR();
    if (hi == 0) li_l[r32] = l_reg; asm volatile("s_waitcnt lgkmcnt(0)" ::: "memory");
    float rli[16];
#pragma unroll
    for (int r = 0; r < 16; ++r) rli[r] = __builtin_amdgcn_rcpf(li_l[crow(r, hi)]);
    const int ovoff = (4 * hi * OPITCH + r32) * 2, osoff = Oo + wid * (QBLK * OPITCH * 2);
#pragma unroll
    for (int r = 0; r < 16; ++r) { const int orow = (r & 3) + 8 * (r >> 2);
#pragma unroll
        for (int d0 = 0; d0 < 4; ++d0) { const float v = o[d0][r] * rli[r];
            const float vn = __builtin_bit_cast(float, __builtin_amdgcn_ds_bpermute((lane ^ 1) << 2, __builtin_bit_cast(int, v)));
            if ((r32 & 1) == 0) __builtin_amdgcn_raw_buffer_store_b32(cvtpk(v, vn), rO, ovoff + d0 * 64, osoff + orow * (OPITCH * 2), 0); } }
    __syncthreads();
#undef RESC
#undef KBASE
#undef ACT
#undef MASKT
#undef HALF_STEP
}
#undef BL8
#undef VMW
#undef SLOAD_H
#undef SWRITE_HK
#undef SWRITE_HV
#undef SWRITE_H
#undef KSWZ
#undef SBAR
}
constexpr size_t WS_QCTR = 768 * 1024;
constexpr size_t WS_POOLW = 4 * MiB;
constexpr int N_ATT_UNITS = 256, N_POOL_UNITS = 512, N_CONV_UNITS = 128;

__device__ __forceinline__ void stage_cum(const Args& a, int b, int h, LAS char* lds, int wave, int lane) {
    const float* logf = (const float*)(a.ws + WS_LOGF) + ((size_t)b * SEQ) * 4 + h;
    const int tid = wave * 64 + lane;
    float v[4];
#pragma unroll
    for (int e = 0; e < 4; ++e) v[e] = logf[(size_t)(4 * tid + e) * 4];
    v[1] += v[0]; v[2] += v[1]; v[3] += v[2];
    float incl = v[3];
#pragma unroll
    for (int o = 1; o < 64; o <<= 1) { const float t = shf(incl, lane >= o ? lane - o : lane); if (lane >= o) incl += t; }
    LAS float* wt = (LAS float*)(lds + att::OFF_WS);
    if (lane == 63) wt[wave] = incl;
    __syncthreads();
    float base = incl - v[3];
    for (int w = 0; w < wave; ++w) base += wt[w];
    LAS float* cs = (LAS float*)(lds + att::OFF_CUM);
    const float inv = 1.0f / ATT_SCALE;
    *(LAS f32x4*)(cs + 4 * tid) = (f32x4){(base + v[0]) * inv, (base + v[1]) * inv, (base + v[2]) * inv, (base + v[3]) * inv};
    __syncthreads();
}
__device__ __forceinline__ void attention_item(const Args& a, int l, int u, LAS char* lds, int wave) {
    int lane; asm volatile("v_mbcnt_lo_u32_b32 %0, -1, 0\n\tv_mbcnt_hi_u32_b32 %0, -1, %0" : "=v"(lane));
    const bf16* P = (const bf16*)(a.ws + WS_PROJ); bf16* Y = (bf16*)(a.ws + WS_Y);
    const int mode = u >> 7, v = u & 127, qb = 7 - (v >> 4), bh = v & 15, b = bh >> 2, h = bh & 3;
    const size_t row0 = (size_t)b * SEQ; const int P0 = qb * 256;
    if (mode == 0) {
        stage_cum(a, b, h, lds, wave, lane);
        att::attn_unit<0>(P, (int)((0 * PROJ_T + (row0 + P0) * MIXW + h * HD) * 2), (int)((1 * PROJ_T + row0 * MIXW + h * HD) * 2), (int)((2 * PROJ_T + row0 * MIXW + h * HD) * 2),
                          Y, (int)(((row0 + P0) * D + h * HD) * 2), P0, 0, 4 * qb + 4, lds, wave, lane);
    } else {
        const int tid = wave * 64 + lane;
        if (tid < 320) ((LAS float*)(lds + att::OFF_REL))[tid] = a.rel_bias[((size_t)l * 4 + h) * 320 + tid] * (1.0f / ATT_SCALE);
        const int jlo = 4 * qb - 8 < 0 ? 0 : 4 * qb - 8;
        att::attn_unit<1>(P, (int)((7 * PROJ_T + (row0 + P0) * MIXW + h * HD) * 2), (int)((8 * PROJ_T + row0 * MIXW + h * HD) * 2), (int)((9 * PROJ_T + row0 * MIXW + h * HD) * 2),
                          Y, (int)(((row0 + P0) * D + 1536 + h * HD) * 2), P0, jlo, 4 * qb + 4, lds, wave, lane);
    }
}
__device__ __forceinline__ void pool_item(const Args& a, int l, int u, LAS char* lds, int wave) {
    int lane; asm volatile("v_mbcnt_lo_u32_b32 %0, -1, 0\n\tv_mbcnt_hi_u32_b32 %0, -1, %0" : "=v"(lane));
    const int g = u & 3, T0 = (u >> 2) * 64, tid = wave * 64 + lane;
    const bf16* Pin = (const bf16*)(a.ws + WS_PROJ) + 3 * PROJ_T + g * 128;
    {
        const int cp = tid & 63, run = tid >> 6, w = 2 << g, t0 = T0 + run * 8, s0 = t0 & (SEQ - 1);
        const bf16* col = Pin + 2 * cp;
        float s_lo = 0.f, s_hi = 0.f;
        for (int j = 1; j < w; ++j) if (s0 - j >= 0) { const unsigned x = *(const unsigned*)(col + (size_t)(t0 - j) * MIXW); s_lo += bflo(x); s_hi += bfhi(x); }
#pragma unroll
        for (int i = 0; i < 8; ++i) { const unsigned x = *(const unsigned*)(col + (size_t)(t0 + i) * MIXW); s_lo += bflo(x); s_hi += bfhi(x);
            const int s = s0 + i; const int cnt = s + 1 < w ? s + 1 : w; const float inv = 1.0f / (float)cnt;
            *(LAS unsigned*)(lds + (run * 8 + i) * 272 + 4 * cp) = pk2(s_lo * inv - bflo(x), s_hi * inv - bfhi(x));
            if (s - w + 1 >= 0) { const unsigned y = *(const unsigned*)(col + (size_t)(t0 + i - w + 1) * MIXW); s_lo -= bflo(y); s_hi -= bfhi(y); } }
    }
    __syncthreads();
    {
        typedef short bf16x8 __attribute__((ext_vector_type(8)));
        const bf16* Wt = (const bf16*)(a.ws + WS_POOLW) + ((size_t)l * 4 + g) * 128 * 128;
        const int rt = (wave & 3) * 16, db = (wave >> 2) * 64, fr = lane & 15, kg = lane >> 4;
        f32x4 acc[4] = {};
#pragma unroll
        for (int ks = 0; ks < 4; ++ks) { const bf16x8 af = *(const LAS bf16x8*)(lds + (rt + fr) * 272 + (ks * 32 + kg * 8) * 2);
#pragma unroll
            for (int nt = 0; nt < 4; ++nt) { const bf16x8 bfr = *(const bf16x8*)(Wt + (size_t)(db + nt * 16 + fr) * 128 + ks * 32 + kg * 8);
                acc[nt] = __builtin_amdgcn_mfma_f32_16x16x32_bf16(bfr, af, acc[nt], 0, 0, 0); } }
        bf16* Y = (bf16*)(a.ws + WS_Y) + (size_t)(T0 + rt + fr) * D + 512 + g * 128;
#pragma unroll
        for (int nt = 0; nt < 4; ++nt) { const int d = db + nt * 16 + kg * 4; const f32x4 sc = *(const f32x4*)(a.pool_scale + l * MIXW + g * 128 + d);
            v2u w; w.x = pk2(acc[nt][0] * sc[0], acc[nt][1] * sc[1]); w.y = pk2(acc[nt][2] * sc[2], acc[nt][3] * sc[3]); *(v2u*)(Y + d) = w; }
    }
    __syncthreads();
}
__device__ __forceinline__ void conv_item(const Args& a, int l, int u, int wave) {
    int lane; asm volatile("v_mbcnt_lo_u32_b32 %0, -1, 0\n\tv_mbcnt_hi_u32_b32 %0, -1, %0" : "=v"(lane));
    const bf16* P = (const bf16*)(a.ws + WS_PROJ); const bf16* Ch = P + 4 * PROJ_T; const bf16* Cb = P + 5 * PROJ_T; const bf16* Cc = P + 6 * PROJ_T;
    const int tid = wave * 64 + lane, c0 = (tid & 63) * 8, t0 = u * 64 + (tid >> 6) * 8, s0 = t0 & (SEQ - 1);
    float wgt[3][8];
#pragma unroll
    for (int j = 0; j < 3; ++j) { const float* w = a.conv_w + ((size_t)l * 3 + j) * MIXW + c0; const f32x4 w0 = *(const f32x4*)w, w1 = *(const f32x4*)(w + 4);
#pragma unroll
        for (int k = 0; k < 4; ++k) { wgt[j][k] = w0[k]; wgt[j][4 + k] = w1[k]; } }
    float z2[8], z1[8];
#pragma unroll
    for (int k = 0; k < 8; ++k) { z2[k] = 0.f; z1[k] = 0.f; }
#pragma unroll
    for (int i = -2; i < 8; ++i) {
        float z[8];
        if (s0 + i >= 0) { const v4u hv = *(const v4u*)(Ch + (size_t)(t0 + i) * MIXW + c0), cv = *(const v4u*)(Cc + (size_t)(t0 + i) * MIXW + c0);
            z[0] = bflo(hv.x) * bflo(cv.x); z[1] = bfhi(hv.x) * bfhi(cv.x); z[2] = bflo(hv.y) * bflo(cv.y); z[3] = bfhi(hv.y) * bfhi(cv.y);
            z[4] = bflo(hv.z) * bflo(cv.z); z[5] = bfhi(hv.z) * bfhi(cv.z); z[6] = bflo(hv.w) * bflo(cv.w); z[7] = bfhi(hv.w) * bfhi(cv.w); }
        else {
#pragma unroll
            for (int k = 0; k < 8; ++k) z[k] = 0.f; }
        if (i >= 0) { const v4u bv = *(const v4u*)(Cb + (size_t)(t0 + i) * MIXW + c0); float o[8];
            const float bb[8] = {bflo(bv.x), bfhi(bv.x), bflo(bv.y), bfhi(bv.y), bflo(bv.z), bfhi(bv.z), bflo(bv.w), bfhi(bv.w)};
#pragma unroll
            for (int k = 0; k < 8; ++k) o[k] = bb[k] * (wgt[0][k] * z2[k] + wgt[1][k] * z1[k] + wgt[2][k] * z[k]);
            v4u ov; ov.x = pk2(o[0], o[1]); ov.y = pk2(o[2], o[3]); ov.z = pk2(o[4], o[5]); ov.w = pk2(o[6], o[7]);
            *(v4u*)((bf16*)(a.ws + WS_Y) + (size_t)(t0 + i) * D + 1024 + c0) = ov; }
#pragma unroll
        for (int k = 0; k < 8; ++k) { z2[k] = z1[k]; z1[k] = z[k]; }
    }
}
__device__ __forceinline__ void mixers_fast(const Args& a, int lq, LAS char* lds, int wave, int lane, int G, int blk) {
    const int l = lq & 1;
    for (int u = blk; u < N_ATT_UNITS; u += G) attention_item(a, l, u, lds, wave);
    unsigned* head = (unsigned*)(a.ws + WS_QCTR) + 64 * lq;
    volatile LAS unsigned* slot = (volatile LAS unsigned*)(lds + att::LDS_END);
    for (;;) {
        if (wave == 0 && lane == 0) *slot = __hip_atomic_fetch_add(head, 1u, __ATOMIC_RELAXED, __HIP_MEMORY_SCOPE_AGENT);
        __syncthreads();
        const unsigned it = *slot;
        __syncthreads();
        if (it >= (unsigned)(N_POOL_UNITS + N_CONV_UNITS)) break;
        if (it < (unsigned)N_POOL_UNITS) pool_item(a, l, (int)it, lds, wave); else conv_item(a, l, (int)it - N_POOL_UNITS, wave);
    }
}
__device__ __forceinline__ void p0_cmax(const Args& a, int gw, int NGW, int lane) {
    unsigned char* ws = a.ws;
    {
        constexpr int NCC = (INW + 255) / 256;
        for (int it = gw; it < DEPTH * 32 * NCC; it += NGW) { const int l = it / (32 * NCC), r = it % (32 * NCC), kc = r / NCC, cc = r % NCC; const int c0 = cc * 256 + 4 * lane;
            if (c0 + 3 < INW) { const float* W = a.w_in + (size_t)l * D * INW + (size_t)(kc * 64) * INW + c0; const float* g = a.norm_mix + l * D + kc * 64;
                float m0 = 0.f, m1 = 0.f, m2 = 0.f, m3 = 0.f;
#pragma unroll 8
                for (int k = 0; k < 64; ++k) { const f32x4 w = *(const f32x4*)(W + (size_t)k * INW); const float gk = fabsf(g[k]);
                    m0 = fmaxf(m0, fabsf(w[0]) * gk); m1 = fmaxf(m1, fabsf(w[1]) * gk); m2 = fmaxf(m2, fabsf(w[2]) * gk); m3 = fmaxf(m3, fabsf(w[3]) * gk); }
                unsigned* cm = (unsigned*)(ws + WS_CMAX) + l * INW + c0;
                const unsigned u0 = __float_as_uint(m0), u1 = __float_as_uint(m1), u2 = __float_as_uint(m2), u3 = __float_as_uint(m3);
                __hip_atomic_fetch_max(cm + 0, u0, __ATOMIC_RELAXED, __HIP_MEMORY_SCOPE_AGENT); __hip_atomic_fetch_max(cm + 1, u1, __ATOMIC_RELAXED, __HIP_MEMORY_SCOPE_AGENT);
                __hip_atomic_fetch_max(cm + 2, u2, __ATOMIC_RELAXED, __HIP_MEMORY_SCOPE_AGENT); __hip_atomic_fetch_max(cm + 3, u3, __ATOMIC_RELAXED, __HIP_MEMORY_SCOPE_AGENT); } }
    }
}
__device__ __forceinline__ void p0_prologue(const Args& a, LAS unsigned char* lds, int gw, int NGW, int wave, int lane) {
    unsigned char* ws = a.ws;
    LAS float* scr = (LAS float*)(lds + wave * 16384);
    constexpr int I_SQ = (D / 64) * (D / 32), I_BR = (MIXW / 64) * (D / 32);
    constexpr int I_LAYER = 4 * I_BR + 2 * I_SQ;
    for (int it = gw; it < DEPTH * I_LAYER; it += NGW) {
        const int l = it / I_LAYER; int r = it - l * I_LAYER;
        if (r < 4 * I_BR) { const int g = r / I_BR, rr = r % I_BR, kb = rr / (D / 32), nb = rr % (D / 32);
            tr_item<false>(a.w_branch + ((size_t)l * 4 + g) * MIXW * D, D, nullptr, (bf16*)(ws + WS_WBR + l * SQ_BYTES), D, g * MIXW, scr, 64 * kb, 32 * nb, lane); continue; }
        r -= 4 * I_BR;
        if (r < I_SQ) { const int kb = r / (D / 32), nb = r % (D / 32);
            tr_item<false>(a.w_out + (size_t)l * D * D, D, nullptr, (bf16*)(ws + WS_WOUT + l * SQ_BYTES), D, 0, scr, 64 * kb, 32 * nb, lane); continue; }
        r -= I_SQ;
        { const int kb = r / (D / 32), nb = r % (D / 32);
            tr_item<false>(a.peer_wq + (size_t)l * D * D, D, a.norm_ffn + l * D, (bf16*)(ws + WS_WQ + l * SQ_BYTES), D, 0, scr, 64 * kb, 32 * nb, lane); }
    }
    for (int it = gw; it < DEPTH * 4 * 8; it += NGW) { const int lg = it >> 3, r = it & 7;
        tr_item<false>(a.pool_w + (size_t)lg * 128 * 128, 128, nullptr, (bf16*)(ws + WS_POOLW) + (size_t)lg * 128 * 128, 128, 0, scr, 64 * (r >> 2), 32 * (r & 3), lane); }
    {
        constexpr int NR = 2 * DEPTH * PEER_E;
        f32x4 nv[8];
        if (gw < NR) { const int t = gw / (DEPTH * PEER_E), row = gw - t * (DEPTH * PEER_E); const float* src = (t ? a.peer_v : a.peer_u) + (size_t)row * D + 4 * lane;
#pragma unroll
            for (int j = 0; j < 8; ++j) nv[j] = *(const f32x4*)(src + 256 * j); }
        for (int r = gw; r < NR; r += NGW) { const int t = r / (DEPTH * PEER_E), row = r - t * (DEPTH * PEER_E);
            f32x4 v[8]; float am = 0.f;
#pragma unroll
            for (int j = 0; j < 8; ++j) v[j] = nv[j];
            { const int r2 = r + NGW; if (r2 < NR) { const int t2 = r2 / (DEPTH * PEER_E), row2 = r2 - t2 * (DEPTH * PEER_E); const float* src = (t2 ? a.peer_v : a.peer_u) + (size_t)row2 * D + 4 * lane;
#pragma unroll
                for (int j = 0; j < 8; ++j) nv[j] = *(const f32x4*)(src + 256 * j); } }
#pragma unroll
            for (int j = 0; j < 8; ++j) am = fmaxf(am, fmaxf(fmaxf(fabsf(v[j][0]), fabsf(v[j][1])), fmaxf(fabsf(v[j][2]), fabsf(v[j][3]))));
            am = wave_max(am, lane);
            const float inv = am > 0.f ? 127.0f / am : 0.f, off = 0.f;
            unsigned char* dst = ws + (t ? WS_PV : WS_PU) + (size_t)row * D + 4 * lane;
#pragma unroll
            for (int j = 0; j < 8; ++j) { const int q0 = (int)(rintf(v[j][0] * inv) + off), q1 = (int)(rintf(v[j][1] * inv) + off), q2 = (int)(rintf(v[j][2] * inv) + off), q3 = (int)(rintf(v[j][3] * inv) + off);
                *(unsigned*)(dst + 256 * j) = (unsigned)(q0 & 255) | ((unsigned)(q1 & 255) << 8) | ((unsigned)(q2 & 255) << 16) | ((unsigned)(q3 & 255) << 24); }
            if (lane == 0) ((float*)(ws + (t ? WS_SV : WS_SU)))[row] = am * (1.0f / 127.0f); }
    }
    { bf16* pk = (bf16*)(ws + WS_PK); const size_t n8 = (size_t)DEPTH * 8 * 2 * 128 * 128 / 8;
      for (size_t i = (size_t)gw * 64 + lane; i < n8; i += (size_t)NGW * 64) { const f32x4 v0 = *(const f32x4*)(a.peer_keys + i * 8), v1 = *(const f32x4*)(a.peer_keys + i * 8 + 4);
          v4u o; o.x = pk2(v0[0], v0[1]); o.y = pk2(v0[2], v0[3]); o.z = pk2(v1[0], v1[1]); o.w = pk2(v1[2], v1[3]); *(v4u*)(pk + i * 8) = o; } }
    {
        float* wf = (float*)(ws + WS_WF); float* binr = (float*)(ws + WS_BINR);
        const int gt = gw * 64 + lane, NGT = NGW * 64;
        for (int i = gt; i < DEPTH * 4 * D; i += NGT) { const int l = i / (4 * D), h = (i / D) & 3, k = i % D; wf[i] = a.w_in[(size_t)l * D * INW + (size_t)k * INW + 1536 + h] * a.norm_mix[l * D + k]; }
        for (int i = gt; i < DEPTH * NPROJ; i += NGT) { const int l = i / NPROJ, j = i % NPROJ; binr[i] = a.b_in[l * INW + colmap_in(j)]; }
    }
    {
        unsigned long long* ssq = (unsigned long long*)(ws + WS_SSQ);
        for (int m = gw; m < M; m += NGW) { float s = 0.f, am = 0.f; f32x4 v[8];
#pragma unroll
            for (int j = 0; j < 8; ++j) { const size_t o = (size_t)m * D + j * 256 + lane * 4; v[j] = *(const f32x4*)(a.x + o); s += (v[j][0] * v[j][0] + v[j][1] * v[j][1]) + (v[j][2] * v[j][2] + v[j][3] * v[j][3]);
                am = fmaxf(am, fmaxf(fmaxf(fabsf(v[j][0]), fabsf(v[j][1])), fmaxf(fabsf(v[j][2]), fabsf(v[j][3])))); }
            s = wave_sum(s, lane); am = wave_max(am, lane); if (lane == 0) { ssq[m] = (unsigned long long)((double)s * 4294967296.0); ((float*)(ws + WS_RSA))[m] = rsqrtf(s * (1.0f / D) + EPS) * am * (1.0f / 127.0f); }
            const float inv = am > 0.f ? 127.0f / am : 0.f; unsigned char* q8 = ws + WS_HB8 + (size_t)m * D + 4 * lane;
#pragma unroll
            for (int j = 0; j < 8; ++j) *(unsigned*)(q8 + 256 * j) = ((unsigned)((int)rintf(v[j][0] * inv) & 255)) | ((unsigned)((int)rintf(v[j][1] * inv) & 255) << 8) | ((unsigned)((int)rintf(v[j][2] * inv) & 255) << 16) | ((unsigned)((int)rintf(v[j][3] * inv) & 255) << 24); }
    }
}
__device__ __forceinline__ void p0_win_i8(const Args& a, LAS unsigned char* lds, int gw, int NGW, int wave, int lane) {
    unsigned char* ws = a.ws; LAS float* scr = (LAS float*)(lds + wave * 16384);
    constexpr int I_WIN = (D / 64) * (NPROJ / 32);
    for (int it = gw; it < DEPTH * I_WIN; it += NGW) { const int l = it / I_WIN, r = it % I_WIN, kb = r / (NPROJ / 32), nb = r % (NPROJ / 32);
        tr_item_i8(a.w_in + (size_t)l * D * INW, a.norm_mix + l * D, (const unsigned*)(ws + WS_CMAX) + l * INW, ws + WS_WIN + l * WIN_BYTES, scr, 64 * kb, 32 * nb, lane); }
    float* sw = (float*)(ws + WS_SW); const int gt = gw * 64 + lane, NGT = NGW * 64;
    bf16* swh = (bf16*)(ws + WS_SWH); bf16* bih = (bf16*)(ws + WS_BIH);
    for (int i = gt; i < DEPTH * NPROJ; i += NGT) { const int l = i / NPROJ, j = i % NPROJ; const float s = __builtin_bit_cast(float, ((const unsigned*)(ws + WS_CMAX))[l * INW + colmap_in(j)]) * (1.0f / 127.0f);
        sw[i] = s; swh[i] = (bf16)f2bf(s); bih[i] = (bf16)f2bf(a.b_in[l * INW + colmap_in(j)]); }
}
__device__ __forceinline__ void quant_rows(const Args& a, int l, int gw, int NGW, int lane) {
    unsigned char* ws = a.ws; const bf16* HB = (const bf16*)(ws + WS_HB);
    for (int m0 = gw; m0 < M; m0 += 2 * NGW) {
        const int m1 = m0 + NGW; const bool ok1 = m1 < M; const int mr[2] = {m0, ok1 ? m1 : m0};
        v4u w[2][4];
#pragma unroll
        for (int r = 0; r < 2; ++r)
#pragma unroll
            for (int j = 0; j < 4; ++j) w[r][j] = *(const v4u*)(HB + (size_t)mr[r] * D + j * 512 + lane * 8);
#pragma unroll
        for (int r = 0; r < 2; ++r) { float am = 0.f; float v[4][8];
#pragma unroll
            for (int j = 0; j < 4; ++j) { v[j][0] = bflo(w[r][j].x); v[j][1] = bfhi(w[r][j].x); v[j][2] = bflo(w[r][j].y); v[j][3] = bfhi(w[r][j].y); v[j][4] = bflo(w[r][j].z); v[j][5] = bfhi(w[r][j].z); v[j][6] = bflo(w[r][j].w); v[j][7] = bfhi(w[r][j].w);
#pragma unroll
                for (int e = 0; e < 8; ++e) am = fmaxf(am, fabsf(v[j][e])); }
            am = wave_max(am, lane);
            if (r == 0 || ok1) {
                if (lane == 0) ((float*)(ws + WS_RSA))[mr[r]] = rsqrtf(ssa_to_f(((const unsigned long long*)(ws + WS_SSQ))[(size_t)l * M + mr[r]]) * (1.0f / D) + EPS) * am * (1.0f / 127.0f);
                const float inv = am > 0.f ? 127.0f / am : 0.f; unsigned char* q8 = ws + WS_HB8 + (size_t)mr[r] * D + 8 * lane;
#pragma unroll
                for (int j = 0; j < 4; ++j) { v2u o;
                    o.x = ((unsigned)((int)rintf(v[j][0] * inv) & 255)) | ((unsigned)((int)rintf(v[j][1] * inv) & 255) << 8) | ((unsigned)((int)rintf(v[j][2] * inv) & 255) << 16) | ((unsigned)((int)rintf(v[j][3] * inv) & 255) << 24);
                    o.y = ((unsigned)((int)rintf(v[j][4] * inv) & 255)) | ((unsigned)((int)rintf(v[j][5] * inv) & 255) << 8) | ((unsigned)((int)rintf(v[j][6] * inv) & 255) << 16) | ((unsigned)((int)rintf(v[j][7] * inv) & 255) << 24);
                    *(v2u*)(q8 + 512 * j) = o; } } }
    }
}

__device__ __forceinline__ void forget_logits(const Args& a, int l, int gw, int NGW, int lane) {
    unsigned char* ws = a.ws; const bf16* HB = (const bf16*)(ws + WS_HB); const float* wf = (const float*)(ws + WS_WF) + l * 4 * D; const unsigned long long* ssq = (const unsigned long long*)(ws + WS_SSQ) + l * M;
    float* logf = (float*)(ws + WS_LOGF);
    f32x4 w[4][4][2];
#pragma unroll
    for (int h = 0; h < 4; ++h)
#pragma unroll
        for (int j = 0; j < 4; ++j) { const int k0 = j * 512 + lane * 8; w[h][j][0] = *(const f32x4*)(wf + h * D + k0); w[h][j][1] = *(const f32x4*)(wf + h * D + k0 + 4); }
    float bias[4];
#pragma unroll
    for (int h = 0; h < 4; ++h) bias[h] = a.b_in[l * INW + 1536 + h];
    for (int m0 = gw; m0 < M; m0 += 2 * NGW) {
        const int m1 = m0 + NGW; const bool ok1 = m1 < M; const int mr[2] = {m0, ok1 ? m1 : m0};
        f32x4 x[2][4][2];
#pragma unroll
        for (int r = 0; r < 2; ++r)
#pragma unroll
            for (int j = 0; j < 4; ++j) { const int k0 = j * 512 + lane * 8;
                if (l == 0) { x[r][j][0] = *(const f32x4*)(a.x + (size_t)mr[r] * D + k0); x[r][j][1] = *(const f32x4*)(a.x + (size_t)mr[r] * D + k0 + 4); }
                else { const v4u xv = *(const v4u*)(HB + (size_t)mr[r] * D + k0); x[r][j][0] = (f32x4){bflo(xv.x), bfhi(xv.x), bflo(xv.y), bfhi(xv.y)}; x[r][j][1] = (f32x4){bflo(xv.z), bfhi(xv.z), bflo(xv.w), bfhi(xv.w)}; } }
#pragma unroll
        for (int r = 0; r < 2; ++r) { const float rs = rsqrtf(ssa_to_f(ssq[mr[r]]) * (1.0f / D) + EPS);
#pragma unroll
            for (int h = 0; h < 4; ++h) { f32x4 s4 = {0.f, 0.f, 0.f, 0.f};
#pragma unroll
                for (int j = 0; j < 4; ++j) { s4 += x[r][j][0] * w[h][j][0]; s4 += x[r][j][1] * w[h][j][1]; }
                const float z = wave_sum((s4[0] + s4[1]) + (s4[2] + s4[3]), lane) * rs + bias[h];
                const float ls = fminf(z, 0.f) - __logf(1.0f + __expf(-fabsf(z)));
                if (lane == h && (r == 0 || ok1)) logf[mr[r] * 4 + h] = ls; } }
    }
}
__device__ __forceinline__ float gelu_tanh(float x) { const float u = 1.5957691216057308f * (x + 0.044715f * x * x * x); return x / (1.0f + __expf(-u)); }
constexpr int PEER_TOK = 32;
constexpr int PL_IDX = 0, PL_GATE = PEER_TOK * 128 * 4, PL_TAB = 2 * PEER_TOK * 128 * 4;
__device__ __forceinline__ int f2key(float f) { const int b = __builtin_bit_cast(int, f); return b ^ ((b >> 31) & 0x7fffffff); }
__device__ __forceinline__ float key2f(int k) { return __builtin_bit_cast(float, k ^ ((k >> 31) & 0x7fffffff)); }
#define CE_DESC(x, y) do { const int hi_ = (x) > (y) ? (x) : (y), lo_ = (x) > (y) ? (y) : (x); (x) = hi_; (y) = lo_; } while (0)
__device__ __forceinline__ void sort16_desc(int* v) {
#pragma unroll
    for (int k = 2; k <= 16; k <<= 1)
#pragma unroll
        for (int j = k >> 1; j > 0; j >>= 1)
#pragma unroll
            for (int i = 0; i < 16; ++i) { const int l = i ^ j; if (l > i) { if ((i & k) == 0) CE_DESC(v[i], v[l]); else CE_DESC(v[l], v[i]); } }
}
__device__ __forceinline__ void merge_top16(int* a, const int* b) {
#pragma unroll
    for (int i = 0; i < 16; ++i) a[i] = a[i] > b[15 - i] ? a[i] : b[15 - i];
#pragma unroll
    for (int j = 8; j > 0; j >>= 1)
#pragma unroll
        for (int i = 0; i < 16; ++i) { const int l = i ^ j; if (l > i) CE_DESC(a[i], a[l]); }
}
__device__ __forceinline__ void top16_of_64(int* v) {
    sort16_desc(v); sort16_desc(v + 16); sort16_desc(v + 32); sort16_desc(v + 48);
    merge_top16(v, v + 16); merge_top16(v + 32, v + 48); merge_top16(v, v + 32);
}
constexpr int cand_slot(int i, int j) {
    int n = 0;
    for (int a = 0; a < 16; ++a) for (int b = 0; b < 16; ++b) { if ((a + 1) * (b + 1) <= 16) { if (a == i && b == j) return n; ++n; } }
    return -1;
}
__device__ __forceinline__ void peer_retrieve(const Args& a, int l, int t0, int h, LAS char* lds, int wave) {
    typedef short bf16x8 __attribute__((ext_vector_type(8)));
    typedef float f32x16 __attribute__((ext_vector_type(16)));
    int lane; asm volatile("v_mbcnt_lo_u32_b32 %0, -1, 0\n\tv_mbcnt_hi_u32_b32 %0, -1, %0" : "=v"(lane));
    const int r32 = lane & 31, hi = lane >> 5, hi4 = hi * 4;
    const bf16* Q = (const bf16*)(a.ws + WS_Q) + (size_t)(t0 + r32) * D + h * 256 + hi * 8;
    const bf16* PK = (const bf16*)(a.ws + WS_PK) + ((size_t)(l * 8 + h) * 2) * 128 * 128 + (size_t)r32 * 128 + hi * 8;
    int top[2][16];
#pragma unroll
    for (int p = 0; p < 2; ++p) {
        f32x16 acc[4] = {};
        bf16x8 qf[8];
#pragma unroll
        for (int cs = 0; cs < 8; ++cs) qf[cs] = *(const bf16x8*)(Q + p * 128 + cs * 16);
#pragma unroll
        for (int kb = 0; kb < 4; ++kb) { bf16x8 kf[8];
#pragma unroll
            for (int cs = 0; cs < 8; ++cs) kf[cs] = *(const bf16x8*)(PK + (size_t)p * 128 * 128 + (size_t)kb * 32 * 128 + cs * 16);
#pragma unroll
            for (int cs = 0; cs < 8; ++cs) acc[kb] = __builtin_amdgcn_mfma_f32_32x32x16_bf16(kf[cs], qf[cs], acc[kb], 0, 0, 0); }
        int v[64];
#pragma unroll
        for (int kb = 0; kb < 4; ++kb)
#pragma unroll
            for (int r = 0; r < 16; ++r) { const int c = kb * 32 + (r & 3) + 8 * (r >> 2);
                v[kb * 16 + r] = (f2key(acc[kb][r]) & ~127) | (c | hi4); }
        top16_of_64(v);
        int mine[16], other[16];
#pragma unroll
        for (int i = 0; i < 16; ++i) { auto rr = __builtin_amdgcn_permlane32_swap((unsigned)v[i], (unsigned)v[i], false, false); mine[i] = (int)rr[0]; other[i] = (int)rr[1]; }
        merge_top16(mine, other);
#pragma unroll
        for (int i = 0; i < 16; ++i) top[p][i] = mine[i];
    }
    LAS int* tab = (LAS int*)(lds + PL_TAB) + (wave * 64 + lane) * 32;
    float sA[16], sB[16];
#pragma unroll
    for (int i = 0; i < 16; ++i) { sA[i] = key2f(top[0][i] & ~127); sB[i] = key2f(top[1][i] & ~127); tab[i] = top[0][i] & 127; tab[16 + i] = top[1][i] & 127; }
    int c[64];
#pragma unroll
    for (int n = 0; n < 64; ++n) c[n] = (int)0x80000000;
#pragma unroll
    for (int i = 0; i < 16; ++i)
#pragma unroll
        for (int j = 0; j < 16; ++j) if ((i + 1) * (j + 1) <= 16) c[cand_slot(i, j)] = (f2key(sA[i] + sB[j]) & ~255) | (16 * i + j);
    top16_of_64(c);
    float ex[16]; float sum = 0.f; const float mx = key2f(c[0] & ~255);
#pragma unroll
    for (int w = 0; w < 16; ++w) { ex[w] = __expf(key2f(c[w] & ~255) - mx); sum += ex[w]; }
    const float inv = 1.0f / sum;
    asm volatile("s_waitcnt lgkmcnt(0)" ::: "memory");
    LAS int* oi = (LAS int*)(lds + PL_IDX) + r32 * 128 + h * 16; LAS float* og = (LAS float*)(lds + PL_GATE) + r32 * 128 + h * 16;
#pragma unroll
    for (int w = 0; w < 16; ++w) { const int id = c[w] & 255; const int e = tab[id >> 4] * 128 + tab[16 + (id & 15)];
        if ((w >> 3) == hi) { oi[w] = e; og[w] = ex[w] * inv; } }
}
constexpr size_t WS_IDX = 816 * MiB;
constexpr size_t WS_GATE = 820 * MiB;
constexpr size_t WS_XQ = 824 * MiB;
constexpr size_t WS_SX = 856 * MiB;
constexpr size_t WS_PART = 857 * MiB;
constexpr size_t WS_SUT = 890 * MiB;
constexpr size_t WS_END2 = 1024 * MiB;
#ifndef PEER_NB
#define PEER_NB 8
#endif
constexpr int NSLICE = 8, SLW = D / NSLICE;
__device__ __forceinline__ void peer_publish4(const Args& a, int l, int t0, LAS char* lds, int tl0) {
    static_assert(PEER_TOK / NWAVES == 4, "four tokens per wave");
    int lane; LANE_ID(lane);
    unsigned char* ws = a.ws;
    {   const float* SU = (const float*)(ws + WS_SU) + l * PEER_E; const float* SV = (const float*)(ws + WS_SV) + l * PEER_E;
        int i0[4], i1[4]; float g0[4], g1[4], su0[4], su1[4], sv0[4], sv1[4];
#pragma unroll
        for (int k = 0; k < 4; ++k) { const int tl = tl0 + k; i0[k] = ((const LAS int*)(lds + PL_IDX))[tl * 128 + lane]; i1[k] = ((const LAS int*)(lds + PL_IDX))[tl * 128 + 64 + lane];
            g0[k] = ((const LAS float*)(lds + PL_GATE))[tl * 128 + lane]; g1[k] = ((const LAS float*)(lds + PL_GATE))[tl * 128 + 64 + lane]; }
#pragma unroll
        for (int k = 0; k < 4; ++k) { su0[k] = SU[i0[k]]; su1[k] = SU[i1[k]]; sv0[k] = SV[i0[k]]; sv1[k] = SV[i1[k]]; }
#pragma unroll
        for (int k = 0; k < 4; ++k) { const int t = t0 + k; int* gi = (int*)(ws + WS_IDX) + (size_t)t * 128; float* gg = (float*)(ws + WS_GATE) + (size_t)t * 128; float* gs = (float*)(ws + WS_SUT) + (size_t)t * 128;
            gi[lane] = i0[k]; gi[64 + lane] = i1[k]; gs[lane] = su0[k]; gs[64 + lane] = su1[k]; gg[lane] = g0[k] * sv0[k]; gg[64 + lane] = g1[k] * sv1[k]; }
    }
    const unsigned long long* ssa1 = (const unsigned long long*)(ws + WS_SSA) + l * M;
    const float* gn = a.norm_ffn + l * D;
    f32x4 g[2][4]; v4u hw[4][2][2]; float rs[4];
#pragma unroll
    for (int i = 0; i < 2; ++i)
#pragma unroll
        for (int q = 0; q < 4; ++q) g[i][q] = *(const f32x4*)(gn + 16 * lane + 1024 * i + 4 * q);
#pragma unroll
    for (int k = 0; k < 4; ++k) { const bf16* HB = (const bf16*)(ws + WS_HB) + (size_t)(t0 + k) * D; rs[k] = rsqrtf(ssa_to_f(ssa1[t0 + k]) * (1.0f / D) + EPS);
#pragma unroll
        for (int i = 0; i < 2; ++i) { hw[k][i][0] = *(const v4u*)(HB + 16 * lane + 1024 * i); hw[k][i][1] = *(const v4u*)(HB + 16 * lane + 1024 * i + 8); } }
#pragma unroll
    for (int k = 0; k < 4; ++k) { const int t = t0 + k;
        float xf[32]; float am = 0.f;
#pragma unroll
        for (int i = 0; i < 2; ++i) { const unsigned hq[8] = {hw[k][i][0].x, hw[k][i][0].y, hw[k][i][0].z, hw[k][i][0].w, hw[k][i][1].x, hw[k][i][1].y, hw[k][i][1].z, hw[k][i][1].w};
#pragma unroll
            for (int q = 0; q < 4; ++q) {
                xf[16 * i + 4 * q + 0] = bflo(hq[2 * q]) * rs[k] * g[i][q][0]; xf[16 * i + 4 * q + 1] = bfhi(hq[2 * q]) * rs[k] * g[i][q][1];
                xf[16 * i + 4 * q + 2] = bflo(hq[2 * q + 1]) * rs[k] * g[i][q][2]; xf[16 * i + 4 * q + 3] = bfhi(hq[2 * q + 1]) * rs[k] * g[i][q][3]; } }
#pragma unroll
        for (int e = 0; e < 32; ++e) am = fmaxf(am, fabsf(xf[e]));
        am = wave_max(am, lane);
        const float inv = am > 0.f ? 127.0f / am : 0.f;
        if (lane == 0) ((float*)(ws + WS_SX))[t] = am * (1.0f / 127.0f);
        unsigned char* xq = ws + WS_XQ + (size_t)t * 4096;
#pragma unroll
        for (int i = 0; i < 2; ++i) { v4u ph, pl;
#pragma unroll
            for (int d = 0; d < 4; ++d) { unsigned wh = 0, wl = 0;
#pragma unroll
                for (int b = 0; b < 4; ++b) { const float sv = xf[16 * i + 4 * d + b] * inv, hq = rintf(sv), lq = rintf((sv - hq) * 128.0f);
                    wh |= ((unsigned)((int)hq & 255)) << (8 * b); wl |= ((unsigned)((int)lq & 255)) << (8 * b); }
                ph[d] = wh; pl[d] = wl; }
            *(v4u*)(xq + 16 * lane + 1024 * i) = ph; *(v4u*)(xq + 2048 + 16 * lane + 1024 * i) = pl; } }
}
struct PeerItems { int pos, npop, rank, nloc, wave;
    __device__ __forceinline__ int nblk() const { return (M / PEER_TOK - rank + nloc - 1) / nloc; }
    __device__ __forceinline__ int count() const { return ((NSLICE - pos + npop - 1) / npop) * nblk() * (PEER_TOK / NWAVES); }
    __device__ __forceinline__ void get(int n, int& s, int& t) const { constexpr int per = PEER_TOK / NWAVES; const int k = n % per, r = n / per, nb = nblk();
        s = pos + (r / nb) * npop; t = (rank + (r % nb) * nloc) * PEER_TOK + wave * per + k; } };
__device__ __forceinline__ void peer_u_wave(const Args& a, int l, const PeerItems& it) {
    int lane; LANE_ID(lane);
    unsigned char* ws = a.ws; const int sub = lane & 15, grp = lane >> 4;
    const __amdgpu_buffer_rsrc_t rU = __builtin_amdgcn_make_buffer_rsrc((void*)(ws + WS_PU + (size_t)l * PE_BYTES), 0, 0x7fffffff, 0x00020000);
    const __amdgpu_buffer_rsrc_t rW = __builtin_amdgcn_make_buffer_rsrc((void*)ws, 0, 0x7fffffff, 0x00020000);
    const int N = it.count(); if (N <= 0) return;
    int s, t; it.get(0, s, t);
    int idc[2], idn[2] = {0, 0}; v4u xhc, xlc, xhn = {}, xln = {}; v4u wA[PEER_NB], wB[PEER_NB];
#define PU_META(I0, I1, XH, XL, S_, T_) do { I0 = (int)__builtin_amdgcn_raw_buffer_load_b32(rW, 4 * lane, (int)WS_IDX + (T_) * 512, 0); I1 = (int)__builtin_amdgcn_raw_buffer_load_b32(rW, 4 * lane, (int)WS_IDX + (T_) * 512 + 256, 0); \
        XH = __builtin_amdgcn_raw_buffer_load_b128(rW, 16 * sub, (int)WS_XQ + (T_) * 4096 + SLW * (S_), 0); XL = __builtin_amdgcn_raw_buffer_load_b128(rW, 16 * sub, (int)WS_XQ + (T_) * 4096 + 2048 + SLW * (S_), 0); } while (0)
#define PU_ISSUE(W, ID, Q, S_) do { _Pragma("unroll") for (int j = 0; j < PEER_NB; ++j) { const int e_ = shi(ID[(PEER_NB * (Q) + j) >> 4], 4 * ((PEER_NB * (Q) + j) & 15) + grp); W[j] = __builtin_amdgcn_raw_buffer_load_b128(rU, e_ * D + SLW * (S_) + 16 * sub, 0, 0); } } while (0)
#define PU_COMP(W, Q) do { _Pragma("unroll") for (int j = 0; j < PEER_NB; ++j) { int dh = 0, dl = 0; \
            dh = __builtin_amdgcn_sdot4((int)W[j].x, (int)xhc.x, dh, false); dl = __builtin_amdgcn_sdot4((int)W[j].x, (int)xlc.x, dl, false); \
            dh = __builtin_amdgcn_sdot4((int)W[j].y, (int)xhc.y, dh, false); dl = __builtin_amdgcn_sdot4((int)W[j].y, (int)xlc.y, dl, false); \
            dh = __builtin_amdgcn_sdot4((int)W[j].z, (int)xhc.z, dh, false); dl = __builtin_amdgcn_sdot4((int)W[j].z, (int)xlc.z, dl, false); \
            dh = __builtin_amdgcn_sdot4((int)W[j].w, (int)xhc.w, dh, false); dl = __builtin_amdgcn_sdot4((int)W[j].w, (int)xlc.w, dl, false); \
            float p_ = (float)dh + (float)dl * (1.0f / 128.0f); \
            p_ += DPP_ROR(p_, 8); p_ += DPP_ROR(p_, 4); p_ += DPP_ROR(p_, 2); p_ += DPP_ROR(p_, 1); \
            if (sub == ((PEER_NB * (Q) + j) & 15)) { if ((PEER_NB * (Q) + j) >> 4) acc1 = p_; else acc0 = p_; } __builtin_amdgcn_sched_barrier(0); } } while (0)
    PU_META(idc[0], idc[1], xhc, xlc, s, t); PU_ISSUE(wA, idc, 0, s); PU_ISSUE(wB, idc, 1, s);
    for (int n = 0; n < N; ++n) {
        int sn = s, tn = t; const bool more = n + 1 < N;
        if (more) it.get(n + 1, sn, tn);
        PU_META(idn[0], idn[1], xhn, xln, sn, tn);
        float acc0 = 0.f, acc1 = 0.f;
        __builtin_amdgcn_sched_barrier(0);
#if PEER_NB == 8
        PU_COMP(wA, 0); PU_ISSUE(wA, idc, 2, s); __builtin_amdgcn_sched_barrier(0);
        PU_COMP(wB, 1); PU_ISSUE(wB, idc, 3, s); __builtin_amdgcn_sched_barrier(0);
        PU_COMP(wA, 2); PU_ISSUE(wA, idn, 0, sn); __builtin_amdgcn_sched_barrier(0);
        PU_COMP(wB, 3); PU_ISSUE(wB, idn, 1, sn); __builtin_amdgcn_sched_barrier(0);
#else
        PU_COMP(wA, 0); PU_ISSUE(wA, idn, 0, sn); __builtin_amdgcn_sched_barrier(0);
        PU_COMP(wB, 1); PU_ISSUE(wB, idn, 1, sn); __builtin_amdgcn_sched_barrier(0);
#endif
        __builtin_amdgcn_raw_buffer_store_b32(__builtin_bit_cast(unsigned, acc0), rW, (4 * sub + grp) * 4, (int)WS_PART + (s * M + t) * 512, 0);
        __builtin_amdgcn_raw_buffer_store_b32(__builtin_bit_cast(unsigned, acc1), rW, (4 * sub + grp) * 4 + 256, (int)WS_PART + (s * M + t) * 512, 0);
        s = sn; t = tn; idc[0] = idn[0]; idc[1] = idn[1]; xhc = xhn; xlc = xln;
    }
#undef PU_META
#undef PU_ISSUE
#undef PU_COMP
}
__device__ __forceinline__ void peer_v_wave(const Args& a, int l, const PeerItems& it) {
    int lane; LANE_ID(lane);
    unsigned char* ws = a.ws; const int sub = lane & 15, grp = lane >> 4;
    const __amdgpu_buffer_rsrc_t rV = __builtin_amdgcn_make_buffer_rsrc((void*)(ws + WS_PV + (size_t)l * PE_BYTES), 0, 0x7fffffff, 0x00020000);
    const __amdgpu_buffer_rsrc_t rW = __builtin_amdgcn_make_buffer_rsrc((void*)ws, 0, 0x7fffffff, 0x00020000);
    const int N = it.count(); if (N <= 0) return;
    int s, t; it.get(0, s, t);
    struct Meta { int id[2]; float gate[2], su[2], pa[2], sx; v2u h1; };
    Meta mc, mn; v4u wA[PEER_NB], wB[PEER_NB];
    const int l4 = 4 * lane;
#define WLD(off_s) __builtin_amdgcn_raw_buffer_load_b32(rW, l4, (int)(off_s), 0)
#define PV_META(MM, S_, T_) do { const int r_ = (T_) * 512; MM.id[0] = (int)WLD(WS_IDX + r_); MM.id[1] = (int)WLD(WS_IDX + r_ + 256); \
        MM.gate[0] = __builtin_bit_cast(float, WLD(WS_GATE + r_)); MM.gate[1] = __builtin_bit_cast(float, WLD(WS_GATE + r_ + 256)); MM.su[0] = __builtin_bit_cast(float, WLD(WS_SUT + r_)); MM.su[1] = __builtin_bit_cast(float, WLD(WS_SUT + r_ + 256)); \
        float a0_ = 0.f, a1_ = 0.f; _Pragma("unroll") for (int q = 0; q < NSLICE; ++q) { const int po_ = (int)WS_PART + (q * M + (T_)) * 512; a0_ += __builtin_bit_cast(float, WLD(po_)); a1_ += __builtin_bit_cast(float, WLD(po_ + 256)); } \
        MM.pa[0] = a0_; MM.pa[1] = a1_; MM.sx = ((const float*)(ws + WS_SX))[T_]; \
        MM.h1 = __builtin_amdgcn_raw_buffer_load_b64(rW, (16 * sub + 4 * grp) * 2, (int)WS_HB + ((T_) * D + SLW * (S_)) * 2, 0); } while (0)
#define PV_ISSUE(W, ID, Q, S_) do { _Pragma("unroll") for (int j = 0; j < PEER_NB; ++j) { const int e_ = shi(ID[(PEER_NB * (Q) + j) >> 4], 4 * ((PEER_NB * (Q) + j) & 15) + grp); W[j] = __builtin_amdgcn_raw_buffer_load_b128(rV, e_ * D + SLW * (S_) + 16 * sub, 0, 0); } } while (0)
#define PV_COMP(W, Q) do { _Pragma("unroll") for (int j4 = 0; j4 < PEER_NB; j4 += 4) { \
            unsigned cp_ = 0; _Pragma("unroll") for (int jj = 0; jj < 4; ++jj) { const int i_ = PEER_NB * (Q) + j4 + jj; cp_ |= ((unsigned)shi(c8[i_ >> 4], 4 * (i_ & 15) + grp) & 255u) << (8 * jj); } \
            _Pragma("unroll") for (int d = 0; d < 4; ++d) { const unsigned a_ = W[j4][d], b_ = W[j4 + 1][d], c_ = W[j4 + 2][d], d_ = W[j4 + 3][d]; \
                const unsigned x0_ = __builtin_amdgcn_perm(b_, a_, 0x05010400u), x1_ = __builtin_amdgcn_perm(b_, a_, 0x07030602u), y0_ = __builtin_amdgcn_perm(d_, c_, 0x05010400u), y1_ = __builtin_amdgcn_perm(d_, c_, 0x07030602u); \
                yi[4 * d + 0] = __builtin_amdgcn_sdot4((int)__builtin_amdgcn_perm(y0_, x0_, 0x05040100u), (int)cp_, yi[4 * d + 0], false); \
                yi[4 * d + 1] = __builtin_amdgcn_sdot4((int)__builtin_amdgcn_perm(y0_, x0_, 0x07060302u), (int)cp_, yi[4 * d + 1], false); \
                yi[4 * d + 2] = __builtin_amdgcn_sdot4((int)__builtin_amdgcn_perm(y1_, x1_, 0x05040100u), (int)cp_, yi[4 * d + 2], false); \
                yi[4 * d + 3] = __builtin_amdgcn_sdot4((int)__builtin_amdgcn_perm(y1_, x1_, 0x07060302u), (int)cp_, yi[4 * d + 3], false); } \
            __builtin_amdgcn_sched_barrier(0); } } while (0)
    PV_META(mc, s, t); PV_ISSUE(wA, mc.id, 0, s); PV_ISSUE(wB, mc.id, 1, s);
    for (int n = 0; n < N; ++n) {
        int sn = s, tn = t; const bool more = n + 1 < N;
        if (more) it.get(n + 1, sn, tn);
        PV_META(mn, sn, tn);
        float coef[2];
#pragma unroll
        for (int hf = 0; hf < 2; ++hf) coef[hf] = gelu_tanh(mc.pa[hf] * mc.su[hf] * mc.sx) * mc.gate[hf];
        const float cmax = wave_max(fmaxf(fabsf(coef[0]), fabsf(coef[1])), lane); const float cinv = cmax > 0.f ? 127.0f / cmax : 0.f, cs = cmax * (1.0f / 127.0f);
        const int c8[2] = {(int)rintf(coef[0] * cinv), (int)rintf(coef[1] * cinv)};
        int yi[16];
#pragma unroll
        for (int k = 0; k < 16; ++k) yi[k] = 0;
        __builtin_amdgcn_sched_barrier(0);
#if PEER_NB == 8
        PV_COMP(wA, 0); PV_ISSUE(wA, mc.id, 2, s); __builtin_amdgcn_sched_barrier(0);
        PV_COMP(wB, 1); PV_ISSUE(wB, mc.id, 3, s); __builtin_amdgcn_sched_barrier(0);
        PV_COMP(wA, 2); PV_ISSUE(wA, mn.id, 0, sn); __builtin_amdgcn_sched_barrier(0);
        PV_COMP(wB, 3); PV_ISSUE(wB, mn.id, 1, sn); __builtin_amdgcn_sched_barrier(0);
#else
        PV_COMP(wA, 0); PV_ISSUE(wA, mn.id, 0, sn); __builtin_amdgcn_sched_barrier(0);
        PV_COMP(wB, 1); PV_ISSUE(wB, mn.id, 1, sn); __builtin_amdgcn_sched_barrier(0);
#endif
#pragma unroll
        for (int k = 0; k < 16; ++k) { yi[k] += shi(yi[k], lane ^ 16); yi[k] += shi(yi[k], lane ^ 32); }
        int yq[4];
#pragma unroll
        for (int k = 0; k < 4; ++k) yq[k] = grp == 0 ? yi[k] : grp == 1 ? yi[4 + k] : grp == 2 ? yi[8 + k] : yi[12 + k];
        const f32x4 h2 = {bflo(mc.h1.x) + cs * (float)yq[0], bfhi(mc.h1.x) + cs * (float)yq[1], bflo(mc.h1.y) + cs * (float)yq[2], bfhi(mc.h1.y) + cs * (float)yq[3]};
        v2u hb; hb.x = pk2(h2[0], h2[1]); hb.y = pk2(h2[2], h2[3]);
        __builtin_amdgcn_raw_buffer_store_b64(hb, rW, (16 * sub + 4 * grp) * 2, (int)WS_HB + (t * D + SLW * s) * 2, 0);
        const float sq = wave_sum((h2[0] * h2[0] + h2[1] * h2[1]) + (h2[2] * h2[2] + h2[3] * h2[3]), lane);
        if (lane == 0) atomicAdd((unsigned long long*)(ws + WS_SSQ) + (size_t)(l + 1) * M + t, (unsigned long long)((double)sq * 4294967296.0));
        s = sn; t = tn; mc = mn;
    }
#undef PV_META
#undef WLD
#undef PV_ISSUE
#undef PV_COMP
}
__device__ __forceinline__ void final_norm_row(const Args& a, int t) {
    int lane; LANE_ID(lane);
    const bf16* HB = (const bf16*)(a.ws + WS_HB) + (size_t)t * D; float* O = a.out + (size_t)t * D;
    const float rf = rsqrtf(ssa_to_f(((const unsigned long long*)(a.ws + WS_SSQ))[(size_t)DEPTH * M + t]) * (1.0f / D) + EPS);
#pragma unroll
    for (int j = 0; j < 8; ++j) { const int k0 = 4 * lane + 256 * j; const v2u w = *(const v2u*)(HB + k0); const f32x4 g = *(const f32x4*)(a.norm_final + k0);
        *(f32x4*)(O + k0) = (f32x4){bflo(w.x) * rf * g[0], bfhi(w.x) * rf * g[1], bflo(w.y) * rf * g[2], bfhi(w.y) * rf * g[3]}; }
}

__global__ void __launch_bounds__(NT, 2) mk_fwd(ArgsK a_in) {
    extern __shared__ __attribute__((aligned(16))) unsigned char lds_raw[];
    LAS unsigned char* lds = (LAS unsigned char*)lds_raw;
    cg::grid_group grid = cg::this_grid();
    grid.sync();
    const int wave0 = __builtin_amdgcn_readfirstlane(threadIdx.x >> 6);
    const int G = gridDim.x;
    const CAS ArgsK* ka = (const CAS ArgsK*)__builtin_amdgcn_kernarg_segment_ptr();
    size_t zoff = 0;
#define PHASE_BEGIN() int lane; LANE_ID(lane); int blk = blockIdx.x, Gp = G, wv = wave0; asm volatile("" : "+s"(zoff), "+s"(ka), "+s"(blk), "+s"(Gp), "+s"(wv)); const int wave = wv, gw = blk * NWAVES + wv, NGW = Gp * NWAVES; (void)gw; (void)NGW; const Args a = load_args(ka, zoff); unsigned char* const ws = a.ws; (void)ws
    volatile LAS unsigned* bst = (volatile LAS unsigned*)(lds + RING_BYTES + 1024);
#define GRID_BAR() do { asm volatile("" : "+s"(zoff)); unsigned char* wsb_ = (unsigned char*)ka->ws + zoff; int wvb_ = wave0; asm volatile("" : "+s"(wvb_)); xcd_barrier((unsigned*)(wsb_ + WS_BAR), xb_xcc_id(), (unsigned)G, bst, wvb_); } while (0)
    volatile LAS unsigned* xinfo = bst + 4;
    { PHASE_BEGIN(); if (wave == 0 && lane == 0) { bst[0] = 0u; bst[1] = 0u; xinfo[2] = xb_add((unsigned*)(ws + WS_BAR) + XB_XCNT(xb_xcc_id()), 1u); }
      p0_cmax(a, gw, NGW, lane); }
    GRID_BAR();
    { PHASE_BEGIN(); p0_win_i8(a, lds, gw, NGW, wave, lane); p0_prologue(a, lds, gw, NGW, wave, lane); }
    GRID_BAR();
    {
        PHASE_BEGIN();
        if (wave == 0 && lane == 0) { unsigned* bar = (unsigned*)(ws + WS_BAR); const unsigned x = xb_xcc_id(); unsigned pos = 0, npop = 0, mine = 1;
            for (unsigned j = 0; j < 16; ++j) { const unsigned c = xb_ld(&bar[XB_XCNT(j)]); if (c) { ++npop; if (j < x) ++pos; } if (j == x) mine = c ? c : 1u; }
            xinfo[0] = pos; xinfo[1] = npop ? npop : 1u; xinfo[3] = mine; }
        __syncthreads();
    }
    int depth_rt = DEPTH; asm volatile("" : "+s"(depth_rt));
    for (int lc = 0; lc < depth_rt; ++lc) {
        int l = lc; asm volatile("" : "+s"(l));
        if (l > 0) { { PHASE_BEGIN(); quant_rows(a, l, gw, NGW, lane); } GRID_BAR(); }
        {
            PHASE_BEGIN();
            pg8::Gemm g{(const bf16*)(ws + WS_HB8), (const bf16*)(ws + WS_WIN + l * WIN_BYTES), M, NPROJ, D / 2}; pg8::StaticOrder S; S.init(M, NPROJ, Gp, blk);
            EpiProj E{ws, (const bf16*)(ws + WS_BIH) + l * NPROJ, (const float*)(ws + WS_RSA), (const bf16*)(ws + WS_SWH) + l * NPROJ};
            pg8::gemm_phase<EpiProj, pg8::StaticOrder, true, true>(lds, g, S, E, wave);
            forget_logits(a, l, gw, NGW, lane);
        }
        GRID_BAR();
#if defined(PROBE) && (PROBE == 2 || PROBE == 4)
        { PHASE_BEGIN(); const unsigned char* Gb = ws + WS_G; const bf16* PJ = (const bf16*)(ws + WS_PROJ);
          for (size_t i = (size_t)gw * 64 + lane; i < (size_t)M * D; i += (size_t)NGW * 64) { const size_t t = i / D, d = i % D;
            if (PROBE == 2) a.out[i] = (float)Gb[t * 8192 + d] + 3.0f * (float)Gb[t * 8192 + 2048 + d] + 7.0f * (float)Gb[t * 8192 + 4096 + d] + 13.0f * (float)Gb[t * 8192 + 6144 + d];
            else { float sacc = 0.f; for (int q = 0; q < 10; ++q) if ((d >> 9) == (q & 3)) sacc += (float)(q + 1) * bflo((unsigned)(unsigned short)PJ[(size_t)q * PROJ_T + t * MIXW + (d & 511)]) ; a.out[i] = sacc; } }
          return; }
#endif
        { PHASE_BEGIN(); mixers_fast(a, l, (LAS char*)lds, wave, lane, Gp, blk); }
        GRID_BAR();
#if defined(PROBE) && PROBE == 3
        { PHASE_BEGIN(); const bf16* src = (const bf16*)(ws + WS_Y);
          for (size_t i = (size_t)gw * 64 + lane; i < (size_t)M * D; i += (size_t)NGW * 64) a.out[i] = bflo((unsigned)(unsigned short)src[i]);
          return; }
#endif
        {
            PHASE_BEGIN();
            pg8::Gemm g{(const bf16*)(ws + WS_Y), (const bf16*)(ws + WS_WBR + l * SQ_BYTES), M, D, D}; pg8::StaticOrder S; S.init(M, D, Gp, blk);
            EpiMerge E{(const unsigned char*)(ws + WS_G), (bf16*)(ws + WS_MRG)};
            pg8::gemm_phase<EpiMerge, pg8::StaticOrder, false>(lds, g, S, E, wave);
        }
        GRID_BAR();
#if defined(PROBE) && PROBE == 1
        { PHASE_BEGIN(); const bf16* src = (const bf16*)(ws + WS_MRG);
          for (size_t i = (size_t)gw * 64 + lane; i < (size_t)M * D; i += (size_t)NGW * 64) a.out[i] = bflo((unsigned)(unsigned short)src[i]);
          return; }
#endif
        {
            PHASE_BEGIN();
            pg8::Gemm g{(const bf16*)(ws + WS_MRG), (const bf16*)(ws + WS_WOUT + l * SQ_BYTES), M, D, D}; pg8::StaticOrder S; S.init(M, D, Gp, blk);
            EpiRes E{l == 0 ? a.x : (const float*)nullptr, (bf16*)(ws + WS_HB), (unsigned long long*)(ws + WS_SSA) + l * M};
            pg8::gemm_phase<EpiRes, pg8::StaticOrder, false>(lds, g, S, E, wave);
        }
        GRID_BAR();
        {
            PHASE_BEGIN();
            pg8::Gemm g{(const bf16*)(ws + WS_HB), (const bf16*)(ws + WS_WQ + l * SQ_BYTES), M, D, D}; pg8::StaticOrder S; S.init(M, D, Gp, blk);
            EpiQ E{(bf16*)(ws + WS_Q), (const unsigned long long*)(ws + WS_SSA) + l * M};
            pg8::gemm_phase<EpiQ, pg8::StaticOrder, false>(lds, g, S, E, wave);
        }
        GRID_BAR();
        {
            PHASE_BEGIN(); (void)lane;
            for (int t0 = blk * PEER_TOK; t0 < M; t0 += Gp * PEER_TOK) {
                peer_retrieve(a, l, t0, wave, (LAS char*)lds, wave);
                __syncthreads();
                peer_publish4(a, l, t0 + wave * (PEER_TOK / NWAVES), (LAS char*)lds, wave * (PEER_TOK / NWAVES));
                __syncthreads();
            }
        }
        GRID_BAR();
        {
            PHASE_BEGIN(); (void)lane;
            const int pos = __builtin_amdgcn_readfirstlane((int)xinfo[0]), npop = __builtin_amdgcn_readfirstlane((int)xinfo[1]), rank = __builtin_amdgcn_readfirstlane((int)xinfo[2]), nloc = __builtin_amdgcn_readfirstlane((int)xinfo[3]);
            const PeerItems it{pos, npop, rank, nloc, wave}; peer_u_wave(a, l, it);
        }
        GRID_BAR();
        {
            PHASE_BEGIN(); (void)lane;
            const int pos = __builtin_amdgcn_readfirstlane((int)xinfo[0]), npop = __builtin_amdgcn_readfirstlane((int)xinfo[1]), rank = __builtin_amdgcn_readfirstlane((int)xinfo[2]), nloc = __builtin_amdgcn_readfirstlane((int)xinfo[3]);
            const PeerItems it{pos, npop, rank, nloc, wave}; peer_v_wave(a, l, it);
        }
        GRID_BAR();
    }
    {
        PHASE_BEGIN(); (void)lane;
        for (int t = gw; t < M; t += NGW) final_norm_row(a, t);
    }
}

extern "C" void kernel_launch(void* const* d_in, const int* in_sizes, int n_in, void* d_out, int out_size, void* d_ws, size_t ws_size, hipStream_t stream) {
    static int grid = 0;
    if (grid == 0) {
        int dev = 0, cus = 0, per_cu = 0;
        if (n_in != 16 || out_size != M * D || ws_size < WS_END2) { fprintf(stderr, "kernel_launch: unexpected shapes (n_in %d out %d ws %zu)\n", n_in, out_size, ws_size); grid = -1; return; }
        (void)hipGetDevice(&dev);
        (void)hipDeviceGetAttribute(&cus, hipDeviceAttributeMultiprocessorCount, dev);
        (void)hipFuncSetAttribute((const void*)mk_fwd, hipFuncAttributeMaxDynamicSharedMemorySize, LDS_BYTES);
        (void)hipOccupancyMaxActiveBlocksPerMultiprocessor(&per_cu, (const void*)mk_fwd, NT, LDS_BYTES);
        if (per_cu < 1) { fprintf(stderr, "kernel_launch: occupancy query says %d blocks per CU\n", per_cu); }
        grid = cus;
        if (grid > 256) grid = 256;
    }
    if (grid < 0) return;
    (void)hipMemsetAsync((char*)d_ws + WS_CTL, 0, CTL_ZERO_BYTES, stream);
    ArgsK a{};
    const GAS float** p = (const GAS float**)&a;
    for (int i = 0; i < 16; ++i) p[i] = (const GAS float*)d_in[i];
    a.out = (GAS float*)d_out; a.ws = (GAS unsigned char*)d_ws;
    void* args[] = {&a};
    hipError_t e = hipLaunchCooperativeKernel((const void*)mk_fwd, dim3(grid), dim3(NT), args, LDS_BYTES, stream);
    if (e != hipSuccess) fprintf(stderr, "cooperative launch failed: %s (grid %d)\n", hipGetErrorString(e), grid);
}
```

```cpp
#include <hip/hip_runtime.h>
#include <hip/hip_cooperative_groups.h>
#include <cstdio>
#include <cstdint>
namespace cg = cooperative_groups;
namespace pg8 {
#define PG8_LAS __attribute__((address_space(3)))
typedef unsigned short bf16_t;
typedef short bf16x8 __attribute__((ext_vector_type(8)));
typedef float f32x4 __attribute__((ext_vector_type(4)));
typedef unsigned u32x4 __attribute__((ext_vector_type(4)));
typedef unsigned u32x2 __attribute__((ext_vector_type(2)));
typedef int i32x4 __attribute__((ext_vector_type(4)));
constexpr int BM = 256, BK = 64, HALF = 128, HTB = HALF * BK * 2  , STAGE_BYTES = 8 * HTB, NXCD = 8, WGM = 8;

__host__ __device__ __forceinline__ int lds_byte(int r, int c) { const int st = (r >> 4) * 2 + (c >> 5), rr = r & 15, cc = c & 31, ob = rr * 64 + cc * 2; return st * 1024 + (ob ^ (((ob >> 9) & 1) << 5)); }
__host__ __device__ __forceinline__ void stage_rc(int b, int& R, int& C) { const int st = b / 1024, sb = b % 1024, swz = sb ^ (((sb >> 9) & 1) << 5); R = (st >> 1) * 16 + swz / 64; C = (st & 1) * 32 + (swz % 64) / 2; }
__host__ __device__ __forceinline__ int perm32(int rho) { const int n = rho >> 4, i = rho & 15; return 8 * (i >> 2) + 4 * n + (i & 3); }

struct Unit { int pm, pn; };
struct Gemm { const bf16_t* A; const bf16_t* Bt; int M, N, K; };

struct StaticOrder {
    int nM, nN, nwg, G, c;
    __host__ __device__ void init(int M, int N, int G_, int c_) { nM = M / BM; nN = N / BM; nwg = nM * nN; G = G_; c = c_; }
    __host__ __device__ bool next(int i, Unit& u) const {
        const long L = (long)i * G + c; if (L >= nwg) return false;
        int wgid = (int)L; { const int q = nwg / NXCD, r = nwg % NXCD, xcd = wgid % NXCD, off = wgid / NXCD; wgid = (xcd < r ? xcd * (q + 1) : r * (q + 1) + (xcd - r) * q) + off; }
        const int nig = WGM * nN, gid = wgid / nig, fm = gid * WGM, gsz = (nM - fm) < WGM ? (nM - fm) : WGM;
        u.pm = fm + ((wgid % nig) % gsz); u.pn = (wgid % nig) / gsz; return true;
    }
};

__device__ __forceinline__ unsigned cvt_pk_bf16(float lo, float hi) { unsigned r; asm volatile("v_cvt_pk_bf16_f32 %0, %1, %2" : "=v"(r) : "v"(lo), "v"(hi)); return r; }

template <class Epi, class Sched, bool ALIGN_EPI = false, bool I8 = false>
__device__ __forceinline__ void gemm_phase(PG8_LAS unsigned char* lds, const Gemm g, const Sched& S, const Epi& E, int wid) {
    int lane_; asm volatile("v_mbcnt_lo_u32_b32 %0, -1, 0\n\tv_mbcnt_hi_u32_b32 %0, -1, %0" : "=v"(lane_));
    const int lane = lane_, tid = wid * 64 + lane, wr = wid >> 2, wc = wid & 3, fr = lane & 15, fq = lane >> 4;
    const int K = g.K, nt = K / BK;
    unsigned voffA, voffB;
    { int R, C; stage_rc(tid * 16, R, C); const int Rb = Epi::PERM ? ((R & ~31) + perm32(R & 31)) : R; voffA = (unsigned)(R * K + C) * 2u; voffB = (unsigned)(Rb * K + C) * 2u; }
    const size_t p2step = (size_t)64 * K * 2;
    const size_t kstep = (size_t)(BK * 2);
    const size_t hstep = (size_t)HALF * K * 2;
    const size_t tstep = 2 * hstep;
    const unsigned ldsw = (unsigned)wid * 1024u;
    const int aoff = lds_byte(wr * 64 + fr, fq * 8), boff = lds_byte(wc * 32 + fr, fq * 8);
#define PG8_SA(b, h) (((b) * 2 + (h)) * HTB)
#define PG8_SB(b, h) ((4 + (b) * 2 + (h)) * HTB)
#define PG8_STAGE(bufoff, gbase, voff) do { _Pragma("unroll") for (int _i = 0; _i < 2; ++_i) \
        __builtin_amdgcn_global_load_lds((const unsigned*)((const char*)(gbase) + _i * p2step + (voff)), (PG8_LAS unsigned*)(lds + (bufoff) + ldsw + _i * 8192), 16, 0, 0); } while (0)
#define PG8_LDA(dst, b, h) do { _Pragma("unroll") for (int m = 0; m < 4; ++m) _Pragma("unroll") for (int k = 0; k < 2; ++k) dst[m][k] = *(const PG8_LAS bf16x8*)(lds + PG8_SA(b, h) + aoff + m * 2048 + k * 1024); } while (0)
#define PG8_LDB(dst, b, h) do { _Pragma("unroll") for (int n = 0; n < 2; ++n) _Pragma("unroll") for (int k = 0; k < 2; ++k) dst[n][k] = *(const PG8_LAS bf16x8*)(lds + PG8_SB(b, h) + boff + n * 2048 + k * 1024); } while (0)
#define PG8_MMA(ai, bj, At, Bt) do { __builtin_amdgcn_s_setprio(1); _Pragma("unroll") for (int m = 0; m < 4; ++m) _Pragma("unroll") for (int n = 0; n < 2; ++n) _Pragma("unroll") for (int k = 0; k < 2; ++k) \
        { if constexpr (I8) acc[ai][bj][m][n] = __builtin_bit_cast(f32x4, __builtin_amdgcn_mfma_i32_16x16x64_i8(__builtin_bit_cast(i32x4, Bt[n][k]), __builtin_bit_cast(i32x4, At[m][k]), __builtin_bit_cast(i32x4, acc[ai][bj][m][n]), 0, 0, 0)); \
          else acc[ai][bj][m][n] = __builtin_amdgcn_mfma_f32_16x16x32_bf16(Bt[n][k], At[m][k], acc[ai][bj][m][n], 0, 0, 0); } __builtin_amdgcn_s_setprio(0); } while (0)
#define PG8_WAIT_V(n) asm volatile("s_waitcnt vmcnt(" #n ")" ::: "memory")
#define PG8_WAIT_L(n) asm volatile("s_waitcnt lgkmcnt(" #n ")" ::: "memory")
#define PG8_BAR __builtin_amdgcn_s_barrier()
#define PG8_SCHED __builtin_amdgcn_sched_barrier(0)
    Unit cur, nxt; int ui = 0;
    if (!S.next(0, cur)) return;
    f32x4 acc[2][2][4][2];
#pragma unroll
    for (int a = 0; a < 2; ++a)
#pragma unroll
        for (int b = 0; b < 2; ++b)
#pragma unroll
            for (int m = 0; m < 4; ++m)
#pragma unroll
                for (int n = 0; n < 2; ++n) acc[a][b][m][n] = (f32x4){0.f, 0.f, 0.f, 0.f};
    bf16x8 At[4][2], B0[2][2], B1[2][2];
    typename Epi::Pre pre = {};
    const char* cA = (const char*)g.A + (size_t)cur.pm * tstep; const char* cB = (const char*)g.Bt + (size_t)cur.pn * tstep;
    PG8_STAGE(PG8_SB(0, 0), cB, voffB); PG8_STAGE(PG8_SB(0, 1), cB + hstep, voffB); PG8_STAGE(PG8_SA(0, 0), cA, voffA); PG8_STAGE(PG8_SA(0, 1), cA + hstep, voffA);
    if (wr == 1) PG8_BAR;
    PG8_WAIT_V(2); PG8_BAR;
    PG8_STAGE(PG8_SB(1, 0), cB + kstep, voffB); PG8_STAGE(PG8_SA(1, 0), cA + kstep, voffA); PG8_STAGE(PG8_SB(1, 1), cB + hstep + kstep, voffB);
    PG8_WAIT_V(6); PG8_BAR;
    for (;;) {
        const bool has_next = S.next(ui + 1, nxt);
        const char* nA = has_next ? (const char*)g.A + (size_t)nxt.pm * tstep : cA; const char* nB = has_next ? (const char*)g.Bt + (size_t)nxt.pn * tstep : cB;
        const int seglen = Epi::HOOK ? 8 : nt;
        for (int t0 = 0; t0 < nt; t0 += seglen) {
        if constexpr (Epi::HOOK) { if (t0 > 0) { int ln_; asm volatile("v_mbcnt_lo_u32_b32 %0, -1, 0\n\tv_mbcnt_hi_u32_b32 %0, -1, %0" : "=v"(ln_)); E.hook(acc, cur, t0 >> 3, wr, wc, ln_ & 15, ln_ >> 4); } }
        for (int t = t0; t < t0 + seglen; t += 2) {
            const bool last = (t == nt - 2);
            if constexpr (Epi::PRELOAD) { if (last) { int ln_; asm volatile("v_mbcnt_lo_u32_b32 %0, -1, 0\n\tv_mbcnt_hi_u32_b32 %0, -1, %0" : "=v"(ln_)); E.preload(pre, cur, wr, wc, ln_ & 15, ln_ >> 4); } }
            const char* a1 = cA + (size_t)(t + 1) * kstep;
            const char* a2 = last ? nA : cA + (size_t)(t + 2) * kstep; const char* b2 = last ? nB : cB + (size_t)(t + 2) * kstep;
            const char* a3 = a2 + kstep; const char* b3 = b2 + kstep;
            PG8_LDB(B0, 0, 0); PG8_LDB(B1, 0, 1); PG8_SCHED; PG8_LDA(At, 0, 0); PG8_STAGE(PG8_SA(1, 1), a1 + hstep, voffA);
            PG8_WAIT_V(8); PG8_WAIT_L(0); PG8_BAR; PG8_MMA(0, 0, At, B0); PG8_MMA(0, 1, At, B1); PG8_BAR; PG8_SCHED;
            PG8_LDA(At, 0, 1); PG8_STAGE(PG8_SB(0, 0), b2, voffB); PG8_STAGE(PG8_SB(0, 1), b2 + hstep, voffB); PG8_STAGE(PG8_SA(0, 0), a2, voffA);
            PG8_WAIT_V(8); PG8_WAIT_L(0); PG8_BAR; PG8_MMA(1, 0, At, B0); PG8_MMA(1, 1, At, B1); PG8_BAR; PG8_SCHED;
            PG8_LDB(B0, 1, 0); PG8_LDB(B1, 1, 1); PG8_SCHED; PG8_LDA(At, 1, 0); PG8_STAGE(PG8_SA(0, 1), a2 + hstep, voffA);
            PG8_WAIT_V(8); PG8_WAIT_L(0); PG8_BAR; PG8_MMA(0, 0, At, B0); PG8_MMA(0, 1, At, B1); PG8_BAR; PG8_SCHED;
            PG8_LDA(At, 1, 1); PG8_STAGE(PG8_SB(1, 0), b3, voffB); PG8_STAGE(PG8_SB(1, 1), b3 + hstep, voffB); PG8_STAGE(PG8_SA(1, 0), a3, voffA);
            PG8_WAIT_V(8); PG8_WAIT_L(0); PG8_BAR; PG8_MMA(1, 0, At, B0); PG8_MMA(1, 1, At, B1); PG8_BAR; PG8_SCHED;
        }
        }
        if constexpr (ALIGN_EPI) { if (wr == 0) PG8_BAR; }
        { int ln_; asm volatile("v_mbcnt_lo_u32_b32 %0, -1, 0\n\tv_mbcnt_hi_u32_b32 %0, -1, %0" : "=v"(ln_));
          if constexpr (Epi::PRELOAD) E(acc, cur, wr, wc, ln_ & 15, ln_ >> 4, pre); else E(acc, cur, wr, wc, ln_ & 15, ln_ >> 4); }
        if (!has_next) break;
#pragma unroll
        for (int a = 0; a < 2; ++a)
#pragma unroll
            for (int b = 0; b < 2; ++b)
#pragma unroll
                for (int m = 0; m < 4; ++m)
#pragma unroll
                    for (int n = 0; n < 2; ++n) acc[a][b][m][n] = (f32x4){0.f, 0.f, 0.f, 0.f};
        cur = nxt; cA = nA; cB = nB; ++ui;
        if constexpr (ALIGN_EPI) { if (wr == 1) PG8_BAR; }
    }
    PG8_WAIT_V(0);
    if constexpr (!ALIGN_EPI) { if (wr == 0) PG8_BAR; }
    PG8_BAR;
#undef PG8_SA
#undef PG8_SB
#undef PG8_STAGE
#undef PG8_LDA
#undef PG8_LDB
#undef PG8_MMA
#undef PG8_WAIT_V
#undef PG8_WAIT_L
#undef PG8_BAR
#undef PG8_SCHED
}
}
constexpr int NWAVES = 8, NT = NWAVES * 64;
constexpr int M = 8192, D = 2048, SEQ = 2048, NBATCH = 4, DEPTH = 2;
constexpr int INW = 13316, NPROJ = 13312, MIXW = 512, HD = 128;
constexpr int PEER_E = 16384;
constexpr float EPS = 1e-6f;
constexpr float ATT_SCALE = 0.08838834764831845f;

constexpr size_t MiB = 1u << 20;
constexpr size_t WS_CTL = 0, CTL_ZERO_BYTES = 1 * MiB;
constexpr size_t WS_SSQ = 0;
constexpr size_t WS_SSA = 256 * 1024;
constexpr size_t WS_WF = 1 * MiB;
constexpr size_t WS_BINR = WS_WF + 64 * 1024;
constexpr size_t WS_LOGF = 2 * MiB;
constexpr size_t WS_CUM = 3 * MiB;
constexpr size_t WS_WIN = 8 * MiB;
constexpr size_t WIN_BYTES = (size_t)NPROJ * D;
constexpr size_t WS_SW = 7 * MiB;
constexpr size_t WS_CMAX = 384 * 1024;
constexpr size_t WS_HB8 = 64 * MiB;
constexpr size_t WS_SA = 7 * MiB + 512 * 1024;
constexpr size_t WS_WBR = 112 * MiB, WS_WOUT = 128 * MiB, WS_WQ = 144 * MiB;
constexpr size_t SQ_BYTES = (size_t)D * D * 2;
constexpr size_t WS_PU = 160 * MiB, WS_PV = 288 * MiB;
constexpr size_t PE_BYTES = (size_t)PEER_E * D;
constexpr size_t WS_PK = 6 * MiB;
constexpr size_t WS_SU = 5 * MiB, WS_SV = 5 * MiB + 256 * 1024;
constexpr size_t WS_HB = 480 * MiB;
constexpr size_t WS_PROJ = 512 * MiB;
constexpr size_t PROJ_T = (size_t)M * MIXW;
constexpr size_t WS_R = 592 * MiB;
constexpr size_t R_PLANE = (size_t)M * D;
constexpr size_t WS_Y = 720 * MiB;
constexpr size_t WS_MRG = 752 * MiB;
constexpr size_t WS_Q = 784 * MiB;
constexpr size_t WS_END = 816 * MiB;

constexpr int RING_BYTES = 131072;
constexpr int LDS_BYTES = 147456;

typedef unsigned short bf16;
typedef unsigned v4u __attribute__((ext_vector_type(4)));
typedef unsigned v2u __attribute__((ext_vector_type(2)));
typedef float f32x4 __attribute__((ext_vector_type(4)));
typedef float f32x2 __attribute__((ext_vector_type(2)));
using bf16x2 = __attribute__((ext_vector_type(2))) __bf16;
#define LAS __attribute__((address_space(3)))

__device__ __forceinline__ unsigned f2bf(float f) { unsigned u = __builtin_bit_cast(unsigned, f); return (u + 0x7fffu + ((u >> 16) & 1u)) >> 16; }
__device__ __forceinline__ unsigned pk2(float lo, float hi) { return f2bf(lo) | (f2bf(hi) << 16); }
__device__ __forceinline__ float bflo(unsigned w) { return __builtin_bit_cast(float, w << 16); }
__device__ __forceinline__ float bfhi(unsigned w) { return __builtin_bit_cast(float, w & 0xffff0000u); }
__device__ __forceinline__ float bf2f(bf16 b) { return __builtin_bit_cast(float, ((unsigned)b) << 16); }
__device__ __forceinline__ float shf(float v, int src) { return __builtin_bit_cast(float, __builtin_amdgcn_ds_bpermute(src << 2, __builtin_bit_cast(int, v))); }
__device__ __forceinline__ int shi(int v, int src) { return __builtin_amdgcn_ds_bpermute(src << 2, v); }
#define DPP_ROR(x, n) __builtin_bit_cast(float, __builtin_amdgcn_update_dpp(0, __builtin_bit_cast(int, (x)), 0x120 + (n), 0xf, 0xf, false))
__device__ __forceinline__ float wave_sum(float v, int) {
    v += DPP_ROR(v, 8); v += DPP_ROR(v, 4); v += DPP_ROR(v, 2); v += DPP_ROR(v, 1);
    const int vi = __builtin_bit_cast(int, v);
    const float r0 = __builtin_bit_cast(float, __builtin_amdgcn_readlane(vi, 0)), r1 = __builtin_bit_cast(float, __builtin_amdgcn_readlane(vi, 16)),
                r2 = __builtin_bit_cast(float, __builtin_amdgcn_readlane(vi, 32)), r3 = __builtin_bit_cast(float, __builtin_amdgcn_readlane(vi, 48));
    return (r0 + r1) + (r2 + r3);
}
__device__ __forceinline__ float wave_max(float v, int) {
    v = fmaxf(v, DPP_ROR(v, 8)); v = fmaxf(v, DPP_ROR(v, 4)); v = fmaxf(v, DPP_ROR(v, 2)); v = fmaxf(v, DPP_ROR(v, 1));
    const int vi = __builtin_bit_cast(int, v);
    const float r0 = __builtin_bit_cast(float, __builtin_amdgcn_readlane(vi, 0)), r1 = __builtin_bit_cast(float, __builtin_amdgcn_readlane(vi, 16)),
                r2 = __builtin_bit_cast(float, __builtin_amdgcn_readlane(vi, 32)), r3 = __builtin_bit_cast(float, __builtin_amdgcn_readlane(vi, 48));
    return fmaxf(fmaxf(r0, r1), fmaxf(r2, r3));
}
__device__ __forceinline__ float ssa_to_f(unsigned long long v) { return (float)((double)v * (1.0 / 4294967296.0)); }
__device__ __forceinline__ float dot2_bf16(unsigned w, unsigned x, float acc) { return __builtin_amdgcn_fdot2_f32_bf16(__builtin_bit_cast(bf16x2, w), __builtin_bit_cast(bf16x2, x), acc, false); }

#define LANE_ID(x) asm volatile("v_mbcnt_lo_u32_b32 %0, -1, 0\n\tv_mbcnt_hi_u32_b32 %0, -1, %0" : "=v"(x))
struct Args {
    const float *x, *norm_mix, *w_in, *b_in, *pool_w, *pool_scale, *conv_w, *rel_bias, *w_branch, *w_out, *norm_ffn, *peer_wq, *peer_keys, *peer_u, *peer_v, *norm_final;
    float* out; unsigned char* ws;
};
#define GAS __attribute__((address_space(1)))
#define CAS __attribute__((address_space(4)))
struct ArgsK {
    const GAS float *x, *norm_mix, *w_in, *b_in, *pool_w, *pool_scale, *conv_w, *rel_bias, *w_branch, *w_out, *norm_ffn, *peer_wq, *peer_keys, *peer_u, *peer_v, *norm_final;
    GAS float* out; GAS unsigned char* ws;
};
__device__ __forceinline__ Args load_args(const CAS ArgsK* k, size_t zoff) {
    Args a;
    a.x = (const float*)k->x; a.norm_mix = (const float*)k->norm_mix; a.w_in = (const float*)k->w_in; a.b_in = (const float*)k->b_in; a.pool_w = (const float*)k->pool_w;
    a.pool_scale = (const float*)k->pool_scale; a.conv_w = (const float*)k->conv_w; a.rel_bias = (const float*)k->rel_bias; a.w_branch = (const float*)k->w_branch;
    a.w_out = (const float*)k->w_out; a.norm_ffn = (const float*)k->norm_ffn; a.peer_wq = (const float*)k->peer_wq; a.peer_keys = (const float*)k->peer_keys;
    a.peer_u = (const float*)k->peer_u; a.peer_v = (const float*)k->peer_v; a.norm_final = (const float*)k->norm_final; a.out = (float*)k->out; a.ws = (unsigned char*)(k->ws + zoff);
    return a;
}

using pg8::f32x4; using pg8::Unit;
constexpr size_t WS_G = 896 * MiB;
constexpr size_t WS_SWH = 7 * MiB + 256 * 1024, WS_BIH = 7 * MiB + 384 * 1024;
constexpr size_t WS_RSA = 7 * MiB + 768 * 1024;
struct EpiProj {
    static constexpr bool PERM = true, HOOK = false, PRELOAD = true;
    struct Pre { pg8::u32x4 sw[2], bi[2]; float rs[2][4]; };
    unsigned char* wsb; const bf16* biash; const float* rsa; const bf16* swh;
    __device__ __forceinline__ void preload(Pre& p, const Unit& u, int wr, int wc, int fr, int fq) const {
        const int row0 = u.pm * 256 + wr * 64 + fr, bcol0 = u.pn * 256 + wc * 32 + 8 * fq;
#pragma unroll
        for (int bj = 0; bj < 2; ++bj) { p.sw[bj] = *(const pg8::u32x4*)(swh + bcol0 + bj * 128); p.bi[bj] = *(const pg8::u32x4*)(biash + bcol0 + bj * 128); }
#pragma unroll
        for (int ai = 0; ai < 2; ++ai)
#pragma unroll
            for (int m = 0; m < 4; ++m) p.rs[ai][m] = rsa[row0 + ai * 128 + m * 16];
    }
    static __device__ __forceinline__ unsigned g8(float z) { const float t = __builtin_amdgcn_rcpf(__builtin_amdgcn_exp2f(__builtin_fmaf(z, -1.4426950408889634f, -8.0f)) + 0.00390625f);
        return (unsigned)(__builtin_amdgcn_fmed3f(t, 1.0f, 255.0f) + 0.5f); }
    static __device__ __forceinline__ unsigned g8x4(const f32x4& v) { return g8(v[0]) | (g8(v[1]) << 8) | (g8(v[2]) << 16) | (g8(v[3]) << 24); }
    __device__ __forceinline__ void operator()(f32x4 (&acc)[2][2][4][2], const Unit& u, int wr, int wc, int fr, int fq, const Pre& p) const {
        const int cl0 = wc * 32 + 8 * fq;
#define ACCF(ai, bj, m, n) __builtin_convertvector(__builtin_bit_cast(pg8::i32x4, acc[ai][bj][m][n]), f32x4)
        const __amdgpu_buffer_rsrc_t rW = __builtin_amdgcn_make_buffer_rsrc((void*)wsb, 0, 0x7fffffff, 0x00020000);
        int sbase, ldb, voff;
        if (u.pn < 20) { sbase = (int)WS_PROJ + ((u.pn >> 1) * (int)PROJ_T + (u.pn & 1) * 256) * 2; ldb = MIXW * 2; voff = fr * ldb + cl0 * 2; }
        else { sbase = (int)WS_G + (u.pn - 20) * 256; ldb = 4 * D; voff = fr * ldb + wc * 64 + fq * 16; }
        sbase += (u.pm * 256 + wr * 64) * ldb;
#pragma unroll
        for (int bj = 0; bj < 2; ++bj) { const f32x4 w0 = {bflo(p.sw[bj].x), bfhi(p.sw[bj].x), bflo(p.sw[bj].y), bfhi(p.sw[bj].y)}, w1 = {bflo(p.sw[bj].z), bfhi(p.sw[bj].z), bflo(p.sw[bj].w), bfhi(p.sw[bj].w)};
            const f32x4 b0 = {bflo(p.bi[bj].x), bfhi(p.bi[bj].x), bflo(p.bi[bj].y), bfhi(p.bi[bj].y)}, b1 = {bflo(p.bi[bj].z), bfhi(p.bi[bj].z), bflo(p.bi[bj].w), bfhi(p.bi[bj].w)};
#pragma unroll
            for (int ai = 0; ai < 2; ++ai)
#pragma unroll
                for (int m = 0; m < 4; ++m) { const float rs = p.rs[ai][m]; const f32x4 v0 = ACCF(ai, bj, m, 0) * rs * w0 + b0, v1 = ACCF(ai, bj, m, 1) * rs * w1 + b1;
                    if (u.pn >= 20) { v2u w; w.x = g8x4(v0); w.y = g8x4(v1);
                        __builtin_amdgcn_raw_buffer_store_b64(w, rW, voff + bj * 8, sbase + (ai * 128 + m * 16) * ldb, 0); }
                    else { pg8::u32x4 w; w.x = pg8::cvt_pk_bf16(v0[0], v0[1]); w.y = pg8::cvt_pk_bf16(v0[2], v0[3]); w.z = pg8::cvt_pk_bf16(v1[0], v1[1]); w.w = pg8::cvt_pk_bf16(v1[2], v1[3]);
                        __builtin_amdgcn_raw_buffer_store_b128(w, rW, voff + bj * 256, sbase + (ai * 128 + m * 16) * ldb, 0); } } }
    }
};
#undef ACCF
struct EpiMerge {
    static constexpr bool PERM = true, HOOK = true; static constexpr bool PRELOAD = false; struct Pre {};
    const unsigned char* G; bf16* O;
    struct Bt { pg8::u32x4 n[4], d[4]; };
    __device__ __forceinline__ void scale(f32x4 (&acc)[2][2][4][2], const Unit& u, int g, int wr, int wc, int fr, int fq) const {
        const __amdgpu_buffer_rsrc_t rs = __builtin_amdgcn_make_buffer_rsrc((void*)G, 0, 0x7fffffff, 0x00020000);
        int voff = fr * 4 * D + 16 * fq; asm volatile("" : "+v"(voff));
        const int sden = (u.pm * 256 + wr * 64) * 4 * D + (g - 1) * D + u.pn * 256 + wc * 64, snum = sden + D;
        const bool fin = g == 4;
#define UB(x, e) ((float)(((x) >> (8 * (e))) & 255u))
#define MG_LOAD(B, b0) do { _Pragma("unroll") for (int i = 0; i < 4; ++i) { const int ai_ = ((b0) + i) >> 2, m_ = ((b0) + i) & 3, so_ = (ai_ * 128 + m_ * 16) * 4 * D; \
            B.d[i] = __builtin_amdgcn_raw_buffer_load_b128(rs, voff, sden + so_, 0); if (!fin) B.n[i] = __builtin_amdgcn_raw_buffer_load_b128(rs, voff, snum + so_, 0); } } while (0)
#define MG_APPLY(B, b0) do { _Pragma("unroll") for (int i = 0; i < 4; ++i) { const int ai_ = ((b0) + i) >> 2, m_ = ((b0) + i) & 3; \
            _Pragma("unroll") for (int q = 0; q < 4; ++q) { const unsigned dq = B.d[i][q], nq = B.n[i][q]; \
                f32x4 r = {UB(dq, 0), UB(dq, 1), UB(dq, 2), UB(dq, 3)}; \
                if (!fin) r *= (f32x4){__builtin_amdgcn_rcpf(UB(nq, 0)), __builtin_amdgcn_rcpf(UB(nq, 1)), __builtin_amdgcn_rcpf(UB(nq, 2)), __builtin_amdgcn_rcpf(UB(nq, 3))}; else r *= 0.00390625f; \
                acc[ai_][q >> 1][m_][q & 1] *= r; asm volatile("" : "+v"(acc[ai_][q >> 1][m_][q & 1])); } } } while (0)
        Bt A = {}, B = {};
        MG_LOAD(A, 0); MG_LOAD(B, 4);
        MG_APPLY(A, 0); asm volatile("" ::: "memory");
        MG_APPLY(B, 4); asm volatile("" ::: "memory");
#undef MG_LOAD
#undef MG_APPLY
#undef UB
    }
    __device__ __forceinline__ void hook(f32x4 (&acc)[2][2][4][2], const Unit& u, int g, int wr, int wc, int fr, int fq) const { scale(acc, u, g, wr, wc, fr, fq); }
    __device__ __forceinline__ void operator()(f32x4 (&acc)[2][2][4][2], const Unit& u, int wr, int wc, int fr, int fq) const {
        scale(acc, u, 4, wr, wc, fr, fq);
        const int row0 = u.pm * 256 + wr * 64 + fr, col0 = u.pn * 256 + wc * 32 + 8 * fq;
#pragma unroll
        for (int ai = 0; ai < 2; ++ai)
#pragma unroll
            for (int m = 0; m < 4; ++m) { bf16* rowp = O + (size_t)(row0 + ai * 128 + m * 16) * D + col0;
#pragma unroll
                for (int bj = 0; bj < 2; ++bj) { const f32x4 v0 = acc[ai][bj][m][0], v1 = acc[ai][bj][m][1];
                    pg8::u32x4 w; w.x = pg8::cvt_pk_bf16(v0[0], v0[1]); w.y = pg8::cvt_pk_bf16(v0[2], v0[3]); w.z = pg8::cvt_pk_bf16(v1[0], v1[1]); w.w = pg8::cvt_pk_bf16(v1[2], v1[3]);
                    *(pg8::u32x4*)(rowp + bj * 128) = w; } }
    }
};
struct EpiRes {
    static constexpr bool PERM = true, HOOK = false; static constexpr bool PRELOAD = false; struct Pre {};
    const float* X; bf16* HB; unsigned long long* ssa;
    __device__ __forceinline__ void operator()(f32x4 (&acc)[2][2][4][2], const Unit& u, int wr, int wc, int fr, int fq) const {
        const int row0 = u.pm * 256 + wr * 64 + fr, col0 = u.pn * 256 + wc * 32 + 8 * fq;
#pragma unroll
        for (int ai = 0; ai < 2; ++ai)
#pragma unroll
            for (int m = 0; m < 4; ++m) { const int row = row0 + ai * 128 + m * 16; const size_t off = (size_t)row * D + col0; float s = 0.f;
#pragma unroll
                for (int bj = 0; bj < 2; ++bj) { const size_t o = off + bj * 128; f32x4 h0, h1;
                    if (X != nullptr) { h0 = *(const f32x4*)(X + o); h1 = *(const f32x4*)(X + o + 4); }
                    else { const pg8::u32x4 w = *(const pg8::u32x4*)(HB + o); h0 = (f32x4){bflo(w.x), bfhi(w.x), bflo(w.y), bfhi(w.y)}; h1 = (f32x4){bflo(w.z), bfhi(w.z), bflo(w.w), bfhi(w.w)}; }
                    h0 += acc[ai][bj][m][0]; h1 += acc[ai][bj][m][1];
                    pg8::u32x4 w; w.x = pg8::cvt_pk_bf16(h0[0], h0[1]); w.y = pg8::cvt_pk_bf16(h0[2], h0[3]); w.z = pg8::cvt_pk_bf16(h1[0], h1[1]); w.w = pg8::cvt_pk_bf16(h1[2], h1[3]);
                    *(pg8::u32x4*)(HB + o) = w;
                    s += ((h0[0] * h0[0] + h0[1] * h0[1]) + (h0[2] * h0[2] + h0[3] * h0[3])) + ((h1[0] * h1[0] + h1[1] * h1[1]) + (h1[2] * h1[2] + h1[3] * h1[3])); }
                { const int ln = fq * 16 + fr; s += shf(s, ln ^ 16); s += shf(s, ln ^ 32); }
                if (fq == 0) atomicAdd(ssa + row, (unsigned long long)((double)s * 4294967296.0)); }
    }
};
struct EpiQ {
    static constexpr bool PERM = true, HOOK = false; static constexpr bool PRELOAD = false; struct Pre {};
    bf16* O; const unsigned long long* ssa;
    __device__ __forceinline__ void operator()(f32x4 (&acc)[2][2][4][2], const Unit& u, int wr, int wc, int fr, int fq) const {
        const int row0 = u.pm * 256 + wr * 64 + fr;
#pragma unroll
        for (int ai = 0; ai < 2; ++ai)
#pragma unroll
            for (int m = 0; m < 4; ++m) { const int row = row0 + ai * 128 + m * 16; const float rs = rsqrtf(ssa_to_f(ssa[row]) * (1.0f / D) + EPS);
                bf16* rowp = O + ((((size_t)(row >> 5) * 8 + u.pn) * 2 * 8 + (wc * 2 + (fq >> 1))) * 64 + (fq & 1) * 32 + (row & 31)) * 8;
#pragma unroll
                for (int bj = 0; bj < 2; ++bj) { const f32x4 v0 = acc[ai][bj][m][0] * rs, v1 = acc[ai][bj][m][1] * rs;
                    pg8::u32x4 w; w.x = pg8::cvt_pk_bf16(v0[0], v0[1]); w.y = pg8::cvt_pk_bf16(v0[2], v0[3]); w.z = pg8::cvt_pk_bf16(v1[0], v1[1]); w.w = pg8::cvt_pk_bf16(v1[2], v1[3]);
                    *(pg8::u32x4*)(rowp + bj * 8 * 512) = w; } }
    }
};

__device__ __forceinline__ int colmap_in(int j) { return j < 1536 ? j : j + 4; }
__device__ __forceinline__ void tr_item_i8(const float* W, const float* gain, const unsigned* cmax, unsigned char* WT, LAS float* scr, int k0, int n0, int lane) {
    const int q = lane & 7, r8 = lane >> 3, sc = colmap_in(n0 + 4 * q);
    f32x4 v[8];
#pragma unroll
    for (int i = 0; i < 8; ++i) v[i] = *(const f32x4*)(W + (size_t)(k0 + 8 * i + r8) * INW + sc);
    f32x4 inv;
#pragma unroll
    for (int e = 0; e < 4; ++e) { const float cm = __builtin_bit_cast(float, cmax[sc + e]); inv[e] = cm > 0.f ? 127.0f / cm : 0.f; }
#pragma unroll
    for (int i = 0; i < 8; ++i) { const float g = gain[k0 + 8 * i + r8];
#pragma unroll
        for (int e = 0; e < 4; ++e) scr[(8 * i + r8) * 33 + 4 * q + e] = v[i][e] * g * inv[e]; }
    asm volatile("s_waitcnt lgkmcnt(0)" ::: "memory");
    const int n = lane >> 1, hf = lane & 1;
    v4u o[2];
#pragma unroll
    for (int w = 0; w < 8; ++w) { unsigned pk = 0;
#pragma unroll
        for (int b = 0; b < 4; ++b) pk |= ((unsigned)((int)rintf(scr[(32 * hf + 4 * w + b) * 33 + n]) & 255)) << (8 * b);
        o[w >> 2][w & 3] = pk; }
    unsigned char* dst = WT + (size_t)(n0 + n) * D + k0 + 32 * hf;
    *(v4u*)dst = o[0]; *(v4u*)(dst + 16) = o[1];
    asm volatile("s_waitcnt lgkmcnt(0)" ::: "memory");
}
template <bool MAP>
__device__ __forceinline__ void tr_item(const float* W, int ldw, const float* scale, bf16* WT, int ldt, int dcol0, LAS float* scr, int k0, int n0, int lane) {
    const int q = lane & 7, r8 = lane >> 3, sc = MAP ? colmap_in(n0 + 4 * q) : (n0 + 4 * q);
    f32x4 v[8];
#pragma unroll
    for (int i = 0; i < 8; ++i) v[i] = *(const f32x4*)(W + (size_t)(k0 + 8 * i + r8) * ldw + sc);
    f32x4 s0 = {1.f, 1.f, 1.f, 1.f}, s1 = s0;
    if (scale) { s0 = *(const f32x4*)(scale + k0 + 8 * q); s1 = *(const f32x4*)(scale + k0 + 8 * q + 4); }
#pragma unroll
    for (int i = 0; i < 8; ++i)
#pragma unroll
        for (int e = 0; e < 4; ++e) scr[(8 * i + r8) * 33 + 4 * q + e] = v[i][e];
    asm volatile("s_waitcnt lgkmcnt(0)" ::: "memory");
    const int c = q;
#pragma unroll
    for (int j = 0; j < 4; ++j) { const int n = r8 + 8 * j; const LAS float* s = scr + (8 * c) * 33 + n;
        v4u o; o.x = pk2(s[0 * 33] * s0[0], s[1 * 33] * s0[1]); o.y = pk2(s[2 * 33] * s0[2], s[3 * 33] * s0[3]); o.z = pk2(s[4 * 33] * s1[0], s[5 * 33] * s1[1]); o.w = pk2(s[6 * 33] * s1[2], s[7 * 33] * s1[3]);
        *(v4u*)(WT + (size_t)(n0 + n) * ldt + dcol0 + k0 + 8 * c) = o; }
    asm volatile("s_waitcnt lgkmcnt(0)" ::: "memory");
}
constexpr size_t WS_BAR = 512 * 1024;
#define XB_TMO      128
#define XB_XCNT(j)  (256  + 64 * (j))
#define XB_XSUB(j)  (1280 + 64 * (j))
#define XB_XGEN(j)  (2304 + 64 * (j))
#define XB_TOP      3328
#define XB_TOPGEN   3392
#define XCD_BAR_WORDS 3456
#define XB_SPIN_CAP (1u << 23)
__device__ __forceinline__ unsigned xb_ld(unsigned* p)              { return __hip_atomic_load(p, __ATOMIC_RELAXED, __HIP_MEMORY_SCOPE_AGENT); }
__device__ __forceinline__ unsigned xb_add(unsigned* p, unsigned v) { return __hip_atomic_fetch_add(p, v, __ATOMIC_RELAXED, __HIP_MEMORY_SCOPE_AGENT); }
__device__ __forceinline__ unsigned xb_xcc_id() { return (unsigned)__builtin_amdgcn_s_getreg((3 << 11) | 20) & 0xFu; }
#define XB_SPIN(cond, bar) do { unsigned _sp = 0; while (cond) { __builtin_amdgcn_s_sleep(1); \
    if ((++_sp & 255u) == 0u) { if (xb_ld(&(bar)[XB_TMO])) break; if (_sp > XB_SPIN_CAP) { atomicAdd(&(bar)[XB_TMO], 1u); break; } } } } while (0)
__device__ __forceinline__ void xcd_barrier_complete(unsigned* bar, unsigned x, unsigned G, unsigned& nloc, unsigned& nx) {
    unsigned sum, cnt, mine, sp = 0u;
    for (;;) {
        sum = 0u; cnt = 0u; mine = 0u;
#pragma unroll
        for (unsigned j = 0; j < 16; ++j) { const unsigned c = xb_ld(&bar[XB_XCNT(j)]); sum += c; cnt += (c > 0u) ? 1u : 0u; mine = (j == x) ? c : mine; }
        if (sum == G) break;
        __builtin_amdgcn_s_sleep(1);
        if ((++sp & 255u) == 0u) { if (xb_ld(&bar[XB_TMO])) break; if (sp > XB_SPIN_CAP) { atomicAdd(&bar[XB_TMO], 1u); break; } }
    }
    nloc = mine > 0u ? mine : 1u; nx = cnt > 0u ? cnt : 1u;
}
__device__ __forceinline__ void xcd_barrier(unsigned* bar, unsigned x, unsigned G, volatile LAS unsigned* st, int wave) {
    asm volatile("s_waitcnt vmcnt(0)" ::: "memory");
    __syncthreads();
    int lane; asm volatile("v_mbcnt_lo_u32_b32 %0, -1, 0\n\tv_mbcnt_hi_u32_b32 %0, -1, %0" : "=v"(lane));
    if (wave == 0 && lane == 0) {
        __builtin_amdgcn_s_waitcnt(0);
        unsigned nloc = st[0], nx = st[1];
        if (nloc == 0u) { xcd_barrier_complete(bar, x, G, nloc, nx); st[0] = nloc; st[1] = nx; }
        const unsigned old = xb_add(&bar[XB_XSUB(x)], 1u);
        const unsigned gen = old / nloc;
        if (old + 1u == (gen + 1u) * nloc) {
            __builtin_amdgcn_fence(__ATOMIC_RELEASE, "agent");
            asm volatile("s_waitcnt vmcnt(0)" ::: "memory");
            const unsigned og = xb_add(&bar[XB_TOP], 1u);
            const unsigned tg = og / nx;
            if (og + 1u == (tg + 1u) * nx) xb_add(&bar[XB_TOPGEN], 1u);
            else XB_SPIN(xb_ld(&bar[XB_TOPGEN]) == tg, bar);
            __builtin_amdgcn_fence(__ATOMIC_ACQUIRE, "agent");
            xb_add(&bar[XB_XGEN(x)], 1u);
            asm volatile("s_waitcnt vmcnt(0)" ::: "memory");
        } else {
            XB_SPIN(xb_ld(&bar[XB_XGEN(x)]) == gen, bar);
            __builtin_amdgcn_fence(__ATOMIC_ACQUIRE, "agent");
            asm volatile("s_waitcnt vmcnt(0)" ::: "memory");
        }
    }
    __syncthreads();
}
namespace att {
constexpr int D = 128, NW = 8, QBLK = 32, KVBLK = 64, QB = NW * QBLK;
constexpr int PITCH = 512, OPITCH = 2048;
constexpr float SCALE = 0.08838834764831845f, THR = 8.f;
constexpr int SHM_V = KVBLK * D * 2, SHM_K = KVBLK * D * 2;
constexpr int OFF_WS = 2 * SHM_V + 2 * SHM_K, OFF_CUM = OFF_WS + NW * 64 * 4, OFF_REL = OFF_CUM + 2048 * 4, LDS_END = OFF_REL + 320 * 4;
typedef unsigned short bf16;
typedef short bf16x8 __attribute__((ext_vector_type(8)));
typedef short s16x4 __attribute__((ext_vector_type(4)));
typedef float f32x16 __attribute__((ext_vector_type(16)));
typedef float f32x4 __attribute__((ext_vector_type(4)));
typedef unsigned u32x4 __attribute__((ext_vector_type(4)));
#define ALDS __attribute__((address_space(3)))

#define KSWZ(row, colB) ((row) * 256 + ((colB) ^ (((row) & 7) << 4)))
#define SBAR() __builtin_amdgcn_sched_barrier(0)
__device__ __forceinline__ int v_st(int k, int c) { const int kk = (k & ~0xC) | ((k & 4) << 1) | ((k & 8) >> 1); return ((kk >> 3) * 4 + (c >> 5)) * 512 + ((kk & 7) * 32 + (c & 31)) * 2; }
__device__ __forceinline__ int v_rd_base(int lane) { return ((lane & 3) << 3) | (((lane >> 2) & 3) << 6) | (((lane >> 4) & 1) << 5) | (((lane >> 5) & 1) << 8); }
constexpr int v_rd_off(int d0, int ks, int half) { return d0 * 512 + ks * 4096 + half * 2048; }
__device__ __forceinline__ int crow(int r, int hi) { return (r & 3) + 8 * (r >> 2) + 4 * hi; }
__device__ __forceinline__ unsigned cvtpk(float lo, float hi) { unsigned r; asm volatile("v_cvt_pk_bf16_f32 %0, %1, %2" : "=v"(r) : "v"(lo), "v"(hi)); return r; }
__device__ __forceinline__ bf16x8 load8(const bf16* p) { return *reinterpret_cast<const bf16x8*>(p); }

__device__ __forceinline__ void mask_tile(f32x16& p0, f32x16& p1, int dq) {
    const float NEG = -__builtin_inff();
#pragma unroll
    for (int r = 0; r < 16; ++r) { const int c = (r & 3) + 8 * (r >> 2);
        if (dq - c < 0) p0[r] = NEG;
        if (dq - c - 32 < 0) p1[r] = NEG; }
}
__device__ __forceinline__ void partialSM(f32x16& p0, f32x16& p1, float& m_reg, float& mn, float& alpha) {
    float pmax = p0[0];
#pragma unroll
    for (int r = 1; r < 16; ++r) pmax = fmaxf(pmax, p0[r]);
#pragma unroll
    for (int r = 0; r < 16; ++r) pmax = fmaxf(pmax, p1[r]);
    { auto rr = __builtin_amdgcn_permlane32_swap(__float_as_uint(pmax), __float_as_uint(pmax), false, false);
      pmax = fmaxf(__uint_as_float(rr[0]), __uint_as_float(rr[1])); }
    constexpr float C2 = 1.4426950408889634f * SCALE;
    if (__builtin_expect(__all((pmax - m_reg) * SCALE <= THR), 1)) { mn = m_reg; alpha = 1.f; }
    else { mn = fmaxf(m_reg, pmax); alpha = __builtin_amdgcn_exp2f((m_reg - mn) * C2); m_reg = mn; }
    const float mnL = -mn * C2;
#pragma unroll
    for (int r = 0; r < 16; ++r) p0[r] = fmaf(p0[r], C2, mnL);
#pragma unroll
    for (int r = 0; r < 16; ++r) p1[r] = fmaf(p1[r], C2, mnL);
#pragma unroll
    for (int r = 0; r < 16; ++r) p0[r] = __builtin_amdgcn_exp2f(p0[r]);
}
__device__ __forceinline__ void finishSM(f32x16& p0, f32x16& p1, float alpha, float& l_reg, bf16x8& pa0, bf16x8& pa1, bf16x8& pa2, bf16x8& pa3) {
#pragma unroll
    for (int r = 0; r < 16; ++r) p1[r] = __builtin_amdgcn_exp2f(p1[r]);
    float ps = 0;
#pragma unroll
    for (int r = 0; r < 16; ++r) ps += p0[r];
#pragma unroll
    for (int r = 0; r < 16; ++r) ps += p1[r];
    { auto rr = __builtin_amdgcn_permlane32_swap(__float_as_uint(ps), __float_as_uint(ps), false, false);
      ps = __uint_as_float(rr[0]) + __uint_as_float(rr[1]); }
    l_reg = l_reg * alpha + ps;
#define PK4(P, B_, OUT) do { unsigned a0 = cvtpk(P[B_+0], P[B_+1]), a1 = cvtpk(P[B_+2], P[B_+3]);                          \
        unsigned b0 = cvtpk(P[B_+4], P[B_+5]), b1 = cvtpk(P[B_+6], P[B_+7]);                                             \
        auto r0 = __builtin_amdgcn_permlane32_swap(a0, b0, false, false); auto r1 = __builtin_amdgcn_permlane32_swap(a1, b1, false, false); \
        u32x4 w = {r0[0], r1[0], r0[1], r1[1]}; OUT = *reinterpret_cast<bf16x8*>(&w); } while (0)
    PK4(p0, 0, pa0); PK4(p0, 8, pa1); PK4(p1, 0, pa2); PK4(p1, 8, pa3);
#undef PK4
}
template <int KB>
__device__ __forceinline__ void qkt(f32x16& p0, f32x16& p1, const ALDS char* K_lds, int r32, int hi, const bf16x8* qr, bool act) {
    if (!act) { const float NEG = -__builtin_inff();
#pragma unroll
        for (int r = 0; r < 16; ++r) { p0[r] = NEG; p1[r] = NEG; } return; }
    p0 = f32x16{}; p1 = f32x16{};
    const ALDS char* kb[4];
#pragma unroll
    for (int dd = 0; dd < 4; ++dd) kb[dd] = K_lds + KB * SHM_K + KSWZ(r32, (dd * 16 + hi * 8) * 2);
#pragma unroll
    for (int d0 = 0; d0 < 8; ++d0) { const ALDS char* a = kb[d0 & 3] + (d0 >> 2) * 128;
        bf16x8 b0 = *(const ALDS bf16x8*)(a);
        bf16x8 b1 = *(const ALDS bf16x8*)(a + 32 * 256);
        p0 = __builtin_amdgcn_mfma_f32_32x32x16_bf16(b0, qr[d0], p0, 0, 0, 0);
        p1 = __builtin_amdgcn_mfma_f32_32x32x16_bf16(b1, qr[d0], p1, 0, 0, 0); }
}
template <int VB>
__device__ __forceinline__ void pv_tile(f32x16* o, int vb0, bf16x8 pa0, bf16x8 pa1, bf16x8 pa2, bf16x8 pa3, bool act) {
    if (!act) return;
#define TRRD(dst, off) asm volatile("ds_read_b64_tr_b16 %0, %1 offset:%2" : "=&v"(dst) : "v"(vb0), "i"(off) : "memory")
#define PV_D0(d0) do { s16x4 l0, l1, l2, l3, h0, h1, h2, h3; constexpr int b_ = VB * SHM_V + v_rd_off(d0, 0, 0); \
        TRRD(l0, b_); TRRD(h0, b_ + 2048); TRRD(l1, b_ + 4096); TRRD(h1, b_ + 6144); TRRD(l2, b_ + 8192); TRRD(h2, b_ + 10240); TRRD(l3, b_ + 12288); TRRD(h3, b_ + 14336); \
        asm volatile("s_waitcnt lgkmcnt(0)" ::: "memory"); SBAR(); \
        o[d0] = __builtin_amdgcn_mfma_f32_32x32x16_bf16(pa0, (bf16x8){l0[0], l0[1], l0[2], l0[3], h0[0], h0[1], h0[2], h0[3]}, o[d0], 0, 0, 0);   \
        o[d0] = __builtin_amdgcn_mfma_f32_32x32x16_bf16(pa1, (bf16x8){l1[0], l1[1], l1[2], l1[3], h1[0], h1[1], h1[2], h1[3]}, o[d0], 0, 0, 0);   \
        o[d0] = __builtin_amdgcn_mfma_f32_32x32x16_bf16(pa2, (bf16x8){l2[0], l2[1], l2[2], l2[3], h2[0], h2[1], h2[2], h2[3]}, o[d0], 0, 0, 0);   \
        o[d0] = __builtin_amdgcn_mfma_f32_32x32x16_bf16(pa3, (bf16x8){l3[0], l3[1], l3[2], l3[3], h3[0], h3[1], h3[2], h3[3]}, o[d0], 0, 0, 0); } while (0)
    PV_D0(0); PV_D0(1); PV_D0(2); PV_D0(3);
#undef PV_D0
#undef TRRD
}
template <int MODE>
__device__ __forceinline__ void bias_mask(f32x16& p0, f32x16& p1, const ALDS char* lds, int kb, int qlo, int qpos, int hi, float cqs, bool act) {
    if (!act) return;
    if (MODE == 0) {
        const ALDS float* cs = (const ALDS float*)(lds + OFF_CUM) + kb + 4 * hi;
#pragma unroll
        for (int g = 0; g < 4; ++g) { const f32x4 c0 = *(const ALDS f32x4*)(cs + 8 * g), c1 = *(const ALDS f32x4*)(cs + 32 + 8 * g);
#pragma unroll
            for (int e = 0; e < 4; ++e) { p0[4 * g + e] += cqs - c0[e]; p1[4 * g + e] += cqs - c1[e]; } }
        if (kb + KVBLK - 1 > qlo) mask_tile(p0, p1, qpos - 4 * hi - kb);
    } else {
        const ALDS float* tb = (const ALDS float*)(lds + OFF_REL);
        if (qlo - (kb + KVBLK - 1) >= 256) { const float c = tb[319];
#pragma unroll
            for (int r = 0; r < 16; ++r) { p0[r] += c; p1[r] += c; } }
        else { const int d0 = qpos - kb - 4 * hi + 63;
#pragma unroll
            for (int r = 0; r < 16; ++r) { const int c = (r & 3) + 8 * (r >> 2);
                int i0 = d0 - c, i1 = d0 - c - 32; i0 = i0 > 319 ? 319 : i0; i1 = i1 > 319 ? 319 : i1; i1 = i1 < 0 ? 0 : i1; i0 = i0 < 0 ? 0 : i0;
                p0[r] += tb[i0]; p1[r] += tb[i1]; } }
    }
}

struct Seam { bf16x8 qr[8]; bf16x8 st_v0, st_v1, st_k0, st_k1; };
#define VMW() asm volatile("s_waitcnt vmcnt(0)" ::: "memory")
#define BL8(rs, vo, so) __builtin_bit_cast(bf16x8, __builtin_amdgcn_raw_buffer_load_b128(rs, vo, so, 0))
#define SLOAD_H(Kp, Vp, k0) do { S.st_v0 = BL8(rP, kvoff, (Vp) + (k0) * (PITCH * 2)); S.st_v1 = BL8(rP, kvoff, (Vp) + ((k0) + 32) * (PITCH * 2));              \
                         S.st_k0 = BL8(rP, kvoff, (Kp) + (k0) * (PITCH * 2)); S.st_k1 = BL8(rP, kvoff, (Kp) + ((k0) + 32) * (PITCH * 2)); } while (0)
#define SWRITE_HK(bf) do { *(ALDS bf16x8*)(K_lds + (bf) * SHM_K + kws) = S.st_k0; *(ALDS bf16x8*)(K_lds + (bf) * SHM_K + kws + 32 * 256) = S.st_k1; } while (0)
#define SWRITE_HV(bf) do { *(ALDS bf16x8*)(V_lds + (bf) * SHM_V + vst0) = S.st_v0; *(ALDS bf16x8*)(V_lds + (bf) * SHM_V + vst1) = S.st_v1; } while (0)
#define SWRITE_H(bf) do { SWRITE_HV(bf); SWRITE_HK(bf); } while (0)

template <int MODE>
__device__ __forceinline__ void attn_unit(const bf16* Pb, int Qo, int Kh, int Vh, bf16* Yb, int Oo, int P0, int j_lo, int j_hi, ALDS char* lds, int wid, int lane) {
    const int tid = wid * 64 + lane, r32 = lane & 31, hi = lane >> 5;
    const int NT = j_hi - j_lo;
    const int qlo = P0 + wid * QBLK, qpos = qlo + r32;
    ALDS char* V_lds = lds; ALDS char* K_lds = lds + 2 * SHM_V;
    ALDS float* ws = (ALDS float*)(lds + OFF_WS) + wid * 64; ALDS float* li_l = ws; ALDS float* al_l = ws + 32;
    float m_reg = -1e30f, l_reg = 0; f32x16 o[4] = {};
    const int sr = tid >> 4, sc = (tid & 15) * 8, vst0 = v_st(sr, sc), vst1 = v_st(32 + sr, sc), kws = KSWZ(sr, sc * 2);
    const int vb0 = (int)(unsigned)(size_t)V_lds + v_rd_base(lane);
    Seam S;
    const __amdgpu_buffer_rsrc_t rP = __builtin_amdgcn_make_buffer_rsrc((void*)Pb, 0, 0x7fffffff, 0x00020000);
    const __amdgpu_buffer_rsrc_t rO = __builtin_amdgcn_make_buffer_rsrc((void*)Yb, 0, 0x7fffffff, 0x00020000);
    const int kvoff = (sr * PITCH + sc) * 2;
#define KBASE(t) ((j_lo + (t)) * KVBLK)
#define ACT(t) (MODE == 0 ? (KBASE(t) <= qlo + QBLK - 1) : ((j_lo + (t)) <= (qlo >> 6) && (j_lo + (t)) + 8 >= (qlo >> 6)))
#define RESC(a) do { if (__any((a) < 1.f)) { if (hi == 0) al_l[r32] = (a); asm volatile("s_waitcnt lgkmcnt(0)" ::: "memory");              \
                     for (int d_ = 0; d_ < 4; ++d_) for (int r = 0; r < 16; ++r) o[d_][r] *= al_l[crow(r, hi)]; } } while (0)
#define MASKT(P0_, P1_, t) bias_mask<MODE>(P0_, P1_, lds, KBASE(t), qlo, qpos, hi, cq_, ACT(t))
    {
        const int kb0 = j_lo * KVBLK;
#pragma unroll
        for (int d0 = 0; d0 < 8; ++d0) S.qr[d0] = BL8(rP, (r32 * PITCH + hi * 8) * 2 + d0 * 32, Qo + wid * (QBLK * PITCH * 2));
        SLOAD_H(Kh, Vh, kb0); VMW(); SWRITE_HK(0);
        __syncthreads();
    }
    const float cq_ = MODE == 0 ? ((const ALDS float*)(lds + OFF_CUM))[qpos] : 0.f;
    f32x16 pA0, pA1, pB0, pB1; float mnA, mnB, alA, alB; bf16x8 pa0, pa1, pa2, pa3;
    SWRITE_HV(0); SBAR();
    if (NT > 1) { SLOAD_H(Kh, Vh, KBASE(1)); }
    SBAR(); qkt<0>(pA0, pA1, K_lds, r32, hi, S.qr, ACT(0));
    MASKT(pA0, pA1, 0); partialSM(pA0, pA1, m_reg, mnA, alA);
    if (NT > 1) { VMW(); SWRITE_H(1); }
    __syncthreads();
#define HALF_STEP(PX0, PX1, mnX, alX, PY0, PY1, alY, t, KB, VB, SB) do {                                                      \
        SBAR(); qkt<KB>(PX0, PX1, K_lds, r32, hi, S.qr, ACT(t));                                                              \
        finishSM(PY0, PY1, alY, l_reg, pa0, pa1, pa2, pa3); SBAR();                                                           \
        if ((t) + 1 < NT) { SLOAD_H(Kh, Vh, KBASE((t) + 1)); SBAR(); }                                                        \
        pv_tile<VB>(o, vb0, pa0, pa1, pa2, pa3, ACT((t) - 1)); MASKT(PX0, PX1, (t)); partialSM(PX0, PX1, m_reg, mnX, alX);    \
        __syncthreads();                                                                                                      \
        if ((t) + 1 < NT) { VMW(); SWRITE_H(SB); }                                                                            \
        RESC(alX); __syncthreads(); } while (0)
    for (int t = 1; t + 1 < NT; t += 2) {
        HALF_STEP(pB0, pB1, mnB, alB, pA0, pA1, alA, t, 1, 0, 0);
        HALF_STEP(pA0, pA1, mnA, alA, pB0, pB1, alB, t + 1, 0, 1, 1);
    }
    const bool even = (NT & 1) == 0;
    if (even) { SBAR(); qkt<1>(pB0, pB1, K_lds, r32, hi, S.qr, ACT(NT - 1)); SBAR(); }
    finishSM(pA0, pA1, alA, l_reg, pa0, pa1, pa2, pa3); SBAR();
    pv_tile<0>(o, vb0, pa0, pa1, pa2, pa3, ACT(even ? NT - 2 : NT - 1));
    if (even) { MASKT(pB0, pB1, NT - 1); partialSM(pB0, pB1, m_reg, mnB, alB); __syncthreads(); RESC(alB);
        finishSM(pB0, pB1, alB, l_reg, pa0, pa1, pa2, pa3); SBAR(); pv_tile<1>(o, vb0, pa0, pa1, pa2, pa3, ACT(NT - 1)); }
    SBAR();
    if (hi == 0) li_l[r32] = l_reg; asm volatile("s_waitcnt lgkmcnt(0)" ::: "memory");
    float rli[16];
#pragma unroll
    for (int r = 0; r < 16; ++r) rli[r] = __builtin_amdgcn_rcpf(li_l[crow(r, hi)]);
    const int ovoff = (4 * hi * OPITCH + r32) * 2, osoff = Oo + wid * (QBLK * OPITCH * 2);
#pragma unroll
    for (int r = 0; r < 16; ++r) { const int orow = (r & 3) + 8 * (r >> 2);
#pragma unroll
        for (int d0 = 0; d0 < 4; ++d0) { const float v = o[d0][r] * rli[r];
            const float vn = __builtin_bit_cast(float, __builtin_amdgcn_ds_bpermute((lane ^ 1) << 2, __builtin_bit_cast(int, v)));
            if ((r32 & 1) == 0) __builtin_amdgcn_raw_buffer_store_b32(cvtpk(v, vn), rO, ovoff + d0 * 64, osoff + orow * (OPITCH * 2), 0); } }
    __syncthreads();
#undef RESC
#undef KBASE
#undef ACT
#undef MASKT
#undef HALF_STEP
}
#undef BL8
#undef VMW
#undef SLOAD_H
#undef SWRITE_HK
#undef SWRITE_HV
#undef SWRITE_H
#undef KSWZ
#undef SBAR
}
constexpr size_t WS_QCTR = 768 * 1024;
constexpr size_t WS_POOLW = 4 * MiB;
constexpr int N_ATT_UNITS = 256, N_POOL_UNITS = 512, N_CONV_UNITS = 128;

__device__ __forceinline__ void stage_cum(const Args& a, int b, int h, LAS char* lds, int wave, int lane) {
    const float* logf = (const float*)(a.ws + WS_LOGF) + ((size_t)b * SEQ) * 4 + h;
    const int tid = wave * 64 + lane;
    float v[4];
#pragma unroll
    for (int e = 0; e < 4; ++e) v[e] = logf[(size_t)(4 * tid + e) * 4];
    v[1] += v[0]; v[2] += v[1]; v[3] += v[2];
    float incl = v[3];
#pragma unroll
    for (int o = 1; o < 64; o <<= 1) { const float t = shf(incl, lane >= o ? lane - o : lane); if (lane >= o) incl += t; }
    LAS float* wt = (LAS float*)(lds + att::OFF_WS);
    if (lane == 63) wt[wave] = incl;
    __syncthreads();
    float base = incl - v[3];
    for (int w = 0; w < wave; ++w) base += wt[w];
    LAS float* cs = (LAS float*)(lds + att::OFF_CUM);
    const float inv = 1.0f / ATT_SCALE;
    *(LAS f32x4*)(cs + 4 * tid) = (f32x4){(base + v[0]) * inv, (base + v[1]) * inv, (base + v[2]) * inv, (base + v[3]) * inv};
    __syncthreads();
}
__device__ __forceinline__ void attention_item(const Args& a, int l, int u, LAS char* lds, int wave) {
    int lane; asm volatile("v_mbcnt_lo_u32_b32 %0, -1, 0\n\tv_mbcnt_hi_u32_b32 %0, -1, %0" : "=v"(lane));
    const bf16* P = (const bf16*)(a.ws + WS_PROJ); bf16* Y = (bf16*)(a.ws + WS_Y);
    const int mode = u >> 7, v = u & 127, qb = 7 - (v >> 4), bh = v & 15, b = bh >> 2, h = bh & 3;
    const size_t row0 = (size_t)b * SEQ; const int P0 = qb * 256;
    if (mode == 0) {
        stage_cum(a, b, h, lds, wave, lane);
        att::attn_unit<0>(P, (int)((0 * PROJ_T + (row0 + P0) * MIXW + h * HD) * 2), (int)((1 * PROJ_T + row0 * MIXW + h * HD) * 2), (int)((2 * PROJ_T + row0 * MIXW + h * HD) * 2),
                          Y, (int)(((row0 + P0) * D + h * HD) * 2), P0, 0, 4 * qb + 4, lds, wave, lane);
    } else {
        const int tid = wave * 64 + lane;
        if (tid < 320) ((LAS float*)(lds + att::OFF_REL))[tid] = a.rel_bias[((size_t)l * 4 + h) * 320 + tid] * (1.0f / ATT_SCALE);
        const int jlo = 4 * qb - 8 < 0 ? 0 : 4 * qb - 8;
        att::attn_unit<1>(P, (int)((7 * PROJ_T + (row0 + P0) * MIXW + h * HD) * 2), (int)((8 * PROJ_T + row0 * MIXW + h * HD) * 2), (int)((9 * PROJ_T + row0 * MIXW + h * HD) * 2),
                          Y, (int)(((row0 + P0) * D + 1536 + h * HD) * 2), P0, jlo, 4 * qb + 4, lds, wave, lane);
    }
}
__device__ __forceinline__ void pool_item(const Args& a, int l, int u, LAS char* lds, int wave) {
    int lane; asm volatile("v_mbcnt_lo_u32_b32 %0, -1, 0\n\tv_mbcnt_hi_u32_b32 %0, -1, %0" : "=v"(lane));
    const int g = u & 3, T0 = (u >> 2) * 64, tid = wave * 64 + lane;
    const bf16* Pin = (const bf16*)(a.ws + WS_PROJ) + 3 * PROJ_T + g * 128;
    {
        const int cp = tid & 63, run = tid >> 6, w = 2 << g, t0 = T0 + run * 8, s0 = t0 & (SEQ - 1);
        const bf16* col = Pin + 2 * cp;
        float s_lo = 0.f, s_hi = 0.f;
        for (int j = 1; j < w; ++j) if (s0 - j >= 0) { const unsigned x = *(const unsigned*)(col + (size_t)(t0 - j) * MIXW); s_lo += bflo(x); s_hi += bfhi(x); }
#pragma unroll
        for (int i = 0; i < 8; ++i) { const unsigned x = *(const unsigned*)(col + (size_t)(t0 + i) * MIXW); s_lo += bflo(x); s_hi += bfhi(x);
            const int s = s0 + i; const int cnt = s + 1 < w ? s + 1 : w; const float inv = 1.0f / (float)cnt;
            *(LAS unsigned*)(lds + (run * 8 + i) * 272 + 4 * cp) = pk2(s_lo * inv - bflo(x), s_hi * inv - bfhi(x));
            if (s - w + 1 >= 0) { const unsigned y = *(const unsigned*)(col + (size_t)(t0 + i - w + 1) * MIXW); s_lo -= bflo(y); s_hi -= bfhi(y); } }
    }
    __syncthreads();
    {
        typedef short bf16x8 __attribute__((ext_vector_type(8)));
        const bf16* Wt = (const bf16*)(a.ws + WS_POOLW) + ((size_t)l * 4 + g) * 128 * 128;
        const int rt = (wave & 3) * 16, db = (wave >> 2) * 64, fr = lane & 15, kg = lane >> 4;
        f32x4 acc[4] = {};
#pragma unroll
        for (int ks = 0; ks < 4; ++ks) { const bf16x8 af = *(const LAS bf16x8*)(lds + (rt + fr) * 272 + (ks * 32 + kg * 8) * 2);
#pragma unroll
            for (int nt = 0; nt < 4; ++nt) { const bf16x8 bfr = *(const bf16x8*)(Wt + (size_t)(db + nt * 16 + fr) * 128 + ks * 32 + kg * 8);
                acc[nt] = __builtin_amdgcn_mfma_f32_16x16x32_bf16(bfr, af, acc[nt], 0, 0, 0); } }
        bf16* Y = (bf16*)(a.ws + WS_Y) + (size_t)(T0 + rt + fr) * D + 512 + g * 128;
#pragma unroll
        for (int nt = 0; nt < 4; ++nt) { const int d = db + nt * 16 + kg * 4; const f32x4 sc = *(const f32x4*)(a.pool_scale + l * MIXW + g * 128 + d);
            v2u w; w.x = pk2(acc[nt][0] * sc[0], acc[nt][1] * sc[1]); w.y = pk2(acc[nt][2] * sc[2], acc[nt][3] * sc[3]); *(v2u*)(Y + d) = w; }
    }
    __syncthreads();
}
__device__ __forceinline__ void conv_item(const Args& a, int l, int u, int wave) {
    int lane; asm volatile("v_mbcnt_lo_u32_b32 %0, -1, 0\n\tv_mbcnt_hi_u32_b32 %0, -1, %0" : "=v"(lane));
    const bf16* P = (const bf16*)(a.ws + WS_PROJ); const bf16* Ch = P + 4 * PROJ_T; const bf16* Cb = P + 5 * PROJ_T; const bf16* Cc = P + 6 * PROJ_T;
    const int tid = wave * 64 + lane, c0 = (tid & 63) * 8, t0 = u * 64 + (tid >> 6) * 8, s0 = t0 & (SEQ - 1);
    float wgt[3][8];
#pragma unroll
    for (int j = 0; j < 3; ++j) { const float* w = a.conv_w + ((size_t)l * 3 + j) * MIXW + c0; const f32x4 w0 = *(const f32x4*)w, w1 = *(const f32x4*)(w + 4);
#pragma unroll
        for (int k = 0; k < 4; ++k) { wgt[j][k] = w0[k]; wgt[j][4 + k] = w1[k]; } }
    float z2[8], z1[8];
#pragma unroll
    for (int k = 0; k < 8; ++k) { z2[k] = 0.f; z1[k] = 0.f; }
#pragma unroll
    for (int i = -2; i < 8; ++i) {
        float z[8];
        if (s0 + i >= 0) { const v4u hv = *(const v4u*)(Ch + (size_t)(t0 + i) * MIXW + c0), cv = *(const v4u*)(Cc + (size_t)(t0 + i) * MIXW + c0);
            z[0] = bflo(hv.x) * bflo(cv.x); z[1] = bfhi(hv.x) * bfhi(cv.x); z[2] = bflo(hv.y) * bflo(cv.y); z[3] = bfhi(hv.y) * bfhi(cv.y);
            z[4] = bflo(hv.z) * bflo(cv.z); z[5] = bfhi(hv.z) * bfhi(cv.z); z[6] = bflo(hv.w) * bflo(cv.w); z[7] = bfhi(hv.w) * bfhi(cv.w); }
        else {
#pragma unroll
            for (int k = 0; k < 8; ++k) z[k] = 0.f; }
        if (i >= 0) { const v4u bv = *(const v4u*)(Cb + (size_t)(t0 + i) * MIXW + c0); float o[8];
            const float bb[8] = {bflo(bv.x), bfhi(bv.x), bflo(bv.y), bfhi(bv.y), bflo(bv.z), bfhi(bv.z), bflo(bv.w), bfhi(bv.w)};
#pragma unroll
            for (int k = 0; k < 8; ++k) o[k] = bb[k] * (wgt[0][k] * z2[k] + wgt[1][k] * z1[k] + wgt[2][k] * z[k]);
            v4u ov; ov.x = pk2(o[0], o[1]); ov.y = pk2(o[2], o[3]); ov.z = pk2(o[4], o[5]); ov.w = pk2(o[6], o[7]);
            *(v4u*)((bf16*)(a.ws + WS_Y) + (size_t)(t0 + i) * D + 1024 + c0) = ov; }
#pragma unroll
        for (int k = 0; k < 8; ++k) { z2[k] = z1[k]; z1[k] = z[k]; }
    }
}
__device__ __forceinline__ void mixers_fast(const Args& a, int lq, LAS char* lds, int wave, int lane, int G, int blk) {
    const int l = lq & 1;
    for (int u = blk; u < N_ATT_UNITS; u += G) attention_item(a, l, u, lds, wave);
    unsigned* head = (unsigned*)(a.ws + WS_QCTR) + 64 * lq;
    volatile LAS unsigned* slot = (volatile LAS unsigned*)(lds + att::LDS_END);
    for (;;) {
        if (wave == 0 && lane == 0) *slot = __hip_atomic_fetch_add(head, 1u, __ATOMIC_RELAXED, __HIP_MEMORY_SCOPE_AGENT);
        __syncthreads();
        const unsigned it = *slot;
        __syncthreads();
        if (it >= (unsigned)(N_POOL_UNITS + N_CONV_UNITS)) break;
        if (it < (unsigned)N_POOL_UNITS) pool_item(a, l, (int)it, lds, wave); else conv_item(a, l, (int)it - N_POOL_UNITS, wave);
    }
}
__device__ __forceinline__ void p0_cmax(const Args& a, int gw, int NGW, int lane) {
    unsigned char* ws = a.ws;
    {
        constexpr int NCC = (INW + 255) / 256;
        for (int it = gw; it < DEPTH * 32 * NCC; it += NGW) { const int l = it / (32 * NCC), r = it % (32 * NCC), kc = r / NCC, cc = r % NCC; const int c0 = cc * 256 + 4 * lane;
            if (c0 + 3 < INW) { const float* W = a.w_in + (size_t)l * D * INW + (size_t)(kc * 64) * INW + c0; const float* g = a.norm_mix + l * D + kc * 64;
                float m0 = 0.f, m1 = 0.f, m2 = 0.f, m3 = 0.f;
#pragma unroll 8
                for (int k = 0; k < 64; ++k) { const f32x4 w = *(const f32x4*)(W + (size_t)k * INW); const float gk = fabsf(g[k]);
                    m0 = fmaxf(m0, fabsf(w[0]) * gk); m1 = fmaxf(m1, fabsf(w[1]) * gk); m2 = fmaxf(m2, fabsf(w[2]) * gk); m3 = fmaxf(m3, fabsf(w[3]) * gk); }
                unsigned* cm = (unsigned*)(ws + WS_CMAX) + l * INW + c0;
                const unsigned u0 = __float_as_uint(m0), u1 = __float_as_uint(m1), u2 = __float_as_uint(m2), u3 = __float_as_uint(m3);
                __hip_atomic_fetch_max(cm + 0, u0, __ATOMIC_RELAXED, __HIP_MEMORY_SCOPE_AGENT); __hip_atomic_fetch_max(cm + 1, u1, __ATOMIC_RELAXED, __HIP_MEMORY_SCOPE_AGENT);
                __hip_atomic_fetch_max(cm + 2, u2, __ATOMIC_RELAXED, __HIP_MEMORY_SCOPE_AGENT); __hip_atomic_fetch_max(cm + 3, u3, __ATOMIC_RELAXED, __HIP_MEMORY_SCOPE_AGENT); } }
    }
}
__device__ __forceinline__ void p0_prologue(const Args& a, LAS unsigned char* lds, int gw, int NGW, int wave, int lane) {
    unsigned char* ws = a.ws;
    LAS float* scr = (LAS float*)(lds + wave * 16384);
    constexpr int I_SQ = (D / 64) * (D / 32), I_BR = (MIXW / 64) * (D / 32);
    constexpr int I_LAYER = 4 * I_BR + 2 * I_SQ;
    for (int it = gw; it < DEPTH * I_LAYER; it += NGW) {
        const int l = it / I_LAYER; int r = it - l * I_LAYER;
        if (r < 4 * I_BR) { const int g = r / I_BR, rr = r % I_BR, kb = rr / (D / 32), nb = rr % (D / 32);
            tr_item<false>(a.w_branch + ((size_t)l * 4 + g) * MIXW * D, D, nullptr, (bf16*)(ws + WS_WBR + l * SQ_BYTES), D, g * MIXW, scr, 64 * kb, 32 * nb, lane); continue; }
        r -= 4 * I_BR;
        if (r < I_SQ) { const int kb = r / (D / 32), nb = r % (D / 32);
            tr_item<false>(a.w_out + (size_t)l * D * D, D, nullptr, (bf16*)(ws + WS_WOUT + l * SQ_BYTES), D, 0, scr, 64 * kb, 32 * nb, lane); continue; }
        r -= I_SQ;
        { const int kb = r / (D / 32), nb = r % (D / 32);
            tr_item<false>(a.peer_wq + (size_t)l * D * D, D, a.norm_ffn + l * D, (bf16*)(ws + WS_WQ + l * SQ_BYTES), D, 0, scr, 64 * kb, 32 * nb, lane); }
    }
    for (int it = gw; it < DEPTH * 4 * 8; it += NGW) { const int lg = it >> 3, r = it & 7;
        tr_item<false>(a.pool_w + (size_t)lg * 128 * 128, 128, nullptr, (bf16*)(ws + WS_POOLW) + (size_t)lg * 128 * 128, 128, 0, scr, 64 * (r >> 2), 32 * (r & 3), lane); }
    {
        constexpr int NR = 2 * DEPTH * PEER_E;
        f32x4 nv[8];
        if (gw < NR) { const int t = gw / (DEPTH * PEER_E), row = gw - t * (DEPTH * PEER_E); const float* src = (t ? a.peer_v : a.peer_u) + (size_t)row * D + 4 * lane;
#pragma unroll
            for (int j = 0; j < 8; ++j) nv[j] = *(const f32x4*)(src + 256 * j); }
        for (int r = gw; r < NR; r += NGW) { const int t = r / (DEPTH * PEER_E), row = r - t * (DEPTH * PEER_E);
            f32x4 v[8]; float am = 0.f;
#pragma unroll
            for (int j = 0; j < 8; ++j) v[j] = nv[j];
            { const int r2 = r + NGW; if (r2 < NR) { const int t2 = r2 / (DEPTH * PEER_E), row2 = r2 - t2 * (DEPTH * PEER_E); const float* src = (t2 ? a.peer_v : a.peer_u) + (size_t)row2 * D + 4 * lane;
#pragma unroll
                for (int j = 0; j < 8; ++j) nv[j] = *(const f32x4*)(src + 256 * j); } }
#pragma unroll
            for (int j = 0; j < 8; ++j) am = fmaxf(am, fmaxf(fmaxf(fabsf(v[j][0]), fabsf(v[j][1])), fmaxf(fabsf(v[j][2]), fabsf(v[j][3]))));
            am = wave_max(am, lane);
            const float inv = am > 0.f ? 127.0f / am : 0.f, off = 0.f;
            unsigned char* dst = ws + (t ? WS_PV : WS_PU) + (size_t)row * D + 4 * lane;
#pragma unroll
            for (int j = 0; j < 8; ++j) { const int q0 = (int)(rintf(v[j][0] * inv) + off), q1 = (int)(rintf(v[j][1] * inv) + off), q2 = (int)(rintf(v[j][2] * inv) + off), q3 = (int)(rintf(v[j][3] * inv) + off);
                *(unsigned*)(dst + 256 * j) = (unsigned)(q0 & 255) | ((unsigned)(q1 & 255) << 8) | ((unsigned)(q2 & 255) << 16) | ((unsigned)(q3 & 255) << 24); }
            if (lane == 0) ((float*)(ws + (t ? WS_SV : WS_SU)))[row] = am * (1.0f / 127.0f); }
    }
    { bf16* pk = (bf16*)(ws + WS_PK); const size_t n8 = (size_t)DEPTH * 8 * 2 * 128 * 128 / 8;
      for (size_t i = (size_t)gw * 64 + lane; i < n8; i += (size_t)NGW * 64) { const size_t ln = i & 63, cs = (i >> 6) & 7, kb = (i >> 9) & 3, lhp = i >> 11; const size_t so = lhp * 16384 + (kb * 32 + (ln & 31)) * 128 + cs * 16 + (ln >> 5) * 8;
          const f32x4 v0 = *(const f32x4*)(a.peer_keys + so), v1 = *(const f32x4*)(a.peer_keys + so + 4);
          v4u o; o.x = pk2(v0[0], v0[1]); o.y = pk2(v0[2], v0[3]); o.z = pk2(v1[0], v1[1]); o.w = pk2(v1[2], v1[3]); *(v4u*)(pk + i * 8) = o; } }
    {
        float* wf = (float*)(ws + WS_WF); float* binr = (float*)(ws + WS_BINR);
        const int gt = gw * 64 + lane, NGT = NGW * 64;
        for (int i = gt; i < DEPTH * 4 * D; i += NGT) { const int l = i / (4 * D), h = (i / D) & 3, k = i % D; wf[i] = a.w_in[(size_t)l * D * INW + (size_t)k * INW + 1536 + h] * a.norm_mix[l * D + k]; }
        for (int i = gt; i < DEPTH * NPROJ; i += NGT) { const int l = i / NPROJ, j = i % NPROJ; binr[i] = a.b_in[l * INW + colmap_in(j)]; }
    }
    {
        unsigned long long* ssq = (unsigned long long*)(ws + WS_SSQ);
        for (int m0 = gw; m0 < M; m0 += 2 * NGW) {
            const int m1 = m0 + NGW; const bool ok1 = m1 < M; const int mr[2] = {m0, ok1 ? m1 : m0};
            f32x4 v[2][8];
#pragma unroll
            for (int r = 0; r < 2; ++r)
#pragma unroll
                for (int j = 0; j < 8; ++j) v[r][j] = *(const f32x4*)(a.x + (size_t)mr[r] * D + j * 256 + lane * 4);
#pragma unroll
            for (int r = 0; r < 2; ++r) { float s = 0.f, am = 0.f;
#pragma unroll
                for (int j = 0; j < 8; ++j) { s += (v[r][j][0] * v[r][j][0] + v[r][j][1] * v[r][j][1]) + (v[r][j][2] * v[r][j][2] + v[r][j][3] * v[r][j][3]);
                    am = fmaxf(am, fmaxf(fmaxf(fabsf(v[r][j][0]), fabsf(v[r][j][1])), fmaxf(fabsf(v[r][j][2]), fabsf(v[r][j][3])))); }
                s = wave_sum(s, lane); am = wave_max(am, lane);
                if (r == 0 || ok1) { const int m = mr[r];
                    if (lane == 0) { ssq[m] = (unsigned long long)((double)s * 4294967296.0); ((float*)(ws + WS_RSA))[m] = rsqrtf(s * (1.0f / D) + EPS) * am * (1.0f / 127.0f); }
                    const float inv = am > 0.f ? 127.0f / am : 0.f; unsigned char* q8 = ws + WS_HB8 + (size_t)m * D + 4 * lane;
#pragma unroll
                    for (int j = 0; j < 8; ++j) *(unsigned*)(q8 + 256 * j) = ((unsigned)((int)rintf(v[r][j][0] * inv) & 255)) | ((unsigned)((int)rintf(v[r][j][1] * inv) & 255) << 8) | ((unsigned)((int)rintf(v[r][j][2] * inv) & 255) << 16) | ((unsigned)((int)rintf(v[r][j][3] * inv) & 255) << 24); } } }
    }
}
__device__ __forceinline__ void p0_win_i8(const Args& a, LAS unsigned char* lds, int gw, int NGW, int wave, int lane) {
    unsigned char* ws = a.ws; LAS float* scr = (LAS float*)(lds + wave * 16384);
    constexpr int I_WIN = (D / 64) * (NPROJ / 32);
    for (int it = gw; it < DEPTH * I_WIN; it += NGW) { const int l = it / I_WIN, r = it % I_WIN, kb = r / (NPROJ / 32), nb = r % (NPROJ / 32);
        tr_item_i8(a.w_in + (size_t)l * D * INW, a.norm_mix + l * D, (const unsigned*)(ws + WS_CMAX) + l * INW, ws + WS_WIN + l * WIN_BYTES, scr, 64 * kb, 32 * nb, lane); }
    float* sw = (float*)(ws + WS_SW); const int gt = gw * 64 + lane, NGT = NGW * 64;
    bf16* swh = (bf16*)(ws + WS_SWH); bf16* bih = (bf16*)(ws + WS_BIH);
    for (int i = gt; i < DEPTH * NPROJ; i += NGT) { const int l = i / NPROJ, j = i % NPROJ; const float s = __builtin_bit_cast(float, ((const unsigned*)(ws + WS_CMAX))[l * INW + colmap_in(j)]) * (1.0f / 127.0f);
        sw[i] = s; swh[i] = (bf16)f2bf(s); bih[i] = (bf16)f2bf(a.b_in[l * INW + colmap_in(j)]); }
}
__device__ __forceinline__ void quant_rows(const Args& a, int l, int gw, int NGW, int lane) {
    unsigned char* ws = a.ws; const bf16* HB = (const bf16*)(ws + WS_HB);
    for (int m0 = gw; m0 < M; m0 += 2 * NGW) {
        const int m1 = m0 + NGW; const bool ok1 = m1 < M; const int mr[2] = {m0, ok1 ? m1 : m0};
        v4u w[2][4];
#pragma unroll
        for (int r = 0; r < 2; ++r)
#pragma unroll
            for (int j = 0; j < 4; ++j) w[r][j] = *(const v4u*)(HB + (size_t)mr[r] * D + j * 512 + lane * 8);
#pragma unroll
        for (int r = 0; r < 2; ++r) { float am = 0.f; float v[4][8];
#pragma unroll
            for (int j = 0; j < 4; ++j) { v[j][0] = bflo(w[r][j].x); v[j][1] = bfhi(w[r][j].x); v[j][2] = bflo(w[r][j].y); v[j][3] = bfhi(w[r][j].y); v[j][4] = bflo(w[r][j].z); v[j][5] = bfhi(w[r][j].z); v[j][6] = bflo(w[r][j].w); v[j][7] = bfhi(w[r][j].w);
#pragma unroll
                for (int e = 0; e < 8; ++e) am = fmaxf(am, fabsf(v[j][e])); }
            am = wave_max(am, lane);
            if (r == 0 || ok1) {
                if (lane == 0) ((float*)(ws + WS_RSA))[mr[r]] = rsqrtf(ssa_to_f(((const unsigned long long*)(ws + WS_SSQ))[(size_t)l * M + mr[r]]) * (1.0f / D) + EPS) * am * (1.0f / 127.0f);
                const float inv = am > 0.f ? 127.0f / am : 0.f; unsigned char* q8 = ws + WS_HB8 + (size_t)mr[r] * D + 8 * lane;
#pragma unroll
                for (int j = 0; j < 4; ++j) { v2u o;
                    o.x = ((unsigned)((int)rintf(v[j][0] * inv) & 255)) | ((unsigned)((int)rintf(v[j][1] * inv) & 255) << 8) | ((unsigned)((int)rintf(v[j][2] * inv) & 255) << 16) | ((unsigned)((int)rintf(v[j][3] * inv) & 255) << 24);
                    o.y = ((unsigned)((int)rintf(v[j][4] * inv) & 255)) | ((unsigned)((int)rintf(v[j][5] * inv) & 255) << 8) | ((unsigned)((int)rintf(v[j][6] * inv) & 255) << 16) | ((unsigned)((int)rintf(v[j][7] * inv) & 255) << 24);
                    *(v2u*)(q8 + 512 * j) = o; } } }
    }
}

__device__ __forceinline__ void forget_logits(const Args& a, int l, int gw, int NGW, int lane) {
    unsigned char* ws = a.ws; const bf16* HB = (const bf16*)(ws + WS_HB); const float* wf = (const float*)(ws + WS_WF) + l * 4 * D; const unsigned long long* ssq = (const unsigned long long*)(ws + WS_SSQ) + l * M;
    float* logf = (float*)(ws + WS_LOGF);
    f32x4 w[4][4][2];
#pragma unroll
    for (int h = 0; h < 4; ++h)
#pragma unroll
        for (int j = 0; j < 4; ++j) { const int k0 = j * 512 + lane * 8; w[h][j][0] = *(const f32x4*)(wf + h * D + k0); w[h][j][1] = *(const f32x4*)(wf + h * D + k0 + 4); }
    float bias[4];
#pragma unroll
    for (int h = 0; h < 4; ++h) bias[h] = a.b_in[l * INW + 1536 + h];
    for (int m0 = gw; m0 < M; m0 += 2 * NGW) {
        const int m1 = m0 + NGW; const bool ok1 = m1 < M; const int mr[2] = {m0, ok1 ? m1 : m0};
        f32x4 x[2][4][2];
#pragma unroll
        for (int r = 0; r < 2; ++r)
#pragma unroll
            for (int j = 0; j < 4; ++j) { const int k0 = j * 512 + lane * 8;
                if (l == 0) { x[r][j][0] = *(const f32x4*)(a.x + (size_t)mr[r] * D + k0); x[r][j][1] = *(const f32x4*)(a.x + (size_t)mr[r] * D + k0 + 4); }
                else { const v4u xv = *(const v4u*)(HB + (size_t)mr[r] * D + k0); x[r][j][0] = (f32x4){bflo(xv.x), bfhi(xv.x), bflo(xv.y), bfhi(xv.y)}; x[r][j][1] = (f32x4){bflo(xv.z), bfhi(xv.z), bflo(xv.w), bfhi(xv.w)}; } }
#pragma unroll
        for (int r = 0; r < 2; ++r) { const float rs = rsqrtf(ssa_to_f(ssq[mr[r]]) * (1.0f / D) + EPS);
#pragma unroll
            for (int h = 0; h < 4; ++h) { f32x4 s4 = {0.f, 0.f, 0.f, 0.f};
#pragma unroll
                for (int j = 0; j < 4; ++j) { s4 += x[r][j][0] * w[h][j][0]; s4 += x[r][j][1] * w[h][j][1]; }
                const float z = wave_sum((s4[0] + s4[1]) + (s4[2] + s4[3]), lane) * rs + bias[h];
                const float ls = fminf(z, 0.f) - __logf(1.0f + __expf(-fabsf(z)));
                if (lane == h && (r == 0 || ok1)) logf[mr[r] * 4 + h] = ls; } }
    }
}
__device__ __forceinline__ float gelu_tanh(float x) { const float u = 1.5957691216057308f * (x + 0.044715f * x * x * x); return x / (1.0f + __expf(-u)); }
constexpr int PEER_TOK = 32;
constexpr int PL_IDX = 0, PL_GATE = PEER_TOK * 128 * 4, PL_TAB = 2 * PEER_TOK * 128 * 4;
__device__ __forceinline__ int f2key(float f) { const int b = __builtin_bit_cast(int, f); return b ^ ((b >> 31) & 0x7fffffff); }
__device__ __forceinline__ float key2f(int k) { return __builtin_bit_cast(float, k ^ ((k >> 31) & 0x7fffffff)); }
#define CE_DESC(x, y) do { const int hi_ = (x) > (y) ? (x) : (y), lo_ = (x) > (y) ? (y) : (x); (x) = hi_; (y) = lo_; } while (0)
__device__ __forceinline__ void sort16_desc(int* v) {
#pragma unroll
    for (int k = 2; k <= 16; k <<= 1)
#pragma unroll
        for (int j = k >> 1; j > 0; j >>= 1)
#pragma unroll
            for (int i = 0; i < 16; ++i) { const int l = i ^ j; if (l > i) { if ((i & k) == 0) CE_DESC(v[i], v[l]); else CE_DESC(v[l], v[i]); } }
}
__device__ __forceinline__ void merge_top16(int* a, const int* b) {
#pragma unroll
    for (int i = 0; i < 16; ++i) a[i] = a[i] > b[15 - i] ? a[i] : b[15 - i];
#pragma unroll
    for (int j = 8; j > 0; j >>= 1)
#pragma unroll
        for (int i = 0; i < 16; ++i) { const int l = i ^ j; if (l > i) CE_DESC(a[i], a[l]); }
}
__device__ __forceinline__ void top16_of_64(int* v) {
    sort16_desc(v); sort16_desc(v + 16); sort16_desc(v + 32); sort16_desc(v + 48);
    merge_top16(v, v + 16); merge_top16(v + 32, v + 48); merge_top16(v, v + 32);
}
constexpr int cand_slot(int i, int j) {
    int n = 0;
    for (int a = 0; a < 16; ++a) for (int b = 0; b < 16; ++b) { if ((a + 1) * (b + 1) <= 16) { if (a == i && b == j) return n; ++n; } }
    return -1;
}
__device__ __forceinline__ void peer_retrieve(const Args& a, int l, int t0, int h, LAS char* lds, int wave) {
    typedef short bf16x8 __attribute__((ext_vector_type(8)));
    typedef float f32x16 __attribute__((ext_vector_type(16)));
    int lane; asm volatile("v_mbcnt_lo_u32_b32 %0, -1, 0\n\tv_mbcnt_hi_u32_b32 %0, -1, %0" : "=v"(lane));
    const int r32 = lane & 31, hi = lane >> 5, hi4 = hi * 4;
    const bf16* Q = (const bf16*)(a.ws + WS_Q) + ((size_t)(t0 >> 5) * 8 + h) * 2 * 8 * 512 + lane * 8;
    const bf16* PK = (const bf16*)(a.ws + WS_PK) + ((size_t)(l * 8 + h) * 2) * 128 * 128 + lane * 8;
    int top[2][16];
#pragma unroll
    for (int p = 0; p < 2; ++p) {
        f32x16 acc[4] = {};
        bf16x8 qf[8];
#pragma unroll
        for (int cs = 0; cs < 8; ++cs) qf[cs] = *(const bf16x8*)(Q + (p * 8 + cs) * 512);
#pragma unroll
        for (int kb = 0; kb < 4; ++kb) { bf16x8 kf[8];
#pragma unroll
            for (int cs = 0; cs < 8; ++cs) kf[cs] = *(const bf16x8*)(PK + (size_t)p * 128 * 128 + ((size_t)kb * 8 + cs) * 512);
#pragma unroll
            for (int cs = 0; cs < 8; ++cs) acc[kb] = __builtin_amdgcn_mfma_f32_32x32x16_bf16(kf[cs], qf[cs], acc[kb], 0, 0, 0); }
        int v[64];
#pragma unroll
        for (int kb = 0; kb < 4; ++kb)
#pragma unroll
            for (int r = 0; r < 16; ++r) { const int c = kb * 32 + (r & 3) + 8 * (r >> 2);
                v[kb * 16 + r] = (f2key(acc[kb][r]) & ~127) | (c | hi4); }
        top16_of_64(v);
        int mine[16], other[16];
#pragma unroll
        for (int i = 0; i < 16; ++i) { auto rr = __builtin_amdgcn_permlane32_swap((unsigned)v[i], (unsigned)v[i], false, false); mine[i] = (int)rr[0]; other[i] = (int)rr[1]; }
        merge_top16(mine, other);
#pragma unroll
        for (int i = 0; i < 16; ++i) top[p][i] = mine[i];
    }
    LAS int* tab = (LAS int*)(lds + PL_TAB) + (wave * 64 + lane) * 32;
    float sA[16], sB[16];
#pragma unroll
    for (int i = 0; i < 16; ++i) { sA[i] = key2f(top[0][i] & ~127); sB[i] = key2f(top[1][i] & ~127); tab[i] = top[0][i] & 127; tab[16 + i] = top[1][i] & 127; }
    int c[64];
#pragma unroll
    for (int n = 0; n < 64; ++n) c[n] = (int)0x80000000;
#pragma unroll
    for (int i = 0; i < 16; ++i)
#pragma unroll
        for (int j = 0; j < 16; ++j) if ((i + 1) * (j + 1) <= 16) c[cand_slot(i, j)] = (f2key(sA[i] + sB[j]) & ~255) | (16 * i + j);
    top16_of_64(c);
    float ex[16]; float sum = 0.f; const float mx = key2f(c[0] & ~255);
#pragma unroll
    for (int w = 0; w < 16; ++w) { ex[w] = __expf(key2f(c[w] & ~255) - mx); sum += ex[w]; }
    const float inv = 1.0f / sum;
    asm volatile("s_waitcnt lgkmcnt(0)" ::: "memory");
    LAS int* oi = (LAS int*)(lds + PL_IDX) + r32 * 128 + h * 16; LAS float* og = (LAS float*)(lds + PL_GATE) + r32 * 128 + h * 16;
#pragma unroll
    for (int w = 0; w < 16; ++w) { const int id = c[w] & 255; const int e = tab[id >> 4] * 128 + tab[16 + (id & 15)];
        if ((w >> 3) == hi) { oi[w] = e; og[w] = ex[w] * inv; } }
}
constexpr size_t WS_IDX = 816 * MiB;
constexpr size_t WS_GATE = 820 * MiB;
constexpr size_t WS_XQ = 824 * MiB;
constexpr size_t WS_SX = 856 * MiB;
constexpr size_t WS_PART = 857 * MiB;
constexpr size_t WS_SUT = 890 * MiB;
constexpr size_t WS_END2 = 1024 * MiB;
#ifndef PEER_NB
#define PEER_NB 8
#endif
constexpr int NSLICE = 8, SLW = D / NSLICE;
__device__ __forceinline__ void peer_publish4(const Args& a, int l, int t0, LAS char* lds, int tl0) {
    static_assert(PEER_TOK / NWAVES == 4, "four tokens per wave");
    int lane; LANE_ID(lane);
    unsigned char* ws = a.ws;
    {   const float* SU = (const float*)(ws + WS_SU) + l * PEER_E; const float* SV = (const float*)(ws + WS_SV) + l * PEER_E;
        int i0[4], i1[4]; float g0[4], g1[4], su0[4], su1[4], sv0[4], sv1[4];
#pragma unroll
        for (int k = 0; k < 4; ++k) { const int tl = tl0 + k; i0[k] = ((const LAS int*)(lds + PL_IDX))[tl * 128 + lane]; i1[k] = ((const LAS int*)(lds + PL_IDX))[tl * 128 + 64 + lane];
            g0[k] = ((const LAS float*)(lds + PL_GATE))[tl * 128 + lane]; g1[k] = ((const LAS float*)(lds + PL_GATE))[tl * 128 + 64 + lane]; }
#pragma unroll
        for (int k = 0; k < 4; ++k) { su0[k] = SU[i0[k]]; su1[k] = SU[i1[k]]; sv0[k] = SV[i0[k]]; sv1[k] = SV[i1[k]]; }
#pragma unroll
        for (int k = 0; k < 4; ++k) { const int t = t0 + k; int* gi = (int*)(ws + WS_IDX) + (size_t)t * 128; float* gg = (float*)(ws + WS_GATE) + (size_t)t * 128; float* gs = (float*)(ws + WS_SUT) + (size_t)t * 128;
            gi[lane] = i0[k]; gi[64 + lane] = i1[k]; gs[lane] = su0[k]; gs[64 + lane] = su1[k]; gg[lane] = g0[k] * sv0[k]; gg[64 + lane] = g1[k] * sv1[k]; }
    }
    const unsigned long long* ssa1 = (const unsigned long long*)(ws + WS_SSA) + l * M;
    const float* gn = a.norm_ffn + l * D;
    f32x4 g[2][4]; v4u hw[4][2][2]; float rs[4];
#pragma unroll
    for (int i = 0; i < 2; ++i)
#pragma unroll
        for (int q = 0; q < 4; ++q) g[i][q] = *(const f32x4*)(gn + 16 * lane + 1024 * i + 4 * q);
#pragma unroll
    for (int k = 0; k < 4; ++k) { const bf16* HB = (const bf16*)(ws + WS_HB) + (size_t)(t0 + k) * D; rs[k] = rsqrtf(ssa_to_f(ssa1[t0 + k]) * (1.0f / D) + EPS);
#pragma unroll
        for (int i = 0; i < 2; ++i) { hw[k][i][0] = *(const v4u*)(HB + 16 * lane + 1024 * i); hw[k][i][1] = *(const v4u*)(HB + 16 * lane + 1024 * i + 8); } }
#pragma unroll
    for (int k = 0; k < 4; ++k) { const int t = t0 + k;
        float xf[32]; float am = 0.f;
#pragma unroll
        for (int i = 0; i < 2; ++i) { const unsigned hq[8] = {hw[k][i][0].x, hw[k][i][0].y, hw[k][i][0].z, hw[k][i][0].w, hw[k][i][1].x, hw[k][i][1].y, hw[k][i][1].z, hw[k][i][1].w};
#pragma unroll
            for (int q = 0; q < 4; ++q) {
                xf[16 * i + 4 * q + 0] = bflo(hq[2 * q]) * rs[k] * g[i][q][0]; xf[16 * i + 4 * q + 1] = bfhi(hq[2 * q]) * rs[k] * g[i][q][1];
                xf[16 * i + 4 * q + 2] = bflo(hq[2 * q + 1]) * rs[k] * g[i][q][2]; xf[16 * i + 4 * q + 3] = bfhi(hq[2 * q + 1]) * rs[k] * g[i][q][3]; } }
#pragma unroll
        for (int e = 0; e < 32; ++e) am = fmaxf(am, fabsf(xf[e]));
        am = wave_max(am, lane);
        const float inv = am > 0.f ? 127.0f / am : 0.f;
        if (lane == 0) ((float*)(ws + WS_SX))[t] = am * (1.0f / 127.0f);
        unsigned char* xq = ws + WS_XQ + (size_t)t * 4096;
#pragma unroll
        for (int i = 0; i < 2; ++i) { v4u ph, pl;
#pragma unroll
            for (int d = 0; d < 4; ++d) { unsigned wh = 0, wl = 0;
#pragma unroll
                for (int b = 0; b < 4; ++b) { const float sv = xf[16 * i + 4 * d + b] * inv, hq = rintf(sv), lq = rintf((sv - hq) * 128.0f);
                    wh |= ((unsigned)((int)hq & 255)) << (8 * b); wl |= ((unsigned)((int)lq & 255)) << (8 * b); }
                ph[d] = wh; pl[d] = wl; }
            *(v4u*)(xq + 16 * lane + 1024 * i) = ph; *(v4u*)(xq + 2048 + 16 * lane + 1024 * i) = pl; } }
}
struct PeerItems { int pos, npop, rank, nloc, wave;
    __device__ __forceinline__ int nblk() const { return (M / PEER_TOK - rank + nloc - 1) / nloc; }
    __device__ __forceinline__ int count() const { return ((NSLICE - pos + npop - 1) / npop) * nblk() * (PEER_TOK / NWAVES); }
    __device__ __forceinline__ void get(int n, int& s, int& t) const { constexpr int per = PEER_TOK / NWAVES; const int k = n % per, r = n / per, nb = nblk();
        s = pos + (r / nb) * npop; t = (rank + (r % nb) * nloc) * PEER_TOK + wave * per + k; } };
__device__ __forceinline__ void peer_u_wave(const Args& a, int l, const PeerItems& it) {
    int lane; LANE_ID(lane);
    unsigned char* ws = a.ws; const int sub = lane & 15, grp = lane >> 4;
    const __amdgpu_buffer_rsrc_t rU = __builtin_amdgcn_make_buffer_rsrc((void*)(ws + WS_PU + (size_t)l * PE_BYTES), 0, 0x7fffffff, 0x00020000);
    const __amdgpu_buffer_rsrc_t rW = __builtin_amdgcn_make_buffer_rsrc((void*)ws, 0, 0x7fffffff, 0x00020000);
    const int N = it.count(); if (N <= 0) return;
    int s, t; it.get(0, s, t);
    int idc[2], idn[2] = {0, 0}; v4u xhc, xlc, xhn = {}, xln = {}; v4u wA[PEER_NB], wB[PEER_NB];
#define PU_META(I0, I1, XH, XL, S_, T_) do { I0 = (int)__builtin_amdgcn_raw_buffer_load_b32(rW, 4 * lane, (int)WS_IDX + (T_) * 512, 0); I1 = (int)__builtin_amdgcn_raw_buffer_load_b32(rW, 4 * lane, (int)WS_IDX + (T_) * 512 + 256, 0); \
        XH = __builtin_amdgcn_raw_buffer_load_b128(rW, 16 * sub, (int)WS_XQ + (T_) * 4096 + SLW * (S_), 0); XL = __builtin_amdgcn_raw_buffer_load_b128(rW, 16 * sub, (int)WS_XQ + (T_) * 4096 + 2048 + SLW * (S_), 0); } while (0)
#define PU_ISSUE(W, ID, Q, S_) do { _Pragma("unroll") for (int j = 0; j < PEER_NB; ++j) { const int e_ = shi(ID[(PEER_NB * (Q) + j) >> 4], 4 * ((PEER_NB * (Q) + j) & 15) + grp); W[j] = __builtin_amdgcn_raw_buffer_load_b128(rU, e_ * D + SLW * (S_) + 16 * sub, 0, 0); } } while (0)
#define PU_COMP(W, Q) do { _Pragma("unroll") for (int j = 0; j < PEER_NB; ++j) { int dh = 0, dl = 0; \
            dh = __builtin_amdgcn_sdot4((int)W[j].x, (int)xhc.x, dh, false); dl = __builtin_amdgcn_sdot4((int)W[j].x, (int)xlc.x, dl, false); \
            dh = __builtin_amdgcn_sdot4((int)W[j].y, (int)xhc.y, dh, false); dl = __builtin_amdgcn_sdot4((int)W[j].y, (int)xlc.y, dl, false); \
            dh = __builtin_amdgcn_sdot4((int)W[j].z, (int)xhc.z, dh, false); dl = __builtin_amdgcn_sdot4((int)W[j].z, (int)xlc.z, dl, false); \
            dh = __builtin_amdgcn_sdot4((int)W[j].w, (int)xhc.w, dh, false); dl = __builtin_amdgcn_sdot4((int)W[j].w, (int)xlc.w, dl, false); \
            float p_ = (float)dh + (float)dl * (1.0f / 128.0f); \
            p_ += DPP_ROR(p_, 8); p_ += DPP_ROR(p_, 4); p_ += DPP_ROR(p_, 2); p_ += DPP_ROR(p_, 1); \
            if (sub == ((PEER_NB * (Q) + j) & 15)) { if ((PEER_NB * (Q) + j) >> 4) acc1 = p_; else acc0 = p_; } __builtin_amdgcn_sched_barrier(0); } } while (0)
    PU_META(idc[0], idc[1], xhc, xlc, s, t); PU_ISSUE(wA, idc, 0, s); PU_ISSUE(wB, idc, 1, s);
    for (int n = 0; n < N; ++n) {
        int sn = s, tn = t; const bool more = n + 1 < N;
        if (more) it.get(n + 1, sn, tn);
        PU_META(idn[0], idn[1], xhn, xln, sn, tn);
        float acc0 = 0.f, acc1 = 0.f;
        __builtin_amdgcn_sched_barrier(0);
#if PEER_NB == 8
        PU_COMP(wA, 0); PU_ISSUE(wA, idc, 2, s); __builtin_amdgcn_sched_barrier(0);
        PU_COMP(wB, 1); PU_ISSUE(wB, idc, 3, s); __builtin_amdgcn_sched_barrier(0);
        PU_COMP(wA, 2); PU_ISSUE(wA, idn, 0, sn); __builtin_amdgcn_sched_barrier(0);
        PU_COMP(wB, 3); PU_ISSUE(wB, idn, 1, sn); __builtin_amdgcn_sched_barrier(0);
#else
        PU_COMP(wA, 0); PU_ISSUE(wA, idn, 0, sn); __builtin_amdgcn_sched_barrier(0);
        PU_COMP(wB, 1); PU_ISSUE(wB, idn, 1, sn); __builtin_amdgcn_sched_barrier(0);
#endif
        __builtin_amdgcn_raw_buffer_store_b32(__builtin_bit_cast(unsigned, acc0), rW, (4 * sub + grp) * 4, (int)WS_PART + (s * M + t) * 512, 0);
        __builtin_amdgcn_raw_buffer_store_b32(__builtin_bit_cast(unsigned, acc1), rW, (4 * sub + grp) * 4 + 256, (int)WS_PART + (s * M + t) * 512, 0);
        s = sn; t = tn; idc[0] = idn[0]; idc[1] = idn[1]; xhc = xhn; xlc = xln;
    }
#undef PU_META
#undef PU_ISSUE
#undef PU_COMP
}
__device__ __forceinline__ void peer_v_wave(const Args& a, int l, const PeerItems& it) {
    int lane; LANE_ID(lane);
    unsigned char* ws = a.ws; const int sub = lane & 15, grp = lane >> 4;
    const __amdgpu_buffer_rsrc_t rV = __builtin_amdgcn_make_buffer_rsrc((void*)(ws + WS_PV + (size_t)l * PE_BYTES), 0, 0x7fffffff, 0x00020000);
    const __amdgpu_buffer_rsrc_t rW = __builtin_amdgcn_make_buffer_rsrc((void*)ws, 0, 0x7fffffff, 0x00020000);
    const int N = it.count(); if (N <= 0) return;
    int s, t; it.get(0, s, t);
    struct Meta { int id[2]; float gate[2], su[2], pa[2], sx; v2u h1; };
    Meta mc, mn; v4u wA[PEER_NB], wB[PEER_NB];
    const int l4 = 4 * lane;
#define WLD(off_s) __builtin_amdgcn_raw_buffer_load_b32(rW, l4, (int)(off_s), 0)
#define PV_META(MM, S_, T_) do { const int r_ = (T_) * 512; MM.id[0] = (int)WLD(WS_IDX + r_); MM.id[1] = (int)WLD(WS_IDX + r_ + 256); \
        MM.gate[0] = __builtin_bit_cast(float, WLD(WS_GATE + r_)); MM.gate[1] = __builtin_bit_cast(float, WLD(WS_GATE + r_ + 256)); MM.su[0] = __builtin_bit_cast(float, WLD(WS_SUT + r_)); MM.su[1] = __builtin_bit_cast(float, WLD(WS_SUT + r_ + 256)); \
        float a0_ = 0.f, a1_ = 0.f; _Pragma("unroll") for (int q = 0; q < NSLICE; ++q) { const int po_ = (int)WS_PART + (q * M + (T_)) * 512; a0_ += __builtin_bit_cast(float, WLD(po_)); a1_ += __builtin_bit_cast(float, WLD(po_ + 256)); } \
        MM.pa[0] = a0_; MM.pa[1] = a1_; MM.sx = ((const float*)(ws + WS_SX))[T_]; \
        MM.h1 = __builtin_amdgcn_raw_buffer_load_b64(rW, (16 * sub + 4 * grp) * 2, (int)WS_HB + ((T_) * D + SLW * (S_)) * 2, 0); } while (0)
#define PV_ISSUE(W, ID, Q, S_) do { _Pragma("unroll") for (int j = 0; j < PEER_NB; ++j) { const int e_ = shi(ID[(PEER_NB * (Q) + j) >> 4], 4 * ((PEER_NB * (Q) + j) & 15) + grp); W[j] = __builtin_amdgcn_raw_buffer_load_b128(rV, e_ * D + SLW * (S_) + 16 * sub, 0, 0); } } while (0)
#define PV_COMP(W, Q) do { _Pragma("unroll") for (int j4 = 0; j4 < PEER_NB; j4 += 4) { \
            unsigned cp_ = 0; _Pragma("unroll") for (int jj = 0; jj < 4; ++jj) { const int i_ = PEER_NB * (Q) + j4 + jj; cp_ |= ((unsigned)shi(c8[i_ >> 4], 4 * (i_ & 15) + grp) & 255u) << (8 * jj); } \
            _Pragma("unroll") for (int d = 0; d < 4; ++d) { const unsigned a_ = W[j4][d], b_ = W[j4 + 1][d], c_ = W[j4 + 2][d], d_ = W[j4 + 3][d]; \
                const unsigned x0_ = __builtin_amdgcn_perm(b_, a_, 0x05010400u), x1_ = __builtin_amdgcn_perm(b_, a_, 0x07030602u), y0_ = __builtin_amdgcn_perm(d_, c_, 0x05010400u), y1_ = __builtin_amdgcn_perm(d_, c_, 0x07030602u); \
                yi[4 * d + 0] = __builtin_amdgcn_sdot4((int)__builtin_amdgcn_perm(y0_, x0_, 0x05040100u), (int)cp_, yi[4 * d + 0], false); \
                yi[4 * d + 1] = __builtin_amdgcn_sdot4((int)__builtin_amdgcn_perm(y0_, x0_, 0x07060302u), (int)cp_, yi[4 * d + 1], false); \
                yi[4 * d + 2] = __builtin_amdgcn_sdot4((int)__builtin_amdgcn_perm(y1_, x1_, 0x05040100u), (int)cp_, yi[4 * d + 2], false); \
                yi[4 * d + 3] = __builtin_amdgcn_sdot4((int)__builtin_amdgcn_perm(y1_, x1_, 0x07060302u), (int)cp_, yi[4 * d + 3], false); } \
            __builtin_amdgcn_sched_barrier(0); } } while (0)
    PV_META(mc, s, t); PV_ISSUE(wA, mc.id, 0, s); PV_ISSUE(wB, mc.id, 1, s);
    for (int n = 0; n < N; ++n) {
        int sn = s, tn = t; const bool more = n + 1 < N;
        if (more) it.get(n + 1, sn, tn);
        PV_META(mn, sn, tn);
        float coef[2];
#pragma unroll
        for (int hf = 0; hf < 2; ++hf) coef[hf] = gelu_tanh(mc.pa[hf] * mc.su[hf] * mc.sx) * mc.gate[hf];
        const float cmax = wave_max(fmaxf(fabsf(coef[0]), fabsf(coef[1])), lane); const float cinv = cmax > 0.f ? 127.0f / cmax : 0.f, cs = cmax * (1.0f / 127.0f);
        const int c8[2] = {(int)rintf(coef[0] * cinv), (int)rintf(coef[1] * cinv)};
        int yi[16];
#pragma unroll
        for (int k = 0; k < 16; ++k) yi[k] = 0;
        __builtin_amdgcn_sched_barrier(0);
#if PEER_NB == 8
        PV_COMP(wA, 0); PV_ISSUE(wA, mc.id, 2, s); __builtin_amdgcn_sched_barrier(0);
        PV_COMP(wB, 1); PV_ISSUE(wB, mc.id, 3, s); __builtin_amdgcn_sched_barrier(0);
        PV_COMP(wA, 2); PV_ISSUE(wA, mn.id, 0, sn); __builtin_amdgcn_sched_barrier(0);
        PV_COMP(wB, 3); PV_ISSUE(wB, mn.id, 1, sn); __builtin_amdgcn_sched_barrier(0);
#else
        PV_COMP(wA, 0); PV_ISSUE(wA, mn.id, 0, sn); __builtin_amdgcn_sched_barrier(0);
        PV_COMP(wB, 1); PV_ISSUE(wB, mn.id, 1, sn); __builtin_amdgcn_sched_barrier(0);
#endif
#pragma unroll
        for (int k = 0; k < 16; ++k) { yi[k] += shi(yi[k], lane ^ 16); yi[k] += shi(yi[k], lane ^ 32); }
        int yq[4];
#pragma unroll
        for (int k = 0; k < 4; ++k) yq[k] = grp == 0 ? yi[k] : grp == 1 ? yi[4 + k] : grp == 2 ? yi[8 + k] : yi[12 + k];
        const f32x4 h2 = {bflo(mc.h1.x) + cs * (float)yq[0], bfhi(mc.h1.x) + cs * (float)yq[1], bflo(mc.h1.y) + cs * (float)yq[2], bfhi(mc.h1.y) + cs * (float)yq[3]};
        v2u hb; hb.x = pk2(h2[0], h2[1]); hb.y = pk2(h2[2], h2[3]);
        __builtin_amdgcn_raw_buffer_store_b64(hb, rW, (16 * sub + 4 * grp) * 2, (int)WS_HB + (t * D + SLW * s) * 2, 0);
        const float sq = wave_sum((h2[0] * h2[0] + h2[1] * h2[1]) + (h2[2] * h2[2] + h2[3] * h2[3]), lane);
        if (lane == 0) atomicAdd((unsigned long long*)(ws + WS_SSQ) + (size_t)(l + 1) * M + t, (unsigned long long)((double)sq * 4294967296.0));
        s = sn; t = tn; mc = mn;
    }
#undef PV_META
#undef WLD
#undef PV_ISSUE
#undef PV_COMP
}
__device__ __forceinline__ void final_norm(const Args& a, int gw, int NGW) {
    int lane; LANE_ID(lane);
    f32x4 g[8];
#pragma unroll
    for (int j = 0; j < 8; ++j) g[j] = *(const f32x4*)(a.norm_final + 4 * lane + 256 * j);
    for (int t0 = gw; t0 < M; t0 += 2 * NGW) { const int t1 = t0 + NGW; const bool ok1 = t1 < M; const int tr[2] = {t0, ok1 ? t1 : t0};
        v2u w[2][8]; float rf[2];
#pragma unroll
        for (int r = 0; r < 2; ++r) { const bf16* HB = (const bf16*)(a.ws + WS_HB) + (size_t)tr[r] * D;
            rf[r] = rsqrtf(ssa_to_f(((const unsigned long long*)(a.ws + WS_SSQ))[(size_t)DEPTH * M + tr[r]]) * (1.0f / D) + EPS);
#pragma unroll
            for (int j = 0; j < 8; ++j) w[r][j] = *(const v2u*)(HB + 4 * lane + 256 * j); }
#pragma unroll
        for (int r = 0; r < 2; ++r) if (r == 0 || ok1) { float* O = a.out + (size_t)tr[r] * D;
#pragma unroll
            for (int j = 0; j < 8; ++j) *(f32x4*)(O + 4 * lane + 256 * j) = (f32x4){bflo(w[r][j].x) * rf[r] * g[j][0], bfhi(w[r][j].x) * rf[r] * g[j][1], bflo(w[r][j].y) * rf[r] * g[j][2], bfhi(w[r][j].y) * rf[r] * g[j][3]}; } }
}

__global__ void __launch_bounds__(NT, 2) mk_fwd(ArgsK a_in) {
    extern __shared__ __attribute__((aligned(16))) unsigned char lds_raw[];
    LAS unsigned char* lds = (LAS unsigned char*)lds_raw;
    cg::grid_group grid = cg::this_grid();
    grid.sync();
    const int wave0 = __builtin_amdgcn_readfirstlane(threadIdx.x >> 6);
    const int G = gridDim.x;
    const CAS ArgsK* ka = (const CAS ArgsK*)__builtin_amdgcn_kernarg_segment_ptr();
    size_t zoff = 0;
#define PHASE_BEGIN() int lane; LANE_ID(lane); int blk = blockIdx.x, Gp = G, wv = wave0; asm volatile("" : "+s"(zoff), "+s"(ka), "+s"(blk), "+s"(Gp), "+s"(wv)); const int wave = wv, gw = blk * NWAVES + wv, NGW = Gp * NWAVES; (void)gw; (void)NGW; const Args a = load_args(ka, zoff); unsigned char* const ws = a.ws; (void)ws
    volatile LAS unsigned* bst = (volatile LAS unsigned*)(lds + RING_BYTES + 1024);
#define GRID_BAR() do { asm volatile("" : "+s"(zoff)); unsigned char* wsb_ = (unsigned char*)ka->ws + zoff; int wvb_ = wave0; asm volatile("" : "+s"(wvb_)); xcd_barrier((unsigned*)(wsb_ + WS_BAR), xb_xcc_id(), (unsigned)G, bst, wvb_); } while (0)
    volatile LAS unsigned* xinfo = bst + 4;
    { PHASE_BEGIN(); if (wave == 0 && lane == 0) { bst[0] = 0u; bst[1] = 0u; xinfo[2] = xb_add((unsigned*)(ws + WS_BAR) + XB_XCNT(xb_xcc_id()), 1u); }
      p0_cmax(a, gw, NGW, lane); }
    GRID_BAR();
    { PHASE_BEGIN(); p0_win_i8(a, lds, gw, NGW, wave, lane); p0_prologue(a, lds, gw, NGW, wave, lane); }
    GRID_BAR();
    {
        PHASE_BEGIN();
        if (wave == 0 && lane == 0) { unsigned* bar = (unsigned*)(ws + WS_BAR); const unsigned x = xb_xcc_id(); unsigned pos = 0, npop = 0, mine = 1;
            for (unsigned j = 0; j < 16; ++j) { const unsigned c = xb_ld(&bar[XB_XCNT(j)]); if (c) { ++npop; if (j < x) ++pos; } if (j == x) mine = c ? c : 1u; }
            xinfo[0] = pos; xinfo[1] = npop ? npop : 1u; xinfo[3] = mine; }
        __syncthreads();
    }
    int depth_rt = DEPTH; asm volatile("" : "+s"(depth_rt));
    for (int lc = 0; lc < depth_rt; ++lc) {
        int l = lc; asm volatile("" : "+s"(l));
        if (l > 0) { { PHASE_BEGIN(); quant_rows(a, l, gw, NGW, lane); } GRID_BAR(); }
        {
            PHASE_BEGIN();
            pg8::Gemm g{(const bf16*)(ws + WS_HB8), (const bf16*)(ws + WS_WIN + l * WIN_BYTES), M, NPROJ, D / 2}; pg8::StaticOrder S; S.init(M, NPROJ, Gp, blk);
            EpiProj E{ws, (const bf16*)(ws + WS_BIH) + l * NPROJ, (const float*)(ws + WS_RSA), (const bf16*)(ws + WS_SWH) + l * NPROJ};
            pg8::gemm_phase<EpiProj, pg8::StaticOrder, true, true>(lds, g, S, E, wave);
            forget_logits(a, l, gw, NGW, lane);
        }
        GRID_BAR();
#if defined(PROBE) && (PROBE == 2 || PROBE == 4)
        { PHASE_BEGIN(); const unsigned char* Gb = ws + WS_G; const bf16* PJ = (const bf16*)(ws + WS_PROJ);
          for (size_t i = (size_t)gw * 64 + lane; i < (size_t)M * D; i += (size_t)NGW * 64) { const size_t t = i / D, d = i % D;
            if (PROBE == 2) a.out[i] = (float)Gb[t * 8192 + d] + 3.0f * (float)Gb[t * 8192 + 2048 + d] + 7.0f * (float)Gb[t * 8192 + 4096 + d] + 13.0f * (float)Gb[t * 8192 + 6144 + d];
            else { float sacc = 0.f; for (int q = 0; q < 10; ++q) if ((d >> 9) == (q & 3)) sacc += (float)(q + 1) * bflo((unsigned)(unsigned short)PJ[(size_t)q * PROJ_T + t * MIXW + (d & 511)]) ; a.out[i] = sacc; } }
          return; }
#endif
        { PHASE_BEGIN(); mixers_fast(a, l, (LAS char*)lds, wave, lane, Gp, blk); }
        GRID_BAR();
#if defined(PROBE) && PROBE == 3
        { PHASE_BEGIN(); const bf16* src = (const bf16*)(ws + WS_Y);
          for (size_t i = (size_t)gw * 64 + lane; i < (size_t)M * D; i += (size_t)NGW * 64) a.out[i] = bflo((unsigned)(unsigned short)src[i]);
          return; }
#endif
        {
            PHASE_BEGIN();
            pg8::Gemm g{(const bf16*)(ws + WS_Y), (const bf16*)(ws + WS_WBR + l * SQ_BYTES), M, D, D}; pg8::StaticOrder S; S.init(M, D, Gp, blk);
            EpiMerge E{(const unsigned char*)(ws + WS_G), (bf16*)(ws + WS_MRG)};
            pg8::gemm_phase<EpiMerge, pg8::StaticOrder, false>(lds, g, S, E, wave);
        }
        GRID_BAR();
#if defined(PROBE) && PROBE == 1
        { PHASE_BEGIN(); const bf16* src = (const bf16*)(ws + WS_MRG);
          for (size_t i = (size_t)gw * 64 + lane; i < (size_t)M * D; i += (size_t)NGW * 64) a.out[i] = bflo((unsigned)(unsigned short)src[i]);
          return; }
#endif
        {
            PHASE_BEGIN();
            pg8::Gemm g{(const bf16*)(ws + WS_MRG), (const bf16*)(ws + WS_WOUT + l * SQ_BYTES), M, D, D}; pg8::StaticOrder S; S.init(M, D, Gp, blk);
            EpiRes E{l == 0 ? a.x : (const float*)nullptr, (bf16*)(ws + WS_HB), (unsigned long long*)(ws + WS_SSA) + l * M};
            pg8::gemm_phase<EpiRes, pg8::StaticOrder, false>(lds, g, S, E, wave);
        }
        GRID_BAR();
        {
            PHASE_BEGIN();
            pg8::Gemm g{(const bf16*)(ws + WS_HB), (const bf16*)(ws + WS_WQ + l * SQ_BYTES), M, D, D}; pg8::StaticOrder S; S.init(M, D, Gp, blk);
            EpiQ E{(bf16*)(ws + WS_Q), (const unsigned long long*)(ws + WS_SSA) + l * M};
            pg8::gemm_phase<EpiQ, pg8::StaticOrder, false>(lds, g, S, E, wave);
        }
        GRID_BAR();
        {
            PHASE_BEGIN(); (void)lane;
#if defined(PROBE) && (PROBE == 10 || PROBE == 11)
            int nrep = 2; asm volatile("" : "+s"(nrep));
            for (int rep = 0; rep < nrep; ++rep)
#endif
            for (int t0 = blk * PEER_TOK; t0 < M; t0 += Gp * PEER_TOK) {
#if defined(PROBE) && PROBE == 11
                if (rep == 0) {
#endif
                peer_retrieve(a, l, t0, wave, (LAS char*)lds, wave);
#if defined(PROBE) && PROBE == 11
                }
#endif
                __syncthreads();
                peer_publish4(a, l, t0 + wave * (PEER_TOK / NWAVES), (LAS char*)lds, wave * (PEER_TOK / NWAVES));
                __syncthreads();
            }
        }
        GRID_BAR();
        {
            PHASE_BEGIN(); (void)lane;
            const int pos = __builtin_amdgcn_readfirstlane((int)xinfo[0]), npop = __builtin_amdgcn_readfirstlane((int)xinfo[1]), rank = __builtin_amdgcn_readfirstlane((int)xinfo[2]), nloc = __builtin_amdgcn_readfirstlane((int)xinfo[3]);
            const PeerItems it{pos, npop, rank, nloc, wave}; peer_u_wave(a, l, it);
        }
        GRID_BAR();
        {
            PHASE_BEGIN(); (void)lane;
            const int pos = __builtin_amdgcn_readfirstlane((int)xinfo[0]), npop = __builtin_amdgcn_readfirstlane((int)xinfo[1]), rank = __builtin_amdgcn_readfirstlane((int)xinfo[2]), nloc = __builtin_amdgcn_readfirstlane((int)xinfo[3]);
            const PeerItems it{pos, npop, rank, nloc, wave}; peer_v_wave(a, l, it);
        }
        GRID_BAR();
    }
    {
        PHASE_BEGIN(); (void)lane;
        final_norm(a, gw, NGW);
    }
}

extern "C" void kernel_launch(void* const* d_in, const int* in_sizes, int n_in, void* d_out, int out_size, void* d_ws, size_t ws_size, hipStream_t stream) {
    static int grid = 0;
    if (grid == 0) {
        int dev = 0, cus = 0, per_cu = 0;
        if (n_in != 16 || out_size != M * D || ws_size < WS_END2) { fprintf(stderr, "kernel_launch: unexpected shapes (n_in %d out %d ws %zu)\n", n_in, out_size, ws_size); grid = -1; return; }
        (void)hipGetDevice(&dev);
        (void)hipDeviceGetAttribute(&cus, hipDeviceAttributeMultiprocessorCount, dev);
        (void)hipFuncSetAttribute((const void*)mk_fwd, hipFuncAttributeMaxDynamicSharedMemorySize, LDS_BYTES);
        (void)hipOccupancyMaxActiveBlocksPerMultiprocessor(&per_cu, (const void*)mk_fwd, NT, LDS_BYTES);
        if (per_cu < 1) { fprintf(stderr, "kernel_launch: occupancy query says %d blocks per CU\n", per_cu); }
        grid = cus;
        if (grid > 256) grid = 256;
    }
    if (grid < 0) return;
    (void)hipMemsetAsync((char*)d_ws + WS_CTL, 0, CTL_ZERO_BYTES, stream);
    ArgsK a{};
    const GAS float** p = (const GAS float**)&a;
    for (int i = 0; i < 16; ++i) p[i] = (const GAS float*)d_in[i];
    a.out = (GAS float*)d_out; a.ws = (GAS unsigned char*)d_ws;
    void* args[] = {&a};
    hipError_t e = hipLaunchCooperativeKernel((const void*)mk_fwd, dim3(grid), dim3(NT), args, LDS_BYTES, stream);
    if (e != hipSuccess) fprintf(stderr, "cooperative launch failed: %s (grid %d)\n", hipGetErrorString(e), grid);
}
```

```cpp
#include <hip/hip_runtime.h>
#include <hip/hip_cooperative_groups.h>
#include <cstdio>
#include <cstdint>
namespace cg = cooperative_groups;
namespace pg8 {
#define PG8_LAS __attribute__((address_space(3)))
typedef unsigned short bf16_t;
typedef short bf16x8 __attribute__((ext_vector_type(8)));
typedef float f32x4 __attribute__((ext_vector_type(4)));
typedef unsigned u32x4 __attribute__((ext_vector_type(4)));
typedef unsigned u32x2 __attribute__((ext_vector_type(2)));
typedef int i32x4 __attribute__((ext_vector_type(4)));
constexpr int BM = 256, BK = 64, HALF = 128, HTB = HALF * BK * 2  , STAGE_BYTES = 8 * HTB, NXCD = 8, WGM = 8;

__host__ __device__ __forceinline__ int lds_byte(int r, int c) { const int st = (r >> 4) * 2 + (c >> 5), rr = r & 15, cc = c & 31, ob = rr * 64 + cc * 2; return st * 1024 + (ob ^ (((ob >> 9) & 1) << 5)); }
__host__ __device__ __forceinline__ void stage_rc(int b, int& R, int& C) { const int st = b / 1024, sb = b % 1024, swz = sb ^ (((sb >> 9) & 1) << 5); R = (st >> 1) * 16 + swz / 64; C = (st & 1) * 32 + (swz % 64) / 2; }
__host__ __device__ __forceinline__ int perm32(int rho) { const int n = rho >> 4, i = rho & 15; return 8 * (i >> 2) + 4 * n + (i & 3); }

struct Unit { int pm, pn; };
struct Gemm { const bf16_t* A; const bf16_t* Bt; int M, N, K; };

struct StaticOrder {
    int nM, nN, nwg, G, c;
    __host__ __device__ void init(int M, int N, int G_, int c_) { nM = M / BM; nN = N / BM; nwg = nM * nN; G = G_; c = c_; }
    __host__ __device__ bool next(int i, Unit& u) const {
        const long L = (long)i * G + c; if (L >= nwg) return false;
        int wgid = (int)L; { const int q = nwg / NXCD, r = nwg % NXCD, xcd = wgid % NXCD, off = wgid / NXCD; wgid = (xcd < r ? xcd * (q + 1) : r * (q + 1) + (xcd - r) * q) + off; }
        const int nig = WGM * nN, gid = wgid / nig, fm = gid * WGM, gsz = (nM - fm) < WGM ? (nM - fm) : WGM;
        u.pm = fm + ((wgid % nig) % gsz); u.pn = (wgid % nig) / gsz; return true;
    }
};

__device__ __forceinline__ unsigned cvt_pk_bf16(float lo, float hi) { unsigned r; asm volatile("v_cvt_pk_bf16_f32 %0, %1, %2" : "=v"(r) : "v"(lo), "v"(hi)); return r; }

template <class Epi, class Sched, bool ALIGN_EPI = false, bool I8 = false>
__device__ __forceinline__ void gemm_phase(PG8_LAS unsigned char* lds, const Gemm g, const Sched& S, const Epi& E, int wid) {
    int lane_; asm volatile("v_mbcnt_lo_u32_b32 %0, -1, 0\n\tv_mbcnt_hi_u32_b32 %0, -1, %0" : "=v"(lane_));
    const int lane = lane_, tid = wid * 64 + lane, wr = wid >> 2, wc = wid & 3, fr = lane & 15, fq = lane >> 4;
    const int K = g.K, nt = K / BK;
    unsigned voffA, voffB;
    { int R, C; stage_rc(tid * 16, R, C); const int Rb = Epi::PERM ? ((R & ~31) + perm32(R & 31)) : R; voffA = (unsigned)(R * K + C) * 2u; voffB = (unsigned)(Rb * K + C) * 2u; }
    const size_t p2step = (size_t)64 * K * 2;
    const size_t kstep = (size_t)(BK * 2);
    const size_t hstep = (size_t)HALF * K * 2;
    const size_t tstep = 2 * hstep;
    const unsigned ldsw = (unsigned)wid * 1024u;
    const int aoff = lds_byte(wr * 64 + fr, fq * 8), boff = lds_byte(wc * 32 + fr, fq * 8);
#define PG8_SA(b, h) (((b) * 2 + (h)) * HTB)
#define PG8_SB(b, h) ((4 + (b) * 2 + (h)) * HTB)
#define PG8_STAGE(bufoff, gbase, voff) do { _Pragma("unroll") for (int _i = 0; _i < 2; ++_i) \
        __builtin_amdgcn_global_load_lds((const unsigned*)((const char*)(gbase) + _i * p2step + (voff)), (PG8_LAS unsigned*)(lds + (bufoff) + ldsw + _i * 8192), 16, 0, 0); } while (0)
#define PG8_LDA(dst, b, h) do { _Pragma("unroll") for (int m = 0; m < 4; ++m) _Pragma("unroll") for (int k = 0; k < 2; ++k) dst[m][k] = *(const PG8_LAS bf16x8*)(lds + PG8_SA(b, h) + aoff + m * 2048 + k * 1024); } while (0)
#define PG8_LDB(dst, b, h) do { _Pragma("unroll") for (int n = 0; n < 2; ++n) _Pragma("unroll") for (int k = 0; k < 2; ++k) dst[n][k] = *(const PG8_LAS bf16x8*)(lds + PG8_SB(b, h) + boff + n * 2048 + k * 1024); } while (0)
#define PG8_MMA(ai, bj, At, Bt) do { __builtin_amdgcn_s_setprio(1); _Pragma("unroll") for (int m = 0; m < 4; ++m) _Pragma("unroll") for (int n = 0; n < 2; ++n) _Pragma("unroll") for (int k = 0; k < 2; ++k) \
        { if constexpr (I8) acc[ai][bj][m][n] = __builtin_bit_cast(f32x4, __builtin_amdgcn_mfma_i32_16x16x64_i8(__builtin_bit_cast(i32x4, Bt[n][k]), __builtin_bit_cast(i32x4, At[m][k]), __builtin_bit_cast(i32x4, acc[ai][bj][m][n]), 0, 0, 0)); \
          else acc[ai][bj][m][n] = __builtin_amdgcn_mfma_f32_16x16x32_bf16(Bt[n][k], At[m][k], acc[ai][bj][m][n], 0, 0, 0); } __builtin_amdgcn_s_setprio(0); } while (0)
#define PG8_WAIT_V(n) asm volatile("s_waitcnt vmcnt(" #n ")" ::: "memory")
#define PG8_WAIT_L(n) asm volatile("s_waitcnt lgkmcnt(" #n ")" ::: "memory")
#define PG8_BAR __builtin_amdgcn_s_barrier()
#define PG8_SCHED __builtin_amdgcn_sched_barrier(0)
    Unit cur, nxt; int ui = 0;
    if (!S.next(0, cur)) return;
    f32x4 acc[2][2][4][2];
#pragma unroll
    for (int a = 0; a < 2; ++a)
#pragma unroll
        for (int b = 0; b < 2; ++b)
#pragma unroll
            for (int m = 0; m < 4; ++m)
#pragma unroll
                for (int n = 0; n < 2; ++n) acc[a][b][m][n] = (f32x4){0.f, 0.f, 0.f, 0.f};
    bf16x8 At[4][2], B0[2][2], B1[2][2];
    typename Epi::Pre pre = {};
    const char* cA = (const char*)g.A + (size_t)cur.pm * tstep; const char* cB = (const char*)g.Bt + (size_t)cur.pn * tstep;
    PG8_STAGE(PG8_SB(0, 0), cB, voffB); PG8_STAGE(PG8_SB(0, 1), cB + hstep, voffB); PG8_STAGE(PG8_SA(0, 0), cA, voffA); PG8_STAGE(PG8_SA(0, 1), cA + hstep, voffA);
    if (wr == 1) PG8_BAR;
    PG8_WAIT_V(2); PG8_BAR;
    PG8_STAGE(PG8_SB(1, 0), cB + kstep, voffB); PG8_STAGE(PG8_SA(1, 0), cA + kstep, voffA); PG8_STAGE(PG8_SB(1, 1), cB + hstep + kstep, voffB);
    PG8_WAIT_V(6); PG8_BAR;
    for (;;) {
        const bool has_next = S.next(ui + 1, nxt);
        const char* nA = has_next ? (const char*)g.A + (size_t)nxt.pm * tstep : cA; const char* nB = has_next ? (const char*)g.Bt + (size_t)nxt.pn * tstep : cB;
        const int seglen = Epi::HOOK ? 8 : nt;
        for (int t0 = 0; t0 < nt; t0 += seglen) {
        if constexpr (Epi::HOOK) { if (t0 > 0) { int ln_; asm volatile("v_mbcnt_lo_u32_b32 %0, -1, 0\n\tv_mbcnt_hi_u32_b32 %0, -1, %0" : "=v"(ln_)); E.hook(acc, cur, t0 >> 3, wr, wc, ln_ & 15, ln_ >> 4); } }
        for (int t = t0; t < t0 + seglen; t += 2) {
            const bool last = (t == nt - 2);
            if constexpr (Epi::PRELOAD) { if (last) { int ln_; asm volatile("v_mbcnt_lo_u32_b32 %0, -1, 0\n\tv_mbcnt_hi_u32_b32 %0, -1, %0" : "=v"(ln_)); E.preload(pre, cur, wr, wc, ln_ & 15, ln_ >> 4); } }
            const char* a1 = cA + (size_t)(t + 1) * kstep;
            const char* a2 = last ? nA : cA + (size_t)(t + 2) * kstep; const char* b2 = last ? nB : cB + (size_t)(t + 2) * kstep;
            const char* a3 = a2 + kstep; const char* b3 = b2 + kstep;
            PG8_LDB(B0, 0, 0); PG8_LDB(B1, 0, 1); PG8_SCHED; PG8_LDA(At, 0, 0); PG8_STAGE(PG8_SA(1, 1), a1 + hstep, voffA);
            PG8_WAIT_V(8); PG8_WAIT_L(0); PG8_BAR; PG8_MMA(0, 0, At, B0); PG8_MMA(0, 1, At, B1); PG8_BAR; PG8_SCHED;
            PG8_LDA(At, 0, 1); PG8_STAGE(PG8_SB(0, 0), b2, voffB); PG8_STAGE(PG8_SB(0, 1), b2 + hstep, voffB); PG8_STAGE(PG8_SA(0, 0), a2, voffA);
            PG8_WAIT_V(8); PG8_WAIT_L(0); PG8_BAR; PG8_MMA(1, 0, At, B0); PG8_MMA(1, 1, At, B1); PG8_BAR; PG8_SCHED;
            PG8_LDB(B0, 1, 0); PG8_LDB(B1, 1, 1); PG8_SCHED; PG8_LDA(At, 1, 0); PG8_STAGE(PG8_SA(0, 1), a2 + hstep, voffA);
            PG8_WAIT_V(8); PG8_WAIT_L(0); PG8_BAR; PG8_MMA(0, 0, At, B0); PG8_MMA(0, 1, At, B1); PG8_BAR; PG8_SCHED;
            PG8_LDA(At, 1, 1); PG8_STAGE(PG8_SB(1, 0), b3, voffB); PG8_STAGE(PG8_SB(1, 1), b3 + hstep, voffB); PG8_STAGE(PG8_SA(1, 0), a3, voffA);
            PG8_WAIT_V(8); PG8_WAIT_L(0); PG8_BAR; PG8_MMA(1, 0, At, B0); PG8_MMA(1, 1, At, B1); PG8_BAR; PG8_SCHED;
        }
        }
        if constexpr (ALIGN_EPI) { if (wr == 0) PG8_BAR; }
        { int ln_; asm volatile("v_mbcnt_lo_u32_b32 %0, -1, 0\n\tv_mbcnt_hi_u32_b32 %0, -1, %0" : "=v"(ln_));
          if constexpr (Epi::PRELOAD) E(acc, cur, wr, wc, ln_ & 15, ln_ >> 4, pre); else E(acc, cur, wr, wc, ln_ & 15, ln_ >> 4); }
        if (!has_next) break;
#pragma unroll
        for (int a = 0; a < 2; ++a)
#pragma unroll
            for (int b = 0; b < 2; ++b)
#pragma unroll
                for (int m = 0; m < 4; ++m)
#pragma unroll
                    for (int n = 0; n < 2; ++n) acc[a][b][m][n] = (f32x4){0.f, 0.f, 0.f, 0.f};
        cur = nxt; cA = nA; cB = nB; ++ui;
        if constexpr (ALIGN_EPI) { if (wr == 1) PG8_BAR; }
    }
    PG8_WAIT_V(0);
    if constexpr (!ALIGN_EPI) { if (wr == 0) PG8_BAR; }
    PG8_BAR;
#undef PG8_SA
#undef PG8_SB
#undef PG8_STAGE
#undef PG8_LDA
#undef PG8_LDB
#undef PG8_MMA
#undef PG8_WAIT_V
#undef PG8_WAIT_L
#undef PG8_BAR
#undef PG8_SCHED
}
}
constexpr int NWAVES = 8, NT = NWAVES * 64;
constexpr int M = 8192, D = 2048, SEQ = 2048, NBATCH = 4, DEPTH = 2;
constexpr int INW = 13316, NPROJ = 13312, MIXW = 512, HD = 128;
constexpr int PEER_E = 16384;
constexpr float EPS = 1e-6f;
constexpr float ATT_SCALE = 0.08838834764831845f;

constexpr size_t MiB = 1u << 20;
constexpr size_t WS_CTL = 0, CTL_ZERO_BYTES = 1 * MiB;
constexpr size_t WS_SSQ = 0;
constexpr size_t WS_SSA = 256 * 1024;
constexpr size_t WS_WF = 1 * MiB;
constexpr size_t WS_BINR = WS_WF + 64 * 1024;
constexpr size_t WS_LOGF = 2 * MiB;
constexpr size_t WS_CUM = 3 * MiB;
constexpr size_t WS_WIN = 8 * MiB;
constexpr size_t WIN_BYTES = (size_t)NPROJ * D;
constexpr size_t WS_SW = 7 * MiB;
constexpr size_t WS_CMAX = 384 * 1024;
constexpr size_t WS_HB8 = 64 * MiB;
constexpr size_t WS_SA = 7 * MiB + 512 * 1024;
constexpr size_t WS_WBR = 112 * MiB, WS_WOUT = 128 * MiB, WS_WQ = 144 * MiB;
constexpr size_t SQ_BYTES = (size_t)D * D * 2;
constexpr size_t WS_PU = 160 * MiB, WS_PV = 288 * MiB;
constexpr size_t PE_BYTES = (size_t)PEER_E * D;
constexpr size_t WS_PK = 6 * MiB;
constexpr size_t WS_SU = 5 * MiB, WS_SV = 5 * MiB + 256 * 1024;
constexpr size_t WS_HB = 480 * MiB;
constexpr size_t WS_PROJ = 512 * MiB;
constexpr size_t PROJ_T = (size_t)M * MIXW;
constexpr size_t WS_R = 592 * MiB;
constexpr size_t R_PLANE = (size_t)M * D;
constexpr size_t WS_Y = 720 * MiB;
constexpr size_t WS_MRG = 752 * MiB;
constexpr size_t WS_Q = 784 * MiB;
constexpr size_t WS_END = 816 * MiB;

constexpr int RING_BYTES = 131072;
constexpr int LDS_BYTES = 147456;

typedef unsigned short bf16;
typedef unsigned v4u __attribute__((ext_vector_type(4)));
typedef unsigned v2u __attribute__((ext_vector_type(2)));
typedef float f32x4 __attribute__((ext_vector_type(4)));
typedef float f32x2 __attribute__((ext_vector_type(2)));
using bf16x2 = __attribute__((ext_vector_type(2))) __bf16;
#define LAS __attribute__((address_space(3)))

__device__ __forceinline__ unsigned f2bf(float f) { unsigned u = __builtin_bit_cast(unsigned, f); return (u + 0x7fffu + ((u >> 16) & 1u)) >> 16; }
__device__ __forceinline__ unsigned pk2(float lo, float hi) { return f2bf(lo) | (f2bf(hi) << 16); }
__device__ __forceinline__ float bflo(unsigned w) { return __builtin_bit_cast(float, w << 16); }
__device__ __forceinline__ float bfhi(unsigned w) { return __builtin_bit_cast(float, w & 0xffff0000u); }
__device__ __forceinline__ float bf2f(bf16 b) { return __builtin_bit_cast(float, ((unsigned)b) << 16); }
__device__ __forceinline__ float shf(float v, int src) { return __builtin_bit_cast(float, __builtin_amdgcn_ds_bpermute(src << 2, __builtin_bit_cast(int, v))); }
__device__ __forceinline__ int shi(int v, int src) { return __builtin_amdgcn_ds_bpermute(src << 2, v); }
#define DPP_ROR(x, n) __builtin_bit_cast(float, __builtin_amdgcn_update_dpp(0, __builtin_bit_cast(int, (x)), 0x120 + (n), 0xf, 0xf, false))
__device__ __forceinline__ float wave_sum(float v, int) {
    v += DPP_ROR(v, 8); v += DPP_ROR(v, 4); v += DPP_ROR(v, 2); v += DPP_ROR(v, 1);
    const int vi = __builtin_bit_cast(int, v);
    const float r0 = __builtin_bit_cast(float, __builtin_amdgcn_readlane(vi, 0)), r1 = __builtin_bit_cast(float, __builtin_amdgcn_readlane(vi, 16)),
                r2 = __builtin_bit_cast(float, __builtin_amdgcn_readlane(vi, 32)), r3 = __builtin_bit_cast(float, __builtin_amdgcn_readlane(vi, 48));
    return (r0 + r1) + (r2 + r3);
}
__device__ __forceinline__ float wave_max(float v, int) {
    v = fmaxf(v, DPP_ROR(v, 8)); v = fmaxf(v, DPP_ROR(v, 4)); v = fmaxf(v, DPP_ROR(v, 2)); v = fmaxf(v, DPP_ROR(v, 1));
    const int vi = __builtin_bit_cast(int, v);
    const float r0 = __builtin_bit_cast(float, __builtin_amdgcn_readlane(vi, 0)), r1 = __builtin_bit_cast(float, __builtin_amdgcn_readlane(vi, 16)),
                r2 = __builtin_bit_cast(float, __builtin_amdgcn_readlane(vi, 32)), r3 = __builtin_bit_cast(float, __builtin_amdgcn_readlane(vi, 48));
    return fmaxf(fmaxf(r0, r1), fmaxf(r2, r3));
}
__device__ __forceinline__ float ssa_to_f(unsigned long long v) { return (float)((double)v * (1.0 / 4294967296.0)); }
__device__ __forceinline__ float dot2_bf16(unsigned w, unsigned x, float acc) { return __builtin_amdgcn_fdot2_f32_bf16(__builtin_bit_cast(bf16x2, w), __builtin_bit_cast(bf16x2, x), acc, false); }

#define LANE_ID(x) asm volatile("v_mbcnt_lo_u32_b32 %0, -1, 0\n\tv_mbcnt_hi_u32_b32 %0, -1, %0" : "=v"(x))
struct Args {
    const float *x, *norm_mix, *w_in, *b_in, *pool_w, *pool_scale, *conv_w, *rel_bias, *w_branch, *w_out, *norm_ffn, *peer_wq, *peer_keys, *peer_u, *peer_v, *norm_final;
    float* out; unsigned char* ws;
};
#define GAS __attribute__((address_space(1)))
#define CAS __attribute__((address_space(4)))
struct ArgsK {
    const GAS float *x, *norm_mix, *w_in, *b_in, *pool_w, *pool_scale, *conv_w, *rel_bias, *w_branch, *w_out, *norm_ffn, *peer_wq, *peer_keys, *peer_u, *peer_v, *norm_final;
    GAS float* out; GAS unsigned char* ws;
};
__device__ __forceinline__ Args load_args(const CAS ArgsK* k, size_t zoff) {
    Args a;
    a.x = (const float*)k->x; a.norm_mix = (const float*)k->norm_mix; a.w_in = (const float*)k->w_in; a.b_in = (const float*)k->b_in; a.pool_w = (const float*)k->pool_w;
    a.pool_scale = (const float*)k->pool_scale; a.conv_w = (const float*)k->conv_w; a.rel_bias = (const float*)k->rel_bias; a.w_branch = (const float*)k->w_branch;
    a.w_out = (const float*)k->w_out; a.norm_ffn = (const float*)k->norm_ffn; a.peer_wq = (const float*)k->peer_wq; a.peer_keys = (const float*)k->peer_keys;
    a.peer_u = (const float*)k->peer_u; a.peer_v = (const float*)k->peer_v; a.norm_final = (const float*)k->norm_final; a.out = (float*)k->out; a.ws = (unsigned char*)(k->ws + zoff);
    return a;
}

using pg8::f32x4; using pg8::Unit;
constexpr size_t WS_G = 896 * MiB;
constexpr size_t WS_SWH = 7 * MiB + 256 * 1024, WS_BIH = 7 * MiB + 384 * 1024;
constexpr size_t WS_RSA = 7 * MiB + 768 * 1024;
struct EpiProj {
    static constexpr bool PERM = true, HOOK = false, PRELOAD = true;
    struct Pre { pg8::u32x4 sw[2], bi[2]; float rs[2][4]; };
    unsigned char* wsb; const bf16* biash; const float* rsa; const bf16* swh;
    __device__ __forceinline__ void preload(Pre& p, const Unit& u, int wr, int wc, int fr, int fq) const {
        const int row0 = u.pm * 256 + wr * 64 + fr, bcol0 = u.pn * 256 + wc * 32 + 8 * fq;
#pragma unroll
        for (int bj = 0; bj < 2; ++bj) { p.sw[bj] = *(const pg8::u32x4*)(swh + bcol0 + bj * 128); p.bi[bj] = *(const pg8::u32x4*)(biash + bcol0 + bj * 128); }
#pragma unroll
        for (int ai = 0; ai < 2; ++ai)
#pragma unroll
            for (int m = 0; m < 4; ++m) p.rs[ai][m] = rsa[row0 + ai * 128 + m * 16];
    }
    static __device__ __forceinline__ unsigned g8(float z) { const float t = __builtin_amdgcn_rcpf(__builtin_amdgcn_exp2f(__builtin_fmaf(z, -1.4426950408889634f, -8.0f)) + 0.00390625f);
        return (unsigned)(__builtin_amdgcn_fmed3f(t, 1.0f, 255.0f) + 0.5f); }
    static __device__ __forceinline__ unsigned g8x4(const f32x4& v) { return g8(v[0]) | (g8(v[1]) << 8) | (g8(v[2]) << 16) | (g8(v[3]) << 24); }
    __device__ __forceinline__ void operator()(f32x4 (&acc)[2][2][4][2], const Unit& u, int wr, int wc, int fr, int fq, const Pre& p) const {
        const int cl0 = wc * 32 + 8 * fq;
#define ACCF(ai, bj, m, n) __builtin_convertvector(__builtin_bit_cast(pg8::i32x4, acc[ai][bj][m][n]), f32x4)
        const __amdgpu_buffer_rsrc_t rW = __builtin_amdgcn_make_buffer_rsrc((void*)wsb, 0, 0x7fffffff, 0x00020000);
        int sbase, ldb, voff;
        if (u.pn < 20) { sbase = (int)WS_PROJ + ((u.pn >> 1) * (int)PROJ_T + (u.pn & 1) * 256) * 2; ldb = MIXW * 2; voff = fr * ldb + cl0 * 2; }
        else { sbase = (int)WS_G + (u.pn - 20) * 256; ldb = 4 * D; voff = fr * ldb + wc * 64 + fq * 16; }
        sbase += (u.pm * 256 + wr * 64) * ldb;
#pragma unroll
        for (int bj = 0; bj < 2; ++bj) { const f32x4 w0 = {bflo(p.sw[bj].x), bfhi(p.sw[bj].x), bflo(p.sw[bj].y), bfhi(p.sw[bj].y)}, w1 = {bflo(p.sw[bj].z), bfhi(p.sw[bj].z), bflo(p.sw[bj].w), bfhi(p.sw[bj].w)};
            const f32x4 b0 = {bflo(p.bi[bj].x), bfhi(p.bi[bj].x), bflo(p.bi[bj].y), bfhi(p.bi[bj].y)}, b1 = {bflo(p.bi[bj].z), bfhi(p.bi[bj].z), bflo(p.bi[bj].w), bfhi(p.bi[bj].w)};
#pragma unroll
            for (int ai = 0; ai < 2; ++ai)
#pragma unroll
                for (int m = 0; m < 4; ++m) { const float rs = p.rs[ai][m]; const f32x4 v0 = ACCF(ai, bj, m, 0) * rs * w0 + b0, v1 = ACCF(ai, bj, m, 1) * rs * w1 + b1;
                    if (u.pn >= 20) { v2u w; w.x = g8x4(v0); w.y = g8x4(v1);
                        __builtin_amdgcn_raw_buffer_store_b64(w, rW, voff + bj * 8, sbase + (ai * 128 + m * 16) * ldb, 0); }
                    else { pg8::u32x4 w; w.x = pg8::cvt_pk_bf16(v0[0], v0[1]); w.y = pg8::cvt_pk_bf16(v0[2], v0[3]); w.z = pg8::cvt_pk_bf16(v1[0], v1[1]); w.w = pg8::cvt_pk_bf16(v1[2], v1[3]);
                        __builtin_amdgcn_raw_buffer_store_b128(w, rW, voff + bj * 256, sbase + (ai * 128 + m * 16) * ldb, 0); } } }
    }
};
#undef ACCF
struct EpiMerge {
    static constexpr bool PERM = true, HOOK = true; static constexpr bool PRELOAD = false; struct Pre {};
    const unsigned char* G; bf16* O;
    struct Bt { pg8::u32x4 n[4], d[4]; };
    __device__ __forceinline__ void scale(f32x4 (&acc)[2][2][4][2], const Unit& u, int g, int wr, int wc, int fr, int fq) const {
        const __amdgpu_buffer_rsrc_t rs = __builtin_amdgcn_make_buffer_rsrc((void*)G, 0, 0x7fffffff, 0x00020000);
        int voff = fr * 4 * D + 16 * fq; asm volatile("" : "+v"(voff));
        const int sden = (u.pm * 256 + wr * 64) * 4 * D + (g - 1) * D + u.pn * 256 + wc * 64, snum = sden + D;
        const bool fin = g == 4;
#define UB(x, e) ((float)(((x) >> (8 * (e))) & 255u))
#define MG_LOAD(B, b0) do { _Pragma("unroll") for (int i = 0; i < 4; ++i) { const int ai_ = ((b0) + i) >> 2, m_ = ((b0) + i) & 3, so_ = (ai_ * 128 + m_ * 16) * 4 * D; \
            B.d[i] = __builtin_amdgcn_raw_buffer_load_b128(rs, voff, sden + so_, 0); if (!fin) B.n[i] = __builtin_amdgcn_raw_buffer_load_b128(rs, voff, snum + so_, 0); } } while (0)
#define MG_APPLY(B, b0) do { _Pragma("unroll") for (int i = 0; i < 4; ++i) { const int ai_ = ((b0) + i) >> 2, m_ = ((b0) + i) & 3; \
            _Pragma("unroll") for (int q = 0; q < 4; ++q) { const unsigned dq = B.d[i][q], nq = B.n[i][q]; \
                f32x4 r = {UB(dq, 0), UB(dq, 1), UB(dq, 2), UB(dq, 3)}; \
                if (!fin) r *= (f32x4){__builtin_amdgcn_rcpf(UB(nq, 0)), __builtin_amdgcn_rcpf(UB(nq, 1)), __builtin_amdgcn_rcpf(UB(nq, 2)), __builtin_amdgcn_rcpf(UB(nq, 3))}; else r *= 0.00390625f; \
                acc[ai_][q >> 1][m_][q & 1] *= r; asm volatile("" : "+v"(acc[ai_][q >> 1][m_][q & 1])); } } } while (0)
        Bt A = {}, B = {};
        MG_LOAD(A, 0); MG_LOAD(B, 4);
        MG_APPLY(A, 0); asm volatile("" ::: "memory");
        MG_APPLY(B, 4); asm volatile("" ::: "memory");
#undef MG_LOAD
#undef MG_APPLY
#undef UB
    }
    __device__ __forceinline__ void hook(f32x4 (&acc)[2][2][4][2], const Unit& u, int g, int wr, int wc, int fr, int fq) const { scale(acc, u, g, wr, wc, fr, fq); }
    __device__ __forceinline__ void operator()(f32x4 (&acc)[2][2][4][2], const Unit& u, int wr, int wc, int fr, int fq) const {
        scale(acc, u, 4, wr, wc, fr, fq);
        const int row0 = u.pm * 256 + wr * 64 + fr, col0 = u.pn * 256 + wc * 32 + 8 * fq;
#pragma unroll
        for (int ai = 0; ai < 2; ++ai)
#pragma unroll
            for (int m = 0; m < 4; ++m) { bf16* rowp = O + (size_t)(row0 + ai * 128 + m * 16) * D + col0;
#pragma unroll
                for (int bj = 0; bj < 2; ++bj) { const f32x4 v0 = acc[ai][bj][m][0], v1 = acc[ai][bj][m][1];
                    pg8::u32x4 w; w.x = pg8::cvt_pk_bf16(v0[0], v0[1]); w.y = pg8::cvt_pk_bf16(v0[2], v0[3]); w.z = pg8::cvt_pk_bf16(v1[0], v1[1]); w.w = pg8::cvt_pk_bf16(v1[2], v1[3]);
                    *(pg8::u32x4*)(rowp + bj * 128) = w; } }
    }
};
struct EpiRes {
    static constexpr bool PERM = true, HOOK = false; static constexpr bool PRELOAD = false; struct Pre {};
    const float* X; bf16* HB; unsigned long long* ssa;
    __device__ __forceinline__ void operator()(f32x4 (&acc)[2][2][4][2], const Unit& u, int wr, int wc, int fr, int fq) const {
        const int row0 = u.pm * 256 + wr * 64 + fr, col0 = u.pn * 256 + wc * 32 + 8 * fq;
#pragma unroll
        for (int ai = 0; ai < 2; ++ai)
#pragma unroll
            for (int m = 0; m < 4; ++m) { const int row = row0 + ai * 128 + m * 16; const size_t off = (size_t)row * D + col0; float s = 0.f;
#pragma unroll
                for (int bj = 0; bj < 2; ++bj) { const size_t o = off + bj * 128; f32x4 h0, h1;
                    if (X != nullptr) { h0 = *(const f32x4*)(X + o); h1 = *(const f32x4*)(X + o + 4); }
                    else { const pg8::u32x4 w = *(const pg8::u32x4*)(HB + o); h0 = (f32x4){bflo(w.x), bfhi(w.x), bflo(w.y), bfhi(w.y)}; h1 = (f32x4){bflo(w.z), bfhi(w.z), bflo(w.w), bfhi(w.w)}; }
                    h0 += acc[ai][bj][m][0]; h1 += acc[ai][bj][m][1];
                    pg8::u32x4 w; w.x = pg8::cvt_pk_bf16(h0[0], h0[1]); w.y = pg8::cvt_pk_bf16(h0[2], h0[3]); w.z = pg8::cvt_pk_bf16(h1[0], h1[1]); w.w = pg8::cvt_pk_bf16(h1[2], h1[3]);
                    *(pg8::u32x4*)(HB + o) = w;
                    s += ((h0[0] * h0[0] + h0[1] * h0[1]) + (h0[2] * h0[2] + h0[3] * h0[3])) + ((h1[0] * h1[0] + h1[1] * h1[1]) + (h1[2] * h1[2] + h1[3] * h1[3])); }
                { const int ln = fq * 16 + fr; s += shf(s, ln ^ 16); s += shf(s, ln ^ 32); }
                if (fq == 0) atomicAdd(ssa + row, (unsigned long long)((double)s * 4294967296.0)); }
    }
};
struct EpiQ {
    static constexpr bool PERM = true, HOOK = false; static constexpr bool PRELOAD = false; struct Pre {};
    bf16* O; const unsigned long long* ssa;
    __device__ __forceinline__ void operator()(f32x4 (&acc)[2][2][4][2], const Unit& u, int wr, int wc, int fr, int fq) const {
        const int row0 = u.pm * 256 + wr * 64 + fr;
#pragma unroll
        for (int ai = 0; ai < 2; ++ai)
#pragma unroll
            for (int m = 0; m < 4; ++m) { const int row = row0 + ai * 128 + m * 16; const float rs = rsqrtf(ssa_to_f(ssa[row]) * (1.0f / D) + EPS);
                bf16* rowp = O + ((((size_t)(row >> 5) * 8 + u.pn) * 2 * 8 + (wc * 2 + (fq >> 1))) * 64 + (fq & 1) * 32 + (row & 31)) * 8;
#pragma unroll
                for (int bj = 0; bj < 2; ++bj) { const f32x4 v0 = acc[ai][bj][m][0] * rs, v1 = acc[ai][bj][m][1] * rs;
                    pg8::u32x4 w; w.x = pg8::cvt_pk_bf16(v0[0], v0[1]); w.y = pg8::cvt_pk_bf16(v0[2], v0[3]); w.z = pg8::cvt_pk_bf16(v1[0], v1[1]); w.w = pg8::cvt_pk_bf16(v1[2], v1[3]);
                    *(pg8::u32x4*)(rowp + bj * 8 * 512) = w; } }
    }
};

__device__ __forceinline__ int colmap_in(int j) { return j < 1536 ? j : j + 4; }
__device__ __forceinline__ void tr_item_i8(const float* W, const float* gain, const unsigned* cmax, unsigned char* WT, LAS float* scr, int k0, int n0, int lane) {
    const int q = lane & 7, r8 = lane >> 3, sc = colmap_in(n0 + 4 * q);
    f32x4 v[8];
#pragma unroll
    for (int i = 0; i < 8; ++i) v[i] = *(const f32x4*)(W + (size_t)(k0 + 8 * i + r8) * INW + sc);
    f32x4 inv;
#pragma unroll
    for (int e = 0; e < 4; ++e) { const float cm = __builtin_bit_cast(float, cmax[sc + e]); inv[e] = cm > 0.f ? 127.0f / cm : 0.f; }
#pragma unroll
    for (int i = 0; i < 8; ++i) { const float g = gain[k0 + 8 * i + r8];
#pragma unroll
        for (int e = 0; e < 4; ++e) scr[(8 * i + r8) * 33 + 4 * q + e] = v[i][e] * g * inv[e]; }
    asm volatile("s_waitcnt lgkmcnt(0)" ::: "memory");
    const int n = lane >> 1, hf = lane & 1;
    v4u o[2];
#pragma unroll
    for (int w = 0; w < 8; ++w) { unsigned pk = 0;
#pragma unroll
        for (int b = 0; b < 4; ++b) pk |= ((unsigned)((int)rintf(scr[(32 * hf + 4 * w + b) * 33 + n]) & 255)) << (8 * b);
        o[w >> 2][w & 3] = pk; }
    unsigned char* dst = WT + (size_t)(n0 + n) * D + k0 + 32 * hf;
    *(v4u*)dst = o[0]; *(v4u*)(dst + 16) = o[1];
    asm volatile("s_waitcnt lgkmcnt(0)" ::: "memory");
}
template <bool MAP>
__device__ __forceinline__ void tr_item(const float* W, int ldw, const float* scale, bf16* WT, int ldt, int dcol0, LAS float* scr, int k0, int n0, int lane) {
    const int q = lane & 7, r8 = lane >> 3, sc = MAP ? colmap_in(n0 + 4 * q) : (n0 + 4 * q);
    f32x4 v[8];
#pragma unroll
    for (int i = 0; i < 8; ++i) v[i] = *(const f32x4*)(W + (size_t)(k0 + 8 * i + r8) * ldw + sc);
    f32x4 s0 = {1.f, 1.f, 1.f, 1.f}, s1 = s0;
    if (scale) { s0 = *(const f32x4*)(scale + k0 + 8 * q); s1 = *(const f32x4*)(scale + k0 + 8 * q + 4); }
#pragma unroll
    for (int i = 0; i < 8; ++i)
#pragma unroll
        for (int e = 0; e < 4; ++e) scr[(8 * i + r8) * 33 + 4 * q + e] = v[i][e];
    asm volatile("s_waitcnt lgkmcnt(0)" ::: "memory");
    const int c = q;
#pragma unroll
    for (int j = 0; j < 4; ++j) { const int n = r8 + 8 * j; const LAS float* s = scr + (8 * c) * 33 + n;
        v4u o; o.x = pk2(s[0 * 33] * s0[0], s[1 * 33] * s0[1]); o.y = pk2(s[2 * 33] * s0[2], s[3 * 33] * s0[3]); o.z = pk2(s[4 * 33] * s1[0], s[5 * 33] * s1[1]); o.w = pk2(s[6 * 33] * s1[2], s[7 * 33] * s1[3]);
        *(v4u*)(WT + (size_t)(n0 + n) * ldt + dcol0 + k0 + 8 * c) = o; }
    asm volatile("s_waitcnt lgkmcnt(0)" ::: "memory");
}
constexpr size_t WS_BAR = 512 * 1024;
#define XB_TMO      128
#define XB_XCNT(j)  (256  + 64 * (j))
#define XB_XSUB(j)  (1280 + 64 * (j))
#define XB_XGEN(j)  (2304 + 64 * (j))
#define XB_TOP      3328
#define XB_TOPGEN   3392
#define XCD_BAR_WORDS 3456
#define XB_SPIN_CAP (1u << 23)
__device__ __forceinline__ unsigned xb_ld(unsigned* p)              { return __hip_atomic_load(p, __ATOMIC_RELAXED, __HIP_MEMORY_SCOPE_AGENT); }
__device__ __forceinline__ unsigned xb_add(unsigned* p, unsigned v) { return __hip_atomic_fetch_add(p, v, __ATOMIC_RELAXED, __HIP_MEMORY_SCOPE_AGENT); }
__device__ __forceinline__ unsigned xb_xcc_id() { return (unsigned)__builtin_amdgcn_s_getreg((3 << 11) | 20) & 0xFu; }
#define XB_SPIN(cond, bar) do { unsigned _sp = 0; while (cond) { __builtin_amdgcn_s_sleep(1); \
    if ((++_sp & 255u) == 0u) { if (xb_ld(&(bar)[XB_TMO])) break; if (_sp > XB_SPIN_CAP) { atomicAdd(&(bar)[XB_TMO], 1u); break; } } } } while (0)
__device__ __forceinline__ void xcd_barrier_complete(unsigned* bar, unsigned x, unsigned G, unsigned& nloc, unsigned& nx) {
    unsigned sum, cnt, mine, sp = 0u;
    for (;;) {
        sum = 0u; cnt = 0u; mine = 0u;
#pragma unroll
        for (unsigned j = 0; j < 16; ++j) { const unsigned c = xb_ld(&bar[XB_XCNT(j)]); sum += c; cnt += (c > 0u) ? 1u : 0u; mine = (j == x) ? c : mine; }
        if (sum == G) break;
        __builtin_amdgcn_s_sleep(1);
        if ((++sp & 255u) == 0u) { if (xb_ld(&bar[XB_TMO])) break; if (sp > XB_SPIN_CAP) { atomicAdd(&bar[XB_TMO], 1u); break; } }
    }
    nloc = mine > 0u ? mine : 1u; nx = cnt > 0u ? cnt : 1u;
}
__device__ __forceinline__ void xcd_barrier(unsigned* bar, unsigned x, unsigned G, volatile LAS unsigned* st, int wave) {
    asm volatile("s_waitcnt vmcnt(0)" ::: "memory");
    __syncthreads();
    int lane; asm volatile("v_mbcnt_lo_u32_b32 %0, -1, 0\n\tv_mbcnt_hi_u32_b32 %0, -1, %0" : "=v"(lane));
    if (wave == 0 && lane == 0) {
        __builtin_amdgcn_s_waitcnt(0);
        unsigned nloc = st[0], nx = st[1];
        if (nloc == 0u) { xcd_barrier_complete(bar, x, G, nloc, nx); st[0] = nloc; st[1] = nx; }
        const unsigned old = xb_add(&bar[XB_XSUB(x)], 1u);
        const unsigned gen = old / nloc;
        if (old + 1u == (gen + 1u) * nloc) {
            __builtin_amdgcn_fence(__ATOMIC_RELEASE, "agent");
            asm volatile("s_waitcnt vmcnt(0)" ::: "memory");
            const unsigned og = xb_add(&bar[XB_TOP], 1u);
            const unsigned tg = og / nx;
            if (og + 1u == (tg + 1u) * nx) xb_add(&bar[XB_TOPGEN], 1u);
            else XB_SPIN(xb_ld(&bar[XB_TOPGEN]) == tg, bar);
            __builtin_amdgcn_fence(__ATOMIC_ACQUIRE, "agent");
            xb_add(&bar[XB_XGEN(x)], 1u);
            asm volatile("s_waitcnt vmcnt(0)" ::: "memory");
        } else {
            XB_SPIN(xb_ld(&bar[XB_XGEN(x)]) == gen, bar);
            __builtin_amdgcn_fence(__ATOMIC_ACQUIRE, "agent");
            asm volatile("s_waitcnt vmcnt(0)" ::: "memory");
        }
    }
    __syncthreads();
}
namespace att {
constexpr int D = 128, NW = 8, QBLK = 32, KVBLK = 64, QB = NW * QBLK;
constexpr int PITCH = 512, OPITCH = 2048;
constexpr float SCALE = 0.08838834764831845f, THR = 8.f;
constexpr int SHM_V = KVBLK * D * 2, SHM_K = KVBLK * D * 2;
constexpr int OFF_WS = 2 * SHM_V + 2 * SHM_K, OFF_CUM = OFF_WS + NW * 64 * 4, OFF_REL = OFF_CUM + 2048 * 4, LDS_END = OFF_REL + 320 * 4;
typedef unsigned short bf16;
typedef short bf16x8 __attribute__((ext_vector_type(8)));
typedef short s16x4 __attribute__((ext_vector_type(4)));
typedef float f32x16 __attribute__((ext_vector_type(16)));
typedef float f32x4 __attribute__((ext_vector_type(4)));
typedef unsigned u32x4 __attribute__((ext_vector_type(4)));
#define ALDS __attribute__((address_space(3)))

#define KSWZ(row, colB) ((row) * 256 + ((colB) ^ (((row) & 7) << 4)))
#define SBAR() __builtin_amdgcn_sched_barrier(0)
__device__ __forceinline__ int v_st(int k, int c) { const int kk = (k & ~0xC) | ((k & 4) << 1) | ((k & 8) >> 1); return ((kk >> 3) * 4 + (c >> 5)) * 512 + ((kk & 7) * 32 + (c & 31)) * 2; }
__device__ __forceinline__ int v_rd_base(int lane) { return ((lane & 3) << 3) | (((lane >> 2) & 3) << 6) | (((lane >> 4) & 1) << 5) | (((lane >> 5) & 1) << 8); }
constexpr int v_rd_off(int d0, int ks, int half) { return d0 * 512 + ks * 4096 + half * 2048; }
__device__ __forceinline__ int crow(int r, int hi) { return (r & 3) + 8 * (r >> 2) + 4 * hi; }
__device__ __forceinline__ unsigned cvtpk(float lo, float hi) { unsigned r; asm volatile("v_cvt_pk_bf16_f32 %0, %1, %2" : "=v"(r) : "v"(lo), "v"(hi)); return r; }
__device__ __forceinline__ bf16x8 load8(const bf16* p) { return *reinterpret_cast<const bf16x8*>(p); }

__device__ __forceinline__ void mask_tile(f32x16& p0, f32x16& p1, int dq) {
    const float NEG = -__builtin_inff();
#pragma unroll
    for (int r = 0; r < 16; ++r) { const int c = (r & 3) + 8 * (r >> 2);
        if (dq - c < 0) p0[r] = NEG;
        if (dq - c - 32 < 0) p1[r] = NEG; }
}
__device__ __forceinline__ void partialSM(f32x16& p0, f32x16& p1, float& m_reg, float& mn, float& alpha) {
    float pmax = p0[0];
#pragma unroll
    for (int r = 1; r < 16; ++r) pmax = fmaxf(pmax, p0[r]);
#pragma unroll
    for (int r = 0; r < 16; ++r) pmax = fmaxf(pmax, p1[r]);
    { auto rr = __builtin_amdgcn_permlane32_swap(__float_as_uint(pmax), __float_as_uint(pmax), false, false);
      pmax = fmaxf(__uint_as_float(rr[0]), __uint_as_float(rr[1])); }
    constexpr float C2 = 1.4426950408889634f * SCALE;
    if (__builtin_expect(__all((pmax - m_reg) * SCALE <= THR), 1)) { mn = m_reg; alpha = 1.f; }
    else { mn = fmaxf(m_reg, pmax); alpha = __builtin_amdgcn_exp2f((m_reg - mn) * C2); m_reg = mn; }
    const float mnL = -mn * C2;
#pragma unroll
    for (int r = 0; r < 16; ++r) p0[r] = fmaf(p0[r], C2, mnL);
#pragma unroll
    for (int r = 0; r < 16; ++r) p1[r] = fmaf(p1[r], C2, mnL);
#pragma unroll
    for (int r = 0; r < 16; ++r) p0[r] = __builtin_amdgcn_exp2f(p0[r]);
}
__device__ __forceinline__ void finishSM(f32x16& p0, f32x16& p1, float alpha, float& l_reg, bf16x8& pa0, bf16x8& pa1, bf16x8& pa2, bf16x8& pa3) {
#pragma unroll
    for (int r = 0; r < 16; ++r) p1[r] = __builtin_amdgcn_exp2f(p1[r]);
    float ps = 0;
#pragma unroll
    for (int r = 0; r < 16; ++r) ps += p0[r];
#pragma unroll
    for (int r = 0; r < 16; ++r) ps += p1[r];
    { auto rr = __builtin_amdgcn_permlane32_swap(__float_as_uint(ps), __float_as_uint(ps), false, false);
      ps = __uint_as_float(rr[0]) + __uint_as_float(rr[1]); }
    l_reg = l_reg * alpha + ps;
#define PK4(P, B_, OUT) do { unsigned a0 = cvtpk(P[B_+0], P[B_+1]), a1 = cvtpk(P[B_+2], P[B_+3]);                          \
        unsigned b0 = cvtpk(P[B_+4], P[B_+5]), b1 = cvtpk(P[B_+6], P[B_+7]);                                             \
        auto r0 = __builtin_amdgcn_permlane32_swap(a0, b0, false, false); auto r1 = __builtin_amdgcn_permlane32_swap(a1, b1, false, false); \
        u32x4 w = {r0[0], r1[0], r0[1], r1[1]}; OUT = *reinterpret_cast<bf16x8*>(&w); } while (0)
    PK4(p0, 0, pa0); PK4(p0, 8, pa1); PK4(p1, 0, pa2); PK4(p1, 8, pa3);
#undef PK4
}
template <int KB>
__device__ __forceinline__ void qkt(f32x16& p0, f32x16& p1, const ALDS char* K_lds, int r32, int hi, const bf16x8* qr, bool act) {
    if (!act) { const float NEG = -__builtin_inff();
#pragma unroll
        for (int r = 0; r < 16; ++r) { p0[r] = NEG; p1[r] = NEG; } return; }
    p0 = f32x16{}; p1 = f32x16{};
    const ALDS char* kb[4];
#pragma unroll
    for (int dd = 0; dd < 4; ++dd) kb[dd] = K_lds + KB * SHM_K + KSWZ(r32, (dd * 16 + hi * 8) * 2);
#pragma unroll
    for (int d0 = 0; d0 < 8; ++d0) { const ALDS char* a = kb[d0 & 3] + (d0 >> 2) * 128;
        bf16x8 b0 = *(const ALDS bf16x8*)(a);
        bf16x8 b1 = *(const ALDS bf16x8*)(a + 32 * 256);
        p0 = __builtin_amdgcn_mfma_f32_32x32x16_bf16(b0, qr[d0], p0, 0, 0, 0);
        p1 = __builtin_amdgcn_mfma_f32_32x32x16_bf16(b1, qr[d0], p1, 0, 0, 0); }
}
template <int VB>
__device__ __forceinline__ void pv_tile(f32x16* o, int vb0, bf16x8 pa0, bf16x8 pa1, bf16x8 pa2, bf16x8 pa3, bool act) {
    if (!act) return;
#define TRRD(dst, off) asm volatile("ds_read_b64_tr_b16 %0, %1 offset:%2" : "=&v"(dst) : "v"(vb0), "i"(off) : "memory")
#define PV_D0(d0) do { s16x4 l0, l1, l2, l3, h0, h1, h2, h3; constexpr int b_ = VB * SHM_V + v_rd_off(d0, 0, 0); \
        TRRD(l0, b_); TRRD(h0, b_ + 2048); TRRD(l1, b_ + 4096); TRRD(h1, b_ + 6144); TRRD(l2, b_ + 8192); TRRD(h2, b_ + 10240); TRRD(l3, b_ + 12288); TRRD(h3, b_ + 14336); \
        asm volatile("s_waitcnt lgkmcnt(0)" ::: "memory"); SBAR(); \
        o[d0] = __builtin_amdgcn_mfma_f32_32x32x16_bf16(pa0, (bf16x8){l0[0], l0[1], l0[2], l0[3], h0[0], h0[1], h0[2], h0[3]}, o[d0], 0, 0, 0);   \
        o[d0] = __builtin_amdgcn_mfma_f32_32x32x16_bf16(pa1, (bf16x8){l1[0], l1[1], l1[2], l1[3], h1[0], h1[1], h1[2], h1[3]}, o[d0], 0, 0, 0);   \
        o[d0] = __builtin_amdgcn_mfma_f32_32x32x16_bf16(pa2, (bf16x8){l2[0], l2[1], l2[2], l2[3], h2[0], h2[1], h2[2], h2[3]}, o[d0], 0, 0, 0);   \
        o[d0] = __builtin_amdgcn_mfma_f32_32x32x16_bf16(pa3, (bf16x8){l3[0], l3[1], l3[2], l3[3], h3[0], h3[1], h3[2], h3[3]}, o[d0], 0, 0, 0); } while (0)
    PV_D0(0); PV_D0(1); PV_D0(2); PV_D0(3);
#undef PV_D0
#undef TRRD
}
template <int MODE>
__device__ __forceinline__ void bias_mask(f32x16& p0, f32x16& p1, const ALDS char* lds, int kb, int qlo, int qpos, int hi, float cqs, bool act) {
    if (!act) return;
    if (MODE == 0) {
        const ALDS float* cs = (const ALDS float*)(lds + OFF_CUM) + kb + 4 * hi;
#pragma unroll
        for (int g = 0; g < 4; ++g) { const f32x4 c0 = *(const ALDS f32x4*)(cs + 8 * g), c1 = *(const ALDS f32x4*)(cs + 32 + 8 * g);
#pragma unroll
            for (int e = 0; e < 4; ++e) { p0[4 * g + e] += cqs - c0[e]; p1[4 * g + e] += cqs - c1[e]; } }
        if (kb + KVBLK - 1 > qlo) mask_tile(p0, p1, qpos - 4 * hi - kb);
    } else {
        const ALDS float* tb = (const ALDS float*)(lds + OFF_REL);
        if (qlo - (kb + KVBLK - 1) >= 256) { const float c = tb[319];
#pragma unroll
            for (int r = 0; r < 16; ++r) { p0[r] += c; p1[r] += c; } }
        else { const int d0 = qpos - kb - 4 * hi + 63;
#pragma unroll
            for (int r = 0; r < 16; ++r) { const int c = (r & 3) + 8 * (r >> 2);
                int i0 = d0 - c, i1 = d0 - c - 32; i0 = i0 > 319 ? 319 : i0; i1 = i1 > 319 ? 319 : i1; i1 = i1 < 0 ? 0 : i1; i0 = i0 < 0 ? 0 : i0;
                p0[r] += tb[i0]; p1[r] += tb[i1]; } }
    }
}

struct Seam { bf16x8 qr[8]; bf16x8 st_v0, st_v1, st_k0, st_k1; };
#define VMW() asm volatile("s_waitcnt vmcnt(0)" ::: "memory")
#define BL8(rs, vo, so) __builtin_bit_cast(bf16x8, __builtin_amdgcn_raw_buffer_load_b128(rs, vo, so, 0))
#define SLOAD_H(Kp, Vp, k0) do { S.st_v0 = BL8(rP, kvoff, (Vp) + (k0) * (PITCH * 2)); S.st_v1 = BL8(rP, kvoff, (Vp) + ((k0) + 32) * (PITCH * 2));              \
                         S.st_k0 = BL8(rP, kvoff, (Kp) + (k0) * (PITCH * 2)); S.st_k1 = BL8(rP, kvoff, (Kp) + ((k0) + 32) * (PITCH * 2)); } while (0)
#define SWRITE_HK(bf) do { *(ALDS bf16x8*)(K_lds + (bf) * SHM_K + kws) = S.st_k0; *(ALDS bf16x8*)(K_lds + (bf) * SHM_K + kws + 32 * 256) = S.st_k1; } while (0)
#define SWRITE_HV(bf) do { *(ALDS bf16x8*)(V_lds + (bf) * SHM_V + vst0) = S.st_v0; *(ALDS bf16x8*)(V_lds + (bf) * SHM_V + vst1) = S.st_v1; } while (0)
#define SWRITE_H(bf) do { SWRITE_HV(bf); SWRITE_HK(bf); } while (0)

template <int MODE, bool PART = false>
__device__ __forceinline__ void attn_unit(const bf16* Pb, int Qo, int Kh, int Vh, bf16* Yb, int Oo, int P0, int j_lo, int j_hi, ALDS char* lds, int wid, int lane, float* PO = nullptr, float* PM = nullptr, float* PL = nullptr) {
    const int tid = wid * 64 + lane, r32 = lane & 31, hi = lane >> 5;
    const int NT = j_hi - j_lo;
    const int qlo = P0 + wid * QBLK, qpos = qlo + r32;
    ALDS char* V_lds = lds; ALDS char* K_lds = lds + 2 * SHM_V;
    ALDS float* ws = (ALDS float*)(lds + OFF_WS) + wid * 64; ALDS float* li_l = ws; ALDS float* al_l = ws + 32;
    float m_reg = -1e30f, l_reg = 0; f32x16 o[4] = {};
    const int sr = tid >> 4, sc = (tid & 15) * 8, vst0 = v_st(sr, sc), vst1 = v_st(32 + sr, sc), kws = KSWZ(sr, sc * 2);
    const int vb0 = (int)(unsigned)(size_t)V_lds + v_rd_base(lane);
    Seam S;
    const __amdgpu_buffer_rsrc_t rP = __builtin_amdgcn_make_buffer_rsrc((void*)Pb, 0, 0x7fffffff, 0x00020000);
    const __amdgpu_buffer_rsrc_t rO = __builtin_amdgcn_make_buffer_rsrc((void*)Yb, 0, 0x7fffffff, 0x00020000);
    const int kvoff = (sr * PITCH + sc) * 2;
#define KBASE(t) ((j_lo + (t)) * KVBLK)
#define ACT(t) (MODE == 0 ? (KBASE(t) <= qlo + QBLK - 1) : ((j_lo + (t)) <= (qlo >> 6) && (j_lo + (t)) + 8 >= (qlo >> 6)))
#define RESC(a) do { if (__any((a) < 1.f)) { if (hi == 0) al_l[r32] = (a); asm volatile("s_waitcnt lgkmcnt(0)" ::: "memory");              \
                     for (int d_ = 0; d_ < 4; ++d_) for (int r = 0; r < 16; ++r) o[d_][r] *= al_l[crow(r, hi)]; } } while (0)
#define MASKT(P0_, P1_, t) bias_mask<MODE>(P0_, P1_, lds, KBASE(t), qlo, qpos, hi, cq_, ACT(t))
    {
        const int kb0 = j_lo * KVBLK;
#pragma unroll
        for (int d0 = 0; d0 < 8; ++d0) S.qr[d0] = BL8(rP, (r32 * PITCH + hi * 8) * 2 + d0 * 32, Qo + wid * (QBLK * PITCH * 2));
        SLOAD_H(Kh, Vh, kb0); VMW(); SWRITE_HK(0);
        __syncthreads();
    }
    const float cq_ = MODE == 0 ? ((const ALDS float*)(lds + OFF_CUM))[qpos] : 0.f;
    f32x16 pA0, pA1, pB0, pB1; float mnA, mnB, alA, alB; bf16x8 pa0, pa1, pa2, pa3;
    SWRITE_HV(0); SBAR();
    if (NT > 1) { SLOAD_H(Kh, Vh, KBASE(1)); }
    SBAR(); qkt<0>(pA0, pA1, K_lds, r32, hi, S.qr, ACT(0));
    MASKT(pA0, pA1, 0); partialSM(pA0, pA1, m_reg, mnA, alA);
    if (NT > 1) { VMW(); SWRITE_H(1); }
    __syncthreads();
#define HALF_STEP(PX0, PX1, mnX, alX, PY0, PY1, alY, t, KB, VB, SB) do {                                                      \
        SBAR(); qkt<KB>(PX0, PX1, K_lds, r32, hi, S.qr, ACT(t));                                                              \
        finishSM(PY0, PY1, alY, l_reg, pa0, pa1, pa2, pa3); SBAR();                                                           \
        if ((t) + 1 < NT) { SLOAD_H(Kh, Vh, KBASE((t) + 1)); SBAR(); }                                                        \
        pv_tile<VB>(o, vb0, pa0, pa1, pa2, pa3, ACT((t) - 1)); MASKT(PX0, PX1, (t)); partialSM(PX0, PX1, m_reg, mnX, alX);    \
        __syncthreads();                                                                                                      \
        if ((t) + 1 < NT) { VMW(); SWRITE_H(SB); }                                                                            \
        RESC(alX); __syncthreads(); } while (0)
    for (int t = 1; t + 1 < NT; t += 2) {
        HALF_STEP(pB0, pB1, mnB, alB, pA0, pA1, alA, t, 1, 0, 0);
        HALF_STEP(pA0, pA1, mnA, alA, pB0, pB1, alB, t + 1, 0, 1, 1);
    }
    const bool even = (NT & 1) == 0;
    if (even) { SBAR(); qkt<1>(pB0, pB1, K_lds, r32, hi, S.qr, ACT(NT - 1)); SBAR(); }
    finishSM(pA0, pA1, alA, l_reg, pa0, pa1, pa2, pa3); SBAR();
    pv_tile<0>(o, vb0, pa0, pa1, pa2, pa3, ACT(even ? NT - 2 : NT - 1));
    if (even) { MASKT(pB0, pB1, NT - 1); partialSM(pB0, pB1, m_reg, mnB, alB); __syncthreads(); RESC(alB);
        finishSM(pB0, pB1, alB, l_reg, pa0, pa1, pa2, pa3); SBAR(); pv_tile<1>(o, vb0, pa0, pa1, pa2, pa3, ACT(NT - 1)); }
    SBAR();
    if constexpr (PART) {
        if (hi == 0) { PM[wid * QBLK + r32] = m_reg; PL[wid * QBLK + r32] = l_reg; }
#pragma unroll
        for (int r = 0; r < 16; ++r) { const int orow = wid * QBLK + (r & 3) + 8 * (r >> 2) + 4 * hi;
#pragma unroll
            for (int d0 = 0; d0 < 4; ++d0) PO[orow * D + d0 * 32 + r32] = o[d0][r]; }
    } else {
    if (hi == 0) li_l[r32] = l_reg; asm volatile("s_waitcnt lgkmcnt(0)" ::: "memory");
    float rli[16];
#pragma unroll
    for (int r = 0; r < 16; ++r) rli[r] = __builtin_amdgcn_rcpf(li_l[crow(r, hi)]);
    const int ovoff = (4 * hi * OPITCH + r32) * 2, osoff = Oo + wid * (QBLK * OPITCH * 2);
#pragma unroll
    for (int r = 0; r < 16; ++r) { const int orow = (r & 3) + 8 * (r >> 2);
#pragma unroll
        for (int d0 = 0; d0 < 4; ++d0) { const float v = o[d0][r] * rli[r];
            const float vn = __builtin_bit_cast(float, __builtin_amdgcn_ds_bpermute((lane ^ 1) << 2, __builtin_bit_cast(int, v)));
            if ((r32 & 1) == 0) __builtin_amdgcn_raw_buffer_store_b32(cvtpk(v, vn), rO, ovoff + d0 * 64, osoff + orow * (OPITCH * 2), 0); } }
    }
    __syncthreads();
#undef RESC
#undef KBASE
#undef ACT
#undef MASKT
#undef HALF_STEP
}
#undef BL8
#undef VMW
#undef SLOAD_H
#undef SWRITE_HK
#undef SWRITE_HV
#undef SWRITE_H
#undef KSWZ
#undef SBAR
}
constexpr size_t WS_QCTR = 768 * 1024;
constexpr size_t WS_POOLW = 4 * MiB;
constexpr int N_ATT_UNITS = 256, N_POOL_UNITS = 512, N_CONV_UNITS = 128;

__device__ __forceinline__ void stage_cum(const Args& a, int b, int h, LAS char* lds, int wave, int lane) {
    const float* logf = (const float*)(a.ws + WS_LOGF) + ((size_t)b * SEQ) * 4 + h;
    const int tid = wave * 64 + lane;
    float v[4];
#pragma unroll
    for (int e = 0; e < 4; ++e) v[e] = logf[(size_t)(4 * tid + e) * 4];
    v[1] += v[0]; v[2] += v[1]; v[3] += v[2];
    float incl = v[3];
#pragma unroll
    for (int o = 1; o < 64; o <<= 1) { const float t = shf(incl, lane >= o ? lane - o : lane); if (lane >= o) incl += t; }
    LAS float* wt = (LAS float*)(lds + att::OFF_WS);
    if (lane == 63) wt[wave] = incl;
    __syncthreads();
    float base = incl - v[3];
    for (int w = 0; w < wave; ++w) base += wt[w];
    LAS float* cs = (LAS float*)(lds + att::OFF_CUM);
    const float inv = 1.0f / ATT_SCALE;
    *(LAS f32x4*)(cs + 4 * tid) = (f32x4){(base + v[0]) * inv, (base + v[1]) * inv, (base + v[2]) * inv, (base + v[3]) * inv};
    __syncthreads();
}
constexpr size_t WS_PO = WS_MRG;
constexpr size_t WS_PML = WS_MRG + 16 * MiB;
constexpr size_t WS_ACNT = WS_QCTR + 4096;
struct AttBlk { int mode, qb, part; };
__device__ __forceinline__ void att_sched(int slot, AttBlk& b0, AttBlk& b1) {
    b1.mode = 0; b1.qb = -1; b1.part = 0; b0.mode = 0; b0.part = 0;
    switch (slot) {
        case 0: b0.qb = 7; b0.part = 1; break;   case 1: b0.qb = 7; b0.part = 2; break;
        case 2: b0.qb = 6; b0.part = 1; break;   case 3: b0.qb = 6; b0.part = 2; break;
        case 4: b0.qb = 5; b0.part = 1; b1.qb = 0; break;
        case 5: b0.qb = 5; b0.part = 2; break;
        case 6: b0.qb = 4; break;
        case 7: b0.qb = 3; break;
        case 8: b0.qb = 2; b1.mode = 1; b1.qb = 0; break;
        case 9: b0.qb = 1; b1.mode = 1; b1.qb = 1; break;
        default: b0.mode = 1; b0.qb = 17 - slot; break;
    }
}
__device__ __forceinline__ void combine_pair(const Args& a, int l, int pair, int wave);
__device__ __forceinline__ void attention_block(const Args& a, int l, int bh, AttBlk k, LAS char* lds, int wave) {
    int lane; asm volatile("v_mbcnt_lo_u32_b32 %0, -1, 0\n\tv_mbcnt_hi_u32_b32 %0, -1, %0" : "=v"(lane));
    const bf16* P = (const bf16*)(a.ws + WS_PROJ); bf16* Y = (bf16*)(a.ws + WS_Y);
    const int qb = k.qb, b = bh >> 2, h = bh & 3;
    const size_t row0 = (size_t)b * SEQ; const int P0 = qb * 256;
    if (k.mode == 0) {
        stage_cum(a, b, h, lds, wave, lane);
        const int nt = 4 * qb + 4, q0 = (int)((0 * PROJ_T + (row0 + P0) * MIXW + h * HD) * 2), k0 = (int)((1 * PROJ_T + row0 * MIXW + h * HD) * 2), v0 = (int)((2 * PROJ_T + row0 * MIXW + h * HD) * 2), o0 = (int)(((row0 + P0) * D + h * HD) * 2);
        if (k.part == 0) att::attn_unit<0>(P, q0, k0, v0, Y, o0, P0, 0, nt, lds, wave, lane);
        else { const int pair = (qb - 4) * 16 + bh, hf = k.part - 1;
            float* PO = (float*)(a.ws + WS_PO) + ((size_t)pair * 2 + hf) * 256 * 128; float* PM = (float*)(a.ws + WS_PML) + ((size_t)pair * 2 + hf) * 512;
            att::attn_unit<0, true>(P, q0, k0, v0, Y, o0, P0, hf ? nt / 2 : 0, hf ? nt : nt / 2, lds, wave, lane, PO, PM, PM + 256);
            asm volatile("s_waitcnt vmcnt(0)" ::: "memory"); __syncthreads();
            if (hf == 0) {
                if (wave == 0 && lane == 0) { __builtin_amdgcn_fence(__ATOMIC_RELEASE, "agent"); asm volatile("s_waitcnt vmcnt(0)" ::: "memory");
                    __hip_atomic_fetch_add((unsigned*)(a.ws + WS_ACNT) + l * 64 + pair, 1u, __ATOMIC_RELAXED, __HIP_MEMORY_SCOPE_AGENT); } } }
    } else {
        const int tid = wave * 64 + lane;
        if (tid < 320) ((LAS float*)(lds + att::OFF_REL))[tid] = a.rel_bias[((size_t)l * 4 + h) * 320 + tid] * (1.0f / ATT_SCALE);
        const int jlo = 4 * qb - 8 < 0 ? 0 : 4 * qb - 8;
        att::attn_unit<1>(P, (int)((7 * PROJ_T + (row0 + P0) * MIXW + h * HD) * 2), (int)((8 * PROJ_T + row0 * MIXW + h * HD) * 2), (int)((9 * PROJ_T + row0 * MIXW + h * HD) * 2),
                          Y, (int)(((row0 + P0) * D + 1536 + h * HD) * 2), P0, jlo, 4 * qb + 4, lds, wave, lane);
    }
}
__device__ __forceinline__ void combine_pair(const Args& a, int l, int pair, int wave) {
    int lane; asm volatile("v_mbcnt_lo_u32_b32 %0, -1, 0\n\tv_mbcnt_hi_u32_b32 %0, -1, %0" : "=v"(lane));
    if (wave == 0 && lane == 0) {
        unsigned* c = (unsigned*)(a.ws + WS_ACNT) + l * 64 + pair; unsigned sp = 0;
        while (__hip_atomic_load(c, __ATOMIC_RELAXED, __HIP_MEMORY_SCOPE_AGENT) < 1u && ++sp < (1u << 24)) __builtin_amdgcn_s_sleep(2);
        __builtin_amdgcn_fence(__ATOMIC_ACQUIRE, "agent"); asm volatile("s_waitcnt vmcnt(0)" ::: "memory"); }
    __syncthreads();
    const int qb = 4 + (pair >> 4), bh = pair & 15, b = bh >> 2, h = bh & 3, tid = wave * 64 + lane, row = tid >> 1, c0 = (tid & 1) * 64;
    const float* POA = (const float*)(a.ws + WS_PO) + ((size_t)pair * 2) * 256 * 128 + row * 128 + c0; const float* POB = POA + 256 * 128;
    const float* ML = (const float*)(a.ws + WS_PML) + (size_t)pair * 2 * 512;
    const float mA = ML[row], lA = ML[256 + row], mB = ML[512 + row], lB = ML[768 + row], mm = fmaxf(mA, mB);
    constexpr float C2 = 1.4426950408889634f * ATT_SCALE;
    const float wA = __builtin_amdgcn_exp2f((mA - mm) * C2), wB = __builtin_amdgcn_exp2f((mB - mm) * C2), inv = 1.0f / (lA * wA + lB * wB), fa = wA * inv, fb = wB * inv;
    bf16* Y = (bf16*)(a.ws + WS_Y) + ((size_t)b * SEQ + qb * 256 + row) * D + h * HD + c0;
#pragma unroll
    for (int k = 0; k < 64; k += 8) { const f32x4 a0 = *(const f32x4*)(POA + k), a1 = *(const f32x4*)(POA + k + 4), b0 = *(const f32x4*)(POB + k), b1 = *(const f32x4*)(POB + k + 4);
        v4u o; o.x = pk2(a0[0] * fa + b0[0] * fb, a0[1] * fa + b0[1] * fb); o.y = pk2(a0[2] * fa + b0[2] * fb, a0[3] * fa + b0[3] * fb);
        o.z = pk2(a1[0] * fa + b1[0] * fb, a1[1] * fa + b1[1] * fb); o.w = pk2(a1[2] * fa + b1[2] * fb, a1[3] * fa + b1[3] * fb); *(v4u*)(Y + k) = o; }
    __syncthreads();
}
__device__ __forceinline__ void pool_item(const Args& a, int l, int u, LAS char* lds, int wave) {
    int lane; asm volatile("v_mbcnt_lo_u32_b32 %0, -1, 0\n\tv_mbcnt_hi_u32_b32 %0, -1, %0" : "=v"(lane));
    const int g = u & 3, T0 = (u >> 2) * 64, tid = wave * 64 + lane;
    const bf16* Pin = (const bf16*)(a.ws + WS_PROJ) + 3 * PROJ_T + g * 128;
    typedef short bf16x8 __attribute__((ext_vector_type(8)));
    const int rt = (wave & 3) * 16, db = (wave >> 2) * 64, fr = lane & 15, kg = lane >> 4;
    bf16x8 bfr[4][4]; f32x4 sc[4];
    { const bf16* Wt = (const bf16*)(a.ws + WS_POOLW) + ((size_t)l * 4 + g) * 128 * 128;
#pragma unroll
      for (int ks = 0; ks < 4; ++ks)
#pragma unroll
          for (int nt = 0; nt < 4; ++nt) bfr[ks][nt] = *(const bf16x8*)(Wt + (size_t)(db + nt * 16 + fr) * 128 + ks * 32 + kg * 8);
#pragma unroll
      for (int nt = 0; nt < 4; ++nt) sc[nt] = *(const f32x4*)(a.pool_scale + l * MIXW + g * 128 + db + nt * 16 + kg * 4); }
    {
        const int cp = tid & 63, run = tid >> 6, w = 2 << g, t0 = T0 + run * 8, s0 = t0 & (SEQ - 1);
        const bf16* col = Pin + 2 * cp;
        float lo[23], hi[23];
#pragma unroll
        for (int k = 0; k < 23; ++k) { const int dj = k - 15; const bool ok = s0 + dj >= 0; const unsigned x = *(const unsigned*)(col + (size_t)(ok ? t0 + dj : t0) * MIXW); lo[k] = ok ? bflo(x) : 0.f; hi[k] = ok ? bfhi(x) : 0.f; }
        float s_lo = 0.f, s_hi = 0.f;
#pragma unroll
        for (int j = 1; j < 16; ++j) if (j < w) { s_lo += lo[15 - j]; s_hi += hi[15 - j]; }
#pragma unroll
        for (int i = 0; i < 8; ++i) { s_lo += lo[15 + i]; s_hi += hi[15 + i];
            const int s = s0 + i; const int cnt = s + 1 < w ? s + 1 : w; const float inv = 1.0f / (float)cnt;
            *(LAS unsigned*)(lds + (run * 8 + i) * 272 + 4 * cp) = pk2(s_lo * inv - lo[15 + i], s_hi * inv - hi[15 + i]);
            const float dl = g == 0 ? lo[14 + i] : g == 1 ? lo[12 + i] : g == 2 ? lo[8 + i] : lo[i], dh = g == 0 ? hi[14 + i] : g == 1 ? hi[12 + i] : g == 2 ? hi[8 + i] : hi[i];
            s_lo -= dl; s_hi -= dh; }
    }
    __syncthreads();
    {
        f32x4 acc[4] = {};
#pragma unroll
        for (int ks = 0; ks < 4; ++ks) { const bf16x8 af = *(const LAS bf16x8*)(lds + (rt + fr) * 272 + (ks * 32 + kg * 8) * 2);
#pragma unroll
            for (int nt = 0; nt < 4; ++nt) acc[nt] = __builtin_amdgcn_mfma_f32_16x16x32_bf16(bfr[ks][nt], af, acc[nt], 0, 0, 0); }
        bf16* Y = (bf16*)(a.ws + WS_Y) + (size_t)(T0 + rt + fr) * D + 512 + g * 128;
#pragma unroll
        for (int nt = 0; nt < 4; ++nt) { const int d = db + nt * 16 + kg * 4;
            v2u w; w.x = pk2(acc[nt][0] * sc[nt][0], acc[nt][1] * sc[nt][1]); w.y = pk2(acc[nt][2] * sc[nt][2], acc[nt][3] * sc[nt][3]); *(v2u*)(Y + d) = w; }
    }
    __syncthreads();
}
__device__ __forceinline__ void conv_item(const Args& a, int l, int u, int wave) {
    int lane; asm volatile("v_mbcnt_lo_u32_b32 %0, -1, 0\n\tv_mbcnt_hi_u32_b32 %0, -1, %0" : "=v"(lane));
    const bf16* P = (const bf16*)(a.ws + WS_PROJ); const bf16* Ch = P + 4 * PROJ_T; const bf16* Cb = P + 5 * PROJ_T; const bf16* Cc = P + 6 * PROJ_T;
    const int tid = wave * 64 + lane, c0 = (tid & 63) * 8, t0 = u * 64 + (tid >> 6) * 8, s0 = t0 & (SEQ - 1);
    float wgt[3][8];
#pragma unroll
    for (int j = 0; j < 3; ++j) { const float* w = a.conv_w + ((size_t)l * 3 + j) * MIXW + c0; const f32x4 w0 = *(const f32x4*)w, w1 = *(const f32x4*)(w + 4);
#pragma unroll
        for (int k = 0; k < 4; ++k) { wgt[j][k] = w0[k]; wgt[j][4 + k] = w1[k]; } }
    v4u hv[10], cv[10], bv[8];
#pragma unroll
    for (int k = 0; k < 10; ++k) { const int i = k - 2; const size_t r = (size_t)(s0 + i >= 0 ? t0 + i : t0) * MIXW + c0; hv[k] = *(const v4u*)(Ch + r); cv[k] = *(const v4u*)(Cc + r); }
#pragma unroll
    for (int i = 0; i < 8; ++i) bv[i] = *(const v4u*)(Cb + (size_t)(t0 + i) * MIXW + c0);
    float z2[8], z1[8];
#pragma unroll
    for (int k = 0; k < 8; ++k) { z2[k] = 0.f; z1[k] = 0.f; }
#pragma unroll
    for (int k = 0; k < 10; ++k) { const int i = k - 2; const float msk = s0 + i >= 0 ? 1.f : 0.f;
        float z[8];
        z[0] = bflo(hv[k].x) * bflo(cv[k].x) * msk; z[1] = bfhi(hv[k].x) * bfhi(cv[k].x) * msk; z[2] = bflo(hv[k].y) * bflo(cv[k].y) * msk; z[3] = bfhi(hv[k].y) * bfhi(cv[k].y) * msk;
        z[4] = bflo(hv[k].z) * bflo(cv[k].z) * msk; z[5] = bfhi(hv[k].z) * bfhi(cv[k].z) * msk; z[6] = bflo(hv[k].w) * bflo(cv[k].w) * msk; z[7] = bfhi(hv[k].w) * bfhi(cv[k].w) * msk;
        if (i >= 0) { const v4u b = bv[i]; float o[8];
            const float bb[8] = {bflo(b.x), bfhi(b.x), bflo(b.y), bfhi(b.y), bflo(b.z), bfhi(b.z), bflo(b.w), bfhi(b.w)};
#pragma unroll
            for (int q = 0; q < 8; ++q) o[q] = bb[q] * (wgt[0][q] * z2[q] + wgt[1][q] * z1[q] + wgt[2][q] * z[q]);
            v4u ov; ov.x = pk2(o[0], o[1]); ov.y = pk2(o[2], o[3]); ov.z = pk2(o[4], o[5]); ov.w = pk2(o[6], o[7]);
            *(v4u*)((bf16*)(a.ws + WS_Y) + (size_t)(t0 + i) * D + 1024 + c0) = ov; }
#pragma unroll
        for (int q = 0; q < 8; ++q) { z2[q] = z1[q]; z1[q] = z[q]; }
    }
}
__device__ __forceinline__ void mixers_fast(const Args& a, int lq, LAS char* lds, int wave, int lane, int G, int blk) {
    const int l = lq & 1;
    AttBlk b0, b1; att_sched(blk >> 4, b0, b1); const int bh = blk & 15;
    unsigned* head = (unsigned*)(a.ws + WS_QCTR) + 64 * lq;
    volatile LAS unsigned* slot = (volatile LAS unsigned*)(lds + att::LDS_END);
    unsigned tk = 0;
    for (int stage = 0;; ++stage) {
#if defined(PROBE) && PROBE == 23
        if (stage < 3 && lq >= 2) continue;
#endif
#if defined(PROBE) && (PROBE == 24 || PROBE == 26 || PROBE == 27)
        if (stage >= 3 && lq >= 2) break;
#endif
        if (stage < 2) { AttBlk k = stage ? b1 : b0; if (G != 256) { k.mode = blk >> 7; k.qb = stage ? -1 : 7 - ((blk & 127) >> 4); k.part = 0; }
#if defined(PROBE) && (PROBE == 26 || PROBE == 27)
            if (lq >= 2 && k.mode != (PROBE == 26 ? 1 : 0)) continue;
#endif
            if (k.qb >= 0) attention_block(a, l, bh, k, lds, wave);
            continue; }
        if (stage == 2) { if (G == 256 && b0.part == 2) combine_pair(a, l, (b0.qb - 4) * 16 + bh, wave); continue; }
        if (stage == 3 && wave == 0 && lane == 0) tk = __hip_atomic_fetch_add(head, 1u, __ATOMIC_RELAXED, __HIP_MEMORY_SCOPE_AGENT);
        if (wave == 0 && lane == 0) *slot = tk;
        __syncthreads();
        const unsigned it = *slot;
        __syncthreads();
        if (it >= (unsigned)(N_POOL_UNITS + N_CONV_UNITS)) break;
        if (wave == 0 && lane == 0) tk = __hip_atomic_fetch_add(head, 1u, __ATOMIC_RELAXED, __HIP_MEMORY_SCOPE_AGENT);
        if (it < (unsigned)N_POOL_UNITS) pool_item(a, l, (int)it, lds, wave); else conv_item(a, l, (int)it - N_POOL_UNITS, wave);
    }
}
__device__ __forceinline__ void p0_cmax(const Args& a, int gw, int NGW, int lane) {
    unsigned char* ws = a.ws;
    {
        constexpr int NCC = (INW + 255) / 256;
        for (int it = gw; it < DEPTH * 32 * NCC; it += NGW) { const int l = it / (32 * NCC), r = it % (32 * NCC), kc = r / NCC, cc = r % NCC; const int c0 = cc * 256 + 4 * lane;
            if (c0 + 3 < INW) { const float* W = a.w_in + (size_t)l * D * INW + (size_t)(kc * 64) * INW + c0; const float* g = a.norm_mix + l * D + kc * 64;
                float m0 = 0.f, m1 = 0.f, m2 = 0.f, m3 = 0.f;
#pragma unroll 8
                for (int k = 0; k < 64; ++k) { const f32x4 w = *(const f32x4*)(W + (size_t)k * INW); const float gk = fabsf(g[k]);
                    m0 = fmaxf(m0, fabsf(w[0]) * gk); m1 = fmaxf(m1, fabsf(w[1]) * gk); m2 = fmaxf(m2, fabsf(w[2]) * gk); m3 = fmaxf(m3, fabsf(w[3]) * gk); }
                unsigned* cm = (unsigned*)(ws + WS_CMAX) + l * INW + c0;
                const unsigned u0 = __float_as_uint(m0), u1 = __float_as_uint(m1), u2 = __float_as_uint(m2), u3 = __float_as_uint(m3);
                __hip_atomic_fetch_max(cm + 0, u0, __ATOMIC_RELAXED, __HIP_MEMORY_SCOPE_AGENT); __hip_atomic_fetch_max(cm + 1, u1, __ATOMIC_RELAXED, __HIP_MEMORY_SCOPE_AGENT);
                __hip_atomic_fetch_max(cm + 2, u2, __ATOMIC_RELAXED, __HIP_MEMORY_SCOPE_AGENT); __hip_atomic_fetch_max(cm + 3, u3, __ATOMIC_RELAXED, __HIP_MEMORY_SCOPE_AGENT); } }
    }
}
__device__ __forceinline__ void p0_prologue(const Args& a, LAS unsigned char* lds, int gw, int NGW, int wave, int lane) {
    unsigned char* ws = a.ws;
    LAS float* scr = (LAS float*)(lds + wave * 16384);
    constexpr int I_SQ = (D / 64) * (D / 32), I_BR = (MIXW / 64) * (D / 32);
    constexpr int I_LAYER = 4 * I_BR + 2 * I_SQ;
    for (int it = gw; it < DEPTH * I_LAYER; it += NGW) {
        const int l = it / I_LAYER; int r = it - l * I_LAYER;
        if (r < 4 * I_BR) { const int g = r / I_BR, rr = r % I_BR, kb = rr / (D / 32), nb = rr % (D / 32);
            tr_item<false>(a.w_branch + ((size_t)l * 4 + g) * MIXW * D, D, nullptr, (bf16*)(ws + WS_WBR + l * SQ_BYTES), D, g * MIXW, scr, 64 * kb, 32 * nb, lane); continue; }
        r -= 4 * I_BR;
        if (r < I_SQ) { const int kb = r / (D / 32), nb = r % (D / 32);
            tr_item<false>(a.w_out + (size_t)l * D * D, D, nullptr, (bf16*)(ws + WS_WOUT + l * SQ_BYTES), D, 0, scr, 64 * kb, 32 * nb, lane); continue; }
        r -= I_SQ;
        { const int kb = r / (D / 32), nb = r % (D / 32);
            tr_item<false>(a.peer_wq + (size_t)l * D * D, D, a.norm_ffn + l * D, (bf16*)(ws + WS_WQ + l * SQ_BYTES), D, 0, scr, 64 * kb, 32 * nb, lane); }
    }
    for (int it = gw; it < DEPTH * 4 * 8; it += NGW) { const int lg = it >> 3, r = it & 7;
        tr_item<false>(a.pool_w + (size_t)lg * 128 * 128, 128, nullptr, (bf16*)(ws + WS_POOLW) + (size_t)lg * 128 * 128, 128, 0, scr, 64 * (r >> 2), 32 * (r & 3), lane); }
    {
        constexpr int NR = 2 * DEPTH * PEER_E;
        f32x4 nv[8];
        if (gw < NR) { const int t = gw / (DEPTH * PEER_E), row = gw - t * (DEPTH * PEER_E); const float* src = (t ? a.peer_v : a.peer_u) + (size_t)row * D + 4 * lane;
#pragma unroll
            for (int j = 0; j < 8; ++j) nv[j] = *(const f32x4*)(src + 256 * j); }
        for (int r = gw; r < NR; r += NGW) { const int t = r / (DEPTH * PEER_E), row = r - t * (DEPTH * PEER_E);
            f32x4 v[8]; float am = 0.f;
#pragma unroll
            for (int j = 0; j < 8; ++j) v[j] = nv[j];
            { const int r2 = r + NGW; if (r2 < NR) { const int t2 = r2 / (DEPTH * PEER_E), row2 = r2 - t2 * (DEPTH * PEER_E); const float* src = (t2 ? a.peer_v : a.peer_u) + (size_t)row2 * D + 4 * lane;
#pragma unroll
                for (int j = 0; j < 8; ++j) nv[j] = *(const f32x4*)(src + 256 * j); } }
#pragma unroll
            for (int j = 0; j < 8; ++j) am = fmaxf(am, fmaxf(fmaxf(fabsf(v[j][0]), fabsf(v[j][1])), fmaxf(fabsf(v[j][2]), fabsf(v[j][3]))));
            am = wave_max(am, lane);
            const float inv = am > 0.f ? 127.0f / am : 0.f, off = 0.f;
            unsigned char* dst = ws + (t ? WS_PV : WS_PU) + (size_t)row * D + 4 * lane;
#pragma unroll
            for (int j = 0; j < 8; ++j) { const int q0 = (int)(rintf(v[j][0] * inv) + off), q1 = (int)(rintf(v[j][1] * inv) + off), q2 = (int)(rintf(v[j][2] * inv) + off), q3 = (int)(rintf(v[j][3] * inv) + off);
                *(unsigned*)(dst + 256 * j) = (unsigned)(q0 & 255) | ((unsigned)(q1 & 255) << 8) | ((unsigned)(q2 & 255) << 16) | ((unsigned)(q3 & 255) << 24); }
            if (lane == 0) ((float*)(ws + (t ? WS_SV : WS_SU)))[row] = am * (1.0f / 127.0f); }
    }
    { bf16* pk = (bf16*)(ws + WS_PK); const size_t n8 = (size_t)DEPTH * 8 * 2 * 128 * 128 / 8;
      for (size_t i = (size_t)gw * 64 + lane; i < n8; i += (size_t)NGW * 64) { const size_t ln = i & 63, cs = (i >> 6) & 7, kb = (i >> 9) & 3, lhp = i >> 11; const size_t so = lhp * 16384 + (kb * 32 + (ln & 31)) * 128 + cs * 16 + (ln >> 5) * 8;
          const f32x4 v0 = *(const f32x4*)(a.peer_keys + so), v1 = *(const f32x4*)(a.peer_keys + so + 4);
          v4u o; o.x = pk2(v0[0], v0[1]); o.y = pk2(v0[2], v0[3]); o.z = pk2(v1[0], v1[1]); o.w = pk2(v1[2], v1[3]); *(v4u*)(pk + i * 8) = o; } }
    {
        float* wf = (float*)(ws + WS_WF); float* binr = (float*)(ws + WS_BINR);
        const int gt = gw * 64 + lane, NGT = NGW * 64;
        for (int i = gt; i < DEPTH * 4 * D; i += NGT) { const int l = i / (4 * D), h = (i / D) & 3, k = i % D; wf[i] = a.w_in[(size_t)l * D * INW + (size_t)k * INW + 1536 + h] * a.norm_mix[l * D + k]; }
        for (int i = gt; i < DEPTH * NPROJ; i += NGT) { const int l = i / NPROJ, j = i % NPROJ; binr[i] = a.b_in[l * INW + colmap_in(j)]; }
    }
    {
        unsigned long long* ssq = (unsigned long long*)(ws + WS_SSQ);
        for (int m0 = gw; m0 < M; m0 += 2 * NGW) {
            const int m1 = m0 + NGW; const bool ok1 = m1 < M; const int mr[2] = {m0, ok1 ? m1 : m0};
            f32x4 v[2][8];
#pragma unroll
            for (int r = 0; r < 2; ++r)
#pragma unroll
                for (int j = 0; j < 8; ++j) v[r][j] = *(const f32x4*)(a.x + (size_t)mr[r] * D + j * 256 + lane * 4);
#pragma unroll
            for (int r = 0; r < 2; ++r) { float s = 0.f, am = 0.f;
#pragma unroll
                for (int j = 0; j < 8; ++j) { s += (v[r][j][0] * v[r][j][0] + v[r][j][1] * v[r][j][1]) + (v[r][j][2] * v[r][j][2] + v[r][j][3] * v[r][j][3]);
                    am = fmaxf(am, fmaxf(fmaxf(fabsf(v[r][j][0]), fabsf(v[r][j][1])), fmaxf(fabsf(v[r][j][2]), fabsf(v[r][j][3])))); }
                s = wave_sum(s, lane); am = wave_max(am, lane);
                if (r == 0 || ok1) { const int m = mr[r];
                    if (lane == 0) { ssq[m] = (unsigned long long)((double)s * 4294967296.0); ((float*)(ws + WS_RSA))[m] = rsqrtf(s * (1.0f / D) + EPS) * am * (1.0f / 127.0f); }
                    const float inv = am > 0.f ? 127.0f / am : 0.f; unsigned char* q8 = ws + WS_HB8 + (size_t)m * D + 4 * lane;
#pragma unroll
                    for (int j = 0; j < 8; ++j) *(unsigned*)(q8 + 256 * j) = ((unsigned)((int)rintf(v[r][j][0] * inv) & 255)) | ((unsigned)((int)rintf(v[r][j][1] * inv) & 255) << 8) | ((unsigned)((int)rintf(v[r][j][2] * inv) & 255) << 16) | ((unsigned)((int)rintf(v[r][j][3] * inv) & 255) << 24); } } }
    }
}
__device__ __forceinline__ void p0_win_i8(const Args& a, LAS unsigned char* lds, int gw, int NGW, int wave, int lane) {
    unsigned char* ws = a.ws; LAS float* scr = (LAS float*)(lds + wave * 16384);
    constexpr int I_WIN = (D / 64) * (NPROJ / 32);
    for (int it = gw; it < DEPTH * I_WIN; it += NGW) { const int l = it / I_WIN, r = it % I_WIN, kb = r / (NPROJ / 32), nb = r % (NPROJ / 32);
        tr_item_i8(a.w_in + (size_t)l * D * INW, a.norm_mix + l * D, (const unsigned*)(ws + WS_CMAX) + l * INW, ws + WS_WIN + l * WIN_BYTES, scr, 64 * kb, 32 * nb, lane); }
    float* sw = (float*)(ws + WS_SW); const int gt = gw * 64 + lane, NGT = NGW * 64;
    bf16* swh = (bf16*)(ws + WS_SWH); bf16* bih = (bf16*)(ws + WS_BIH);
    for (int i = gt; i < DEPTH * NPROJ; i += NGT) { const int l = i / NPROJ, j = i % NPROJ; const float s = __builtin_bit_cast(float, ((const unsigned*)(ws + WS_CMAX))[l * INW + colmap_in(j)]) * (1.0f / 127.0f);
        sw[i] = s; swh[i] = (bf16)f2bf(s); bih[i] = (bf16)f2bf(a.b_in[l * INW + colmap_in(j)]); }
}
__device__ __forceinline__ void quant_rows(const Args& a, int l, int gw, int NGW, int lane) {
    unsigned char* ws = a.ws; const bf16* HB = (const bf16*)(ws + WS_HB);
    for (int m0 = gw; m0 < M; m0 += 2 * NGW) {
        const int m1 = m0 + NGW; const bool ok1 = m1 < M; const int mr[2] = {m0, ok1 ? m1 : m0};
        v4u w[2][4];
#pragma unroll
        for (int r = 0; r < 2; ++r)
#pragma unroll
            for (int j = 0; j < 4; ++j) w[r][j] = *(const v4u*)(HB + (size_t)mr[r] * D + j * 512 + lane * 8);
#pragma unroll
        for (int r = 0; r < 2; ++r) { float am = 0.f; float v[4][8];
#pragma unroll
            for (int j = 0; j < 4; ++j) { v[j][0] = bflo(w[r][j].x); v[j][1] = bfhi(w[r][j].x); v[j][2] = bflo(w[r][j].y); v[j][3] = bfhi(w[r][j].y); v[j][4] = bflo(w[r][j].z); v[j][5] = bfhi(w[r][j].z); v[j][6] = bflo(w[r][j].w); v[j][7] = bfhi(w[r][j].w);
#pragma unroll
                for (int e = 0; e < 8; ++e) am = fmaxf(am, fabsf(v[j][e])); }
            am = wave_max(am, lane);
            if (r == 0 || ok1) {
                if (lane == 0) ((float*)(ws + WS_RSA))[mr[r]] = rsqrtf(ssa_to_f(((const unsigned long long*)(ws + WS_SSQ))[(size_t)l * M + mr[r]]) * (1.0f / D) + EPS) * am * (1.0f / 127.0f);
                const float inv = am > 0.f ? 127.0f / am : 0.f; unsigned char* q8 = ws + WS_HB8 + (size_t)mr[r] * D + 8 * lane;
#pragma unroll
                for (int j = 0; j < 4; ++j) { v2u o;
                    o.x = ((unsigned)((int)rintf(v[j][0] * inv) & 255)) | ((unsigned)((int)rintf(v[j][1] * inv) & 255) << 8) | ((unsigned)((int)rintf(v[j][2] * inv) & 255) << 16) | ((unsigned)((int)rintf(v[j][3] * inv) & 255) << 24);
                    o.y = ((unsigned)((int)rintf(v[j][4] * inv) & 255)) | ((unsigned)((int)rintf(v[j][5] * inv) & 255) << 8) | ((unsigned)((int)rintf(v[j][6] * inv) & 255) << 16) | ((unsigned)((int)rintf(v[j][7] * inv) & 255) << 24);
                    *(v2u*)(q8 + 512 * j) = o; } } }
    }
}

__device__ __forceinline__ void forget_logits(const Args& a, int l, int gw, int NGW, int lane) {
    unsigned char* ws = a.ws; const bf16* HB = (const bf16*)(ws + WS_HB); const float* wf = (const float*)(ws + WS_WF) + l * 4 * D; const unsigned long long* ssq = (const unsigned long long*)(ws + WS_SSQ) + l * M;
    float* logf = (float*)(ws + WS_LOGF);
    f32x4 w[4][4][2];
#pragma unroll
    for (int h = 0; h < 4; ++h)
#pragma unroll
        for (int j = 0; j < 4; ++j) { const int k0 = j * 512 + lane * 8; w[h][j][0] = *(const f32x4*)(wf + h * D + k0); w[h][j][1] = *(const f32x4*)(wf + h * D + k0 + 4); }
    float bias[4];
#pragma unroll
    for (int h = 0; h < 4; ++h) bias[h] = a.b_in[l * INW + 1536 + h];
    for (int m0 = gw; m0 < M; m0 += 2 * NGW) {
        const int m1 = m0 + NGW; const bool ok1 = m1 < M; const int mr[2] = {m0, ok1 ? m1 : m0};
        f32x4 x[2][4][2];
#pragma unroll
        for (int r = 0; r < 2; ++r)
#pragma unroll
            for (int j = 0; j < 4; ++j) { const int k0 = j * 512 + lane * 8;
                if (l == 0) { x[r][j][0] = *(const f32x4*)(a.x + (size_t)mr[r] * D + k0); x[r][j][1] = *(const f32x4*)(a.x + (size_t)mr[r] * D + k0 + 4); }
                else { const v4u xv = *(const v4u*)(HB + (size_t)mr[r] * D + k0); x[r][j][0] = (f32x4){bflo(xv.x), bfhi(xv.x), bflo(xv.y), bfhi(xv.y)}; x[r][j][1] = (f32x4){bflo(xv.z), bfhi(xv.z), bflo(xv.w), bfhi(xv.w)}; } }
#pragma unroll
        for (int r = 0; r < 2; ++r) { const float rs = rsqrtf(ssa_to_f(ssq[mr[r]]) * (1.0f / D) + EPS);
#pragma unroll
            for (int h = 0; h < 4; ++h) { f32x4 s4 = {0.f, 0.f, 0.f, 0.f};
#pragma unroll
                for (int j = 0; j < 4; ++j) { s4 += x[r][j][0] * w[h][j][0]; s4 += x[r][j][1] * w[h][j][1]; }
                const float z = wave_sum((s4[0] + s4[1]) + (s4[2] + s4[3]), lane) * rs + bias[h];
                const float ls = fminf(z, 0.f) - __logf(1.0f + __expf(-fabsf(z)));
                if (lane == h && (r == 0 || ok1)) logf[mr[r] * 4 + h] = ls; } }
    }
}
__device__ __forceinline__ float gelu_tanh(float x) { const float u = 1.5957691216057308f * (x + 0.044715f * x * x * x); return x / (1.0f + __expf(-u)); }
constexpr int PEER_TOK = 32;
constexpr int PL_IDX = 0, PL_GATE = PEER_TOK * 128 * 4, PL_TAB = 2 * PEER_TOK * 128 * 4;
__device__ __forceinline__ int f2key(float f) { const int b = __builtin_bit_cast(int, f); return b ^ ((b >> 31) & 0x7fffffff); }
__device__ __forceinline__ float key2f(int k) { return __builtin_bit_cast(float, k ^ ((k >> 31) & 0x7fffffff)); }
#define CE_DESC(x, y) do { const int hi_ = (x) > (y) ? (x) : (y), lo_ = (x) > (y) ? (y) : (x); (x) = hi_; (y) = lo_; } while (0)
__device__ __forceinline__ void sort16_desc(int* v) {
#pragma unroll
    for (int k = 2; k <= 16; k <<= 1)
#pragma unroll
        for (int j = k >> 1; j > 0; j >>= 1)
#pragma unroll
            for (int i = 0; i < 16; ++i) { const int l = i ^ j; if (l > i) { if ((i & k) == 0) CE_DESC(v[i], v[l]); else CE_DESC(v[l], v[i]); } }
}
__device__ __forceinline__ void merge_top16(int* a, const int* b) {
#pragma unroll
    for (int i = 0; i < 16; ++i) a[i] = a[i] > b[15 - i] ? a[i] : b[15 - i];
#pragma unroll
    for (int j = 8; j > 0; j >>= 1)
#pragma unroll
        for (int i = 0; i < 16; ++i) { const int l = i ^ j; if (l > i) CE_DESC(a[i], a[l]); }
}
__device__ __forceinline__ void top16_of_64(int* v) {
    sort16_desc(v); sort16_desc(v + 16); sort16_desc(v + 32); sort16_desc(v + 48);
    merge_top16(v, v + 16); merge_top16(v + 32, v + 48); merge_top16(v, v + 32);
}
constexpr int cand_slot(int i, int j) {
    int n = 0;
    for (int a = 0; a < 16; ++a) for (int b = 0; b < 16; ++b) { if ((a + 1) * (b + 1) <= 16) { if (a == i && b == j) return n; ++n; } }
    return -1;
}
__device__ __forceinline__ void peer_retrieve(const Args& a, int l, int t0, int h, LAS char* lds, int wave) {
    typedef short bf16x8 __attribute__((ext_vector_type(8)));
    typedef float f32x16 __attribute__((ext_vector_type(16)));
    int lane; asm volatile("v_mbcnt_lo_u32_b32 %0, -1, 0\n\tv_mbcnt_hi_u32_b32 %0, -1, %0" : "=v"(lane));
    const int r32 = lane & 31, hi = lane >> 5, hi4 = hi * 4;
    const bf16* Q = (const bf16*)(a.ws + WS_Q) + ((size_t)(t0 >> 5) * 8 + h) * 2 * 8 * 512 + lane * 8;
    const bf16* PK = (const bf16*)(a.ws + WS_PK) + ((size_t)(l * 8 + h) * 2) * 128 * 128 + lane * 8;
    int top[2][16];
#pragma unroll
    for (int p = 0; p < 2; ++p) {
        f32x16 acc[4] = {};
        bf16x8 qf[8];
#pragma unroll
        for (int cs = 0; cs < 8; ++cs) qf[cs] = *(const bf16x8*)(Q + (p * 8 + cs) * 512);
#pragma unroll
        for (int kb = 0; kb < 4; ++kb) { bf16x8 kf[8];
#pragma unroll
            for (int cs = 0; cs < 8; ++cs) kf[cs] = *(const bf16x8*)(PK + (size_t)p * 128 * 128 + ((size_t)kb * 8 + cs) * 512);
#pragma unroll
            for (int cs = 0; cs < 8; ++cs) acc[kb] = __builtin_amdgcn_mfma_f32_32x32x16_bf16(kf[cs], qf[cs], acc[kb], 0, 0, 0); }
        int v[64];
#pragma unroll
        for (int kb = 0; kb < 4; ++kb)
#pragma unroll
            for (int r = 0; r < 16; ++r) { const int c = kb * 32 + (r & 3) + 8 * (r >> 2);
                v[kb * 16 + r] = (f2key(acc[kb][r]) & ~127) | (c | hi4); }
        top16_of_64(v);
        int mine[16], other[16];
#pragma unroll
        for (int i = 0; i < 16; ++i) { auto rr = __builtin_amdgcn_permlane32_swap((unsigned)v[i], (unsigned)v[i], false, false); mine[i] = (int)rr[0]; other[i] = (int)rr[1]; }
        merge_top16(mine, other);
#pragma unroll
        for (int i = 0; i < 16; ++i) top[p][i] = mine[i];
    }
    LAS int* tab = (LAS int*)(lds + PL_TAB) + (wave * 64 + lane) * 32;
    float sA[16], sB[16];
#pragma unroll
    for (int i = 0; i < 16; ++i) { sA[i] = key2f(top[0][i] & ~127); sB[i] = key2f(top[1][i] & ~127); tab[i] = top[0][i] & 127; tab[16 + i] = top[1][i] & 127; }
    int c[64];
#pragma unroll
    for (int n = 0; n < 64; ++n) c[n] = (int)0x80000000;
#pragma unroll
    for (int i = 0; i < 16; ++i)
#pragma unroll
        for (int j = 0; j < 16; ++j) if ((i + 1) * (j + 1) <= 16) c[cand_slot(i, j)] = (f2key(sA[i] + sB[j]) & ~255) | (16 * i + j);
    top16_of_64(c);
    float ex[16]; float sum = 0.f; const float mx = key2f(c[0] & ~255);
#pragma unroll
    for (int w = 0; w < 16; ++w) { ex[w] = __expf(key2f(c[w] & ~255) - mx); sum += ex[w]; }
    const float inv = 1.0f / sum;
    asm volatile("s_waitcnt lgkmcnt(0)" ::: "memory");
    LAS int* oi = (LAS int*)(lds + PL_IDX) + r32 * 128 + h * 16; LAS float* og = (LAS float*)(lds + PL_GATE) + r32 * 128 + h * 16;
#pragma unroll
    for (int w = 0; w < 16; ++w) { const int id = c[w] & 255; const int e = tab[id >> 4] * 128 + tab[16 + (id & 15)];
        if ((w >> 3) == hi) { oi[w] = e; og[w] = ex[w] * inv; } }
}
constexpr size_t WS_IDX = 816 * MiB;
constexpr size_t WS_GATE = 820 * MiB;
constexpr size_t WS_XQ = 824 * MiB;
constexpr size_t WS_SX = 856 * MiB;
constexpr size_t WS_PART = 857 * MiB;
constexpr size_t WS_SUT = 890 * MiB;
constexpr size_t WS_END2 = 1024 * MiB;
#ifndef PEER_NB
#define PEER_NB 8
#endif
constexpr int NSLICE = 8, SLW = D / NSLICE;
__device__ __forceinline__ void peer_publish4(const Args& a, int l, int t0, LAS char* lds, int tl0) {
    static_assert(PEER_TOK / NWAVES == 4, "four tokens per wave");
    int lane; LANE_ID(lane);
    unsigned char* ws = a.ws;
    {   const float* SU = (const float*)(ws + WS_SU) + l * PEER_E; const float* SV = (const float*)(ws + WS_SV) + l * PEER_E;
        int i0[4], i1[4]; float g0[4], g1[4], su0[4], su1[4], sv0[4], sv1[4];
#pragma unroll
        for (int k = 0; k < 4; ++k) { const int tl = tl0 + k; i0[k] = ((const LAS int*)(lds + PL_IDX))[tl * 128 + lane]; i1[k] = ((const LAS int*)(lds + PL_IDX))[tl * 128 + 64 + lane];
            g0[k] = ((const LAS float*)(lds + PL_GATE))[tl * 128 + lane]; g1[k] = ((const LAS float*)(lds + PL_GATE))[tl * 128 + 64 + lane]; }
#pragma unroll
        for (int k = 0; k < 4; ++k) { su0[k] = SU[i0[k]]; su1[k] = SU[i1[k]]; sv0[k] = SV[i0[k]]; sv1[k] = SV[i1[k]]; }
#pragma unroll
        for (int k = 0; k < 4; ++k) { const int t = t0 + k; int* gi = (int*)(ws + WS_IDX) + (size_t)t * 128; float* gg = (float*)(ws + WS_GATE) + (size_t)t * 128; float* gs = (float*)(ws + WS_SUT) + (size_t)t * 128;
            gi[lane] = i0[k]; gi[64 + lane] = i1[k]; gs[lane] = su0[k]; gs[64 + lane] = su1[k]; gg[lane] = g0[k] * sv0[k]; gg[64 + lane] = g1[k] * sv1[k]; }
    }
    const unsigned long long* ssa1 = (const unsigned long long*)(ws + WS_SSA) + l * M;
    const float* gn = a.norm_ffn + l * D;
    f32x4 g[2][4]; v4u hw[4][2][2]; float rs[4];
#pragma unroll
    for (int i = 0; i < 2; ++i)
#pragma unroll
        for (int q = 0; q < 4; ++q) g[i][q] = *(const f32x4*)(gn + 16 * lane + 1024 * i + 4 * q);
#pragma unroll
    for (int k = 0; k < 4; ++k) { const bf16* HB = (const bf16*)(ws + WS_HB) + (size_t)(t0 + k) * D; rs[k] = rsqrtf(ssa_to_f(ssa1[t0 + k]) * (1.0f / D) + EPS);
#pragma unroll
        for (int i = 0; i < 2; ++i) { hw[k][i][0] = *(const v4u*)(HB + 16 * lane + 1024 * i); hw[k][i][1] = *(const v4u*)(HB + 16 * lane + 1024 * i + 8); } }
#pragma unroll
    for (int k = 0; k < 4; ++k) { const int t = t0 + k;
        float xf[32]; float am = 0.f;
#pragma unroll
        for (int i = 0; i < 2; ++i) { const unsigned hq[8] = {hw[k][i][0].x, hw[k][i][0].y, hw[k][i][0].z, hw[k][i][0].w, hw[k][i][1].x, hw[k][i][1].y, hw[k][i][1].z, hw[k][i][1].w};
#pragma unroll
            for (int q = 0; q < 4; ++q) {
                xf[16 * i + 4 * q + 0] = bflo(hq[2 * q]) * rs[k] * g[i][q][0]; xf[16 * i + 4 * q + 1] = bfhi(hq[2 * q]) * rs[k] * g[i][q][1];
                xf[16 * i + 4 * q + 2] = bflo(hq[2 * q + 1]) * rs[k] * g[i][q][2]; xf[16 * i + 4 * q + 3] = bfhi(hq[2 * q + 1]) * rs[k] * g[i][q][3]; } }
#pragma unroll
        for (int e = 0; e < 32; ++e) am = fmaxf(am, fabsf(xf[e]));
        am = wave_max(am, lane);
        const float inv = am > 0.f ? 127.0f / am : 0.f;
        if (lane == 0) ((float*)(ws + WS_SX))[t] = am * (1.0f / 127.0f);
        unsigned char* xq = ws + WS_XQ + (size_t)t * 4096;
#pragma unroll
        for (int i = 0; i < 2; ++i) { v4u ph, pl;
#pragma unroll
            for (int d = 0; d < 4; ++d) { unsigned wh = 0, wl = 0;
#pragma unroll
                for (int b = 0; b < 4; ++b) { const float sv = xf[16 * i + 4 * d + b] * inv, hq = rintf(sv), lq = rintf((sv - hq) * 128.0f);
                    wh |= ((unsigned)((int)hq & 255)) << (8 * b); wl |= ((unsigned)((int)lq & 255)) << (8 * b); }
                ph[d] = wh; pl[d] = wl; }
            *(v4u*)(xq + 16 * lane + 1024 * i) = ph; *(v4u*)(xq + 2048 + 16 * lane + 1024 * i) = pl; } }
}
struct PeerItems { int pos, npop, rank, nloc, wave;
    __device__ __forceinline__ int nblk() const { return (M / PEER_TOK - rank + nloc - 1) / nloc; }
    __device__ __forceinline__ int count() const { return ((NSLICE - pos + npop - 1) / npop) * nblk() * (PEER_TOK / NWAVES); }
    __device__ __forceinline__ void get(int n, int& s, int& t) const { constexpr int per = PEER_TOK / NWAVES; const int k = n % per, r = n / per, nb = nblk();
        s = pos + (r / nb) * npop; t = (rank + (r % nb) * nloc) * PEER_TOK + wave * per + k; } };
__device__ __forceinline__ void peer_u_wave(const Args& a, int l, const PeerItems& it) {
    int lane; LANE_ID(lane);
    unsigned char* ws = a.ws; const int sub = lane & 15, grp = lane >> 4;
    const __amdgpu_buffer_rsrc_t rU = __builtin_amdgcn_make_buffer_rsrc((void*)(ws + WS_PU + (size_t)l * PE_BYTES), 0, 0x7fffffff, 0x00020000);
    const __amdgpu_buffer_rsrc_t rW = __builtin_amdgcn_make_buffer_rsrc((void*)ws, 0, 0x7fffffff, 0x00020000);
    const int N = it.count(); if (N <= 0) return;
    int s, t; it.get(0, s, t);
    int idc[2], idn[2] = {0, 0}; v4u xhc, xlc, xhn = {}, xln = {}; v4u wA[PEER_NB], wB[PEER_NB];
#define PU_META(I0, I1, XH, XL, S_, T_) do { I0 = (int)__builtin_amdgcn_raw_buffer_load_b32(rW, 4 * lane, (int)WS_IDX + (T_) * 512, 0); I1 = (int)__builtin_amdgcn_raw_buffer_load_b32(rW, 4 * lane, (int)WS_IDX + (T_) * 512 + 256, 0); \
        XH = __builtin_amdgcn_raw_buffer_load_b128(rW, 16 * sub, (int)WS_XQ + (T_) * 4096 + SLW * (S_), 0); XL = __builtin_amdgcn_raw_buffer_load_b128(rW, 16 * sub, (int)WS_XQ + (T_) * 4096 + 2048 + SLW * (S_), 0); } while (0)
#define PU_ISSUE(W, ID, Q, S_) do { _Pragma("unroll") for (int j = 0; j < PEER_NB; ++j) { const int e_ = shi(ID[(PEER_NB * (Q) + j) >> 4], 4 * ((PEER_NB * (Q) + j) & 15) + grp); W[j] = __builtin_amdgcn_raw_buffer_load_b128(rU, e_ * D + SLW * (S_) + 16 * sub, 0, 0); } } while (0)
#define PU_COMP(W, Q) do { _Pragma("unroll") for (int j = 0; j < PEER_NB; ++j) { int dh = 0, dl = 0; \
            dh = __builtin_amdgcn_sdot4((int)W[j].x, (int)xhc.x, dh, false); dl = __builtin_amdgcn_sdot4((int)W[j].x, (int)xlc.x, dl, false); \
            dh = __builtin_amdgcn_sdot4((int)W[j].y, (int)xhc.y, dh, false); dl = __builtin_amdgcn_sdot4((int)W[j].y, (int)xlc.y, dl, false); \
            dh = __builtin_amdgcn_sdot4((int)W[j].z, (int)xhc.z, dh, false); dl = __builtin_amdgcn_sdot4((int)W[j].z, (int)xlc.z, dl, false); \
            dh = __builtin_amdgcn_sdot4((int)W[j].w, (int)xhc.w, dh, false); dl = __builtin_amdgcn_sdot4((int)W[j].w, (int)xlc.w, dl, false); \
            float p_ = (float)dh + (float)dl * (1.0f / 128.0f); \
            p_ += DPP_ROR(p_, 8); p_ += DPP_ROR(p_, 4); p_ += DPP_ROR(p_, 2); p_ += DPP_ROR(p_, 1); \
            if (sub == ((PEER_NB * (Q) + j) & 15)) { if ((PEER_NB * (Q) + j) >> 4) acc1 = p_; else acc0 = p_; } __builtin_amdgcn_sched_barrier(0); } } while (0)
    PU_META(idc[0], idc[1], xhc, xlc, s, t); PU_ISSUE(wA, idc, 0, s); PU_ISSUE(wB, idc, 1, s);
    for (int n = 0; n < N; ++n) {
        int sn = s, tn = t; const bool more = n + 1 < N;
        if (more) it.get(n + 1, sn, tn);
        PU_META(idn[0], idn[1], xhn, xln, sn, tn);
        float acc0 = 0.f, acc1 = 0.f;
        __builtin_amdgcn_sched_barrier(0);
#if PEER_NB == 8
        PU_COMP(wA, 0); PU_ISSUE(wA, idc, 2, s); __builtin_amdgcn_sched_barrier(0);
        PU_COMP(wB, 1); PU_ISSUE(wB, idc, 3, s); __builtin_amdgcn_sched_barrier(0);
        PU_COMP(wA, 2); PU_ISSUE(wA, idn, 0, sn); __builtin_amdgcn_sched_barrier(0);
        PU_COMP(wB, 3); PU_ISSUE(wB, idn, 1, sn); __builtin_amdgcn_sched_barrier(0);
#else
        PU_COMP(wA, 0); PU_ISSUE(wA, idn, 0, sn); __builtin_amdgcn_sched_barrier(0);
        PU_COMP(wB, 1); PU_ISSUE(wB, idn, 1, sn); __builtin_amdgcn_sched_barrier(0);
#endif
        __builtin_amdgcn_raw_buffer_store_b32(__builtin_bit_cast(unsigned, acc0), rW, (4 * sub + grp) * 4, (int)WS_PART + (s * M + t) * 512, 0);
        __builtin_amdgcn_raw_buffer_store_b32(__builtin_bit_cast(unsigned, acc1), rW, (4 * sub + grp) * 4 + 256, (int)WS_PART + (s * M + t) * 512, 0);
        s = sn; t = tn; idc[0] = idn[0]; idc[1] = idn[1]; xhc = xhn; xlc = xln;
    }
#undef PU_META
#undef PU_ISSUE
#undef PU_COMP
}
__device__ __forceinline__ void peer_v_wave(const Args& a, int l, const PeerItems& it) {
    int lane; LANE_ID(lane);
    unsigned char* ws = a.ws; const int sub = lane & 15, grp = lane >> 4;
    const __amdgpu_buffer_rsrc_t rV = __builtin_amdgcn_make_buffer_rsrc((void*)(ws + WS_PV + (size_t)l * PE_BYTES), 0, 0x7fffffff, 0x00020000);
    const __amdgpu_buffer_rsrc_t rW = __builtin_amdgcn_make_buffer_rsrc((void*)ws, 0, 0x7fffffff, 0x00020000);
    const int N = it.count(); if (N <= 0) return;
    int s, t; it.get(0, s, t);
    struct Meta { int id[2]; float gate[2], su[2], pa[2], sx; v2u h1; };
    Meta mc, mn; v4u wA[PEER_NB], wB[PEER_NB];
    const int l4 = 4 * lane;
#define WLD(off_s) __builtin_amdgcn_raw_buffer_load_b32(rW, l4, (int)(off_s), 0)
#define PV_META(MM, S_, T_) do { const int r_ = (T_) * 512; MM.id[0] = (int)WLD(WS_IDX + r_); MM.id[1] = (int)WLD(WS_IDX + r_ + 256); \
        MM.gate[0] = __builtin_bit_cast(float, WLD(WS_GATE + r_)); MM.gate[1] = __builtin_bit_cast(float, WLD(WS_GATE + r_ + 256)); MM.su[0] = __builtin_bit_cast(float, WLD(WS_SUT + r_)); MM.su[1] = __builtin_bit_cast(float, WLD(WS_SUT + r_ + 256)); \
        float a0_ = 0.f, a1_ = 0.f; _Pragma("unroll") for (int q = 0; q < NSLICE; ++q) { const int po_ = (int)WS_PART + (q * M + (T_)) * 512; a0_ += __builtin_bit_cast(float, WLD(po_)); a1_ += __builtin_bit_cast(float, WLD(po_ + 256)); } \
        MM.pa[0] = a0_; MM.pa[1] = a1_; MM.sx = ((const float*)(ws + WS_SX))[T_]; \
        MM.h1 = __builtin_amdgcn_raw_buffer_load_b64(rW, (16 * sub + 4 * grp) * 2, (int)WS_HB + ((T_) * D + SLW * (S_)) * 2, 0); } while (0)
#define PV_ISSUE(W, ID, Q, S_) do { _Pragma("unroll") for (int j = 0; j < PEER_NB; ++j) { const int e_ = shi(ID[(PEER_NB * (Q) + j) >> 4], 4 * ((PEER_NB * (Q) + j) & 15) + grp); W[j] = __builtin_amdgcn_raw_buffer_load_b128(rV, e_ * D + SLW * (S_) + 16 * sub, 0, 0); } } while (0)
#define PV_COMP(W, Q) do { _Pragma("unroll") for (int j4 = 0; j4 < PEER_NB; j4 += 4) { \
            unsigned cp_ = 0; _Pragma("unroll") for (int jj = 0; jj < 4; ++jj) { const int i_ = PEER_NB * (Q) + j4 + jj; cp_ |= ((unsigned)shi(c8[i_ >> 4], 4 * (i_ & 15) + grp) & 255u) << (8 * jj); } \
            _Pragma("unroll") for (int d = 0; d < 4; ++d) { const unsigned a_ = W[j4][d], b_ = W[j4 + 1][d], c_ = W[j4 + 2][d], d_ = W[j4 + 3][d]; \
                const unsigned x0_ = __builtin_amdgcn_perm(b_, a_, 0x05010400u), x1_ = __builtin_amdgcn_perm(b_, a_, 0x07030602u), y0_ = __builtin_amdgcn_perm(d_, c_, 0x05010400u), y1_ = __builtin_amdgcn_perm(d_, c_, 0x07030602u); \
                yi[4 * d + 0] = __builtin_amdgcn_sdot4((int)__builtin_amdgcn_perm(y0_, x0_, 0x05040100u), (int)cp_, yi[4 * d + 0], false); \
                yi[4 * d + 1] = __builtin_amdgcn_sdot4((int)__builtin_amdgcn_perm(y0_, x0_, 0x07060302u), (int)cp_, yi[4 * d + 1], false); \
                yi[4 * d + 2] = __builtin_amdgcn_sdot4((int)__builtin_amdgcn_perm(y1_, x1_, 0x05040100u), (int)cp_, yi[4 * d + 2], false); \
                yi[4 * d + 3] = __builtin_amdgcn_sdot4((int)__builtin_amdgcn_perm(y1_, x1_, 0x07060302u), (int)cp_, yi[4 * d + 3], false); } \
            __builtin_amdgcn_sched_barrier(0); } } while (0)
    PV_META(mc, s, t); PV_ISSUE(wA, mc.id, 0, s); PV_ISSUE(wB, mc.id, 1, s);
    for (int n = 0; n < N; ++n) {
        int sn = s, tn = t; const bool more = n + 1 < N;
        if (more) it.get(n + 1, sn, tn);
        PV_META(mn, sn, tn);
        float coef[2];
#pragma unroll
        for (int hf = 0; hf < 2; ++hf) coef[hf] = gelu_tanh(mc.pa[hf] * mc.su[hf] * mc.sx) * mc.gate[hf];
        const float cmax = wave_max(fmaxf(fabsf(coef[0]), fabsf(coef[1])), lane); const float cinv = cmax > 0.f ? 127.0f / cmax : 0.f, cs = cmax * (1.0f / 127.0f);
        const int c8[2] = {(int)rintf(coef[0] * cinv), (int)rintf(coef[1] * cinv)};
        int yi[16];
#pragma unroll
        for (int k = 0; k < 16; ++k) yi[k] = 0;
        __builtin_amdgcn_sched_barrier(0);
#if PEER_NB == 8
        PV_COMP(wA, 0); PV_ISSUE(wA, mc.id, 2, s); __builtin_amdgcn_sched_barrier(0);
        PV_COMP(wB, 1); PV_ISSUE(wB, mc.id, 3, s); __builtin_amdgcn_sched_barrier(0);
        PV_COMP(wA, 2); PV_ISSUE(wA, mn.id, 0, sn); __builtin_amdgcn_sched_barrier(0);
        PV_COMP(wB, 3); PV_ISSUE(wB, mn.id, 1, sn); __builtin_amdgcn_sched_barrier(0);
#else
        PV_COMP(wA, 0); PV_ISSUE(wA, mn.id, 0, sn); __builtin_amdgcn_sched_barrier(0);
        PV_COMP(wB, 1); PV_ISSUE(wB, mn.id, 1, sn); __builtin_amdgcn_sched_barrier(0);
#endif
#pragma unroll
        for (int k = 0; k < 16; ++k) { yi[k] += shi(yi[k], lane ^ 16); yi[k] += shi(yi[k], lane ^ 32); }
        int yq[4];
#pragma unroll
        for (int k = 0; k < 4; ++k) yq[k] = grp == 0 ? yi[k] : grp == 1 ? yi[4 + k] : grp == 2 ? yi[8 + k] : yi[12 + k];
        const f32x4 h2 = {bflo(mc.h1.x) + cs * (float)yq[0], bfhi(mc.h1.x) + cs * (float)yq[1], bflo(mc.h1.y) + cs * (float)yq[2], bfhi(mc.h1.y) + cs * (float)yq[3]};
        v2u hb; hb.x = pk2(h2[0], h2[1]); hb.y = pk2(h2[2], h2[3]);
        __builtin_amdgcn_raw_buffer_store_b64(hb, rW, (16 * sub + 4 * grp) * 2, (int)WS_HB + (t * D + SLW * s) * 2, 0);
        const float sq = wave_sum((h2[0] * h2[0] + h2[1] * h2[1]) + (h2[2] * h2[2] + h2[3] * h2[3]), lane);
        if (lane == 0) atomicAdd((unsigned long long*)(ws + WS_SSQ) + (size_t)(l + 1) * M + t, (unsigned long long)((double)sq * 4294967296.0));
        s = sn; t = tn; mc = mn;
    }
#undef PV_META
#undef WLD
#undef PV_ISSUE
#undef PV_COMP
}
__device__ __forceinline__ void final_norm(const Args& a, int gw, int NGW) {
    int lane; LANE_ID(lane);
    f32x4 g[8];
#pragma unroll
    for (int j = 0; j < 8; ++j) g[j] = *(const f32x4*)(a.norm_final + 4 * lane + 256 * j);
    for (int t0 = gw; t0 < M; t0 += 2 * NGW) { const int t1 = t0 + NGW; const bool ok1 = t1 < M; const int tr[2] = {t0, ok1 ? t1 : t0};
        v2u w[2][8]; float rf[2];
#pragma unroll
        for (int r = 0; r < 2; ++r) { const bf16* HB = (const bf16*)(a.ws + WS_HB) + (size_t)tr[r] * D;
            rf[r] = rsqrtf(ssa_to_f(((const unsigned long long*)(a.ws + WS_SSQ))[(size_t)DEPTH * M + tr[r]]) * (1.0f / D) + EPS);
#pragma unroll
            for (int j = 0; j < 8; ++j) w[r][j] = *(const v2u*)(HB + 4 * lane + 256 * j); }
#pragma unroll
        for (int r = 0; r < 2; ++r) if (r == 0 || ok1) { float* O = a.out + (size_t)tr[r] * D;
#pragma unroll
            for (int j = 0; j < 8; ++j) *(f32x4*)(O + 4 * lane + 256 * j) = (f32x4){bflo(w[r][j].x) * rf[r] * g[j][0], bfhi(w[r][j].x) * rf[r] * g[j][1], bflo(w[r][j].y) * rf[r] * g[j][2], bfhi(w[r][j].y) * rf[r] * g[j][3]}; } }
}

__global__ void __launch_bounds__(NT, 2) mk_fwd(ArgsK a_in) {
    extern __shared__ __attribute__((aligned(16))) unsigned char lds_raw[];
    LAS unsigned char* lds = (LAS unsigned char*)lds_raw;
    cg::grid_group grid = cg::this_grid();
    grid.sync();
    const int wave0 = __builtin_amdgcn_readfirstlane(threadIdx.x >> 6);
    const int G = gridDim.x;
    const CAS ArgsK* ka = (const CAS ArgsK*)__builtin_amdgcn_kernarg_segment_ptr();
    size_t zoff = 0;
#define PHASE_BEGIN() int lane; LANE_ID(lane); int blk = blockIdx.x, Gp = G, wv = wave0; asm volatile("" : "+s"(zoff), "+s"(ka), "+s"(blk), "+s"(Gp), "+s"(wv)); const int wave = wv, gw = blk * NWAVES + wv, NGW = Gp * NWAVES; (void)gw; (void)NGW; const Args a = load_args(ka, zoff); unsigned char* const ws = a.ws; (void)ws
    volatile LAS unsigned* bst = (volatile LAS unsigned*)(lds + RING_BYTES + 1024);
#define GRID_BAR() do { asm volatile("" : "+s"(zoff)); unsigned char* wsb_ = (unsigned char*)ka->ws + zoff; int wvb_ = wave0; asm volatile("" : "+s"(wvb_)); xcd_barrier((unsigned*)(wsb_ + WS_BAR), xb_xcc_id(), (unsigned)G, bst, wvb_); } while (0)
    volatile LAS unsigned* xinfo = bst + 4;
    { PHASE_BEGIN(); if (wave == 0 && lane == 0) { bst[0] = 0u; bst[1] = 0u; xinfo[2] = xb_add((unsigned*)(ws + WS_BAR) + XB_XCNT(xb_xcc_id()), 1u); }
      p0_cmax(a, gw, NGW, lane); }
    GRID_BAR();
    { PHASE_BEGIN(); p0_win_i8(a, lds, gw, NGW, wave, lane); p0_prologue(a, lds, gw, NGW, wave, lane); }
    GRID_BAR();
    {
        PHASE_BEGIN();
        if (wave == 0 && lane == 0) { unsigned* bar = (unsigned*)(ws + WS_BAR); const unsigned x = xb_xcc_id(); unsigned pos = 0, npop = 0, mine = 1;
            for (unsigned j = 0; j < 16; ++j) { const unsigned c = xb_ld(&bar[XB_XCNT(j)]); if (c) { ++npop; if (j < x) ++pos; } if (j == x) mine = c ? c : 1u; }
            xinfo[0] = pos; xinfo[1] = npop ? npop : 1u; xinfo[3] = mine; }
        __syncthreads();
    }
    int depth_rt = DEPTH; asm volatile("" : "+s"(depth_rt));
    for (int lc = 0; lc < depth_rt; ++lc) {
        int l = lc; asm volatile("" : "+s"(l));
        if (l > 0) { { PHASE_BEGIN(); quant_rows(a, l, gw, NGW, lane); } GRID_BAR(); }
        {
            PHASE_BEGIN();
            pg8::Gemm g{(const bf16*)(ws + WS_HB8), (const bf16*)(ws + WS_WIN + l * WIN_BYTES), M, NPROJ, D / 2}; pg8::StaticOrder S; S.init(M, NPROJ, Gp, blk);
            EpiProj E{ws, (const bf16*)(ws + WS_BIH) + l * NPROJ, (const float*)(ws + WS_RSA), (const bf16*)(ws + WS_SWH) + l * NPROJ};
            pg8::gemm_phase<EpiProj, pg8::StaticOrder, true, true>(lds, g, S, E, wave);
            forget_logits(a, l, gw, NGW, lane);
        }
        GRID_BAR();
#if defined(PROBE) && (PROBE == 2 || PROBE == 4)
        { PHASE_BEGIN(); const unsigned char* Gb = ws + WS_G; const bf16* PJ = (const bf16*)(ws + WS_PROJ);
          for (size_t i = (size_t)gw * 64 + lane; i < (size_t)M * D; i += (size_t)NGW * 64) { const size_t t = i / D, d = i % D;
            if (PROBE == 2) a.out[i] = (float)Gb[t * 8192 + d] + 3.0f * (float)Gb[t * 8192 + 2048 + d] + 7.0f * (float)Gb[t * 8192 + 4096 + d] + 13.0f * (float)Gb[t * 8192 + 6144 + d];
            else { float sacc = 0.f; for (int q = 0; q < 10; ++q) if ((d >> 9) == (q & 3)) sacc += (float)(q + 1) * bflo((unsigned)(unsigned short)PJ[(size_t)q * PROJ_T + t * MIXW + (d & 511)]) ; a.out[i] = sacc; } }
          return; }
#endif
        { PHASE_BEGIN(); mixers_fast(a, l, (LAS char*)lds, wave, lane, Gp, blk); }
        GRID_BAR();
#if defined(PROBE) && (PROBE >= 23 && PROBE <= 27)
        { PHASE_BEGIN(); mixers_fast(a, l + 2, (LAS char*)lds, wave, lane, Gp, blk); }
        GRID_BAR();
#endif
#if defined(PROBE) && PROBE == 3
        { PHASE_BEGIN(); const bf16* src = (const bf16*)(ws + WS_Y);
          for (size_t i = (size_t)gw * 64 + lane; i < (size_t)M * D; i += (size_t)NGW * 64) a.out[i] = bflo((unsigned)(unsigned short)src[i]);
          return; }
#endif
        {
            PHASE_BEGIN();
            pg8::Gemm g{(const bf16*)(ws + WS_Y), (const bf16*)(ws + WS_WBR + l * SQ_BYTES), M, D, D}; pg8::StaticOrder S; S.init(M, D, Gp, blk);
            EpiMerge E{(const unsigned char*)(ws + WS_G), (bf16*)(ws + WS_MRG)};
            pg8::gemm_phase<EpiMerge, pg8::StaticOrder, false>(lds, g, S, E, wave);
        }
        GRID_BAR();
#if defined(PROBE) && PROBE == 1
        { PHASE_BEGIN(); const bf16* src = (const bf16*)(ws + WS_MRG);
          for (size_t i = (size_t)gw * 64 + lane; i < (size_t)M * D; i += (size_t)NGW * 64) a.out[i] = bflo((unsigned)(unsigned short)src[i]);
          return; }
#endif
        {
            PHASE_BEGIN();
            pg8::Gemm g{(const bf16*)(ws + WS_MRG), (const bf16*)(ws + WS_WOUT + l * SQ_BYTES), M, D, D}; pg8::StaticOrder S; S.init(M, D, Gp, blk);
            EpiRes E{l == 0 ? a.x : (const float*)nullptr, (bf16*)(ws + WS_HB), (unsigned long long*)(ws + WS_SSA) + l * M};
            pg8::gemm_phase<EpiRes, pg8::StaticOrder, false>(lds, g, S, E, wave);
        }
        GRID_BAR();
        {
            PHASE_BEGIN();
            pg8::Gemm g{(const bf16*)(ws + WS_HB), (const bf16*)(ws + WS_WQ + l * SQ_BYTES), M, D, D}; pg8::StaticOrder S; S.init(M, D, Gp, blk);
            EpiQ E{(bf16*)(ws + WS_Q), (const unsigned long long*)(ws + WS_SSA) + l * M};
            pg8::gemm_phase<EpiQ, pg8::StaticOrder, false>(lds, g, S, E, wave);
        }
        GRID_BAR();
        {
            PHASE_BEGIN(); (void)lane;
#if defined(PROBE) && (PROBE == 10 || PROBE == 11)
            int nrep = 2; asm volatile("" : "+s"(nrep));
            for (int rep = 0; rep < nrep; ++rep)
#endif
            for (int t0 = blk * PEER_TOK; t0 < M; t0 += Gp * PEER_TOK) {
#if defined(PROBE) && PROBE == 11
                if (rep == 0) {
#endif
                peer_retrieve(a, l, t0, wave, (LAS char*)lds, wave);
#if defined(PROBE) && PROBE == 11
                }
#endif
                __syncthreads();
                peer_publish4(a, l, t0 + wave * (PEER_TOK / NWAVES), (LAS char*)lds, wave * (PEER_TOK / NWAVES));
                __syncthreads();
            }
        }
        GRID_BAR();
        {
            PHASE_BEGIN(); (void)lane;
            const int pos = __builtin_amdgcn_readfirstlane((int)xinfo[0]), npop = __builtin_amdgcn_readfirstlane((int)xinfo[1]), rank = __builtin_amdgcn_readfirstlane((int)xinfo[2]), nloc = __builtin_amdgcn_readfirstlane((int)xinfo[3]);
            const PeerItems it{pos, npop, rank, nloc, wave}; peer_u_wave(a, l, it);
        }
        GRID_BAR();
        {
            PHASE_BEGIN(); (void)lane;
            const int pos = __builtin_amdgcn_readfirstlane((int)xinfo[0]), npop = __builtin_amdgcn_readfirstlane((int)xinfo[1]), rank = __builtin_amdgcn_readfirstlane((int)xinfo[2]), nloc = __builtin_amdgcn_readfirstlane((int)xinfo[3]);
            const PeerItems it{pos, npop, rank, nloc, wave}; peer_v_wave(a, l, it);
        }
        GRID_BAR();
    }
    {
        PHASE_BEGIN(); (void)lane;
        final_norm(a, gw, NGW);
    }
}

extern "C" void kernel_launch(void* const* d_in, const int* in_sizes, int n_in, void* d_out, int out_size, void* d_ws, size_t ws_size, hipStream_t stream) {
    static int grid = 0;
    if (grid == 0) {
        int dev = 0, cus = 0, per_cu = 0;
        if (n_in != 16 || out_size != M * D || ws_size < WS_END2) { fprintf(stderr, "kernel_launch: unexpected shapes (n_in %d out %d ws %zu)\n", n_in, out_size, ws_size); grid = -1; return; }
        (void)hipGetDevice(&dev);
        (void)hipDeviceGetAttribute(&cus, hipDeviceAttributeMultiprocessorCount, dev);
        (void)hipFuncSetAttribute((const void*)mk_fwd, hipFuncAttributeMaxDynamicSharedMemorySize, LDS_BYTES);
        (void)hipOccupancyMaxActiveBlocksPerMultiprocessor(&per_cu, (const void*)mk_fwd, NT, LDS_BYTES);
        if (per_cu < 1) { fprintf(stderr, "kernel_launch: occupancy query says %d blocks per CU\n", per_cu); }
        grid = cus;
        if (grid > 256) grid = 256;
    }
    if (grid < 0) return;
    (void)hipMemsetAsync((char*)d_ws + WS_CTL, 0, CTL_ZERO_BYTES, stream);
    ArgsK a{};
    const GAS float** p = (const GAS float**)&a;
    for (int i = 0; i < 16; ++i) p[i] = (const GAS float*)d_in[i];
    a.out = (GAS float*)d_out; a.ws = (GAS unsigned char*)d_ws;
    void* args[] = {&a};
    hipError_t e = hipLaunchCooperativeKernel((const void*)mk_fwd, dim3(grid), dim3(NT), args, LDS_BYTES, stream);
    if (e != hipSuccess) fprintf(stderr, "cooperative launch failed: %s (grid %d)\n", hipGetErrorString(e), grid);
}
```

```cpp
#include <hip/hip_runtime.h>
#include <hip/hip_cooperative_groups.h>
#include <cstdio>
#include <cstdint>
namespace cg = cooperative_groups;
namespace pg8 {
#define PG8_LAS __attribute__((address_space(3)))
typedef unsigned short bf16_t;
typedef short bf16x8 __attribute__((ext_vector_type(8)));
typedef float f32x4 __attribute__((ext_vector_type(4)));
typedef unsigned u32x4 __attribute__((ext_vector_type(4)));
typedef unsigned u32x2 __attribute__((ext_vector_type(2)));
typedef int i32x4 __attribute__((ext_vector_type(4)));
constexpr int BM = 256, BK = 64, HALF = 128, HTB = HALF * BK * 2  , STAGE_BYTES = 8 * HTB, NXCD = 8, WGM = 8;

__host__ __device__ __forceinline__ int lds_byte(int r, int c) { const int st = (r >> 4) * 2 + (c >> 5), rr = r & 15, cc = c & 31, ob = rr * 64 + cc * 2; return st * 1024 + (ob ^ (((ob >> 9) & 1) << 5)); }
__host__ __device__ __forceinline__ void stage_rc(int b, int& R, int& C) { const int st = b / 1024, sb = b % 1024, swz = sb ^ (((sb >> 9) & 1) << 5); R = (st >> 1) * 16 + swz / 64; C = (st & 1) * 32 + (swz % 64) / 2; }
__host__ __device__ __forceinline__ int perm32(int rho) { const int n = rho >> 4, i = rho & 15; return 8 * (i >> 2) + 4 * n + (i & 3); }

struct Unit { int pm, pn; };
struct Gemm { const bf16_t* A; const bf16_t* Bt; int M, N, K; };

struct StaticOrder {
    int nM, nN, nwg, G, c;
    __host__ __device__ void init(int M, int N, int G_, int c_) { nM = M / BM; nN = N / BM; nwg = nM * nN; G = G_; c = c_; }
    __host__ __device__ bool next(int i, Unit& u) const {
        const long L = (long)i * G + c; if (L >= nwg) return false;
        int wgid = (int)L; { const int q = nwg / NXCD, r = nwg % NXCD, xcd = wgid % NXCD, off = wgid / NXCD; wgid = (xcd < r ? xcd * (q + 1) : r * (q + 1) + (xcd - r) * q) + off; }
        const int nig = WGM * nN, gid = wgid / nig, fm = gid * WGM, gsz = (nM - fm) < WGM ? (nM - fm) : WGM;
        u.pm = fm + ((wgid % nig) % gsz); u.pn = (wgid % nig) / gsz; return true;
    }
};

__device__ __forceinline__ unsigned cvt_pk_bf16(float lo, float hi) { unsigned r; asm volatile("v_cvt_pk_bf16_f32 %0, %1, %2" : "=v"(r) : "v"(lo), "v"(hi)); return r; }

template <class Epi, class Sched, bool ALIGN_EPI = false, bool I8 = false>
__device__ __forceinline__ void gemm_phase(PG8_LAS unsigned char* lds, const Gemm g, const Sched& S, const Epi& E, int wid) {
    int lane_; asm volatile("v_mbcnt_lo_u32_b32 %0, -1, 0\n\tv_mbcnt_hi_u32_b32 %0, -1, %0" : "=v"(lane_));
    const int lane = lane_, tid = wid * 64 + lane, wr = wid >> 2, wc = wid & 3, fr = lane & 15, fq = lane >> 4;
    const int K = g.K, nt = K / BK;
    unsigned voffA, voffB;
    { int R, C; stage_rc(tid * 16, R, C); const int Rb = Epi::PERM ? ((R & ~31) + perm32(R & 31)) : R; voffA = (unsigned)(R * K + C) * 2u; voffB = (unsigned)(Rb * K + C) * 2u; }
    const size_t p2step = (size_t)64 * K * 2;
    const size_t kstep = (size_t)(BK * 2);
    const size_t hstep = (size_t)HALF * K * 2;
    const size_t tstep = 2 * hstep;
    const unsigned ldsw = (unsigned)wid * 1024u;
    const int aoff = lds_byte(wr * 64 + fr, fq * 8), boff = lds_byte(wc * 32 + fr, fq * 8);
#define PG8_SA(b, h) (((b) * 2 + (h)) * HTB)
#define PG8_SB(b, h) ((4 + (b) * 2 + (h)) * HTB)
#define PG8_STAGE(bufoff, gbase, voff) do { _Pragma("unroll") for (int _i = 0; _i < 2; ++_i) \
        __builtin_amdgcn_global_load_lds((const unsigned*)((const char*)(gbase) + _i * p2step + (voff)), (PG8_LAS unsigned*)(lds + (bufoff) + ldsw + _i * 8192), 16, 0, 0); } while (0)
#define PG8_LDA(dst, b, h) do { _Pragma("unroll") for (int m = 0; m < 4; ++m) _Pragma("unroll") for (int k = 0; k < 2; ++k) dst[m][k] = *(const PG8_LAS bf16x8*)(lds + PG8_SA(b, h) + aoff + m * 2048 + k * 1024); } while (0)
#define PG8_LDB(dst, b, h) do { _Pragma("unroll") for (int n = 0; n < 2; ++n) _Pragma("unroll") for (int k = 0; k < 2; ++k) dst[n][k] = *(const PG8_LAS bf16x8*)(lds + PG8_SB(b, h) + boff + n * 2048 + k * 1024); } while (0)
#define PG8_MMA(ai, bj, At, Bt) do { __builtin_amdgcn_s_setprio(1); _Pragma("unroll") for (int m = 0; m < 4; ++m) _Pragma("unroll") for (int n = 0; n < 2; ++n) _Pragma("unroll") for (int k = 0; k < 2; ++k) \
        { if constexpr (I8) acc[ai][bj][m][n] = __builtin_bit_cast(f32x4, __builtin_amdgcn_mfma_i32_16x16x64_i8(__builtin_bit_cast(i32x4, Bt[n][k]), __builtin_bit_cast(i32x4, At[m][k]), __builtin_bit_cast(i32x4, acc[ai][bj][m][n]), 0, 0, 0)); \
          else acc[ai][bj][m][n] = __builtin_amdgcn_mfma_f32_16x16x32_bf16(Bt[n][k], At[m][k], acc[ai][bj][m][n], 0, 0, 0); } __builtin_amdgcn_s_setprio(0); } while (0)
#define PG8_WAIT_V(n) asm volatile("s_waitcnt vmcnt(" #n ")" ::: "memory")
#define PG8_WAIT_L(n) asm volatile("s_waitcnt lgkmcnt(" #n ")" ::: "memory")
#define PG8_BAR __builtin_amdgcn_s_barrier()
#define PG8_SCHED __builtin_amdgcn_sched_barrier(0)
    Unit cur, nxt; int ui = 0;
    if (!S.next(0, cur)) return;
    f32x4 acc[2][2][4][2];
#pragma unroll
    for (int a = 0; a < 2; ++a)
#pragma unroll
        for (int b = 0; b < 2; ++b)
#pragma unroll
            for (int m = 0; m < 4; ++m)
#pragma unroll
                for (int n = 0; n < 2; ++n) acc[a][b][m][n] = (f32x4){0.f, 0.f, 0.f, 0.f};
    bf16x8 At[4][2], B0[2][2], B1[2][2];
    typename Epi::Pre pre = {};
    const char* cA = (const char*)g.A + (size_t)cur.pm * tstep; const char* cB = (const char*)g.Bt + (size_t)cur.pn * tstep;
    PG8_STAGE(PG8_SB(0, 0), cB, voffB); PG8_STAGE(PG8_SB(0, 1), cB + hstep, voffB); PG8_STAGE(PG8_SA(0, 0), cA, voffA); PG8_STAGE(PG8_SA(0, 1), cA + hstep, voffA);
    if (wr == 1) PG8_BAR;
    PG8_WAIT_V(2); PG8_BAR;
    PG8_STAGE(PG8_SB(1, 0), cB + kstep, voffB); PG8_STAGE(PG8_SA(1, 0), cA + kstep, voffA); PG8_STAGE(PG8_SB(1, 1), cB + hstep + kstep, voffB);
    PG8_WAIT_V(6); PG8_BAR;
    for (;;) {
        const bool has_next = S.next(ui + 1, nxt);
        const char* nA = has_next ? (const char*)g.A + (size_t)nxt.pm * tstep : cA; const char* nB = has_next ? (const char*)g.Bt + (size_t)nxt.pn * tstep : cB;
        const int seglen = Epi::HOOK ? 8 : nt;
        for (int t0 = 0; t0 < nt; t0 += seglen) {
        if constexpr (Epi::HOOK) { if (t0 > 0) { int ln_; asm volatile("v_mbcnt_lo_u32_b32 %0, -1, 0\n\tv_mbcnt_hi_u32_b32 %0, -1, %0" : "=v"(ln_)); E.hook(acc, cur, t0 >> 3, wr, wc, ln_ & 15, ln_ >> 4); } }
        for (int t = t0; t < t0 + seglen; t += 2) {
            const bool last = (t == nt - 2);
            if constexpr (Epi::PRELOAD) { if (last) { int ln_; asm volatile("v_mbcnt_lo_u32_b32 %0, -1, 0\n\tv_mbcnt_hi_u32_b32 %0, -1, %0" : "=v"(ln_)); E.preload(pre, cur, wr, wc, ln_ & 15, ln_ >> 4); } }
            const char* a1 = cA + (size_t)(t + 1) * kstep;
            const char* a2 = last ? nA : cA + (size_t)(t + 2) * kstep; const char* b2 = last ? nB : cB + (size_t)(t + 2) * kstep;
            const char* a3 = a2 + kstep; const char* b3 = b2 + kstep;
            PG8_LDB(B0, 0, 0); PG8_LDB(B1, 0, 1); PG8_SCHED; PG8_LDA(At, 0, 0); PG8_STAGE(PG8_SA(1, 1), a1 + hstep, voffA);
            PG8_WAIT_V(8); PG8_WAIT_L(0); PG8_BAR; PG8_MMA(0, 0, At, B0); PG8_MMA(0, 1, At, B1); PG8_BAR; PG8_SCHED;
            PG8_LDA(At, 0, 1); PG8_STAGE(PG8_SB(0, 0), b2, voffB); PG8_STAGE(PG8_SB(0, 1), b2 + hstep, voffB); PG8_STAGE(PG8_SA(0, 0), a2, voffA);
            PG8_WAIT_V(8); PG8_WAIT_L(0); PG8_BAR; PG8_MMA(1, 0, At, B0); PG8_MMA(1, 1, At, B1); PG8_BAR; PG8_SCHED;
            PG8_LDB(B0, 1, 0); PG8_LDB(B1, 1, 1); PG8_SCHED; PG8_LDA(At, 1, 0); PG8_STAGE(PG8_SA(0, 1), a2 + hstep, voffA);
            PG8_WAIT_V(8); PG8_WAIT_L(0); PG8_BAR; PG8_MMA(0, 0, At, B0); PG8_MMA(0, 1, At, B1); PG8_BAR; PG8_SCHED;
            PG8_LDA(At, 1, 1); PG8_STAGE(PG8_SB(1, 0), b3, voffB); PG8_STAGE(PG8_SB(1, 1), b3 + hstep, voffB); PG8_STAGE(PG8_SA(1, 0), a3, voffA);
            PG8_WAIT_V(8); PG8_WAIT_L(0); PG8_BAR; PG8_MMA(1, 0, At, B0); PG8_MMA(1, 1, At, B1); PG8_BAR; PG8_SCHED;
        }
        }
        if constexpr (ALIGN_EPI) { if (wr == 0) PG8_BAR; }
        { int ln_; asm volatile("v_mbcnt_lo_u32_b32 %0, -1, 0\n\tv_mbcnt_hi_u32_b32 %0, -1, %0" : "=v"(ln_));
          if constexpr (Epi::PRELOAD) E(acc, cur, wr, wc, ln_ & 15, ln_ >> 4, pre); else E(acc, cur, wr, wc, ln_ & 15, ln_ >> 4); }
        if (!has_next) break;
#pragma unroll
        for (int a = 0; a < 2; ++a)
#pragma unroll
            for (int b = 0; b < 2; ++b)
#pragma unroll
                for (int m = 0; m < 4; ++m)
#pragma unroll
                    for (int n = 0; n < 2; ++n) acc[a][b][m][n] = (f32x4){0.f, 0.f, 0.f, 0.f};
        cur = nxt; cA = nA; cB = nB; ++ui;
        if constexpr (ALIGN_EPI) { if (wr == 1) PG8_BAR; }
    }
    PG8_WAIT_V(0);
    if constexpr (!ALIGN_EPI) { if (wr == 0) PG8_BAR; }
    PG8_BAR;
#undef PG8_SA
#undef PG8_SB
#undef PG8_STAGE
#undef PG8_LDA
#undef PG8_LDB
#undef PG8_MMA
#undef PG8_WAIT_V
#undef PG8_WAIT_L
#undef PG8_BAR
#undef PG8_SCHED
}
}
constexpr int NWAVES = 8, NT = NWAVES * 64;
constexpr int M = 8192, D = 2048, SEQ = 2048, NBATCH = 4, DEPTH = 2;
constexpr int INW = 13316, NPROJ = 13312, MIXW = 512, HD = 128;
constexpr int PEER_E = 16384;
constexpr float EPS = 1e-6f;
constexpr float ATT_SCALE = 0.08838834764831845f;

constexpr size_t MiB = 1u << 20;
constexpr size_t WS_CTL = 0, CTL_ZERO_BYTES = 1 * MiB;
constexpr size_t WS_SSQ = 0;
constexpr size_t WS_SSA = 256 * 1024;
constexpr size_t WS_WF = 1 * MiB;
constexpr size_t WS_BINR = WS_WF + 64 * 1024;
constexpr size_t WS_LOGF = 2 * MiB;
constexpr size_t WS_CUM = 3 * MiB;
constexpr size_t WS_WIN = 8 * MiB;
constexpr size_t WIN_BYTES = (size_t)NPROJ * D;
constexpr size_t WS_SW = 7 * MiB;
constexpr size_t WS_CMAX = 384 * 1024;
constexpr size_t WS_HB8 = 64 * MiB;
constexpr size_t WS_SA = 7 * MiB + 512 * 1024;
constexpr size_t WS_WBR = 112 * MiB, WS_WOUT = 128 * MiB, WS_WQ = 144 * MiB;
constexpr size_t SQ_BYTES = (size_t)D * D * 2;
constexpr size_t WS_PU = 160 * MiB, WS_PV = 288 * MiB;
constexpr size_t PE_BYTES = (size_t)PEER_E * D;
constexpr size_t WS_PK = 6 * MiB;
constexpr size_t WS_SU = 5 * MiB, WS_SV = 5 * MiB + 256 * 1024;
constexpr size_t WS_HB = 480 * MiB;
constexpr size_t WS_PROJ = 512 * MiB;
constexpr size_t PROJ_T = (size_t)M * MIXW;
constexpr size_t WS_R = 592 * MiB;
constexpr size_t R_PLANE = (size_t)M * D;
constexpr size_t WS_Y = 720 * MiB;
constexpr size_t WS_MRG = 752 * MiB;
constexpr size_t WS_Q = 784 * MiB;
constexpr size_t WS_END = 816 * MiB;

constexpr int RING_BYTES = 131072;
constexpr int LDS_BYTES = 147456;

typedef unsigned short bf16;
typedef unsigned v4u __attribute__((ext_vector_type(4)));
typedef unsigned v2u __attribute__((ext_vector_type(2)));
typedef float f32x4 __attribute__((ext_vector_type(4)));
typedef float f32x2 __attribute__((ext_vector_type(2)));
using bf16x2 = __attribute__((ext_vector_type(2))) __bf16;
#define LAS __attribute__((address_space(3)))

__device__ __forceinline__ unsigned f2bf(float f) { unsigned u = __builtin_bit_cast(unsigned, f); return (u + 0x7fffu + ((u >> 16) & 1u)) >> 16; }
__device__ __forceinline__ unsigned pk2(float lo, float hi) { return f2bf(lo) | (f2bf(hi) << 16); }
__device__ __forceinline__ float bflo(unsigned w) { return __builtin_bit_cast(float, w << 16); }
__device__ __forceinline__ float bfhi(unsigned w) { return __builtin_bit_cast(float, w & 0xffff0000u); }
__device__ __forceinline__ float bf2f(bf16 b) { return __builtin_bit_cast(float, ((unsigned)b) << 16); }
__device__ __forceinline__ float shf(float v, int src) { return __builtin_bit_cast(float, __builtin_amdgcn_ds_bpermute(src << 2, __builtin_bit_cast(int, v))); }
__device__ __forceinline__ int shi(int v, int src) { return __builtin_amdgcn_ds_bpermute(src << 2, v); }
#define DPP_ROR(x, n) __builtin_bit_cast(float, __builtin_amdgcn_update_dpp(0, __builtin_bit_cast(int, (x)), 0x120 + (n), 0xf, 0xf, false))
__device__ __forceinline__ float wave_sum(float v, int) {
    v += DPP_ROR(v, 8); v += DPP_ROR(v, 4); v += DPP_ROR(v, 2); v += DPP_ROR(v, 1);
    const int vi = __builtin_bit_cast(int, v);
    const float r0 = __builtin_bit_cast(float, __builtin_amdgcn_readlane(vi, 0)), r1 = __builtin_bit_cast(float, __builtin_amdgcn_readlane(vi, 16)),
                r2 = __builtin_bit_cast(float, __builtin_amdgcn_readlane(vi, 32)), r3 = __builtin_bit_cast(float, __builtin_amdgcn_readlane(vi, 48));
    return (r0 + r1) + (r2 + r3);
}
__device__ __forceinline__ float wave_max(float v, int) {
    v = fmaxf(v, DPP_ROR(v, 8)); v = fmaxf(v, DPP_ROR(v, 4)); v = fmaxf(v, DPP_ROR(v, 2)); v = fmaxf(v, DPP_ROR(v, 1));
    const int vi = __builtin_bit_cast(int, v);
    const float r0 = __builtin_bit_cast(float, __builtin_amdgcn_readlane(vi, 0)), r1 = __builtin_bit_cast(float, __builtin_amdgcn_readlane(vi, 16)),
                r2 = __builtin_bit_cast(float, __builtin_amdgcn_readlane(vi, 32)), r3 = __builtin_bit_cast(float, __builtin_amdgcn_readlane(vi, 48));
    return fmaxf(fmaxf(r0, r1), fmaxf(r2, r3));
}
__device__ __forceinline__ float ssa_to_f(unsigned long long v) { return (float)((double)v * (1.0 / 4294967296.0)); }
__device__ __forceinline__ float dot2_bf16(unsigned w, unsigned x, float acc) { return __builtin_amdgcn_fdot2_f32_bf16(__builtin_bit_cast(bf16x2, w), __builtin_bit_cast(bf16x2, x), acc, false); }

#define LANE_ID(x) asm volatile("v_mbcnt_lo_u32_b32 %0, -1, 0\n\tv_mbcnt_hi_u32_b32 %0, -1, %0" : "=v"(x))
struct Args {
    const float *x, *norm_mix, *w_in, *b_in, *pool_w, *pool_scale, *conv_w, *rel_bias, *w_branch, *w_out, *norm_ffn, *peer_wq, *peer_keys, *peer_u, *peer_v, *norm_final;
    float* out; unsigned char* ws;
};
#define GAS __attribute__((address_space(1)))
#define CAS __attribute__((address_space(4)))
struct ArgsK {
    const GAS float *x, *norm_mix, *w_in, *b_in, *pool_w, *pool_scale, *conv_w, *rel_bias, *w_branch, *w_out, *norm_ffn, *peer_wq, *peer_keys, *peer_u, *peer_v, *norm_final;
    GAS float* out; GAS unsigned char* ws;
};
__device__ __forceinline__ Args load_args(const CAS ArgsK* k, size_t zoff) {
    Args a;
    a.x = (const float*)k->x; a.norm_mix = (const float*)k->norm_mix; a.w_in = (const float*)k->w_in; a.b_in = (const float*)k->b_in; a.pool_w = (const float*)k->pool_w;
    a.pool_scale = (const float*)k->pool_scale; a.conv_w = (const float*)k->conv_w; a.rel_bias = (const float*)k->rel_bias; a.w_branch = (const float*)k->w_branch;
    a.w_out = (const float*)k->w_out; a.norm_ffn = (const float*)k->norm_ffn; a.peer_wq = (const float*)k->peer_wq; a.peer_keys = (const float*)k->peer_keys;
    a.peer_u = (const float*)k->peer_u; a.peer_v = (const float*)k->peer_v; a.norm_final = (const float*)k->norm_final; a.out = (float*)k->out; a.ws = (unsigned char*)(k->ws + zoff);
    return a;
}

using pg8::f32x4; using pg8::Unit;
constexpr size_t WS_G = 896 * MiB;
constexpr size_t WS_SWH = 7 * MiB + 256 * 1024, WS_BIH = 7 * MiB + 384 * 1024;
constexpr size_t WS_RSA = 7 * MiB + 768 * 1024;
struct EpiProj {
    static constexpr bool PERM = true, HOOK = false, PRELOAD = true;
    struct Pre { pg8::u32x4 sw[2], bi[2]; float rs[2][4]; };
    unsigned char* wsb; const bf16* biash; const float* rsa; const bf16* swh;
    __device__ __forceinline__ void preload(Pre& p, const Unit& u, int wr, int wc, int fr, int fq) const {
        const int row0 = u.pm * 256 + wr * 64 + fr, bcol0 = u.pn * 256 + wc * 32 + 8 * fq;
#pragma unroll
        for (int bj = 0; bj < 2; ++bj) { p.sw[bj] = *(const pg8::u32x4*)(swh + bcol0 + bj * 128); p.bi[bj] = *(const pg8::u32x4*)(biash + bcol0 + bj * 128); }
#pragma unroll
        for (int ai = 0; ai < 2; ++ai)
#pragma unroll
            for (int m = 0; m < 4; ++m) p.rs[ai][m] = rsa[row0 + ai * 128 + m * 16];
    }
    static __device__ __forceinline__ unsigned g8(float z) { const float t = __builtin_amdgcn_rcpf(__builtin_amdgcn_exp2f(__builtin_fmaf(z, -1.4426950408889634f, -8.0f)) + 0.00390625f);
        return (unsigned)(__builtin_amdgcn_fmed3f(t, 1.0f, 255.0f) + 0.5f); }
    static __device__ __forceinline__ unsigned g8x4(const f32x4& v) { return g8(v[0]) | (g8(v[1]) << 8) | (g8(v[2]) << 16) | (g8(v[3]) << 24); }
    __device__ __forceinline__ void operator()(f32x4 (&acc)[2][2][4][2], const Unit& u, int wr, int wc, int fr, int fq, const Pre& p) const {
        const int cl0 = wc * 32 + 8 * fq;
#define ACCF(ai, bj, m, n) __builtin_convertvector(__builtin_bit_cast(pg8::i32x4, acc[ai][bj][m][n]), f32x4)
        const __amdgpu_buffer_rsrc_t rW = __builtin_amdgcn_make_buffer_rsrc((void*)wsb, 0, 0x7fffffff, 0x00020000);
        int sbase, ldb, voff;
        if (u.pn < 20) { sbase = (int)WS_PROJ + ((u.pn >> 1) * (int)PROJ_T + (u.pn & 1) * 256) * 2; ldb = MIXW * 2; voff = fr * ldb + cl0 * 2; }
        else { sbase = (int)WS_G + (u.pn - 20) * 256; ldb = 4 * D; voff = fr * ldb + wc * 64 + fq * 16; }
        sbase += (u.pm * 256 + wr * 64) * ldb;
#pragma unroll
        for (int bj = 0; bj < 2; ++bj) { const f32x4 w0 = {bflo(p.sw[bj].x), bfhi(p.sw[bj].x), bflo(p.sw[bj].y), bfhi(p.sw[bj].y)}, w1 = {bflo(p.sw[bj].z), bfhi(p.sw[bj].z), bflo(p.sw[bj].w), bfhi(p.sw[bj].w)};
            const f32x4 b0 = {bflo(p.bi[bj].x), bfhi(p.bi[bj].x), bflo(p.bi[bj].y), bfhi(p.bi[bj].y)}, b1 = {bflo(p.bi[bj].z), bfhi(p.bi[bj].z), bflo(p.bi[bj].w), bfhi(p.bi[bj].w)};
#pragma unroll
            for (int ai = 0; ai < 2; ++ai)
#pragma unroll
                for (int m = 0; m < 4; ++m) { const float rs = p.rs[ai][m]; const f32x4 v0 = ACCF(ai, bj, m, 0) * rs * w0 + b0, v1 = ACCF(ai, bj, m, 1) * rs * w1 + b1;
                    if (u.pn >= 20) { v2u w; w.x = g8x4(v0); w.y = g8x4(v1);
                        __builtin_amdgcn_raw_buffer_store_b64(w, rW, voff + bj * 8, sbase + (ai * 128 + m * 16) * ldb, 0); }
                    else { pg8::u32x4 w; w.x = pg8::cvt_pk_bf16(v0[0], v0[1]); w.y = pg8::cvt_pk_bf16(v0[2], v0[3]); w.z = pg8::cvt_pk_bf16(v1[0], v1[1]); w.w = pg8::cvt_pk_bf16(v1[2], v1[3]);
                        __builtin_amdgcn_raw_buffer_store_b128(w, rW, voff + bj * 256, sbase + (ai * 128 + m * 16) * ldb, 0); } } }
    }
};
#undef ACCF
struct EpiMerge {
    static constexpr bool PERM = true, HOOK = true; static constexpr bool PRELOAD = false; struct Pre {};
    const unsigned char* G; bf16* O;
    struct Bt { pg8::u32x4 n[4], d[4]; };
    __device__ __forceinline__ void scale(f32x4 (&acc)[2][2][4][2], const Unit& u, int g, int wr, int wc, int fr, int fq) const {
        const __amdgpu_buffer_rsrc_t rs = __builtin_amdgcn_make_buffer_rsrc((void*)G, 0, 0x7fffffff, 0x00020000);
        int voff = fr * 4 * D + 16 * fq; asm volatile("" : "+v"(voff));
        const int sden = (u.pm * 256 + wr * 64) * 4 * D + (g - 1) * D + u.pn * 256 + wc * 64, snum = sden + D;
        const bool fin = g == 4;
#define UB(x, e) ((float)(((x) >> (8 * (e))) & 255u))
#define MG_LOAD(B, b0) do { _Pragma("unroll") for (int i = 0; i < 4; ++i) { const int ai_ = ((b0) + i) >> 2, m_ = ((b0) + i) & 3, so_ = (ai_ * 128 + m_ * 16) * 4 * D; \
            B.d[i] = __builtin_amdgcn_raw_buffer_load_b128(rs, voff, sden + so_, 0); if (!fin) B.n[i] = __builtin_amdgcn_raw_buffer_load_b128(rs, voff, snum + so_, 0); } } while (0)
#define MG_APPLY(B, b0) do { _Pragma("unroll") for (int i = 0; i < 4; ++i) { const int ai_ = ((b0) + i) >> 2, m_ = ((b0) + i) & 3; \
            _Pragma("unroll") for (int q = 0; q < 4; ++q) { const unsigned dq = B.d[i][q], nq = B.n[i][q]; \
                f32x4 r = {UB(dq, 0), UB(dq, 1), UB(dq, 2), UB(dq, 3)}; \
                if (!fin) r *= (f32x4){__builtin_amdgcn_rcpf(UB(nq, 0)), __builtin_amdgcn_rcpf(UB(nq, 1)), __builtin_amdgcn_rcpf(UB(nq, 2)), __builtin_amdgcn_rcpf(UB(nq, 3))}; else r *= 0.00390625f; \
                acc[ai_][q >> 1][m_][q & 1] *= r; asm volatile("" : "+v"(acc[ai_][q >> 1][m_][q & 1])); } } } while (0)
        Bt A = {}, B = {};
        MG_LOAD(A, 0); MG_LOAD(B, 4);
        MG_APPLY(A, 0); asm volatile("" ::: "memory");
        MG_APPLY(B, 4); asm volatile("" ::: "memory");
#undef MG_LOAD
#undef MG_APPLY
#undef UB
    }
    __device__ __forceinline__ void hook(f32x4 (&acc)[2][2][4][2], const Unit& u, int g, int wr, int wc, int fr, int fq) const { scale(acc, u, g, wr, wc, fr, fq); }
    __device__ __forceinline__ void operator()(f32x4 (&acc)[2][2][4][2], const Unit& u, int wr, int wc, int fr, int fq) const {
        scale(acc, u, 4, wr, wc, fr, fq);
        const int row0 = u.pm * 256 + wr * 64 + fr, col0 = u.pn * 256 + wc * 32 + 8 * fq;
#pragma unroll
        for (int ai = 0; ai < 2; ++ai)
#pragma unroll
            for (int m = 0; m < 4; ++m) { bf16* rowp = O + (size_t)(row0 + ai * 128 + m * 16) * D + col0;
#pragma unroll
                for (int bj = 0; bj < 2; ++bj) { const f32x4 v0 = acc[ai][bj][m][0], v1 = acc[ai][bj][m][1];
                    pg8::u32x4 w; w.x = pg8::cvt_pk_bf16(v0[0], v0[1]); w.y = pg8::cvt_pk_bf16(v0[2], v0[3]); w.z = pg8::cvt_pk_bf16(v1[0], v1[1]); w.w = pg8::cvt_pk_bf16(v1[2], v1[3]);
                    *(pg8::u32x4*)(rowp + bj * 128) = w; } }
    }
};
struct EpiRes {
    static constexpr bool PERM = true, HOOK = false; static constexpr bool PRELOAD = false; struct Pre {};
    const float* X; bf16* HB; unsigned long long* ssa;
    __device__ __forceinline__ void operator()(f32x4 (&acc)[2][2][4][2], const Unit& u, int wr, int wc, int fr, int fq) const {
        const int row0 = u.pm * 256 + wr * 64 + fr, col0 = u.pn * 256 + wc * 32 + 8 * fq;
#pragma unroll
        for (int ai = 0; ai < 2; ++ai)
#pragma unroll
            for (int m = 0; m < 4; ++m) { const int row = row0 + ai * 128 + m * 16; const size_t off = (size_t)row * D + col0; float s = 0.f;
#pragma unroll
                for (int bj = 0; bj < 2; ++bj) { const size_t o = off + bj * 128; f32x4 h0, h1;
                    if (X != nullptr) { h0 = *(const f32x4*)(X + o); h1 = *(const f32x4*)(X + o + 4); }
                    else { const pg8::u32x4 w = *(const pg8::u32x4*)(HB + o); h0 = (f32x4){bflo(w.x), bfhi(w.x), bflo(w.y), bfhi(w.y)}; h1 = (f32x4){bflo(w.z), bfhi(w.z), bflo(w.w), bfhi(w.w)}; }
                    h0 += acc[ai][bj][m][0]; h1 += acc[ai][bj][m][1];
                    pg8::u32x4 w; w.x = pg8::cvt_pk_bf16(h0[0], h0[1]); w.y = pg8::cvt_pk_bf16(h0[2], h0[3]); w.z = pg8::cvt_pk_bf16(h1[0], h1[1]); w.w = pg8::cvt_pk_bf16(h1[2], h1[3]);
                    *(pg8::u32x4*)(HB + o) = w;
                    s += ((h0[0] * h0[0] + h0[1] * h0[1]) + (h0[2] * h0[2] + h0[3] * h0[3])) + ((h1[0] * h1[0] + h1[1] * h1[1]) + (h1[2] * h1[2] + h1[3] * h1[3])); }
                { const int ln = fq * 16 + fr; s += shf(s, ln ^ 16); s += shf(s, ln ^ 32); }
                if (fq == 0) atomicAdd(ssa + row, (unsigned long long)((double)s * 4294967296.0)); }
    }
};
struct EpiQ {
    static constexpr bool PERM = true, HOOK = false; static constexpr bool PRELOAD = false; struct Pre {};
    bf16* O; const unsigned long long* ssa;
    __device__ __forceinline__ void operator()(f32x4 (&acc)[2][2][4][2], const Unit& u, int wr, int wc, int fr, int fq) const {
        const int row0 = u.pm * 256 + wr * 64 + fr;
#pragma unroll
        for (int ai = 0; ai < 2; ++ai)
#pragma unroll
            for (int m = 0; m < 4; ++m) { const int row = row0 + ai * 128 + m * 16; const float rs = rsqrtf(ssa_to_f(ssa[row]) * (1.0f / D) + EPS);
                bf16* rowp = O + ((((size_t)(row >> 5) * 8 + u.pn) * 2 * 8 + (wc * 2 + (fq >> 1))) * 64 + (fq & 1) * 32 + (row & 31)) * 8;
#pragma unroll
                for (int bj = 0; bj < 2; ++bj) { const f32x4 v0 = acc[ai][bj][m][0] * rs, v1 = acc[ai][bj][m][1] * rs;
                    pg8::u32x4 w; w.x = pg8::cvt_pk_bf16(v0[0], v0[1]); w.y = pg8::cvt_pk_bf16(v0[2], v0[3]); w.z = pg8::cvt_pk_bf16(v1[0], v1[1]); w.w = pg8::cvt_pk_bf16(v1[2], v1[3]);
                    *(pg8::u32x4*)(rowp + bj * 8 * 512) = w; } }
    }
};

__device__ __forceinline__ int colmap_in(int j) { return j < 1536 ? j : j + 4; }
__device__ __forceinline__ void tr_item_i8(const float* W, const float* gain, const unsigned* cmax, unsigned char* WT, LAS float* scr, int k0, int n0, int lane) {
    const int q = lane & 7, r8 = lane >> 3, sc = colmap_in(n0 + 4 * q);
    f32x4 v[8];
#pragma unroll
    for (int i = 0; i < 8; ++i) v[i] = *(const f32x4*)(W + (size_t)(k0 + 8 * i + r8) * INW + sc);
    f32x4 inv;
#pragma unroll
    for (int e = 0; e < 4; ++e) { const float cm = __builtin_bit_cast(float, cmax[sc + e]); inv[e] = cm > 0.f ? 127.0f / cm : 0.f; }
#pragma unroll
    for (int i = 0; i < 8; ++i) { const float g = gain[k0 + 8 * i + r8];
#pragma unroll
        for (int e = 0; e < 4; ++e) scr[(8 * i + r8) * 33 + 4 * q + e] = v[i][e] * g * inv[e]; }
    asm volatile("s_waitcnt lgkmcnt(0)" ::: "memory");
    const int n = lane >> 1, hf = lane & 1;
    v4u o[2];
#pragma unroll
    for (int w = 0; w < 8; ++w) { unsigned pk = 0;
#pragma unroll
        for (int b = 0; b < 4; ++b) pk |= ((unsigned)((int)rintf(scr[(32 * hf + 4 * w + b) * 33 + n]) & 255)) << (8 * b);
        o[w >> 2][w & 3] = pk; }
    unsigned char* dst = WT + (size_t)(n0 + n) * D + k0 + 32 * hf;
    *(v4u*)dst = o[0]; *(v4u*)(dst + 16) = o[1];
    asm volatile("s_waitcnt lgkmcnt(0)" ::: "memory");
}
template <bool MAP>
__device__ __forceinline__ void tr_item(const float* W, int ldw, const float* scale, bf16* WT, int ldt, int dcol0, LAS float* scr, int k0, int n0, int lane) {
    const int q = lane & 7, r8 = lane >> 3, sc = MAP ? colmap_in(n0 + 4 * q) : (n0 + 4 * q);
    f32x4 v[8];
#pragma unroll
    for (int i = 0; i < 8; ++i) v[i] = *(const f32x4*)(W + (size_t)(k0 + 8 * i + r8) * ldw + sc);
    f32x4 s0 = {1.f, 1.f, 1.f, 1.f}, s1 = s0;
    if (scale) { s0 = *(const f32x4*)(scale + k0 + 8 * q); s1 = *(const f32x4*)(scale + k0 + 8 * q + 4); }
#pragma unroll
    for (int i = 0; i < 8; ++i)
#pragma unroll
        for (int e = 0; e < 4; ++e) scr[(8 * i + r8) * 33 + 4 * q + e] = v[i][e];
    asm volatile("s_waitcnt lgkmcnt(0)" ::: "memory");
    const int c = q;
#pragma unroll
    for (int j = 0; j < 4; ++j) { const int n = r8 + 8 * j; const LAS float* s = scr + (8 * c) * 33 + n;
        v4u o; o.x = pk2(s[0 * 33] * s0[0], s[1 * 33] * s0[1]); o.y = pk2(s[2 * 33] * s0[2], s[3 * 33] * s0[3]); o.z = pk2(s[4 * 33] * s1[0], s[5 * 33] * s1[1]); o.w = pk2(s[6 * 33] * s1[2], s[7 * 33] * s1[3]);
        *(v4u*)(WT + (size_t)(n0 + n) * ldt + dcol0 + k0 + 8 * c) = o; }
    asm volatile("s_waitcnt lgkmcnt(0)" ::: "memory");
}
constexpr size_t WS_BAR = 512 * 1024;
#define XB_TMO      128
#define XB_XCNT(j)  (256  + 64 * (j))
#define XB_XSUB(j)  (1280 + 64 * (j))
#define XB_XGEN(j)  (2304 + 64 * (j))
#define XB_TOP      3328
#define XB_TOPGEN   3392
#define XCD_BAR_WORDS 3456
#define XB_SPIN_CAP (1u << 23)
__device__ __forceinline__ unsigned xb_ld(unsigned* p)              { return __hip_atomic_load(p, __ATOMIC_RELAXED, __HIP_MEMORY_SCOPE_AGENT); }
__device__ __forceinline__ unsigned xb_add(unsigned* p, unsigned v) { return __hip_atomic_fetch_add(p, v, __ATOMIC_RELAXED, __HIP_MEMORY_SCOPE_AGENT); }
__device__ __forceinline__ unsigned xb_xcc_id() { return (unsigned)__builtin_amdgcn_s_getreg((3 << 11) | 20) & 0xFu; }
#define XB_SPIN(cond, bar) do { unsigned _sp = 0; while (cond) { __builtin_amdgcn_s_sleep(1); \
    if ((++_sp & 255u) == 0u) { if (xb_ld(&(bar)[XB_TMO])) break; if (_sp > XB_SPIN_CAP) { atomicAdd(&(bar)[XB_TMO], 1u); break; } } } } while (0)
__device__ __forceinline__ void xcd_barrier_complete(unsigned* bar, unsigned x, unsigned G, unsigned& nloc, unsigned& nx) {
    unsigned sum, cnt, mine, sp = 0u;
    for (;;) {
        sum = 0u; cnt = 0u; mine = 0u;
#pragma unroll
        for (unsigned j = 0; j < 16; ++j) { const unsigned c = xb_ld(&bar[XB_XCNT(j)]); sum += c; cnt += (c > 0u) ? 1u : 0u; mine = (j == x) ? c : mine; }
        if (sum == G) break;
        __builtin_amdgcn_s_sleep(1);
        if ((++sp & 255u) == 0u) { if (xb_ld(&bar[XB_TMO])) break; if (sp > XB_SPIN_CAP) { atomicAdd(&bar[XB_TMO], 1u); break; } }
    }
    nloc = mine > 0u ? mine : 1u; nx = cnt > 0u ? cnt : 1u;
}
__device__ __forceinline__ void xcd_barrier(unsigned* bar, unsigned x, unsigned G, volatile LAS unsigned* st, int wave) {
    asm volatile("s_waitcnt vmcnt(0)" ::: "memory");
    __syncthreads();
    int lane; asm volatile("v_mbcnt_lo_u32_b32 %0, -1, 0\n\tv_mbcnt_hi_u32_b32 %0, -1, %0" : "=v"(lane));
    if (wave == 0 && lane == 0) {
        __builtin_amdgcn_s_waitcnt(0);
        unsigned nloc = st[0], nx = st[1];
        if (nloc == 0u) { xcd_barrier_complete(bar, x, G, nloc, nx); st[0] = nloc; st[1] = nx; }
        const unsigned old = xb_add(&bar[XB_XSUB(x)], 1u);
        const unsigned gen = old / nloc;
        if (old + 1u == (gen + 1u) * nloc) {
            __builtin_amdgcn_fence(__ATOMIC_RELEASE, "agent");
            asm volatile("s_waitcnt vmcnt(0)" ::: "memory");
            const unsigned og = xb_add(&bar[XB_TOP], 1u);
            const unsigned tg = og / nx;
            if (og + 1u == (tg + 1u) * nx) xb_add(&bar[XB_TOPGEN], 1u);
            else XB_SPIN(xb_ld(&bar[XB_TOPGEN]) == tg, bar);
            __builtin_amdgcn_fence(__ATOMIC_ACQUIRE, "agent");
            xb_add(&bar[XB_XGEN(x)], 1u);
            asm volatile("s_waitcnt vmcnt(0)" ::: "memory");
        } else {
            XB_SPIN(xb_ld(&bar[XB_XGEN(x)]) == gen, bar);
            __builtin_amdgcn_fence(__ATOMIC_ACQUIRE, "agent");
            asm volatile("s_waitcnt vmcnt(0)" ::: "memory");
        }
    }
    __syncthreads();
}
namespace att {
constexpr int D = 128, NW = 8, QBLK = 32, KVBLK = 64, QB = NW * QBLK;
constexpr int PITCH = 512, OPITCH = 2048;
constexpr float SCALE = 0.08838834764831845f, THR = 8.f;
constexpr int SHM_V = KVBLK * D * 2, SHM_K = KVBLK * D * 2;
constexpr int OFF_WS = 2 * SHM_V + 2 * SHM_K, OFF_CUM = OFF_WS + NW * 64 * 4, OFF_REL = OFF_CUM + 2048 * 4, LDS_END = OFF_REL + 320 * 4;
typedef unsigned short bf16;
typedef short bf16x8 __attribute__((ext_vector_type(8)));
typedef short s16x4 __attribute__((ext_vector_type(4)));
typedef float f32x16 __attribute__((ext_vector_type(16)));
typedef float f32x4 __attribute__((ext_vector_type(4)));
typedef unsigned u32x4 __attribute__((ext_vector_type(4)));
#define ALDS __attribute__((address_space(3)))

#define KSWZ(row, colB) ((row) * 256 + ((colB) ^ (((row) & 7) << 4)))
#define SBAR() __builtin_amdgcn_sched_barrier(0)
__device__ __forceinline__ int v_st(int k, int c) { const int kk = (k & ~0xC) | ((k & 4) << 1) | ((k & 8) >> 1); return ((kk >> 3) * 4 + (c >> 5)) * 512 + ((kk & 7) * 32 + (c & 31)) * 2; }
__device__ __forceinline__ int v_rd_base(int lane) { return ((lane & 3) << 3) | (((lane >> 2) & 3) << 6) | (((lane >> 4) & 1) << 5) | (((lane >> 5) & 1) << 8); }
constexpr int v_rd_off(int d0, int ks, int half) { return d0 * 512 + ks * 4096 + half * 2048; }
__device__ __forceinline__ int crow(int r, int hi) { return (r & 3) + 8 * (r >> 2) + 4 * hi; }
__device__ __forceinline__ unsigned cvtpk(float lo, float hi) { unsigned r; asm volatile("v_cvt_pk_bf16_f32 %0, %1, %2" : "=v"(r) : "v"(lo), "v"(hi)); return r; }
__device__ __forceinline__ bf16x8 load8(const bf16* p) { return *reinterpret_cast<const bf16x8*>(p); }

__device__ __forceinline__ void mask_tile(f32x16& p0, f32x16& p1, int dq) {
    const float NEG = -__builtin_inff();
#pragma unroll
    for (int r = 0; r < 16; ++r) { const int c = (r & 3) + 8 * (r >> 2);
        if (dq - c < 0) p0[r] = NEG;
        if (dq - c - 32 < 0) p1[r] = NEG; }
}
__device__ __forceinline__ void partialSM(f32x16& p0, f32x16& p1, float& m_reg, float& mn, float& alpha) {
    float pmax = p0[0];
#pragma unroll
    for (int r = 1; r < 16; ++r) pmax = fmaxf(pmax, p0[r]);
#pragma unroll
    for (int r = 0; r < 16; ++r) pmax = fmaxf(pmax, p1[r]);
    { auto rr = __builtin_amdgcn_permlane32_swap(__float_as_uint(pmax), __float_as_uint(pmax), false, false);
      pmax = fmaxf(__uint_as_float(rr[0]), __uint_as_float(rr[1])); }
    constexpr float C2 = 1.4426950408889634f * SCALE;
    if (__builtin_expect(__all((pmax - m_reg) * SCALE <= THR), 1)) { mn = m_reg; alpha = 1.f; }
    else { mn = fmaxf(m_reg, pmax); alpha = __builtin_amdgcn_exp2f((m_reg - mn) * C2); m_reg = mn; }
    const float mnL = -mn * C2;
#pragma unroll
    for (int r = 0; r < 16; ++r) p0[r] = fmaf(p0[r], C2, mnL);
#pragma unroll
    for (int r = 0; r < 16; ++r) p1[r] = fmaf(p1[r], C2, mnL);
#pragma unroll
    for (int r = 0; r < 16; ++r) p0[r] = __builtin_amdgcn_exp2f(p0[r]);
}
__device__ __forceinline__ void finishSM(f32x16& p0, f32x16& p1, float alpha, float& l_reg, bf16x8& pa0, bf16x8& pa1, bf16x8& pa2, bf16x8& pa3) {
#pragma unroll
    for (int r = 0; r < 16; ++r) p1[r] = __builtin_amdgcn_exp2f(p1[r]);
    float ps = 0;
#pragma unroll
    for (int r = 0; r < 16; ++r) ps += p0[r];
#pragma unroll
    for (int r = 0; r < 16; ++r) ps += p1[r];
    { auto rr = __builtin_amdgcn_permlane32_swap(__float_as_uint(ps), __float_as_uint(ps), false, false);
      ps = __uint_as_float(rr[0]) + __uint_as_float(rr[1]); }
    l_reg = l_reg * alpha + ps;
#define PK4(P, B_, OUT) do { unsigned a0 = cvtpk(P[B_+0], P[B_+1]), a1 = cvtpk(P[B_+2], P[B_+3]);                          \
        unsigned b0 = cvtpk(P[B_+4], P[B_+5]), b1 = cvtpk(P[B_+6], P[B_+7]);                                             \
        auto r0 = __builtin_amdgcn_permlane32_swap(a0, b0, false, false); auto r1 = __builtin_amdgcn_permlane32_swap(a1, b1, false, false); \
        u32x4 w = {r0[0], r1[0], r0[1], r1[1]}; OUT = *reinterpret_cast<bf16x8*>(&w); } while (0)
    PK4(p0, 0, pa0); PK4(p0, 8, pa1); PK4(p1, 0, pa2); PK4(p1, 8, pa3);
#undef PK4
}
template <int KB>
__device__ __forceinline__ void qkt(f32x16& p0, f32x16& p1, const ALDS char* K_lds, int r32, int hi, const bf16x8* qr, bool act) {
    if (!act) { const float NEG = -__builtin_inff();
#pragma unroll
        for (int r = 0; r < 16; ++r) { p0[r] = NEG; p1[r] = NEG; } return; }
    p0 = f32x16{}; p1 = f32x16{};
    const ALDS char* kb[4];
#pragma unroll
    for (int dd = 0; dd < 4; ++dd) kb[dd] = K_lds + KB * SHM_K + KSWZ(r32, (dd * 16 + hi * 8) * 2);
#pragma unroll
    for (int d0 = 0; d0 < 8; ++d0) { const ALDS char* a = kb[d0 & 3] + (d0 >> 2) * 128;
        bf16x8 b0 = *(const ALDS bf16x8*)(a);
        bf16x8 b1 = *(const ALDS bf16x8*)(a + 32 * 256);
        p0 = __builtin_amdgcn_mfma_f32_32x32x16_bf16(b0, qr[d0], p0, 0, 0, 0);
        p1 = __builtin_amdgcn_mfma_f32_32x32x16_bf16(b1, qr[d0], p1, 0, 0, 0); }
}
template <int VB>
__device__ __forceinline__ void pv_tile(f32x16* o, int vb0, bf16x8 pa0, bf16x8 pa1, bf16x8 pa2, bf16x8 pa3, bool act) {
    if (!act) return;
#define TRRD(dst, off) asm volatile("ds_read_b64_tr_b16 %0, %1 offset:%2" : "=&v"(dst) : "v"(vb0), "i"(off) : "memory")
#define PV_D0(d0) do { s16x4 l0, l1, l2, l3, h0, h1, h2, h3; constexpr int b_ = VB * SHM_V + v_rd_off(d0, 0, 0); \
        TRRD(l0, b_); TRRD(h0, b_ + 2048); TRRD(l1, b_ + 4096); TRRD(h1, b_ + 6144); TRRD(l2, b_ + 8192); TRRD(h2, b_ + 10240); TRRD(l3, b_ + 12288); TRRD(h3, b_ + 14336); \
        asm volatile("s_waitcnt lgkmcnt(0)" ::: "memory"); SBAR(); \
        o[d0] = __builtin_amdgcn_mfma_f32_32x32x16_bf16(pa0, (bf16x8){l0[0], l0[1], l0[2], l0[3], h0[0], h0[1], h0[2], h0[3]}, o[d0], 0, 0, 0);   \
        o[d0] = __builtin_amdgcn_mfma_f32_32x32x16_bf16(pa1, (bf16x8){l1[0], l1[1], l1[2], l1[3], h1[0], h1[1], h1[2], h1[3]}, o[d0], 0, 0, 0);   \
        o[d0] = __builtin_amdgcn_mfma_f32_32x32x16_bf16(pa2, (bf16x8){l2[0], l2[1], l2[2], l2[3], h2[0], h2[1], h2[2], h2[3]}, o[d0], 0, 0, 0);   \
        o[d0] = __builtin_amdgcn_mfma_f32_32x32x16_bf16(pa3, (bf16x8){l3[0], l3[1], l3[2], l3[3], h3[0], h3[1], h3[2], h3[3]}, o[d0], 0, 0, 0); } while (0)
    PV_D0(0); PV_D0(1); PV_D0(2); PV_D0(3);
#undef PV_D0
#undef TRRD
}
template <int MODE>
__device__ __forceinline__ void bias_mask(f32x16& p0, f32x16& p1, const ALDS char* lds, int kb, int qlo, int qpos, int hi, float cqs, bool act) {
    if (!act) return;
    if (MODE == 0) {
        const ALDS float* cs = (const ALDS float*)(lds + OFF_CUM) + kb + 4 * hi;
#pragma unroll
        for (int g = 0; g < 4; ++g) { const f32x4 c0 = *(const ALDS f32x4*)(cs + 8 * g), c1 = *(const ALDS f32x4*)(cs + 32 + 8 * g);
#pragma unroll
            for (int e = 0; e < 4; ++e) { p0[4 * g + e] += cqs - c0[e]; p1[4 * g + e] += cqs - c1[e]; } }
        if (kb + KVBLK - 1 > qlo) mask_tile(p0, p1, qpos - 4 * hi - kb);
    } else {
        const ALDS float* tb = (const ALDS float*)(lds + OFF_REL);
        if (qlo - (kb + KVBLK - 1) >= 256) { const float c = tb[319];
#pragma unroll
            for (int r = 0; r < 16; ++r) { p0[r] += c; p1[r] += c; } }
        else { const int d0 = qpos - kb - 4 * hi + 63;
#pragma unroll
            for (int r = 0; r < 16; ++r) { const int c = (r & 3) + 8 * (r >> 2);
                int i0 = d0 - c, i1 = d0 - c - 32; i0 = i0 > 319 ? 319 : i0; i1 = i1 > 319 ? 319 : i1; i1 = i1 < 0 ? 0 : i1; i0 = i0 < 0 ? 0 : i0;
                p0[r] += tb[i0]; p1[r] += tb[i1]; } }
    }
}

struct Seam { bf16x8 qr[8]; bf16x8 st_v0, st_v1, st_k0, st_k1; };
#define VMW() asm volatile("s_waitcnt vmcnt(0)" ::: "memory")
#define BL8(rs, vo, so) __builtin_bit_cast(bf16x8, __builtin_amdgcn_raw_buffer_load_b128(rs, vo, so, 0))
#define SLOAD_H(Kp, Vp, k0) do { S.st_v0 = BL8(rP, kvoff, (Vp) + (k0) * (PITCH * 2)); S.st_v1 = BL8(rP, kvoff, (Vp) + ((k0) + 32) * (PITCH * 2));              \
                         S.st_k0 = BL8(rP, kvoff, (Kp) + (k0) * (PITCH * 2)); S.st_k1 = BL8(rP, kvoff, (Kp) + ((k0) + 32) * (PITCH * 2)); } while (0)
#define SWRITE_HK(bf) do { *(ALDS bf16x8*)(K_lds + (bf) * SHM_K + kws) = S.st_k0; *(ALDS bf16x8*)(K_lds + (bf) * SHM_K + kws + 32 * 256) = S.st_k1; } while (0)
#define SWRITE_HV(bf) do { *(ALDS bf16x8*)(V_lds + (bf) * SHM_V + vst0) = S.st_v0; *(ALDS bf16x8*)(V_lds + (bf) * SHM_V + vst1) = S.st_v1; } while (0)
#define SWRITE_H(bf) do { SWRITE_HV(bf); SWRITE_HK(bf); } while (0)

template <int MODE, bool PART = false>
__device__ __forceinline__ void attn_unit(const bf16* Pb, int Qo, int Kh, int Vh, bf16* Yb, int Oo, int P0, int j_lo, int j_hi, ALDS char* lds, int wid, int lane, float* PO = nullptr, float* PM = nullptr, float* PL = nullptr) {
    const int tid = wid * 64 + lane, r32 = lane & 31, hi = lane >> 5;
    const int NT = j_hi - j_lo;
    const int qlo = P0 + wid * QBLK, qpos = qlo + r32;
    ALDS char* V_lds = lds; ALDS char* K_lds = lds + 2 * SHM_V;
    ALDS float* ws = (ALDS float*)(lds + OFF_WS) + wid * 64; ALDS float* li_l = ws; ALDS float* al_l = ws + 32;
    float m_reg = -1e30f, l_reg = 0; f32x16 o[4] = {};
    const int sr = tid >> 4, sc = (tid & 15) * 8, vst0 = v_st(sr, sc), vst1 = v_st(32 + sr, sc), kws = KSWZ(sr, sc * 2);
    const int vb0 = (int)(unsigned)(size_t)V_lds + v_rd_base(lane);
    Seam S;
    const __amdgpu_buffer_rsrc_t rP = __builtin_amdgcn_make_buffer_rsrc((void*)Pb, 0, 0x7fffffff, 0x00020000);
    const __amdgpu_buffer_rsrc_t rO = __builtin_amdgcn_make_buffer_rsrc((void*)Yb, 0, 0x7fffffff, 0x00020000);
    const int kvoff = (sr * PITCH + sc) * 2;
#define KBASE(t) ((j_lo + (t)) * KVBLK)
#define ACT(t) (MODE == 0 ? (KBASE(t) <= qlo + QBLK - 1) : ((j_lo + (t)) <= (qlo >> 6) && (j_lo + (t)) + 8 >= (qlo >> 6)))
#define RESC(a) do { if (__any((a) < 1.f)) { if (hi == 0) al_l[r32] = (a); asm volatile("s_waitcnt lgkmcnt(0)" ::: "memory");              \
                     for (int d_ = 0; d_ < 4; ++d_) for (int r = 0; r < 16; ++r) o[d_][r] *= al_l[crow(r, hi)]; } } while (0)
#define MASKT(P0_, P1_, t) bias_mask<MODE>(P0_, P1_, lds, KBASE(t), qlo, qpos, hi, cq_, ACT(t))
    {
        const int kb0 = j_lo * KVBLK;
#pragma unroll
        for (int d0 = 0; d0 < 8; ++d0) S.qr[d0] = BL8(rP, (r32 * PITCH + hi * 8) * 2 + d0 * 32, Qo + wid * (QBLK * PITCH * 2));
        SLOAD_H(Kh, Vh, kb0); VMW(); SWRITE_HK(0);
        __syncthreads();
    }
    const float cq_ = MODE == 0 ? ((const ALDS float*)(lds + OFF_CUM))[qpos] : 0.f;
    f32x16 pA0, pA1, pB0, pB1; float mnA, mnB, alA, alB; bf16x8 pa0, pa1, pa2, pa3;
    SWRITE_HV(0); SBAR();
    if (NT > 1) { SLOAD_H(Kh, Vh, KBASE(1)); }
    SBAR(); qkt<0>(pA0, pA1, K_lds, r32, hi, S.qr, ACT(0));
    MASKT(pA0, pA1, 0); partialSM(pA0, pA1, m_reg, mnA, alA);
    if (NT > 1) { VMW(); SWRITE_H(1); }
    __syncthreads();
#define HALF_STEP(PX0, PX1, mnX, alX, PY0, PY1, alY, t, KB, VB, SB) do {                                                      \
        SBAR(); qkt<KB>(PX0, PX1, K_lds, r32, hi, S.qr, ACT(t));                                                              \
        finishSM(PY0, PY1, alY, l_reg, pa0, pa1, pa2, pa3); SBAR();                                                           \
        if ((t) + 1 < NT) { SLOAD_H(Kh, Vh, KBASE((t) + 1)); SBAR(); }                                                        \
        pv_tile<VB>(o, vb0, pa0, pa1, pa2, pa3, ACT((t) - 1)); MASKT(PX0, PX1, (t)); partialSM(PX0, PX1, m_reg, mnX, alX);    \
        __syncthreads();                                                                                                      \
        if ((t) + 1 < NT) { VMW(); SWRITE_H(SB); }                                                                            \
        RESC(alX); __syncthreads(); } while (0)
    for (int t = 1; t + 1 < NT; t += 2) {
        HALF_STEP(pB0, pB1, mnB, alB, pA0, pA1, alA, t, 1, 0, 0);
        HALF_STEP(pA0, pA1, mnA, alA, pB0, pB1, alB, t + 1, 0, 1, 1);
    }
    const bool even = (NT & 1) == 0;
    if (even) { SBAR(); qkt<1>(pB0, pB1, K_lds, r32, hi, S.qr, ACT(NT - 1)); SBAR(); }
    finishSM(pA0, pA1, alA, l_reg, pa0, pa1, pa2, pa3); SBAR();
    pv_tile<0>(o, vb0, pa0, pa1, pa2, pa3, ACT(even ? NT - 2 : NT - 1));
    if (even) { MASKT(pB0, pB1, NT - 1); partialSM(pB0, pB1, m_reg, mnB, alB); __syncthreads(); RESC(alB);
        finishSM(pB0, pB1, alB, l_reg, pa0, pa1, pa2, pa3); SBAR(); pv_tile<1>(o, vb0, pa0, pa1, pa2, pa3, ACT(NT - 1)); }
    SBAR();
    if constexpr (PART) {
        if (hi == 0) { PM[wid * QBLK + r32] = m_reg; PL[wid * QBLK + r32] = l_reg; }
#pragma unroll
        for (int r = 0; r < 16; ++r) { const int orow = wid * QBLK + (r & 3) + 8 * (r >> 2) + 4 * hi;
#pragma unroll
            for (int d0 = 0; d0 < 4; ++d0) PO[orow * D + d0 * 32 + r32] = o[d0][r]; }
    } else {
    if (hi == 0) li_l[r32] = l_reg; asm volatile("s_waitcnt lgkmcnt(0)" ::: "memory");
    float rli[16];
#pragma unroll
    for (int r = 0; r < 16; ++r) rli[r] = __builtin_amdgcn_rcpf(li_l[crow(r, hi)]);
    const int ovoff = (4 * hi * OPITCH + r32) * 2, osoff = Oo + wid * (QBLK * OPITCH * 2);
#pragma unroll
    for (int r = 0; r < 16; ++r) { const int orow = (r & 3) + 8 * (r >> 2);
#pragma unroll
        for (int d0 = 0; d0 < 4; ++d0) { const float v = o[d0][r] * rli[r];
            const float vn = __builtin_bit_cast(float, __builtin_amdgcn_ds_bpermute((lane ^ 1) << 2, __builtin_bit_cast(int, v)));
            if ((r32 & 1) == 0) __builtin_amdgcn_raw_buffer_store_b32(cvtpk(v, vn), rO, ovoff + d0 * 64, osoff + orow * (OPITCH * 2), 0); } }
    }
    __syncthreads();
#undef RESC
#undef KBASE
#undef ACT
#undef MASKT
#undef HALF_STEP
}
#undef BL8
#undef VMW
#undef SLOAD_H
#undef SWRITE_HK
#undef SWRITE_HV
#undef SWRITE_H
#undef KSWZ
#undef SBAR
}
constexpr size_t WS_QCTR = 768 * 1024;
constexpr size_t WS_POOLW = 4 * MiB;
constexpr int N_ATT_UNITS = 256, N_POOL_UNITS = 512, N_CONV_UNITS = 128;

__device__ __forceinline__ void stage_cum(const Args& a, int b, int h, LAS char* lds, int wave, int lane) {
    const float* logf = (const float*)(a.ws + WS_LOGF) + ((size_t)b * SEQ) * 4 + h;
    const int tid = wave * 64 + lane;
    float v[4];
#pragma unroll
    for (int e = 0; e < 4; ++e) v[e] = logf[(size_t)(4 * tid + e) * 4];
    v[1] += v[0]; v[2] += v[1]; v[3] += v[2];
    float incl = v[3];
#pragma unroll
    for (int o = 1; o < 64; o <<= 1) { const float t = shf(incl, lane >= o ? lane - o : lane); if (lane >= o) incl += t; }
    LAS float* wt = (LAS float*)(lds + att::OFF_WS);
    if (lane == 63) wt[wave] = incl;
    __syncthreads();
    float base = incl - v[3];
    for (int w = 0; w < wave; ++w) base += wt[w];
    LAS float* cs = (LAS float*)(lds + att::OFF_CUM);
    const float inv = 1.0f / ATT_SCALE;
    *(LAS f32x4*)(cs + 4 * tid) = (f32x4){(base + v[0]) * inv, (base + v[1]) * inv, (base + v[2]) * inv, (base + v[3]) * inv};
    __syncthreads();
}
constexpr size_t WS_PO = WS_MRG;
constexpr size_t WS_PML = WS_MRG + 16 * MiB;
constexpr size_t WS_ACNT = WS_QCTR + 4096;
struct AttBlk { int mode, qb, part; };
__device__ __forceinline__ void att_sched(int slot, AttBlk& b0, AttBlk& b1) {
    b1.mode = 0; b1.qb = -1; b1.part = 0; b0.mode = 0; b0.part = 0;
    switch (slot) {
        case 0: b0.qb = 7; b0.part = 1; break;   case 1: b0.qb = 7; b0.part = 2; break;
        case 2: b0.qb = 6; b0.part = 1; break;   case 3: b0.qb = 6; b0.part = 2; break;
        case 4: b0.qb = 5; b0.part = 1; b1.qb = 0; break;
        case 5: b0.qb = 5; b0.part = 2; break;
        case 6: b0.qb = 4; break;
        case 7: b0.qb = 3; break;
        case 8: b0.qb = 2; b1.mode = 1; b1.qb = 0; break;
        case 9: b0.qb = 1; b1.mode = 1; b1.qb = 1; break;
        default: b0.mode = 1; b0.qb = 17 - slot; break;
    }
}
__device__ __forceinline__ void combine_pair(const Args& a, int l, int pair, int wave);
__device__ __forceinline__ void attention_block(const Args& a, int l, int bh, AttBlk k, LAS char* lds, int wave) {
    int lane; asm volatile("v_mbcnt_lo_u32_b32 %0, -1, 0\n\tv_mbcnt_hi_u32_b32 %0, -1, %0" : "=v"(lane));
    const bf16* P = (const bf16*)(a.ws + WS_PROJ); bf16* Y = (bf16*)(a.ws + WS_Y);
    const int qb = k.qb, b = bh >> 2, h = bh & 3;
    const size_t row0 = (size_t)b * SEQ; const int P0 = qb * 256;
    if (k.mode == 0) {
        stage_cum(a, b, h, lds, wave, lane);
        const int nt = 4 * qb + 4, q0 = (int)((0 * PROJ_T + (row0 + P0) * MIXW + h * HD) * 2), k0 = (int)((1 * PROJ_T + row0 * MIXW + h * HD) * 2), v0 = (int)((2 * PROJ_T + row0 * MIXW + h * HD) * 2), o0 = (int)(((row0 + P0) * D + h * HD) * 2);
        if (k.part == 0) att::attn_unit<0>(P, q0, k0, v0, Y, o0, P0, 0, nt, lds, wave, lane);
        else { const int pair = (qb - 4) * 16 + bh, hf = k.part - 1;
            float* PO = (float*)(a.ws + WS_PO) + ((size_t)pair * 2 + hf) * 256 * 128; float* PM = (float*)(a.ws + WS_PML) + ((size_t)pair * 2 + hf) * 512;
            att::attn_unit<0, true>(P, q0, k0, v0, Y, o0, P0, hf ? nt / 2 : 0, hf ? nt : nt / 2, lds, wave, lane, PO, PM, PM + 256);
            asm volatile("s_waitcnt vmcnt(0)" ::: "memory"); __syncthreads();
            if (hf == 0) {
                if (wave == 0 && lane == 0) { __builtin_amdgcn_fence(__ATOMIC_RELEASE, "agent"); asm volatile("s_waitcnt vmcnt(0)" ::: "memory");
                    __hip_atomic_fetch_add((unsigned*)(a.ws + WS_ACNT) + l * 64 + pair, 1u, __ATOMIC_RELAXED, __HIP_MEMORY_SCOPE_AGENT); } } }
    } else {
        const int tid = wave * 64 + lane;
        if (tid < 320) ((LAS float*)(lds + att::OFF_REL))[tid] = a.rel_bias[((size_t)l * 4 + h) * 320 + tid] * (1.0f / ATT_SCALE);
        const int jlo = 4 * qb - 8 < 0 ? 0 : 4 * qb - 8;
        att::attn_unit<1>(P, (int)((7 * PROJ_T + (row0 + P0) * MIXW + h * HD) * 2), (int)((8 * PROJ_T + row0 * MIXW + h * HD) * 2), (int)((9 * PROJ_T + row0 * MIXW + h * HD) * 2),
                          Y, (int)(((row0 + P0) * D + 1536 + h * HD) * 2), P0, jlo, 4 * qb + 4, lds, wave, lane);
    }
}
__device__ __forceinline__ void combine_pair(const Args& a, int l, int pair, int wave) {
    int lane; asm volatile("v_mbcnt_lo_u32_b32 %0, -1, 0\n\tv_mbcnt_hi_u32_b32 %0, -1, %0" : "=v"(lane));
    if (wave == 0 && lane == 0) {
        unsigned* c = (unsigned*)(a.ws + WS_ACNT) + l * 64 + pair; unsigned sp = 0;
        while (__hip_atomic_load(c, __ATOMIC_RELAXED, __HIP_MEMORY_SCOPE_AGENT) < 1u && ++sp < (1u << 24)) __builtin_amdgcn_s_sleep(2);
        __builtin_amdgcn_fence(__ATOMIC_ACQUIRE, "agent"); asm volatile("s_waitcnt vmcnt(0)" ::: "memory"); }
    __syncthreads();
    const int qb = 4 + (pair >> 4), bh = pair & 15, b = bh >> 2, h = bh & 3, tid = wave * 64 + lane, row = tid >> 1, c0 = (tid & 1) * 64;
    const float* POA = (const float*)(a.ws + WS_PO) + ((size_t)pair * 2) * 256 * 128 + row * 128 + c0; const float* POB = POA + 256 * 128;
    const float* ML = (const float*)(a.ws + WS_PML) + (size_t)pair * 2 * 512;
    const float mA = ML[row], lA = ML[256 + row], mB = ML[512 + row], lB = ML[768 + row], mm = fmaxf(mA, mB);
    constexpr float C2 = 1.4426950408889634f * ATT_SCALE;
    const float wA = __builtin_amdgcn_exp2f((mA - mm) * C2), wB = __builtin_amdgcn_exp2f((mB - mm) * C2), inv = 1.0f / (lA * wA + lB * wB), fa = wA * inv, fb = wB * inv;
    bf16* Y = (bf16*)(a.ws + WS_Y) + ((size_t)b * SEQ + qb * 256 + row) * D + h * HD + c0;
#pragma unroll
    for (int k = 0; k < 64; k += 8) { const f32x4 a0 = *(const f32x4*)(POA + k), a1 = *(const f32x4*)(POA + k + 4), b0 = *(const f32x4*)(POB + k), b1 = *(const f32x4*)(POB + k + 4);
        v4u o; o.x = pk2(a0[0] * fa + b0[0] * fb, a0[1] * fa + b0[1] * fb); o.y = pk2(a0[2] * fa + b0[2] * fb, a0[3] * fa + b0[3] * fb);
        o.z = pk2(a1[0] * fa + b1[0] * fb, a1[1] * fa + b1[1] * fb); o.w = pk2(a1[2] * fa + b1[2] * fb, a1[3] * fa + b1[3] * fb); *(v4u*)(Y + k) = o; }
    __syncthreads();
}
__device__ __forceinline__ void pool_item(const Args& a, int l, int u, LAS char* lds, int wave) {
    int lane; asm volatile("v_mbcnt_lo_u32_b32 %0, -1, 0\n\tv_mbcnt_hi_u32_b32 %0, -1, %0" : "=v"(lane));
    const int g = u & 3, T0 = (u >> 2) * 64, tid = wave * 64 + lane;
    const bf16* Pin = (const bf16*)(a.ws + WS_PROJ) + 3 * PROJ_T + g * 128;
    typedef short bf16x8 __attribute__((ext_vector_type(8)));
    const int rt = (wave & 3) * 16, db = (wave >> 2) * 64, fr = lane & 15, kg = lane >> 4;
    bf16x8 bfr[4][4]; f32x4 sc[4];
    { const bf16* Wt = (const bf16*)(a.ws + WS_POOLW) + ((size_t)l * 4 + g) * 128 * 128;
#pragma unroll
      for (int ks = 0; ks < 4; ++ks)
#pragma unroll
          for (int nt = 0; nt < 4; ++nt) bfr[ks][nt] = *(const bf16x8*)(Wt + (size_t)(db + nt * 16 + fr) * 128 + ks * 32 + kg * 8);
#pragma unroll
      for (int nt = 0; nt < 4; ++nt) sc[nt] = *(const f32x4*)(a.pool_scale + l * MIXW + g * 128 + db + nt * 16 + kg * 4); }
    {
        const int cp = tid & 63, run = tid >> 6, w = 2 << g, t0 = T0 + run * 8, s0 = t0 & (SEQ - 1);
        const bf16* col = Pin + 2 * cp;
        float lo[23], hi[23];
#pragma unroll
        for (int k = 0; k < 23; ++k) { const int dj = k - 15; const bool ok = s0 + dj >= 0; const unsigned x = *(const unsigned*)(col + (size_t)(ok ? t0 + dj : t0) * MIXW); lo[k] = ok ? bflo(x) : 0.f; hi[k] = ok ? bfhi(x) : 0.f; }
        float s_lo = 0.f, s_hi = 0.f;
#pragma unroll
        for (int j = 1; j < 16; ++j) if (j < w) { s_lo += lo[15 - j]; s_hi += hi[15 - j]; }
#pragma unroll
        for (int i = 0; i < 8; ++i) { s_lo += lo[15 + i]; s_hi += hi[15 + i];
            const int s = s0 + i; const int cnt = s + 1 < w ? s + 1 : w; const float inv = 1.0f / (float)cnt;
            *(LAS unsigned*)(lds + (run * 8 + i) * 272 + 4 * cp) = pk2(s_lo * inv - lo[15 + i], s_hi * inv - hi[15 + i]);
            const float dl = g == 0 ? lo[14 + i] : g == 1 ? lo[12 + i] : g == 2 ? lo[8 + i] : lo[i], dh = g == 0 ? hi[14 + i] : g == 1 ? hi[12 + i] : g == 2 ? hi[8 + i] : hi[i];
            s_lo -= dl; s_hi -= dh; }
    }
    __syncthreads();
    {
        f32x4 acc[4] = {};
#pragma unroll
        for (int ks = 0; ks < 4; ++ks) { const bf16x8 af = *(const LAS bf16x8*)(lds + (rt + fr) * 272 + (ks * 32 + kg * 8) * 2);
#pragma unroll
            for (int nt = 0; nt < 4; ++nt) acc[nt] = __builtin_amdgcn_mfma_f32_16x16x32_bf16(bfr[ks][nt], af, acc[nt], 0, 0, 0); }
        bf16* Y = (bf16*)(a.ws + WS_Y) + (size_t)(T0 + rt + fr) * D + 512 + g * 128;
#pragma unroll
        for (int nt = 0; nt < 4; ++nt) { const int d = db + nt * 16 + kg * 4;
            v2u w; w.x = pk2(acc[nt][0] * sc[nt][0], acc[nt][1] * sc[nt][1]); w.y = pk2(acc[nt][2] * sc[nt][2], acc[nt][3] * sc[nt][3]); *(v2u*)(Y + d) = w; }
    }
    __syncthreads();
}
__device__ __forceinline__ void conv_item(const Args& a, int l, int u, int wave) {
    int lane; asm volatile("v_mbcnt_lo_u32_b32 %0, -1, 0\n\tv_mbcnt_hi_u32_b32 %0, -1, %0" : "=v"(lane));
    const bf16* P = (const bf16*)(a.ws + WS_PROJ); const bf16* Ch = P + 4 * PROJ_T; const bf16* Cb = P + 5 * PROJ_T; const bf16* Cc = P + 6 * PROJ_T;
    const int tid = wave * 64 + lane, c0 = (tid & 63) * 8, t0 = u * 64 + (tid >> 6) * 8, s0 = t0 & (SEQ - 1);
    float wgt[3][8];
#pragma unroll
    for (int j = 0; j < 3; ++j) { const float* w = a.conv_w + ((size_t)l * 3 + j) * MIXW + c0; const f32x4 w0 = *(const f32x4*)w, w1 = *(const f32x4*)(w + 4);
#pragma unroll
        for (int k = 0; k < 4; ++k) { wgt[j][k] = w0[k]; wgt[j][4 + k] = w1[k]; } }
    v4u hv[10], cv[10], bv[8];
#pragma unroll
    for (int k = 0; k < 10; ++k) { const int i = k - 2; const size_t r = (size_t)(s0 + i >= 0 ? t0 + i : t0) * MIXW + c0; hv[k] = *(const v4u*)(Ch + r); cv[k] = *(const v4u*)(Cc + r); }
#pragma unroll
    for (int i = 0; i < 8; ++i) bv[i] = *(const v4u*)(Cb + (size_t)(t0 + i) * MIXW + c0);
    float z2[8], z1[8];
#pragma unroll
    for (int k = 0; k < 8; ++k) { z2[k] = 0.f; z1[k] = 0.f; }
#pragma unroll
    for (int k = 0; k < 10; ++k) { const int i = k - 2; const float msk = s0 + i >= 0 ? 1.f : 0.f;
        float z[8];
        z[0] = bflo(hv[k].x) * bflo(cv[k].x) * msk; z[1] = bfhi(hv[k].x) * bfhi(cv[k].x) * msk; z[2] = bflo(hv[k].y) * bflo(cv[k].y) * msk; z[3] = bfhi(hv[k].y) * bfhi(cv[k].y) * msk;
        z[4] = bflo(hv[k].z) * bflo(cv[k].z) * msk; z[5] = bfhi(hv[k].z) * bfhi(cv[k].z) * msk; z[6] = bflo(hv[k].w) * bflo(cv[k].w) * msk; z[7] = bfhi(hv[k].w) * bfhi(cv[k].w) * msk;
        if (i >= 0) { const v4u b = bv[i]; float o[8];
            const float bb[8] = {bflo(b.x), bfhi(b.x), bflo(b.y), bfhi(b.y), bflo(b.z), bfhi(b.z), bflo(b.w), bfhi(b.w)};
#pragma unroll
            for (int q = 0; q < 8; ++q) o[q] = bb[q] * (wgt[0][q] * z2[q] + wgt[1][q] * z1[q] + wgt[2][q] * z[q]);
            v4u ov; ov.x = pk2(o[0], o[1]); ov.y = pk2(o[2], o[3]); ov.z = pk2(o[4], o[5]); ov.w = pk2(o[6], o[7]);
            *(v4u*)((bf16*)(a.ws + WS_Y) + (size_t)(t0 + i) * D + 1024 + c0) = ov; }
#pragma unroll
        for (int q = 0; q < 8; ++q) { z2[q] = z1[q]; z1[q] = z[q]; }
    }
}
__device__ __forceinline__ void mixers_fast(const Args& a, int lq, LAS char* lds, int wave, int lane, int G, int blk) {
    const int l = lq;
    AttBlk b0, b1; att_sched(blk >> 4, b0, b1); const int bh = blk & 15;
    unsigned* head = (unsigned*)(a.ws + WS_QCTR) + 64 * lq;
    volatile LAS unsigned* slot = (volatile LAS unsigned*)(lds + att::LDS_END);
    unsigned tk = 0;
    for (int stage = 0;; ++stage) {
        if (stage < 2) { AttBlk k = stage ? b1 : b0; if (G != 256) { k.mode = blk >> 7; k.qb = stage ? -1 : 7 - ((blk & 127) >> 4); k.part = 0; }
            if (k.qb >= 0) attention_block(a, l, bh, k, lds, wave);
            continue; }
        if (stage == 2) { if (G == 256 && b0.part == 2) combine_pair(a, l, (b0.qb - 4) * 16 + bh, wave); continue; }
        if (stage == 3 && wave == 0 && lane == 0) tk = __hip_atomic_fetch_add(head, 1u, __ATOMIC_RELAXED, __HIP_MEMORY_SCOPE_AGENT);
        if (wave == 0 && lane == 0) *slot = tk;
        __syncthreads();
        const unsigned it = *slot;
        __syncthreads();
        if (it >= (unsigned)(N_POOL_UNITS + N_CONV_UNITS)) break;
        if (wave == 0 && lane == 0) tk = __hip_atomic_fetch_add(head, 1u, __ATOMIC_RELAXED, __HIP_MEMORY_SCOPE_AGENT);
        if (it < (unsigned)N_POOL_UNITS) pool_item(a, l, (int)it, lds, wave); else conv_item(a, l, (int)it - N_POOL_UNITS, wave);
    }
}
__device__ __forceinline__ void p0_cmax(const Args& a, int gw, int NGW, int lane) {
    unsigned char* ws = a.ws;
    {
        constexpr int NCC = (INW + 255) / 256;
        for (int it = gw; it < DEPTH * 32 * NCC; it += NGW) { const int l = it / (32 * NCC), r = it % (32 * NCC), kc = r / NCC, cc = r % NCC; const int c0 = cc * 256 + 4 * lane;
            if (c0 + 3 < INW) { const float* W = a.w_in + (size_t)l * D * INW + (size_t)(kc * 64) * INW + c0; const float* g = a.norm_mix + l * D + kc * 64;
                float m0 = 0.f, m1 = 0.f, m2 = 0.f, m3 = 0.f;
#pragma unroll 8
                for (int k = 0; k < 64; ++k) { const f32x4 w = *(const f32x4*)(W + (size_t)k * INW); const float gk = fabsf(g[k]);
                    m0 = fmaxf(m0, fabsf(w[0]) * gk); m1 = fmaxf(m1, fabsf(w[1]) * gk); m2 = fmaxf(m2, fabsf(w[2]) * gk); m3 = fmaxf(m3, fabsf(w[3]) * gk); }
                unsigned* cm = (unsigned*)(ws + WS_CMAX) + l * INW + c0;
                const unsigned u0 = __float_as_uint(m0), u1 = __float_as_uint(m1), u2 = __float_as_uint(m2), u3 = __float_as_uint(m3);
                __hip_atomic_fetch_max(cm + 0, u0, __ATOMIC_RELAXED, __HIP_MEMORY_SCOPE_AGENT); __hip_atomic_fetch_max(cm + 1, u1, __ATOMIC_RELAXED, __HIP_MEMORY_SCOPE_AGENT);
                __hip_atomic_fetch_max(cm + 2, u2, __ATOMIC_RELAXED, __HIP_MEMORY_SCOPE_AGENT); __hip_atomic_fetch_max(cm + 3, u3, __ATOMIC_RELAXED, __HIP_MEMORY_SCOPE_AGENT); } }
    }
}
__device__ __forceinline__ void p0_prologue(const Args& a, LAS unsigned char* lds, int gw, int NGW, int wave, int lane) {
    unsigned char* ws = a.ws;
    LAS float* scr = (LAS float*)(lds + wave * 16384);
    constexpr int I_SQ = (D / 64) * (D / 32), I_BR = (MIXW / 64) * (D / 32);
    constexpr int I_LAYER = 4 * I_BR + 2 * I_SQ;
    for (int it = gw; it < DEPTH * I_LAYER; it += NGW) {
        const int l = it / I_LAYER; int r = it - l * I_LAYER;
        if (r < 4 * I_BR) { const int g = r / I_BR, rr = r % I_BR, kb = rr / (D / 32), nb = rr % (D / 32);
            tr_item<false>(a.w_branch + ((size_t)l * 4 + g) * MIXW * D, D, nullptr, (bf16*)(ws + WS_WBR + l * SQ_BYTES), D, g * MIXW, scr, 64 * kb, 32 * nb, lane); continue; }
        r -= 4 * I_BR;
        if (r < I_SQ) { const int kb = r / (D / 32), nb = r % (D / 32);
            tr_item<false>(a.w_out + (size_t)l * D * D, D, nullptr, (bf16*)(ws + WS_WOUT + l * SQ_BYTES), D, 0, scr, 64 * kb, 32 * nb, lane); continue; }
        r -= I_SQ;
        { const int kb = r / (D / 32), nb = r % (D / 32);
            tr_item<false>(a.peer_wq + (size_t)l * D * D, D, a.norm_ffn + l * D, (bf16*)(ws + WS_WQ + l * SQ_BYTES), D, 0, scr, 64 * kb, 32 * nb, lane); }
    }
    for (int it = gw; it < DEPTH * 4 * 8; it += NGW) { const int lg = it >> 3, r = it & 7;
        tr_item<false>(a.pool_w + (size_t)lg * 128 * 128, 128, nullptr, (bf16*)(ws + WS_POOLW) + (size_t)lg * 128 * 128, 128, 0, scr, 64 * (r >> 2), 32 * (r & 3), lane); }
    {
        constexpr int NR = 2 * DEPTH * PEER_E;
        f32x4 nv[8];
        if (gw < NR) { const int t = gw / (DEPTH * PEER_E), row = gw - t * (DEPTH * PEER_E); const float* src = (t ? a.peer_v : a.peer_u) + (size_t)row * D + 4 * lane;
#pragma unroll
            for (int j = 0; j < 8; ++j) nv[j] = *(const f32x4*)(src + 256 * j); }
        for (int r = gw; r < NR; r += NGW) { const int t = r / (DEPTH * PEER_E), row = r - t * (DEPTH * PEER_E);
            f32x4 v[8]; float am = 0.f;
#pragma unroll
            for (int j = 0; j < 8; ++j) v[j] = nv[j];
            { const int r2 = r + NGW; if (r2 < NR) { const int t2 = r2 / (DEPTH * PEER_E), row2 = r2 - t2 * (DEPTH * PEER_E); const float* src = (t2 ? a.peer_v : a.peer_u) + (size_t)row2 * D + 4 * lane;
#pragma unroll
                for (int j = 0; j < 8; ++j) nv[j] = *(const f32x4*)(src + 256 * j); } }
#pragma unroll
            for (int j = 0; j < 8; ++j) am = fmaxf(am, fmaxf(fmaxf(fabsf(v[j][0]), fabsf(v[j][1])), fmaxf(fabsf(v[j][2]), fabsf(v[j][3]))));
            am = wave_max(am, lane);
            const float inv = am > 0.f ? 127.0f / am : 0.f, off = 0.f;
            unsigned char* dst = ws + (t ? WS_PV : WS_PU) + (size_t)row * D + 4 * lane;
#pragma unroll
            for (int j = 0; j < 8; ++j) { const int q0 = (int)(rintf(v[j][0] * inv) + off), q1 = (int)(rintf(v[j][1] * inv) + off), q2 = (int)(rintf(v[j][2] * inv) + off), q3 = (int)(rintf(v[j][3] * inv) + off);
                *(unsigned*)(dst + 256 * j) = (unsigned)(q0 & 255) | ((unsigned)(q1 & 255) << 8) | ((unsigned)(q2 & 255) << 16) | ((unsigned)(q3 & 255) << 24); }
            if (lane == 0) ((float*)(ws + (t ? WS_SV : WS_SU)))[row] = am * (1.0f / 127.0f); }
    }
    { bf16* pk = (bf16*)(ws + WS_PK); const size_t n8 = (size_t)DEPTH * 8 * 2 * 128 * 128 / 8;
      for (size_t i = (size_t)gw * 64 + lane; i < n8; i += (size_t)NGW * 64) { const size_t ln = i & 63, cs = (i >> 6) & 7, kb = (i >> 9) & 3, lhp = i >> 11; const size_t so = lhp * 16384 + (kb * 32 + (ln & 31)) * 128 + cs * 16 + (ln >> 5) * 8;
          const f32x4 v0 = *(const f32x4*)(a.peer_keys + so), v1 = *(const f32x4*)(a.peer_keys + so + 4);
          v4u o; o.x = pk2(v0[0], v0[1]); o.y = pk2(v0[2], v0[3]); o.z = pk2(v1[0], v1[1]); o.w = pk2(v1[2], v1[3]); *(v4u*)(pk + i * 8) = o; } }
    {
        float* wf = (float*)(ws + WS_WF); float* binr = (float*)(ws + WS_BINR);
        const int gt = gw * 64 + lane, NGT = NGW * 64;
        for (int i = gt; i < DEPTH * 4 * D; i += NGT) { const int l = i / (4 * D), h = (i / D) & 3, k = i % D; wf[i] = a.w_in[(size_t)l * D * INW + (size_t)k * INW + 1536 + h] * a.norm_mix[l * D + k]; }
        for (int i = gt; i < DEPTH * NPROJ; i += NGT) { const int l = i / NPROJ, j = i % NPROJ; binr[i] = a.b_in[l * INW + colmap_in(j)]; }
    }
    {
        unsigned long long* ssq = (unsigned long long*)(ws + WS_SSQ);
        for (int m0 = gw; m0 < M; m0 += 2 * NGW) {
            const int m1 = m0 + NGW; const bool ok1 = m1 < M; const int mr[2] = {m0, ok1 ? m1 : m0};
            f32x4 v[2][8];
#pragma unroll
            for (int r = 0; r < 2; ++r)
#pragma unroll
                for (int j = 0; j < 8; ++j) v[r][j] = *(const f32x4*)(a.x + (size_t)mr[r] * D + j * 256 + lane * 4);
#pragma unroll
            for (int r = 0; r < 2; ++r) { float s = 0.f, am = 0.f;
#pragma unroll
                for (int j = 0; j < 8; ++j) { s += (v[r][j][0] * v[r][j][0] + v[r][j][1] * v[r][j][1]) + (v[r][j][2] * v[r][j][2] + v[r][j][3] * v[r][j][3]);
                    am = fmaxf(am, fmaxf(fmaxf(fabsf(v[r][j][0]), fabsf(v[r][j][1])), fmaxf(fabsf(v[r][j][2]), fabsf(v[r][j][3])))); }
                s = wave_sum(s, lane); am = wave_max(am, lane);
                if (r == 0 || ok1) { const int m = mr[r];
                    if (lane == 0) { ssq[m] = (unsigned long long)((double)s * 4294967296.0); ((float*)(ws + WS_RSA))[m] = rsqrtf(s * (1.0f / D) + EPS) * am * (1.0f / 127.0f); }
                    const float inv = am > 0.f ? 127.0f / am : 0.f; unsigned char* q8 = ws + WS_HB8 + (size_t)m * D + 4 * lane;
#pragma unroll
                    for (int j = 0; j < 8; ++j) *(unsigned*)(q8 + 256 * j) = ((unsigned)((int)rintf(v[r][j][0] * inv) & 255)) | ((unsigned)((int)rintf(v[r][j][1] * inv) & 255) << 8) | ((unsigned)((int)rintf(v[r][j][2] * inv) & 255) << 16) | ((unsigned)((int)rintf(v[r][j][3] * inv) & 255) << 24); } } }
    }
}
__device__ __forceinline__ void p0_win_i8(const Args& a, LAS unsigned char* lds, int gw, int NGW, int wave, int lane) {
    unsigned char* ws = a.ws; LAS float* scr = (LAS float*)(lds + wave * 16384);
    constexpr int I_WIN = (D / 64) * (NPROJ / 32);
    for (int it = gw; it < DEPTH * I_WIN; it += NGW) { const int l = it / I_WIN, r = it % I_WIN, kb = r / (NPROJ / 32), nb = r % (NPROJ / 32);
        tr_item_i8(a.w_in + (size_t)l * D * INW, a.norm_mix + l * D, (const unsigned*)(ws + WS_CMAX) + l * INW, ws + WS_WIN + l * WIN_BYTES, scr, 64 * kb, 32 * nb, lane); }
    float* sw = (float*)(ws + WS_SW); const int gt = gw * 64 + lane, NGT = NGW * 64;
    bf16* swh = (bf16*)(ws + WS_SWH); bf16* bih = (bf16*)(ws + WS_BIH);
    for (int i = gt; i < DEPTH * NPROJ; i += NGT) { const int l = i / NPROJ, j = i % NPROJ; const float s = __builtin_bit_cast(float, ((const unsigned*)(ws + WS_CMAX))[l * INW + colmap_in(j)]) * (1.0f / 127.0f);
        sw[i] = s; swh[i] = (bf16)f2bf(s); bih[i] = (bf16)f2bf(a.b_in[l * INW + colmap_in(j)]); }
}
__device__ __forceinline__ void quant_rows(const Args& a, int l, int gw, int NGW, int lane) {
    unsigned char* ws = a.ws; const bf16* HB = (const bf16*)(ws + WS_HB);
    for (int m0 = gw; m0 < M; m0 += 2 * NGW) {
        const int m1 = m0 + NGW; const bool ok1 = m1 < M; const int mr[2] = {m0, ok1 ? m1 : m0};
        v4u w[2][4];
#pragma unroll
        for (int r = 0; r < 2; ++r)
#pragma unroll
            for (int j = 0; j < 4; ++j) w[r][j] = *(const v4u*)(HB + (size_t)mr[r] * D + j * 512 + lane * 8);
#pragma unroll
        for (int r = 0; r < 2; ++r) { float am = 0.f; float v[4][8];
#pragma unroll
            for (int j = 0; j < 4; ++j) { v[j][0] = bflo(w[r][j].x); v[j][1] = bfhi(w[r][j].x); v[j][2] = bflo(w[r][j].y); v[j][3] = bfhi(w[r][j].y); v[j][4] = bflo(w[r][j].z); v[j][5] = bfhi(w[r][j].z); v[j][6] = bflo(w[r][j].w); v[j][7] = bfhi(w[r][j].w);
#pragma unroll
                for (int e = 0; e < 8; ++e) am = fmaxf(am, fabsf(v[j][e])); }
            am = wave_max(am, lane);
            if (r == 0 || ok1) {
                if (lane == 0) ((float*)(ws + WS_RSA))[mr[r]] = rsqrtf(ssa_to_f(((const unsigned long long*)(ws + WS_SSQ))[(size_t)l * M + mr[r]]) * (1.0f / D) + EPS) * am * (1.0f / 127.0f);
                const float inv = am > 0.f ? 127.0f / am : 0.f; unsigned char* q8 = ws + WS_HB8 + (size_t)mr[r] * D + 8 * lane;
#pragma unroll
                for (int j = 0; j < 4; ++j) { v2u o;
                    o.x = ((unsigned)((int)rintf(v[j][0] * inv) & 255)) | ((unsigned)((int)rintf(v[j][1] * inv) & 255) << 8) | ((unsigned)((int)rintf(v[j][2] * inv) & 255) << 16) | ((unsigned)((int)rintf(v[j][3] * inv) & 255) << 24);
                    o.y = ((unsigned)((int)rintf(v[j][4] * inv) & 255)) | ((unsigned)((int)rintf(v[j][5] * inv) & 255) << 8) | ((unsigned)((int)rintf(v[j][6] * inv) & 255) << 16) | ((unsigned)((int)rintf(v[j][7] * inv) & 255) << 24);
                    *(v2u*)(q8 + 512 * j) = o; } } }
    }
}

__device__ __forceinline__ void forget_logits(const Args& a, int l, int gw, int NGW, int lane) {
    unsigned char* ws = a.ws; const bf16* HB = (const bf16*)(ws + WS_HB); const float* wf = (const float*)(ws + WS_WF) + l * 4 * D; const unsigned long long* ssq = (const unsigned long long*)(ws + WS_SSQ) + l * M;
    float* logf = (float*)(ws + WS_LOGF);
    f32x4 w[4][4][2];
#pragma unroll
    for (int h = 0; h < 4; ++h)
#pragma unroll
        for (int j = 0; j < 4; ++j) { const int k0 = j * 512 + lane * 8; w[h][j][0] = *(const f32x4*)(wf + h * D + k0); w[h][j][1] = *(const f32x4*)(wf + h * D + k0 + 4); }
    float bias[4];
#pragma unroll
    for (int h = 0; h < 4; ++h) bias[h] = a.b_in[l * INW + 1536 + h];
    for (int m0 = gw; m0 < M; m0 += 2 * NGW) {
        const int m1 = m0 + NGW; const bool ok1 = m1 < M; const int mr[2] = {m0, ok1 ? m1 : m0};
        f32x4 x[2][4][2];
#pragma unroll
        for (int r = 0; r < 2; ++r)
#pragma unroll
            for (int j = 0; j < 4; ++j) { const int k0 = j * 512 + lane * 8;
                if (l == 0) { x[r][j][0] = *(const f32x4*)(a.x + (size_t)mr[r] * D + k0); x[r][j][1] = *(const f32x4*)(a.x + (size_t)mr[r] * D + k0 + 4); }
                else { const v4u xv = *(const v4u*)(HB + (size_t)mr[r] * D + k0); x[r][j][0] = (f32x4){bflo(xv.x), bfhi(xv.x), bflo(xv.y), bfhi(xv.y)}; x[r][j][1] = (f32x4){bflo(xv.z), bfhi(xv.z), bflo(xv.w), bfhi(xv.w)}; } }
#pragma unroll
        for (int r = 0; r < 2; ++r) { const float rs = rsqrtf(ssa_to_f(ssq[mr[r]]) * (1.0f / D) + EPS);
#pragma unroll
            for (int h = 0; h < 4; ++h) { f32x4 s4 = {0.f, 0.f, 0.f, 0.f};
#pragma unroll
                for (int j = 0; j < 4; ++j) { s4 += x[r][j][0] * w[h][j][0]; s4 += x[r][j][1] * w[h][j][1]; }
                const float z = wave_sum((s4[0] + s4[1]) + (s4[2] + s4[3]), lane) * rs + bias[h];
                const float ls = fminf(z, 0.f) - __logf(1.0f + __expf(-fabsf(z)));
                if (lane == h && (r == 0 || ok1)) logf[mr[r] * 4 + h] = ls; } }
    }
}
__device__ __forceinline__ float gelu_tanh(float x) { const float u = 1.5957691216057308f * (x + 0.044715f * x * x * x); return x / (1.0f + __expf(-u)); }
constexpr int PEER_TOK = 32;
constexpr int PL_IDX = 0, PL_GATE = PEER_TOK * 128 * 4, PL_TAB = 2 * PEER_TOK * 128 * 4;
__device__ __forceinline__ int f2key(float f) { const int b = __builtin_bit_cast(int, f); return b ^ ((b >> 31) & 0x7fffffff); }
__device__ __forceinline__ float key2f(int k) { return __builtin_bit_cast(float, k ^ ((k >> 31) & 0x7fffffff)); }
#define CE_DESC(x, y) do { const int hi_ = (x) > (y) ? (x) : (y), lo_ = (x) > (y) ? (y) : (x); (x) = hi_; (y) = lo_; } while (0)
__device__ __forceinline__ void sort16_desc(int* v) {
#pragma unroll
    for (int k = 2; k <= 16; k <<= 1)
#pragma unroll
        for (int j = k >> 1; j > 0; j >>= 1)
#pragma unroll
            for (int i = 0; i < 16; ++i) { const int l = i ^ j; if (l > i) { if ((i & k) == 0) CE_DESC(v[i], v[l]); else CE_DESC(v[l], v[i]); } }
}
__device__ __forceinline__ void merge_top16(int* a, const int* b) {
#pragma unroll
    for (int i = 0; i < 16; ++i) a[i] = a[i] > b[15 - i] ? a[i] : b[15 - i];
#pragma unroll
    for (int j = 8; j > 0; j >>= 1)
#pragma unroll
        for (int i = 0; i < 16; ++i) { const int l = i ^ j; if (l > i) CE_DESC(a[i], a[l]); }
}
__device__ __forceinline__ void top16_of_64(int* v) {
    sort16_desc(v); sort16_desc(v + 16); sort16_desc(v + 32); sort16_desc(v + 48);
    merge_top16(v, v + 16); merge_top16(v + 32, v + 48); merge_top16(v, v + 32);
}
constexpr int cand_slot(int i, int j) {
    int n = 0;
    for (int a = 0; a < 16; ++a) for (int b = 0; b < 16; ++b) { if ((a + 1) * (b + 1) <= 16) { if (a == i && b == j) return n; ++n; } }
    return -1;
}
__device__ __forceinline__ void peer_retrieve(const Args& a, int l, int t0, int h, LAS char* lds, int wave) {
    typedef short bf16x8 __attribute__((ext_vector_type(8)));
    typedef float f32x16 __attribute__((ext_vector_type(16)));
    int lane; asm volatile("v_mbcnt_lo_u32_b32 %0, -1, 0\n\tv_mbcnt_hi_u32_b32 %0, -1, %0" : "=v"(lane));
    const int r32 = lane & 31, hi = lane >> 5, hi4 = hi * 4;
    const bf16* Q = (const bf16*)(a.ws + WS_Q) + ((size_t)(t0 >> 5) * 8 + h) * 2 * 8 * 512 + lane * 8;
    const bf16* PK = (const bf16*)(a.ws + WS_PK) + ((size_t)(l * 8 + h) * 2) * 128 * 128 + lane * 8;
    int top[2][16];
#pragma unroll
    for (int p = 0; p < 2; ++p) {
        f32x16 acc[4] = {};
        bf16x8 qf[8];
#pragma unroll
        for (int cs = 0; cs < 8; ++cs) qf[cs] = *(const bf16x8*)(Q + (p * 8 + cs) * 512);
#pragma unroll
        for (int kb = 0; kb < 4; ++kb) { bf16x8 kf[8];
#pragma unroll
            for (int cs = 0; cs < 8; ++cs) kf[cs] = *(const bf16x8*)(PK + (size_t)p * 128 * 128 + ((size_t)kb * 8 + cs) * 512);
#pragma unroll
            for (int cs = 0; cs < 8; ++cs) acc[kb] = __builtin_amdgcn_mfma_f32_32x32x16_bf16(kf[cs], qf[cs], acc[kb], 0, 0, 0); }
        int v[64];
#pragma unroll
        for (int kb = 0; kb < 4; ++kb)
#pragma unroll
            for (int r = 0; r < 16; ++r) { const int c = kb * 32 + (r & 3) + 8 * (r >> 2);
                v[kb * 16 + r] = (f2key(acc[kb][r]) & ~127) | (c | hi4); }
        top16_of_64(v);
        int mine[16], other[16];
#pragma unroll
        for (int i = 0; i < 16; ++i) { auto rr = __builtin_amdgcn_permlane32_swap((unsigned)v[i], (unsigned)v[i], false, false); mine[i] = (int)rr[0]; other[i] = (int)rr[1]; }
        merge_top16(mine, other);
#pragma unroll
        for (int i = 0; i < 16; ++i) top[p][i] = mine[i];
    }
    LAS int* tab = (LAS int*)(lds + PL_TAB) + (wave * 64 + lane) * 32;
    float sA[16], sB[16];
#pragma unroll
    for (int i = 0; i < 16; ++i) { sA[i] = key2f(top[0][i] & ~127); sB[i] = key2f(top[1][i] & ~127); tab[i] = top[0][i] & 127; tab[16 + i] = top[1][i] & 127; }
    int c[64];
#pragma unroll
    for (int n = 0; n < 64; ++n) c[n] = (int)0x80000000;
#pragma unroll
    for (int i = 0; i < 16; ++i)
#pragma unroll
        for (int j = 0; j < 16; ++j) if ((i + 1) * (j + 1) <= 16) c[cand_slot(i, j)] = (f2key(sA[i] + sB[j]) & ~255) | (16 * i + j);
    top16_of_64(c);
    float ex[16]; float sum = 0.f; const float mx = key2f(c[0] & ~255);
#pragma unroll
    for (int w = 0; w < 16; ++w) { ex[w] = __expf(key2f(c[w] & ~255) - mx); sum += ex[w]; }
    const float inv = 1.0f / sum;
    asm volatile("s_waitcnt lgkmcnt(0)" ::: "memory");
    LAS int* oi = (LAS int*)(lds + PL_IDX) + r32 * 128 + h * 16; LAS float* og = (LAS float*)(lds + PL_GATE) + r32 * 128 + h * 16;
#pragma unroll
    for (int w = 0; w < 16; ++w) { const int id = c[w] & 255; const int e = tab[id >> 4] * 128 + tab[16 + (id & 15)];
        if ((w >> 3) == hi) { oi[w] = e; og[w] = ex[w] * inv; } }
}
constexpr size_t WS_IDX = 816 * MiB;
constexpr size_t WS_GATE = 820 * MiB;
constexpr size_t WS_XQ = 824 * MiB;
constexpr size_t WS_SX = 856 * MiB;
constexpr size_t WS_PART = 857 * MiB;
constexpr size_t WS_SUT = 890 * MiB;
constexpr size_t WS_END2 = 1024 * MiB;
#ifndef PEER_NB
#define PEER_NB 8
#endif
constexpr int NSLICE = 8, SLW = D / NSLICE;
__device__ __forceinline__ void peer_publish4(const Args& a, int l, int t0, LAS char* lds, int tl0) {
    static_assert(PEER_TOK / NWAVES == 4, "four tokens per wave");
    int lane; LANE_ID(lane);
    unsigned char* ws = a.ws;
    {   const float* SU = (const float*)(ws + WS_SU) + l * PEER_E; const float* SV = (const float*)(ws + WS_SV) + l * PEER_E;
        int i0[4], i1[4]; float g0[4], g1[4], su0[4], su1[4], sv0[4], sv1[4];
#pragma unroll
        for (int k = 0; k < 4; ++k) { const int tl = tl0 + k; i0[k] = ((const LAS int*)(lds + PL_IDX))[tl * 128 + lane]; i1[k] = ((const LAS int*)(lds + PL_IDX))[tl * 128 + 64 + lane];
            g0[k] = ((const LAS float*)(lds + PL_GATE))[tl * 128 + lane]; g1[k] = ((const LAS float*)(lds + PL_GATE))[tl * 128 + 64 + lane]; }
#pragma unroll
        for (int k = 0; k < 4; ++k) { su0[k] = SU[i0[k]]; su1[k] = SU[i1[k]]; sv0[k] = SV[i0[k]]; sv1[k] = SV[i1[k]]; }
#pragma unroll
        for (int k = 0; k < 4; ++k) { const int t = t0 + k; int* gi = (int*)(ws + WS_IDX) + (size_t)t * 128; float* gg = (float*)(ws + WS_GATE) + (size_t)t * 128; float* gs = (float*)(ws + WS_SUT) + (size_t)t * 128;
            gi[lane] = i0[k]; gi[64 + lane] = i1[k]; gs[lane] = su0[k]; gs[64 + lane] = su1[k]; gg[lane] = g0[k] * sv0[k]; gg[64 + lane] = g1[k] * sv1[k]; }
    }
    const unsigned long long* ssa1 = (const unsigned long long*)(ws + WS_SSA) + l * M;
    const float* gn = a.norm_ffn + l * D;
    f32x4 g[2][4]; v4u hw[4][2][2]; float rs[4];
#pragma unroll
    for (int i = 0; i < 2; ++i)
#pragma unroll
        for (int q = 0; q < 4; ++q) g[i][q] = *(const f32x4*)(gn + 16 * lane + 1024 * i + 4 * q);
#pragma unroll
    for (int k = 0; k < 4; ++k) { const bf16* HB = (const bf16*)(ws + WS_HB) + (size_t)(t0 + k) * D; rs[k] = rsqrtf(ssa_to_f(ssa1[t0 + k]) * (1.0f / D) + EPS);
#pragma unroll
        for (int i = 0; i < 2; ++i) { hw[k][i][0] = *(const v4u*)(HB + 16 * lane + 1024 * i); hw[k][i][1] = *(const v4u*)(HB + 16 * lane + 1024 * i + 8); } }
#pragma unroll
    for (int k = 0; k < 4; ++k) { const int t = t0 + k;
        float xf[32]; float am = 0.f;
#pragma unroll
        for (int i = 0; i < 2; ++i) { const unsigned hq[8] = {hw[k][i][0].x, hw[k][i][0].y, hw[k][i][0].z, hw[k][i][0].w, hw[k][i][1].x, hw[k][i][1].y, hw[k][i][1].z, hw[k][i][1].w};
#pragma unroll
            for (int q = 0; q < 4; ++q) {
                xf[16 * i + 4 * q + 0] = bflo(hq[2 * q]) * rs[k] * g[i][q][0]; xf[16 * i + 4 * q + 1] = bfhi(hq[2 * q]) * rs[k] * g[i][q][1];
                xf[16 * i + 4 * q + 2] = bflo(hq[2 * q + 1]) * rs[k] * g[i][q][2]; xf[16 * i + 4 * q + 3] = bfhi(hq[2 * q + 1]) * rs[k] * g[i][q][3]; } }
#pragma unroll
        for (int e = 0; e < 32; ++e) am = fmaxf(am, fabsf(xf[e]));
        am = wave_max(am, lane);
        const float inv = am > 0.f ? 127.0f / am : 0.f;
        if (lane == 0) ((float*)(ws + WS_SX))[t] = am * (1.0f / 127.0f);
        unsigned char* xq = ws + WS_XQ + (size_t)t * 4096;
#pragma unroll
        for (int i = 0; i < 2; ++i) { v4u ph, pl;
#pragma unroll
            for (int d = 0; d < 4; ++d) { unsigned wh = 0, wl = 0;
#pragma unroll
                for (int b = 0; b < 4; ++b) { const float sv = xf[16 * i + 4 * d + b] * inv, hq = rintf(sv), lq = rintf((sv - hq) * 128.0f);
                    wh |= ((unsigned)((int)hq & 255)) << (8 * b); wl |= ((unsigned)((int)lq & 255)) << (8 * b); }
                ph[d] = wh; pl[d] = wl; }
            *(v4u*)(xq + 16 * lane + 1024 * i) = ph; *(v4u*)(xq + 2048 + 16 * lane + 1024 * i) = pl; } }
}
struct PeerItems { int pos, npop, rank, nloc, wave;
    __device__ __forceinline__ int nblk() const { return (M / PEER_TOK - rank + nloc - 1) / nloc; }
    __device__ __forceinline__ int count() const { return ((NSLICE - pos + npop - 1) / npop) * nblk() * (PEER_TOK / NWAVES); }
    __device__ __forceinline__ void get(int n, int& s, int& t) const { constexpr int per = PEER_TOK / NWAVES; const int k = n % per, r = n / per, nb = nblk();
        s = pos + (r / nb) * npop; t = (rank + (r % nb) * nloc) * PEER_TOK + wave * per + k; } };
__device__ __forceinline__ void peer_u_wave(const Args& a, int l, const PeerItems& it) {
    int lane; LANE_ID(lane);
    unsigned char* ws = a.ws; const int sub = lane & 15, grp = lane >> 4;
    const __amdgpu_buffer_rsrc_t rU = __builtin_amdgcn_make_buffer_rsrc((void*)(ws + WS_PU + (size_t)l * PE_BYTES), 0, 0x7fffffff, 0x00020000);
    const __amdgpu_buffer_rsrc_t rW = __builtin_amdgcn_make_buffer_rsrc((void*)ws, 0, 0x7fffffff, 0x00020000);
    const int N = it.count(); if (N <= 0) return;
    int s, t; it.get(0, s, t);
    int idc[2], idn[2] = {0, 0}; v4u xhc, xlc, xhn = {}, xln = {}; v4u wA[PEER_NB], wB[PEER_NB];
#define PU_META(I0, I1, XH, XL, S_, T_) do { I0 = (int)__builtin_amdgcn_raw_buffer_load_b32(rW, 4 * lane, (int)WS_IDX + (T_) * 512, 0); I1 = (int)__builtin_amdgcn_raw_buffer_load_b32(rW, 4 * lane, (int)WS_IDX + (T_) * 512 + 256, 0); \
        XH = __builtin_amdgcn_raw_buffer_load_b128(rW, 16 * sub, (int)WS_XQ + (T_) * 4096 + SLW * (S_), 0); XL = __builtin_amdgcn_raw_buffer_load_b128(rW, 16 * sub, (int)WS_XQ + (T_) * 4096 + 2048 + SLW * (S_), 0); } while (0)
#define PU_ISSUE(W, ID, Q, S_) do { _Pragma("unroll") for (int j = 0; j < PEER_NB; ++j) { const int e_ = shi(ID[(PEER_NB * (Q) + j) >> 4], 4 * ((PEER_NB * (Q) + j) & 15) + grp); W[j] = __builtin_amdgcn_raw_buffer_load_b128(rU, e_ * D + SLW * (S_) + 16 * sub, 0, 0); } } while (0)
#define PU_COMP(W, Q) do { _Pragma("unroll") for (int j = 0; j < PEER_NB; ++j) { int dh = 0, dl = 0; \
            dh = __builtin_amdgcn_sdot4((int)W[j].x, (int)xhc.x, dh, false); dl = __builtin_amdgcn_sdot4((int)W[j].x, (int)xlc.x, dl, false); \
            dh = __builtin_amdgcn_sdot4((int)W[j].y, (int)xhc.y, dh, false); dl = __builtin_amdgcn_sdot4((int)W[j].y, (int)xlc.y, dl, false); \
            dh = __builtin_amdgcn_sdot4((int)W[j].z, (int)xhc.z, dh, false); dl = __builtin_amdgcn_sdot4((int)W[j].z, (int)xlc.z, dl, false); \
            dh = __builtin_amdgcn_sdot4((int)W[j].w, (int)xhc.w, dh, false); dl = __builtin_amdgcn_sdot4((int)W[j].w, (int)xlc.w, dl, false); \
            float p_ = (float)dh + (float)dl * (1.0f / 128.0f); \
            p_ += DPP_ROR(p_, 8); p_ += DPP_ROR(p_, 4); p_ += DPP_ROR(p_, 2); p_ += DPP_ROR(p_, 1); \
            if (sub == ((PEER_NB * (Q) + j) & 15)) { if ((PEER_NB * (Q) + j) >> 4) acc1 = p_; else acc0 = p_; } __builtin_amdgcn_sched_barrier(0); } } while (0)
    PU_META(idc[0], idc[1], xhc, xlc, s, t); PU_ISSUE(wA, idc, 0, s); PU_ISSUE(wB, idc, 1, s);
    for (int n = 0; n < N; ++n) {
        int sn = s, tn = t; const bool more = n + 1 < N;
        if (more) it.get(n + 1, sn, tn);
        PU_META(idn[0], idn[1], xhn, xln, sn, tn);
        float acc0 = 0.f, acc1 = 0.f;
        __builtin_amdgcn_sched_barrier(0);
#if PEER_NB == 8
        PU_COMP(wA, 0); PU_ISSUE(wA, idc, 2, s); __builtin_amdgcn_sched_barrier(0);
        PU_COMP(wB, 1); PU_ISSUE(wB, idc, 3, s); __builtin_amdgcn_sched_barrier(0);
        PU_COMP(wA, 2); PU_ISSUE(wA, idn, 0, sn); __builtin_amdgcn_sched_barrier(0);
        PU_COMP(wB, 3); PU_ISSUE(wB, idn, 1, sn); __builtin_amdgcn_sched_barrier(0);
#else
        PU_COMP(wA, 0); PU_ISSUE(wA, idn, 0, sn); __builtin_amdgcn_sched_barrier(0);
        PU_COMP(wB, 1); PU_ISSUE(wB, idn, 1, sn); __builtin_amdgcn_sched_barrier(0);
#endif
        __builtin_amdgcn_raw_buffer_store_b32(__builtin_bit_cast(unsigned, acc0), rW, (4 * sub + grp) * 4, (int)WS_PART + (s * M + t) * 512, 0);
        __builtin_amdgcn_raw_buffer_store_b32(__builtin_bit_cast(unsigned, acc1), rW, (4 * sub + grp) * 4 + 256, (int)WS_PART + (s * M + t) * 512, 0);
        s = sn; t = tn; idc[0] = idn[0]; idc[1] = idn[1]; xhc = xhn; xlc = xln;
    }
#undef PU_META
#undef PU_ISSUE
#undef PU_COMP
}
__device__ __forceinline__ void peer_v_wave(const Args& a, int l, const PeerItems& it) {
    int lane; LANE_ID(lane);
    unsigned char* ws = a.ws; const int sub = lane & 15, grp = lane >> 4;
    const __amdgpu_buffer_rsrc_t rV = __builtin_amdgcn_make_buffer_rsrc((void*)(ws + WS_PV + (size_t)l * PE_BYTES), 0, 0x7fffffff, 0x00020000);
    const __amdgpu_buffer_rsrc_t rW = __builtin_amdgcn_make_buffer_rsrc((void*)ws, 0, 0x7fffffff, 0x00020000);
    const int N = it.count(); if (N <= 0) return;
    int s, t; it.get(0, s, t);
    struct Meta { int id[2]; float gate[2], su[2], pa[2], sx; v2u h1; };
    Meta mc, mn; v4u wA[PEER_NB], wB[PEER_NB];
    const int l4 = 4 * lane;
#define WLD(off_s) __builtin_amdgcn_raw_buffer_load_b32(rW, l4, (int)(off_s), 0)
#define PV_META(MM, S_, T_) do { const int r_ = (T_) * 512; MM.id[0] = (int)WLD(WS_IDX + r_); MM.id[1] = (int)WLD(WS_IDX + r_ + 256); \
        MM.gate[0] = __builtin_bit_cast(float, WLD(WS_GATE + r_)); MM.gate[1] = __builtin_bit_cast(float, WLD(WS_GATE + r_ + 256)); MM.su[0] = __builtin_bit_cast(float, WLD(WS_SUT + r_)); MM.su[1] = __builtin_bit_cast(float, WLD(WS_SUT + r_ + 256)); \
        float a0_ = 0.f, a1_ = 0.f; _Pragma("unroll") for (int q = 0; q < NSLICE; ++q) { const int po_ = (int)WS_PART + (q * M + (T_)) * 512; a0_ += __builtin_bit_cast(float, WLD(po_)); a1_ += __builtin_bit_cast(float, WLD(po_ + 256)); } \
        MM.pa[0] = a0_; MM.pa[1] = a1_; MM.sx = ((const float*)(ws + WS_SX))[T_]; \
        MM.h1 = __builtin_amdgcn_raw_buffer_load_b64(rW, (16 * sub + 4 * grp) * 2, (int)WS_HB + ((T_) * D + SLW * (S_)) * 2, 0); } while (0)
#define PV_ISSUE(W, ID, Q, S_) do { _Pragma("unroll") for (int j = 0; j < PEER_NB; ++j) { const int e_ = shi(ID[(PEER_NB * (Q) + j) >> 4], 4 * ((PEER_NB * (Q) + j) & 15) + grp); W[j] = __builtin_amdgcn_raw_buffer_load_b128(rV, e_ * D + SLW * (S_) + 16 * sub, 0, 0); } } while (0)
#define PV_COMP(W, Q) do { _Pragma("unroll") for (int j4 = 0; j4 < PEER_NB; j4 += 4) { \
            unsigned cp_ = 0; _Pragma("unroll") for (int jj = 0; jj < 4; ++jj) { const int i_ = PEER_NB * (Q) + j4 + jj; cp_ |= ((unsigned)shi(c8[i_ >> 4], 4 * (i_ & 15) + grp) & 255u) << (8 * jj); } \
            _Pragma("unroll") for (int d = 0; d < 4; ++d) { const unsigned a_ = W[j4][d], b_ = W[j4 + 1][d], c_ = W[j4 + 2][d], d_ = W[j4 + 3][d]; \
                const unsigned x0_ = __builtin_amdgcn_perm(b_, a_, 0x05010400u), x1_ = __builtin_amdgcn_perm(b_, a_, 0x07030602u), y0_ = __builtin_amdgcn_perm(d_, c_, 0x05010400u), y1_ = __builtin_amdgcn_perm(d_, c_, 0x07030602u); \
                yi[4 * d + 0] = __builtin_amdgcn_sdot4((int)__builtin_amdgcn_perm(y0_, x0_, 0x05040100u), (int)cp_, yi[4 * d + 0], false); \
                yi[4 * d + 1] = __builtin_amdgcn_sdot4((int)__builtin_amdgcn_perm(y0_, x0_, 0x07060302u), (int)cp_, yi[4 * d + 1], false); \
                yi[4 * d + 2] = __builtin_amdgcn_sdot4((int)__builtin_amdgcn_perm(y1_, x1_, 0x05040100u), (int)cp_, yi[4 * d + 2], false); \
                yi[4 * d + 3] = __builtin_amdgcn_sdot4((int)__builtin_amdgcn_perm(y1_, x1_, 0x07060302u), (int)cp_, yi[4 * d + 3], false); } \
            __builtin_amdgcn_sched_barrier(0); } } while (0)
    PV_META(mc, s, t); PV_ISSUE(wA, mc.id, 0, s); PV_ISSUE(wB, mc.id, 1, s);
    for (int n = 0; n < N; ++n) {
        int sn = s, tn = t; const bool more = n + 1 < N;
        if (more) it.get(n + 1, sn, tn);
        PV_META(mn, sn, tn);
        float coef[2];
#pragma unroll
        for (int hf = 0; hf < 2; ++hf) coef[hf] = gelu_tanh(mc.pa[hf] * mc.su[hf] * mc.sx) * mc.gate[hf];
        const float cmax = wave_max(fmaxf(fabsf(coef[0]), fabsf(coef[1])), lane); const float cinv = cmax > 0.f ? 127.0f / cmax : 0.f, cs = cmax * (1.0f / 127.0f);
        const int c8[2] = {(int)rintf(coef[0] * cinv), (int)rintf(coef[1] * cinv)};
        int yi[16];
#pragma unroll
        for (int k = 0; k < 16; ++k) yi[k] = 0;
        __builtin_amdgcn_sched_barrier(0);
#if PEER_NB == 8
        PV_COMP(wA, 0); PV_ISSUE(wA, mc.id, 2, s); __builtin_amdgcn_sched_barrier(0);
        PV_COMP(wB, 1); PV_ISSUE(wB, mc.id, 3, s); __builtin_amdgcn_sched_barrier(0);
        PV_COMP(wA, 2); PV_ISSUE(wA, mn.id, 0, sn); __builtin_amdgcn_sched_barrier(0);
        PV_COMP(wB, 3); PV_ISSUE(wB, mn.id, 1, sn); __builtin_amdgcn_sched_barrier(0);
#else
        PV_COMP(wA, 0); PV_ISSUE(wA, mn.id, 0, sn); __builtin_amdgcn_sched_barrier(0);
        PV_COMP(wB, 1); PV_ISSUE(wB, mn.id, 1, sn); __builtin_amdgcn_sched_barrier(0);
#endif
#pragma unroll
        for (int k = 0; k < 16; ++k) { yi[k] += shi(yi[k], lane ^ 16); yi[k] += shi(yi[k], lane ^ 32); }
        int yq[4];
#pragma unroll
        for (int k = 0; k < 4; ++k) yq[k] = grp == 0 ? yi[k] : grp == 1 ? yi[4 + k] : grp == 2 ? yi[8 + k] : yi[12 + k];
        const f32x4 h2 = {bflo(mc.h1.x) + cs * (float)yq[0], bfhi(mc.h1.x) + cs * (float)yq[1], bflo(mc.h1.y) + cs * (float)yq[2], bfhi(mc.h1.y) + cs * (float)yq[3]};
        v2u hb; hb.x = pk2(h2[0], h2[1]); hb.y = pk2(h2[2], h2[3]);
        __builtin_amdgcn_raw_buffer_store_b64(hb, rW, (16 * sub + 4 * grp) * 2, (int)WS_HB + (t * D + SLW * s) * 2, 0);
        const float sq = wave_sum((h2[0] * h2[0] + h2[1] * h2[1]) + (h2[2] * h2[2] + h2[3] * h2[3]), lane);
        if (lane == 0) atomicAdd((unsigned long long*)(ws + WS_SSQ) + (size_t)(l + 1) * M + t, (unsigned long long)((double)sq * 4294967296.0));
        s = sn; t = tn; mc = mn;
    }
#undef PV_META
#undef WLD
#undef PV_ISSUE
#undef PV_COMP
}
__device__ __forceinline__ void final_norm(const Args& a, int gw, int NGW) {
    int lane; LANE_ID(lane);
    f32x4 g[8];
#pragma unroll
    for (int j = 0; j < 8; ++j) g[j] = *(const f32x4*)(a.norm_final + 4 * lane + 256 * j);
    for (int t0 = gw; t0 < M; t0 += 2 * NGW) { const int t1 = t0 + NGW; const bool ok1 = t1 < M; const int tr[2] = {t0, ok1 ? t1 : t0};
        v2u w[2][8]; float rf[2];
#pragma unroll
        for (int r = 0; r < 2; ++r) { const bf16* HB = (const bf16*)(a.ws + WS_HB) + (size_t)tr[r] * D;
            rf[r] = rsqrtf(ssa_to_f(((const unsigned long long*)(a.ws + WS_SSQ))[(size_t)DEPTH * M + tr[r]]) * (1.0f / D) + EPS);
#pragma unroll
            for (int j = 0; j < 8; ++j) w[r][j] = *(const v2u*)(HB + 4 * lane + 256 * j); }
#pragma unroll
        for (int r = 0; r < 2; ++r) if (r == 0 || ok1) { float* O = a.out + (size_t)tr[r] * D;
#pragma unroll
            for (int j = 0; j < 8; ++j) *(f32x4*)(O + 4 * lane + 256 * j) = (f32x4){bflo(w[r][j].x) * rf[r] * g[j][0], bfhi(w[r][j].x) * rf[r] * g[j][1], bflo(w[r][j].y) * rf[r] * g[j][2], bfhi(w[r][j].y) * rf[r] * g[j][3]}; } }
}

__global__ void __launch_bounds__(NT, 2) mk_fwd(ArgsK a_in) {
    extern __shared__ __attribute__((aligned(16))) unsigned char lds_raw[];
    LAS unsigned char* lds = (LAS unsigned char*)lds_raw;
    cg::grid_group grid = cg::this_grid();
    grid.sync();
    const int wave0 = __builtin_amdgcn_readfirstlane(threadIdx.x >> 6);
    const int G = gridDim.x;
    const CAS ArgsK* ka = (const CAS ArgsK*)__builtin_amdgcn_kernarg_segment_ptr();
    size_t zoff = 0;
#define PHASE_BEGIN() int lane; LANE_ID(lane); int blk = blockIdx.x, Gp = G, wv = wave0; asm volatile("" : "+s"(zoff), "+s"(ka), "+s"(blk), "+s"(Gp), "+s"(wv)); const int wave = wv, gw = blk * NWAVES + wv, NGW = Gp * NWAVES; (void)gw; (void)NGW; const Args a = load_args(ka, zoff); unsigned char* const ws = a.ws; (void)ws
    volatile LAS unsigned* bst = (volatile LAS unsigned*)(lds + RING_BYTES + 1024);
#define GRID_BAR() do { asm volatile("" : "+s"(zoff)); unsigned char* wsb_ = (unsigned char*)ka->ws + zoff; int wvb_ = wave0; asm volatile("" : "+s"(wvb_)); xcd_barrier((unsigned*)(wsb_ + WS_BAR), xb_xcc_id(), (unsigned)G, bst, wvb_); } while (0)
    volatile LAS unsigned* xinfo = bst + 4;
    { PHASE_BEGIN(); if (wave == 0 && lane == 0) { bst[0] = 0u; bst[1] = 0u; xinfo[2] = xb_add((unsigned*)(ws + WS_BAR) + XB_XCNT(xb_xcc_id()), 1u); }
      p0_cmax(a, gw, NGW, lane); }
    GRID_BAR();
    { PHASE_BEGIN(); p0_win_i8(a, lds, gw, NGW, wave, lane); p0_prologue(a, lds, gw, NGW, wave, lane); }
    GRID_BAR();
    {
        PHASE_BEGIN();
        if (wave == 0 && lane == 0) { unsigned* bar = (unsigned*)(ws + WS_BAR); const unsigned x = xb_xcc_id(); unsigned pos = 0, npop = 0, mine = 1;
            for (unsigned j = 0; j < 16; ++j) { const unsigned c = xb_ld(&bar[XB_XCNT(j)]); if (c) { ++npop; if (j < x) ++pos; } if (j == x) mine = c ? c : 1u; }
            xinfo[0] = pos; xinfo[1] = npop ? npop : 1u; xinfo[3] = mine; }
        __syncthreads();
    }
    int depth_rt = DEPTH; asm volatile("" : "+s"(depth_rt));
    for (int lc = 0; lc < depth_rt; ++lc) {
        int l = lc; asm volatile("" : "+s"(l));
        if (l > 0) { { PHASE_BEGIN(); quant_rows(a, l, gw, NGW, lane); } GRID_BAR(); }
        {
            PHASE_BEGIN();
            pg8::Gemm g{(const bf16*)(ws + WS_HB8), (const bf16*)(ws + WS_WIN + l * WIN_BYTES), M, NPROJ, D / 2}; pg8::StaticOrder S; S.init(M, NPROJ, Gp, blk);
            EpiProj E{ws, (const bf16*)(ws + WS_BIH) + l * NPROJ, (const float*)(ws + WS_RSA), (const bf16*)(ws + WS_SWH) + l * NPROJ};
            pg8::gemm_phase<EpiProj, pg8::StaticOrder, true, true>(lds, g, S, E, wave);
            forget_logits(a, l, gw, NGW, lane);
        }
        GRID_BAR();
        { PHASE_BEGIN(); mixers_fast(a, l, (LAS char*)lds, wave, lane, Gp, blk); }
        GRID_BAR();
        {
            PHASE_BEGIN();
            pg8::Gemm g{(const bf16*)(ws + WS_Y), (const bf16*)(ws + WS_WBR + l * SQ_BYTES), M, D, D}; pg8::StaticOrder S; S.init(M, D, Gp, blk);
            EpiMerge E{(const unsigned char*)(ws + WS_G), (bf16*)(ws + WS_MRG)};
            pg8::gemm_phase<EpiMerge, pg8::StaticOrder, false>(lds, g, S, E, wave);
        }
        GRID_BAR();
        {
            PHASE_BEGIN();
            pg8::Gemm g{(const bf16*)(ws + WS_MRG), (const bf16*)(ws + WS_WOUT + l * SQ_BYTES), M, D, D}; pg8::StaticOrder S; S.init(M, D, Gp, blk);
            EpiRes E{l == 0 ? a.x : (const float*)nullptr, (bf16*)(ws + WS_HB), (unsigned long long*)(ws + WS_SSA) + l * M};
            pg8::gemm_phase<EpiRes, pg8::StaticOrder, false>(lds, g, S, E, wave);
        }
        GRID_BAR();
        {
            PHASE_BEGIN();
            pg8::Gemm g{(const bf16*)(ws + WS_HB), (const bf16*)(ws + WS_WQ + l * SQ_BYTES), M, D, D}; pg8::StaticOrder S; S.init(M, D, Gp, blk);
            EpiQ E{(bf16*)(ws + WS_Q), (const unsigned long long*)(ws + WS_SSA) + l * M};
            pg8::gemm_phase<EpiQ, pg8::StaticOrder, false>(lds, g, S, E, wave);
        }
        GRID_BAR();
        {
            PHASE_BEGIN(); (void)lane;
            for (int t0 = blk * PEER_TOK; t0 < M; t0 += Gp * PEER_TOK) {
                peer_retrieve(a, l, t0, wave, (LAS char*)lds, wave);
                __syncthreads();
                peer_publish4(a, l, t0 + wave * (PEER_TOK / NWAVES), (LAS char*)lds, wave * (PEER_TOK / NWAVES));
                __syncthreads();
            }
        }
        GRID_BAR();
        {
            PHASE_BEGIN(); (void)lane;
            const int pos = __builtin_amdgcn_readfirstlane((int)xinfo[0]), npop = __builtin_amdgcn_readfirstlane((int)xinfo[1]), rank = __builtin_amdgcn_readfirstlane((int)xinfo[2]), nloc = __builtin_amdgcn_readfirstlane((int)xinfo[3]);
            const PeerItems it{pos, npop, rank, nloc, wave}; peer_u_wave(a, l, it);
        }
        GRID_BAR();
        {
            PHASE_BEGIN(); (void)lane;
            const int pos = __builtin_amdgcn_readfirstlane((int)xinfo[0]), npop = __builtin_amdgcn_readfirstlane((int)xinfo[1]), rank = __builtin_amdgcn_readfirstlane((int)xinfo[2]), nloc = __builtin_amdgcn_readfirstlane((int)xinfo[3]);
            const PeerItems it{pos, npop, rank, nloc, wave}; peer_v_wave(a, l, it);
        }
        GRID_BAR();
    }
    {
        PHASE_BEGIN(); (void)lane;
        final_norm(a, gw, NGW);
    }
}

extern "C" void kernel_launch(void* const* d_in, const int* in_sizes, int n_in, void* d_out, int out_size, void* d_ws, size_t ws_size, hipStream_t stream) {
    static int grid = 0;
    if (grid == 0) {
        int dev = 0, cus = 0, per_cu = 0;
        if (n_in != 16 || out_size != M * D || ws_size < WS_END2) { fprintf(stderr, "kernel_launch: unexpected shapes (n_in %d out %d ws %zu)\n", n_in, out_size, ws_size); grid = -1; return; }
        (void)hipGetDevice(&dev);
        (void)hipDeviceGetAttribute(&cus, hipDeviceAttributeMultiprocessorCount, dev);
        (void)hipFuncSetAttribute((const void*)mk_fwd, hipFuncAttributeMaxDynamicSharedMemorySize, LDS_BYTES);
        (void)hipOccupancyMaxActiveBlocksPerMultiprocessor(&per_cu, (const void*)mk_fwd, NT, LDS_BYTES);
        if (per_cu < 1) { fprintf(stderr, "kernel_launch: occupancy query says %d blocks per CU\n", per_cu); }
        grid = cus;
        if (grid > 256) grid = 256;
    }
    if (grid < 0) return;
    (void)hipMemsetAsync((char*)d_ws + WS_CTL, 0, CTL_ZERO_BYTES, stream);
    ArgsK a{};
    const GAS float** p = (const GAS float**)&a;
    for (int i = 0; i < 16; ++i) p[i] = (const GAS float*)d_in[i];
    a.out = (GAS float*)d_out; a.ws = (GAS unsigned char*)d_ws;
    void* args[] = {&a};
    hipError_t e = hipLaunchCooperativeKernel((const void*)mk_fwd, dim3(grid), dim3(NT), args, LDS_BYTES, stream);
    if (e != hipSuccess) fprintf(stderr, "cooperative launch failed: %s (grid %d)\n", hipGetErrorString(e), grid);
}
```

```cpp
#include <hip/hip_runtime.h>
#include <hip/hip_cooperative_groups.h>
#include <cstdio>
#include <cstdint>
namespace cg = cooperative_groups;
namespace pg8 {
#define PG8_LAS __attribute__((address_space(3)))
typedef unsigned short bf16_t;
typedef short bf16x8 __attribute__((ext_vector_type(8)));
typedef float f32x4 __attribute__((ext_vector_type(4)));
typedef unsigned u32x4 __attribute__((ext_vector_type(4)));
typedef unsigned u32x2 __attribute__((ext_vector_type(2)));
typedef int i32x4 __attribute__((ext_vector_type(4)));
constexpr int BM = 256, BK = 64, HALF = 128, HTB = HALF * BK * 2  , STAGE_BYTES = 8 * HTB, NXCD = 8, WGM = 8;

__host__ __device__ __forceinline__ int lds_byte(int r, int c) { const int st = (r >> 4) * 2 + (c >> 5), rr = r & 15, cc = c & 31, ob = rr * 64 + cc * 2; return st * 1024 + (ob ^ (((ob >> 9) & 1) << 5)); }
__host__ __device__ __forceinline__ void stage_rc(int b, int& R, int& C) { const int st = b / 1024, sb = b % 1024, swz = sb ^ (((sb >> 9) & 1) << 5); R = (st >> 1) * 16 + swz / 64; C = (st & 1) * 32 + (swz % 64) / 2; }
__host__ __device__ __forceinline__ int perm32(int rho) { const int n = rho >> 4, i = rho & 15; return 8 * (i >> 2) + 4 * n + (i & 3); }

struct Unit { int pm, pn; };
struct Gemm { const bf16_t* A; const bf16_t* Bt; int M, N, K; };

struct StaticOrder {
    int nM, nN, nwg, G, c;
    __host__ __device__ void init(int M, int N, int G_, int c_) { nM = M / BM; nN = N / BM; nwg = nM * nN; G = G_; c = c_; }
    __host__ __device__ bool next(int i, Unit& u) const {
        const long L = (long)i * G + c; if (L >= nwg) return false;
        int wgid = (int)L; { const int q = nwg / NXCD, r = nwg % NXCD, xcd = wgid % NXCD, off = wgid / NXCD; wgid = (xcd < r ? xcd * (q + 1) : r * (q + 1) + (xcd - r) * q) + off; }
        const int nig = WGM * nN, gid = wgid / nig, fm = gid * WGM, gsz = (nM - fm) < WGM ? (nM - fm) : WGM;
        u.pm = fm + ((wgid % nig) % gsz); u.pn = (wgid % nig) / gsz; return true;
    }
};

__device__ __forceinline__ unsigned cvt_pk_bf16(float lo, float hi) { unsigned r; asm volatile("v_cvt_pk_bf16_f32 %0, %1, %2" : "=v"(r) : "v"(lo), "v"(hi)); return r; }

template <class Epi, class Sched, bool ALIGN_EPI = false, bool I8 = false>
__device__ __forceinline__ void gemm_phase(PG8_LAS unsigned char* lds, const Gemm g, const Sched& S, const Epi& E, int wid) {
    int lane_; asm volatile("v_mbcnt_lo_u32_b32 %0, -1, 0\n\tv_mbcnt_hi_u32_b32 %0, -1, %0" : "=v"(lane_));
    const int lane = lane_, tid = wid * 64 + lane, wr = wid >> 2, wc = wid & 3, fr = lane & 15, fq = lane >> 4;
    const int K = g.K, nt = K / BK;
    unsigned voffA, voffB;
    { int R, C; stage_rc(tid * 16, R, C); const int Rb = Epi::PERM ? ((R & ~31) + perm32(R & 31)) : R; voffA = (unsigned)(R * K + C) * 2u; voffB = (unsigned)(Rb * K + C) * 2u; }
    const size_t p2step = (size_t)64 * K * 2;
    const size_t kstep = (size_t)(BK * 2);
    const size_t hstep = (size_t)HALF * K * 2;
    const size_t tstep = 2 * hstep;
    const unsigned ldsw = (unsigned)wid * 1024u;
    const int aoff = lds_byte(wr * 64 + fr, fq * 8), boff = lds_byte(wc * 32 + fr, fq * 8);
#define PG8_SA(b, h) (((b) * 2 + (h)) * HTB)
#define PG8_SB(b, h) ((4 + (b) * 2 + (h)) * HTB)
#define PG8_STAGE(bufoff, gbase, voff) do { _Pragma("unroll") for (int _i = 0; _i < 2; ++_i) \
        __builtin_amdgcn_global_load_lds((const unsigned*)((const char*)(gbase) + _i * p2step + (voff)), (PG8_LAS unsigned*)(lds + (bufoff) + ldsw + _i * 8192), 16, 0, 0); } while (0)
#define PG8_LDA(dst, b, h) do { _Pragma("unroll") for (int m = 0; m < 4; ++m) _Pragma("unroll") for (int k = 0; k < 2; ++k) dst[m][k] = *(const PG8_LAS bf16x8*)(lds + PG8_SA(b, h) + aoff + m * 2048 + k * 1024); } while (0)
#define PG8_LDB(dst, b, h) do { _Pragma("unroll") for (int n = 0; n < 2; ++n) _Pragma("unroll") for (int k = 0; k < 2; ++k) dst[n][k] = *(const PG8_LAS bf16x8*)(lds + PG8_SB(b, h) + boff + n * 2048 + k * 1024); } while (0)
#define PG8_MMA(ai, bj, At, Bt) do { __builtin_amdgcn_s_setprio(1); _Pragma("unroll") for (int m = 0; m < 4; ++m) _Pragma("unroll") for (int n = 0; n < 2; ++n) _Pragma("unroll") for (int k = 0; k < 2; ++k) \
        { if constexpr (I8) acc[ai][bj][m][n] = __builtin_bit_cast(f32x4, __builtin_amdgcn_mfma_i32_16x16x64_i8(__builtin_bit_cast(i32x4, Bt[n][k]), __builtin_bit_cast(i32x4, At[m][k]), __builtin_bit_cast(i32x4, acc[ai][bj][m][n]), 0, 0, 0)); \
          else acc[ai][bj][m][n] = __builtin_amdgcn_mfma_f32_16x16x32_bf16(Bt[n][k], At[m][k], acc[ai][bj][m][n], 0, 0, 0); } __builtin_amdgcn_s_setprio(0); } while (0)
#define PG8_WAIT_V(n) asm volatile("s_waitcnt vmcnt(" #n ")" ::: "memory")
#define PG8_WAIT_L(n) asm volatile("s_waitcnt lgkmcnt(" #n ")" ::: "memory")
#define PG8_BAR __builtin_amdgcn_s_barrier()
#define PG8_SCHED __builtin_amdgcn_sched_barrier(0)
    Unit cur, nxt; int ui = 0;
    if (!S.next(0, cur)) return;
    f32x4 acc[2][2][4][2];
#pragma unroll
    for (int a = 0; a < 2; ++a)
#pragma unroll
        for (int b = 0; b < 2; ++b)
#pragma unroll
            for (int m = 0; m < 4; ++m)
#pragma unroll
                for (int n = 0; n < 2; ++n) acc[a][b][m][n] = (f32x4){0.f, 0.f, 0.f, 0.f};
    bf16x8 At[4][2], B0[2][2], B1[2][2];
    typename Epi::Pre pre = {};
    const char* cA = (const char*)g.A + (size_t)cur.pm * tstep; const char* cB = (const char*)g.Bt + (size_t)cur.pn * tstep;
    PG8_STAGE(PG8_SB(0, 0), cB, voffB); PG8_STAGE(PG8_SB(0, 1), cB + hstep, voffB); PG8_STAGE(PG8_SA(0, 0), cA, voffA); PG8_STAGE(PG8_SA(0, 1), cA + hstep, voffA);
    if (wr == 1) PG8_BAR;
    PG8_WAIT_V(2); PG8_BAR;
    PG8_STAGE(PG8_SB(1, 0), cB + kstep, voffB); PG8_STAGE(PG8_SA(1, 0), cA + kstep, voffA); PG8_STAGE(PG8_SB(1, 1), cB + hstep + kstep, voffB);
    PG8_WAIT_V(6); PG8_BAR;
    for (;;) {
        const bool has_next = S.next(ui + 1, nxt);
        const char* nA = has_next ? (const char*)g.A + (size_t)nxt.pm * tstep : cA; const char* nB = has_next ? (const char*)g.Bt + (size_t)nxt.pn * tstep : cB;
        const int seglen = Epi::HOOK ? 8 : nt;
        for (int t0 = 0; t0 < nt; t0 += seglen) {
        if constexpr (Epi::HOOK) { if (t0 > 0) { int ln_; asm volatile("v_mbcnt_lo_u32_b32 %0, -1, 0\n\tv_mbcnt_hi_u32_b32 %0, -1, %0" : "=v"(ln_)); E.hook(acc, cur, t0 >> 3, wr, wc, ln_ & 15, ln_ >> 4); } }
        for (int t = t0; t < t0 + seglen; t += 2) {
            const bool last = (t == nt - 2);
            if constexpr (Epi::PRELOAD) { if (last) { int ln_; asm volatile("v_mbcnt_lo_u32_b32 %0, -1, 0\n\tv_mbcnt_hi_u32_b32 %0, -1, %0" : "=v"(ln_)); E.preload(pre, cur, wr, wc, ln_ & 15, ln_ >> 4); } }
            const char* a1 = cA + (size_t)(t + 1) * kstep;
            const char* a2 = last ? nA : cA + (size_t)(t + 2) * kstep; const char* b2 = last ? nB : cB + (size_t)(t + 2) * kstep;
            const char* a3 = a2 + kstep; const char* b3 = b2 + kstep;
            PG8_LDB(B0, 0, 0); PG8_LDB(B1, 0, 1); PG8_SCHED; PG8_LDA(At, 0, 0); PG8_STAGE(PG8_SA(1, 1), a1 + hstep, voffA);
            PG8_WAIT_V(8); PG8_WAIT_L(0); PG8_BAR; PG8_MMA(0, 0, At, B0); PG8_MMA(0, 1, At, B1); PG8_BAR; PG8_SCHED;
            PG8_LDA(At, 0, 1); PG8_STAGE(PG8_SB(0, 0), b2, voffB); PG8_STAGE(PG8_SB(0, 1), b2 + hstep, voffB); PG8_STAGE(PG8_SA(0, 0), a2, voffA);
            PG8_WAIT_V(8); PG8_WAIT_L(0); PG8_BAR; PG8_MMA(1, 0, At, B0); PG8_MMA(1, 1, At, B1); PG8_BAR; PG8_SCHED;
            PG8_LDB(B0, 1, 0); PG8_LDB(B1, 1, 1); PG8_SCHED; PG8_LDA(At, 1, 0); PG8_STAGE(PG8_SA(0, 1), a2 + hstep, voffA);
            PG8_WAIT_V(8); PG8_WAIT_L(0); PG8_BAR; PG8_MMA(0, 0, At, B0); PG8_MMA(0, 1, At, B1); PG8_BAR; PG8_SCHED;
            PG8_LDA(At, 1, 1); PG8_STAGE(PG8_SB(1, 0), b3, voffB); PG8_STAGE(PG8_SB(1, 1), b3 + hstep, voffB); PG8_STAGE(PG8_SA(1, 0), a3, voffA);
            PG8_WAIT_V(8); PG8_WAIT_L(0); PG8_BAR; PG8_MMA(1, 0, At, B0); PG8_MMA(1, 1, At, B1); PG8_BAR; PG8_SCHED;
        }
        }
        if constexpr (ALIGN_EPI) { if (wr == 0) PG8_BAR; }
        { int ln_; asm volatile("v_mbcnt_lo_u32_b32 %0, -1, 0\n\tv_mbcnt_hi_u32_b32 %0, -1, %0" : "=v"(ln_));
          if constexpr (Epi::PRELOAD) E(acc, cur, wr, wc, ln_ & 15, ln_ >> 4, pre); else E(acc, cur, wr, wc, ln_ & 15, ln_ >> 4); }
        if (!has_next) break;
#pragma unroll
        for (int a = 0; a < 2; ++a)
#pragma unroll
            for (int b = 0; b < 2; ++b)
#pragma unroll
                for (int m = 0; m < 4; ++m)
#pragma unroll
                    for (int n = 0; n < 2; ++n) acc[a][b][m][n] = (f32x4){0.f, 0.f, 0.f, 0.f};
        cur = nxt; cA = nA; cB = nB; ++ui;
        if constexpr (ALIGN_EPI) { if (wr == 1) PG8_BAR; }
    }
    PG8_WAIT_V(0);
    if constexpr (!ALIGN_EPI) { if (wr == 0) PG8_BAR; }
    PG8_BAR;
#undef PG8_SA
#undef PG8_SB
#undef PG8_STAGE
#undef PG8_LDA
#undef PG8_LDB
#undef PG8_MMA
#undef PG8_WAIT_V
#undef PG8_WAIT_L
#undef PG8_BAR
#undef PG8_SCHED
}
}
constexpr int NWAVES = 8, NT = NWAVES * 64;
constexpr int M = 8192, D = 2048, SEQ = 2048, NBATCH = 4, DEPTH = 2;
constexpr int INW = 13316, NPROJ = 13312, MIXW = 512, HD = 128;
constexpr int PEER_E = 16384;
constexpr float EPS = 1e-6f;
constexpr float ATT_SCALE = 0.08838834764831845f;

constexpr size_t MiB = 1u << 20;
constexpr size_t WS_CTL = 0, CTL_ZERO_BYTES = 1 * MiB;
constexpr size_t WS_SSQ = 0;
constexpr size_t WS_SSA = 256 * 1024;
constexpr size_t WS_WF = 1 * MiB;
constexpr size_t WS_BINR = WS_WF + 64 * 1024;
constexpr size_t WS_LOGF = 2 * MiB;
constexpr size_t WS_CUM = 3 * MiB;
constexpr size_t WS_WIN = 8 * MiB;
constexpr size_t WIN_BYTES = (size_t)NPROJ * D;
constexpr size_t WS_SW = 7 * MiB;
constexpr size_t WS_CMAX = 384 * 1024;
constexpr size_t WS_HB8 = 64 * MiB;
constexpr size_t WS_SA = 7 * MiB + 512 * 1024;
constexpr size_t WS_WBR = 112 * MiB, WS_WOUT = 128 * MiB, WS_WQ = 144 * MiB;
constexpr size_t SQ_BYTES = (size_t)D * D * 2;
constexpr size_t WS_PU = 160 * MiB, WS_PV = 288 * MiB;
constexpr size_t PE_BYTES = (size_t)PEER_E * D;
constexpr size_t WS_PK = 6 * MiB;
constexpr size_t WS_SU = 5 * MiB, WS_SV = 5 * MiB + 256 * 1024;
constexpr size_t WS_HB = 480 * MiB;
constexpr size_t WS_PROJ = 512 * MiB;
constexpr size_t PROJ_T = (size_t)M * MIXW;
constexpr size_t WS_R = 592 * MiB;
constexpr size_t R_PLANE = (size_t)M * D;
constexpr size_t WS_Y = 720 * MiB;
constexpr size_t WS_MRG = 752 * MiB;
constexpr size_t WS_Q = 784 * MiB;
constexpr size_t WS_END = 816 * MiB;

constexpr int RING_BYTES = 131072;
constexpr int LDS_BYTES = 147456;

typedef unsigned short bf16;
typedef unsigned v4u __attribute__((ext_vector_type(4)));
typedef unsigned v2u __attribute__((ext_vector_type(2)));
typedef float f32x4 __attribute__((ext_vector_type(4)));
typedef float f32x2 __attribute__((ext_vector_type(2)));
using bf16x2 = __attribute__((ext_vector_type(2))) __bf16;
#define LAS __attribute__((address_space(3)))

__device__ __forceinline__ unsigned f2bf(float f) { unsigned u = __builtin_bit_cast(unsigned, f); return (u + 0x7fffu + ((u >> 16) & 1u)) >> 16; }
__device__ __forceinline__ unsigned pk2(float lo, float hi) { return f2bf(lo) | (f2bf(hi) << 16); }
__device__ __forceinline__ float bflo(unsigned w) { return __builtin_bit_cast(float, w << 16); }
__device__ __forceinline__ float bfhi(unsigned w) { return __builtin_bit_cast(float, w & 0xffff0000u); }
__device__ __forceinline__ float bf2f(bf16 b) { return __builtin_bit_cast(float, ((unsigned)b) << 16); }
__device__ __forceinline__ float shf(float v, int src) { return __builtin_bit_cast(float, __builtin_amdgcn_ds_bpermute(src << 2, __builtin_bit_cast(int, v))); }
__device__ __forceinline__ int shi(int v, int src) { return __builtin_amdgcn_ds_bpermute(src << 2, v); }
#define DPP_ROR(x, n) __builtin_bit_cast(float, __builtin_amdgcn_update_dpp(0, __builtin_bit_cast(int, (x)), 0x120 + (n), 0xf, 0xf, false))
__device__ __forceinline__ float wave_sum(float v, int) {
    v += DPP_ROR(v, 8); v += DPP_ROR(v, 4); v += DPP_ROR(v, 2); v += DPP_ROR(v, 1);
    const int vi = __builtin_bit_cast(int, v);
    const float r0 = __builtin_bit_cast(float, __builtin_amdgcn_readlane(vi, 0)), r1 = __builtin_bit_cast(float, __builtin_amdgcn_readlane(vi, 16)),
                r2 = __builtin_bit_cast(float, __builtin_amdgcn_readlane(vi, 32)), r3 = __builtin_bit_cast(float, __builtin_amdgcn_readlane(vi, 48));
    return (r0 + r1) + (r2 + r3);
}
__device__ __forceinline__ float wave_max(float v, int) {
    v = fmaxf(v, DPP_ROR(v, 8)); v = fmaxf(v, DPP_ROR(v, 4)); v = fmaxf(v, DPP_ROR(v, 2)); v = fmaxf(v, DPP_ROR(v, 1));
    const int vi = __builtin_bit_cast(int, v);
    const float r0 = __builtin_bit_cast(float, __builtin_amdgcn_readlane(vi, 0)), r1 = __builtin_bit_cast(float, __builtin_amdgcn_readlane(vi, 16)),
                r2 = __builtin_bit_cast(float, __builtin_amdgcn_readlane(vi, 32)), r3 = __builtin_bit_cast(float, __builtin_amdgcn_readlane(vi, 48));
    return fmaxf(fmaxf(r0, r1), fmaxf(r2, r3));
}
__device__ __forceinline__ float ssa_to_f(unsigned long long v) { return (float)((double)v * (1.0 / 4294967296.0)); }
__device__ __forceinline__ float dot2_bf16(unsigned w, unsigned x, float acc) { return __builtin_amdgcn_fdot2_f32_bf16(__builtin_bit_cast(bf16x2, w), __builtin_bit_cast(bf16x2, x), acc, false); }

#define LANE_ID(x) asm volatile("v_mbcnt_lo_u32_b32 %0, -1, 0\n\tv_mbcnt_hi_u32_b32 %0, -1, %0" : "=v"(x))
struct Args {
    const float *x, *norm_mix, *w_in, *b_in, *pool_w, *pool_scale, *conv_w, *rel_bias, *w_branch, *w_out, *norm_ffn, *peer_wq, *peer_keys, *peer_u, *peer_v, *norm_final;
    float* out; unsigned char* ws;
};
#define GAS __attribute__((address_space(1)))
#define CAS __attribute__((address_space(4)))
struct ArgsK {
    const GAS float *x, *norm_mix, *w_in, *b_in, *pool_w, *pool_scale, *conv_w, *rel_bias, *w_branch, *w_out, *norm_ffn, *peer_wq, *peer_keys, *peer_u, *peer_v, *norm_final;
    GAS float* out; GAS unsigned char* ws;
};
__device__ __forceinline__ Args load_args(const CAS ArgsK* k, size_t zoff) {
    Args a;
    a.x = (const float*)k->x; a.norm_mix = (const float*)k->norm_mix; a.w_in = (const float*)k->w_in; a.b_in = (const float*)k->b_in; a.pool_w = (const float*)k->pool_w;
    a.pool_scale = (const float*)k->pool_scale; a.conv_w = (const float*)k->conv_w; a.rel_bias = (const float*)k->rel_bias; a.w_branch = (const float*)k->w_branch;
    a.w_out = (const float*)k->w_out; a.norm_ffn = (const float*)k->norm_ffn; a.peer_wq = (const float*)k->peer_wq; a.peer_keys = (const float*)k->peer_keys;
    a.peer_u = (const float*)k->peer_u; a.peer_v = (const float*)k->peer_v; a.norm_final = (const float*)k->norm_final; a.out = (float*)k->out; a.ws = (unsigned char*)(k->ws + zoff);
    return a;
}

using pg8::f32x4; using pg8::Unit;
constexpr size_t WS_G = 896 * MiB;
constexpr size_t WS_SWH = 7 * MiB + 256 * 1024, WS_BIH = 7 * MiB + 384 * 1024;
constexpr size_t WS_RSA = 7 * MiB + 768 * 1024;
constexpr int GATE_LUT_N = 1024, GATE_LUT_S = 64;
constexpr int LDS_GATE_LUT = RING_BYTES + 2048;
constexpr int LDS_EPI_PRE = RING_BYTES + 4096;
struct EpiProj {
    static constexpr bool PERM = true, HOOK = false, PRELOAD = true;
    struct Pre {};
    struct Ops { pg8::u32x4 sw[2], bi[2]; float rs[2][4]; };
    unsigned char* wsb; const bf16* biash; const float* rsa; const bf16* swh;
    const LAS unsigned char* lut;
    LAS unsigned char* pre;
    __device__ __forceinline__ void preload(Pre&, const Unit& u, int wr, int wc, int fr, int fq) const {
        const int wid = wr * 4 + wc, lane = fq * 16 + fr;
        if (wid == 0) { if (lane < 32) __builtin_amdgcn_global_load_lds((const unsigned*)(swh + u.pn * 256 + lane * 8), (LAS unsigned*)pre, 16, 0, 0); }
        else if (wid == 1) { if (lane < 32) __builtin_amdgcn_global_load_lds((const unsigned*)(biash + u.pn * 256 + lane * 8), (LAS unsigned*)(pre + 512), 16, 0, 0); }
        else if (wid == 2) __builtin_amdgcn_global_load_lds((const unsigned*)(rsa + u.pm * 256 + lane * 4), (LAS unsigned*)(pre + 1024), 16, 0, 0);
    }
    static __device__ __forceinline__ unsigned g8(float z) { const float t = __builtin_amdgcn_rcpf(__builtin_amdgcn_exp2f(__builtin_fmaf(z, -1.4426950408889634f, -8.0f)) + 0.00390625f);
        return (unsigned)(__builtin_amdgcn_fmed3f(t, 1.0f, 255.0f) + 0.5f); }
    static __device__ __forceinline__ unsigned g8x4(const f32x4& v) { return g8(v[0]) | (g8(v[1]) << 8) | (g8(v[2]) << 16) | (g8(v[3]) << 24); }
    __device__ __forceinline__ void operator()(f32x4 (&acc)[2][2][4][2], const Unit& u, int wr, int wc, int fr, int fq, const Pre&) const {
        const int cl0 = wc * 32 + 8 * fq;
        Ops p;
#pragma unroll
        for (int bj = 0; bj < 2; ++bj) { p.sw[bj] = *(const LAS pg8::u32x4*)(pre + (cl0 + bj * 128) * 2); p.bi[bj] = *(const LAS pg8::u32x4*)(pre + 512 + (cl0 + bj * 128) * 2); }
#pragma unroll
        for (int ai = 0; ai < 2; ++ai)
#pragma unroll
            for (int m = 0; m < 4; ++m) p.rs[ai][m] = *(const LAS float*)(pre + 1024 + (wr * 64 + fr + ai * 128 + m * 16) * 4);
#define ACCF(ai, bj, m, n) __builtin_convertvector(__builtin_bit_cast(pg8::i32x4, acc[ai][bj][m][n]), f32x4)
        const __amdgpu_buffer_rsrc_t rW = __builtin_amdgcn_make_buffer_rsrc((void*)wsb, 0, 0x7fffffff, 0x00020000);
        int sbase, ldb, voff;
        if (u.pn < 20) { sbase = (int)WS_PROJ + ((u.pn >> 1) * (int)PROJ_T + (u.pn & 1) * 256) * 2; ldb = MIXW * 2; voff = fr * ldb + cl0 * 2; }
        else { sbase = (int)WS_G + (u.pn - 20) * 256; ldb = 4 * D; voff = fr * ldb + wc * 64 + fq * 16; }
        sbase += (u.pm * 256 + wr * 64) * ldb;
        const float ws_ = u.pn >= 20 ? (float)GATE_LUT_S : 1.0f, bo_ = u.pn >= 20 ? (float)(GATE_LUT_N / 2) + 0.5f : 0.0f;
#pragma unroll
        for (int bj = 0; bj < 2; ++bj) { const f32x4 w0 = (f32x4){bflo(p.sw[bj].x), bfhi(p.sw[bj].x), bflo(p.sw[bj].y), bfhi(p.sw[bj].y)} * ws_, w1 = (f32x4){bflo(p.sw[bj].z), bfhi(p.sw[bj].z), bflo(p.sw[bj].w), bfhi(p.sw[bj].w)} * ws_;
            const f32x4 b0 = (f32x4){bflo(p.bi[bj].x), bfhi(p.bi[bj].x), bflo(p.bi[bj].y), bfhi(p.bi[bj].y)} * ws_ + bo_, b1 = (f32x4){bflo(p.bi[bj].z), bfhi(p.bi[bj].z), bflo(p.bi[bj].w), bfhi(p.bi[bj].w)} * ws_ + bo_;
#pragma unroll
            for (int ai = 0; ai < 2; ++ai)
#pragma unroll
                for (int m = 0; m < 4; ++m) { const float rs = p.rs[ai][m]; const f32x4 v0 = ACCF(ai, bj, m, 0) * rs * w0 + b0, v1 = ACCF(ai, bj, m, 1) * rs * w1 + b1;
                    if (u.pn >= 20) { unsigned c[8];
#pragma unroll
                        for (int e = 0; e < 4; ++e) { c[e] = lut[(unsigned)__builtin_amdgcn_fmed3f(v0[e], 0.0f, (float)(GATE_LUT_N - 1))]; c[4 + e] = lut[(unsigned)__builtin_amdgcn_fmed3f(v1[e], 0.0f, (float)(GATE_LUT_N - 1))]; }
                        v2u w; w.x = c[0] | (c[1] << 8) | (c[2] << 16) | (c[3] << 24); w.y = c[4] | (c[5] << 8) | (c[6] << 16) | (c[7] << 24);
                        __builtin_amdgcn_raw_buffer_store_b64(w, rW, voff + bj * 8, sbase + (ai * 128 + m * 16) * ldb, 0); }
                    else { pg8::u32x4 w; w.x = pg8::cvt_pk_bf16(v0[0], v0[1]); w.y = pg8::cvt_pk_bf16(v0[2], v0[3]); w.z = pg8::cvt_pk_bf16(v1[0], v1[1]); w.w = pg8::cvt_pk_bf16(v1[2], v1[3]);
                        __builtin_amdgcn_raw_buffer_store_b128(w, rW, voff + bj * 256, sbase + (ai * 128 + m * 16) * ldb, 0); } } }
    }
};
#undef ACCF
struct EpiMerge {
    static constexpr bool PERM = true, HOOK = true; static constexpr bool PRELOAD = false; struct Pre {};
    const unsigned char* G; bf16* O;
    struct Bt { pg8::u32x4 n[4], d[4]; };
    __device__ __forceinline__ void scale(f32x4 (&acc)[2][2][4][2], const Unit& u, int g, int wr, int wc, int fr, int fq) const {
        const __amdgpu_buffer_rsrc_t rs = __builtin_amdgcn_make_buffer_rsrc((void*)G, 0, 0x7fffffff, 0x00020000);
        int voff = fr * 4 * D + 16 * fq; asm volatile("" : "+v"(voff));
        const int sden = (u.pm * 256 + wr * 64) * 4 * D + (g - 1) * D + u.pn * 256 + wc * 64, snum = sden + D;
        const bool fin = g == 4;
#define UB(x, e) ((float)(((x) >> (8 * (e))) & 255u))
#define MG_LOAD(B, b0) do { _Pragma("unroll") for (int i = 0; i < 4; ++i) { const int ai_ = ((b0) + i) >> 2, m_ = ((b0) + i) & 3, so_ = (ai_ * 128 + m_ * 16) * 4 * D; \
            B.d[i] = __builtin_amdgcn_raw_buffer_load_b128(rs, voff, sden + so_, 0); if (!fin) B.n[i] = __builtin_amdgcn_raw_buffer_load_b128(rs, voff, snum + so_, 0); } } while (0)
#define MG_APPLY(B, b0) do { _Pragma("unroll") for (int i = 0; i < 4; ++i) { const int ai_ = ((b0) + i) >> 2, m_ = ((b0) + i) & 3; \
            _Pragma("unroll") for (int q = 0; q < 4; ++q) { const unsigned dq = B.d[i][q], nq = B.n[i][q]; \
                f32x4 r = {UB(dq, 0), UB(dq, 1), UB(dq, 2), UB(dq, 3)}; \
                if (!fin) r *= (f32x4){__builtin_amdgcn_rcpf(UB(nq, 0)), __builtin_amdgcn_rcpf(UB(nq, 1)), __builtin_amdgcn_rcpf(UB(nq, 2)), __builtin_amdgcn_rcpf(UB(nq, 3))}; else r *= 0.00390625f; \
                acc[ai_][q >> 1][m_][q & 1] *= r; asm volatile("" : "+v"(acc[ai_][q >> 1][m_][q & 1])); } } } while (0)
        Bt A = {}, B = {};
        MG_LOAD(A, 0); MG_LOAD(B, 4);
        MG_APPLY(A, 0); asm volatile("" ::: "memory");
        MG_APPLY(B, 4); asm volatile("" ::: "memory");
#undef MG_LOAD
#undef MG_APPLY
#undef UB
    }
    __device__ __forceinline__ void hook(f32x4 (&acc)[2][2][4][2], const Unit& u, int g, int wr, int wc, int fr, int fq) const { scale(acc, u, g, wr, wc, fr, fq); }
    __device__ __forceinline__ void operator()(f32x4 (&acc)[2][2][4][2], const Unit& u, int wr, int wc, int fr, int fq) const {
        scale(acc, u, 4, wr, wc, fr, fq);
        const int row0 = u.pm * 256 + wr * 64 + fr, col0 = u.pn * 256 + wc * 32 + 8 * fq;
#pragma unroll
        for (int ai = 0; ai < 2; ++ai)
#pragma unroll
            for (int m = 0; m < 4; ++m) { bf16* rowp = O + (size_t)(row0 + ai * 128 + m * 16) * D + col0;
#pragma unroll
                for (int bj = 0; bj < 2; ++bj) { const f32x4 v0 = acc[ai][bj][m][0], v1 = acc[ai][bj][m][1];
                    pg8::u32x4 w; w.x = pg8::cvt_pk_bf16(v0[0], v0[1]); w.y = pg8::cvt_pk_bf16(v0[2], v0[3]); w.z = pg8::cvt_pk_bf16(v1[0], v1[1]); w.w = pg8::cvt_pk_bf16(v1[2], v1[3]);
                    *(pg8::u32x4*)(rowp + bj * 128) = w; } }
    }
};
struct EpiRes {
    static constexpr bool PERM = true, HOOK = false; static constexpr bool PRELOAD = false; struct Pre {};
    const float* X; bf16* HB; unsigned long long* ssa;
    __device__ __forceinline__ void operator()(f32x4 (&acc)[2][2][4][2], const Unit& u, int wr, int wc, int fr, int fq) const {
        const int row0 = u.pm * 256 + wr * 64 + fr, col0 = u.pn * 256 + wc * 32 + 8 * fq;
#pragma unroll
        for (int ai = 0; ai < 2; ++ai)
#pragma unroll
            for (int m = 0; m < 4; ++m) { const int row = row0 + ai * 128 + m * 16; const size_t off = (size_t)row * D + col0; float s = 0.f;
#pragma unroll
                for (int bj = 0; bj < 2; ++bj) { const size_t o = off + bj * 128; f32x4 h0, h1;
                    if (X != nullptr) { h0 = __builtin_nontemporal_load((const f32x4*)(X + o)); h1 = __builtin_nontemporal_load((const f32x4*)(X + o + 4)); }
                    else { const pg8::u32x4 w = *(const pg8::u32x4*)(HB + o); h0 = (f32x4){bflo(w.x), bfhi(w.x), bflo(w.y), bfhi(w.y)}; h1 = (f32x4){bflo(w.z), bfhi(w.z), bflo(w.w), bfhi(w.w)}; }
                    h0 += acc[ai][bj][m][0]; h1 += acc[ai][bj][m][1];
                    pg8::u32x4 w; w.x = pg8::cvt_pk_bf16(h0[0], h0[1]); w.y = pg8::cvt_pk_bf16(h0[2], h0[3]); w.z = pg8::cvt_pk_bf16(h1[0], h1[1]); w.w = pg8::cvt_pk_bf16(h1[2], h1[3]);
                    *(pg8::u32x4*)(HB + o) = w;
                    s += ((h0[0] * h0[0] + h0[1] * h0[1]) + (h0[2] * h0[2] + h0[3] * h0[3])) + ((h1[0] * h1[0] + h1[1] * h1[1]) + (h1[2] * h1[2] + h1[3] * h1[3])); }
                { const int ln = fq * 16 + fr; s += shf(s, ln ^ 16); s += shf(s, ln ^ 32); }
                if (fq == 0) atomicAdd(ssa + row, (unsigned long long)((double)s * 4294967296.0)); }
    }
};
struct EpiQ {
    static constexpr bool PERM = true, HOOK = false; static constexpr bool PRELOAD = false; struct Pre {};
    bf16* O; const unsigned long long* ssa;
    __device__ __forceinline__ void operator()(f32x4 (&acc)[2][2][4][2], const Unit& u, int wr, int wc, int fr, int fq) const {
        const int row0 = u.pm * 256 + wr * 64 + fr;
#pragma unroll
        for (int ai = 0; ai < 2; ++ai)
#pragma unroll
            for (int m = 0; m < 4; ++m) { const int row = row0 + ai * 128 + m * 16; const float rs = rsqrtf(ssa_to_f(ssa[row]) * (1.0f / D) + EPS);
                bf16* rowp = O + ((((size_t)(row >> 5) * 8 + u.pn) * 2 * 8 + (wc * 2 + (fq >> 1))) * 64 + (fq & 1) * 32 + (row & 31)) * 8;
#pragma unroll
                for (int bj = 0; bj < 2; ++bj) { const f32x4 v0 = acc[ai][bj][m][0] * rs, v1 = acc[ai][bj][m][1] * rs;
                    pg8::u32x4 w; w.x = pg8::cvt_pk_bf16(v0[0], v0[1]); w.y = pg8::cvt_pk_bf16(v0[2], v0[3]); w.z = pg8::cvt_pk_bf16(v1[0], v1[1]); w.w = pg8::cvt_pk_bf16(v1[2], v1[3]);
                    *(pg8::u32x4*)(rowp + bj * 8 * 512) = w; } }
    }
};

__device__ __forceinline__ int colmap_in(int j) { return j < 1536 ? j : j + 4; }
__device__ __forceinline__ void tr_item_i8(const float* W, const float* gain, const unsigned* cmax, unsigned char* WT, LAS float* scr, int k0, int n0, int lane) {
    const int q = lane & 7, r8 = lane >> 3, sc = colmap_in(n0 + 4 * q);
    f32x4 v[8];
#pragma unroll
    for (int i = 0; i < 8; ++i) v[i] = *(const f32x4*)(W + (size_t)(k0 + 8 * i + r8) * INW + sc);
    f32x4 inv;
#pragma unroll
    for (int e = 0; e < 4; ++e) { const float cm = __builtin_bit_cast(float, cmax[sc + e]); inv[e] = cm > 0.f ? 127.0f / cm : 0.f; }
#pragma unroll
    for (int i = 0; i < 8; ++i) { const float g = gain[k0 + 8 * i + r8];
#pragma unroll
        for (int e = 0; e < 4; ++e) scr[(8 * i + r8) * 33 + 4 * q + e] = v[i][e] * g * inv[e]; }
    asm volatile("s_waitcnt lgkmcnt(0)" ::: "memory");
    const int n = lane >> 1, hf = lane & 1;
    v4u o[2];
#pragma unroll
    for (int w = 0; w < 8; ++w) { unsigned pk = 0;
#pragma unroll
        for (int b = 0; b < 4; ++b) pk |= ((unsigned)((int)rintf(scr[(32 * hf + 4 * w + b) * 33 + n]) & 255)) << (8 * b);
        o[w >> 2][w & 3] = pk; }
    unsigned char* dst = WT + (size_t)(n0 + n) * D + k0 + 32 * hf;
    *(v4u*)dst = o[0]; *(v4u*)(dst + 16) = o[1];
    asm volatile("s_waitcnt lgkmcnt(0)" ::: "memory");
}
template <bool MAP>
__device__ __forceinline__ void tr_item(const float* W, int ldw, const float* scale, bf16* WT, int ldt, int dcol0, LAS float* scr, int k0, int n0, int lane) {
    const int q = lane & 7, r8 = lane >> 3, sc = MAP ? colmap_in(n0 + 4 * q) : (n0 + 4 * q);
    f32x4 v[8];
#pragma unroll
    for (int i = 0; i < 8; ++i) v[i] = *(const f32x4*)(W + (size_t)(k0 + 8 * i + r8) * ldw + sc);
    f32x4 s0 = {1.f, 1.f, 1.f, 1.f}, s1 = s0;
    if (scale) { s0 = *(const f32x4*)(scale + k0 + 8 * q); s1 = *(const f32x4*)(scale + k0 + 8 * q + 4); }
#pragma unroll
    for (int i = 0; i < 8; ++i)
#pragma unroll
        for (int e = 0; e < 4; ++e) scr[(8 * i + r8) * 33 + 4 * q + e] = v[i][e];
    asm volatile("s_waitcnt lgkmcnt(0)" ::: "memory");
    const int c = q;
#pragma unroll
    for (int j = 0; j < 4; ++j) { const int n = r8 + 8 * j; const LAS float* s = scr + (8 * c) * 33 + n;
        v4u o; o.x = pk2(s[0 * 33] * s0[0], s[1 * 33] * s0[1]); o.y = pk2(s[2 * 33] * s0[2], s[3 * 33] * s0[3]); o.z = pk2(s[4 * 33] * s1[0], s[5 * 33] * s1[1]); o.w = pk2(s[6 * 33] * s1[2], s[7 * 33] * s1[3]);
        *(v4u*)(WT + (size_t)(n0 + n) * ldt + dcol0 + k0 + 8 * c) = o; }
    asm volatile("s_waitcnt lgkmcnt(0)" ::: "memory");
}
constexpr size_t WS_BAR = 512 * 1024;
#define XB_TMO      128
#define XB_XCNT(j)  (256  + 64 * (j))
#define XB_XSUB(j)  (1280 + 64 * (j))
#define XB_XGEN(j)  (2304 + 64 * (j))
#define XB_TOP      3328
#define XB_TOPGEN   3392
#define XCD_BAR_WORDS 3456
#define XB_SPIN_CAP (1u << 23)
__device__ __forceinline__ unsigned xb_ld(unsigned* p)              { return __hip_atomic_load(p, __ATOMIC_RELAXED, __HIP_MEMORY_SCOPE_AGENT); }
__device__ __forceinline__ unsigned xb_add(unsigned* p, unsigned v) { return __hip_atomic_fetch_add(p, v, __ATOMIC_RELAXED, __HIP_MEMORY_SCOPE_AGENT); }
__device__ __forceinline__ unsigned xb_xcc_id() { return (unsigned)__builtin_amdgcn_s_getreg((3 << 11) | 20) & 0xFu; }
#define XB_SPIN(cond, bar) do { unsigned _sp = 0; while (cond) { __builtin_amdgcn_s_sleep(1); \
    if ((++_sp & 255u) == 0u) { if (xb_ld(&(bar)[XB_TMO])) break; if (_sp > XB_SPIN_CAP) { atomicAdd(&(bar)[XB_TMO], 1u); break; } } } } while (0)
__device__ __forceinline__ void xcd_barrier_complete(unsigned* bar, unsigned x, unsigned G, unsigned& nloc, unsigned& nx) {
    unsigned sum, cnt, mine, sp = 0u;
    for (;;) {
        sum = 0u; cnt = 0u; mine = 0u;
#pragma unroll
        for (unsigned j = 0; j < 16; ++j) { const unsigned c = xb_ld(&bar[XB_XCNT(j)]); sum += c; cnt += (c > 0u) ? 1u : 0u; mine = (j == x) ? c : mine; }
        if (sum == G) break;
        __builtin_amdgcn_s_sleep(1);
        if ((++sp & 255u) == 0u) { if (xb_ld(&bar[XB_TMO])) break; if (sp > XB_SPIN_CAP) { atomicAdd(&bar[XB_TMO], 1u); break; } }
    }
    nloc = mine > 0u ? mine : 1u; nx = cnt > 0u ? cnt : 1u;
}
__device__ __forceinline__ void xcd_barrier(unsigned* bar, unsigned x, unsigned G, volatile LAS unsigned* st, int wave) {
    asm volatile("s_waitcnt vmcnt(0)" ::: "memory");
    __syncthreads();
    int lane; asm volatile("v_mbcnt_lo_u32_b32 %0, -1, 0\n\tv_mbcnt_hi_u32_b32 %0, -1, %0" : "=v"(lane));
    if (wave == 0 && lane == 0) {
        __builtin_amdgcn_s_waitcnt(0);
        unsigned nloc = st[0], nx = st[1];
        if (nloc == 0u) { xcd_barrier_complete(bar, x, G, nloc, nx); st[0] = nloc; st[1] = nx; }
        const unsigned old = xb_add(&bar[XB_XSUB(x)], 1u);
        const unsigned gen = old / nloc;
        if (old + 1u == (gen + 1u) * nloc) {
            __builtin_amdgcn_fence(__ATOMIC_RELEASE, "agent");
            asm volatile("s_waitcnt vmcnt(0)" ::: "memory");
            const unsigned og = xb_add(&bar[XB_TOP], 1u);
            const unsigned tg = og / nx;
            if (og + 1u == (tg + 1u) * nx) xb_add(&bar[XB_TOPGEN], 1u);
            else XB_SPIN(xb_ld(&bar[XB_TOPGEN]) == tg, bar);
            __builtin_amdgcn_fence(__ATOMIC_ACQUIRE, "agent");
            xb_add(&bar[XB_XGEN(x)], 1u);
            asm volatile("s_waitcnt vmcnt(0)" ::: "memory");
        } else {
            XB_SPIN(xb_ld(&bar[XB_XGEN(x)]) == gen, bar);
            __builtin_amdgcn_fence(__ATOMIC_ACQUIRE, "agent");
            asm volatile("s_waitcnt vmcnt(0)" ::: "memory");
        }
    }
    __syncthreads();
}
namespace att {
constexpr int D = 128, NW = 8, QBLK = 32, KVBLK = 64, QB = NW * QBLK;
constexpr int PITCH = 512, OPITCH = 2048;
constexpr float SCALE = 0.08838834764831845f, THR = 8.f;
constexpr int SHM_V = KVBLK * D * 2, SHM_K = KVBLK * D * 2;
constexpr int OFF_WS = 2 * SHM_V + 2 * SHM_K, OFF_CUM = OFF_WS + NW * 64 * 4, OFF_REL = OFF_CUM + 2048 * 4, LDS_END = OFF_REL + 320 * 4;
typedef unsigned short bf16;
typedef short bf16x8 __attribute__((ext_vector_type(8)));
typedef short s16x4 __attribute__((ext_vector_type(4)));
typedef float f32x16 __attribute__((ext_vector_type(16)));
typedef float f32x4 __attribute__((ext_vector_type(4)));
typedef unsigned u32x4 __attribute__((ext_vector_type(4)));
#define ALDS __attribute__((address_space(3)))

#define KSWZ(row, colB) ((row) * 256 + ((colB) ^ (((row) & 7) << 4)))
#define SBAR() __builtin_amdgcn_sched_barrier(0)
__device__ __forceinline__ int v_st(int k, int c) { const int kk = (k & ~0xC) | ((k & 4) << 1) | ((k & 8) >> 1); return ((kk >> 3) * 4 + (c >> 5)) * 512 + ((kk & 7) * 32 + (c & 31)) * 2; }
__device__ __forceinline__ int v_rd_base(int lane) { return ((lane & 3) << 3) | (((lane >> 2) & 3) << 6) | (((lane >> 4) & 1) << 5) | (((lane >> 5) & 1) << 8); }
constexpr int v_rd_off(int d0, int ks, int half) { return d0 * 512 + ks * 4096 + half * 2048; }
__device__ __forceinline__ int crow(int r, int hi) { return (r & 3) + 8 * (r >> 2) + 4 * hi; }
__device__ __forceinline__ unsigned cvtpk(float lo, float hi) { unsigned r; asm volatile("v_cvt_pk_bf16_f32 %0, %1, %2" : "=v"(r) : "v"(lo), "v"(hi)); return r; }
__device__ __forceinline__ bf16x8 load8(const bf16* p) { return *reinterpret_cast<const bf16x8*>(p); }

__device__ __forceinline__ void mask_tile(f32x16& p0, f32x16& p1, int dq) {
    const float NEG = -__builtin_inff();
#pragma unroll
    for (int r = 0; r < 16; ++r) { const int c = (r & 3) + 8 * (r >> 2);
        if (dq - c < 0) p0[r] = NEG;
        if (dq - c - 32 < 0) p1[r] = NEG; }
}
__device__ __forceinline__ void partialSM(f32x16& p0, f32x16& p1, float& m_reg, float& mn, float& alpha) {
    float pmax = p0[0];
#pragma unroll
    for (int r = 1; r < 16; ++r) pmax = fmaxf(pmax, p0[r]);
#pragma unroll
    for (int r = 0; r < 16; ++r) pmax = fmaxf(pmax, p1[r]);
    { auto rr = __builtin_amdgcn_permlane32_swap(__float_as_uint(pmax), __float_as_uint(pmax), false, false);
      pmax = fmaxf(__uint_as_float(rr[0]), __uint_as_float(rr[1])); }
    constexpr float C2 = 1.4426950408889634f * SCALE;
    if (__builtin_expect(__all((pmax - m_reg) * SCALE <= THR), 1)) { mn = m_reg; alpha = 1.f; }
    else { mn = fmaxf(m_reg, pmax); alpha = __builtin_amdgcn_exp2f((m_reg - mn) * C2); m_reg = mn; }
    const float mnL = -mn * C2;
#pragma unroll
    for (int r = 0; r < 16; ++r) p0[r] = fmaf(p0[r], C2, mnL);
#pragma unroll
    for (int r = 0; r < 16; ++r) p1[r] = fmaf(p1[r], C2, mnL);
#pragma unroll
    for (int r = 0; r < 16; ++r) p0[r] = __builtin_amdgcn_exp2f(p0[r]);
}
__device__ __forceinline__ void finishSM(f32x16& p0, f32x16& p1, float alpha, float& l_reg, bf16x8& pa0, bf16x8& pa1, bf16x8& pa2, bf16x8& pa3) {
#pragma unroll
    for (int r = 0; r < 16; ++r) p1[r] = __builtin_amdgcn_exp2f(p1[r]);
    float ps = 0;
#pragma unroll
    for (int r = 0; r < 16; ++r) ps += p0[r];
#pragma unroll
    for (int r = 0; r < 16; ++r) ps += p1[r];
    { auto rr = __builtin_amdgcn_permlane32_swap(__float_as_uint(ps), __float_as_uint(ps), false, false);
      ps = __uint_as_float(rr[0]) + __uint_as_float(rr[1]); }
    l_reg = l_reg * alpha + ps;
#define PK4(P, B_, OUT) do { unsigned a0 = cvtpk(P[B_+0], P[B_+1]), a1 = cvtpk(P[B_+2], P[B_+3]);                          \
        unsigned b0 = cvtpk(P[B_+4], P[B_+5]), b1 = cvtpk(P[B_+6], P[B_+7]);                                             \
        auto r0 = __builtin_amdgcn_permlane32_swap(a0, b0, false, false); auto r1 = __builtin_amdgcn_permlane32_swap(a1, b1, false, false); \
        u32x4 w = {r0[0], r1[0], r0[1], r1[1]}; OUT = *reinterpret_cast<bf16x8*>(&w); } while (0)
    PK4(p0, 0, pa0); PK4(p0, 8, pa1); PK4(p1, 0, pa2); PK4(p1, 8, pa3);
#undef PK4
}
template <int KB>
__device__ __forceinline__ void qkt(f32x16& p0, f32x16& p1, const ALDS char* K_lds, int r32, int hi, const bf16x8* qr, bool act) {
    if (!act) { const float NEG = -__builtin_inff();
#pragma unroll
        for (int r = 0; r < 16; ++r) { p0[r] = NEG; p1[r] = NEG; } return; }
    p0 = f32x16{}; p1 = f32x16{};
    const ALDS char* kb[4];
#pragma unroll
    for (int dd = 0; dd < 4; ++dd) kb[dd] = K_lds + KB * SHM_K + KSWZ(r32, (dd * 16 + hi * 8) * 2);
#pragma unroll
    for (int d0 = 0; d0 < 8; ++d0) { const ALDS char* a = kb[d0 & 3] + (d0 >> 2) * 128;
        bf16x8 b0 = *(const ALDS bf16x8*)(a);
        bf16x8 b1 = *(const ALDS bf16x8*)(a + 32 * 256);
        p0 = __builtin_amdgcn_mfma_f32_32x32x16_bf16(b0, qr[d0], p0, 0, 0, 0);
        p1 = __builtin_amdgcn_mfma_f32_32x32x16_bf16(b1, qr[d0], p1, 0, 0, 0); }
}
template <int VB>
__device__ __forceinline__ void pv_tile(f32x16* o, int vb0, bf16x8 pa0, bf16x8 pa1, bf16x8 pa2, bf16x8 pa3, bool act) {
    if (!act) return;
#define TRRD(dst, off) asm volatile("ds_read_b64_tr_b16 %0, %1 offset:%2" : "=&v"(dst) : "v"(vb0), "i"(off) : "memory")
#define PV_D0(d0) do { s16x4 l0, l1, l2, l3, h0, h1, h2, h3; constexpr int b_ = VB * SHM_V + v_rd_off(d0, 0, 0); \
        TRRD(l0, b_); TRRD(h0, b_ + 2048); TRRD(l1, b_ + 4096); TRRD(h1, b_ + 6144); TRRD(l2, b_ + 8192); TRRD(h2, b_ + 10240); TRRD(l3, b_ + 12288); TRRD(h3, b_ + 14336); \
        asm volatile("s_waitcnt lgkmcnt(0)" ::: "memory"); SBAR(); \
        o[d0] = __builtin_amdgcn_mfma_f32_32x32x16_bf16(pa0, (bf16x8){l0[0], l0[1], l0[2], l0[3], h0[0], h0[1], h0[2], h0[3]}, o[d0], 0, 0, 0);   \
        o[d0] = __builtin_amdgcn_mfma_f32_32x32x16_bf16(pa1, (bf16x8){l1[0], l1[1], l1[2], l1[3], h1[0], h1[1], h1[2], h1[3]}, o[d0], 0, 0, 0);   \
        o[d0] = __builtin_amdgcn_mfma_f32_32x32x16_bf16(pa2, (bf16x8){l2[0], l2[1], l2[2], l2[3], h2[0], h2[1], h2[2], h2[3]}, o[d0], 0, 0, 0);   \
        o[d0] = __builtin_amdgcn_mfma_f32_32x32x16_bf16(pa3, (bf16x8){l3[0], l3[1], l3[2], l3[3], h3[0], h3[1], h3[2], h3[3]}, o[d0], 0, 0, 0); } while (0)
    PV_D0(0); PV_D0(1); PV_D0(2); PV_D0(3);
#undef PV_D0
#undef TRRD
}
template <int MODE>
__device__ __forceinline__ void bias_mask(f32x16& p0, f32x16& p1, const ALDS char* lds, int kb, int qlo, int qpos, int hi, float cqs, bool act) {
    if (!act) return;
    if (MODE == 0) {
        const ALDS float* cs = (const ALDS float*)(lds + OFF_CUM) + kb + 4 * hi;
#pragma unroll
        for (int g = 0; g < 4; ++g) { const f32x4 c0 = *(const ALDS f32x4*)(cs + 8 * g), c1 = *(const ALDS f32x4*)(cs + 32 + 8 * g);
#pragma unroll
            for (int e = 0; e < 4; ++e) { p0[4 * g + e] += cqs - c0[e]; p1[4 * g + e] += cqs - c1[e]; } }
        if (kb + KVBLK - 1 > qlo) mask_tile(p0, p1, qpos - 4 * hi - kb);
    } else {
        const ALDS float* tb = (const ALDS float*)(lds + OFF_REL);
        if (qlo - (kb + KVBLK - 1) >= 256) { const float c = tb[319];
#pragma unroll
            for (int r = 0; r < 16; ++r) { p0[r] += c; p1[r] += c; } }
        else { const int d0 = qpos - kb - 4 * hi + 63;
#pragma unroll
            for (int r = 0; r < 16; ++r) { const int c = (r & 3) + 8 * (r >> 2);
                int i0 = d0 - c, i1 = d0 - c - 32; i0 = i0 > 319 ? 319 : i0; i1 = i1 > 319 ? 319 : i1; i1 = i1 < 0 ? 0 : i1; i0 = i0 < 0 ? 0 : i0;
                p0[r] += tb[i0]; p1[r] += tb[i1]; } }
    }
}

struct Seam { bf16x8 qr[8]; bf16x8 st_v0, st_v1, st_k0, st_k1; };
#define VMW() asm volatile("s_waitcnt vmcnt(0)" ::: "memory")
#define BL8(rs, vo, so) __builtin_bit_cast(bf16x8, __builtin_amdgcn_raw_buffer_load_b128(rs, vo, so, 0))
#define SLOAD_H(Kp, Vp, k0) do { S.st_v0 = BL8(rP, kvoff, (Vp) + (k0) * (PITCH * 2)); S.st_v1 = BL8(rP, kvoff, (Vp) + ((k0) + 32) * (PITCH * 2));              \
                         S.st_k0 = BL8(rP, kvoff, (Kp) + (k0) * (PITCH * 2)); S.st_k1 = BL8(rP, kvoff, (Kp) + ((k0) + 32) * (PITCH * 2)); } while (0)
#define SWRITE_HK(bf) do { *(ALDS bf16x8*)(K_lds + (bf) * SHM_K + kws) = S.st_k0; *(ALDS bf16x8*)(K_lds + (bf) * SHM_K + kws + 32 * 256) = S.st_k1; } while (0)
#define SWRITE_HV(bf) do { *(ALDS bf16x8*)(V_lds + (bf) * SHM_V + vst0) = S.st_v0; *(ALDS bf16x8*)(V_lds + (bf) * SHM_V + vst1) = S.st_v1; } while (0)
#define SWRITE_H(bf) do { SWRITE_HV(bf); SWRITE_HK(bf); } while (0)

template <int MODE, bool PART = false>
__device__ __forceinline__ void attn_unit(const bf16* Pb, int Qo, int Kh, int Vh, bf16* Yb, int Oo, int P0, int j_lo, int j_hi, ALDS char* lds, int wid, int lane, float* PO = nullptr, float* PM = nullptr, float* PL = nullptr) {
    const int tid = wid * 64 + lane, r32 = lane & 31, hi = lane >> 5;
    const int NT = j_hi - j_lo;
    const int qlo = P0 + wid * QBLK, qpos = qlo + r32;
    ALDS char* V_lds = lds; ALDS char* K_lds = lds + 2 * SHM_V;
    ALDS float* ws = (ALDS float*)(lds + OFF_WS) + wid * 64; ALDS float* li_l = ws; ALDS float* al_l = ws + 32;
    float m_reg = -1e30f, l_reg = 0; f32x16 o[4] = {};
    const int sr = tid >> 4, sc = (tid & 15) * 8, vst0 = v_st(sr, sc), vst1 = v_st(32 + sr, sc), kws = KSWZ(sr, sc * 2);
    const int vb0 = (int)(unsigned)(size_t)V_lds + v_rd_base(lane);
    Seam S;
    const __amdgpu_buffer_rsrc_t rP = __builtin_amdgcn_make_buffer_rsrc((void*)Pb, 0, 0x7fffffff, 0x00020000);
    const __amdgpu_buffer_rsrc_t rO = __builtin_amdgcn_make_buffer_rsrc((void*)Yb, 0, 0x7fffffff, 0x00020000);
    const int kvoff = (sr * PITCH + sc) * 2;
#define KBASE(t) ((j_lo + (t)) * KVBLK)
#define ACT(t) (MODE == 0 ? (KBASE(t) <= qlo + QBLK - 1) : ((j_lo + (t)) <= (qlo >> 6) && (j_lo + (t)) + 8 >= (qlo >> 6)))
#define RESC(a) do { if (__any((a) < 1.f)) { if (hi == 0) al_l[r32] = (a); asm volatile("s_waitcnt lgkmcnt(0)" ::: "memory");              \
                     for (int d_ = 0; d_ < 4; ++d_) for (int r = 0; r < 16; ++r) o[d_][r] *= al_l[crow(r, hi)]; } } while (0)
#define MASKT(P0_, P1_, t) bias_mask<MODE>(P0_, P1_, lds, KBASE(t), qlo, qpos, hi, cq_, ACT(t))
    {
        const int kb0 = j_lo * KVBLK;
#pragma unroll
        for (int d0 = 0; d0 < 8; ++d0) S.qr[d0] = BL8(rP, (r32 * PITCH + hi * 8) * 2 + d0 * 32, Qo + wid * (QBLK * PITCH * 2));
        SLOAD_H(Kh, Vh, kb0); VMW(); SWRITE_HK(0);
        __syncthreads();
    }
    const float cq_ = MODE == 0 ? ((const ALDS float*)(lds + OFF_CUM))[qpos] : 0.f;
    f32x16 pA0, pA1, pB0, pB1; float mnA, mnB, alA, alB; bf16x8 pa0, pa1, pa2, pa3;
    SWRITE_HV(0); SBAR();
    if (NT > 1) { SLOAD_H(Kh, Vh, KBASE(1)); }
    SBAR(); qkt<0>(pA0, pA1, K_lds, r32, hi, S.qr, ACT(0));
    MASKT(pA0, pA1, 0); partialSM(pA0, pA1, m_reg, mnA, alA);
    if (NT > 1) { VMW(); SWRITE_H(1); }
    __syncthreads();
#define HALF_STEP(PX0, PX1, mnX, alX, PY0, PY1, alY, t, KB, VB, SB) do {                                                      \
        SBAR(); qkt<KB>(PX0, PX1, K_lds, r32, hi, S.qr, ACT(t));                                                              \
        finishSM(PY0, PY1, alY, l_reg, pa0, pa1, pa2, pa3); SBAR();                                                           \
        if ((t) + 1 < NT) { SLOAD_H(Kh, Vh, KBASE((t) + 1)); SBAR(); }                                                        \
        pv_tile<VB>(o, vb0, pa0, pa1, pa2, pa3, ACT((t) - 1)); MASKT(PX0, PX1, (t)); partialSM(PX0, PX1, m_reg, mnX, alX);    \
        __syncthreads();                                                                                                      \
        if ((t) + 1 < NT) { VMW(); SWRITE_H(SB); }                                                                            \
        RESC(alX); __syncthreads(); } while (0)
    for (int t = 1; t + 1 < NT; t += 2) {
        HALF_STEP(pB0, pB1, mnB, alB, pA0, pA1, alA, t, 1, 0, 0);
        HALF_STEP(pA0, pA1, mnA, alA, pB0, pB1, alB, t + 1, 0, 1, 1);
    }
    const bool even = (NT & 1) == 0;
    if (even) { SBAR(); qkt<1>(pB0, pB1, K_lds, r32, hi, S.qr, ACT(NT - 1)); SBAR(); }
    finishSM(pA0, pA1, alA, l_reg, pa0, pa1, pa2, pa3); SBAR();
    pv_tile<0>(o, vb0, pa0, pa1, pa2, pa3, ACT(even ? NT - 2 : NT - 1));
    if (even) { MASKT(pB0, pB1, NT - 1); partialSM(pB0, pB1, m_reg, mnB, alB); __syncthreads(); RESC(alB);
        finishSM(pB0, pB1, alB, l_reg, pa0, pa1, pa2, pa3); SBAR(); pv_tile<1>(o, vb0, pa0, pa1, pa2, pa3, ACT(NT - 1)); }
    SBAR();
    if constexpr (PART) {
        if (hi == 0) { PM[wid * QBLK + r32] = m_reg; PL[wid * QBLK + r32] = l_reg; }
#pragma unroll
        for (int r = 0; r < 16; ++r) { const int orow = wid * QBLK + (r & 3) + 8 * (r >> 2) + 4 * hi;
#pragma unroll
            for (int d0 = 0; d0 < 4; ++d0) PO[orow * D + d0 * 32 + r32] = o[d0][r]; }
    } else {
    if (hi == 0) li_l[r32] = l_reg; asm volatile("s_waitcnt lgkmcnt(0)" ::: "memory");
    float rli[16];
#pragma unroll
    for (int r = 0; r < 16; ++r) rli[r] = __builtin_amdgcn_rcpf(li_l[crow(r, hi)]);
    const int ovoff = (4 * hi * OPITCH + r32) * 2, osoff = Oo + wid * (QBLK * OPITCH * 2);
#pragma unroll
    for (int r = 0; r < 16; ++r) { const int orow = (r & 3) + 8 * (r >> 2);
#pragma unroll
        for (int d0 = 0; d0 < 4; ++d0) { const float v = o[d0][r] * rli[r];
            const float vn = __builtin_bit_cast(float, __builtin_amdgcn_ds_bpermute((lane ^ 1) << 2, __builtin_bit_cast(int, v)));
            if ((r32 & 1) == 0) __builtin_amdgcn_raw_buffer_store_b32(cvtpk(v, vn), rO, ovoff + d0 * 64, osoff + orow * (OPITCH * 2), 0); } }
    }
    __syncthreads();
#undef RESC
#undef KBASE
#undef ACT
#undef MASKT
#undef HALF_STEP
}
#undef BL8
#undef VMW
#undef SLOAD_H
#undef SWRITE_HK
#undef SWRITE_HV
#undef SWRITE_H
#undef KSWZ
#undef SBAR
}
constexpr size_t WS_QCTR = 768 * 1024;
constexpr size_t WS_POOLW = 4 * MiB;
constexpr int N_ATT_UNITS = 256, N_POOL_UNITS = 512, N_CONV_UNITS = 128;

__device__ __forceinline__ void stage_cum(const Args& a, int b, int h, LAS char* lds, int wave, int lane) {
    const float* logf = (const float*)(a.ws + WS_LOGF) + ((size_t)b * SEQ) * 4 + h;
    const int tid = wave * 64 + lane;
    float v[4];
#pragma unroll
    for (int e = 0; e < 4; ++e) v[e] = logf[(size_t)(4 * tid + e) * 4];
    v[1] += v[0]; v[2] += v[1]; v[3] += v[2];
    float incl = v[3];
#pragma unroll
    for (int o = 1; o < 64; o <<= 1) { const float t = shf(incl, lane >= o ? lane - o : lane); if (lane >= o) incl += t; }
    LAS float* wt = (LAS float*)(lds + att::OFF_WS);
    if (lane == 63) wt[wave] = incl;
    __syncthreads();
    float base = incl - v[3];
    for (int w = 0; w < wave; ++w) base += wt[w];
    LAS float* cs = (LAS float*)(lds + att::OFF_CUM);
    const float inv = 1.0f / ATT_SCALE;
    *(LAS f32x4*)(cs + 4 * tid) = (f32x4){(base + v[0]) * inv, (base + v[1]) * inv, (base + v[2]) * inv, (base + v[3]) * inv};
    __syncthreads();
}
constexpr size_t WS_PO = WS_MRG;
constexpr size_t WS_PML = WS_MRG + 16 * MiB;
constexpr size_t WS_ACNT = WS_QCTR + 4096;
struct AttBlk { int mode, qb, part; };
__device__ __forceinline__ void att_sched(int slot, AttBlk& b0, AttBlk& b1) {
    b1.mode = 0; b1.qb = -1; b1.part = 0; b0.mode = 0; b0.part = 0;
    switch (slot) {
        case 0: b0.qb = 7; b0.part = 1; break;   case 1: b0.qb = 7; b0.part = 2; break;
        case 2: b0.qb = 6; b0.part = 1; break;   case 3: b0.qb = 6; b0.part = 2; break;
        case 4: b0.qb = 5; b0.part = 1; b1.qb = 0; break;
        case 5: b0.qb = 5; b0.part = 2; break;
        case 6: b0.qb = 4; break;
        case 7: b0.qb = 3; break;
        case 8: b0.qb = 2; b1.mode = 1; b1.qb = 0; break;
        case 9: b0.qb = 1; b1.mode = 1; b1.qb = 1; break;
        default: b0.mode = 1; b0.qb = 17 - slot; break;
    }
}
__device__ __forceinline__ void combine_pair(const Args& a, int l, int pair, int wave);
__device__ __forceinline__ void attention_block(const Args& a, int l, int bh, AttBlk k, LAS char* lds, int wave) {
    int lane; asm volatile("v_mbcnt_lo_u32_b32 %0, -1, 0\n\tv_mbcnt_hi_u32_b32 %0, -1, %0" : "=v"(lane));
    const bf16* P = (const bf16*)(a.ws + WS_PROJ); bf16* Y = (bf16*)(a.ws + WS_Y);
    const int qb = k.qb, b = bh >> 2, h = bh & 3;
    const size_t row0 = (size_t)b * SEQ; const int P0 = qb * 256;
    if (k.mode == 0) {
        stage_cum(a, b, h, lds, wave, lane);
        const int nt = 4 * qb + 4, q0 = (int)((0 * PROJ_T + (row0 + P0) * MIXW + h * HD) * 2), k0 = (int)((1 * PROJ_T + row0 * MIXW + h * HD) * 2), v0 = (int)((2 * PROJ_T + row0 * MIXW + h * HD) * 2), o0 = (int)(((row0 + P0) * D + h * HD) * 2);
        if (k.part == 0) att::attn_unit<0>(P, q0, k0, v0, Y, o0, P0, 0, nt, lds, wave, lane);
        else { const int pair = (qb - 4) * 16 + bh, hf = k.part - 1;
            float* PO = (float*)(a.ws + WS_PO) + ((size_t)pair * 2 + hf) * 256 * 128; float* PM = (float*)(a.ws + WS_PML) + ((size_t)pair * 2 + hf) * 512;
            att::attn_unit<0, true>(P, q0, k0, v0, Y, o0, P0, hf ? nt / 2 : 0, hf ? nt : nt / 2, lds, wave, lane, PO, PM, PM + 256);
            asm volatile("s_waitcnt vmcnt(0)" ::: "memory"); __syncthreads();
            if (hf == 0) {
                if (wave == 0 && lane == 0) { __builtin_amdgcn_fence(__ATOMIC_RELEASE, "agent"); asm volatile("s_waitcnt vmcnt(0)" ::: "memory");
                    __hip_atomic_fetch_add((unsigned*)(a.ws + WS_ACNT) + l * 64 + pair, 1u, __ATOMIC_RELAXED, __HIP_MEMORY_SCOPE_AGENT); } } }
    } else {
        const int tid = wave * 64 + lane;
        if (tid < 320) ((LAS float*)(lds + att::OFF_REL))[tid] = a.rel_bias[((size_t)l * 4 + h) * 320 + tid] * (1.0f / ATT_SCALE);
        const int jlo = 4 * qb - 8 < 0 ? 0 : 4 * qb - 8;
        att::attn_unit<1>(P, (int)((7 * PROJ_T + (row0 + P0) * MIXW + h * HD) * 2), (int)((8 * PROJ_T + row0 * MIXW + h * HD) * 2), (int)((9 * PROJ_T + row0 * MIXW + h * HD) * 2),
                          Y, (int)(((row0 + P0) * D + 1536 + h * HD) * 2), P0, jlo, 4 * qb + 4, lds, wave, lane);
    }
}
__device__ __forceinline__ void combine_pair(const Args& a, int l, int pair, int wave) {
    int lane; asm volatile("v_mbcnt_lo_u32_b32 %0, -1, 0\n\tv_mbcnt_hi_u32_b32 %0, -1, %0" : "=v"(lane));
    if (wave == 0 && lane == 0) {
        unsigned* c = (unsigned*)(a.ws + WS_ACNT) + l * 64 + pair; unsigned sp = 0;
        while (__hip_atomic_load(c, __ATOMIC_RELAXED, __HIP_MEMORY_SCOPE_AGENT) < 1u && ++sp < (1u << 24)) __builtin_amdgcn_s_sleep(2);
        __builtin_amdgcn_fence(__ATOMIC_ACQUIRE, "agent"); asm volatile("s_waitcnt vmcnt(0)" ::: "memory"); }
    __syncthreads();
    const int qb = 4 + (pair >> 4), bh = pair & 15, b = bh >> 2, h = bh & 3, tid = wave * 64 + lane, row = tid >> 1, c0 = (tid & 1) * 64;
    const float* POA = (const float*)(a.ws + WS_PO) + ((size_t)pair * 2) * 256 * 128 + row * 128 + c0; const float* POB = POA + 256 * 128;
    const float* ML = (const float*)(a.ws + WS_PML) + (size_t)pair * 2 * 512;
    const float mA = ML[row], lA = ML[256 + row], mB = ML[512 + row], lB = ML[768 + row], mm = fmaxf(mA, mB);
    constexpr float C2 = 1.4426950408889634f * ATT_SCALE;
    const float wA = __builtin_amdgcn_exp2f((mA - mm) * C2), wB = __builtin_amdgcn_exp2f((mB - mm) * C2), inv = 1.0f / (lA * wA + lB * wB), fa = wA * inv, fb = wB * inv;
    bf16* Y = (bf16*)(a.ws + WS_Y) + ((size_t)b * SEQ + qb * 256 + row) * D + h * HD + c0;
#pragma unroll
    for (int k = 0; k < 64; k += 8) { const f32x4 a0 = *(const f32x4*)(POA + k), a1 = *(const f32x4*)(POA + k + 4), b0 = *(const f32x4*)(POB + k), b1 = *(const f32x4*)(POB + k + 4);
        v4u o; o.x = pk2(a0[0] * fa + b0[0] * fb, a0[1] * fa + b0[1] * fb); o.y = pk2(a0[2] * fa + b0[2] * fb, a0[3] * fa + b0[3] * fb);
        o.z = pk2(a1[0] * fa + b1[0] * fb, a1[1] * fa + b1[1] * fb); o.w = pk2(a1[2] * fa + b1[2] * fb, a1[3] * fa + b1[3] * fb); *(v4u*)(Y + k) = o; }
    __syncthreads();
}
__device__ __forceinline__ void pool_item(const Args& a, int l, int u, LAS char* lds, int wave) {
    int lane; asm volatile("v_mbcnt_lo_u32_b32 %0, -1, 0\n\tv_mbcnt_hi_u32_b32 %0, -1, %0" : "=v"(lane));
    const int g = u & 3, T0 = (u >> 2) * 64, tid = wave * 64 + lane;
    const bf16* Pin = (const bf16*)(a.ws + WS_PROJ) + 3 * PROJ_T + g * 128;
    typedef short bf16x8 __attribute__((ext_vector_type(8)));
    const int rt = (wave & 3) * 16, db = (wave >> 2) * 64, fr = lane & 15, kg = lane >> 4;
    bf16x8 bfr[4][4]; f32x4 sc[4];
    { const bf16* Wt = (const bf16*)(a.ws + WS_POOLW) + ((size_t)l * 4 + g) * 128 * 128;
#pragma unroll
      for (int ks = 0; ks < 4; ++ks)
#pragma unroll
          for (int nt = 0; nt < 4; ++nt) bfr[ks][nt] = *(const bf16x8*)(Wt + (size_t)(db + nt * 16 + fr) * 128 + ks * 32 + kg * 8);
#pragma unroll
      for (int nt = 0; nt < 4; ++nt) sc[nt] = *(const f32x4*)(a.pool_scale + l * MIXW + g * 128 + db + nt * 16 + kg * 4); }
    {
        const int cp = tid & 63, run = tid >> 6, w = 2 << g, t0 = T0 + run * 8, s0 = t0 & (SEQ - 1);
        const bf16* col = Pin + 2 * cp;
        float lo[23], hi[23];
#pragma unroll
        for (int k = 0; k < 23; ++k) { const int dj = k - 15; const bool ok = s0 + dj >= 0; const unsigned x = *(const unsigned*)(col + (size_t)(ok ? t0 + dj : t0) * MIXW); lo[k] = ok ? bflo(x) : 0.f; hi[k] = ok ? bfhi(x) : 0.f; }
        float s_lo = 0.f, s_hi = 0.f;
#pragma unroll
        for (int j = 1; j < 16; ++j) if (j < w) { s_lo += lo[15 - j]; s_hi += hi[15 - j]; }
#pragma unroll
        for (int i = 0; i < 8; ++i) { s_lo += lo[15 + i]; s_hi += hi[15 + i];
            const int s = s0 + i; const int cnt = s + 1 < w ? s + 1 : w; const float inv = 1.0f / (float)cnt;
            *(LAS unsigned*)(lds + (run * 8 + i) * 272 + 4 * cp) = pk2(s_lo * inv - lo[15 + i], s_hi * inv - hi[15 + i]);
            const float dl = g == 0 ? lo[14 + i] : g == 1 ? lo[12 + i] : g == 2 ? lo[8 + i] : lo[i], dh = g == 0 ? hi[14 + i] : g == 1 ? hi[12 + i] : g == 2 ? hi[8 + i] : hi[i];
            s_lo -= dl; s_hi -= dh; }
    }
    __syncthreads();
    {
        f32x4 acc[4] = {};
#pragma unroll
        for (int ks = 0; ks < 4; ++ks) { const bf16x8 af = *(const LAS bf16x8*)(lds + (rt + fr) * 272 + (ks * 32 + kg * 8) * 2);
#pragma unroll
            for (int nt = 0; nt < 4; ++nt) acc[nt] = __builtin_amdgcn_mfma_f32_16x16x32_bf16(bfr[ks][nt], af, acc[nt], 0, 0, 0); }
        bf16* Y = (bf16*)(a.ws + WS_Y) + (size_t)(T0 + rt + fr) * D + 512 + g * 128;
#pragma unroll
        for (int nt = 0; nt < 4; ++nt) { const int d = db + nt * 16 + kg * 4;
            v2u w; w.x = pk2(acc[nt][0] * sc[nt][0], acc[nt][1] * sc[nt][1]); w.y = pk2(acc[nt][2] * sc[nt][2], acc[nt][3] * sc[nt][3]); *(v2u*)(Y + d) = w; }
    }
    __syncthreads();
}
__device__ __forceinline__ void conv_item(const Args& a, int l, int u, int wave) {
    int lane; asm volatile("v_mbcnt_lo_u32_b32 %0, -1, 0\n\tv_mbcnt_hi_u32_b32 %0, -1, %0" : "=v"(lane));
    const bf16* P = (const bf16*)(a.ws + WS_PROJ); const bf16* Ch = P + 4 * PROJ_T; const bf16* Cb = P + 5 * PROJ_T; const bf16* Cc = P + 6 * PROJ_T;
    const int tid = wave * 64 + lane, c0 = (tid & 63) * 8, t0 = u * 64 + (tid >> 6) * 8, s0 = t0 & (SEQ - 1);
    float wgt[3][8];
#pragma unroll
    for (int j = 0; j < 3; ++j) { const float* w = a.conv_w + ((size_t)l * 3 + j) * MIXW + c0; const f32x4 w0 = *(const f32x4*)w, w1 = *(const f32x4*)(w + 4);
#pragma unroll
        for (int k = 0; k < 4; ++k) { wgt[j][k] = w0[k]; wgt[j][4 + k] = w1[k]; } }
    v4u hv[10], cv[10], bv[8];
#pragma unroll
    for (int k = 0; k < 10; ++k) { const int i = k - 2; const size_t r = (size_t)(s0 + i >= 0 ? t0 + i : t0) * MIXW + c0; hv[k] = *(const v4u*)(Ch + r); cv[k] = *(const v4u*)(Cc + r); }
#pragma unroll
    for (int i = 0; i < 8; ++i) bv[i] = *(const v4u*)(Cb + (size_t)(t0 + i) * MIXW + c0);
    float z2[8], z1[8];
#pragma unroll
    for (int k = 0; k < 8; ++k) { z2[k] = 0.f; z1[k] = 0.f; }
#pragma unroll
    for (int k = 0; k < 10; ++k) { const int i = k - 2; const float msk = s0 + i >= 0 ? 1.f : 0.f;
        float z[8];
        z[0] = bflo(hv[k].x) * bflo(cv[k].x) * msk; z[1] = bfhi(hv[k].x) * bfhi(cv[k].x) * msk; z[2] = bflo(hv[k].y) * bflo(cv[k].y) * msk; z[3] = bfhi(hv[k].y) * bfhi(cv[k].y) * msk;
        z[4] = bflo(hv[k].z) * bflo(cv[k].z) * msk; z[5] = bfhi(hv[k].z) * bfhi(cv[k].z) * msk; z[6] = bflo(hv[k].w) * bflo(cv[k].w) * msk; z[7] = bfhi(hv[k].w) * bfhi(cv[k].w) * msk;
        if (i >= 0) { const v4u b = bv[i]; float o[8];
            const float bb[8] = {bflo(b.x), bfhi(b.x), bflo(b.y), bfhi(b.y), bflo(b.z), bfhi(b.z), bflo(b.w), bfhi(b.w)};
#pragma unroll
            for (int q = 0; q < 8; ++q) o[q] = bb[q] * (wgt[0][q] * z2[q] + wgt[1][q] * z1[q] + wgt[2][q] * z[q]);
            v4u ov; ov.x = pk2(o[0], o[1]); ov.y = pk2(o[2], o[3]); ov.z = pk2(o[4], o[5]); ov.w = pk2(o[6], o[7]);
            *(v4u*)((bf16*)(a.ws + WS_Y) + (size_t)(t0 + i) * D + 1024 + c0) = ov; }
#pragma unroll
        for (int q = 0; q < 8; ++q) { z2[q] = z1[q]; z1[q] = z[q]; }
    }
}
__device__ __forceinline__ void mixers_fast(const Args& a, int lq, LAS char* lds, int wave, int lane, int G, int blk) {
    const int l = lq;
    AttBlk b0, b1; att_sched(blk >> 4, b0, b1);
    const bool split = G == 256;
    const int natt = split ? 2 : (N_ATT_UNITS - blk + G - 1) / G;
    unsigned* head = (unsigned*)(a.ws + WS_QCTR) + 64 * lq;
    volatile LAS unsigned* slot = (volatile LAS unsigned*)(lds + att::LDS_END);
    unsigned tk = 0;
    for (int stage = 0;; ++stage) {
        if (stage < natt) { AttBlk k = stage ? b1 : b0; int bh = blk & 15;
            if (!split) { const int u = blk + stage * G; k.mode = u >> 7; k.qb = 7 - ((u & 127) >> 4); k.part = 0; bh = u & 15; }
            if (k.qb >= 0) attention_block(a, l, bh, k, lds, wave);
            continue; }
        if (stage == natt) { if (split && b0.part == 2) combine_pair(a, l, (b0.qb - 4) * 16 + (blk & 15), wave); continue; }
        if (stage == natt + 1 && wave == 0 && lane == 0) tk = __hip_atomic_fetch_add(head, 1u, __ATOMIC_RELAXED, __HIP_MEMORY_SCOPE_AGENT);
        if (wave == 0 && lane == 0) *slot = tk;
        __syncthreads();
        const unsigned it = *slot;
        __syncthreads();
        if (it >= (unsigned)(N_POOL_UNITS + N_CONV_UNITS)) break;
        if (wave == 0 && lane == 0) tk = __hip_atomic_fetch_add(head, 1u, __ATOMIC_RELAXED, __HIP_MEMORY_SCOPE_AGENT);
        if (it < (unsigned)N_POOL_UNITS) pool_item(a, l, (int)it, lds, wave); else conv_item(a, l, (int)it - N_POOL_UNITS, wave);
    }
}
__device__ __forceinline__ void p0_cmax(const Args& a, int gw, int NGW, int lane) {
    unsigned char* ws = a.ws;
    {
        constexpr int NCC = (INW + 255) / 256;
        for (int it = gw; it < DEPTH * 32 * NCC; it += NGW) { const int l = it / (32 * NCC), r = it % (32 * NCC), kc = r / NCC, cc = r % NCC; const int c0 = cc * 256 + 4 * lane;
            if (c0 + 3 < INW) { const float* W = a.w_in + (size_t)l * D * INW + (size_t)(kc * 64) * INW + c0; const float* g = a.norm_mix + l * D + kc * 64;
                float m0 = 0.f, m1 = 0.f, m2 = 0.f, m3 = 0.f;
#pragma unroll 8
                for (int k = 0; k < 64; ++k) { const f32x4 w = *(const f32x4*)(W + (size_t)k * INW); const float gk = fabsf(g[k]);
                    m0 = fmaxf(m0, fabsf(w[0]) * gk); m1 = fmaxf(m1, fabsf(w[1]) * gk); m2 = fmaxf(m2, fabsf(w[2]) * gk); m3 = fmaxf(m3, fabsf(w[3]) * gk); }
                unsigned* cm = (unsigned*)(ws + WS_CMAX) + l * INW + c0;
                const unsigned u0 = __float_as_uint(m0), u1 = __float_as_uint(m1), u2 = __float_as_uint(m2), u3 = __float_as_uint(m3);
                __hip_atomic_fetch_max(cm + 0, u0, __ATOMIC_RELAXED, __HIP_MEMORY_SCOPE_AGENT); __hip_atomic_fetch_max(cm + 1, u1, __ATOMIC_RELAXED, __HIP_MEMORY_SCOPE_AGENT);
                __hip_atomic_fetch_max(cm + 2, u2, __ATOMIC_RELAXED, __HIP_MEMORY_SCOPE_AGENT); __hip_atomic_fetch_max(cm + 3, u3, __ATOMIC_RELAXED, __HIP_MEMORY_SCOPE_AGENT); } }
    }
}
__device__ __forceinline__ void weight_copies(const Args& a, LAS unsigned char* lds, int l, int part, int gw, int NGW, int wave, int lane) {
    unsigned char* ws = a.ws;
    LAS float* scr = (LAS float*)(lds + wave * 16384);
    constexpr int I_SQ = (D / 64) * (D / 32), I_BR = (MIXW / 64) * (D / 32);
    constexpr int I_LAYER = 4 * I_BR + 2 * I_SQ;
    for (int it = (part ? 4 * I_BR : 0) + gw; it < (part ? I_LAYER : 4 * I_BR); it += NGW) {
        int r = it;
        if (r < 4 * I_BR) { const int g = r / I_BR, rr = r % I_BR, kb = rr / (D / 32), nb = rr % (D / 32);
            tr_item<false>(a.w_branch + ((size_t)l * 4 + g) * MIXW * D, D, nullptr, (bf16*)(ws + WS_WBR + l * SQ_BYTES), D, g * MIXW, scr, 64 * kb, 32 * nb, lane); continue; }
        r -= 4 * I_BR;
        if (r < I_SQ) { const int kb = r / (D / 32), nb = r % (D / 32);
            tr_item<false>(a.w_out + (size_t)l * D * D, D, nullptr, (bf16*)(ws + WS_WOUT + l * SQ_BYTES), D, 0, scr, 64 * kb, 32 * nb, lane); continue; }
        r -= I_SQ;
        { const int kb = r / (D / 32), nb = r % (D / 32);
            tr_item<false>(a.peer_wq + (size_t)l * D * D, D, a.norm_ffn + l * D, (bf16*)(ws + WS_WQ + l * SQ_BYTES), D, 0, scr, 64 * kb, 32 * nb, lane); }
    }
}
__device__ __forceinline__ void p0_prologue(const Args& a, LAS unsigned char* lds, int gw, int NGW, int wave, int lane) {
    unsigned char* ws = a.ws;
    LAS float* scr = (LAS float*)(lds + wave * 16384);
    for (int l = 0; l < DEPTH; ++l) weight_copies(a, lds, l, 1, gw, NGW, wave, lane);
    for (int it = gw; it < DEPTH * 4 * 8; it += NGW) { const int lg = it >> 3, r = it & 7;
        tr_item<false>(a.pool_w + (size_t)lg * 128 * 128, 128, nullptr, (bf16*)(ws + WS_POOLW) + (size_t)lg * 128 * 128, 128, 0, scr, 64 * (r >> 2), 32 * (r & 3), lane); }
    {
        constexpr int NR = 2 * DEPTH * PEER_E;
        f32x4 nv[8];
        if (gw < NR) { const int t = gw / (DEPTH * PEER_E), row = gw - t * (DEPTH * PEER_E); const float* src = (t ? a.peer_v : a.peer_u) + (size_t)row * D + 4 * lane;
#pragma unroll
            for (int j = 0; j < 8; ++j) nv[j] = __builtin_nontemporal_load((const f32x4*)(src + 256 * j)); }
        for (int r = gw; r < NR; r += NGW) { const int t = r / (DEPTH * PEER_E), row = r - t * (DEPTH * PEER_E);
            f32x4 v[8]; float am = 0.f;
#pragma unroll
            for (int j = 0; j < 8; ++j) v[j] = nv[j];
            { const int r2 = r + NGW; if (r2 < NR) { const int t2 = r2 / (DEPTH * PEER_E), row2 = r2 - t2 * (DEPTH * PEER_E); const float* src = (t2 ? a.peer_v : a.peer_u) + (size_t)row2 * D + 4 * lane;
#pragma unroll
                for (int j = 0; j < 8; ++j) nv[j] = __builtin_nontemporal_load((const f32x4*)(src + 256 * j)); } }
#pragma unroll
            for (int j = 0; j < 8; ++j) am = fmaxf(am, fmaxf(fmaxf(fabsf(v[j][0]), fabsf(v[j][1])), fmaxf(fabsf(v[j][2]), fabsf(v[j][3]))));
            am = wave_max(am, lane);
            const float inv = am > 0.f ? 127.0f / am : 0.f, off = 0.f;
            unsigned char* dst = ws + (t ? WS_PV : WS_PU) + (size_t)row * D + 4 * lane;
#pragma unroll
            for (int j = 0; j < 8; ++j) { const int q0 = (int)(rintf(v[j][0] * inv) + off), q1 = (int)(rintf(v[j][1] * inv) + off), q2 = (int)(rintf(v[j][2] * inv) + off), q3 = (int)(rintf(v[j][3] * inv) + off);
                *(unsigned*)(dst + 256 * j) = (unsigned)(q0 & 255) | ((unsigned)(q1 & 255) << 8) | ((unsigned)(q2 & 255) << 16) | ((unsigned)(q3 & 255) << 24); }
            if (lane == 0) ((float*)(ws + (t ? WS_SV : WS_SU)))[row] = am * (1.0f / 127.0f); }
    }
    { bf16* pk = (bf16*)(ws + WS_PK); const size_t n8 = (size_t)DEPTH * 8 * 2 * 128 * 128 / 8;
      for (size_t i = (size_t)gw * 64 + lane; i < n8; i += (size_t)NGW * 64) { const size_t ln = i & 63, cs = (i >> 6) & 7, kb = (i >> 9) & 3, lhp = i >> 11; const size_t so = lhp * 16384 + (kb * 32 + (ln & 31)) * 128 + cs * 16 + (ln >> 5) * 8;
          const f32x4 v0 = *(const f32x4*)(a.peer_keys + so), v1 = *(const f32x4*)(a.peer_keys + so + 4);
          v4u o; o.x = pk2(v0[0], v0[1]); o.y = pk2(v0[2], v0[3]); o.z = pk2(v1[0], v1[1]); o.w = pk2(v1[2], v1[3]); *(v4u*)(pk + i * 8) = o; } }
    {
        float* wf = (float*)(ws + WS_WF); float* binr = (float*)(ws + WS_BINR);
        const int gt = gw * 64 + lane, NGT = NGW * 64;
        for (int i = gt; i < DEPTH * 4 * D; i += NGT) { const int l = i / (4 * D), h = (i / D) & 3, k = i % D; wf[i] = a.w_in[(size_t)l * D * INW + (size_t)k * INW + 1536 + h] * a.norm_mix[l * D + k]; }
        for (int i = gt; i < DEPTH * NPROJ; i += NGT) { const int l = i / NPROJ, j = i % NPROJ; binr[i] = a.b_in[l * INW + colmap_in(j)]; }
    }
    {
        unsigned long long* ssq = (unsigned long long*)(ws + WS_SSQ);
        for (int m0 = gw; m0 < M; m0 += 2 * NGW) {
            const int m1 = m0 + NGW; const bool ok1 = m1 < M; const int mr[2] = {m0, ok1 ? m1 : m0};
            f32x4 v[2][8];
#pragma unroll
            for (int r = 0; r < 2; ++r)
#pragma unroll
                for (int j = 0; j < 8; ++j) v[r][j] = *(const f32x4*)(a.x + (size_t)mr[r] * D + j * 256 + lane * 4);
#pragma unroll
            for (int r = 0; r < 2; ++r) { float s = 0.f, am = 0.f;
#pragma unroll
                for (int j = 0; j < 8; ++j) { s += (v[r][j][0] * v[r][j][0] + v[r][j][1] * v[r][j][1]) + (v[r][j][2] * v[r][j][2] + v[r][j][3] * v[r][j][3]);
                    am = fmaxf(am, fmaxf(fmaxf(fabsf(v[r][j][0]), fabsf(v[r][j][1])), fmaxf(fabsf(v[r][j][2]), fabsf(v[r][j][3])))); }
                s = wave_sum(s, lane); am = wave_max(am, lane);
                if (r == 0 || ok1) { const int m = mr[r];
                    if (lane == 0) { ssq[m] = (unsigned long long)((double)s * 4294967296.0); ((float*)(ws + WS_RSA))[m] = rsqrtf(s * (1.0f / D) + EPS) * am * (1.0f / 127.0f); }
                    const float inv = am > 0.f ? 127.0f / am : 0.f; unsigned char* q8 = ws + WS_HB8 + (size_t)m * D + 4 * lane;
#pragma unroll
                    for (int j = 0; j < 8; ++j) *(unsigned*)(q8 + 256 * j) = ((unsigned)((int)rintf(v[r][j][0] * inv) & 255)) | ((unsigned)((int)rintf(v[r][j][1] * inv) & 255) << 8) | ((unsigned)((int)rintf(v[r][j][2] * inv) & 255) << 16) | ((unsigned)((int)rintf(v[r][j][3] * inv) & 255) << 24); } } }
    }
}
__device__ __forceinline__ void p0_win_i8(const Args& a, LAS unsigned char* lds, int gw, int NGW, int wave, int lane) {
    unsigned char* ws = a.ws; LAS float* scr = (LAS float*)(lds + wave * 16384);
    constexpr int I_WIN = (D / 64) * (NPROJ / 32);
    for (int it = gw; it < DEPTH * I_WIN; it += NGW) { const int l = it / I_WIN, r = it % I_WIN, kb = r / (NPROJ / 32), nb = r % (NPROJ / 32);
        tr_item_i8(a.w_in + (size_t)l * D * INW, a.norm_mix + l * D, (const unsigned*)(ws + WS_CMAX) + l * INW, ws + WS_WIN + l * WIN_BYTES, scr, 64 * kb, 32 * nb, lane); }
    float* sw = (float*)(ws + WS_SW); const int gt = gw * 64 + lane, NGT = NGW * 64;
    bf16* swh = (bf16*)(ws + WS_SWH); bf16* bih = (bf16*)(ws + WS_BIH);
    for (int i = gt; i < DEPTH * NPROJ; i += NGT) { const int l = i / NPROJ, j = i % NPROJ; const float s = __builtin_bit_cast(float, ((const unsigned*)(ws + WS_CMAX))[l * INW + colmap_in(j)]) * (1.0f / 127.0f);
        sw[i] = s; swh[i] = (bf16)f2bf(s); bih[i] = (bf16)f2bf(a.b_in[l * INW + colmap_in(j)]); }
}
__device__ __forceinline__ void quant_rows(const Args& a, int l, int gw, int NGW, int lane) {
    unsigned char* ws = a.ws; const bf16* HB = (const bf16*)(ws + WS_HB);
    for (int m0 = gw; m0 < M; m0 += 2 * NGW) {
        const int m1 = m0 + NGW; const bool ok1 = m1 < M; const int mr[2] = {m0, ok1 ? m1 : m0};
        v4u w[2][4];
#pragma unroll
        for (int r = 0; r < 2; ++r)
#pragma unroll
            for (int j = 0; j < 4; ++j) w[r][j] = *(const v4u*)(HB + (size_t)mr[r] * D + j * 512 + lane * 8);
#pragma unroll
        for (int r = 0; r < 2; ++r) { float am = 0.f; float v[4][8];
#pragma unroll
            for (int j = 0; j < 4; ++j) { v[j][0] = bflo(w[r][j].x); v[j][1] = bfhi(w[r][j].x); v[j][2] = bflo(w[r][j].y); v[j][3] = bfhi(w[r][j].y); v[j][4] = bflo(w[r][j].z); v[j][5] = bfhi(w[r][j].z); v[j][6] = bflo(w[r][j].w); v[j][7] = bfhi(w[r][j].w);
#pragma unroll
                for (int e = 0; e < 8; ++e) am = fmaxf(am, fabsf(v[j][e])); }
            am = wave_max(am, lane);
            if (r == 0 || ok1) {
                if (lane == 0) ((float*)(ws + WS_RSA))[mr[r]] = rsqrtf(ssa_to_f(((const unsigned long long*)(ws + WS_SSQ))[(size_t)l * M + mr[r]]) * (1.0f / D) + EPS) * am * (1.0f / 127.0f);
                const float inv = am > 0.f ? 127.0f / am : 0.f; unsigned char* q8 = ws + WS_HB8 + (size_t)mr[r] * D + 8 * lane;
#pragma unroll
                for (int j = 0; j < 4; ++j) { v2u o;
                    o.x = ((unsigned)((int)rintf(v[j][0] * inv) & 255)) | ((unsigned)((int)rintf(v[j][1] * inv) & 255) << 8) | ((unsigned)((int)rintf(v[j][2] * inv) & 255) << 16) | ((unsigned)((int)rintf(v[j][3] * inv) & 255) << 24);
                    o.y = ((unsigned)((int)rintf(v[j][4] * inv) & 255)) | ((unsigned)((int)rintf(v[j][5] * inv) & 255) << 8) | ((unsigned)((int)rintf(v[j][6] * inv) & 255) << 16) | ((unsigned)((int)rintf(v[j][7] * inv) & 255) << 24);
                    *(v2u*)(q8 + 512 * j) = o; } } }
    }
}

__device__ __forceinline__ void forget_logits(const Args& a, int l, int gw, int NGW, int lane) {
    unsigned char* ws = a.ws; const bf16* HB = (const bf16*)(ws + WS_HB); const float* wf = (const float*)(ws + WS_WF) + l * 4 * D; const unsigned long long* ssq = (const unsigned long long*)(ws + WS_SSQ) + l * M;
    float* logf = (float*)(ws + WS_LOGF);
    f32x4 w[4][4][2];
#pragma unroll
    for (int h = 0; h < 4; ++h)
#pragma unroll
        for (int j = 0; j < 4; ++j) { const int k0 = j * 512 + lane * 8; w[h][j][0] = *(const f32x4*)(wf + h * D + k0); w[h][j][1] = *(const f32x4*)(wf + h * D + k0 + 4); }
    float bias[4];
#pragma unroll
    for (int h = 0; h < 4; ++h) bias[h] = a.b_in[l * INW + 1536 + h];
    for (int m0 = gw; m0 < M; m0 += 2 * NGW) {
        const int m1 = m0 + NGW; const bool ok1 = m1 < M; const int mr[2] = {m0, ok1 ? m1 : m0};
        f32x4 x[2][4][2];
#pragma unroll
        for (int r = 0; r < 2; ++r)
#pragma unroll
            for (int j = 0; j < 4; ++j) { const int k0 = j * 512 + lane * 8;
                if (l == 0) { x[r][j][0] = *(const f32x4*)(a.x + (size_t)mr[r] * D + k0); x[r][j][1] = *(const f32x4*)(a.x + (size_t)mr[r] * D + k0 + 4); }
                else { const v4u xv = *(const v4u*)(HB + (size_t)mr[r] * D + k0); x[r][j][0] = (f32x4){bflo(xv.x), bfhi(xv.x), bflo(xv.y), bfhi(xv.y)}; x[r][j][1] = (f32x4){bflo(xv.z), bfhi(xv.z), bflo(xv.w), bfhi(xv.w)}; } }
#pragma unroll
        for (int r = 0; r < 2; ++r) { const float rs = rsqrtf(ssa_to_f(ssq[mr[r]]) * (1.0f / D) + EPS);
#pragma unroll
            for (int h = 0; h < 4; ++h) { f32x4 s4 = {0.f, 0.f, 0.f, 0.f};
#pragma unroll
                for (int j = 0; j < 4; ++j) { s4 += x[r][j][0] * w[h][j][0]; s4 += x[r][j][1] * w[h][j][1]; }
                const float z = wave_sum((s4[0] + s4[1]) + (s4[2] + s4[3]), lane) * rs + bias[h];
                const float ls = fminf(z, 0.f) - __logf(1.0f + __expf(-fabsf(z)));
                if (lane == h && (r == 0 || ok1)) logf[mr[r] * 4 + h] = ls; } }
    }
}
__device__ __forceinline__ float gelu_tanh(float x) { const float u = 1.5957691216057308f * (x + 0.044715f * x * x * x); return x / (1.0f + __expf(-u)); }
constexpr int PEER_TOK = 32;
constexpr int PL_IDX = 0, PL_GATE = PEER_TOK * 128 * 4, PL_TAB = 2 * PEER_TOK * 128 * 4;
__device__ __forceinline__ int f2key(float f) { const int b = __builtin_bit_cast(int, f); return b ^ ((b >> 31) & 0x7fffffff); }
__device__ __forceinline__ float key2f(int k) { return __builtin_bit_cast(float, k ^ ((k >> 31) & 0x7fffffff)); }
#define CE_DESC(x, y) do { const int hi_ = (x) > (y) ? (x) : (y), lo_ = (x) > (y) ? (y) : (x); (x) = hi_; (y) = lo_; } while (0)
__device__ __forceinline__ void sort16_desc(int* v) {
#pragma unroll
    for (int k = 2; k <= 16; k <<= 1)
#pragma unroll
        for (int j = k >> 1; j > 0; j >>= 1)
#pragma unroll
            for (int i = 0; i < 16; ++i) { const int l = i ^ j; if (l > i) { if ((i & k) == 0) CE_DESC(v[i], v[l]); else CE_DESC(v[l], v[i]); } }
}
__device__ __forceinline__ void merge_top16(int* a, const int* b) {
#pragma unroll
    for (int i = 0; i < 16; ++i) a[i] = a[i] > b[15 - i] ? a[i] : b[15 - i];
#pragma unroll
    for (int j = 8; j > 0; j >>= 1)
#pragma unroll
        for (int i = 0; i < 16; ++i) { const int l = i ^ j; if (l > i) CE_DESC(a[i], a[l]); }
}
__device__ __forceinline__ void top16_of_64(int* v) {
    sort16_desc(v); sort16_desc(v + 16); sort16_desc(v + 32); sort16_desc(v + 48);
    merge_top16(v, v + 16); merge_top16(v + 32, v + 48); merge_top16(v, v + 32);
}
constexpr int cand_slot(int i, int j) {
    int n = 0;
    for (int a = 0; a < 16; ++a) for (int b = 0; b < 16; ++b) { if ((a + 1) * (b + 1) <= 16) { if (a == i && b == j) return n; ++n; } }
    return -1;
}
__device__ __forceinline__ void peer_retrieve(const Args& a, int l, int t0, int h, LAS char* lds, int wave) {
    typedef short bf16x8 __attribute__((ext_vector_type(8)));
    typedef float f32x16 __attribute__((ext_vector_type(16)));
    int lane; asm volatile("v_mbcnt_lo_u32_b32 %0, -1, 0\n\tv_mbcnt_hi_u32_b32 %0, -1, %0" : "=v"(lane));
    const int r32 = lane & 31, hi = lane >> 5, hi4 = hi * 4;
    const bf16* Q = (const bf16*)(a.ws + WS_Q) + ((size_t)(t0 >> 5) * 8 + h) * 2 * 8 * 512 + lane * 8;
    const bf16* PK = (const bf16*)(a.ws + WS_PK) + ((size_t)(l * 8 + h) * 2) * 128 * 128 + lane * 8;
    int top[2][16];
#pragma unroll
    for (int p = 0; p < 2; ++p) {
        f32x16 acc[4] = {};
        bf16x8 qf[8];
#pragma unroll
        for (int cs = 0; cs < 8; ++cs) qf[cs] = *(const bf16x8*)(Q + (p * 8 + cs) * 512);
#pragma unroll
        for (int kb = 0; kb < 4; ++kb) { bf16x8 kf[8];
#pragma unroll
            for (int cs = 0; cs < 8; ++cs) kf[cs] = *(const bf16x8*)(PK + (size_t)p * 128 * 128 + ((size_t)kb * 8 + cs) * 512);
#pragma unroll
            for (int cs = 0; cs < 8; ++cs) acc[kb] = __builtin_amdgcn_mfma_f32_32x32x16_bf16(kf[cs], qf[cs], acc[kb], 0, 0, 0); }
        int v[64];
#pragma unroll
        for (int kb = 0; kb < 4; ++kb)
#pragma unroll
            for (int r = 0; r < 16; ++r) { const int c = kb * 32 + (r & 3) + 8 * (r >> 2);
                v[kb * 16 + r] = (f2key(acc[kb][r]) & ~127) | (c | hi4); }
        top16_of_64(v);
        int mine[16], other[16];
#pragma unroll
        for (int i = 0; i < 16; ++i) { auto rr = __builtin_amdgcn_permlane32_swap((unsigned)v[i], (unsigned)v[i], false, false); mine[i] = (int)rr[0]; other[i] = (int)rr[1]; }
        merge_top16(mine, other);
#pragma unroll
        for (int i = 0; i < 16; ++i) top[p][i] = mine[i];
    }
    LAS int* tab = (LAS int*)(lds + PL_TAB) + (wave * 64 + lane) * 32;
    float sA[16], sB[16];
#pragma unroll
    for (int i = 0; i < 16; ++i) { sA[i] = key2f(top[0][i] & ~127); sB[i] = key2f(top[1][i] & ~127); tab[i] = top[0][i] & 127; tab[16 + i] = top[1][i] & 127; }
    int c[64];
#pragma unroll
    for (int n = 0; n < 64; ++n) c[n] = (int)0x80000000;
#pragma unroll
    for (int i = 0; i < 16; ++i)
#pragma unroll
        for (int j = 0; j < 16; ++j) if ((i + 1) * (j + 1) <= 16) c[cand_slot(i, j)] = (f2key(sA[i] + sB[j]) & ~255) | (16 * i + j);
    top16_of_64(c);
    float ex[16]; float sum = 0.f; const float mx = key2f(c[0] & ~255);
#pragma unroll
    for (int w = 0; w < 16; ++w) { ex[w] = __expf(key2f(c[w] & ~255) - mx); sum += ex[w]; }
    const float inv = 1.0f / sum;
    asm volatile("s_waitcnt lgkmcnt(0)" ::: "memory");
    LAS int* oi = (LAS int*)(lds + PL_IDX) + r32 * 128 + h * 16; LAS float* og = (LAS float*)(lds + PL_GATE) + r32 * 128 + h * 16;
#pragma unroll
    for (int w = 0; w < 16; ++w) { const int id = c[w] & 255; const int e = tab[id >> 4] * 128 + tab[16 + (id & 15)];
        if ((w >> 3) == hi) { oi[w] = e; og[w] = ex[w] * inv; } }
}
constexpr size_t WS_IDX = 816 * MiB;
constexpr size_t WS_GATE = 820 * MiB;
constexpr size_t WS_XQ = 824 * MiB;
constexpr size_t WS_SX = 856 * MiB;
constexpr size_t WS_PART = 857 * MiB;
constexpr size_t WS_END2 = 1024 * MiB;
#ifndef PEER_NB
#define PEER_NB 8
#endif
constexpr int NSLICE = 8, SLW = D / NSLICE;
__device__ __forceinline__ void peer_publish4(const Args& a, int l, int t0, LAS char* lds, int tl0) {
    static_assert(PEER_TOK / NWAVES == 4, "four tokens per wave");
    int lane; LANE_ID(lane);
    unsigned char* ws = a.ws;
    {   const float* SU = (const float*)(ws + WS_SU) + l * PEER_E; const float* SV = (const float*)(ws + WS_SV) + l * PEER_E;
        int i0[4], i1[4]; float g0[4], g1[4], su0[4], su1[4], sv0[4], sv1[4];
#pragma unroll
        for (int k = 0; k < 4; ++k) { const int tl = tl0 + k; i0[k] = ((const LAS int*)(lds + PL_IDX))[tl * 128 + lane]; i1[k] = ((const LAS int*)(lds + PL_IDX))[tl * 128 + 64 + lane];
            g0[k] = ((const LAS float*)(lds + PL_GATE))[tl * 128 + lane]; g1[k] = ((const LAS float*)(lds + PL_GATE))[tl * 128 + 64 + lane]; }
#pragma unroll
        for (int k = 0; k < 4; ++k) { su0[k] = SU[i0[k]]; su1[k] = SU[i1[k]]; sv0[k] = SV[i0[k]]; sv1[k] = SV[i1[k]]; }
#pragma unroll
        for (int k = 0; k < 4; ++k) { const int t = t0 + k; unsigned* gi = (unsigned*)(ws + WS_IDX) + (size_t)t * 64; unsigned* gg = (unsigned*)(ws + WS_GATE) + (size_t)t * 128;
            gi[lane] = (unsigned)i0[k] | ((unsigned)i1[k] << 16); gg[lane] = pk2(g0[k] * sv0[k], su0[k]); gg[64 + lane] = pk2(g1[k] * sv1[k], su1[k]); }
    }
    const unsigned long long* ssa1 = (const unsigned long long*)(ws + WS_SSA) + l * M;
    const float* gn = a.norm_ffn + l * D;
    f32x4 g[2][4]; v4u hw[4][2][2]; float rs[4];
#pragma unroll
    for (int i = 0; i < 2; ++i)
#pragma unroll
        for (int q = 0; q < 4; ++q) g[i][q] = *(const f32x4*)(gn + 16 * lane + 1024 * i + 4 * q);
#pragma unroll
    for (int k = 0; k < 4; ++k) { const bf16* HB = (const bf16*)(ws + WS_HB) + (size_t)(t0 + k) * D; rs[k] = rsqrtf(ssa_to_f(ssa1[t0 + k]) * (1.0f / D) + EPS);
#pragma unroll
        for (int i = 0; i < 2; ++i) { hw[k][i][0] = *(const v4u*)(HB + 16 * lane + 1024 * i); hw[k][i][1] = *(const v4u*)(HB + 16 * lane + 1024 * i + 8); } }
#pragma unroll
    for (int k = 0; k < 4; ++k) { const int t = t0 + k;
        float xf[32]; float am = 0.f;
#pragma unroll
        for (int i = 0; i < 2; ++i) { const unsigned hq[8] = {hw[k][i][0].x, hw[k][i][0].y, hw[k][i][0].z, hw[k][i][0].w, hw[k][i][1].x, hw[k][i][1].y, hw[k][i][1].z, hw[k][i][1].w};
#pragma unroll
            for (int q = 0; q < 4; ++q) {
                xf[16 * i + 4 * q + 0] = bflo(hq[2 * q]) * rs[k] * g[i][q][0]; xf[16 * i + 4 * q + 1] = bfhi(hq[2 * q]) * rs[k] * g[i][q][1];
                xf[16 * i + 4 * q + 2] = bflo(hq[2 * q + 1]) * rs[k] * g[i][q][2]; xf[16 * i + 4 * q + 3] = bfhi(hq[2 * q + 1]) * rs[k] * g[i][q][3]; } }
#pragma unroll
        for (int e = 0; e < 32; ++e) am = fmaxf(am, fabsf(xf[e]));
        am = wave_max(am, lane);
        const float inv = am > 0.f ? 127.0f / am : 0.f;
        if (lane == 0) ((float*)(ws + WS_SX))[t] = am * (1.0f / 127.0f);
        unsigned char* xq = ws + WS_XQ + (size_t)t * D;
#pragma unroll
        for (int i = 0; i < 2; ++i) { v4u ph;
#pragma unroll
            for (int d = 0; d < 4; ++d) { unsigned wh = 0;
#pragma unroll
                for (int b = 0; b < 4; ++b) wh |= ((unsigned)((int)rintf(xf[16 * i + 4 * d + b] * inv) & 255)) << (8 * b);
                ph[d] = wh; }
            *(v4u*)(xq + 16 * lane + 1024 * i) = ph; } }
}
struct PeerItems { int pos, npop, rank, nloc, wave;
    __device__ __forceinline__ int nblk() const { return (M / PEER_TOK - rank + nloc - 1) / nloc; }
    __device__ __forceinline__ int count() const { return ((NSLICE - pos + npop - 1) / npop) * nblk() * (PEER_TOK / NWAVES); }
    __device__ __forceinline__ void get(int n, int& s, int& t) const { constexpr int per = PEER_TOK / NWAVES; const int k = n % per, r = n / per, nb = nblk();
        s = pos + (r / nb) * npop; t = (rank + (r % nb) * nloc) * PEER_TOK + wave * per + k; } };
__device__ __forceinline__ void peer_u_wave(const Args& a, int l, const PeerItems& it, LAS unsigned char* lds) {
    int lane; LANE_ID(lane);
    unsigned char* ws = a.ws; const int sub = lane & 15, grp = lane >> 4;
    const __amdgpu_buffer_rsrc_t rU = __builtin_amdgcn_make_buffer_rsrc((void*)(ws + WS_PU + (size_t)l * PE_BYTES), 0, 0x7fffffff, 0x00020000);
    const __amdgpu_buffer_rsrc_t rW = __builtin_amdgcn_make_buffer_rsrc((void*)ws, 0, 0x7fffffff, 0x00020000);
    const int N = it.count(); if (N <= 0) return;
    int s, t; it.get(0, s, t);
    int idc[2], idn[2] = {0, 0}; v4u xhc, xhn = {}; v4u wA[PEER_NB], wB[PEER_NB];
    unsigned ixc[16], ixn[16];
    LAS unsigned short* ib = (LAS unsigned short*)(lds + 4096 + it.wave * 256);
#define IDX_TABLE(TW, I0, I1) do { ib[(lane & 3) * 32 + (lane >> 2)] = (unsigned short)(I0); ib[(lane & 3) * 32 + 16 + (lane >> 2)] = (unsigned short)(I1); \
        _Pragma("unroll") for (int q_ = 0; q_ < 4; ++q_) { const v4u t_ = *(const LAS v4u*)(ib + grp * 32 + 8 * q_); TW[4 * q_] = t_.x; TW[4 * q_ + 1] = t_.y; TW[4 * q_ + 2] = t_.z; TW[4 * q_ + 3] = t_.w; } } while (0)
#define IDX_OF(TW, i_) ((int)(((TW)[(i_) >> 1] >> (16 * ((i_) & 1))) & 0xffffu))
#define PU_META(I0, I1, XH, S_, T_) do { { const unsigned iw_ = __builtin_amdgcn_raw_buffer_load_b32(rW, 4 * lane, (int)WS_IDX + (T_) * 256, 0); I0 = (int)(iw_ & 0xffffu); I1 = (int)(iw_ >> 16); } \
        XH = __builtin_amdgcn_raw_buffer_load_b128(rW, 16 * sub, (int)WS_XQ + (T_) * D + SLW * (S_), 0); } while (0)
#define PU_ISSUE(W, TW, Q, S_) do { _Pragma("unroll") for (int j = 0; j < PEER_NB; ++j) { const int e_ = IDX_OF(TW, PEER_NB * (Q) + j); W[j] = __builtin_amdgcn_raw_buffer_load_b128(rU, e_ * D + SLW * (S_) + 16 * sub, 0, 0); } } while (0)
#define DPP_RORI(x, n) __builtin_amdgcn_update_dpp(0, (x), 0x120 + (n), 0xf, 0xf, false)
#define PU_COMP(W, Q) do { _Pragma("unroll") for (int j = 0; j < PEER_NB; ++j) { int dh = 0; \
            dh = __builtin_amdgcn_sdot4((int)W[j].x, (int)xhc.x, dh, false); dh = __builtin_amdgcn_sdot4((int)W[j].y, (int)xhc.y, dh, false); \
            dh = __builtin_amdgcn_sdot4((int)W[j].z, (int)xhc.z, dh, false); dh = __builtin_amdgcn_sdot4((int)W[j].w, (int)xhc.w, dh, false); \
            dh += DPP_RORI(dh, 8); dh += DPP_RORI(dh, 4); dh += DPP_RORI(dh, 2); dh += DPP_RORI(dh, 1);     \
            if (sub == ((PEER_NB * (Q) + j) & 15)) { if ((PEER_NB * (Q) + j) >> 4) acc1 = dh; else acc0 = dh; } __builtin_amdgcn_sched_barrier(0); } } while (0)
    PU_META(idc[0], idc[1], xhc, s, t); IDX_TABLE(ixc, idc[0], idc[1]); PU_ISSUE(wA, ixc, 0, s); PU_ISSUE(wB, ixc, 1, s);
    for (int n = 0; n < N; ++n) {
        int sn = s, tn = t; const bool more = n + 1 < N;
        if (more) it.get(n + 1, sn, tn);
        PU_META(idn[0], idn[1], xhn, sn, tn);
        int acc0 = 0, acc1 = 0;
        __builtin_amdgcn_sched_barrier(0);
#if PEER_NB == 8
        PU_COMP(wA, 0); PU_ISSUE(wA, ixc, 2, s); __builtin_amdgcn_sched_barrier(0);
        PU_COMP(wB, 1); PU_ISSUE(wB, ixc, 3, s); __builtin_amdgcn_sched_barrier(0);
        IDX_TABLE(ixn, idn[0], idn[1]);
        PU_COMP(wA, 2); PU_ISSUE(wA, ixn, 0, sn); __builtin_amdgcn_sched_barrier(0);
        PU_COMP(wB, 3); PU_ISSUE(wB, ixn, 1, sn); __builtin_amdgcn_sched_barrier(0);
#else
        IDX_TABLE(ixn, idn[0], idn[1]);
        PU_COMP(wA, 0); PU_ISSUE(wA, ixn, 0, sn); __builtin_amdgcn_sched_barrier(0);
        PU_COMP(wB, 1); PU_ISSUE(wB, ixn, 1, sn); __builtin_amdgcn_sched_barrier(0);
#endif
        __builtin_amdgcn_raw_buffer_store_b32(pk2((float)acc0, (float)acc1), rW, (4 * sub + grp) * 4, (int)WS_PART + (s * M + t) * 256, 0);
        s = sn; t = tn; xhc = xhn;
#pragma unroll
        for (int q_ = 8; q_ < 16; ++q_) ixc[q_] = ixn[q_];
    }
#undef PU_META
#undef PU_ISSUE
#undef PU_COMP
}
__device__ __forceinline__ void peer_v_wave(const Args& a, int l, const PeerItems& it, LAS unsigned char* lds) {
    int lane; LANE_ID(lane);
    unsigned char* ws = a.ws; const int sub = lane & 15, grp = lane >> 4;
    const __amdgpu_buffer_rsrc_t rV = __builtin_amdgcn_make_buffer_rsrc((void*)(ws + WS_PV + (size_t)l * PE_BYTES), 0, 0x7fffffff, 0x00020000);
    const __amdgpu_buffer_rsrc_t rW = __builtin_amdgcn_make_buffer_rsrc((void*)ws, 0, 0x7fffffff, 0x00020000);
    const int N = it.count(); if (N <= 0) return;
    int s, t; it.get(0, s, t);
    struct Meta { int id[2]; float gate[2], su[2], pa[2], sx; v2u h1; };
    Meta mc, mn; v4u wA[PEER_NB], wB[PEER_NB];
    unsigned ixc[16], ixn[16];
    LAS unsigned short* ib = (LAS unsigned short*)(lds + 4096 + it.wave * 256);
    const int l4 = 4 * lane;
#define WLD(off_s) __builtin_amdgcn_raw_buffer_load_b32(rW, l4, (int)(off_s), 0)
#define PV_META(MM, S_, T_) do { const int r_ = (T_) * 512; { const unsigned iw_ = WLD(WS_IDX + (T_) * 256); MM.id[0] = (int)(iw_ & 0xffffu); MM.id[1] = (int)(iw_ >> 16); const unsigned g0_ = WLD(WS_GATE + r_), g1_ = WLD(WS_GATE + r_ + 256); \
          MM.gate[0] = bflo(g0_); MM.su[0] = bfhi(g0_); MM.gate[1] = bflo(g1_); MM.su[1] = bfhi(g1_); } \
        float a0_ = 0.f, a1_ = 0.f; _Pragma("unroll") for (int q = 0; q < NSLICE; ++q) { const unsigned pw_ = WLD((int)WS_PART + (q * M + (T_)) * 256); a0_ += bflo(pw_); a1_ += bfhi(pw_); } \
        MM.pa[0] = a0_; MM.pa[1] = a1_; MM.sx = ((const float*)(ws + WS_SX))[T_]; \
        MM.h1 = __builtin_amdgcn_raw_buffer_load_b64(rW, (16 * sub + 4 * grp) * 2, (int)WS_HB + ((T_) * D + SLW * (S_)) * 2, 0); } while (0)
#define PV_ISSUE(W, TW, Q, S_) do { _Pragma("unroll") for (int j = 0; j < PEER_NB; ++j) { const int e_ = IDX_OF(TW, PEER_NB * (Q) + j); W[j] = __builtin_amdgcn_raw_buffer_load_b128(rV, e_ * D + SLW * (S_) + 16 * sub, 0, 0); } } while (0)
#define PV_COMP(W, Q) do { _Pragma("unroll") for (int j4 = 0; j4 < PEER_NB; j4 += 4) { \
            const unsigned cp_ = cpw[(PEER_NB * (Q) + j4) >> 2]; \
            _Pragma("unroll") for (int d = 0; d < 4; ++d) { const unsigned a_ = W[j4][d], b_ = W[j4 + 1][d], c_ = W[j4 + 2][d], d_ = W[j4 + 3][d]; \
                const unsigned x0_ = __builtin_amdgcn_perm(b_, a_, 0x05010400u), x1_ = __builtin_amdgcn_perm(b_, a_, 0x07030602u), y0_ = __builtin_amdgcn_perm(d_, c_, 0x05010400u), y1_ = __builtin_amdgcn_perm(d_, c_, 0x07030602u); \
                yi[4 * d + 0] = __builtin_amdgcn_sdot4((int)__builtin_amdgcn_perm(y0_, x0_, 0x05040100u), (int)cp_, yi[4 * d + 0], false); \
                yi[4 * d + 1] = __builtin_amdgcn_sdot4((int)__builtin_amdgcn_perm(y0_, x0_, 0x07060302u), (int)cp_, yi[4 * d + 1], false); \
                yi[4 * d + 2] = __builtin_amdgcn_sdot4((int)__builtin_amdgcn_perm(y1_, x1_, 0x05040100u), (int)cp_, yi[4 * d + 2], false); \
                yi[4 * d + 3] = __builtin_amdgcn_sdot4((int)__builtin_amdgcn_perm(y1_, x1_, 0x07060302u), (int)cp_, yi[4 * d + 3], false); } \
            __builtin_amdgcn_sched_barrier(0); } } while (0)
    PV_META(mc, s, t); IDX_TABLE(ixc, mc.id[0], mc.id[1]); PV_ISSUE(wA, ixc, 0, s); PV_ISSUE(wB, ixc, 1, s);
    for (int n = 0; n < N; ++n) {
        int sn = s, tn = t; const bool more = n + 1 < N;
        if (more) it.get(n + 1, sn, tn);
        PV_META(mn, sn, tn);
        float coef[2];
#pragma unroll
        for (int hf = 0; hf < 2; ++hf) coef[hf] = gelu_tanh(mc.pa[hf] * mc.su[hf] * mc.sx) * mc.gate[hf];
        const float cmax = wave_max(fmaxf(fabsf(coef[0]), fabsf(coef[1])), lane); const float cinv = cmax > 0.f ? 127.0f / cmax : 0.f, cs = cmax * (1.0f / 127.0f);
        const int c8[2] = {(int)rintf(coef[0] * cinv), (int)rintf(coef[1] * cinv)};
        unsigned cpw[8];
        { LAS unsigned char* cb = lds + it.wave * 128;
          cb[(lane & 3) * 32 + (lane >> 2)] = (unsigned char)c8[0]; cb[(lane & 3) * 32 + 16 + (lane >> 2)] = (unsigned char)c8[1];
          const v4u c0_ = *(const LAS v4u*)(cb + grp * 32), c1_ = *(const LAS v4u*)(cb + grp * 32 + 16);
          cpw[0] = c0_.x; cpw[1] = c0_.y; cpw[2] = c0_.z; cpw[3] = c0_.w; cpw[4] = c1_.x; cpw[5] = c1_.y; cpw[6] = c1_.z; cpw[7] = c1_.w; }
        int yi[16];
#pragma unroll
        for (int k = 0; k < 16; ++k) yi[k] = 0;
        __builtin_amdgcn_sched_barrier(0);
#if PEER_NB == 8
        PV_COMP(wA, 0); PV_ISSUE(wA, ixc, 2, s); __builtin_amdgcn_sched_barrier(0);
        PV_COMP(wB, 1); PV_ISSUE(wB, ixc, 3, s); __builtin_amdgcn_sched_barrier(0);
        IDX_TABLE(ixn, mn.id[0], mn.id[1]);
        PV_COMP(wA, 2); PV_ISSUE(wA, ixn, 0, sn); __builtin_amdgcn_sched_barrier(0);
        PV_COMP(wB, 3); PV_ISSUE(wB, ixn, 1, sn); __builtin_amdgcn_sched_barrier(0);
#else
        IDX_TABLE(ixn, mn.id[0], mn.id[1]);
        PV_COMP(wA, 0); PV_ISSUE(wA, ixn, 0, sn); __builtin_amdgcn_sched_barrier(0);
        PV_COMP(wB, 1); PV_ISSUE(wB, ixn, 1, sn); __builtin_amdgcn_sched_barrier(0);
#endif
        int yq[4];
        { int z[8];
#pragma unroll
          for (int k = 0; k < 8; ++k) { const auto r = __builtin_amdgcn_permlane32_swap((unsigned)yi[k], (unsigned)yi[k + 8], false, false); z[k] = (int)r[0] + (int)r[1]; }
#pragma unroll
          for (int k = 0; k < 4; ++k) { const auto r = __builtin_amdgcn_permlane16_swap((unsigned)z[k], (unsigned)z[k + 4], false, false); yq[k] = (int)r[0] + (int)r[1]; } }
        const f32x4 h2 = {bflo(mc.h1.x) + cs * (float)yq[0], bfhi(mc.h1.x) + cs * (float)yq[1], bflo(mc.h1.y) + cs * (float)yq[2], bfhi(mc.h1.y) + cs * (float)yq[3]};
        v2u hb; hb.x = pk2(h2[0], h2[1]); hb.y = pk2(h2[2], h2[3]);
        __builtin_amdgcn_raw_buffer_store_b64(hb, rW, (16 * sub + 4 * grp) * 2, (int)WS_HB + (t * D + SLW * s) * 2, 0);
        const float sq = wave_sum((h2[0] * h2[0] + h2[1] * h2[1]) + (h2[2] * h2[2] + h2[3] * h2[3]), lane);
        if (lane == 0) atomicAdd((unsigned long long*)(ws + WS_SSQ) + (size_t)(l + 1) * M + t, (unsigned long long)((double)sq * 4294967296.0));
        s = sn; t = tn; mc = mn;
#pragma unroll
        for (int q_ = 8; q_ < 16; ++q_) ixc[q_] = ixn[q_];
    }
#undef PV_META
#undef WLD
#undef PV_ISSUE
#undef PV_COMP
}
#define OSTORE(p_, ...) __builtin_nontemporal_store((__VA_ARGS__), (f32x4*)(p_))
__device__ __forceinline__ void final_norm(const Args& a, int gw, int NGW) {
    int lane; LANE_ID(lane);
    f32x4 g[8];
#pragma unroll
    for (int j = 0; j < 8; ++j) g[j] = *(const f32x4*)(a.norm_final + 4 * lane + 256 * j);
    for (int t0 = gw; t0 < M; t0 += 2 * NGW) { const int t1 = t0 + NGW; const bool ok1 = t1 < M; const int tr[2] = {t0, ok1 ? t1 : t0};
        v2u w[2][8]; float rf[2];
#pragma unroll
        for (int r = 0; r < 2; ++r) { const bf16* HB = (const bf16*)(a.ws + WS_HB) + (size_t)tr[r] * D;
            rf[r] = rsqrtf(ssa_to_f(((const unsigned long long*)(a.ws + WS_SSQ))[(size_t)DEPTH * M + tr[r]]) * (1.0f / D) + EPS);
#pragma unroll
            for (int j = 0; j < 8; ++j) w[r][j] = __builtin_nontemporal_load((const v2u*)(HB + 4 * lane + 256 * j)); }
#pragma unroll
        for (int r = 0; r < 2; ++r) if (r == 0 || ok1) { float* O = a.out + (size_t)tr[r] * D;
#pragma unroll
            for (int j = 0; j < 8; ++j) OSTORE(O + 4 * lane + 256 * j, (f32x4){bflo(w[r][j].x) * rf[r] * g[j][0], bfhi(w[r][j].x) * rf[r] * g[j][1], bflo(w[r][j].y) * rf[r] * g[j][2], bfhi(w[r][j].y) * rf[r] * g[j][3]}); } }
}

__global__ void __launch_bounds__(NT, 2) mk_fwd(ArgsK a_in) {
    extern __shared__ __attribute__((aligned(16))) unsigned char lds_raw[];
    LAS unsigned char* lds = (LAS unsigned char*)lds_raw;
    cg::grid_group grid = cg::this_grid();
    grid.sync();
    const int wave0 = __builtin_amdgcn_readfirstlane(threadIdx.x >> 6);
    const int G = gridDim.x;
    const CAS ArgsK* ka = (const CAS ArgsK*)__builtin_amdgcn_kernarg_segment_ptr();
    size_t zoff = 0;
#define PHASE_BEGIN() int lane; LANE_ID(lane); int blk = blockIdx.x, Gp = G, wv = wave0; asm volatile("" : "+s"(zoff), "+s"(ka), "+s"(blk), "+s"(Gp), "+s"(wv)); const int wave = wv, gw = blk * NWAVES + wv, NGW = Gp * NWAVES; (void)gw; (void)NGW; const Args a = load_args(ka, zoff); unsigned char* const ws = a.ws; (void)ws
    volatile LAS unsigned* bst = (volatile LAS unsigned*)(lds + RING_BYTES + 1024);
#define GRID_BAR() do { asm volatile("" : "+s"(zoff)); unsigned char* wsb_ = (unsigned char*)ka->ws + zoff; int wvb_ = wave0; asm volatile("" : "+s"(wvb_)); xcd_barrier((unsigned*)(wsb_ + WS_BAR), xb_xcc_id(), (unsigned)G, bst, wvb_); } while (0)
    volatile LAS unsigned* xinfo = bst + 4;
    { PHASE_BEGIN(); if (wave == 0 && lane == 0) { bst[0] = 0u; bst[1] = 0u; xinfo[2] = xb_add((unsigned*)(ws + WS_BAR) + XB_XCNT(xb_xcc_id()), 1u); }
      for (int i = wave * 64 + lane; i < GATE_LUT_N; i += NT) ((LAS unsigned char*)(lds + LDS_GATE_LUT))[i] = (unsigned char)EpiProj::g8((float)(i - GATE_LUT_N / 2) * (1.0f / GATE_LUT_S));
      p0_cmax(a, gw, NGW, lane); }
    GRID_BAR();
    { PHASE_BEGIN(); p0_win_i8(a, lds, gw, NGW, wave, lane); p0_prologue(a, lds, gw, NGW, wave, lane); }
    GRID_BAR();
    {
        PHASE_BEGIN();
        if (wave == 0 && lane == 0) { unsigned* bar = (unsigned*)(ws + WS_BAR); const unsigned x = xb_xcc_id(); unsigned pos = 0, npop = 0, mine = 1;
            for (unsigned j = 0; j < 16; ++j) { const unsigned c = xb_ld(&bar[XB_XCNT(j)]); if (c) { ++npop; if (j < x) ++pos; } if (j == x) mine = c ? c : 1u; }
            xinfo[0] = pos; xinfo[1] = npop ? npop : 1u; xinfo[3] = mine; }
        __syncthreads();
    }
    int depth_rt = DEPTH; asm volatile("" : "+s"(depth_rt));
    for (int lc = 0; lc < depth_rt; ++lc) {
        int l = lc; asm volatile("" : "+s"(l));
        if (l > 0) { { PHASE_BEGIN(); quant_rows(a, l, gw, NGW, lane); } GRID_BAR(); }
        {
            PHASE_BEGIN();
            pg8::Gemm g{(const bf16*)(ws + WS_HB8), (const bf16*)(ws + WS_WIN + l * WIN_BYTES), M, NPROJ, D / 2}; pg8::StaticOrder S; S.init(M, NPROJ, Gp, blk);
            EpiProj E{ws, (const bf16*)(ws + WS_BIH) + l * NPROJ, (const float*)(ws + WS_RSA), (const bf16*)(ws + WS_SWH) + l * NPROJ, (const LAS unsigned char*)(lds + LDS_GATE_LUT), lds + LDS_EPI_PRE};
            pg8::gemm_phase<EpiProj, pg8::StaticOrder, true, true>(lds, g, S, E, wave);
            {
                constexpr int NU = (M / 256) * (NPROJ / 256); const int nmax = (NU + Gp - 1) / Gp, nfull = NU - (nmax - 1) * Gp, nshort = Gp - nfull;
                if (nshort * 4 >= Gp) { if (blk >= nfull) { forget_logits(a, l, (blk - nfull) * NWAVES + wave, nshort * NWAVES, lane); weight_copies(a, lds, l, 0, (blk - nfull) * NWAVES + wave, nshort * NWAVES, wave, lane); } }
                else { forget_logits(a, l, gw, NGW, lane); weight_copies(a, lds, l, 0, gw, NGW, wave, lane); }
            }
        }
        GRID_BAR();
        { PHASE_BEGIN(); mixers_fast(a, l, (LAS char*)lds, wave, lane, Gp, blk); }
        GRID_BAR();
        {
            PHASE_BEGIN();
            pg8::Gemm g{(const bf16*)(ws + WS_Y), (const bf16*)(ws + WS_WBR + l * SQ_BYTES), M, D, D}; pg8::StaticOrder S; S.init(M, D, Gp, blk);
            EpiMerge E{(const unsigned char*)(ws + WS_G), (bf16*)(ws + WS_MRG)};
            pg8::gemm_phase<EpiMerge, pg8::StaticOrder, false>(lds, g, S, E, wave);
        }
        GRID_BAR();
        {
            PHASE_BEGIN();
            pg8::Gemm g{(const bf16*)(ws + WS_MRG), (const bf16*)(ws + WS_WOUT + l * SQ_BYTES), M, D, D}; pg8::StaticOrder S; S.init(M, D, Gp, blk);
            EpiRes E{l == 0 ? a.x : (const float*)nullptr, (bf16*)(ws + WS_HB), (unsigned long long*)(ws + WS_SSA) + l * M};
            pg8::gemm_phase<EpiRes, pg8::StaticOrder, false>(lds, g, S, E, wave);
        }
        GRID_BAR();
        {
            PHASE_BEGIN();
            pg8::Gemm g{(const bf16*)(ws + WS_HB), (const bf16*)(ws + WS_WQ + l * SQ_BYTES), M, D, D}; pg8::StaticOrder S; S.init(M, D, Gp, blk);
            EpiQ E{(bf16*)(ws + WS_Q), (const unsigned long long*)(ws + WS_SSA) + l * M};
            pg8::gemm_phase<EpiQ, pg8::StaticOrder, false>(lds, g, S, E, wave);
        }
        GRID_BAR();
        {
            PHASE_BEGIN(); (void)lane;
            for (int t0 = blk * PEER_TOK; t0 < M; t0 += Gp * PEER_TOK) {
                peer_retrieve(a, l, t0, wave, (LAS char*)lds, wave);
                __syncthreads();
                peer_publish4(a, l, t0 + wave * (PEER_TOK / NWAVES), (LAS char*)lds, wave * (PEER_TOK / NWAVES));
                __syncthreads();
            }
        }
        GRID_BAR();
        {
            PHASE_BEGIN(); (void)lane;
            const int pos = __builtin_amdgcn_readfirstlane((int)xinfo[0]), npop = __builtin_amdgcn_readfirstlane((int)xinfo[1]), rank = __builtin_amdgcn_readfirstlane((int)xinfo[2]), nloc = __builtin_amdgcn_readfirstlane((int)xinfo[3]);
            const PeerItems it{pos, npop, rank, nloc, wave}; peer_u_wave(a, l, it, lds);
        }
        GRID_BAR();
        {
            PHASE_BEGIN(); (void)lane;
            const int pos = __builtin_amdgcn_readfirstlane((int)xinfo[0]), npop = __builtin_amdgcn_readfirstlane((int)xinfo[1]), rank = __builtin_amdgcn_readfirstlane((int)xinfo[2]), nloc = __builtin_amdgcn_readfirstlane((int)xinfo[3]);
            const PeerItems it{pos, npop, rank, nloc, wave}; peer_v_wave(a, l, it, lds);
        }
        GRID_BAR();
    }
    {
        PHASE_BEGIN(); (void)lane;
        final_norm(a, gw, NGW);
    }
}

extern "C" void kernel_launch(void* const* d_in, const int* in_sizes, int n_in, void* d_out, int out_size, void* d_ws, size_t ws_size, hipStream_t stream) {
    static int grid = 0;
    if (grid == 0) {
        int dev = 0, cus = 0, per_cu = 0;
        if (n_in != 16 || out_size != M * D || ws_size < WS_END2) { fprintf(stderr, "kernel_launch: unexpected shapes (n_in %d out %d ws %zu)\n", n_in, out_size, ws_size); grid = -1; return; }
        (void)hipGetDevice(&dev);
        (void)hipDeviceGetAttribute(&cus, hipDeviceAttributeMultiprocessorCount, dev);
        (void)hipFuncSetAttribute((const void*)mk_fwd, hipFuncAttributeMaxDynamicSharedMemorySize, LDS_BYTES);
        (void)hipOccupancyMaxActiveBlocksPerMultiprocessor(&per_cu, (const void*)mk_fwd, NT, LDS_BYTES);
        if (per_cu < 1) { fprintf(stderr, "kernel_launch: occupancy query says %d blocks per CU\n", per_cu); }
        grid = cus;
        if (grid > 256) grid = 256;
    }
    if (grid < 0) return;
    (void)hipMemsetAsync((char*)d_ws + WS_CTL, 0, CTL_ZERO_BYTES, stream);
    ArgsK a{};
    const GAS float** p = (const GAS float**)&a;
    for (int i = 0; i < 16; ++i) p[i] = (const GAS float*)d_in[i];
    a.out = (GAS float*)d_out; a.ws = (GAS unsigned char*)d_ws;
    void* args[] = {&a};
    hipError_t e = hipLaunchCooperativeKernel((const void*)mk_fwd, dim3(grid), dim3(NT), args, LDS_BYTES, stream);
    if (e != hipSuccess) fprintf(stderr, "cooperative launch failed: %s (grid %d)\n", hipGetErrorString(e), grid);
}
```

```cpp
#include <hip/hip_runtime.h>
#include <hip/hip_cooperative_groups.h>
#include <cstdio>
#include <cstdint>
namespace cg = cooperative_groups;
namespace pg8 {
#define PG8_LAS __attribute__((address_space(3)))
typedef unsigned short bf16_t;
typedef short bf16x8 __attribute__((ext_vector_type(8)));
typedef float f32x4 __attribute__((ext_vector_type(4)));
typedef unsigned u32x4 __attribute__((ext_vector_type(4)));
typedef unsigned u32x2 __attribute__((ext_vector_type(2)));
typedef int i32x4 __attribute__((ext_vector_type(4)));
constexpr int BM = 256, BK = 64, HALF = 128, HTB = HALF * BK * 2  , STAGE_BYTES = 8 * HTB, NXCD = 8, WGM = 8;

__host__ __device__ __forceinline__ int lds_byte(int r, int c) { const int st = (r >> 4) * 2 + (c >> 5), rr = r & 15, cc = c & 31, ob = rr * 64 + cc * 2; return st * 1024 + (ob ^ (((ob >> 9) & 1) << 5)); }
__host__ __device__ __forceinline__ void stage_rc(int b, int& R, int& C) { const int st = b / 1024, sb = b % 1024, swz = sb ^ (((sb >> 9) & 1) << 5); R = (st >> 1) * 16 + swz / 64; C = (st & 1) * 32 + (swz % 64) / 2; }
__host__ __device__ __forceinline__ int perm32(int rho) { const int n = rho >> 4, i = rho & 15; return 8 * (i >> 2) + 4 * n + (i & 3); }

struct Unit { int pm, pn; };
struct Gemm { const bf16_t* A; const bf16_t* Bt; int M, N, K; };

struct StaticOrder {
    int nM, nN, nwg, G, c;
    __host__ __device__ void init(int M, int N, int G_, int c_) { nM = M / BM; nN = N / BM; nwg = nM * nN; G = G_; c = c_; }
    __host__ __device__ bool next(int i, Unit& u) const {
        const long L = (long)i * G + c; if (L >= nwg) return false;
        int wgid = (int)L; { const int q = nwg / NXCD, r = nwg % NXCD, xcd = wgid % NXCD, off = wgid / NXCD; wgid = (xcd < r ? xcd * (q + 1) : r * (q + 1) + (xcd - r) * q) + off; }
        const int nig = WGM * nN, gid = wgid / nig, fm = gid * WGM, gsz = (nM - fm) < WGM ? (nM - fm) : WGM;
        u.pm = fm + ((wgid % nig) % gsz); u.pn = (wgid % nig) / gsz; return true;
    }
};

__device__ __forceinline__ unsigned cvt_pk_bf16(float lo, float hi) { unsigned r; asm volatile("v_cvt_pk_bf16_f32 %0, %1, %2" : "=v"(r) : "v"(lo), "v"(hi)); return r; }

template <class Epi, class Sched, bool ALIGN_EPI = false, bool I8 = false>
__device__ __forceinline__ void gemm_phase(PG8_LAS unsigned char* lds, const Gemm g, const Sched& S, const Epi& E, int wid) {
    int lane_; asm volatile("v_mbcnt_lo_u32_b32 %0, -1, 0\n\tv_mbcnt_hi_u32_b32 %0, -1, %0" : "=v"(lane_));
    const int lane = lane_, tid = wid * 64 + lane, wr = wid >> 2, wc = wid & 3, fr = lane & 15, fq = lane >> 4;
    const int K = g.K, nt = K / BK;
    unsigned voffA, voffB;
    { int R, C; stage_rc(tid * 16, R, C); const int Rb = Epi::PERM ? ((R & ~31) + perm32(R & 31)) : R; voffA = (unsigned)(R * K + C) * 2u; voffB = (unsigned)(Rb * K + C) * 2u; }
    const size_t p2step = (size_t)64 * K * 2;
    const size_t kstep = (size_t)(BK * 2);
    const size_t hstep = (size_t)HALF * K * 2;
    const size_t tstep = 2 * hstep;
    const unsigned ldsw = (unsigned)wid * 1024u;
    const int aoff = lds_byte(wr * 64 + fr, fq * 8), boff = lds_byte(wc * 32 + fr, fq * 8);
#define PG8_SA(b, h) (((b) * 2 + (h)) * HTB)
#define PG8_SB(b, h) ((4 + (b) * 2 + (h)) * HTB)
#define PG8_STAGE(bufoff, gbase, voff) do { _Pragma("unroll") for (int _i = 0; _i < 2; ++_i) \
        __builtin_amdgcn_global_load_lds((const unsigned*)((const char*)(gbase) + _i * p2step + (voff)), (PG8_LAS unsigned*)(lds + (bufoff) + ldsw + _i * 8192), 16, 0, 0); } while (0)
#define PG8_LDA(dst, b, h) do { _Pragma("unroll") for (int m = 0; m < 4; ++m) _Pragma("unroll") for (int k = 0; k < 2; ++k) dst[m][k] = *(const PG8_LAS bf16x8*)(lds + PG8_SA(b, h) + aoff + m * 2048 + k * 1024); } while (0)
#define PG8_LDB(dst, b, h) do { _Pragma("unroll") for (int n = 0; n < 2; ++n) _Pragma("unroll") for (int k = 0; k < 2; ++k) dst[n][k] = *(const PG8_LAS bf16x8*)(lds + PG8_SB(b, h) + boff + n * 2048 + k * 1024); } while (0)
#define PG8_MMA(ai, bj, At, Bt) do { __builtin_amdgcn_s_setprio(1); _Pragma("unroll") for (int m = 0; m < 4; ++m) _Pragma("unroll") for (int n = 0; n < 2; ++n) _Pragma("unroll") for (int k = 0; k < 2; ++k) \
        { if constexpr (I8) acc[ai][bj][m][n] = __builtin_bit_cast(f32x4, __builtin_amdgcn_mfma_i32_16x16x64_i8(__builtin_bit_cast(i32x4, Bt[n][k]), __builtin_bit_cast(i32x4, At[m][k]), __builtin_bit_cast(i32x4, acc[ai][bj][m][n]), 0, 0, 0)); \
          else acc[ai][bj][m][n] = __builtin_amdgcn_mfma_f32_16x16x32_bf16(Bt[n][k], At[m][k], acc[ai][bj][m][n], 0, 0, 0); } __builtin_amdgcn_s_setprio(0); } while (0)
#define PG8_WAIT_V(n) asm volatile("s_waitcnt vmcnt(" #n ")" ::: "memory")
#define PG8_WAIT_L(n) asm volatile("s_waitcnt lgkmcnt(" #n ")" ::: "memory")
#define PG8_BAR __builtin_amdgcn_s_barrier()
#define PG8_SCHED __builtin_amdgcn_sched_barrier(0)
    Unit cur, nxt; int ui = 0;
    if (!S.next(0, cur)) return;
    f32x4 acc[2][2][4][2];
#pragma unroll
    for (int a = 0; a < 2; ++a)
#pragma unroll
        for (int b = 0; b < 2; ++b)
#pragma unroll
            for (int m = 0; m < 4; ++m)
#pragma unroll
                for (int n = 0; n < 2; ++n) acc[a][b][m][n] = (f32x4){0.f, 0.f, 0.f, 0.f};
    bf16x8 At[4][2], B0[2][2], B1[2][2];
    typename Epi::Pre pre = {};
    const char* cA = (const char*)g.A + (size_t)cur.pm * tstep; const char* cB = (const char*)g.Bt + (size_t)cur.pn * tstep;
    PG8_STAGE(PG8_SB(0, 0), cB, voffB); PG8_STAGE(PG8_SB(0, 1), cB + hstep, voffB); PG8_STAGE(PG8_SA(0, 0), cA, voffA); PG8_STAGE(PG8_SA(0, 1), cA + hstep, voffA);
    if (wr == 1) PG8_BAR;
    PG8_WAIT_V(2); PG8_BAR;
    PG8_STAGE(PG8_SB(1, 0), cB + kstep, voffB); PG8_STAGE(PG8_SA(1, 0), cA + kstep, voffA); PG8_STAGE(PG8_SB(1, 1), cB + hstep + kstep, voffB);
    PG8_WAIT_V(6); PG8_BAR;
    for (;;) {
        const bool has_next = S.next(ui + 1, nxt);
        const char* nA = has_next ? (const char*)g.A + (size_t)nxt.pm * tstep : cA; const char* nB = has_next ? (const char*)g.Bt + (size_t)nxt.pn * tstep : cB;
        const int seglen = Epi::HOOK ? 8 : nt;
        for (int t0 = 0; t0 < nt; t0 += seglen) {
        if constexpr (Epi::HOOK) { if (t0 > 0) { int ln_; asm volatile("v_mbcnt_lo_u32_b32 %0, -1, 0\n\tv_mbcnt_hi_u32_b32 %0, -1, %0" : "=v"(ln_)); E.hook(acc, cur, t0 >> 3, wr, wc, ln_ & 15, ln_ >> 4); } }
        for (int t = t0; t < t0 + seglen; t += 2) {
            const bool last = (t == nt - 2);
            if constexpr (Epi::PRELOAD) { if (last) { int ln_; asm volatile("v_mbcnt_lo_u32_b32 %0, -1, 0\n\tv_mbcnt_hi_u32_b32 %0, -1, %0" : "=v"(ln_)); E.preload(pre, cur, wr, wc, ln_ & 15, ln_ >> 4); } }
            const char* a1 = cA + (size_t)(t + 1) * kstep;
            const char* a2 = last ? nA : cA + (size_t)(t + 2) * kstep; const char* b2 = last ? nB : cB + (size_t)(t + 2) * kstep;
            const char* a3 = a2 + kstep; const char* b3 = b2 + kstep;
            PG8_LDB(B0, 0, 0); PG8_LDB(B1, 0, 1); PG8_SCHED; PG8_LDA(At, 0, 0); PG8_STAGE(PG8_SA(1, 1), a1 + hstep, voffA);
            PG8_WAIT_V(8); PG8_WAIT_L(0); PG8_BAR; PG8_MMA(0, 0, At, B0); PG8_MMA(0, 1, At, B1); PG8_BAR; PG8_SCHED;
            PG8_LDA(At, 0, 1); PG8_STAGE(PG8_SB(0, 0), b2, voffB); PG8_STAGE(PG8_SB(0, 1), b2 + hstep, voffB); PG8_STAGE(PG8_SA(0, 0), a2, voffA);
            PG8_WAIT_V(8); PG8_WAIT_L(0); PG8_BAR; PG8_MMA(1, 0, At, B0); PG8_MMA(1, 1, At, B1); PG8_BAR; PG8_SCHED;
            PG8_LDB(B0, 1, 0); PG8_LDB(B1, 1, 1); PG8_SCHED; PG8_LDA(At, 1, 0); PG8_STAGE(PG8_SA(0, 1), a2 + hstep, voffA);
            PG8_WAIT_V(8); PG8_WAIT_L(0); PG8_BAR; PG8_MMA(0, 0, At, B0); PG8_MMA(0, 1, At, B1); PG8_BAR; PG8_SCHED;
            PG8_LDA(At, 1, 1); PG8_STAGE(PG8_SB(1, 0), b3, voffB); PG8_STAGE(PG8_SB(1, 1), b3 + hstep, voffB); PG8_STAGE(PG8_SA(1, 0), a3, voffA);
            PG8_WAIT_V(8); PG8_WAIT_L(0); PG8_BAR; PG8_MMA(1, 0, At, B0); PG8_MMA(1, 1, At, B1); PG8_BAR; PG8_SCHED;
        }
        }
        if constexpr (ALIGN_EPI) { if (wr == 0) PG8_BAR; }
        { int ln_; asm volatile("v_mbcnt_lo_u32_b32 %0, -1, 0\n\tv_mbcnt_hi_u32_b32 %0, -1, %0" : "=v"(ln_));
          if constexpr (Epi::PRELOAD) E(acc, cur, wr, wc, ln_ & 15, ln_ >> 4, pre); else E(acc, cur, wr, wc, ln_ & 15, ln_ >> 4); }
        if (!has_next) break;
#pragma unroll
        for (int a = 0; a < 2; ++a)
#pragma unroll
            for (int b = 0; b < 2; ++b)
#pragma unroll
                for (int m = 0; m < 4; ++m)
#pragma unroll
                    for (int n = 0; n < 2; ++n) acc[a][b][m][n] = (f32x4){0.f, 0.f, 0.f, 0.f};
        cur = nxt; cA = nA; cB = nB; ++ui;
        if constexpr (ALIGN_EPI) { if (wr == 1) PG8_BAR; }
    }
    PG8_WAIT_V(0);
    if constexpr (!ALIGN_EPI) { if (wr == 0) PG8_BAR; }
    PG8_BAR;
#undef PG8_SA
#undef PG8_SB
#undef PG8_STAGE
#undef PG8_LDA
#undef PG8_LDB
#undef PG8_MMA
#undef PG8_WAIT_V
#undef PG8_WAIT_L
#undef PG8_BAR
#undef PG8_SCHED
}
}
constexpr int NWAVES = 8, NT = NWAVES * 64;
constexpr int M = 8192, D = 2048, SEQ = 2048, NBATCH = 4, DEPTH = 2;
constexpr int INW = 13316, NPROJ = 13312, MIXW = 512, HD = 128;
constexpr int PEER_E = 16384;
constexpr float EPS = 1e-6f;
constexpr float ATT_SCALE = 0.08838834764831845f;

constexpr size_t MiB = 1u << 20;
constexpr size_t WS_CTL = 0, CTL_ZERO_BYTES = 1 * MiB;
constexpr size_t WS_SSQ = 0;
constexpr size_t WS_SSA = 256 * 1024;
constexpr size_t WS_WF = 1 * MiB;
constexpr size_t WS_BINR = WS_WF + 64 * 1024;
constexpr size_t WS_LOGF = 2 * MiB;
constexpr size_t WS_CUM = 3 * MiB;
constexpr size_t WS_WIN = 8 * MiB;
constexpr size_t WIN_BYTES = (size_t)NPROJ * D;
constexpr size_t WS_SW = 7 * MiB;
constexpr size_t WS_CMAX = 384 * 1024;
constexpr size_t WS_HB8 = 64 * MiB;
constexpr size_t WS_SA = 7 * MiB + 512 * 1024;
constexpr size_t WS_WBR = 112 * MiB, WS_WOUT = 128 * MiB, WS_WQ = 144 * MiB;
constexpr size_t SQ_BYTES = (size_t)D * D * 2;
constexpr size_t WS_PU = 160 * MiB, WS_PV = 288 * MiB;
constexpr size_t PE_BYTES = (size_t)PEER_E * D;
constexpr size_t WS_PK = 6 * MiB;
constexpr size_t WS_SU = 5 * MiB, WS_SV = 5 * MiB + 256 * 1024;
constexpr size_t WS_HB = 480 * MiB;
constexpr size_t WS_PROJ = 512 * MiB;
constexpr size_t PROJ_T = (size_t)M * MIXW;
constexpr size_t WS_R = 592 * MiB;
constexpr size_t R_PLANE = (size_t)M * D;
constexpr size_t WS_Y = 720 * MiB;
constexpr size_t WS_MRG = 752 * MiB;
constexpr size_t WS_Q = 784 * MiB;
constexpr size_t WS_END = 816 * MiB;

constexpr int RING_BYTES = 131072;
constexpr int LDS_BYTES = 147456;

typedef unsigned short bf16;
typedef unsigned v4u __attribute__((ext_vector_type(4)));
typedef unsigned v2u __attribute__((ext_vector_type(2)));
typedef float f32x4 __attribute__((ext_vector_type(4)));
typedef float f32x2 __attribute__((ext_vector_type(2)));
using bf16x2 = __attribute__((ext_vector_type(2))) __bf16;
#define LAS __attribute__((address_space(3)))

__device__ __forceinline__ unsigned f2bf(float f) { unsigned u = __builtin_bit_cast(unsigned, f); return (u + 0x7fffu + ((u >> 16) & 1u)) >> 16; }
__device__ __forceinline__ unsigned pk2(float lo, float hi) { return f2bf(lo) | (f2bf(hi) << 16); }
__device__ __forceinline__ float bflo(unsigned w) { return __builtin_bit_cast(float, w << 16); }
__device__ __forceinline__ float bfhi(unsigned w) { return __builtin_bit_cast(float, w & 0xffff0000u); }
__device__ __forceinline__ float bf2f(bf16 b) { return __builtin_bit_cast(float, ((unsigned)b) << 16); }
__device__ __forceinline__ float shf(float v, int src) { return __builtin_bit_cast(float, __builtin_amdgcn_ds_bpermute(src << 2, __builtin_bit_cast(int, v))); }
__device__ __forceinline__ int shi(int v, int src) { return __builtin_amdgcn_ds_bpermute(src << 2, v); }
#define DPP_ROR(x, n) __builtin_bit_cast(float, __builtin_amdgcn_update_dpp(0, __builtin_bit_cast(int, (x)), 0x120 + (n), 0xf, 0xf, false))
__device__ __forceinline__ float wave_sum(float v, int) {
    v += DPP_ROR(v, 8); v += DPP_ROR(v, 4); v += DPP_ROR(v, 2); v += DPP_ROR(v, 1);
    const int vi = __builtin_bit_cast(int, v);
    const float r0 = __builtin_bit_cast(float, __builtin_amdgcn_readlane(vi, 0)), r1 = __builtin_bit_cast(float, __builtin_amdgcn_readlane(vi, 16)),
                r2 = __builtin_bit_cast(float, __builtin_amdgcn_readlane(vi, 32)), r3 = __builtin_bit_cast(float, __builtin_amdgcn_readlane(vi, 48));
    return (r0 + r1) + (r2 + r3);
}
__device__ __forceinline__ float wave_max(float v, int) {
    v = fmaxf(v, DPP_ROR(v, 8)); v = fmaxf(v, DPP_ROR(v, 4)); v = fmaxf(v, DPP_ROR(v, 2)); v = fmaxf(v, DPP_ROR(v, 1));
    const int vi = __builtin_bit_cast(int, v);
    const float r0 = __builtin_bit_cast(float, __builtin_amdgcn_readlane(vi, 0)), r1 = __builtin_bit_cast(float, __builtin_amdgcn_readlane(vi, 16)),
                r2 = __builtin_bit_cast(float, __builtin_amdgcn_readlane(vi, 32)), r3 = __builtin_bit_cast(float, __builtin_amdgcn_readlane(vi, 48));
    return fmaxf(fmaxf(r0, r1), fmaxf(r2, r3));
}
__device__ __forceinline__ float ssa_to_f(unsigned long long v) { return (float)((double)v * (1.0 / 4294967296.0)); }
__device__ __forceinline__ float dot2_bf16(unsigned w, unsigned x, float acc) { return __builtin_amdgcn_fdot2_f32_bf16(__builtin_bit_cast(bf16x2, w), __builtin_bit_cast(bf16x2, x), acc, false); }

#define LANE_ID(x) asm volatile("v_mbcnt_lo_u32_b32 %0, -1, 0\n\tv_mbcnt_hi_u32_b32 %0, -1, %0" : "=v"(x))
struct Args {
    const float *x, *norm_mix, *w_in, *b_in, *pool_w, *pool_scale, *conv_w, *rel_bias, *w_branch, *w_out, *norm_ffn, *peer_wq, *peer_keys, *peer_u, *peer_v, *norm_final;
    float* out; unsigned char* ws;
};
#define GAS __attribute__((address_space(1)))
#define CAS __attribute__((address_space(4)))
struct ArgsK {
    const GAS float *x, *norm_mix, *w_in, *b_in, *pool_w, *pool_scale, *conv_w, *rel_bias, *w_branch, *w_out, *norm_ffn, *peer_wq, *peer_keys, *peer_u, *peer_v, *norm_final;
    GAS float* out; GAS unsigned char* ws;
};
__device__ __forceinline__ Args load_args(const CAS ArgsK* k, size_t zoff) {
    Args a;
    a.x = (const float*)k->x; a.norm_mix = (const float*)k->norm_mix; a.w_in = (const float*)k->w_in; a.b_in = (const float*)k->b_in; a.pool_w = (const float*)k->pool_w;
    a.pool_scale = (const float*)k->pool_scale; a.conv_w = (const float*)k->conv_w; a.rel_bias = (const float*)k->rel_bias; a.w_branch = (const float*)k->w_branch;
    a.w_out = (const float*)k->w_out; a.norm_ffn = (const float*)k->norm_ffn; a.peer_wq = (const float*)k->peer_wq; a.peer_keys = (const float*)k->peer_keys;
    a.peer_u = (const float*)k->peer_u; a.peer_v = (const float*)k->peer_v; a.norm_final = (const float*)k->norm_final; a.out = (float*)k->out; a.ws = (unsigned char*)(k->ws + zoff);
    return a;
}

using pg8::f32x4; using pg8::Unit;
constexpr size_t WS_G = 896 * MiB;
constexpr size_t WS_SWH = 7 * MiB + 256 * 1024, WS_BIH = 7 * MiB + 384 * 1024;
constexpr size_t WS_RSA = 7 * MiB + 768 * 1024;
constexpr int GATE_LUT_N = 1024, GATE_LUT_S = 64;
constexpr int LDS_GATE_LUT = RING_BYTES + 2048;
constexpr int LDS_EPI_PRE = RING_BYTES + 4096;
struct EpiProj {
    static constexpr bool PERM = true, HOOK = false, PRELOAD = true;
    struct Pre {};
    struct Ops { pg8::u32x4 sw[2], bi[2]; float rs[2][4]; };
    unsigned char* wsb; const bf16* biash; const float* rsa; const bf16* swh;
    const LAS unsigned char* lut;
    LAS unsigned char* pre;
    __device__ __forceinline__ void preload(Pre&, const Unit& u, int wr, int wc, int fr, int fq) const {
        const int wid = wr * 4 + wc, lane = fq * 16 + fr;
        if (wid == 0) { if (lane < 32) __builtin_amdgcn_global_load_lds((const unsigned*)(swh + u.pn * 256 + lane * 8), (LAS unsigned*)pre, 16, 0, 0); }
        else if (wid == 1) { if (lane < 32) __builtin_amdgcn_global_load_lds((const unsigned*)(biash + u.pn * 256 + lane * 8), (LAS unsigned*)(pre + 512), 16, 0, 0); }
        else if (wid == 2) __builtin_amdgcn_global_load_lds((const unsigned*)(rsa + u.pm * 256 + lane * 4), (LAS unsigned*)(pre + 1024), 16, 0, 0);
    }
    static __device__ __forceinline__ unsigned g8(float z) { const float t = __builtin_amdgcn_rcpf(__builtin_amdgcn_exp2f(__builtin_fmaf(z, -1.4426950408889634f, -8.0f)) + 0.00390625f);
        return (unsigned)(__builtin_amdgcn_fmed3f(t, 1.0f, 255.0f) + 0.5f); }
    static __device__ __forceinline__ unsigned g8x4(const f32x4& v) { return g8(v[0]) | (g8(v[1]) << 8) | (g8(v[2]) << 16) | (g8(v[3]) << 24); }
    __device__ __forceinline__ void operator()(f32x4 (&acc)[2][2][4][2], const Unit& u, int wr, int wc, int fr, int fq, const Pre&) const {
        const int cl0 = wc * 32 + 8 * fq;
        Ops p;
#pragma unroll
        for (int bj = 0; bj < 2; ++bj) { p.sw[bj] = *(const LAS pg8::u32x4*)(pre + (cl0 + bj * 128) * 2); p.bi[bj] = *(const LAS pg8::u32x4*)(pre + 512 + (cl0 + bj * 128) * 2); }
#pragma unroll
        for (int ai = 0; ai < 2; ++ai)
#pragma unroll
            for (int m = 0; m < 4; ++m) p.rs[ai][m] = *(const LAS float*)(pre + 1024 + (wr * 64 + fr + ai * 128 + m * 16) * 4);
#define ACCF(ai, bj, m, n) __builtin_convertvector(__builtin_bit_cast(pg8::i32x4, acc[ai][bj][m][n]), f32x4)
        const __amdgpu_buffer_rsrc_t rW = __builtin_amdgcn_make_buffer_rsrc((void*)wsb, 0, 0x7fffffff, 0x00020000);
        int sbase, ldb, voff;
        if (u.pn < 20) { sbase = (int)WS_PROJ + ((u.pn >> 1) * (int)PROJ_T + (u.pn & 1) * 256) * 2; ldb = MIXW * 2; voff = fr * ldb + cl0 * 2; }
        else { sbase = (int)WS_G + (u.pn - 20) * 256; ldb = 4 * D; voff = fr * ldb + wc * 64 + fq * 16; }
        sbase += (u.pm * 256 + wr * 64) * ldb;
        const float ws_ = u.pn >= 20 ? (float)GATE_LUT_S : 1.0f, bo_ = u.pn >= 20 ? (float)(GATE_LUT_N / 2) + 0.5f : 0.0f;
        unsigned gpk[2][4][2] = {};
#pragma unroll
        for (int bj = 0; bj < 2; ++bj) { const f32x4 w0 = (f32x4){bflo(p.sw[bj].x), bfhi(p.sw[bj].x), bflo(p.sw[bj].y), bfhi(p.sw[bj].y)} * ws_, w1 = (f32x4){bflo(p.sw[bj].z), bfhi(p.sw[bj].z), bflo(p.sw[bj].w), bfhi(p.sw[bj].w)} * ws_;
            const f32x4 b0 = (f32x4){bflo(p.bi[bj].x), bfhi(p.bi[bj].x), bflo(p.bi[bj].y), bfhi(p.bi[bj].y)} * ws_ + bo_, b1 = (f32x4){bflo(p.bi[bj].z), bfhi(p.bi[bj].z), bflo(p.bi[bj].w), bfhi(p.bi[bj].w)} * ws_ + bo_;
#pragma unroll
            for (int ai = 0; ai < 2; ++ai)
#pragma unroll
                for (int m = 0; m < 4; ++m) { const float rs = p.rs[ai][m]; const f32x4 v0 = ACCF(ai, bj, m, 0) * rs * w0 + b0, v1 = ACCF(ai, bj, m, 1) * rs * w1 + b1;
                    if (u.pn >= 20) { unsigned c[8];
#pragma unroll
                        for (int e = 0; e < 4; ++e) { c[e] = lut[(unsigned)__builtin_amdgcn_fmed3f(v0[e], 0.0f, (float)(GATE_LUT_N - 1))]; c[4 + e] = lut[(unsigned)__builtin_amdgcn_fmed3f(v1[e], 0.0f, (float)(GATE_LUT_N - 1))]; }
                        const unsigned d0_ = c[0] | (c[1] << 8) | (c[2] << 16) | (c[3] << 24), d1_ = c[4] | (c[5] << 8) | (c[6] << 16) | (c[7] << 24);
                        if (bj == 0) { gpk[ai][m][0] = d0_; gpk[ai][m][1] = d1_; }
                        else { pg8::u32x4 w; w.x = gpk[ai][m][0]; w.y = gpk[ai][m][1]; w.z = d0_; w.w = d1_;
                            __builtin_amdgcn_raw_buffer_store_b128(w, rW, voff, sbase + (ai * 128 + m * 16) * ldb, 0); } }
                    else { pg8::u32x4 w; w.x = pg8::cvt_pk_bf16(v0[0], v0[1]); w.y = pg8::cvt_pk_bf16(v0[2], v0[3]); w.z = pg8::cvt_pk_bf16(v1[0], v1[1]); w.w = pg8::cvt_pk_bf16(v1[2], v1[3]);
                        __builtin_amdgcn_raw_buffer_store_b128(w, rW, voff + bj * 256, sbase + (ai * 128 + m * 16) * ldb, 0); } } }
    }
};
#undef ACCF
struct EpiMerge {
    static constexpr bool PERM = true, HOOK = true; static constexpr bool PRELOAD = false; struct Pre {};
    const unsigned char* G; bf16* O;
    struct Bt { pg8::u32x4 n[4], d[4]; };
    __device__ __forceinline__ void scale(f32x4 (&acc)[2][2][4][2], const Unit& u, int g, int wr, int wc, int fr, int fq) const {
        const __amdgpu_buffer_rsrc_t rs = __builtin_amdgcn_make_buffer_rsrc((void*)G, 0, 0x7fffffff, 0x00020000);
        int voff = fr * 4 * D + 16 * fq; asm volatile("" : "+v"(voff));
        const int sden = (u.pm * 256 + wr * 64) * 4 * D + (g - 1) * D + u.pn * 256 + wc * 64, snum = sden + D;
        const bool fin = g == 4;
#define UB(x, e) ((float)(((x) >> (8 * (e))) & 255u))
#define MG_LOAD(B, b0) do { _Pragma("unroll") for (int i = 0; i < 4; ++i) { const int ai_ = ((b0) + i) >> 2, m_ = ((b0) + i) & 3, so_ = (ai_ * 128 + m_ * 16) * 4 * D; \
            B.d[i] = __builtin_amdgcn_raw_buffer_load_b128(rs, voff, sden + so_, 0); if (!fin) B.n[i] = __builtin_amdgcn_raw_buffer_load_b128(rs, voff, snum + so_, 0); } } while (0)
#define MG_APPLY(B, b0) do { _Pragma("unroll") for (int i = 0; i < 4; ++i) { const int ai_ = ((b0) + i) >> 2, m_ = ((b0) + i) & 3; \
            _Pragma("unroll") for (int q = 0; q < 4; ++q) { const unsigned dq = B.d[i][q], nq = B.n[i][q]; \
                f32x4 r = {UB(dq, 0), UB(dq, 1), UB(dq, 2), UB(dq, 3)}; \
                if (!fin) r *= (f32x4){__builtin_amdgcn_rcpf(UB(nq, 0)), __builtin_amdgcn_rcpf(UB(nq, 1)), __builtin_amdgcn_rcpf(UB(nq, 2)), __builtin_amdgcn_rcpf(UB(nq, 3))}; else r *= 0.00390625f; \
                acc[ai_][q >> 1][m_][q & 1] *= r; asm volatile("" : "+v"(acc[ai_][q >> 1][m_][q & 1])); } } } while (0)
        Bt A = {}, B = {};
        MG_LOAD(A, 0); MG_LOAD(B, 4);
        MG_APPLY(A, 0); asm volatile("" ::: "memory");
        MG_APPLY(B, 4); asm volatile("" ::: "memory");
#undef MG_LOAD
#undef MG_APPLY
#undef UB
    }
    __device__ __forceinline__ void hook(f32x4 (&acc)[2][2][4][2], const Unit& u, int g, int wr, int wc, int fr, int fq) const { scale(acc, u, g, wr, wc, fr, fq); }
    __device__ __forceinline__ void operator()(f32x4 (&acc)[2][2][4][2], const Unit& u, int wr, int wc, int fr, int fq) const {
        scale(acc, u, 4, wr, wc, fr, fq);
        const int row0 = u.pm * 256 + wr * 64 + fr, col0 = u.pn * 256 + wc * 32 + 8 * fq;
#pragma unroll
        for (int ai = 0; ai < 2; ++ai)
#pragma unroll
            for (int m = 0; m < 4; ++m) { bf16* rowp = O + (size_t)(row0 + ai * 128 + m * 16) * D + col0;
#pragma unroll
                for (int bj = 0; bj < 2; ++bj) { const f32x4 v0 = acc[ai][bj][m][0], v1 = acc[ai][bj][m][1];
                    pg8::u32x4 w; w.x = pg8::cvt_pk_bf16(v0[0], v0[1]); w.y = pg8::cvt_pk_bf16(v0[2], v0[3]); w.z = pg8::cvt_pk_bf16(v1[0], v1[1]); w.w = pg8::cvt_pk_bf16(v1[2], v1[3]);
                    *(pg8::u32x4*)(rowp + bj * 128) = w; } }
    }
};
struct EpiRes {
    static constexpr bool PERM = true, HOOK = false; static constexpr bool PRELOAD = false; struct Pre {};
    const float* X; bf16* HB; unsigned long long* ssa;
    __device__ __forceinline__ void operator()(f32x4 (&acc)[2][2][4][2], const Unit& u, int wr, int wc, int fr, int fq) const {
        const int row0 = u.pm * 256 + wr * 64 + fr, col0 = u.pn * 256 + wc * 32 + 8 * fq;
#pragma unroll
        for (int ai = 0; ai < 2; ++ai)
#pragma unroll
            for (int m = 0; m < 4; ++m) { const int row = row0 + ai * 128 + m * 16; const size_t off = (size_t)row * D + col0; float s = 0.f;
#pragma unroll
                for (int bj = 0; bj < 2; ++bj) { const size_t o = off + bj * 128; f32x4 h0, h1;
                    if (X != nullptr) { h0 = __builtin_nontemporal_load((const f32x4*)(X + o)); h1 = __builtin_nontemporal_load((const f32x4*)(X + o + 4)); }
                    else { const pg8::u32x4 w = *(const pg8::u32x4*)(HB + o); h0 = (f32x4){bflo(w.x), bfhi(w.x), bflo(w.y), bfhi(w.y)}; h1 = (f32x4){bflo(w.z), bfhi(w.z), bflo(w.w), bfhi(w.w)}; }
                    h0 += acc[ai][bj][m][0]; h1 += acc[ai][bj][m][1];
                    pg8::u32x4 w; w.x = pg8::cvt_pk_bf16(h0[0], h0[1]); w.y = pg8::cvt_pk_bf16(h0[2], h0[3]); w.z = pg8::cvt_pk_bf16(h1[0], h1[1]); w.w = pg8::cvt_pk_bf16(h1[2], h1[3]);
                    *(pg8::u32x4*)(HB + o) = w;
                    s += ((h0[0] * h0[0] + h0[1] * h0[1]) + (h0[2] * h0[2] + h0[3] * h0[3])) + ((h1[0] * h1[0] + h1[1] * h1[1]) + (h1[2] * h1[2] + h1[3] * h1[3])); }
                { const int ln = fq * 16 + fr; s += shf(s, ln ^ 16); s += shf(s, ln ^ 32); }
                if (fq == 0) atomicAdd(ssa + row, (unsigned long long)((double)s * 4294967296.0)); }
    }
};
struct EpiQ {
    static constexpr bool PERM = true, HOOK = false; static constexpr bool PRELOAD = false; struct Pre {};
    bf16* O; const unsigned long long* ssa;
    __device__ __forceinline__ void operator()(f32x4 (&acc)[2][2][4][2], const Unit& u, int wr, int wc, int fr, int fq) const {
        const int row0 = u.pm * 256 + wr * 64 + fr;
#pragma unroll
        for (int ai = 0; ai < 2; ++ai)
#pragma unroll
            for (int m = 0; m < 4; ++m) { const int row = row0 + ai * 128 + m * 16; const float rs = rsqrtf(ssa_to_f(ssa[row]) * (1.0f / D) + EPS);
                bf16* rowp = O + ((((size_t)(row >> 5) * 8 + u.pn) * 2 * 8 + (wc * 2 + (fq >> 1))) * 64 + (fq & 1) * 32 + (row & 31)) * 8;
#pragma unroll
                for (int bj = 0; bj < 2; ++bj) { const f32x4 v0 = acc[ai][bj][m][0] * rs, v1 = acc[ai][bj][m][1] * rs;
                    pg8::u32x4 w; w.x = pg8::cvt_pk_bf16(v0[0], v0[1]); w.y = pg8::cvt_pk_bf16(v0[2], v0[3]); w.z = pg8::cvt_pk_bf16(v1[0], v1[1]); w.w = pg8::cvt_pk_bf16(v1[2], v1[3]);
                    *(pg8::u32x4*)(rowp + bj * 8 * 512) = w; } }
    }
};

__device__ __forceinline__ int colmap_in(int j) { return j < 1536 ? j : j + 4; }
__device__ __forceinline__ void tr_item_i8(const float* W, const float* gain, const unsigned* cmax, unsigned char* WT, LAS float* scr, int k0, int n0, int lane) {
    const int q = lane & 7, r8 = lane >> 3, sc = colmap_in(n0 + 4 * q);
    f32x4 v[8];
#pragma unroll
    for (int i = 0; i < 8; ++i) v[i] = *(const f32x4*)(W + (size_t)(k0 + 8 * i + r8) * INW + sc);
    f32x4 inv;
#pragma unroll
    for (int e = 0; e < 4; ++e) { const float cm = __builtin_bit_cast(float, cmax[sc + e]); inv[e] = cm > 0.f ? 127.0f / cm : 0.f; }
#pragma unroll
    for (int i = 0; i < 8; ++i) { const float g = gain[k0 + 8 * i + r8];
#pragma unroll
        for (int e = 0; e < 4; ++e) scr[(8 * i + r8) * 33 + 4 * q + e] = v[i][e] * g * inv[e]; }
    asm volatile("s_waitcnt lgkmcnt(0)" ::: "memory");
    const int n = lane >> 1, hf = lane & 1;
    v4u o[2];
#pragma unroll
    for (int w = 0; w < 8; ++w) { unsigned pk = 0;
#pragma unroll
        for (int b = 0; b < 4; ++b) pk |= ((unsigned)((int)rintf(scr[(32 * hf + 4 * w + b) * 33 + n]) & 255)) << (8 * b);
        o[w >> 2][w & 3] = pk; }
    unsigned char* dst = WT + (size_t)(n0 + n) * D + k0 + 32 * hf;
    *(v4u*)dst = o[0]; *(v4u*)(dst + 16) = o[1];
    asm volatile("s_waitcnt lgkmcnt(0)" ::: "memory");
}
template <bool MAP>
__device__ __forceinline__ void tr_item(const float* W, int ldw, const float* scale, bf16* WT, int ldt, int dcol0, LAS float* scr, int k0, int n0, int lane) {
    const int q = lane & 7, r8 = lane >> 3, sc = MAP ? colmap_in(n0 + 4 * q) : (n0 + 4 * q);
    f32x4 v[8];
#pragma unroll
    for (int i = 0; i < 8; ++i) v[i] = __builtin_nontemporal_load((const f32x4*)(W + (size_t)(k0 + 8 * i + r8) * ldw + sc));
    f32x4 s0 = {1.f, 1.f, 1.f, 1.f}, s1 = s0;
    if (scale) { s0 = *(const f32x4*)(scale + k0 + 8 * q); s1 = *(const f32x4*)(scale + k0 + 8 * q + 4); }
#pragma unroll
    for (int i = 0; i < 8; ++i)
#pragma unroll
        for (int e = 0; e < 4; ++e) scr[(8 * i + r8) * 33 + 4 * q + e] = v[i][e];
    asm volatile("s_waitcnt lgkmcnt(0)" ::: "memory");
    const int c = q;
#pragma unroll
    for (int j = 0; j < 4; ++j) { const int n = r8 + 8 * j; const LAS float* s = scr + (8 * c) * 33 + n;
        v4u o; o.x = pk2(s[0 * 33] * s0[0], s[1 * 33] * s0[1]); o.y = pk2(s[2 * 33] * s0[2], s[3 * 33] * s0[3]); o.z = pk2(s[4 * 33] * s1[0], s[5 * 33] * s1[1]); o.w = pk2(s[6 * 33] * s1[2], s[7 * 33] * s1[3]);
        *(v4u*)(WT + (size_t)(n0 + n) * ldt + dcol0 + k0 + 8 * c) = o; }
    asm volatile("s_waitcnt lgkmcnt(0)" ::: "memory");
}
constexpr size_t WS_BAR = 512 * 1024;
#define XB_TMO      128
#define XB_XCNT(j)  (256  + 64 * (j))
#define XB_XSUB(j)  (1280 + 64 * (j))
#define XB_XGEN(j)  (2304 + 64 * (j))
#define XB_TOP      3328
#define XB_TOPGEN   3392
#define XCD_BAR_WORDS 3456
#define XB_SPIN_CAP (1u << 23)
__device__ __forceinline__ unsigned xb_ld(unsigned* p)              { return __hip_atomic_load(p, __ATOMIC_RELAXED, __HIP_MEMORY_SCOPE_AGENT); }
__device__ __forceinline__ unsigned xb_add(unsigned* p, unsigned v) { return __hip_atomic_fetch_add(p, v, __ATOMIC_RELAXED, __HIP_MEMORY_SCOPE_AGENT); }
__device__ __forceinline__ unsigned xb_xcc_id() { return (unsigned)__builtin_amdgcn_s_getreg((3 << 11) | 20) & 0xFu; }
#define XB_SPIN(cond, bar) do { unsigned _sp = 0; while (cond) { __builtin_amdgcn_s_sleep(1); \
    if ((++_sp & 255u) == 0u) { if (xb_ld(&(bar)[XB_TMO])) break; if (_sp > XB_SPIN_CAP) { atomicAdd(&(bar)[XB_TMO], 1u); break; } } } } while (0)
__device__ __forceinline__ void xcd_barrier_complete(unsigned* bar, unsigned x, unsigned G, unsigned& nloc, unsigned& nx) {
    unsigned sum, cnt, mine, sp = 0u;
    for (;;) {
        sum = 0u; cnt = 0u; mine = 0u;
#pragma unroll
        for (unsigned j = 0; j < 16; ++j) { const unsigned c = xb_ld(&bar[XB_XCNT(j)]); sum += c; cnt += (c > 0u) ? 1u : 0u; mine = (j == x) ? c : mine; }
        if (sum == G) break;
        __builtin_amdgcn_s_sleep(1);
        if ((++sp & 255u) == 0u) { if (xb_ld(&bar[XB_TMO])) break; if (sp > XB_SPIN_CAP) { atomicAdd(&bar[XB_TMO], 1u); break; } }
    }
    nloc = mine > 0u ? mine : 1u; nx = cnt > 0u ? cnt : 1u;
}
__device__ __forceinline__ void xcd_barrier(unsigned* bar, unsigned x, unsigned G, volatile LAS unsigned* st, int wave) {
    asm volatile("s_waitcnt vmcnt(0)" ::: "memory");
    __syncthreads();
    int lane; asm volatile("v_mbcnt_lo_u32_b32 %0, -1, 0\n\tv_mbcnt_hi_u32_b32 %0, -1, %0" : "=v"(lane));
    if (wave == 0 && lane == 0) {
        __builtin_amdgcn_s_waitcnt(0);
        unsigned nloc = st[0], nx = st[1];
        if (nloc == 0u) { xcd_barrier_complete(bar, x, G, nloc, nx); st[0] = nloc; st[1] = nx; }
        const unsigned old = xb_add(&bar[XB_XSUB(x)], 1u);
        const unsigned gen = old / nloc;
        if (old + 1u == (gen + 1u) * nloc) {
            __builtin_amdgcn_fence(__ATOMIC_RELEASE, "agent");
            asm volatile("s_waitcnt vmcnt(0)" ::: "memory");
            const unsigned og = xb_add(&bar[XB_TOP], 1u);
            const unsigned tg = og / nx;
            if (og + 1u == (tg + 1u) * nx) xb_add(&bar[XB_TOPGEN], 1u);
            else XB_SPIN(xb_ld(&bar[XB_TOPGEN]) == tg, bar);
            __builtin_amdgcn_fence(__ATOMIC_ACQUIRE, "agent");
            xb_add(&bar[XB_XGEN(x)], 1u);
            asm volatile("s_waitcnt vmcnt(0)" ::: "memory");
        } else {
            XB_SPIN(xb_ld(&bar[XB_XGEN(x)]) == gen, bar);
            __builtin_amdgcn_fence(__ATOMIC_ACQUIRE, "agent");
            asm volatile("s_waitcnt vmcnt(0)" ::: "memory");
        }
    }
    __syncthreads();
}
namespace att {
constexpr int D = 128, NW = 8, QBLK = 32, KVBLK = 64, QB = NW * QBLK;
constexpr int PITCH = 512, OPITCH = 2048;
constexpr float SCALE = 0.08838834764831845f, THR = 8.f;
constexpr int SHM_V = KVBLK * D * 2, SHM_K = KVBLK * D * 2;
constexpr int OFF_WS = 2 * SHM_V + 2 * SHM_K, OFF_CUM = OFF_WS + NW * 64 * 4, OFF_REL = OFF_CUM + 2048 * 4, LDS_END = OFF_REL + 320 * 4;
typedef unsigned short bf16;
typedef short bf16x8 __attribute__((ext_vector_type(8)));
typedef short s16x4 __attribute__((ext_vector_type(4)));
typedef float f32x16 __attribute__((ext_vector_type(16)));
typedef float f32x4 __attribute__((ext_vector_type(4)));
typedef unsigned u32x4 __attribute__((ext_vector_type(4)));
#define ALDS __attribute__((address_space(3)))

#define KSWZ(row, colB) ((row) * 256 + ((colB) ^ (((row) & 7) << 4)))
#define SBAR() __builtin_amdgcn_sched_barrier(0)
__device__ __forceinline__ int v_st(int k, int c) { const int kk = (k & ~0xC) | ((k & 4) << 1) | ((k & 8) >> 1); return ((kk >> 3) * 4 + (c >> 5)) * 512 + ((kk & 7) * 32 + (c & 31)) * 2; }
__device__ __forceinline__ int v_rd_base(int lane) { return ((lane & 3) << 3) | (((lane >> 2) & 3) << 6) | (((lane >> 4) & 1) << 5) | (((lane >> 5) & 1) << 8); }
constexpr int v_rd_off(int d0, int ks, int half) { return d0 * 512 + ks * 4096 + half * 2048; }
__device__ __forceinline__ int crow(int r, int hi) { return (r & 3) + 8 * (r >> 2) + 4 * hi; }
__device__ __forceinline__ unsigned cvtpk(float lo, float hi) { unsigned r; asm volatile("v_cvt_pk_bf16_f32 %0, %1, %2" : "=v"(r) : "v"(lo), "v"(hi)); return r; }
__device__ __forceinline__ bf16x8 load8(const bf16* p) { return *reinterpret_cast<const bf16x8*>(p); }

__device__ __forceinline__ void mask_tile(f32x16& p0, f32x16& p1, int dq) {
    const float NEG = -__builtin_inff();
#pragma unroll
    for (int r = 0; r < 16; ++r) { const int c = (r & 3) + 8 * (r >> 2);
        if (dq - c < 0) p0[r] = NEG;
        if (dq - c - 32 < 0) p1[r] = NEG; }
}
__device__ __forceinline__ void partialSM(f32x16& p0, f32x16& p1, float& m_reg, float& mn, float& alpha) {
    float pmax = p0[0];
#pragma unroll
    for (int r = 1; r < 16; ++r) pmax = fmaxf(pmax, p0[r]);
#pragma unroll
    for (int r = 0; r < 16; ++r) pmax = fmaxf(pmax, p1[r]);
    { auto rr = __builtin_amdgcn_permlane32_swap(__float_as_uint(pmax), __float_as_uint(pmax), false, false);
      pmax = fmaxf(__uint_as_float(rr[0]), __uint_as_float(rr[1])); }
    constexpr float C2 = 1.4426950408889634f * SCALE;
    if (__builtin_expect(__all((pmax - m_reg) * SCALE <= THR), 1)) { mn = m_reg; alpha = 1.f; }
    else { mn = fmaxf(m_reg, pmax); alpha = __builtin_amdgcn_exp2f((m_reg - mn) * C2); m_reg = mn; }
    const float mnL = -mn * C2;
#pragma unroll
    for (int r = 0; r < 16; ++r) p0[r] = fmaf(p0[r], C2, mnL);
#pragma unroll
    for (int r = 0; r < 16; ++r) p1[r] = fmaf(p1[r], C2, mnL);
#pragma unroll
    for (int r = 0; r < 16; ++r) p0[r] = __builtin_amdgcn_exp2f(p0[r]);
}
__device__ __forceinline__ void finishSM(f32x16& p0, f32x16& p1, float alpha, float& l_reg, bf16x8& pa0, bf16x8& pa1, bf16x8& pa2, bf16x8& pa3) {
#pragma unroll
    for (int r = 0; r < 16; ++r) p1[r] = __builtin_amdgcn_exp2f(p1[r]);
    float ps = 0;
#pragma unroll
    for (int r = 0; r < 16; ++r) ps += p0[r];
#pragma unroll
    for (int r = 0; r < 16; ++r) ps += p1[r];
    { auto rr = __builtin_amdgcn_permlane32_swap(__float_as_uint(ps), __float_as_uint(ps), false, false);
      ps = __uint_as_float(rr[0]) + __uint_as_float(rr[1]); }
    l_reg = l_reg * alpha + ps;
#define PK4(P, B_, OUT) do { unsigned a0 = cvtpk(P[B_+0], P[B_+1]), a1 = cvtpk(P[B_+2], P[B_+3]);                          \
        unsigned b0 = cvtpk(P[B_+4], P[B_+5]), b1 = cvtpk(P[B_+6], P[B_+7]);                                             \
        auto r0 = __builtin_amdgcn_permlane32_swap(a0, b0, false, false); auto r1 = __builtin_amdgcn_permlane32_swap(a1, b1, false, false); \
        u32x4 w = {r0[0], r1[0], r0[1], r1[1]}; OUT = *reinterpret_cast<bf16x8*>(&w); } while (0)
    PK4(p0, 0, pa0); PK4(p0, 8, pa1); PK4(p1, 0, pa2); PK4(p1, 8, pa3);
#undef PK4
}
template <int KB>
__device__ __forceinline__ void qkt(f32x16& p0, f32x16& p1, const ALDS char* K_lds, int r32, int hi, const bf16x8* qr, bool act) {
    if (!act) { const float NEG = -__builtin_inff();
#pragma unroll
        for (int r = 0; r < 16; ++r) { p0[r] = NEG; p1[r] = NEG; } return; }
    p0 = f32x16{}; p1 = f32x16{};
    const ALDS char* kb[4];
#pragma unroll
    for (int dd = 0; dd < 4; ++dd) kb[dd] = K_lds + KB * SHM_K + KSWZ(r32, (dd * 16 + hi * 8) * 2);
#pragma unroll
    for (int d0 = 0; d0 < 8; ++d0) { const ALDS char* a = kb[d0 & 3] + (d0 >> 2) * 128;
        bf16x8 b0 = *(const ALDS bf16x8*)(a);
        bf16x8 b1 = *(const ALDS bf16x8*)(a + 32 * 256);
        p0 = __builtin_amdgcn_mfma_f32_32x32x16_bf16(b0, qr[d0], p0, 0, 0, 0);
        p1 = __builtin_amdgcn_mfma_f32_32x32x16_bf16(b1, qr[d0], p1, 0, 0, 0); }
}
template <int VB>
__device__ __forceinline__ void pv_tile(f32x16* o, int vb0, bf16x8 pa0, bf16x8 pa1, bf16x8 pa2, bf16x8 pa3, bool act) {
    if (!act) return;
#define TRRD(dst, off) asm volatile("ds_read_b64_tr_b16 %0, %1 offset:%2" : "=&v"(dst) : "v"(vb0), "i"(off) : "memory")
#define PV_D0(d0) do { s16x4 l0, l1, l2, l3, h0, h1, h2, h3; constexpr int b_ = VB * SHM_V + v_rd_off(d0, 0, 0); \
        TRRD(l0, b_); TRRD(h0, b_ + 2048); TRRD(l1, b_ + 4096); TRRD(h1, b_ + 6144); TRRD(l2, b_ + 8192); TRRD(h2, b_ + 10240); TRRD(l3, b_ + 12288); TRRD(h3, b_ + 14336); \
        asm volatile("s_waitcnt lgkmcnt(0)" ::: "memory"); SBAR(); \
        o[d0] = __builtin_amdgcn_mfma_f32_32x32x16_bf16(pa0, (bf16x8){l0[0], l0[1], l0[2], l0[3], h0[0], h0[1], h0[2], h0[3]}, o[d0], 0, 0, 0);   \
        o[d0] = __builtin_amdgcn_mfma_f32_32x32x16_bf16(pa1, (bf16x8){l1[0], l1[1], l1[2], l1[3], h1[0], h1[1], h1[2], h1[3]}, o[d0], 0, 0, 0);   \
        o[d0] = __builtin_amdgcn_mfma_f32_32x32x16_bf16(pa2, (bf16x8){l2[0], l2[1], l2[2], l2[3], h2[0], h2[1], h2[2], h2[3]}, o[d0], 0, 0, 0);   \
        o[d0] = __builtin_amdgcn_mfma_f32_32x32x16_bf16(pa3, (bf16x8){l3[0], l3[1], l3[2], l3[3], h3[0], h3[1], h3[2], h3[3]}, o[d0], 0, 0, 0); } while (0)
    PV_D0(0); PV_D0(1); PV_D0(2); PV_D0(3);
#undef PV_D0
#undef TRRD
}
template <int MODE>
__device__ __forceinline__ void bias_mask(f32x16& p0, f32x16& p1, const ALDS char* lds, int kb, int qlo, int qpos, int hi, float cqs, bool act) {
    if (!act) return;
    if (MODE == 0) {
        const ALDS float* cs = (const ALDS float*)(lds + OFF_CUM) + kb + 4 * hi;
#pragma unroll
        for (int g = 0; g < 4; ++g) { const f32x4 c0 = *(const ALDS f32x4*)(cs + 8 * g), c1 = *(const ALDS f32x4*)(cs + 32 + 8 * g);
#pragma unroll
            for (int e = 0; e < 4; ++e) { p0[4 * g + e] += cqs - c0[e]; p1[4 * g + e] += cqs - c1[e]; } }
        if (kb + KVBLK - 1 > qlo) mask_tile(p0, p1, qpos - 4 * hi - kb);
    } else {
        const ALDS float* tb = (const ALDS float*)(lds + OFF_REL);
        if (qlo - (kb + KVBLK - 1) >= 256) { const float c = tb[319];
#pragma unroll
            for (int r = 0; r < 16; ++r) { p0[r] += c; p1[r] += c; } }
        else { const int d0 = qpos - kb - 4 * hi + 63;
#pragma unroll
            for (int r = 0; r < 16; ++r) { const int c = (r & 3) + 8 * (r >> 2);
                int i0 = d0 - c, i1 = d0 - c - 32; i0 = i0 > 319 ? 319 : i0; i1 = i1 > 319 ? 319 : i1; i1 = i1 < 0 ? 0 : i1; i0 = i0 < 0 ? 0 : i0;
                p0[r] += tb[i0]; p1[r] += tb[i1]; } }
    }
}

struct Seam { bf16x8 qr[8]; bf16x8 st_v0, st_v1, st_k0, st_k1; };
#define VMW() asm volatile("s_waitcnt vmcnt(0)" ::: "memory")
#define BL8(rs, vo, so) __builtin_bit_cast(bf16x8, __builtin_amdgcn_raw_buffer_load_b128(rs, vo, so, 0))
#define SLOAD_H(Kp, Vp, k0) do { S.st_v0 = BL8(rP, kvoff, (Vp) + (k0) * (PITCH * 2)); S.st_v1 = BL8(rP, kvoff, (Vp) + ((k0) + 32) * (PITCH * 2));              \
                         S.st_k0 = BL8(rP, kvoff, (Kp) + (k0) * (PITCH * 2)); S.st_k1 = BL8(rP, kvoff, (Kp) + ((k0) + 32) * (PITCH * 2)); } while (0)
#define SWRITE_HK(bf) do { *(ALDS bf16x8*)(K_lds + (bf) * SHM_K + kws) = S.st_k0; *(ALDS bf16x8*)(K_lds + (bf) * SHM_K + kws + 32 * 256) = S.st_k1; } while (0)
#define SWRITE_HV(bf) do { *(ALDS bf16x8*)(V_lds + (bf) * SHM_V + vst0) = S.st_v0; *(ALDS bf16x8*)(V_lds + (bf) * SHM_V + vst1) = S.st_v1; } while (0)
#define SWRITE_H(bf) do { SWRITE_HV(bf); SWRITE_HK(bf); } while (0)

template <int MODE, bool PART = false>
__device__ __forceinline__ void attn_unit(const bf16* Pb, int Qo, int Kh, int Vh, bf16* Yb, int Oo, int P0, int j_lo, int j_hi, ALDS char* lds, int wid, int lane, float* PO = nullptr, float* PM = nullptr, float* PL = nullptr) {
    const int tid = wid * 64 + lane, r32 = lane & 31, hi = lane >> 5;
    const int NT = j_hi - j_lo;
    const int qlo = P0 + wid * QBLK, qpos = qlo + r32;
    ALDS char* V_lds = lds; ALDS char* K_lds = lds + 2 * SHM_V;
    ALDS float* ws = (ALDS float*)(lds + OFF_WS) + wid * 64; ALDS float* li_l = ws; ALDS float* al_l = ws + 32;
    float m_reg = -1e30f, l_reg = 0; f32x16 o[4] = {};
    const int sr = tid >> 4, sc = (tid & 15) * 8, vst0 = v_st(sr, sc), vst1 = v_st(32 + sr, sc), kws = KSWZ(sr, sc * 2);
    const int vb0 = (int)(unsigned)(size_t)V_lds + v_rd_base(lane);
    Seam S;
    const __amdgpu_buffer_rsrc_t rP = __builtin_amdgcn_make_buffer_rsrc((void*)Pb, 0, 0x7fffffff, 0x00020000);
    const __amdgpu_buffer_rsrc_t rO = __builtin_amdgcn_make_buffer_rsrc((void*)Yb, 0, 0x7fffffff, 0x00020000);
    const int kvoff = (sr * PITCH + sc) * 2;
#define KBASE(t) ((j_lo + (t)) * KVBLK)
#define ACT(t) (MODE == 0 ? (KBASE(t) <= qlo + QBLK - 1) : ((j_lo + (t)) <= (qlo >> 6) && (j_lo + (t)) + 8 >= (qlo >> 6)))
#define RESC(a) do { if (__any((a) < 1.f)) { if (hi == 0) al_l[r32] = (a); asm volatile("s_waitcnt lgkmcnt(0)" ::: "memory");              \
                     for (int d_ = 0; d_ < 4; ++d_) for (int r = 0; r < 16; ++r) o[d_][r] *= al_l[crow(r, hi)]; } } while (0)
#define MASKT(P0_, P1_, t) bias_mask<MODE>(P0_, P1_, lds, KBASE(t), qlo, qpos, hi, cq_, ACT(t))
    {
        const int kb0 = j_lo * KVBLK;
#pragma unroll
        for (int d0 = 0; d0 < 8; ++d0) S.qr[d0] = BL8(rP, (r32 * PITCH + hi * 8) * 2 + d0 * 32, Qo + wid * (QBLK * PITCH * 2));
        SLOAD_H(Kh, Vh, kb0); VMW(); SWRITE_HK(0);
        __syncthreads();
    }
    const float cq_ = MODE == 0 ? ((const ALDS float*)(lds + OFF_CUM))[qpos] : 0.f;
    f32x16 pA0, pA1, pB0, pB1; float mnA, mnB, alA, alB; bf16x8 pa0, pa1, pa2, pa3;
    SWRITE_HV(0); SBAR();
    if (NT > 1) { SLOAD_H(Kh, Vh, KBASE(1)); }
    SBAR(); qkt<0>(pA0, pA1, K_lds, r32, hi, S.qr, ACT(0));
    MASKT(pA0, pA1, 0); partialSM(pA0, pA1, m_reg, mnA, alA);
    if (NT > 1) { VMW(); SWRITE_H(1); }
    __syncthreads();
#define HALF_STEP(PX0, PX1, mnX, alX, PY0, PY1, alY, t, KB, VB, SB) do {                                                      \
        SBAR(); qkt<KB>(PX0, PX1, K_lds, r32, hi, S.qr, ACT(t));                                                              \
        finishSM(PY0, PY1, alY, l_reg, pa0, pa1, pa2, pa3); SBAR();                                                           \
        if ((t) + 1 < NT) { SLOAD_H(Kh, Vh, KBASE((t) + 1)); SBAR(); }                                                        \
        pv_tile<VB>(o, vb0, pa0, pa1, pa2, pa3, ACT((t) - 1)); MASKT(PX0, PX1, (t)); partialSM(PX0, PX1, m_reg, mnX, alX);    \
        __syncthreads();                                                                                                      \
        if ((t) + 1 < NT) { VMW(); SWRITE_H(SB); }                                                                            \
        RESC(alX); __syncthreads(); } while (0)
    for (int t = 1; t + 1 < NT; t += 2) {
        HALF_STEP(pB0, pB1, mnB, alB, pA0, pA1, alA, t, 1, 0, 0);
        HALF_STEP(pA0, pA1, mnA, alA, pB0, pB1, alB, t + 1, 0, 1, 1);
    }
    const bool even = (NT & 1) == 0;
    if (even) { SBAR(); qkt<1>(pB0, pB1, K_lds, r32, hi, S.qr, ACT(NT - 1)); SBAR(); }
    finishSM(pA0, pA1, alA, l_reg, pa0, pa1, pa2, pa3); SBAR();
    pv_tile<0>(o, vb0, pa0, pa1, pa2, pa3, ACT(even ? NT - 2 : NT - 1));
    if (even) { MASKT(pB0, pB1, NT - 1); partialSM(pB0, pB1, m_reg, mnB, alB); __syncthreads(); RESC(alB);
        finishSM(pB0, pB1, alB, l_reg, pa0, pa1, pa2, pa3); SBAR(); pv_tile<1>(o, vb0, pa0, pa1, pa2, pa3, ACT(NT - 1)); }
    SBAR();
    if constexpr (PART) {
        if (hi == 0) { PM[wid * QBLK + r32] = m_reg; PL[wid * QBLK + r32] = l_reg; }
#pragma unroll
        for (int r = 0; r < 16; ++r) { const int orow = wid * QBLK + (r & 3) + 8 * (r >> 2) + 4 * hi;
#pragma unroll
            for (int d0 = 0; d0 < 4; ++d0) PO[orow * D + d0 * 32 + r32] = o[d0][r]; }
    } else {
    if (hi == 0) li_l[r32] = l_reg; asm volatile("s_waitcnt lgkmcnt(0)" ::: "memory");
    float rli[16];
#pragma unroll
    for (int r = 0; r < 16; ++r) rli[r] = __builtin_amdgcn_rcpf(li_l[crow(r, hi)]);
    const int ovoff = (4 * hi * OPITCH + r32) * 2, osoff = Oo + wid * (QBLK * OPITCH * 2);
#pragma unroll
    for (int r = 0; r < 16; ++r) { const int orow = (r & 3) + 8 * (r >> 2);
#pragma unroll
        for (int d0 = 0; d0 < 4; ++d0) { const float v = o[d0][r] * rli[r];
            const float vn = __builtin_bit_cast(float, __builtin_amdgcn_ds_bpermute((lane ^ 1) << 2, __builtin_bit_cast(int, v)));
            if ((r32 & 1) == 0) __builtin_amdgcn_raw_buffer_store_b32(cvtpk(v, vn), rO, ovoff + d0 * 64, osoff + orow * (OPITCH * 2), 0); } }
    }
    __syncthreads();
#undef RESC
#undef KBASE
#undef ACT
#undef MASKT
#undef HALF_STEP
}
#undef BL8
#undef VMW
#undef SLOAD_H
#undef SWRITE_HK
#undef SWRITE_HV
#undef SWRITE_H
#undef KSWZ
#undef SBAR
}
constexpr size_t WS_QCTR = 768 * 1024;
constexpr size_t WS_POOLW = 4 * MiB;
constexpr int N_ATT_UNITS = 256, N_POOL_UNITS = 512, N_CONV_UNITS = 128;

__device__ __forceinline__ void stage_cum(const Args& a, int b, int h, LAS char* lds, int wave, int lane) {
    const float* logf = (const float*)(a.ws + WS_LOGF) + ((size_t)b * SEQ) * 4 + h;
    const int tid = wave * 64 + lane;
    float v[4];
#pragma unroll
    for (int e = 0; e < 4; ++e) v[e] = logf[(size_t)(4 * tid + e) * 4];
    v[1] += v[0]; v[2] += v[1]; v[3] += v[2];
    float incl = v[3];
#pragma unroll
    for (int o = 1; o < 64; o <<= 1) { const float t = shf(incl, lane >= o ? lane - o : lane); if (lane >= o) incl += t; }
    LAS float* wt = (LAS float*)(lds + att::OFF_WS);
    if (lane == 63) wt[wave] = incl;
    __syncthreads();
    float base = incl - v[3];
    for (int w = 0; w < wave; ++w) base += wt[w];
    LAS float* cs = (LAS float*)(lds + att::OFF_CUM);
    const float inv = 1.0f / ATT_SCALE;
    *(LAS f32x4*)(cs + 4 * tid) = (f32x4){(base + v[0]) * inv, (base + v[1]) * inv, (base + v[2]) * inv, (base + v[3]) * inv};
    __syncthreads();
}
constexpr size_t WS_PO = WS_MRG;
constexpr size_t WS_PML = WS_MRG + 16 * MiB;
constexpr size_t WS_ACNT = WS_QCTR + 4096;
struct AttBlk { int mode, qb, part; };
__device__ __forceinline__ void att_sched(int slot, AttBlk& b0, AttBlk& b1) {
    b1.mode = 0; b1.qb = -1; b1.part = 0; b0.mode = 0; b0.part = 0;
    switch (slot) {
        case 0: b0.qb = 7; b0.part = 1; break;   case 1: b0.qb = 7; b0.part = 2; break;
        case 2: b0.qb = 6; b0.part = 1; break;   case 3: b0.qb = 6; b0.part = 2; break;
        case 4: b0.qb = 5; b0.part = 1; b1.qb = 0; break;
        case 5: b0.qb = 5; b0.part = 2; break;
        case 6: b0.qb = 4; break;
        case 7: b0.qb = 3; break;
        case 8: b0.qb = 2; b1.mode = 1; b1.qb = 0; break;
        case 9: b0.qb = 1; b1.mode = 1; b1.qb = 1; break;
        default: b0.mode = 1; b0.qb = 17 - slot; break;
    }
}
__device__ __forceinline__ void combine_pair(const Args& a, int l, int pair, int wave);
__device__ __forceinline__ void attention_block(const Args& a, int l, int bh, AttBlk k, LAS char* lds, int wave) {
    int lane; asm volatile("v_mbcnt_lo_u32_b32 %0, -1, 0\n\tv_mbcnt_hi_u32_b32 %0, -1, %0" : "=v"(lane));
    const bf16* P = (const bf16*)(a.ws + WS_PROJ); bf16* Y = (bf16*)(a.ws + WS_Y);
    const int qb = k.qb, b = bh >> 2, h = bh & 3;
    const size_t row0 = (size_t)b * SEQ; const int P0 = qb * 256;
    if (k.mode == 0) {
        stage_cum(a, b, h, lds, wave, lane);
        const int nt = 4 * qb + 4, q0 = (int)((0 * PROJ_T + (row0 + P0) * MIXW + h * HD) * 2), k0 = (int)((1 * PROJ_T + row0 * MIXW + h * HD) * 2), v0 = (int)((2 * PROJ_T + row0 * MIXW + h * HD) * 2), o0 = (int)(((row0 + P0) * D + h * HD) * 2);
        if (k.part == 0) att::attn_unit<0>(P, q0, k0, v0, Y, o0, P0, 0, nt, lds, wave, lane);
        else { const int pair = (qb - 4) * 16 + bh, hf = k.part - 1;
            float* PO = (float*)(a.ws + WS_PO) + ((size_t)pair * 2 + hf) * 256 * 128; float* PM = (float*)(a.ws + WS_PML) + ((size_t)pair * 2 + hf) * 512;
            att::attn_unit<0, true>(P, q0, k0, v0, Y, o0, P0, hf ? nt / 2 : 0, hf ? nt : nt / 2, lds, wave, lane, PO, PM, PM + 256);
            asm volatile("s_waitcnt vmcnt(0)" ::: "memory"); __syncthreads();
            if (hf == 0) {
                if (wave == 0 && lane == 0) { __builtin_amdgcn_fence(__ATOMIC_RELEASE, "agent"); asm volatile("s_waitcnt vmcnt(0)" ::: "memory");
                    __hip_atomic_fetch_add((unsigned*)(a.ws + WS_ACNT) + l * 64 + pair, 1u, __ATOMIC_RELAXED, __HIP_MEMORY_SCOPE_AGENT); } } }
    } else {
        const int tid = wave * 64 + lane;
        if (tid < 320) ((LAS float*)(lds + att::OFF_REL))[tid] = a.rel_bias[((size_t)l * 4 + h) * 320 + tid] * (1.0f / ATT_SCALE);
        const int jlo = 4 * qb - 8 < 0 ? 0 : 4 * qb - 8;
        att::attn_unit<1>(P, (int)((7 * PROJ_T + (row0 + P0) * MIXW + h * HD) * 2), (int)((8 * PROJ_T + row0 * MIXW + h * HD) * 2), (int)((9 * PROJ_T + row0 * MIXW + h * HD) * 2),
                          Y, (int)(((row0 + P0) * D + 1536 + h * HD) * 2), P0, jlo, 4 * qb + 4, lds, wave, lane);
    }
}
__device__ __forceinline__ void combine_pair(const Args& a, int l, int pair, int wave) {
    int lane; asm volatile("v_mbcnt_lo_u32_b32 %0, -1, 0\n\tv_mbcnt_hi_u32_b32 %0, -1, %0" : "=v"(lane));
    if (wave == 0 && lane == 0) {
        unsigned* c = (unsigned*)(a.ws + WS_ACNT) + l * 64 + pair; unsigned sp = 0;
        while (__hip_atomic_load(c, __ATOMIC_RELAXED, __HIP_MEMORY_SCOPE_AGENT) < 1u && ++sp < (1u << 24)) __builtin_amdgcn_s_sleep(2);
        __builtin_amdgcn_fence(__ATOMIC_ACQUIRE, "agent"); asm volatile("s_waitcnt vmcnt(0)" ::: "memory"); }
    __syncthreads();
    const int qb = 4 + (pair >> 4), bh = pair & 15, b = bh >> 2, h = bh & 3, tid = wave * 64 + lane, row = tid >> 1, c0 = (tid & 1) * 64;
    const float* POA = (const float*)(a.ws + WS_PO) + ((size_t)pair * 2) * 256 * 128 + row * 128 + c0; const float* POB = POA + 256 * 128;
    const float* ML = (const float*)(a.ws + WS_PML) + (size_t)pair * 2 * 512;
    const float mA = ML[row], lA = ML[256 + row], mB = ML[512 + row], lB = ML[768 + row], mm = fmaxf(mA, mB);
    constexpr float C2 = 1.4426950408889634f * ATT_SCALE;
    const float wA = __builtin_amdgcn_exp2f((mA - mm) * C2), wB = __builtin_amdgcn_exp2f((mB - mm) * C2), inv = 1.0f / (lA * wA + lB * wB), fa = wA * inv, fb = wB * inv;
    bf16* Y = (bf16*)(a.ws + WS_Y) + ((size_t)b * SEQ + qb * 256 + row) * D + h * HD + c0;
#pragma unroll
    for (int k = 0; k < 64; k += 8) { const f32x4 a0 = *(const f32x4*)(POA + k), a1 = *(const f32x4*)(POA + k + 4), b0 = *(const f32x4*)(POB + k), b1 = *(const f32x4*)(POB + k + 4);
        v4u o; o.x = pk2(a0[0] * fa + b0[0] * fb, a0[1] * fa + b0[1] * fb); o.y = pk2(a0[2] * fa + b0[2] * fb, a0[3] * fa + b0[3] * fb);
        o.z = pk2(a1[0] * fa + b1[0] * fb, a1[1] * fa + b1[1] * fb); o.w = pk2(a1[2] * fa + b1[2] * fb, a1[3] * fa + b1[3] * fb); *(v4u*)(Y + k) = o; }
    __syncthreads();
}
__device__ __forceinline__ void pool_item(const Args& a, int l, int u, LAS char* lds, int wave) {
    int lane; asm volatile("v_mbcnt_lo_u32_b32 %0, -1, 0\n\tv_mbcnt_hi_u32_b32 %0, -1, %0" : "=v"(lane));
    const int g = u & 3, T0 = (u >> 2) * 64, tid = wave * 64 + lane;
    const bf16* Pin = (const bf16*)(a.ws + WS_PROJ) + 3 * PROJ_T + g * 128;
    typedef short bf16x8 __attribute__((ext_vector_type(8)));
    const int rt = (wave & 3) * 16, db = (wave >> 2) * 64, fr = lane & 15, kg = lane >> 4;
    bf16x8 bfr[4][4]; f32x4 sc[4];
    { const bf16* Wt = (const bf16*)(a.ws + WS_POOLW) + ((size_t)l * 4 + g) * 128 * 128;
#pragma unroll
      for (int ks = 0; ks < 4; ++ks)
#pragma unroll
          for (int nt = 0; nt < 4; ++nt) bfr[ks][nt] = *(const bf16x8*)(Wt + (size_t)(db + nt * 16 + fr) * 128 + ks * 32 + kg * 8);
#pragma unroll
      for (int nt = 0; nt < 4; ++nt) sc[nt] = *(const f32x4*)(a.pool_scale + l * MIXW + g * 128 + db + nt * 16 + kg * 4); }
    {
        const int cp = tid & 63, run = tid >> 6, w = 2 << g, t0 = T0 + run * 8, s0 = t0 & (SEQ - 1);
        const bf16* col = Pin + 2 * cp;
        float lo[23], hi[23];
#pragma unroll
        for (int k = 0; k < 23; ++k) { const int dj = k - 15; const bool ok = s0 + dj >= 0; const unsigned x = *(const unsigned*)(col + (size_t)(ok ? t0 + dj : t0) * MIXW); lo[k] = ok ? bflo(x) : 0.f; hi[k] = ok ? bfhi(x) : 0.f; }
        float s_lo = 0.f, s_hi = 0.f;
#pragma unroll
        for (int j = 1; j < 16; ++j) if (j < w) { s_lo += lo[15 - j]; s_hi += hi[15 - j]; }
#pragma unroll
        for (int i = 0; i < 8; ++i) { s_lo += lo[15 + i]; s_hi += hi[15 + i];
            const int s = s0 + i; const int cnt = s + 1 < w ? s + 1 : w; const float inv = 1.0f / (float)cnt;
            *(LAS unsigned*)(lds + (run * 8 + i) * 272 + 4 * cp) = pk2(s_lo * inv - lo[15 + i], s_hi * inv - hi[15 + i]);
            const float dl = g == 0 ? lo[14 + i] : g == 1 ? lo[12 + i] : g == 2 ? lo[8 + i] : lo[i], dh = g == 0 ? hi[14 + i] : g == 1 ? hi[12 + i] : g == 2 ? hi[8 + i] : hi[i];
            s_lo -= dl; s_hi -= dh; }
    }
    __syncthreads();
    {
        f32x4 acc[4] = {};
#pragma unroll
        for (int ks = 0; ks < 4; ++ks) { const bf16x8 af = *(const LAS bf16x8*)(lds + (rt + fr) * 272 + (ks * 32 + kg * 8) * 2);
#pragma unroll
            for (int nt = 0; nt < 4; ++nt) acc[nt] = __builtin_amdgcn_mfma_f32_16x16x32_bf16(bfr[ks][nt], af, acc[nt], 0, 0, 0); }
        bf16* Y = (bf16*)(a.ws + WS_Y) + (size_t)(T0 + rt + fr) * D + 512 + g * 128;
#pragma unroll
        for (int nt = 0; nt < 4; ++nt) { const int d = db + nt * 16 + kg * 4;
            v2u w; w.x = pk2(acc[nt][0] * sc[nt][0], acc[nt][1] * sc[nt][1]); w.y = pk2(acc[nt][2] * sc[nt][2], acc[nt][3] * sc[nt][3]); *(v2u*)(Y + d) = w; }
    }
    __syncthreads();
}
__device__ __forceinline__ void conv_item(const Args& a, int l, int u, int wave) {
    int lane; asm volatile("v_mbcnt_lo_u32_b32 %0, -1, 0\n\tv_mbcnt_hi_u32_b32 %0, -1, %0" : "=v"(lane));
    const bf16* P = (const bf16*)(a.ws + WS_PROJ); const bf16* Ch = P + 4 * PROJ_T; const bf16* Cb = P + 5 * PROJ_T; const bf16* Cc = P + 6 * PROJ_T;
    const int tid = wave * 64 + lane, c0 = (tid & 63) * 8, t0 = u * 64 + (tid >> 6) * 8, s0 = t0 & (SEQ - 1);
    float wgt[3][8];
#pragma unroll
    for (int j = 0; j < 3; ++j) { const float* w = a.conv_w + ((size_t)l * 3 + j) * MIXW + c0; const f32x4 w0 = *(const f32x4*)w, w1 = *(const f32x4*)(w + 4);
#pragma unroll
        for (int k = 0; k < 4; ++k) { wgt[j][k] = w0[k]; wgt[j][4 + k] = w1[k]; } }
    v4u hv[10], cv[10], bv[8];
#pragma unroll
    for (int k = 0; k < 10; ++k) { const int i = k - 2; const size_t r = (size_t)(s0 + i >= 0 ? t0 + i : t0) * MIXW + c0; hv[k] = *(const v4u*)(Ch + r); cv[k] = *(const v4u*)(Cc + r); }
#pragma unroll
    for (int i = 0; i < 8; ++i) bv[i] = *(const v4u*)(Cb + (size_t)(t0 + i) * MIXW + c0);
    float z2[8], z1[8];
#pragma unroll
    for (int k = 0; k < 8; ++k) { z2[k] = 0.f; z1[k] = 0.f; }
#pragma unroll
    for (int k = 0; k < 10; ++k) { const int i = k - 2; const float msk = s0 + i >= 0 ? 1.f : 0.f;
        float z[8];
        z[0] = bflo(hv[k].x) * bflo(cv[k].x) * msk; z[1] = bfhi(hv[k].x) * bfhi(cv[k].x) * msk; z[2] = bflo(hv[k].y) * bflo(cv[k].y) * msk; z[3] = bfhi(hv[k].y) * bfhi(cv[k].y) * msk;
        z[4] = bflo(hv[k].z) * bflo(cv[k].z) * msk; z[5] = bfhi(hv[k].z) * bfhi(cv[k].z) * msk; z[6] = bflo(hv[k].w) * bflo(cv[k].w) * msk; z[7] = bfhi(hv[k].w) * bfhi(cv[k].w) * msk;
        if (i >= 0) { const v4u b = bv[i]; float o[8];
            const float bb[8] = {bflo(b.x), bfhi(b.x), bflo(b.y), bfhi(b.y), bflo(b.z), bfhi(b.z), bflo(b.w), bfhi(b.w)};
#pragma unroll
            for (int q = 0; q < 8; ++q) o[q] = bb[q] * (wgt[0][q] * z2[q] + wgt[1][q] * z1[q] + wgt[2][q] * z[q]);
            v4u ov; ov.x = pk2(o[0], o[1]); ov.y = pk2(o[2], o[3]); ov.z = pk2(o[4], o[5]); ov.w = pk2(o[6], o[7]);
            *(v4u*)((bf16*)(a.ws + WS_Y) + (size_t)(t0 + i) * D + 1024 + c0) = ov; }
#pragma unroll
        for (int q = 0; q < 8; ++q) { z2[q] = z1[q]; z1[q] = z[q]; }
    }
}
__device__ __forceinline__ void mixers_fast(const Args& a, int lq, LAS char* lds, int wave, int lane, int G, int blk) {
    const int l = lq;
    AttBlk b0, b1; att_sched(blk >> 4, b0, b1);
    const bool split = G == 256;
    const int natt = split ? 2 : (N_ATT_UNITS - blk + G - 1) / G;
    unsigned* head = (unsigned*)(a.ws + WS_QCTR) + 64 * lq;
    volatile LAS unsigned* slot = (volatile LAS unsigned*)(lds + att::LDS_END);
    unsigned tk = 0;
    for (int stage = 0;; ++stage) {
        if (stage < natt) { AttBlk k = stage ? b1 : b0; int bh = blk & 15;
            if (!split) { const int u = blk + stage * G; k.mode = u >> 7; k.qb = 7 - ((u & 127) >> 4); k.part = 0; bh = u & 15; }
            if (k.qb >= 0) attention_block(a, l, bh, k, lds, wave);
            continue; }
        if (stage == natt) { if (split && b0.part == 2) combine_pair(a, l, (b0.qb - 4) * 16 + (blk & 15), wave); continue; }
        if (stage == natt + 1 && wave == 0 && lane == 0) tk = __hip_atomic_fetch_add(head, 1u, __ATOMIC_RELAXED, __HIP_MEMORY_SCOPE_AGENT);
        if (wave == 0 && lane == 0) *slot = tk;
        __syncthreads();
        const unsigned it = *slot;
        __syncthreads();
        if (it >= (unsigned)(N_POOL_UNITS + N_CONV_UNITS)) break;
        if (wave == 0 && lane == 0) tk = __hip_atomic_fetch_add(head, 1u, __ATOMIC_RELAXED, __HIP_MEMORY_SCOPE_AGENT);
        if (it < (unsigned)N_POOL_UNITS) pool_item(a, l, (int)it, lds, wave); else conv_item(a, l, (int)it - N_POOL_UNITS, wave);
    }
}
__device__ __forceinline__ void p0_cmax(const Args& a, int gw, int NGW, int lane) {
    unsigned char* ws = a.ws;
    {
        constexpr int NCC = (INW + 255) / 256;
        for (int it = gw; it < DEPTH * 32 * NCC; it += NGW) { const int l = it / (32 * NCC), r = it % (32 * NCC), kc = r / NCC, cc = r % NCC; const int c0 = cc * 256 + 4 * lane;
            if (c0 + 3 < INW) { const float* W = a.w_in + (size_t)l * D * INW + (size_t)(kc * 64) * INW + c0; const float* g = a.norm_mix + l * D + kc * 64;
                float m0 = 0.f, m1 = 0.f, m2 = 0.f, m3 = 0.f;
#pragma unroll 8
                for (int k = 0; k < 64; ++k) { const f32x4 w = *(const f32x4*)(W + (size_t)k * INW); const float gk = fabsf(g[k]);
                    m0 = fmaxf(m0, fabsf(w[0]) * gk); m1 = fmaxf(m1, fabsf(w[1]) * gk); m2 = fmaxf(m2, fabsf(w[2]) * gk); m3 = fmaxf(m3, fabsf(w[3]) * gk); }
                unsigned* cm = (unsigned*)(ws + WS_CMAX) + l * INW + c0;
                const unsigned u0 = __float_as_uint(m0), u1 = __float_as_uint(m1), u2 = __float_as_uint(m2), u3 = __float_as_uint(m3);
                __hip_atomic_fetch_max(cm + 0, u0, __ATOMIC_RELAXED, __HIP_MEMORY_SCOPE_AGENT); __hip_atomic_fetch_max(cm + 1, u1, __ATOMIC_RELAXED, __HIP_MEMORY_SCOPE_AGENT);
                __hip_atomic_fetch_max(cm + 2, u2, __ATOMIC_RELAXED, __HIP_MEMORY_SCOPE_AGENT); __hip_atomic_fetch_max(cm + 3, u3, __ATOMIC_RELAXED, __HIP_MEMORY_SCOPE_AGENT); } }
    }
}
__device__ __forceinline__ void weight_copies(const Args& a, LAS unsigned char* lds, int l, int part, int gw, int NGW, int wave, int lane) {
    unsigned char* ws = a.ws;
    LAS float* scr = (LAS float*)(lds + wave * 16384);
    constexpr int I_SQ = (D / 64) * (D / 32), I_BR = (MIXW / 64) * (D / 32);
    constexpr int I_LAYER = 4 * I_BR + 2 * I_SQ;
    for (int it = (part ? 4 * I_BR : 0) + gw; it < (part ? I_LAYER : 4 * I_BR); it += NGW) {
        int r = it;
        if (r < 4 * I_BR) { const int g = r / I_BR, rr = r % I_BR, kb = rr / (D / 32), nb = rr % (D / 32);
            tr_item<false>(a.w_branch + ((size_t)l * 4 + g) * MIXW * D, D, nullptr, (bf16*)(ws + WS_WBR + l * SQ_BYTES), D, g * MIXW, scr, 64 * kb, 32 * nb, lane); continue; }
        r -= 4 * I_BR;
        if (r < I_SQ) { const int kb = r / (D / 32), nb = r % (D / 32);
            tr_item<false>(a.w_out + (size_t)l * D * D, D, nullptr, (bf16*)(ws + WS_WOUT + l * SQ_BYTES), D, 0, scr, 64 * kb, 32 * nb, lane); continue; }
        r -= I_SQ;
        { const int kb = r / (D / 32), nb = r % (D / 32);
            tr_item<false>(a.peer_wq + (size_t)l * D * D, D, a.norm_ffn + l * D, (bf16*)(ws + WS_WQ + l * SQ_BYTES), D, 0, scr, 64 * kb, 32 * nb, lane); }
    }
}
__device__ __forceinline__ void p0_prologue(const Args& a, LAS unsigned char* lds, int gw, int NGW, int wave, int lane) {
    unsigned char* ws = a.ws;
    LAS float* scr = (LAS float*)(lds + wave * 16384);
    for (int l = 0; l < DEPTH; ++l) weight_copies(a, lds, l, 1, gw, NGW, wave, lane);
    for (int it = gw; it < DEPTH * 4 * 8; it += NGW) { const int lg = it >> 3, r = it & 7;
        tr_item<false>(a.pool_w + (size_t)lg * 128 * 128, 128, nullptr, (bf16*)(ws + WS_POOLW) + (size_t)lg * 128 * 128, 128, 0, scr, 64 * (r >> 2), 32 * (r & 3), lane); }
    {
        constexpr int NR = 2 * DEPTH * PEER_E;
        f32x4 nv[8];
        if (gw < NR) { const int t = gw / (DEPTH * PEER_E), row = gw - t * (DEPTH * PEER_E); const float* src = (t ? a.peer_v : a.peer_u) + (size_t)row * D + 4 * lane;
#pragma unroll
            for (int j = 0; j < 8; ++j) nv[j] = __builtin_nontemporal_load((const f32x4*)(src + 256 * j)); }
        for (int r = gw; r < NR; r += NGW) { const int t = r / (DEPTH * PEER_E), row = r - t * (DEPTH * PEER_E);
            f32x4 v[8]; float am = 0.f;
#pragma unroll
            for (int j = 0; j < 8; ++j) v[j] = nv[j];
            { const int r2 = r + NGW; if (r2 < NR) { const int t2 = r2 / (DEPTH * PEER_E), row2 = r2 - t2 * (DEPTH * PEER_E); const float* src = (t2 ? a.peer_v : a.peer_u) + (size_t)row2 * D + 4 * lane;
#pragma unroll
                for (int j = 0; j < 8; ++j) nv[j] = __builtin_nontemporal_load((const f32x4*)(src + 256 * j)); } }
#pragma unroll
            for (int j = 0; j < 8; ++j) am = fmaxf(am, fmaxf(fmaxf(fabsf(v[j][0]), fabsf(v[j][1])), fmaxf(fabsf(v[j][2]), fabsf(v[j][3]))));
            am = wave_max(am, lane);
            const float inv = am > 0.f ? 127.0f / am : 0.f, off = 0.f;
            unsigned char* dst = ws + (t ? WS_PV : WS_PU) + (size_t)row * D + 4 * lane;
#pragma unroll
            for (int j = 0; j < 8; ++j) { const int q0 = (int)(rintf(v[j][0] * inv) + off), q1 = (int)(rintf(v[j][1] * inv) + off), q2 = (int)(rintf(v[j][2] * inv) + off), q3 = (int)(rintf(v[j][3] * inv) + off);
                *(unsigned*)(dst + 256 * j) = (unsigned)(q0 & 255) | ((unsigned)(q1 & 255) << 8) | ((unsigned)(q2 & 255) << 16) | ((unsigned)(q3 & 255) << 24); }
            if (lane == 0) ((float*)(ws + (t ? WS_SV : WS_SU)))[row] = am * (1.0f / 127.0f); }
    }
    { bf16* pk = (bf16*)(ws + WS_PK); const size_t n8 = (size_t)DEPTH * 8 * 2 * 128 * 128 / 8;
      for (size_t i = (size_t)gw * 64 + lane; i < n8; i += (size_t)NGW * 64) { const size_t ln = i & 63, cs = (i >> 6) & 7, kb = (i >> 9) & 3, lhp = i >> 11; const size_t so = lhp * 16384 + (kb * 32 + (ln & 31)) * 128 + cs * 16 + (ln >> 5) * 8;
          const f32x4 v0 = *(const f32x4*)(a.peer_keys + so), v1 = *(const f32x4*)(a.peer_keys + so + 4);
          v4u o; o.x = pk2(v0[0], v0[1]); o.y = pk2(v0[2], v0[3]); o.z = pk2(v1[0], v1[1]); o.w = pk2(v1[2], v1[3]); *(v4u*)(pk + i * 8) = o; } }
    {
        float* wf = (float*)(ws + WS_WF); float* binr = (float*)(ws + WS_BINR);
        const int gt = gw * 64 + lane, NGT = NGW * 64;
        for (int i = gt; i < DEPTH * 4 * D; i += NGT) { const int l = i / (4 * D), h = (i / D) & 3, k = i % D; wf[i] = a.w_in[(size_t)l * D * INW + (size_t)k * INW + 1536 + h] * a.norm_mix[l * D + k]; }
        for (int i = gt; i < DEPTH * NPROJ; i += NGT) { const int l = i / NPROJ, j = i % NPROJ; binr[i] = a.b_in[l * INW + colmap_in(j)]; }
    }
    {
        unsigned long long* ssq = (unsigned long long*)(ws + WS_SSQ);
        for (int m0 = gw; m0 < M; m0 += 2 * NGW) {
            const int m1 = m0 + NGW; const bool ok1 = m1 < M; const int mr[2] = {m0, ok1 ? m1 : m0};
            f32x4 v[2][8];
#pragma unroll
            for (int r = 0; r < 2; ++r)
#pragma unroll
                for (int j = 0; j < 8; ++j) v[r][j] = *(const f32x4*)(a.x + (size_t)mr[r] * D + j * 256 + lane * 4);
#pragma unroll
            for (int r = 0; r < 2; ++r) { float s = 0.f, am = 0.f;
#pragma unroll
                for (int j = 0; j < 8; ++j) { s += (v[r][j][0] * v[r][j][0] + v[r][j][1] * v[r][j][1]) + (v[r][j][2] * v[r][j][2] + v[r][j][3] * v[r][j][3]);
                    am = fmaxf(am, fmaxf(fmaxf(fabsf(v[r][j][0]), fabsf(v[r][j][1])), fmaxf(fabsf(v[r][j][2]), fabsf(v[r][j][3])))); }
                s = wave_sum(s, lane); am = wave_max(am, lane);
                if (r == 0 || ok1) { const int m = mr[r];
                    if (lane == 0) { ssq[m] = (unsigned long long)((double)s * 4294967296.0); ((float*)(ws + WS_RSA))[m] = rsqrtf(s * (1.0f / D) + EPS) * am * (1.0f / 127.0f); }
                    const float inv = am > 0.f ? 127.0f / am : 0.f; unsigned char* q8 = ws + WS_HB8 + (size_t)m * D + 4 * lane;
#pragma unroll
                    for (int j = 0; j < 8; ++j) *(unsigned*)(q8 + 256 * j) = ((unsigned)((int)rintf(v[r][j][0] * inv) & 255)) | ((unsigned)((int)rintf(v[r][j][1] * inv) & 255) << 8) | ((unsigned)((int)rintf(v[r][j][2] * inv) & 255) << 16) | ((unsigned)((int)rintf(v[r][j][3] * inv) & 255) << 24); } } }
    }
}
__device__ __forceinline__ void p0_win_i8(const Args& a, LAS unsigned char* lds, int gw, int NGW, int wave, int lane) {
    unsigned char* ws = a.ws; LAS float* scr = (LAS float*)(lds + wave * 16384);
    constexpr int I_WIN = (D / 64) * (NPROJ / 32);
    for (int it = gw; it < DEPTH * I_WIN; it += NGW) { const int l = it / I_WIN, r = it % I_WIN, kb = r / (NPROJ / 32), nb = r % (NPROJ / 32);
        tr_item_i8(a.w_in + (size_t)l * D * INW, a.norm_mix + l * D, (const unsigned*)(ws + WS_CMAX) + l * INW, ws + WS_WIN + l * WIN_BYTES, scr, 64 * kb, 32 * nb, lane); }
    float* sw = (float*)(ws + WS_SW); const int gt = gw * 64 + lane, NGT = NGW * 64;
    bf16* swh = (bf16*)(ws + WS_SWH); bf16* bih = (bf16*)(ws + WS_BIH);
    for (int i = gt; i < DEPTH * NPROJ; i += NGT) { const int l = i / NPROJ, j = i % NPROJ; const float s = __builtin_bit_cast(float, ((const unsigned*)(ws + WS_CMAX))[l * INW + colmap_in(j)]) * (1.0f / 127.0f);
        sw[i] = s; swh[i] = (bf16)f2bf(s); bih[i] = (bf16)f2bf(a.b_in[l * INW + colmap_in(j)]); }
}
__device__ __forceinline__ void quant_rows(const Args& a, int l, int gw, int NGW, int lane) {
    unsigned char* ws = a.ws; const bf16* HB = (const bf16*)(ws + WS_HB);
    for (int m0 = gw; m0 < M; m0 += 2 * NGW) {
        const int m1 = m0 + NGW; const bool ok1 = m1 < M; const int mr[2] = {m0, ok1 ? m1 : m0};
        v4u w[2][4];
#pragma unroll
        for (int r = 0; r < 2; ++r)
#pragma unroll
            for (int j = 0; j < 4; ++j) w[r][j] = *(const v4u*)(HB + (size_t)mr[r] * D + j * 512 + lane * 8);
#pragma unroll
        for (int r = 0; r < 2; ++r) { float am = 0.f; float v[4][8];
#pragma unroll
            for (int j = 0; j < 4; ++j) { v[j][0] = bflo(w[r][j].x); v[j][1] = bfhi(w[r][j].x); v[j][2] = bflo(w[r][j].y); v[j][3] = bfhi(w[r][j].y); v[j][4] = bflo(w[r][j].z); v[j][5] = bfhi(w[r][j].z); v[j][6] = bflo(w[r][j].w); v[j][7] = bfhi(w[r][j].w);
#pragma unroll
                for (int e = 0; e < 8; ++e) am = fmaxf(am, fabsf(v[j][e])); }
            am = wave_max(am, lane);
            if (r == 0 || ok1) {
                if (lane == 0) ((float*)(ws + WS_RSA))[mr[r]] = rsqrtf(ssa_to_f(((const unsigned long long*)(ws + WS_SSQ))[(size_t)l * M + mr[r]]) * (1.0f / D) + EPS) * am * (1.0f / 127.0f);
                const float inv = am > 0.f ? 127.0f / am : 0.f; unsigned char* q8 = ws + WS_HB8 + (size_t)mr[r] * D + 8 * lane;
#pragma unroll
                for (int j = 0; j < 4; ++j) { v2u o;
                    o.x = ((unsigned)((int)rintf(v[j][0] * inv) & 255)) | ((unsigned)((int)rintf(v[j][1] * inv) & 255) << 8) | ((unsigned)((int)rintf(v[j][2] * inv) & 255) << 16) | ((unsigned)((int)rintf(v[j][3] * inv) & 255) << 24);
                    o.y = ((unsigned)((int)rintf(v[j][4] * inv) & 255)) | ((unsigned)((int)rintf(v[j][5] * inv) & 255) << 8) | ((unsigned)((int)rintf(v[j][6] * inv) & 255) << 16) | ((unsigned)((int)rintf(v[j][7] * inv) & 255) << 24);
                    *(v2u*)(q8 + 512 * j) = o; } } }
    }
}

__device__ __forceinline__ void forget_logits(const Args& a, int l, int gw, int NGW, int lane) {
    unsigned char* ws = a.ws; const bf16* HB = (const bf16*)(ws + WS_HB); const float* wf = (const float*)(ws + WS_WF) + l * 4 * D; const unsigned long long* ssq = (const unsigned long long*)(ws + WS_SSQ) + l * M;
    float* logf = (float*)(ws + WS_LOGF);
    f32x4 w[4][4][2];
#pragma unroll
    for (int h = 0; h < 4; ++h)
#pragma unroll
        for (int j = 0; j < 4; ++j) { const int k0 = j * 512 + lane * 8; w[h][j][0] = *(const f32x4*)(wf + h * D + k0); w[h][j][1] = *(const f32x4*)(wf + h * D + k0 + 4); }
    float bias[4];
#pragma unroll
    for (int h = 0; h < 4; ++h) bias[h] = a.b_in[l * INW + 1536 + h];
    for (int m0 = gw; m0 < M; m0 += 2 * NGW) {
        const int m1 = m0 + NGW; const bool ok1 = m1 < M; const int mr[2] = {m0, ok1 ? m1 : m0};
        f32x4 x[2][4][2];
#pragma unroll
        for (int r = 0; r < 2; ++r)
#pragma unroll
            for (int j = 0; j < 4; ++j) { const int k0 = j * 512 + lane * 8;
                if (l == 0) { x[r][j][0] = __builtin_nontemporal_load((const f32x4*)(a.x + (size_t)mr[r] * D + k0)); x[r][j][1] = __builtin_nontemporal_load((const f32x4*)(a.x + (size_t)mr[r] * D + k0 + 4)); }
                else { const v4u xv = __builtin_nontemporal_load((const v4u*)(HB + (size_t)mr[r] * D + k0)); x[r][j][0] = (f32x4){bflo(xv.x), bfhi(xv.x), bflo(xv.y), bfhi(xv.y)}; x[r][j][1] = (f32x4){bflo(xv.z), bfhi(xv.z), bflo(xv.w), bfhi(xv.w)}; } }
#pragma unroll
        for (int r = 0; r < 2; ++r) { const float rs = rsqrtf(ssa_to_f(ssq[mr[r]]) * (1.0f / D) + EPS);
#pragma unroll
            for (int h = 0; h < 4; ++h) { f32x4 s4 = {0.f, 0.f, 0.f, 0.f};
#pragma unroll
                for (int j = 0; j < 4; ++j) { s4 += x[r][j][0] * w[h][j][0]; s4 += x[r][j][1] * w[h][j][1]; }
                const float z = wave_sum((s4[0] + s4[1]) + (s4[2] + s4[3]), lane) * rs + bias[h];
                const float ls = fminf(z, 0.f) - __logf(1.0f + __expf(-fabsf(z)));
                if (lane == h && (r == 0 || ok1)) logf[mr[r] * 4 + h] = ls; } }
    }
}
__device__ __forceinline__ float gelu_tanh(float x) { const float u = 1.5957691216057308f * (x + 0.044715f * x * x * x); return x / (1.0f + __expf(-u)); }
constexpr int PEER_TOK = 32;
constexpr int PL_ROW = 129, PL_LANE = 33;
constexpr int PL_IDX = 0, PL_GATE = PEER_TOK * PL_ROW * 4, PL_TAB = 2 * PEER_TOK * PL_ROW * 4;
__device__ __forceinline__ int f2key(float f) { const int b = __builtin_bit_cast(int, f); return b ^ ((b >> 31) & 0x7fffffff); }
__device__ __forceinline__ float key2f(int k) { return __builtin_bit_cast(float, k ^ ((k >> 31) & 0x7fffffff)); }
#define CE_DESC(x, y) do { const int hi_ = (x) > (y) ? (x) : (y), lo_ = (x) > (y) ? (y) : (x); (x) = hi_; (y) = lo_; } while (0)
__device__ __forceinline__ void sort16_desc(int* v) {
#pragma unroll
    for (int k = 2; k <= 16; k <<= 1)
#pragma unroll
        for (int j = k >> 1; j > 0; j >>= 1)
#pragma unroll
            for (int i = 0; i < 16; ++i) { const int l = i ^ j; if (l > i) { if ((i & k) == 0) CE_DESC(v[i], v[l]); else CE_DESC(v[l], v[i]); } }
}
__device__ __forceinline__ void merge_top16(int* a, const int* b) {
#pragma unroll
    for (int i = 0; i < 16; ++i) a[i] = a[i] > b[15 - i] ? a[i] : b[15 - i];
#pragma unroll
    for (int j = 8; j > 0; j >>= 1)
#pragma unroll
        for (int i = 0; i < 16; ++i) { const int l = i ^ j; if (l > i) CE_DESC(a[i], a[l]); }
}
__device__ __forceinline__ void top16_of_64(int* v) {
    sort16_desc(v); sort16_desc(v + 16); sort16_desc(v + 32); sort16_desc(v + 48);
    merge_top16(v, v + 16); merge_top16(v + 32, v + 48); merge_top16(v, v + 32);
}
constexpr int cand_slot(int i, int j) {
    int n = 0;
    for (int a = 0; a < 16; ++a) for (int b = 0; b < 16; ++b) { if ((a + 1) * (b + 1) <= 16) { if (a == i && b == j) return n; ++n; } }
    return -1;
}
__device__ __forceinline__ void peer_retrieve(const Args& a, int l, int t0, int h, LAS char* lds, int wave) {
    typedef short bf16x8 __attribute__((ext_vector_type(8)));
    typedef float f32x16 __attribute__((ext_vector_type(16)));
    int lane; asm volatile("v_mbcnt_lo_u32_b32 %0, -1, 0\n\tv_mbcnt_hi_u32_b32 %0, -1, %0" : "=v"(lane));
    const int r32 = lane & 31, hi = lane >> 5, hi4 = hi * 4;
    const bf16* Q = (const bf16*)(a.ws + WS_Q) + ((size_t)(t0 >> 5) * 8 + h) * 2 * 8 * 512 + lane * 8;
    const bf16* PK = (const bf16*)(a.ws + WS_PK) + ((size_t)(l * 8 + h) * 2) * 128 * 128 + lane * 8;
    int top[2][16];
#pragma unroll
    for (int p = 0; p < 2; ++p) {
        f32x16 acc[4] = {};
        bf16x8 qf[8];
#pragma unroll
        for (int cs = 0; cs < 8; ++cs) qf[cs] = *(const bf16x8*)(Q + (p * 8 + cs) * 512);
        bf16x8 kfA[8], kfB[8];
#define PK_LOAD(KF, kb_) do { _Pragma("unroll") for (int cs = 0; cs < 8; ++cs) KF[cs] = *(const bf16x8*)(PK + (size_t)p * 128 * 128 + ((size_t)(kb_) * 8 + cs) * 512); } while (0)
#define PK_MMA(KF, kb_) do { _Pragma("unroll") for (int cs = 0; cs < 8; ++cs) acc[kb_] = __builtin_amdgcn_mfma_f32_32x32x16_bf16(KF[cs], qf[cs], acc[kb_], 0, 0, 0); } while (0)
        PK_LOAD(kfA, 0); PK_LOAD(kfB, 1); __builtin_amdgcn_sched_barrier(0);
        PK_MMA(kfA, 0); __builtin_amdgcn_sched_barrier(0); PK_LOAD(kfA, 2); __builtin_amdgcn_sched_barrier(0);
        PK_MMA(kfB, 1); __builtin_amdgcn_sched_barrier(0); PK_LOAD(kfB, 3); __builtin_amdgcn_sched_barrier(0);
        PK_MMA(kfA, 2); __builtin_amdgcn_sched_barrier(0);
        PK_MMA(kfB, 3);
#undef PK_LOAD
#undef PK_MMA
        int v[64];
#pragma unroll
        for (int kb = 0; kb < 4; ++kb)
#pragma unroll
            for (int r = 0; r < 16; ++r) { const int c = kb * 32 + (r & 3) + 8 * (r >> 2);
                v[kb * 16 + r] = (f2key(acc[kb][r]) & ~127) | (c | hi4); }
        top16_of_64(v);
        int mine[16], other[16];
#pragma unroll
        for (int i = 0; i < 16; ++i) { auto rr = __builtin_amdgcn_permlane32_swap((unsigned)v[i], (unsigned)v[i], false, false); mine[i] = (int)rr[0]; other[i] = (int)rr[1]; }
        merge_top16(mine, other);
#pragma unroll
        for (int i = 0; i < 16; ++i) top[p][i] = mine[i];
    }
    LAS int* tab = (LAS int*)(lds + PL_TAB) + (wave * 64 + lane) * PL_LANE;
    float sA[16], sB[16];
#pragma unroll
    for (int i = 0; i < 16; ++i) { sA[i] = key2f(top[0][i] & ~127); sB[i] = key2f(top[1][i] & ~127); tab[i] = top[0][i] & 127; tab[16 + i] = top[1][i] & 127; }
    int c[64];
#pragma unroll
    for (int n = 0; n < 64; ++n) c[n] = (int)0x80000000;
#pragma unroll
    for (int i = 0; i < 16; ++i)
#pragma unroll
        for (int j = 0; j < 16; ++j) if ((i + 1) * (j + 1) <= 16) c[cand_slot(i, j)] = (f2key(sA[i] + sB[j]) & ~255) | (16 * i + j);
    { int ch[32];
#pragma unroll
      for (int k = 0; k < 32; ++k) ch[k] = hi ? c[32 + k] : c[k];
      sort16_desc(ch); sort16_desc(ch + 16); merge_top16(ch, ch + 16);
      int mine[16], other[16];
#pragma unroll
      for (int i = 0; i < 16; ++i) { auto rr = __builtin_amdgcn_permlane32_swap((unsigned)ch[i], (unsigned)ch[i], false, false); mine[i] = (int)rr[0]; other[i] = (int)rr[1]; }
      merge_top16(mine, other);
#pragma unroll
      for (int i = 0; i < 16; ++i) c[i] = mine[i]; }
    float ex[16]; float sum = 0.f; const float mx = key2f(c[0] & ~255);
#pragma unroll
    for (int w = 0; w < 16; ++w) { ex[w] = __expf(key2f(c[w] & ~255) - mx); sum += ex[w]; }
    const float inv = 1.0f / sum;
    asm volatile("s_waitcnt lgkmcnt(0)" ::: "memory");
    LAS int* oi = (LAS int*)(lds + PL_IDX) + r32 * PL_ROW + h * 16; LAS float* og = (LAS float*)(lds + PL_GATE) + r32 * PL_ROW + h * 16;
#pragma unroll
    for (int w = 0; w < 16; ++w) { const int id = c[w] & 255; const int e = tab[id >> 4] * 128 + tab[16 + (id & 15)];
        if ((w >> 3) == hi) { oi[w] = e; og[w] = ex[w] * inv; } }
}
constexpr size_t WS_IDX = 816 * MiB;
constexpr size_t WS_GATE = 820 * MiB;
constexpr size_t WS_XQ = 824 * MiB;
constexpr size_t WS_SX = 856 * MiB;
constexpr size_t WS_PART = 857 * MiB;
constexpr size_t WS_END2 = 1024 * MiB;
#ifndef PEER_NB
#define PEER_NB 8
#endif
constexpr int NSLICE = 8, SLW = D / NSLICE;
__device__ __forceinline__ void peer_publish4(const Args& a, int l, int t0, LAS char* lds, int tl0) {
    static_assert(PEER_TOK / NWAVES == 4, "four tokens per wave");
    int lane; LANE_ID(lane);
    unsigned char* ws = a.ws;
    {   const float* SU = (const float*)(ws + WS_SU) + l * PEER_E; const float* SV = (const float*)(ws + WS_SV) + l * PEER_E;
        int i0[4], i1[4]; float g0[4], g1[4], su0[4], su1[4], sv0[4], sv1[4];
#pragma unroll
        for (int k = 0; k < 4; ++k) { const int tl = tl0 + k; i0[k] = ((const LAS int*)(lds + PL_IDX))[tl * PL_ROW + lane]; i1[k] = ((const LAS int*)(lds + PL_IDX))[tl * PL_ROW + 64 + lane];
            g0[k] = ((const LAS float*)(lds + PL_GATE))[tl * PL_ROW + lane]; g1[k] = ((const LAS float*)(lds + PL_GATE))[tl * PL_ROW + 64 + lane]; }
#pragma unroll
        for (int k = 0; k < 4; ++k) { su0[k] = SU[i0[k]]; su1[k] = SU[i1[k]]; sv0[k] = SV[i0[k]]; sv1[k] = SV[i1[k]]; }
#pragma unroll
        for (int k = 0; k < 4; ++k) { const int t = t0 + k; unsigned* gi = (unsigned*)(ws + WS_IDX) + (size_t)t * 64; unsigned* gg = (unsigned*)(ws + WS_GATE) + (size_t)t * 128;
            gi[lane] = (unsigned)i0[k] | ((unsigned)i1[k] << 16); gg[lane] = pk2(g0[k] * sv0[k], su0[k]); gg[64 + lane] = pk2(g1[k] * sv1[k], su1[k]); }
    }
    const unsigned long long* ssa1 = (const unsigned long long*)(ws + WS_SSA) + l * M;
    const float* gn = a.norm_ffn + l * D;
    f32x4 g[2][4]; v4u hw[4][2][2]; float rs[4];
#pragma unroll
    for (int i = 0; i < 2; ++i)
#pragma unroll
        for (int q = 0; q < 4; ++q) g[i][q] = *(const f32x4*)(gn + 16 * lane + 1024 * i + 4 * q);
#pragma unroll
    for (int k = 0; k < 4; ++k) { const bf16* HB = (const bf16*)(ws + WS_HB) + (size_t)(t0 + k) * D; rs[k] = rsqrtf(ssa_to_f(ssa1[t0 + k]) * (1.0f / D) + EPS);
#pragma unroll
        for (int i = 0; i < 2; ++i) { hw[k][i][0] = *(const v4u*)(HB + 16 * lane + 1024 * i); hw[k][i][1] = *(const v4u*)(HB + 16 * lane + 1024 * i + 8); } }
#pragma unroll
    for (int k = 0; k < 4; ++k) { const int t = t0 + k;
        float xf[32]; float am = 0.f;
#pragma unroll
        for (int i = 0; i < 2; ++i) { const unsigned hq[8] = {hw[k][i][0].x, hw[k][i][0].y, hw[k][i][0].z, hw[k][i][0].w, hw[k][i][1].x, hw[k][i][1].y, hw[k][i][1].z, hw[k][i][1].w};
#pragma unroll
            for (int q = 0; q < 4; ++q) {
                xf[16 * i + 4 * q + 0] = bflo(hq[2 * q]) * rs[k] * g[i][q][0]; xf[16 * i + 4 * q + 1] = bfhi(hq[2 * q]) * rs[k] * g[i][q][1];
                xf[16 * i + 4 * q + 2] = bflo(hq[2 * q + 1]) * rs[k] * g[i][q][2]; xf[16 * i + 4 * q + 3] = bfhi(hq[2 * q + 1]) * rs[k] * g[i][q][3]; } }
#pragma unroll
        for (int e = 0; e < 32; ++e) am = fmaxf(am, fabsf(xf[e]));
        am = wave_max(am, lane);
        const float inv = am > 0.f ? 127.0f / am : 0.f;
        if (lane == 0) ((float*)(ws + WS_SX))[t] = am * (1.0f / 127.0f);
        unsigned char* xq = ws + WS_XQ + (size_t)t * D;
#pragma unroll
        for (int i = 0; i < 2; ++i) { v4u ph;
#pragma unroll
            for (int d = 0; d < 4; ++d) { unsigned wh = 0;
#pragma unroll
                for (int b = 0; b < 4; ++b) wh |= ((unsigned)((int)rintf(xf[16 * i + 4 * d + b] * inv) & 255)) << (8 * b);
                ph[d] = wh; }
            *(v4u*)(xq + 16 * lane + 1024 * i) = ph; } }
}
struct PeerItems { int pos, npop, rank, nloc, wave;
    __device__ __forceinline__ int nblk() const { return (M / PEER_TOK - rank + nloc - 1) / nloc; }
    __device__ __forceinline__ int count() const { return ((NSLICE - pos + npop - 1) / npop) * nblk() * (PEER_TOK / NWAVES); }
    __device__ __forceinline__ void get(int n, int& s, int& t) const { constexpr int per = PEER_TOK / NWAVES; const int k = n % per, r = n / per, nb = nblk();
        s = pos + (r / nb) * npop; t = (rank + (r % nb) * nloc) * PEER_TOK + wave * per + k; } };
__device__ __forceinline__ void peer_u_wave(const Args& a, int l, const PeerItems& it, LAS unsigned char* lds) {
    int lane; LANE_ID(lane);
    unsigned char* ws = a.ws; const int sub = lane & 15, grp = lane >> 4;
    const __amdgpu_buffer_rsrc_t rU = __builtin_amdgcn_make_buffer_rsrc((void*)(ws + WS_PU + (size_t)l * PE_BYTES), 0, 0x7fffffff, 0x00020000);
    const __amdgpu_buffer_rsrc_t rW = __builtin_amdgcn_make_buffer_rsrc((void*)ws, 0, 0x7fffffff, 0x00020000);
    const int N = it.count(); if (N <= 0) return;
    int s, t; it.get(0, s, t);
    int idc[2], idn[2] = {0, 0}; v4u xhc, xhn = {}; v4u wA[PEER_NB], wB[PEER_NB];
    unsigned ixc[16], ixn[16];
    LAS unsigned short* ib = (LAS unsigned short*)(lds + 4096 + it.wave * 256);
#define IDX_TABLE(TW, I0, I1) do { ib[(lane & 3) * 32 + (lane >> 2)] = (unsigned short)(I0); ib[(lane & 3) * 32 + 16 + (lane >> 2)] = (unsigned short)(I1); \
        _Pragma("unroll") for (int q_ = 0; q_ < 4; ++q_) { const v4u t_ = *(const LAS v4u*)(ib + grp * 32 + 8 * q_); TW[4 * q_] = t_.x; TW[4 * q_ + 1] = t_.y; TW[4 * q_ + 2] = t_.z; TW[4 * q_ + 3] = t_.w; } } while (0)
#define IDX_OF(TW, i_) ((int)(((TW)[(i_) >> 1] >> (16 * ((i_) & 1))) & 0xffffu))
#define PU_META(I0, I1, XH, S_, T_) do { { const unsigned iw_ = __builtin_amdgcn_raw_buffer_load_b32(rW, 4 * lane, (int)WS_IDX + (T_) * 256, 0); I0 = (int)(iw_ & 0xffffu); I1 = (int)(iw_ >> 16); } \
        XH = __builtin_amdgcn_raw_buffer_load_b128(rW, 16 * sub, (int)WS_XQ + (T_) * D + SLW * (S_), 0); } while (0)
#define PU_ISSUE(W, TW, Q, S_) do { _Pragma("unroll") for (int j = 0; j < PEER_NB; ++j) { const int e_ = IDX_OF(TW, PEER_NB * (Q) + j); W[j] = __builtin_amdgcn_raw_buffer_load_b128(rU, e_ * D + SLW * (S_) + 16 * sub, 0, 0); } } while (0)
#define DPP_RORI(x, n) __builtin_amdgcn_update_dpp(0, (x), 0x120 + (n), 0xf, 0xf, false)
#define PU_COMP(W, Q) do { _Pragma("unroll") for (int j = 0; j < PEER_NB; ++j) { int dh = 0; \
            dh = __builtin_amdgcn_sdot4((int)W[j].x, (int)xhc.x, dh, false); dh = __builtin_amdgcn_sdot4((int)W[j].y, (int)xhc.y, dh, false); \
            dh = __builtin_amdgcn_sdot4((int)W[j].z, (int)xhc.z, dh, false); dh = __builtin_amdgcn_sdot4((int)W[j].w, (int)xhc.w, dh, false); \
            dh += DPP_RORI(dh, 8); dh += DPP_RORI(dh, 4); dh += DPP_RORI(dh, 2); dh += DPP_RORI(dh, 1);     \
            if (sub == ((PEER_NB * (Q) + j) & 15)) { if ((PEER_NB * (Q) + j) >> 4) acc1 = dh; else acc0 = dh; } } } while (0)
    PU_META(idc[0], idc[1], xhc, s, t); IDX_TABLE(ixc, idc[0], idc[1]); PU_ISSUE(wA, ixc, 0, s); PU_ISSUE(wB, ixc, 1, s);
    for (int n = 0; n < N; ++n) {
        int sn = s, tn = t; const bool more = n + 1 < N;
        if (more) it.get(n + 1, sn, tn);
        PU_META(idn[0], idn[1], xhn, sn, tn);
        int acc0 = 0, acc1 = 0;
        __builtin_amdgcn_sched_barrier(0);
#if PEER_NB == 8
        PU_COMP(wA, 0); PU_ISSUE(wA, ixc, 2, s); __builtin_amdgcn_sched_barrier(0);
        PU_COMP(wB, 1); PU_ISSUE(wB, ixc, 3, s); __builtin_amdgcn_sched_barrier(0);
        IDX_TABLE(ixn, idn[0], idn[1]);
        PU_COMP(wA, 2); PU_ISSUE(wA, ixn, 0, sn); __builtin_amdgcn_sched_barrier(0);
        PU_COMP(wB, 3); PU_ISSUE(wB, ixn, 1, sn); __builtin_amdgcn_sched_barrier(0);
#else
        IDX_TABLE(ixn, idn[0], idn[1]);
        PU_COMP(wA, 0); PU_ISSUE(wA, ixn, 0, sn); __builtin_amdgcn_sched_barrier(0);
        PU_COMP(wB, 1); PU_ISSUE(wB, ixn, 1, sn); __builtin_amdgcn_sched_barrier(0);
#endif
        __builtin_amdgcn_raw_buffer_store_b32(pk2((float)acc0, (float)acc1), rW, (4 * sub + grp) * 4, (int)WS_PART + (s * M + t) * 256, 0);
        s = sn; t = tn; xhc = xhn;
#pragma unroll
        for (int q_ = 8; q_ < 16; ++q_) ixc[q_] = ixn[q_];
    }
#undef PU_META
#undef PU_ISSUE
#undef PU_COMP
}
__device__ __forceinline__ void peer_v_wave(const Args& a, int l, const PeerItems& it, LAS unsigned char* lds) {
    int lane; LANE_ID(lane);
    unsigned char* ws = a.ws; const int sub = lane & 15, grp = lane >> 4;
    const __amdgpu_buffer_rsrc_t rV = __builtin_amdgcn_make_buffer_rsrc((void*)(ws + WS_PV + (size_t)l * PE_BYTES), 0, 0x7fffffff, 0x00020000);
    const __amdgpu_buffer_rsrc_t rW = __builtin_amdgcn_make_buffer_rsrc((void*)ws, 0, 0x7fffffff, 0x00020000);
    const int N = it.count(); if (N <= 0) return;
    int s, t; it.get(0, s, t);
    struct Meta { int id[2]; float gate[2], su[2], pa[2], sx; v2u h1; };
    Meta mc, mn; v4u wA[PEER_NB], wB[PEER_NB];
    unsigned ixc[16], ixn[16];
    LAS unsigned short* ib = (LAS unsigned short*)(lds + 4096 + it.wave * 256);
    const int l4 = 4 * lane;
#define WLD(off_s) __builtin_amdgcn_raw_buffer_load_b32(rW, l4, (int)(off_s), 0)
#define PV_META(MM, S_, T_) do { const int r_ = (T_) * 512; { const unsigned iw_ = WLD(WS_IDX + (T_) * 256); MM.id[0] = (int)(iw_ & 0xffffu); MM.id[1] = (int)(iw_ >> 16); const unsigned g0_ = WLD(WS_GATE + r_), g1_ = WLD(WS_GATE + r_ + 256); \
          MM.gate[0] = bflo(g0_); MM.su[0] = bfhi(g0_); MM.gate[1] = bflo(g1_); MM.su[1] = bfhi(g1_); } \
        float a0_ = 0.f, a1_ = 0.f; _Pragma("unroll") for (int q = 0; q < NSLICE; ++q) { const unsigned pw_ = WLD((int)WS_PART + (q * M + (T_)) * 256); a0_ += bflo(pw_); a1_ += bfhi(pw_); } \
        MM.pa[0] = a0_; MM.pa[1] = a1_; MM.sx = ((const float*)(ws + WS_SX))[T_]; \
        MM.h1 = __builtin_amdgcn_raw_buffer_load_b64(rW, (16 * sub + 4 * grp) * 2, (int)WS_HB + ((T_) * D + SLW * (S_)) * 2, 0); } while (0)
#define PV_ISSUE(W, TW, Q, S_) do { _Pragma("unroll") for (int j = 0; j < PEER_NB; ++j) { const int e_ = IDX_OF(TW, PEER_NB * (Q) + j); W[j] = __builtin_amdgcn_raw_buffer_load_b128(rV, e_ * D + SLW * (S_) + 16 * sub, 0, 0); } } while (0)
    typedef int i32x4_t __attribute__((ext_vector_type(4)));
    unsigned psel[4];
#pragma unroll
    for (int b_ = 0; b_ < 4; ++b_) psel[b_] = (0x0c0c0c0cu & ~(0xffu << (8 * (sub & 3)))) | ((unsigned)b_ << (8 * (sub & 3)));
    const bool md0 = (sub >> 2) == 0, md1 = (sub >> 2) == 1, md2 = (sub >> 2) == 2, md3 = (sub >> 2) == 3;
#define PV_COMP(W, Q) do { _Pragma("unroll") for (int j = 0; j < PEER_NB; ++j) { const int i_ = PEER_NB * (Q) + j; \
            const unsigned val_ = __builtin_amdgcn_perm(0u, cpw[i_ >> 2], psel[i_ & 3]); \
            const i32x4_t av_ = {(int)(md0 ? val_ : 0u), (int)(md1 ? val_ : 0u), (int)(md2 ? val_ : 0u), (int)(md3 ? val_ : 0u)}; \
            accv = __builtin_amdgcn_mfma_i32_16x16x64_i8(av_, __builtin_bit_cast(i32x4_t, W[j]), accv, 0, 0, 0); } } while (0)
    PV_META(mc, s, t); IDX_TABLE(ixc, mc.id[0], mc.id[1]); PV_ISSUE(wA, ixc, 0, s); PV_ISSUE(wB, ixc, 1, s);
    for (int n = 0; n < N; ++n) {
        int sn = s, tn = t; const bool more = n + 1 < N;
        if (more) it.get(n + 1, sn, tn);
        PV_META(mn, sn, tn);
        float coef[2];
#pragma unroll
        for (int hf = 0; hf < 2; ++hf) coef[hf] = gelu_tanh(mc.pa[hf] * mc.su[hf] * mc.sx) * mc.gate[hf];
        const float cmax = wave_max(fmaxf(fabsf(coef[0]), fabsf(coef[1])), lane); const float cinv = cmax > 0.f ? 127.0f / cmax : 0.f, cs = cmax * (1.0f / 127.0f);
        const int c8[2] = {(int)rintf(coef[0] * cinv), (int)rintf(coef[1] * cinv)};
        unsigned cpw[8];
        { LAS unsigned char* cb = lds + it.wave * 128;
          cb[(lane & 3) * 32 + (lane >> 2)] = (unsigned char)c8[0]; cb[(lane & 3) * 32 + 16 + (lane >> 2)] = (unsigned char)c8[1];
          const v4u c0_ = *(const LAS v4u*)(cb + grp * 32), c1_ = *(const LAS v4u*)(cb + grp * 32 + 16);
          cpw[0] = c0_.x; cpw[1] = c0_.y; cpw[2] = c0_.z; cpw[3] = c0_.w; cpw[4] = c1_.x; cpw[5] = c1_.y; cpw[6] = c1_.z; cpw[7] = c1_.w; }
        i32x4_t accv = {0, 0, 0, 0};
        __builtin_amdgcn_sched_barrier(0);
#if PEER_NB == 8
        PV_COMP(wA, 0); PV_ISSUE(wA, ixc, 2, s); __builtin_amdgcn_sched_barrier(0);
        PV_COMP(wB, 1); PV_ISSUE(wB, ixc, 3, s); __builtin_amdgcn_sched_barrier(0);
        IDX_TABLE(ixn, mn.id[0], mn.id[1]);
        PV_COMP(wA, 2); PV_ISSUE(wA, ixn, 0, sn); __builtin_amdgcn_sched_barrier(0);
        PV_COMP(wB, 3); PV_ISSUE(wB, ixn, 1, sn); __builtin_amdgcn_sched_barrier(0);
#else
        IDX_TABLE(ixn, mn.id[0], mn.id[1]);
        PV_COMP(wA, 0); PV_ISSUE(wA, ixn, 0, sn); __builtin_amdgcn_sched_barrier(0);
        PV_COMP(wB, 1); PV_ISSUE(wB, ixn, 1, sn); __builtin_amdgcn_sched_barrier(0);
#endif
        const int yq[4] = {accv[0], accv[1], accv[2], accv[3]};
        const f32x4 h2 = {bflo(mc.h1.x) + cs * (float)yq[0], bfhi(mc.h1.x) + cs * (float)yq[1], bflo(mc.h1.y) + cs * (float)yq[2], bfhi(mc.h1.y) + cs * (float)yq[3]};
        v2u hb; hb.x = pk2(h2[0], h2[1]); hb.y = pk2(h2[2], h2[3]);
        __builtin_amdgcn_raw_buffer_store_b64(hb, rW, (16 * sub + 4 * grp) * 2, (int)WS_HB + (t * D + SLW * s) * 2, 0);
        const float sq = wave_sum((h2[0] * h2[0] + h2[1] * h2[1]) + (h2[2] * h2[2] + h2[3] * h2[3]), lane);
        if (lane == 0) atomicAdd((unsigned long long*)(ws + WS_SSQ) + (size_t)(l + 1) * M + t, (unsigned long long)((double)sq * 4294967296.0));
        s = sn; t = tn; mc = mn;
#pragma unroll
        for (int q_ = 8; q_ < 16; ++q_) ixc[q_] = ixn[q_];
    }
#undef PV_META
#undef WLD
#undef PV_ISSUE
#undef PV_COMP
}
#define OSTORE(p_, ...) __builtin_nontemporal_store((__VA_ARGS__), (f32x4*)(p_))
__device__ __forceinline__ void final_norm(const Args& a, int gw, int NGW) {
    int lane; LANE_ID(lane);
    f32x4 g[8];
#pragma unroll
    for (int j = 0; j < 8; ++j) g[j] = *(const f32x4*)(a.norm_final + 4 * lane + 256 * j);
    for (int t0 = gw; t0 < M; t0 += 2 * NGW) { const int t1 = t0 + NGW; const bool ok1 = t1 < M; const int tr[2] = {t0, ok1 ? t1 : t0};
        v2u w[2][8]; float rf[2];
#pragma unroll
        for (int r = 0; r < 2; ++r) { const bf16* HB = (const bf16*)(a.ws + WS_HB) + (size_t)tr[r] * D;
            rf[r] = rsqrtf(ssa_to_f(((const unsigned long long*)(a.ws + WS_SSQ))[(size_t)DEPTH * M + tr[r]]) * (1.0f / D) + EPS);
#pragma unroll
            for (int j = 0; j < 8; ++j) w[r][j] = __builtin_nontemporal_load((const v2u*)(HB + 4 * lane + 256 * j)); }
#pragma unroll
        for (int r = 0; r < 2; ++r) if (r == 0 || ok1) { float* O = a.out + (size_t)tr[r] * D;
#pragma unroll
            for (int j = 0; j < 8; ++j) OSTORE(O + 4 * lane + 256 * j, (f32x4){bflo(w[r][j].x) * rf[r] * g[j][0], bfhi(w[r][j].x) * rf[r] * g[j][1], bflo(w[r][j].y) * rf[r] * g[j][2], bfhi(w[r][j].y) * rf[r] * g[j][3]}); } }
}

__global__ void __launch_bounds__(NT, 2) mk_fwd(ArgsK a_in) {
    extern __shared__ __attribute__((aligned(16))) unsigned char lds_raw[];
    LAS unsigned char* lds = (LAS unsigned char*)lds_raw;
    cg::grid_group grid = cg::this_grid();
    grid.sync();
    const int wave0 = __builtin_amdgcn_readfirstlane(threadIdx.x >> 6);
    const int G = gridDim.x;
    const CAS ArgsK* ka = (const CAS ArgsK*)__builtin_amdgcn_kernarg_segment_ptr();
    size_t zoff = 0;
#define PHASE_BEGIN() int lane; LANE_ID(lane); int blk = blockIdx.x, Gp = G, wv = wave0; asm volatile("" : "+s"(zoff), "+s"(ka), "+s"(blk), "+s"(Gp), "+s"(wv)); const int wave = wv, gw = blk * NWAVES + wv, NGW = Gp * NWAVES; (void)gw; (void)NGW; const Args a = load_args(ka, zoff); unsigned char* const ws = a.ws; (void)ws
    volatile LAS unsigned* bst = (volatile LAS unsigned*)(lds + RING_BYTES + 1024);
#define GRID_BAR() do { asm volatile("" : "+s"(zoff)); unsigned char* wsb_ = (unsigned char*)ka->ws + zoff; int wvb_ = wave0; asm volatile("" : "+s"(wvb_)); xcd_barrier((unsigned*)(wsb_ + WS_BAR), xb_xcc_id(), (unsigned)G, bst, wvb_); } while (0)
    volatile LAS unsigned* xinfo = bst + 4;
    { PHASE_BEGIN(); if (wave == 0 && lane == 0) { bst[0] = 0u; bst[1] = 0u; xinfo[2] = xb_add((unsigned*)(ws + WS_BAR) + XB_XCNT(xb_xcc_id()), 1u); }
      for (int i = wave * 64 + lane; i < GATE_LUT_N; i += NT) ((LAS unsigned char*)(lds + LDS_GATE_LUT))[i] = (unsigned char)EpiProj::g8((float)(i - GATE_LUT_N / 2) * (1.0f / GATE_LUT_S));
      p0_cmax(a, gw, NGW, lane); }
    GRID_BAR();
    { PHASE_BEGIN(); p0_win_i8(a, lds, gw, NGW, wave, lane); p0_prologue(a, lds, gw, NGW, wave, lane); }
    GRID_BAR();
    {
        PHASE_BEGIN();
        if (wave == 0 && lane == 0) { unsigned* bar = (unsigned*)(ws + WS_BAR); const unsigned x = xb_xcc_id(); unsigned pos = 0, npop = 0, mine = 1;
            for (unsigned j = 0; j < 16; ++j) { const unsigned c = xb_ld(&bar[XB_XCNT(j)]); if (c) { ++npop; if (j < x) ++pos; } if (j == x) mine = c ? c : 1u; }
            xinfo[0] = pos; xinfo[1] = npop ? npop : 1u; xinfo[3] = mine; }
        __syncthreads();
    }
    int depth_rt = DEPTH; asm volatile("" : "+s"(depth_rt));
    for (int lc = 0; lc < depth_rt; ++lc) {
        int l = lc; asm volatile("" : "+s"(l));
        if (l > 0) { { PHASE_BEGIN(); quant_rows(a, l, gw, NGW, lane); } GRID_BAR(); }
        {
            PHASE_BEGIN();
            pg8::Gemm g{(const bf16*)(ws + WS_HB8), (const bf16*)(ws + WS_WIN + l * WIN_BYTES), M, NPROJ, D / 2}; pg8::StaticOrder S; S.init(M, NPROJ, Gp, blk);
            EpiProj E{ws, (const bf16*)(ws + WS_BIH) + l * NPROJ, (const float*)(ws + WS_RSA), (const bf16*)(ws + WS_SWH) + l * NPROJ, (const LAS unsigned char*)(lds + LDS_GATE_LUT), lds + LDS_EPI_PRE};
            pg8::gemm_phase<EpiProj, pg8::StaticOrder, true, true>(lds, g, S, E, wave);
            {
                constexpr int NU = (M / 256) * (NPROJ / 256); const int nmax = (NU + Gp - 1) / Gp, nfull = NU - (nmax - 1) * Gp, nshort = Gp - nfull;
                if (nshort * 4 >= Gp) { if (blk >= nfull) { forget_logits(a, l, (blk - nfull) * NWAVES + wave, nshort * NWAVES, lane); weight_copies(a, lds, l, 0, (blk - nfull) * NWAVES + wave, nshort * NWAVES, wave, lane); } }
                else { forget_logits(a, l, gw, NGW, lane); weight_copies(a, lds, l, 0, gw, NGW, wave, lane); }
            }
        }
        GRID_BAR();
        { PHASE_BEGIN(); mixers_fast(a, l, (LAS char*)lds, wave, lane, Gp, blk); }
        GRID_BAR();
        {
            PHASE_BEGIN();
            pg8::Gemm g{(const bf16*)(ws + WS_Y), (const bf16*)(ws + WS_WBR + l * SQ_BYTES), M, D, D}; pg8::StaticOrder S; S.init(M, D, Gp, blk);
            EpiMerge E{(const unsigned char*)(ws + WS_G), (bf16*)(ws + WS_MRG)};
            pg8::gemm_phase<EpiMerge, pg8::StaticOrder, false>(lds, g, S, E, wave);
        }
        GRID_BAR();
        {
            PHASE_BEGIN();
            pg8::Gemm g{(const bf16*)(ws + WS_MRG), (const bf16*)(ws + WS_WOUT + l * SQ_BYTES), M, D, D}; pg8::StaticOrder S; S.init(M, D, Gp, blk);
            EpiRes E{l == 0 ? a.x : (const float*)nullptr, (bf16*)(ws + WS_HB), (unsigned long long*)(ws + WS_SSA) + l * M};
            pg8::gemm_phase<EpiRes, pg8::StaticOrder, false>(lds, g, S, E, wave);
        }
        GRID_BAR();
        {
            PHASE_BEGIN();
            pg8::Gemm g{(const bf16*)(ws + WS_HB), (const bf16*)(ws + WS_WQ + l * SQ_BYTES), M, D, D}; pg8::StaticOrder S; S.init(M, D, Gp, blk);
            EpiQ E{(bf16*)(ws + WS_Q), (const unsigned long long*)(ws + WS_SSA) + l * M};
            pg8::gemm_phase<EpiQ, pg8::StaticOrder, false>(lds, g, S, E, wave);
        }
        GRID_BAR();
        {
            PHASE_BEGIN(); (void)lane;
            for (int t0 = blk * PEER_TOK; t0 < M; t0 += Gp * PEER_TOK) {
                peer_retrieve(a, l, t0, wave, (LAS char*)lds, wave);
                __syncthreads();
                peer_publish4(a, l, t0 + wave * (PEER_TOK / NWAVES), (LAS char*)lds, wave * (PEER_TOK / NWAVES));
                __syncthreads();
            }
        }
        GRID_BAR();
        {
            PHASE_BEGIN(); (void)lane;
            const int pos = __builtin_amdgcn_readfirstlane((int)xinfo[0]), npop = __builtin_amdgcn_readfirstlane((int)xinfo[1]), rank = __builtin_amdgcn_readfirstlane((int)xinfo[2]), nloc = __builtin_amdgcn_readfirstlane((int)xinfo[3]);
            const PeerItems it{pos, npop, rank, nloc, wave}; peer_u_wave(a, l, it, lds);
        }
        GRID_BAR();
        {
            PHASE_BEGIN(); (void)lane;
            const int pos = __builtin_amdgcn_readfirstlane((int)xinfo[0]), npop = __builtin_amdgcn_readfirstlane((int)xinfo[1]), rank = __builtin_amdgcn_readfirstlane((int)xinfo[2]), nloc = __builtin_amdgcn_readfirstlane((int)xinfo[3]);
            const PeerItems it{pos, npop, rank, nloc, wave}; peer_v_wave(a, l, it, lds);
        }
        GRID_BAR();
    }
    {
        PHASE_BEGIN(); (void)lane;
        final_norm(a, gw, NGW);
    }
}

extern "C" void kernel_launch(void* const* d_in, const int* in_sizes, int n_in, void* d_out, int out_size, void* d_ws, size_t ws_size, hipStream_t stream) {
    static int grid = 0;
    if (grid == 0) {
        int dev = 0, cus = 0, per_cu = 0;
        if (n_in != 16 || out_size != M * D || ws_size < WS_END2) { fprintf(stderr, "kernel_launch: unexpected shapes (n_in %d out %d ws %zu)\n", n_in, out_size, ws_size); grid = -1; return; }
        (void)hipGetDevice(&dev);
        (void)hipDeviceGetAttribute(&cus, hipDeviceAttributeMultiprocessorCount, dev);
        (void)hipFuncSetAttribute((const void*)mk_fwd, hipFuncAttributeMaxDynamicSharedMemorySize, LDS_BYTES);
        (void)hipOccupancyMaxActiveBlocksPerMultiprocessor(&per_cu, (const void*)mk_fwd, NT, LDS_BYTES);
        if (per_cu < 1) { fprintf(stderr, "kernel_launch: occupancy query says %d blocks per CU\n", per_cu); }
        grid = cus;
        if (grid > 256) grid = 256;
    }
    if (grid < 0) return;
    (void)hipMemsetAsync((char*)d_ws + WS_CTL, 0, CTL_ZERO_BYTES, stream);
    ArgsK a{};
    const GAS float** p = (const GAS float**)&a;
    for (int i = 0; i < 16; ++i) p[i] = (const GAS float*)d_in[i];
    a.out = (GAS float*)d_out; a.ws = (GAS unsigned char*)d_ws;
    void* args[] = {&a};
    hipError_t e = hipLaunchCooperativeKernel((const void*)mk_fwd, dim3(grid), dim3(NT), args, LDS_BYTES, stream);
    if (e != hipSuccess) fprintf(stderr, "cooperative launch failed: %s (grid %d)\n", hipGetErrorString(e), grid);
}
```
